# Optimizing an MI355X kernel written in HIP

```python
import math
import jax, jax.numpy as jnp
from jax import lax
import numpy as np

D_MODEL = 1024
BATCH = 8
SEQ = 2048
DEPTH = 1

D_MIX = D_MODEL
RWKV_WIDTH = D_MIX // 2
RWKV_HEAD = 64
RWKV_HEADS = RWKV_WIDTH // RWKV_HEAD
DECAY_LORA = 64
ICLR_LORA = 64
RWKV_GN_EPS = 64e-5
DIFF_WIDTH = D_MIX - RWKV_WIDTH
DIFF_HEAD_V = 128
DIFF_HEAD_QK = DIFF_HEAD_V // 2
DIFF_HEADS = DIFF_WIDTH // DIFF_HEAD_V
DIFF_QK_WIDTH = DIFF_HEADS * 2 * DIFF_HEAD_QK
Q_BLOCK = 128
NORM_EPS = 1e-6
QK_NORM_EPS = 1e-6
SUBLN_EPS = 1e-5
NEG_INF = -1e30

SHIFT_COLS = 3 * RWKV_WIDTH + DECAY_LORA + ICLR_LORA
SHIFT_SPLIT = (RWKV_WIDTH, 2 * RWKV_WIDTH, 3 * RWKV_WIDTH, 3 * RWKV_WIDTH + DECAY_LORA)
REST_SPLIT = (RWKV_WIDTH, RWKV_WIDTH + DIFF_QK_WIDTH, RWKV_WIDTH + 2 * DIFF_QK_WIDTH,
              RWKV_WIDTH + 2 * DIFF_QK_WIDTH + DIFF_WIDTH)
IN_COLS = SHIFT_COLS + RWKV_WIDTH + 2 * DIFF_QK_WIDTH + 2 * DIFF_WIDTH

kernel_name = "hymba_rwkv7_diffattn_alibi_block"


def rms_norm(x, g, eps):
    xf = x.astype(jnp.float32)
    y = xf * lax.rsqrt(jnp.mean(xf * xf, axis=-1, keepdims=True) + eps)
    return (y * g.astype(jnp.float32)).astype(x.dtype)


def token_shift(p, mu):
    prev = jnp.pad(p, ((0, 0), (1, 0), (0, 0)))[:, :-1]
    return p + (prev - p) * mu


def alibi_slopes(n):
    return jnp.asarray([2.0 ** (-8.0 * (h + 1) / n) for h in range(n)], jnp.float32)


def rwkv7_recurrence(r, w, k, v, a, b):
    B, T, H, N = r.shape

    def step(S, inp):
        r_t, w_t, k_t, v_t, a_t, b_t = inp
        sa = jnp.einsum('bhij,bhj->bhi', S, a_t)
        S = S * w_t[:, :, None, :] + sa[..., None] * b_t[:, :, None, :] + v_t[..., None] * k_t[:, :, None, :]
        y = jnp.einsum('bhij,bhj->bhi', S, r_t)
        return S, y

    xs = tuple(jnp.moveaxis(t, 1, 0) for t in (r, w, k, v, a, b))
    S0 = jnp.zeros((B, H, N, N), jnp.float32)
    _, y = lax.scan(step, S0, xs)
    return jnp.moveaxis(y, 0, 1)


def rwkv7_branch(r, k, v, zw, za, w0, w_decay_up, a0, w_iclr_up, k_k, k_a, r_k, ln_w, ln_b):
    B, T, _ = r.shape
    f32 = jnp.float32
    hn = (RWKV_HEADS, RWKV_HEAD)
    heads = lambda t: t.astype(f32).reshape(B, T, RWKV_HEADS, RWKV_HEAD)
    w = -jax.nn.softplus(-(w0.astype(f32) + jnp.tanh(zw.astype(f32)) @ w_decay_up.astype(f32))) - 0.5
    decay = jnp.exp(-jnp.exp(w))
    a = jax.nn.sigmoid(a0.astype(f32) + za.astype(f32) @ w_iclr_up.astype(f32))
    r, k, v, decay, a = heads(r), heads(k), heads(v), heads(decay), heads(a)
    kk = k * k_k.astype(f32).reshape(hn)
    kk = kk / jnp.maximum(jnp.sqrt(jnp.sum(kk * kk, axis=-1, keepdims=True)), 1e-12)
    k = k * (1.0 + (a - 1.0) * k_a.astype(f32).reshape(hn))
    y = rwkv7_recurrence(r, decay, k, v, -kk, kk * a)
    mu = jnp.mean(y, axis=-1, keepdims=True)
    var = jnp.mean(jnp.square(y - mu), axis=-1, keepdims=True)
    y = (y - mu) * lax.rsqrt(var + RWKV_GN_EPS) * ln_w.astype(f32).reshape(hn) + ln_b.astype(f32).reshape(hn)
    y = y + jnp.sum(r * k * r_k.astype(f32), axis=-1, keepdims=True) * v
    return y.reshape(B, T, RWKV_WIDTH)


def diff_attention_branch(q, k, v, q_norm_g, k_norm_g, lq1, lk1, lq2, lk2, subln_g, lambda_init):
    B, T, _ = q.shape
    f32 = jnp.float32
    q = rms_norm(q.reshape(B, T, DIFF_HEADS, 2, DIFF_HEAD_QK), q_norm_g, QK_NORM_EPS)
    k = rms_norm(k.reshape(B, T, DIFF_HEADS, 2, DIFF_HEAD_QK), k_norm_g, QK_NORM_EPS)
    q = q.transpose(0, 2, 3, 1, 4)
    k = k.transpose(0, 2, 3, 1, 4)
    v = v.reshape(B, T, DIFF_HEADS, DIFF_HEAD_V).transpose(0, 2, 1, 3)
    lam = (jnp.exp(jnp.sum(lq1.astype(f32) * lk1.astype(f32)))
           - jnp.exp(jnp.sum(lq2.astype(f32) * lk2.astype(f32))) + lambda_init)
    slopes = alibi_slopes(DIFF_HEADS)
    scale = DIFF_HEAD_QK ** -0.5
    outs = []
    for blk in range(T // Q_BLOCK):
        q0, q1 = blk * Q_BLOCK, (blk + 1) * Q_BLOCK
        s = jnp.einsum('bhmqd,bhmkd->bhmqk', q[:, :, :, q0:q1], k[:, :, :, :q1]).astype(f32) * scale
        dist = jnp.arange(q0, q1)[:, None] - jnp.arange(q1)[None, :]
        s = s - slopes[None, :, None, None, None] * dist.astype(f32)
        s = jnp.where(dist >= 0, s, NEG_INF)
        p = jax.nn.softmax(s, axis=-1)
        attn = p[:, :, 0] - lam * p[:, :, 1]
        outs.append(jnp.einsum('bhqk,bhkd->bhqd', attn.astype(v.dtype), v[:, :, :q1]))
    o = jnp.concatenate(outs, axis=2).transpose(0, 2, 1, 3)
    o = rms_norm(o, subln_g, SUBLN_EPS).astype(f32) * (1.0 - lambda_init)
    return o.reshape(B, T, DIFF_WIDTH)


def setup_inputs(seed: int = 0) -> dict:
    key = jax.random.key(seed)
    ks = jax.random.split(key, 21)
    f = jnp.float32
    L = DEPTH

    def nrm(k, shape, s):
        return s * jax.random.normal(k, shape, f)

    ramp = (jnp.arange(RWKV_WIDTH, dtype=f) / (RWKV_WIDTH - 1)) ** 0.9
    return {
        "x": jax.random.normal(ks[0], (BATCH, SEQ, D_MODEL), f),
        "norm_g": 1.0 + nrm(ks[1], (L, D_MODEL), 0.02),
        "w_in": nrm(ks[2], (L, D_MODEL, IN_COLS), D_MODEL ** -0.5),
        "shift_mu": jax.random.uniform(ks[3], (L, SHIFT_COLS), f),
        "w0": -6.0 + 5.0 * ramp[None, :] + nrm(ks[4], (L, RWKV_WIDTH), 0.1),
        "w_decay_up": nrm(ks[5], (L, DECAY_LORA, RWKV_WIDTH), 0.1),
        "a0": nrm(ks[6], (L, RWKV_WIDTH), 0.1),
        "w_iclr_up": nrm(ks[7], (L, ICLR_LORA, RWKV_WIDTH), 0.1),
        "k_k": 0.85 + nrm(ks[8], (L, RWKV_WIDTH), 0.05),
        "k_a": 1.0 + nrm(ks[9], (L, RWKV_WIDTH), 0.05),
        "r_k": nrm(ks[10], (L, RWKV_HEADS, RWKV_HEAD), 0.1),
        "ln_x_w": 1.0 + nrm(ks[11], (L, RWKV_WIDTH), 0.02),
        "ln_x_b": nrm(ks[12], (L, RWKV_WIDTH), 0.02),
        "q_norm_g": 1.0 + nrm(ks[13], (L, DIFF_HEAD_QK), 0.02),
        "k_norm_g": 1.0 + nrm(ks[14], (L, DIFF_HEAD_QK), 0.02),
        "lambda_q1": nrm(ks[15], (L, DIFF_HEAD_QK), 0.1),
        "lambda_k1": nrm(ks[16], (L, DIFF_HEAD_QK), 0.1),
        "lambda_q2": nrm(ks[17], (L, DIFF_HEAD_QK), 0.1),
        "lambda_k2": nrm(ks[18], (L, DIFF_HEAD_QK), 0.1),
        "subln_g": 1.0 + nrm(ks[19], (L, DIFF_HEAD_V), 0.02),
        "w_out": nrm(ks[20], (L, D_MIX, D_MODEL), D_MIX ** -0.5),
    }


def reference(x, norm_g, w_in, shift_mu, w0, w_decay_up, a0, w_iclr_up, k_k, k_a, r_k,
              ln_x_w, ln_x_b, q_norm_g, k_norm_g, lambda_q1, lambda_k1, lambda_q2, lambda_k2,
              subln_g, w_out):
    f32 = jnp.float32
    h = x
    for l in range(DEPTH):
        hn = rms_norm(h, norm_g[l], NORM_EPS)
        proj = jnp.einsum('btd,de->bte', hn, w_in[l])
        shifted = token_shift(proj[..., :SHIFT_COLS], shift_mu[l])
        r, k, v, zw, za = jnp.split(shifted, SHIFT_SPLIT, axis=-1)
        g_a, dq, dk, dv, g_b = jnp.split(proj[..., SHIFT_COLS:], REST_SPLIT, axis=-1)
        lambda_init = 0.8 - 0.6 * math.exp(-0.3 * l)
        y_a = rwkv7_branch(r, k, v, zw, za, w0[l], w_decay_up[l], a0[l], w_iclr_up[l],
                           k_k[l], k_a[l], r_k[l], ln_x_w[l], ln_x_b[l])
        y_b = diff_attention_branch(dq, dk, dv, q_norm_g[l], k_norm_g[l], lambda_q1[l], lambda_k1[l],
                                    lambda_q2[l], lambda_k2[l], subln_g[l], lambda_init)
        mixed = jnp.concatenate([y_a * jax.nn.silu(g_a.astype(f32)),
                                 y_b * jax.nn.silu(g_b.astype(f32))], axis=-1)
        h = h + jnp.einsum('bte,ed->btd', mixed.astype(h.dtype), w_out[l])
    return h
```

```cpp
#define MK_N_LAUNCHES 1
#include <hip/hip_runtime.h>
#include <hip/hip_bf16.h>
#include <cstdio>
#include <cstdint>
#include <cmath>
namespace pg8 {
#define PG8_LAS __attribute__((address_space(3)))
typedef unsigned short bf16_t;
typedef short bf16x8 __attribute__((ext_vector_type(8)));
typedef float f32x4 __attribute__((ext_vector_type(4)));
typedef unsigned u32x4 __attribute__((ext_vector_type(4)));
constexpr int BM = 256, BK = 64, HALF = 128, HTB = HALF * BK * 2  , STAGE_BYTES = 8 * HTB, NXCD = 8, WGM = 8;

__host__ __device__ __forceinline__ int lds_byte(int r, int c) { const int st = (r >> 4) * 2 + (c >> 5), rr = r & 15, cc = c & 31, ob = rr * 64 + cc * 2; return st * 1024 + (ob ^ (((ob >> 9) & 1) << 5)); }
__host__ __device__ __forceinline__ void stage_rc(int b, int& R, int& C) { const int st = b / 1024, sb = b % 1024, swz = sb ^ (((sb >> 9) & 1) << 5); R = (st >> 1) * 16 + swz / 64; C = (st & 1) * 32 + (swz % 64) / 2; }
__host__ __device__ __forceinline__ int perm32(int rho) { const int n = rho >> 4, i = rho & 15; return 8 * (i >> 2) + 4 * n + (i & 3); }

struct Unit { int pm, pn; };
struct Gemm { const bf16_t* A; const bf16_t* Bt; int M, N, K; };

struct StaticOrder {
    int nM, nN, nwg, G, c;
    __host__ __device__ void init(int M, int N, int G_, int c_) { nM = M / BM; nN = N / BM; nwg = nM * nN; G = G_; c = c_; }
    __host__ __device__ bool next(int i, Unit& u) const {
        const long L = (long)i * G + c; if (L >= nwg) return false;
        int wgid = (int)L; { const int q = nwg / NXCD, r = nwg % NXCD, xcd = wgid % NXCD, off = wgid / NXCD; wgid = (xcd < r ? xcd * (q + 1) : r * (q + 1) + (xcd - r) * q) + off; }
        const int nig = WGM * nN, gid = wgid / nig, fm = gid * WGM, gsz = (nM - fm) < WGM ? (nM - fm) : WGM;
        u.pm = fm + ((wgid % nig) % gsz); u.pn = (wgid % nig) / gsz; return true;
    }
    __device__ __forceinline__ void a_ready(const Unit&) const {}
    __device__ __forceinline__ void done(const Unit&) const {}
};

__device__ __forceinline__ unsigned cvt_pk_bf16(float lo, float hi) { unsigned r; asm volatile("v_cvt_pk_bf16_f32 %0, %1, %2" : "=v"(r) : "v"(lo), "v"(hi)); return r; }
struct EpiBf16S {
    static constexpr bool PERM = true, AFTER_DRAIN = false;
    bf16_t* O; int ldc;
    __device__ __forceinline__ void operator()(const f32x4 (&acc)[2][2][4][2], const Unit& u, int wr, int wc, int fr, int fq) const {
        const int row0 = u.pm * BM + wr * 64 + fr, col0 = u.pn * BM + wc * 32 + 8 * fq;
#pragma unroll
        for (int ai = 0; ai < 2; ++ai)
#pragma unroll
            for (int m = 0; m < 4; ++m) { bf16_t* rowp = O + (size_t)(row0 + ai * HALF + m * 16) * ldc + col0;
#pragma unroll
                for (int bj = 0; bj < 2; ++bj) { const f32x4 v0 = acc[ai][bj][m][0], v1 = acc[ai][bj][m][1];
                    u32x4 w; w.x = cvt_pk_bf16(v0[0], v0[1]); w.y = cvt_pk_bf16(v0[2], v0[3]); w.z = cvt_pk_bf16(v1[0], v1[1]); w.w = cvt_pk_bf16(v1[2], v1[3]);
                    *(u32x4*)(rowp + bj * HALF) = w; } }
    }
};
struct EpiResF32 {
    static constexpr bool PERM = false, AFTER_DRAIN = false;
    const float* base; float* out; int ldc;
    __device__ __forceinline__ void operator()(const f32x4 (&acc)[2][2][4][2], const Unit& u, int wr, int wc, int fr, int fq) const {
        const int row0 = u.pm * BM + wr * 64 + fr, col0 = u.pn * BM + wc * 32 + 4 * fq;
#pragma unroll
        for (int ai = 0; ai < 2; ++ai)
#pragma unroll
            for (int m = 0; m < 4; ++m) { const size_t off = (size_t)(row0 + ai * HALF + m * 16) * ldc + col0;
#pragma unroll
                for (int bj = 0; bj < 2; ++bj)
#pragma unroll
                    for (int n = 0; n < 2; ++n) { const f32x4 bs = *(const f32x4*)(base + off + bj * HALF + n * 16); *(f32x4*)(out + off + bj * HALF + n * 16) = bs + acc[ai][bj][m][n]; } }
    }
};
template <class Epi, class Sched, bool ALIGN_EPI = false, bool SP2 = false>
__device__ __forceinline__ void gemm_phase(PG8_LAS unsigned char* lds, const Gemm g, const Sched& S, const Epi& E) {
    const int tid = threadIdx.x, wid = __builtin_amdgcn_readfirstlane(tid >> 6), lane = tid & 63, wr = wid >> 2, wc = wid & 3, fr = lane & 15, fq = lane >> 4;
    const int K = g.K, nt = K / BK;
    unsigned voffA[2], voffB[2];
#pragma unroll
    for (int i = 0; i < 2; ++i) { int R, C; stage_rc(tid * 16 + i * 8192, R, C); const int Rb = Epi::PERM ? ((R & ~31) + perm32(R & 31)) : R;
        voffA[i] = (unsigned)(R * K + C) * 2u; voffB[i] = (unsigned)(Rb * K + C) * 2u; }
    const size_t kstep = (size_t)(BK * 2);
    const size_t hstep = (size_t)HALF * K * 2;
    const size_t tstep = 2 * hstep;
    const unsigned ldsw = (unsigned)wid * 1024u;
    const int aoff = lds_byte(wr * 64 + fr, fq * 8), boff = lds_byte(wc * 32 + fr, fq * 8);
#define PG8_SA(b, h) (((b) * 2 + (h)) * HTB)
#define PG8_SB(b, h) ((4 + (b) * 2 + (h)) * HTB)
#define PG8_STAGE(bufoff, gbase, voff) do { _Pragma("unroll") for (int _i = 0; _i < 2; ++_i) \
        __builtin_amdgcn_global_load_lds((const unsigned*)((const char*)(gbase) + (voff)[_i]), (PG8_LAS unsigned*)(lds + (bufoff) + ldsw + _i * 8192), 16, 0, 0); } while (0)
#define PG8_LDA(dst, b, h) do { _Pragma("unroll") for (int m = 0; m < 4; ++m) _Pragma("unroll") for (int k = 0; k < 2; ++k) dst[m][k] = *(const PG8_LAS bf16x8*)(lds + PG8_SA(b, h) + aoff + m * 2048 + k * 1024); } while (0)
#define PG8_LDB(dst, b, h) do { _Pragma("unroll") for (int n = 0; n < 2; ++n) _Pragma("unroll") for (int k = 0; k < 2; ++k) dst[n][k] = *(const PG8_LAS bf16x8*)(lds + PG8_SB(b, h) + boff + n * 2048 + k * 1024); } while (0)
#define PG8_MMA(ai, bj, At, Bt) do { __builtin_amdgcn_s_setprio(1); _Pragma("unroll") for (int m = 0; m < 4; ++m) _Pragma("unroll") for (int n = 0; n < 2; ++n) _Pragma("unroll") for (int k = 0; k < 2; ++k) \
        acc[ai][bj][m][n] = __builtin_amdgcn_mfma_f32_16x16x32_bf16(Bt[n][k], At[m][k], acc[ai][bj][m][n], 0, 0, 0); __builtin_amdgcn_s_setprio(0); } while (0)
#define PG8_WAIT_V(n) asm volatile("s_waitcnt vmcnt(" #n ")" ::: "memory")
#define PG8_WAIT_L(n) asm volatile("s_waitcnt lgkmcnt(" #n ")" ::: "memory")
#define PG8_BAR __builtin_amdgcn_s_barrier()
#define PG8_SCHED __builtin_amdgcn_sched_barrier(0)
    Unit cur, nxt; int ui = 0;
    if (!S.next(0, cur)) return;
    f32x4 acc[2][2][4][2];
#pragma unroll
    for (int a = 0; a < 2; ++a)
#pragma unroll
        for (int b = 0; b < 2; ++b)
#pragma unroll
            for (int m = 0; m < 4; ++m)
#pragma unroll
                for (int n = 0; n < 2; ++n) acc[a][b][m][n] = (f32x4){0.f, 0.f, 0.f, 0.f};
    bf16x8 At[4][2], B0[2][2], B1[2][2];
    const char* cA = (const char*)g.A + (size_t)cur.pm * tstep; const char* cB = (const char*)g.Bt + (size_t)cur.pn * tstep;
    S.a_ready(cur);
    if constexpr (SP2) {
        PG8_STAGE(PG8_SB(0, 0), cB, voffB); PG8_STAGE(PG8_SB(0, 1), cB + hstep, voffB); PG8_STAGE(PG8_SA(0, 0), cA, voffA); PG8_STAGE(PG8_SA(0, 1), cA + hstep, voffA);
        if (wr == 1) PG8_BAR;
        PG8_WAIT_V(2); PG8_BAR;
        PG8_STAGE(PG8_SB(1, 0), cB + kstep, voffB); PG8_STAGE(PG8_SA(1, 0), cA + kstep, voffA); PG8_STAGE(PG8_SB(1, 1), cB + hstep + kstep, voffB);
        PG8_WAIT_V(6); PG8_BAR;
    } else {
        PG8_STAGE(PG8_SB(0, 0), cB, voffB); PG8_STAGE(PG8_SA(0, 0), cA, voffA); PG8_STAGE(PG8_SB(0, 1), cB + hstep, voffB); PG8_STAGE(PG8_SA(0, 1), cA + hstep, voffA);
        if (wr == 1) PG8_BAR;
        PG8_WAIT_V(4); PG8_BAR;
        PG8_STAGE(PG8_SB(1, 0), cB + kstep, voffB); PG8_STAGE(PG8_SA(1, 0), cA + kstep, voffA); PG8_STAGE(PG8_SB(1, 1), cB + hstep + kstep, voffB);
        PG8_WAIT_V(6); PG8_BAR;
    }
    for (;;) {
        const bool has_next = S.next(ui + 1, nxt);
        const char* nA = has_next ? (const char*)g.A + (size_t)nxt.pm * tstep : cA; const char* nB = has_next ? (const char*)g.Bt + (size_t)nxt.pn * tstep : cB;
        for (int t = 0; t < nt; t += 2) {
            const bool last = (t == nt - 2);
            const char* a1 = cA + (size_t)(t + 1) * kstep;
            const char* a2 = last ? nA : cA + (size_t)(t + 2) * kstep; const char* b2 = last ? nB : cB + (size_t)(t + 2) * kstep;
            const char* a3 = a2 + kstep; const char* b3 = b2 + kstep;
            if (last && has_next) S.a_ready(nxt);
            if constexpr (SP2) {
            PG8_LDB(B0, 0, 0); PG8_LDB(B1, 0, 1); PG8_SCHED; PG8_LDA(At, 0, 0); PG8_STAGE(PG8_SA(1, 1), a1 + hstep, voffA);
            PG8_WAIT_V(8); PG8_WAIT_L(0); PG8_BAR; PG8_MMA(0, 0, At, B0); PG8_MMA(0, 1, At, B1); PG8_BAR; PG8_SCHED;
            PG8_LDA(At, 0, 1); PG8_STAGE(PG8_SB(0, 0), b2, voffB); PG8_STAGE(PG8_SB(0, 1), b2 + hstep, voffB); PG8_STAGE(PG8_SA(0, 0), a2, voffA);
            PG8_WAIT_V(8); PG8_WAIT_L(0); PG8_BAR; PG8_MMA(1, 0, At, B0); PG8_MMA(1, 1, At, B1); PG8_BAR; PG8_SCHED;
            PG8_LDB(B0, 1, 0); PG8_LDB(B1, 1, 1); PG8_SCHED; PG8_LDA(At, 1, 0); PG8_STAGE(PG8_SA(0, 1), a2 + hstep, voffA);
            PG8_WAIT_V(8); PG8_WAIT_L(0); PG8_BAR; PG8_MMA(0, 0, At, B0); PG8_MMA(0, 1, At, B1); PG8_BAR; PG8_SCHED;
            PG8_LDA(At, 1, 1); PG8_STAGE(PG8_SB(1, 0), b3, voffB); PG8_STAGE(PG8_SB(1, 1), b3 + hstep, voffB); PG8_STAGE(PG8_SA(1, 0), a3, voffA);
            PG8_WAIT_V(8); PG8_WAIT_L(0); PG8_BAR; PG8_MMA(1, 0, At, B0); PG8_MMA(1, 1, At, B1); PG8_BAR; PG8_SCHED;
            } else {
            PG8_LDB(B0, 0, 0); PG8_SCHED; PG8_LDA(At, 0, 0); PG8_STAGE(PG8_SA(1, 1), a1 + hstep, voffA);
            PG8_WAIT_L(8); PG8_BAR; PG8_WAIT_L(0); PG8_MMA(0, 0, At, B0); PG8_BAR; PG8_SCHED;
            PG8_LDB(B1, 0, 1); PG8_STAGE(PG8_SB(0, 0), b2, voffB);
            PG8_BAR; PG8_WAIT_L(0); PG8_MMA(0, 1, At, B1); PG8_BAR;
            PG8_LDA(At, 0, 1); PG8_STAGE(PG8_SA(0, 0), a2, voffA);
            PG8_BAR; PG8_WAIT_L(0); PG8_MMA(1, 0, At, B0); PG8_BAR; PG8_SCHED;
            PG8_STAGE(PG8_SB(0, 1), b2 + hstep, voffB);
            PG8_WAIT_V(6); PG8_BAR; PG8_MMA(1, 1, At, B1); PG8_BAR;
            PG8_LDB(B0, 1, 0); PG8_SCHED; PG8_LDA(At, 1, 0); PG8_STAGE(PG8_SA(0, 1), a2 + hstep, voffA);
            PG8_WAIT_L(8); PG8_BAR; PG8_WAIT_L(0); PG8_MMA(0, 0, At, B0); PG8_BAR; PG8_SCHED;
            PG8_LDB(B1, 1, 1); PG8_STAGE(PG8_SB(1, 0), b3, voffB);
            PG8_BAR; PG8_WAIT_L(0); PG8_MMA(0, 1, At, B1); PG8_BAR;
            PG8_LDA(At, 1, 1); PG8_STAGE(PG8_SA(1, 0), a3, voffA);
            PG8_BAR; PG8_WAIT_L(0); PG8_MMA(1, 0, At, B0); PG8_BAR; PG8_SCHED;
            PG8_STAGE(PG8_SB(1, 1), b3 + hstep, voffB);
            PG8_WAIT_V(6); PG8_BAR; PG8_MMA(1, 1, At, B1); PG8_BAR;
            }
        }
        if constexpr (ALIGN_EPI) { if (wr == 0) PG8_BAR; }
        if constexpr (!Epi::AFTER_DRAIN) { E(acc, cur, wr, wc, fr, fq); S.done(cur); }
        if (!has_next) break;
#pragma unroll
        for (int a = 0; a < 2; ++a)
#pragma unroll
            for (int b = 0; b < 2; ++b)
#pragma unroll
                for (int m = 0; m < 4; ++m)
#pragma unroll
                    for (int n = 0; n < 2; ++n) acc[a][b][m][n] = (f32x4){0.f, 0.f, 0.f, 0.f};
        cur = nxt; cA = nA; cB = nB; ++ui;
        if constexpr (ALIGN_EPI) { if (wr == 1) PG8_BAR; }
    }
    PG8_WAIT_V(0);
    if constexpr (!ALIGN_EPI) { if (wr == 0) PG8_BAR; }
    PG8_BAR;
    if constexpr (Epi::AFTER_DRAIN) { E.fused(acc, cur, wr, wc, fr, fq, lds, wid, lane); S.done(cur); }
#undef PG8_SA
#undef PG8_SB
#undef PG8_STAGE
#undef PG8_LDA
#undef PG8_LDB
#undef PG8_MMA
#undef PG8_WAIT_V
#undef PG8_WAIT_L
#undef PG8_BAR
#undef PG8_SCHED
}
}
constexpr int NWAVES = 8;
#ifndef MK_N_LAUNCHES
#define MK_N_LAUNCHES 1
#endif
constexpr int N_PHASES = 6;
constexpr int BATCH = 8, T = 2048, D = 1024, M = BATCH * T;
constexpr int NP = 4352;
constexpr int C_R = 0, C_K = 512, C_V = 1024, C_ZW = 1536, C_ZA = 1600, C_GA = 1792, C_DQ = 2304, C_DK = 2816, C_DV = 3328, C_GB = 3840;
constexpr int RH = 8, RN = 64;
constexpr int AH = 4;
constexpr float C2 = 0.125f * 1.4426950408889634f;
constexpr float LOG2E = 1.4426950408889634f;
constexpr float LAMBDA_INIT = 0.2f;

constexpr size_t MiB = 1u << 20;
constexpr size_t WS_CTL = 0, CTL_ZERO_BYTES = 1 * MiB;
constexpr size_t WS_WIN = 2 * MiB;
constexpr size_t WS_WOUT = 11 * MiB;
constexpr size_t WS_WD = 13 * MiB, WS_WA = 13 * MiB + 65536;
constexpr size_t WS_RHO = 13 * MiB + 2 * 65536;
constexpr size_t WS_XN = 14 * MiB;
constexpr size_t WS_PROJ = 46 * MiB;
constexpr size_t WS_MIX = 182 * MiB;
constexpr size_t WS_END = 214 * MiB;
constexpr int CW_BAR = 4096;

constexpr int RING_OFF = 0, RING_BYTES = 131072;
constexpr int LDSCTL_OFF = RING_BYTES, MISC_OFF = LDSCTL_OFF + 320;
constexpr int LDS_BYTES = 147456;

#define GAS __attribute__((address_space(1)))
#define LAS __attribute__((address_space(3)))
typedef unsigned short bf16;
typedef unsigned v4u __attribute__((ext_vector_type(4)));
typedef unsigned v2u __attribute__((ext_vector_type(2)));
typedef float f32x4 __attribute__((ext_vector_type(4)));
typedef float f32x16 __attribute__((ext_vector_type(16)));
typedef short bf16x8 __attribute__((ext_vector_type(8)));
typedef short s16x4 __attribute__((ext_vector_type(4)));
typedef GAS unsigned gu32;
typedef GAS unsigned long long gu64;
#define RLX_AGENT __ATOMIC_RELAXED, __HIP_MEMORY_SCOPE_AGENT
#define LDS_WAIT() asm volatile("s_waitcnt lgkmcnt(0)" ::: "memory")
#define VM_WAIT() asm volatile("s_waitcnt vmcnt(0)" ::: "memory")
__device__ __forceinline__ unsigned f2bf(float f) { unsigned u = __builtin_bit_cast(unsigned, f); return (u + 0x7fffu + ((u >> 16) & 1u)) >> 16; }
__device__ __forceinline__ unsigned pk2(float lo, float hi) { return f2bf(lo) | (f2bf(hi) << 16); }
__device__ __forceinline__ float bflo(unsigned u) { return __uint_as_float(u << 16); }
__device__ __forceinline__ float bfhi(unsigned u) { return __uint_as_float(u & 0xffff0000u); }
__device__ __forceinline__ float bf1(unsigned short u) { return __uint_as_float((unsigned)u << 16); }
#define XB_TMO      128
#define XB_XCNT(j)  (256  + 64 * (j))
#define XB_XSUB(j)  (1280 + 64 * (j))
#define XB_XGEN(j)  (2304 + 64 * (j))
#define XB_TOP      3328
#define XB_TOPGEN   3392
#define XCD_BAR_WORDS 3456
#define XB_SPIN_CAP (1u << 18)

__device__ __forceinline__ unsigned xb_ld(unsigned* p)              { return __hip_atomic_load(p, __ATOMIC_RELAXED, __HIP_MEMORY_SCOPE_AGENT); }
__device__ __forceinline__ unsigned xb_add(unsigned* p, unsigned v) { return __hip_atomic_fetch_add(p, v, __ATOMIC_RELAXED, __HIP_MEMORY_SCOPE_AGENT); }
__device__ __forceinline__ unsigned xb_xcc_id() { return (unsigned)__builtin_amdgcn_s_getreg((3 << 11) | 20) & 0xFu; }
#define XB_SPIN(cond, bar) do { unsigned _sp = 0; while (cond) { __builtin_amdgcn_s_sleep(1); \
    if ((++_sp & 255u) == 0u) { if (xb_ld(&(bar)[XB_TMO])) break; if (_sp > XB_SPIN_CAP) { atomicAdd(&(bar)[XB_TMO], 1u); break; } } } } while (0)

struct XcdBarrier {
    unsigned* bar; unsigned x;
    volatile LAS unsigned* st;
};

__device__ __forceinline__ XcdBarrier xcd_barrier_post(unsigned* bar, volatile LAS unsigned* st) {
    XcdBarrier b; b.bar = bar; b.x = xb_xcc_id(); b.st = st;
    if (threadIdx.x == 0) (void)xb_add(&bar[XB_XCNT(b.x)], 1u);
    return b;
}
__device__ __forceinline__ void xcd_barrier_complete(unsigned* bar, unsigned x, unsigned& nloc, unsigned& nx) {
    const unsigned G = gridDim.x * gridDim.y * gridDim.z;
    unsigned sum, cnt, mine, sp = 0u;
    for (;;) {
        sum = 0u; cnt = 0u; mine = 0u;
#pragma unroll
        for (unsigned j = 0; j < 16; ++j) { const unsigned c = xb_ld(&bar[XB_XCNT(j)]); sum += c; cnt += (c > 0u) ? 1u : 0u; mine = (j == x) ? c : mine; }
        if (sum == G) break;
        __builtin_amdgcn_s_sleep(1);
        if ((++sp & 255u) == 0u) { if (xb_ld(&bar[XB_TMO])) break; if (sp > XB_SPIN_CAP) { atomicAdd(&bar[XB_TMO], 1u); break; } }
    }
    nloc = mine > 0u ? mine : 1u; nx = cnt > 0u ? cnt : 1u;
}

__device__ __forceinline__ void xcd_barrier(const XcdBarrier& b) {
    asm volatile("s_waitcnt vmcnt(0)" ::: "memory");
    __syncthreads();
    if (threadIdx.x == 0) {
        unsigned* bar = b.bar;
        __builtin_amdgcn_s_waitcnt(0);
        unsigned nloc = b.st[0], nx = b.st[1];
        if (nloc == 0u) { xcd_barrier_complete(bar, b.x, nloc, nx); b.st[0] = nloc; b.st[1] = nx; }
        const unsigned old = xb_add(&bar[XB_XSUB(b.x)], 1u);
        const unsigned gen = old / nloc;
        if (old + 1u == (gen + 1u) * nloc) {
            __builtin_amdgcn_fence(__ATOMIC_RELEASE, "agent");
            asm volatile("s_waitcnt vmcnt(0)" ::: "memory");
            const unsigned og = xb_add(&bar[XB_TOP], 1u);
            const unsigned tg = og / nx;
            if (og + 1u == (tg + 1u) * nx) xb_add(&bar[XB_TOPGEN], 1u);
            else XB_SPIN(xb_ld(&bar[XB_TOPGEN]) == tg, bar);
            __builtin_amdgcn_fence(__ATOMIC_ACQUIRE, "agent");
            xb_add(&bar[XB_XGEN(b.x)], 1u);
            asm volatile("s_waitcnt vmcnt(0)" ::: "memory");
        } else {
            XB_SPIN(xb_ld(&bar[XB_XGEN(b.x)]) == gen, bar);
            __builtin_amdgcn_fence(__ATOMIC_ACQUIRE, "agent");
            asm volatile("s_waitcnt vmcnt(0)" ::: "memory");
        }
    }
    __syncthreads();
}
struct Frame {
    LAS unsigned char* lds;
    volatile LAS unsigned* MISC;
    gu32* ctl;
    int tid, lane, wave;
    int vcu, G;
    const float* x; float* out;
    const float *norm_g, *w_in, *shift_mu, *w0, *w_decay_up, *a0, *w_iclr_up, *k_k, *k_a, *r_k, *ln_w, *ln_b, *qn_g, *kn_g, *lq1, *lk1, *lq2, *lk2, *subln_g, *w_out;
    bf16 *WinT, *WoutT, *WdT, *WaT, *XN, *PROJ, *MIX;
    float *RHO, *Y;
    bf16 *KT, *AHt, *BHt, *LW;
};

__device__ __forceinline__ float wave_sum(float v) {
#pragma unroll
    for (int o = 1; o < 64; o <<= 1) v += __shfl_xor(v, o);
    return v;
}
template <int CTRL> __device__ __forceinline__ float dpp_f(float x) { return __builtin_bit_cast(float, __builtin_amdgcn_mov_dpp(__builtin_bit_cast(int, x), CTRL, 0xf, 0xf, true)); }
__device__ __forceinline__ float row16_sum(float x) {
    x += dpp_f<0xB1>(x); x += dpp_f<0x4E>(x); x += dpp_f<0x141>(x); x += dpp_f<0x140>(x); return x;
}
__device__ __forceinline__ float swap32_sum(float x) {
    auto rr = __builtin_amdgcn_permlane32_swap(__float_as_uint(x), __float_as_uint(x), false, false);
    return __uint_as_float(rr[0]) + __uint_as_float(rr[1]);
}

__device__ __forceinline__ void p0_transpose_item(const float* W, int N, int nsrc, const float* kscale, bf16* WT, int K, int ndst, LAS float* scr, int k0, int lane) {
#pragma unroll 8
    for (int i = 0; i < 32; ++i) { const int kk = 2 * i + (lane >> 5);
        float v = 0.f; if (nsrc >= 0) { v = W[(size_t)(k0 + kk) * N + nsrc + (lane & 31)]; if (kscale) v *= kscale[k0 + kk]; }
        scr[kk * 33 + (lane & 31)] = v; }
    LDS_WAIT(); asm volatile("" ::: "memory");
    const int c = lane & 7;
#pragma unroll
    for (int j = 0; j < 4; ++j) { const int n = (lane >> 3) + 8 * j; const LAS float* s = scr + (8 * c) * 33 + n;
        v4u o; o.x = pk2(s[0 * 33], s[1 * 33]); o.y = pk2(s[2 * 33], s[3 * 33]); o.z = pk2(s[4 * 33], s[5 * 33]); o.w = pk2(s[6 * 33], s[7 * 33]);
        *(GAS v4u*)(WT + (size_t)(ndst + n) * K + k0 + 8 * c) = o; }
    LDS_WAIT(); asm volatile("" ::: "memory");
}
__device__ __forceinline__ void p0_prologue(Frame& F) {
    LAS float* scr = (LAS float*)(F.lds + RING_OFF + F.wave * 16384);
    const int gw = F.vcu * NWAVES + F.wave, NGW = F.G * NWAVES;
    constexpr int I_IN = (D / 64) * (NP / 32), I_OUT = (D / 64) * (D / 32), I_L = 512 / 32;
    constexpr int NITEMS = I_IN + I_OUT + 2 * I_L;
    for (int it = gw; it < NITEMS; it += NGW) {
        int r = it;
        if (r < I_IN) { const int kb = r / (NP / 32), nb = r % (NP / 32), nd = 32 * nb; const int ns = nd < 1664 ? nd : (nd < 1792 ? -1 : nd - 128);
            p0_transpose_item(F.w_in, 4224, ns, F.norm_g, F.WinT, D, nd, scr, 64 * kb, F.lane); continue; } r -= I_IN;
        if (r < I_OUT) { const int kb = r / (D / 32), nb = r % (D / 32);
            p0_transpose_item(F.w_out, D, 32 * nb, nullptr, F.WoutT, D, 32 * nb, scr, 64 * kb, F.lane); continue; } r -= I_OUT;
        if (r < I_L) { p0_transpose_item(F.w_decay_up, 512, 32 * r, nullptr, F.WdT, 64, 32 * r, scr, 0, F.lane); continue; } r -= I_L;
        p0_transpose_item(F.w_iclr_up, 512, 32 * r, nullptr, F.WaT, 64, 32 * r, scr, 0, F.lane);
    }
    for (int m = gw; m < M; m += NGW) {
        const GAS f32x4* xr = (const GAS f32x4*)(F.x + (size_t)m * D) + F.lane;
        f32x4 v[4]; float s = 0.f;
#pragma unroll
        for (int j = 0; j < 4; ++j) { v[j] = xr[64 * j]; s += (v[j].x * v[j].x + v[j].y * v[j].y) + (v[j].z * v[j].z + v[j].w * v[j].w); }
        const float rstd = 1.f / sqrtf(wave_sum(s) * (1.f / D) + 1e-6f);
        GAS unsigned long long* o8 = (GAS unsigned long long*)(F.XN + (size_t)m * D) + F.lane;
#pragma unroll
        for (int j = 0; j < 4; ++j) o8[64 * j] = (unsigned long long)pk2(v[j].x * rstd, v[j].y * rstd) | ((unsigned long long)pk2(v[j].z * rstd, v[j].w * rstd) << 32);
    }
}

__device__ __forceinline__ float tanh_f(float x) { const float e = __expf(-2.f * fabsf(x)); const float t = (1.f - e) / (1.f + e); return x < 0.f ? -t : t; }
__device__ __forceinline__ void shifted8(const bf16* proj, size_t m, bool has_prev, int col, const float* mu, float (&o)[8]) {
    const v4u c = *(const GAS v4u*)(proj + m * NP + col);
    v4u p = (v4u){0u, 0u, 0u, 0u}; if (has_prev) p = *(const GAS v4u*)(proj + (m - 1) * NP + col);
    const f32x4 m0 = *(const GAS f32x4*)(mu), m1 = *(const GAS f32x4*)(mu + 4);
    const unsigned cw[4] = {c.x, c.y, c.z, c.w}, pw[4] = {p.x, p.y, p.z, p.w}; const float mm[8] = {m0.x, m0.y, m0.z, m0.w, m1.x, m1.y, m1.z, m1.w};
#pragma unroll
    for (int j = 0; j < 4; ++j) { const float c0 = bflo(cw[j]), c1 = bfhi(cw[j]), p0 = bflo(pw[j]), p1 = bfhi(pw[j]);
        o[2 * j] = c0 + (p0 - c0) * mm[2 * j]; o[2 * j + 1] = c1 + (p1 - c1) * mm[2 * j + 1]; }
}
__device__ __forceinline__ void shifted4(const bf16* proj, size_t m, bool has_prev, int col, const float* mu, float (&o)[4]) {
    const v2u c = *(const GAS v2u*)(proj + m * NP + col);
    v2u p = (v2u){0u, 0u}; if (has_prev) p = *(const GAS v2u*)(proj + (m - 1) * NP + col);
    const f32x4 m0 = *(const GAS f32x4*)(mu);
    o[0] = bflo(c.x) + (bflo(p.x) - bflo(c.x)) * m0.x; o[1] = bfhi(c.x) + (bfhi(p.x) - bfhi(c.x)) * m0.y;
    o[2] = bflo(c.y) + (bflo(p.y) - bflo(c.y)) * m0.z; o[3] = bfhi(c.y) + (bfhi(p.y) - bfhi(c.y)) * m0.w;
}
__device__ __forceinline__ void p2_prep_tile(Frame& F, int tt) {
    const int w = F.wave, lane = F.lane, hi = lane >> 5, l31 = lane & 31;
    const int b = tt >> 5, t0 = (tt & 31) * 64; const size_t m0 = (size_t)tt * 64;
    const int bh = b * RH + w;
#pragma unroll 1
    for (int tb = 0; tb < 2; ++tb) {
        const int tok = tb * 32 + l31, t = t0 + tok; const size_t m = m0 + tok; const bool hp = t > 0;
        const size_t obase = ((size_t)bh * T + t) * 64;
        float ss = 0.f;
#pragma unroll
        for (int gq = 0; gq < 8; ++gq) { const int hc = w * 64 + 8 * gq + 4 * hi; float k4[4]; shifted4(F.PROJ, m, hp, C_K + hc, F.shift_mu + 512 + hc, k4);
            const f32x4 kkp = *(const GAS f32x4*)(F.k_k + hc);
#pragma unroll
            for (int e = 0; e < 4; ++e) { const float q = k4[e] * kkp[e]; ss += q * q; } }
        ss = swap32_sum(ss);
        const float inv = 1.f / fmaxf(sqrtf(ss), 1e-12f);
        v4u bz[4], ba[4];
#pragma unroll
        for (int s = 0; s < 4; ++s) {
            const int col = 16 * s + 8 * hi; float zw[8], za[8];
            shifted8(F.PROJ, m, hp, C_ZW + col, F.shift_mu + 1536 + col, zw);
            shifted8(F.PROJ, m, hp, C_ZA + col, F.shift_mu + 1600 + col, za);
            bz[s].x = pk2(tanh_f(zw[0]), tanh_f(zw[1])); bz[s].y = pk2(tanh_f(zw[2]), tanh_f(zw[3])); bz[s].z = pk2(tanh_f(zw[4]), tanh_f(zw[5])); bz[s].w = pk2(tanh_f(zw[6]), tanh_f(zw[7]));
            ba[s].x = pk2(za[0], za[1]); ba[s].y = pk2(za[2], za[3]); ba[s].z = pk2(za[4], za[5]); ba[s].w = pk2(za[6], za[7]);
        }
        float rho = 0.f;
#pragma unroll 1
        for (int cb = 0; cb < 2; ++cb) {
            f32x16 accd = f32x16{}, acca = f32x16{};
#pragma unroll
            for (int s = 0; s < 4; ++s) {
                const int col = 16 * s + 8 * hi;
                const bf16x8 aD = *(const GAS bf16x8*)(F.WdT + (size_t)(w * 64 + cb * 32 + l31) * 64 + col);
                const bf16x8 aA = *(const GAS bf16x8*)(F.WaT + (size_t)(w * 64 + cb * 32 + l31) * 64 + col);
                accd = __builtin_amdgcn_mfma_f32_32x32x16_bf16(aD, __builtin_bit_cast(bf16x8, bz[s]), accd, 0, 0, 0);
                acca = __builtin_amdgcn_mfma_f32_32x32x16_bf16(aA, __builtin_bit_cast(bf16x8, ba[s]), acca, 0, 0, 0);
            }
#pragma unroll
            for (int rg = 0; rg < 4; ++rg) {
                const int ch0 = 32 * cb + 8 * rg + 4 * hi, hc = w * 64 + ch0;
                float rr[4], kk4[4];
                shifted4(F.PROJ, m, hp, C_R + hc, F.shift_mu + hc, rr);
                shifted4(F.PROJ, m, hp, C_K + hc, F.shift_mu + 512 + hc, kk4);
                const f32x4 w0v = *(const GAS f32x4*)(F.w0 + hc), a0v = *(const GAS f32x4*)(F.a0 + hc), kkp = *(const GAS f32x4*)(F.k_k + hc), kap = *(const GAS f32x4*)(F.k_a + hc), rkp = *(const GAS f32x4*)(F.r_k + hc);
                float ktv[4], lwv[4], ahv[4], bhv[4];
#pragma unroll
                for (int e = 0; e < 4; ++e) {
                    const int r = 4 * rg + e;
                    const float nx = -(w0v[e] + accd[r]); const float sp = fmaxf(nx, 0.f) + log1pf(__expf(-fabsf(nx)));
                    lwv[e] = -__expf(-sp - 0.5f);
                    const float a = 1.f / (1.f + __expf(-(a0v[e] + acca[r])));
                    const float kk = kk4[e] * kkp[e] * inv;
                    ahv[e] = -kk; bhv[e] = kk * a;
                    ktv[e] = kk4[e] * (1.f + (a - 1.f) * kap[e]);
                    rho += rr[e] * ktv[e] * rkp[e];
                }
                *(GAS v2u*)(F.KT + obase + ch0) = (v2u){pk2(ktv[0], ktv[1]), pk2(ktv[2], ktv[3])};
                *(GAS v2u*)(F.LW + obase + ch0) = (v2u){pk2(lwv[0], lwv[1]), pk2(lwv[2], lwv[3])};
                *(GAS v2u*)(F.AHt + obase + ch0) = (v2u){pk2(ahv[0], ahv[1]), pk2(ahv[2], ahv[3])};
                *(GAS v2u*)(F.BHt + obase + ch0) = (v2u){pk2(bhv[0], bhv[1]), pk2(bhv[2], bhv[3])};
            }
        }
        rho = swap32_sum(rho);
        if (hi == 0) F.RHO[(size_t)bh * T + t] = rho;
    }
}
__device__ __forceinline__ void p2_qknorm(Frame& F) {
    const int gw = F.vcu * NWAVES + F.wave, NGW = F.G * NWAVES, lane = F.lane, sub = lane & 7;
    for (int it = gw; it < 2 * M; it += NGW) {
        const size_t m = (size_t)(it >> 1); const int isk = it & 1;
        bf16* p = F.PROJ + m * NP + (isk ? C_DK : C_DQ) + (lane >> 3) * 64 + sub * 8;
        const v4u c = *(const GAS v4u*)p; const unsigned cw[4] = {c.x, c.y, c.z, c.w};
        float xv[8]; float ss = 0.f;
#pragma unroll
        for (int j = 0; j < 4; ++j) { xv[2 * j] = bflo(cw[j]); xv[2 * j + 1] = bfhi(cw[j]); ss += xv[2 * j] * xv[2 * j] + xv[2 * j + 1] * xv[2 * j + 1]; }
        ss += __shfl_xor(ss, 1); ss += __shfl_xor(ss, 2); ss += __shfl_xor(ss, 4);
        const float r = (1.f / sqrtf(ss * (1.f / 64.f) + 1e-6f)) * (isk ? 1.f : C2);
        const float* g = (isk ? F.kn_g : F.qn_g) + sub * 8;
        const f32x4 g0 = *(const GAS f32x4*)g, g1 = *(const GAS f32x4*)(g + 4);
        v4u o; o.x = pk2(xv[0] * r * g0.x, xv[1] * r * g0.y); o.y = pk2(xv[2] * r * g0.z, xv[3] * r * g0.w); o.z = pk2(xv[4] * r * g1.x, xv[5] * r * g1.y); o.w = pk2(xv[6] * r * g1.z, xv[7] * r * g1.w);
        *(GAS v4u*)p = o;
    }
}

__device__ __forceinline__ void p3_scan(Frame& F, int item) {
    const int lane = F.lane, bh = item >> 2, rg = item & 3;
    const int b = bh >> 3, h = bh & 7;
    const int row = rg * 16 + F.wave * 2 + ((lane >> 4) & 1), g = (lane & 15) + 16 * (lane >> 5);
    const GAS unsigned* kt = (const GAS unsigned*)(F.KT + (size_t)bh * T * 64) + g;
    const GAS unsigned* ah = (const GAS unsigned*)(F.AHt + (size_t)bh * T * 64) + g;
    const GAS unsigned* bhp = (const GAS unsigned*)(F.BHt + (size_t)bh * T * 64) + g;
    const GAS unsigned* lw = (const GAS unsigned*)(F.LW + (size_t)bh * T * 64) + g;
    const GAS unsigned* rp = (const GAS unsigned*)(F.PROJ + (size_t)b * T * NP + C_R + h * 64) + g;
    const GAS unsigned short* vp = (const GAS unsigned short*)(F.PROJ + (size_t)b * T * NP + C_V + h * 64 + row);
    const float mur0 = F.shift_mu[h * 64 + 2 * g], mur1 = F.shift_mu[h * 64 + 2 * g + 1], muv = F.shift_mu[1024 + h * 64 + row];
    float* yo = F.Y + (size_t)bh * T * 64 + row;
    const bool writer = (lane & 47) == 0;
    float s0 = 0.f, s1 = 0.f; float rprev0 = 0.f, rprev1 = 0.f, vprev = 0.f;
    constexpr int U = 8;
    unsigned nk[U], na[U], nb[U], nl[U], nr[U]; unsigned short nv[U];
#pragma unroll
    for (int u = 0; u < U; ++u) { nk[u] = kt[(size_t)u * 32]; na[u] = ah[(size_t)u * 32]; nb[u] = bhp[(size_t)u * 32]; nl[u] = lw[(size_t)u * 32]; nr[u] = rp[(size_t)u * (NP / 2)]; nv[u] = vp[(size_t)u * NP]; }
#pragma unroll 1
    for (int tbk = 0; tbk < T; tbk += U) {
        unsigned ck[U], ca[U], cb[U], cl[U], cr[U]; unsigned short cv[U];
#pragma unroll
        for (int u = 0; u < U; ++u) { ck[u] = nk[u]; ca[u] = na[u]; cb[u] = nb[u]; cl[u] = nl[u]; cr[u] = nr[u]; cv[u] = nv[u]; }
        if (tbk + U < T) {
#pragma unroll
            for (int u = 0; u < U; ++u) { const size_t tn = (size_t)(tbk + U + u); nk[u] = kt[tn * 32]; na[u] = ah[tn * 32]; nb[u] = bhp[tn * 32]; nl[u] = lw[tn * 32]; nr[u] = rp[tn * (NP / 2)]; nv[u] = vp[tn * NP]; }
        }
#pragma unroll
        for (int u = 0; u < U; ++u) {
            const float rc0 = bflo(cr[u]), rc1 = bfhi(cr[u]), vc = bf1(cv[u]);
            const float r0 = rc0 + (rprev0 - rc0) * mur0, r1 = rc1 + (rprev1 - rc1) * mur1, v = vc + (vprev - vc) * muv;
            rprev0 = rc0; rprev1 = rc1; vprev = vc;
            const float w0 = __builtin_amdgcn_exp2f(bflo(cl[u]) * LOG2E), w1 = __builtin_amdgcn_exp2f(bfhi(cl[u]) * LOG2E);
            float sa = s0 * bflo(ca[u]) + s1 * bfhi(ca[u]);
            sa = swap32_sum(row16_sum(sa));
            s0 = s0 * w0 + sa * bflo(cb[u]) + v * bflo(ck[u]);
            s1 = s1 * w1 + sa * bfhi(cb[u]) + v * bfhi(ck[u]);
            float y = s0 * r0 + s1 * r1;
            y = swap32_sum(row16_sum(y));
            if (writer) yo[(size_t)(tbk + u) * 64] = y;
        }
    }
}

__device__ __forceinline__ void p4_post(Frame& F) {
    const int gw = F.vcu * NWAVES + F.wave, NGW = F.G * NWAVES, c = F.lane;
    for (int it = gw; it < M * RH; it += NGW) {
        const size_t m = (size_t)(it >> 3); const int h = it & 7; const int b = (int)(m >> 11), t = (int)(m & 2047), bh = b * RH + h;
        const float y = F.Y[((size_t)bh * T + t) * 64 + c];
        const float mean = wave_sum(y) * (1.f / 64.f); const float d = y - mean; const float var = wave_sum(d * d) * (1.f / 64.f);
        float yn = d * (1.f / sqrtf(var + 64e-5f)) * F.ln_w[h * 64 + c] + F.ln_b[h * 64 + c];
        const float vc = bf1(F.PROJ[m * NP + C_V + h * 64 + c]); const float vpv = t > 0 ? bf1(F.PROJ[(m - 1) * NP + C_V + h * 64 + c]) : 0.f;
        const float v = vc + (vpv - vc) * F.shift_mu[1024 + h * 64 + c];
        yn += F.RHO[(size_t)bh * T + t] * v;
        const float gt = bf1(F.PROJ[m * NP + C_GA + h * 64 + c]);
        const float o = yn * gt / (1.f + __expf(-gt));
        F.MIX[m * D + h * 64 + c] = (bf16)f2bf(o);
    }
}
constexpr int AT_KROW = 272, AT_KB = 64 * AT_KROW, AT_VB = 64 * 256, AT_BUF = AT_KB + AT_VB;
__device__ __forceinline__ s16x4 vtr(const LAS unsigned char* p) { typedef short v4i16_t __attribute__((ext_vector_type(4))); return __builtin_bit_cast(s16x4, __builtin_amdgcn_ds_read_tr16_b64_v4i16((LAS v4i16_t*)p)); }
__device__ __forceinline__ void attn_unit(Frame& F, int b, int h, int qb, float slope2, float shift2, float lam) {
    const int tid = F.tid, lane = F.lane, l31 = lane & 31, hi = lane >> 5, wid = F.wave, map = wid >> 2, qs = wid & 3;
    LAS unsigned char* lds = F.lds + RING_OFF;
    const int q0 = qb * 128, qrow = q0 + 32 * qs + l31;
    const size_t mrow = (size_t)b * T + qrow;
    bf16x8 qf[4];
    { const bf16* qp = F.PROJ + mrow * NP + C_DQ + h * 128 + map * 64 + 8 * hi;
#pragma unroll
      for (int s = 0; s < 4; ++s) qf[s] = *(const GAS bf16x8*)(qp + 16 * s); }
    const bf16* kg = F.PROJ + (size_t)b * T * NP + C_DK + h * 128;
    const bf16* vg = F.PROJ + (size_t)b * T * NP + C_DV + h * 128;
    const int NT = 2 * qb + 2, tl = 2 * qb + (qs >> 1);
    const int srow0 = tid >> 4, sch = tid & 15, srow1 = srow0 + 32;
    const unsigned kdst0 = srow0 * AT_KROW + sch * 16, kdst1 = srow1 * AT_KROW + sch * 16;
    const unsigned vdst0 = AT_KB + srow0 * 256 + ((sch ^ ((srow0 & 3) << 2)) * 16), vdst1 = AT_KB + srow1 * 256 + ((sch ^ ((srow1 & 3) << 2)) * 16);
    v4u kr0, kr1, vr0, vr1;
#define AT_LOAD(t_) do { const size_t r0_ = (size_t)(64 * (t_) + srow0) * NP + sch * 8, r1_ = (size_t)(64 * (t_) + srow1) * NP + sch * 8; \
        kr0 = *(const GAS v4u*)(kg + r0_); kr1 = *(const GAS v4u*)(kg + r1_); vr0 = *(const GAS v4u*)(vg + r0_); vr1 = *(const GAS v4u*)(vg + r1_); } while (0)
#define AT_STORE(buf_) do { LAS unsigned char* b_ = lds + (buf_) * AT_BUF; *(LAS v4u*)(b_ + kdst0) = kr0; *(LAS v4u*)(b_ + kdst1) = kr1; *(LAS v4u*)(b_ + vdst0) = vr0; *(LAS v4u*)(b_ + vdst1) = vr1; } while (0)
    f32x16 o[4];
#pragma unroll
    for (int vb = 0; vb < 4; ++vb) o[vb] = f32x16{};
    float lsum = 0.f;
    AT_LOAD(0); AT_STORE(0);
    __syncthreads();
    const int G = lane >> 4, qq = (lane & 15) >> 2, pp = lane & 3;
#pragma unroll 1
    for (int t = 0; t < NT; ++t) {
        if (t + 1 < NT) AT_LOAD(t + 1);
        if (t <= tl) {
            const LAS unsigned char* Kb = lds + (t & 1) * AT_BUF; const LAS unsigned char* Vb = Kb + AT_KB;
            const float base = slope2 * (float)(64 * t + 4 * hi - qrow) - shift2;
            f32x16 p0, p1;
#pragma unroll
            for (int r = 0; r < 16; ++r) { p0[r] = base + slope2 * (float)((r & 3) + 8 * (r >> 2)); p1[r] = p0[r] + 32.f * slope2; }
#pragma unroll
            for (int s = 0; s < 4; ++s) {
                const bf16x8 a0 = *(const LAS bf16x8*)(Kb + l31 * AT_KROW + map * 128 + (2 * s + hi) * 16);
                const bf16x8 a1 = *(const LAS bf16x8*)(Kb + (32 + l31) * AT_KROW + map * 128 + (2 * s + hi) * 16);
                p0 = __builtin_amdgcn_mfma_f32_32x32x16_bf16(a0, qf[s], p0, 0, 0, 0);
                p1 = __builtin_amdgcn_mfma_f32_32x32x16_bf16(a1, qf[s], p1, 0, 0, 0);
            }
            if (t == tl) {
#pragma unroll
                for (int r = 0; r < 16; ++r) { const int ki = 64 * t + 4 * hi + (r & 3) + 8 * (r >> 2); if (ki > qrow) p0[r] = -1e30f; if (ki + 32 > qrow) p1[r] = -1e30f; }
            }
            float ls = 0.f;
#pragma unroll
            for (int r = 0; r < 16; ++r) { p0[r] = __builtin_amdgcn_exp2f(p0[r]); p1[r] = __builtin_amdgcn_exp2f(p1[r]); ls += p0[r] + p1[r]; }
            lsum += ls;
            v4u pw[4];
            pw[0] = (v4u){pk2(p0[0], p0[1]), pk2(p0[2], p0[3]), pk2(p0[4], p0[5]), pk2(p0[6], p0[7])};
            pw[1] = (v4u){pk2(p0[8], p0[9]), pk2(p0[10], p0[11]), pk2(p0[12], p0[13]), pk2(p0[14], p0[15])};
            pw[2] = (v4u){pk2(p1[0], p1[1]), pk2(p1[2], p1[3]), pk2(p1[4], p1[5]), pk2(p1[6], p1[7])};
            pw[3] = (v4u){pk2(p1[8], p1[9]), pk2(p1[10], p1[11]), pk2(p1[12], p1[13]), pk2(p1[14], p1[15])};
#pragma unroll
            for (int ks = 0; ks < 4; ++ks) {
                const int kvb = 32 * (ks >> 1) + 16 * (ks & 1);
                const int rowlo = kvb + 4 * hi + qq;
#pragma unroll
                for (int vb = 0; vb < 4; ++vb) {
                    const int chunk = (4 * vb + 2 * (G & 1) + (pp >> 1)) ^ (qq << 2);
                    const LAS unsigned char* alo = Vb + rowlo * 256 + chunk * 16 + 8 * (pp & 1);
                    const s16x4 lo = vtr(alo), hi4 = vtr(alo + 8 * 256);
                    const bf16x8 vf = (bf16x8){lo[0], lo[1], lo[2], lo[3], hi4[0], hi4[1], hi4[2], hi4[3]};
                    o[vb] = __builtin_amdgcn_mfma_f32_32x32x16_bf16(vf, __builtin_bit_cast(bf16x8, pw[ks]), o[vb], 0, 0, 0);
                }
            }
        }
        if (t + 1 < NT) AT_STORE((t + 1) & 1);
        __syncthreads();
    }
#undef AT_LOAD
#undef AT_STORE
    const float ltot = swap32_sum(lsum);
    LAS float* X = (LAS float*)lds;
    if (map == 1) {
        const float sc = lam / ltot;
#pragma unroll
        for (int vb = 0; vb < 4; ++vb)
#pragma unroll
            for (int r = 0; r < 16; ++r) X[(qs * 64 + vb * 16 + r) * 64 + lane] = o[vb][r] * sc;
    }
    __syncthreads();
    if (map == 0) {
        const float il = 1.f / ltot; float ss = 0.f;
#pragma unroll
        for (int vb = 0; vb < 4; ++vb)
#pragma unroll
            for (int r = 0; r < 16; ++r) { const float v = o[vb][r] * il - X[(qs * 64 + vb * 16 + r) * 64 + lane]; o[vb][r] = v; ss += v * v; }
        ss = swap32_sum(ss);
        const float rn = (1.f / sqrtf(ss * (1.f / 128.f) + 1e-5f)) * (1.f - LAMBDA_INIT);
        const bf16* gp = F.PROJ + mrow * NP + C_GB + h * 128;
        bf16* op = F.MIX + mrow * D + 512 + h * 128;
#pragma unroll
        for (int vb = 0; vb < 4; ++vb)
#pragma unroll
            for (int rg = 0; rg < 4; ++rg) {
                const int vc = 32 * vb + 8 * rg + 4 * hi;
                const v2u gw = *(const GAS v2u*)(gp + vc); const f32x4 sg = *(const GAS f32x4*)(F.subln_g + vc);
                const float g4[4] = {bflo(gw.x), bfhi(gw.x), bflo(gw.y), bfhi(gw.y)}; float ov[4];
#pragma unroll
                for (int e = 0; e < 4; ++e) ov[e] = o[vb][4 * rg + e] * rn * sg[e] * g4[e] / (1.f + __expf(-g4[e]));
                *(GAS v2u*)(op + vc) = (v2u){pk2(ov[0], ov[1]), pk2(ov[2], ov[3])};
            }
    }
    __syncthreads();
}
__device__ __forceinline__ void p3_attention(Frame& F) {
    const float l1 = wave_sum(F.lq1[F.lane] * F.lk1[F.lane]), l2 = wave_sum(F.lq2[F.lane] * F.lk2[F.lane]);
    const float lam = __expf(l1) - __expf(l2) + LAMBDA_INIT;
    float gq = fabsf(F.qn_g[F.lane]), gk = fabsf(F.kn_g[F.lane]);
#pragma unroll
    for (int o = 1; o < 64; o <<= 1) { gq = fmaxf(gq, __shfl_xor(gq, o)); gk = fmaxf(gk, __shfl_xor(gk, o)); }
    const float shift2 = 8.f * gq * gk * LOG2E;
    for (int v = F.vcu; v < 256; v += F.G) {
        const int bhh = v >> 3, j = v & 7, b = bhh >> 2, h = bhh & 3;
        const float slope2 = exp2f(-2.f * (float)(h + 1)) * LOG2E;
        attn_unit(F, b, h, j, slope2, shift2, lam);
        attn_unit(F, b, h, 15 - j, slope2, shift2, lam);
    }
}

struct Args { const float* in[21]; float* out; unsigned char* ws; int ph_lo, ph_hi; };
__global__ void __launch_bounds__(NWAVES * 64, 2) hymba_fwd(Args args) {
    extern __shared__ __attribute__((aligned(16))) unsigned char lds[];
    Frame F;
    F.lds = (LAS unsigned char*)lds;
    F.MISC = (volatile LAS unsigned*)(F.lds + MISC_OFF);
    F.tid = threadIdx.x; F.lane = F.tid & 63; F.wave = __builtin_amdgcn_readfirstlane(F.tid >> 6);
    F.G = gridDim.x; { const int bx = blockIdx.x; F.vcu = (F.G % 8 == 0) ? (bx % 8) * (F.G / 8) + bx / 8 : bx; }
    unsigned char* ws = args.ws;
    F.ctl = (gu32*)(ws + WS_CTL);
    F.x = args.in[0]; F.norm_g = args.in[1]; F.w_in = args.in[2]; F.shift_mu = args.in[3]; F.w0 = args.in[4]; F.w_decay_up = args.in[5]; F.a0 = args.in[6]; F.w_iclr_up = args.in[7];
    F.k_k = args.in[8]; F.k_a = args.in[9]; F.r_k = args.in[10]; F.ln_w = args.in[11]; F.ln_b = args.in[12]; F.qn_g = args.in[13]; F.kn_g = args.in[14];
    F.lq1 = args.in[15]; F.lk1 = args.in[16]; F.lq2 = args.in[17]; F.lk2 = args.in[18]; F.subln_g = args.in[19]; F.w_out = args.in[20]; F.out = args.out;
    F.WinT = (bf16*)(ws + WS_WIN); F.WoutT = (bf16*)(ws + WS_WOUT); F.WdT = (bf16*)(ws + WS_WD); F.WaT = (bf16*)(ws + WS_WA);
    F.XN = (bf16*)(ws + WS_XN); F.PROJ = (bf16*)(ws + WS_PROJ); F.MIX = (bf16*)(ws + WS_MIX);
    F.RHO = (float*)(ws + WS_RHO); F.Y = (float*)(ws + WS_XN);
    { bf16* so = (bf16*)args.out; const size_t n = (size_t)BATCH * RH * T * 64; F.KT = so; F.AHt = so + n; F.BHt = so + 2 * n; F.LW = so + 3 * n; }
    for (int u = F.tid; u < (LDS_BYTES - LDSCTL_OFF) / 4; u += NWAVES * 64) ((LAS unsigned*)(F.lds + LDSCTL_OFF))[u] = 0u;
    __syncthreads();
    XcdBarrier bar; bar.bar = (unsigned*)(F.ctl + CW_BAR); bar.x = 0; bar.st = nullptr;
    if (MK_N_LAUNCHES == 1) bar = xcd_barrier_post((unsigned*)(F.ctl + CW_BAR), F.MISC + 8);
#define GRID_BAR() do { if (MK_N_LAUNCHES == 1) xcd_barrier(bar); } while (0)
    const int lo = args.ph_lo, hi = args.ph_hi;
#define IN(k) (lo <= (k) && (k) < hi)
#define BOTH(k) (IN(k) && IN((k) + 1))
#ifndef SKIP
#define SKIP 0
#endif
    if (IN(0) && !(SKIP & 1)) { p0_prologue(F); if (BOTH(0)) GRID_BAR(); }
    if (IN(1) && !(SKIP & 2)) {
        pg8::Gemm g{F.XN, F.WinT, M, NP, D}; pg8::StaticOrder S; S.init(M, NP, F.G, (int)blockIdx.x);
        pg8::EpiBf16S E{F.PROJ, NP};
        pg8::gemm_phase<pg8::EpiBf16S, pg8::StaticOrder, true, true>(F.lds + RING_OFF, g, S, E);
        if (BOTH(1)) GRID_BAR();
    }
    if (IN(2) && !(SKIP & 4)) {
        for (int tt = F.vcu; tt < M / 64; tt += F.G) p2_prep_tile(F, tt);
        p2_qknorm(F);
        if (BOTH(2)) GRID_BAR();
    }
    if (IN(3) && !(SKIP & 8)) {
        for (int it = F.vcu; it < 256; it += F.G) p3_scan(F, it);
        p3_attention(F);
        if (BOTH(3)) GRID_BAR();
    }
    if (IN(4) && !(SKIP & 16)) { p4_post(F); if (BOTH(4)) GRID_BAR(); }
    if (IN(5) && !(SKIP & 32)) {
        pg8::Gemm g{F.MIX, F.WoutT, M, D, D}; pg8::StaticOrder S; S.init(M, D, F.G, (int)blockIdx.x);
        pg8::EpiResF32 E{F.x, F.out, D};
        pg8::gemm_phase<pg8::EpiResF32, pg8::StaticOrder, false, true>(F.lds + RING_OFF, g, S, E);
    }
#undef IN
#undef BOTH
}

extern "C" void kernel_launch(void* const* d_in, const int* in_sizes, int n_in, void* d_out, int out_size, void* d_ws, size_t ws_size, hipStream_t stream) {
    static int grid = 0;
    if (grid == 0) {
        if (n_in != 21 || in_sizes[0] != M * D || out_size != M * D || ws_size < WS_END) { fprintf(stderr, "kernel_launch: unexpected shapes (n_in %d, in0 %d, out %d, ws %zu); nothing launched\n", n_in, n_in > 0 ? in_sizes[0] : -1, out_size, ws_size); grid = -1; return; }
        int dev = 0, cus = 0, per_cu = 0;
        if (hipGetDevice(&dev) != hipSuccess || hipDeviceGetAttribute(&cus, hipDeviceAttributeMultiprocessorCount, dev) != hipSuccess) { grid = -1; return; }
        if (hipFuncSetAttribute((const void*)hymba_fwd, hipFuncAttributeMaxDynamicSharedMemorySize, LDS_BYTES) != hipSuccess) { fprintf(stderr, "kernel_launch: hipFuncSetAttribute failed\n"); grid = -1; return; }
        if (hipOccupancyMaxActiveBlocksPerMultiprocessor(&per_cu, (const void*)hymba_fwd, NWAVES * 64, LDS_BYTES) != hipSuccess || per_cu < 1) { fprintf(stderr, "kernel_launch: occupancy query reports %d workgroups per CU; nothing launched\n", per_cu); grid = -1; return; }
        (void)hipGetLastError();
        grid = cus;
        if (grid > 256) grid = 256;
    }
    if (grid < 0) return;
    if (hipMemsetAsync((char*)d_ws + WS_CTL, 0, CTL_ZERO_BYTES, stream) != hipSuccess) { fprintf(stderr, "kernel_launch: hipMemsetAsync failed\n"); return; }
    Args a{};
    for (int i = 0; i < 21; ++i) a.in[i] = (const float*)d_in[i];
    a.out = (float*)d_out; a.ws = (unsigned char*)d_ws;
    for (int li = 0; li < MK_N_LAUNCHES; ++li) {
        a.ph_lo = (MK_N_LAUNCHES == 1) ? 0 : li; a.ph_hi = (MK_N_LAUNCHES == 1) ? N_PHASES : li + 1;
        hipLaunchKernelGGL(hymba_fwd, dim3(grid), dim3(NWAVES * 64), LDS_BYTES, stream, a);
        const hipError_t le = hipPeekAtLastError();
        if (le != hipSuccess) { fprintf(stderr, "kernel_launch: launch %d failed: %s\n", li, hipGetErrorName(le)); break; }
    }
}
```

```cpp
#define MK_N_LAUNCHES 1
#include <hip/hip_runtime.h>
#include <hip/hip_bf16.h>
#include <cstdio>
#include <cstdint>
#include <cmath>
namespace pg8 {
#define PG8_LAS __attribute__((address_space(3)))
typedef unsigned short bf16_t;
typedef short bf16x8 __attribute__((ext_vector_type(8)));
typedef float f32x4 __attribute__((ext_vector_type(4)));
typedef unsigned u32x4 __attribute__((ext_vector_type(4)));
constexpr int BM = 256, BK = 64, HALF = 128, HTB = HALF * BK * 2  , STAGE_BYTES = 8 * HTB, NXCD = 8, WGM = 8;

__host__ __device__ __forceinline__ int lds_byte(int r, int c) { const int st = (r >> 4) * 2 + (c >> 5), rr = r & 15, cc = c & 31, ob = rr * 64 + cc * 2; return st * 1024 + (ob ^ (((ob >> 9) & 1) << 5)); }
__host__ __device__ __forceinline__ void stage_rc(int b, int& R, int& C) { const int st = b / 1024, sb = b % 1024, swz = sb ^ (((sb >> 9) & 1) << 5); R = (st >> 1) * 16 + swz / 64; C = (st & 1) * 32 + (swz % 64) / 2; }
__host__ __device__ __forceinline__ int perm32(int rho) { const int n = rho >> 4, i = rho & 15; return 8 * (i >> 2) + 4 * n + (i & 3); }

struct Unit { int pm, pn; };
struct Gemm { const bf16_t* A; const bf16_t* Bt; int M, N, K; };

struct StaticOrder {
    int nM, nN, nwg, G, c;
    __host__ __device__ void init(int M, int N, int G_, int c_) { nM = M / BM; nN = N / BM; nwg = nM * nN; G = G_; c = c_; }
    __host__ __device__ bool next(int i, Unit& u) const {
        const long L = (long)i * G + c; if (L >= nwg) return false;
        int wgid = (int)L; { const int q = nwg / NXCD, r = nwg % NXCD, xcd = wgid % NXCD, off = wgid / NXCD; wgid = (xcd < r ? xcd * (q + 1) : r * (q + 1) + (xcd - r) * q) + off; }
        const int nig = WGM * nN, gid = wgid / nig, fm = gid * WGM, gsz = (nM - fm) < WGM ? (nM - fm) : WGM;
        u.pm = fm + ((wgid % nig) % gsz); u.pn = (wgid % nig) / gsz; return true;
    }
    __device__ __forceinline__ void a_ready(const Unit&) const {}
    __device__ __forceinline__ void done(const Unit&) const {}
};

__device__ __forceinline__ unsigned cvt_pk_bf16(float lo, float hi) { unsigned r; asm volatile("v_cvt_pk_bf16_f32 %0, %1, %2" : "=v"(r) : "v"(lo), "v"(hi)); return r; }
struct EpiBf16S {
    static constexpr bool PERM = true, AFTER_DRAIN = false;
    bf16_t* O; int ldc;
    __device__ __forceinline__ void operator()(const f32x4 (&acc)[2][2][4][2], const Unit& u, int wr, int wc, int fr, int fq) const {
        const int row0 = u.pm * BM + wr * 64 + fr, col0 = u.pn * BM + wc * 32 + 8 * fq;
#pragma unroll
        for (int ai = 0; ai < 2; ++ai)
#pragma unroll
            for (int m = 0; m < 4; ++m) { bf16_t* rowp = O + (size_t)(row0 + ai * HALF + m * 16) * ldc + col0;
#pragma unroll
                for (int bj = 0; bj < 2; ++bj) { const f32x4 v0 = acc[ai][bj][m][0], v1 = acc[ai][bj][m][1];
                    u32x4 w; w.x = cvt_pk_bf16(v0[0], v0[1]); w.y = cvt_pk_bf16(v0[2], v0[3]); w.z = cvt_pk_bf16(v1[0], v1[1]); w.w = cvt_pk_bf16(v1[2], v1[3]);
                    *(u32x4*)(rowp + bj * HALF) = w; } }
    }
};
struct EpiResF32 {
    static constexpr bool PERM = false, AFTER_DRAIN = false;
    const float* base; float* out; int ldc;
    __device__ __forceinline__ void operator()(const f32x4 (&acc)[2][2][4][2], const Unit& u, int wr, int wc, int fr, int fq) const {
        const int row0 = u.pm * BM + wr * 64 + fr, col0 = u.pn * BM + wc * 32 + 4 * fq;
#pragma unroll
        for (int ai = 0; ai < 2; ++ai)
#pragma unroll
            for (int m = 0; m < 4; ++m) { const size_t off = (size_t)(row0 + ai * HALF + m * 16) * ldc + col0;
#pragma unroll
                for (int bj = 0; bj < 2; ++bj)
#pragma unroll
                    for (int n = 0; n < 2; ++n) { const f32x4 bs = *(const f32x4*)(base + off + bj * HALF + n * 16); *(f32x4*)(out + off + bj * HALF + n * 16) = bs + acc[ai][bj][m][n]; } }
    }
};
template <class Epi, class Sched, bool ALIGN_EPI = false, bool SP2 = false>
__device__ __forceinline__ void gemm_phase(PG8_LAS unsigned char* lds, const Gemm g, const Sched& S, const Epi& E) {
    const int tid = threadIdx.x, wid = __builtin_amdgcn_readfirstlane(tid >> 6), lane = tid & 63, wr = wid >> 2, wc = wid & 3, fr = lane & 15, fq = lane >> 4;
    const int K = g.K, nt = K / BK;
    unsigned voffA[2], voffB[2];
#pragma unroll
    for (int i = 0; i < 2; ++i) { int R, C; stage_rc(tid * 16 + i * 8192, R, C); const int Rb = Epi::PERM ? ((R & ~31) + perm32(R & 31)) : R;
        voffA[i] = (unsigned)(R * K + C) * 2u; voffB[i] = (unsigned)(Rb * K + C) * 2u; }
    const size_t kstep = (size_t)(BK * 2);
    const size_t hstep = (size_t)HALF * K * 2;
    const size_t tstep = 2 * hstep;
    const unsigned ldsw = (unsigned)wid * 1024u;
    const int aoff = lds_byte(wr * 64 + fr, fq * 8), boff = lds_byte(wc * 32 + fr, fq * 8);
#define PG8_SA(b, h) (((b) * 2 + (h)) * HTB)
#define PG8_SB(b, h) ((4 + (b) * 2 + (h)) * HTB)
#define PG8_STAGE(bufoff, gbase, voff) do { _Pragma("unroll") for (int _i = 0; _i < 2; ++_i) \
        __builtin_amdgcn_global_load_lds((const unsigned*)((const char*)(gbase) + (voff)[_i]), (PG8_LAS unsigned*)(lds + (bufoff) + ldsw + _i * 8192), 16, 0, 0); } while (0)
#define PG8_LDA(dst, b, h) do { _Pragma("unroll") for (int m = 0; m < 4; ++m) _Pragma("unroll") for (int k = 0; k < 2; ++k) dst[m][k] = *(const PG8_LAS bf16x8*)(lds + PG8_SA(b, h) + aoff + m * 2048 + k * 1024); } while (0)
#define PG8_LDB(dst, b, h) do { _Pragma("unroll") for (int n = 0; n < 2; ++n) _Pragma("unroll") for (int k = 0; k < 2; ++k) dst[n][k] = *(const PG8_LAS bf16x8*)(lds + PG8_SB(b, h) + boff + n * 2048 + k * 1024); } while (0)
#define PG8_MMA(ai, bj, At, Bt) do { __builtin_amdgcn_s_setprio(1); _Pragma("unroll") for (int m = 0; m < 4; ++m) _Pragma("unroll") for (int n = 0; n < 2; ++n) _Pragma("unroll") for (int k = 0; k < 2; ++k) \
        acc[ai][bj][m][n] = __builtin_amdgcn_mfma_f32_16x16x32_bf16(Bt[n][k], At[m][k], acc[ai][bj][m][n], 0, 0, 0); __builtin_amdgcn_s_setprio(0); } while (0)
#define PG8_WAIT_V(n) asm volatile("s_waitcnt vmcnt(" #n ")" ::: "memory")
#define PG8_WAIT_L(n) asm volatile("s_waitcnt lgkmcnt(" #n ")" ::: "memory")
#define PG8_BAR __builtin_amdgcn_s_barrier()
#define PG8_SCHED __builtin_amdgcn_sched_barrier(0)
    Unit cur, nxt; int ui = 0;
    if (!S.next(0, cur)) return;
    f32x4 acc[2][2][4][2];
#pragma unroll
    for (int a = 0; a < 2; ++a)
#pragma unroll
        for (int b = 0; b < 2; ++b)
#pragma unroll
            for (int m = 0; m < 4; ++m)
#pragma unroll
                for (int n = 0; n < 2; ++n) acc[a][b][m][n] = (f32x4){0.f, 0.f, 0.f, 0.f};
    bf16x8 At[4][2], B0[2][2], B1[2][2];
    const char* cA = (const char*)g.A + (size_t)cur.pm * tstep; const char* cB = (const char*)g.Bt + (size_t)cur.pn * tstep;
    S.a_ready(cur);
    if constexpr (SP2) {
        PG8_STAGE(PG8_SB(0, 0), cB, voffB); PG8_STAGE(PG8_SB(0, 1), cB + hstep, voffB); PG8_STAGE(PG8_SA(0, 0), cA, voffA); PG8_STAGE(PG8_SA(0, 1), cA + hstep, voffA);
        if (wr == 1) PG8_BAR;
        PG8_WAIT_V(2); PG8_BAR;
        PG8_STAGE(PG8_SB(1, 0), cB + kstep, voffB); PG8_STAGE(PG8_SA(1, 0), cA + kstep, voffA); PG8_STAGE(PG8_SB(1, 1), cB + hstep + kstep, voffB);
        PG8_WAIT_V(6); PG8_BAR;
    } else {
        PG8_STAGE(PG8_SB(0, 0), cB, voffB); PG8_STAGE(PG8_SA(0, 0), cA, voffA); PG8_STAGE(PG8_SB(0, 1), cB + hstep, voffB); PG8_STAGE(PG8_SA(0, 1), cA + hstep, voffA);
        if (wr == 1) PG8_BAR;
        PG8_WAIT_V(4); PG8_BAR;
        PG8_STAGE(PG8_SB(1, 0), cB + kstep, voffB); PG8_STAGE(PG8_SA(1, 0), cA + kstep, voffA); PG8_STAGE(PG8_SB(1, 1), cB + hstep + kstep, voffB);
        PG8_WAIT_V(6); PG8_BAR;
    }
    for (;;) {
        const bool has_next = S.next(ui + 1, nxt);
        const char* nA = has_next ? (const char*)g.A + (size_t)nxt.pm * tstep : cA; const char* nB = has_next ? (const char*)g.Bt + (size_t)nxt.pn * tstep : cB;
        for (int t = 0; t < nt; t += 2) {
            const bool last = (t == nt - 2);
            const char* a1 = cA + (size_t)(t + 1) * kstep;
            const char* a2 = last ? nA : cA + (size_t)(t + 2) * kstep; const char* b2 = last ? nB : cB + (size_t)(t + 2) * kstep;
            const char* a3 = a2 + kstep; const char* b3 = b2 + kstep;
            if (last && has_next) S.a_ready(nxt);
            if constexpr (SP2) {
            PG8_LDB(B0, 0, 0); PG8_LDB(B1, 0, 1); PG8_SCHED; PG8_LDA(At, 0, 0); PG8_STAGE(PG8_SA(1, 1), a1 + hstep, voffA);
            PG8_WAIT_V(8); PG8_WAIT_L(0); PG8_BAR; PG8_MMA(0, 0, At, B0); PG8_MMA(0, 1, At, B1); PG8_BAR; PG8_SCHED;
            PG8_LDA(At, 0, 1); PG8_STAGE(PG8_SB(0, 0), b2, voffB); PG8_STAGE(PG8_SB(0, 1), b2 + hstep, voffB); PG8_STAGE(PG8_SA(0, 0), a2, voffA);
            PG8_WAIT_V(8); PG8_WAIT_L(0); PG8_BAR; PG8_MMA(1, 0, At, B0); PG8_MMA(1, 1, At, B1); PG8_BAR; PG8_SCHED;
            PG8_LDB(B0, 1, 0); PG8_LDB(B1, 1, 1); PG8_SCHED; PG8_LDA(At, 1, 0); PG8_STAGE(PG8_SA(0, 1), a2 + hstep, voffA);
            PG8_WAIT_V(8); PG8_WAIT_L(0); PG8_BAR; PG8_MMA(0, 0, At, B0); PG8_MMA(0, 1, At, B1); PG8_BAR; PG8_SCHED;
            PG8_LDA(At, 1, 1); PG8_STAGE(PG8_SB(1, 0), b3, voffB); PG8_STAGE(PG8_SB(1, 1), b3 + hstep, voffB); PG8_STAGE(PG8_SA(1, 0), a3, voffA);
            PG8_WAIT_V(8); PG8_WAIT_L(0); PG8_BAR; PG8_MMA(1, 0, At, B0); PG8_MMA(1, 1, At, B1); PG8_BAR; PG8_SCHED;
            } else {
            PG8_LDB(B0, 0, 0); PG8_SCHED; PG8_LDA(At, 0, 0); PG8_STAGE(PG8_SA(1, 1), a1 + hstep, voffA);
            PG8_WAIT_L(8); PG8_BAR; PG8_WAIT_L(0); PG8_MMA(0, 0, At, B0); PG8_BAR; PG8_SCHED;
            PG8_LDB(B1, 0, 1); PG8_STAGE(PG8_SB(0, 0), b2, voffB);
            PG8_BAR; PG8_WAIT_L(0); PG8_MMA(0, 1, At, B1); PG8_BAR;
            PG8_LDA(At, 0, 1); PG8_STAGE(PG8_SA(0, 0), a2, voffA);
            PG8_BAR; PG8_WAIT_L(0); PG8_MMA(1, 0, At, B0); PG8_BAR; PG8_SCHED;
            PG8_STAGE(PG8_SB(0, 1), b2 + hstep, voffB);
            PG8_WAIT_V(6); PG8_BAR; PG8_MMA(1, 1, At, B1); PG8_BAR;
            PG8_LDB(B0, 1, 0); PG8_SCHED; PG8_LDA(At, 1, 0); PG8_STAGE(PG8_SA(0, 1), a2 + hstep, voffA);
            PG8_WAIT_L(8); PG8_BAR; PG8_WAIT_L(0); PG8_MMA(0, 0, At, B0); PG8_BAR; PG8_SCHED;
            PG8_LDB(B1, 1, 1); PG8_STAGE(PG8_SB(1, 0), b3, voffB);
            PG8_BAR; PG8_WAIT_L(0); PG8_MMA(0, 1, At, B1); PG8_BAR;
            PG8_LDA(At, 1, 1); PG8_STAGE(PG8_SA(1, 0), a3, voffA);
            PG8_BAR; PG8_WAIT_L(0); PG8_MMA(1, 0, At, B0); PG8_BAR; PG8_SCHED;
            PG8_STAGE(PG8_SB(1, 1), b3 + hstep, voffB);
            PG8_WAIT_V(6); PG8_BAR; PG8_MMA(1, 1, At, B1); PG8_BAR;
            }
        }
        if constexpr (ALIGN_EPI) { if (wr == 0) PG8_BAR; }
        if constexpr (!Epi::AFTER_DRAIN) { E(acc, cur, wr, wc, fr, fq); S.done(cur); }
        if (!has_next) break;
#pragma unroll
        for (int a = 0; a < 2; ++a)
#pragma unroll
            for (int b = 0; b < 2; ++b)
#pragma unroll
                for (int m = 0; m < 4; ++m)
#pragma unroll
                    for (int n = 0; n < 2; ++n) acc[a][b][m][n] = (f32x4){0.f, 0.f, 0.f, 0.f};
        cur = nxt; cA = nA; cB = nB; ++ui;
        if constexpr (ALIGN_EPI) { if (wr == 1) PG8_BAR; }
    }
    PG8_WAIT_V(0);
    if constexpr (!ALIGN_EPI) { if (wr == 0) PG8_BAR; }
    PG8_BAR;
    if constexpr (Epi::AFTER_DRAIN) { E.fused(acc, cur, wr, wc, fr, fq, lds, wid, lane); S.done(cur); }
#undef PG8_SA
#undef PG8_SB
#undef PG8_STAGE
#undef PG8_LDA
#undef PG8_LDB
#undef PG8_MMA
#undef PG8_WAIT_V
#undef PG8_WAIT_L
#undef PG8_BAR
#undef PG8_SCHED
}
}
constexpr int NWAVES = 8;
#ifndef MK_N_LAUNCHES
#define MK_N_LAUNCHES 1
#endif
constexpr int N_PHASES = 5;
constexpr int BATCH = 8, T = 2048, D = 1024, M = BATCH * T;
constexpr int NP = 4352;
constexpr int C_R = 0, C_K = 512, C_V = 1024, C_ZW = 1536, C_ZA = 1600, C_GA = 1792, C_DQ = 2304, C_DK = 2816, C_DV = 3328, C_GB = 3840;
constexpr int RH = 8, RN = 64;
constexpr int AH = 4;
constexpr float C2 = 0.125f * 1.4426950408889634f;
constexpr float LOG2E = 1.4426950408889634f;
constexpr float LAMBDA_INIT = 0.2f;

constexpr size_t MiB = 1u << 20;
constexpr size_t WS_CTL = 0, CTL_ZERO_BYTES = 1 * MiB;
constexpr size_t WS_WIN = 2 * MiB;
constexpr size_t WS_WOUT = 11 * MiB;
constexpr size_t WS_WD = 13 * MiB, WS_WA = 13 * MiB + 65536;
constexpr size_t WS_RHO = 13 * MiB + 2 * 65536;
constexpr size_t WS_XN = 14 * MiB;
constexpr size_t WS_PROJ = 46 * MiB;
constexpr size_t WS_MIX = 182 * MiB;
constexpr size_t WS_END = 214 * MiB;
constexpr int CW_BAR = 4096;

constexpr int RING_OFF = 0, RING_BYTES = 131072;
constexpr int LDSCTL_OFF = RING_BYTES, MISC_OFF = LDSCTL_OFF + 320;
constexpr int LDS_BYTES = 147456;

#define GAS __attribute__((address_space(1)))
#define LAS __attribute__((address_space(3)))
typedef unsigned short bf16;
typedef unsigned v4u __attribute__((ext_vector_type(4)));
typedef unsigned v2u __attribute__((ext_vector_type(2)));
typedef float f32x4 __attribute__((ext_vector_type(4)));
typedef float f32x16 __attribute__((ext_vector_type(16)));
typedef short bf16x8 __attribute__((ext_vector_type(8)));
typedef short s16x4 __attribute__((ext_vector_type(4)));
typedef GAS unsigned gu32;
typedef GAS unsigned long long gu64;
#define RLX_AGENT __ATOMIC_RELAXED, __HIP_MEMORY_SCOPE_AGENT
#define LDS_WAIT() asm volatile("s_waitcnt lgkmcnt(0)" ::: "memory")
#define VM_WAIT() asm volatile("s_waitcnt vmcnt(0)" ::: "memory")
__device__ __forceinline__ unsigned f2bf(float f) { unsigned u = __builtin_bit_cast(unsigned, f); return (u + 0x7fffu + ((u >> 16) & 1u)) >> 16; }
__device__ __forceinline__ unsigned pk2(float lo, float hi) { return f2bf(lo) | (f2bf(hi) << 16); }
__device__ __forceinline__ float bflo(unsigned u) { return __uint_as_float(u << 16); }
__device__ __forceinline__ float bfhi(unsigned u) { return __uint_as_float(u & 0xffff0000u); }
__device__ __forceinline__ float bf1(unsigned short u) { return __uint_as_float((unsigned)u << 16); }
#define XB_TMO      128
#define XB_XCNT(j)  (256  + 64 * (j))
#define XB_XSUB(j)  (1280 + 64 * (j))
#define XB_XGEN(j)  (2304 + 64 * (j))
#define XB_TOP      3328
#define XB_TOPGEN   3392
#define XCD_BAR_WORDS 3456
#define XB_SPIN_CAP (1u << 18)

__device__ __forceinline__ unsigned xb_ld(unsigned* p)              { return __hip_atomic_load(p, __ATOMIC_RELAXED, __HIP_MEMORY_SCOPE_AGENT); }
__device__ __forceinline__ unsigned xb_add(unsigned* p, unsigned v) { return __hip_atomic_fetch_add(p, v, __ATOMIC_RELAXED, __HIP_MEMORY_SCOPE_AGENT); }
__device__ __forceinline__ unsigned xb_xcc_id() { return (unsigned)__builtin_amdgcn_s_getreg((3 << 11) | 20) & 0xFu; }
#define XB_SPIN(cond, bar) do { unsigned _sp = 0; while (cond) { __builtin_amdgcn_s_sleep(1); \
    if ((++_sp & 255u) == 0u) { if (xb_ld(&(bar)[XB_TMO])) break; if (_sp > XB_SPIN_CAP) { atomicAdd(&(bar)[XB_TMO], 1u); break; } } } } while (0)

struct XcdBarrier {
    unsigned* bar; unsigned x;
    volatile LAS unsigned* st;
};

__device__ __forceinline__ XcdBarrier xcd_barrier_post(unsigned* bar, volatile LAS unsigned* st) {
    XcdBarrier b; b.bar = bar; b.x = xb_xcc_id(); b.st = st;
    if (threadIdx.x == 0) (void)xb_add(&bar[XB_XCNT(b.x)], 1u);
    return b;
}
__device__ __forceinline__ void xcd_barrier_complete(unsigned* bar, unsigned x, unsigned& nloc, unsigned& nx) {
    const unsigned G = gridDim.x * gridDim.y * gridDim.z;
    unsigned sum, cnt, mine, sp = 0u;
    for (;;) {
        sum = 0u; cnt = 0u; mine = 0u;
#pragma unroll
        for (unsigned j = 0; j < 16; ++j) { const unsigned c = xb_ld(&bar[XB_XCNT(j)]); sum += c; cnt += (c > 0u) ? 1u : 0u; mine = (j == x) ? c : mine; }
        if (sum == G) break;
        __builtin_amdgcn_s_sleep(1);
        if ((++sp & 255u) == 0u) { if (xb_ld(&bar[XB_TMO])) break; if (sp > XB_SPIN_CAP) { atomicAdd(&bar[XB_TMO], 1u); break; } }
    }
    nloc = mine > 0u ? mine : 1u; nx = cnt > 0u ? cnt : 1u;
}

__device__ __forceinline__ void xcd_barrier(const XcdBarrier& b) {
    asm volatile("s_waitcnt vmcnt(0)" ::: "memory");
    __syncthreads();
    if (threadIdx.x == 0) {
        unsigned* bar = b.bar;
        __builtin_amdgcn_s_waitcnt(0);
        unsigned nloc = b.st[0], nx = b.st[1];
        if (nloc == 0u) { xcd_barrier_complete(bar, b.x, nloc, nx); b.st[0] = nloc; b.st[1] = nx; }
        const unsigned old = xb_add(&bar[XB_XSUB(b.x)], 1u);
        const unsigned gen = old / nloc;
        if (old + 1u == (gen + 1u) * nloc) {
            __builtin_amdgcn_fence(__ATOMIC_RELEASE, "agent");
            asm volatile("s_waitcnt vmcnt(0)" ::: "memory");
            const unsigned og = xb_add(&bar[XB_TOP], 1u);
            const unsigned tg = og / nx;
            if (og + 1u == (tg + 1u) * nx) xb_add(&bar[XB_TOPGEN], 1u);
            else XB_SPIN(xb_ld(&bar[XB_TOPGEN]) == tg, bar);
            __builtin_amdgcn_fence(__ATOMIC_ACQUIRE, "agent");
            xb_add(&bar[XB_XGEN(b.x)], 1u);
            asm volatile("s_waitcnt vmcnt(0)" ::: "memory");
        } else {
            XB_SPIN(xb_ld(&bar[XB_XGEN(b.x)]) == gen, bar);
            __builtin_amdgcn_fence(__ATOMIC_ACQUIRE, "agent");
            asm volatile("s_waitcnt vmcnt(0)" ::: "memory");
        }
    }
    __syncthreads();
}
struct Frame {
    LAS unsigned char* lds;
    volatile LAS unsigned* MISC;
    gu32* ctl;
    int tid, lane, wave;
    int vcu, G;
    const float* x; float* out;
    const float *norm_g, *w_in, *shift_mu, *w0, *w_decay_up, *a0, *w_iclr_up, *k_k, *k_a, *r_k, *ln_w, *ln_b, *qn_g, *kn_g, *lq1, *lk1, *lq2, *lk2, *subln_g, *w_out;
    bf16 *WinT, *WoutT, *WdT, *WaT, *XN, *PROJ, *MIX;
};

__device__ __forceinline__ float wave_sum(float v) {
#pragma unroll
    for (int o = 1; o < 64; o <<= 1) v += __shfl_xor(v, o);
    return v;
}
template <int CTRL> __device__ __forceinline__ float dpp_f(float x) { return __builtin_bit_cast(float, __builtin_amdgcn_mov_dpp(__builtin_bit_cast(int, x), CTRL, 0xf, 0xf, true)); }
__device__ __forceinline__ float row16_sum(float x) {
    x += dpp_f<0xB1>(x); x += dpp_f<0x4E>(x); x += dpp_f<0x141>(x); x += dpp_f<0x140>(x); return x;
}
__device__ __forceinline__ float swap32_sum(float x) {
    auto rr = __builtin_amdgcn_permlane32_swap(__float_as_uint(x), __float_as_uint(x), false, false);
    return __uint_as_float(rr[0]) + __uint_as_float(rr[1]);
}

__device__ __forceinline__ void p0_transpose_item(const float* W, int N, int nsrc, const float* kscale, bf16* WT, int K, int ndst, LAS float* scr, int k0, int lane) {
#pragma unroll 8
    for (int i = 0; i < 32; ++i) { const int kk = 2 * i + (lane >> 5);
        float v = 0.f; if (nsrc >= 0) { v = W[(size_t)(k0 + kk) * N + nsrc + (lane & 31)]; if (kscale) v *= kscale[k0 + kk]; }
        scr[kk * 33 + (lane & 31)] = v; }
    LDS_WAIT(); asm volatile("" ::: "memory");
    const int c = lane & 7;
#pragma unroll
    for (int j = 0; j < 4; ++j) { const int n = (lane >> 3) + 8 * j; const LAS float* s = scr + (8 * c) * 33 + n;
        v4u o; o.x = pk2(s[0 * 33], s[1 * 33]); o.y = pk2(s[2 * 33], s[3 * 33]); o.z = pk2(s[4 * 33], s[5 * 33]); o.w = pk2(s[6 * 33], s[7 * 33]);
        *(GAS v4u*)(WT + (size_t)(ndst + n) * K + k0 + 8 * c) = o; }
    LDS_WAIT(); asm volatile("" ::: "memory");
}
__device__ __forceinline__ void p0_prologue(Frame& F) {
    LAS float* scr = (LAS float*)(F.lds + RING_OFF + F.wave * 16384);
    const int gw = F.vcu * NWAVES + F.wave, NGW = F.G * NWAVES;
    constexpr int I_IN = (D / 64) * (NP / 32), I_OUT = (D / 64) * (D / 32), I_L = 512 / 32;
    constexpr int NITEMS = I_IN + I_OUT + 2 * I_L;
    for (int it = gw; it < NITEMS; it += NGW) {
        int r = it;
        if (r < I_IN) { const int kb = r / (NP / 32), nb = r % (NP / 32), nd = 32 * nb; const int ns = nd < 1664 ? nd : (nd < 1792 ? -1 : nd - 128);
            p0_transpose_item(F.w_in, 4224, ns, F.norm_g, F.WinT, D, nd, scr, 64 * kb, F.lane); continue; } r -= I_IN;
        if (r < I_OUT) { const int kb = r / (D / 32), nb = r % (D / 32);
            p0_transpose_item(F.w_out, D, 32 * nb, nullptr, F.WoutT, D, 32 * nb, scr, 64 * kb, F.lane); continue; } r -= I_OUT;
        if (r < I_L) { p0_transpose_item(F.w_decay_up, 512, 32 * r, nullptr, F.WdT, 64, 32 * r, scr, 0, F.lane); continue; } r -= I_L;
        p0_transpose_item(F.w_iclr_up, 512, 32 * r, nullptr, F.WaT, 64, 32 * r, scr, 0, F.lane);
    }
    for (int m = gw; m < M; m += NGW) {
        const GAS f32x4* xr = (const GAS f32x4*)(F.x + (size_t)m * D) + F.lane;
        f32x4 v[4]; float s = 0.f;
#pragma unroll
        for (int j = 0; j < 4; ++j) { v[j] = xr[64 * j]; s += (v[j].x * v[j].x + v[j].y * v[j].y) + (v[j].z * v[j].z + v[j].w * v[j].w); }
        const float rstd = 1.f / sqrtf(wave_sum(s) * (1.f / D) + 1e-6f);
        GAS unsigned long long* o8 = (GAS unsigned long long*)(F.XN + (size_t)m * D) + F.lane;
#pragma unroll
        for (int j = 0; j < 4; ++j) o8[64 * j] = (unsigned long long)pk2(v[j].x * rstd, v[j].y * rstd) | ((unsigned long long)pk2(v[j].z * rstd, v[j].w * rstd) << 32);
    }
}

__device__ __forceinline__ float tanh_f(float x) { const float e = __expf(-2.f * fabsf(x)); const float t = (1.f - e) * __builtin_amdgcn_rcpf(1.f + e); return x < 0.f ? -t : t; }
__device__ __forceinline__ void shifted8(const bf16* proj, size_t m, bool has_prev, int col, const float* mu, float (&o)[8]) {
    const v4u c = *(const GAS v4u*)(proj + m * NP + col);
    v4u p = (v4u){0u, 0u, 0u, 0u}; if (has_prev) p = *(const GAS v4u*)(proj + (m - 1) * NP + col);
    const f32x4 m0 = *(const GAS f32x4*)(mu), m1 = *(const GAS f32x4*)(mu + 4);
    const unsigned cw[4] = {c.x, c.y, c.z, c.w}, pw[4] = {p.x, p.y, p.z, p.w}; const float mm[8] = {m0.x, m0.y, m0.z, m0.w, m1.x, m1.y, m1.z, m1.w};
#pragma unroll
    for (int j = 0; j < 4; ++j) { const float c0 = bflo(cw[j]), c1 = bfhi(cw[j]), p0 = bflo(pw[j]), p1 = bfhi(pw[j]);
        o[2 * j] = c0 + (p0 - c0) * mm[2 * j]; o[2 * j + 1] = c1 + (p1 - c1) * mm[2 * j + 1]; }
}
__device__ __forceinline__ void shifted4(const bf16* proj, size_t m, bool has_prev, int col, const float* mu, float (&o)[4]) {
    const v2u c = *(const GAS v2u*)(proj + m * NP + col);
    v2u p = (v2u){0u, 0u}; if (has_prev) p = *(const GAS v2u*)(proj + (m - 1) * NP + col);
    const f32x4 m0 = *(const GAS f32x4*)(mu);
    o[0] = bflo(c.x) + (bflo(p.x) - bflo(c.x)) * m0.x; o[1] = bfhi(c.x) + (bfhi(p.x) - bfhi(c.x)) * m0.y;
    o[2] = bflo(c.y) + (bflo(p.y) - bflo(c.y)) * m0.z; o[3] = bfhi(c.y) + (bfhi(p.y) - bfhi(c.y)) * m0.w;
}
__device__ __forceinline__ void p2_qknorm(Frame& F) {
    const int gw = F.vcu * NWAVES + F.wave, NGW = F.G * NWAVES, lane = F.lane, sub = lane & 7;
    for (int it = gw; it < 2 * M; it += NGW) {
        const size_t m = (size_t)(it >> 1); const int isk = it & 1;
        bf16* p = F.PROJ + m * NP + (isk ? C_DK : C_DQ) + (lane >> 3) * 64 + sub * 8;
        const v4u c = *(const GAS v4u*)p; const unsigned cw[4] = {c.x, c.y, c.z, c.w};
        float xv[8]; float ss = 0.f;
#pragma unroll
        for (int j = 0; j < 4; ++j) { xv[2 * j] = bflo(cw[j]); xv[2 * j + 1] = bfhi(cw[j]); ss += xv[2 * j] * xv[2 * j] + xv[2 * j + 1] * xv[2 * j + 1]; }
        ss += __shfl_xor(ss, 1); ss += __shfl_xor(ss, 2); ss += __shfl_xor(ss, 4);
        const float r = (1.f / sqrtf(ss * (1.f / 64.f) + 1e-6f)) * (isk ? 1.f : C2);
        const float* g = (isk ? F.kn_g : F.qn_g) + sub * 8;
        const f32x4 g0 = *(const GAS f32x4*)g, g1 = *(const GAS f32x4*)(g + 4);
        v4u o; o.x = pk2(xv[0] * r * g0.x, xv[1] * r * g0.y); o.y = pk2(xv[2] * r * g0.z, xv[3] * r * g0.w); o.z = pk2(xv[4] * r * g1.x, xv[5] * r * g1.y); o.w = pk2(xv[6] * r * g1.z, xv[7] * r * g1.w);
        *(GAS v4u*)p = o;
    }
}

typedef float f32x2_t __attribute__((ext_vector_type(2))); typedef __bf16 bf16x2_t __attribute__((ext_vector_type(2)));
__device__ __forceinline__ unsigned cvtpk(float lo, float hi) { f32x2_t v = {lo, hi}; bf16x2_t b = __builtin_convertvector(v, bf16x2_t); return __builtin_bit_cast(unsigned, b); }
#define MFMA32(a, b, c) __builtin_amdgcn_mfma_f32_32x32x16_bf16(__builtin_bit_cast(bf16x8, (a)), __builtin_bit_cast(bf16x8, (b)), (c), 0, 0, 0)
#define FRAGACC(z, s) ((v4u){cvtpk((z)[8 * (s)], (z)[8 * (s) + 1]), cvtpk((z)[8 * (s) + 2], (z)[8 * (s) + 3]), cvtpk((z)[8 * (s) + 4], (z)[8 * (s) + 5]), cvtpk((z)[8 * (s) + 6], (z)[8 * (s) + 7])})
template <int CTRL, int RM> __device__ __forceinline__ float dpp_upd0(float x) { return __builtin_bit_cast(float, __builtin_amdgcn_update_dpp(0, __builtin_bit_cast(int, x), CTRL, RM, 0xf, false)); }
__device__ __forceinline__ float scan32(float x) {
    x += dpp_upd0<0x111, 0xf>(x); x += dpp_upd0<0x112, 0xf>(x); x += dpp_upd0<0x114, 0xf>(x); x += dpp_upd0<0x118, 0xf>(x); x += dpp_upd0<0x142, 0xa>(x); return x;
}
constexpr int RW_UNITS = BATCH * RH * (T / 32);
struct RwDump { v4u* PF; v4u* DD; v4u* QF; v4u* YD; float* GAM; float* RHO; };

__device__ __forceinline__ void rwkvA_unit(Frame& F, const RwDump& Dm, int bh, int ci, LAS float* wscr, LAS unsigned char* park) {
    int lane = F.lane; asm volatile("" : "+v"(lane));
    const int hi = lane >> 5, l31 = lane & 31, b = bh >> 3, w = bh & 7;
    LAS v4u* pk = (LAS v4u*)park + lane;
#define PARK(slot) pk[(slot) * 64]
    int tok = 0; asm volatile("" : "+v"(tok));
#define DEP(x) asm volatile("" : "+v"(tok) : "v"(x))
    const int t = ci * 32 + l31; const size_t m = (size_t)b * T + t; const bool hp = t > 0;
    const int u = bh * (T / 32) + ci;
    const float pm = hp ? 1.f : 0.f;
    const bf16* pc = F.PROJ + m * NP + w * 64 + 4 * hi; const bf16* pp = F.PROJ + (hp ? m - 1 : m) * NP + w * 64 + 4 * hi;
    const float* mu = F.shift_mu + w * 64 + 4 * hi;
    const float *pw0 = F.w0 + w * 64 + 4 * hi, *pa0 = F.a0 + w * 64 + 4 * hi, *pkk = F.k_k + w * 64 + 4 * hi, *pka = F.k_a + w * 64 + 4 * hi, *prk = F.r_k + w * 64 + 4 * hi;
#define SH4(dst, COL, MU, OFF) do { const v2u c_ = *(const GAS v2u*)(pc + tok + (COL) + (OFF)), p_ = *(const GAS v2u*)(pp + tok + (COL) + (OFF)); const f32x4 m_ = *(const GAS f32x4*)(mu + tok + (MU) + (OFF)); \
        dst[0] = bflo(c_.x) + (bflo(p_.x) * pm - bflo(c_.x)) * m_.x; dst[1] = bfhi(c_.x) + (bfhi(p_.x) * pm - bfhi(c_.x)) * m_.y; \
        dst[2] = bflo(c_.y) + (bflo(p_.y) * pm - bflo(c_.y)) * m_.z; dst[3] = bfhi(c_.y) + (bfhi(p_.y) * pm - bfhi(c_.y)) * m_.w; } while (0)
    float ss = 0.f;
#pragma unroll
    for (int gq = 0; gq < 8; ++gq) { float k4[4]; SH4(k4, C_K, 512, 8 * gq); const f32x4 kkp = *(const GAS f32x4*)(pkk + tok + 8 * gq);
#pragma unroll
        for (int e = 0; e < 4; ++e) { const float q = k4[e] * kkp[e]; ss += q * q; }
        if (gq & 1) DEP(ss); }
    ss = swap32_sum(ss);
    const float inv = __builtin_amdgcn_rcpf(fmaxf(__builtin_amdgcn_sqrtf(ss), 1e-12f));
    asm volatile("" ::: "memory");
    v4u bz[4], ba[4];
    { const bf16* zc = F.PROJ + m * NP + 8 * hi; const bf16* zp = F.PROJ + (hp ? m - 1 : m) * NP + 8 * hi; const float* zmu = F.shift_mu + 8 * hi;
#pragma unroll
      for (int s = 0; s < 4; ++s) {
#pragma unroll
        for (int which = 0; which < 2; ++which) {
            const int COL = (which ? C_ZA : C_ZW) + 16 * s, MUO = (which ? 1600 : 1536) + 16 * s;
            const v4u c = *(const GAS v4u*)(zc + tok + COL), p = *(const GAS v4u*)(zp + tok + COL); const f32x4 m0 = *(const GAS f32x4*)(zmu + tok + MUO), m1 = *(const GAS f32x4*)(zmu + tok + MUO + 4);
            float z[8];
#pragma unroll
            for (int j = 0; j < 4; ++j) { const float c0 = bflo(c[j]), c1 = bfhi(c[j]); const float mm0 = j < 2 ? m0[2 * j] : m1[2 * j - 4], mm1 = j < 2 ? m0[2 * j + 1] : m1[2 * j - 3];
                z[2 * j] = c0 + (bflo(p[j]) * pm - c0) * mm0; z[2 * j + 1] = c1 + (bfhi(p[j]) * pm - c1) * mm1; }
            if (which == 0) bz[s] = (v4u){cvtpk(tanh_f(z[0]), tanh_f(z[1])), cvtpk(tanh_f(z[2]), tanh_f(z[3])), cvtpk(tanh_f(z[4]), tanh_f(z[5])), cvtpk(tanh_f(z[6]), tanh_f(z[7]))};
            else ba[s] = (v4u){cvtpk(z[0], z[1]), cvtpk(z[2], z[3]), cvtpk(z[4], z[5]), cvtpk(z[6], z[7])};
            if (which == 0) DEP(bz[s][3]); else DEP(ba[s][3]);
        }
      } }
    asm volatile("" ::: "memory");
    v4u fa[4], fb[4], fk[4], fr[4], fv[4]; float rho = 0.f;
    float* gp = Dm.GAM + (size_t)u * 64 + hi * 32;
#define RW_LORA(cb) f32x16 accd = f32x16{}, acca = f32x16{}; _Pragma("unroll") for (int s = 0; s < 4; ++s) { \
        const v4u aD = *(const GAS v4u*)(F.WdT + tok + (size_t)(w * 64 + (cb) * 32 + l31) * 64 + 16 * s + 8 * hi); accd = MFMA32(aD, bz[s], accd); \
        const v4u aA = *(const GAS v4u*)(F.WaT + tok + (size_t)(w * 64 + (cb) * 32 + l31) * 64 + 16 * s + 8 * hi); acca = MFMA32(aA, ba[s], acca); }
#define RW_GROUP(cb, rg) do { constexpr int OFF = 32 * (cb) + 8 * (rg); const int ch0 = OFF + 4 * hi; \
            float rr[4], kk4[4], vv[4]; \
            SH4(rr, C_R, 0, OFF); SH4(kk4, C_K, 512, OFF); SH4(vv, C_V, 1024, OFF); \
            const f32x4 w0v = *(const GAS f32x4*)(pw0 + tok + OFF), a0v = *(const GAS f32x4*)(pa0 + tok + OFF), kkp = *(const GAS f32x4*)(pkk + tok + OFF), kap = *(const GAS f32x4*)(pka + tok + OFF), rkp = *(const GAS f32x4*)(prk + tok + OFF); \
            float xa[4], xb[4], xk[4], xr[4], gg[4], ge[4]; \
            _Pragma("unroll") for (int e = 0; e < 4; ++e) { \
                const float nx = -(w0v[e] + accd[4 * (rg) + e]); const float sp = fmaxf(nx, 0.f) + __logf(1.f + __expf(-fabsf(nx))); \
                const float l2 = -__expf(-sp - 0.5f) * LOG2E; \
                const float g = scan32(l2); \
                const float a = __builtin_amdgcn_rcpf(1.f + __expf(-(a0v[e] + acca[4 * (rg) + e]))); \
                const float kk = kk4[e] * kkp[e] * inv; \
                const float kt = kk4[e] * (1.f + (a - 1.f) * kap[e]); \
                rho += rr[e] * kt * rkp[e]; \
                const float eg = __builtin_amdgcn_exp2f(g), egp = __builtin_amdgcn_exp2f(g - l2), eng = __builtin_amdgcn_rcpf(eg); \
                xa[e] = -kk * egp; xb[e] = kk * a * eng; xk[e] = kt * eng; xr[e] = rr[e] * eg; gg[e] = g; ge[e] = eg; } \
            if (l31 == 31) { *(LAS f32x4*)(wscr + ch0) = (f32x4){gg[0], gg[1], gg[2], gg[3]}; *(GAS f32x4*)(gp + (cb) * 16 + 4 * (rg)) = (f32x4){ge[0], ge[1], ge[2], ge[3]}; } \
            constexpr int s_ = 2 * (cb) + ((rg) >> 1), vg = 2 * ((rg) & 1); \
            fa[s_][vg] = cvtpk(xa[0], xa[1]); fa[s_][vg + 1] = cvtpk(xa[2], xa[3]); \
            fb[s_][vg] = cvtpk(xb[0], xb[1]); fb[s_][vg + 1] = cvtpk(xb[2], xb[3]); \
            fk[s_][vg] = cvtpk(xk[0], xk[1]); fk[s_][vg + 1] = cvtpk(xk[2], xk[3]); \
            fr[s_][vg] = cvtpk(xr[0], xr[1]); fr[s_][vg + 1] = cvtpk(xr[2], xr[3]); \
            fv[s_][vg] = cvtpk(vv[0], vv[1]); fv[s_][vg + 1] = cvtpk(vv[2], vv[3]); \
            if (((rg) & 1) == 1) { PARK(s_) = fv[s_]; PARK(4 + s_) = fr[s_]; } \
            DEP(fa[s_][vg + 1]); DEP(fb[s_][vg + 1]); DEP(fk[s_][vg + 1]); DEP(fr[s_][vg + 1]); DEP(fv[s_][vg + 1]); DEP(rho); } while (0)
    { RW_LORA(0) RW_GROUP(0, 0); RW_GROUP(0, 1); RW_GROUP(0, 2); RW_GROUP(0, 3); }
    { RW_LORA(1) RW_GROUP(1, 0); RW_GROUP(1, 1); RW_GROUP(1, 2); RW_GROUP(1, 3); }
#undef RW_LORA
#undef RW_GROUP
#undef SH4
    LDS_WAIT(); asm volatile("" ::: "memory");
    float EC[2]; EC[0] = __builtin_amdgcn_exp2f(wscr[l31]); EC[1] = __builtin_amdgcn_exp2f(wscr[32 + l31]);
    LDS_WAIT(); asm volatile("" ::: "memory");
    rho = swap32_sum(rho);
    if (hi == 0) Dm.RHO[(size_t)u * 32 + l31] = rho;
    v4u idf[2];
    { const int jst = 4 * ((l31 >> 3) & 1) + (l31 & 3); const bool hm = ((l31 >> 2) & 1) == hi; const unsigned one = 0x3F80u << (16 * (jst & 1));
#pragma unroll
      for (int sig = 0; sig < 2; ++sig) { const bool on = hm && ((l31 >> 4) == sig);
#pragma unroll
          for (int q = 0; q < 4; ++q) idf[sig][q] = (on && (jst >> 1) == q) ? one : 0u; } }
    LDS_WAIT();
    v4u Af[2][2], Vf[2][2];
#pragma unroll
    for (int blk = 0; blk < 2; ++blk) {
        f32x16 za = MFMA32(fa[2 * blk], idf[0], f32x16{}); za = MFMA32(fa[2 * blk + 1], idf[1], za);
        f32x16 zv = MFMA32(PARK(2 * blk), idf[0], f32x16{}); zv = MFMA32(PARK(2 * blk + 1), idf[1], zv);
        f32x16 zb = MFMA32(fb[2 * blk], idf[0], f32x16{}); zb = MFMA32(fb[2 * blk + 1], idf[1], zb);
        f32x16 zk = MFMA32(fk[2 * blk], idf[0], f32x16{}); zk = MFMA32(fk[2 * blk + 1], idf[1], zk);
        zb = zb * EC[blk]; zk = zk * EC[blk];
#pragma unroll
        for (int s = 0; s < 2; ++s) { Af[blk][s] = FRAGACC(za, s); Vf[blk][s] = FRAGACC(zv, s); PARK(8 + 2 * blk + s) = FRAGACC(zb, s); PARK(12 + 2 * blk + s) = FRAGACC(zk, s); }
        __builtin_amdgcn_sched_barrier(0);
    }
    f32x16 Aab = f32x16{}, TT = f32x16{}, AakT = f32x16{}, ArbT = f32x16{}, ArkT = f32x16{};
#pragma unroll
    for (int s = 0; s < 4; ++s) { const v4u frs = PARK(4 + s); Aab = MFMA32(fa[s], fb[s], Aab); TT = MFMA32(fb[s], fa[s], TT); AakT = MFMA32(fk[s], fa[s], AakT); ArbT = MFMA32(fb[s], frs, ArbT); ArkT = MFMA32(fk[s], frs, ArkT); }
#pragma unroll
    for (int r = 0; r < 16; ++r) { const int rowi = (r & 3) + 8 * (r >> 2) + 4 * hi;
        Aab[r] = (l31 < rowi) ? Aab[r] : 0.f; TT[r] = (rowi < l31) ? TT[r] : 0.f; AakT[r] = (rowi < l31) ? AakT[r] : 0.f;
        ArbT[r] = (rowi <= l31) ? ArbT[r] : 0.f; ArkT[r] = (rowi <= l31) ? ArkT[r] : 0.f; }
    v4u AakTf[2], ArbTf[2], ArkTf[2];
#pragma unroll
    for (int s = 0; s < 2; ++s) { AakTf[s] = FRAGACC(AakT, s); ArbTf[s] = FRAGACC(ArbT, s); ArkTf[s] = FRAGACC(ArkT, s); }
    __builtin_amdgcn_sched_barrier(0);
    v4u Xf[2], XTf[2], TTf[2];
#pragma unroll
    for (int s = 0; s < 2; ++s) { Xf[s] = FRAGACC(Aab, s); XTf[s] = FRAGACC(TT, s); }
#pragma unroll
    for (int r = 0; r < 16; ++r) { const int rowi = (r & 3) + 8 * (r >> 2) + 4 * hi; TT[r] += (rowi == l31) ? 1.f : 0.f; }
#pragma unroll
    for (int it = 0; it < 4; ++it) {
        f32x16 X2 = MFMA32(XTf[0], Xf[0], f32x16{}); X2 = MFMA32(XTf[1], Xf[1], X2);
        if (it < 3) { f32x16 X2T = MFMA32(Xf[0], XTf[0], f32x16{}); X2T = MFMA32(Xf[1], XTf[1], X2T);
#pragma unroll
            for (int s = 0; s < 2; ++s) XTf[s] = FRAGACC(X2T, s); }
#pragma unroll
        for (int s = 0; s < 2; ++s) { Xf[s] = FRAGACC(X2, s); TTf[s] = FRAGACC(TT, s); }
        TT = MFMA32(Xf[0], TTf[0], TT); TT = MFMA32(Xf[1], TTf[1], TT);
        __builtin_amdgcn_sched_barrier(0);
    }
#pragma unroll
    for (int s = 0; s < 2; ++s) TTf[s] = FRAGACC(TT, s);
    v4u Wf[2][2], Uf[2][2];
#pragma unroll
    for (int blk = 0; blk < 2; ++blk) {
        f32x16 av = MFMA32(AakTf[0], Vf[blk][0], f32x16{}); av = MFMA32(AakTf[1], Vf[blk][1], av);
        const v4u avf0 = FRAGACC(av, 0), avf1 = FRAGACC(av, 1);
        f32x16 uu = MFMA32(TTf[0], avf0, f32x16{}); uu = MFMA32(TTf[1], avf1, uu);
        f32x16 ww = MFMA32(TTf[0], Af[blk][0], f32x16{}); ww = MFMA32(TTf[1], Af[blk][1], ww);
#pragma unroll
        for (int s = 0; s < 2; ++s) { Wf[blk][s] = FRAGACC(ww, s); Uf[blk][s] = FRAGACC(uu, s); }
        __builtin_amdgcn_sched_barrier(0);
    }
    v4u* QFp = Dm.QF + (size_t)u * 256 + lane; v4u* YDp = Dm.YD + (size_t)u * 256 + lane;
#pragma unroll
    for (int blk = 0; blk < 2; ++blk) {
        f32x16 q;
#pragma unroll
        for (int s = 0; s < 2; ++s)
            { const v4u frs = PARK(4 + 2 * blk + s);
#pragma unroll
              for (int j = 0; j < 4; ++j) { q[8 * s + 2 * j] = bflo(frs[j]); q[8 * s + 2 * j + 1] = bfhi(frs[j]); } }
        q = MFMA32(Wf[blk][0], ArbTf[0], q); q = MFMA32(Wf[blk][1], ArbTf[1], q);
        *(GAS v4u*)(QFp + (2 * blk) * 64) = FRAGACC(q, 0); *(GAS v4u*)(QFp + (2 * blk + 1) * 64) = FRAGACC(q, 1);
        f32x16 y = MFMA32(Uf[blk][0], ArbTf[0], f32x16{}); y = MFMA32(Uf[blk][1], ArbTf[1], y); y = MFMA32(Vf[blk][0], ArkTf[0], y); y = MFMA32(Vf[blk][1], ArkTf[1], y);
        *(GAS v4u*)(YDp + (2 * blk) * 64) = FRAGACC(y, 0); *(GAS v4u*)(YDp + (2 * blk + 1) * 64) = FRAGACC(y, 1);
        __builtin_amdgcn_sched_barrier(0);
    }
    v4u* PFp = Dm.PF + (size_t)u * 512 + lane; v4u* DDp = Dm.DD + (size_t)u * 512 + lane;
#pragma unroll
    for (int c1 = 0; c1 < 2; ++c1)
#pragma unroll
        for (int cb = 0; cb < 2; ++cb) {
            f32x16 p = MFMA32(Wf[c1][0], PARK(8 + 2 * cb), f32x16{}); p = MFMA32(Wf[c1][1], PARK(8 + 2 * cb + 1), p);
            *(GAS v4u*)(PFp + (cb * 4 + 2 * c1) * 64) = FRAGACC(p, 0); *(GAS v4u*)(PFp + (cb * 4 + 2 * c1 + 1) * 64) = FRAGACC(p, 1);
            __builtin_amdgcn_sched_barrier(0);
        }
#pragma unroll
    for (int cb = 0; cb < 2; ++cb)
#pragma unroll
        for (int ib = 0; ib < 2; ++ib) {
            f32x16 d = MFMA32(PARK(8 + 2 * cb), Uf[ib][0], f32x16{}); d = MFMA32(PARK(8 + 2 * cb + 1), Uf[ib][1], d); d = MFMA32(PARK(12 + 2 * cb), Vf[ib][0], d); d = MFMA32(PARK(12 + 2 * cb + 1), Vf[ib][1], d);
            *(GAS v4u*)(DDp + ((cb * 2 + ib) * 2) * 64) = FRAGACC(d, 0); *(GAS v4u*)(DDp + ((cb * 2 + ib) * 2 + 1) * 64) = FRAGACC(d, 1);
            __builtin_amdgcn_sched_barrier(0);
        }
}

#undef PARK
#undef DEP
constexpr int RB_PF = 0, RB_DD = 8192, RB_QF = 16384, RB_YD = 20480, RB_GAM = 24576, RB_BUF = 24832, RB_STAT = 2 * RB_BUF;
__device__ __forceinline__ void unpack16(const v4u a, const v4u b, f32x16& o) {
#pragma unroll
    for (int j = 0; j < 4; ++j) { o[2 * j] = bflo(a[j]); o[2 * j + 1] = bfhi(a[j]); o[8 + 2 * j] = bflo(b[j]); o[8 + 2 * j + 1] = bfhi(b[j]); }
}
__device__ __forceinline__ void rwkvB_unit(Frame& F, const RwDump& Dm, int bh) {
    const int tid = F.tid, lane = F.lane, hi = lane >> 5, l31 = lane & 31, wid = F.wave, b = bh >> 3, h = bh & 7;
    LAS unsigned char* lds = F.lds + RING_OFF;
    const size_t u0 = (size_t)bh * (T / 32);
    v4u st0, st1, st2, st3;
#define RB_LOAD(ci_) do { const size_t u_ = u0 + (ci_); st0 = *(const GAS v4u*)(Dm.PF + u_ * 512 + tid); st1 = *(const GAS v4u*)(Dm.DD + u_ * 512 + tid); \
        st2 = (tid < 256) ? *(const GAS v4u*)(Dm.QF + u_ * 256 + tid) : *(const GAS v4u*)(Dm.YD + u_ * 256 + (tid - 256)); \
        if (tid < 16) st3 = *(const GAS v4u*)((const v4u*)(Dm.GAM + u_ * 64) + tid); } while (0)
#define RB_STORE(buf_) do { LAS unsigned char* b_ = lds + (buf_) * RB_BUF; *(LAS v4u*)(b_ + RB_PF + tid * 16) = st0; *(LAS v4u*)(b_ + RB_DD + tid * 16) = st1; \
        *(LAS v4u*)(b_ + RB_QF + tid * 16) = st2; if (tid < 16) *(LAS v4u*)(b_ + RB_GAM + tid * 16) = st3; } while (0)
    f32x16 S[2]; S[0] = f32x16{}; S[1] = f32x16{};
    f32x16 ypend = f32x16{};
    LAS float* stat = (LAS float*)(lds + RB_STAT);
    const bool cons = wid < 2; const int ib = wid;
    RB_LOAD(0); RB_STORE(0);
    __syncthreads();
#define RB_EPI(cj_) do { const int par_ = (cj_) & 1; \
        const float s1_ = stat[((par_ * 2 + 0) * 32 + l31) * 2] + stat[((par_ * 2 + 1) * 32 + l31) * 2], s2_ = stat[((par_ * 2 + 0) * 32 + l31) * 2 + 1] + stat[((par_ * 2 + 1) * 32 + l31) * 2 + 1]; \
        const float mean_ = s1_ * (1.f / 64.f), var_ = fmaxf(s2_ * (1.f / 64.f) - mean_ * mean_, 0.f), rstd_ = 1.f / sqrtf(var_ + 64e-5f); \
        const int tt_ = (cj_) * 32 + l31; const size_t mm_ = (size_t)b * T + tt_; const float rho_ = Dm.RHO[(u0 + (cj_)) * 32 + l31]; \
        _Pragma("unroll") for (int rg = 0; rg < 4; ++rg) { const int i0_ = 32 * ib + 8 * rg + 4 * hi, hc_ = h * 64 + i0_; float vv_[4]; \
            shifted4(F.PROJ, mm_, tt_ > 0, C_V + hc_, F.shift_mu + 1024 + hc_, vv_); \
            const v2u gw_ = *(const GAS v2u*)(F.PROJ + mm_ * NP + C_GA + hc_); const float g4_[4] = {bflo(gw_.x), bfhi(gw_.x), bflo(gw_.y), bfhi(gw_.y)}; \
            const f32x4 lw_ = *(const GAS f32x4*)(F.ln_w + hc_), lb_ = *(const GAS f32x4*)(F.ln_b + hc_); float o_[4]; \
            _Pragma("unroll") for (int e = 0; e < 4; ++e) { const float yn_ = (ypend[4 * rg + e] - mean_) * rstd_ * lw_[e] + lb_[e] + rho_ * vv_[e]; o_[e] = yn_ * g4_[e] / (1.f + __expf(-g4_[e])); } \
            *(GAS v2u*)(F.MIX + mm_ * D + hc_) = (v2u){cvtpk(o_[0], o_[1]), cvtpk(o_[2], o_[3])}; } } while (0)
#pragma unroll 1
    for (int ci = 0; ci < T / 32; ++ci) {
        if (ci + 1 < T / 32) RB_LOAD(ci + 1);
        if (cons) {
            const LAS unsigned char* bb = lds + (ci & 1) * RB_BUF;
            if (ci > 0) RB_EPI(ci - 1);
            v4u Sf[4];
#pragma unroll
            for (int s = 0; s < 4; ++s) Sf[s] = FRAGACC(S[s >> 1], s & 1);
            f32x16 y; unpack16(*(const LAS v4u*)(bb + RB_YD + ((2 * ib) * 64 + lane) * 16), *(const LAS v4u*)(bb + RB_YD + ((2 * ib + 1) * 64 + lane) * 16), y);
#pragma unroll
            for (int s = 0; s < 4; ++s) y = MFMA32(Sf[s], *(const LAS v4u*)(bb + RB_QF + (s * 64 + lane) * 16), y);
#pragma unroll
            for (int rb = 0; rb < 2; ++rb) {
                f32x16 acc; unpack16(*(const LAS v4u*)(bb + RB_DD + (((rb * 2 + ib) * 2) * 64 + lane) * 16), *(const LAS v4u*)(bb + RB_DD + (((rb * 2 + ib) * 2 + 1) * 64 + lane) * 16), acc);
                const LAS f32x4* gm = (const LAS f32x4*)(bb + RB_GAM + (hi * 32 + rb * 16) * 4);
#pragma unroll
                for (int q = 0; q < 4; ++q) { const f32x4 gv = gm[q];
#pragma unroll
                    for (int e = 0; e < 4; ++e) acc[4 * q + e] += gv[e] * S[rb][4 * q + e]; }
#pragma unroll
                for (int s = 0; s < 4; ++s) acc = MFMA32(*(const LAS v4u*)(bb + RB_PF + ((rb * 4 + s) * 64 + lane) * 16), Sf[s], acc);
                S[rb] = acc;
            }
            float s1 = 0.f, s2 = 0.f;
#pragma unroll
            for (int r = 0; r < 16; ++r) { s1 += y[r]; s2 += y[r] * y[r]; }
            s1 = swap32_sum(s1); s2 = swap32_sum(s2);
            if (hi == 0) { stat[(((ci & 1) * 2 + ib) * 32 + l31) * 2] = s1; stat[(((ci & 1) * 2 + ib) * 32 + l31) * 2 + 1] = s2; }
            ypend = y;
        }
        if (ci + 1 < T / 32) RB_STORE((ci + 1) & 1);
        __syncthreads();
    }
    if (cons) RB_EPI(T / 32 - 1);
    __syncthreads();
#undef RB_LOAD
#undef RB_STORE
#undef RB_EPI
}
constexpr int AT_KROW = 272, AT_KB = 64 * AT_KROW, AT_VB = 64 * 256, AT_BUF = AT_KB + AT_VB;
__device__ __forceinline__ s16x4 vtr(const LAS unsigned char* p) { typedef short v4i16_t __attribute__((ext_vector_type(4))); return __builtin_bit_cast(s16x4, __builtin_amdgcn_ds_read_tr16_b64_v4i16((LAS v4i16_t*)p)); }
__device__ __forceinline__ void attn_unit(Frame& F, int b, int h, int qb, float slope2, float shift2, float lam) {
    const int tid = F.tid, lane = F.lane, l31 = lane & 31, hi = lane >> 5, wid = F.wave, map = wid >> 2, qs = wid & 3;
    LAS unsigned char* lds = F.lds + RING_OFF;
    const int q0 = qb * 128, qrow = q0 + 32 * qs + l31;
    const size_t mrow = (size_t)b * T + qrow;
    bf16x8 qf[4];
    { const bf16* qp = F.PROJ + mrow * NP + C_DQ + h * 128 + map * 64 + 8 * hi;
#pragma unroll
      for (int s = 0; s < 4; ++s) qf[s] = *(const GAS bf16x8*)(qp + 16 * s); }
    const bf16* kg = F.PROJ + (size_t)b * T * NP + C_DK + h * 128;
    const bf16* vg = F.PROJ + (size_t)b * T * NP + C_DV + h * 128;
    const int NT = 2 * qb + 2, tl = 2 * qb + (qs >> 1);
    const int srow0 = tid >> 4, sch = tid & 15, srow1 = srow0 + 32;
    const unsigned kdst0 = srow0 * AT_KROW + sch * 16, kdst1 = srow1 * AT_KROW + sch * 16;
    const unsigned vdst0 = AT_KB + srow0 * 256 + ((sch ^ ((srow0 & 3) << 2)) * 16), vdst1 = AT_KB + srow1 * 256 + ((sch ^ ((srow1 & 3) << 2)) * 16);
    v4u kr0, kr1, vr0, vr1;
#define AT_LOAD(t_) do { const size_t r0_ = (size_t)(64 * (t_) + srow0) * NP + sch * 8, r1_ = (size_t)(64 * (t_) + srow1) * NP + sch * 8; \
        kr0 = *(const GAS v4u*)(kg + r0_); kr1 = *(const GAS v4u*)(kg + r1_); vr0 = *(const GAS v4u*)(vg + r0_); vr1 = *(const GAS v4u*)(vg + r1_); } while (0)
#define AT_STORE(buf_) do { LAS unsigned char* b_ = lds + (buf_) * AT_BUF; *(LAS v4u*)(b_ + kdst0) = kr0; *(LAS v4u*)(b_ + kdst1) = kr1; *(LAS v4u*)(b_ + vdst0) = vr0; *(LAS v4u*)(b_ + vdst1) = vr1; } while (0)
    f32x16 o[4];
#pragma unroll
    for (int vb = 0; vb < 4; ++vb) o[vb] = f32x16{};
    float lsum = 0.f;
    AT_LOAD(0); AT_STORE(0);
    __syncthreads();
    const int G = lane >> 4, qq = (lane & 15) >> 2, pp = lane & 3;
#pragma unroll 1
    for (int t = 0; t < NT; ++t) {
        if (t + 1 < NT) AT_LOAD(t + 1);
        if (t <= tl) {
            const LAS unsigned char* Kb = lds + (t & 1) * AT_BUF; const LAS unsigned char* Vb = Kb + AT_KB;
            const float base = slope2 * (float)(64 * t + 4 * hi - qrow) - shift2;
            f32x16 p0, p1;
#pragma unroll
            for (int r = 0; r < 16; ++r) { p0[r] = base + slope2 * (float)((r & 3) + 8 * (r >> 2)); p1[r] = p0[r] + 32.f * slope2; }
#pragma unroll
            for (int s = 0; s < 4; ++s) {
                const bf16x8 a0 = *(const LAS bf16x8*)(Kb + l31 * AT_KROW + map * 128 + (2 * s + hi) * 16);
                const bf16x8 a1 = *(const LAS bf16x8*)(Kb + (32 + l31) * AT_KROW + map * 128 + (2 * s + hi) * 16);
                p0 = __builtin_amdgcn_mfma_f32_32x32x16_bf16(a0, qf[s], p0, 0, 0, 0);
                p1 = __builtin_amdgcn_mfma_f32_32x32x16_bf16(a1, qf[s], p1, 0, 0, 0);
            }
            if (t == tl) {
#pragma unroll
                for (int r = 0; r < 16; ++r) { const int ki = 64 * t + 4 * hi + (r & 3) + 8 * (r >> 2); if (ki > qrow) p0[r] = -1e30f; if (ki + 32 > qrow) p1[r] = -1e30f; }
            }
            float ls = 0.f;
#pragma unroll
            for (int r = 0; r < 16; ++r) { p0[r] = __builtin_amdgcn_exp2f(p0[r]); p1[r] = __builtin_amdgcn_exp2f(p1[r]); ls += p0[r] + p1[r]; }
            lsum += ls;
            v4u pw[4];
            pw[0] = (v4u){cvtpk(p0[0], p0[1]), cvtpk(p0[2], p0[3]), cvtpk(p0[4], p0[5]), cvtpk(p0[6], p0[7])};
            pw[1] = (v4u){cvtpk(p0[8], p0[9]), cvtpk(p0[10], p0[11]), cvtpk(p0[12], p0[13]), cvtpk(p0[14], p0[15])};
            pw[2] = (v4u){cvtpk(p1[0], p1[1]), cvtpk(p1[2], p1[3]), cvtpk(p1[4], p1[5]), cvtpk(p1[6], p1[7])};
            pw[3] = (v4u){cvtpk(p1[8], p1[9]), cvtpk(p1[10], p1[11]), cvtpk(p1[12], p1[13]), cvtpk(p1[14], p1[15])};
#pragma unroll
            for (int ks = 0; ks < 4; ++ks) {
                const int kvb = 32 * (ks >> 1) + 16 * (ks & 1);
                const int rowlo = kvb + 4 * hi + qq;
#pragma unroll
                for (int vb = 0; vb < 4; ++vb) {
                    const int chunk = (4 * vb + 2 * (G & 1) + (pp >> 1)) ^ (qq << 2);
                    const LAS unsigned char* alo = Vb + rowlo * 256 + chunk * 16 + 8 * (pp & 1);
                    const s16x4 lo = vtr(alo), hi4 = vtr(alo + 8 * 256);
                    const bf16x8 vf = (bf16x8){lo[0], lo[1], lo[2], lo[3], hi4[0], hi4[1], hi4[2], hi4[3]};
                    o[vb] = __builtin_amdgcn_mfma_f32_32x32x16_bf16(vf, __builtin_bit_cast(bf16x8, pw[ks]), o[vb], 0, 0, 0);
                }
            }
        }
        if (t + 1 < NT) AT_STORE((t + 1) & 1);
        __syncthreads();
    }
#undef AT_LOAD
#undef AT_STORE
    const float ltot = swap32_sum(lsum);
    LAS float* X = (LAS float*)lds;
    if (map == 1) {
        const float sc = lam / ltot;
#pragma unroll
        for (int vb = 0; vb < 4; ++vb)
#pragma unroll
            for (int r = 0; r < 16; ++r) X[(qs * 64 + vb * 16 + r) * 64 + lane] = o[vb][r] * sc;
    }
    __syncthreads();
    if (map == 0) {
        const float il = 1.f / ltot; float ss = 0.f;
#pragma unroll
        for (int vb = 0; vb < 4; ++vb)
#pragma unroll
            for (int r = 0; r < 16; ++r) { const float v = o[vb][r] * il - X[(qs * 64 + vb * 16 + r) * 64 + lane]; o[vb][r] = v; ss += v * v; }
        ss = swap32_sum(ss);
        const float rn = (1.f / sqrtf(ss * (1.f / 128.f) + 1e-5f)) * (1.f - LAMBDA_INIT);
        const bf16* gp = F.PROJ + mrow * NP + C_GB + h * 128;
        bf16* op = F.MIX + mrow * D + 512 + h * 128;
#pragma unroll
        for (int vb = 0; vb < 4; ++vb)
#pragma unroll
            for (int rg = 0; rg < 4; ++rg) {
                const int vc = 32 * vb + 8 * rg + 4 * hi;
                const v2u gw = *(const GAS v2u*)(gp + vc); const f32x4 sg = *(const GAS f32x4*)(F.subln_g + vc);
                const float g4[4] = {bflo(gw.x), bfhi(gw.x), bflo(gw.y), bfhi(gw.y)}; float ov[4];
#pragma unroll
                for (int e = 0; e < 4; ++e) ov[e] = o[vb][4 * rg + e] * rn * sg[e] * g4[e] / (1.f + __expf(-g4[e]));
                *(GAS v2u*)(op + vc) = (v2u){cvtpk(ov[0], ov[1]), cvtpk(ov[2], ov[3])};
            }
    }
    __syncthreads();
}
constexpr int CW_QUEUE = 8192;
constexpr int Q_RW = BATCH * RH, Q_AT = BATCH * AH * (T / 128), Q_ALL = Q_RW + Q_AT;
__device__ __forceinline__ void p3_queue(Frame& F, const RwDump& Dm) {
    const float l1 = wave_sum(F.lq1[F.lane] * F.lk1[F.lane]), l2 = wave_sum(F.lq2[F.lane] * F.lk2[F.lane]);
    const float lam = __expf(l1) - __expf(l2) + LAMBDA_INIT;
    float gq = fabsf(F.qn_g[F.lane]), gk = fabsf(F.kn_g[F.lane]);
#pragma unroll
    for (int o = 1; o < 64; o <<= 1) { gq = fmaxf(gq, __shfl_xor(gq, o)); gk = fmaxf(gk, __shfl_xor(gk, o)); }
    const float shift2 = 8.f * gq * gk * LOG2E;
    for (;;) {
        if (F.tid == 0) F.MISC[12] = __hip_atomic_fetch_add(F.ctl + CW_QUEUE, 1u, RLX_AGENT);
        __syncthreads();
        const int item = __builtin_amdgcn_readfirstlane((int)F.MISC[12]);
        __syncthreads();
        if (item >= Q_ALL) break;
        if (item < Q_RW) rwkvB_unit(F, Dm, item);
        else { const int idx = item - Q_RW, qb = 15 - (idx >> 5), bhh = idx & 31, b = bhh >> 2, h = bhh & 3;
            attn_unit(F, b, h, qb, exp2f(-2.f * (float)(h + 1)) * LOG2E, shift2, lam); }
    }
}

struct Args { const float* in[21]; float* out; unsigned char* ws; int ph_lo, ph_hi; };
__global__ void __launch_bounds__(NWAVES * 64, 2) hymba_fwd(Args args) {
    extern __shared__ __attribute__((aligned(16))) unsigned char lds[];
    Frame F;
    F.lds = (LAS unsigned char*)lds;
    F.MISC = (volatile LAS unsigned*)(F.lds + MISC_OFF);
    F.tid = threadIdx.x; F.lane = F.tid & 63; F.wave = __builtin_amdgcn_readfirstlane(F.tid >> 6);
    F.G = gridDim.x; { const int bx = blockIdx.x; F.vcu = (F.G % 8 == 0) ? (bx % 8) * (F.G / 8) + bx / 8 : bx; }
    unsigned char* ws = args.ws;
    F.ctl = (gu32*)(ws + WS_CTL);
    F.x = args.in[0]; F.norm_g = args.in[1]; F.w_in = args.in[2]; F.shift_mu = args.in[3]; F.w0 = args.in[4]; F.w_decay_up = args.in[5]; F.a0 = args.in[6]; F.w_iclr_up = args.in[7];
    F.k_k = args.in[8]; F.k_a = args.in[9]; F.r_k = args.in[10]; F.ln_w = args.in[11]; F.ln_b = args.in[12]; F.qn_g = args.in[13]; F.kn_g = args.in[14];
    F.lq1 = args.in[15]; F.lk1 = args.in[16]; F.lq2 = args.in[17]; F.lk2 = args.in[18]; F.subln_g = args.in[19]; F.w_out = args.in[20]; F.out = args.out;
    F.WinT = (bf16*)(ws + WS_WIN); F.WoutT = (bf16*)(ws + WS_WOUT); F.WdT = (bf16*)(ws + WS_WD); F.WaT = (bf16*)(ws + WS_WA);
    F.XN = (bf16*)(ws + WS_XN); F.PROJ = (bf16*)(ws + WS_PROJ); F.MIX = (bf16*)(ws + WS_MIX);
    for (int u = F.tid; u < (LDS_BYTES - LDSCTL_OFF) / 4; u += NWAVES * 64) ((LAS unsigned*)(F.lds + LDSCTL_OFF))[u] = 0u;
    __syncthreads();
    XcdBarrier bar; bar.bar = (unsigned*)(F.ctl + CW_BAR); bar.x = 0; bar.st = nullptr;
    if (MK_N_LAUNCHES == 1) bar = xcd_barrier_post((unsigned*)(F.ctl + CW_BAR), F.MISC + 8);
#define GRID_BAR() do { if (MK_N_LAUNCHES == 1) xcd_barrier(bar); } while (0)
    const int lo = args.ph_lo, hi = args.ph_hi;
#define IN(k) (lo <= (k) && (k) < hi)
#define BOTH(k) (IN(k) && IN((k) + 1))
#ifndef SKIP
#define SKIP 0
#endif
    if (IN(0) && !(SKIP & 1)) { p0_prologue(F); if (BOTH(0)) GRID_BAR(); }
    if (IN(1) && !(SKIP & 2)) {
        pg8::Gemm g{F.XN, F.WinT, M, NP, D}; pg8::StaticOrder S; S.init(M, NP, F.G, (int)blockIdx.x);
        pg8::EpiBf16S E{F.PROJ, NP};
        pg8::gemm_phase<pg8::EpiBf16S, pg8::StaticOrder, true, true>(F.lds + RING_OFF, g, S, E);
        if (BOTH(1)) GRID_BAR();
    }
    RwDump Dm; { unsigned char* so = (unsigned char*)args.out; Dm.PF = (v4u*)so; Dm.DD = (v4u*)(so + 32 * MiB); Dm.QF = (v4u*)(ws + WS_XN); Dm.YD = (v4u*)(ws + WS_XN + 16 * MiB);
        Dm.GAM = (float*)(ws + WS_END); Dm.RHO = (float*)(ws + WS_END + 1 * MiB); }
    if (IN(2) && !(SKIP & 4)) {
        LAS float* wscr = (LAS float*)(F.lds + LDSCTL_OFF + 1024) + F.wave * 64;
#pragma unroll 1
        for (int p = F.vcu; p < BATCH * (T / 32); p += F.G) rwkvA_unit(F, Dm, (p >> 6) * RH + F.wave, p & 63, wscr, F.lds + RING_OFF + F.wave * 16384);
        p2_qknorm(F);
        if (BOTH(2)) GRID_BAR();
    }
    if (IN(3) && !(SKIP & 8)) {
        p3_queue(F, Dm);
        if (BOTH(3)) GRID_BAR();
    }
    if (IN(4) && !(SKIP & 16)) {
        pg8::Gemm g{F.MIX, F.WoutT, M, D, D}; pg8::StaticOrder S; S.init(M, D, F.G, (int)blockIdx.x);
        pg8::EpiResF32 E{F.x, F.out, D};
        pg8::gemm_phase<pg8::EpiResF32, pg8::StaticOrder, false, true>(F.lds + RING_OFF, g, S, E);
    }
#undef IN
#undef BOTH
}

extern "C" void kernel_launch(void* const* d_in, const int* in_sizes, int n_in, void* d_out, int out_size, void* d_ws, size_t ws_size, hipStream_t stream) {
    static int grid = 0;
    if (grid == 0) {
        if (n_in != 21 || in_sizes[0] != M * D || out_size != M * D || ws_size < WS_END + 2 * MiB) { fprintf(stderr, "kernel_launch: unexpected shapes (n_in %d, in0 %d, out %d, ws %zu); nothing launched\n", n_in, n_in > 0 ? in_sizes[0] : -1, out_size, ws_size); grid = -1; return; }
        int dev = 0, cus = 0, per_cu = 0;
        if (hipGetDevice(&dev) != hipSuccess || hipDeviceGetAttribute(&cus, hipDeviceAttributeMultiprocessorCount, dev) != hipSuccess) { grid = -1; return; }
        if (hipFuncSetAttribute((const void*)hymba_fwd, hipFuncAttributeMaxDynamicSharedMemorySize, LDS_BYTES) != hipSuccess) { fprintf(stderr, "kernel_launch: hipFuncSetAttribute failed\n"); grid = -1; return; }
        if (hipOccupancyMaxActiveBlocksPerMultiprocessor(&per_cu, (const void*)hymba_fwd, NWAVES * 64, LDS_BYTES) != hipSuccess || per_cu < 1) { fprintf(stderr, "kernel_launch: occupancy query reports %d workgroups per CU; nothing launched\n", per_cu); grid = -1; return; }
        (void)hipGetLastError();
        grid = cus;
        if (grid > 256) grid = 256;
    }
    if (grid < 0) return;
    if (hipMemsetAsync((char*)d_ws + WS_CTL, 0, CTL_ZERO_BYTES, stream) != hipSuccess) { fprintf(stderr, "kernel_launch: hipMemsetAsync failed\n"); return; }
    Args a{};
    for (int i = 0; i < 21; ++i) a.in[i] = (const float*)d_in[i];
    a.out = (float*)d_out; a.ws = (unsigned char*)d_ws;
    for (int li = 0; li < MK_N_LAUNCHES; ++li) {
        a.ph_lo = (MK_N_LAUNCHES == 1) ? 0 : li; a.ph_hi = (MK_N_LAUNCHES == 1) ? N_PHASES : li + 1;
        hipLaunchKernelGGL(hymba_fwd, dim3(grid), dim3(NWAVES * 64), LDS_BYTES, stream, a);
        const hipError_t le = hipPeekAtLastError();
        if (le != hipSuccess) { fprintf(stderr, "kernel_launch: launch %d failed: %s\n", li, hipGetErrorName(le)); break; }
    }
}
```

```cpp
#define MK_N_LAUNCHES 1
#include <hip/hip_runtime.h>
#include <hip/hip_bf16.h>
#include <cstdio>
#include <cstdint>
#include <cmath>
namespace pg8 {
#define PG8_LAS __attribute__((address_space(3)))
typedef unsigned short bf16_t;
typedef short bf16x8 __attribute__((ext_vector_type(8)));
typedef float f32x4 __attribute__((ext_vector_type(4)));
typedef unsigned u32x4 __attribute__((ext_vector_type(4)));
constexpr int BM = 256, BK = 64, HALF = 128, HTB = HALF * BK * 2  , STAGE_BYTES = 8 * HTB, NXCD = 8, WGM = 8;

__host__ __device__ __forceinline__ int lds_byte(int r, int c) { const int st = (r >> 4) * 2 + (c >> 5), rr = r & 15, cc = c & 31, ob = rr * 64 + cc * 2; return st * 1024 + (ob ^ (((ob >> 9) & 1) << 5)); }
__host__ __device__ __forceinline__ void stage_rc(int b, int& R, int& C) { const int st = b / 1024, sb = b % 1024, swz = sb ^ (((sb >> 9) & 1) << 5); R = (st >> 1) * 16 + swz / 64; C = (st & 1) * 32 + (swz % 64) / 2; }
__host__ __device__ __forceinline__ int perm32(int rho) { const int n = rho >> 4, i = rho & 15; return 8 * (i >> 2) + 4 * n + (i & 3); }

struct Unit { int pm, pn; };
struct Gemm { const bf16_t* A; const bf16_t* Bt; int M, N, K; };

struct StaticOrder {
    int nM, nN, nwg, G, c;
    __host__ __device__ void init(int M, int N, int G_, int c_) { nM = M / BM; nN = N / BM; nwg = nM * nN; G = G_; c = c_; }
    __host__ __device__ bool next(int i, Unit& u) const {
        const long L = (long)i * G + c; if (L >= nwg) return false;
        int wgid = (int)L; { const int q = nwg / NXCD, r = nwg % NXCD, xcd = wgid % NXCD, off = wgid / NXCD; wgid = (xcd < r ? xcd * (q + 1) : r * (q + 1) + (xcd - r) * q) + off; }
        const int nig = WGM * nN, gid = wgid / nig, fm = gid * WGM, gsz = (nM - fm) < WGM ? (nM - fm) : WGM;
        u.pm = fm + ((wgid % nig) % gsz); u.pn = (wgid % nig) / gsz; return true;
    }
    __device__ __forceinline__ void a_ready(const Unit&) const {}
    __device__ __forceinline__ void done(const Unit&) const {}
};

__device__ __forceinline__ unsigned cvt_pk_bf16(float lo, float hi) { unsigned r; asm volatile("v_cvt_pk_bf16_f32 %0, %1, %2" : "=v"(r) : "v"(lo), "v"(hi)); return r; }
struct EpiBf16S {
    static constexpr bool PERM = true, AFTER_DRAIN = false;
    bf16_t* O; int ldc;
    __device__ __forceinline__ void operator()(const f32x4 (&acc)[2][2][4][2], const Unit& u, int wr, int wc, int fr, int fq) const {
        const int row0 = u.pm * BM + wr * 64 + fr, col0 = u.pn * BM + wc * 32 + 8 * fq;
#pragma unroll
        for (int ai = 0; ai < 2; ++ai)
#pragma unroll
            for (int m = 0; m < 4; ++m) { bf16_t* rowp = O + (size_t)(row0 + ai * HALF + m * 16) * ldc + col0;
#pragma unroll
                for (int bj = 0; bj < 2; ++bj) { const f32x4 v0 = acc[ai][bj][m][0], v1 = acc[ai][bj][m][1];
                    u32x4 w; w.x = cvt_pk_bf16(v0[0], v0[1]); w.y = cvt_pk_bf16(v0[2], v0[3]); w.z = cvt_pk_bf16(v1[0], v1[1]); w.w = cvt_pk_bf16(v1[2], v1[3]);
                    *(u32x4*)(rowp + bj * HALF) = w; } }
    }
};
struct EpiResF32 {
    static constexpr bool PERM = false, AFTER_DRAIN = false;
    const float* base; float* out; int ldc;
    __device__ __forceinline__ void operator()(const f32x4 (&acc)[2][2][4][2], const Unit& u, int wr, int wc, int fr, int fq) const {
        const int row0 = u.pm * BM + wr * 64 + fr, col0 = u.pn * BM + wc * 32 + 4 * fq;
#pragma unroll
        for (int ai = 0; ai < 2; ++ai)
#pragma unroll
            for (int m = 0; m < 4; ++m) { const size_t off = (size_t)(row0 + ai * HALF + m * 16) * ldc + col0;
#pragma unroll
                for (int bj = 0; bj < 2; ++bj)
#pragma unroll
                    for (int n = 0; n < 2; ++n) { const f32x4 bs = *(const f32x4*)(base + off + bj * HALF + n * 16); *(f32x4*)(out + off + bj * HALF + n * 16) = bs + acc[ai][bj][m][n]; } }
    }
};
template <class Epi, class Sched, bool ALIGN_EPI = false, bool SP2 = false>
__device__ __forceinline__ void gemm_phase(PG8_LAS unsigned char* lds, const Gemm g, const Sched& S, const Epi& E) {
    const int tid = threadIdx.x, wid = __builtin_amdgcn_readfirstlane(tid >> 6), lane = tid & 63, wr = wid >> 2, wc = wid & 3, fr = lane & 15, fq = lane >> 4;
    const int K = g.K, nt = K / BK;
    unsigned voffA[2], voffB[2];
#pragma unroll
    for (int i = 0; i < 2; ++i) { int R, C; stage_rc(tid * 16 + i * 8192, R, C); const int Rb = Epi::PERM ? ((R & ~31) + perm32(R & 31)) : R;
        voffA[i] = (unsigned)(R * K + C) * 2u; voffB[i] = (unsigned)(Rb * K + C) * 2u; }
    const size_t kstep = (size_t)(BK * 2);
    const size_t hstep = (size_t)HALF * K * 2;
    const size_t tstep = 2 * hstep;
    const unsigned ldsw = (unsigned)wid * 1024u;
    const int aoff = lds_byte(wr * 64 + fr, fq * 8), boff = lds_byte(wc * 32 + fr, fq * 8);
#define PG8_SA(b, h) (((b) * 2 + (h)) * HTB)
#define PG8_SB(b, h) ((4 + (b) * 2 + (h)) * HTB)
#define PG8_STAGE(bufoff, gbase, voff) do { _Pragma("unroll") for (int _i = 0; _i < 2; ++_i) \
        __builtin_amdgcn_global_load_lds((const unsigned*)((const char*)(gbase) + (voff)[_i]), (PG8_LAS unsigned*)(lds + (bufoff) + ldsw + _i * 8192), 16, 0, 0); } while (0)
#define PG8_LDA(dst, b, h) do { _Pragma("unroll") for (int m = 0; m < 4; ++m) _Pragma("unroll") for (int k = 0; k < 2; ++k) dst[m][k] = *(const PG8_LAS bf16x8*)(lds + PG8_SA(b, h) + aoff + m * 2048 + k * 1024); } while (0)
#define PG8_LDB(dst, b, h) do { _Pragma("unroll") for (int n = 0; n < 2; ++n) _Pragma("unroll") for (int k = 0; k < 2; ++k) dst[n][k] = *(const PG8_LAS bf16x8*)(lds + PG8_SB(b, h) + boff + n * 2048 + k * 1024); } while (0)
#define PG8_MMA(ai, bj, At, Bt) do { __builtin_amdgcn_s_setprio(1); _Pragma("unroll") for (int m = 0; m < 4; ++m) _Pragma("unroll") for (int n = 0; n < 2; ++n) _Pragma("unroll") for (int k = 0; k < 2; ++k) \
        acc[ai][bj][m][n] = __builtin_amdgcn_mfma_f32_16x16x32_bf16(Bt[n][k], At[m][k], acc[ai][bj][m][n], 0, 0, 0); __builtin_amdgcn_s_setprio(0); } while (0)
#define PG8_WAIT_V(n) asm volatile("s_waitcnt vmcnt(" #n ")" ::: "memory")
#define PG8_WAIT_L(n) asm volatile("s_waitcnt lgkmcnt(" #n ")" ::: "memory")
#define PG8_BAR __builtin_amdgcn_s_barrier()
#define PG8_SCHED __builtin_amdgcn_sched_barrier(0)
    Unit cur, nxt; int ui = 0;
    if (!S.next(0, cur)) return;
    f32x4 acc[2][2][4][2];
#pragma unroll
    for (int a = 0; a < 2; ++a)
#pragma unroll
        for (int b = 0; b < 2; ++b)
#pragma unroll
            for (int m = 0; m < 4; ++m)
#pragma unroll
                for (int n = 0; n < 2; ++n) acc[a][b][m][n] = (f32x4){0.f, 0.f, 0.f, 0.f};
    bf16x8 At[4][2], B0[2][2], B1[2][2];
    const char* cA = (const char*)g.A + (size_t)cur.pm * tstep; const char* cB = (const char*)g.Bt + (size_t)cur.pn * tstep;
    S.a_ready(cur);
    if constexpr (SP2) {
        PG8_STAGE(PG8_SB(0, 0), cB, voffB); PG8_STAGE(PG8_SB(0, 1), cB + hstep, voffB); PG8_STAGE(PG8_SA(0, 0), cA, voffA); PG8_STAGE(PG8_SA(0, 1), cA + hstep, voffA);
        if (wr == 1) PG8_BAR;
        PG8_WAIT_V(2); PG8_BAR;
        PG8_STAGE(PG8_SB(1, 0), cB + kstep, voffB); PG8_STAGE(PG8_SA(1, 0), cA + kstep, voffA); PG8_STAGE(PG8_SB(1, 1), cB + hstep + kstep, voffB);
        PG8_WAIT_V(6); PG8_BAR;
    } else {
        PG8_STAGE(PG8_SB(0, 0), cB, voffB); PG8_STAGE(PG8_SA(0, 0), cA, voffA); PG8_STAGE(PG8_SB(0, 1), cB + hstep, voffB); PG8_STAGE(PG8_SA(0, 1), cA + hstep, voffA);
        if (wr == 1) PG8_BAR;
        PG8_WAIT_V(4); PG8_BAR;
        PG8_STAGE(PG8_SB(1, 0), cB + kstep, voffB); PG8_STAGE(PG8_SA(1, 0), cA + kstep, voffA); PG8_STAGE(PG8_SB(1, 1), cB + hstep + kstep, voffB);
        PG8_WAIT_V(6); PG8_BAR;
    }
    for (;;) {
        const bool has_next = S.next(ui + 1, nxt);
        const char* nA = has_next ? (const char*)g.A + (size_t)nxt.pm * tstep : cA; const char* nB = has_next ? (const char*)g.Bt + (size_t)nxt.pn * tstep : cB;
        for (int t = 0; t < nt; t += 2) {
            const bool last = (t == nt - 2);
            const char* a1 = cA + (size_t)(t + 1) * kstep;
            const char* a2 = last ? nA : cA + (size_t)(t + 2) * kstep; const char* b2 = last ? nB : cB + (size_t)(t + 2) * kstep;
            const char* a3 = a2 + kstep; const char* b3 = b2 + kstep;
            if (last && has_next) S.a_ready(nxt);
            if constexpr (SP2) {
            PG8_LDB(B0, 0, 0); PG8_LDB(B1, 0, 1); PG8_SCHED; PG8_LDA(At, 0, 0); PG8_STAGE(PG8_SA(1, 1), a1 + hstep, voffA);
            PG8_WAIT_V(8); PG8_WAIT_L(0); PG8_BAR; PG8_MMA(0, 0, At, B0); PG8_MMA(0, 1, At, B1); PG8_BAR; PG8_SCHED;
            PG8_LDA(At, 0, 1); PG8_STAGE(PG8_SB(0, 0), b2, voffB); PG8_STAGE(PG8_SB(0, 1), b2 + hstep, voffB); PG8_STAGE(PG8_SA(0, 0), a2, voffA);
            PG8_WAIT_V(8); PG8_WAIT_L(0); PG8_BAR; PG8_MMA(1, 0, At, B0); PG8_MMA(1, 1, At, B1); PG8_BAR; PG8_SCHED;
            PG8_LDB(B0, 1, 0); PG8_LDB(B1, 1, 1); PG8_SCHED; PG8_LDA(At, 1, 0); PG8_STAGE(PG8_SA(0, 1), a2 + hstep, voffA);
            PG8_WAIT_V(8); PG8_WAIT_L(0); PG8_BAR; PG8_MMA(0, 0, At, B0); PG8_MMA(0, 1, At, B1); PG8_BAR; PG8_SCHED;
            PG8_LDA(At, 1, 1); PG8_STAGE(PG8_SB(1, 0), b3, voffB); PG8_STAGE(PG8_SB(1, 1), b3 + hstep, voffB); PG8_STAGE(PG8_SA(1, 0), a3, voffA);
            PG8_WAIT_V(8); PG8_WAIT_L(0); PG8_BAR; PG8_MMA(1, 0, At, B0); PG8_MMA(1, 1, At, B1); PG8_BAR; PG8_SCHED;
            } else {
            PG8_LDB(B0, 0, 0); PG8_SCHED; PG8_LDA(At, 0, 0); PG8_STAGE(PG8_SA(1, 1), a1 + hstep, voffA);
            PG8_WAIT_L(8); PG8_BAR; PG8_WAIT_L(0); PG8_MMA(0, 0, At, B0); PG8_BAR; PG8_SCHED;
            PG8_LDB(B1, 0, 1); PG8_STAGE(PG8_SB(0, 0), b2, voffB);
            PG8_BAR; PG8_WAIT_L(0); PG8_MMA(0, 1, At, B1); PG8_BAR;
            PG8_LDA(At, 0, 1); PG8_STAGE(PG8_SA(0, 0), a2, voffA);
            PG8_BAR; PG8_WAIT_L(0); PG8_MMA(1, 0, At, B0); PG8_BAR; PG8_SCHED;
            PG8_STAGE(PG8_SB(0, 1), b2 + hstep, voffB);
            PG8_WAIT_V(6); PG8_BAR; PG8_MMA(1, 1, At, B1); PG8_BAR;
            PG8_LDB(B0, 1, 0); PG8_SCHED; PG8_LDA(At, 1, 0); PG8_STAGE(PG8_SA(0, 1), a2 + hstep, voffA);
            PG8_WAIT_L(8); PG8_BAR; PG8_WAIT_L(0); PG8_MMA(0, 0, At, B0); PG8_BAR; PG8_SCHED;
            PG8_LDB(B1, 1, 1); PG8_STAGE(PG8_SB(1, 0), b3, voffB);
            PG8_BAR; PG8_WAIT_L(0); PG8_MMA(0, 1, At, B1); PG8_BAR;
            PG8_LDA(At, 1, 1); PG8_STAGE(PG8_SA(1, 0), a3, voffA);
            PG8_BAR; PG8_WAIT_L(0); PG8_MMA(1, 0, At, B0); PG8_BAR; PG8_SCHED;
            PG8_STAGE(PG8_SB(1, 1), b3 + hstep, voffB);
            PG8_WAIT_V(6); PG8_BAR; PG8_MMA(1, 1, At, B1); PG8_BAR;
            }
        }
        if constexpr (ALIGN_EPI) { if (wr == 0) PG8_BAR; }
        if constexpr (!Epi::AFTER_DRAIN) { E(acc, cur, wr, wc, fr, fq); S.done(cur); }
        if (!has_next) break;
#pragma unroll
        for (int a = 0; a < 2; ++a)
#pragma unroll
            for (int b = 0; b < 2; ++b)
#pragma unroll
                for (int m = 0; m < 4; ++m)
#pragma unroll
                    for (int n = 0; n < 2; ++n) acc[a][b][m][n] = (f32x4){0.f, 0.f, 0.f, 0.f};
        cur = nxt; cA = nA; cB = nB; ++ui;
        if constexpr (ALIGN_EPI) { if (wr == 1) PG8_BAR; }
    }
    PG8_WAIT_V(0);
    if constexpr (!ALIGN_EPI) { if (wr == 0) PG8_BAR; }
    PG8_BAR;
    if constexpr (Epi::AFTER_DRAIN) { E.fused(acc, cur, wr, wc, fr, fq, lds, wid, lane); S.done(cur); }
#undef PG8_SA
#undef PG8_SB
#undef PG8_STAGE
#undef PG8_LDA
#undef PG8_LDB
#undef PG8_MMA
#undef PG8_WAIT_V
#undef PG8_WAIT_L
#undef PG8_BAR
#undef PG8_SCHED
}
}
constexpr int NWAVES = 8;
#ifndef MK_N_LAUNCHES
#define MK_N_LAUNCHES 1
#endif
constexpr int N_PHASES = 5;
constexpr int BATCH = 8, T = 2048, D = 1024, M = BATCH * T;
constexpr int NP = 4352;
constexpr int C_R = 0, C_K = 512, C_V = 1024, C_ZW = 1536, C_ZA = 1600, C_GA = 1792, C_DQ = 2304, C_DK = 2816, C_DV = 3328, C_GB = 3840;
constexpr int RH = 8, RN = 64;
constexpr int AH = 4;
constexpr float C2 = 0.125f * 1.4426950408889634f;
constexpr float LOG2E = 1.4426950408889634f;
constexpr float LAMBDA_INIT = 0.2f;

constexpr size_t MiB = 1u << 20;
constexpr size_t WS_CTL = 0, CTL_ZERO_BYTES = 1 * MiB;
constexpr size_t WS_WIN = 2 * MiB;
constexpr size_t WS_WOUT = 11 * MiB;
constexpr size_t WS_WD = 13 * MiB, WS_WA = 13 * MiB + 65536;
constexpr size_t WS_RHO = 13 * MiB + 2 * 65536;
constexpr size_t WS_XN = 14 * MiB;
constexpr size_t WS_PROJ = 46 * MiB;
constexpr size_t WS_MIX = 182 * MiB;
constexpr size_t WS_END = 214 * MiB;
constexpr int CW_BAR = 4096;

constexpr int RING_OFF = 0, RING_BYTES = 131072;
constexpr int LDSCTL_OFF = RING_BYTES, MISC_OFF = LDSCTL_OFF + 320;
constexpr int LDS_BYTES = 147456;

#define GAS __attribute__((address_space(1)))
#define LAS __attribute__((address_space(3)))
typedef unsigned short bf16;
typedef unsigned v4u __attribute__((ext_vector_type(4)));
typedef unsigned v2u __attribute__((ext_vector_type(2)));
typedef float f32x4 __attribute__((ext_vector_type(4)));
typedef float f32x16 __attribute__((ext_vector_type(16)));
typedef short bf16x8 __attribute__((ext_vector_type(8)));
typedef short s16x4 __attribute__((ext_vector_type(4)));
typedef GAS unsigned gu32;
typedef GAS unsigned long long gu64;
#define RLX_AGENT __ATOMIC_RELAXED, __HIP_MEMORY_SCOPE_AGENT
#define LDS_WAIT() asm volatile("s_waitcnt lgkmcnt(0)" ::: "memory")
#define VM_WAIT() asm volatile("s_waitcnt vmcnt(0)" ::: "memory")
__device__ __forceinline__ unsigned f2bf(float f) { unsigned u = __builtin_bit_cast(unsigned, f); return (u + 0x7fffu + ((u >> 16) & 1u)) >> 16; }
__device__ __forceinline__ unsigned pk2(float lo, float hi) { return f2bf(lo) | (f2bf(hi) << 16); }
__device__ __forceinline__ float bflo(unsigned u) { return __uint_as_float(u << 16); }
__device__ __forceinline__ float bfhi(unsigned u) { return __uint_as_float(u & 0xffff0000u); }
__device__ __forceinline__ float bf1(unsigned short u) { return __uint_as_float((unsigned)u << 16); }
#define XB_TMO      128
#define XB_XCNT(j)  (256  + 64 * (j))
#define XB_XSUB(j)  (1280 + 64 * (j))
#define XB_XGEN(j)  (2304 + 64 * (j))
#define XB_TOP      3328
#define XB_TOPGEN   3392
#define XCD_BAR_WORDS 3456
#define XB_SPIN_CAP (1u << 18)

__device__ __forceinline__ unsigned xb_ld(unsigned* p)              { return __hip_atomic_load(p, __ATOMIC_RELAXED, __HIP_MEMORY_SCOPE_AGENT); }
__device__ __forceinline__ unsigned xb_add(unsigned* p, unsigned v) { return __hip_atomic_fetch_add(p, v, __ATOMIC_RELAXED, __HIP_MEMORY_SCOPE_AGENT); }
__device__ __forceinline__ unsigned xb_xcc_id() { return (unsigned)__builtin_amdgcn_s_getreg((3 << 11) | 20) & 0xFu; }
#define XB_SPIN(cond, bar) do { unsigned _sp = 0; while (cond) { __builtin_amdgcn_s_sleep(1); \
    if ((++_sp & 255u) == 0u) { if (xb_ld(&(bar)[XB_TMO])) break; if (_sp > XB_SPIN_CAP) { atomicAdd(&(bar)[XB_TMO], 1u); break; } } } } while (0)

struct XcdBarrier {
    unsigned* bar; unsigned x;
    volatile LAS unsigned* st;
};

__device__ __forceinline__ XcdBarrier xcd_barrier_post(unsigned* bar, volatile LAS unsigned* st) {
    XcdBarrier b; b.bar = bar; b.x = xb_xcc_id(); b.st = st;
    if (threadIdx.x == 0) (void)xb_add(&bar[XB_XCNT(b.x)], 1u);
    return b;
}
__device__ __forceinline__ void xcd_barrier_complete(unsigned* bar, unsigned x, unsigned& nloc, unsigned& nx) {
    const unsigned G = gridDim.x * gridDim.y * gridDim.z;
    unsigned sum, cnt, mine, sp = 0u;
    for (;;) {
        sum = 0u; cnt = 0u; mine = 0u;
#pragma unroll
        for (unsigned j = 0; j < 16; ++j) { const unsigned c = xb_ld(&bar[XB_XCNT(j)]); sum += c; cnt += (c > 0u) ? 1u : 0u; mine = (j == x) ? c : mine; }
        if (sum == G) break;
        __builtin_amdgcn_s_sleep(1);
        if ((++sp & 255u) == 0u) { if (xb_ld(&bar[XB_TMO])) break; if (sp > XB_SPIN_CAP) { atomicAdd(&bar[XB_TMO], 1u); break; } }
    }
    nloc = mine > 0u ? mine : 1u; nx = cnt > 0u ? cnt : 1u;
}

__device__ __forceinline__ void xcd_barrier(const XcdBarrier& b) {
    asm volatile("s_waitcnt vmcnt(0)" ::: "memory");
    __syncthreads();
    if (threadIdx.x == 0) {
        unsigned* bar = b.bar;
        __builtin_amdgcn_s_waitcnt(0);
        unsigned nloc = b.st[0], nx = b.st[1];
        if (nloc == 0u) { xcd_barrier_complete(bar, b.x, nloc, nx); b.st[0] = nloc; b.st[1] = nx; }
        const unsigned old = xb_add(&bar[XB_XSUB(b.x)], 1u);
        const unsigned gen = old / nloc;
        if (old + 1u == (gen + 1u) * nloc) {
            __builtin_amdgcn_fence(__ATOMIC_RELEASE, "agent");
            asm volatile("s_waitcnt vmcnt(0)" ::: "memory");
            const unsigned og = xb_add(&bar[XB_TOP], 1u);
            const unsigned tg = og / nx;
            if (og + 1u == (tg + 1u) * nx) xb_add(&bar[XB_TOPGEN], 1u);
            else XB_SPIN(xb_ld(&bar[XB_TOPGEN]) == tg, bar);
            __builtin_amdgcn_fence(__ATOMIC_ACQUIRE, "agent");
            xb_add(&bar[XB_XGEN(b.x)], 1u);
            asm volatile("s_waitcnt vmcnt(0)" ::: "memory");
        } else {
            XB_SPIN(xb_ld(&bar[XB_XGEN(b.x)]) == gen, bar);
            __builtin_amdgcn_fence(__ATOMIC_ACQUIRE, "agent");
            asm volatile("s_waitcnt vmcnt(0)" ::: "memory");
        }
    }
    __syncthreads();
}
struct Frame {
    LAS unsigned char* lds;
    volatile LAS unsigned* MISC;
    gu32* ctl;
    int tid, lane, wave;
    int vcu, G;
    const float* x; float* out;
    const float *norm_g, *w_in, *shift_mu, *w0, *w_decay_up, *a0, *w_iclr_up, *k_k, *k_a, *r_k, *ln_w, *ln_b, *qn_g, *kn_g, *lq1, *lk1, *lq2, *lk2, *subln_g, *w_out;
    bf16 *WinT, *WoutT, *WdT, *WaT, *XN, *PROJ, *MIX;
};

__device__ __forceinline__ float wave_sum(float v) {
#pragma unroll
    for (int o = 1; o < 64; o <<= 1) v += __shfl_xor(v, o);
    return v;
}
template <int CTRL> __device__ __forceinline__ float dpp_f(float x) { return __builtin_bit_cast(float, __builtin_amdgcn_mov_dpp(__builtin_bit_cast(int, x), CTRL, 0xf, 0xf, true)); }
__device__ __forceinline__ float row16_sum(float x) {
    x += dpp_f<0xB1>(x); x += dpp_f<0x4E>(x); x += dpp_f<0x141>(x); x += dpp_f<0x140>(x); return x;
}
__device__ __forceinline__ float swap32_sum(float x) {
    auto rr = __builtin_amdgcn_permlane32_swap(__float_as_uint(x), __float_as_uint(x), false, false);
    return __uint_as_float(rr[0]) + __uint_as_float(rr[1]);
}

__device__ __forceinline__ void p0_transpose_item(const float* W, int N, int nsrc, const float* kscale, bf16* WT, int K, int ndst, LAS float* scr, int k0, int lane) {
#pragma unroll 8
    for (int i = 0; i < 32; ++i) { const int kk = 2 * i + (lane >> 5);
        float v = 0.f; if (nsrc >= 0) { v = W[(size_t)(k0 + kk) * N + nsrc + (lane & 31)]; if (kscale) v *= kscale[k0 + kk]; }
        scr[kk * 33 + (lane & 31)] = v; }
    LDS_WAIT(); asm volatile("" ::: "memory");
    const int c = lane & 7;
#pragma unroll
    for (int j = 0; j < 4; ++j) { const int n = (lane >> 3) + 8 * j; const LAS float* s = scr + (8 * c) * 33 + n;
        v4u o; o.x = pk2(s[0 * 33], s[1 * 33]); o.y = pk2(s[2 * 33], s[3 * 33]); o.z = pk2(s[4 * 33], s[5 * 33]); o.w = pk2(s[6 * 33], s[7 * 33]);
        *(GAS v4u*)(WT + (size_t)(ndst + n) * K + k0 + 8 * c) = o; }
    LDS_WAIT(); asm volatile("" ::: "memory");
}
__device__ __forceinline__ void p0_prologue(Frame& F) {
    LAS float* scr = (LAS float*)(F.lds + RING_OFF + F.wave * 16384);
    const int gw = F.vcu * NWAVES + F.wave, NGW = F.G * NWAVES;
    constexpr int I_IN = (D / 64) * (NP / 32), I_OUT = (D / 64) * (D / 32), I_L = 512 / 32;
    constexpr int NITEMS = I_IN + I_OUT + 2 * I_L;
    for (int it = gw; it < NITEMS; it += NGW) {
        int r = it;
        if (r < I_IN) { const int kb = r / (NP / 32), nb = r % (NP / 32), nd = 32 * nb; const int ns = nd < 1664 ? nd : (nd < 1792 ? -1 : nd - 128);
            p0_transpose_item(F.w_in, 4224, ns, F.norm_g, F.WinT, D, nd, scr, 64 * kb, F.lane); continue; } r -= I_IN;
        if (r < I_OUT) { const int kb = r / (D / 32), nb = r % (D / 32);
            p0_transpose_item(F.w_out, D, 32 * nb, nullptr, F.WoutT, D, 32 * nb, scr, 64 * kb, F.lane); continue; } r -= I_OUT;
        if (r < I_L) { p0_transpose_item(F.w_decay_up, 512, 32 * r, nullptr, F.WdT, 64, 32 * r, scr, 0, F.lane); continue; } r -= I_L;
        p0_transpose_item(F.w_iclr_up, 512, 32 * r, nullptr, F.WaT, 64, 32 * r, scr, 0, F.lane);
    }
    for (int m = gw; m < M; m += NGW) {
        const GAS f32x4* xr = (const GAS f32x4*)(F.x + (size_t)m * D) + F.lane;
        f32x4 v[4]; float s = 0.f;
#pragma unroll
        for (int j = 0; j < 4; ++j) { v[j] = xr[64 * j]; s += (v[j].x * v[j].x + v[j].y * v[j].y) + (v[j].z * v[j].z + v[j].w * v[j].w); }
        const float rstd = 1.f / sqrtf(wave_sum(s) * (1.f / D) + 1e-6f);
        GAS unsigned long long* o8 = (GAS unsigned long long*)(F.XN + (size_t)m * D) + F.lane;
#pragma unroll
        for (int j = 0; j < 4; ++j) o8[64 * j] = (unsigned long long)pk2(v[j].x * rstd, v[j].y * rstd) | ((unsigned long long)pk2(v[j].z * rstd, v[j].w * rstd) << 32);
    }
}

__device__ __forceinline__ float tanh_f(float x) { const float e = __expf(-2.f * fabsf(x)); const float t = (1.f - e) * __builtin_amdgcn_rcpf(1.f + e); return x < 0.f ? -t : t; }
__device__ __forceinline__ void shifted8(const bf16* proj, size_t m, bool has_prev, int col, const float* mu, float (&o)[8]) {
    const v4u c = *(const GAS v4u*)(proj + m * NP + col);
    v4u p = (v4u){0u, 0u, 0u, 0u}; if (has_prev) p = *(const GAS v4u*)(proj + (m - 1) * NP + col);
    const f32x4 m0 = *(const GAS f32x4*)(mu), m1 = *(const GAS f32x4*)(mu + 4);
    const unsigned cw[4] = {c.x, c.y, c.z, c.w}, pw[4] = {p.x, p.y, p.z, p.w}; const float mm[8] = {m0.x, m0.y, m0.z, m0.w, m1.x, m1.y, m1.z, m1.w};
#pragma unroll
    for (int j = 0; j < 4; ++j) { const float c0 = bflo(cw[j]), c1 = bfhi(cw[j]), p0 = bflo(pw[j]), p1 = bfhi(pw[j]);
        o[2 * j] = c0 + (p0 - c0) * mm[2 * j]; o[2 * j + 1] = c1 + (p1 - c1) * mm[2 * j + 1]; }
}
__device__ __forceinline__ void shifted4(const bf16* proj, size_t m, bool has_prev, int col, const float* mu, float (&o)[4]) {
    const v2u c = *(const GAS v2u*)(proj + m * NP + col);
    v2u p = (v2u){0u, 0u}; if (has_prev) p = *(const GAS v2u*)(proj + (m - 1) * NP + col);
    const f32x4 m0 = *(const GAS f32x4*)(mu);
    o[0] = bflo(c.x) + (bflo(p.x) - bflo(c.x)) * m0.x; o[1] = bfhi(c.x) + (bfhi(p.x) - bfhi(c.x)) * m0.y;
    o[2] = bflo(c.y) + (bflo(p.y) - bflo(c.y)) * m0.z; o[3] = bfhi(c.y) + (bfhi(p.y) - bfhi(c.y)) * m0.w;
}
__device__ __forceinline__ void p2_qknorm(Frame& F) {
    const int gw = F.vcu * NWAVES + F.wave, NGW = F.G * NWAVES, lane = F.lane, sub = lane & 7;
    for (int it = gw; it < 2 * M; it += NGW) {
        const size_t m = (size_t)(it >> 1); const int isk = it & 1;
        bf16* p = F.PROJ + m * NP + (isk ? C_DK : C_DQ) + (lane >> 3) * 64 + sub * 8;
        const v4u c = *(const GAS v4u*)p; const unsigned cw[4] = {c.x, c.y, c.z, c.w};
        float xv[8]; float ss = 0.f;
#pragma unroll
        for (int j = 0; j < 4; ++j) { xv[2 * j] = bflo(cw[j]); xv[2 * j + 1] = bfhi(cw[j]); ss += xv[2 * j] * xv[2 * j] + xv[2 * j + 1] * xv[2 * j + 1]; }
        ss += __shfl_xor(ss, 1); ss += __shfl_xor(ss, 2); ss += __shfl_xor(ss, 4);
        const float r = (1.f / sqrtf(ss * (1.f / 64.f) + 1e-6f)) * (isk ? 1.f : C2);
        const float* g = (isk ? F.kn_g : F.qn_g) + sub * 8;
        const f32x4 g0 = *(const GAS f32x4*)g, g1 = *(const GAS f32x4*)(g + 4);
        v4u o; o.x = pk2(xv[0] * r * g0.x, xv[1] * r * g0.y); o.y = pk2(xv[2] * r * g0.z, xv[3] * r * g0.w); o.z = pk2(xv[4] * r * g1.x, xv[5] * r * g1.y); o.w = pk2(xv[6] * r * g1.z, xv[7] * r * g1.w);
        *(GAS v4u*)p = o;
    }
}

typedef float f32x2_t __attribute__((ext_vector_type(2))); typedef __bf16 bf16x2_t __attribute__((ext_vector_type(2)));
__device__ __forceinline__ unsigned cvtpk(float lo, float hi) { f32x2_t v = {lo, hi}; bf16x2_t b = __builtin_convertvector(v, bf16x2_t); return __builtin_bit_cast(unsigned, b); }
#define MFMA32(a, b, c) __builtin_amdgcn_mfma_f32_32x32x16_bf16(__builtin_bit_cast(bf16x8, (a)), __builtin_bit_cast(bf16x8, (b)), (c), 0, 0, 0)
#define FRAGACC(z, s) ((v4u){cvtpk((z)[8 * (s)], (z)[8 * (s) + 1]), cvtpk((z)[8 * (s) + 2], (z)[8 * (s) + 3]), cvtpk((z)[8 * (s) + 4], (z)[8 * (s) + 5]), cvtpk((z)[8 * (s) + 6], (z)[8 * (s) + 7])})
template <int CTRL, int RM> __device__ __forceinline__ float dpp_upd0(float x) { return __builtin_bit_cast(float, __builtin_amdgcn_update_dpp(0, __builtin_bit_cast(int, x), CTRL, RM, 0xf, false)); }
__device__ __forceinline__ float scan32(float x) {
    x += dpp_upd0<0x111, 0xf>(x); x += dpp_upd0<0x112, 0xf>(x); x += dpp_upd0<0x114, 0xf>(x); x += dpp_upd0<0x118, 0xf>(x); x += dpp_upd0<0x142, 0xa>(x); return x;
}
constexpr int RW_UNITS = BATCH * RH * (T / 32);
struct RwDump { v4u* PF; v4u* DD; v4u* QF; v4u* YD; float* GAM; float* RHO; };

__device__ __forceinline__ void rwkvA_unit(Frame& F, const RwDump& Dm, int bh, int ci, LAS float* wscr, LAS unsigned char* park) {
    int lane = F.lane; asm volatile("" : "+v"(lane));
    const int hi = lane >> 5, l31 = lane & 31, b = bh >> 3, w = bh & 7;
    LAS v4u* pk = (LAS v4u*)park + lane;
#define PARK(slot) pk[(slot) * 64]
    int tok = 0; asm volatile("" : "+v"(tok));
#define DEP(x) asm volatile("" : "+v"(tok) : "v"(x))
    const int t = ci * 32 + l31; const size_t m = (size_t)b * T + t; const bool hp = t > 0;
    const int u = bh * (T / 32) + ci;
    const float pm = hp ? 1.f : 0.f;
    const bf16* pc = F.PROJ + m * NP + w * 64 + 4 * hi; const bf16* pp = F.PROJ + (hp ? m - 1 : m) * NP + w * 64 + 4 * hi;
    const float* mu = F.shift_mu + w * 64 + 4 * hi;
    const float *pw0 = F.w0 + w * 64 + 4 * hi, *pa0 = F.a0 + w * 64 + 4 * hi, *pkk = F.k_k + w * 64 + 4 * hi, *pka = F.k_a + w * 64 + 4 * hi, *prk = F.r_k + w * 64 + 4 * hi;
#define SH4(dst, COL, MU, OFF) do { const v2u c_ = *(const GAS v2u*)(pc + tok + (COL) + (OFF)), p_ = *(const GAS v2u*)(pp + tok + (COL) + (OFF)); const f32x4 m_ = *(const GAS f32x4*)(mu + tok + (MU) + (OFF)); \
        dst[0] = bflo(c_.x) + (bflo(p_.x) * pm - bflo(c_.x)) * m_.x; dst[1] = bfhi(c_.x) + (bfhi(p_.x) * pm - bfhi(c_.x)) * m_.y; \
        dst[2] = bflo(c_.y) + (bflo(p_.y) * pm - bflo(c_.y)) * m_.z; dst[3] = bfhi(c_.y) + (bfhi(p_.y) * pm - bfhi(c_.y)) * m_.w; } while (0)
    float ss = 0.f;
#pragma unroll
    for (int gq = 0; gq < 8; ++gq) { float k4[4]; SH4(k4, C_K, 512, 8 * gq); const f32x4 kkp = *(const GAS f32x4*)(pkk + tok + 8 * gq);
#pragma unroll
        for (int e = 0; e < 4; ++e) { const float q = k4[e] * kkp[e]; ss += q * q; }
        if (gq & 1) DEP(ss); }
    ss = swap32_sum(ss);
    const float inv = __builtin_amdgcn_rcpf(fmaxf(__builtin_amdgcn_sqrtf(ss), 1e-12f));
    asm volatile("" ::: "memory");
    v4u bz[4], ba[4];
    { const bf16* zc = F.PROJ + m * NP + 8 * hi; const bf16* zp = F.PROJ + (hp ? m - 1 : m) * NP + 8 * hi; const float* zmu = F.shift_mu + 8 * hi;
#pragma unroll
      for (int s = 0; s < 4; ++s) {
#pragma unroll
        for (int which = 0; which < 2; ++which) {
            const int COL = (which ? C_ZA : C_ZW) + 16 * s, MUO = (which ? 1600 : 1536) + 16 * s;
            const v4u c = *(const GAS v4u*)(zc + tok + COL), p = *(const GAS v4u*)(zp + tok + COL); const f32x4 m0 = *(const GAS f32x4*)(zmu + tok + MUO), m1 = *(const GAS f32x4*)(zmu + tok + MUO + 4);
            float z[8];
#pragma unroll
            for (int j = 0; j < 4; ++j) { const float c0 = bflo(c[j]), c1 = bfhi(c[j]); const float mm0 = j < 2 ? m0[2 * j] : m1[2 * j - 4], mm1 = j < 2 ? m0[2 * j + 1] : m1[2 * j - 3];
                z[2 * j] = c0 + (bflo(p[j]) * pm - c0) * mm0; z[2 * j + 1] = c1 + (bfhi(p[j]) * pm - c1) * mm1; }
            if (which == 0) bz[s] = (v4u){cvtpk(tanh_f(z[0]), tanh_f(z[1])), cvtpk(tanh_f(z[2]), tanh_f(z[3])), cvtpk(tanh_f(z[4]), tanh_f(z[5])), cvtpk(tanh_f(z[6]), tanh_f(z[7]))};
            else ba[s] = (v4u){cvtpk(z[0], z[1]), cvtpk(z[2], z[3]), cvtpk(z[4], z[5]), cvtpk(z[6], z[7])};
            if (which == 0) DEP(bz[s][3]); else DEP(ba[s][3]);
        }
      } }
    asm volatile("" ::: "memory");
    v4u fa[4], fb[4], fk[4], fr[4], fv[4]; float rho = 0.f;
    float* gp = Dm.GAM + (size_t)u * 64 + hi * 32;
#define RW_LORA(cb) f32x16 accd = f32x16{}, acca = f32x16{}; _Pragma("unroll") for (int s = 0; s < 4; ++s) { \
        const v4u aD = *(const GAS v4u*)(F.WdT + tok + (size_t)(w * 64 + (cb) * 32 + l31) * 64 + 16 * s + 8 * hi); accd = MFMA32(aD, bz[s], accd); \
        const v4u aA = *(const GAS v4u*)(F.WaT + tok + (size_t)(w * 64 + (cb) * 32 + l31) * 64 + 16 * s + 8 * hi); acca = MFMA32(aA, ba[s], acca); }
#define RW_GROUP(cb, rg) do { constexpr int OFF = 32 * (cb) + 8 * (rg); const int ch0 = OFF + 4 * hi; \
            float rr[4], kk4[4], vv[4]; \
            SH4(rr, C_R, 0, OFF); SH4(kk4, C_K, 512, OFF); SH4(vv, C_V, 1024, OFF); \
            const f32x4 w0v = *(const GAS f32x4*)(pw0 + tok + OFF), a0v = *(const GAS f32x4*)(pa0 + tok + OFF), kkp = *(const GAS f32x4*)(pkk + tok + OFF), kap = *(const GAS f32x4*)(pka + tok + OFF), rkp = *(const GAS f32x4*)(prk + tok + OFF); \
            float xa[4], xb[4], xk[4], xr[4], gg[4], ge[4]; \
            _Pragma("unroll") for (int e = 0; e < 4; ++e) { \
                const float nx = -(w0v[e] + accd[4 * (rg) + e]); const float sp = fmaxf(nx, 0.f) + __logf(1.f + __expf(-fabsf(nx))); \
                const float l2 = -__expf(-sp - 0.5f) * LOG2E; \
                const float g = scan32(l2); \
                const float a = __builtin_amdgcn_rcpf(1.f + __expf(-(a0v[e] + acca[4 * (rg) + e]))); \
                const float kk = kk4[e] * kkp[e] * inv; \
                const float kt = kk4[e] * (1.f + (a - 1.f) * kap[e]); \
                rho += rr[e] * kt * rkp[e]; \
                const float eg = __builtin_amdgcn_exp2f(g), egp = __builtin_amdgcn_exp2f(g - l2), eng = __builtin_amdgcn_rcpf(eg); \
                xa[e] = -kk * egp; xb[e] = kk * a * eng; xk[e] = kt * eng; xr[e] = rr[e] * eg; gg[e] = g; ge[e] = eg; } \
            if (l31 == 31) { *(LAS f32x4*)(wscr + ch0) = (f32x4){gg[0], gg[1], gg[2], gg[3]}; *(GAS f32x4*)(gp + (cb) * 16 + 4 * (rg)) = (f32x4){ge[0], ge[1], ge[2], ge[3]}; } \
            constexpr int s_ = 2 * (cb) + ((rg) >> 1), vg = 2 * ((rg) & 1); \
            fa[s_][vg] = cvtpk(xa[0], xa[1]); fa[s_][vg + 1] = cvtpk(xa[2], xa[3]); \
            fb[s_][vg] = cvtpk(xb[0], xb[1]); fb[s_][vg + 1] = cvtpk(xb[2], xb[3]); \
            fk[s_][vg] = cvtpk(xk[0], xk[1]); fk[s_][vg + 1] = cvtpk(xk[2], xk[3]); \
            fr[s_][vg] = cvtpk(xr[0], xr[1]); fr[s_][vg + 1] = cvtpk(xr[2], xr[3]); \
            fv[s_][vg] = cvtpk(vv[0], vv[1]); fv[s_][vg + 1] = cvtpk(vv[2], vv[3]); \
            if (((rg) & 1) == 1) { PARK(s_) = fv[s_]; PARK(4 + s_) = fr[s_]; } \
            DEP(fa[s_][vg + 1]); DEP(fb[s_][vg + 1]); DEP(fk[s_][vg + 1]); DEP(fr[s_][vg + 1]); DEP(fv[s_][vg + 1]); DEP(rho); } while (0)
    { RW_LORA(0) RW_GROUP(0, 0); RW_GROUP(0, 1); RW_GROUP(0, 2); RW_GROUP(0, 3); }
    { RW_LORA(1) RW_GROUP(1, 0); RW_GROUP(1, 1); RW_GROUP(1, 2); RW_GROUP(1, 3); }
#undef RW_LORA
#undef RW_GROUP
#undef SH4
    LDS_WAIT(); asm volatile("" ::: "memory");
    float EC[2]; EC[0] = __builtin_amdgcn_exp2f(wscr[l31]); EC[1] = __builtin_amdgcn_exp2f(wscr[32 + l31]);
    LDS_WAIT(); asm volatile("" ::: "memory");
    rho = swap32_sum(rho);
    if (hi == 0) Dm.RHO[(size_t)u * 32 + l31] = rho;
    v4u idf[2];
    { const int jst = 4 * ((l31 >> 3) & 1) + (l31 & 3); const bool hm = ((l31 >> 2) & 1) == hi; const unsigned one = 0x3F80u << (16 * (jst & 1));
#pragma unroll
      for (int sig = 0; sig < 2; ++sig) { const bool on = hm && ((l31 >> 4) == sig);
#pragma unroll
          for (int q = 0; q < 4; ++q) idf[sig][q] = (on && (jst >> 1) == q) ? one : 0u; } }
    LDS_WAIT();
    v4u Af[2][2], Vf[2][2];
#pragma unroll
    for (int blk = 0; blk < 2; ++blk) {
        f32x16 za = MFMA32(fa[2 * blk], idf[0], f32x16{}); za = MFMA32(fa[2 * blk + 1], idf[1], za);
        f32x16 zv = MFMA32(PARK(2 * blk), idf[0], f32x16{}); zv = MFMA32(PARK(2 * blk + 1), idf[1], zv);
        f32x16 zb = MFMA32(fb[2 * blk], idf[0], f32x16{}); zb = MFMA32(fb[2 * blk + 1], idf[1], zb);
        f32x16 zk = MFMA32(fk[2 * blk], idf[0], f32x16{}); zk = MFMA32(fk[2 * blk + 1], idf[1], zk);
        zb = zb * EC[blk]; zk = zk * EC[blk];
#pragma unroll
        for (int s = 0; s < 2; ++s) { Af[blk][s] = FRAGACC(za, s); Vf[blk][s] = FRAGACC(zv, s); PARK(8 + 2 * blk + s) = FRAGACC(zb, s); PARK(12 + 2 * blk + s) = FRAGACC(zk, s); }
        __builtin_amdgcn_sched_barrier(0);
    }
    f32x16 Aab = f32x16{}, TT = f32x16{}, AakT = f32x16{}, ArbT = f32x16{}, ArkT = f32x16{};
#pragma unroll
    for (int s = 0; s < 4; ++s) { const v4u frs = PARK(4 + s); Aab = MFMA32(fa[s], fb[s], Aab); TT = MFMA32(fb[s], fa[s], TT); AakT = MFMA32(fk[s], fa[s], AakT); ArbT = MFMA32(fb[s], frs, ArbT); ArkT = MFMA32(fk[s], frs, ArkT); }
#pragma unroll
    for (int r = 0; r < 16; ++r) { const int rowi = (r & 3) + 8 * (r >> 2) + 4 * hi;
        Aab[r] = (l31 < rowi) ? Aab[r] : 0.f; TT[r] = (rowi < l31) ? TT[r] : 0.f; AakT[r] = (rowi < l31) ? AakT[r] : 0.f;
        ArbT[r] = (rowi <= l31) ? ArbT[r] : 0.f; ArkT[r] = (rowi <= l31) ? ArkT[r] : 0.f; }
    v4u AakTf[2], ArbTf[2], ArkTf[2];
#pragma unroll
    for (int s = 0; s < 2; ++s) { AakTf[s] = FRAGACC(AakT, s); ArbTf[s] = FRAGACC(ArbT, s); ArkTf[s] = FRAGACC(ArkT, s); }
    __builtin_amdgcn_sched_barrier(0);
    v4u Xf[2], XTf[2], TTf[2];
#pragma unroll
    for (int s = 0; s < 2; ++s) { Xf[s] = FRAGACC(Aab, s); XTf[s] = FRAGACC(TT, s); }
#pragma unroll
    for (int r = 0; r < 16; ++r) { const int rowi = (r & 3) + 8 * (r >> 2) + 4 * hi; TT[r] += (rowi == l31) ? 1.f : 0.f; }
#pragma unroll
    for (int it = 0; it < 4; ++it) {
        f32x16 X2 = MFMA32(XTf[0], Xf[0], f32x16{}); X2 = MFMA32(XTf[1], Xf[1], X2);
        if (it < 3) { f32x16 X2T = MFMA32(Xf[0], XTf[0], f32x16{}); X2T = MFMA32(Xf[1], XTf[1], X2T);
#pragma unroll
            for (int s = 0; s < 2; ++s) XTf[s] = FRAGACC(X2T, s); }
#pragma unroll
        for (int s = 0; s < 2; ++s) { Xf[s] = FRAGACC(X2, s); TTf[s] = FRAGACC(TT, s); }
        TT = MFMA32(Xf[0], TTf[0], TT); TT = MFMA32(Xf[1], TTf[1], TT);
        __builtin_amdgcn_sched_barrier(0);
    }
#pragma unroll
    for (int s = 0; s < 2; ++s) TTf[s] = FRAGACC(TT, s);
    v4u Wf[2][2], Uf[2][2];
#pragma unroll
    for (int blk = 0; blk < 2; ++blk) {
        f32x16 av = MFMA32(AakTf[0], Vf[blk][0], f32x16{}); av = MFMA32(AakTf[1], Vf[blk][1], av);
        const v4u avf0 = FRAGACC(av, 0), avf1 = FRAGACC(av, 1);
        f32x16 uu = MFMA32(TTf[0], avf0, f32x16{}); uu = MFMA32(TTf[1], avf1, uu);
        f32x16 ww = MFMA32(TTf[0], Af[blk][0], f32x16{}); ww = MFMA32(TTf[1], Af[blk][1], ww);
#pragma unroll
        for (int s = 0; s < 2; ++s) { Wf[blk][s] = FRAGACC(ww, s); Uf[blk][s] = FRAGACC(uu, s); }
        __builtin_amdgcn_sched_barrier(0);
    }
    v4u* QFp = Dm.QF + (size_t)u * 256 + lane; v4u* YDp = Dm.YD + (size_t)u * 256 + lane;
#pragma unroll
    for (int blk = 0; blk < 2; ++blk) {
        f32x16 q;
#pragma unroll
        for (int s = 0; s < 2; ++s)
            { const v4u frs = PARK(4 + 2 * blk + s);
#pragma unroll
              for (int j = 0; j < 4; ++j) { q[8 * s + 2 * j] = bflo(frs[j]); q[8 * s + 2 * j + 1] = bfhi(frs[j]); } }
        q = MFMA32(Wf[blk][0], ArbTf[0], q); q = MFMA32(Wf[blk][1], ArbTf[1], q);
        *(GAS v4u*)(QFp + (2 * blk) * 64) = FRAGACC(q, 0); *(GAS v4u*)(QFp + (2 * blk + 1) * 64) = FRAGACC(q, 1);
        f32x16 y = MFMA32(Uf[blk][0], ArbTf[0], f32x16{}); y = MFMA32(Uf[blk][1], ArbTf[1], y); y = MFMA32(Vf[blk][0], ArkTf[0], y); y = MFMA32(Vf[blk][1], ArkTf[1], y);
        *(GAS v4u*)(YDp + (2 * blk) * 64) = FRAGACC(y, 0); *(GAS v4u*)(YDp + (2 * blk + 1) * 64) = FRAGACC(y, 1);
        __builtin_amdgcn_sched_barrier(0);
    }
    v4u* PFp = Dm.PF + (size_t)u * 512 + lane; v4u* DDp = Dm.DD + (size_t)u * 512 + lane;
#pragma unroll
    for (int c1 = 0; c1 < 2; ++c1)
#pragma unroll
        for (int cb = 0; cb < 2; ++cb) {
            f32x16 p = MFMA32(Wf[c1][0], PARK(8 + 2 * cb), f32x16{}); p = MFMA32(Wf[c1][1], PARK(8 + 2 * cb + 1), p);
            *(GAS v4u*)(PFp + (cb * 4 + 2 * c1) * 64) = FRAGACC(p, 0); *(GAS v4u*)(PFp + (cb * 4 + 2 * c1 + 1) * 64) = FRAGACC(p, 1);
            __builtin_amdgcn_sched_barrier(0);
        }
#pragma unroll
    for (int cb = 0; cb < 2; ++cb)
#pragma unroll
        for (int ib = 0; ib < 2; ++ib) {
            f32x16 d = MFMA32(PARK(8 + 2 * cb), Uf[ib][0], f32x16{}); d = MFMA32(PARK(8 + 2 * cb + 1), Uf[ib][1], d); d = MFMA32(PARK(12 + 2 * cb), Vf[ib][0], d); d = MFMA32(PARK(12 + 2 * cb + 1), Vf[ib][1], d);
            *(GAS v4u*)(DDp + ((cb * 2 + ib) * 2) * 64) = FRAGACC(d, 0); *(GAS v4u*)(DDp + ((cb * 2 + ib) * 2 + 1) * 64) = FRAGACC(d, 1);
            __builtin_amdgcn_sched_barrier(0);
        }
}

#undef PARK
#undef DEP
constexpr int RB_PF = 0, RB_DD = 8192, RB_QF = 16384, RB_YD = 20480, RB_GAM = 24576, RB_BUF = 24832, RB_STAT = 2 * RB_BUF, RB_Y = RB_STAT + 1024;
__device__ __forceinline__ void unpack16(const v4u a, const v4u b, f32x16& o) {
#pragma unroll
    for (int j = 0; j < 4; ++j) { o[2 * j] = bflo(a[j]); o[2 * j + 1] = bfhi(a[j]); o[8 + 2 * j] = bflo(b[j]); o[8 + 2 * j + 1] = bfhi(b[j]); }
}
struct RbStage { v4u p0, p1, d0, d1, q, y, g; };
struct RbEpi { v2u vc[4], vp[4], ga[4]; float rho; };
__device__ __forceinline__ void rwkvB_unit(Frame& F, const RwDump& Dm, int bh) {
    const int tid = F.tid, lane = F.lane, hi = lane >> 5, l31 = lane & 31, wid = F.wave, b = bh >> 3, h = bh & 7;
    LAS unsigned char* lds = F.lds + RING_OFF;
    const size_t u0 = (size_t)bh * (T / 32);
    constexpr int NS = T / 32;
    LAS float* stat = (LAS float*)(lds + RB_STAT);
    LAS float* ybuf = (LAS float*)(lds + RB_Y);
    const int stid = tid - 256;
#define ST_LOAD(X, ci_) do { if ((ci_) < NS) { const size_t u_ = u0 + (ci_); X.p0 = *(const GAS v4u*)(Dm.PF + u_ * 512 + stid); X.p1 = *(const GAS v4u*)(Dm.PF + u_ * 512 + 256 + stid); \
        X.d0 = *(const GAS v4u*)(Dm.DD + u_ * 512 + stid); X.d1 = *(const GAS v4u*)(Dm.DD + u_ * 512 + 256 + stid); X.q = *(const GAS v4u*)(Dm.QF + u_ * 256 + stid); X.y = *(const GAS v4u*)(Dm.YD + u_ * 256 + stid); \
        if (stid < 16) X.g = *(const GAS v4u*)((const v4u*)(Dm.GAM + u_ * 64) + stid); } } while (0)
#define ST_STORE(X, buf_) do { LAS unsigned char* b_ = lds + (buf_) * RB_BUF; *(LAS v4u*)(b_ + RB_PF + stid * 16) = X.p0; *(LAS v4u*)(b_ + RB_PF + 4096 + stid * 16) = X.p1; \
        *(LAS v4u*)(b_ + RB_DD + stid * 16) = X.d0; *(LAS v4u*)(b_ + RB_DD + 4096 + stid * 16) = X.d1; *(LAS v4u*)(b_ + RB_QF + stid * 16) = X.q; *(LAS v4u*)(b_ + RB_YD + stid * 16) = X.y; \
        if (stid < 16) *(LAS v4u*)(b_ + RB_GAM + stid * 16) = X.g; } while (0)
    const int eib = (wid - 2) & 1;
    const bf16* epc = F.PROJ + (size_t)b * T * NP + h * 64 + 32 * eib + 4 * hi;
#define EP_LOAD(X, cj_) do { if ((cj_) < NS) { const int tt_ = (cj_) * 32 + l31; const bf16* pc_ = epc + (size_t)tt_ * NP; const bf16* pp_ = epc + (size_t)(tt_ > 0 ? tt_ - 1 : 0) * NP; \
        _Pragma("unroll") for (int rg = 0; rg < 4; ++rg) { X.vc[rg] = *(const GAS v2u*)(pc_ + C_V + 8 * rg); X.vp[rg] = *(const GAS v2u*)(pp_ + C_V + 8 * rg); X.ga[rg] = *(const GAS v2u*)(pc_ + C_GA + 8 * rg); } \
        X.rho = Dm.RHO[(u0 + (cj_)) * 32 + l31]; } } while (0)
#define EP_RUN(X, cj_) do { const int par_ = (cj_) & 1; \
        const float s1_ = stat[((par_ * 2 + 0) * 32 + l31) * 2] + stat[((par_ * 2 + 1) * 32 + l31) * 2], s2_ = stat[((par_ * 2 + 0) * 32 + l31) * 2 + 1] + stat[((par_ * 2 + 1) * 32 + l31) * 2 + 1]; \
        const float mean_ = s1_ * (1.f / 64.f), var_ = fmaxf(s2_ * (1.f / 64.f) - mean_ * mean_, 0.f), rstd_ = __builtin_amdgcn_rsqf(var_ + 64e-5f); \
        const int tt_ = (cj_) * 32 + l31; const size_t mm_ = (size_t)b * T + tt_; const float pm_ = tt_ > 0 ? 1.f : 0.f; \
        const LAS float* yb_ = ybuf + (par_ * 2 + eib) * 1024 + lane; \
        _Pragma("unroll") for (int rg = 0; rg < 4; ++rg) { const int hc_ = h * 64 + 32 * eib + 8 * rg + 4 * hi; \
            const f32x4 mu_ = *(const GAS f32x4*)(F.shift_mu + 1024 + hc_), lw_ = *(const GAS f32x4*)(F.ln_w + hc_), lb_ = *(const GAS f32x4*)(F.ln_b + hc_); \
            const float vc_[4] = {bflo(X.vc[rg].x), bfhi(X.vc[rg].x), bflo(X.vc[rg].y), bfhi(X.vc[rg].y)}, vp_[4] = {bflo(X.vp[rg].x), bfhi(X.vp[rg].x), bflo(X.vp[rg].y), bfhi(X.vp[rg].y)}; \
            const float g4_[4] = {bflo(X.ga[rg].x), bfhi(X.ga[rg].x), bflo(X.ga[rg].y), bfhi(X.ga[rg].y)}; float o_[4]; \
            _Pragma("unroll") for (int e = 0; e < 4; ++e) { const float vv_ = vc_[e] + (vp_[e] * pm_ - vc_[e]) * mu_[e]; \
                const float yn_ = (yb_[(4 * rg + e) * 64] - mean_) * rstd_ * lw_[e] + lb_[e] + X.rho * vv_; o_[e] = yn_ * g4_[e] * __builtin_amdgcn_rcpf(1.f + __expf(-g4_[e])); } \
            *(GAS v2u*)(F.MIX + mm_ * D + hc_) = (v2u){cvtpk(o_[0], o_[1]), cvtpk(o_[2], o_[3])}; } } while (0)
    f32x16 S[2]; S[0] = f32x16{}; S[1] = f32x16{};
    const int ib = wid & 1;
#define CONS(ci_) do { const LAS unsigned char* bb = lds + ((ci_) & 1) * RB_BUF; \
        v4u Sf[4]; _Pragma("unroll") for (int s = 0; s < 4; ++s) Sf[s] = FRAGACC(S[s >> 1], s & 1); \
        f32x16 y; unpack16(*(const LAS v4u*)(bb + RB_YD + ((2 * ib) * 64 + lane) * 16), *(const LAS v4u*)(bb + RB_YD + ((2 * ib + 1) * 64 + lane) * 16), y); \
        _Pragma("unroll") for (int rb = 0; rb < 2; ++rb) { \
            f32x16 acc; unpack16(*(const LAS v4u*)(bb + RB_DD + (((rb * 2 + ib) * 2) * 64 + lane) * 16), *(const LAS v4u*)(bb + RB_DD + (((rb * 2 + ib) * 2 + 1) * 64 + lane) * 16), acc); \
            const LAS f32x4* gm = (const LAS f32x4*)(bb + RB_GAM + (hi * 32 + rb * 16) * 4); \
            _Pragma("unroll") for (int q = 0; q < 4; ++q) { const f32x4 gv = gm[q]; _Pragma("unroll") for (int e = 0; e < 4; ++e) acc[4 * q + e] += gv[e] * S[rb][4 * q + e]; } \
            _Pragma("unroll") for (int s = 0; s < 4; ++s) acc = MFMA32(*(const LAS v4u*)(bb + RB_PF + ((rb * 4 + s) * 64 + lane) * 16), Sf[s], acc); \
            S[rb] = acc; } \
        _Pragma("unroll") for (int s = 0; s < 4; ++s) y = MFMA32(Sf[s], *(const LAS v4u*)(bb + RB_QF + (s * 64 + lane) * 16), y); \
        float s1 = 0.f, s2 = 0.f; LAS float* yb_ = ybuf + (((ci_) & 1) * 2 + ib) * 1024 + lane; \
        _Pragma("unroll") for (int r = 0; r < 16; ++r) { s1 += y[r]; s2 += y[r] * y[r]; yb_[r * 64] = y[r]; } \
        s1 = swap32_sum(s1); s2 = swap32_sum(s2); \
        if (hi == 0) { stat[((((ci_) & 1) * 2 + ib) * 32 + l31) * 2] = s1; stat[((((ci_) & 1) * 2 + ib) * 32 + l31) * 2 + 1] = s2; } } while (0)
#define RB_BAR() __syncthreads()
    if (wid < 2) {
        RB_BAR();
#pragma unroll 1
        for (int k = 0; k < NS; ++k) { CONS(k); RB_BAR(); }
        RB_BAR();
    } else if (wid >= 4) {
        RbStage sA, sB, sC, sD;
        ST_LOAD(sA, 0); ST_LOAD(sB, 1); ST_LOAD(sC, 2); ST_LOAD(sD, 3); ST_STORE(sA, 0); ST_LOAD(sA, 4);
        RB_BAR();
#define ST_STEP(k_, SN) do { if ((k_) + 1 < NS) ST_STORE(SN, ((k_) + 1) & 1); ST_LOAD(SN, (k_) + 5); RB_BAR(); } while (0)
#pragma unroll 1
        for (int k = 0; k < NS; k += 4) { ST_STEP(k, sB); ST_STEP(k + 1, sC); ST_STEP(k + 2, sD); ST_STEP(k + 3, sA); }
        RB_BAR();
#undef ST_STEP
    } else {
        RbEpi eA, eB, eC, eD;
        EP_LOAD(eA, 0); EP_LOAD(eB, 1); EP_LOAD(eC, 2);
        RB_BAR();
#define EP_STEP(k_, EP) do { if ((k_) > 0) EP_RUN(EP, (k_) - 1); EP_LOAD(EP, (k_) + 3); RB_BAR(); } while (0)
#pragma unroll 1
        for (int k = 0; k < NS; k += 4) { EP_STEP(k, eD); EP_STEP(k + 1, eA); EP_STEP(k + 2, eB); EP_STEP(k + 3, eC); }
        EP_RUN(eD, NS - 1);
        RB_BAR();
#undef EP_STEP
    }
#undef RB_BAR
#undef ST_LOAD
#undef ST_STORE
#undef EP_LOAD
#undef EP_RUN
#undef CONS
}
constexpr int AT_KROW = 272, AT_KB = 64 * AT_KROW, AT_VB = 64 * 256, AT_BUF = AT_KB + AT_VB;
__device__ __forceinline__ s16x4 vtr(const LAS unsigned char* p) { typedef short v4i16_t __attribute__((ext_vector_type(4))); return __builtin_bit_cast(s16x4, __builtin_amdgcn_ds_read_tr16_b64_v4i16((LAS v4i16_t*)p)); }
__device__ __forceinline__ void attn_unit(Frame& F, int b, int h, int qb, float slope2, float shift2, float lam) {
    const int tid = F.tid, lane = F.lane, l31 = lane & 31, hi = lane >> 5, wid = F.wave, map = wid >> 2, qs = wid & 3;
    LAS unsigned char* lds = F.lds + RING_OFF;
    const int q0 = qb * 128, qrow = q0 + 32 * qs + l31;
    const size_t mrow = (size_t)b * T + qrow;
    bf16x8 qf[4];
    { const bf16* qp = F.PROJ + mrow * NP + C_DQ + h * 128 + map * 64 + 8 * hi;
#pragma unroll
      for (int s = 0; s < 4; ++s) qf[s] = *(const GAS bf16x8*)(qp + 16 * s); }
    const bf16* kg = F.PROJ + (size_t)b * T * NP + C_DK + h * 128;
    const bf16* vg = F.PROJ + (size_t)b * T * NP + C_DV + h * 128;
    const int NT = 2 * qb + 2, tl = 2 * qb + (qs >> 1);
    const int srow0 = tid >> 4, sch = tid & 15, srow1 = srow0 + 32;
    const unsigned kdst0 = srow0 * AT_KROW + sch * 16, kdst1 = srow1 * AT_KROW + sch * 16;
    const unsigned vdst0 = AT_KB + srow0 * 256 + ((sch ^ ((srow0 & 3) << 2)) * 16), vdst1 = AT_KB + srow1 * 256 + ((sch ^ ((srow1 & 3) << 2)) * 16);
    v4u kr0, kr1, vr0, vr1;
#define AT_LOAD(t_) do { const size_t r0_ = (size_t)(64 * (t_) + srow0) * NP + sch * 8, r1_ = (size_t)(64 * (t_) + srow1) * NP + sch * 8; \
        kr0 = *(const GAS v4u*)(kg + r0_); kr1 = *(const GAS v4u*)(kg + r1_); vr0 = *(const GAS v4u*)(vg + r0_); vr1 = *(const GAS v4u*)(vg + r1_); } while (0)
#define AT_STORE(buf_) do { LAS unsigned char* b_ = lds + (buf_) * AT_BUF; *(LAS v4u*)(b_ + kdst0) = kr0; *(LAS v4u*)(b_ + kdst1) = kr1; *(LAS v4u*)(b_ + vdst0) = vr0; *(LAS v4u*)(b_ + vdst1) = vr1; } while (0)
    f32x16 o[4];
#pragma unroll
    for (int vb = 0; vb < 4; ++vb) o[vb] = f32x16{};
    float lsum = 0.f;
    AT_LOAD(0); AT_STORE(0);
    __syncthreads();
    const int G = lane >> 4, qq = (lane & 15) >> 2, pp = lane & 3;
#pragma unroll 1
    for (int t = 0; t < NT; ++t) {
        if (t + 1 < NT) AT_LOAD(t + 1);
        if (t <= tl) {
            const LAS unsigned char* Kb = lds + (t & 1) * AT_BUF; const LAS unsigned char* Vb = Kb + AT_KB;
            const float base = slope2 * (float)(64 * t + 4 * hi - qrow) - shift2;
            f32x16 p0, p1;
#pragma unroll
            for (int r = 0; r < 16; ++r) { p0[r] = base + slope2 * (float)((r & 3) + 8 * (r >> 2)); p1[r] = p0[r] + 32.f * slope2; }
#pragma unroll
            for (int s = 0; s < 4; ++s) {
                const bf16x8 a0 = *(const LAS bf16x8*)(Kb + l31 * AT_KROW + map * 128 + (2 * s + hi) * 16);
                const bf16x8 a1 = *(const LAS bf16x8*)(Kb + (32 + l31) * AT_KROW + map * 128 + (2 * s + hi) * 16);
                p0 = __builtin_amdgcn_mfma_f32_32x32x16_bf16(a0, qf[s], p0, 0, 0, 0);
                p1 = __builtin_amdgcn_mfma_f32_32x32x16_bf16(a1, qf[s], p1, 0, 0, 0);
            }
            if (t == tl) {
#pragma unroll
                for (int r = 0; r < 16; ++r) { const int ki = 64 * t + 4 * hi + (r & 3) + 8 * (r >> 2); if (ki > qrow) p0[r] = -1e30f; if (ki + 32 > qrow) p1[r] = -1e30f; }
            }
            float ls = 0.f;
#pragma unroll
            for (int r = 0; r < 16; ++r) { p0[r] = __builtin_amdgcn_exp2f(p0[r]); p1[r] = __builtin_amdgcn_exp2f(p1[r]); ls += p0[r] + p1[r]; }
            lsum += ls;
            v4u pw[4];
            pw[0] = (v4u){cvtpk(p0[0], p0[1]), cvtpk(p0[2], p0[3]), cvtpk(p0[4], p0[5]), cvtpk(p0[6], p0[7])};
            pw[1] = (v4u){cvtpk(p0[8], p0[9]), cvtpk(p0[10], p0[11]), cvtpk(p0[12], p0[13]), cvtpk(p0[14], p0[15])};
            pw[2] = (v4u){cvtpk(p1[0], p1[1]), cvtpk(p1[2], p1[3]), cvtpk(p1[4], p1[5]), cvtpk(p1[6], p1[7])};
            pw[3] = (v4u){cvtpk(p1[8], p1[9]), cvtpk(p1[10], p1[11]), cvtpk(p1[12], p1[13]), cvtpk(p1[14], p1[15])};
#pragma unroll
            for (int ks = 0; ks < 4; ++ks) {
                const int kvb = 32 * (ks >> 1) + 16 * (ks & 1);
                const int rowlo = kvb + 4 * hi + qq;
#pragma unroll
                for (int vb = 0; vb < 4; ++vb) {
                    const int chunk = (4 * vb + 2 * (G & 1) + (pp >> 1)) ^ (qq << 2);
                    const LAS unsigned char* alo = Vb + rowlo * 256 + chunk * 16 + 8 * (pp & 1);
                    const s16x4 lo = vtr(alo), hi4 = vtr(alo + 8 * 256);
                    const bf16x8 vf = (bf16x8){lo[0], lo[1], lo[2], lo[3], hi4[0], hi4[1], hi4[2], hi4[3]};
                    o[vb] = __builtin_amdgcn_mfma_f32_32x32x16_bf16(vf, __builtin_bit_cast(bf16x8, pw[ks]), o[vb], 0, 0, 0);
                }
            }
        }
        if (t + 1 < NT) AT_STORE((t + 1) & 1);
        __syncthreads();
    }
#undef AT_LOAD
#undef AT_STORE
    const float ltot = swap32_sum(lsum);
    LAS float* X = (LAS float*)lds;
    if (map == 1) {
        const float sc = lam / ltot;
#pragma unroll
        for (int vb = 0; vb < 4; ++vb)
#pragma unroll
            for (int r = 0; r < 16; ++r) X[(qs * 64 + vb * 16 + r) * 64 + lane] = o[vb][r] * sc;
    }
    __syncthreads();
    if (map == 0) {
        const float il = 1.f / ltot; float ss = 0.f;
#pragma unroll
        for (int vb = 0; vb < 4; ++vb)
#pragma unroll
            for (int r = 0; r < 16; ++r) { const float v = o[vb][r] * il - X[(qs * 64 + vb * 16 + r) * 64 + lane]; o[vb][r] = v; ss += v * v; }
        ss = swap32_sum(ss);
        const float rn = (1.f / sqrtf(ss * (1.f / 128.f) + 1e-5f)) * (1.f - LAMBDA_INIT);
        const bf16* gp = F.PROJ + mrow * NP + C_GB + h * 128;
        bf16* op = F.MIX + mrow * D + 512 + h * 128;
#pragma unroll
        for (int vb = 0; vb < 4; ++vb)
#pragma unroll
            for (int rg = 0; rg < 4; ++rg) {
                const int vc = 32 * vb + 8 * rg + 4 * hi;
                const v2u gw = *(const GAS v2u*)(gp + vc); const f32x4 sg = *(const GAS f32x4*)(F.subln_g + vc);
                const float g4[4] = {bflo(gw.x), bfhi(gw.x), bflo(gw.y), bfhi(gw.y)}; float ov[4];
#pragma unroll
                for (int e = 0; e < 4; ++e) ov[e] = o[vb][4 * rg + e] * rn * sg[e] * g4[e] / (1.f + __expf(-g4[e]));
                *(GAS v2u*)(op + vc) = (v2u){cvtpk(ov[0], ov[1]), cvtpk(ov[2], ov[3])};
            }
    }
    __syncthreads();
}
constexpr int CW_QUEUE = 8192;
constexpr int Q_RW = BATCH * RH, Q_AT = BATCH * AH * (T / 128), Q_ALL = Q_RW + Q_AT;
__device__ __forceinline__ void p3_queue(Frame& F, const RwDump& Dm) {
    const float l1 = wave_sum(F.lq1[F.lane] * F.lk1[F.lane]), l2 = wave_sum(F.lq2[F.lane] * F.lk2[F.lane]);
    const float lam = __expf(l1) - __expf(l2) + LAMBDA_INIT;
    float gq = fabsf(F.qn_g[F.lane]), gk = fabsf(F.kn_g[F.lane]);
#pragma unroll
    for (int o = 1; o < 64; o <<= 1) { gq = fmaxf(gq, __shfl_xor(gq, o)); gk = fmaxf(gk, __shfl_xor(gk, o)); }
    const float shift2 = 8.f * gq * gk * LOG2E;
    for (;;) {
        if (F.tid == 0) F.MISC[12] = __hip_atomic_fetch_add(F.ctl + CW_QUEUE, 1u, RLX_AGENT);
        __syncthreads();
        const int item = __builtin_amdgcn_readfirstlane((int)F.MISC[12]);
        __syncthreads();
        if (item >= Q_ALL) break;
        if (item < Q_RW) rwkvB_unit(F, Dm, item);
        else { const int idx = item - Q_RW, qb = 15 - (idx >> 5), bhh = idx & 31, b = bhh >> 2, h = bhh & 3;
            attn_unit(F, b, h, qb, exp2f(-2.f * (float)(h + 1)) * LOG2E, shift2, lam); }
    }
}

struct Args { const float* in[21]; float* out; unsigned char* ws; int ph_lo, ph_hi; };
__global__ void __launch_bounds__(NWAVES * 64, 2) hymba_fwd(Args args) {
    extern __shared__ __attribute__((aligned(16))) unsigned char lds[];
    Frame F;
    F.lds = (LAS unsigned char*)lds;
    F.MISC = (volatile LAS unsigned*)(F.lds + MISC_OFF);
    F.tid = threadIdx.x; F.lane = F.tid & 63; F.wave = __builtin_amdgcn_readfirstlane(F.tid >> 6);
    F.G = gridDim.x; { const int bx = blockIdx.x; F.vcu = (F.G % 8 == 0) ? (bx % 8) * (F.G / 8) + bx / 8 : bx; }
    unsigned char* ws = args.ws;
    F.ctl = (gu32*)(ws + WS_CTL);
    F.x = args.in[0]; F.norm_g = args.in[1]; F.w_in = args.in[2]; F.shift_mu = args.in[3]; F.w0 = args.in[4]; F.w_decay_up = args.in[5]; F.a0 = args.in[6]; F.w_iclr_up = args.in[7];
    F.k_k = args.in[8]; F.k_a = args.in[9]; F.r_k = args.in[10]; F.ln_w = args.in[11]; F.ln_b = args.in[12]; F.qn_g = args.in[13]; F.kn_g = args.in[14];
    F.lq1 = args.in[15]; F.lk1 = args.in[16]; F.lq2 = args.in[17]; F.lk2 = args.in[18]; F.subln_g = args.in[19]; F.w_out = args.in[20]; F.out = args.out;
    F.WinT = (bf16*)(ws + WS_WIN); F.WoutT = (bf16*)(ws + WS_WOUT); F.WdT = (bf16*)(ws + WS_WD); F.WaT = (bf16*)(ws + WS_WA);
    F.XN = (bf16*)(ws + WS_XN); F.PROJ = (bf16*)(ws + WS_PROJ); F.MIX = (bf16*)(ws + WS_MIX);
    for (int u = F.tid; u < (LDS_BYTES - LDSCTL_OFF) / 4; u += NWAVES * 64) ((LAS unsigned*)(F.lds + LDSCTL_OFF))[u] = 0u;
    __syncthreads();
    XcdBarrier bar; bar.bar = (unsigned*)(F.ctl + CW_BAR); bar.x = 0; bar.st = nullptr;
    if (MK_N_LAUNCHES == 1) bar = xcd_barrier_post((unsigned*)(F.ctl + CW_BAR), F.MISC + 8);
#define GRID_BAR() do { if (MK_N_LAUNCHES == 1) xcd_barrier(bar); } while (0)
    const int lo = args.ph_lo, hi = args.ph_hi;
#define IN(k) (lo <= (k) && (k) < hi)
#define BOTH(k) (IN(k) && IN((k) + 1))
#ifndef SKIP
#define SKIP 0
#endif
#ifndef DBL
#define DBL 0
#endif
    if (IN(0) && !(SKIP & 1)) { p0_prologue(F); if (DBL & 1) { GRID_BAR(); p0_prologue(F); } if (BOTH(0)) GRID_BAR(); }
    if (IN(1) && !(SKIP & 2)) {
        pg8::Gemm g{F.XN, F.WinT, M, NP, D}; pg8::StaticOrder S; S.init(M, NP, F.G, (int)blockIdx.x);
        pg8::EpiBf16S E{F.PROJ, NP};
        pg8::gemm_phase<pg8::EpiBf16S, pg8::StaticOrder, true, true>(F.lds + RING_OFF, g, S, E);
        if (DBL & 2) { GRID_BAR(); pg8::gemm_phase<pg8::EpiBf16S, pg8::StaticOrder, true, true>(F.lds + RING_OFF, g, S, E); }
        if (BOTH(1)) GRID_BAR();
    }
    RwDump Dm; { unsigned char* so = (unsigned char*)args.out; Dm.PF = (v4u*)so; Dm.DD = (v4u*)(so + 32 * MiB); Dm.QF = (v4u*)(ws + WS_XN); Dm.YD = (v4u*)(ws + WS_XN + 16 * MiB);
        Dm.GAM = (float*)(ws + WS_END); Dm.RHO = (float*)(ws + WS_END + 1 * MiB); }
    if (IN(2) && !(SKIP & 4)) {
        LAS float* wscr = (LAS float*)(F.lds + LDSCTL_OFF + 1024) + F.wave * 64;
#pragma unroll 1
        for (int p = F.vcu; p < BATCH * (T / 32); p += F.G) rwkvA_unit(F, Dm, (p >> 6) * RH + F.wave, p & 63, wscr, F.lds + RING_OFF + F.wave * 16384);
        if (DBL & 4) { GRID_BAR();
#pragma unroll 1
            for (int p = F.vcu; p < BATCH * (T / 32); p += F.G) rwkvA_unit(F, Dm, (p >> 6) * RH + F.wave, p & 63, wscr, F.lds + RING_OFF + F.wave * 16384); }
        p2_qknorm(F);
        if (BOTH(2)) GRID_BAR();
    }
    if (IN(3) && !(SKIP & 8)) {
        p3_queue(F, Dm);
        if (BOTH(3)) GRID_BAR();
    }
    if (IN(4) && !(SKIP & 16)) {
        pg8::Gemm g{F.MIX, F.WoutT, M, D, D}; pg8::StaticOrder S; S.init(M, D, F.G, (int)blockIdx.x);
        pg8::EpiResF32 E{F.x, F.out, D};
        pg8::gemm_phase<pg8::EpiResF32, pg8::StaticOrder, false, true>(F.lds + RING_OFF, g, S, E);
        if (DBL & 16) { GRID_BAR(); pg8::gemm_phase<pg8::EpiResF32, pg8::StaticOrder, false, true>(F.lds + RING_OFF, g, S, E); }
    }
#undef IN
#undef BOTH
}

extern "C" void kernel_launch(void* const* d_in, const int* in_sizes, int n_in, void* d_out, int out_size, void* d_ws, size_t ws_size, hipStream_t stream) {
    static int grid = 0;
    if (grid == 0) {
        if (n_in != 21 || in_sizes[0] != M * D || out_size != M * D || ws_size < WS_END + 2 * MiB) { fprintf(stderr, "kernel_launch: unexpected shapes (n_in %d, in0 %d, out %d, ws %zu); nothing launched\n", n_in, n_in > 0 ? in_sizes[0] : -1, out_size, ws_size); grid = -1; return; }
        int dev = 0, cus = 0, per_cu = 0;
        if (hipGetDevice(&dev) != hipSuccess || hipDeviceGetAttribute(&cus, hipDeviceAttributeMultiprocessorCount, dev) != hipSuccess) { grid = -1; return; }
        if (hipFuncSetAttribute((const void*)hymba_fwd, hipFuncAttributeMaxDynamicSharedMemorySize, LDS_BYTES) != hipSuccess) { fprintf(stderr, "kernel_launch: hipFuncSetAttribute failed\n"); grid = -1; return; }
        if (hipOccupancyMaxActiveBlocksPerMultiprocessor(&per_cu, (const void*)hymba_fwd, NWAVES * 64, LDS_BYTES) != hipSuccess || per_cu < 1) { fprintf(stderr, "kernel_launch: occupancy query reports %d workgroups per CU; nothing launched\n", per_cu); grid = -1; return; }
        (void)hipGetLastError();
        grid = cus;
        if (grid > 256) grid = 256;
    }
    if (grid < 0) return;
    if (hipMemsetAsync((char*)d_ws + WS_CTL, 0, CTL_ZERO_BYTES, stream) != hipSuccess) { fprintf(stderr, "kernel_launch: hipMemsetAsync failed\n"); return; }
    Args a{};
    for (int i = 0; i < 21; ++i) a.in[i] = (const float*)d_in[i];
    a.out = (float*)d_out; a.ws = (unsigned char*)d_ws;
    for (int li = 0; li < MK_N_LAUNCHES; ++li) {
        a.ph_lo = (MK_N_LAUNCHES == 1) ? 0 : li; a.ph_hi = (MK_N_LAUNCHES == 1) ? N_PHASES : li + 1;
        hipLaunchKernelGGL(hymba_fwd, dim3(grid), dim3(NWAVES * 64), LDS_BYTES, stream, a);
        const hipError_t le = hipPeekAtLastError();
        if (le != hipSuccess) { fprintf(stderr, "kernel_launch: launch %d failed: %s\n", li, hipGetErrorName(le)); break; }
    }
}
```

```cpp
#define MK_N_LAUNCHES 1
#include <hip/hip_runtime.h>
#include <hip/hip_bf16.h>
#include <cstdio>
#include <cstdint>
#include <cmath>
namespace pg8 {
#define PG8_LAS __attribute__((address_space(3)))
typedef unsigned short bf16_t;
typedef short bf16x8 __attribute__((ext_vector_type(8)));
typedef float f32x4 __attribute__((ext_vector_type(4)));
typedef unsigned u32x4 __attribute__((ext_vector_type(4)));
constexpr int BM = 256, BK = 64, HALF = 128, HTB = HALF * BK * 2  , STAGE_BYTES = 8 * HTB, NXCD = 8, WGM = 8;

__host__ __device__ __forceinline__ int lds_byte(int r, int c) { const int st = (r >> 4) * 2 + (c >> 5), rr = r & 15, cc = c & 31, ob = rr * 64 + cc * 2; return st * 1024 + (ob ^ (((ob >> 9) & 1) << 5)); }
__host__ __device__ __forceinline__ void stage_rc(int b, int& R, int& C) { const int st = b / 1024, sb = b % 1024, swz = sb ^ (((sb >> 9) & 1) << 5); R = (st >> 1) * 16 + swz / 64; C = (st & 1) * 32 + (swz % 64) / 2; }
__host__ __device__ __forceinline__ int perm32(int rho) { const int n = rho >> 4, i = rho & 15; return 8 * (i >> 2) + 4 * n + (i & 3); }

__device__ __forceinline__ int mk_lane_pg8() { int l; asm volatile("v_mbcnt_lo_u32_b32 %0, -1, 0\n\tv_mbcnt_hi_u32_b32 %0, -1, %0" : "=v"(l)); return l; }
struct Unit { int pm, pn; };
struct Gemm { const bf16_t* A; const bf16_t* Bt; int M, N, K; };

struct StaticOrder {
    int nM, nN, nwg, G, c;
    __host__ __device__ void init(int M, int N, int G_, int c_) { nM = M / BM; nN = N / BM; nwg = nM * nN; G = G_; c = c_; }
    __host__ __device__ bool next(int i, Unit& u) const {
        const long L = (long)i * G + c; if (L >= nwg) return false;
        int wgid = (int)L; { const int q = nwg / NXCD, r = nwg % NXCD, xcd = wgid % NXCD, off = wgid / NXCD; wgid = (xcd < r ? xcd * (q + 1) : r * (q + 1) + (xcd - r) * q) + off; }
        const int nig = WGM * nN, gid = wgid / nig, fm = gid * WGM, gsz = (nM - fm) < WGM ? (nM - fm) : WGM;
        u.pm = fm + ((wgid % nig) % gsz); u.pn = (wgid % nig) / gsz; return true;
    }
    __device__ __forceinline__ void a_ready(const Unit&) const {}
    __device__ __forceinline__ void done(const Unit&) const {}
};

__device__ __forceinline__ unsigned cvt_pk_bf16(float lo, float hi) { unsigned r; asm volatile("v_cvt_pk_bf16_f32 %0, %1, %2" : "=v"(r) : "v"(lo), "v"(hi)); return r; }
struct EpiBf16S {
    static constexpr bool PERM = true, AFTER_DRAIN = false;
    bf16_t* O; int ldc;
    __device__ __forceinline__ void operator()(const f32x4 (&acc)[2][2][4][2], const Unit& u, int wr, int wc, int fr, int fq) const {
        const int row0 = u.pm * BM + wr * 64 + fr, col0 = u.pn * BM + wc * 32 + 8 * fq;
#pragma unroll
        for (int ai = 0; ai < 2; ++ai)
#pragma unroll
            for (int m = 0; m < 4; ++m) { bf16_t* rowp = O + (size_t)(row0 + ai * HALF + m * 16) * ldc + col0;
#pragma unroll
                for (int bj = 0; bj < 2; ++bj) { const f32x4 v0 = acc[ai][bj][m][0], v1 = acc[ai][bj][m][1];
                    u32x4 w; w.x = cvt_pk_bf16(v0[0], v0[1]); w.y = cvt_pk_bf16(v0[2], v0[3]); w.z = cvt_pk_bf16(v1[0], v1[1]); w.w = cvt_pk_bf16(v1[2], v1[3]);
                    *(u32x4*)(rowp + bj * HALF) = w; } }
    }
};
struct EpiResF32 {
    static constexpr bool PERM = false, AFTER_DRAIN = false;
    const float* base; float* out; int ldc;
    __device__ __forceinline__ void operator()(const f32x4 (&acc)[2][2][4][2], const Unit& u, int wr, int wc, int fr, int fq) const {
        const int row0 = u.pm * BM + wr * 64 + fr, col0 = u.pn * BM + wc * 32 + 4 * fq;
#pragma unroll
        for (int ai = 0; ai < 2; ++ai)
#pragma unroll
            for (int m = 0; m < 4; ++m) { const size_t off = (size_t)(row0 + ai * HALF + m * 16) * ldc + col0;
#pragma unroll
                for (int bj = 0; bj < 2; ++bj)
#pragma unroll
                    for (int n = 0; n < 2; ++n) { const f32x4 bs = *(const f32x4*)(base + off + bj * HALF + n * 16); *(f32x4*)(out + off + bj * HALF + n * 16) = bs + acc[ai][bj][m][n]; } }
    }
};
template <class Epi, class Sched, bool ALIGN_EPI = false, bool SP2 = false>
__device__ __forceinline__ void gemm_phase(PG8_LAS unsigned char* lds, const Gemm g, const Sched& S, const Epi& E, const int mk_wave_id  ) {
    const int wid = mk_wave_id, lane = mk_lane_pg8(), tid = wid * 64 + lane, wr = wid >> 2, wc = wid & 3, fr = lane & 15, fq = lane >> 4;
    const int K = g.K, nt = K / BK;
    unsigned voffA[2], voffB[2];
#pragma unroll
    for (int i = 0; i < 2; ++i) { int R, C; stage_rc(tid * 16 + i * 8192, R, C); const int Rb = Epi::PERM ? ((R & ~31) + perm32(R & 31)) : R;
        voffA[i] = (unsigned)(R * K + C) * 2u; voffB[i] = (unsigned)(Rb * K + C) * 2u; }
    const size_t kstep = (size_t)(BK * 2);
    const size_t hstep = (size_t)HALF * K * 2;
    const size_t tstep = 2 * hstep;
    const unsigned ldsw = (unsigned)wid * 1024u;
    const int aoff = lds_byte(wr * 64 + fr, fq * 8), boff = lds_byte(wc * 32 + fr, fq * 8);
#define PG8_SA(b, h) (((b) * 2 + (h)) * HTB)
#define PG8_SB(b, h) ((4 + (b) * 2 + (h)) * HTB)
#define PG8_STAGE(bufoff, gbase, voff) do { _Pragma("unroll") for (int _i = 0; _i < 2; ++_i) \
        __builtin_amdgcn_global_load_lds((const unsigned*)((const char*)(gbase) + (voff)[_i]), (PG8_LAS unsigned*)(lds + (bufoff) + ldsw + _i * 8192), 16, 0, 0); } while (0)
#define PG8_LDA(dst, b, h) do { _Pragma("unroll") for (int m = 0; m < 4; ++m) _Pragma("unroll") for (int k = 0; k < 2; ++k) dst[m][k] = *(const PG8_LAS bf16x8*)(lds + PG8_SA(b, h) + aoff + m * 2048 + k * 1024); } while (0)
#define PG8_LDB(dst, b, h) do { _Pragma("unroll") for (int n = 0; n < 2; ++n) _Pragma("unroll") for (int k = 0; k < 2; ++k) dst[n][k] = *(const PG8_LAS bf16x8*)(lds + PG8_SB(b, h) + boff + n * 2048 + k * 1024); } while (0)
#define PG8_MMA(ai, bj, At, Bt) do { __builtin_amdgcn_s_setprio(1); _Pragma("unroll") for (int m = 0; m < 4; ++m) _Pragma("unroll") for (int n = 0; n < 2; ++n) _Pragma("unroll") for (int k = 0; k < 2; ++k) \
        acc[ai][bj][m][n] = __builtin_amdgcn_mfma_f32_16x16x32_bf16(Bt[n][k], At[m][k], acc[ai][bj][m][n], 0, 0, 0); __builtin_amdgcn_s_setprio(0); } while (0)
#define PG8_WAIT_V(n) asm volatile("s_waitcnt vmcnt(" #n ")" ::: "memory")
#define PG8_WAIT_L(n) asm volatile("s_waitcnt lgkmcnt(" #n ")" ::: "memory")
#define PG8_BAR __builtin_amdgcn_s_barrier()
#define PG8_SCHED __builtin_amdgcn_sched_barrier(0)
    Unit cur, nxt; int ui = 0;
    if (!S.next(0, cur)) return;
    f32x4 acc[2][2][4][2];
#pragma unroll
    for (int a = 0; a < 2; ++a)
#pragma unroll
        for (int b = 0; b < 2; ++b)
#pragma unroll
            for (int m = 0; m < 4; ++m)
#pragma unroll
                for (int n = 0; n < 2; ++n) acc[a][b][m][n] = (f32x4){0.f, 0.f, 0.f, 0.f};
    bf16x8 At[4][2], B0[2][2], B1[2][2];
    const char* cA = (const char*)g.A + (size_t)cur.pm * tstep; const char* cB = (const char*)g.Bt + (size_t)cur.pn * tstep;
    S.a_ready(cur);
    if constexpr (SP2) {
        PG8_STAGE(PG8_SB(0, 0), cB, voffB); PG8_STAGE(PG8_SB(0, 1), cB + hstep, voffB); PG8_STAGE(PG8_SA(0, 0), cA, voffA); PG8_STAGE(PG8_SA(0, 1), cA + hstep, voffA);
        if (wr == 1) PG8_BAR;
        PG8_WAIT_V(2); PG8_BAR;
        PG8_STAGE(PG8_SB(1, 0), cB + kstep, voffB); PG8_STAGE(PG8_SA(1, 0), cA + kstep, voffA); PG8_STAGE(PG8_SB(1, 1), cB + hstep + kstep, voffB);
        PG8_WAIT_V(6); PG8_BAR;
    } else {
        PG8_STAGE(PG8_SB(0, 0), cB, voffB); PG8_STAGE(PG8_SA(0, 0), cA, voffA); PG8_STAGE(PG8_SB(0, 1), cB + hstep, voffB); PG8_STAGE(PG8_SA(0, 1), cA + hstep, voffA);
        if (wr == 1) PG8_BAR;
        PG8_WAIT_V(4); PG8_BAR;
        PG8_STAGE(PG8_SB(1, 0), cB + kstep, voffB); PG8_STAGE(PG8_SA(1, 0), cA + kstep, voffA); PG8_STAGE(PG8_SB(1, 1), cB + hstep + kstep, voffB);
        PG8_WAIT_V(6); PG8_BAR;
    }
    for (;;) {
        const bool has_next = S.next(ui + 1, nxt);
        const char* nA = has_next ? (const char*)g.A + (size_t)nxt.pm * tstep : cA; const char* nB = has_next ? (const char*)g.Bt + (size_t)nxt.pn * tstep : cB;
        for (int t = 0; t < nt; t += 2) {
            const bool last = (t == nt - 2);
            const char* a1 = cA + (size_t)(t + 1) * kstep;
            const char* a2 = last ? nA : cA + (size_t)(t + 2) * kstep; const char* b2 = last ? nB : cB + (size_t)(t + 2) * kstep;
            const char* a3 = a2 + kstep; const char* b3 = b2 + kstep;
            if (last && has_next) S.a_ready(nxt);
            if constexpr (SP2) {
            PG8_LDB(B0, 0, 0); PG8_LDB(B1, 0, 1); PG8_SCHED; PG8_LDA(At, 0, 0); PG8_STAGE(PG8_SA(1, 1), a1 + hstep, voffA);
            PG8_WAIT_V(8); PG8_WAIT_L(0); PG8_BAR; PG8_MMA(0, 0, At, B0); PG8_MMA(0, 1, At, B1); PG8_BAR; PG8_SCHED;
            PG8_LDA(At, 0, 1); PG8_STAGE(PG8_SB(0, 0), b2, voffB); PG8_STAGE(PG8_SB(0, 1), b2 + hstep, voffB); PG8_STAGE(PG8_SA(0, 0), a2, voffA);
            PG8_WAIT_V(8); PG8_WAIT_L(0); PG8_BAR; PG8_MMA(1, 0, At, B0); PG8_MMA(1, 1, At, B1); PG8_BAR; PG8_SCHED;
            PG8_LDB(B0, 1, 0); PG8_LDB(B1, 1, 1); PG8_SCHED; PG8_LDA(At, 1, 0); PG8_STAGE(PG8_SA(0, 1), a2 + hstep, voffA);
            PG8_WAIT_V(8); PG8_WAIT_L(0); PG8_BAR; PG8_MMA(0, 0, At, B0); PG8_MMA(0, 1, At, B1); PG8_BAR; PG8_SCHED;
            PG8_LDA(At, 1, 1); PG8_STAGE(PG8_SB(1, 0), b3, voffB); PG8_STAGE(PG8_SB(1, 1), b3 + hstep, voffB); PG8_STAGE(PG8_SA(1, 0), a3, voffA);
            PG8_WAIT_V(8); PG8_WAIT_L(0); PG8_BAR; PG8_MMA(1, 0, At, B0); PG8_MMA(1, 1, At, B1); PG8_BAR; PG8_SCHED;
            } else {
            PG8_LDB(B0, 0, 0); PG8_SCHED; PG8_LDA(At, 0, 0); PG8_STAGE(PG8_SA(1, 1), a1 + hstep, voffA);
            PG8_WAIT_L(8); PG8_BAR; PG8_WAIT_L(0); PG8_MMA(0, 0, At, B0); PG8_BAR; PG8_SCHED;
            PG8_LDB(B1, 0, 1); PG8_STAGE(PG8_SB(0, 0), b2, voffB);
            PG8_BAR; PG8_WAIT_L(0); PG8_MMA(0, 1, At, B1); PG8_BAR;
            PG8_LDA(At, 0, 1); PG8_STAGE(PG8_SA(0, 0), a2, voffA);
            PG8_BAR; PG8_WAIT_L(0); PG8_MMA(1, 0, At, B0); PG8_BAR; PG8_SCHED;
            PG8_STAGE(PG8_SB(0, 1), b2 + hstep, voffB);
            PG8_WAIT_V(6); PG8_BAR; PG8_MMA(1, 1, At, B1); PG8_BAR;
            PG8_LDB(B0, 1, 0); PG8_SCHED; PG8_LDA(At, 1, 0); PG8_STAGE(PG8_SA(0, 1), a2 + hstep, voffA);
            PG8_WAIT_L(8); PG8_BAR; PG8_WAIT_L(0); PG8_MMA(0, 0, At, B0); PG8_BAR; PG8_SCHED;
            PG8_LDB(B1, 1, 1); PG8_STAGE(PG8_SB(1, 0), b3, voffB);
            PG8_BAR; PG8_WAIT_L(0); PG8_MMA(0, 1, At, B1); PG8_BAR;
            PG8_LDA(At, 1, 1); PG8_STAGE(PG8_SA(1, 0), a3, voffA);
            PG8_BAR; PG8_WAIT_L(0); PG8_MMA(1, 0, At, B0); PG8_BAR; PG8_SCHED;
            PG8_STAGE(PG8_SB(1, 1), b3 + hstep, voffB);
            PG8_WAIT_V(6); PG8_BAR; PG8_MMA(1, 1, At, B1); PG8_BAR;
            }
        }
        if constexpr (ALIGN_EPI) { if (wr == 0) PG8_BAR; }
        if constexpr (!Epi::AFTER_DRAIN) { E(acc, cur, wr, wc, fr, fq); S.done(cur); }
        if (!has_next) break;
#pragma unroll
        for (int a = 0; a < 2; ++a)
#pragma unroll
            for (int b = 0; b < 2; ++b)
#pragma unroll
                for (int m = 0; m < 4; ++m)
#pragma unroll
                    for (int n = 0; n < 2; ++n) acc[a][b][m][n] = (f32x4){0.f, 0.f, 0.f, 0.f};
        cur = nxt; cA = nA; cB = nB; ++ui;
        if constexpr (ALIGN_EPI) { if (wr == 1) PG8_BAR; }
    }
    PG8_WAIT_V(0);
    if constexpr (!ALIGN_EPI) { if (wr == 0) PG8_BAR; }
    PG8_BAR;
    if constexpr (Epi::AFTER_DRAIN) { E.fused(acc, cur, wr, wc, fr, fq, lds, wid, lane); S.done(cur); }
#undef PG8_SA
#undef PG8_SB
#undef PG8_STAGE
#undef PG8_LDA
#undef PG8_LDB
#undef PG8_MMA
#undef PG8_WAIT_V
#undef PG8_WAIT_L
#undef PG8_BAR
#undef PG8_SCHED
}
}
constexpr int NWAVES = 8;
#ifndef MK_N_LAUNCHES
#define MK_N_LAUNCHES 1
#endif
constexpr int N_PHASES = 5;
constexpr int BATCH = 8, T = 2048, D = 1024, M = BATCH * T;
constexpr int NP = 4352;
constexpr int C_R = 0, C_K = 512, C_V = 1024, C_ZW = 1536, C_ZA = 1600, C_GA = 1792, C_DQ = 2304, C_DK = 2816, C_DV = 3328, C_GB = 3840;
constexpr int RH = 8, RN = 64;
constexpr int AH = 4;
constexpr float C2 = 0.125f * 1.4426950408889634f;
constexpr float LOG2E = 1.4426950408889634f;
constexpr float LAMBDA_INIT = 0.2f;

constexpr size_t MiB = 1u << 20;
constexpr size_t WS_CTL = 0, CTL_ZERO_BYTES = 1 * MiB;
constexpr size_t WS_WIN = 2 * MiB;
constexpr size_t WS_WOUT = 11 * MiB;
constexpr size_t WS_WD = 13 * MiB, WS_WA = 13 * MiB + 65536;
constexpr size_t WS_RHO = 13 * MiB + 2 * 65536;
constexpr size_t WS_XN = 14 * MiB;
constexpr size_t WS_PROJ = 46 * MiB;
constexpr size_t WS_MIX = 182 * MiB;
constexpr size_t WS_END = 214 * MiB;
constexpr int CW_BAR = 4096;

constexpr int RING_OFF = 0, RING_BYTES = 131072;
constexpr int LDSCTL_OFF = RING_BYTES, MISC_OFF = LDSCTL_OFF + 320;
constexpr int LDS_BYTES = 147456;

#define GAS __attribute__((address_space(1)))
#define LAS __attribute__((address_space(3)))
typedef unsigned short bf16;
typedef unsigned v4u __attribute__((ext_vector_type(4)));
typedef unsigned v2u __attribute__((ext_vector_type(2)));
typedef float f32x4 __attribute__((ext_vector_type(4)));
typedef float f32x16 __attribute__((ext_vector_type(16)));
typedef short bf16x8 __attribute__((ext_vector_type(8)));
typedef short s16x4 __attribute__((ext_vector_type(4)));
typedef GAS unsigned gu32;
typedef GAS unsigned long long gu64;
#define RLX_AGENT __ATOMIC_RELAXED, __HIP_MEMORY_SCOPE_AGENT
#define LDS_WAIT() asm volatile("s_waitcnt lgkmcnt(0)" ::: "memory")
#define VM_WAIT() asm volatile("s_waitcnt vmcnt(0)" ::: "memory")
__device__ __forceinline__ unsigned f2bf(float f) { unsigned u = __builtin_bit_cast(unsigned, f); return (u + 0x7fffu + ((u >> 16) & 1u)) >> 16; }
__device__ __forceinline__ unsigned pk2(float lo, float hi) { return f2bf(lo) | (f2bf(hi) << 16); }
__device__ __forceinline__ float bflo(unsigned u) { return __uint_as_float(u << 16); }
__device__ __forceinline__ float bfhi(unsigned u) { return __uint_as_float(u & 0xffff0000u); }
__device__ __forceinline__ float bf1(unsigned short u) { return __uint_as_float((unsigned)u << 16); }
__device__ __forceinline__ int mk_lane() { int l; asm volatile("v_mbcnt_lo_u32_b32 %0, -1, 0\n\tv_mbcnt_hi_u32_b32 %0, -1, %0" : "=v"(l)); return l; }
#define XB_TMO      128
#define XB_XCNT(j)  (256  + 64 * (j))
#define XB_XSUB(j)  (1280 + 64 * (j))
#define XB_XGEN(j)  (2304 + 64 * (j))
#define XB_TOP      3328
#define XB_TOPGEN   3392
#define XCD_BAR_WORDS 3456
#define XB_SPIN_CAP (1u << 18)

__device__ __forceinline__ unsigned xb_ld(unsigned* p)              { return __hip_atomic_load(p, __ATOMIC_RELAXED, __HIP_MEMORY_SCOPE_AGENT); }
__device__ __forceinline__ unsigned xb_add(unsigned* p, unsigned v) { return __hip_atomic_fetch_add(p, v, __ATOMIC_RELAXED, __HIP_MEMORY_SCOPE_AGENT); }
__device__ __forceinline__ unsigned xb_xcc_id() { return (unsigned)__builtin_amdgcn_s_getreg((3 << 11) | 20) & 0xFu; }
#define XB_SPIN(cond, bar) do { unsigned _sp = 0; while (cond) { __builtin_amdgcn_s_sleep(1); \
    if ((++_sp & 255u) == 0u) { if (xb_ld(&(bar)[XB_TMO])) break; if (_sp > XB_SPIN_CAP) { atomicAdd(&(bar)[XB_TMO], 1u); break; } } } } while (0)

struct XcdBarrier {
    unsigned* bar; unsigned x;
    volatile LAS unsigned* st;
    int wave;
};

__device__ __forceinline__ XcdBarrier xcd_barrier_post(unsigned* bar, volatile LAS unsigned* st, int wave) {
    XcdBarrier b; b.bar = bar; b.x = xb_xcc_id(); b.st = st; b.wave = wave;
    if (wave == 0 && mk_lane() == 0) (void)xb_add(&bar[XB_XCNT(b.x)], 1u);
    return b;
}
__device__ __forceinline__ void xcd_barrier_complete(unsigned* bar, unsigned x, unsigned& nloc, unsigned& nx) {
    const unsigned G = gridDim.x * gridDim.y * gridDim.z;
    unsigned sum, cnt, mine, sp = 0u;
    for (;;) {
        sum = 0u; cnt = 0u; mine = 0u;
#pragma unroll
        for (unsigned j = 0; j < 16; ++j) { const unsigned c = xb_ld(&bar[XB_XCNT(j)]); sum += c; cnt += (c > 0u) ? 1u : 0u; mine = (j == x) ? c : mine; }
        if (sum == G) break;
        __builtin_amdgcn_s_sleep(1);
        if ((++sp & 255u) == 0u) { if (xb_ld(&bar[XB_TMO])) break; if (sp > XB_SPIN_CAP) { atomicAdd(&bar[XB_TMO], 1u); break; } }
    }
    nloc = mine > 0u ? mine : 1u; nx = cnt > 0u ? cnt : 1u;
}

__device__ __forceinline__ void xcd_barrier(const XcdBarrier& b) {
    asm volatile("s_waitcnt vmcnt(0)" ::: "memory");
    __syncthreads();
    if (b.wave == 0 && mk_lane() == 0) {
        unsigned* bar = b.bar;
        __builtin_amdgcn_s_waitcnt(0);
        unsigned nloc = b.st[0], nx = b.st[1];
        if (nloc == 0u) { xcd_barrier_complete(bar, b.x, nloc, nx); b.st[0] = nloc; b.st[1] = nx; }
        const unsigned old = xb_add(&bar[XB_XSUB(b.x)], 1u);
        const unsigned gen = old / nloc;
        if (old + 1u == (gen + 1u) * nloc) {
            __builtin_amdgcn_fence(__ATOMIC_RELEASE, "agent");
            asm volatile("s_waitcnt vmcnt(0)" ::: "memory");
            const unsigned og = xb_add(&bar[XB_TOP], 1u);
            const unsigned tg = og / nx;
            if (og + 1u == (tg + 1u) * nx) xb_add(&bar[XB_TOPGEN], 1u);
            else XB_SPIN(xb_ld(&bar[XB_TOPGEN]) == tg, bar);
            __builtin_amdgcn_fence(__ATOMIC_ACQUIRE, "agent");
            xb_add(&bar[XB_XGEN(b.x)], 1u);
            asm volatile("s_waitcnt vmcnt(0)" ::: "memory");
        } else {
            XB_SPIN(xb_ld(&bar[XB_XGEN(b.x)]) == gen, bar);
            __builtin_amdgcn_fence(__ATOMIC_ACQUIRE, "agent");
            asm volatile("s_waitcnt vmcnt(0)" ::: "memory");
        }
    }
    __syncthreads();
}
struct Frame {
    LAS unsigned char* lds;
    volatile LAS unsigned* MISC;
    gu32* ctl;
    int tid, lane, wave;
    int vcu, G;
    const float* x; float* out;
    const float *norm_g, *w_in, *shift_mu, *w0, *w_decay_up, *a0, *w_iclr_up, *k_k, *k_a, *r_k, *ln_w, *ln_b, *qn_g, *kn_g, *lq1, *lk1, *lq2, *lk2, *subln_g, *w_out;
    bf16 *WinT, *WoutT, *WdT, *WaT, *XN, *PROJ, *MIX;
};

typedef float f32x2q_t __attribute__((ext_vector_type(2))); typedef __bf16 bf16x2q_t __attribute__((ext_vector_type(2)));
__device__ __forceinline__ unsigned cvtpk2(float lo, float hi) { f32x2q_t v = {lo, hi}; bf16x2q_t b = __builtin_convertvector(v, bf16x2q_t); return __builtin_bit_cast(unsigned, b); }
__device__ __forceinline__ float wave_sum(float v) {
#pragma unroll
    for (int o = 1; o < 64; o <<= 1) v += __shfl_xor(v, o);
    return v;
}
template <int CTRL> __device__ __forceinline__ float dpp_f(float x) { return __builtin_bit_cast(float, __builtin_amdgcn_mov_dpp(__builtin_bit_cast(int, x), CTRL, 0xf, 0xf, true)); }
__device__ __forceinline__ float row16_sum(float x) {
    x += dpp_f<0xB1>(x); x += dpp_f<0x4E>(x); x += dpp_f<0x141>(x); x += dpp_f<0x140>(x); return x;
}
__device__ __forceinline__ float swap32_sum(float x) {
    auto rr = __builtin_amdgcn_permlane32_swap(__float_as_uint(x), __float_as_uint(x), false, false);
    return __uint_as_float(rr[0]) + __uint_as_float(rr[1]);
}

__device__ __forceinline__ void p0_transpose_item(const float* W, int N, int nsrc, const float* kscale, bf16* WT, int K, int ndst, LAS float* scr, int k0, int lane) {
#pragma unroll 8
    for (int i = 0; i < 32; ++i) { const int kk = 2 * i + (lane >> 5);
        float v = 0.f; if (nsrc >= 0) { v = W[(size_t)(k0 + kk) * N + nsrc + (lane & 31)]; if (kscale) v *= kscale[k0 + kk]; }
        scr[kk * 33 + (lane & 31)] = v; }
    LDS_WAIT(); asm volatile("" ::: "memory");
    const int c = lane & 7;
#pragma unroll
    for (int j = 0; j < 4; ++j) { const int n = (lane >> 3) + 8 * j; const LAS float* s = scr + (8 * c) * 33 + n;
        v4u o; o.x = pk2(s[0 * 33], s[1 * 33]); o.y = pk2(s[2 * 33], s[3 * 33]); o.z = pk2(s[4 * 33], s[5 * 33]); o.w = pk2(s[6 * 33], s[7 * 33]);
        *(GAS v4u*)(WT + (size_t)(ndst + n) * K + k0 + 8 * c) = o; }
    LDS_WAIT(); asm volatile("" ::: "memory");
}
__device__ __forceinline__ void p0_prologue(Frame& F) {
    LAS float* scr = (LAS float*)(F.lds + RING_OFF + F.wave * 16384);
    const int gw = F.vcu * NWAVES + F.wave, NGW = F.G * NWAVES;
    constexpr int I_IN = (D / 64) * (NP / 32), I_OUT = (D / 64) * (D / 32), I_L = 512 / 32;
    constexpr int NITEMS = I_IN + I_OUT + 2 * I_L;
    for (int it = gw; it < NITEMS; it += NGW) {
        int r = it;
        if (r < I_IN) { const int kb = r / (NP / 32), nb = r % (NP / 32), nd = 32 * nb; const int ns = nd < 1664 ? nd : (nd < 1792 ? -1 : nd - 128);
            p0_transpose_item(F.w_in, 4224, ns, F.norm_g, F.WinT, D, nd, scr, 64 * kb, F.lane); continue; } r -= I_IN;
        if (r < I_OUT) { const int kb = r / (D / 32), nb = r % (D / 32);
            p0_transpose_item(F.w_out, D, 32 * nb, nullptr, F.WoutT, D, 32 * nb, scr, 64 * kb, F.lane); continue; } r -= I_OUT;
        if (r < I_L) { p0_transpose_item(F.w_decay_up, 512, 32 * r, nullptr, F.WdT, 64, 32 * r, scr, 0, F.lane); continue; } r -= I_L;
        p0_transpose_item(F.w_iclr_up, 512, 32 * r, nullptr, F.WaT, 64, 32 * r, scr, 0, F.lane);
    }
    for (int m0 = gw * 2; m0 < M; m0 += NGW * 2) {
        f32x4 v[2][4]; float s[2];
#pragma unroll
        for (int u = 0; u < 2; ++u) { const GAS f32x4* xr = (const GAS f32x4*)(F.x + (size_t)(m0 + u) * D) + F.lane;
#pragma unroll
            for (int j = 0; j < 4; ++j) v[u][j] = __builtin_nontemporal_load(xr + 64 * j); }
#pragma unroll
        for (int u = 0; u < 2; ++u) { float a = 0.f;
#pragma unroll
            for (int j = 0; j < 4; ++j) a += (v[u][j].x * v[u][j].x + v[u][j].y * v[u][j].y) + (v[u][j].z * v[u][j].z + v[u][j].w * v[u][j].w);
            s[u] = a; }
#pragma unroll
        for (int u = 0; u < 2; ++u) {
            const float rstd = __builtin_amdgcn_rsqf(wave_sum(s[u]) * (1.f / D) + 1e-6f);
            GAS unsigned long long* o8 = (GAS unsigned long long*)(F.XN + (size_t)(m0 + u) * D) + F.lane;
#pragma unroll
            for (int j = 0; j < 4; ++j) o8[64 * j] = (unsigned long long)cvtpk2(v[u][j].x * rstd, v[u][j].y * rstd) | ((unsigned long long)cvtpk2(v[u][j].z * rstd, v[u][j].w * rstd) << 32);
        }
    }
}

__device__ __forceinline__ float tanh_f(float x) { const float e = __expf(-2.f * fabsf(x)); const float t = (1.f - e) * __builtin_amdgcn_rcpf(1.f + e); return x < 0.f ? -t : t; }
__device__ __forceinline__ void shifted8(const bf16* proj, size_t m, bool has_prev, int col, const float* mu, float (&o)[8]) {
    const v4u c = *(const GAS v4u*)(proj + m * NP + col);
    v4u p = (v4u){0u, 0u, 0u, 0u}; if (has_prev) p = *(const GAS v4u*)(proj + (m - 1) * NP + col);
    const f32x4 m0 = *(const GAS f32x4*)(mu), m1 = *(const GAS f32x4*)(mu + 4);
    const unsigned cw[4] = {c.x, c.y, c.z, c.w}, pw[4] = {p.x, p.y, p.z, p.w}; const float mm[8] = {m0.x, m0.y, m0.z, m0.w, m1.x, m1.y, m1.z, m1.w};
#pragma unroll
    for (int j = 0; j < 4; ++j) { const float c0 = bflo(cw[j]), c1 = bfhi(cw[j]), p0 = bflo(pw[j]), p1 = bfhi(pw[j]);
        o[2 * j] = c0 + (p0 - c0) * mm[2 * j]; o[2 * j + 1] = c1 + (p1 - c1) * mm[2 * j + 1]; }
}
__device__ __forceinline__ void shifted4(const bf16* proj, size_t m, bool has_prev, int col, const float* mu, float (&o)[4]) {
    const v2u c = *(const GAS v2u*)(proj + m * NP + col);
    v2u p = (v2u){0u, 0u}; if (has_prev) p = *(const GAS v2u*)(proj + (m - 1) * NP + col);
    const f32x4 m0 = *(const GAS f32x4*)(mu);
    o[0] = bflo(c.x) + (bflo(p.x) - bflo(c.x)) * m0.x; o[1] = bfhi(c.x) + (bfhi(p.x) - bfhi(c.x)) * m0.y;
    o[2] = bflo(c.y) + (bflo(p.y) - bflo(c.y)) * m0.z; o[3] = bfhi(c.y) + (bfhi(p.y) - bfhi(c.y)) * m0.w;
}
__device__ __forceinline__ void p2_qknorm(Frame& F) {
    const int gw = F.vcu * NWAVES + F.wave, NGW = F.G * NWAVES, lane = F.lane, sub = lane & 7;
    const f32x4 gq0 = *(const GAS f32x4*)(F.qn_g + sub * 8), gq1 = *(const GAS f32x4*)(F.qn_g + sub * 8 + 4), gk0 = *(const GAS f32x4*)(F.kn_g + sub * 8), gk1 = *(const GAS f32x4*)(F.kn_g + sub * 8 + 4);
    constexpr int UQ = 4;
    for (int it0 = gw * UQ; it0 < 2 * M; it0 += NGW * UQ) {
        bf16* p[UQ]; v4u c[UQ];
#pragma unroll
        for (int u = 0; u < UQ; ++u) { const int it = it0 + u; const size_t m = (size_t)(it >> 1); p[u] = F.PROJ + m * NP + ((it & 1) ? C_DK : C_DQ) + (lane >> 3) * 64 + sub * 8; c[u] = *(const GAS v4u*)p[u]; }
#pragma unroll
        for (int u = 0; u < UQ; ++u) {
            const int isk = (it0 + u) & 1; const unsigned cw[4] = {c[u].x, c[u].y, c[u].z, c[u].w};
            float xv[8]; float ss = 0.f;
#pragma unroll
            for (int j = 0; j < 4; ++j) { xv[2 * j] = bflo(cw[j]); xv[2 * j + 1] = bfhi(cw[j]); ss += xv[2 * j] * xv[2 * j] + xv[2 * j + 1] * xv[2 * j + 1]; }
            ss += dpp_f<0xB1>(ss); ss += dpp_f<0x4E>(ss); ss += dpp_f<0x141>(ss);
            const float r = __builtin_amdgcn_rsqf(ss * (1.f / 64.f) + 1e-6f) * (isk ? 1.f : C2);
            const f32x4 g0 = isk ? gk0 : gq0, g1 = isk ? gk1 : gq1;
            v4u o; o.x = cvtpk2(xv[0] * r * g0.x, xv[1] * r * g0.y); o.y = cvtpk2(xv[2] * r * g0.z, xv[3] * r * g0.w); o.z = cvtpk2(xv[4] * r * g1.x, xv[5] * r * g1.y); o.w = cvtpk2(xv[6] * r * g1.z, xv[7] * r * g1.w);
            *(GAS v4u*)p[u] = o;
        }
    }
}
typedef float f32x2_t __attribute__((ext_vector_type(2))); typedef __bf16 bf16x2_t __attribute__((ext_vector_type(2)));
__device__ __forceinline__ unsigned cvtpk(float lo, float hi) { f32x2_t v = {lo, hi}; bf16x2_t b = __builtin_convertvector(v, bf16x2_t); return __builtin_bit_cast(unsigned, b); }
#define MFMA32(a, b, c) __builtin_amdgcn_mfma_f32_32x32x16_bf16(__builtin_bit_cast(bf16x8, (a)), __builtin_bit_cast(bf16x8, (b)), (c), 0, 0, 0)
#define FRAGACC(z, s) ((v4u){cvtpk((z)[8 * (s)], (z)[8 * (s) + 1]), cvtpk((z)[8 * (s) + 2], (z)[8 * (s) + 3]), cvtpk((z)[8 * (s) + 4], (z)[8 * (s) + 5]), cvtpk((z)[8 * (s) + 6], (z)[8 * (s) + 7])})
template <int CTRL, int RM> __device__ __forceinline__ float dpp_upd0(float x) { return __builtin_bit_cast(float, __builtin_amdgcn_update_dpp(0, __builtin_bit_cast(int, x), CTRL, RM, 0xf, false)); }
__device__ __forceinline__ float scan32(float x) {
    x += dpp_upd0<0x111, 0xf>(x); x += dpp_upd0<0x112, 0xf>(x); x += dpp_upd0<0x114, 0xf>(x); x += dpp_upd0<0x118, 0xf>(x); x += dpp_upd0<0x142, 0xa>(x); return x;
}
constexpr int RW_UNITS = BATCH * RH * (T / 32);
struct RwDump { v4u* PF; v4u* DD; v4u* QF; v4u* YD; float* GAM; float* RHO; };

__device__ __forceinline__ void rwkvA_unit(Frame& F, const RwDump& Dm, int bh, int ci, LAS float* wscr, LAS unsigned char* park) {
    int lane = mk_lane(); asm volatile("" : "+v"(lane));
    const int hi = lane >> 5, l31 = lane & 31, b = bh >> 3, w = bh & 7;
    LAS v4u* pk = (LAS v4u*)park + lane;
#define PARK(slot) pk[(slot) * 64]
    int tok = 0; asm volatile("" : "+v"(tok));
#define DEP(x) asm volatile("" : "+v"(tok) : "v"(x))
    const int t = ci * 32 + l31; const size_t m = (size_t)b * T + t; const bool hp = t > 0;
    const int u = bh * (T / 32) + ci;
    const float pm = hp ? 1.f : 0.f;
    const bf16* pc = F.PROJ + m * NP + w * 64 + 4 * hi; const bf16* pp = F.PROJ + (hp ? m - 1 : m) * NP + w * 64 + 4 * hi;
    const float* mu = F.shift_mu + w * 64 + 4 * hi;
    const float *pw0 = F.w0 + w * 64 + 4 * hi, *pa0 = F.a0 + w * 64 + 4 * hi, *pkk = F.k_k + w * 64 + 4 * hi, *pka = F.k_a + w * 64 + 4 * hi, *prk = F.r_k + w * 64 + 4 * hi;
#define SH4(dst, COL, MU, OFF) do { const v2u c_ = *(const GAS v2u*)(pc + tok + (COL) + (OFF)), p_ = *(const GAS v2u*)(pp + tok + (COL) + (OFF)); const f32x4 m_ = *(const GAS f32x4*)(mu + tok + (MU) + (OFF)); \
        dst[0] = bflo(c_.x) + (bflo(p_.x) * pm - bflo(c_.x)) * m_.x; dst[1] = bfhi(c_.x) + (bfhi(p_.x) * pm - bfhi(c_.x)) * m_.y; \
        dst[2] = bflo(c_.y) + (bflo(p_.y) * pm - bflo(c_.y)) * m_.z; dst[3] = bfhi(c_.y) + (bfhi(p_.y) * pm - bfhi(c_.y)) * m_.w; } while (0)
    float ss = 0.f;
#pragma unroll
    for (int gq = 0; gq < 8; ++gq) { float k4[4]; SH4(k4, C_K, 512, 8 * gq); const f32x4 kkp = *(const GAS f32x4*)(pkk + tok + 8 * gq);
#pragma unroll
        for (int e = 0; e < 4; ++e) { const float q = k4[e] * kkp[e]; ss += q * q; }
        if (gq & 1) DEP(ss); }
    ss = swap32_sum(ss);
    const float inv = __builtin_amdgcn_rcpf(fmaxf(__builtin_amdgcn_sqrtf(ss), 1e-12f));
    asm volatile("" ::: "memory");
    v4u bz[4], ba[4];
    { const bf16* zc = F.PROJ + m * NP + 8 * hi; const bf16* zp = F.PROJ + (hp ? m - 1 : m) * NP + 8 * hi; const float* zmu = F.shift_mu + 8 * hi;
#pragma unroll
      for (int s = 0; s < 4; ++s) {
#pragma unroll
        for (int which = 0; which < 2; ++which) {
            const int COL = (which ? C_ZA : C_ZW) + 16 * s, MUO = (which ? 1600 : 1536) + 16 * s;
            const v4u c = *(const GAS v4u*)(zc + tok + COL), p = *(const GAS v4u*)(zp + tok + COL); const f32x4 m0 = *(const GAS f32x4*)(zmu + tok + MUO), m1 = *(const GAS f32x4*)(zmu + tok + MUO + 4);
            float z[8];
#pragma unroll
            for (int j = 0; j < 4; ++j) { const float c0 = bflo(c[j]), c1 = bfhi(c[j]); const float mm0 = j < 2 ? m0[2 * j] : m1[2 * j - 4], mm1 = j < 2 ? m0[2 * j + 1] : m1[2 * j - 3];
                z[2 * j] = c0 + (bflo(p[j]) * pm - c0) * mm0; z[2 * j + 1] = c1 + (bfhi(p[j]) * pm - c1) * mm1; }
            if (which == 0) bz[s] = (v4u){cvtpk(tanh_f(z[0]), tanh_f(z[1])), cvtpk(tanh_f(z[2]), tanh_f(z[3])), cvtpk(tanh_f(z[4]), tanh_f(z[5])), cvtpk(tanh_f(z[6]), tanh_f(z[7]))};
            else ba[s] = (v4u){cvtpk(z[0], z[1]), cvtpk(z[2], z[3]), cvtpk(z[4], z[5]), cvtpk(z[6], z[7])};
            if (which == 0) DEP(bz[s][3]); else DEP(ba[s][3]);
        }
      } }
    asm volatile("" ::: "memory");
    v4u fa[4], fb[4], fk[4], fr[4], fv[4]; float rho = 0.f;
    float* gp = Dm.GAM + (size_t)u * 64 + hi * 32;
#define RW_LORA(cb) f32x16 accd = f32x16{}, acca = f32x16{}; _Pragma("unroll") for (int s = 0; s < 4; ++s) { \
        const v4u aD = *(const GAS v4u*)(F.WdT + tok + (size_t)(w * 64 + (cb) * 32 + l31) * 64 + 16 * s + 8 * hi); accd = MFMA32(aD, bz[s], accd); \
        const v4u aA = *(const GAS v4u*)(F.WaT + tok + (size_t)(w * 64 + (cb) * 32 + l31) * 64 + 16 * s + 8 * hi); acca = MFMA32(aA, ba[s], acca); }
#define RW_GROUP(cb, rg) do { constexpr int OFF = 32 * (cb) + 8 * (rg); const int ch0 = OFF + 4 * hi; \
            float rr[4], kk4[4], vv[4]; \
            SH4(rr, C_R, 0, OFF); SH4(kk4, C_K, 512, OFF); SH4(vv, C_V, 1024, OFF); \
            const f32x4 w0v = *(const GAS f32x4*)(pw0 + tok + OFF), a0v = *(const GAS f32x4*)(pa0 + tok + OFF), kkp = *(const GAS f32x4*)(pkk + tok + OFF), kap = *(const GAS f32x4*)(pka + tok + OFF), rkp = *(const GAS f32x4*)(prk + tok + OFF); \
            float xa[4], xb[4], xk[4], xr[4], gg[4], ge[4]; \
            _Pragma("unroll") for (int e = 0; e < 4; ++e) { \
                const float nx = -(w0v[e] + accd[4 * (rg) + e]); const float sp = fmaxf(nx, 0.f) + __logf(1.f + __expf(-fabsf(nx))); \
                const float l2 = -__expf(-sp - 0.5f) * LOG2E; \
                const float g = scan32(l2); \
                const float a = __builtin_amdgcn_rcpf(1.f + __expf(-(a0v[e] + acca[4 * (rg) + e]))); \
                const float kk = kk4[e] * kkp[e] * inv; \
                const float kt = kk4[e] * (1.f + (a - 1.f) * kap[e]); \
                rho += rr[e] * kt * rkp[e]; \
                const float eg = __builtin_amdgcn_exp2f(g), egp = __builtin_amdgcn_exp2f(g - l2), eng = __builtin_amdgcn_rcpf(eg); \
                xa[e] = -kk * egp; xb[e] = kk * a * eng; xk[e] = kt * eng; xr[e] = rr[e] * eg; gg[e] = g; ge[e] = eg; } \
            if (l31 == 31) { *(LAS f32x4*)(wscr + ch0) = (f32x4){gg[0], gg[1], gg[2], gg[3]}; *(GAS f32x4*)(gp + (cb) * 16 + 4 * (rg)) = (f32x4){ge[0], ge[1], ge[2], ge[3]}; } \
            constexpr int s_ = 2 * (cb) + ((rg) >> 1), vg = 2 * ((rg) & 1); \
            fa[s_][vg] = cvtpk(xa[0], xa[1]); fa[s_][vg + 1] = cvtpk(xa[2], xa[3]); \
            fb[s_][vg] = cvtpk(xb[0], xb[1]); fb[s_][vg + 1] = cvtpk(xb[2], xb[3]); \
            fk[s_][vg] = cvtpk(xk[0], xk[1]); fk[s_][vg + 1] = cvtpk(xk[2], xk[3]); \
            fr[s_][vg] = cvtpk(xr[0], xr[1]); fr[s_][vg + 1] = cvtpk(xr[2], xr[3]); \
            fv[s_][vg] = cvtpk(vv[0], vv[1]); fv[s_][vg + 1] = cvtpk(vv[2], vv[3]); \
            if (((rg) & 1) == 1) { PARK(s_) = fv[s_]; PARK(4 + s_) = fr[s_]; } \
            DEP(fa[s_][vg + 1]); DEP(fb[s_][vg + 1]); DEP(fk[s_][vg + 1]); DEP(fr[s_][vg + 1]); DEP(fv[s_][vg + 1]); DEP(rho); } while (0)
    { RW_LORA(0) RW_GROUP(0, 0); RW_GROUP(0, 1); RW_GROUP(0, 2); RW_GROUP(0, 3); }
    { RW_LORA(1) RW_GROUP(1, 0); RW_GROUP(1, 1); RW_GROUP(1, 2); RW_GROUP(1, 3); }
#undef RW_LORA
#undef RW_GROUP
#undef SH4
    LDS_WAIT(); asm volatile("" ::: "memory");
    float EC[2]; EC[0] = __builtin_amdgcn_exp2f(wscr[l31]); EC[1] = __builtin_amdgcn_exp2f(wscr[32 + l31]);
    LDS_WAIT(); asm volatile("" ::: "memory");
    rho = swap32_sum(rho);
    if (hi == 0) Dm.RHO[(size_t)u * 32 + l31] = rho;
    v4u idf[2];
    { const int jst = 4 * ((l31 >> 3) & 1) + (l31 & 3); const bool hm = ((l31 >> 2) & 1) == hi; const unsigned one = 0x3F80u << (16 * (jst & 1));
#pragma unroll
      for (int sig = 0; sig < 2; ++sig) { const bool on = hm && ((l31 >> 4) == sig);
#pragma unroll
          for (int q = 0; q < 4; ++q) idf[sig][q] = (on && (jst >> 1) == q) ? one : 0u; } }
    LDS_WAIT();
    v4u Af[2][2], Vf[2][2];
#pragma unroll
    for (int blk = 0; blk < 2; ++blk) {
        f32x16 za = MFMA32(fa[2 * blk], idf[0], f32x16{}); za = MFMA32(fa[2 * blk + 1], idf[1], za);
        f32x16 zv = MFMA32(PARK(2 * blk), idf[0], f32x16{}); zv = MFMA32(PARK(2 * blk + 1), idf[1], zv);
        f32x16 zb = MFMA32(fb[2 * blk], idf[0], f32x16{}); zb = MFMA32(fb[2 * blk + 1], idf[1], zb);
        f32x16 zk = MFMA32(fk[2 * blk], idf[0], f32x16{}); zk = MFMA32(fk[2 * blk + 1], idf[1], zk);
        zb = zb * EC[blk]; zk = zk * EC[blk];
#pragma unroll
        for (int s = 0; s < 2; ++s) { Af[blk][s] = FRAGACC(za, s); Vf[blk][s] = FRAGACC(zv, s); PARK(8 + 2 * blk + s) = FRAGACC(zb, s); PARK(12 + 2 * blk + s) = FRAGACC(zk, s); }
        __builtin_amdgcn_sched_barrier(0);
    }
    f32x16 Aab = f32x16{}, TT = f32x16{}, AakT = f32x16{}, ArbT = f32x16{}, ArkT = f32x16{};
#pragma unroll
    for (int s = 0; s < 4; ++s) { const v4u frs = PARK(4 + s); Aab = MFMA32(fa[s], fb[s], Aab); TT = MFMA32(fb[s], fa[s], TT); AakT = MFMA32(fk[s], fa[s], AakT); ArbT = MFMA32(fb[s], frs, ArbT); ArkT = MFMA32(fk[s], frs, ArkT); }
#pragma unroll
    for (int r = 0; r < 16; ++r) { const int rowi = (r & 3) + 8 * (r >> 2) + 4 * hi;
        Aab[r] = (l31 < rowi) ? Aab[r] : 0.f; TT[r] = (rowi < l31) ? TT[r] : 0.f; AakT[r] = (rowi < l31) ? AakT[r] : 0.f;
        ArbT[r] = (rowi <= l31) ? ArbT[r] : 0.f; ArkT[r] = (rowi <= l31) ? ArkT[r] : 0.f; }
    v4u AakTf[2], ArbTf[2], ArkTf[2];
#pragma unroll
    for (int s = 0; s < 2; ++s) { AakTf[s] = FRAGACC(AakT, s); ArbTf[s] = FRAGACC(ArbT, s); ArkTf[s] = FRAGACC(ArkT, s); }
    __builtin_amdgcn_sched_barrier(0);
    v4u Xf[2], XTf[2], TTf[2];
#pragma unroll
    for (int s = 0; s < 2; ++s) { Xf[s] = FRAGACC(Aab, s); XTf[s] = FRAGACC(TT, s); }
#pragma unroll
    for (int r = 0; r < 16; ++r) { const int rowi = (r & 3) + 8 * (r >> 2) + 4 * hi; TT[r] += (rowi == l31) ? 1.f : 0.f; }
#pragma unroll
    for (int it = 0; it < 4; ++it) {
        f32x16 X2 = MFMA32(XTf[0], Xf[0], f32x16{}); X2 = MFMA32(XTf[1], Xf[1], X2);
        if (it < 3) { f32x16 X2T = MFMA32(Xf[0], XTf[0], f32x16{}); X2T = MFMA32(Xf[1], XTf[1], X2T);
#pragma unroll
            for (int s = 0; s < 2; ++s) XTf[s] = FRAGACC(X2T, s); }
#pragma unroll
        for (int s = 0; s < 2; ++s) { Xf[s] = FRAGACC(X2, s); TTf[s] = FRAGACC(TT, s); }
        TT = MFMA32(Xf[0], TTf[0], TT); TT = MFMA32(Xf[1], TTf[1], TT);
        __builtin_amdgcn_sched_barrier(0);
    }
#pragma unroll
    for (int s = 0; s < 2; ++s) TTf[s] = FRAGACC(TT, s);
    v4u Wf[2][2], Uf[2][2];
#pragma unroll
    for (int blk = 0; blk < 2; ++blk) {
        f32x16 av = MFMA32(AakTf[0], Vf[blk][0], f32x16{}); av = MFMA32(AakTf[1], Vf[blk][1], av);
        const v4u avf0 = FRAGACC(av, 0), avf1 = FRAGACC(av, 1);
        f32x16 uu = MFMA32(TTf[0], avf0, f32x16{}); uu = MFMA32(TTf[1], avf1, uu);
        f32x16 ww = MFMA32(TTf[0], Af[blk][0], f32x16{}); ww = MFMA32(TTf[1], Af[blk][1], ww);
#pragma unroll
        for (int s = 0; s < 2; ++s) { Wf[blk][s] = FRAGACC(ww, s); Uf[blk][s] = FRAGACC(uu, s); }
        __builtin_amdgcn_sched_barrier(0);
    }
    v4u* QFp = Dm.QF + (size_t)u * 256 + lane; v4u* YDp = Dm.YD + (size_t)u * 256 + lane;
#pragma unroll
    for (int blk = 0; blk < 2; ++blk) {
        f32x16 q;
#pragma unroll
        for (int s = 0; s < 2; ++s)
            { const v4u frs = PARK(4 + 2 * blk + s);
#pragma unroll
              for (int j = 0; j < 4; ++j) { q[8 * s + 2 * j] = bflo(frs[j]); q[8 * s + 2 * j + 1] = bfhi(frs[j]); } }
        q = MFMA32(Wf[blk][0], ArbTf[0], q); q = MFMA32(Wf[blk][1], ArbTf[1], q);
        *(GAS v4u*)(QFp + (2 * blk) * 64) = FRAGACC(q, 0); *(GAS v4u*)(QFp + (2 * blk + 1) * 64) = FRAGACC(q, 1);
        f32x16 y = MFMA32(Uf[blk][0], ArbTf[0], f32x16{}); y = MFMA32(Uf[blk][1], ArbTf[1], y); y = MFMA32(Vf[blk][0], ArkTf[0], y); y = MFMA32(Vf[blk][1], ArkTf[1], y);
        *(GAS v4u*)(YDp + (2 * blk) * 64) = FRAGACC(y, 0); *(GAS v4u*)(YDp + (2 * blk + 1) * 64) = FRAGACC(y, 1);
        __builtin_amdgcn_sched_barrier(0);
    }
    v4u* PFp = Dm.PF + (size_t)u * 512 + lane; v4u* DDp = Dm.DD + (size_t)u * 512 + lane;
#pragma unroll
    for (int c1 = 0; c1 < 2; ++c1)
#pragma unroll
        for (int cb = 0; cb < 2; ++cb) {
            f32x16 p = MFMA32(Wf[c1][0], PARK(8 + 2 * cb), f32x16{}); p = MFMA32(Wf[c1][1], PARK(8 + 2 * cb + 1), p);
            *(GAS v4u*)(PFp + (cb * 4 + 2 * c1) * 64) = FRAGACC(p, 0); *(GAS v4u*)(PFp + (cb * 4 + 2 * c1 + 1) * 64) = FRAGACC(p, 1);
            __builtin_amdgcn_sched_barrier(0);
        }
#pragma unroll
    for (int cb = 0; cb < 2; ++cb)
#pragma unroll
        for (int ib = 0; ib < 2; ++ib) {
            f32x16 d = MFMA32(PARK(8 + 2 * cb), Uf[ib][0], f32x16{}); d = MFMA32(PARK(8 + 2 * cb + 1), Uf[ib][1], d); d = MFMA32(PARK(12 + 2 * cb), Vf[ib][0], d); d = MFMA32(PARK(12 + 2 * cb + 1), Vf[ib][1], d);
            *(GAS v4u*)(DDp + ((cb * 2 + ib) * 2) * 64) = FRAGACC(d, 0); *(GAS v4u*)(DDp + ((cb * 2 + ib) * 2 + 1) * 64) = FRAGACC(d, 1);
            __builtin_amdgcn_sched_barrier(0);
        }
}

#undef PARK
#undef DEP
constexpr int RB_PF = 0, RB_DD = 8192, RB_QF = 16384, RB_YD = 20480, RB_GAM = 24576, RB_BUF = 24832, RB_STAT = 2 * RB_BUF, RB_Y = RB_STAT + 1024;
__device__ __forceinline__ void unpack16(const v4u a, const v4u b, f32x16& o) {
#pragma unroll
    for (int j = 0; j < 4; ++j) { o[2 * j] = bflo(a[j]); o[2 * j + 1] = bfhi(a[j]); o[8 + 2 * j] = bflo(b[j]); o[8 + 2 * j + 1] = bfhi(b[j]); }
}
struct RbStage { v4u p[4], d[4], q[2], y[2], g; };
struct RbEpi { v2u vc[2], vp[2], ga[2]; float rho; };
__device__ __forceinline__ void rwkvB_unit(Frame& F, const RwDump& Dm, int bh) {
    int lane = mk_lane(); asm volatile("" : "+v"(lane));
    const int wid = F.wave, tid = wid * 64 + lane, hi = lane >> 5, l31 = lane & 31, b = bh >> 3, h = bh & 7;
    LAS unsigned char* lds = F.lds + RING_OFF;
    const size_t u0 = (size_t)bh * (T / 32);
    constexpr int NS = T / 32;
    LAS float* stat = (LAS float*)(lds + RB_STAT);
    LAS float* ybuf = (LAS float*)(lds + RB_Y);
    const int stid = tid - 384;
#define ST_LOAD(X, ci_) do { { const size_t u_ = u0 + ((ci_) < NS ? (ci_) : NS - 1); \
        _Pragma("unroll") for (int j = 0; j < 4; ++j) { X.p[j] = *(const GAS v4u*)(Dm.PF + u_ * 512 + j * 128 + stid); X.d[j] = *(const GAS v4u*)(Dm.DD + u_ * 512 + j * 128 + stid); } \
        _Pragma("unroll") for (int j = 0; j < 2; ++j) { X.q[j] = *(const GAS v4u*)(Dm.QF + u_ * 256 + j * 128 + stid); X.y[j] = *(const GAS v4u*)(Dm.YD + u_ * 256 + j * 128 + stid); } \
        if (stid < 16) X.g = *(const GAS v4u*)((const v4u*)(Dm.GAM + u_ * 64) + stid); } } while (0)
#define ST_STORE(X, buf_) do { LAS unsigned char* b_ = lds + (buf_) * RB_BUF; \
        _Pragma("unroll") for (int j = 0; j < 4; ++j) { *(LAS v4u*)(b_ + RB_PF + (j * 128 + stid) * 16) = X.p[j]; *(LAS v4u*)(b_ + RB_DD + (j * 128 + stid) * 16) = X.d[j]; } \
        _Pragma("unroll") for (int j = 0; j < 2; ++j) { *(LAS v4u*)(b_ + RB_QF + (j * 128 + stid) * 16) = X.q[j]; *(LAS v4u*)(b_ + RB_YD + (j * 128 + stid) * 16) = X.y[j]; } \
        if (stid < 16) *(LAS v4u*)(b_ + RB_GAM + stid * 16) = X.g; } while (0)
    const int eib = (wid - 2) & 1, eh = ((wid - 2) >> 1) & 1;
    const bf16* epc = F.PROJ + (size_t)b * T * NP + h * 64 + 32 * eib + 16 * eh + 4 * hi;
#define EP_LOAD(X, cj_) do { { const int tt_ = ((cj_) < NS ? (cj_) : NS - 1) * 32 + l31; const bf16* pc_ = epc + (size_t)tt_ * NP; const bf16* pp_ = epc + (size_t)(tt_ > 0 ? tt_ - 1 : 0) * NP; \
        _Pragma("unroll") for (int rg = 0; rg < 2; ++rg) { X.vc[rg] = *(const GAS v2u*)(pc_ + C_V + 8 * rg); X.vp[rg] = *(const GAS v2u*)(pp_ + C_V + 8 * rg); X.ga[rg] = *(const GAS v2u*)(pc_ + C_GA + 8 * rg); } \
        X.rho = Dm.RHO[(u0 + ((cj_) < NS ? (cj_) : NS - 1)) * 32 + l31]; } } while (0)
#define EP_RUN(X, cj_) do { const int par_ = (cj_) & 1; \
        const float s1_ = stat[((par_ * 2 + 0) * 32 + l31) * 2] + stat[((par_ * 2 + 1) * 32 + l31) * 2], s2_ = stat[((par_ * 2 + 0) * 32 + l31) * 2 + 1] + stat[((par_ * 2 + 1) * 32 + l31) * 2 + 1]; \
        const float mean_ = s1_ * (1.f / 64.f), var_ = fmaxf(s2_ * (1.f / 64.f) - mean_ * mean_, 0.f), rstd_ = __builtin_amdgcn_rsqf(var_ + 64e-5f); \
        const int tt_ = (cj_) * 32 + l31; const size_t mm_ = (size_t)b * T + tt_; const float pm_ = tt_ > 0 ? 1.f : 0.f; \
        const LAS float* yb_ = ybuf + (par_ * 2 + eib) * 1024 + lane; \
        _Pragma("unroll") for (int rg = 0; rg < 2; ++rg) { const int hc_ = h * 64 + 32 * eib + 16 * eh + 8 * rg + 4 * hi; \
            const f32x4 mu_ = emu[rg], lw_ = elw[rg], lb_ = elb[rg]; \
            const float vc_[4] = {bflo(X.vc[rg].x), bfhi(X.vc[rg].x), bflo(X.vc[rg].y), bfhi(X.vc[rg].y)}, vp_[4] = {bflo(X.vp[rg].x), bfhi(X.vp[rg].x), bflo(X.vp[rg].y), bfhi(X.vp[rg].y)}; \
            const float g4_[4] = {bflo(X.ga[rg].x), bfhi(X.ga[rg].x), bflo(X.ga[rg].y), bfhi(X.ga[rg].y)}; float o_[4]; \
            _Pragma("unroll") for (int e = 0; e < 4; ++e) { const float vv_ = vc_[e] + (vp_[e] * pm_ - vc_[e]) * mu_[e]; \
                const float yn_ = (yb_[(4 * (2 * eh + rg) + e) * 64] - mean_) * rstd_ * lw_[e] + lb_[e] + X.rho * vv_; o_[e] = yn_ * g4_[e] * __builtin_amdgcn_rcpf(1.f + __expf(-g4_[e])); } \
            *(GAS v2u*)(F.MIX + mm_ * D + hc_) = (v2u){cvtpk(o_[0], o_[1]), cvtpk(o_[2], o_[3])}; } } while (0)
    f32x16 S[2]; S[0] = f32x16{}; S[1] = f32x16{};
    const int ib = wid & 1;
#define CONS(ci_) do { const LAS unsigned char* bb = lds + ((ci_) & 1) * RB_BUF; \
        v4u Sf[4]; _Pragma("unroll") for (int s = 0; s < 4; ++s) Sf[s] = FRAGACC(S[s >> 1], s & 1); \
        f32x16 y; unpack16(*(const LAS v4u*)(bb + RB_YD + ((2 * ib) * 64 + lane) * 16), *(const LAS v4u*)(bb + RB_YD + ((2 * ib + 1) * 64 + lane) * 16), y); \
        _Pragma("unroll") for (int rb = 0; rb < 2; ++rb) { \
            f32x16 acc; unpack16(*(const LAS v4u*)(bb + RB_DD + (((rb * 2 + ib) * 2) * 64 + lane) * 16), *(const LAS v4u*)(bb + RB_DD + (((rb * 2 + ib) * 2 + 1) * 64 + lane) * 16), acc); \
            const LAS f32x4* gm = (const LAS f32x4*)(bb + RB_GAM + (hi * 32 + rb * 16) * 4); \
            _Pragma("unroll") for (int q = 0; q < 4; ++q) { const f32x4 gv = gm[q]; _Pragma("unroll") for (int e = 0; e < 4; ++e) acc[4 * q + e] += gv[e] * S[rb][4 * q + e]; } \
            _Pragma("unroll") for (int s = 0; s < 4; ++s) acc = MFMA32(*(const LAS v4u*)(bb + RB_PF + ((rb * 4 + s) * 64 + lane) * 16), Sf[s], acc); \
            S[rb] = acc; } \
        _Pragma("unroll") for (int s = 0; s < 4; ++s) y = MFMA32(Sf[s], *(const LAS v4u*)(bb + RB_QF + (s * 64 + lane) * 16), y); \
        float s1 = 0.f, s2 = 0.f; LAS float* yb_ = ybuf + (((ci_) & 1) * 2 + ib) * 1024 + lane; \
        _Pragma("unroll") for (int r = 0; r < 16; ++r) { s1 += y[r]; s2 += y[r] * y[r]; yb_[r * 64] = y[r]; } \
        s1 = swap32_sum(s1); s2 = swap32_sum(s2); \
        if (hi == 0) { stat[((((ci_) & 1) * 2 + ib) * 32 + l31) * 2] = s1; stat[((((ci_) & 1) * 2 + ib) * 32 + l31) * 2 + 1] = s2; } } while (0)
#define RB_BAR() do { asm volatile("s_waitcnt lgkmcnt(0)" ::: "memory"); __builtin_amdgcn_s_barrier(); asm volatile("" ::: "memory"); } while (0)
    if (wid < 2) {
        RB_BAR();
#pragma unroll 1
        for (int k = 0; k < NS; ++k) { CONS(k); RB_BAR(); }
        RB_BAR();
    } else if (wid >= 6) {
        RbStage sA, sB, sC;
        ST_LOAD(sA, 0); ST_LOAD(sB, 1); ST_LOAD(sC, 2); ST_STORE(sA, 0); ST_LOAD(sA, 3);
        RB_BAR();
#define ST_STEP(k_, SN) do { ST_STORE(SN, ((k_) + 1) & 1); ST_LOAD(SN, (k_) + 4); RB_BAR(); } while (0)
#pragma unroll 1
        for (int k = 0; k < NS - 1; k += 3) { ST_STEP(k, sB); ST_STEP(k + 1, sC); ST_STEP(k + 2, sA); }
        ST_STEP(NS - 1, sB);
        RB_BAR();
#undef ST_STEP
    } else {
        RbEpi eA, eB, eC, eD; f32x4 emu[2], elw[2], elb[2];
#pragma unroll
        for (int rg = 0; rg < 2; ++rg) { const int hc_ = h * 64 + 32 * eib + 16 * eh + 8 * rg + 4 * hi; emu[rg] = *(const GAS f32x4*)(F.shift_mu + 1024 + hc_); elw[rg] = *(const GAS f32x4*)(F.ln_w + hc_); elb[rg] = *(const GAS f32x4*)(F.ln_b + hc_); }
        EP_LOAD(eA, 0); EP_LOAD(eB, 1); EP_LOAD(eC, 2);
        RB_BAR();
        EP_LOAD(eD, 3); RB_BAR();
#define EP_STEP(k_, EP) do { EP_RUN(EP, (k_) - 1); EP_LOAD(EP, (k_) + 3); RB_BAR(); } while (0)
#pragma unroll 1
        for (int k = 1; k <= NS; k += 4) { EP_STEP(k, eA); EP_STEP(k + 1, eB); EP_STEP(k + 2, eC); EP_STEP(k + 3, eD); }
#undef EP_STEP
    }
#undef RB_BAR
#undef ST_LOAD
#undef ST_STORE
#undef EP_LOAD
#undef EP_RUN
#undef CONS
}
constexpr int AT_KB = 64 * 256, AT_VB = 64 * 256, AT_BUF = AT_KB + AT_VB, AT_QOFF = 2 * AT_KB + 3 * AT_VB;
__device__ __forceinline__ s16x4 vtr(const LAS unsigned char* p) { typedef short v4i16_t __attribute__((ext_vector_type(4))); return __builtin_bit_cast(s16x4, __builtin_amdgcn_ds_read_tr16_b64_v4i16((LAS v4i16_t*)p)); }
__device__ __forceinline__ void attn_unit(Frame& F, int b, int h, int qb) {
    int lane = mk_lane(); asm volatile("" : "+v"(lane));
    const int wid = F.wave, tid = wid * 64 + lane, l31 = lane & 31, hi = lane >> 5, map = wid >> 2, qs = wid & 3;
    LAS unsigned char* lds = F.lds + RING_OFF;
    const float slope2 = exp2f(-2.f * (float)(h + 1)) * LOG2E, shift2 = __uint_as_float(F.MISC[15]);
    const int q0 = qb * 128, qrow = q0 + 32 * qs + l31;
    const size_t mrow = (size_t)b * T + qrow;
    LAS bf16x8* qpark = (LAS bf16x8*)(lds + AT_QOFF + wid * 4096) + lane;
    { const bf16* qp = F.PROJ + mrow * NP + C_DQ + h * 128 + map * 64 + 8 * hi;
#pragma unroll
      for (int s = 0; s < 4; ++s) qpark[s * 64] = *(const GAS bf16x8*)(qp + 16 * s); }
    const bf16* kg = F.PROJ + (size_t)b * T * NP + C_DK + h * 128;
    const bf16* vg = F.PROJ + (size_t)b * T * NP + C_DV + h * 128;
    const int NT = 2 * qb + 2, tl = 2 * qb + (qs >> 1);
    const int Wk = (int)__builtin_ceilf((2.f * shift2 + 32.2f) / slope2);
    const int tf = __builtin_amdgcn_readfirstlane(max(0, (qb * 128 - Wk) >> 6));
    constexpr int AT_V0 = 2 * AT_KB;
    const int drow0 = 4 * wid + (lane >> 4), drow1 = drow0 + 32, dch = lane & 15;
    const unsigned ksrc0 = (unsigned)(drow0 * NP + ((dch ^ (drow0 & 15)) * 8)), ksrc1 = (unsigned)(drow1 * NP + ((dch ^ (drow1 & 15)) * 8));
    const unsigned vsrc0 = (unsigned)(drow0 * NP + ((dch ^ ((drow0 & 3) << 2)) * 8)), vsrc1 = (unsigned)(drow1 * NP + ((dch ^ ((drow1 & 3) << 2)) * 8));
#define AT_DMA(t_, kb_, v3_) do { const size_t tb_ = (size_t)(64 * (t_)) * NP; LAS unsigned char* bk_ = lds + (kb_) * AT_KB + wid * 1024; LAS unsigned char* bv_ = lds + AT_V0 + (v3_) * AT_VB + wid * 1024; \
        __builtin_amdgcn_global_load_lds((const unsigned*)(kg + tb_ + ksrc0), (LAS unsigned*)bk_, 16, 0, 0); __builtin_amdgcn_global_load_lds((const unsigned*)(kg + tb_ + ksrc1), (LAS unsigned*)(bk_ + 8192), 16, 0, 0); \
        __builtin_amdgcn_global_load_lds((const unsigned*)(vg + tb_ + vsrc0), (LAS unsigned*)bv_, 16, 0, 0); __builtin_amdgcn_global_load_lds((const unsigned*)(vg + tb_ + vsrc1), (LAS unsigned*)(bv_ + 8192), 16, 0, 0); } while (0)
    f32x16 o[4];
#pragma unroll
    for (int vb = 0; vb < 4; ++vb) o[vb] = f32x16{};
    float lsum = 0.f;
    AT_DMA(tf, tf & 1, tf % 3);
    __syncthreads();
    const int G = lane >> 4, qq = (lane & 15) >> 2, pp = lane & 3;
    const int vrow = (4 * hi + qq) * 256 + 8 * (pp & 1), vch = 2 * (G & 1) + (pp >> 1);
    v4u pw[4];
#define SBAR_() __builtin_amdgcn_sched_barrier(0)
#define AT_QK(t) do { \
            const LAS unsigned char* Kb = lds + ((t) & 1) * AT_KB; \
            float sl_ = slope2; asm volatile("" : "+v"(sl_));     \
            const float base = sl_ * (float)(64 * (t) + 4 * hi - qrow) - shift2; \
            float ls = 0.f; \
            _Pragma("unroll") for (int hf = 0; hf < 2; ++hf) {        \
                f32x16 p; \
                _Pragma("unroll") for (int r = 0; r < 16; ++r) p[r] = __builtin_fmaf(sl_, (float)(32 * hf + (r & 3) + 8 * (r >> 2)), base); \
                _Pragma("unroll") for (int s = 0; s < 4; ++s) { \
                    const bf16x8 a0 = *(const LAS bf16x8*)(Kb + (32 * hf + l31) * 256 + (((map * 8 + 2 * s + hi) ^ (l31 & 15)) * 16)); \
                    p = __builtin_amdgcn_mfma_f32_32x32x16_bf16(a0, qpark[s * 64], p, 0, 0, 0); } \
                if ((t) == tl) { \
                    _Pragma("unroll") for (int r = 0; r < 16; ++r) { const int ki = 64 * (t) + 32 * hf + 4 * hi + (r & 3) + 8 * (r >> 2); if (ki > qrow) p[r] = -1e30f; } } \
                _Pragma("unroll") for (int r = 0; r < 16; ++r) { p[r] = __builtin_amdgcn_exp2f(p[r]); ls += p[r]; } \
                pw[2 * hf] = (v4u){cvtpk(p[0], p[1]), cvtpk(p[2], p[3]), cvtpk(p[4], p[5]), cvtpk(p[6], p[7])}; \
                pw[2 * hf + 1] = (v4u){cvtpk(p[8], p[9]), cvtpk(p[10], p[11]), cvtpk(p[12], p[13]), cvtpk(p[14], p[15])}; } \
            lsum += ls; } while (0)
#define AT_VRD(dst, ks, vb0) do { _Pragma("unroll") for (int vb = (vb0); vb < (vb0) + 2; ++vb) { const LAS unsigned char* a_ = Vb + vrow + ((4 * vb + vch) ^ (qq << 2)) * 16 + (32 * ((ks) >> 1) + 16 * ((ks) & 1)) * 256; \
        dst[2 * (vb - (vb0))] = vtr(a_); dst[2 * (vb - (vb0)) + 1] = vtr(a_ + 8 * 256); } } while (0)
#define AT_PV(src, pwk, vb0) do { _Pragma("unroll") for (int vb = (vb0); vb < (vb0) + 2; ++vb) { const int j_ = 2 * (vb - (vb0)); \
        const bf16x8 vf = (bf16x8){src[j_][0], src[j_][1], src[j_][2], src[j_][3], src[j_ + 1][0], src[j_ + 1][1], src[j_ + 1][2], src[j_ + 1][3]}; \
        o[vb] = __builtin_amdgcn_mfma_f32_32x32x16_bf16(vf, __builtin_bit_cast(bf16x8, pwk), o[vb], 0, 0, 0); } } while (0)
#define AT_PVV(v3_) do { const LAS unsigned char* Vb = lds + AT_V0 + (v3_) * AT_VB; s16x4 vA[4], vB[4]; \
            AT_VRD(vA, 0, 0); SBAR_(); AT_VRD(vB, 0, 2); SBAR_(); \
            AT_PV(vA, pw[0], 0); SBAR_(); AT_VRD(vA, 1, 0); SBAR_(); AT_PV(vB, pw[0], 2); SBAR_(); AT_VRD(vB, 1, 2); SBAR_(); \
            AT_PV(vA, pw[1], 0); SBAR_(); AT_VRD(vA, 2, 0); SBAR_(); AT_PV(vB, pw[1], 2); SBAR_(); AT_VRD(vB, 2, 2); SBAR_(); \
            AT_PV(vA, pw[2], 0); SBAR_(); AT_VRD(vA, 3, 0); SBAR_(); AT_PV(vB, pw[2], 2); SBAR_(); AT_VRD(vB, 3, 2); SBAR_(); \
            AT_PV(vA, pw[3], 0); SBAR_(); AT_PV(vB, pw[3], 2); } while (0)
    if (map == 0) {
        int v3 = tf % 3;
#pragma unroll 1
        for (int t = tf; t < NT; ++t) { const int vn = v3 == 2 ? 0 : v3 + 1;
            if (t + 1 < NT) AT_DMA(t + 1, (t + 1) & 1, vn);
            if (t <= tl) { AT_QK(t); AT_PVV(v3); }
            __syncthreads(); v3 = vn; }
    } else {
        int v3 = tf % 3;
#pragma unroll 1
        for (int t = tf; t < NT; ++t) { const int vp = v3 == 0 ? 2 : v3 - 1, vn = v3 == 2 ? 0 : v3 + 1;
            if (t + 1 < NT) AT_DMA(t + 1, (t + 1) & 1, vn);
            if (t > tf && t - 1 <= tl) AT_PVV(vp);
            if (t <= tl) AT_QK(t);
            __syncthreads(); v3 = vn; }
        if (NT - 1 <= tl) { const int vp = v3 == 0 ? 2 : v3 - 1; AT_PVV(vp); }
    }
#undef AT_PVV
#undef AT_QK
#undef AT_VRD
#undef AT_PV
#undef SBAR_
#undef AT_DMA
    __syncthreads();
    const float ltot = swap32_sum(lsum);
    LAS float* X = (LAS float*)lds;
    if (map == 1) {
        const float sc = __uint_as_float(F.MISC[14]) / ltot;
#pragma unroll
        for (int vb = 0; vb < 4; ++vb)
#pragma unroll
            for (int r = 0; r < 16; ++r) X[(qs * 64 + vb * 16 + r) * 64 + lane] = o[vb][r] * sc;
    }
    __syncthreads();
    if (map == 0) {
        const float il = 1.f / ltot; float ss = 0.f;
#pragma unroll
        for (int vb = 0; vb < 4; ++vb)
#pragma unroll
            for (int r = 0; r < 16; ++r) { const float v = o[vb][r] * il - X[(qs * 64 + vb * 16 + r) * 64 + lane]; o[vb][r] = v; ss += v * v; }
        ss = swap32_sum(ss);
        const float rn = (1.f / sqrtf(ss * (1.f / 128.f) + 1e-5f)) * (1.f - LAMBDA_INIT);
        int etok = 0; asm volatile("" : "+v"(etok));
        const int lane_e = mk_lane(), hi = lane_e >> 5;
        const size_t mrow_e = (size_t)b * T + qb * 128 + 32 * qs + (lane_e & 31);
        const bf16* gp = F.PROJ + mrow_e * NP + C_GB + h * 128;
        bf16* op = F.MIX + mrow_e * D + 512 + h * 128;
#pragma unroll
        for (int vb = 0; vb < 4; ++vb)
#pragma unroll
            for (int rg = 0; rg < 4; ++rg) {
                const int vc = 32 * vb + 8 * rg + 4 * hi + etok;
                const v2u gw = *(const GAS v2u*)(gp + vc); const f32x4 sg = *(const GAS f32x4*)(F.subln_g + vc);
                const float g4[4] = {bflo(gw.x), bfhi(gw.x), bflo(gw.y), bfhi(gw.y)}; float ov[4];
#pragma unroll
                for (int e = 0; e < 4; ++e) ov[e] = o[vb][4 * rg + e] * rn * sg[e] * g4[e] / (1.f + __expf(-g4[e]));
                const unsigned w1_ = cvtpk(ov[2], ov[3]);
                *(GAS v2u*)(op + vc) = (v2u){cvtpk(ov[0], ov[1]), w1_};
                asm volatile("" : "+v"(etok) : "v"(w1_));
            }
    }
    __syncthreads();
}
#ifndef DBL
#define DBL 0
#endif
constexpr int CW_QUEUE = 8192;
constexpr int QX_RW = 8, QX_AT = 64, QX_ALL = QX_RW + QX_AT;
__device__ __forceinline__ void p3_queue(Frame& F, const RwDump& Dm) {
    const int ql = mk_lane();
    const float l1 = wave_sum(F.lq1[ql] * F.lk1[ql]), l2 = wave_sum(F.lq2[ql] * F.lk2[ql]);
    const float lam = __uint_as_float(__builtin_amdgcn_readfirstlane(__float_as_uint(__expf(l1) - __expf(l2) + LAMBDA_INIT)));
    float gq = fabsf(F.qn_g[ql]), gk = fabsf(F.kn_g[ql]);
#pragma unroll
    for (int o = 1; o < 64; o <<= 1) { gq = fmaxf(gq, __shfl_xor(gq, o)); gk = fmaxf(gk, __shfl_xor(gk, o)); }
    const float shift2 = __uint_as_float(__builtin_amdgcn_readfirstlane(__float_as_uint(8.f * gq * gk * LOG2E)));
    if (F.wave == 0 && mk_lane() == 0) { F.MISC[14] = __float_as_uint(lam); F.MISC[15] = __float_as_uint(shift2); }
    __syncthreads();
#ifdef Q_BLK
    const int x0 = (int)(blockIdx.x & 7);
#else
    const int x0 = (int)(xb_xcc_id() & 7u);
#endif
#pragma unroll 1
    for (int dx = 0; dx < 8; ++dx) {
        const int xq = (x0 + dx) & 7;
        for (;;) {
            if (F.wave == 0 && mk_lane() == 0) F.MISC[12] = __hip_atomic_fetch_add(F.ctl + CW_QUEUE + 64 * xq, 1u, RLX_AGENT);
            __syncthreads();
            const int item = __builtin_amdgcn_readfirstlane((int)F.MISC[12]);
            __syncthreads();
            if (item >= QX_ALL) break;
            if (item < QX_RW) {
#ifndef NO_RWB
                rwkvB_unit(F, Dm, xq * 8 + item);
#endif
 if (DBL & 64) rwkvB_unit(F, Dm, xq * 8 + item); }
            else { const int idx = item - QX_RW, h = 3 - (idx >> 4), qb = 15 - (idx & 15);
#pragma unroll 1
#ifndef NO_ATT
                for (int rep = 0; rep < ((DBL & 32) ? 2 : 1); ++rep) attn_unit(F, xq, h, qb);
#endif
            }
        }
    }
}

struct Args { const float* in[21]; float* out; unsigned char* ws; int ph_lo, ph_hi; };
__global__ void __launch_bounds__(NWAVES * 64, 2) hymba_fwd(Args args) {
    extern __shared__ __attribute__((aligned(16))) unsigned char lds[];
    Frame F;
    F.lds = (LAS unsigned char*)lds;
    F.MISC = (volatile LAS unsigned*)(F.lds + MISC_OFF);
    F.wave = __builtin_amdgcn_readfirstlane((int)threadIdx.x >> 6); F.lane = mk_lane(); F.tid = F.wave * 64 + F.lane;
    F.G = gridDim.x; { const int bx = blockIdx.x; F.vcu = (F.G % 8 == 0) ? (bx % 8) * (F.G / 8) + bx / 8 : bx; }
    unsigned char* ws = args.ws;
    F.ctl = (gu32*)(ws + WS_CTL);
    F.x = args.in[0]; F.norm_g = args.in[1]; F.w_in = args.in[2]; F.shift_mu = args.in[3]; F.w0 = args.in[4]; F.w_decay_up = args.in[5]; F.a0 = args.in[6]; F.w_iclr_up = args.in[7];
    F.k_k = args.in[8]; F.k_a = args.in[9]; F.r_k = args.in[10]; F.ln_w = args.in[11]; F.ln_b = args.in[12]; F.qn_g = args.in[13]; F.kn_g = args.in[14];
    F.lq1 = args.in[15]; F.lk1 = args.in[16]; F.lq2 = args.in[17]; F.lk2 = args.in[18]; F.subln_g = args.in[19]; F.w_out = args.in[20]; F.out = args.out;
    F.WinT = (bf16*)(ws + WS_WIN); F.WoutT = (bf16*)(ws + WS_WOUT); F.WdT = (bf16*)(ws + WS_WD); F.WaT = (bf16*)(ws + WS_WA);
    F.XN = (bf16*)(ws + WS_XN); F.PROJ = (bf16*)(ws + WS_PROJ); F.MIX = (bf16*)(ws + WS_MIX);
    for (int u = F.tid; u < (LDS_BYTES - LDSCTL_OFF) / 4; u += NWAVES * 64) ((LAS unsigned*)(F.lds + LDSCTL_OFF))[u] = 0u;
    __syncthreads();
    XcdBarrier bar; bar.bar = (unsigned*)(F.ctl + CW_BAR); bar.x = 0; bar.st = nullptr; bar.wave = F.wave;
    if (MK_N_LAUNCHES == 1) bar = xcd_barrier_post((unsigned*)(F.ctl + CW_BAR), F.MISC + 8, F.wave);
#define GRID_BAR() do { if (MK_N_LAUNCHES == 1) xcd_barrier(bar); } while (0)
    const int lo = args.ph_lo, hi = args.ph_hi;
#define IN(k) (lo <= (k) && (k) < hi)
#define BOTH(k) (IN(k) && IN((k) + 1))
#ifndef SKIP
#define SKIP 0
#endif
    if (IN(0) && !(SKIP & 1)) { p0_prologue(F); if (DBL & 1) { GRID_BAR(); p0_prologue(F); } if (BOTH(0)) GRID_BAR(); }
    if (IN(1) && !(SKIP & 2)) {
        pg8::Gemm g{F.XN, F.WinT, M, NP, D}; pg8::StaticOrder S; S.init(M, NP, F.G, (int)blockIdx.x);
        pg8::EpiBf16S E{F.PROJ, NP};
        pg8::gemm_phase<pg8::EpiBf16S, pg8::StaticOrder, true, true>(F.lds + RING_OFF, g, S, E, F.wave);
        if (DBL & 2) { GRID_BAR(); pg8::gemm_phase<pg8::EpiBf16S, pg8::StaticOrder, true, true>(F.lds + RING_OFF, g, S, E, F.wave); }
        if (BOTH(1)) GRID_BAR();
    }
    RwDump Dm; { unsigned char* so = (unsigned char*)args.out; Dm.PF = (v4u*)so; Dm.DD = (v4u*)(so + 32 * MiB); Dm.QF = (v4u*)(ws + WS_XN); Dm.YD = (v4u*)(ws + WS_XN + 16 * MiB);
        Dm.GAM = (float*)(ws + WS_END); Dm.RHO = (float*)(ws + WS_END + 1 * MiB); }
    if (IN(2) && !(SKIP & 4)) {
        LAS float* wscr = (LAS float*)(F.lds + LDSCTL_OFF + 1024) + F.wave * 64;
#pragma unroll 1
        for (int p = F.vcu; p < BATCH * (T / 32); p += F.G) rwkvA_unit(F, Dm, (p >> 6) * RH + F.wave, p & 63, wscr, F.lds + RING_OFF + F.wave * 16384);
        if (DBL & 4) { GRID_BAR();
#pragma unroll 1
            for (int p = F.vcu; p < BATCH * (T / 32); p += F.G) rwkvA_unit(F, Dm, (p >> 6) * RH + F.wave, p & 63, wscr, F.lds + RING_OFF + F.wave * 16384); }
        p2_qknorm(F);
        if (BOTH(2)) GRID_BAR();
    }
    if (IN(3) && !(SKIP & 8)) {
        p3_queue(F, Dm);
        if (BOTH(3)) GRID_BAR();
    }
    if (IN(4) && !(SKIP & 16)) {
        pg8::Gemm g{F.MIX, F.WoutT, M, D, D}; pg8::StaticOrder S; S.init(M, D, F.G, (int)blockIdx.x);
        pg8::EpiResF32 E{F.x, F.out, D};
        pg8::gemm_phase<pg8::EpiResF32, pg8::StaticOrder, false, true>(F.lds + RING_OFF, g, S, E, F.wave);
        if (DBL & 16) { GRID_BAR(); pg8::gemm_phase<pg8::EpiResF32, pg8::StaticOrder, false, true>(F.lds + RING_OFF, g, S, E, F.wave); }
    }
#undef IN
#undef BOTH
}

extern "C" void kernel_launch(void* const* d_in, const int* in_sizes, int n_in, void* d_out, int out_size, void* d_ws, size_t ws_size, hipStream_t stream) {
    static int grid = 0;
    if (grid == 0) {
        if (n_in != 21 || in_sizes[0] != M * D || out_size != M * D || ws_size < WS_END + 2 * MiB) { fprintf(stderr, "kernel_launch: unexpected shapes (n_in %d, in0 %d, out %d, ws %zu); nothing launched\n", n_in, n_in > 0 ? in_sizes[0] : -1, out_size, ws_size); grid = -1; return; }
        int dev = 0, cus = 0, per_cu = 0;
        if (hipGetDevice(&dev) != hipSuccess || hipDeviceGetAttribute(&cus, hipDeviceAttributeMultiprocessorCount, dev) != hipSuccess) { grid = -1; return; }
        if (hipFuncSetAttribute((const void*)hymba_fwd, hipFuncAttributeMaxDynamicSharedMemorySize, LDS_BYTES) != hipSuccess) { fprintf(stderr, "kernel_launch: hipFuncSetAttribute failed\n"); grid = -1; return; }
        if (hipOccupancyMaxActiveBlocksPerMultiprocessor(&per_cu, (const void*)hymba_fwd, NWAVES * 64, LDS_BYTES) != hipSuccess || per_cu < 1) { fprintf(stderr, "kernel_launch: occupancy query reports %d workgroups per CU; nothing launched\n", per_cu); grid = -1; return; }
        (void)hipGetLastError();
        grid = cus;
        if (grid > 256) grid = 256;
    }
    if (grid < 0) return;
    if (hipMemsetAsync((char*)d_ws + WS_CTL, 0, CTL_ZERO_BYTES, stream) != hipSuccess) { fprintf(stderr, "kernel_launch: hipMemsetAsync failed\n"); return; }
    Args a{};
    for (int i = 0; i < 21; ++i) a.in[i] = (const float*)d_in[i];
    a.out = (float*)d_out; a.ws = (unsigned char*)d_ws;
    for (int li = 0; li < MK_N_LAUNCHES; ++li) {
        a.ph_lo = (MK_N_LAUNCHES == 1) ? 0 : li; a.ph_hi = (MK_N_LAUNCHES == 1) ? N_PHASES : li + 1;
        hipLaunchKernelGGL(hymba_fwd, dim3(grid), dim3(NWAVES * 64), LDS_BYTES, stream, a);
        const hipError_t le = hipPeekAtLastError();
        if (le != hipSuccess) { fprintf(stderr, "kernel_launch: launch %d failed: %s\n", li, hipGetErrorName(le)); break; }
    }
}
```

```cpp
#define MK_N_LAUNCHES 1
#include <hip/hip_runtime.h>
#include <hip/hip_bf16.h>
#include <cstdio>
#include <cstdint>
#include <cmath>
namespace pg8 {
#define PG8_LAS __attribute__((address_space(3)))
typedef unsigned short bf16_t;
typedef short bf16x8 __attribute__((ext_vector_type(8)));
typedef float f32x4 __attribute__((ext_vector_type(4)));
typedef unsigned u32x4 __attribute__((ext_vector_type(4)));
constexpr int BM = 256, BK = 64, HALF = 128, HTB = HALF * BK * 2  , STAGE_BYTES = 8 * HTB, NXCD = 8, WGM = 8;

__host__ __device__ __forceinline__ int lds_byte(int r, int c) { const int st = (r >> 4) * 2 + (c >> 5), rr = r & 15, cc = c & 31, ob = rr * 64 + cc * 2; return st * 1024 + (ob ^ (((ob >> 9) & 1) << 5)); }
__host__ __device__ __forceinline__ void stage_rc(int b, int& R, int& C) { const int st = b / 1024, sb = b % 1024, swz = sb ^ (((sb >> 9) & 1) << 5); R = (st >> 1) * 16 + swz / 64; C = (st & 1) * 32 + (swz % 64) / 2; }
__host__ __device__ __forceinline__ int perm32(int rho) { const int n = rho >> 4, i = rho & 15; return 8 * (i >> 2) + 4 * n + (i & 3); }

__device__ __forceinline__ int mk_lane_pg8() { int l; asm volatile("v_mbcnt_lo_u32_b32 %0, -1, 0\n\tv_mbcnt_hi_u32_b32 %0, -1, %0" : "=v"(l)); return l; }
struct Unit { int pm, pn; };
struct Gemm { const bf16_t* A; const bf16_t* Bt; int M, N, K; };

struct StaticOrder {
    int nM, nN, nwg, G, c;
    __host__ __device__ void init(int M, int N, int G_, int c_) { nM = M / BM; nN = N / BM; nwg = nM * nN; G = G_; c = c_; }
    __host__ __device__ bool next(int i, Unit& u) const {
        const long L = (long)i * G + c; if (L >= nwg) return false;
        int wgid = (int)L; { const int q = nwg / NXCD, r = nwg % NXCD, xcd = wgid % NXCD, off = wgid / NXCD; wgid = (xcd < r ? xcd * (q + 1) : r * (q + 1) + (xcd - r) * q) + off; }
        const int nig = WGM * nN, gid = wgid / nig, fm = gid * WGM, gsz = (nM - fm) < WGM ? (nM - fm) : WGM;
        u.pm = fm + ((wgid % nig) % gsz); u.pn = (wgid % nig) / gsz; return true;
    }
    __device__ __forceinline__ void a_ready(const Unit&) const {}
    __device__ __forceinline__ void done(const Unit&) const {}
};

__device__ __forceinline__ unsigned cvt_pk_bf16(float lo, float hi) { unsigned r; asm volatile("v_cvt_pk_bf16_f32 %0, %1, %2" : "=v"(r) : "v"(lo), "v"(hi)); return r; }
struct EpiBf16S {
    static constexpr bool PERM = true, AFTER_DRAIN = false;
    bf16_t* O; int ldc;
    __device__ __forceinline__ void operator()(const f32x4 (&acc)[2][2][4][2], const Unit& u, int wr, int wc, int fr, int fq) const {
        const int row0 = u.pm * BM + wr * 64 + fr, col0 = u.pn * BM + wc * 32 + 8 * fq;
#pragma unroll
        for (int ai = 0; ai < 2; ++ai)
#pragma unroll
            for (int m = 0; m < 4; ++m) { bf16_t* rowp = O + (size_t)(row0 + ai * HALF + m * 16) * ldc + col0;
#pragma unroll
                for (int bj = 0; bj < 2; ++bj) { const f32x4 v0 = acc[ai][bj][m][0], v1 = acc[ai][bj][m][1];
                    u32x4 w; w.x = cvt_pk_bf16(v0[0], v0[1]); w.y = cvt_pk_bf16(v0[2], v0[3]); w.z = cvt_pk_bf16(v1[0], v1[1]); w.w = cvt_pk_bf16(v1[2], v1[3]);
                    *(u32x4*)(rowp + bj * HALF) = w; } }
    }
};
struct EpiResF32 {
    static constexpr bool PERM = false, AFTER_DRAIN = false;
    const float* base; float* out; int ldc;
    __device__ __forceinline__ void operator()(const f32x4 (&acc)[2][2][4][2], const Unit& u, int wr, int wc, int fr, int fq) const {
        const int row0 = u.pm * BM + wr * 64 + fr, col0 = u.pn * BM + wc * 32 + 4 * fq;
#pragma unroll
        for (int ai = 0; ai < 2; ++ai)
#pragma unroll
            for (int m = 0; m < 4; ++m) { const size_t off = (size_t)(row0 + ai * HALF + m * 16) * ldc + col0;
#pragma unroll
                for (int bj = 0; bj < 2; ++bj)
#pragma unroll
                    for (int n = 0; n < 2; ++n) { const f32x4 bs = *(const f32x4*)(base + off + bj * HALF + n * 16); *(f32x4*)(out + off + bj * HALF + n * 16) = bs + acc[ai][bj][m][n]; } }
    }
};
template <class Epi, class Sched, bool ALIGN_EPI = false, bool SP2 = false>
__device__ __forceinline__ void gemm_phase(PG8_LAS unsigned char* lds, const Gemm g, const Sched& S, const Epi& E, const int mk_wave_id  ) {
    const int wid = mk_wave_id, lane = mk_lane_pg8(), tid = wid * 64 + lane, wr = wid >> 2, wc = wid & 3, fr = lane & 15, fq = lane >> 4;
    const int K = g.K, nt = K / BK;
    unsigned voffA[2], voffB[2];
#pragma unroll
    for (int i = 0; i < 2; ++i) { int R, C; stage_rc(tid * 16 + i * 8192, R, C); const int Rb = Epi::PERM ? ((R & ~31) + perm32(R & 31)) : R;
        voffA[i] = (unsigned)(R * K + C) * 2u; voffB[i] = (unsigned)(Rb * K + C) * 2u; }
    const size_t kstep = (size_t)(BK * 2);
    const size_t hstep = (size_t)HALF * K * 2;
    const size_t tstep = 2 * hstep;
    const unsigned ldsw = (unsigned)wid * 1024u;
    const int aoff = lds_byte(wr * 64 + fr, fq * 8), boff = lds_byte(wc * 32 + fr, fq * 8);
#define PG8_SA(b, h) (((b) * 2 + (h)) * HTB)
#define PG8_SB(b, h) ((4 + (b) * 2 + (h)) * HTB)
#define PG8_STAGE(bufoff, gbase, voff) do { _Pragma("unroll") for (int _i = 0; _i < 2; ++_i) \
        __builtin_amdgcn_global_load_lds((const unsigned*)((const char*)(gbase) + (voff)[_i]), (PG8_LAS unsigned*)(lds + (bufoff) + ldsw + _i * 8192), 16, 0, 0); } while (0)
#define PG8_LDA(dst, b, h) do { _Pragma("unroll") for (int m = 0; m < 4; ++m) _Pragma("unroll") for (int k = 0; k < 2; ++k) dst[m][k] = *(const PG8_LAS bf16x8*)(lds + PG8_SA(b, h) + aoff + m * 2048 + k * 1024); } while (0)
#define PG8_LDB(dst, b, h) do { _Pragma("unroll") for (int n = 0; n < 2; ++n) _Pragma("unroll") for (int k = 0; k < 2; ++k) dst[n][k] = *(const PG8_LAS bf16x8*)(lds + PG8_SB(b, h) + boff + n * 2048 + k * 1024); } while (0)
#define PG8_MMA(ai, bj, At, Bt) do { __builtin_amdgcn_s_setprio(1); _Pragma("unroll") for (int m = 0; m < 4; ++m) _Pragma("unroll") for (int n = 0; n < 2; ++n) _Pragma("unroll") for (int k = 0; k < 2; ++k) \
        acc[ai][bj][m][n] = __builtin_amdgcn_mfma_f32_16x16x32_bf16(Bt[n][k], At[m][k], acc[ai][bj][m][n], 0, 0, 0); __builtin_amdgcn_s_setprio(0); } while (0)
#define PG8_WAIT_V(n) asm volatile("s_waitcnt vmcnt(" #n ")" ::: "memory")
#define PG8_WAIT_L(n) asm volatile("s_waitcnt lgkmcnt(" #n ")" ::: "memory")
#define PG8_BAR __builtin_amdgcn_s_barrier()
#define PG8_SCHED __builtin_amdgcn_sched_barrier(0)
    Unit cur, nxt; int ui = 0;
    if (!S.next(0, cur)) return;
    f32x4 acc[2][2][4][2];
#pragma unroll
    for (int a = 0; a < 2; ++a)
#pragma unroll
        for (int b = 0; b < 2; ++b)
#pragma unroll
            for (int m = 0; m < 4; ++m)
#pragma unroll
                for (int n = 0; n < 2; ++n) acc[a][b][m][n] = (f32x4){0.f, 0.f, 0.f, 0.f};
    bf16x8 At[4][2], B0[2][2], B1[2][2];
    const char* cA = (const char*)g.A + (size_t)cur.pm * tstep; const char* cB = (const char*)g.Bt + (size_t)cur.pn * tstep;
    S.a_ready(cur);
    if constexpr (SP2) {
        PG8_STAGE(PG8_SB(0, 0), cB, voffB); PG8_STAGE(PG8_SB(0, 1), cB + hstep, voffB); PG8_STAGE(PG8_SA(0, 0), cA, voffA); PG8_STAGE(PG8_SA(0, 1), cA + hstep, voffA);
        if (wr == 1) PG8_BAR;
        PG8_WAIT_V(2); PG8_BAR;
        PG8_STAGE(PG8_SB(1, 0), cB + kstep, voffB); PG8_STAGE(PG8_SA(1, 0), cA + kstep, voffA); PG8_STAGE(PG8_SB(1, 1), cB + hstep + kstep, voffB);
        PG8_WAIT_V(6); PG8_BAR;
    } else {
        PG8_STAGE(PG8_SB(0, 0), cB, voffB); PG8_STAGE(PG8_SA(0, 0), cA, voffA); PG8_STAGE(PG8_SB(0, 1), cB + hstep, voffB); PG8_STAGE(PG8_SA(0, 1), cA + hstep, voffA);
        if (wr == 1) PG8_BAR;
        PG8_WAIT_V(4); PG8_BAR;
        PG8_STAGE(PG8_SB(1, 0), cB + kstep, voffB); PG8_STAGE(PG8_SA(1, 0), cA + kstep, voffA); PG8_STAGE(PG8_SB(1, 1), cB + hstep + kstep, voffB);
        PG8_WAIT_V(6); PG8_BAR;
    }
    for (;;) {
        const bool has_next = S.next(ui + 1, nxt);
        const char* nA = has_next ? (const char*)g.A + (size_t)nxt.pm * tstep : cA; const char* nB = has_next ? (const char*)g.Bt + (size_t)nxt.pn * tstep : cB;
        for (int t = 0; t < nt; t += 2) {
            const bool last = (t == nt - 2);
            const char* a1 = cA + (size_t)(t + 1) * kstep;
            const char* a2 = last ? nA : cA + (size_t)(t + 2) * kstep; const char* b2 = last ? nB : cB + (size_t)(t + 2) * kstep;
            const char* a3 = a2 + kstep; const char* b3 = b2 + kstep;
            if (last && has_next) S.a_ready(nxt);
            if constexpr (SP2) {
            PG8_LDB(B0, 0, 0); PG8_LDB(B1, 0, 1); PG8_SCHED; PG8_LDA(At, 0, 0); PG8_STAGE(PG8_SA(1, 1), a1 + hstep, voffA);
            PG8_WAIT_V(8); PG8_WAIT_L(0); PG8_BAR; PG8_MMA(0, 0, At, B0); PG8_MMA(0, 1, At, B1); PG8_BAR; PG8_SCHED;
            PG8_LDA(At, 0, 1); PG8_STAGE(PG8_SB(0, 0), b2, voffB); PG8_STAGE(PG8_SB(0, 1), b2 + hstep, voffB); PG8_STAGE(PG8_SA(0, 0), a2, voffA);
            PG8_WAIT_V(8); PG8_WAIT_L(0); PG8_BAR; PG8_MMA(1, 0, At, B0); PG8_MMA(1, 1, At, B1); PG8_BAR; PG8_SCHED;
            PG8_LDB(B0, 1, 0); PG8_LDB(B1, 1, 1); PG8_SCHED; PG8_LDA(At, 1, 0); PG8_STAGE(PG8_SA(0, 1), a2 + hstep, voffA);
            PG8_WAIT_V(8); PG8_WAIT_L(0); PG8_BAR; PG8_MMA(0, 0, At, B0); PG8_MMA(0, 1, At, B1); PG8_BAR; PG8_SCHED;
            PG8_LDA(At, 1, 1); PG8_STAGE(PG8_SB(1, 0), b3, voffB); PG8_STAGE(PG8_SB(1, 1), b3 + hstep, voffB); PG8_STAGE(PG8_SA(1, 0), a3, voffA);
            PG8_WAIT_V(8); PG8_WAIT_L(0); PG8_BAR; PG8_MMA(1, 0, At, B0); PG8_MMA(1, 1, At, B1); PG8_BAR; PG8_SCHED;
            } else {
            PG8_LDB(B0, 0, 0); PG8_SCHED; PG8_LDA(At, 0, 0); PG8_STAGE(PG8_SA(1, 1), a1 + hstep, voffA);
            PG8_WAIT_L(8); PG8_BAR; PG8_WAIT_L(0); PG8_MMA(0, 0, At, B0); PG8_BAR; PG8_SCHED;
            PG8_LDB(B1, 0, 1); PG8_STAGE(PG8_SB(0, 0), b2, voffB);
            PG8_BAR; PG8_WAIT_L(0); PG8_MMA(0, 1, At, B1); PG8_BAR;
            PG8_LDA(At, 0, 1); PG8_STAGE(PG8_SA(0, 0), a2, voffA);
            PG8_BAR; PG8_WAIT_L(0); PG8_MMA(1, 0, At, B0); PG8_BAR; PG8_SCHED;
            PG8_STAGE(PG8_SB(0, 1), b2 + hstep, voffB);
            PG8_WAIT_V(6); PG8_BAR; PG8_MMA(1, 1, At, B1); PG8_BAR;
            PG8_LDB(B0, 1, 0); PG8_SCHED; PG8_LDA(At, 1, 0); PG8_STAGE(PG8_SA(0, 1), a2 + hstep, voffA);
            PG8_WAIT_L(8); PG8_BAR; PG8_WAIT_L(0); PG8_MMA(0, 0, At, B0); PG8_BAR; PG8_SCHED;
            PG8_LDB(B1, 1, 1); PG8_STAGE(PG8_SB(1, 0), b3, voffB);
            PG8_BAR; PG8_WAIT_L(0); PG8_MMA(0, 1, At, B1); PG8_BAR;
            PG8_LDA(At, 1, 1); PG8_STAGE(PG8_SA(1, 0), a3, voffA);
            PG8_BAR; PG8_WAIT_L(0); PG8_MMA(1, 0, At, B0); PG8_BAR; PG8_SCHED;
            PG8_STAGE(PG8_SB(1, 1), b3 + hstep, voffB);
            PG8_WAIT_V(6); PG8_BAR; PG8_MMA(1, 1, At, B1); PG8_BAR;
            }
        }
        if constexpr (ALIGN_EPI) { if (wr == 0) PG8_BAR; }
        if constexpr (!Epi::AFTER_DRAIN) { E(acc, cur, wr, wc, fr, fq); S.done(cur); }
        if (!has_next) break;
#pragma unroll
        for (int a = 0; a < 2; ++a)
#pragma unroll
            for (int b = 0; b < 2; ++b)
#pragma unroll
                for (int m = 0; m < 4; ++m)
#pragma unroll
                    for (int n = 0; n < 2; ++n) acc[a][b][m][n] = (f32x4){0.f, 0.f, 0.f, 0.f};
        cur = nxt; cA = nA; cB = nB; ++ui;
        if constexpr (ALIGN_EPI) { if (wr == 1) PG8_BAR; }
    }
    PG8_WAIT_V(0);
    if constexpr (!ALIGN_EPI) { if (wr == 0) PG8_BAR; }
    PG8_BAR;
    if constexpr (Epi::AFTER_DRAIN) { E.fused(acc, cur, wr, wc, fr, fq, lds, wid, lane); S.done(cur); }
#undef PG8_SA
#undef PG8_SB
#undef PG8_STAGE
#undef PG8_LDA
#undef PG8_LDB
#undef PG8_MMA
#undef PG8_WAIT_V
#undef PG8_WAIT_L
#undef PG8_BAR
#undef PG8_SCHED
}
}
constexpr int NWAVES = 8;
#ifndef MK_N_LAUNCHES
#define MK_N_LAUNCHES 1
#endif
constexpr int N_PHASES = 5;
constexpr int BATCH = 8, T = 2048, D = 1024, M = BATCH * T;
constexpr int NP = 4352;
constexpr int C_R = 0, C_K = 512, C_V = 1024, C_ZW = 1536, C_ZA = 1600, C_GA = 1792, C_DQ = 2304, C_DK = 2816, C_DV = 3328, C_GB = 3840;
constexpr int RH = 8, RN = 64;
constexpr int AH = 4;
constexpr float C2 = 0.125f * 1.4426950408889634f;
constexpr float LOG2E = 1.4426950408889634f;
constexpr float LAMBDA_INIT = 0.2f;

constexpr size_t MiB = 1u << 20;
constexpr size_t WS_CTL = 0, CTL_ZERO_BYTES = 1 * MiB;
constexpr size_t WS_WIN = 2 * MiB;
constexpr size_t WS_WOUT = 11 * MiB;
constexpr size_t WS_WD = 13 * MiB, WS_WA = 13 * MiB + 65536;
constexpr size_t WS_RHO = 13 * MiB + 2 * 65536;
constexpr size_t WS_XN = 14 * MiB;
constexpr size_t WS_PROJ = 46 * MiB;
constexpr size_t WS_MIX = 182 * MiB;
constexpr size_t WS_END = 214 * MiB;
constexpr int CW_BAR = 4096;

constexpr int RING_OFF = 0, RING_BYTES = 131072;
constexpr int LDSCTL_OFF = RING_BYTES, MISC_OFF = LDSCTL_OFF + 320;
constexpr int LDS_BYTES = 147456;

#define GAS __attribute__((address_space(1)))
#define LAS __attribute__((address_space(3)))
typedef unsigned short bf16;
typedef unsigned v4u __attribute__((ext_vector_type(4)));
typedef unsigned v2u __attribute__((ext_vector_type(2)));
typedef float f32x4 __attribute__((ext_vector_type(4)));
typedef float f32x16 __attribute__((ext_vector_type(16)));
typedef short bf16x8 __attribute__((ext_vector_type(8)));
typedef short s16x4 __attribute__((ext_vector_type(4)));
typedef GAS unsigned gu32;
typedef GAS unsigned long long gu64;
#define RLX_AGENT __ATOMIC_RELAXED, __HIP_MEMORY_SCOPE_AGENT
#define LDS_WAIT() asm volatile("s_waitcnt lgkmcnt(0)" ::: "memory")
#define VM_WAIT() asm volatile("s_waitcnt vmcnt(0)" ::: "memory")
__device__ __forceinline__ unsigned f2bf(float f) { unsigned u = __builtin_bit_cast(unsigned, f); return (u + 0x7fffu + ((u >> 16) & 1u)) >> 16; }
__device__ __forceinline__ unsigned pk2(float lo, float hi) { return f2bf(lo) | (f2bf(hi) << 16); }
__device__ __forceinline__ float bflo(unsigned u) { return __uint_as_float(u << 16); }
__device__ __forceinline__ float bfhi(unsigned u) { return __uint_as_float(u & 0xffff0000u); }
__device__ __forceinline__ float bf1(unsigned short u) { return __uint_as_float((unsigned)u << 16); }
__device__ __forceinline__ int mk_lane() { int l; asm volatile("v_mbcnt_lo_u32_b32 %0, -1, 0\n\tv_mbcnt_hi_u32_b32 %0, -1, %0" : "=v"(l)); return l; }
#define XB_TMO      128
#define XB_XCNT(j)  (256  + 64 * (j))
#define XB_XSUB(j)  (1280 + 64 * (j))
#define XB_XGEN(j)  (2304 + 64 * (j))
#define XB_TOP      3328
#define XB_TOPGEN   3392
#define XCD_BAR_WORDS 3456
#define XB_SPIN_CAP (1u << 18)

__device__ __forceinline__ unsigned xb_ld(unsigned* p)              { return __hip_atomic_load(p, __ATOMIC_RELAXED, __HIP_MEMORY_SCOPE_AGENT); }
__device__ __forceinline__ unsigned xb_add(unsigned* p, unsigned v) { return __hip_atomic_fetch_add(p, v, __ATOMIC_RELAXED, __HIP_MEMORY_SCOPE_AGENT); }
__device__ __forceinline__ unsigned xb_xcc_id() { return (unsigned)__builtin_amdgcn_s_getreg((3 << 11) | 20) & 0xFu; }
#define XB_SPIN(cond, bar) do { unsigned _sp = 0; while (cond) { __builtin_amdgcn_s_sleep(1); \
    if ((++_sp & 255u) == 0u) { if (xb_ld(&(bar)[XB_TMO])) break; if (_sp > XB_SPIN_CAP) { atomicAdd(&(bar)[XB_TMO], 1u); break; } } } } while (0)

struct XcdBarrier {
    unsigned* bar; unsigned x;
    volatile LAS unsigned* st;
    int wave;
};

__device__ __forceinline__ XcdBarrier xcd_barrier_post(unsigned* bar, volatile LAS unsigned* st, int wave) {
    XcdBarrier b; b.bar = bar; b.x = xb_xcc_id(); b.st = st; b.wave = wave;
    if (wave == 0 && mk_lane() == 0) (void)xb_add(&bar[XB_XCNT(b.x)], 1u);
    return b;
}
__device__ __forceinline__ void xcd_barrier_complete(unsigned* bar, unsigned x, unsigned& nloc, unsigned& nx) {
    const unsigned G = gridDim.x * gridDim.y * gridDim.z;
    unsigned sum, cnt, mine, sp = 0u;
    for (;;) {
        sum = 0u; cnt = 0u; mine = 0u;
#pragma unroll
        for (unsigned j = 0; j < 16; ++j) { const unsigned c = xb_ld(&bar[XB_XCNT(j)]); sum += c; cnt += (c > 0u) ? 1u : 0u; mine = (j == x) ? c : mine; }
        if (sum == G) break;
        __builtin_amdgcn_s_sleep(1);
        if ((++sp & 255u) == 0u) { if (xb_ld(&bar[XB_TMO])) break; if (sp > XB_SPIN_CAP) { atomicAdd(&bar[XB_TMO], 1u); break; } }
    }
    nloc = mine > 0u ? mine : 1u; nx = cnt > 0u ? cnt : 1u;
}

__device__ __forceinline__ void xcd_barrier(const XcdBarrier& b) {
    asm volatile("s_waitcnt vmcnt(0)" ::: "memory");
    __syncthreads();
    if (b.wave == 0 && mk_lane() == 0) {
        unsigned* bar = b.bar;
        __builtin_amdgcn_s_waitcnt(0);
        unsigned nloc = b.st[0], nx = b.st[1];
        if (nloc == 0u) { xcd_barrier_complete(bar, b.x, nloc, nx); b.st[0] = nloc; b.st[1] = nx; }
        const unsigned old = xb_add(&bar[XB_XSUB(b.x)], 1u);
        const unsigned gen = old / nloc;
        if (old + 1u == (gen + 1u) * nloc) {
            __builtin_amdgcn_fence(__ATOMIC_RELEASE, "agent");
            asm volatile("s_waitcnt vmcnt(0)" ::: "memory");
            const unsigned og = xb_add(&bar[XB_TOP], 1u);
            const unsigned tg = og / nx;
            if (og + 1u == (tg + 1u) * nx) xb_add(&bar[XB_TOPGEN], 1u);
            else XB_SPIN(xb_ld(&bar[XB_TOPGEN]) == tg, bar);
            __builtin_amdgcn_fence(__ATOMIC_ACQUIRE, "agent");
            xb_add(&bar[XB_XGEN(b.x)], 1u);
            asm volatile("s_waitcnt vmcnt(0)" ::: "memory");
        } else {
            XB_SPIN(xb_ld(&bar[XB_XGEN(b.x)]) == gen, bar);
            __builtin_amdgcn_fence(__ATOMIC_ACQUIRE, "agent");
            asm volatile("s_waitcnt vmcnt(0)" ::: "memory");
        }
    }
    __syncthreads();
}
struct Frame {
    LAS unsigned char* lds;
    volatile LAS unsigned* MISC;
    gu32* ctl;
    int tid, lane, wave;
    int vcu, G;
    const float* x; float* out;
    const float *norm_g, *w_in, *shift_mu, *w0, *w_decay_up, *a0, *w_iclr_up, *k_k, *k_a, *r_k, *ln_w, *ln_b, *qn_g, *kn_g, *lq1, *lk1, *lq2, *lk2, *subln_g, *w_out;
    bf16 *WinT, *WoutT, *WdT, *WaT, *XN, *PROJ, *MIX;
};

typedef float f32x2q_t __attribute__((ext_vector_type(2))); typedef __bf16 bf16x2q_t __attribute__((ext_vector_type(2)));
__device__ __forceinline__ unsigned cvtpk2(float lo, float hi) { f32x2q_t v = {lo, hi}; bf16x2q_t b = __builtin_convertvector(v, bf16x2q_t); return __builtin_bit_cast(unsigned, b); }
__device__ __forceinline__ float wave_sum(float v) {
#pragma unroll
    for (int o = 1; o < 64; o <<= 1) v += __shfl_xor(v, o);
    return v;
}
template <int CTRL> __device__ __forceinline__ float dpp_f(float x) { return __builtin_bit_cast(float, __builtin_amdgcn_mov_dpp(__builtin_bit_cast(int, x), CTRL, 0xf, 0xf, true)); }
__device__ __forceinline__ float row16_sum(float x) {
    x += dpp_f<0xB1>(x); x += dpp_f<0x4E>(x); x += dpp_f<0x141>(x); x += dpp_f<0x140>(x); return x;
}
__device__ __forceinline__ float swap32_sum(float x) {
    auto rr = __builtin_amdgcn_permlane32_swap(__float_as_uint(x), __float_as_uint(x), false, false);
    return __uint_as_float(rr[0]) + __uint_as_float(rr[1]);
}

__device__ __forceinline__ void p0_transpose_item(const float* W, int N, int nsrc, const float* kscale, bf16* WT, int K, int ndst, LAS float* scr, int k0, int lane) {
    float v[32];
#pragma unroll
    for (int i = 0; i < 32; ++i) { const int kk = 2 * i + (lane >> 5); v[i] = (nsrc >= 0) ? W[(size_t)(k0 + kk) * N + nsrc + (lane & 31)] : 0.f; }
    if (kscale && nsrc >= 0) {
#pragma unroll
        for (int i = 0; i < 32; ++i) v[i] *= kscale[k0 + 2 * i + (lane >> 5)];
    }
#pragma unroll
    for (int i = 0; i < 32; ++i) scr[(2 * i + (lane >> 5)) * 33 + (lane & 31)] = v[i];
    LDS_WAIT(); asm volatile("" ::: "memory");
    const int c = lane & 7;
#pragma unroll
    for (int j = 0; j < 4; ++j) { const int n = (lane >> 3) + 8 * j; const LAS float* s = scr + (8 * c) * 33 + n;
        v4u o; o.x = cvtpk2(s[0 * 33], s[1 * 33]); o.y = cvtpk2(s[2 * 33], s[3 * 33]); o.z = cvtpk2(s[4 * 33], s[5 * 33]); o.w = cvtpk2(s[6 * 33], s[7 * 33]);
        *(GAS v4u*)(WT + (size_t)(ndst + n) * K + k0 + 8 * c) = o; }
    LDS_WAIT(); asm volatile("" ::: "memory");
}
__device__ __forceinline__ void p0_prologue(Frame& F) {
    LAS float* scr = (LAS float*)(F.lds + RING_OFF + F.wave * 16384);
    const int gw = F.vcu * NWAVES + F.wave, NGW = F.G * NWAVES;
    constexpr int I_IN = (D / 64) * (NP / 32), I_OUT = (D / 64) * (D / 32), I_L = 512 / 32;
    constexpr int NITEMS = I_IN + I_OUT + 2 * I_L;
    for (int it = gw; it < NITEMS; it += NGW) {
        int r = it;
        if (r < I_IN) { const int kb = r / (NP / 32), nb = r % (NP / 32), nd = 32 * nb; const int ns = nd < 1664 ? nd : (nd < 1792 ? -1 : nd - 128);
            p0_transpose_item(F.w_in, 4224, ns, F.norm_g, F.WinT, D, nd, scr, 64 * kb, F.lane); continue; } r -= I_IN;
        if (r < I_OUT) { const int kb = r / (D / 32), nb = r % (D / 32);
            p0_transpose_item(F.w_out, D, 32 * nb, nullptr, F.WoutT, D, 32 * nb, scr, 64 * kb, F.lane); continue; } r -= I_OUT;
        if (r < I_L) { p0_transpose_item(F.w_decay_up, 512, 32 * r, nullptr, F.WdT, 64, 32 * r, scr, 0, F.lane); continue; } r -= I_L;
        p0_transpose_item(F.w_iclr_up, 512, 32 * r, nullptr, F.WaT, 64, 32 * r, scr, 0, F.lane);
    }
    for (int m0 = gw * 4; m0 < M; m0 += NGW * 4) {
        f32x4 v[4][4]; float s[4];
#pragma unroll
        for (int u = 0; u < 4; ++u) { const GAS f32x4* xr = (const GAS f32x4*)(F.x + (size_t)(m0 + u) * D) + F.lane;
#pragma unroll
            for (int j = 0; j < 4; ++j) v[u][j] = __builtin_nontemporal_load(xr + 64 * j); }
#pragma unroll
        for (int u = 0; u < 4; ++u) { float a = 0.f;
#pragma unroll
            for (int j = 0; j < 4; ++j) a += (v[u][j].x * v[u][j].x + v[u][j].y * v[u][j].y) + (v[u][j].z * v[u][j].z + v[u][j].w * v[u][j].w);
            s[u] = a; }
#pragma unroll
        for (int u = 0; u < 4; ++u) {
            const float rstd = __builtin_amdgcn_rsqf(wave_sum(s[u]) * (1.f / D) + 1e-6f);
            GAS unsigned long long* o8 = (GAS unsigned long long*)(F.XN + (size_t)(m0 + u) * D) + F.lane;
#pragma unroll
            for (int j = 0; j < 4; ++j) o8[64 * j] = (unsigned long long)cvtpk2(v[u][j].x * rstd, v[u][j].y * rstd) | ((unsigned long long)cvtpk2(v[u][j].z * rstd, v[u][j].w * rstd) << 32);
        }
    }
}

__device__ __forceinline__ float tanh_f(float x) { const float e = __expf(-2.f * fabsf(x)); const float t = (1.f - e) * __builtin_amdgcn_rcpf(1.f + e); return x < 0.f ? -t : t; }
__device__ __forceinline__ void shifted8(const bf16* proj, size_t m, bool has_prev, int col, const float* mu, float (&o)[8]) {
    const v4u c = *(const GAS v4u*)(proj + m * NP + col);
    v4u p = (v4u){0u, 0u, 0u, 0u}; if (has_prev) p = *(const GAS v4u*)(proj + (m - 1) * NP + col);
    const f32x4 m0 = *(const GAS f32x4*)(mu), m1 = *(const GAS f32x4*)(mu + 4);
    const unsigned cw[4] = {c.x, c.y, c.z, c.w}, pw[4] = {p.x, p.y, p.z, p.w}; const float mm[8] = {m0.x, m0.y, m0.z, m0.w, m1.x, m1.y, m1.z, m1.w};
#pragma unroll
    for (int j = 0; j < 4; ++j) { const float c0 = bflo(cw[j]), c1 = bfhi(cw[j]), p0 = bflo(pw[j]), p1 = bfhi(pw[j]);
        o[2 * j] = c0 + (p0 - c0) * mm[2 * j]; o[2 * j + 1] = c1 + (p1 - c1) * mm[2 * j + 1]; }
}
__device__ __forceinline__ void shifted4(const bf16* proj, size_t m, bool has_prev, int col, const float* mu, float (&o)[4]) {
    const v2u c = *(const GAS v2u*)(proj + m * NP + col);
    v2u p = (v2u){0u, 0u}; if (has_prev) p = *(const GAS v2u*)(proj + (m - 1) * NP + col);
    const f32x4 m0 = *(const GAS f32x4*)(mu);
    o[0] = bflo(c.x) + (bflo(p.x) - bflo(c.x)) * m0.x; o[1] = bfhi(c.x) + (bfhi(p.x) - bfhi(c.x)) * m0.y;
    o[2] = bflo(c.y) + (bflo(p.y) - bflo(c.y)) * m0.z; o[3] = bfhi(c.y) + (bfhi(p.y) - bfhi(c.y)) * m0.w;
}
__device__ __forceinline__ void p2_qknorm(Frame& F) {
    const int gw = F.vcu * NWAVES + F.wave, NGW = F.G * NWAVES, lane = F.lane, sub = lane & 7;
    const f32x4 gq0 = *(const GAS f32x4*)(F.qn_g + sub * 8), gq1 = *(const GAS f32x4*)(F.qn_g + sub * 8 + 4), gk0 = *(const GAS f32x4*)(F.kn_g + sub * 8), gk1 = *(const GAS f32x4*)(F.kn_g + sub * 8 + 4);
    constexpr int UQ = 4;
    for (int it0 = gw * UQ; it0 < 2 * M; it0 += NGW * UQ) {
        bf16* p[UQ]; v4u c[UQ];
#pragma unroll
        for (int u = 0; u < UQ; ++u) { const int it = it0 + u; const size_t m = (size_t)(it >> 1); p[u] = F.PROJ + m * NP + ((it & 1) ? C_DK : C_DQ) + (lane >> 3) * 64 + sub * 8; c[u] = *(const GAS v4u*)p[u]; }
#pragma unroll
        for (int u = 0; u < UQ; ++u) {
            const int isk = (it0 + u) & 1; const unsigned cw[4] = {c[u].x, c[u].y, c[u].z, c[u].w};
            float xv[8]; float ss = 0.f;
#pragma unroll
            for (int j = 0; j < 4; ++j) { xv[2 * j] = bflo(cw[j]); xv[2 * j + 1] = bfhi(cw[j]); ss += xv[2 * j] * xv[2 * j] + xv[2 * j + 1] * xv[2 * j + 1]; }
            ss += dpp_f<0xB1>(ss); ss += dpp_f<0x4E>(ss); ss += dpp_f<0x141>(ss);
            const float r = __builtin_amdgcn_rsqf(ss * (1.f / 64.f) + 1e-6f) * (isk ? 1.f : C2);
            const f32x4 g0 = isk ? gk0 : gq0, g1 = isk ? gk1 : gq1;
            v4u o; o.x = cvtpk2(xv[0] * r * g0.x, xv[1] * r * g0.y); o.y = cvtpk2(xv[2] * r * g0.z, xv[3] * r * g0.w); o.z = cvtpk2(xv[4] * r * g1.x, xv[5] * r * g1.y); o.w = cvtpk2(xv[6] * r * g1.z, xv[7] * r * g1.w);
            *(GAS v4u*)p[u] = o;
        }
    }
}
typedef float f32x2_t __attribute__((ext_vector_type(2))); typedef __bf16 bf16x2_t __attribute__((ext_vector_type(2)));
__device__ __forceinline__ unsigned cvtpk(float lo, float hi) { f32x2_t v = {lo, hi}; bf16x2_t b = __builtin_convertvector(v, bf16x2_t); return __builtin_bit_cast(unsigned, b); }
#define MFMA32(a, b, c) __builtin_amdgcn_mfma_f32_32x32x16_bf16(__builtin_bit_cast(bf16x8, (a)), __builtin_bit_cast(bf16x8, (b)), (c), 0, 0, 0)
#define FRAGACC(z, s) ((v4u){cvtpk((z)[8 * (s)], (z)[8 * (s) + 1]), cvtpk((z)[8 * (s) + 2], (z)[8 * (s) + 3]), cvtpk((z)[8 * (s) + 4], (z)[8 * (s) + 5]), cvtpk((z)[8 * (s) + 6], (z)[8 * (s) + 7])})
template <int CTRL, int RM> __device__ __forceinline__ float dpp_upd0(float x) { return __builtin_bit_cast(float, __builtin_amdgcn_update_dpp(0, __builtin_bit_cast(int, x), CTRL, RM, 0xf, false)); }
__device__ __forceinline__ float scan32(float x) {
    x += dpp_upd0<0x111, 0xf>(x); x += dpp_upd0<0x112, 0xf>(x); x += dpp_upd0<0x114, 0xf>(x); x += dpp_upd0<0x118, 0xf>(x); x += dpp_upd0<0x142, 0xa>(x); return x;
}
constexpr int RW_UNITS = BATCH * RH * (T / 32);
struct RwDump { v4u* PF; v4u* DD; v4u* QF; v4u* YD; float* GAM; float* RHO; };

__device__ __forceinline__ void rwkvA_unit(Frame& F, const RwDump& Dm, int bh, int ci, LAS float* wscr, LAS unsigned char* park) {
    int lane = mk_lane(); asm volatile("" : "+v"(lane));
    const int hi = lane >> 5, l31 = lane & 31, b = bh >> 3, w = bh & 7;
    LAS v4u* pk = (LAS v4u*)park + lane;
#define PARK(slot) pk[(slot) * 64]
    int tok = 0; asm volatile("" : "+v"(tok));
#define DEP(x) asm volatile("" : "+v"(tok) : "v"(x))
    const int t = ci * 32 + l31; const size_t m = (size_t)b * T + t; const bool hp = t > 0;
    const int u = ci * (BATCH * RH) + bh;
    const float pm = hp ? 1.f : 0.f;
    const bf16* pc = F.PROJ + m * NP + w * 64 + 4 * hi; const bf16* pp = F.PROJ + (hp ? m - 1 : m) * NP + w * 64 + 4 * hi;
    const float* mu = F.shift_mu + w * 64 + 4 * hi;
    const float *pw0 = F.w0 + w * 64 + 4 * hi, *pa0 = F.a0 + w * 64 + 4 * hi, *pkk = F.k_k + w * 64 + 4 * hi, *pka = F.k_a + w * 64 + 4 * hi, *prk = F.r_k + w * 64 + 4 * hi;
#define SH4(dst, COL, MU, OFF) do { const v2u c_ = *(const GAS v2u*)(pc + tok + (COL) + (OFF)), p_ = *(const GAS v2u*)(pp + tok + (COL) + (OFF)); const f32x4 m_ = *(const GAS f32x4*)(mu + tok + (MU) + (OFF)); \
        dst[0] = bflo(c_.x) + (bflo(p_.x) * pm - bflo(c_.x)) * m_.x; dst[1] = bfhi(c_.x) + (bfhi(p_.x) * pm - bfhi(c_.x)) * m_.y; \
        dst[2] = bflo(c_.y) + (bflo(p_.y) * pm - bflo(c_.y)) * m_.z; dst[3] = bfhi(c_.y) + (bfhi(p_.y) * pm - bfhi(c_.y)) * m_.w; } while (0)
    float ss = 0.f;
#pragma unroll
    for (int gq = 0; gq < 8; ++gq) { float k4[4]; SH4(k4, C_K, 512, 8 * gq); const f32x4 kkp = *(const GAS f32x4*)(pkk + tok + 8 * gq);
#pragma unroll
        for (int e = 0; e < 4; ++e) { const float q = k4[e] * kkp[e]; ss += q * q; }
        if (gq & 1) DEP(ss); }
    ss = swap32_sum(ss);
    const float inv = __builtin_amdgcn_rcpf(fmaxf(__builtin_amdgcn_sqrtf(ss), 1e-12f));
    asm volatile("" ::: "memory");
    v4u bz[4], ba[4];
    { const bf16* zc = F.PROJ + m * NP + 8 * hi; const bf16* zp = F.PROJ + (hp ? m - 1 : m) * NP + 8 * hi; const float* zmu = F.shift_mu + 8 * hi;
#pragma unroll
      for (int s = 0; s < 4; ++s) {
#pragma unroll
        for (int which = 0; which < 2; ++which) {
            const int COL = (which ? C_ZA : C_ZW) + 16 * s, MUO = (which ? 1600 : 1536) + 16 * s;
            const v4u c = *(const GAS v4u*)(zc + tok + COL), p = *(const GAS v4u*)(zp + tok + COL); const f32x4 m0 = *(const GAS f32x4*)(zmu + tok + MUO), m1 = *(const GAS f32x4*)(zmu + tok + MUO + 4);
            float z[8];
#pragma unroll
            for (int j = 0; j < 4; ++j) { const float c0 = bflo(c[j]), c1 = bfhi(c[j]); const float mm0 = j < 2 ? m0[2 * j] : m1[2 * j - 4], mm1 = j < 2 ? m0[2 * j + 1] : m1[2 * j - 3];
                z[2 * j] = c0 + (bflo(p[j]) * pm - c0) * mm0; z[2 * j + 1] = c1 + (bfhi(p[j]) * pm - c1) * mm1; }
            if (which == 0) bz[s] = (v4u){cvtpk(tanh_f(z[0]), tanh_f(z[1])), cvtpk(tanh_f(z[2]), tanh_f(z[3])), cvtpk(tanh_f(z[4]), tanh_f(z[5])), cvtpk(tanh_f(z[6]), tanh_f(z[7]))};
            else ba[s] = (v4u){cvtpk(z[0], z[1]), cvtpk(z[2], z[3]), cvtpk(z[4], z[5]), cvtpk(z[6], z[7])};
            if (which == 0) DEP(bz[s][3]); else DEP(ba[s][3]);
        }
      } }
    asm volatile("" ::: "memory");
    v4u fa[4], fb[4], fk[4], fr[4], fv[4]; float rho = 0.f;
    float* gp = Dm.GAM + (size_t)u * 64 + hi * 32;
#define RW_LORA(cb) f32x16 accd = f32x16{}, acca = f32x16{}; _Pragma("unroll") for (int s = 0; s < 4; ++s) { \
        const v4u aD = *(const GAS v4u*)(F.WdT + tok + (size_t)(w * 64 + (cb) * 32 + l31) * 64 + 16 * s + 8 * hi); accd = MFMA32(aD, bz[s], accd); \
        const v4u aA = *(const GAS v4u*)(F.WaT + tok + (size_t)(w * 64 + (cb) * 32 + l31) * 64 + 16 * s + 8 * hi); acca = MFMA32(aA, ba[s], acca); }
#define RW_GROUP(cb, rg) do { constexpr int OFF = 32 * (cb) + 8 * (rg); const int ch0 = OFF + 4 * hi; \
            float rr[4], kk4[4], vv[4]; \
            SH4(rr, C_R, 0, OFF); SH4(kk4, C_K, 512, OFF); SH4(vv, C_V, 1024, OFF); \
            const f32x4 w0v = *(const GAS f32x4*)(pw0 + tok + OFF), a0v = *(const GAS f32x4*)(pa0 + tok + OFF), kkp = *(const GAS f32x4*)(pkk + tok + OFF), kap = *(const GAS f32x4*)(pka + tok + OFF), rkp = *(const GAS f32x4*)(prk + tok + OFF); \
            float xa[4], xb[4], xk[4], xr[4], gg[4], ge[4]; \
            _Pragma("unroll") for (int e = 0; e < 4; ++e) { \
                const float nx = -(w0v[e] + accd[4 * (rg) + e]); const float sp = fmaxf(nx, 0.f) + __logf(1.f + __expf(-fabsf(nx))); \
                const float l2 = -__expf(-sp - 0.5f) * LOG2E; \
                const float g = scan32(l2); \
                const float a = __builtin_amdgcn_rcpf(1.f + __expf(-(a0v[e] + acca[4 * (rg) + e]))); \
                const float kk = kk4[e] * kkp[e] * inv; \
                const float kt = kk4[e] * (1.f + (a - 1.f) * kap[e]); \
                rho += rr[e] * kt * rkp[e]; \
                const float eg = __builtin_amdgcn_exp2f(g), egp = __builtin_amdgcn_exp2f(g - l2), eng = __builtin_amdgcn_rcpf(eg); \
                xa[e] = -kk * egp; xb[e] = kk * a * eng; xk[e] = kt * eng; xr[e] = rr[e] * eg; gg[e] = g; ge[e] = eg; } \
            if (l31 == 31) { *(LAS f32x4*)(wscr + ch0) = (f32x4){gg[0], gg[1], gg[2], gg[3]}; *(GAS f32x4*)(gp + (cb) * 16 + 4 * (rg)) = (f32x4){ge[0], ge[1], ge[2], ge[3]}; } \
            constexpr int s_ = 2 * (cb) + ((rg) >> 1), vg = 2 * ((rg) & 1); \
            fa[s_][vg] = cvtpk(xa[0], xa[1]); fa[s_][vg + 1] = cvtpk(xa[2], xa[3]); \
            fb[s_][vg] = cvtpk(xb[0], xb[1]); fb[s_][vg + 1] = cvtpk(xb[2], xb[3]); \
            fk[s_][vg] = cvtpk(xk[0], xk[1]); fk[s_][vg + 1] = cvtpk(xk[2], xk[3]); \
            fr[s_][vg] = cvtpk(xr[0], xr[1]); fr[s_][vg + 1] = cvtpk(xr[2], xr[3]); \
            fv[s_][vg] = cvtpk(vv[0], vv[1]); fv[s_][vg + 1] = cvtpk(vv[2], vv[3]); \
            if (((rg) & 1) == 1) { PARK(s_) = fv[s_]; PARK(4 + s_) = fr[s_]; } \
            DEP(fa[s_][vg + 1]); DEP(fb[s_][vg + 1]); DEP(fk[s_][vg + 1]); DEP(fr[s_][vg + 1]); DEP(fv[s_][vg + 1]); DEP(rho); } while (0)
    { RW_LORA(0) RW_GROUP(0, 0); RW_GROUP(0, 1); RW_GROUP(0, 2); RW_GROUP(0, 3); }
    { RW_LORA(1) RW_GROUP(1, 0); RW_GROUP(1, 1); RW_GROUP(1, 2); RW_GROUP(1, 3); }
#undef RW_LORA
#undef RW_GROUP
#undef SH4
    LDS_WAIT(); asm volatile("" ::: "memory");
    float EC[2]; EC[0] = __builtin_amdgcn_exp2f(wscr[l31]); EC[1] = __builtin_amdgcn_exp2f(wscr[32 + l31]);
    LDS_WAIT(); asm volatile("" ::: "memory");
    rho = swap32_sum(rho);
    if (hi == 0) Dm.RHO[(size_t)u * 32 + l31] = rho;
    v4u idf[2];
    { const int jst = 4 * ((l31 >> 3) & 1) + (l31 & 3); const bool hm = ((l31 >> 2) & 1) == hi; const unsigned one = 0x3F80u << (16 * (jst & 1));
#pragma unroll
      for (int sig = 0; sig < 2; ++sig) { const bool on = hm && ((l31 >> 4) == sig);
#pragma unroll
          for (int q = 0; q < 4; ++q) idf[sig][q] = (on && (jst >> 1) == q) ? one : 0u; } }
    LDS_WAIT();
    v4u Af[2][2], Vf[2][2];
#pragma unroll
    for (int blk = 0; blk < 2; ++blk) {
        f32x16 za = MFMA32(fa[2 * blk], idf[0], f32x16{}); za = MFMA32(fa[2 * blk + 1], idf[1], za);
        f32x16 zv = MFMA32(PARK(2 * blk), idf[0], f32x16{}); zv = MFMA32(PARK(2 * blk + 1), idf[1], zv);
        f32x16 zb = MFMA32(fb[2 * blk], idf[0], f32x16{}); zb = MFMA32(fb[2 * blk + 1], idf[1], zb);
        f32x16 zk = MFMA32(fk[2 * blk], idf[0], f32x16{}); zk = MFMA32(fk[2 * blk + 1], idf[1], zk);
        zb = zb * EC[blk]; zk = zk * EC[blk];
#pragma unroll
        for (int s = 0; s < 2; ++s) { Af[blk][s] = FRAGACC(za, s); Vf[blk][s] = FRAGACC(zv, s); PARK(8 + 2 * blk + s) = FRAGACC(zb, s); PARK(12 + 2 * blk + s) = FRAGACC(zk, s); }
        __builtin_amdgcn_sched_barrier(0);
    }
    f32x16 Aab = f32x16{}, TT = f32x16{}, AakT = f32x16{}, ArbT = f32x16{}, ArkT = f32x16{};
#pragma unroll
    for (int s = 0; s < 4; ++s) { const v4u frs = PARK(4 + s); Aab = MFMA32(fa[s], fb[s], Aab); TT = MFMA32(fb[s], fa[s], TT); AakT = MFMA32(fk[s], fa[s], AakT); ArbT = MFMA32(fb[s], frs, ArbT); ArkT = MFMA32(fk[s], frs, ArkT); }
#pragma unroll
    for (int r = 0; r < 16; ++r) { const int rowi = (r & 3) + 8 * (r >> 2) + 4 * hi;
        Aab[r] = (l31 < rowi) ? Aab[r] : 0.f; TT[r] = (rowi < l31) ? TT[r] : 0.f; AakT[r] = (rowi < l31) ? AakT[r] : 0.f;
        ArbT[r] = (rowi <= l31) ? ArbT[r] : 0.f; ArkT[r] = (rowi <= l31) ? ArkT[r] : 0.f; }
    v4u AakTf[2], ArbTf[2], ArkTf[2];
#pragma unroll
    for (int s = 0; s < 2; ++s) { AakTf[s] = FRAGACC(AakT, s); ArbTf[s] = FRAGACC(ArbT, s); ArkTf[s] = FRAGACC(ArkT, s); }
    __builtin_amdgcn_sched_barrier(0);
    v4u Xf[2], XTf[2], TTf[2];
#pragma unroll
    for (int s = 0; s < 2; ++s) { Xf[s] = FRAGACC(Aab, s); XTf[s] = FRAGACC(TT, s); }
#pragma unroll
    for (int r = 0; r < 16; ++r) { const int rowi = (r & 3) + 8 * (r >> 2) + 4 * hi; TT[r] += (rowi == l31) ? 1.f : 0.f; }
#pragma unroll
    for (int it = 0; it < 4; ++it) {
        f32x16 X2 = MFMA32(XTf[0], Xf[0], f32x16{}); X2 = MFMA32(XTf[1], Xf[1], X2);
        if (it < 3) { f32x16 X2T = MFMA32(Xf[0], XTf[0], f32x16{}); X2T = MFMA32(Xf[1], XTf[1], X2T);
#pragma unroll
            for (int s = 0; s < 2; ++s) XTf[s] = FRAGACC(X2T, s); }
#pragma unroll
        for (int s = 0; s < 2; ++s) { Xf[s] = FRAGACC(X2, s); TTf[s] = FRAGACC(TT, s); }
        TT = MFMA32(Xf[0], TTf[0], TT); TT = MFMA32(Xf[1], TTf[1], TT);
        __builtin_amdgcn_sched_barrier(0);
    }
#pragma unroll
    for (int s = 0; s < 2; ++s) TTf[s] = FRAGACC(TT, s);
    v4u Wf[2][2], Uf[2][2];
#pragma unroll
    for (int blk = 0; blk < 2; ++blk) {
        f32x16 av = MFMA32(AakTf[0], Vf[blk][0], f32x16{}); av = MFMA32(AakTf[1], Vf[blk][1], av);
        const v4u avf0 = FRAGACC(av, 0), avf1 = FRAGACC(av, 1);
        f32x16 uu = MFMA32(TTf[0], avf0, f32x16{}); uu = MFMA32(TTf[1], avf1, uu);
        f32x16 ww = MFMA32(TTf[0], Af[blk][0], f32x16{}); ww = MFMA32(TTf[1], Af[blk][1], ww);
#pragma unroll
        for (int s = 0; s < 2; ++s) { Wf[blk][s] = FRAGACC(ww, s); Uf[blk][s] = FRAGACC(uu, s); }
        __builtin_amdgcn_sched_barrier(0);
    }
    v4u* QFp = Dm.QF + (size_t)u * 256 + lane; v4u* YDp = Dm.YD + (size_t)u * 256 + lane;
#pragma unroll
    for (int blk = 0; blk < 2; ++blk) {
        f32x16 q;
#pragma unroll
        for (int s = 0; s < 2; ++s)
            { const v4u frs = PARK(4 + 2 * blk + s);
#pragma unroll
              for (int j = 0; j < 4; ++j) { q[8 * s + 2 * j] = bflo(frs[j]); q[8 * s + 2 * j + 1] = bfhi(frs[j]); } }
        q = MFMA32(Wf[blk][0], ArbTf[0], q); q = MFMA32(Wf[blk][1], ArbTf[1], q);
        *(GAS v4u*)(QFp + (2 * blk) * 64) = FRAGACC(q, 0); *(GAS v4u*)(QFp + (2 * blk + 1) * 64) = FRAGACC(q, 1);
        f32x16 y = MFMA32(Uf[blk][0], ArbTf[0], f32x16{}); y = MFMA32(Uf[blk][1], ArbTf[1], y); y = MFMA32(Vf[blk][0], ArkTf[0], y); y = MFMA32(Vf[blk][1], ArkTf[1], y);
        *(GAS v4u*)(YDp + (2 * blk) * 64) = FRAGACC(y, 0); *(GAS v4u*)(YDp + (2 * blk + 1) * 64) = FRAGACC(y, 1);
        __builtin_amdgcn_sched_barrier(0);
    }
    v4u* PFp = Dm.PF + (size_t)u * 512 + lane; v4u* DDp = Dm.DD + (size_t)u * 512 + lane;
#pragma unroll
    for (int c1 = 0; c1 < 2; ++c1)
#pragma unroll
        for (int cb = 0; cb < 2; ++cb) {
            f32x16 p = MFMA32(Wf[c1][0], PARK(8 + 2 * cb), f32x16{}); p = MFMA32(Wf[c1][1], PARK(8 + 2 * cb + 1), p);
            *(GAS v4u*)(PFp + (cb * 4 + 2 * c1) * 64) = FRAGACC(p, 0); *(GAS v4u*)(PFp + (cb * 4 + 2 * c1 + 1) * 64) = FRAGACC(p, 1);
            __builtin_amdgcn_sched_barrier(0);
        }
#pragma unroll
    for (int cb = 0; cb < 2; ++cb)
#pragma unroll
        for (int ib = 0; ib < 2; ++ib) {
            f32x16 d = MFMA32(PARK(8 + 2 * cb), Uf[ib][0], f32x16{}); d = MFMA32(PARK(8 + 2 * cb + 1), Uf[ib][1], d); d = MFMA32(PARK(12 + 2 * cb), Vf[ib][0], d); d = MFMA32(PARK(12 + 2 * cb + 1), Vf[ib][1], d);
            *(GAS v4u*)(DDp + ((cb * 2 + ib) * 2) * 64) = FRAGACC(d, 0); *(GAS v4u*)(DDp + ((cb * 2 + ib) * 2 + 1) * 64) = FRAGACC(d, 1);
            __builtin_amdgcn_sched_barrier(0);
        }
}

#undef PARK
#undef DEP
constexpr int RB_PF = 0, RB_DD = 8192, RB_QF = 16384, RB_YD = 20480, RB_GAM = 24576, RB_BUF = 24832, RB_STAT = 2 * RB_BUF, RB_Y = RB_STAT + 1024;
__device__ __forceinline__ void unpack16(const v4u a, const v4u b, f32x16& o) {
#pragma unroll
    for (int j = 0; j < 4; ++j) { o[2 * j] = bflo(a[j]); o[2 * j + 1] = bfhi(a[j]); o[8 + 2 * j] = bflo(b[j]); o[8 + 2 * j + 1] = bfhi(b[j]); }
}
struct RbStage { v4u p[4], d[4], q[2], y[2], g; };
struct RbEpi { v2u vc[2], vp[2], ga[2]; float rho; };
__device__ __forceinline__ void rwkvB_unit(Frame& F, const RwDump& Dm, int bh) {
    int lane = mk_lane(); asm volatile("" : "+v"(lane));
    const int wid = F.wave, tid = wid * 64 + lane, hi = lane >> 5, l31 = lane & 31, b = bh >> 3, h = bh & 7;
    LAS unsigned char* lds = F.lds + RING_OFF;
    constexpr int NS = T / 32;
    LAS float* stat = (LAS float*)(lds + RB_STAT);
    LAS float* ybuf = (LAS float*)(lds + RB_Y);
    const int stid = tid - 256;
#define ST_LOAD(X, ci_) do { { const size_t u_ = (size_t)((ci_) < NS ? (ci_) : NS - 1) * (BATCH * RH) + bh; \
        _Pragma("unroll") for (int j = 0; j < 4; ++j) { X.p[j] = *(const GAS v4u*)(Dm.PF + u_ * 512 + j * 128 + stid); X.d[j] = *(const GAS v4u*)(Dm.DD + u_ * 512 + j * 128 + stid); } \
        _Pragma("unroll") for (int j = 0; j < 2; ++j) { X.q[j] = *(const GAS v4u*)(Dm.QF + u_ * 256 + j * 128 + stid); X.y[j] = *(const GAS v4u*)(Dm.YD + u_ * 256 + j * 128 + stid); } \
        if (stid < 16) X.g = *(const GAS v4u*)((const v4u*)(Dm.GAM + u_ * 64) + stid); } } while (0)
#define ST_STORE(X, buf_) do { LAS unsigned char* b_ = lds + (buf_) * RB_BUF; \
        _Pragma("unroll") for (int j = 0; j < 4; ++j) { *(LAS v4u*)(b_ + RB_PF + (j * 128 + stid) * 16) = X.p[j]; *(LAS v4u*)(b_ + RB_DD + (j * 128 + stid) * 16) = X.d[j]; } \
        _Pragma("unroll") for (int j = 0; j < 2; ++j) { *(LAS v4u*)(b_ + RB_QF + (j * 128 + stid) * 16) = X.q[j]; *(LAS v4u*)(b_ + RB_YD + (j * 128 + stid) * 16) = X.y[j]; } \
        if (stid < 16) *(LAS v4u*)(b_ + RB_GAM + stid * 16) = X.g; } while (0)
    const int eib = wid & 1, eh = (wid >> 2) & 1;
    const bf16* epc = F.PROJ + (size_t)b * T * NP + h * 64 + 32 * eib + 16 * eh + 4 * hi;
#define EP_LOAD(X, cj_) do { { const int tt_ = ((cj_) < NS ? (cj_) : NS - 1) * 32 + l31; const bf16* pc_ = epc + (size_t)tt_ * NP; const bf16* pp_ = epc + (size_t)(tt_ > 0 ? tt_ - 1 : 0) * NP; \
        _Pragma("unroll") for (int rg = 0; rg < 2; ++rg) { X.vc[rg] = *(const GAS v2u*)(pc_ + C_V + 8 * rg); X.vp[rg] = *(const GAS v2u*)(pp_ + C_V + 8 * rg); X.ga[rg] = *(const GAS v2u*)(pc_ + C_GA + 8 * rg); } \
        X.rho = Dm.RHO[((size_t)((cj_) < NS ? (cj_) : NS - 1) * (BATCH * RH) + bh) * 32 + l31]; } } while (0)
#define EP_RUN(X, cj_) do { const int par_ = (cj_) & 1; \
        const float s1_ = stat[((par_ * 2 + 0) * 32 + l31) * 2] + stat[((par_ * 2 + 1) * 32 + l31) * 2], s2_ = stat[((par_ * 2 + 0) * 32 + l31) * 2 + 1] + stat[((par_ * 2 + 1) * 32 + l31) * 2 + 1]; \
        const float mean_ = s1_ * (1.f / 64.f), var_ = fmaxf(s2_ * (1.f / 64.f) - mean_ * mean_, 0.f), rstd_ = __builtin_amdgcn_rsqf(var_ + 64e-5f); \
        const int tt_ = (cj_) * 32 + l31; const size_t mm_ = (size_t)b * T + tt_; const float pm_ = tt_ > 0 ? 1.f : 0.f; \
        const LAS float* yb_ = ybuf + (par_ * 2 + eib) * 1024 + lane; \
        _Pragma("unroll") for (int rg = 0; rg < 2; ++rg) { const int hc_ = h * 64 + 32 * eib + 16 * eh + 8 * rg + 4 * hi; \
            const f32x4 mu_ = emu[rg], lw_ = elw[rg], lb_ = elb[rg]; \
            const float vc_[4] = {bflo(X.vc[rg].x), bfhi(X.vc[rg].x), bflo(X.vc[rg].y), bfhi(X.vc[rg].y)}, vp_[4] = {bflo(X.vp[rg].x), bfhi(X.vp[rg].x), bflo(X.vp[rg].y), bfhi(X.vp[rg].y)}; \
            const float g4_[4] = {bflo(X.ga[rg].x), bfhi(X.ga[rg].x), bflo(X.ga[rg].y), bfhi(X.ga[rg].y)}; float o_[4]; \
            _Pragma("unroll") for (int e = 0; e < 4; ++e) { const float vv_ = vc_[e] + (vp_[e] * pm_ - vc_[e]) * mu_[e]; \
                const float yn_ = (yb_[(4 * (2 * eh + rg) + e) * 64] - mean_) * rstd_ * lw_[e] + lb_[e] + X.rho * vv_; o_[e] = yn_ * g4_[e] * __builtin_amdgcn_rcpf(1.f + __expf(-g4_[e])); } \
            *(GAS v2u*)(F.MIX + mm_ * D + hc_) = (v2u){cvtpk(o_[0], o_[1]), cvtpk(o_[2], o_[3])}; } } while (0)
    f32x16 S[2]; S[0] = f32x16{}; S[1] = f32x16{};
    const int ib = wid & 1;
#define CONS(ci_) do { const LAS unsigned char* bb = lds + ((ci_) & 1) * RB_BUF; \
          \
        v4u pf_[8], qf_[4], dd_[4], yd_[2]; f32x4 gm_[8]; \
        _Pragma("unroll") for (int q = 0; q < 8; ++q) gm_[q] = *(const LAS f32x4*)(bb + RB_GAM + (hi * 32 + 4 * q) * 4); \
        _Pragma("unroll") for (int q = 0; q < 4; ++q) dd_[q] = *(const LAS v4u*)(bb + RB_DD + ((((q >> 1) * 2 + ib) * 2 + (q & 1)) * 64 + lane) * 16); \
        _Pragma("unroll") for (int q = 0; q < 8; ++q) pf_[q] = *(const LAS v4u*)(bb + RB_PF + (q * 64 + lane) * 16); \
        _Pragma("unroll") for (int q = 0; q < 2; ++q) yd_[q] = *(const LAS v4u*)(bb + RB_YD + ((2 * ib + q) * 64 + lane) * 16); \
        _Pragma("unroll") for (int q = 0; q < 4; ++q) qf_[q] = *(const LAS v4u*)(bb + RB_QF + (q * 64 + lane) * 16); \
        __builtin_amdgcn_sched_barrier(0); \
        v4u Sf[4]; _Pragma("unroll") for (int s = 0; s < 4; ++s) Sf[s] = FRAGACC(S[s >> 1], s & 1); \
        _Pragma("unroll") for (int rb = 0; rb < 2; ++rb) { \
            f32x16 acc; unpack16(dd_[2 * rb], dd_[2 * rb + 1], acc); \
            _Pragma("unroll") for (int q = 0; q < 4; ++q) { const f32x4 gv = gm_[4 * rb + q]; _Pragma("unroll") for (int e = 0; e < 4; ++e) acc[4 * q + e] += gv[e] * S[rb][4 * q + e]; } \
            _Pragma("unroll") for (int s = 0; s < 4; ++s) acc = MFMA32(pf_[rb * 4 + s], Sf[s], acc); \
            S[rb] = acc; } \
        f32x16 y; unpack16(yd_[0], yd_[1], y); \
        _Pragma("unroll") for (int s = 0; s < 4; ++s) y = MFMA32(Sf[s], qf_[s], y); \
        float s1 = 0.f, s2 = 0.f; LAS float* yb_ = ybuf + (((ci_) & 1) * 2 + ib) * 1024 + lane; \
        _Pragma("unroll") for (int r = 0; r < 16; ++r) { s1 += y[r]; s2 += y[r] * y[r]; yb_[r * 64] = y[r]; } \
        s1 = swap32_sum(s1); s2 = swap32_sum(s2); \
        if (hi == 0) { stat[((((ci_) & 1) * 2 + ib) * 32 + l31) * 2] = s1; stat[((((ci_) & 1) * 2 + ib) * 32 + l31) * 2 + 1] = s2; } } while (0)
#define RB_BAR() do { asm volatile("s_waitcnt lgkmcnt(0)" ::: "memory"); __builtin_amdgcn_s_barrier(); asm volatile("" ::: "memory"); } while (0)
    if (wid < 2) {
        RB_BAR();
#pragma unroll 1
        for (int k = 0; k < NS; ++k) { CONS(k); RB_BAR(); }
        RB_BAR();
    } else if (wid == 4 || wid == 5) {
        RbStage sA, sB, sC, sD;
        ST_LOAD(sA, 0); ST_LOAD(sB, 1); ST_LOAD(sC, 2); ST_LOAD(sD, 3); ST_STORE(sA, 0); ST_LOAD(sA, 4);
        RB_BAR();
#define ST_STEP(k_, SN) do { ST_STORE(SN, ((k_) + 1) & 1); ST_LOAD(SN, (k_) + 5); RB_BAR(); } while (0)
#pragma unroll 1
        for (int k = 0; k < NS; k += 4) { ST_STEP(k, sB); ST_STEP(k + 1, sC); ST_STEP(k + 2, sD); ST_STEP(k + 3, sA); }
        RB_BAR();
#undef ST_STEP
    } else {
        RbEpi eA, eB, eC, eD; f32x4 emu[2], elw[2], elb[2];
#pragma unroll
        for (int rg = 0; rg < 2; ++rg) { const int hc_ = h * 64 + 32 * eib + 16 * eh + 8 * rg + 4 * hi; emu[rg] = *(const GAS f32x4*)(F.shift_mu + 1024 + hc_); elw[rg] = *(const GAS f32x4*)(F.ln_w + hc_); elb[rg] = *(const GAS f32x4*)(F.ln_b + hc_); }
        EP_LOAD(eA, 0); EP_LOAD(eB, 1); EP_LOAD(eC, 2);
        RB_BAR();
        EP_LOAD(eD, 3); RB_BAR();
#define EP_STEP(k_, EP) do { EP_RUN(EP, (k_) - 1); EP_LOAD(EP, (k_) + 3); RB_BAR(); } while (0)
#pragma unroll 1
        for (int k = 1; k <= NS; k += 4) { EP_STEP(k, eA); EP_STEP(k + 1, eB); EP_STEP(k + 2, eC); EP_STEP(k + 3, eD); }
#undef EP_STEP
    }
#undef RB_BAR
#undef ST_LOAD
#undef ST_STORE
#undef EP_LOAD
#undef EP_RUN
#undef CONS
}
constexpr int AT_KB = 64 * 256, AT_VB = 64 * 256, AT_BUF = AT_KB + AT_VB, AT_QOFF = 2 * AT_KB + 3 * AT_VB;
__device__ __forceinline__ s16x4 vtr(const LAS unsigned char* p) { typedef short v4i16_t __attribute__((ext_vector_type(4))); return __builtin_bit_cast(s16x4, __builtin_amdgcn_ds_read_tr16_b64_v4i16((LAS v4i16_t*)p)); }
__device__ __forceinline__ void attn_unit(Frame& F, int b, int h, int qb) {
    int lane = mk_lane(); asm volatile("" : "+v"(lane));
    const int wid = F.wave, tid = wid * 64 + lane, l31 = lane & 31, hi = lane >> 5, map = wid >> 2, qs = wid & 3;
    LAS unsigned char* lds = F.lds + RING_OFF;
    const float slope2 = exp2f(-2.f * (float)(h + 1)) * LOG2E, shift2 = __uint_as_float(F.MISC[15]);
    const int q0 = qb * 128, qrow = q0 + 32 * qs + l31;
    const size_t mrow = (size_t)b * T + qrow;
    LAS bf16x8* qpark = (LAS bf16x8*)(lds + AT_QOFF + wid * 4096) + lane;
    { const bf16* qp = F.PROJ + mrow * NP + C_DQ + h * 128 + map * 64 + 8 * hi;
#pragma unroll
      for (int s = 0; s < 4; ++s) qpark[s * 64] = *(const GAS bf16x8*)(qp + 16 * s); }
    const bf16* kg = F.PROJ + (size_t)b * T * NP + C_DK + h * 128;
    const bf16* vg = F.PROJ + (size_t)b * T * NP + C_DV + h * 128;
    const int NT = 2 * qb + 2, tl = 2 * qb + (qs >> 1);
    const int Wk = (int)__builtin_ceilf((2.f * shift2 + 32.2f) / slope2);
    const int tf = __builtin_amdgcn_readfirstlane(max(0, (qb * 128 - Wk) >> 6));
    constexpr int AT_V0 = 2 * AT_KB;
    const int drow0 = 4 * wid + (lane >> 4), drow1 = drow0 + 32, dch = lane & 15;
    const unsigned ksrc0 = (unsigned)(drow0 * NP + ((dch ^ (drow0 & 15)) * 8)), ksrc1 = (unsigned)(drow1 * NP + ((dch ^ (drow1 & 15)) * 8));
    const unsigned vsrc0 = (unsigned)(drow0 * NP + ((dch ^ ((drow0 & 3) << 2)) * 8)), vsrc1 = (unsigned)(drow1 * NP + ((dch ^ ((drow1 & 3) << 2)) * 8));
#define AT_DMA(t_, kb_, v3_) do { const size_t tb_ = (size_t)(64 * (t_)) * NP; LAS unsigned char* bk_ = lds + (kb_) * AT_KB + wid * 1024; LAS unsigned char* bv_ = lds + AT_V0 + (v3_) * AT_VB + wid * 1024; \
        __builtin_amdgcn_global_load_lds((const unsigned*)(kg + tb_ + ksrc0), (LAS unsigned*)bk_, 16, 0, 0); __builtin_amdgcn_global_load_lds((const unsigned*)(kg + tb_ + ksrc1), (LAS unsigned*)(bk_ + 8192), 16, 0, 0); \
        __builtin_amdgcn_global_load_lds((const unsigned*)(vg + tb_ + vsrc0), (LAS unsigned*)bv_, 16, 0, 0); __builtin_amdgcn_global_load_lds((const unsigned*)(vg + tb_ + vsrc1), (LAS unsigned*)(bv_ + 8192), 16, 0, 0); } while (0)
    f32x16 o[4];
#pragma unroll
    for (int vb = 0; vb < 4; ++vb) o[vb] = f32x16{};
    float lsum = 0.f;
    AT_DMA(tf, tf & 1, tf % 3);
    __syncthreads();
    const int G = lane >> 4, qq = (lane & 15) >> 2, pp = lane & 3;
    const int vrow = (4 * hi + qq) * 256 + 8 * (pp & 1), vch = 2 * (G & 1) + (pp >> 1);
    v4u pw[4];
#define SBAR_() __builtin_amdgcn_sched_barrier(0)
#define AT_QK(t) do { \
            const LAS unsigned char* Kb = lds + ((t) & 1) * AT_KB; \
            float sl_ = slope2; asm volatile("" : "+v"(sl_));     \
            const float base = sl_ * (float)(64 * (t) + 4 * hi - qrow) - shift2; \
            float ls = 0.f; \
            _Pragma("unroll") for (int hf = 0; hf < 2; ++hf) {        \
                f32x16 p; \
                _Pragma("unroll") for (int r = 0; r < 16; ++r) p[r] = __builtin_fmaf(sl_, (float)(32 * hf + (r & 3) + 8 * (r >> 2)), base); \
                _Pragma("unroll") for (int s = 0; s < 4; ++s) { \
                    const bf16x8 a0 = *(const LAS bf16x8*)(Kb + (32 * hf + l31) * 256 + (((map * 8 + 2 * s + hi) ^ (l31 & 15)) * 16)); \
                    p = __builtin_amdgcn_mfma_f32_32x32x16_bf16(a0, qpark[s * 64], p, 0, 0, 0); } \
                if ((t) == tl) { \
                    _Pragma("unroll") for (int r = 0; r < 16; ++r) { const int ki = 64 * (t) + 32 * hf + 4 * hi + (r & 3) + 8 * (r >> 2); if (ki > qrow) p[r] = -1e30f; } } \
                _Pragma("unroll") for (int r = 0; r < 16; ++r) { p[r] = __builtin_amdgcn_exp2f(p[r]); ls += p[r]; } \
                pw[2 * hf] = (v4u){cvtpk(p[0], p[1]), cvtpk(p[2], p[3]), cvtpk(p[4], p[5]), cvtpk(p[6], p[7])}; \
                pw[2 * hf + 1] = (v4u){cvtpk(p[8], p[9]), cvtpk(p[10], p[11]), cvtpk(p[12], p[13]), cvtpk(p[14], p[15])}; } \
            lsum += ls; } while (0)
#define AT_VRD(dst, ks, vb0) do { _Pragma("unroll") for (int vb = (vb0); vb < (vb0) + 2; ++vb) { const LAS unsigned char* a_ = Vb + vrow + ((4 * vb + vch) ^ (qq << 2)) * 16 + (32 * ((ks) >> 1) + 16 * ((ks) & 1)) * 256; \
        dst[2 * (vb - (vb0))] = vtr(a_); dst[2 * (vb - (vb0)) + 1] = vtr(a_ + 8 * 256); } } while (0)
#define AT_PV(src, pwk, vb0) do { _Pragma("unroll") for (int vb = (vb0); vb < (vb0) + 2; ++vb) { const int j_ = 2 * (vb - (vb0)); \
        const bf16x8 vf = (bf16x8){src[j_][0], src[j_][1], src[j_][2], src[j_][3], src[j_ + 1][0], src[j_ + 1][1], src[j_ + 1][2], src[j_ + 1][3]}; \
        o[vb] = __builtin_amdgcn_mfma_f32_32x32x16_bf16(vf, __builtin_bit_cast(bf16x8, pwk), o[vb], 0, 0, 0); } } while (0)
#define AT_PVV(v3_) do { const LAS unsigned char* Vb = lds + AT_V0 + (v3_) * AT_VB; s16x4 vA[4], vB[4]; \
            AT_VRD(vA, 0, 0); SBAR_(); AT_VRD(vB, 0, 2); SBAR_(); \
            AT_PV(vA, pw[0], 0); SBAR_(); AT_VRD(vA, 1, 0); SBAR_(); AT_PV(vB, pw[0], 2); SBAR_(); AT_VRD(vB, 1, 2); SBAR_(); \
            AT_PV(vA, pw[1], 0); SBAR_(); AT_VRD(vA, 2, 0); SBAR_(); AT_PV(vB, pw[1], 2); SBAR_(); AT_VRD(vB, 2, 2); SBAR_(); \
            AT_PV(vA, pw[2], 0); SBAR_(); AT_VRD(vA, 3, 0); SBAR_(); AT_PV(vB, pw[2], 2); SBAR_(); AT_VRD(vB, 3, 2); SBAR_(); \
            AT_PV(vA, pw[3], 0); SBAR_(); AT_PV(vB, pw[3], 2); } while (0)
    if (map == 0) {
        int v3 = tf % 3;
#pragma unroll 1
        for (int t = tf; t < NT; ++t) { const int vn = v3 == 2 ? 0 : v3 + 1;
            if (t + 1 < NT) AT_DMA(t + 1, (t + 1) & 1, vn);
            if (t <= tl) { AT_QK(t); AT_PVV(v3); }
            __syncthreads(); v3 = vn; }
    } else {
        int v3 = tf % 3;
#pragma unroll 1
        for (int t = tf; t < NT; ++t) { const int vp = v3 == 0 ? 2 : v3 - 1, vn = v3 == 2 ? 0 : v3 + 1;
            if (t + 1 < NT) AT_DMA(t + 1, (t + 1) & 1, vn);
            if (t > tf && t - 1 <= tl) AT_PVV(vp);
            if (t <= tl) AT_QK(t);
            __syncthreads(); v3 = vn; }
        if (NT - 1 <= tl) { const int vp = v3 == 0 ? 2 : v3 - 1; AT_PVV(vp); }
    }
#undef AT_PVV
#undef AT_QK
#undef AT_VRD
#undef AT_PV
#undef SBAR_
#undef AT_DMA
    __syncthreads();
    const float ltot = swap32_sum(lsum);
    LAS float* X = (LAS float*)lds;
    if (map == 1) {
        const float sc = __uint_as_float(F.MISC[14]) / ltot;
#pragma unroll
        for (int vb = 0; vb < 4; ++vb)
#pragma unroll
            for (int r = 0; r < 16; ++r) X[(qs * 64 + vb * 16 + r) * 64 + lane] = o[vb][r] * sc;
    }
    __syncthreads();
    if (map == 0) {
        const float il = 1.f / ltot; float ss = 0.f;
#pragma unroll
        for (int vb = 0; vb < 4; ++vb)
#pragma unroll
            for (int r = 0; r < 16; ++r) { const float v = o[vb][r] * il - X[(qs * 64 + vb * 16 + r) * 64 + lane]; o[vb][r] = v; ss += v * v; }
        ss = swap32_sum(ss);
        const float rn = (1.f / sqrtf(ss * (1.f / 128.f) + 1e-5f)) * (1.f - LAMBDA_INIT);
        int etok = 0; asm volatile("" : "+v"(etok));
        const int lane_e = mk_lane(), hi = lane_e >> 5;
        const size_t mrow_e = (size_t)b * T + qb * 128 + 32 * qs + (lane_e & 31);
        const bf16* gp = F.PROJ + mrow_e * NP + C_GB + h * 128;
        bf16* op = F.MIX + mrow_e * D + 512 + h * 128;
#pragma unroll
        for (int vb = 0; vb < 4; ++vb)
#pragma unroll
            for (int rg = 0; rg < 4; ++rg) {
                const int vc = 32 * vb + 8 * rg + 4 * hi + etok;
                const v2u gw = *(const GAS v2u*)(gp + vc); const f32x4 sg = *(const GAS f32x4*)(F.subln_g + vc);
                const float g4[4] = {bflo(gw.x), bfhi(gw.x), bflo(gw.y), bfhi(gw.y)}; float ov[4];
#pragma unroll
                for (int e = 0; e < 4; ++e) ov[e] = o[vb][4 * rg + e] * rn * sg[e] * g4[e] / (1.f + __expf(-g4[e]));
                const unsigned w1_ = cvtpk(ov[2], ov[3]);
                *(GAS v2u*)(op + vc) = (v2u){cvtpk(ov[0], ov[1]), w1_};
                asm volatile("" : "+v"(etok) : "v"(w1_));
            }
    }
    __syncthreads();
}
#ifndef DBL
#define DBL 0
#endif
constexpr int CW_QUEUE = 8192;
constexpr int QX_RW = 8, QX_AT = 64, QX_ALL = QX_RW + QX_AT;
__device__ __forceinline__ void p3_queue(Frame& F, const RwDump& Dm, const int qbase = CW_QUEUE) {
    const int ql = mk_lane();
    const float l1 = wave_sum(F.lq1[ql] * F.lk1[ql]), l2 = wave_sum(F.lq2[ql] * F.lk2[ql]);
    const float lam = __uint_as_float(__builtin_amdgcn_readfirstlane(__float_as_uint(__expf(l1) - __expf(l2) + LAMBDA_INIT)));
    float gq = fabsf(F.qn_g[ql]), gk = fabsf(F.kn_g[ql]);
#pragma unroll
    for (int o = 1; o < 64; o <<= 1) { gq = fmaxf(gq, __shfl_xor(gq, o)); gk = fmaxf(gk, __shfl_xor(gk, o)); }
    const float shift2 = __uint_as_float(__builtin_amdgcn_readfirstlane(__float_as_uint(8.f * gq * gk * LOG2E)));
    if (F.wave == 0 && mk_lane() == 0) { F.MISC[14] = __float_as_uint(lam); F.MISC[15] = __float_as_uint(shift2); }
    __syncthreads();
#ifdef Q_BLK
    const int x0 = (int)(blockIdx.x & 7);
#else
    const int x0 = (int)(xb_xcc_id() & 7u);
#endif
#pragma unroll 1
    for (int dx = 0; dx < 8; ++dx) {
        const int xq = (x0 + dx) & 7;
        for (;;) {
            if (F.wave == 0 && mk_lane() == 0) F.MISC[12] = __hip_atomic_fetch_add(F.ctl + qbase + 64 * xq, 1u, RLX_AGENT);
            __syncthreads();
            const int item = __builtin_amdgcn_readfirstlane((int)F.MISC[12]);
            __syncthreads();
            if (item >= QX_ALL) break;
            if (item < QX_RW) {
#ifndef NO_RWB
                rwkvB_unit(F, Dm, xq * 8 + item);
#endif
 if (DBL & 64) rwkvB_unit(F, Dm, xq * 8 + item); }
            else { const int idx = item - QX_RW, h = 3 - (idx >> 4), qb = 15 - (idx & 15);
#pragma unroll 1
#ifndef NO_ATT
                for (int rep = 0; rep < ((DBL & 32) ? 2 : 1); ++rep) attn_unit(F, xq, h, qb);
#endif
            }
        }
    }
}

struct Args { const float* in[21]; float* out; unsigned char* ws; int ph_lo, ph_hi; };
__global__ void __launch_bounds__(NWAVES * 64, 2) hymba_fwd(Args args) {
    extern __shared__ __attribute__((aligned(16))) unsigned char lds[];
    Frame F;
    F.lds = (LAS unsigned char*)lds;
    F.MISC = (volatile LAS unsigned*)(F.lds + MISC_OFF);
    F.wave = __builtin_amdgcn_readfirstlane((int)threadIdx.x >> 6); F.lane = mk_lane(); F.tid = F.wave * 64 + F.lane;
    F.G = gridDim.x; { const int bx = blockIdx.x; F.vcu = (F.G % 8 == 0) ? (bx % 8) * (F.G / 8) + bx / 8 : bx; }
    unsigned char* ws = args.ws;
    F.ctl = (gu32*)(ws + WS_CTL);
    F.x = args.in[0]; F.norm_g = args.in[1]; F.w_in = args.in[2]; F.shift_mu = args.in[3]; F.w0 = args.in[4]; F.w_decay_up = args.in[5]; F.a0 = args.in[6]; F.w_iclr_up = args.in[7];
    F.k_k = args.in[8]; F.k_a = args.in[9]; F.r_k = args.in[10]; F.ln_w = args.in[11]; F.ln_b = args.in[12]; F.qn_g = args.in[13]; F.kn_g = args.in[14];
    F.lq1 = args.in[15]; F.lk1 = args.in[16]; F.lq2 = args.in[17]; F.lk2 = args.in[18]; F.subln_g = args.in[19]; F.w_out = args.in[20]; F.out = args.out;
    F.WinT = (bf16*)(ws + WS_WIN); F.WoutT = (bf16*)(ws + WS_WOUT); F.WdT = (bf16*)(ws + WS_WD); F.WaT = (bf16*)(ws + WS_WA);
    F.XN = (bf16*)(ws + WS_XN); F.PROJ = (bf16*)(ws + WS_PROJ); F.MIX = (bf16*)(ws + WS_MIX);
    for (int u = F.tid; u < (LDS_BYTES - LDSCTL_OFF) / 4; u += NWAVES * 64) ((LAS unsigned*)(F.lds + LDSCTL_OFF))[u] = 0u;
    __syncthreads();
    XcdBarrier bar; bar.bar = (unsigned*)(F.ctl + CW_BAR); bar.x = 0; bar.st = nullptr; bar.wave = F.wave;
    if (MK_N_LAUNCHES == 1) bar = xcd_barrier_post((unsigned*)(F.ctl + CW_BAR), F.MISC + 8, F.wave);
#define GRID_BAR() do { if (MK_N_LAUNCHES == 1) xcd_barrier(bar); } while (0)
    const int lo = args.ph_lo, hi = args.ph_hi;
#define IN(k) (lo <= (k) && (k) < hi)
#define BOTH(k) (IN(k) && IN((k) + 1))
#ifndef SKIP
#define SKIP 0
#endif
    if (IN(0) && !(SKIP & 1)) { p0_prologue(F); if (DBL & 1) { GRID_BAR(); p0_prologue(F); } if (BOTH(0)) GRID_BAR(); }
    if (IN(1) && !(SKIP & 2)) {
        pg8::Gemm g{F.XN, F.WinT, M, NP, D}; pg8::StaticOrder S; S.init(M, NP, F.G, (int)blockIdx.x);
        pg8::EpiBf16S E{F.PROJ, NP};
        pg8::gemm_phase<pg8::EpiBf16S, pg8::StaticOrder, true, true>(F.lds + RING_OFF, g, S, E, F.wave);
        if (DBL & 2) { GRID_BAR(); pg8::gemm_phase<pg8::EpiBf16S, pg8::StaticOrder, true, true>(F.lds + RING_OFF, g, S, E, F.wave); }
        if (BOTH(1)) GRID_BAR();
    }
    RwDump Dm; { unsigned char* so = (unsigned char*)args.out; Dm.PF = (v4u*)so; Dm.DD = (v4u*)(so + 32 * MiB); Dm.QF = (v4u*)(ws + WS_XN); Dm.YD = (v4u*)(ws + WS_XN + 16 * MiB);
        Dm.GAM = (float*)(ws + WS_END); Dm.RHO = (float*)(ws + WS_END + 1 * MiB); }
    if (IN(2) && !(SKIP & 4)) {
        LAS float* wscr = (LAS float*)(F.lds + LDSCTL_OFF + 1024) + F.wave * 64;
#pragma unroll 1
        for (int p = F.vcu; p < BATCH * (T / 32); p += F.G) rwkvA_unit(F, Dm, (p >> 6) * RH + F.wave, p & 63, wscr, F.lds + RING_OFF + F.wave * 16384);
        if (DBL & 4) { GRID_BAR();
#pragma unroll 1
            for (int p = F.vcu; p < BATCH * (T / 32); p += F.G) rwkvA_unit(F, Dm, (p >> 6) * RH + F.wave, p & 63, wscr, F.lds + RING_OFF + F.wave * 16384); }
        p2_qknorm(F);
        if (BOTH(2)) GRID_BAR();
    }
    if (IN(3) && !(SKIP & 8)) {
        p3_queue(F, Dm);
        if (DBL & 512) { GRID_BAR(); p3_queue(F, Dm, CW_QUEUE + 1024); }
        if (BOTH(3)) GRID_BAR();
    }
    if (IN(4) && !(SKIP & 16)) {
        pg8::Gemm g{F.MIX, F.WoutT, M, D, D}; pg8::StaticOrder S; S.init(M, D, F.G, (int)blockIdx.x);
        pg8::EpiResF32 E{F.x, F.out, D};
        pg8::gemm_phase<pg8::EpiResF32, pg8::StaticOrder, false, true>(F.lds + RING_OFF, g, S, E, F.wave);
        if (DBL & 16) { GRID_BAR(); pg8::gemm_phase<pg8::EpiResF32, pg8::StaticOrder, false, true>(F.lds + RING_OFF, g, S, E, F.wave); }
    }
#undef IN
#undef BOTH
}

extern "C" void kernel_launch(void* const* d_in, const int* in_sizes, int n_in, void* d_out, int out_size, void* d_ws, size_t ws_size, hipStream_t stream) {
    static int grid = 0;
    if (grid == 0) {
        if (n_in != 21 || in_sizes[0] != M * D || out_size != M * D || ws_size < WS_END + 2 * MiB) { fprintf(stderr, "kernel_launch: unexpected shapes (n_in %d, in0 %d, out %d, ws %zu); nothing launched\n", n_in, n_in > 0 ? in_sizes[0] : -1, out_size, ws_size); grid = -1; return; }
        int dev = 0, cus = 0, per_cu = 0;
        if (hipGetDevice(&dev) != hipSuccess || hipDeviceGetAttribute(&cus, hipDeviceAttributeMultiprocessorCount, dev) != hipSuccess) { grid = -1; return; }
        if (hipFuncSetAttribute((const void*)hymba_fwd, hipFuncAttributeMaxDynamicSharedMemorySize, LDS_BYTES) != hipSuccess) { fprintf(stderr, "kernel_launch: hipFuncSetAttribute failed\n"); grid = -1; return; }
        if (hipOccupancyMaxActiveBlocksPerMultiprocessor(&per_cu, (const void*)hymba_fwd, NWAVES * 64, LDS_BYTES) != hipSuccess || per_cu < 1) { fprintf(stderr, "kernel_launch: occupancy query reports %d workgroups per CU; nothing launched\n", per_cu); grid = -1; return; }
        (void)hipGetLastError();
        grid = cus;
        if (grid > 256) grid = 256;
    }
    if (grid < 0) return;
    if (hipMemsetAsync((char*)d_ws + WS_CTL, 0, CTL_ZERO_BYTES, stream) != hipSuccess) { fprintf(stderr, "kernel_launch: hipMemsetAsync failed\n"); return; }
    Args a{};
    for (int i = 0; i < 21; ++i) a.in[i] = (const float*)d_in[i];
    a.out = (float*)d_out; a.ws = (unsigned char*)d_ws;
    for (int li = 0; li < MK_N_LAUNCHES; ++li) {
        a.ph_lo = (MK_N_LAUNCHES == 1) ? 0 : li; a.ph_hi = (MK_N_LAUNCHES == 1) ? N_PHASES : li + 1;
        hipLaunchKernelGGL(hymba_fwd, dim3(grid), dim3(NWAVES * 64), LDS_BYTES, stream, a);
        const hipError_t le = hipPeekAtLastError();
        if (le != hipSuccess) { fprintf(stderr, "kernel_launch: launch %d failed: %s\n", li, hipGetErrorName(le)); break; }
    }
}
```

```cpp
#define MK_N_LAUNCHES 1
#include <hip/hip_runtime.h>
#include <hip/hip_bf16.h>
#include <cstdio>
#include <cstdint>
#include <cmath>
namespace pg8 {
#define PG8_LAS __attribute__((address_space(3)))
typedef unsigned short bf16_t;
typedef short bf16x8 __attribute__((ext_vector_type(8)));
typedef float f32x4 __attribute__((ext_vector_type(4)));
typedef unsigned u32x4 __attribute__((ext_vector_type(4)));
constexpr int BM = 256, BK = 64, HALF = 128, HTB = HALF * BK * 2  , STAGE_BYTES = 8 * HTB, NXCD = 8, WGM = 8;

__host__ __device__ __forceinline__ int lds_byte(int r, int c) { const int st = (r >> 4) * 2 + (c >> 5), rr = r & 15, cc = c & 31, ob = rr * 64 + cc * 2; return st * 1024 + (ob ^ (((ob >> 9) & 1) << 5)); }
__host__ __device__ __forceinline__ void stage_rc(int b, int& R, int& C) { const int st = b / 1024, sb = b % 1024, swz = sb ^ (((sb >> 9) & 1) << 5); R = (st >> 1) * 16 + swz / 64; C = (st & 1) * 32 + (swz % 64) / 2; }
__host__ __device__ __forceinline__ int perm32(int rho) { const int n = rho >> 4, i = rho & 15; return 8 * (i >> 2) + 4 * n + (i & 3); }

__device__ __forceinline__ int mk_lane_pg8() { int l; asm volatile("v_mbcnt_lo_u32_b32 %0, -1, 0\n\tv_mbcnt_hi_u32_b32 %0, -1, %0" : "=v"(l)); return l; }
struct Unit { int pm, pn; };
struct Gemm { const bf16_t* A; const bf16_t* Bt; int M, N, K; };

struct StaticOrder {
    int nM, nN, nwg, G, c;
    __host__ __device__ void init(int M, int N, int G_, int c_) { nM = M / BM; nN = N / BM; nwg = nM * nN; G = G_; c = c_; }
    __host__ __device__ bool next(int i, Unit& u) const {
        const long L = (long)i * G + c; if (L >= nwg) return false;
        int wgid = (int)L; { const int q = nwg / NXCD, r = nwg % NXCD, xcd = wgid % NXCD, off = wgid / NXCD; wgid = (xcd < r ? xcd * (q + 1) : r * (q + 1) + (xcd - r) * q) + off; }
        const int nig = WGM * nN, gid = wgid / nig, fm = gid * WGM, gsz = (nM - fm) < WGM ? (nM - fm) : WGM;
        u.pm = fm + ((wgid % nig) % gsz); u.pn = (wgid % nig) / gsz; return true;
    }
    __device__ __forceinline__ void a_ready(const Unit&) const {}
    __device__ __forceinline__ void done(const Unit&) const {}
};

__device__ __forceinline__ unsigned cvt_pk_bf16(float lo, float hi) { unsigned r; asm volatile("v_cvt_pk_bf16_f32 %0, %1, %2" : "=v"(r) : "v"(lo), "v"(hi)); return r; }
struct EpiBf16S {
    static constexpr bool PERM = true, AFTER_DRAIN = false;
    bf16_t* O; int ldc;
    __device__ __forceinline__ void operator()(const f32x4 (&acc)[2][2][4][2], const Unit& u, int wr, int wc, int fr, int fq) const {
        const int row0 = u.pm * BM + wr * 64 + fr, col0 = u.pn * BM + wc * 32 + 8 * fq;
#pragma unroll
        for (int ai = 0; ai < 2; ++ai)
#pragma unroll
            for (int m = 0; m < 4; ++m) { bf16_t* rowp = O + (size_t)(row0 + ai * HALF + m * 16) * ldc + col0;
#pragma unroll
                for (int bj = 0; bj < 2; ++bj) { const f32x4 v0 = acc[ai][bj][m][0], v1 = acc[ai][bj][m][1];
                    u32x4 w; w.x = cvt_pk_bf16(v0[0], v0[1]); w.y = cvt_pk_bf16(v0[2], v0[3]); w.z = cvt_pk_bf16(v1[0], v1[1]); w.w = cvt_pk_bf16(v1[2], v1[3]);
                    *(u32x4*)(rowp + bj * HALF) = w; } }
    }
};
struct EpiResF32 {
    static constexpr bool PERM = false, AFTER_DRAIN = false;
    const float* base; float* out; int ldc;
    __device__ __forceinline__ void operator()(const f32x4 (&acc)[2][2][4][2], const Unit& u, int wr, int wc, int fr, int fq) const {
        const int row0 = u.pm * BM + wr * 64 + fr, col0 = u.pn * BM + wc * 32 + 4 * fq;
#pragma unroll
        for (int ai = 0; ai < 2; ++ai)
#pragma unroll
            for (int m = 0; m < 4; ++m) { const size_t off = (size_t)(row0 + ai * HALF + m * 16) * ldc + col0;
#pragma unroll
                for (int bj = 0; bj < 2; ++bj)
#pragma unroll
                    for (int n = 0; n < 2; ++n) { const f32x4 bs = *(const f32x4*)(base + off + bj * HALF + n * 16); *(f32x4*)(out + off + bj * HALF + n * 16) = bs + acc[ai][bj][m][n]; } }
    }
};
template <class Epi, class Sched, bool ALIGN_EPI = false, bool SP2 = false>
__device__ __forceinline__ void gemm_phase(PG8_LAS unsigned char* lds, const Gemm g, const Sched& S, const Epi& E, const int mk_wave_id  ) {
    const int wid = mk_wave_id, lane = mk_lane_pg8(), tid = wid * 64 + lane, wr = wid >> 2, wc = wid & 3, fr = lane & 15, fq = lane >> 4;
    const int K = g.K, nt = K / BK;
    unsigned voffA[2], voffB[2];
#pragma unroll
    for (int i = 0; i < 2; ++i) { int R, C; stage_rc(tid * 16 + i * 8192, R, C); const int Rb = Epi::PERM ? ((R & ~31) + perm32(R & 31)) : R;
        voffA[i] = (unsigned)(R * K + C) * 2u; voffB[i] = (unsigned)(Rb * K + C) * 2u; }
    const size_t kstep = (size_t)(BK * 2);
    const size_t hstep = (size_t)HALF * K * 2;
    const size_t tstep = 2 * hstep;
    const unsigned ldsw = (unsigned)wid * 1024u;
    const int aoff = lds_byte(wr * 64 + fr, fq * 8), boff = lds_byte(wc * 32 + fr, fq * 8);
#define PG8_SA(b, h) (((b) * 2 + (h)) * HTB)
#define PG8_SB(b, h) ((4 + (b) * 2 + (h)) * HTB)
#define PG8_STAGE(bufoff, gbase, voff) do { _Pragma("unroll") for (int _i = 0; _i < 2; ++_i) \
        __builtin_amdgcn_global_load_lds((const unsigned*)((const char*)(gbase) + (voff)[_i]), (PG8_LAS unsigned*)(lds + (bufoff) + ldsw + _i * 8192), 16, 0, 0); } while (0)
#define PG8_LDA(dst, b, h) do { _Pragma("unroll") for (int m = 0; m < 4; ++m) _Pragma("unroll") for (int k = 0; k < 2; ++k) dst[m][k] = *(const PG8_LAS bf16x8*)(lds + PG8_SA(b, h) + aoff + m * 2048 + k * 1024); } while (0)
#define PG8_LDB(dst, b, h) do { _Pragma("unroll") for (int n = 0; n < 2; ++n) _Pragma("unroll") for (int k = 0; k < 2; ++k) dst[n][k] = *(const PG8_LAS bf16x8*)(lds + PG8_SB(b, h) + boff + n * 2048 + k * 1024); } while (0)
#define PG8_MMA(ai, bj, At, Bt) do { __builtin_amdgcn_s_setprio(1); _Pragma("unroll") for (int m = 0; m < 4; ++m) _Pragma("unroll") for (int n = 0; n < 2; ++n) _Pragma("unroll") for (int k = 0; k < 2; ++k) \
        acc[ai][bj][m][n] = __builtin_amdgcn_mfma_f32_16x16x32_bf16(Bt[n][k], At[m][k], acc[ai][bj][m][n], 0, 0, 0); __builtin_amdgcn_s_setprio(0); } while (0)
#define PG8_WAIT_V(n) asm volatile("s_waitcnt vmcnt(" #n ")" ::: "memory")
#define PG8_WAIT_L(n) asm volatile("s_waitcnt lgkmcnt(" #n ")" ::: "memory")
#define PG8_BAR __builtin_amdgcn_s_barrier()
#define PG8_SCHED __builtin_amdgcn_sched_barrier(0)
    Unit cur, nxt; int ui = 0;
    if (!S.next(0, cur)) return;
    f32x4 acc[2][2][4][2];
#pragma unroll
    for (int a = 0; a < 2; ++a)
#pragma unroll
        for (int b = 0; b < 2; ++b)
#pragma unroll
            for (int m = 0; m < 4; ++m)
#pragma unroll
                for (int n = 0; n < 2; ++n) acc[a][b][m][n] = (f32x4){0.f, 0.f, 0.f, 0.f};
    bf16x8 At[4][2], B0[2][2], B1[2][2];
    const char* cA = (const char*)g.A + (size_t)cur.pm * tstep; const char* cB = (const char*)g.Bt + (size_t)cur.pn * tstep;
    S.a_ready(cur);
    if constexpr (SP2) {
        PG8_STAGE(PG8_SB(0, 0), cB, voffB); PG8_STAGE(PG8_SB(0, 1), cB + hstep, voffB); PG8_STAGE(PG8_SA(0, 0), cA, voffA); PG8_STAGE(PG8_SA(0, 1), cA + hstep, voffA);
        if (wr == 1) PG8_BAR;
        PG8_WAIT_V(2); PG8_BAR;
        PG8_STAGE(PG8_SB(1, 0), cB + kstep, voffB); PG8_STAGE(PG8_SA(1, 0), cA + kstep, voffA); PG8_STAGE(PG8_SB(1, 1), cB + hstep + kstep, voffB);
        PG8_WAIT_V(6); PG8_BAR;
    } else {
        PG8_STAGE(PG8_SB(0, 0), cB, voffB); PG8_STAGE(PG8_SA(0, 0), cA, voffA); PG8_STAGE(PG8_SB(0, 1), cB + hstep, voffB); PG8_STAGE(PG8_SA(0, 1), cA + hstep, voffA);
        if (wr == 1) PG8_BAR;
        PG8_WAIT_V(4); PG8_BAR;
        PG8_STAGE(PG8_SB(1, 0), cB + kstep, voffB); PG8_STAGE(PG8_SA(1, 0), cA + kstep, voffA); PG8_STAGE(PG8_SB(1, 1), cB + hstep + kstep, voffB);
        PG8_WAIT_V(6); PG8_BAR;
    }
    for (;;) {
        const bool has_next = S.next(ui + 1, nxt);
        const char* nA = has_next ? (const char*)g.A + (size_t)nxt.pm * tstep : cA; const char* nB = has_next ? (const char*)g.Bt + (size_t)nxt.pn * tstep : cB;
        for (int t = 0; t < nt; t += 2) {
            const bool last = (t == nt - 2);
            const char* a1 = cA + (size_t)(t + 1) * kstep;
            const char* a2 = last ? nA : cA + (size_t)(t + 2) * kstep; const char* b2 = last ? nB : cB + (size_t)(t + 2) * kstep;
            const char* a3 = a2 + kstep; const char* b3 = b2 + kstep;
            if (last && has_next) S.a_ready(nxt);
            if constexpr (SP2) {
            PG8_LDB(B0, 0, 0); PG8_LDB(B1, 0, 1); PG8_SCHED; PG8_LDA(At, 0, 0); PG8_STAGE(PG8_SA(1, 1), a1 + hstep, voffA);
            PG8_WAIT_V(8); PG8_WAIT_L(0); PG8_BAR; PG8_MMA(0, 0, At, B0); PG8_MMA(0, 1, At, B1); PG8_BAR; PG8_SCHED;
            PG8_LDA(At, 0, 1); PG8_STAGE(PG8_SB(0, 0), b2, voffB); PG8_STAGE(PG8_SB(0, 1), b2 + hstep, voffB); PG8_STAGE(PG8_SA(0, 0), a2, voffA);
            PG8_WAIT_V(8); PG8_WAIT_L(0); PG8_BAR; PG8_MMA(1, 0, At, B0); PG8_MMA(1, 1, At, B1); PG8_BAR; PG8_SCHED;
            PG8_LDB(B0, 1, 0); PG8_LDB(B1, 1, 1); PG8_SCHED; PG8_LDA(At, 1, 0); PG8_STAGE(PG8_SA(0, 1), a2 + hstep, voffA);
            PG8_WAIT_V(8); PG8_WAIT_L(0); PG8_BAR; PG8_MMA(0, 0, At, B0); PG8_MMA(0, 1, At, B1); PG8_BAR; PG8_SCHED;
            PG8_LDA(At, 1, 1); PG8_STAGE(PG8_SB(1, 0), b3, voffB); PG8_STAGE(PG8_SB(1, 1), b3 + hstep, voffB); PG8_STAGE(PG8_SA(1, 0), a3, voffA);
            PG8_WAIT_V(8); PG8_WAIT_L(0); PG8_BAR; PG8_MMA(1, 0, At, B0); PG8_MMA(1, 1, At, B1); PG8_BAR; PG8_SCHED;
            } else {
            PG8_LDB(B0, 0, 0); PG8_SCHED; PG8_LDA(At, 0, 0); PG8_STAGE(PG8_SA(1, 1), a1 + hstep, voffA);
            PG8_WAIT_L(8); PG8_BAR; PG8_WAIT_L(0); PG8_MMA(0, 0, At, B0); PG8_BAR; PG8_SCHED;
            PG8_LDB(B1, 0, 1); PG8_STAGE(PG8_SB(0, 0), b2, voffB);
            PG8_BAR; PG8_WAIT_L(0); PG8_MMA(0, 1, At, B1); PG8_BAR;
            PG8_LDA(At, 0, 1); PG8_STAGE(PG8_SA(0, 0), a2, voffA);
            PG8_BAR; PG8_WAIT_L(0); PG8_MMA(1, 0, At, B0); PG8_BAR; PG8_SCHED;
            PG8_STAGE(PG8_SB(0, 1), b2 + hstep, voffB);
            PG8_WAIT_V(6); PG8_BAR; PG8_MMA(1, 1, At, B1); PG8_BAR;
            PG8_LDB(B0, 1, 0); PG8_SCHED; PG8_LDA(At, 1, 0); PG8_STAGE(PG8_SA(0, 1), a2 + hstep, voffA);
            PG8_WAIT_L(8); PG8_BAR; PG8_WAIT_L(0); PG8_MMA(0, 0, At, B0); PG8_BAR; PG8_SCHED;
            PG8_LDB(B1, 1, 1); PG8_STAGE(PG8_SB(1, 0), b3, voffB);
            PG8_BAR; PG8_WAIT_L(0); PG8_MMA(0, 1, At, B1); PG8_BAR;
            PG8_LDA(At, 1, 1); PG8_STAGE(PG8_SA(1, 0), a3, voffA);
            PG8_BAR; PG8_WAIT_L(0); PG8_MMA(1, 0, At, B0); PG8_BAR; PG8_SCHED;
            PG8_STAGE(PG8_SB(1, 1), b3 + hstep, voffB);
            PG8_WAIT_V(6); PG8_BAR; PG8_MMA(1, 1, At, B1); PG8_BAR;
            }
        }
        if constexpr (ALIGN_EPI) { if (wr == 0) PG8_BAR; }
        if constexpr (!Epi::AFTER_DRAIN) { E(acc, cur, wr, wc, fr, fq); S.done(cur); }
        if (!has_next) break;
#pragma unroll
        for (int a = 0; a < 2; ++a)
#pragma unroll
            for (int b = 0; b < 2; ++b)
#pragma unroll
                for (int m = 0; m < 4; ++m)
#pragma unroll
                    for (int n = 0; n < 2; ++n) acc[a][b][m][n] = (f32x4){0.f, 0.f, 0.f, 0.f};
        cur = nxt; cA = nA; cB = nB; ++ui;
        if constexpr (ALIGN_EPI) { if (wr == 1) PG8_BAR; }
    }
    PG8_WAIT_V(0);
    if constexpr (!ALIGN_EPI) { if (wr == 0) PG8_BAR; }
    PG8_BAR;
    if constexpr (Epi::AFTER_DRAIN) { E.fused(acc, cur, wr, wc, fr, fq, lds, wid, lane); S.done(cur); }
#undef PG8_SA
#undef PG8_SB
#undef PG8_STAGE
#undef PG8_LDA
#undef PG8_LDB
#undef PG8_MMA
#undef PG8_WAIT_V
#undef PG8_WAIT_L
#undef PG8_BAR
#undef PG8_SCHED
}
}
constexpr int NWAVES = 8;
#ifndef MK_N_LAUNCHES
#define MK_N_LAUNCHES 1
#endif
constexpr int N_PHASES = 5;
constexpr int BATCH = 8, T = 2048, D = 1024, M = BATCH * T;
constexpr int NP = 4352;
constexpr int C_R = 0, C_K = 512, C_V = 1024, C_ZW = 1536, C_ZA = 1600, C_GA = 1792, C_DQ = 2304, C_DK = 2816, C_DV = 3328, C_GB = 3840;
constexpr int RH = 8, RN = 64;
constexpr int AH = 4;
constexpr float C2 = 0.125f * 1.4426950408889634f;
constexpr float LOG2E = 1.4426950408889634f;
constexpr float LAMBDA_INIT = 0.2f;

constexpr size_t MiB = 1u << 20;
constexpr size_t WS_CTL = 0, CTL_ZERO_BYTES = 1 * MiB;
constexpr size_t WS_WIN = 2 * MiB;
constexpr size_t WS_WOUT = 11 * MiB;
constexpr size_t WS_WD = 13 * MiB, WS_WA = 13 * MiB + 65536;
constexpr size_t WS_RHO = 13 * MiB + 2 * 65536;
constexpr size_t WS_XN = 14 * MiB;
constexpr size_t WS_PROJ = 46 * MiB;
constexpr size_t WS_MIX = 182 * MiB;
constexpr size_t WS_END = 214 * MiB;
constexpr int CW_BAR = 4096;

constexpr int RING_OFF = 0, RING_BYTES = 131072;
constexpr int LDSCTL_OFF = RING_BYTES, MISC_OFF = LDSCTL_OFF + 320;
constexpr int LDS_BYTES = 147456;

#define GAS __attribute__((address_space(1)))
#define LAS __attribute__((address_space(3)))
typedef unsigned short bf16;
typedef unsigned v4u __attribute__((ext_vector_type(4)));
typedef unsigned v2u __attribute__((ext_vector_type(2)));
typedef float f32x4 __attribute__((ext_vector_type(4)));
typedef float f32x16 __attribute__((ext_vector_type(16)));
typedef short bf16x8 __attribute__((ext_vector_type(8)));
typedef short s16x4 __attribute__((ext_vector_type(4)));
typedef GAS unsigned gu32;
typedef GAS unsigned long long gu64;
#define RLX_AGENT __ATOMIC_RELAXED, __HIP_MEMORY_SCOPE_AGENT
#define LDS_WAIT() asm volatile("s_waitcnt lgkmcnt(0)" ::: "memory")
#define VM_WAIT() asm volatile("s_waitcnt vmcnt(0)" ::: "memory")
__device__ __forceinline__ unsigned f2bf(float f) { unsigned u = __builtin_bit_cast(unsigned, f); return (u + 0x7fffu + ((u >> 16) & 1u)) >> 16; }
__device__ __forceinline__ unsigned pk2(float lo, float hi) { return f2bf(lo) | (f2bf(hi) << 16); }
__device__ __forceinline__ float bflo(unsigned u) { return __uint_as_float(u << 16); }
__device__ __forceinline__ float bfhi(unsigned u) { return __uint_as_float(u & 0xffff0000u); }
__device__ __forceinline__ float bf1(unsigned short u) { return __uint_as_float((unsigned)u << 16); }
__device__ __forceinline__ int mk_lane() { int l; asm volatile("v_mbcnt_lo_u32_b32 %0, -1, 0\n\tv_mbcnt_hi_u32_b32 %0, -1, %0" : "=v"(l)); return l; }
#define XB_TMO      128
#define XB_XCNT(j)  (256  + 64 * (j))
#define XB_XSUB(j)  (1280 + 64 * (j))
#define XB_XGEN(j)  (2304 + 64 * (j))
#define XB_TOP      3328
#define XB_TOPGEN   3392
#define XCD_BAR_WORDS 3456
#define XB_SPIN_CAP (1u << 18)

__device__ __forceinline__ unsigned xb_ld(unsigned* p)              { return __hip_atomic_load(p, __ATOMIC_RELAXED, __HIP_MEMORY_SCOPE_AGENT); }
__device__ __forceinline__ unsigned xb_add(unsigned* p, unsigned v) { return __hip_atomic_fetch_add(p, v, __ATOMIC_RELAXED, __HIP_MEMORY_SCOPE_AGENT); }
__device__ __forceinline__ unsigned xb_xcc_id() { return (unsigned)__builtin_amdgcn_s_getreg((3 << 11) | 20) & 0xFu; }
#define XB_SPIN(cond, bar) do { unsigned _sp = 0; while (cond) { __builtin_amdgcn_s_sleep(1); \
    if ((++_sp & 255u) == 0u) { if (xb_ld(&(bar)[XB_TMO])) break; if (_sp > XB_SPIN_CAP) { atomicAdd(&(bar)[XB_TMO], 1u); break; } } } } while (0)

struct XcdBarrier {
    unsigned* bar; unsigned x;
    volatile LAS unsigned* st;
    int wave;
};

__device__ __forceinline__ XcdBarrier xcd_barrier_post(unsigned* bar, volatile LAS unsigned* st, int wave) {
    XcdBarrier b; b.bar = bar; b.x = xb_xcc_id(); b.st = st; b.wave = wave;
    if (wave == 0 && mk_lane() == 0) (void)xb_add(&bar[XB_XCNT(b.x)], 1u);
    return b;
}
__device__ __forceinline__ void xcd_barrier_complete(unsigned* bar, unsigned x, unsigned& nloc, unsigned& nx) {
    const unsigned G = gridDim.x * gridDim.y * gridDim.z;
    unsigned sum, cnt, mine, sp = 0u;
    for (;;) {
        sum = 0u; cnt = 0u; mine = 0u;
#pragma unroll
        for (unsigned j = 0; j < 16; ++j) { const unsigned c = xb_ld(&bar[XB_XCNT(j)]); sum += c; cnt += (c > 0u) ? 1u : 0u; mine = (j == x) ? c : mine; }
        if (sum == G) break;
        __builtin_amdgcn_s_sleep(1);
        if ((++sp & 255u) == 0u) { if (xb_ld(&bar[XB_TMO])) break; if (sp > XB_SPIN_CAP) { atomicAdd(&bar[XB_TMO], 1u); break; } }
    }
    nloc = mine > 0u ? mine : 1u; nx = cnt > 0u ? cnt : 1u;
}

__device__ __forceinline__ void xcd_barrier(const XcdBarrier& b) {
    asm volatile("s_waitcnt vmcnt(0)" ::: "memory");
    __syncthreads();
    if (b.wave == 0 && mk_lane() == 0) {
        unsigned* bar = b.bar;
        __builtin_amdgcn_s_waitcnt(0);
        unsigned nloc = b.st[0], nx = b.st[1];
        if (nloc == 0u) { xcd_barrier_complete(bar, b.x, nloc, nx); b.st[0] = nloc; b.st[1] = nx; }
        const unsigned old = xb_add(&bar[XB_XSUB(b.x)], 1u);
        const unsigned gen = old / nloc;
        if (old + 1u == (gen + 1u) * nloc) {
            __builtin_amdgcn_fence(__ATOMIC_RELEASE, "agent");
            asm volatile("s_waitcnt vmcnt(0)" ::: "memory");
            const unsigned og = xb_add(&bar[XB_TOP], 1u);
            const unsigned tg = og / nx;
            if (og + 1u == (tg + 1u) * nx) xb_add(&bar[XB_TOPGEN], 1u);
            else XB_SPIN(xb_ld(&bar[XB_TOPGEN]) == tg, bar);
            __builtin_amdgcn_fence(__ATOMIC_ACQUIRE, "agent");
            xb_add(&bar[XB_XGEN(b.x)], 1u);
            asm volatile("s_waitcnt vmcnt(0)" ::: "memory");
        } else {
            XB_SPIN(xb_ld(&bar[XB_XGEN(b.x)]) == gen, bar);
            __builtin_amdgcn_fence(__ATOMIC_ACQUIRE, "agent");
            asm volatile("s_waitcnt vmcnt(0)" ::: "memory");
        }
    }
    __syncthreads();
}
struct Frame {
    LAS unsigned char* lds;
    volatile LAS unsigned* MISC;
    gu32* ctl;
    int tid, lane, wave;
    int vcu, G;
    const float* x; float* out;
    const float *norm_g, *w_in, *shift_mu, *w0, *w_decay_up, *a0, *w_iclr_up, *k_k, *k_a, *r_k, *ln_w, *ln_b, *qn_g, *kn_g, *lq1, *lk1, *lq2, *lk2, *subln_g, *w_out;
    bf16 *WinT, *WoutT, *WdT, *WaT, *XN, *PROJ, *MIX;
};

typedef float f32x2q_t __attribute__((ext_vector_type(2))); typedef __bf16 bf16x2q_t __attribute__((ext_vector_type(2)));
__device__ __forceinline__ unsigned cvtpk2(float lo, float hi) { f32x2q_t v = {lo, hi}; bf16x2q_t b = __builtin_convertvector(v, bf16x2q_t); return __builtin_bit_cast(unsigned, b); }
__device__ __forceinline__ float wave_sum(float v) {
#pragma unroll
    for (int o = 1; o < 64; o <<= 1) v += __shfl_xor(v, o);
    return v;
}
template <int CTRL> __device__ __forceinline__ float dpp_f(float x) { return __builtin_bit_cast(float, __builtin_amdgcn_mov_dpp(__builtin_bit_cast(int, x), CTRL, 0xf, 0xf, true)); }
__device__ __forceinline__ float row16_sum(float x) {
    x += dpp_f<0xB1>(x); x += dpp_f<0x4E>(x); x += dpp_f<0x141>(x); x += dpp_f<0x140>(x); return x;
}
__device__ __forceinline__ float swap32_sum(float x) {
    auto rr = __builtin_amdgcn_permlane32_swap(__float_as_uint(x), __float_as_uint(x), false, false);
    return __uint_as_float(rr[0]) + __uint_as_float(rr[1]);
}

__device__ __forceinline__ void p0_transpose_item(const float* W, int N, int nsrc, const float* kscale, bf16* WT, int K, int ndst, LAS float* scr, int k0, int lane) {
    float v[32];
#pragma unroll
    for (int i = 0; i < 32; ++i) { const int kk = 2 * i + (lane >> 5); v[i] = (nsrc >= 0) ? W[(size_t)(k0 + kk) * N + nsrc + (lane & 31)] : 0.f; }
    if (kscale && nsrc >= 0) {
#pragma unroll
        for (int i = 0; i < 32; ++i) v[i] *= kscale[k0 + 2 * i + (lane >> 5)];
    }
#pragma unroll
    for (int i = 0; i < 32; ++i) scr[(2 * i + (lane >> 5)) * 33 + (lane & 31)] = v[i];
    LDS_WAIT(); asm volatile("" ::: "memory");
    const int c = lane & 7;
#pragma unroll
    for (int j = 0; j < 4; ++j) { const int n = (lane >> 3) + 8 * j; const LAS float* s = scr + (8 * c) * 33 + n;
        v4u o; o.x = cvtpk2(s[0 * 33], s[1 * 33]); o.y = cvtpk2(s[2 * 33], s[3 * 33]); o.z = cvtpk2(s[4 * 33], s[5 * 33]); o.w = cvtpk2(s[6 * 33], s[7 * 33]);
        *(GAS v4u*)(WT + (size_t)(ndst + n) * K + k0 + 8 * c) = o; }
    LDS_WAIT(); asm volatile("" ::: "memory");
}
__device__ __forceinline__ void p0_prologue(Frame& F) {
    LAS float* scr = (LAS float*)(F.lds + RING_OFF + F.wave * 16384);
    const int gw = F.vcu * NWAVES + F.wave, NGW = F.G * NWAVES;
    constexpr int I_IN = (D / 64) * (NP / 32), I_OUT = (D / 64) * (D / 32), I_L = 512 / 32;
    constexpr int NITEMS = I_IN + I_OUT + 2 * I_L;
    for (int it = gw; it < NITEMS; it += NGW) {
        int r = it;
        if (r < I_IN) { const int kb = r / (NP / 32), nb = r % (NP / 32), nd = 32 * nb; const int ns = nd < 1664 ? nd : (nd < 1792 ? -1 : nd - 128);
            p0_transpose_item(F.w_in, 4224, ns, F.norm_g, F.WinT, D, nd, scr, 64 * kb, F.lane); continue; } r -= I_IN;
        if (r < I_OUT) { const int kb = r / (D / 32), nb = r % (D / 32);
            p0_transpose_item(F.w_out, D, 32 * nb, nullptr, F.WoutT, D, 32 * nb, scr, 64 * kb, F.lane); continue; } r -= I_OUT;
        if (r < I_L) { p0_transpose_item(F.w_decay_up, 512, 32 * r, nullptr, F.WdT, 64, 32 * r, scr, 0, F.lane); continue; } r -= I_L;
        p0_transpose_item(F.w_iclr_up, 512, 32 * r, nullptr, F.WaT, 64, 32 * r, scr, 0, F.lane);
    }
    for (int m0 = gw * 4; m0 < M; m0 += NGW * 4) {
        f32x4 v[4][4]; float s[4];
#pragma unroll
        for (int u = 0; u < 4; ++u) { const GAS f32x4* xr = (const GAS f32x4*)(F.x + (size_t)(m0 + u) * D) + F.lane;
#pragma unroll
            for (int j = 0; j < 4; ++j) v[u][j] = __builtin_nontemporal_load(xr + 64 * j); }
#pragma unroll
        for (int u = 0; u < 4; ++u) { float a = 0.f;
#pragma unroll
            for (int j = 0; j < 4; ++j) a += (v[u][j].x * v[u][j].x + v[u][j].y * v[u][j].y) + (v[u][j].z * v[u][j].z + v[u][j].w * v[u][j].w);
            s[u] = a; }
#pragma unroll
        for (int u = 0; u < 4; ++u) {
            const float rstd = __builtin_amdgcn_rsqf(wave_sum(s[u]) * (1.f / D) + 1e-6f);
            GAS unsigned long long* o8 = (GAS unsigned long long*)(F.XN + (size_t)(m0 + u) * D) + F.lane;
#pragma unroll
            for (int j = 0; j < 4; ++j) o8[64 * j] = (unsigned long long)cvtpk2(v[u][j].x * rstd, v[u][j].y * rstd) | ((unsigned long long)cvtpk2(v[u][j].z * rstd, v[u][j].w * rstd) << 32);
        }
    }
}

__device__ __forceinline__ float tanh_f(float x) { const float e = __expf(-2.f * fabsf(x)); const float t = (1.f - e) * __builtin_amdgcn_rcpf(1.f + e); return x < 0.f ? -t : t; }
__device__ __forceinline__ void shifted8(const bf16* proj, size_t m, bool has_prev, int col, const float* mu, float (&o)[8]) {
    const v4u c = *(const GAS v4u*)(proj + m * NP + col);
    v4u p = (v4u){0u, 0u, 0u, 0u}; if (has_prev) p = *(const GAS v4u*)(proj + (m - 1) * NP + col);
    const f32x4 m0 = *(const GAS f32x4*)(mu), m1 = *(const GAS f32x4*)(mu + 4);
    const unsigned cw[4] = {c.x, c.y, c.z, c.w}, pw[4] = {p.x, p.y, p.z, p.w}; const float mm[8] = {m0.x, m0.y, m0.z, m0.w, m1.x, m1.y, m1.z, m1.w};
#pragma unroll
    for (int j = 0; j < 4; ++j) { const float c0 = bflo(cw[j]), c1 = bfhi(cw[j]), p0 = bflo(pw[j]), p1 = bfhi(pw[j]);
        o[2 * j] = c0 + (p0 - c0) * mm[2 * j]; o[2 * j + 1] = c1 + (p1 - c1) * mm[2 * j + 1]; }
}
__device__ __forceinline__ void shifted4(const bf16* proj, size_t m, bool has_prev, int col, const float* mu, float (&o)[4]) {
    const v2u c = *(const GAS v2u*)(proj + m * NP + col);
    v2u p = (v2u){0u, 0u}; if (has_prev) p = *(const GAS v2u*)(proj + (m - 1) * NP + col);
    const f32x4 m0 = *(const GAS f32x4*)(mu);
    o[0] = bflo(c.x) + (bflo(p.x) - bflo(c.x)) * m0.x; o[1] = bfhi(c.x) + (bfhi(p.x) - bfhi(c.x)) * m0.y;
    o[2] = bflo(c.y) + (bflo(p.y) - bflo(c.y)) * m0.z; o[3] = bfhi(c.y) + (bfhi(p.y) - bfhi(c.y)) * m0.w;
}
__device__ __forceinline__ void p2_qknorm(Frame& F) {
    const int gw = F.vcu * NWAVES + F.wave, NGW = F.G * NWAVES, lane = F.lane, sub = lane & 7;
    const f32x4 gq0 = *(const GAS f32x4*)(F.qn_g + sub * 8), gq1 = *(const GAS f32x4*)(F.qn_g + sub * 8 + 4), gk0 = *(const GAS f32x4*)(F.kn_g + sub * 8), gk1 = *(const GAS f32x4*)(F.kn_g + sub * 8 + 4);
    constexpr int UQ = 4;
    for (int it0 = gw * UQ; it0 < 2 * M; it0 += NGW * UQ) {
        bf16* p[UQ]; v4u c[UQ];
#pragma unroll
        for (int u = 0; u < UQ; ++u) { const int it = it0 + u; const size_t m = (size_t)(it >> 1); p[u] = F.PROJ + m * NP + ((it & 1) ? C_DK : C_DQ) + (lane >> 3) * 64 + sub * 8; c[u] = *(const GAS v4u*)p[u]; }
#pragma unroll
        for (int u = 0; u < UQ; ++u) {
            const int isk = (it0 + u) & 1; const unsigned cw[4] = {c[u].x, c[u].y, c[u].z, c[u].w};
            float xv[8]; float ss = 0.f;
#pragma unroll
            for (int j = 0; j < 4; ++j) { xv[2 * j] = bflo(cw[j]); xv[2 * j + 1] = bfhi(cw[j]); ss += xv[2 * j] * xv[2 * j] + xv[2 * j + 1] * xv[2 * j + 1]; }
            ss += dpp_f<0xB1>(ss); ss += dpp_f<0x4E>(ss); ss += dpp_f<0x141>(ss);
            const float r = __builtin_amdgcn_rsqf(ss * (1.f / 64.f) + 1e-6f) * (isk ? 1.f : C2);
            const f32x4 g0 = isk ? gk0 : gq0, g1 = isk ? gk1 : gq1;
            v4u o; o.x = cvtpk2(xv[0] * r * g0.x, xv[1] * r * g0.y); o.y = cvtpk2(xv[2] * r * g0.z, xv[3] * r * g0.w); o.z = cvtpk2(xv[4] * r * g1.x, xv[5] * r * g1.y); o.w = cvtpk2(xv[6] * r * g1.z, xv[7] * r * g1.w);
            *(GAS v4u*)p[u] = o;
        }
    }
}
typedef float f32x2_t __attribute__((ext_vector_type(2))); typedef __bf16 bf16x2_t __attribute__((ext_vector_type(2)));
__device__ __forceinline__ unsigned cvtpk(float lo, float hi) { f32x2_t v = {lo, hi}; bf16x2_t b = __builtin_convertvector(v, bf16x2_t); return __builtin_bit_cast(unsigned, b); }
#define MFMA32(a, b, c) __builtin_amdgcn_mfma_f32_32x32x16_bf16(__builtin_bit_cast(bf16x8, (a)), __builtin_bit_cast(bf16x8, (b)), (c), 0, 0, 0)
#define FRAGACC(z, s) ((v4u){cvtpk((z)[8 * (s)], (z)[8 * (s) + 1]), cvtpk((z)[8 * (s) + 2], (z)[8 * (s) + 3]), cvtpk((z)[8 * (s) + 4], (z)[8 * (s) + 5]), cvtpk((z)[8 * (s) + 6], (z)[8 * (s) + 7])})
template <int CTRL, int RM> __device__ __forceinline__ float dpp_upd0(float x) { return __builtin_bit_cast(float, __builtin_amdgcn_update_dpp(0, __builtin_bit_cast(int, x), CTRL, RM, 0xf, false)); }
__device__ __forceinline__ float scan32(float x) {
    x += dpp_upd0<0x111, 0xf>(x); x += dpp_upd0<0x112, 0xf>(x); x += dpp_upd0<0x114, 0xf>(x); x += dpp_upd0<0x118, 0xf>(x); x += dpp_upd0<0x142, 0xa>(x); return x;
}
__device__ __forceinline__ void st_wt16(v4u* p, const v4u v) { *(GAS v4u*)p = v; }
constexpr int RW_UNITS = BATCH * RH * (T / 32);
struct RwDump { v4u* PF; v4u* DD; v4u* QF; v4u* YD; float* GAM; float* RHO; };

__device__ __forceinline__ void rwkvA_unit(Frame& F, const RwDump& Dm, int bh, int ci, LAS float* wscr, LAS unsigned char* park) {
    int lane = mk_lane(); asm volatile("" : "+v"(lane));
    const int hi = lane >> 5, l31 = lane & 31, b = bh >> 3, w = bh & 7;
    LAS v4u* pk = (LAS v4u*)park + lane;
#define PARK(slot) pk[(slot) * 64]
    int tok = 0; asm volatile("" : "+v"(tok));
#define DEP(x) asm volatile("" : "+v"(tok) : "v"(x))
    const int t = ci * 32 + l31; const size_t m = (size_t)b * T + t; const bool hp = t > 0;
    const int u = ci * (BATCH * RH) + bh;
    const float pm = hp ? 1.f : 0.f;
    const bf16* pc = F.PROJ + m * NP + w * 64 + 4 * hi; const bf16* pp = F.PROJ + (hp ? m - 1 : m) * NP + w * 64 + 4 * hi;
    const float* mu = F.shift_mu + w * 64 + 4 * hi;
    const float *pw0 = F.w0 + w * 64 + 4 * hi, *pa0 = F.a0 + w * 64 + 4 * hi, *pkk = F.k_k + w * 64 + 4 * hi, *pka = F.k_a + w * 64 + 4 * hi, *prk = F.r_k + w * 64 + 4 * hi;
#define SH4(dst, COL, MU, OFF) do { const v2u c_ = *(const GAS v2u*)(pc + tok + (COL) + (OFF)), p_ = *(const GAS v2u*)(pp + tok + (COL) + (OFF)); const f32x4 m_ = *(const GAS f32x4*)(mu + tok + (MU) + (OFF)); \
        dst[0] = bflo(c_.x) + (bflo(p_.x) * pm - bflo(c_.x)) * m_.x; dst[1] = bfhi(c_.x) + (bfhi(p_.x) * pm - bfhi(c_.x)) * m_.y; \
        dst[2] = bflo(c_.y) + (bflo(p_.y) * pm - bflo(c_.y)) * m_.z; dst[3] = bfhi(c_.y) + (bfhi(p_.y) * pm - bfhi(c_.y)) * m_.w; } while (0)
    float ss = 0.f;
#pragma unroll
    for (int gq = 0; gq < 8; ++gq) { float k4[4]; SH4(k4, C_K, 512, 8 * gq); const f32x4 kkp = *(const GAS f32x4*)(pkk + tok + 8 * gq);
#pragma unroll
        for (int e = 0; e < 4; ++e) { const float q = k4[e] * kkp[e]; ss += q * q; }
        if (gq & 1) DEP(ss); }
    ss = swap32_sum(ss);
    const float inv = __builtin_amdgcn_rcpf(fmaxf(__builtin_amdgcn_sqrtf(ss), 1e-12f));
    asm volatile("" ::: "memory");
    v4u bz[4], ba[4];
    { const bf16* zc = F.PROJ + m * NP + 8 * hi; const bf16* zp = F.PROJ + (hp ? m - 1 : m) * NP + 8 * hi; const float* zmu = F.shift_mu + 8 * hi;
#pragma unroll
      for (int s = 0; s < 4; ++s) {
#pragma unroll
        for (int which = 0; which < 2; ++which) {
            const int COL = (which ? C_ZA : C_ZW) + 16 * s, MUO = (which ? 1600 : 1536) + 16 * s;
            const v4u c = *(const GAS v4u*)(zc + tok + COL), p = *(const GAS v4u*)(zp + tok + COL); const f32x4 m0 = *(const GAS f32x4*)(zmu + tok + MUO), m1 = *(const GAS f32x4*)(zmu + tok + MUO + 4);
            float z[8];
#pragma unroll
            for (int j = 0; j < 4; ++j) { const float c0 = bflo(c[j]), c1 = bfhi(c[j]); const float mm0 = j < 2 ? m0[2 * j] : m1[2 * j - 4], mm1 = j < 2 ? m0[2 * j + 1] : m1[2 * j - 3];
                z[2 * j] = c0 + (bflo(p[j]) * pm - c0) * mm0; z[2 * j + 1] = c1 + (bfhi(p[j]) * pm - c1) * mm1; }
            if (which == 0) bz[s] = (v4u){cvtpk(tanh_f(z[0]), tanh_f(z[1])), cvtpk(tanh_f(z[2]), tanh_f(z[3])), cvtpk(tanh_f(z[4]), tanh_f(z[5])), cvtpk(tanh_f(z[6]), tanh_f(z[7]))};
            else ba[s] = (v4u){cvtpk(z[0], z[1]), cvtpk(z[2], z[3]), cvtpk(z[4], z[5]), cvtpk(z[6], z[7])};
            if (which == 0) DEP(bz[s][3]); else DEP(ba[s][3]);
        }
      } }
    asm volatile("" ::: "memory");
    v4u fa[4], fb[4], fk[4], fr[4], fv[4]; float rho = 0.f;
    float* gp = Dm.GAM + (size_t)u * 64 + hi * 32;
#define RW_LORA(cb) f32x16 accd = f32x16{}, acca = f32x16{}; _Pragma("unroll") for (int s = 0; s < 4; ++s) { \
        const v4u aD = *(const GAS v4u*)(F.WdT + tok + (size_t)(w * 64 + (cb) * 32 + l31) * 64 + 16 * s + 8 * hi); accd = MFMA32(aD, bz[s], accd); \
        const v4u aA = *(const GAS v4u*)(F.WaT + tok + (size_t)(w * 64 + (cb) * 32 + l31) * 64 + 16 * s + 8 * hi); acca = MFMA32(aA, ba[s], acca); }
#define RW_GROUP(cb, rg) do { constexpr int OFF = 32 * (cb) + 8 * (rg); const int ch0 = OFF + 4 * hi; \
            float rr[4], kk4[4], vv[4]; \
            SH4(rr, C_R, 0, OFF); SH4(kk4, C_K, 512, OFF); SH4(vv, C_V, 1024, OFF); \
            const f32x4 w0v = *(const GAS f32x4*)(pw0 + tok + OFF), a0v = *(const GAS f32x4*)(pa0 + tok + OFF), kkp = *(const GAS f32x4*)(pkk + tok + OFF), kap = *(const GAS f32x4*)(pka + tok + OFF), rkp = *(const GAS f32x4*)(prk + tok + OFF); \
            float xa[4], xb[4], xk[4], xr[4], gg[4], ge[4]; \
            _Pragma("unroll") for (int e = 0; e < 4; ++e) { \
                const float nx = -(w0v[e] + accd[4 * (rg) + e]); const float sp = fmaxf(nx, 0.f) + __logf(1.f + __expf(-fabsf(nx))); \
                const float l2 = -__expf(-sp - 0.5f) * LOG2E; \
                const float g = scan32(l2); \
                const float a = __builtin_amdgcn_rcpf(1.f + __expf(-(a0v[e] + acca[4 * (rg) + e]))); \
                const float kk = kk4[e] * kkp[e] * inv; \
                const float kt = kk4[e] * (1.f + (a - 1.f) * kap[e]); \
                rho += rr[e] * kt * rkp[e]; \
                const float eg = __builtin_amdgcn_exp2f(g), egp = __builtin_amdgcn_exp2f(g - l2), eng = __builtin_amdgcn_rcpf(eg); \
                xa[e] = -kk * egp; xb[e] = kk * a * eng; xk[e] = kt * eng; xr[e] = rr[e] * eg; gg[e] = g; ge[e] = eg; } \
            if (l31 == 31) { *(LAS f32x4*)(wscr + ch0) = (f32x4){gg[0], gg[1], gg[2], gg[3]}; st_wt16((v4u*)(gp + (cb) * 16 + 4 * (rg)), (v4u){__float_as_uint(ge[0]), __float_as_uint(ge[1]), __float_as_uint(ge[2]), __float_as_uint(ge[3])}); } \
            constexpr int s_ = 2 * (cb) + ((rg) >> 1), vg = 2 * ((rg) & 1); \
            fa[s_][vg] = cvtpk(xa[0], xa[1]); fa[s_][vg + 1] = cvtpk(xa[2], xa[3]); \
            fb[s_][vg] = cvtpk(xb[0], xb[1]); fb[s_][vg + 1] = cvtpk(xb[2], xb[3]); \
            fk[s_][vg] = cvtpk(xk[0], xk[1]); fk[s_][vg + 1] = cvtpk(xk[2], xk[3]); \
            fr[s_][vg] = cvtpk(xr[0], xr[1]); fr[s_][vg + 1] = cvtpk(xr[2], xr[3]); \
            fv[s_][vg] = cvtpk(vv[0], vv[1]); fv[s_][vg + 1] = cvtpk(vv[2], vv[3]); \
            if (((rg) & 1) == 1) { PARK(s_) = fv[s_]; PARK(4 + s_) = fr[s_]; } \
            DEP(fa[s_][vg + 1]); DEP(fb[s_][vg + 1]); DEP(fk[s_][vg + 1]); DEP(fr[s_][vg + 1]); DEP(fv[s_][vg + 1]); DEP(rho); } while (0)
    { RW_LORA(0) RW_GROUP(0, 0); RW_GROUP(0, 1); RW_GROUP(0, 2); RW_GROUP(0, 3); }
    { RW_LORA(1) RW_GROUP(1, 0); RW_GROUP(1, 1); RW_GROUP(1, 2); RW_GROUP(1, 3); }
#undef RW_LORA
#undef RW_GROUP
#undef SH4
    LDS_WAIT(); asm volatile("" ::: "memory");
    float EC[2]; EC[0] = __builtin_amdgcn_exp2f(wscr[l31]); EC[1] = __builtin_amdgcn_exp2f(wscr[32 + l31]);
    LDS_WAIT(); asm volatile("" ::: "memory");
    rho = swap32_sum(rho);
    if (hi == 0) __hip_atomic_store((gu32*)(Dm.RHO + (size_t)u * 32 + l31), __float_as_uint(rho), RLX_AGENT);
    v4u idf[2];
    { const int jst = 4 * ((l31 >> 3) & 1) + (l31 & 3); const bool hm = ((l31 >> 2) & 1) == hi; const unsigned one = 0x3F80u << (16 * (jst & 1));
#pragma unroll
      for (int sig = 0; sig < 2; ++sig) { const bool on = hm && ((l31 >> 4) == sig);
#pragma unroll
          for (int q = 0; q < 4; ++q) idf[sig][q] = (on && (jst >> 1) == q) ? one : 0u; } }
    LDS_WAIT();
    v4u Af[2][2], Vf[2][2];
#pragma unroll
    for (int blk = 0; blk < 2; ++blk) {
        f32x16 za = MFMA32(fa[2 * blk], idf[0], f32x16{}); za = MFMA32(fa[2 * blk + 1], idf[1], za);
        f32x16 zv = MFMA32(PARK(2 * blk), idf[0], f32x16{}); zv = MFMA32(PARK(2 * blk + 1), idf[1], zv);
        f32x16 zb = MFMA32(fb[2 * blk], idf[0], f32x16{}); zb = MFMA32(fb[2 * blk + 1], idf[1], zb);
        f32x16 zk = MFMA32(fk[2 * blk], idf[0], f32x16{}); zk = MFMA32(fk[2 * blk + 1], idf[1], zk);
        zb = zb * EC[blk]; zk = zk * EC[blk];
#pragma unroll
        for (int s = 0; s < 2; ++s) { Af[blk][s] = FRAGACC(za, s); Vf[blk][s] = FRAGACC(zv, s); PARK(8 + 2 * blk + s) = FRAGACC(zb, s); PARK(12 + 2 * blk + s) = FRAGACC(zk, s); }
        __builtin_amdgcn_sched_barrier(0);
    }
    f32x16 Aab = f32x16{}, TT = f32x16{}, AakT = f32x16{}, ArbT = f32x16{}, ArkT = f32x16{};
#pragma unroll
    for (int s = 0; s < 4; ++s) { const v4u frs = PARK(4 + s); Aab = MFMA32(fa[s], fb[s], Aab); TT = MFMA32(fb[s], fa[s], TT); AakT = MFMA32(fk[s], fa[s], AakT); ArbT = MFMA32(fb[s], frs, ArbT); ArkT = MFMA32(fk[s], frs, ArkT); }
#pragma unroll
    for (int r = 0; r < 16; ++r) { const int rowi = (r & 3) + 8 * (r >> 2) + 4 * hi;
        Aab[r] = (l31 < rowi) ? Aab[r] : 0.f; TT[r] = (rowi < l31) ? TT[r] : 0.f; AakT[r] = (rowi < l31) ? AakT[r] : 0.f;
        ArbT[r] = (rowi <= l31) ? ArbT[r] : 0.f; ArkT[r] = (rowi <= l31) ? ArkT[r] : 0.f; }
    v4u AakTf[2], ArbTf[2], ArkTf[2];
#pragma unroll
    for (int s = 0; s < 2; ++s) { AakTf[s] = FRAGACC(AakT, s); ArbTf[s] = FRAGACC(ArbT, s); ArkTf[s] = FRAGACC(ArkT, s); }
    __builtin_amdgcn_sched_barrier(0);
    v4u Xf[2], XTf[2], TTf[2];
#pragma unroll
    for (int s = 0; s < 2; ++s) { Xf[s] = FRAGACC(Aab, s); XTf[s] = FRAGACC(TT, s); }
#pragma unroll
    for (int r = 0; r < 16; ++r) { const int rowi = (r & 3) + 8 * (r >> 2) + 4 * hi; TT[r] += (rowi == l31) ? 1.f : 0.f; }
#pragma unroll
    for (int it = 0; it < 4; ++it) {
        f32x16 X2 = MFMA32(XTf[0], Xf[0], f32x16{}); X2 = MFMA32(XTf[1], Xf[1], X2);
        if (it < 3) { f32x16 X2T = MFMA32(Xf[0], XTf[0], f32x16{}); X2T = MFMA32(Xf[1], XTf[1], X2T);
#pragma unroll
            for (int s = 0; s < 2; ++s) XTf[s] = FRAGACC(X2T, s); }
#pragma unroll
        for (int s = 0; s < 2; ++s) { Xf[s] = FRAGACC(X2, s); TTf[s] = FRAGACC(TT, s); }
        TT = MFMA32(Xf[0], TTf[0], TT); TT = MFMA32(Xf[1], TTf[1], TT);
        __builtin_amdgcn_sched_barrier(0);
    }
#pragma unroll
    for (int s = 0; s < 2; ++s) TTf[s] = FRAGACC(TT, s);
    v4u Wf[2][2], Uf[2][2];
#pragma unroll
    for (int blk = 0; blk < 2; ++blk) {
        f32x16 av = MFMA32(AakTf[0], Vf[blk][0], f32x16{}); av = MFMA32(AakTf[1], Vf[blk][1], av);
        const v4u avf0 = FRAGACC(av, 0), avf1 = FRAGACC(av, 1);
        f32x16 uu = MFMA32(TTf[0], avf0, f32x16{}); uu = MFMA32(TTf[1], avf1, uu);
        f32x16 ww = MFMA32(TTf[0], Af[blk][0], f32x16{}); ww = MFMA32(TTf[1], Af[blk][1], ww);
#pragma unroll
        for (int s = 0; s < 2; ++s) { Wf[blk][s] = FRAGACC(ww, s); Uf[blk][s] = FRAGACC(uu, s); }
        __builtin_amdgcn_sched_barrier(0);
    }
    v4u* QFp = Dm.QF + (size_t)u * 256 + lane; v4u* YDp = Dm.YD + (size_t)u * 256 + lane;
#pragma unroll
    for (int blk = 0; blk < 2; ++blk) {
        f32x16 q;
#pragma unroll
        for (int s = 0; s < 2; ++s)
            { const v4u frs = PARK(4 + 2 * blk + s);
#pragma unroll
              for (int j = 0; j < 4; ++j) { q[8 * s + 2 * j] = bflo(frs[j]); q[8 * s + 2 * j + 1] = bfhi(frs[j]); } }
        q = MFMA32(Wf[blk][0], ArbTf[0], q); q = MFMA32(Wf[blk][1], ArbTf[1], q);
        st_wt16(QFp + (2 * blk) * 64, FRAGACC(q, 0)); st_wt16(QFp + (2 * blk + 1) * 64, FRAGACC(q, 1));
        f32x16 y = MFMA32(Uf[blk][0], ArbTf[0], f32x16{}); y = MFMA32(Uf[blk][1], ArbTf[1], y); y = MFMA32(Vf[blk][0], ArkTf[0], y); y = MFMA32(Vf[blk][1], ArkTf[1], y);
        st_wt16(YDp + (2 * blk) * 64, FRAGACC(y, 0)); st_wt16(YDp + (2 * blk + 1) * 64, FRAGACC(y, 1));
        __builtin_amdgcn_sched_barrier(0);
    }
    v4u* PFp = Dm.PF + (size_t)u * 512 + lane; v4u* DDp = Dm.DD + (size_t)u * 512 + lane;
#pragma unroll
    for (int c1 = 0; c1 < 2; ++c1)
#pragma unroll
        for (int cb = 0; cb < 2; ++cb) {
            f32x16 p = MFMA32(Wf[c1][0], PARK(8 + 2 * cb), f32x16{}); p = MFMA32(Wf[c1][1], PARK(8 + 2 * cb + 1), p);
            st_wt16(PFp + (cb * 4 + 2 * c1) * 64, FRAGACC(p, 0)); st_wt16(PFp + (cb * 4 + 2 * c1 + 1) * 64, FRAGACC(p, 1));
            __builtin_amdgcn_sched_barrier(0);
        }
#pragma unroll
    for (int cb = 0; cb < 2; ++cb)
#pragma unroll
        for (int ib = 0; ib < 2; ++ib) {
            f32x16 d = MFMA32(PARK(8 + 2 * cb), Uf[ib][0], f32x16{}); d = MFMA32(PARK(8 + 2 * cb + 1), Uf[ib][1], d); d = MFMA32(PARK(12 + 2 * cb), Vf[ib][0], d); d = MFMA32(PARK(12 + 2 * cb + 1), Vf[ib][1], d);
            st_wt16(DDp + ((cb * 2 + ib) * 2) * 64, FRAGACC(d, 0)); st_wt16(DDp + ((cb * 2 + ib) * 2 + 1) * 64, FRAGACC(d, 1));
            __builtin_amdgcn_sched_barrier(0);
        }
}

#undef PARK
#undef DEP
constexpr int RB_PF = 0, RB_DD = 8192, RB_QF = 16384, RB_YD = 20480, RB_GAM = 24576, RB_BUF = 24832, RB_STAT = 2 * RB_BUF, RB_Y = RB_STAT + 1024;
__device__ __forceinline__ void unpack16(const v4u a, const v4u b, f32x16& o) {
#pragma unroll
    for (int j = 0; j < 4; ++j) { o[2 * j] = bflo(a[j]); o[2 * j + 1] = bfhi(a[j]); o[8 + 2 * j] = bflo(b[j]); o[8 + 2 * j + 1] = bfhi(b[j]); }
}
constexpr int RW_SPLIT = T / 32, CW_DONE = 16384;
__device__ __forceinline__ void rw_wait_chunk(Frame& F, int ci) {
    unsigned spins = 0;
#pragma unroll 1
    for (int j = 7; j >= 0; --j) { gu32* c = F.ctl + CW_DONE + 64 * (ci + j);
        while ((unsigned)__builtin_amdgcn_readfirstlane(__hip_atomic_load(c, RLX_AGENT)) < (unsigned)BATCH) { __builtin_amdgcn_s_sleep(8); if (++spins > (1u << 22)) break; } }
    __builtin_amdgcn_fence(__ATOMIC_ACQUIRE, "agent");
}
__device__ __forceinline__ void rw_publish_chunk(Frame& F, int ci) {
    asm volatile("s_waitcnt vmcnt(0)" ::: "memory");
    __syncthreads();
    if (F.wave == 0 && mk_lane() == 0) {
        __hip_atomic_fetch_add(F.ctl + CW_DONE + 64 * ci, 1u, RLX_AGENT);
    }
}
struct RbStage { v4u p[2], d[2], q, y, g; };
struct RbEpi { v2u vc[2], vp[2], ga[2]; float rho; };
__device__ __forceinline__ void rwkvB_unit(Frame& F, const RwDump& Dm, int bh) {
    int lane = mk_lane(); asm volatile("" : "+v"(lane));
    const int wid = F.wave, tid = wid * 64 + lane, hi = lane >> 5, l31 = lane & 31, b = bh >> 3, h = bh & 7;
    LAS unsigned char* lds = F.lds + RING_OFF;
    constexpr int NS = T / 32;
    LAS float* stat = (LAS float*)(lds + RB_STAT);
    LAS float* ybuf = (LAS float*)(lds + RB_Y);
    const int stid = tid - 128;
    const bool st_p2 = wid < 4, st_q = wid < 6, st_y = wid >= 4;
#define ST_LOAD(X, ci_) do { { if ((ci_) >= RW_SPLIT && (ci_) < NS && (((ci_) - RW_SPLIT) & 7) == 0) rw_wait_chunk(F, (ci_)); const size_t u_ = (size_t)((ci_) < NS ? (ci_) : NS - 1) * (BATCH * RH) + bh; \
        X.p[0] = *(const GAS v4u*)(Dm.PF + u_ * 512 + stid); X.d[0] = *(const GAS v4u*)(Dm.DD + u_ * 512 + stid); \
        if (st_p2) { X.p[1] = *(const GAS v4u*)(Dm.PF + u_ * 512 + 384 + stid); X.d[1] = *(const GAS v4u*)(Dm.DD + u_ * 512 + 384 + stid); } \
        if (st_q) X.q = *(const GAS v4u*)(Dm.QF + u_ * 256 + stid); \
        if (st_y) X.y = *(const GAS v4u*)(Dm.YD + u_ * 256 + (stid - 128)); \
        if (stid < 16) X.g = *(const GAS v4u*)((const v4u*)(Dm.GAM + u_ * 64) + stid); } } while (0)
#define ST_STORE(X, buf_) do { LAS unsigned char* b_ = lds + (buf_) * RB_BUF; \
        *(LAS v4u*)(b_ + RB_PF + stid * 16) = X.p[0]; *(LAS v4u*)(b_ + RB_DD + stid * 16) = X.d[0]; \
        if (st_p2) { *(LAS v4u*)(b_ + RB_PF + (384 + stid) * 16) = X.p[1]; *(LAS v4u*)(b_ + RB_DD + (384 + stid) * 16) = X.d[1]; } \
        if (st_q) *(LAS v4u*)(b_ + RB_QF + stid * 16) = X.q; \
        if (st_y) *(LAS v4u*)(b_ + RB_YD + (stid - 128) * 16) = X.y; \
        if (stid < 16) *(LAS v4u*)(b_ + RB_GAM + stid * 16) = X.g; } while (0)
    const int eib = wid & 1, eh = (wid >> 2) & 1;
    const bf16* epc = F.PROJ + (size_t)b * T * NP + h * 64 + 32 * eib + 16 * eh + 4 * hi;
#define EP_LOAD(X, cj_) do { { const int tt_ = ((cj_) < NS ? (cj_) : NS - 1) * 32 + l31; const bf16* pc_ = epc + (size_t)tt_ * NP; const bf16* pp_ = epc + (size_t)(tt_ > 0 ? tt_ - 1 : 0) * NP; \
        _Pragma("unroll") for (int rg = 0; rg < 2; ++rg) { X.vc[rg] = *(const GAS v2u*)(pc_ + C_V + 8 * rg); X.vp[rg] = *(const GAS v2u*)(pp_ + C_V + 8 * rg); X.ga[rg] = *(const GAS v2u*)(pc_ + C_GA + 8 * rg); } \
        X.rho = Dm.RHO[((size_t)((cj_) < NS ? (cj_) : NS - 1) * (BATCH * RH) + bh) * 32 + l31]; } } while (0)
#define EP_RUN(X, cj_) do { const int par_ = (cj_) & 1; \
        const float s1_ = stat[((par_ * 2 + 0) * 32 + l31) * 2] + stat[((par_ * 2 + 1) * 32 + l31) * 2], s2_ = stat[((par_ * 2 + 0) * 32 + l31) * 2 + 1] + stat[((par_ * 2 + 1) * 32 + l31) * 2 + 1]; \
        const float mean_ = s1_ * (1.f / 64.f), var_ = fmaxf(s2_ * (1.f / 64.f) - mean_ * mean_, 0.f), rstd_ = __builtin_amdgcn_rsqf(var_ + 64e-5f); \
        const int tt_ = (cj_) * 32 + l31; const size_t mm_ = (size_t)b * T + tt_; const float pm_ = tt_ > 0 ? 1.f : 0.f; \
        const LAS float* yb_ = ybuf + (par_ * 2 + eib) * 1024 + lane; \
        _Pragma("unroll") for (int rg = 0; rg < 2; ++rg) { const int hc_ = h * 64 + 32 * eib + 16 * eh + 8 * rg + 4 * hi; \
            const f32x4 mu_ = emu[rg], lw_ = elw[rg], lb_ = elb[rg]; \
            const float vc_[4] = {bflo(X.vc[rg].x), bfhi(X.vc[rg].x), bflo(X.vc[rg].y), bfhi(X.vc[rg].y)}, vp_[4] = {bflo(X.vp[rg].x), bfhi(X.vp[rg].x), bflo(X.vp[rg].y), bfhi(X.vp[rg].y)}; \
            const float g4_[4] = {bflo(X.ga[rg].x), bfhi(X.ga[rg].x), bflo(X.ga[rg].y), bfhi(X.ga[rg].y)}; float o_[4]; \
            _Pragma("unroll") for (int e = 0; e < 4; ++e) { const float vv_ = vc_[e] + (vp_[e] * pm_ - vc_[e]) * mu_[e]; \
                const float yn_ = (yb_[(4 * (2 * eh + rg) + e) * 64] - mean_) * rstd_ * lw_[e] + lb_[e] + X.rho * vv_; o_[e] = yn_ * g4_[e] * __builtin_amdgcn_rcpf(1.f + __expf(-g4_[e])); } \
            *(GAS v2u*)(F.MIX + mm_ * D + hc_) = (v2u){cvtpk(o_[0], o_[1]), cvtpk(o_[2], o_[3])}; } } while (0)
    f32x16 S[2]; S[0] = f32x16{}; S[1] = f32x16{};
    const int ib = wid & 1;
#define CONS(ci_) do { const LAS unsigned char* bb = lds + ((ci_) & 1) * RB_BUF; \
          \
        v4u pf_[8], qf_[4], dd_[4], yd_[2]; f32x4 gm_[8]; \
        _Pragma("unroll") for (int q = 0; q < 8; ++q) gm_[q] = *(const LAS f32x4*)(bb + RB_GAM + (hi * 32 + 4 * q) * 4); \
        _Pragma("unroll") for (int q = 0; q < 4; ++q) dd_[q] = *(const LAS v4u*)(bb + RB_DD + ((((q >> 1) * 2 + ib) * 2 + (q & 1)) * 64 + lane) * 16); \
        _Pragma("unroll") for (int q = 0; q < 8; ++q) pf_[q] = *(const LAS v4u*)(bb + RB_PF + (q * 64 + lane) * 16); \
        _Pragma("unroll") for (int q = 0; q < 2; ++q) yd_[q] = *(const LAS v4u*)(bb + RB_YD + ((2 * ib + q) * 64 + lane) * 16); \
        _Pragma("unroll") for (int q = 0; q < 4; ++q) qf_[q] = *(const LAS v4u*)(bb + RB_QF + (q * 64 + lane) * 16); \
        __builtin_amdgcn_sched_barrier(0); \
        v4u Sf[4]; _Pragma("unroll") for (int s = 0; s < 4; ++s) Sf[s] = FRAGACC(S[s >> 1], s & 1); \
        _Pragma("unroll") for (int rb = 0; rb < 2; ++rb) { \
            f32x16 acc; unpack16(dd_[2 * rb], dd_[2 * rb + 1], acc); \
            _Pragma("unroll") for (int q = 0; q < 4; ++q) { const f32x4 gv = gm_[4 * rb + q]; _Pragma("unroll") for (int e = 0; e < 4; ++e) acc[4 * q + e] += gv[e] * S[rb][4 * q + e]; } \
            _Pragma("unroll") for (int s = 0; s < 4; ++s) acc = MFMA32(pf_[rb * 4 + s], Sf[s], acc); \
            S[rb] = acc; } \
        f32x16 y; unpack16(yd_[0], yd_[1], y); \
        _Pragma("unroll") for (int s = 0; s < 4; ++s) y = MFMA32(Sf[s], qf_[s], y); \
        float s1 = 0.f, s2 = 0.f; LAS float* yb_ = ybuf + (((ci_) & 1) * 2 + ib) * 1024 + lane; \
        _Pragma("unroll") for (int r = 0; r < 16; ++r) { s1 += y[r]; s2 += y[r] * y[r]; yb_[r * 64] = y[r]; } \
        s1 = swap32_sum(s1); s2 = swap32_sum(s2); \
        if (hi == 0) { stat[((((ci_) & 1) * 2 + ib) * 32 + l31) * 2] = s1; stat[((((ci_) & 1) * 2 + ib) * 32 + l31) * 2 + 1] = s2; } } while (0)
#define RB_BAR() do { asm volatile("s_waitcnt lgkmcnt(0)" ::: "memory"); __builtin_amdgcn_s_barrier(); asm volatile("" ::: "memory"); } while (0)
    if (wid < 2) {
        RB_BAR();
#pragma unroll 1
        for (int k = 0; k < NS; ++k) { CONS(k); RB_BAR(); }
        RB_BAR();
    } else {
        const bool epi = (wid != 4 && wid != 5);
        RbStage sA, sB, sC; RbEpi eA, eB, eC; f32x4 emu[2], elw[2], elb[2];
#pragma unroll
        for (int rg = 0; rg < 2; ++rg) { const int hc_ = h * 64 + 32 * eib + 16 * eh + 8 * rg + 4 * hi; emu[rg] = *(const GAS f32x4*)(F.shift_mu + 1024 + hc_); elw[rg] = *(const GAS f32x4*)(F.ln_w + hc_); elb[rg] = *(const GAS f32x4*)(F.ln_b + hc_); }
        ST_LOAD(sA, 0); ST_LOAD(sB, 1); ST_LOAD(sC, 2); ST_STORE(sA, 0); ST_LOAD(sA, 3);
        if (epi) { EP_LOAD(eA, 0); EP_LOAD(eB, 1); }
        RB_BAR();
        ST_STORE(sB, 1); ST_LOAD(sB, 4); if (epi) EP_LOAD(eC, 2); RB_BAR();
#define HY_STEP(k_, SN, EP) do { ST_STORE(SN, ((k_) + 1) & 1); ST_LOAD(SN, (k_) + 4); if (epi) { EP_RUN(EP, (k_) - 1); EP_LOAD(EP, (k_) + 2); } RB_BAR(); } while (0)
#pragma unroll 1
        for (int k = 1; k < NS; k += 3) { HY_STEP(k, sC, eA); HY_STEP(k + 1, sA, eB); HY_STEP(k + 2, sB, eC); }
        if (epi) EP_RUN(eA, NS - 1);
        RB_BAR();
#undef HY_STEP
    }
#undef RB_BAR
#undef ST_LOAD
#undef ST_STORE
#undef EP_LOAD
#undef EP_RUN
#undef CONS
}
constexpr int CW_G17 = 12288;
struct OneUnit { int pm, pn;
    __device__ __forceinline__ bool next(int i, pg8::Unit& u) const { if (i != 0) return false; u.pm = pm; u.pn = pn; return true; }
    __device__ __forceinline__ void a_ready(const pg8::Unit&) const {}
    __device__ __forceinline__ void done(const pg8::Unit&) const {} };
constexpr int AT_KB = 64 * 256, AT_VB = 64 * 256, AT_BUF = AT_KB + AT_VB, AT_QOFF = 2 * AT_KB + 3 * AT_VB;
__device__ __forceinline__ s16x4 vtr(const LAS unsigned char* p) { typedef short v4i16_t __attribute__((ext_vector_type(4))); return __builtin_bit_cast(s16x4, __builtin_amdgcn_ds_read_tr16_b64_v4i16((LAS v4i16_t*)p)); }
__device__ __forceinline__ void attn_unit(Frame& F, int b, int h, int qb) {
    int lane = mk_lane(); asm volatile("" : "+v"(lane));
    const int wid = F.wave, tid = wid * 64 + lane, l31 = lane & 31, hi = lane >> 5, map = wid >> 2, qs = wid & 3;
    LAS unsigned char* lds = F.lds + RING_OFF;
    const float slope2 = exp2f(-2.f * (float)(h + 1)) * LOG2E, shift2 = __uint_as_float(F.MISC[15]);
    const int q0 = qb * 128, qrow = q0 + 32 * qs + l31;
    const size_t mrow = (size_t)b * T + qrow;
    LAS bf16x8* qpark = (LAS bf16x8*)(lds + AT_QOFF + wid * 4096) + lane;
    { const bf16* qp = F.PROJ + mrow * NP + C_DQ + h * 128 + map * 64 + 8 * hi;
#pragma unroll
      for (int s = 0; s < 4; ++s) qpark[s * 64] = *(const GAS bf16x8*)(qp + 16 * s); }
    const bf16* kg = F.PROJ + (size_t)b * T * NP + C_DK + h * 128;
    const bf16* vg = F.PROJ + (size_t)b * T * NP + C_DV + h * 128;
    const int NT = 2 * qb + 2, tl = 2 * qb + (qs >> 1);
    const int Wk = (int)__builtin_ceilf((2.f * shift2 + 32.2f) / slope2);
    const int tf = __builtin_amdgcn_readfirstlane(max(0, (qb * 128 - Wk) >> 6));
    constexpr int AT_V0 = 2 * AT_KB;
    const int drow0 = 4 * wid + (lane >> 4), drow1 = drow0 + 32, dch = lane & 15;
    const unsigned ksrc0 = (unsigned)(drow0 * NP + ((dch ^ (drow0 & 15)) * 8)), ksrc1 = (unsigned)(drow1 * NP + ((dch ^ (drow1 & 15)) * 8));
    const unsigned vsrc0 = (unsigned)(drow0 * NP + ((dch ^ ((drow0 & 3) << 2)) * 8)), vsrc1 = (unsigned)(drow1 * NP + ((dch ^ ((drow1 & 3) << 2)) * 8));
#define AT_DMA(t_, kb_, v3_) do { const size_t tb_ = (size_t)(64 * (t_)) * NP; LAS unsigned char* bk_ = lds + (kb_) * AT_KB + wid * 1024; LAS unsigned char* bv_ = lds + AT_V0 + (v3_) * AT_VB + wid * 1024; \
        __builtin_amdgcn_global_load_lds((const unsigned*)(kg + tb_ + ksrc0), (LAS unsigned*)bk_, 16, 0, 0); __builtin_amdgcn_global_load_lds((const unsigned*)(kg + tb_ + ksrc1), (LAS unsigned*)(bk_ + 8192), 16, 0, 0); \
        __builtin_amdgcn_global_load_lds((const unsigned*)(vg + tb_ + vsrc0), (LAS unsigned*)bv_, 16, 0, 0); __builtin_amdgcn_global_load_lds((const unsigned*)(vg + tb_ + vsrc1), (LAS unsigned*)(bv_ + 8192), 16, 0, 0); } while (0)
    f32x16 o[4];
#pragma unroll
    for (int vb = 0; vb < 4; ++vb) o[vb] = f32x16{};
    float lsum = 0.f;
    AT_DMA(tf, tf & 1, tf % 3);
    __syncthreads();
    const int G = lane >> 4, qq = (lane & 15) >> 2, pp = lane & 3;
    const int vrow = (4 * hi + qq) * 256 + 8 * (pp & 1), vch = 2 * (G & 1) + (pp >> 1);
    v4u pw[4];
#define SBAR_() __builtin_amdgcn_sched_barrier(0)
#define AT_QK(t) do { \
            const LAS unsigned char* Kb = lds + ((t) & 1) * AT_KB; \
            float sl_ = slope2; asm volatile("" : "+v"(sl_));     \
            const float base = sl_ * (float)(64 * (t) + 4 * hi - qrow) - shift2; \
            float ls = 0.f; \
            _Pragma("unroll") for (int hf = 0; hf < 2; ++hf) {        \
                f32x16 p; \
                _Pragma("unroll") for (int r = 0; r < 16; ++r) p[r] = __builtin_fmaf(sl_, (float)(32 * hf + (r & 3) + 8 * (r >> 2)), base); \
                _Pragma("unroll") for (int s = 0; s < 4; ++s) { \
                    const bf16x8 a0 = *(const LAS bf16x8*)(Kb + (32 * hf + l31) * 256 + (((map * 8 + 2 * s + hi) ^ (l31 & 15)) * 16)); \
                    p = __builtin_amdgcn_mfma_f32_32x32x16_bf16(a0, qpark[s * 64], p, 0, 0, 0); } \
                if ((t) == tl) { \
                    _Pragma("unroll") for (int r = 0; r < 16; ++r) { const int ki = 64 * (t) + 32 * hf + 4 * hi + (r & 3) + 8 * (r >> 2); if (ki > qrow) p[r] = -1e30f; } } \
                _Pragma("unroll") for (int r = 0; r < 16; ++r) { p[r] = __builtin_amdgcn_exp2f(p[r]); ls += p[r]; } \
                pw[2 * hf] = (v4u){cvtpk(p[0], p[1]), cvtpk(p[2], p[3]), cvtpk(p[4], p[5]), cvtpk(p[6], p[7])}; \
                pw[2 * hf + 1] = (v4u){cvtpk(p[8], p[9]), cvtpk(p[10], p[11]), cvtpk(p[12], p[13]), cvtpk(p[14], p[15])}; } \
            lsum += ls; } while (0)
#define AT_VRD(dst, ks, vb0) do { _Pragma("unroll") for (int vb = (vb0); vb < (vb0) + 2; ++vb) { const LAS unsigned char* a_ = Vb + vrow + ((4 * vb + vch) ^ (qq << 2)) * 16 + (32 * ((ks) >> 1) + 16 * ((ks) & 1)) * 256; \
        dst[2 * (vb - (vb0))] = vtr(a_); dst[2 * (vb - (vb0)) + 1] = vtr(a_ + 8 * 256); } } while (0)
#define AT_PV(src, pwk, vb0) do { _Pragma("unroll") for (int vb = (vb0); vb < (vb0) + 2; ++vb) { const int j_ = 2 * (vb - (vb0)); \
        const bf16x8 vf = (bf16x8){src[j_][0], src[j_][1], src[j_][2], src[j_][3], src[j_ + 1][0], src[j_ + 1][1], src[j_ + 1][2], src[j_ + 1][3]}; \
        o[vb] = __builtin_amdgcn_mfma_f32_32x32x16_bf16(vf, __builtin_bit_cast(bf16x8, pwk), o[vb], 0, 0, 0); } } while (0)
#define AT_PVV(v3_) do { const LAS unsigned char* Vb = lds + AT_V0 + (v3_) * AT_VB; s16x4 vA[4], vB[4]; \
            AT_VRD(vA, 0, 0); SBAR_(); AT_VRD(vB, 0, 2); SBAR_(); \
            AT_PV(vA, pw[0], 0); SBAR_(); AT_VRD(vA, 1, 0); SBAR_(); AT_PV(vB, pw[0], 2); SBAR_(); AT_VRD(vB, 1, 2); SBAR_(); \
            AT_PV(vA, pw[1], 0); SBAR_(); AT_VRD(vA, 2, 0); SBAR_(); AT_PV(vB, pw[1], 2); SBAR_(); AT_VRD(vB, 2, 2); SBAR_(); \
            AT_PV(vA, pw[2], 0); SBAR_(); AT_VRD(vA, 3, 0); SBAR_(); AT_PV(vB, pw[2], 2); SBAR_(); AT_VRD(vB, 3, 2); SBAR_(); \
            AT_PV(vA, pw[3], 0); SBAR_(); AT_PV(vB, pw[3], 2); } while (0)
    if (map == 0) {
        int v3 = tf % 3;
#pragma unroll 1
        for (int t = tf; t < NT; ++t) { const int vn = v3 == 2 ? 0 : v3 + 1;
            if (t + 1 < NT) AT_DMA(t + 1, (t + 1) & 1, vn);
            if (t <= tl) { AT_QK(t); AT_PVV(v3); }
            __syncthreads(); v3 = vn; }
    } else {
        int v3 = tf % 3;
#pragma unroll 1
        for (int t = tf; t < NT; ++t) { const int vp = v3 == 0 ? 2 : v3 - 1, vn = v3 == 2 ? 0 : v3 + 1;
            if (t + 1 < NT) AT_DMA(t + 1, (t + 1) & 1, vn);
            if (t > tf && t - 1 <= tl) AT_PVV(vp);
            if (t <= tl) AT_QK(t);
            __syncthreads(); v3 = vn; }
        if (NT - 1 <= tl) { const int vp = v3 == 0 ? 2 : v3 - 1; AT_PVV(vp); }
    }
#undef AT_PVV
#undef AT_QK
#undef AT_VRD
#undef AT_PV
#undef SBAR_
#undef AT_DMA
    __syncthreads();
    const float ltot = swap32_sum(lsum);
    LAS float* X = (LAS float*)lds;
    if (map == 1) {
        const float sc = __uint_as_float(F.MISC[14]) / ltot;
#pragma unroll
        for (int vb = 0; vb < 4; ++vb)
#pragma unroll
            for (int r = 0; r < 16; ++r) X[(qs * 64 + vb * 16 + r) * 64 + lane] = o[vb][r] * sc;
    }
    __syncthreads();
    if (map == 0) {
        const float il = 1.f / ltot; float ss = 0.f;
#pragma unroll
        for (int vb = 0; vb < 4; ++vb)
#pragma unroll
            for (int r = 0; r < 16; ++r) { const float v = o[vb][r] * il - X[(qs * 64 + vb * 16 + r) * 64 + lane]; o[vb][r] = v; ss += v * v; }
        ss = swap32_sum(ss);
        const float rn = (1.f / sqrtf(ss * (1.f / 128.f) + 1e-5f)) * (1.f - LAMBDA_INIT);
        int etok = 0; asm volatile("" : "+v"(etok));
        const int lane_e = mk_lane(), hi = lane_e >> 5;
        const size_t mrow_e = (size_t)b * T + qb * 128 + 32 * qs + (lane_e & 31);
        const bf16* gp = F.PROJ + mrow_e * NP + C_GB + h * 128;
        bf16* op = F.MIX + mrow_e * D + 512 + h * 128;
#pragma unroll
        for (int vb = 0; vb < 4; ++vb)
#pragma unroll
            for (int rg = 0; rg < 4; ++rg) {
                const int vc = 32 * vb + 8 * rg + 4 * hi + etok;
                const v2u gw = *(const GAS v2u*)(gp + vc); const f32x4 sg = *(const GAS f32x4*)(F.subln_g + vc);
                const float g4[4] = {bflo(gw.x), bfhi(gw.x), bflo(gw.y), bfhi(gw.y)}; float ov[4];
#pragma unroll
                for (int e = 0; e < 4; ++e) ov[e] = o[vb][4 * rg + e] * rn * sg[e] * g4[e] / (1.f + __expf(-g4[e]));
                const unsigned w1_ = cvtpk(ov[2], ov[3]);
                *(GAS v2u*)(op + vc) = (v2u){cvtpk(ov[0], ov[1]), w1_};
                asm volatile("" : "+v"(etok) : "v"(w1_));
            }
    }
    __syncthreads();
}
#ifndef DBL
#define DBL 0
#endif
constexpr int CW_QUEUE = 8192;
constexpr int QX_RW = 8, QX_A2 = 0, QX_AT = 64, QX_ALL = QX_RW + QX_A2 + QX_AT;
__device__ __forceinline__ void p3_queue(Frame& F, const RwDump& Dm, const int qbase = CW_QUEUE) {
    const int ql = mk_lane();
    const float l1 = wave_sum(F.lq1[ql] * F.lk1[ql]), l2 = wave_sum(F.lq2[ql] * F.lk2[ql]);
    const float lam = __uint_as_float(__builtin_amdgcn_readfirstlane(__float_as_uint(__expf(l1) - __expf(l2) + LAMBDA_INIT)));
    float gq = fabsf(F.qn_g[ql]), gk = fabsf(F.kn_g[ql]);
#pragma unroll
    for (int o = 1; o < 64; o <<= 1) { gq = fmaxf(gq, __shfl_xor(gq, o)); gk = fmaxf(gk, __shfl_xor(gk, o)); }
    const float shift2 = __uint_as_float(__builtin_amdgcn_readfirstlane(__float_as_uint(8.f * gq * gk * LOG2E)));
    if (F.wave == 0 && mk_lane() == 0) { F.MISC[14] = __float_as_uint(lam); F.MISC[15] = __float_as_uint(shift2); }
    __syncthreads();
#ifdef Q_BLK
    const int x0 = (int)(blockIdx.x & 7);
#else
    const int x0 = (int)(xb_xcc_id() & 7u);
#endif
#pragma unroll 1
    for (int dx = 0; dx < 8; ++dx) {
        const int xq = (x0 + dx) & 7;
        for (;;) {
            if (F.wave == 0 && mk_lane() == 0) F.MISC[12] = __hip_atomic_fetch_add(F.ctl + qbase + 64 * xq, 1u, RLX_AGENT);
            __syncthreads();
            const int item = __builtin_amdgcn_readfirstlane((int)F.MISC[12]);
            __syncthreads();
            if (item >= QX_ALL) break;
            if (item < QX_RW) { rwkvB_unit(F, Dm, xq * 8 + item); if (DBL & 64) rwkvB_unit(F, Dm, xq * 8 + item); }
            else { const int idx = item - QX_RW - QX_A2, h = 3 - (idx >> 4), qb = 15 - (idx & 15);
#pragma unroll 1
#ifndef NO_ATT
                for (int rep = 0; rep < ((DBL & 32) ? 2 : 1); ++rep) attn_unit(F, xq, h, qb);
#endif
            }
        }
    }
}

struct Args { const float* in[21]; float* out; unsigned char* ws; int ph_lo, ph_hi; };
__global__ void __launch_bounds__(NWAVES * 64, 2) hymba_fwd(Args args) {
    extern __shared__ __attribute__((aligned(16))) unsigned char lds[];
    Frame F;
    F.lds = (LAS unsigned char*)lds;
    F.MISC = (volatile LAS unsigned*)(F.lds + MISC_OFF);
    F.wave = __builtin_amdgcn_readfirstlane((int)threadIdx.x >> 6); F.lane = mk_lane(); F.tid = F.wave * 64 + F.lane;
    F.G = gridDim.x; { const int bx = blockIdx.x; F.vcu = (F.G % 8 == 0) ? (bx % 8) * (F.G / 8) + bx / 8 : bx; }
    unsigned char* ws = args.ws;
    F.ctl = (gu32*)(ws + WS_CTL);
    F.x = args.in[0]; F.norm_g = args.in[1]; F.w_in = args.in[2]; F.shift_mu = args.in[3]; F.w0 = args.in[4]; F.w_decay_up = args.in[5]; F.a0 = args.in[6]; F.w_iclr_up = args.in[7];
    F.k_k = args.in[8]; F.k_a = args.in[9]; F.r_k = args.in[10]; F.ln_w = args.in[11]; F.ln_b = args.in[12]; F.qn_g = args.in[13]; F.kn_g = args.in[14];
    F.lq1 = args.in[15]; F.lk1 = args.in[16]; F.lq2 = args.in[17]; F.lk2 = args.in[18]; F.subln_g = args.in[19]; F.w_out = args.in[20]; F.out = args.out;
    F.WinT = (bf16*)(ws + WS_WIN); F.WoutT = (bf16*)(ws + WS_WOUT); F.WdT = (bf16*)(ws + WS_WD); F.WaT = (bf16*)(ws + WS_WA);
    F.XN = (bf16*)(ws + WS_XN); F.PROJ = (bf16*)(ws + WS_PROJ); F.MIX = (bf16*)(ws + WS_MIX);
    for (int u = F.tid; u < (LDS_BYTES - LDSCTL_OFF) / 4; u += NWAVES * 64) ((LAS unsigned*)(F.lds + LDSCTL_OFF))[u] = 0u;
    __syncthreads();
    XcdBarrier bar; bar.bar = (unsigned*)(F.ctl + CW_BAR); bar.x = 0; bar.st = nullptr; bar.wave = F.wave;
    if (MK_N_LAUNCHES == 1) bar = xcd_barrier_post((unsigned*)(F.ctl + CW_BAR), F.MISC + 8, F.wave);
#define GRID_BAR() do { if (MK_N_LAUNCHES == 1) xcd_barrier(bar); } while (0)
    const int lo = args.ph_lo, hi = args.ph_hi;
#define IN(k) (lo <= (k) && (k) < hi)
#define BOTH(k) (IN(k) && IN((k) + 1))
#ifndef SKIP
#define SKIP 0
#endif
    if (IN(0) && !(SKIP & 1)) { p0_prologue(F); if (DBL & 1) { GRID_BAR(); p0_prologue(F); } if (BOTH(0)) GRID_BAR(); }
    if (IN(1) && !(SKIP & 2)) {
        pg8::Gemm g{F.XN, F.WinT, M, NP, D}; pg8::StaticOrder S; S.init(M, NP, F.G, (int)blockIdx.x);
        pg8::EpiBf16S E{F.PROJ, NP};
        pg8::gemm_phase<pg8::EpiBf16S, pg8::StaticOrder, true, true>(F.lds + RING_OFF, g, S, E, F.wave);
        if (DBL & 2) { GRID_BAR(); pg8::gemm_phase<pg8::EpiBf16S, pg8::StaticOrder, true, true>(F.lds + RING_OFF, g, S, E, F.wave); }
        if (BOTH(1)) GRID_BAR();
    }
    RwDump Dm; { unsigned char* so = (unsigned char*)args.out; Dm.PF = (v4u*)so; Dm.DD = (v4u*)(so + 32 * MiB); Dm.QF = (v4u*)(ws + WS_XN); Dm.YD = (v4u*)(ws + WS_XN + 16 * MiB);
        Dm.GAM = (float*)(ws + WS_END); Dm.RHO = (float*)(ws + WS_END + 1 * MiB); }
    if (IN(2) && !(SKIP & 4)) {
        LAS float* wscr = (LAS float*)(F.lds + LDSCTL_OFF + 1024) + F.wave * 64;
#pragma unroll 1
        for (int p = F.vcu; p < BATCH * (T / 32); p += F.G) rwkvA_unit(F, Dm, (p >> 6) * RH + F.wave, p & 63, wscr, F.lds + RING_OFF + F.wave * 16384);
        if (DBL & 4) { GRID_BAR();
#pragma unroll 1
            for (int p = F.vcu; p < BATCH * (T / 32); p += F.G) rwkvA_unit(F, Dm, (p >> 6) * RH + F.wave, p & 63, wscr, F.lds + RING_OFF + F.wave * 16384); }
        p2_qknorm(F);
        if (BOTH(2)) GRID_BAR();
    }
    if (IN(3) && !(SKIP & 8)) {
        p3_queue(F, Dm);
        if (DBL & 512) { GRID_BAR(); p3_queue(F, Dm, CW_QUEUE + 1024); }
        if (BOTH(3)) GRID_BAR();
    }
    if (IN(4) && !(SKIP & 16)) {
        pg8::Gemm g{F.MIX, F.WoutT, M, D, D}; pg8::StaticOrder S; S.init(M, D, F.G, (int)blockIdx.x);
        pg8::EpiResF32 E{F.x, F.out, D};
        pg8::gemm_phase<pg8::EpiResF32, pg8::StaticOrder, false, true>(F.lds + RING_OFF, g, S, E, F.wave);
        if (DBL & 16) { GRID_BAR(); pg8::gemm_phase<pg8::EpiResF32, pg8::StaticOrder, false, true>(F.lds + RING_OFF, g, S, E, F.wave); }
    }
#undef IN
#undef BOTH
}

extern "C" void kernel_launch(void* const* d_in, const int* in_sizes, int n_in, void* d_out, int out_size, void* d_ws, size_t ws_size, hipStream_t stream) {
    static int grid = 0;
    if (grid == 0) {
        if (n_in != 21 || in_sizes[0] != M * D || out_size != M * D || ws_size < WS_END + 2 * MiB) { fprintf(stderr, "kernel_launch: unexpected shapes (n_in %d, in0 %d, out %d, ws %zu); nothing launched\n", n_in, n_in > 0 ? in_sizes[0] : -1, out_size, ws_size); grid = -1; return; }
        int dev = 0, cus = 0, per_cu = 0;
        if (hipGetDevice(&dev) != hipSuccess || hipDeviceGetAttribute(&cus, hipDeviceAttributeMultiprocessorCount, dev) != hipSuccess) { grid = -1; return; }
        if (hipFuncSetAttribute((const void*)hymba_fwd, hipFuncAttributeMaxDynamicSharedMemorySize, LDS_BYTES) != hipSuccess) { fprintf(stderr, "kernel_launch: hipFuncSetAttribute failed\n"); grid = -1; return; }
        if (hipOccupancyMaxActiveBlocksPerMultiprocessor(&per_cu, (const void*)hymba_fwd, NWAVES * 64, LDS_BYTES) != hipSuccess || per_cu < 1) { fprintf(stderr, "kernel_launch: occupancy query reports %d workgroups per CU; nothing launched\n", per_cu); grid = -1; return; }
        (void)hipGetLastError();
        grid = cus;
        if (grid > 256) grid = 256;
    }
    if (grid < 0) return;
    if (hipMemsetAsync((char*)d_ws + WS_CTL, 0, CTL_ZERO_BYTES, stream) != hipSuccess) { fprintf(stderr, "kernel_launch: hipMemsetAsync failed\n"); return; }
    Args a{};
    for (int i = 0; i < 21; ++i) a.in[i] = (const float*)d_in[i];
    a.out = (float*)d_out; a.ws = (unsigned char*)d_ws;
    for (int li = 0; li < MK_N_LAUNCHES; ++li) {
        a.ph_lo = (MK_N_LAUNCHES == 1) ? 0 : li; a.ph_hi = (MK_N_LAUNCHES == 1) ? N_PHASES : li + 1;
        hipLaunchKernelGGL(hymba_fwd, dim3(grid), dim3(NWAVES * 64), LDS_BYTES, stream, a);
        const hipError_t le = hipPeekAtLastError();
        if (le != hipSuccess) { fprintf(stderr, "kernel_launch: launch %d failed: %s\n", li, hipGetErrorName(le)); break; }
    }
}
```

```cpp
#define MK_N_LAUNCHES 1
#include <hip/hip_runtime.h>
#include <hip/hip_bf16.h>
#include <cstdio>
#include <cstdint>
#include <cmath>
namespace pg8 {
#define PG8_LAS __attribute__((address_space(3)))
typedef unsigned short bf16_t;
typedef short bf16x8 __attribute__((ext_vector_type(8)));
typedef float f32x4 __attribute__((ext_vector_type(4)));
typedef unsigned u32x4 __attribute__((ext_vector_type(4)));
constexpr int BM = 256, BK = 64, HALF = 128, HTB = HALF * BK * 2  , STAGE_BYTES = 8 * HTB, NXCD = 8, WGM = 8;

__host__ __device__ __forceinline__ int lds_byte(int r, int c) { const int st = (r >> 4) * 2 + (c >> 5), rr = r & 15, cc = c & 31, ob = rr * 64 + cc * 2; return st * 1024 + (ob ^ (((ob >> 9) & 1) << 5)); }
__host__ __device__ __forceinline__ void stage_rc(int b, int& R, int& C) { const int st = b / 1024, sb = b % 1024, swz = sb ^ (((sb >> 9) & 1) << 5); R = (st >> 1) * 16 + swz / 64; C = (st & 1) * 32 + (swz % 64) / 2; }
__host__ __device__ __forceinline__ int perm32(int rho) { const int n = rho >> 4, i = rho & 15; return 8 * (i >> 2) + 4 * n + (i & 3); }

__device__ __forceinline__ int mk_lane_pg8() { int l; asm volatile("v_mbcnt_lo_u32_b32 %0, -1, 0\n\tv_mbcnt_hi_u32_b32 %0, -1, %0" : "=v"(l)); return l; }
struct Unit { int pm, pn; };
struct Gemm { const bf16_t* A; const bf16_t* Bt; int M, N, K; };

struct StaticOrder {
    int nM, nN, nwg, G, c;
    __host__ __device__ void init(int M, int N, int G_, int c_) { nM = M / BM; nN = N / BM; nwg = nM * nN; G = G_; c = c_; }
    __host__ __device__ bool next(int i, Unit& u) const {
        const long L = (long)i * G + c; if (L >= nwg) return false;
        int wgid = (int)L; { const int q = nwg / NXCD, r = nwg % NXCD, xcd = wgid % NXCD, off = wgid / NXCD; wgid = (xcd < r ? xcd * (q + 1) : r * (q + 1) + (xcd - r) * q) + off; }
        const int nig = WGM * nN, gid = wgid / nig, fm = gid * WGM, gsz = (nM - fm) < WGM ? (nM - fm) : WGM;
        u.pm = fm + ((wgid % nig) % gsz); u.pn = (wgid % nig) / gsz; return true;
    }
    __device__ __forceinline__ void a_ready(const Unit&) const {}
    __device__ __forceinline__ void done(const Unit&) const {}
};

__device__ __forceinline__ unsigned cvt_pk_bf16(float lo, float hi) { unsigned r; asm volatile("v_cvt_pk_bf16_f32 %0, %1, %2" : "=v"(r) : "v"(lo), "v"(hi)); return r; }
struct EpiBf16S {
    static constexpr bool PERM = true, AFTER_DRAIN = false;
    bf16_t* O; int ldc;
    __device__ __forceinline__ void operator()(const f32x4 (&acc)[2][2][4][2], const Unit& u, int wr, int wc, int fr, int fq) const {
        const int row0 = u.pm * BM + wr * 64 + fr, col0 = u.pn * BM + wc * 32 + 8 * fq;
#pragma unroll
        for (int ai = 0; ai < 2; ++ai)
#pragma unroll
            for (int m = 0; m < 4; ++m) { bf16_t* rowp = O + (size_t)(row0 + ai * HALF + m * 16) * ldc + col0;
#pragma unroll
                for (int bj = 0; bj < 2; ++bj) { const f32x4 v0 = acc[ai][bj][m][0], v1 = acc[ai][bj][m][1];
                    u32x4 w; w.x = cvt_pk_bf16(v0[0], v0[1]); w.y = cvt_pk_bf16(v0[2], v0[3]); w.z = cvt_pk_bf16(v1[0], v1[1]); w.w = cvt_pk_bf16(v1[2], v1[3]);
                    *(u32x4*)(rowp + bj * HALF) = w; } }
    }
};
struct EpiResF32 {
    static constexpr bool PERM = false, AFTER_DRAIN = false;
    const float* base; float* out; int ldc;
    __device__ __forceinline__ void operator()(const f32x4 (&acc)[2][2][4][2], const Unit& u, int wr, int wc, int fr, int fq) const {
        const int row0 = u.pm * BM + wr * 64 + fr, col0 = u.pn * BM + wc * 32 + 4 * fq;
#pragma unroll
        for (int ai = 0; ai < 2; ++ai)
#pragma unroll
            for (int m = 0; m < 4; ++m) { const size_t off = (size_t)(row0 + ai * HALF + m * 16) * ldc + col0;
#pragma unroll
                for (int bj = 0; bj < 2; ++bj)
#pragma unroll
                    for (int n = 0; n < 2; ++n) { const f32x4 bs = *(const f32x4*)(base + off + bj * HALF + n * 16); *(f32x4*)(out + off + bj * HALF + n * 16) = bs + acc[ai][bj][m][n]; } }
    }
};
template <class Epi, class Sched, bool ALIGN_EPI = false, bool SP2 = false>
__device__ __forceinline__ void gemm_phase(PG8_LAS unsigned char* lds, const Gemm g, const Sched& S, const Epi& E, const int mk_wave_id  ) {
    const int wid = mk_wave_id, lane = mk_lane_pg8(), tid = wid * 64 + lane, wr = wid >> 2, wc = wid & 3, fr = lane & 15, fq = lane >> 4;
    const int K = g.K, nt = K / BK;
    unsigned voffA[2], voffB[2];
#pragma unroll
    for (int i = 0; i < 2; ++i) { int R, C; stage_rc(tid * 16 + i * 8192, R, C); const int Rb = Epi::PERM ? ((R & ~31) + perm32(R & 31)) : R;
        voffA[i] = (unsigned)(R * K + C) * 2u; voffB[i] = (unsigned)(Rb * K + C) * 2u; }
    const size_t kstep = (size_t)(BK * 2);
    const size_t hstep = (size_t)HALF * K * 2;
    const size_t tstep = 2 * hstep;
    const unsigned ldsw = (unsigned)wid * 1024u;
    const int aoff = lds_byte(wr * 64 + fr, fq * 8), boff = lds_byte(wc * 32 + fr, fq * 8);
#define PG8_SA(b, h) (((b) * 2 + (h)) * HTB)
#define PG8_SB(b, h) ((4 + (b) * 2 + (h)) * HTB)
#define PG8_STAGE(bufoff, gbase, voff) do { _Pragma("unroll") for (int _i = 0; _i < 2; ++_i) \
        __builtin_amdgcn_global_load_lds((const unsigned*)((const char*)(gbase) + (voff)[_i]), (PG8_LAS unsigned*)(lds + (bufoff) + ldsw + _i * 8192), 16, 0, 0); } while (0)
#define PG8_LDA(dst, b, h) do { _Pragma("unroll") for (int m = 0; m < 4; ++m) _Pragma("unroll") for (int k = 0; k < 2; ++k) dst[m][k] = *(const PG8_LAS bf16x8*)(lds + PG8_SA(b, h) + aoff + m * 2048 + k * 1024); } while (0)
#define PG8_LDB(dst, b, h) do { _Pragma("unroll") for (int n = 0; n < 2; ++n) _Pragma("unroll") for (int k = 0; k < 2; ++k) dst[n][k] = *(const PG8_LAS bf16x8*)(lds + PG8_SB(b, h) + boff + n * 2048 + k * 1024); } while (0)
#define PG8_MMA(ai, bj, At, Bt) do { __builtin_amdgcn_s_setprio(1); _Pragma("unroll") for (int m = 0; m < 4; ++m) _Pragma("unroll") for (int n = 0; n < 2; ++n) _Pragma("unroll") for (int k = 0; k < 2; ++k) \
        acc[ai][bj][m][n] = __builtin_amdgcn_mfma_f32_16x16x32_bf16(Bt[n][k], At[m][k], acc[ai][bj][m][n], 0, 0, 0); __builtin_amdgcn_s_setprio(0); } while (0)
#define PG8_WAIT_V(n) asm volatile("s_waitcnt vmcnt(" #n ")" ::: "memory")
#define PG8_WAIT_L(n) asm volatile("s_waitcnt lgkmcnt(" #n ")" ::: "memory")
#define PG8_BAR __builtin_amdgcn_s_barrier()
#define PG8_SCHED __builtin_amdgcn_sched_barrier(0)
    Unit cur, nxt; int ui = 0;
    if (!S.next(0, cur)) return;
    f32x4 acc[2][2][4][2];
#pragma unroll
    for (int a = 0; a < 2; ++a)
#pragma unroll
        for (int b = 0; b < 2; ++b)
#pragma unroll
            for (int m = 0; m < 4; ++m)
#pragma unroll
                for (int n = 0; n < 2; ++n) acc[a][b][m][n] = (f32x4){0.f, 0.f, 0.f, 0.f};
    bf16x8 At[4][2], B0[2][2], B1[2][2];
    const char* cA = (const char*)g.A + (size_t)cur.pm * tstep; const char* cB = (const char*)g.Bt + (size_t)cur.pn * tstep;
    S.a_ready(cur);
    if constexpr (SP2) {
        PG8_STAGE(PG8_SB(0, 0), cB, voffB); PG8_STAGE(PG8_SB(0, 1), cB + hstep, voffB); PG8_STAGE(PG8_SA(0, 0), cA, voffA); PG8_STAGE(PG8_SA(0, 1), cA + hstep, voffA);
        if (wr == 1) PG8_BAR;
        PG8_WAIT_V(2); PG8_BAR;
        PG8_STAGE(PG8_SB(1, 0), cB + kstep, voffB); PG8_STAGE(PG8_SA(1, 0), cA + kstep, voffA); PG8_STAGE(PG8_SB(1, 1), cB + hstep + kstep, voffB);
        PG8_WAIT_V(6); PG8_BAR;
    } else {
        PG8_STAGE(PG8_SB(0, 0), cB, voffB); PG8_STAGE(PG8_SA(0, 0), cA, voffA); PG8_STAGE(PG8_SB(0, 1), cB + hstep, voffB); PG8_STAGE(PG8_SA(0, 1), cA + hstep, voffA);
        if (wr == 1) PG8_BAR;
        PG8_WAIT_V(4); PG8_BAR;
        PG8_STAGE(PG8_SB(1, 0), cB + kstep, voffB); PG8_STAGE(PG8_SA(1, 0), cA + kstep, voffA); PG8_STAGE(PG8_SB(1, 1), cB + hstep + kstep, voffB);
        PG8_WAIT_V(6); PG8_BAR;
    }
    for (;;) {
        const bool has_next = S.next(ui + 1, nxt);
        const char* nA = has_next ? (const char*)g.A + (size_t)nxt.pm * tstep : cA; const char* nB = has_next ? (const char*)g.Bt + (size_t)nxt.pn * tstep : cB;
        for (int t = 0; t < nt; t += 2) {
            const bool last = (t == nt - 2);
            const char* a1 = cA + (size_t)(t + 1) * kstep;
            const char* a2 = last ? nA : cA + (size_t)(t + 2) * kstep; const char* b2 = last ? nB : cB + (size_t)(t + 2) * kstep;
            const char* a3 = a2 + kstep; const char* b3 = b2 + kstep;
            if (last && has_next) S.a_ready(nxt);
            if constexpr (SP2) {
            PG8_LDB(B0, 0, 0); PG8_LDB(B1, 0, 1); PG8_SCHED; PG8_LDA(At, 0, 0); PG8_STAGE(PG8_SA(1, 1), a1 + hstep, voffA);
            PG8_WAIT_V(8); PG8_WAIT_L(0); PG8_BAR; PG8_MMA(0, 0, At, B0); PG8_MMA(0, 1, At, B1); PG8_BAR; PG8_SCHED;
            PG8_LDA(At, 0, 1); PG8_STAGE(PG8_SB(0, 0), b2, voffB); PG8_STAGE(PG8_SB(0, 1), b2 + hstep, voffB); PG8_STAGE(PG8_SA(0, 0), a2, voffA);
            PG8_WAIT_V(8); PG8_WAIT_L(0); PG8_BAR; PG8_MMA(1, 0, At, B0); PG8_MMA(1, 1, At, B1); PG8_BAR; PG8_SCHED;
            PG8_LDB(B0, 1, 0); PG8_LDB(B1, 1, 1); PG8_SCHED; PG8_LDA(At, 1, 0); PG8_STAGE(PG8_SA(0, 1), a2 + hstep, voffA);
            PG8_WAIT_V(8); PG8_WAIT_L(0); PG8_BAR; PG8_MMA(0, 0, At, B0); PG8_MMA(0, 1, At, B1); PG8_BAR; PG8_SCHED;
            PG8_LDA(At, 1, 1); PG8_STAGE(PG8_SB(1, 0), b3, voffB); PG8_STAGE(PG8_SB(1, 1), b3 + hstep, voffB); PG8_STAGE(PG8_SA(1, 0), a3, voffA);
            PG8_WAIT_V(8); PG8_WAIT_L(0); PG8_BAR; PG8_MMA(1, 0, At, B0); PG8_MMA(1, 1, At, B1); PG8_BAR; PG8_SCHED;
            } else {
            PG8_LDB(B0, 0, 0); PG8_SCHED; PG8_LDA(At, 0, 0); PG8_STAGE(PG8_SA(1, 1), a1 + hstep, voffA);
            PG8_WAIT_L(8); PG8_BAR; PG8_WAIT_L(0); PG8_MMA(0, 0, At, B0); PG8_BAR; PG8_SCHED;
            PG8_LDB(B1, 0, 1); PG8_STAGE(PG8_SB(0, 0), b2, voffB);
            PG8_BAR; PG8_WAIT_L(0); PG8_MMA(0, 1, At, B1); PG8_BAR;
            PG8_LDA(At, 0, 1); PG8_STAGE(PG8_SA(0, 0), a2, voffA);
            PG8_BAR; PG8_WAIT_L(0); PG8_MMA(1, 0, At, B0); PG8_BAR; PG8_SCHED;
            PG8_STAGE(PG8_SB(0, 1), b2 + hstep, voffB);
            PG8_WAIT_V(6); PG8_BAR; PG8_MMA(1, 1, At, B1); PG8_BAR;
            PG8_LDB(B0, 1, 0); PG8_SCHED; PG8_LDA(At, 1, 0); PG8_STAGE(PG8_SA(0, 1), a2 + hstep, voffA);
            PG8_WAIT_L(8); PG8_BAR; PG8_WAIT_L(0); PG8_MMA(0, 0, At, B0); PG8_BAR; PG8_SCHED;
            PG8_LDB(B1, 1, 1); PG8_STAGE(PG8_SB(1, 0), b3, voffB);
            PG8_BAR; PG8_WAIT_L(0); PG8_MMA(0, 1, At, B1); PG8_BAR;
            PG8_LDA(At, 1, 1); PG8_STAGE(PG8_SA(1, 0), a3, voffA);
            PG8_BAR; PG8_WAIT_L(0); PG8_MMA(1, 0, At, B0); PG8_BAR; PG8_SCHED;
            PG8_STAGE(PG8_SB(1, 1), b3 + hstep, voffB);
            PG8_WAIT_V(6); PG8_BAR; PG8_MMA(1, 1, At, B1); PG8_BAR;
            }
        }
        if constexpr (ALIGN_EPI) { if (wr == 0) PG8_BAR; }
        if constexpr (!Epi::AFTER_DRAIN) { E(acc, cur, wr, wc, fr, fq); S.done(cur); }
        if (!has_next) break;
#pragma unroll
        for (int a = 0; a < 2; ++a)
#pragma unroll
            for (int b = 0; b < 2; ++b)
#pragma unroll
                for (int m = 0; m < 4; ++m)
#pragma unroll
                    for (int n = 0; n < 2; ++n) acc[a][b][m][n] = (f32x4){0.f, 0.f, 0.f, 0.f};
        cur = nxt; cA = nA; cB = nB; ++ui;
        if constexpr (ALIGN_EPI) { if (wr == 1) PG8_BAR; }
    }
    PG8_WAIT_V(0);
    if constexpr (!ALIGN_EPI) { if (wr == 0) PG8_BAR; }
    PG8_BAR;
    if constexpr (Epi::AFTER_DRAIN) { E.fused(acc, cur, wr, wc, fr, fq, lds, wid, lane); S.done(cur); }
#undef PG8_SA
#undef PG8_SB
#undef PG8_STAGE
#undef PG8_LDA
#undef PG8_LDB
#undef PG8_MMA
#undef PG8_WAIT_V
#undef PG8_WAIT_L
#undef PG8_BAR
#undef PG8_SCHED
}
}
constexpr int NWAVES = 8;
#ifndef MK_N_LAUNCHES
#define MK_N_LAUNCHES 1
#endif
constexpr int N_PHASES = 5;
constexpr int BATCH = 8, T = 2048, D = 1024, M = BATCH * T;
constexpr int NP = 4352;
constexpr int C_R = 0, C_K = 512, C_V = 1024, C_ZW = 1536, C_ZA = 1600, C_GA = 1792, C_DQ = 2304, C_DK = 2816, C_DV = 3328, C_GB = 3840;
constexpr int RH = 8, RN = 64;
constexpr int AH = 4;
constexpr float C2 = 0.125f * 1.4426950408889634f;
constexpr float LOG2E = 1.4426950408889634f;
constexpr float LAMBDA_INIT = 0.2f;

constexpr size_t MiB = 1u << 20;
constexpr size_t WS_CTL = 0, CTL_ZERO_BYTES = 1 * MiB;
constexpr size_t WS_WIN = 2 * MiB;
constexpr size_t WS_WOUT = 11 * MiB;
constexpr size_t WS_WD = 13 * MiB, WS_WA = 13 * MiB + 65536;
constexpr size_t WS_RHO = 13 * MiB + 2 * 65536;
constexpr size_t WS_XN = 14 * MiB;
constexpr size_t WS_PROJ = 46 * MiB;
constexpr size_t WS_MIX = 182 * MiB;
constexpr size_t WS_END = 214 * MiB;
constexpr int CW_BAR = 4096;

constexpr int RING_OFF = 0, RING_BYTES = 131072;
constexpr int LDSCTL_OFF = RING_BYTES, MISC_OFF = LDSCTL_OFF + 320;
constexpr int LDS_BYTES = 155648;

#define GAS __attribute__((address_space(1)))
#define LAS __attribute__((address_space(3)))
typedef unsigned short bf16;
typedef unsigned v4u __attribute__((ext_vector_type(4)));
typedef unsigned v2u __attribute__((ext_vector_type(2)));
typedef float f32x4 __attribute__((ext_vector_type(4)));
typedef float f32x16 __attribute__((ext_vector_type(16)));
typedef short bf16x8 __attribute__((ext_vector_type(8)));
typedef short s16x4 __attribute__((ext_vector_type(4)));
typedef GAS unsigned gu32;
typedef GAS unsigned long long gu64;
#define RLX_AGENT __ATOMIC_RELAXED, __HIP_MEMORY_SCOPE_AGENT
#define LDS_WAIT() asm volatile("s_waitcnt lgkmcnt(0)" ::: "memory")
#define VM_WAIT() asm volatile("s_waitcnt vmcnt(0)" ::: "memory")
__device__ __forceinline__ unsigned f2bf(float f) { unsigned u = __builtin_bit_cast(unsigned, f); return (u + 0x7fffu + ((u >> 16) & 1u)) >> 16; }
__device__ __forceinline__ unsigned pk2(float lo, float hi) { return f2bf(lo) | (f2bf(hi) << 16); }
__device__ __forceinline__ float bflo(unsigned u) { return __uint_as_float(u << 16); }
__device__ __forceinline__ float bfhi(unsigned u) { return __uint_as_float(u & 0xffff0000u); }
__device__ __forceinline__ float bf1(unsigned short u) { return __uint_as_float((unsigned)u << 16); }
__device__ __forceinline__ int mk_lane() { int l; asm volatile("v_mbcnt_lo_u32_b32 %0, -1, 0\n\tv_mbcnt_hi_u32_b32 %0, -1, %0" : "=v"(l)); return l; }
#define XB_TMO      128
#define XB_XCNT(j)  (256  + 64 * (j))
#define XB_XSUB(j)  (1280 + 64 * (j))
#define XB_XGEN(j)  (2304 + 64 * (j))
#define XB_TOP      3328
#define XB_TOPGEN   3392
#define XCD_BAR_WORDS 3456
#define XB_SPIN_CAP (1u << 18)

__device__ __forceinline__ unsigned xb_ld(unsigned* p)              { return __hip_atomic_load(p, __ATOMIC_RELAXED, __HIP_MEMORY_SCOPE_AGENT); }
__device__ __forceinline__ unsigned xb_add(unsigned* p, unsigned v) { return __hip_atomic_fetch_add(p, v, __ATOMIC_RELAXED, __HIP_MEMORY_SCOPE_AGENT); }
__device__ __forceinline__ unsigned xb_xcc_id() { return (unsigned)__builtin_amdgcn_s_getreg((3 << 11) | 20) & 0xFu; }
#define XB_SPIN(cond, bar) do { unsigned _sp = 0; while (cond) { __builtin_amdgcn_s_sleep(1); \
    if ((++_sp & 255u) == 0u) { if (xb_ld(&(bar)[XB_TMO])) break; if (_sp > XB_SPIN_CAP) { atomicAdd(&(bar)[XB_TMO], 1u); break; } } } } while (0)

struct XcdBarrier {
    unsigned* bar; unsigned x;
    volatile LAS unsigned* st;
    int wave;
};

__device__ __forceinline__ XcdBarrier xcd_barrier_post(unsigned* bar, volatile LAS unsigned* st, int wave) {
    XcdBarrier b; b.bar = bar; b.x = xb_xcc_id(); b.st = st; b.wave = wave;
    if (wave == 0 && mk_lane() == 0) (void)xb_add(&bar[XB_XCNT(b.x)], 1u);
    return b;
}
__device__ __forceinline__ void xcd_barrier_complete(unsigned* bar, unsigned x, unsigned& nloc, unsigned& nx) {
    const unsigned G = gridDim.x * gridDim.y * gridDim.z;
    unsigned sum, cnt, mine, sp = 0u;
    for (;;) {
        sum = 0u; cnt = 0u; mine = 0u;
#pragma unroll
        for (unsigned j = 0; j < 16; ++j) { const unsigned c = xb_ld(&bar[XB_XCNT(j)]); sum += c; cnt += (c > 0u) ? 1u : 0u; mine = (j == x) ? c : mine; }
        if (sum == G) break;
        __builtin_amdgcn_s_sleep(1);
        if ((++sp & 255u) == 0u) { if (xb_ld(&bar[XB_TMO])) break; if (sp > XB_SPIN_CAP) { atomicAdd(&bar[XB_TMO], 1u); break; } }
    }
    nloc = mine > 0u ? mine : 1u; nx = cnt > 0u ? cnt : 1u;
}

__device__ __forceinline__ void xcd_barrier(const XcdBarrier& b) {
    asm volatile("s_waitcnt vmcnt(0)" ::: "memory");
    __syncthreads();
    if (b.wave == 0 && mk_lane() == 0) {
        unsigned* bar = b.bar;
        __builtin_amdgcn_s_waitcnt(0);
        unsigned nloc = b.st[0], nx = b.st[1];
        if (nloc == 0u) { xcd_barrier_complete(bar, b.x, nloc, nx); b.st[0] = nloc; b.st[1] = nx; }
        const unsigned old = xb_add(&bar[XB_XSUB(b.x)], 1u);
        const unsigned gen = old / nloc;
        if (old + 1u == (gen + 1u) * nloc) {
            __builtin_amdgcn_fence(__ATOMIC_RELEASE, "agent");
            asm volatile("s_waitcnt vmcnt(0)" ::: "memory");
            const unsigned og = xb_add(&bar[XB_TOP], 1u);
            const unsigned tg = og / nx;
            if (og + 1u == (tg + 1u) * nx) xb_add(&bar[XB_TOPGEN], 1u);
            else XB_SPIN(xb_ld(&bar[XB_TOPGEN]) == tg, bar);
            __builtin_amdgcn_fence(__ATOMIC_ACQUIRE, "agent");
            xb_add(&bar[XB_XGEN(b.x)], 1u);
            asm volatile("s_waitcnt vmcnt(0)" ::: "memory");
        } else {
            XB_SPIN(xb_ld(&bar[XB_XGEN(b.x)]) == gen, bar);
            __builtin_amdgcn_fence(__ATOMIC_ACQUIRE, "agent");
            asm volatile("s_waitcnt vmcnt(0)" ::: "memory");
        }
    }
    __syncthreads();
}
struct Frame {
    LAS unsigned char* lds;
    volatile LAS unsigned* MISC;
    gu32* ctl;
    int tid, lane, wave;
    int vcu, G;
    const float* x; float* out;
    const float *norm_g, *w_in, *shift_mu, *w0, *w_decay_up, *a0, *w_iclr_up, *k_k, *k_a, *r_k, *ln_w, *ln_b, *qn_g, *kn_g, *lq1, *lk1, *lq2, *lk2, *subln_g, *w_out;
    bf16 *WinT, *WoutT, *WdT, *WaT, *XN, *PROJ, *MIX;
};

typedef float f32x2q_t __attribute__((ext_vector_type(2))); typedef __bf16 bf16x2q_t __attribute__((ext_vector_type(2)));
__device__ __forceinline__ unsigned cvtpk2(float lo, float hi) { f32x2q_t v = {lo, hi}; bf16x2q_t b = __builtin_convertvector(v, bf16x2q_t); return __builtin_bit_cast(unsigned, b); }
__device__ __forceinline__ float wave_sum(float v) {
#pragma unroll
    for (int o = 1; o < 64; o <<= 1) v += __shfl_xor(v, o);
    return v;
}
template <int CTRL> __device__ __forceinline__ float dpp_f(float x) { return __builtin_bit_cast(float, __builtin_amdgcn_mov_dpp(__builtin_bit_cast(int, x), CTRL, 0xf, 0xf, true)); }
__device__ __forceinline__ float row16_sum(float x) {
    x += dpp_f<0xB1>(x); x += dpp_f<0x4E>(x); x += dpp_f<0x141>(x); x += dpp_f<0x140>(x); return x;
}
__device__ __forceinline__ float swap32_sum(float x) {
    auto rr = __builtin_amdgcn_permlane32_swap(__float_as_uint(x), __float_as_uint(x), false, false);
    return __uint_as_float(rr[0]) + __uint_as_float(rr[1]);
}

__device__ __forceinline__ void p0_transpose_item(const float* W, int N, int nsrc, const float* kscale, bf16* WT, int K, int ndst, LAS float* scr, int k0, int lane) {
    float v[32];
#pragma unroll
    for (int i = 0; i < 32; ++i) { const int kk = 2 * i + (lane >> 5); v[i] = (nsrc >= 0) ? W[(size_t)(k0 + kk) * N + nsrc + (lane & 31)] : 0.f; }
    if (kscale && nsrc >= 0) {
#pragma unroll
        for (int i = 0; i < 32; ++i) v[i] *= kscale[k0 + 2 * i + (lane >> 5)];
    }
#pragma unroll
    for (int i = 0; i < 32; ++i) scr[(2 * i + (lane >> 5)) * 33 + (lane & 31)] = v[i];
    LDS_WAIT(); asm volatile("" ::: "memory");
    const int c = lane & 7;
#pragma unroll
    for (int j = 0; j < 4; ++j) { const int n = (lane >> 3) + 8 * j; const LAS float* s = scr + (8 * c) * 33 + n;
        v4u o; o.x = cvtpk2(s[0 * 33], s[1 * 33]); o.y = cvtpk2(s[2 * 33], s[3 * 33]); o.z = cvtpk2(s[4 * 33], s[5 * 33]); o.w = cvtpk2(s[6 * 33], s[7 * 33]);
        *(GAS v4u*)(WT + (size_t)(ndst + n) * K + k0 + 8 * c) = o; }
    LDS_WAIT(); asm volatile("" ::: "memory");
}
__device__ __forceinline__ void p0_prologue(Frame& F) {
    LAS float* scr = (LAS float*)(F.lds + RING_OFF + F.wave * 16384);
    const int gw = F.vcu * NWAVES + F.wave, NGW = F.G * NWAVES;
    constexpr int I_IN = (D / 64) * (NP / 32), I_OUT = (D / 64) * (D / 32), I_L = 512 / 32;
    constexpr int NITEMS = I_IN + I_OUT + 2 * I_L;
    for (int it = gw; it < NITEMS; it += NGW) {
        int r = it;
        if (r < I_IN) { const int kb = r / (NP / 32), nb = r % (NP / 32), nd = 32 * nb; const int ns = nd < 1664 ? nd : (nd < 1792 ? -1 : nd - 128);
            p0_transpose_item(F.w_in, 4224, ns, F.norm_g, F.WinT, D, nd, scr, 64 * kb, F.lane); continue; } r -= I_IN;
        if (r < I_OUT) { const int kb = r / (D / 32), nb = r % (D / 32);
            p0_transpose_item(F.w_out, D, 32 * nb, nullptr, F.WoutT, D, 32 * nb, scr, 64 * kb, F.lane); continue; } r -= I_OUT;
        if (r < I_L) { p0_transpose_item(F.w_decay_up, 512, 32 * r, nullptr, F.WdT, 64, 32 * r, scr, 0, F.lane); continue; } r -= I_L;
        p0_transpose_item(F.w_iclr_up, 512, 32 * r, nullptr, F.WaT, 64, 32 * r, scr, 0, F.lane);
    }
    for (int m0 = gw * 4; m0 < M; m0 += NGW * 4) {
        f32x4 v[4][4]; float s[4];
#pragma unroll
        for (int u = 0; u < 4; ++u) { const GAS f32x4* xr = (const GAS f32x4*)(F.x + (size_t)(m0 + u) * D) + F.lane;
#pragma unroll
            for (int j = 0; j < 4; ++j) v[u][j] = __builtin_nontemporal_load(xr + 64 * j); }
#pragma unroll
        for (int u = 0; u < 4; ++u) { float a = 0.f;
#pragma unroll
            for (int j = 0; j < 4; ++j) a += (v[u][j].x * v[u][j].x + v[u][j].y * v[u][j].y) + (v[u][j].z * v[u][j].z + v[u][j].w * v[u][j].w);
            s[u] = a; }
#pragma unroll
        for (int u = 0; u < 4; ++u) {
            const float rstd = __builtin_amdgcn_rsqf(wave_sum(s[u]) * (1.f / D) + 1e-6f);
            GAS unsigned long long* o8 = (GAS unsigned long long*)(F.XN + (size_t)(m0 + u) * D) + F.lane;
#pragma unroll
            for (int j = 0; j < 4; ++j) o8[64 * j] = (unsigned long long)cvtpk2(v[u][j].x * rstd, v[u][j].y * rstd) | ((unsigned long long)cvtpk2(v[u][j].z * rstd, v[u][j].w * rstd) << 32);
        }
    }
}

__device__ __forceinline__ float tanh_f(float x) { const float e = __expf(-2.f * fabsf(x)); const float t = (1.f - e) * __builtin_amdgcn_rcpf(1.f + e); return x < 0.f ? -t : t; }
__device__ __forceinline__ void shifted8(const bf16* proj, size_t m, bool has_prev, int col, const float* mu, float (&o)[8]) {
    const v4u c = *(const GAS v4u*)(proj + m * NP + col);
    v4u p = (v4u){0u, 0u, 0u, 0u}; if (has_prev) p = *(const GAS v4u*)(proj + (m - 1) * NP + col);
    const f32x4 m0 = *(const GAS f32x4*)(mu), m1 = *(const GAS f32x4*)(mu + 4);
    const unsigned cw[4] = {c.x, c.y, c.z, c.w}, pw[4] = {p.x, p.y, p.z, p.w}; const float mm[8] = {m0.x, m0.y, m0.z, m0.w, m1.x, m1.y, m1.z, m1.w};
#pragma unroll
    for (int j = 0; j < 4; ++j) { const float c0 = bflo(cw[j]), c1 = bfhi(cw[j]), p0 = bflo(pw[j]), p1 = bfhi(pw[j]);
        o[2 * j] = c0 + (p0 - c0) * mm[2 * j]; o[2 * j + 1] = c1 + (p1 - c1) * mm[2 * j + 1]; }
}
__device__ __forceinline__ void shifted4(const bf16* proj, size_t m, bool has_prev, int col, const float* mu, float (&o)[4]) {
    const v2u c = *(const GAS v2u*)(proj + m * NP + col);
    v2u p = (v2u){0u, 0u}; if (has_prev) p = *(const GAS v2u*)(proj + (m - 1) * NP + col);
    const f32x4 m0 = *(const GAS f32x4*)(mu);
    o[0] = bflo(c.x) + (bflo(p.x) - bflo(c.x)) * m0.x; o[1] = bfhi(c.x) + (bfhi(p.x) - bfhi(c.x)) * m0.y;
    o[2] = bflo(c.y) + (bflo(p.y) - bflo(c.y)) * m0.z; o[3] = bfhi(c.y) + (bfhi(p.y) - bfhi(c.y)) * m0.w;
}
__device__ __forceinline__ void p2_qknorm(Frame& F) {
    const int gw = F.vcu * NWAVES + F.wave, NGW = F.G * NWAVES, lane = F.lane, sub = lane & 7;
    const f32x4 gq0 = *(const GAS f32x4*)(F.qn_g + sub * 8), gq1 = *(const GAS f32x4*)(F.qn_g + sub * 8 + 4), gk0 = *(const GAS f32x4*)(F.kn_g + sub * 8), gk1 = *(const GAS f32x4*)(F.kn_g + sub * 8 + 4);
    constexpr int UQ = 4;
    for (int it0 = gw * UQ; it0 < 2 * M; it0 += NGW * UQ) {
        bf16* p[UQ]; v4u c[UQ];
#pragma unroll
        for (int u = 0; u < UQ; ++u) { const int it = it0 + u; const size_t m = (size_t)(it >> 1); p[u] = F.PROJ + m * NP + ((it & 1) ? C_DK : C_DQ) + (lane >> 3) * 64 + sub * 8; c[u] = *(const GAS v4u*)p[u]; }
#pragma unroll
        for (int u = 0; u < UQ; ++u) {
            const int isk = (it0 + u) & 1; const unsigned cw[4] = {c[u].x, c[u].y, c[u].z, c[u].w};
            float xv[8]; float ss = 0.f;
#pragma unroll
            for (int j = 0; j < 4; ++j) { xv[2 * j] = bflo(cw[j]); xv[2 * j + 1] = bfhi(cw[j]); ss += xv[2 * j] * xv[2 * j] + xv[2 * j + 1] * xv[2 * j + 1]; }
            ss += dpp_f<0xB1>(ss); ss += dpp_f<0x4E>(ss); ss += dpp_f<0x141>(ss);
            const float r = __builtin_amdgcn_rsqf(ss * (1.f / 64.f) + 1e-6f) * (isk ? 1.f : C2);
            const f32x4 g0 = isk ? gk0 : gq0, g1 = isk ? gk1 : gq1;
            v4u o; o.x = cvtpk2(xv[0] * r * g0.x, xv[1] * r * g0.y); o.y = cvtpk2(xv[2] * r * g0.z, xv[3] * r * g0.w); o.z = cvtpk2(xv[4] * r * g1.x, xv[5] * r * g1.y); o.w = cvtpk2(xv[6] * r * g1.z, xv[7] * r * g1.w);
            *(GAS v4u*)p[u] = o;
        }
    }
}
typedef float f32x2_t __attribute__((ext_vector_type(2))); typedef __bf16 bf16x2_t __attribute__((ext_vector_type(2)));
__device__ __forceinline__ unsigned cvtpk(float lo, float hi) { f32x2_t v = {lo, hi}; bf16x2_t b = __builtin_convertvector(v, bf16x2_t); return __builtin_bit_cast(unsigned, b); }
#define MFMA32(a, b, c) __builtin_amdgcn_mfma_f32_32x32x16_bf16(__builtin_bit_cast(bf16x8, (a)), __builtin_bit_cast(bf16x8, (b)), (c), 0, 0, 0)
#define FRAGACC(z, s) ((v4u){cvtpk((z)[8 * (s)], (z)[8 * (s) + 1]), cvtpk((z)[8 * (s) + 2], (z)[8 * (s) + 3]), cvtpk((z)[8 * (s) + 4], (z)[8 * (s) + 5]), cvtpk((z)[8 * (s) + 6], (z)[8 * (s) + 7])})
template <int CTRL, int RM> __device__ __forceinline__ float dpp_upd0(float x) { return __builtin_bit_cast(float, __builtin_amdgcn_update_dpp(0, __builtin_bit_cast(int, x), CTRL, RM, 0xf, false)); }
__device__ __forceinline__ float scan32(float x) {
    x += dpp_upd0<0x111, 0xf>(x); x += dpp_upd0<0x112, 0xf>(x); x += dpp_upd0<0x114, 0xf>(x); x += dpp_upd0<0x118, 0xf>(x); x += dpp_upd0<0x142, 0xa>(x); return x;
}
__device__ __forceinline__ void st_wt16(v4u* p, const v4u v) { *(GAS v4u*)p = v; }
constexpr int RW_UNITS = BATCH * RH * (T / 32);
struct RwDump { v4u* PF; v4u* DD; v4u* QF; v4u* YD; float* GAM; float* RHO; };

__device__ __forceinline__ void rwkvA_unit(Frame& F, const RwDump& Dm, int bh, int ci, LAS float* wscr, LAS unsigned char* park, LAS v4u* zsh, int zpar) {
    int lane = mk_lane(); asm volatile("" : "+v"(lane));
    const int hi = lane >> 5, l31 = lane & 31, b = bh >> 3, w = bh & 7;
    LAS v4u* pk = (LAS v4u*)park + lane;
#define PARK(slot) pk[(slot) * 64]
    int tok = 0; asm volatile("" : "+v"(tok));
#define DEP(x) asm volatile("" : "+v"(tok) : "v"(x))
    const int t = ci * 32 + l31; const size_t m = (size_t)b * T + t; const bool hp = t > 0;
    const int u = ci * (BATCH * RH) + bh;
    const float pm = hp ? 1.f : 0.f;
    const bf16* pc = F.PROJ + m * NP + w * 64 + 4 * hi; const bf16* pp = F.PROJ + (hp ? m - 1 : m) * NP + w * 64 + 4 * hi;
    const float* mu = F.shift_mu + w * 64 + 4 * hi;
    const float *pw0 = F.w0 + w * 64 + 4 * hi, *pa0 = F.a0 + w * 64 + 4 * hi, *pkk = F.k_k + w * 64 + 4 * hi, *pka = F.k_a + w * 64 + 4 * hi, *prk = F.r_k + w * 64 + 4 * hi;
#define SH4(dst, COL, MU, OFF) do { const v2u c_ = *(const GAS v2u*)(pc + tok + (COL) + (OFF)), p_ = *(const GAS v2u*)(pp + tok + (COL) + (OFF)); const f32x4 m_ = *(const GAS f32x4*)(mu + tok + (MU) + (OFF)); \
        dst[0] = bflo(c_.x) + (bflo(p_.x) * pm - bflo(c_.x)) * m_.x; dst[1] = bfhi(c_.x) + (bfhi(p_.x) * pm - bfhi(c_.x)) * m_.y; \
        dst[2] = bflo(c_.y) + (bflo(p_.y) * pm - bflo(c_.y)) * m_.z; dst[3] = bfhi(c_.y) + (bfhi(p_.y) * pm - bfhi(c_.y)) * m_.w; } while (0)
    float ss = 0.f;
#pragma unroll
    for (int gq = 0; gq < 8; ++gq) { float k4[4]; SH4(k4, C_K, 512, 8 * gq); const f32x4 kkp = *(const GAS f32x4*)(pkk + tok + 8 * gq);
#pragma unroll
        for (int e = 0; e < 4; ++e) { const float q = k4[e] * kkp[e]; ss += q * q; }
        if (gq == 3) DEP(ss); }
    ss = swap32_sum(ss);
    const float inv = __builtin_amdgcn_rcpf(fmaxf(__builtin_amdgcn_sqrtf(ss), 1e-12f));
    asm volatile("" ::: "memory");
    v4u bz[4], ba[4];
    { const int s = F.wave >> 1; const bool which = (F.wave & 1) != 0;
      const bf16* zc = F.PROJ + m * NP + 8 * hi; const bf16* zp = F.PROJ + (hp ? m - 1 : m) * NP + 8 * hi; const float* zmu = F.shift_mu + 8 * hi;
      const int COL = (which ? C_ZA : C_ZW) + 16 * s, MUO = (which ? 1600 : 1536) + 16 * s;
      const v4u c = *(const GAS v4u*)(zc + tok + COL), p = *(const GAS v4u*)(zp + tok + COL); const f32x4 m0 = *(const GAS f32x4*)(zmu + tok + MUO), m1 = *(const GAS f32x4*)(zmu + tok + MUO + 4);
      float z[8];
#pragma unroll
      for (int j = 0; j < 4; ++j) { const float c0 = bflo(c[j]), c1 = bfhi(c[j]); const float mm0 = j < 2 ? m0[2 * j] : m1[2 * j - 4], mm1 = j < 2 ? m0[2 * j + 1] : m1[2 * j - 3];
          z[2 * j] = c0 + (bflo(p[j]) * pm - c0) * mm0; z[2 * j + 1] = c1 + (bfhi(p[j]) * pm - c1) * mm1; }
      if (!which) {
#pragma unroll
          for (int j = 0; j < 8; ++j) z[j] = tanh_f(z[j]); }
      LAS v4u* zs = zsh + zpar * 512;
      zs[((which ? 4 : 0) + s) * 64 + lane] = (v4u){cvtpk(z[0], z[1]), cvtpk(z[2], z[3]), cvtpk(z[4], z[5]), cvtpk(z[6], z[7])};
      __syncthreads();
#pragma unroll
      for (int q = 0; q < 4; ++q) { bz[q] = zs[q * 64 + lane]; ba[q] = zs[(4 + q) * 64 + lane]; }
      DEP(bz[3][3]); DEP(ba[3][3]); }
    asm volatile("" ::: "memory");
    v4u fa[4], fb[4], fk[4], fr[4], fv[4]; float rho = 0.f;
    float* gp = Dm.GAM + (size_t)u * 64 + hi * 32;
#define RW_LORA(cb) f32x16 accd = f32x16{}, acca = f32x16{}; _Pragma("unroll") for (int s = 0; s < 4; ++s) { \
        const v4u aD = *(const GAS v4u*)(F.WdT + tok + (size_t)(w * 64 + (cb) * 32 + l31) * 64 + 16 * s + 8 * hi); accd = MFMA32(aD, bz[s], accd); \
        const v4u aA = *(const GAS v4u*)(F.WaT + tok + (size_t)(w * 64 + (cb) * 32 + l31) * 64 + 16 * s + 8 * hi); acca = MFMA32(aA, ba[s], acca); }
    struct RwGL { v2u rc, rp, kc, kp, vc, vp; } gA, gB;
#define RW_LOADG(X, OFF) do { X.rc = *(const GAS v2u*)(pc + tok + C_R + (OFF)); X.rp = *(const GAS v2u*)(pp + tok + C_R + (OFF)); X.kc = *(const GAS v2u*)(pc + tok + C_K + (OFF)); X.kp = *(const GAS v2u*)(pp + tok + C_K + (OFF)); \
        X.vc = *(const GAS v2u*)(pc + tok + C_V + (OFF)); X.vp = *(const GAS v2u*)(pp + tok + C_V + (OFF)); } while (0)
#define RW_LERP(dst, c_, p_, m_) do { dst[0] = bflo(c_.x) + (bflo(p_.x) * pm - bflo(c_.x)) * m_.x; dst[1] = bfhi(c_.x) + (bfhi(p_.x) * pm - bfhi(c_.x)) * m_.y; \
        dst[2] = bflo(c_.y) + (bflo(p_.y) * pm - bflo(c_.y)) * m_.z; dst[3] = bfhi(c_.y) + (bfhi(p_.y) * pm - bfhi(c_.y)) * m_.w; } while (0)
#define RW_GROUP(cb, rg, CUR, NXT, HASN) do { constexpr int OFF = 32 * (cb) + 8 * (rg); const int ch0 = OFF + 4 * hi; \
            if (HASN) RW_LOADG(NXT, OFF + 8); \
            float rr[4], kk4[4], vv[4]; \
            const f32x4 mr_ = *(const GAS f32x4*)(mu + tok + OFF), mk_ = *(const GAS f32x4*)(mu + tok + 512 + OFF), mv_ = *(const GAS f32x4*)(mu + tok + 1024 + OFF); \
            const f32x4 w0v = *(const GAS f32x4*)(pw0 + tok + OFF), a0v = *(const GAS f32x4*)(pa0 + tok + OFF), kkp = *(const GAS f32x4*)(pkk + tok + OFF), kap = *(const GAS f32x4*)(pka + tok + OFF), rkp = *(const GAS f32x4*)(prk + tok + OFF); \
            RW_LERP(rr, CUR.rc, CUR.rp, mr_); RW_LERP(kk4, CUR.kc, CUR.kp, mk_); RW_LERP(vv, CUR.vc, CUR.vp, mv_); \
            float xa[4], xb[4], xk[4], xr[4], gg[4], ge[4]; \
            _Pragma("unroll") for (int e = 0; e < 4; ++e) { \
                const float nx = -(w0v[e] + accd[4 * (rg) + e]); const float sp = fmaxf(nx, 0.f) + __logf(1.f + __expf(-fabsf(nx))); \
                const float l2 = -__expf(-sp - 0.5f) * LOG2E; \
                const float g = scan32(l2); \
                const float a = __builtin_amdgcn_rcpf(1.f + __expf(-(a0v[e] + acca[4 * (rg) + e]))); \
                const float kk = kk4[e] * kkp[e] * inv; \
                const float kt = kk4[e] * (1.f + (a - 1.f) * kap[e]); \
                rho += rr[e] * kt * rkp[e]; \
                const float eg = __builtin_amdgcn_exp2f(g), egp = __builtin_amdgcn_exp2f(g - l2), eng = __builtin_amdgcn_rcpf(eg); \
                xa[e] = -kk * egp; xb[e] = kk * a * eng; xk[e] = kt * eng; xr[e] = rr[e] * eg; gg[e] = g; ge[e] = eg; } \
            if (l31 == 31) { *(LAS f32x4*)(wscr + ch0) = (f32x4){gg[0], gg[1], gg[2], gg[3]}; st_wt16((v4u*)(gp + (cb) * 16 + 4 * (rg)), (v4u){__float_as_uint(ge[0]), __float_as_uint(ge[1]), __float_as_uint(ge[2]), __float_as_uint(ge[3])}); } \
            constexpr int s_ = 2 * (cb) + ((rg) >> 1), vg = 2 * ((rg) & 1); \
            fa[s_][vg] = cvtpk(xa[0], xa[1]); fa[s_][vg + 1] = cvtpk(xa[2], xa[3]); \
            fb[s_][vg] = cvtpk(xb[0], xb[1]); fb[s_][vg + 1] = cvtpk(xb[2], xb[3]); \
            fk[s_][vg] = cvtpk(xk[0], xk[1]); fk[s_][vg + 1] = cvtpk(xk[2], xk[3]); \
            fr[s_][vg] = cvtpk(xr[0], xr[1]); fr[s_][vg + 1] = cvtpk(xr[2], xr[3]); \
            fv[s_][vg] = cvtpk(vv[0], vv[1]); fv[s_][vg + 1] = cvtpk(vv[2], vv[3]); \
            if (((rg) & 1) == 1) { PARK(s_) = fv[s_]; PARK(4 + s_) = fr[s_]; } \
            DEP(fa[s_][vg + 1]); DEP(fb[s_][vg + 1]); DEP(fk[s_][vg + 1]); DEP(fr[s_][vg + 1]); DEP(fv[s_][vg + 1]); DEP(rho); } while (0)
    RW_LOADG(gA, 0);
    { RW_LORA(0) RW_GROUP(0, 0, gA, gB, true); RW_GROUP(0, 1, gB, gA, true); RW_GROUP(0, 2, gA, gB, true); RW_GROUP(0, 3, gB, gA, true); }
    { RW_LORA(1) RW_GROUP(1, 0, gA, gB, true); RW_GROUP(1, 1, gB, gA, true); RW_GROUP(1, 2, gA, gB, true); RW_GROUP(1, 3, gB, gA, false); }
#undef RW_LOADG
#undef RW_LERP
#undef RW_LORA
#undef RW_GROUP
#undef SH4
    LDS_WAIT(); asm volatile("" ::: "memory");
    float EC[2]; EC[0] = __builtin_amdgcn_exp2f(wscr[l31]); EC[1] = __builtin_amdgcn_exp2f(wscr[32 + l31]);
    LDS_WAIT(); asm volatile("" ::: "memory");
    rho = swap32_sum(rho);
    if (hi == 0) __hip_atomic_store((gu32*)(Dm.RHO + (size_t)u * 32 + l31), __float_as_uint(rho), RLX_AGENT);
    v4u idf[2];
    { const int jst = 4 * ((l31 >> 3) & 1) + (l31 & 3); const bool hm = ((l31 >> 2) & 1) == hi; const unsigned one = 0x3F80u << (16 * (jst & 1));
#pragma unroll
      for (int sig = 0; sig < 2; ++sig) { const bool on = hm && ((l31 >> 4) == sig);
#pragma unroll
          for (int q = 0; q < 4; ++q) idf[sig][q] = (on && (jst >> 1) == q) ? one : 0u; } }
    LDS_WAIT();
    v4u Af[2][2], Vf[2][2];
#pragma unroll
    for (int blk = 0; blk < 2; ++blk) {
        f32x16 za = MFMA32(fa[2 * blk], idf[0], f32x16{}); za = MFMA32(fa[2 * blk + 1], idf[1], za);
        f32x16 zv = MFMA32(PARK(2 * blk), idf[0], f32x16{}); zv = MFMA32(PARK(2 * blk + 1), idf[1], zv);
        f32x16 zb = MFMA32(fb[2 * blk], idf[0], f32x16{}); zb = MFMA32(fb[2 * blk + 1], idf[1], zb);
        f32x16 zk = MFMA32(fk[2 * blk], idf[0], f32x16{}); zk = MFMA32(fk[2 * blk + 1], idf[1], zk);
        zb = zb * EC[blk]; zk = zk * EC[blk];
#pragma unroll
        for (int s = 0; s < 2; ++s) { Af[blk][s] = FRAGACC(za, s); Vf[blk][s] = FRAGACC(zv, s); PARK(8 + 2 * blk + s) = FRAGACC(zb, s); PARK(12 + 2 * blk + s) = FRAGACC(zk, s); }
        __builtin_amdgcn_sched_barrier(0);
    }
    f32x16 Aab = f32x16{}, TT = f32x16{}, AakT = f32x16{}, ArbT = f32x16{}, ArkT = f32x16{};
#pragma unroll
    for (int s = 0; s < 4; ++s) { const v4u frs = PARK(4 + s); Aab = MFMA32(fa[s], fb[s], Aab); TT = MFMA32(fb[s], fa[s], TT); AakT = MFMA32(fk[s], fa[s], AakT); ArbT = MFMA32(fb[s], frs, ArbT); ArkT = MFMA32(fk[s], frs, ArkT); }
#pragma unroll
    for (int r = 0; r < 16; ++r) { const int rowi = (r & 3) + 8 * (r >> 2) + 4 * hi;
        Aab[r] = (l31 < rowi) ? Aab[r] : 0.f; TT[r] = (rowi < l31) ? TT[r] : 0.f; AakT[r] = (rowi < l31) ? AakT[r] : 0.f;
        ArbT[r] = (rowi <= l31) ? ArbT[r] : 0.f; ArkT[r] = (rowi <= l31) ? ArkT[r] : 0.f; }
    v4u AakTf[2], ArbTf[2], ArkTf[2];
#pragma unroll
    for (int s = 0; s < 2; ++s) { AakTf[s] = FRAGACC(AakT, s); ArbTf[s] = FRAGACC(ArbT, s); ArkTf[s] = FRAGACC(ArkT, s); }
    __builtin_amdgcn_sched_barrier(0);
    v4u Xf[2], XTf[2], TTf[2];
#pragma unroll
    for (int s = 0; s < 2; ++s) { Xf[s] = FRAGACC(Aab, s); XTf[s] = FRAGACC(TT, s); }
#pragma unroll
    for (int r = 0; r < 16; ++r) { const int rowi = (r & 3) + 8 * (r >> 2) + 4 * hi; TT[r] += (rowi == l31) ? 1.f : 0.f; }
#pragma unroll
    for (int it = 0; it < 4; ++it) {
        f32x16 X2 = MFMA32(XTf[0], Xf[0], f32x16{}); X2 = MFMA32(XTf[1], Xf[1], X2);
        if (it < 3) { f32x16 X2T = MFMA32(Xf[0], XTf[0], f32x16{}); X2T = MFMA32(Xf[1], XTf[1], X2T);
#pragma unroll
            for (int s = 0; s < 2; ++s) XTf[s] = FRAGACC(X2T, s); }
#pragma unroll
        for (int s = 0; s < 2; ++s) { Xf[s] = FRAGACC(X2, s); TTf[s] = FRAGACC(TT, s); }
        TT = MFMA32(Xf[0], TTf[0], TT); TT = MFMA32(Xf[1], TTf[1], TT);
        __builtin_amdgcn_sched_barrier(0);
    }
#pragma unroll
    for (int s = 0; s < 2; ++s) TTf[s] = FRAGACC(TT, s);
    v4u Wf[2][2], Uf[2][2];
#pragma unroll
    for (int blk = 0; blk < 2; ++blk) {
        f32x16 av = MFMA32(AakTf[0], Vf[blk][0], f32x16{}); av = MFMA32(AakTf[1], Vf[blk][1], av);
        const v4u avf0 = FRAGACC(av, 0), avf1 = FRAGACC(av, 1);
        f32x16 uu = MFMA32(TTf[0], avf0, f32x16{}); uu = MFMA32(TTf[1], avf1, uu);
        f32x16 ww = MFMA32(TTf[0], Af[blk][0], f32x16{}); ww = MFMA32(TTf[1], Af[blk][1], ww);
#pragma unroll
        for (int s = 0; s < 2; ++s) { Wf[blk][s] = FRAGACC(ww, s); Uf[blk][s] = FRAGACC(uu, s); }
        __builtin_amdgcn_sched_barrier(0);
    }
    v4u* QFp = Dm.QF + (size_t)u * 256 + lane; v4u* YDp = Dm.YD + (size_t)u * 256 + lane;
#pragma unroll
    for (int blk = 0; blk < 2; ++blk) {
        f32x16 q;
#pragma unroll
        for (int s = 0; s < 2; ++s)
            { const v4u frs = PARK(4 + 2 * blk + s);
#pragma unroll
              for (int j = 0; j < 4; ++j) { q[8 * s + 2 * j] = bflo(frs[j]); q[8 * s + 2 * j + 1] = bfhi(frs[j]); } }
        q = MFMA32(Wf[blk][0], ArbTf[0], q); q = MFMA32(Wf[blk][1], ArbTf[1], q);
        st_wt16(QFp + (2 * blk) * 64, FRAGACC(q, 0)); st_wt16(QFp + (2 * blk + 1) * 64, FRAGACC(q, 1));
        f32x16 y = MFMA32(Uf[blk][0], ArbTf[0], f32x16{}); y = MFMA32(Uf[blk][1], ArbTf[1], y); y = MFMA32(Vf[blk][0], ArkTf[0], y); y = MFMA32(Vf[blk][1], ArkTf[1], y);
        st_wt16(YDp + (2 * blk) * 64, FRAGACC(y, 0)); st_wt16(YDp + (2 * blk + 1) * 64, FRAGACC(y, 1));
        __builtin_amdgcn_sched_barrier(0);
    }
    v4u* PFp = Dm.PF + (size_t)u * 512 + lane; v4u* DDp = Dm.DD + (size_t)u * 512 + lane;
#pragma unroll
    for (int c1 = 0; c1 < 2; ++c1)
#pragma unroll
        for (int cb = 0; cb < 2; ++cb) {
            f32x16 p = MFMA32(Wf[c1][0], PARK(8 + 2 * cb), f32x16{}); p = MFMA32(Wf[c1][1], PARK(8 + 2 * cb + 1), p);
            st_wt16(PFp + (cb * 4 + 2 * c1) * 64, FRAGACC(p, 0)); st_wt16(PFp + (cb * 4 + 2 * c1 + 1) * 64, FRAGACC(p, 1));
            __builtin_amdgcn_sched_barrier(0);
        }
#pragma unroll
    for (int cb = 0; cb < 2; ++cb)
#pragma unroll
        for (int ib = 0; ib < 2; ++ib) {
            f32x16 d = MFMA32(PARK(8 + 2 * cb), Uf[ib][0], f32x16{}); d = MFMA32(PARK(8 + 2 * cb + 1), Uf[ib][1], d); d = MFMA32(PARK(12 + 2 * cb), Vf[ib][0], d); d = MFMA32(PARK(12 + 2 * cb + 1), Vf[ib][1], d);
            st_wt16(DDp + ((cb * 2 + ib) * 2) * 64, FRAGACC(d, 0)); st_wt16(DDp + ((cb * 2 + ib) * 2 + 1) * 64, FRAGACC(d, 1));
            __builtin_amdgcn_sched_barrier(0);
        }
}

#undef PARK
#undef DEP
constexpr int RB_PF = 0, RB_DD = 8192, RB_QF = 16384, RB_YD = 20480, RB_GAM = 24576, RB_BUF = 24832, RB_STAT = 2 * RB_BUF, RB_Y = RB_STAT + 1024;
__device__ __forceinline__ void unpack16(const v4u a, const v4u b, f32x16& o) {
#pragma unroll
    for (int j = 0; j < 4; ++j) { o[2 * j] = bflo(a[j]); o[2 * j + 1] = bfhi(a[j]); o[8 + 2 * j] = bflo(b[j]); o[8 + 2 * j + 1] = bfhi(b[j]); }
}
constexpr int RW_SPLIT = T / 32, CW_DONE = 16384;
__device__ __forceinline__ void rw_wait_chunk(Frame& F, int ci) {
    unsigned spins = 0;
#pragma unroll 1
    for (int j = 7; j >= 0; --j) { gu32* c = F.ctl + CW_DONE + 64 * (ci + j);
        while ((unsigned)__builtin_amdgcn_readfirstlane(__hip_atomic_load(c, RLX_AGENT)) < (unsigned)BATCH) { __builtin_amdgcn_s_sleep(8); if (++spins > (1u << 22)) break; } }
    __builtin_amdgcn_fence(__ATOMIC_ACQUIRE, "agent");
}
__device__ __forceinline__ void rw_publish_chunk(Frame& F, int ci) {
    asm volatile("s_waitcnt vmcnt(0)" ::: "memory");
    __syncthreads();
    if (F.wave == 0 && mk_lane() == 0) {
        __hip_atomic_fetch_add(F.ctl + CW_DONE + 64 * ci, 1u, RLX_AGENT);
    }
}
struct RbStage { v4u p[2], d[2], q, y, g; };
struct RbEpi { v2u vc[2], vp[2], ga[2]; float rho; };
__device__ __forceinline__ void rwkvB_unit(Frame& F, const RwDump& Dm, int bh) {
    int lane = mk_lane(); asm volatile("" : "+v"(lane));
    const int wid = F.wave, tid = wid * 64 + lane, hi = lane >> 5, l31 = lane & 31, b = bh >> 3, h = bh & 7;
    LAS unsigned char* lds = F.lds + RING_OFF;
    constexpr int NS = T / 32;
    LAS float* stat = (LAS float*)(lds + RB_STAT);
    LAS float* ybuf = (LAS float*)(lds + RB_Y);
    const int stid = tid - 128;
    const bool st_p2 = wid < 4, st_q = wid < 6, st_y = wid >= 4;
#define ST_LOAD(X, ci_) do { { if ((ci_) >= RW_SPLIT && (ci_) < NS && (((ci_) - RW_SPLIT) & 7) == 0) rw_wait_chunk(F, (ci_)); const size_t u_ = (size_t)((ci_) < NS ? (ci_) : NS - 1) * (BATCH * RH) + bh; \
        X.p[0] = *(const GAS v4u*)(Dm.PF + u_ * 512 + stid); X.d[0] = *(const GAS v4u*)(Dm.DD + u_ * 512 + stid); \
        if (st_p2) { X.p[1] = *(const GAS v4u*)(Dm.PF + u_ * 512 + 384 + stid); X.d[1] = *(const GAS v4u*)(Dm.DD + u_ * 512 + 384 + stid); } \
        if (st_q) X.q = *(const GAS v4u*)(Dm.QF + u_ * 256 + stid); \
        if (st_y) X.y = *(const GAS v4u*)(Dm.YD + u_ * 256 + (stid - 128)); \
        if (stid < 16) X.g = *(const GAS v4u*)((const v4u*)(Dm.GAM + u_ * 64) + stid); } } while (0)
#define ST_STORE(X, buf_) do { LAS unsigned char* b_ = lds + (buf_) * RB_BUF; \
        *(LAS v4u*)(b_ + RB_PF + stid * 16) = X.p[0]; *(LAS v4u*)(b_ + RB_DD + stid * 16) = X.d[0]; \
        if (st_p2) { *(LAS v4u*)(b_ + RB_PF + (384 + stid) * 16) = X.p[1]; *(LAS v4u*)(b_ + RB_DD + (384 + stid) * 16) = X.d[1]; } \
        if (st_q) *(LAS v4u*)(b_ + RB_QF + stid * 16) = X.q; \
        if (st_y) *(LAS v4u*)(b_ + RB_YD + (stid - 128) * 16) = X.y; \
        if (stid < 16) *(LAS v4u*)(b_ + RB_GAM + stid * 16) = X.g; } while (0)
    const int eib = wid & 1, eh = (wid >> 2) & 1;
    const bf16* epc = F.PROJ + (size_t)b * T * NP + h * 64 + 32 * eib + 16 * eh + 4 * hi;
#define EP_LOAD(X, cj_) do { { const int tt_ = ((cj_) < NS ? (cj_) : NS - 1) * 32 + l31; const bf16* pc_ = epc + (size_t)tt_ * NP; const bf16* pp_ = epc + (size_t)(tt_ > 0 ? tt_ - 1 : 0) * NP; \
        _Pragma("unroll") for (int rg = 0; rg < 2; ++rg) { X.vc[rg] = *(const GAS v2u*)(pc_ + C_V + 8 * rg); X.vp[rg] = *(const GAS v2u*)(pp_ + C_V + 8 * rg); X.ga[rg] = *(const GAS v2u*)(pc_ + C_GA + 8 * rg); } \
        X.rho = Dm.RHO[((size_t)((cj_) < NS ? (cj_) : NS - 1) * (BATCH * RH) + bh) * 32 + l31]; } } while (0)
#define EP_RUN(X, cj_) do { const int par_ = (cj_) & 1; \
        const float s1_ = stat[((par_ * 2 + 0) * 32 + l31) * 2] + stat[((par_ * 2 + 1) * 32 + l31) * 2], s2_ = stat[((par_ * 2 + 0) * 32 + l31) * 2 + 1] + stat[((par_ * 2 + 1) * 32 + l31) * 2 + 1]; \
        const float mean_ = s1_ * (1.f / 64.f), var_ = fmaxf(s2_ * (1.f / 64.f) - mean_ * mean_, 0.f), rstd_ = __builtin_amdgcn_rsqf(var_ + 64e-5f); \
        const int tt_ = (cj_) * 32 + l31; const size_t mm_ = (size_t)b * T + tt_; const float pm_ = tt_ > 0 ? 1.f : 0.f; \
        const LAS float* yb_ = ybuf + (par_ * 2 + eib) * 1024 + lane; \
        _Pragma("unroll") for (int rg = 0; rg < 2; ++rg) { const int hc_ = h * 64 + 32 * eib + 16 * eh + 8 * rg + 4 * hi; \
            const f32x4 mu_ = emu[rg], lw_ = elw[rg], lb_ = elb[rg]; \
            const float vc_[4] = {bflo(X.vc[rg].x), bfhi(X.vc[rg].x), bflo(X.vc[rg].y), bfhi(X.vc[rg].y)}, vp_[4] = {bflo(X.vp[rg].x), bfhi(X.vp[rg].x), bflo(X.vp[rg].y), bfhi(X.vp[rg].y)}; \
            const float g4_[4] = {bflo(X.ga[rg].x), bfhi(X.ga[rg].x), bflo(X.ga[rg].y), bfhi(X.ga[rg].y)}; float o_[4]; \
            _Pragma("unroll") for (int e = 0; e < 4; ++e) { const float vv_ = vc_[e] + (vp_[e] * pm_ - vc_[e]) * mu_[e]; \
                const float yn_ = (yb_[(4 * (2 * eh + rg) + e) * 64] - mean_) * rstd_ * lw_[e] + lb_[e] + X.rho * vv_; o_[e] = yn_ * g4_[e] * __builtin_amdgcn_rcpf(1.f + __expf(-g4_[e])); } \
            *(GAS v2u*)(F.MIX + mm_ * D + hc_) = (v2u){cvtpk(o_[0], o_[1]), cvtpk(o_[2], o_[3])}; } } while (0)
    f32x16 S[2]; S[0] = f32x16{}; S[1] = f32x16{};
    const int ib = wid & 1;
#define CONS(ci_) do { const LAS unsigned char* bb = lds + ((ci_) & 1) * RB_BUF; \
          \
        v4u pf_[8], qf_[4], dd_[4], yd_[2]; f32x4 gm_[8]; \
        _Pragma("unroll") for (int q = 0; q < 8; ++q) gm_[q] = *(const LAS f32x4*)(bb + RB_GAM + (hi * 32 + 4 * q) * 4); \
        _Pragma("unroll") for (int q = 0; q < 4; ++q) dd_[q] = *(const LAS v4u*)(bb + RB_DD + ((((q >> 1) * 2 + ib) * 2 + (q & 1)) * 64 + lane) * 16); \
        _Pragma("unroll") for (int q = 0; q < 8; ++q) pf_[q] = *(const LAS v4u*)(bb + RB_PF + (q * 64 + lane) * 16); \
        _Pragma("unroll") for (int q = 0; q < 2; ++q) yd_[q] = *(const LAS v4u*)(bb + RB_YD + ((2 * ib + q) * 64 + lane) * 16); \
        _Pragma("unroll") for (int q = 0; q < 4; ++q) qf_[q] = *(const LAS v4u*)(bb + RB_QF + (q * 64 + lane) * 16); \
        __builtin_amdgcn_sched_barrier(0); \
        v4u Sf[4]; _Pragma("unroll") for (int s = 0; s < 4; ++s) Sf[s] = FRAGACC(S[s >> 1], s & 1); \
        _Pragma("unroll") for (int rb = 0; rb < 2; ++rb) { \
            f32x16 acc; unpack16(dd_[2 * rb], dd_[2 * rb + 1], acc); \
            _Pragma("unroll") for (int q = 0; q < 4; ++q) { const f32x4 gv = gm_[4 * rb + q]; _Pragma("unroll") for (int e = 0; e < 4; ++e) acc[4 * q + e] += gv[e] * S[rb][4 * q + e]; } \
            _Pragma("unroll") for (int s = 0; s < 4; ++s) acc = MFMA32(pf_[rb * 4 + s], Sf[s], acc); \
            S[rb] = acc; } \
        f32x16 y; unpack16(yd_[0], yd_[1], y); \
        _Pragma("unroll") for (int s = 0; s < 4; ++s) y = MFMA32(Sf[s], qf_[s], y); \
        float s1 = 0.f, s2 = 0.f; LAS float* yb_ = ybuf + (((ci_) & 1) * 2 + ib) * 1024 + lane; \
        _Pragma("unroll") for (int r = 0; r < 16; ++r) { s1 += y[r]; s2 += y[r] * y[r]; yb_[r * 64] = y[r]; } \
        s1 = swap32_sum(s1); s2 = swap32_sum(s2); \
        if (hi == 0) { stat[((((ci_) & 1) * 2 + ib) * 32 + l31) * 2] = s1; stat[((((ci_) & 1) * 2 + ib) * 32 + l31) * 2 + 1] = s2; } } while (0)
#define RB_BAR() do { asm volatile("s_waitcnt lgkmcnt(0)" ::: "memory"); __builtin_amdgcn_s_barrier(); asm volatile("" ::: "memory"); } while (0)
    if (wid < 2) {
        RB_BAR();
#pragma unroll 1
        for (int k = 0; k < NS; ++k) { CONS(k); RB_BAR(); }
        RB_BAR();
    } else {
        const bool epi = (wid != 4 && wid != 5);
        RbStage sA, sB, sC; RbEpi eA, eB, eC; f32x4 emu[2], elw[2], elb[2];
#pragma unroll
        for (int rg = 0; rg < 2; ++rg) { const int hc_ = h * 64 + 32 * eib + 16 * eh + 8 * rg + 4 * hi; emu[rg] = *(const GAS f32x4*)(F.shift_mu + 1024 + hc_); elw[rg] = *(const GAS f32x4*)(F.ln_w + hc_); elb[rg] = *(const GAS f32x4*)(F.ln_b + hc_); }
        ST_LOAD(sA, 0); ST_LOAD(sB, 1); ST_LOAD(sC, 2); ST_STORE(sA, 0); ST_LOAD(sA, 3);
        if (epi) { EP_LOAD(eA, 0); EP_LOAD(eB, 1); }
        RB_BAR();
        ST_STORE(sB, 1); ST_LOAD(sB, 4); if (epi) EP_LOAD(eC, 2); RB_BAR();
#define HY_STEP(k_, SN, EP) do { ST_STORE(SN, ((k_) + 1) & 1); ST_LOAD(SN, (k_) + 4); if (epi) { EP_RUN(EP, (k_) - 1); EP_LOAD(EP, (k_) + 2); } RB_BAR(); } while (0)
#pragma unroll 1
        for (int k = 1; k < NS; k += 3) { HY_STEP(k, sC, eA); HY_STEP(k + 1, sA, eB); HY_STEP(k + 2, sB, eC); }
        if (epi) EP_RUN(eA, NS - 1);
        RB_BAR();
#undef HY_STEP
    }
#undef RB_BAR
#undef ST_LOAD
#undef ST_STORE
#undef EP_LOAD
#undef EP_RUN
#undef CONS
}
constexpr int CW_G17 = 12288;
struct OneUnit { int pm, pn;
    __device__ __forceinline__ bool next(int i, pg8::Unit& u) const { if (i != 0) return false; u.pm = pm; u.pn = pn; return true; }
    __device__ __forceinline__ void a_ready(const pg8::Unit&) const {}
    __device__ __forceinline__ void done(const pg8::Unit&) const {} };
constexpr int AT_KB = 64 * 256, AT_VB = 64 * 256, AT_BUF = AT_KB + AT_VB, AT_QOFF = 2 * AT_KB + 3 * AT_VB;
__device__ __forceinline__ s16x4 vtr(const LAS unsigned char* p) { typedef short v4i16_t __attribute__((ext_vector_type(4))); return __builtin_bit_cast(s16x4, __builtin_amdgcn_ds_read_tr16_b64_v4i16((LAS v4i16_t*)p)); }
__device__ __forceinline__ void attn_unit(Frame& F, int b, int h, int qb) {
    int lane = mk_lane(); asm volatile("" : "+v"(lane));
    const int wid = F.wave, tid = wid * 64 + lane, l31 = lane & 31, hi = lane >> 5, map = wid >> 2, qs = wid & 3;
    LAS unsigned char* lds = F.lds + RING_OFF;
    const float slope2 = exp2f(-2.f * (float)(h + 1)) * LOG2E, shift2 = __uint_as_float(F.MISC[15]);
    const int q0 = qb * 128, qrow = q0 + 32 * qs + l31;
    const size_t mrow = (size_t)b * T + qrow;
    LAS bf16x8* qpark = (LAS bf16x8*)(lds + AT_QOFF + wid * 4096) + lane;
    { const bf16* qp = F.PROJ + mrow * NP + C_DQ + h * 128 + map * 64 + 8 * hi;
#pragma unroll
      for (int s = 0; s < 4; ++s) qpark[s * 64] = *(const GAS bf16x8*)(qp + 16 * s); }
    const bf16* kg = F.PROJ + (size_t)b * T * NP + C_DK + h * 128;
    const bf16* vg = F.PROJ + (size_t)b * T * NP + C_DV + h * 128;
    const int NT = 2 * qb + 2, tl = 2 * qb + (qs >> 1);
    const int Wk = (int)__builtin_ceilf((2.f * shift2 + 32.2f) / slope2);
    const int tf = __builtin_amdgcn_readfirstlane(max(0, (qb * 128 - Wk) >> 6));
    constexpr int AT_V0 = 2 * AT_KB;
    const int drow0 = 4 * wid + (lane >> 4), drow1 = drow0 + 32, dch = lane & 15;
    const unsigned ksrc0 = (unsigned)(drow0 * NP + ((dch ^ (drow0 & 15)) * 8)), ksrc1 = (unsigned)(drow1 * NP + ((dch ^ (drow1 & 15)) * 8));
    const unsigned vsrc0 = (unsigned)(drow0 * NP + ((dch ^ ((drow0 & 3) << 2)) * 8)), vsrc1 = (unsigned)(drow1 * NP + ((dch ^ ((drow1 & 3) << 2)) * 8));
#define AT_DMA(t_, kb_, v3_) do { const size_t tb_ = (size_t)(64 * (t_)) * NP; LAS unsigned char* bk_ = lds + (kb_) * AT_KB + wid * 1024; LAS unsigned char* bv_ = lds + AT_V0 + (v3_) * AT_VB + wid * 1024; \
        __builtin_amdgcn_global_load_lds((const unsigned*)(kg + tb_ + ksrc0), (LAS unsigned*)bk_, 16, 0, 0); __builtin_amdgcn_global_load_lds((const unsigned*)(kg + tb_ + ksrc1), (LAS unsigned*)(bk_ + 8192), 16, 0, 0); \
        __builtin_amdgcn_global_load_lds((const unsigned*)(vg + tb_ + vsrc0), (LAS unsigned*)bv_, 16, 0, 0); __builtin_amdgcn_global_load_lds((const unsigned*)(vg + tb_ + vsrc1), (LAS unsigned*)(bv_ + 8192), 16, 0, 0); } while (0)
    f32x16 o[4];
#pragma unroll
    for (int vb = 0; vb < 4; ++vb) o[vb] = f32x16{};
    float lsum = 0.f;
    AT_DMA(tf, tf & 1, tf % 3);
    __syncthreads();
    const int G = lane >> 4, qq = (lane & 15) >> 2, pp = lane & 3;
    const int vrow = (4 * hi + qq) * 256 + 8 * (pp & 1), vch = 2 * (G & 1) + (pp >> 1);
    v4u pw[4];
#define SBAR_() __builtin_amdgcn_sched_barrier(0)
#define AT_QK(t) do { \
            const LAS unsigned char* Kb = lds + ((t) & 1) * AT_KB; \
            float sl_ = slope2; asm volatile("" : "+v"(sl_));     \
            const float base = sl_ * (float)(64 * (t) + 4 * hi - qrow) - shift2; \
            float ls = 0.f; \
            _Pragma("unroll") for (int hf = 0; hf < 2; ++hf) {        \
                f32x16 p; \
                _Pragma("unroll") for (int r = 0; r < 16; ++r) p[r] = __builtin_fmaf(sl_, (float)(32 * hf + (r & 3) + 8 * (r >> 2)), base); \
                _Pragma("unroll") for (int s = 0; s < 4; ++s) { \
                    const bf16x8 a0 = *(const LAS bf16x8*)(Kb + (32 * hf + l31) * 256 + (((map * 8 + 2 * s + hi) ^ (l31 & 15)) * 16)); \
                    p = __builtin_amdgcn_mfma_f32_32x32x16_bf16(a0, qpark[s * 64], p, 0, 0, 0); } \
                if ((t) == tl) { \
                    _Pragma("unroll") for (int r = 0; r < 16; ++r) { const int ki = 64 * (t) + 32 * hf + 4 * hi + (r & 3) + 8 * (r >> 2); if (ki > qrow) p[r] = -1e30f; } } \
                _Pragma("unroll") for (int r = 0; r < 16; ++r) { p[r] = __builtin_amdgcn_exp2f(p[r]); ls += p[r]; } \
                pw[2 * hf] = (v4u){cvtpk(p[0], p[1]), cvtpk(p[2], p[3]), cvtpk(p[4], p[5]), cvtpk(p[6], p[7])}; \
                pw[2 * hf + 1] = (v4u){cvtpk(p[8], p[9]), cvtpk(p[10], p[11]), cvtpk(p[12], p[13]), cvtpk(p[14], p[15])}; } \
            lsum += ls; } while (0)
#define AT_VRD(dst, ks, vb0) do { _Pragma("unroll") for (int vb = (vb0); vb < (vb0) + 2; ++vb) { const LAS unsigned char* a_ = Vb + vrow + ((4 * vb + vch) ^ (qq << 2)) * 16 + (32 * ((ks) >> 1) + 16 * ((ks) & 1)) * 256; \
        dst[2 * (vb - (vb0))] = vtr(a_); dst[2 * (vb - (vb0)) + 1] = vtr(a_ + 8 * 256); } } while (0)
#define AT_PV(src, pwk, vb0) do { _Pragma("unroll") for (int vb = (vb0); vb < (vb0) + 2; ++vb) { const int j_ = 2 * (vb - (vb0)); \
        const bf16x8 vf = (bf16x8){src[j_][0], src[j_][1], src[j_][2], src[j_][3], src[j_ + 1][0], src[j_ + 1][1], src[j_ + 1][2], src[j_ + 1][3]}; \
        o[vb] = __builtin_amdgcn_mfma_f32_32x32x16_bf16(vf, __builtin_bit_cast(bf16x8, pwk), o[vb], 0, 0, 0); } } while (0)
#define AT_PVV(v3_) do { const LAS unsigned char* Vb = lds + AT_V0 + (v3_) * AT_VB; s16x4 vA[4], vB[4]; \
            AT_VRD(vA, 0, 0); SBAR_(); AT_VRD(vB, 0, 2); SBAR_(); \
            AT_PV(vA, pw[0], 0); SBAR_(); AT_VRD(vA, 1, 0); SBAR_(); AT_PV(vB, pw[0], 2); SBAR_(); AT_VRD(vB, 1, 2); SBAR_(); \
            AT_PV(vA, pw[1], 0); SBAR_(); AT_VRD(vA, 2, 0); SBAR_(); AT_PV(vB, pw[1], 2); SBAR_(); AT_VRD(vB, 2, 2); SBAR_(); \
            AT_PV(vA, pw[2], 0); SBAR_(); AT_VRD(vA, 3, 0); SBAR_(); AT_PV(vB, pw[2], 2); SBAR_(); AT_VRD(vB, 3, 2); SBAR_(); \
            AT_PV(vA, pw[3], 0); SBAR_(); AT_PV(vB, pw[3], 2); } while (0)
    if (map == 0) {
        int v3 = tf % 3;
#pragma unroll 1
        for (int t = tf; t < NT; ++t) { const int vn = v3 == 2 ? 0 : v3 + 1;
            if (t + 1 < NT) AT_DMA(t + 1, (t + 1) & 1, vn);
            if (t <= tl) { AT_QK(t); AT_PVV(v3); }
            __syncthreads(); v3 = vn; }
    } else {
        int v3 = tf % 3;
#pragma unroll 1
        for (int t = tf; t < NT; ++t) { const int vp = v3 == 0 ? 2 : v3 - 1, vn = v3 == 2 ? 0 : v3 + 1;
            if (t + 1 < NT) AT_DMA(t + 1, (t + 1) & 1, vn);
            if (t > tf && t - 1 <= tl) AT_PVV(vp);
            if (t <= tl) AT_QK(t);
            __syncthreads(); v3 = vn; }
        if (NT - 1 <= tl) { const int vp = v3 == 0 ? 2 : v3 - 1; AT_PVV(vp); }
    }
#undef AT_PVV
#undef AT_QK
#undef AT_VRD
#undef AT_PV
#undef SBAR_
#undef AT_DMA
    __syncthreads();
    const float ltot = swap32_sum(lsum);
    LAS float* X = (LAS float*)lds;
    if (map == 1) {
        const float sc = __uint_as_float(F.MISC[14]) / ltot;
#pragma unroll
        for (int vb = 0; vb < 4; ++vb)
#pragma unroll
            for (int r = 0; r < 16; ++r) X[(qs * 64 + vb * 16 + r) * 64 + lane] = o[vb][r] * sc;
    }
    __syncthreads();
    if (map == 0) {
        const float il = 1.f / ltot; float ss = 0.f;
#pragma unroll
        for (int vb = 0; vb < 4; ++vb)
#pragma unroll
            for (int r = 0; r < 16; ++r) { const float v = o[vb][r] * il - X[(qs * 64 + vb * 16 + r) * 64 + lane]; o[vb][r] = v; ss += v * v; }
        ss = swap32_sum(ss);
        const float rn = (1.f / sqrtf(ss * (1.f / 128.f) + 1e-5f)) * (1.f - LAMBDA_INIT);
        int etok = 0; asm volatile("" : "+v"(etok));
        const int lane_e = mk_lane(), hi = lane_e >> 5;
        const size_t mrow_e = (size_t)b * T + qb * 128 + 32 * qs + (lane_e & 31);
        const bf16* gp = F.PROJ + mrow_e * NP + C_GB + h * 128;
        bf16* op = F.MIX + mrow_e * D + 512 + h * 128;
#pragma unroll
        for (int vb = 0; vb < 4; ++vb)
#pragma unroll
            for (int rg = 0; rg < 4; ++rg) {
                const int vc = 32 * vb + 8 * rg + 4 * hi + etok;
                const v2u gw = *(const GAS v2u*)(gp + vc); const f32x4 sg = *(const GAS f32x4*)(F.subln_g + vc);
                const float g4[4] = {bflo(gw.x), bfhi(gw.x), bflo(gw.y), bfhi(gw.y)}; float ov[4];
#pragma unroll
                for (int e = 0; e < 4; ++e) ov[e] = o[vb][4 * rg + e] * rn * sg[e] * g4[e] / (1.f + __expf(-g4[e]));
                const unsigned w1_ = cvtpk(ov[2], ov[3]);
                *(GAS v2u*)(op + vc) = (v2u){cvtpk(ov[0], ov[1]), w1_};
                asm volatile("" : "+v"(etok) : "v"(w1_));
            }
    }
    __syncthreads();
}
#ifndef DBL
#define DBL 0
#endif
constexpr int CW_QUEUE = 8192;
constexpr int QX_RW = 8, QX_A2 = 0, QX_AT = 64, QX_ALL = QX_RW + QX_A2 + QX_AT;
__device__ __forceinline__ void p3_queue(Frame& F, const RwDump& Dm, const int qbase = CW_QUEUE) {
    const int ql = mk_lane();
    const float l1 = wave_sum(F.lq1[ql] * F.lk1[ql]), l2 = wave_sum(F.lq2[ql] * F.lk2[ql]);
    const float lam = __uint_as_float(__builtin_amdgcn_readfirstlane(__float_as_uint(__expf(l1) - __expf(l2) + LAMBDA_INIT)));
    float gq = fabsf(F.qn_g[ql]), gk = fabsf(F.kn_g[ql]);
#pragma unroll
    for (int o = 1; o < 64; o <<= 1) { gq = fmaxf(gq, __shfl_xor(gq, o)); gk = fmaxf(gk, __shfl_xor(gk, o)); }
    const float shift2 = __uint_as_float(__builtin_amdgcn_readfirstlane(__float_as_uint(8.f * gq * gk * LOG2E)));
    if (F.wave == 0 && mk_lane() == 0) { F.MISC[14] = __float_as_uint(lam); F.MISC[15] = __float_as_uint(shift2); }
    __syncthreads();
#ifdef Q_BLK
    const int x0 = (int)(blockIdx.x & 7);
#else
    const int x0 = (int)(xb_xcc_id() & 7u);
#endif
#pragma unroll 1
    for (int dx = 0; dx < 8; ++dx) {
        const int xq = (x0 + dx) & 7;
        for (;;) {
            if (F.wave == 0 && mk_lane() == 0) F.MISC[12] = __hip_atomic_fetch_add(F.ctl + qbase + 64 * xq, 1u, RLX_AGENT);
            __syncthreads();
            const int item = __builtin_amdgcn_readfirstlane((int)F.MISC[12]);
            __syncthreads();
            if (item >= QX_ALL) break;
            if (item < QX_RW) { rwkvB_unit(F, Dm, xq * 8 + item); if (DBL & 64) rwkvB_unit(F, Dm, xq * 8 + item); }
            else { const int idx = item - QX_RW - QX_A2, h = 3 - (idx >> 4), qb = 15 - (idx & 15);
#pragma unroll 1
#ifndef NO_ATT
                for (int rep = 0; rep < ((DBL & 32) ? 2 : 1); ++rep) attn_unit(F, xq, h, qb);
#endif
            }
        }
    }
}

struct Args { const float* in[21]; float* out; unsigned char* ws; int ph_lo, ph_hi; };
__global__ void __launch_bounds__(NWAVES * 64, 2) hymba_fwd(Args args) {
    extern __shared__ __attribute__((aligned(16))) unsigned char lds[];
    Frame F;
    F.lds = (LAS unsigned char*)lds;
    F.MISC = (volatile LAS unsigned*)(F.lds + MISC_OFF);
    F.wave = __builtin_amdgcn_readfirstlane((int)threadIdx.x >> 6); F.lane = mk_lane(); F.tid = F.wave * 64 + F.lane;
    F.G = gridDim.x; { const int bx = blockIdx.x; F.vcu = (F.G % 8 == 0) ? (bx % 8) * (F.G / 8) + bx / 8 : bx; }
    unsigned char* ws = args.ws;
    F.ctl = (gu32*)(ws + WS_CTL);
    F.x = args.in[0]; F.norm_g = args.in[1]; F.w_in = args.in[2]; F.shift_mu = args.in[3]; F.w0 = args.in[4]; F.w_decay_up = args.in[5]; F.a0 = args.in[6]; F.w_iclr_up = args.in[7];
    F.k_k = args.in[8]; F.k_a = args.in[9]; F.r_k = args.in[10]; F.ln_w = args.in[11]; F.ln_b = args.in[12]; F.qn_g = args.in[13]; F.kn_g = args.in[14];
    F.lq1 = args.in[15]; F.lk1 = args.in[16]; F.lq2 = args.in[17]; F.lk2 = args.in[18]; F.subln_g = args.in[19]; F.w_out = args.in[20]; F.out = args.out;
    F.WinT = (bf16*)(ws + WS_WIN); F.WoutT = (bf16*)(ws + WS_WOUT); F.WdT = (bf16*)(ws + WS_WD); F.WaT = (bf16*)(ws + WS_WA);
    F.XN = (bf16*)(ws + WS_XN); F.PROJ = (bf16*)(ws + WS_PROJ); F.MIX = (bf16*)(ws + WS_MIX);
    for (int u = F.tid; u < (LDS_BYTES - LDSCTL_OFF) / 4; u += NWAVES * 64) ((LAS unsigned*)(F.lds + LDSCTL_OFF))[u] = 0u;
    __syncthreads();
    XcdBarrier bar; bar.bar = (unsigned*)(F.ctl + CW_BAR); bar.x = 0; bar.st = nullptr; bar.wave = F.wave;
    if (MK_N_LAUNCHES == 1) bar = xcd_barrier_post((unsigned*)(F.ctl + CW_BAR), F.MISC + 8, F.wave);
#define GRID_BAR() do { if (MK_N_LAUNCHES == 1) xcd_barrier(bar); } while (0)
    const int lo = args.ph_lo, hi = args.ph_hi;
#define IN(k) (lo <= (k) && (k) < hi)
#define BOTH(k) (IN(k) && IN((k) + 1))
#ifndef SKIP
#define SKIP 0
#endif
    if (IN(0) && !(SKIP & 1)) { p0_prologue(F); if (DBL & 1) { GRID_BAR(); p0_prologue(F); } if (BOTH(0)) GRID_BAR(); }
    if (IN(1) && !(SKIP & 2)) {
        pg8::Gemm g{F.XN, F.WinT, M, NP, D}; pg8::StaticOrder S; S.init(M, NP, F.G, (int)blockIdx.x);
        pg8::EpiBf16S E{F.PROJ, NP};
        pg8::gemm_phase<pg8::EpiBf16S, pg8::StaticOrder, true, true>(F.lds + RING_OFF, g, S, E, F.wave);
        if (DBL & 2) { GRID_BAR(); pg8::gemm_phase<pg8::EpiBf16S, pg8::StaticOrder, true, true>(F.lds + RING_OFF, g, S, E, F.wave); }
        if (BOTH(1)) GRID_BAR();
    }
    RwDump Dm; { unsigned char* so = (unsigned char*)args.out; Dm.PF = (v4u*)so; Dm.DD = (v4u*)(so + 32 * MiB); Dm.QF = (v4u*)(ws + WS_XN); Dm.YD = (v4u*)(ws + WS_XN + 16 * MiB);
        Dm.GAM = (float*)(ws + WS_END); Dm.RHO = (float*)(ws + WS_END + 1 * MiB); }
    if (IN(2) && !(SKIP & 4)) {
        LAS float* wscr = (LAS float*)(F.lds + LDSCTL_OFF + 1024) + F.wave * 64; int zpar = 0;
#pragma unroll 1
        for (int p = F.vcu; p < BATCH * (T / 32); p += F.G) { rwkvA_unit(F, Dm, (p >> 6) * RH + F.wave, p & 63, wscr, F.lds + RING_OFF + F.wave * 16384, (LAS v4u*)(F.lds + LDSCTL_OFF + 4096), zpar); zpar ^= 1; }
        if (DBL & 4) { GRID_BAR();
#pragma unroll 1
            for (int p = F.vcu; p < BATCH * (T / 32); p += F.G) { rwkvA_unit(F, Dm, (p >> 6) * RH + F.wave, p & 63, wscr, F.lds + RING_OFF + F.wave * 16384, (LAS v4u*)(F.lds + LDSCTL_OFF + 4096), zpar); zpar ^= 1; } }
        p2_qknorm(F);
        if (BOTH(2)) GRID_BAR();
    }
    if (IN(3) && !(SKIP & 8)) {
        p3_queue(F, Dm);
        if (DBL & 512) { GRID_BAR(); p3_queue(F, Dm, CW_QUEUE + 1024); }
        if (BOTH(3)) GRID_BAR();
    }
    if (IN(4) && !(SKIP & 16)) {
        pg8::Gemm g{F.MIX, F.WoutT, M, D, D}; pg8::StaticOrder S; S.init(M, D, F.G, (int)blockIdx.x);
        pg8::EpiResF32 E{F.x, F.out, D};
        pg8::gemm_phase<pg8::EpiResF32, pg8::StaticOrder, false, true>(F.lds + RING_OFF, g, S, E, F.wave);
        if (DBL & 16) { GRID_BAR(); pg8::gemm_phase<pg8::EpiResF32, pg8::StaticOrder, false, true>(F.lds + RING_OFF, g, S, E, F.wave); }
    }
#undef IN
#undef BOTH
}

extern "C" void kernel_launch(void* const* d_in, const int* in_sizes, int n_in, void* d_out, int out_size, void* d_ws, size_t ws_size, hipStream_t stream) {
    static int grid = 0;
    if (grid == 0) {
        if (n_in != 21 || in_sizes[0] != M * D || out_size != M * D || ws_size < WS_END + 2 * MiB) { fprintf(stderr, "kernel_launch: unexpected shapes (n_in %d, in0 %d, out %d, ws %zu); nothing launched\n", n_in, n_in > 0 ? in_sizes[0] : -1, out_size, ws_size); grid = -1; return; }
        int dev = 0, cus = 0, per_cu = 0;
        if (hipGetDevice(&dev) != hipSuccess || hipDeviceGetAttribute(&cus, hipDeviceAttributeMultiprocessorCount, dev) != hipSuccess) { grid = -1; return; }
        if (hipFuncSetAttribute((const void*)hymba_fwd, hipFuncAttributeMaxDynamicSharedMemorySize, LDS_BYTES) != hipSuccess) { fprintf(stderr, "kernel_launch: hipFuncSetAttribute failed\n"); grid = -1; return; }
        if (hipOccupancyMaxActiveBlocksPerMultiprocessor(&per_cu, (const void*)hymba_fwd, NWAVES * 64, LDS_BYTES) != hipSuccess || per_cu < 1) { fprintf(stderr, "kernel_launch: occupancy query reports %d workgroups per CU; nothing launched\n", per_cu); grid = -1; return; }
        (void)hipGetLastError();
        grid = cus;
        if (grid > 256) grid = 256;
    }
    if (grid < 0) return;
    if (hipMemsetAsync((char*)d_ws + WS_CTL, 0, CTL_ZERO_BYTES, stream) != hipSuccess) { fprintf(stderr, "kernel_launch: hipMemsetAsync failed\n"); return; }
    Args a{};
    for (int i = 0; i < 21; ++i) a.in[i] = (const float*)d_in[i];
    a.out = (float*)d_out; a.ws = (unsigned char*)d_ws;
    for (int li = 0; li < MK_N_LAUNCHES; ++li) {
        a.ph_lo = (MK_N_LAUNCHES == 1) ? 0 : li; a.ph_hi = (MK_N_LAUNCHES == 1) ? N_PHASES : li + 1;
        hipLaunchKernelGGL(hymba_fwd, dim3(grid), dim3(NWAVES * 64), LDS_BYTES, stream, a);
        const hipError_t le = hipPeekAtLastError();
        if (le != hipSuccess) { fprintf(stderr, "kernel_launch: launch %d failed: %s\n", li, hipGetErrorName(le)); break; }
    }
}
```

```cpp
#include <hip/hip_runtime.h>
#include <hip/hip_bf16.h>
#include <cstdio>
#include <cstdint>
#include <cmath>
namespace pg8 {
#define PG8_LAS __attribute__((address_space(3)))
typedef unsigned short bf16_t;
typedef short bf16x8 __attribute__((ext_vector_type(8)));
typedef float f32x4 __attribute__((ext_vector_type(4)));
typedef unsigned u32x4 __attribute__((ext_vector_type(4)));
constexpr int BM = 256, BK = 64, HALF = 128, HTB = HALF * BK * 2  , STAGE_BYTES = 8 * HTB, NXCD = 8, WGM = 8;

__host__ __device__ __forceinline__ int lds_byte(int r, int c) { const int st = (r >> 4) * 2 + (c >> 5), rr = r & 15, cc = c & 31, ob = rr * 64 + cc * 2; return st * 1024 + (ob ^ (((ob >> 9) & 1) << 5)); }
__host__ __device__ __forceinline__ void stage_rc(int b, int& R, int& C) { const int st = b / 1024, sb = b % 1024, swz = sb ^ (((sb >> 9) & 1) << 5); R = (st >> 1) * 16 + swz / 64; C = (st & 1) * 32 + (swz % 64) / 2; }
__host__ __device__ __forceinline__ int perm32(int rho) { const int n = rho >> 4, i = rho & 15; return 8 * (i >> 2) + 4 * n + (i & 3); }

__device__ __forceinline__ int mk_lane_pg8() { int l; asm volatile("v_mbcnt_lo_u32_b32 %0, -1, 0\n\tv_mbcnt_hi_u32_b32 %0, -1, %0" : "=v"(l)); return l; }
struct Unit { int pm, pn; };
struct Gemm { const bf16_t* A; const bf16_t* Bt; int M, N, K; };

struct StaticOrder {
    int nM, nN, nwg, G, c;
    __host__ __device__ void init(int M, int N, int G_, int c_) { nM = M / BM; nN = N / BM; nwg = nM * nN; G = G_; c = c_; }
    __host__ __device__ bool next(int i, Unit& u) const {
        const long L = (long)i * G + c; if (L >= nwg) return false;
        int wgid = (int)L; { const int q = nwg / NXCD, r = nwg % NXCD, xcd = wgid % NXCD, off = wgid / NXCD; wgid = (xcd < r ? xcd * (q + 1) : r * (q + 1) + (xcd - r) * q) + off; }
        const int nig = WGM * nN, gid = wgid / nig, fm = gid * WGM, gsz = (nM - fm) < WGM ? (nM - fm) : WGM;
        u.pm = fm + ((wgid % nig) % gsz); u.pn = (wgid % nig) / gsz; return true;
    }
    __device__ __forceinline__ void a_ready(const Unit&) const {}
    __device__ __forceinline__ void done(const Unit&) const {}
};

__device__ __forceinline__ unsigned cvt_pk_bf16(float lo, float hi) { unsigned r; asm volatile("v_cvt_pk_bf16_f32 %0, %1, %2" : "=v"(r) : "v"(lo), "v"(hi)); return r; }
struct EpiBf16S {
    static constexpr bool PERM = true, AFTER_DRAIN = false;
    bf16_t* O; int ldc;
    __device__ __forceinline__ void operator()(const f32x4 (&acc)[2][2][4][2], const Unit& u, int wr, int wc, int fr, int fq) const {
        const int row0 = u.pm * BM + wr * 64 + fr, col0 = u.pn * BM + wc * 32 + 8 * fq;
#pragma unroll
        for (int ai = 0; ai < 2; ++ai)
#pragma unroll
            for (int m = 0; m < 4; ++m) { bf16_t* rowp = O + (size_t)(row0 + ai * HALF + m * 16) * ldc + col0;
#pragma unroll
                for (int bj = 0; bj < 2; ++bj) { const f32x4 v0 = acc[ai][bj][m][0], v1 = acc[ai][bj][m][1];
                    u32x4 w; w.x = cvt_pk_bf16(v0[0], v0[1]); w.y = cvt_pk_bf16(v0[2], v0[3]); w.z = cvt_pk_bf16(v1[0], v1[1]); w.w = cvt_pk_bf16(v1[2], v1[3]);
                    *(u32x4*)(rowp + bj * HALF) = w; } }
    }
};
struct EpiResF32 {
    static constexpr bool PERM = false, AFTER_DRAIN = false;
    const float* base; float* out; int ldc;
    __device__ __forceinline__ void operator()(const f32x4 (&acc)[2][2][4][2], const Unit& u, int wr, int wc, int fr, int fq) const {
        const int row0 = u.pm * BM + wr * 64 + fr, col0 = u.pn * BM + wc * 32 + 4 * fq;
#pragma unroll
        for (int ai = 0; ai < 2; ++ai)
#pragma unroll
            for (int m = 0; m < 4; ++m) { const size_t off = (size_t)(row0 + ai * HALF + m * 16) * ldc + col0;
#pragma unroll
                for (int bj = 0; bj < 2; ++bj)
#pragma unroll
                    for (int n = 0; n < 2; ++n) { const f32x4 bs = *(const f32x4*)(base + off + bj * HALF + n * 16); *(f32x4*)(out + off + bj * HALF + n * 16) = bs + acc[ai][bj][m][n]; } }
    }
};
template <class Epi, class Sched, bool ALIGN_EPI = false, bool SP2 = false>
__device__ __forceinline__ void gemm_phase(PG8_LAS unsigned char* lds, const Gemm g, const Sched& S, const Epi& E, const int mk_wave_id  ) {
    const int wid = mk_wave_id, lane = mk_lane_pg8(), tid = wid * 64 + lane, wr = wid >> 2, wc = wid & 3, fr = lane & 15, fq = lane >> 4;
    const int K = g.K, nt = K / BK;
    unsigned voffA[2], voffB[2];
#pragma unroll
    for (int i = 0; i < 2; ++i) { int R, C; stage_rc(tid * 16 + i * 8192, R, C); const int Rb = Epi::PERM ? ((R & ~31) + perm32(R & 31)) : R;
        voffA[i] = (unsigned)(R * K + C) * 2u; voffB[i] = (unsigned)(Rb * K + C) * 2u; }
    const size_t kstep = (size_t)(BK * 2);
    const size_t hstep = (size_t)HALF * K * 2;
    const size_t tstep = 2 * hstep;
    const unsigned ldsw = (unsigned)wid * 1024u;
    const int aoff = lds_byte(wr * 64 + fr, fq * 8), boff = lds_byte(wc * 32 + fr, fq * 8);
#define PG8_SA(b, h) (((b) * 2 + (h)) * HTB)
#define PG8_SB(b, h) ((4 + (b) * 2 + (h)) * HTB)
#define PG8_STAGE(bufoff, gbase, voff) do { _Pragma("unroll") for (int _i = 0; _i < 2; ++_i) \
        __builtin_amdgcn_global_load_lds((const unsigned*)((const char*)(gbase) + (voff)[_i]), (PG8_LAS unsigned*)(lds + (bufoff) + ldsw + _i * 8192), 16, 0, 0); } while (0)
#define PG8_LDA(dst, b, h) do { _Pragma("unroll") for (int m = 0; m < 4; ++m) _Pragma("unroll") for (int k = 0; k < 2; ++k) dst[m][k] = *(const PG8_LAS bf16x8*)(lds + PG8_SA(b, h) + aoff + m * 2048 + k * 1024); } while (0)
#define PG8_LDB(dst, b, h) do { _Pragma("unroll") for (int n = 0; n < 2; ++n) _Pragma("unroll") for (int k = 0; k < 2; ++k) dst[n][k] = *(const PG8_LAS bf16x8*)(lds + PG8_SB(b, h) + boff + n * 2048 + k * 1024); } while (0)
#define PG8_MMA(ai, bj, At, Bt) do { __builtin_amdgcn_s_setprio(1); _Pragma("unroll") for (int m = 0; m < 4; ++m) _Pragma("unroll") for (int n = 0; n < 2; ++n) _Pragma("unroll") for (int k = 0; k < 2; ++k) \
        acc[ai][bj][m][n] = __builtin_amdgcn_mfma_f32_16x16x32_bf16(Bt[n][k], At[m][k], acc[ai][bj][m][n], 0, 0, 0); __builtin_amdgcn_s_setprio(0); } while (0)
#define PG8_WAIT_V(n) asm volatile("s_waitcnt vmcnt(" #n ")" ::: "memory")
#define PG8_WAIT_L(n) asm volatile("s_waitcnt lgkmcnt(" #n ")" ::: "memory")
#define PG8_BAR __builtin_amdgcn_s_barrier()
#define PG8_SCHED __builtin_amdgcn_sched_barrier(0)
    Unit cur, nxt; int ui = 0;
    if (!S.next(0, cur)) return;
    f32x4 acc[2][2][4][2];
#pragma unroll
    for (int a = 0; a < 2; ++a)
#pragma unroll
        for (int b = 0; b < 2; ++b)
#pragma unroll
            for (int m = 0; m < 4; ++m)
#pragma unroll
                for (int n = 0; n < 2; ++n) acc[a][b][m][n] = (f32x4){0.f, 0.f, 0.f, 0.f};
    bf16x8 At[4][2], B0[2][2], B1[2][2];
    const char* cA = (const char*)g.A + (size_t)cur.pm * tstep; const char* cB = (const char*)g.Bt + (size_t)cur.pn * tstep;
    S.a_ready(cur);
    if constexpr (SP2) {
        PG8_STAGE(PG8_SB(0, 0), cB, voffB); PG8_STAGE(PG8_SB(0, 1), cB + hstep, voffB); PG8_STAGE(PG8_SA(0, 0), cA, voffA); PG8_STAGE(PG8_SA(0, 1), cA + hstep, voffA);
        if (wr == 1) PG8_BAR;
        PG8_WAIT_V(2); PG8_BAR;
        PG8_STAGE(PG8_SB(1, 0), cB + kstep, voffB); PG8_STAGE(PG8_SA(1, 0), cA + kstep, voffA); PG8_STAGE(PG8_SB(1, 1), cB + hstep + kstep, voffB);
        PG8_WAIT_V(6); PG8_BAR;
    } else {
        PG8_STAGE(PG8_SB(0, 0), cB, voffB); PG8_STAGE(PG8_SA(0, 0), cA, voffA); PG8_STAGE(PG8_SB(0, 1), cB + hstep, voffB); PG8_STAGE(PG8_SA(0, 1), cA + hstep, voffA);
        if (wr == 1) PG8_BAR;
        PG8_WAIT_V(4); PG8_BAR;
        PG8_STAGE(PG8_SB(1, 0), cB + kstep, voffB); PG8_STAGE(PG8_SA(1, 0), cA + kstep, voffA); PG8_STAGE(PG8_SB(1, 1), cB + hstep + kstep, voffB);
        PG8_WAIT_V(6); PG8_BAR;
    }
    for (;;) {
        const bool has_next = S.next(ui + 1, nxt);
        const char* nA = has_next ? (const char*)g.A + (size_t)nxt.pm * tstep : cA; const char* nB = has_next ? (const char*)g.Bt + (size_t)nxt.pn * tstep : cB;
        for (int t = 0; t < nt; t += 2) {
            const bool last = (t == nt - 2);
            const char* a1 = cA + (size_t)(t + 1) * kstep;
            const char* a2 = last ? nA : cA + (size_t)(t + 2) * kstep; const char* b2 = last ? nB : cB + (size_t)(t + 2) * kstep;
            const char* a3 = a2 + kstep; const char* b3 = b2 + kstep;
            if (last && has_next) S.a_ready(nxt);
            if constexpr (SP2) {
            PG8_LDB(B0, 0, 0); PG8_LDB(B1, 0, 1); PG8_SCHED; PG8_LDA(At, 0, 0); PG8_STAGE(PG8_SA(1, 1), a1 + hstep, voffA);
            PG8_WAIT_V(8); PG8_WAIT_L(0); PG8_BAR; PG8_MMA(0, 0, At, B0); PG8_MMA(0, 1, At, B1); PG8_BAR; PG8_SCHED;
            PG8_LDA(At, 0, 1); PG8_STAGE(PG8_SB(0, 0), b2, voffB); PG8_STAGE(PG8_SB(0, 1), b2 + hstep, voffB); PG8_STAGE(PG8_SA(0, 0), a2, voffA);
            PG8_WAIT_V(8); PG8_WAIT_L(0); PG8_BAR; PG8_MMA(1, 0, At, B0); PG8_MMA(1, 1, At, B1); PG8_BAR; PG8_SCHED;
            PG8_LDB(B0, 1, 0); PG8_LDB(B1, 1, 1); PG8_SCHED; PG8_LDA(At, 1, 0); PG8_STAGE(PG8_SA(0, 1), a2 + hstep, voffA);
            PG8_WAIT_V(8); PG8_WAIT_L(0); PG8_BAR; PG8_MMA(0, 0, At, B0); PG8_MMA(0, 1, At, B1); PG8_BAR; PG8_SCHED;
            PG8_LDA(At, 1, 1); PG8_STAGE(PG8_SB(1, 0), b3, voffB); PG8_STAGE(PG8_SB(1, 1), b3 + hstep, voffB); PG8_STAGE(PG8_SA(1, 0), a3, voffA);
            PG8_WAIT_V(8); PG8_WAIT_L(0); PG8_BAR; PG8_MMA(1, 0, At, B0); PG8_MMA(1, 1, At, B1); PG8_BAR; PG8_SCHED;
            } else {
            PG8_LDB(B0, 0, 0); PG8_SCHED; PG8_LDA(At, 0, 0); PG8_STAGE(PG8_SA(1, 1), a1 + hstep, voffA);
            PG8_WAIT_L(8); PG8_BAR; PG8_WAIT_L(0); PG8_MMA(0, 0, At, B0); PG8_BAR; PG8_SCHED;
            PG8_LDB(B1, 0, 1); PG8_STAGE(PG8_SB(0, 0), b2, voffB);
            PG8_BAR; PG8_WAIT_L(0); PG8_MMA(0, 1, At, B1); PG8_BAR;
            PG8_LDA(At, 0, 1); PG8_STAGE(PG8_SA(0, 0), a2, voffA);
            PG8_BAR; PG8_WAIT_L(0); PG8_MMA(1, 0, At, B0); PG8_BAR; PG8_SCHED;
            PG8_STAGE(PG8_SB(0, 1), b2 + hstep, voffB);
            PG8_WAIT_V(6); PG8_BAR; PG8_MMA(1, 1, At, B1); PG8_BAR;
            PG8_LDB(B0, 1, 0); PG8_SCHED; PG8_LDA(At, 1, 0); PG8_STAGE(PG8_SA(0, 1), a2 + hstep, voffA);
            PG8_WAIT_L(8); PG8_BAR; PG8_WAIT_L(0); PG8_MMA(0, 0, At, B0); PG8_BAR; PG8_SCHED;
            PG8_LDB(B1, 1, 1); PG8_STAGE(PG8_SB(1, 0), b3, voffB);
            PG8_BAR; PG8_WAIT_L(0); PG8_MMA(0, 1, At, B1); PG8_BAR;
            PG8_LDA(At, 1, 1); PG8_STAGE(PG8_SA(1, 0), a3, voffA);
            PG8_BAR; PG8_WAIT_L(0); PG8_MMA(1, 0, At, B0); PG8_BAR; PG8_SCHED;
            PG8_STAGE(PG8_SB(1, 1), b3 + hstep, voffB);
            PG8_WAIT_V(6); PG8_BAR; PG8_MMA(1, 1, At, B1); PG8_BAR;
            }
        }
        if constexpr (ALIGN_EPI) { if (wr == 0) PG8_BAR; }
        if constexpr (!Epi::AFTER_DRAIN) { E(acc, cur, wr, wc, fr, fq); S.done(cur); }
        if (!has_next) break;
#pragma unroll
        for (int a = 0; a < 2; ++a)
#pragma unroll
            for (int b = 0; b < 2; ++b)
#pragma unroll
                for (int m = 0; m < 4; ++m)
#pragma unroll
                    for (int n = 0; n < 2; ++n) acc[a][b][m][n] = (f32x4){0.f, 0.f, 0.f, 0.f};
        cur = nxt; cA = nA; cB = nB; ++ui;
        if constexpr (ALIGN_EPI) { if (wr == 1) PG8_BAR; }
    }
    PG8_WAIT_V(0);
    if constexpr (!ALIGN_EPI) { if (wr == 0) PG8_BAR; }
    PG8_BAR;
    if constexpr (Epi::AFTER_DRAIN) { E.fused(acc, cur, wr, wc, fr, fq, lds, wid, lane); S.done(cur); }
#undef PG8_SA
#undef PG8_SB
#undef PG8_STAGE
#undef PG8_LDA
#undef PG8_LDB
#undef PG8_MMA
#undef PG8_WAIT_V
#undef PG8_WAIT_L
#undef PG8_BAR
#undef PG8_SCHED
}
}
constexpr int NWAVES = 8;
#ifndef MK_N_LAUNCHES
#define MK_N_LAUNCHES 1
#endif
constexpr int N_PHASES = 5;
constexpr int BATCH = 8, T = 2048, D = 1024, M = BATCH * T;
constexpr int NP = 4352;
constexpr int C_R = 0, C_K = 512, C_V = 1024, C_ZW = 1536, C_ZA = 1600, C_GA = 1792, C_DQ = 2304, C_DK = 2816, C_DV = 3328, C_GB = 3840;
constexpr int RH = 8, RN = 64;
constexpr int AH = 4;
constexpr float C2 = 0.125f * 1.4426950408889634f;
constexpr float LOG2E = 1.4426950408889634f;
constexpr float LAMBDA_INIT = 0.2f;

constexpr size_t MiB = 1u << 20;
constexpr size_t WS_CTL = 0, CTL_ZERO_BYTES = 1 * MiB;
constexpr size_t WS_WIN = 2 * MiB;
constexpr size_t WS_WOUT = 11 * MiB;
constexpr size_t WS_WD = 13 * MiB, WS_WA = 13 * MiB + 65536;
constexpr size_t WS_RHO = 13 * MiB + 2 * 65536;
constexpr size_t WS_XN = 14 * MiB;
constexpr size_t WS_PROJ = 46 * MiB;
constexpr size_t WS_MIX = 182 * MiB;
constexpr size_t WS_END = 214 * MiB;
constexpr int CW_BAR = 4096;

constexpr int RING_OFF = 0, RING_BYTES = 131072;
constexpr int LDSCTL_OFF = RING_BYTES, MISC_OFF = LDSCTL_OFF + 320;
constexpr int LDS_BYTES = 155648;

#define GAS __attribute__((address_space(1)))
#define LAS __attribute__((address_space(3)))
typedef unsigned short bf16;
typedef unsigned v4u __attribute__((ext_vector_type(4)));
typedef unsigned v2u __attribute__((ext_vector_type(2)));
typedef float f32x4 __attribute__((ext_vector_type(4)));
typedef float f32x16 __attribute__((ext_vector_type(16)));
typedef short bf16x8 __attribute__((ext_vector_type(8)));
typedef short s16x4 __attribute__((ext_vector_type(4)));
typedef GAS unsigned gu32;
typedef GAS unsigned long long gu64;
#define RLX_AGENT __ATOMIC_RELAXED, __HIP_MEMORY_SCOPE_AGENT
#define LDS_WAIT() asm volatile("s_waitcnt lgkmcnt(0)" ::: "memory")
#define VM_WAIT() asm volatile("s_waitcnt vmcnt(0)" ::: "memory")
__device__ __forceinline__ unsigned f2bf(float f) { unsigned u = __builtin_bit_cast(unsigned, f); return (u + 0x7fffu + ((u >> 16) & 1u)) >> 16; }
__device__ __forceinline__ unsigned pk2(float lo, float hi) { return f2bf(lo) | (f2bf(hi) << 16); }
__device__ __forceinline__ float bflo(unsigned u) { return __uint_as_float(u << 16); }
__device__ __forceinline__ float bfhi(unsigned u) { return __uint_as_float(u & 0xffff0000u); }
__device__ __forceinline__ float bf1(unsigned short u) { return __uint_as_float((unsigned)u << 16); }
__device__ __forceinline__ int mk_lane() { int l; asm volatile("v_mbcnt_lo_u32_b32 %0, -1, 0\n\tv_mbcnt_hi_u32_b32 %0, -1, %0" : "=v"(l)); return l; }
#define XB_TMO      128
#define XB_XCNT(j)  (256  + 64 * (j))
#define XB_XSUB(j)  (1280 + 64 * (j))
#define XB_XGEN(j)  (2304 + 64 * (j))
#define XB_TOP      3328
#define XB_TOPGEN   3392
#define XCD_BAR_WORDS 3456
#define XB_SPIN_CAP (1u << 18)

__device__ __forceinline__ unsigned xb_ld(unsigned* p)              { return __hip_atomic_load(p, __ATOMIC_RELAXED, __HIP_MEMORY_SCOPE_AGENT); }
__device__ __forceinline__ unsigned xb_add(unsigned* p, unsigned v) { return __hip_atomic_fetch_add(p, v, __ATOMIC_RELAXED, __HIP_MEMORY_SCOPE_AGENT); }
__device__ __forceinline__ unsigned xb_xcc_id() { return (unsigned)__builtin_amdgcn_s_getreg((3 << 11) | 20) & 0xFu; }
#define XB_SPIN(cond, bar) do { unsigned _sp = 0; while (cond) { __builtin_amdgcn_s_sleep(1); \
    if ((++_sp & 255u) == 0u) { if (xb_ld(&(bar)[XB_TMO])) break; if (_sp > XB_SPIN_CAP) { atomicAdd(&(bar)[XB_TMO], 1u); break; } } } } while (0)

struct XcdBarrier {
    unsigned* bar; unsigned x;
    volatile LAS unsigned* st;
    int wave;
};

__device__ __forceinline__ XcdBarrier xcd_barrier_post(unsigned* bar, volatile LAS unsigned* st, int wave) {
    XcdBarrier b; b.bar = bar; b.x = xb_xcc_id(); b.st = st; b.wave = wave;
    if (wave == 0 && mk_lane() == 0) (void)xb_add(&bar[XB_XCNT(b.x)], 1u);
    return b;
}
__device__ __forceinline__ void xcd_barrier_complete(unsigned* bar, unsigned x, unsigned& nloc, unsigned& nx) {
    const unsigned G = gridDim.x * gridDim.y * gridDim.z;
    unsigned sum, cnt, mine, sp = 0u;
    for (;;) {
        sum = 0u; cnt = 0u; mine = 0u;
#pragma unroll
        for (unsigned j = 0; j < 16; ++j) { const unsigned c = xb_ld(&bar[XB_XCNT(j)]); sum += c; cnt += (c > 0u) ? 1u : 0u; mine = (j == x) ? c : mine; }
        if (sum == G) break;
        __builtin_amdgcn_s_sleep(1);
        if ((++sp & 255u) == 0u) { if (xb_ld(&bar[XB_TMO])) break; if (sp > XB_SPIN_CAP) { atomicAdd(&bar[XB_TMO], 1u); break; } }
    }
    nloc = mine > 0u ? mine : 1u; nx = cnt > 0u ? cnt : 1u;
}

__device__ __forceinline__ void xcd_barrier(const XcdBarrier& b) {
    asm volatile("s_waitcnt vmcnt(0)" ::: "memory");
    __syncthreads();
    if (b.wave == 0 && mk_lane() == 0) {
        unsigned* bar = b.bar;
        __builtin_amdgcn_s_waitcnt(0);
        unsigned nloc = b.st[0], nx = b.st[1];
        if (nloc == 0u) { xcd_barrier_complete(bar, b.x, nloc, nx); b.st[0] = nloc; b.st[1] = nx; }
        const unsigned old = xb_add(&bar[XB_XSUB(b.x)], 1u);
        const unsigned gen = old / nloc;
        if (old + 1u == (gen + 1u) * nloc) {
            __builtin_amdgcn_fence(__ATOMIC_RELEASE, "agent");
            asm volatile("s_waitcnt vmcnt(0)" ::: "memory");
            const unsigned og = xb_add(&bar[XB_TOP], 1u);
            const unsigned tg = og / nx;
            if (og + 1u == (tg + 1u) * nx) xb_add(&bar[XB_TOPGEN], 1u);
            else XB_SPIN(xb_ld(&bar[XB_TOPGEN]) == tg, bar);
            __builtin_amdgcn_fence(__ATOMIC_ACQUIRE, "agent");
            xb_add(&bar[XB_XGEN(b.x)], 1u);
            asm volatile("s_waitcnt vmcnt(0)" ::: "memory");
        } else {
            XB_SPIN(xb_ld(&bar[XB_XGEN(b.x)]) == gen, bar);
            __builtin_amdgcn_fence(__ATOMIC_ACQUIRE, "agent");
            asm volatile("s_waitcnt vmcnt(0)" ::: "memory");
        }
    }
    __syncthreads();
}
struct Frame {
    LAS unsigned char* lds;
    volatile LAS unsigned* MISC;
    gu32* ctl;
    int tid, lane, wave;
    int vcu, G;
    const float* x; float* out;
    const float *norm_g, *w_in, *shift_mu, *w0, *w_decay_up, *a0, *w_iclr_up, *k_k, *k_a, *r_k, *ln_w, *ln_b, *qn_g, *kn_g, *lq1, *lk1, *lq2, *lk2, *subln_g, *w_out;
    bf16 *WinT, *WoutT, *WdT, *WaT, *XN, *PROJ, *MIX;
};

typedef float f32x2q_t __attribute__((ext_vector_type(2))); typedef __bf16 bf16x2q_t __attribute__((ext_vector_type(2)));
__device__ __forceinline__ unsigned cvtpk2(float lo, float hi) { f32x2q_t v = {lo, hi}; bf16x2q_t b = __builtin_convertvector(v, bf16x2q_t); return __builtin_bit_cast(unsigned, b); }
__device__ __forceinline__ float wave_sum(float v) {
#pragma unroll
    for (int o = 1; o < 64; o <<= 1) v += __shfl_xor(v, o);
    return v;
}
template <int CTRL> __device__ __forceinline__ float dpp_f(float x) { return __builtin_bit_cast(float, __builtin_amdgcn_mov_dpp(__builtin_bit_cast(int, x), CTRL, 0xf, 0xf, true)); }
__device__ __forceinline__ float row16_sum(float x) {
    x += dpp_f<0xB1>(x); x += dpp_f<0x4E>(x); x += dpp_f<0x141>(x); x += dpp_f<0x140>(x); return x;
}
__device__ __forceinline__ float swap32_sum(float x) {
    auto rr = __builtin_amdgcn_permlane32_swap(__float_as_uint(x), __float_as_uint(x), false, false);
    return __uint_as_float(rr[0]) + __uint_as_float(rr[1]);
}

__device__ __forceinline__ void p0_transpose_item(const float* W, int N, int nsrc, const float* kscale, bf16* WT, int K, int ndst, LAS float* scr, int k0, int lane) {
    float v[32];
#pragma unroll
    for (int i = 0; i < 32; ++i) { const int kk = 2 * i + (lane >> 5); v[i] = (nsrc >= 0) ? W[(size_t)(k0 + kk) * N + nsrc + (lane & 31)] : 0.f; }
    if (kscale && nsrc >= 0) {
#pragma unroll
        for (int i = 0; i < 32; ++i) v[i] *= kscale[k0 + 2 * i + (lane >> 5)];
    }
#pragma unroll
    for (int i = 0; i < 32; ++i) scr[(2 * i + (lane >> 5)) * 33 + (lane & 31)] = v[i];
    LDS_WAIT(); asm volatile("" ::: "memory");
    const int c = lane & 7;
#pragma unroll
    for (int j = 0; j < 4; ++j) { const int n = (lane >> 3) + 8 * j; const LAS float* s = scr + (8 * c) * 33 + n;
        v4u o; o.x = cvtpk2(s[0 * 33], s[1 * 33]); o.y = cvtpk2(s[2 * 33], s[3 * 33]); o.z = cvtpk2(s[4 * 33], s[5 * 33]); o.w = cvtpk2(s[6 * 33], s[7 * 33]);
        *(GAS v4u*)(WT + (size_t)(ndst + n) * K + k0 + 8 * c) = o; }
    LDS_WAIT(); asm volatile("" ::: "memory");
}
__device__ __forceinline__ void p0_rows4(Frame& F, int m0) {
    f32x4 v[4][4]; float s[4];
#pragma unroll
    for (int u = 0; u < 4; ++u) { const GAS f32x4* xr = (const GAS f32x4*)(F.x + (size_t)(m0 + u) * D) + F.lane;
#pragma unroll
        for (int j = 0; j < 4; ++j) v[u][j] = __builtin_nontemporal_load(xr + 64 * j); }
#pragma unroll
    for (int u = 0; u < 4; ++u) { float a = 0.f;
#pragma unroll
        for (int j = 0; j < 4; ++j) a += (v[u][j].x * v[u][j].x + v[u][j].y * v[u][j].y) + (v[u][j].z * v[u][j].z + v[u][j].w * v[u][j].w);
        s[u] = a; }
#pragma unroll
    for (int u = 0; u < 4; ++u) {
        const float rstd = __builtin_amdgcn_rsqf(wave_sum(s[u]) * (1.f / D) + 1e-6f);
        GAS unsigned long long* o8 = (GAS unsigned long long*)(F.XN + (size_t)(m0 + u) * D) + F.lane;
#pragma unroll
        for (int j = 0; j < 4; ++j) o8[64 * j] = (unsigned long long)cvtpk2(v[u][j].x * rstd, v[u][j].y * rstd) | ((unsigned long long)cvtpk2(v[u][j].z * rstd, v[u][j].w * rstd) << 32);
    }
}
__device__ __forceinline__ void p0_prologue(Frame& F) {
    LAS float* scr = (LAS float*)(F.lds + RING_OFF + F.wave * 16384);
    const int gw = F.vcu * NWAVES + F.wave, NGW = F.G * NWAVES;
    constexpr int I_IN = (D / 64) * (NP / 32), I_OUT = (D / 64) * (D / 32), I_L = 512 / 32;
    constexpr int NITEMS = I_IN + I_OUT + 2 * I_L;
    int m0 = gw * 4;
    if (!(gw & 1) && m0 < M) { p0_rows4(F, m0); m0 += NGW * 4; }
#pragma unroll 1
    for (int it = gw; it < NITEMS; it += NGW) {
        int r = it;
        if (r < I_IN) { const int kb = r / (NP / 32), nb = r % (NP / 32), nd = 32 * nb; const int ns = nd < 1664 ? nd : (nd < 1792 ? -1 : nd - 128);
            p0_transpose_item(F.w_in, 4224, ns, F.norm_g, F.WinT, D, nd, scr, 64 * kb, F.lane); continue; } r -= I_IN;
        if (r < I_OUT) { const int kb = r / (D / 32), nb = r % (D / 32);
            p0_transpose_item(F.w_out, D, 32 * nb, nullptr, F.WoutT, D, 32 * nb, scr, 64 * kb, F.lane); continue; } r -= I_OUT;
        if (r < I_L) { p0_transpose_item(F.w_decay_up, 512, 32 * r, nullptr, F.WdT, 64, 32 * r, scr, 0, F.lane); continue; } r -= I_L;
        p0_transpose_item(F.w_iclr_up, 512, 32 * r, nullptr, F.WaT, 64, 32 * r, scr, 0, F.lane);
    }
#pragma unroll 1
    for (; m0 < M; m0 += NGW * 4) p0_rows4(F, m0);
}

__device__ __forceinline__ float tanh_f(float x) { const float e = __expf(-2.f * fabsf(x)); const float t = (1.f - e) * __builtin_amdgcn_rcpf(1.f + e); return x < 0.f ? -t : t; }
__device__ __forceinline__ void shifted8(const bf16* proj, size_t m, bool has_prev, int col, const float* mu, float (&o)[8]) {
    const v4u c = *(const GAS v4u*)(proj + m * NP + col);
    v4u p = (v4u){0u, 0u, 0u, 0u}; if (has_prev) p = *(const GAS v4u*)(proj + (m - 1) * NP + col);
    const f32x4 m0 = *(const GAS f32x4*)(mu), m1 = *(const GAS f32x4*)(mu + 4);
    const unsigned cw[4] = {c.x, c.y, c.z, c.w}, pw[4] = {p.x, p.y, p.z, p.w}; const float mm[8] = {m0.x, m0.y, m0.z, m0.w, m1.x, m1.y, m1.z, m1.w};
#pragma unroll
    for (int j = 0; j < 4; ++j) { const float c0 = bflo(cw[j]), c1 = bfhi(cw[j]), p0 = bflo(pw[j]), p1 = bfhi(pw[j]);
        o[2 * j] = c0 + (p0 - c0) * mm[2 * j]; o[2 * j + 1] = c1 + (p1 - c1) * mm[2 * j + 1]; }
}
__device__ __forceinline__ void shifted4(const bf16* proj, size_t m, bool has_prev, int col, const float* mu, float (&o)[4]) {
    const v2u c = *(const GAS v2u*)(proj + m * NP + col);
    v2u p = (v2u){0u, 0u}; if (has_prev) p = *(const GAS v2u*)(proj + (m - 1) * NP + col);
    const f32x4 m0 = *(const GAS f32x4*)(mu);
    o[0] = bflo(c.x) + (bflo(p.x) - bflo(c.x)) * m0.x; o[1] = bfhi(c.x) + (bfhi(p.x) - bfhi(c.x)) * m0.y;
    o[2] = bflo(c.y) + (bflo(p.y) - bflo(c.y)) * m0.z; o[3] = bfhi(c.y) + (bfhi(p.y) - bfhi(c.y)) * m0.w;
}
__device__ __forceinline__ void p2_qknorm(Frame& F) {
    const int gw = F.vcu * NWAVES + F.wave, NGW = F.G * NWAVES, lane = F.lane, sub = lane & 7;
    const f32x4 gq0 = *(const GAS f32x4*)(F.qn_g + sub * 8), gq1 = *(const GAS f32x4*)(F.qn_g + sub * 8 + 4), gk0 = *(const GAS f32x4*)(F.kn_g + sub * 8), gk1 = *(const GAS f32x4*)(F.kn_g + sub * 8 + 4);
    constexpr int UQ = 4;
    for (int it0 = gw * UQ; it0 < 2 * M; it0 += NGW * UQ) {
        bf16* p[UQ]; v4u c[UQ];
#pragma unroll
        for (int u = 0; u < UQ; ++u) { const int it = it0 + u; const size_t m = (size_t)(it >> 1); p[u] = F.PROJ + m * NP + ((it & 1) ? C_DK : C_DQ) + (lane >> 3) * 64 + sub * 8; c[u] = *(const GAS v4u*)p[u]; }
#pragma unroll
        for (int u = 0; u < UQ; ++u) {
            const int isk = (it0 + u) & 1; const unsigned cw[4] = {c[u].x, c[u].y, c[u].z, c[u].w};
            float xv[8]; float ss = 0.f;
#pragma unroll
            for (int j = 0; j < 4; ++j) { xv[2 * j] = bflo(cw[j]); xv[2 * j + 1] = bfhi(cw[j]); ss += xv[2 * j] * xv[2 * j] + xv[2 * j + 1] * xv[2 * j + 1]; }
            ss += dpp_f<0xB1>(ss); ss += dpp_f<0x4E>(ss); ss += dpp_f<0x141>(ss);
            const float r = __builtin_amdgcn_rsqf(ss * (1.f / 64.f) + 1e-6f) * (isk ? 1.f : C2);
            const f32x4 g0 = isk ? gk0 : gq0, g1 = isk ? gk1 : gq1;
            v4u o; o.x = cvtpk2(xv[0] * r * g0.x, xv[1] * r * g0.y); o.y = cvtpk2(xv[2] * r * g0.z, xv[3] * r * g0.w); o.z = cvtpk2(xv[4] * r * g1.x, xv[5] * r * g1.y); o.w = cvtpk2(xv[6] * r * g1.z, xv[7] * r * g1.w);
            *(GAS v4u*)p[u] = o;
        }
    }
}
typedef float f32x2_t __attribute__((ext_vector_type(2))); typedef __bf16 bf16x2_t __attribute__((ext_vector_type(2)));
__device__ __forceinline__ unsigned cvtpk(float lo, float hi) { f32x2_t v = {lo, hi}; bf16x2_t b = __builtin_convertvector(v, bf16x2_t); return __builtin_bit_cast(unsigned, b); }
#define MFMA32(a, b, c) __builtin_amdgcn_mfma_f32_32x32x16_bf16(__builtin_bit_cast(bf16x8, (a)), __builtin_bit_cast(bf16x8, (b)), (c), 0, 0, 0)
#define FRAGACC(z, s) ((v4u){cvtpk((z)[8 * (s)], (z)[8 * (s) + 1]), cvtpk((z)[8 * (s) + 2], (z)[8 * (s) + 3]), cvtpk((z)[8 * (s) + 4], (z)[8 * (s) + 5]), cvtpk((z)[8 * (s) + 6], (z)[8 * (s) + 7])})
template <int CTRL, int RM> __device__ __forceinline__ float dpp_upd0(float x) { return __builtin_bit_cast(float, __builtin_amdgcn_update_dpp(0, __builtin_bit_cast(int, x), CTRL, RM, 0xf, false)); }
__device__ __forceinline__ float scan32(float x) {
    x += dpp_upd0<0x111, 0xf>(x); x += dpp_upd0<0x112, 0xf>(x); x += dpp_upd0<0x114, 0xf>(x); x += dpp_upd0<0x118, 0xf>(x); x += dpp_upd0<0x142, 0xa>(x); return x;
}
__device__ __forceinline__ void st_wt16(v4u* p, const v4u v) { *(GAS v4u*)p = v; }
constexpr int RW_UNITS = BATCH * RH * (T / 32);
struct RwDump { v4u* PF; v4u* DD; v4u* QF; v4u* YD; float* GAM; float* RHO; };

__device__ __forceinline__ void rwkvA_unit(Frame& F, const RwDump& Dm, int bh, int ci, LAS float* wscr, LAS unsigned char* park, LAS v4u* zsh, int zpar) {
    int lane = mk_lane(); asm volatile("" : "+v"(lane));
    const int hi = lane >> 5, l31 = lane & 31, b = bh >> 3, w = bh & 7;
    LAS v4u* pk = (LAS v4u*)park + lane;
#define PARK(slot) pk[(slot) * 64]
    int tok = 0; asm volatile("" : "+v"(tok));
#define DEP(x) asm volatile("" : "+v"(tok) : "v"(x))
    const int t = ci * 32 + l31; const size_t m = (size_t)b * T + t; const bool hp = t > 0;
    const int u = ci * (BATCH * RH) + bh;
    const float pm = hp ? 1.f : 0.f;
    const bf16* pc = F.PROJ + m * NP + w * 64 + 4 * hi; const bf16* pp = F.PROJ + (hp ? m - 1 : m) * NP + w * 64 + 4 * hi;
    const float* mu = F.shift_mu + w * 64 + 4 * hi;
    const float *pw0 = F.w0 + w * 64 + 4 * hi, *pa0 = F.a0 + w * 64 + 4 * hi, *pkk = F.k_k + w * 64 + 4 * hi, *pka = F.k_a + w * 64 + 4 * hi, *prk = F.r_k + w * 64 + 4 * hi;
#define SH4(dst, COL, MU, OFF) do { const v2u c_ = *(const GAS v2u*)(pc + tok + (COL) + (OFF)), p_ = *(const GAS v2u*)(pp + tok + (COL) + (OFF)); const f32x4 m_ = *(const GAS f32x4*)(mu + tok + (MU) + (OFF)); \
        dst[0] = bflo(c_.x) + (bflo(p_.x) * pm - bflo(c_.x)) * m_.x; dst[1] = bfhi(c_.x) + (bfhi(p_.x) * pm - bfhi(c_.x)) * m_.y; \
        dst[2] = bflo(c_.y) + (bflo(p_.y) * pm - bflo(c_.y)) * m_.z; dst[3] = bfhi(c_.y) + (bfhi(p_.y) * pm - bfhi(c_.y)) * m_.w; } while (0)
    float ss = 0.f;
#pragma unroll
    for (int gq = 0; gq < 8; ++gq) { float k4[4]; SH4(k4, C_K, 512, 8 * gq); const f32x4 kkp = *(const GAS f32x4*)(pkk + tok + 8 * gq);
#pragma unroll
        for (int e = 0; e < 4; ++e) { const float q = k4[e] * kkp[e]; ss += q * q; }
        if (gq == 3) DEP(ss); }
    ss = swap32_sum(ss);
    const float inv = __builtin_amdgcn_rcpf(fmaxf(__builtin_amdgcn_sqrtf(ss), 1e-12f));
    asm volatile("" ::: "memory");
    v4u bz[4], ba[4];
    { const int s = F.wave >> 1; const bool which = (F.wave & 1) != 0;
      const bf16* zc = F.PROJ + m * NP + 8 * hi; const bf16* zp = F.PROJ + (hp ? m - 1 : m) * NP + 8 * hi; const float* zmu = F.shift_mu + 8 * hi;
      const int COL = (which ? C_ZA : C_ZW) + 16 * s, MUO = (which ? 1600 : 1536) + 16 * s;
      const v4u c = *(const GAS v4u*)(zc + tok + COL), p = *(const GAS v4u*)(zp + tok + COL); const f32x4 m0 = *(const GAS f32x4*)(zmu + tok + MUO), m1 = *(const GAS f32x4*)(zmu + tok + MUO + 4);
      float z[8];
#pragma unroll
      for (int j = 0; j < 4; ++j) { const float c0 = bflo(c[j]), c1 = bfhi(c[j]); const float mm0 = j < 2 ? m0[2 * j] : m1[2 * j - 4], mm1 = j < 2 ? m0[2 * j + 1] : m1[2 * j - 3];
          z[2 * j] = c0 + (bflo(p[j]) * pm - c0) * mm0; z[2 * j + 1] = c1 + (bfhi(p[j]) * pm - c1) * mm1; }
      if (!which) {
#pragma unroll
          for (int j = 0; j < 8; ++j) z[j] = tanh_f(z[j]); }
      LAS v4u* zs = zsh + zpar * 512;
      zs[((which ? 4 : 0) + s) * 64 + lane] = (v4u){cvtpk(z[0], z[1]), cvtpk(z[2], z[3]), cvtpk(z[4], z[5]), cvtpk(z[6], z[7])};
      __syncthreads();
#pragma unroll
      for (int q = 0; q < 4; ++q) { bz[q] = zs[q * 64 + lane]; ba[q] = zs[(4 + q) * 64 + lane]; }
      DEP(bz[3][3]); DEP(ba[3][3]); }
    asm volatile("" ::: "memory");
    v4u fa[4], fb[4], fk[4], fr[4], fv[4]; float rho = 0.f;
    float* gp = Dm.GAM + (size_t)u * 64 + hi * 32;
#define RW_LORA(cb) f32x16 accd = f32x16{}, acca = f32x16{}; _Pragma("unroll") for (int s = 0; s < 4; ++s) { \
        const v4u aD = *(const GAS v4u*)(F.WdT + tok + (size_t)(w * 64 + (cb) * 32 + l31) * 64 + 16 * s + 8 * hi); accd = MFMA32(aD, bz[s], accd); \
        const v4u aA = *(const GAS v4u*)(F.WaT + tok + (size_t)(w * 64 + (cb) * 32 + l31) * 64 + 16 * s + 8 * hi); acca = MFMA32(aA, ba[s], acca); }
    struct RwGL { v2u rc, rp, kc, kp, vc, vp; } gA, gB;
#define RW_LOADG(X, OFF) do { X.rc = *(const GAS v2u*)(pc + tok + C_R + (OFF)); X.rp = *(const GAS v2u*)(pp + tok + C_R + (OFF)); X.kc = *(const GAS v2u*)(pc + tok + C_K + (OFF)); X.kp = *(const GAS v2u*)(pp + tok + C_K + (OFF)); \
        X.vc = *(const GAS v2u*)(pc + tok + C_V + (OFF)); X.vp = *(const GAS v2u*)(pp + tok + C_V + (OFF)); } while (0)
#define RW_LERP(dst, c_, p_, m_) do { dst[0] = bflo(c_.x) + (bflo(p_.x) * pm - bflo(c_.x)) * m_.x; dst[1] = bfhi(c_.x) + (bfhi(p_.x) * pm - bfhi(c_.x)) * m_.y; \
        dst[2] = bflo(c_.y) + (bflo(p_.y) * pm - bflo(c_.y)) * m_.z; dst[3] = bfhi(c_.y) + (bfhi(p_.y) * pm - bfhi(c_.y)) * m_.w; } while (0)
#define RW_GROUP(cb, rg, CUR, NXT, HASN) do { constexpr int OFF = 32 * (cb) + 8 * (rg); const int ch0 = OFF + 4 * hi; \
            if (HASN) RW_LOADG(NXT, OFF + 8); \
            float rr[4], kk4[4], vv[4]; \
            const f32x4 mr_ = *(const GAS f32x4*)(mu + tok + OFF), mk_ = *(const GAS f32x4*)(mu + tok + 512 + OFF), mv_ = *(const GAS f32x4*)(mu + tok + 1024 + OFF); \
            const f32x4 w0v = *(const GAS f32x4*)(pw0 + tok + OFF), a0v = *(const GAS f32x4*)(pa0 + tok + OFF), kkp = *(const GAS f32x4*)(pkk + tok + OFF), kap = *(const GAS f32x4*)(pka + tok + OFF), rkp = *(const GAS f32x4*)(prk + tok + OFF); \
            RW_LERP(rr, CUR.rc, CUR.rp, mr_); RW_LERP(kk4, CUR.kc, CUR.kp, mk_); RW_LERP(vv, CUR.vc, CUR.vp, mv_); \
            float xa[4], xb[4], xk[4], xr[4], gg[4], ge[4]; \
            _Pragma("unroll") for (int e = 0; e < 4; ++e) { \
                const float nx = -(w0v[e] + accd[4 * (rg) + e]); const float sp = fmaxf(nx, 0.f) + __logf(1.f + __expf(-fabsf(nx))); \
                const float l2 = -__expf(-sp - 0.5f) * LOG2E; \
                const float g = scan32(l2); \
                const float a = __builtin_amdgcn_rcpf(1.f + __expf(-(a0v[e] + acca[4 * (rg) + e]))); \
                const float kk = kk4[e] * kkp[e] * inv; \
                const float kt = kk4[e] * (1.f + (a - 1.f) * kap[e]); \
                rho += rr[e] * kt * rkp[e]; \
                const float eg = __builtin_amdgcn_exp2f(g), egp = __builtin_amdgcn_exp2f(g - l2), eng = __builtin_amdgcn_rcpf(eg); \
                xa[e] = -kk * egp; xb[e] = kk * a * eng; xk[e] = kt * eng; xr[e] = rr[e] * eg; gg[e] = g; ge[e] = eg; } \
            if (l31 == 31) { *(LAS f32x4*)(wscr + ch0) = (f32x4){gg[0], gg[1], gg[2], gg[3]}; st_wt16((v4u*)(gp + (cb) * 16 + 4 * (rg)), (v4u){__float_as_uint(ge[0]), __float_as_uint(ge[1]), __float_as_uint(ge[2]), __float_as_uint(ge[3])}); } \
            constexpr int s_ = 2 * (cb) + ((rg) >> 1), vg = 2 * ((rg) & 1); \
            fa[s_][vg] = cvtpk(xa[0], xa[1]); fa[s_][vg + 1] = cvtpk(xa[2], xa[3]); \
            fb[s_][vg] = cvtpk(xb[0], xb[1]); fb[s_][vg + 1] = cvtpk(xb[2], xb[3]); \
            fk[s_][vg] = cvtpk(xk[0], xk[1]); fk[s_][vg + 1] = cvtpk(xk[2], xk[3]); \
            fr[s_][vg] = cvtpk(xr[0], xr[1]); fr[s_][vg + 1] = cvtpk(xr[2], xr[3]); \
            fv[s_][vg] = cvtpk(vv[0], vv[1]); fv[s_][vg + 1] = cvtpk(vv[2], vv[3]); \
            if (((rg) & 1) == 1) { PARK(s_) = fv[s_]; PARK(4 + s_) = fr[s_]; } \
            DEP(fa[s_][vg + 1]); DEP(fb[s_][vg + 1]); DEP(fk[s_][vg + 1]); DEP(fr[s_][vg + 1]); DEP(fv[s_][vg + 1]); DEP(rho); } while (0)
    RW_LOADG(gA, 0);
    { RW_LORA(0) RW_GROUP(0, 0, gA, gB, true); RW_GROUP(0, 1, gB, gA, true); RW_GROUP(0, 2, gA, gB, true); RW_GROUP(0, 3, gB, gA, true); }
    { RW_LORA(1) RW_GROUP(1, 0, gA, gB, true); RW_GROUP(1, 1, gB, gA, true); RW_GROUP(1, 2, gA, gB, true); RW_GROUP(1, 3, gB, gA, false); }
#undef RW_LOADG
#undef RW_LERP
#undef RW_LORA
#undef RW_GROUP
#undef SH4
    LDS_WAIT(); asm volatile("" ::: "memory");
    float EC[2]; EC[0] = __builtin_amdgcn_exp2f(wscr[l31]); EC[1] = __builtin_amdgcn_exp2f(wscr[32 + l31]);
    LDS_WAIT(); asm volatile("" ::: "memory");
    rho = swap32_sum(rho);
    if (hi == 0) __hip_atomic_store((gu32*)(Dm.RHO + (size_t)u * 32 + l31), __float_as_uint(rho), RLX_AGENT);
    v4u idf[2];
    { const int jst = 4 * ((l31 >> 3) & 1) + (l31 & 3); const bool hm = ((l31 >> 2) & 1) == hi; const unsigned one = 0x3F80u << (16 * (jst & 1));
#pragma unroll
      for (int sig = 0; sig < 2; ++sig) { const bool on = hm && ((l31 >> 4) == sig);
#pragma unroll
          for (int q = 0; q < 4; ++q) idf[sig][q] = (on && (jst >> 1) == q) ? one : 0u; } }
    LDS_WAIT();
    v4u Af[2][2], Vf[2][2];
#pragma unroll
    for (int blk = 0; blk < 2; ++blk) {
        f32x16 za = MFMA32(fa[2 * blk], idf[0], f32x16{}); za = MFMA32(fa[2 * blk + 1], idf[1], za);
        f32x16 zv = MFMA32(PARK(2 * blk), idf[0], f32x16{}); zv = MFMA32(PARK(2 * blk + 1), idf[1], zv);
        f32x16 zb = MFMA32(fb[2 * blk], idf[0], f32x16{}); zb = MFMA32(fb[2 * blk + 1], idf[1], zb);
        f32x16 zk = MFMA32(fk[2 * blk], idf[0], f32x16{}); zk = MFMA32(fk[2 * blk + 1], idf[1], zk);
        zb = zb * EC[blk]; zk = zk * EC[blk];
#pragma unroll
        for (int s = 0; s < 2; ++s) { Af[blk][s] = FRAGACC(za, s); Vf[blk][s] = FRAGACC(zv, s); PARK(8 + 2 * blk + s) = FRAGACC(zb, s); PARK(12 + 2 * blk + s) = FRAGACC(zk, s); }
        __builtin_amdgcn_sched_barrier(0);
    }
    f32x16 Aab = f32x16{}, TT = f32x16{}, AakT = f32x16{}, ArbT = f32x16{}, ArkT = f32x16{};
#pragma unroll
    for (int s = 0; s < 4; ++s) { const v4u frs = PARK(4 + s); Aab = MFMA32(fa[s], fb[s], Aab); TT = MFMA32(fb[s], fa[s], TT); AakT = MFMA32(fk[s], fa[s], AakT); ArbT = MFMA32(fb[s], frs, ArbT); ArkT = MFMA32(fk[s], frs, ArkT); }
#pragma unroll
    for (int r = 0; r < 16; ++r) { const int rowi = (r & 3) + 8 * (r >> 2) + 4 * hi;
        Aab[r] = (l31 < rowi) ? Aab[r] : 0.f; TT[r] = (rowi < l31) ? TT[r] : 0.f; AakT[r] = (rowi < l31) ? AakT[r] : 0.f;
        ArbT[r] = (rowi <= l31) ? ArbT[r] : 0.f; ArkT[r] = (rowi <= l31) ? ArkT[r] : 0.f; }
    v4u AakTf[2], ArbTf[2], ArkTf[2];
#pragma unroll
    for (int s = 0; s < 2; ++s) { AakTf[s] = FRAGACC(AakT, s); ArbTf[s] = FRAGACC(ArbT, s); ArkTf[s] = FRAGACC(ArkT, s); }
    __builtin_amdgcn_sched_barrier(0);
    v4u Xf[2], XTf[2], TTf[2];
#pragma unroll
    for (int s = 0; s < 2; ++s) { Xf[s] = FRAGACC(Aab, s); XTf[s] = FRAGACC(TT, s); }
#pragma unroll
    for (int r = 0; r < 16; ++r) { const int rowi = (r & 3) + 8 * (r >> 2) + 4 * hi; TT[r] += (rowi == l31) ? 1.f : 0.f; }
#pragma unroll
    for (int it = 0; it < 4; ++it) {
        f32x16 X2 = MFMA32(XTf[0], Xf[0], f32x16{}); X2 = MFMA32(XTf[1], Xf[1], X2);
        if (it < 3) { f32x16 X2T = MFMA32(Xf[0], XTf[0], f32x16{}); X2T = MFMA32(Xf[1], XTf[1], X2T);
#pragma unroll
            for (int s = 0; s < 2; ++s) XTf[s] = FRAGACC(X2T, s); }
#pragma unroll
        for (int s = 0; s < 2; ++s) { Xf[s] = FRAGACC(X2, s); TTf[s] = FRAGACC(TT, s); }
        TT = MFMA32(Xf[0], TTf[0], TT); TT = MFMA32(Xf[1], TTf[1], TT);
        __builtin_amdgcn_sched_barrier(0);
    }
#pragma unroll
    for (int s = 0; s < 2; ++s) TTf[s] = FRAGACC(TT, s);
    v4u Wf[2][2], Uf[2][2];
#pragma unroll
    for (int blk = 0; blk < 2; ++blk) {
        f32x16 av = MFMA32(AakTf[0], Vf[blk][0], f32x16{}); av = MFMA32(AakTf[1], Vf[blk][1], av);
        const v4u avf0 = FRAGACC(av, 0), avf1 = FRAGACC(av, 1);
        f32x16 uu = MFMA32(TTf[0], avf0, f32x16{}); uu = MFMA32(TTf[1], avf1, uu);
        f32x16 ww = MFMA32(TTf[0], Af[blk][0], f32x16{}); ww = MFMA32(TTf[1], Af[blk][1], ww);
#pragma unroll
        for (int s = 0; s < 2; ++s) { Wf[blk][s] = FRAGACC(ww, s); Uf[blk][s] = FRAGACC(uu, s); }
        __builtin_amdgcn_sched_barrier(0);
    }
    v4u* QFp = Dm.QF + (size_t)u * 256 + lane; v4u* YDp = Dm.YD + (size_t)u * 256 + lane;
#pragma unroll
    for (int blk = 0; blk < 2; ++blk) {
        f32x16 q;
#pragma unroll
        for (int s = 0; s < 2; ++s)
            { const v4u frs = PARK(4 + 2 * blk + s);
#pragma unroll
              for (int j = 0; j < 4; ++j) { q[8 * s + 2 * j] = bflo(frs[j]); q[8 * s + 2 * j + 1] = bfhi(frs[j]); } }
        q = MFMA32(Wf[blk][0], ArbTf[0], q); q = MFMA32(Wf[blk][1], ArbTf[1], q);
        st_wt16(QFp + (2 * blk) * 64, FRAGACC(q, 0)); st_wt16(QFp + (2 * blk + 1) * 64, FRAGACC(q, 1));
        f32x16 y = MFMA32(Uf[blk][0], ArbTf[0], f32x16{}); y = MFMA32(Uf[blk][1], ArbTf[1], y); y = MFMA32(Vf[blk][0], ArkTf[0], y); y = MFMA32(Vf[blk][1], ArkTf[1], y);
        st_wt16(YDp + (2 * blk) * 64, FRAGACC(y, 0)); st_wt16(YDp + (2 * blk + 1) * 64, FRAGACC(y, 1));
        __builtin_amdgcn_sched_barrier(0);
    }
    v4u* PFp = Dm.PF + (size_t)u * 512 + lane; v4u* DDp = Dm.DD + (size_t)u * 512 + lane;
#pragma unroll
    for (int c1 = 0; c1 < 2; ++c1)
#pragma unroll
        for (int cb = 0; cb < 2; ++cb) {
            f32x16 p = MFMA32(Wf[c1][0], PARK(8 + 2 * cb), f32x16{}); p = MFMA32(Wf[c1][1], PARK(8 + 2 * cb + 1), p);
            st_wt16(PFp + (cb * 4 + 2 * c1) * 64, FRAGACC(p, 0)); st_wt16(PFp + (cb * 4 + 2 * c1 + 1) * 64, FRAGACC(p, 1));
            __builtin_amdgcn_sched_barrier(0);
        }
#pragma unroll
    for (int cb = 0; cb < 2; ++cb)
#pragma unroll
        for (int ib = 0; ib < 2; ++ib) {
            f32x16 d = MFMA32(PARK(8 + 2 * cb), Uf[ib][0], f32x16{}); d = MFMA32(PARK(8 + 2 * cb + 1), Uf[ib][1], d); d = MFMA32(PARK(12 + 2 * cb), Vf[ib][0], d); d = MFMA32(PARK(12 + 2 * cb + 1), Vf[ib][1], d);
            st_wt16(DDp + ((cb * 2 + ib) * 2) * 64, FRAGACC(d, 0)); st_wt16(DDp + ((cb * 2 + ib) * 2 + 1) * 64, FRAGACC(d, 1));
            __builtin_amdgcn_sched_barrier(0);
        }
}

#undef PARK
#undef DEP
constexpr int RB_PF = 0, RB_DD = 8192, RB_QF = 16384, RB_YD = 20480, RB_GAM = 24576, RB_BUF = 24832, RB_STAT = 2 * RB_BUF, RB_Y = RB_STAT + 1024;
__device__ __forceinline__ void unpack16(const v4u a, const v4u b, f32x16& o) {
#pragma unroll
    for (int j = 0; j < 4; ++j) { o[2 * j] = bflo(a[j]); o[2 * j + 1] = bfhi(a[j]); o[8 + 2 * j] = bflo(b[j]); o[8 + 2 * j + 1] = bfhi(b[j]); }
}
constexpr int RW_SPLIT = T / 32, CW_DONE = 16384;
__device__ __forceinline__ void rw_wait_chunk(Frame& F, int ci) {
    unsigned spins = 0;
#pragma unroll 1
    for (int j = 7; j >= 0; --j) { gu32* c = F.ctl + CW_DONE + 64 * (ci + j);
        while ((unsigned)__builtin_amdgcn_readfirstlane(__hip_atomic_load(c, RLX_AGENT)) < (unsigned)BATCH) { __builtin_amdgcn_s_sleep(8); if (++spins > (1u << 22)) break; } }
    __builtin_amdgcn_fence(__ATOMIC_ACQUIRE, "agent");
}
__device__ __forceinline__ void rw_publish_chunk(Frame& F, int ci) {
    asm volatile("s_waitcnt vmcnt(0)" ::: "memory");
    __syncthreads();
    if (F.wave == 0 && mk_lane() == 0) {
        __hip_atomic_fetch_add(F.ctl + CW_DONE + 64 * ci, 1u, RLX_AGENT);
    }
}
struct RbStage { v4u p[2], d[2], q, y, g; };
struct RbEpi { v2u vc[2], vp[2], ga[2]; float rho; };
__device__ __forceinline__ void rwkvB_unit(Frame& F, const RwDump& Dm, int bh) {
    int lane = mk_lane(); asm volatile("" : "+v"(lane));
    const int wid = F.wave, tid = wid * 64 + lane, hi = lane >> 5, l31 = lane & 31, b = bh >> 3, h = bh & 7;
    LAS unsigned char* lds = F.lds + RING_OFF;
    constexpr int NS = T / 32;
    LAS float* stat = (LAS float*)(lds + RB_STAT);
    LAS float* ybuf = (LAS float*)(lds + RB_Y);
    const int stid = tid - 128;
    const bool st_p2 = wid < 4, st_q = wid < 6, st_y = wid >= 4;
#define ST_LOAD(X, ci_) do { { if ((ci_) >= RW_SPLIT && (ci_) < NS && (((ci_) - RW_SPLIT) & 7) == 0) rw_wait_chunk(F, (ci_)); const size_t u_ = (size_t)((ci_) < NS ? (ci_) : NS - 1) * (BATCH * RH) + bh; \
        X.p[0] = *(const GAS v4u*)(Dm.PF + u_ * 512 + stid); X.d[0] = *(const GAS v4u*)(Dm.DD + u_ * 512 + stid); \
        if (st_p2) { X.p[1] = *(const GAS v4u*)(Dm.PF + u_ * 512 + 384 + stid); X.d[1] = *(const GAS v4u*)(Dm.DD + u_ * 512 + 384 + stid); } \
        if (st_q) X.q = *(const GAS v4u*)(Dm.QF + u_ * 256 + stid); \
        if (st_y) X.y = *(const GAS v4u*)(Dm.YD + u_ * 256 + (stid - 128)); \
        if (stid < 16) X.g = *(const GAS v4u*)((const v4u*)(Dm.GAM + u_ * 64) + stid); } } while (0)
#define ST_STORE(X, buf_) do { LAS unsigned char* b_ = lds + (buf_) * RB_BUF; \
        *(LAS v4u*)(b_ + RB_PF + stid * 16) = X.p[0]; *(LAS v4u*)(b_ + RB_DD + stid * 16) = X.d[0]; \
        if (st_p2) { *(LAS v4u*)(b_ + RB_PF + (384 + stid) * 16) = X.p[1]; *(LAS v4u*)(b_ + RB_DD + (384 + stid) * 16) = X.d[1]; } \
        if (st_q) *(LAS v4u*)(b_ + RB_QF + stid * 16) = X.q; \
        if (st_y) *(LAS v4u*)(b_ + RB_YD + (stid - 128) * 16) = X.y; \
        if (stid < 16) *(LAS v4u*)(b_ + RB_GAM + stid * 16) = X.g; } while (0)
    const int eib = wid & 1, eh = (wid >> 2) & 1;
    const bf16* epc = F.PROJ + (size_t)b * T * NP + h * 64 + 32 * eib + 16 * eh + 4 * hi;
#define EP_LOAD(X, cj_) do { { const int tt_ = ((cj_) < NS ? (cj_) : NS - 1) * 32 + l31; const bf16* pc_ = epc + (size_t)tt_ * NP; const bf16* pp_ = epc + (size_t)(tt_ > 0 ? tt_ - 1 : 0) * NP; \
        _Pragma("unroll") for (int rg = 0; rg < 2; ++rg) { X.vc[rg] = *(const GAS v2u*)(pc_ + C_V + 8 * rg); X.vp[rg] = *(const GAS v2u*)(pp_ + C_V + 8 * rg); X.ga[rg] = *(const GAS v2u*)(pc_ + C_GA + 8 * rg); } \
        X.rho = Dm.RHO[((size_t)((cj_) < NS ? (cj_) : NS - 1) * (BATCH * RH) + bh) * 32 + l31]; } } while (0)
#define EP_RUN(X, cj_) do { const int par_ = (cj_) & 1; \
        const float s1_ = stat[((par_ * 2 + 0) * 32 + l31) * 2] + stat[((par_ * 2 + 1) * 32 + l31) * 2], s2_ = stat[((par_ * 2 + 0) * 32 + l31) * 2 + 1] + stat[((par_ * 2 + 1) * 32 + l31) * 2 + 1]; \
        const float mean_ = s1_ * (1.f / 64.f), var_ = fmaxf(s2_ * (1.f / 64.f) - mean_ * mean_, 0.f), rstd_ = __builtin_amdgcn_rsqf(var_ + 64e-5f); \
        const int tt_ = (cj_) * 32 + l31; const size_t mm_ = (size_t)b * T + tt_; const float pm_ = tt_ > 0 ? 1.f : 0.f; \
        const LAS float* yb_ = ybuf + (par_ * 2 + eib) * 1024 + lane; \
        _Pragma("unroll") for (int rg = 0; rg < 2; ++rg) { const int hc_ = h * 64 + 32 * eib + 16 * eh + 8 * rg + 4 * hi; \
            const f32x4 mu_ = emu[rg], lw_ = elw[rg], lb_ = elb[rg]; \
            const float vc_[4] = {bflo(X.vc[rg].x), bfhi(X.vc[rg].x), bflo(X.vc[rg].y), bfhi(X.vc[rg].y)}, vp_[4] = {bflo(X.vp[rg].x), bfhi(X.vp[rg].x), bflo(X.vp[rg].y), bfhi(X.vp[rg].y)}; \
            const float g4_[4] = {bflo(X.ga[rg].x), bfhi(X.ga[rg].x), bflo(X.ga[rg].y), bfhi(X.ga[rg].y)}; float o_[4]; \
            _Pragma("unroll") for (int e = 0; e < 4; ++e) { const float vv_ = vc_[e] + (vp_[e] * pm_ - vc_[e]) * mu_[e]; \
                const float yn_ = (yb_[(4 * (2 * eh + rg) + e) * 64] - mean_) * rstd_ * lw_[e] + lb_[e] + X.rho * vv_; o_[e] = yn_ * g4_[e] * __builtin_amdgcn_rcpf(1.f + __expf(-g4_[e])); } \
            *(GAS v2u*)(F.MIX + mm_ * D + hc_) = (v2u){cvtpk(o_[0], o_[1]), cvtpk(o_[2], o_[3])}; } } while (0)
    f32x16 S[2]; S[0] = f32x16{}; S[1] = f32x16{};
    const int ib = wid & 1;
#define CONS(ci_) do { const LAS unsigned char* bb = lds + ((ci_) & 1) * RB_BUF; \
          \
        v4u pf_[8], qf_[4], dd_[4], yd_[2]; f32x4 gm_[8]; \
        _Pragma("unroll") for (int q = 0; q < 8; ++q) gm_[q] = *(const LAS f32x4*)(bb + RB_GAM + (hi * 32 + 4 * q) * 4); \
        _Pragma("unroll") for (int q = 0; q < 4; ++q) dd_[q] = *(const LAS v4u*)(bb + RB_DD + ((((q >> 1) * 2 + ib) * 2 + (q & 1)) * 64 + lane) * 16); \
        _Pragma("unroll") for (int q = 0; q < 8; ++q) pf_[q] = *(const LAS v4u*)(bb + RB_PF + (q * 64 + lane) * 16); \
        _Pragma("unroll") for (int q = 0; q < 2; ++q) yd_[q] = *(const LAS v4u*)(bb + RB_YD + ((2 * ib + q) * 64 + lane) * 16); \
        _Pragma("unroll") for (int q = 0; q < 4; ++q) qf_[q] = *(const LAS v4u*)(bb + RB_QF + (q * 64 + lane) * 16); \
        __builtin_amdgcn_sched_barrier(0); \
        v4u Sf[4]; _Pragma("unroll") for (int s = 0; s < 4; ++s) Sf[s] = FRAGACC(S[s >> 1], s & 1); \
        _Pragma("unroll") for (int rb = 0; rb < 2; ++rb) { \
            f32x16 acc; unpack16(dd_[2 * rb], dd_[2 * rb + 1], acc); \
            _Pragma("unroll") for (int q = 0; q < 4; ++q) { const f32x4 gv = gm_[4 * rb + q]; _Pragma("unroll") for (int e = 0; e < 4; ++e) acc[4 * q + e] += gv[e] * S[rb][4 * q + e]; } \
            _Pragma("unroll") for (int s = 0; s < 4; ++s) acc = MFMA32(pf_[rb * 4 + s], Sf[s], acc); \
            S[rb] = acc; } \
        f32x16 y; unpack16(yd_[0], yd_[1], y); \
        _Pragma("unroll") for (int s = 0; s < 4; ++s) y = MFMA32(Sf[s], qf_[s], y); \
        float s1 = 0.f, s2 = 0.f; LAS float* yb_ = ybuf + (((ci_) & 1) * 2 + ib) * 1024 + lane; \
        _Pragma("unroll") for (int r = 0; r < 16; ++r) { s1 += y[r]; s2 += y[r] * y[r]; yb_[r * 64] = y[r]; } \
        s1 = swap32_sum(s1); s2 = swap32_sum(s2); \
        if (hi == 0) { stat[((((ci_) & 1) * 2 + ib) * 32 + l31) * 2] = s1; stat[((((ci_) & 1) * 2 + ib) * 32 + l31) * 2 + 1] = s2; } } while (0)
#define RB_BAR() do { asm volatile("s_waitcnt lgkmcnt(0)" ::: "memory"); __builtin_amdgcn_s_barrier(); asm volatile("" ::: "memory"); } while (0)
    if (wid < 2) {
        RB_BAR();
#pragma unroll 1
        for (int k = 0; k < NS; ++k) { CONS(k); RB_BAR(); }
        RB_BAR();
    } else {
        const bool epi = (wid != 4 && wid != 5);
        RbStage sA, sB, sC; RbEpi eA, eB, eC; f32x4 emu[2], elw[2], elb[2];
#pragma unroll
        for (int rg = 0; rg < 2; ++rg) { const int hc_ = h * 64 + 32 * eib + 16 * eh + 8 * rg + 4 * hi; emu[rg] = *(const GAS f32x4*)(F.shift_mu + 1024 + hc_); elw[rg] = *(const GAS f32x4*)(F.ln_w + hc_); elb[rg] = *(const GAS f32x4*)(F.ln_b + hc_); }
        ST_LOAD(sA, 0); ST_LOAD(sB, 1); ST_LOAD(sC, 2); ST_STORE(sA, 0); ST_LOAD(sA, 3);
        if (epi) { EP_LOAD(eA, 0); EP_LOAD(eB, 1); }
        RB_BAR();
        ST_STORE(sB, 1); ST_LOAD(sB, 4); if (epi) EP_LOAD(eC, 2); RB_BAR();
#define HY_STEP(k_, SN, EP) do { ST_STORE(SN, ((k_) + 1) & 1); ST_LOAD(SN, (k_) + 4); if (epi) { EP_RUN(EP, (k_) - 1); EP_LOAD(EP, (k_) + 2); } RB_BAR(); } while (0)
#pragma unroll 1
        for (int k = 1; k < NS; k += 3) { HY_STEP(k, sC, eA); HY_STEP(k + 1, sA, eB); HY_STEP(k + 2, sB, eC); }
        if (epi) EP_RUN(eA, NS - 1);
        RB_BAR();
#undef HY_STEP
    }
#undef RB_BAR
#undef ST_LOAD
#undef ST_STORE
#undef EP_LOAD
#undef EP_RUN
#undef CONS
}
constexpr int CW_G17 = 12288;
struct OneUnit { int pm, pn;
    __device__ __forceinline__ bool next(int i, pg8::Unit& u) const { if (i != 0) return false; u.pm = pm; u.pn = pn; return true; }
    __device__ __forceinline__ void a_ready(const pg8::Unit&) const {}
    __device__ __forceinline__ void done(const pg8::Unit&) const {} };
constexpr int AT_KB = 64 * 256, AT_VB = 64 * 256, AT_BUF = AT_KB + AT_VB, AT_QOFF = 2 * AT_KB + 3 * AT_VB;
__device__ __forceinline__ s16x4 vtr(const LAS unsigned char* p) { typedef short v4i16_t __attribute__((ext_vector_type(4))); return __builtin_bit_cast(s16x4, __builtin_amdgcn_ds_read_tr16_b64_v4i16((LAS v4i16_t*)p)); }
__device__ __forceinline__ void attn_unit(Frame& F, int b, int h, int qb) {
    int lane = mk_lane(); asm volatile("" : "+v"(lane));
    const int wid = F.wave, tid = wid * 64 + lane, l31 = lane & 31, hi = lane >> 5, map = wid >> 2, qs = wid & 3;
    LAS unsigned char* lds = F.lds + RING_OFF;
    const float slope2 = exp2f(-2.f * (float)(h + 1)) * LOG2E, shift2 = __uint_as_float(F.MISC[15]);
    const int q0 = qb * 128, qrow = q0 + 32 * qs + l31;
    const size_t mrow = (size_t)b * T + qrow;
    LAS bf16x8* qpark = (LAS bf16x8*)(lds + AT_QOFF + wid * 4096) + lane;
    { const bf16* qp = F.PROJ + mrow * NP + C_DQ + h * 128 + map * 64 + 8 * hi;
#pragma unroll
      for (int s = 0; s < 4; ++s) qpark[s * 64] = *(const GAS bf16x8*)(qp + 16 * s); }
    const bf16* kg = F.PROJ + (size_t)b * T * NP + C_DK + h * 128;
    const bf16* vg = F.PROJ + (size_t)b * T * NP + C_DV + h * 128;
    const int NT = 2 * qb + 2, tl = 2 * qb + (qs >> 1);
    const int Wk = (int)__builtin_ceilf((2.f * shift2 + 32.2f) / slope2);
    const int tf = __builtin_amdgcn_readfirstlane(max(0, (qb * 128 - Wk) >> 6));
    constexpr int AT_V0 = 2 * AT_KB;
    const int drow0 = 4 * wid + (lane >> 4), drow1 = drow0 + 32, dch = lane & 15;
    const unsigned ksrc0 = (unsigned)(drow0 * NP + ((dch ^ (drow0 & 15)) * 8)), ksrc1 = (unsigned)(drow1 * NP + ((dch ^ (drow1 & 15)) * 8));
    const unsigned vsrc0 = (unsigned)(drow0 * NP + ((dch ^ ((drow0 & 3) << 2)) * 8)), vsrc1 = (unsigned)(drow1 * NP + ((dch ^ ((drow1 & 3) << 2)) * 8));
#define AT_DMA(t_, kb_, v3_) do { const size_t tb_ = (size_t)(64 * (t_)) * NP; LAS unsigned char* bk_ = lds + (kb_) * AT_KB + wid * 1024; LAS unsigned char* bv_ = lds + AT_V0 + (v3_) * AT_VB + wid * 1024; \
        __builtin_amdgcn_global_load_lds((const unsigned*)(kg + tb_ + ksrc0), (LAS unsigned*)bk_, 16, 0, 0); __builtin_amdgcn_global_load_lds((const unsigned*)(kg + tb_ + ksrc1), (LAS unsigned*)(bk_ + 8192), 16, 0, 0); \
        __builtin_amdgcn_global_load_lds((const unsigned*)(vg + tb_ + vsrc0), (LAS unsigned*)bv_, 16, 0, 0); __builtin_amdgcn_global_load_lds((const unsigned*)(vg + tb_ + vsrc1), (LAS unsigned*)(bv_ + 8192), 16, 0, 0); } while (0)
    f32x16 o[4];
#pragma unroll
    for (int vb = 0; vb < 4; ++vb) o[vb] = f32x16{};
    float lsum = 0.f;
    AT_DMA(tf, tf & 1, tf % 3);
    __syncthreads();
    const int G = lane >> 4, qq = (lane & 15) >> 2, pp = lane & 3;
    const int vrow = (4 * hi + qq) * 256 + 8 * (pp & 1), vch = 2 * (G & 1) + (pp >> 1);
    v4u pw[4];
#define SBAR_() __builtin_amdgcn_sched_barrier(0)
#define AT_QK(t) do { \
            const LAS unsigned char* Kb = lds + ((t) & 1) * AT_KB; \
            float sl_ = slope2; asm volatile("" : "+v"(sl_));     \
            const float base = sl_ * (float)(64 * (t) + 4 * hi - qrow) - shift2; \
            float ls = 0.f; \
            _Pragma("unroll") for (int hf = 0; hf < 2; ++hf) {        \
                f32x16 p; \
                _Pragma("unroll") for (int r = 0; r < 16; ++r) p[r] = __builtin_fmaf(sl_, (float)(32 * hf + (r & 3) + 8 * (r >> 2)), base); \
                _Pragma("unroll") for (int s = 0; s < 4; ++s) { \
                    const bf16x8 a0 = *(const LAS bf16x8*)(Kb + (32 * hf + l31) * 256 + (((map * 8 + 2 * s + hi) ^ (l31 & 15)) * 16)); \
                    p = __builtin_amdgcn_mfma_f32_32x32x16_bf16(a0, qpark[s * 64], p, 0, 0, 0); } \
                if ((t) == tl) { \
                    _Pragma("unroll") for (int r = 0; r < 16; ++r) { const int ki = 64 * (t) + 32 * hf + 4 * hi + (r & 3) + 8 * (r >> 2); if (ki > qrow) p[r] = -1e30f; } } \
                _Pragma("unroll") for (int r = 0; r < 16; ++r) { p[r] = __builtin_amdgcn_exp2f(p[r]); ls += p[r]; } \
                pw[2 * hf] = (v4u){cvtpk(p[0], p[1]), cvtpk(p[2], p[3]), cvtpk(p[4], p[5]), cvtpk(p[6], p[7])}; \
                pw[2 * hf + 1] = (v4u){cvtpk(p[8], p[9]), cvtpk(p[10], p[11]), cvtpk(p[12], p[13]), cvtpk(p[14], p[15])}; } \
            lsum += ls; } while (0)
#define AT_VRD(dst, ks, vb0) do { _Pragma("unroll") for (int vb = (vb0); vb < (vb0) + 2; ++vb) { const LAS unsigned char* a_ = Vb + vrow + ((4 * vb + vch) ^ (qq << 2)) * 16 + (32 * ((ks) >> 1) + 16 * ((ks) & 1)) * 256; \
        dst[2 * (vb - (vb0))] = vtr(a_); dst[2 * (vb - (vb0)) + 1] = vtr(a_ + 8 * 256); } } while (0)
#define AT_PV(src, pwk, vb0) do { _Pragma("unroll") for (int vb = (vb0); vb < (vb0) + 2; ++vb) { const int j_ = 2 * (vb - (vb0)); \
        const bf16x8 vf = (bf16x8){src[j_][0], src[j_][1], src[j_][2], src[j_][3], src[j_ + 1][0], src[j_ + 1][1], src[j_ + 1][2], src[j_ + 1][3]}; \
        o[vb] = __builtin_amdgcn_mfma_f32_32x32x16_bf16(vf, __builtin_bit_cast(bf16x8, pwk), o[vb], 0, 0, 0); } } while (0)
#define AT_PVV(v3_) do { const LAS unsigned char* Vb = lds + AT_V0 + (v3_) * AT_VB; s16x4 vA[4], vB[4]; \
            AT_VRD(vA, 0, 0); SBAR_(); AT_VRD(vB, 0, 2); SBAR_(); \
            AT_PV(vA, pw[0], 0); SBAR_(); AT_VRD(vA, 1, 0); SBAR_(); AT_PV(vB, pw[0], 2); SBAR_(); AT_VRD(vB, 1, 2); SBAR_(); \
            AT_PV(vA, pw[1], 0); SBAR_(); AT_VRD(vA, 2, 0); SBAR_(); AT_PV(vB, pw[1], 2); SBAR_(); AT_VRD(vB, 2, 2); SBAR_(); \
            AT_PV(vA, pw[2], 0); SBAR_(); AT_VRD(vA, 3, 0); SBAR_(); AT_PV(vB, pw[2], 2); SBAR_(); AT_VRD(vB, 3, 2); SBAR_(); \
            AT_PV(vA, pw[3], 0); SBAR_(); AT_PV(vB, pw[3], 2); } while (0)
    if (map == 0) {
        int v3 = tf % 3;
#pragma unroll 1
        for (int t = tf; t < NT; ++t) { const int vn = v3 == 2 ? 0 : v3 + 1;
            if (t + 1 < NT) AT_DMA(t + 1, (t + 1) & 1, vn);
            if (t <= tl) { AT_QK(t); AT_PVV(v3); }
            __syncthreads(); v3 = vn; }
    } else {
        int v3 = tf % 3;
#pragma unroll 1
        for (int t = tf; t < NT; ++t) { const int vp = v3 == 0 ? 2 : v3 - 1, vn = v3 == 2 ? 0 : v3 + 1;
            if (t + 1 < NT) AT_DMA(t + 1, (t + 1) & 1, vn);
            if (t > tf && t - 1 <= tl) AT_PVV(vp);
            if (t <= tl) AT_QK(t);
            __syncthreads(); v3 = vn; }
        if (NT - 1 <= tl) { const int vp = v3 == 0 ? 2 : v3 - 1; AT_PVV(vp); }
    }
#undef AT_PVV
#undef AT_QK
#undef AT_VRD
#undef AT_PV
#undef SBAR_
#undef AT_DMA
    __syncthreads();
    const float ltot = swap32_sum(lsum);
    LAS float* X = (LAS float*)lds;
    if (map == 1) {
        const float sc = __uint_as_float(F.MISC[14]) / ltot;
#pragma unroll
        for (int vb = 0; vb < 4; ++vb)
#pragma unroll
            for (int r = 0; r < 16; ++r) X[(qs * 64 + vb * 16 + r) * 64 + lane] = o[vb][r] * sc;
    }
    __syncthreads();
    if (map == 0) {
        const float il = 1.f / ltot; float ss = 0.f;
#pragma unroll
        for (int vb = 0; vb < 4; ++vb)
#pragma unroll
            for (int r = 0; r < 16; ++r) { const float v = o[vb][r] * il - X[(qs * 64 + vb * 16 + r) * 64 + lane]; o[vb][r] = v; ss += v * v; }
        ss = swap32_sum(ss);
        const float rn = (1.f / sqrtf(ss * (1.f / 128.f) + 1e-5f)) * (1.f - LAMBDA_INIT);
        int etok = 0; asm volatile("" : "+v"(etok));
        const int lane_e = mk_lane(), hi = lane_e >> 5;
        const size_t mrow_e = (size_t)b * T + qb * 128 + 32 * qs + (lane_e & 31);
        const bf16* gp = F.PROJ + mrow_e * NP + C_GB + h * 128;
        bf16* op = F.MIX + mrow_e * D + 512 + h * 128;
#pragma unroll
        for (int vb = 0; vb < 4; ++vb)
#pragma unroll
            for (int rg = 0; rg < 4; ++rg) {
                const int vc = 32 * vb + 8 * rg + 4 * hi + etok;
                const v2u gw = *(const GAS v2u*)(gp + vc); const f32x4 sg = *(const GAS f32x4*)(F.subln_g + vc);
                const float g4[4] = {bflo(gw.x), bfhi(gw.x), bflo(gw.y), bfhi(gw.y)}; float ov[4];
#pragma unroll
                for (int e = 0; e < 4; ++e) ov[e] = o[vb][4 * rg + e] * rn * sg[e] * g4[e] / (1.f + __expf(-g4[e]));
                const unsigned w1_ = cvtpk(ov[2], ov[3]);
                *(GAS v2u*)(op + vc) = (v2u){cvtpk(ov[0], ov[1]), w1_};
                asm volatile("" : "+v"(etok) : "v"(w1_));
            }
    }
    __syncthreads();
}
#ifndef DBL
#define DBL 0
#endif
constexpr int CW_QUEUE = 8192;
constexpr int QX_RW = 8, QX_A2 = 0, QX_AT = 64, QX_ALL = QX_RW + QX_A2 + QX_AT;
__device__ __forceinline__ void p3_queue(Frame& F, const RwDump& Dm, const int qbase = CW_QUEUE) {
    const int ql = mk_lane();
    const float l1 = wave_sum(F.lq1[ql] * F.lk1[ql]), l2 = wave_sum(F.lq2[ql] * F.lk2[ql]);
    const float lam = __uint_as_float(__builtin_amdgcn_readfirstlane(__float_as_uint(__expf(l1) - __expf(l2) + LAMBDA_INIT)));
    float gq = fabsf(F.qn_g[ql]), gk = fabsf(F.kn_g[ql]);
#pragma unroll
    for (int o = 1; o < 64; o <<= 1) { gq = fmaxf(gq, __shfl_xor(gq, o)); gk = fmaxf(gk, __shfl_xor(gk, o)); }
    const float shift2 = __uint_as_float(__builtin_amdgcn_readfirstlane(__float_as_uint(8.f * gq * gk * LOG2E)));
    if (F.wave == 0 && mk_lane() == 0) { F.MISC[14] = __float_as_uint(lam); F.MISC[15] = __float_as_uint(shift2); }
    __syncthreads();
#ifdef Q_BLK
    const int x0 = (int)(blockIdx.x & 7);
#else
    const int x0 = (int)(xb_xcc_id() & 7u);
#endif
#pragma unroll 1
    for (int dx = 0; dx < 8; ++dx) {
        const int xq = (x0 + dx) & 7;
        for (;;) {
            if (F.wave == 0 && mk_lane() == 0) F.MISC[12] = __hip_atomic_fetch_add(F.ctl + qbase + 64 * xq, 1u, RLX_AGENT);
            __syncthreads();
            const int item = __builtin_amdgcn_readfirstlane((int)F.MISC[12]);
            __syncthreads();
            if (item >= QX_ALL) break;
            if (item < QX_RW) { rwkvB_unit(F, Dm, xq * 8 + item); if (DBL & 64) rwkvB_unit(F, Dm, xq * 8 + item); }
            else { const int idx = item - QX_RW - QX_A2, h = 3 - (idx >> 4), qb = 15 - (idx & 15);
#pragma unroll 1
#ifndef NO_ATT
                for (int rep = 0; rep < ((DBL & 32) ? 2 : 1); ++rep) attn_unit(F, xq, h, qb);
#endif
            }
        }
    }
}

struct Args { const float* in[21]; float* out; unsigned char* ws; int ph_lo, ph_hi; };
__global__ void __launch_bounds__(NWAVES * 64, 2) hymba_fwd(Args args) {
    extern __shared__ __attribute__((aligned(16))) unsigned char lds[];
    Frame F;
    F.lds = (LAS unsigned char*)lds;
    F.MISC = (volatile LAS unsigned*)(F.lds + MISC_OFF);
    F.wave = __builtin_amdgcn_readfirstlane((int)threadIdx.x >> 6); F.lane = mk_lane(); F.tid = F.wave * 64 + F.lane;
    F.G = gridDim.x; { const int bx = blockIdx.x; F.vcu = (F.G % 8 == 0) ? (bx % 8) * (F.G / 8) + bx / 8 : bx; }
    unsigned char* ws = args.ws;
    F.ctl = (gu32*)(ws + WS_CTL);
    F.x = args.in[0]; F.norm_g = args.in[1]; F.w_in = args.in[2]; F.shift_mu = args.in[3]; F.w0 = args.in[4]; F.w_decay_up = args.in[5]; F.a0 = args.in[6]; F.w_iclr_up = args.in[7];
    F.k_k = args.in[8]; F.k_a = args.in[9]; F.r_k = args.in[10]; F.ln_w = args.in[11]; F.ln_b = args.in[12]; F.qn_g = args.in[13]; F.kn_g = args.in[14];
    F.lq1 = args.in[15]; F.lk1 = args.in[16]; F.lq2 = args.in[17]; F.lk2 = args.in[18]; F.subln_g = args.in[19]; F.w_out = args.in[20]; F.out = args.out;
    F.WinT = (bf16*)(ws + WS_WIN); F.WoutT = (bf16*)(ws + WS_WOUT); F.WdT = (bf16*)(ws + WS_WD); F.WaT = (bf16*)(ws + WS_WA);
    F.XN = (bf16*)(ws + WS_XN); F.PROJ = (bf16*)(ws + WS_PROJ); F.MIX = (bf16*)(ws + WS_MIX);
    for (int u = F.tid; u < (LDS_BYTES - LDSCTL_OFF) / 4; u += NWAVES * 64) ((LAS unsigned*)(F.lds + LDSCTL_OFF))[u] = 0u;
    __syncthreads();
    XcdBarrier bar; bar.bar = (unsigned*)(F.ctl + CW_BAR); bar.x = 0; bar.st = nullptr; bar.wave = F.wave;
    if (MK_N_LAUNCHES == 1) bar = xcd_barrier_post((unsigned*)(F.ctl + CW_BAR), F.MISC + 8, F.wave);
#define GRID_BAR() do { if (MK_N_LAUNCHES == 1) xcd_barrier(bar); } while (0)
    const int lo = args.ph_lo, hi = args.ph_hi;
#define IN(k) (lo <= (k) && (k) < hi)
#define BOTH(k) (IN(k) && IN((k) + 1))
#ifndef SKIP
#define SKIP 0
#endif
    if (IN(0) && !(SKIP & 1)) { p0_prologue(F); if (DBL & 1) { GRID_BAR(); p0_prologue(F); } if (BOTH(0)) GRID_BAR(); }
    if (IN(1) && !(SKIP & 2)) {
        pg8::Gemm g{F.XN, F.WinT, M, NP, D}; pg8::StaticOrder S; S.init(M, NP, F.G, (int)blockIdx.x);
        pg8::EpiBf16S E{F.PROJ, NP};
        pg8::gemm_phase<pg8::EpiBf16S, pg8::StaticOrder, true, true>(F.lds + RING_OFF, g, S, E, F.wave);
        if (DBL & 2) { GRID_BAR(); pg8::gemm_phase<pg8::EpiBf16S, pg8::StaticOrder, true, true>(F.lds + RING_OFF, g, S, E, F.wave); }
        if (BOTH(1)) GRID_BAR();
    }
    RwDump Dm; { unsigned char* so = (unsigned char*)args.out; Dm.PF = (v4u*)so; Dm.DD = (v4u*)(so + 32 * MiB); Dm.QF = (v4u*)(ws + WS_XN); Dm.YD = (v4u*)(ws + WS_XN + 16 * MiB);
        Dm.GAM = (float*)(ws + WS_END); Dm.RHO = (float*)(ws + WS_END + 1 * MiB); }
    if (IN(2) && !(SKIP & 4)) {
        LAS float* wscr = (LAS float*)(F.lds + LDSCTL_OFF + 1024) + F.wave * 64; int zpar = 0;
#pragma unroll 1
        for (int p = F.vcu; p < BATCH * (T / 32); p += F.G) { rwkvA_unit(F, Dm, (p >> 6) * RH + F.wave, p & 63, wscr, F.lds + RING_OFF + F.wave * 16384, (LAS v4u*)(F.lds + LDSCTL_OFF + 4096), zpar); zpar ^= 1; }
        if (DBL & 4) { GRID_BAR();
#pragma unroll 1
            for (int p = F.vcu; p < BATCH * (T / 32); p += F.G) { rwkvA_unit(F, Dm, (p >> 6) * RH + F.wave, p & 63, wscr, F.lds + RING_OFF + F.wave * 16384, (LAS v4u*)(F.lds + LDSCTL_OFF + 4096), zpar); zpar ^= 1; } }
        p2_qknorm(F);
        if (BOTH(2)) GRID_BAR();
    }
    if (IN(3) && !(SKIP & 8)) {
        p3_queue(F, Dm);
        if (DBL & 512) { GRID_BAR(); p3_queue(F, Dm, CW_QUEUE + 1024); }
        if (BOTH(3)) GRID_BAR();
    }
    if (IN(4) && !(SKIP & 16)) {
        pg8::Gemm g{F.MIX, F.WoutT, M, D, D}; pg8::StaticOrder S; S.init(M, D, F.G, (int)blockIdx.x);
        pg8::EpiResF32 E{F.x, F.out, D};
        pg8::gemm_phase<pg8::EpiResF32, pg8::StaticOrder, false, true>(F.lds + RING_OFF, g, S, E, F.wave);
        if (DBL & 16) { GRID_BAR(); pg8::gemm_phase<pg8::EpiResF32, pg8::StaticOrder, false, true>(F.lds + RING_OFF, g, S, E, F.wave); }
    }
#undef IN
#undef BOTH
}

extern "C" void kernel_launch(void* const* d_in, const int* in_sizes, int n_in, void* d_out, int out_size, void* d_ws, size_t ws_size, hipStream_t stream) {
    static int grid = 0;
    if (grid == 0) {
        if (n_in != 21 || in_sizes[0] != M * D || out_size != M * D || ws_size < WS_END + 2 * MiB) { fprintf(stderr, "kernel_launch: unexpected shapes (n_in %d, in0 %d, out %d, ws %zu); nothing launched\n", n_in, n_in > 0 ? in_sizes[0] : -1, out_size, ws_size); grid = -1; return; }
        int dev = 0, cus = 0, per_cu = 0;
        if (hipGetDevice(&dev) != hipSuccess || hipDeviceGetAttribute(&cus, hipDeviceAttributeMultiprocessorCount, dev) != hipSuccess) { grid = -1; return; }
        if (hipFuncSetAttribute((const void*)hymba_fwd, hipFuncAttributeMaxDynamicSharedMemorySize, LDS_BYTES) != hipSuccess) { fprintf(stderr, "kernel_launch: hipFuncSetAttribute failed\n"); grid = -1; return; }
        if (hipOccupancyMaxActiveBlocksPerMultiprocessor(&per_cu, (const void*)hymba_fwd, NWAVES * 64, LDS_BYTES) != hipSuccess || per_cu < 1) { fprintf(stderr, "kernel_launch: occupancy query reports %d workgroups per CU; nothing launched\n", per_cu); grid = -1; return; }
        (void)hipGetLastError();
        grid = cus;
        if (grid > 256) grid = 256;
    }
    if (grid < 0) return;
    if (hipMemsetAsync((char*)d_ws + WS_CTL, 0, CTL_ZERO_BYTES, stream) != hipSuccess) { fprintf(stderr, "kernel_launch: hipMemsetAsync failed\n"); return; }
    Args a{};
    for (int i = 0; i < 21; ++i) a.in[i] = (const float*)d_in[i];
    a.out = (float*)d_out; a.ws = (unsigned char*)d_ws;
    for (int li = 0; li < MK_N_LAUNCHES; ++li) {
        a.ph_lo = (MK_N_LAUNCHES == 1) ? 0 : li; a.ph_hi = (MK_N_LAUNCHES == 1) ? N_PHASES : li + 1;
        hipLaunchKernelGGL(hymba_fwd, dim3(grid), dim3(NWAVES * 64), LDS_BYTES, stream, a);
        const hipError_t le = hipPeekAtLastError();
        if (le != hipSuccess) { fprintf(stderr, "kernel_launch: launch %d failed: %s\n", li, hipGetErrorName(le)); break; }
    }
}
```

```cpp
#include <hip/hip_runtime.h>
#include <hip/hip_bf16.h>
#include <cstdio>
#include <cstdint>
#include <cmath>
namespace pg8 {
#define PG8_LAS __attribute__((address_space(3)))
typedef unsigned short bf16_t;
typedef short bf16x8 __attribute__((ext_vector_type(8)));
typedef float f32x4 __attribute__((ext_vector_type(4)));
typedef unsigned u32x4 __attribute__((ext_vector_type(4)));
constexpr int BM = 256, BK = 64, HALF = 128, HTB = HALF * BK * 2  , STAGE_BYTES = 8 * HTB, NXCD = 8, WGM = 8;

__host__ __device__ __forceinline__ int lds_byte(int r, int c) { const int st = (r >> 4) * 2 + (c >> 5), rr = r & 15, cc = c & 31, ob = rr * 64 + cc * 2; return st * 1024 + (ob ^ (((ob >> 9) & 1) << 5)); }
__host__ __device__ __forceinline__ void stage_rc(int b, int& R, int& C) { const int st = b / 1024, sb = b % 1024, swz = sb ^ (((sb >> 9) & 1) << 5); R = (st >> 1) * 16 + swz / 64; C = (st & 1) * 32 + (swz % 64) / 2; }
__host__ __device__ __forceinline__ int perm32(int rho) { const int n = rho >> 4, i = rho & 15; return 8 * (i >> 2) + 4 * n + (i & 3); }

__device__ __forceinline__ int mk_lane_pg8() { int l; asm volatile("v_mbcnt_lo_u32_b32 %0, -1, 0\n\tv_mbcnt_hi_u32_b32 %0, -1, %0" : "=v"(l)); return l; }
struct Unit { int pm, pn; };
struct Gemm { const bf16_t* A; const bf16_t* Bt; int M, N, K; };

struct StaticOrder {
    int nM, nN, nwg, G, c;
    __host__ __device__ void init(int M, int N, int G_, int c_) { nM = M / BM; nN = N / BM; nwg = nM * nN; G = G_; c = c_; }
    __host__ __device__ bool next(int i, Unit& u) const {
        const long L = (long)i * G + c; if (L >= nwg) return false;
        int wgid = (int)L; { const int q = nwg / NXCD, r = nwg % NXCD, xcd = wgid % NXCD, off = wgid / NXCD; wgid = (xcd < r ? xcd * (q + 1) : r * (q + 1) + (xcd - r) * q) + off; }
        const int nig = WGM * nN, gid = wgid / nig, fm = gid * WGM, gsz = (nM - fm) < WGM ? (nM - fm) : WGM;
        u.pm = fm + ((wgid % nig) % gsz); u.pn = (wgid % nig) / gsz; return true;
    }
    __device__ __forceinline__ void a_ready(const Unit&) const {}
    __device__ __forceinline__ void done(const Unit&) const {}
};

__device__ __forceinline__ unsigned cvt_pk_bf16(float lo, float hi) { unsigned r; asm volatile("v_cvt_pk_bf16_f32 %0, %1, %2" : "=v"(r) : "v"(lo), "v"(hi)); return r; }
struct EpiBf16S {
    static constexpr bool PERM = true, AFTER_DRAIN = false;
    bf16_t* O; int ldc;
    __device__ __forceinline__ void operator()(const f32x4 (&acc)[2][2][4][2], const Unit& u, int wr, int wc, int fr, int fq) const {
        const int row0 = u.pm * BM + wr * 64 + fr, col0 = u.pn * BM + wc * 32 + 8 * fq;
#pragma unroll
        for (int ai = 0; ai < 2; ++ai)
#pragma unroll
            for (int m = 0; m < 4; ++m) { bf16_t* rowp = O + (size_t)(row0 + ai * HALF + m * 16) * ldc + col0;
#pragma unroll
                for (int bj = 0; bj < 2; ++bj) { const f32x4 v0 = acc[ai][bj][m][0], v1 = acc[ai][bj][m][1];
                    u32x4 w; w.x = cvt_pk_bf16(v0[0], v0[1]); w.y = cvt_pk_bf16(v0[2], v0[3]); w.z = cvt_pk_bf16(v1[0], v1[1]); w.w = cvt_pk_bf16(v1[2], v1[3]);
                    *(u32x4*)(rowp + bj * HALF) = w; } }
    }
};
struct EpiResF32 {
    static constexpr bool PERM = false, AFTER_DRAIN = false;
    const float* base; float* out; int ldc;
    __device__ __forceinline__ void operator()(const f32x4 (&acc)[2][2][4][2], const Unit& u, int wr, int wc, int fr, int fq) const {
        const int row0 = u.pm * BM + wr * 64 + fr, col0 = u.pn * BM + wc * 32 + 4 * fq;
#pragma unroll
        for (int ai = 0; ai < 2; ++ai)
#pragma unroll
            for (int m = 0; m < 4; ++m) { const size_t off = (size_t)(row0 + ai * HALF + m * 16) * ldc + col0;
#pragma unroll
                for (int bj = 0; bj < 2; ++bj)
#pragma unroll
                    for (int n = 0; n < 2; ++n) { const f32x4 bs = *(const f32x4*)(base + off + bj * HALF + n * 16); *(f32x4*)(out + off + bj * HALF + n * 16) = bs + acc[ai][bj][m][n]; } }
    }
};
template <class Epi, class Sched, bool ALIGN_EPI = false, bool SP2 = false>
__device__ __forceinline__ void gemm_phase(PG8_LAS unsigned char* lds, const Gemm g, const Sched& S, const Epi& E, const int mk_wave_id  ) {
    const int wid = mk_wave_id, lane = mk_lane_pg8(), tid = wid * 64 + lane, wr = wid >> 2, wc = wid & 3, fr = lane & 15, fq = lane >> 4;
    const int K = g.K, nt = K / BK;
    unsigned voffA[2], voffB[2];
#pragma unroll
    for (int i = 0; i < 2; ++i) { int R, C; stage_rc(tid * 16 + i * 8192, R, C); const int Rb = Epi::PERM ? ((R & ~31) + perm32(R & 31)) : R;
        voffA[i] = (unsigned)(R * K + C) * 2u; voffB[i] = (unsigned)(Rb * K + C) * 2u; }
    const size_t kstep = (size_t)(BK * 2);
    const size_t hstep = (size_t)HALF * K * 2;
    const size_t tstep = 2 * hstep;
    const unsigned ldsw = (unsigned)wid * 1024u;
    const int aoff = lds_byte(wr * 64 + fr, fq * 8), boff = lds_byte(wc * 32 + fr, fq * 8);
#define PG8_SA(b, h) (((b) * 2 + (h)) * HTB)
#define PG8_SB(b, h) ((4 + (b) * 2 + (h)) * HTB)
#define PG8_STAGE(bufoff, gbase, voff) do { _Pragma("unroll") for (int _i = 0; _i < 2; ++_i) \
        __builtin_amdgcn_global_load_lds((const unsigned*)((const char*)(gbase) + (voff)[_i]), (PG8_LAS unsigned*)(lds + (bufoff) + ldsw + _i * 8192), 16, 0, 0); } while (0)
#define PG8_LDA(dst, b, h) do { _Pragma("unroll") for (int m = 0; m < 4; ++m) _Pragma("unroll") for (int k = 0; k < 2; ++k) dst[m][k] = *(const PG8_LAS bf16x8*)(lds + PG8_SA(b, h) + aoff + m * 2048 + k * 1024); } while (0)
#define PG8_LDB(dst, b, h) do { _Pragma("unroll") for (int n = 0; n < 2; ++n) _Pragma("unroll") for (int k = 0; k < 2; ++k) dst[n][k] = *(const PG8_LAS bf16x8*)(lds + PG8_SB(b, h) + boff + n * 2048 + k * 1024); } while (0)
#define PG8_MMA(ai, bj, At, Bt) do { __builtin_amdgcn_s_setprio(1); _Pragma("unroll") for (int m = 0; m < 4; ++m) _Pragma("unroll") for (int n = 0; n < 2; ++n) _Pragma("unroll") for (int k = 0; k < 2; ++k) \
        acc[ai][bj][m][n] = __builtin_amdgcn_mfma_f32_16x16x32_bf16(Bt[n][k], At[m][k], acc[ai][bj][m][n], 0, 0, 0); __builtin_amdgcn_s_setprio(0); } while (0)
#define PG8_WAIT_V(n) asm volatile("s_waitcnt vmcnt(" #n ")" ::: "memory")
#define PG8_WAIT_L(n) asm volatile("s_waitcnt lgkmcnt(" #n ")" ::: "memory")
#define PG8_BAR __builtin_amdgcn_s_barrier()
#define PG8_SCHED __builtin_amdgcn_sched_barrier(0)
    Unit cur, nxt; int ui = 0;
    if (!S.next(0, cur)) return;
    f32x4 acc[2][2][4][2];
#pragma unroll
    for (int a = 0; a < 2; ++a)
#pragma unroll
        for (int b = 0; b < 2; ++b)
#pragma unroll
            for (int m = 0; m < 4; ++m)
#pragma unroll
                for (int n = 0; n < 2; ++n) acc[a][b][m][n] = (f32x4){0.f, 0.f, 0.f, 0.f};
    bf16x8 At[4][2], B0[2][2], B1[2][2];
    const char* cA = (const char*)g.A + (size_t)cur.pm * tstep; const char* cB = (const char*)g.Bt + (size_t)cur.pn * tstep;
    S.a_ready(cur);
    if constexpr (SP2) {
        PG8_STAGE(PG8_SB(0, 0), cB, voffB); PG8_STAGE(PG8_SB(0, 1), cB + hstep, voffB); PG8_STAGE(PG8_SA(0, 0), cA, voffA); PG8_STAGE(PG8_SA(0, 1), cA + hstep, voffA);
        if (wr == 1) PG8_BAR;
        PG8_WAIT_V(2); PG8_BAR;
        PG8_STAGE(PG8_SB(1, 0), cB + kstep, voffB); PG8_STAGE(PG8_SA(1, 0), cA + kstep, voffA); PG8_STAGE(PG8_SB(1, 1), cB + hstep + kstep, voffB);
        PG8_WAIT_V(6); PG8_BAR;
    } else {
        PG8_STAGE(PG8_SB(0, 0), cB, voffB); PG8_STAGE(PG8_SA(0, 0), cA, voffA); PG8_STAGE(PG8_SB(0, 1), cB + hstep, voffB); PG8_STAGE(PG8_SA(0, 1), cA + hstep, voffA);
        if (wr == 1) PG8_BAR;
        PG8_WAIT_V(4); PG8_BAR;
        PG8_STAGE(PG8_SB(1, 0), cB + kstep, voffB); PG8_STAGE(PG8_SA(1, 0), cA + kstep, voffA); PG8_STAGE(PG8_SB(1, 1), cB + hstep + kstep, voffB);
        PG8_WAIT_V(6); PG8_BAR;
    }
    for (;;) {
        const bool has_next = S.next(ui + 1, nxt);
        const char* nA = has_next ? (const char*)g.A + (size_t)nxt.pm * tstep : cA; const char* nB = has_next ? (const char*)g.Bt + (size_t)nxt.pn * tstep : cB;
        for (int t = 0; t < nt; t += 2) {
            const bool last = (t == nt - 2);
            const char* a1 = cA + (size_t)(t + 1) * kstep;
            const char* a2 = last ? nA : cA + (size_t)(t + 2) * kstep; const char* b2 = last ? nB : cB + (size_t)(t + 2) * kstep;
            const char* a3 = a2 + kstep; const char* b3 = b2 + kstep;
            if (last && has_next) S.a_ready(nxt);
            if constexpr (SP2) {
            PG8_LDB(B0, 0, 0); PG8_LDB(B1, 0, 1); PG8_SCHED; PG8_LDA(At, 0, 0); PG8_STAGE(PG8_SA(1, 1), a1 + hstep, voffA);
            PG8_WAIT_V(8); PG8_WAIT_L(0); PG8_BAR; PG8_MMA(0, 0, At, B0); PG8_MMA(0, 1, At, B1); PG8_BAR; PG8_SCHED;
            PG8_LDA(At, 0, 1); PG8_STAGE(PG8_SB(0, 0), b2, voffB); PG8_STAGE(PG8_SB(0, 1), b2 + hstep, voffB); PG8_STAGE(PG8_SA(0, 0), a2, voffA);
            PG8_WAIT_V(8); PG8_WAIT_L(0); PG8_BAR; PG8_MMA(1, 0, At, B0); PG8_MMA(1, 1, At, B1); PG8_BAR; PG8_SCHED;
            PG8_LDB(B0, 1, 0); PG8_LDB(B1, 1, 1); PG8_SCHED; PG8_LDA(At, 1, 0); PG8_STAGE(PG8_SA(0, 1), a2 + hstep, voffA);
            PG8_WAIT_V(8); PG8_WAIT_L(0); PG8_BAR; PG8_MMA(0, 0, At, B0); PG8_MMA(0, 1, At, B1); PG8_BAR; PG8_SCHED;
            PG8_LDA(At, 1, 1); PG8_STAGE(PG8_SB(1, 0), b3, voffB); PG8_STAGE(PG8_SB(1, 1), b3 + hstep, voffB); PG8_STAGE(PG8_SA(1, 0), a3, voffA);
            PG8_WAIT_V(8); PG8_WAIT_L(0); PG8_BAR; PG8_MMA(1, 0, At, B0); PG8_MMA(1, 1, At, B1); PG8_BAR; PG8_SCHED;
            } else {
            PG8_LDB(B0, 0, 0); PG8_SCHED; PG8_LDA(At, 0, 0); PG8_STAGE(PG8_SA(1, 1), a1 + hstep, voffA);
            PG8_WAIT_L(8); PG8_BAR; PG8_WAIT_L(0); PG8_MMA(0, 0, At, B0); PG8_BAR; PG8_SCHED;
            PG8_LDB(B1, 0, 1); PG8_STAGE(PG8_SB(0, 0), b2, voffB);
            PG8_BAR; PG8_WAIT_L(0); PG8_MMA(0, 1, At, B1); PG8_BAR;
            PG8_LDA(At, 0, 1); PG8_STAGE(PG8_SA(0, 0), a2, voffA);
            PG8_BAR; PG8_WAIT_L(0); PG8_MMA(1, 0, At, B0); PG8_BAR; PG8_SCHED;
            PG8_STAGE(PG8_SB(0, 1), b2 + hstep, voffB);
            PG8_WAIT_V(6); PG8_BAR; PG8_MMA(1, 1, At, B1); PG8_BAR;
            PG8_LDB(B0, 1, 0); PG8_SCHED; PG8_LDA(At, 1, 0); PG8_STAGE(PG8_SA(0, 1), a2 + hstep, voffA);
            PG8_WAIT_L(8); PG8_BAR; PG8_WAIT_L(0); PG8_MMA(0, 0, At, B0); PG8_BAR; PG8_SCHED;
            PG8_LDB(B1, 1, 1); PG8_STAGE(PG8_SB(1, 0), b3, voffB);
            PG8_BAR; PG8_WAIT_L(0); PG8_MMA(0, 1, At, B1); PG8_BAR;
            PG8_LDA(At, 1, 1); PG8_STAGE(PG8_SA(1, 0), a3, voffA);
            PG8_BAR; PG8_WAIT_L(0); PG8_MMA(1, 0, At, B0); PG8_BAR; PG8_SCHED;
            PG8_STAGE(PG8_SB(1, 1), b3 + hstep, voffB);
            PG8_WAIT_V(6); PG8_BAR; PG8_MMA(1, 1, At, B1); PG8_BAR;
            }
        }
        if constexpr (ALIGN_EPI) { if (wr == 0) PG8_BAR; }
        if constexpr (!Epi::AFTER_DRAIN) { E(acc, cur, wr, wc, fr, fq); S.done(cur); }
        if (!has_next) break;
#pragma unroll
        for (int a = 0; a < 2; ++a)
#pragma unroll
            for (int b = 0; b < 2; ++b)
#pragma unroll
                for (int m = 0; m < 4; ++m)
#pragma unroll
                    for (int n = 0; n < 2; ++n) acc[a][b][m][n] = (f32x4){0.f, 0.f, 0.f, 0.f};
        cur = nxt; cA = nA; cB = nB; ++ui;
        if constexpr (ALIGN_EPI) { if (wr == 1) PG8_BAR; }
    }
    PG8_WAIT_V(0);
    if constexpr (!ALIGN_EPI) { if (wr == 0) PG8_BAR; }
    PG8_BAR;
    if constexpr (Epi::AFTER_DRAIN) { E.fused(acc, cur, wr, wc, fr, fq, lds, wid, lane); S.done(cur); }
#undef PG8_SA
#undef PG8_SB
#undef PG8_STAGE
#undef PG8_LDA
#undef PG8_LDB
#undef PG8_MMA
#undef PG8_WAIT_V
#undef PG8_WAIT_L
#undef PG8_BAR
#undef PG8_SCHED
}
}
constexpr int NWAVES = 8;
#ifndef MK_N_LAUNCHES
#define MK_N_LAUNCHES 1
#endif
constexpr int N_PHASES = 5;
constexpr int BATCH = 8, T = 2048, D = 1024, M = BATCH * T;
constexpr int NP = 4352;
constexpr int C_R = 0, C_K = 512, C_V = 1024, C_ZW = 1536, C_ZA = 1600, C_GA = 1792, C_DQ = 2304, C_DK = 2816, C_DV = 3328, C_GB = 3840;
constexpr int RH = 8, RN = 64;
constexpr int AH = 4;
constexpr float C2 = 0.125f * 1.4426950408889634f;
constexpr float LOG2E = 1.4426950408889634f;
constexpr float LAMBDA_INIT = 0.2f;

constexpr size_t MiB = 1u << 20;
constexpr size_t WS_CTL = 0, CTL_ZERO_BYTES = 1 * MiB;
constexpr size_t WS_WIN = 2 * MiB;
constexpr size_t WS_WOUT = 11 * MiB;
constexpr size_t WS_WD = 13 * MiB, WS_WA = 13 * MiB + 65536;
constexpr size_t WS_RHO = 13 * MiB + 2 * 65536;
constexpr size_t WS_XN = 14 * MiB;
constexpr size_t WS_PROJ = 46 * MiB;
constexpr size_t WS_MIX = 182 * MiB;
constexpr size_t WS_END = 214 * MiB;
constexpr int CW_BAR = 4096;

constexpr int RING_OFF = 0, RING_BYTES = 131072;
constexpr int LDSCTL_OFF = RING_BYTES, MISC_OFF = LDSCTL_OFF + 320;
constexpr int LDS_BYTES = 155648;

#define GAS __attribute__((address_space(1)))
#define LAS __attribute__((address_space(3)))
typedef unsigned short bf16;
typedef unsigned v4u __attribute__((ext_vector_type(4)));
typedef unsigned v2u __attribute__((ext_vector_type(2)));
typedef float f32x4 __attribute__((ext_vector_type(4)));
typedef float f32x16 __attribute__((ext_vector_type(16)));
typedef short bf16x8 __attribute__((ext_vector_type(8)));
typedef short s16x4 __attribute__((ext_vector_type(4)));
typedef GAS unsigned gu32;
typedef GAS unsigned long long gu64;
#define RLX_AGENT __ATOMIC_RELAXED, __HIP_MEMORY_SCOPE_AGENT
#define LDS_WAIT() asm volatile("s_waitcnt lgkmcnt(0)" ::: "memory")
#define VM_WAIT() asm volatile("s_waitcnt vmcnt(0)" ::: "memory")
__device__ __forceinline__ unsigned f2bf(float f) { unsigned u = __builtin_bit_cast(unsigned, f); return (u + 0x7fffu + ((u >> 16) & 1u)) >> 16; }
__device__ __forceinline__ unsigned pk2(float lo, float hi) { return f2bf(lo) | (f2bf(hi) << 16); }
__device__ __forceinline__ float bflo(unsigned u) { return __uint_as_float(u << 16); }
__device__ __forceinline__ float bfhi(unsigned u) { return __uint_as_float(u & 0xffff0000u); }
__device__ __forceinline__ float bf1(unsigned short u) { return __uint_as_float((unsigned)u << 16); }
__device__ __forceinline__ int mk_lane() { int l; asm volatile("v_mbcnt_lo_u32_b32 %0, -1, 0\n\tv_mbcnt_hi_u32_b32 %0, -1, %0" : "=v"(l)); return l; }
#define XB_TMO      128
#define XB_XCNT(j)  (256  + 64 * (j))
#define XB_XSUB(j)  (1280 + 64 * (j))
#define XB_XGEN(j)  (2304 + 64 * (j))
#define XB_TOP      3328
#define XB_TOPGEN   3392
#define XCD_BAR_WORDS 3456
#define XB_SPIN_CAP (1u << 18)

__device__ __forceinline__ unsigned xb_ld(unsigned* p)              { return __hip_atomic_load(p, __ATOMIC_RELAXED, __HIP_MEMORY_SCOPE_AGENT); }
__device__ __forceinline__ unsigned xb_add(unsigned* p, unsigned v) { return __hip_atomic_fetch_add(p, v, __ATOMIC_RELAXED, __HIP_MEMORY_SCOPE_AGENT); }
__device__ __forceinline__ unsigned xb_xcc_id() { return (unsigned)__builtin_amdgcn_s_getreg((3 << 11) | 20) & 0xFu; }
#define XB_SPIN(cond, bar) do { unsigned _sp = 0; while (cond) { __builtin_amdgcn_s_sleep(1); \
    if ((++_sp & 255u) == 0u) { if (xb_ld(&(bar)[XB_TMO])) break; if (_sp > XB_SPIN_CAP) { atomicAdd(&(bar)[XB_TMO], 1u); break; } } } } while (0)

struct XcdBarrier {
    unsigned* bar; unsigned x;
    volatile LAS unsigned* st;
    int wave;
};

__device__ __forceinline__ XcdBarrier xcd_barrier_post(unsigned* bar, volatile LAS unsigned* st, int wave) {
    XcdBarrier b; b.bar = bar; b.x = xb_xcc_id(); b.st = st; b.wave = wave;
    if (wave == 0 && mk_lane() == 0) (void)xb_add(&bar[XB_XCNT(b.x)], 1u);
    return b;
}
__device__ __forceinline__ void xcd_barrier_complete(unsigned* bar, unsigned x, unsigned& nloc, unsigned& nx) {
    const unsigned G = gridDim.x * gridDim.y * gridDim.z;
    unsigned sum, cnt, mine, sp = 0u;
    for (;;) {
        sum = 0u; cnt = 0u; mine = 0u;
#pragma unroll
        for (unsigned j = 0; j < 16; ++j) { const unsigned c = xb_ld(&bar[XB_XCNT(j)]); sum += c; cnt += (c > 0u) ? 1u : 0u; mine = (j == x) ? c : mine; }
        if (sum == G) break;
        __builtin_amdgcn_s_sleep(1);
        if ((++sp & 255u) == 0u) { if (xb_ld(&bar[XB_TMO])) break; if (sp > XB_SPIN_CAP) { atomicAdd(&bar[XB_TMO], 1u); break; } }
    }
    nloc = mine > 0u ? mine : 1u; nx = cnt > 0u ? cnt : 1u;
}

__device__ __forceinline__ void xcd_barrier(const XcdBarrier& b) {
    asm volatile("s_waitcnt vmcnt(0)" ::: "memory");
    __syncthreads();
    if (b.wave == 0 && mk_lane() == 0) {
        unsigned* bar = b.bar;
        __builtin_amdgcn_s_waitcnt(0);
        unsigned nloc = b.st[0], nx = b.st[1];
        if (nloc == 0u) { xcd_barrier_complete(bar, b.x, nloc, nx); b.st[0] = nloc; b.st[1] = nx; }
        const unsigned old = xb_add(&bar[XB_XSUB(b.x)], 1u);
        const unsigned gen = old / nloc;
        if (old + 1u == (gen + 1u) * nloc) {
            __builtin_amdgcn_fence(__ATOMIC_RELEASE, "agent");
            asm volatile("s_waitcnt vmcnt(0)" ::: "memory");
            const unsigned og = xb_add(&bar[XB_TOP], 1u);
            const unsigned tg = og / nx;
            if (og + 1u == (tg + 1u) * nx) xb_add(&bar[XB_TOPGEN], 1u);
            else XB_SPIN(xb_ld(&bar[XB_TOPGEN]) == tg, bar);
            __builtin_amdgcn_fence(__ATOMIC_ACQUIRE, "agent");
            xb_add(&bar[XB_XGEN(b.x)], 1u);
            asm volatile("s_waitcnt vmcnt(0)" ::: "memory");
        } else {
            XB_SPIN(xb_ld(&bar[XB_XGEN(b.x)]) == gen, bar);
            __builtin_amdgcn_fence(__ATOMIC_ACQUIRE, "agent");
            asm volatile("s_waitcnt vmcnt(0)" ::: "memory");
        }
    }
    __syncthreads();
}
struct Frame {
    LAS unsigned char* lds;
    volatile LAS unsigned* MISC;
    gu32* ctl;
    int tid, lane, wave;
    int vcu, G;
    const float* x; float* out;
    const float *norm_g, *w_in, *shift_mu, *w0, *w_decay_up, *a0, *w_iclr_up, *k_k, *k_a, *r_k, *ln_w, *ln_b, *qn_g, *kn_g, *lq1, *lk1, *lq2, *lk2, *subln_g, *w_out;
    bf16 *WinT, *WoutT, *WdT, *WaT, *XN, *PROJ, *MIX;
};

typedef float f32x2q_t __attribute__((ext_vector_type(2))); typedef __bf16 bf16x2q_t __attribute__((ext_vector_type(2)));
__device__ __forceinline__ unsigned cvtpk2(float lo, float hi) { f32x2q_t v = {lo, hi}; bf16x2q_t b = __builtin_convertvector(v, bf16x2q_t); return __builtin_bit_cast(unsigned, b); }
__device__ __forceinline__ float wave_sum(float v) {
#pragma unroll
    for (int o = 1; o < 64; o <<= 1) v += __shfl_xor(v, o);
    return v;
}
template <int CTRL> __device__ __forceinline__ float dpp_f(float x) { return __builtin_bit_cast(float, __builtin_amdgcn_mov_dpp(__builtin_bit_cast(int, x), CTRL, 0xf, 0xf, true)); }
__device__ __forceinline__ float row16_sum(float x) {
    x += dpp_f<0xB1>(x); x += dpp_f<0x4E>(x); x += dpp_f<0x141>(x); x += dpp_f<0x140>(x); return x;
}
__device__ __forceinline__ float swap32_sum(float x) {
    auto rr = __builtin_amdgcn_permlane32_swap(__float_as_uint(x), __float_as_uint(x), false, false);
    return __uint_as_float(rr[0]) + __uint_as_float(rr[1]);
}

__device__ __forceinline__ void p0_transpose_item(const float* W, int N, int nsrc, const float* kscale, bf16* WT, int K, int ndst, LAS float* scr, int k0, int lane) {
    float v[32];
#pragma unroll
    for (int i = 0; i < 32; ++i) { const int kk = 2 * i + (lane >> 5); v[i] = (nsrc >= 0) ? W[(size_t)(k0 + kk) * N + nsrc + (lane & 31)] : 0.f; }
    if (kscale && nsrc >= 0) {
#pragma unroll
        for (int i = 0; i < 32; ++i) v[i] *= kscale[k0 + 2 * i + (lane >> 5)];
    }
#pragma unroll
    for (int i = 0; i < 32; ++i) scr[(2 * i + (lane >> 5)) * 33 + (lane & 31)] = v[i];
    LDS_WAIT(); asm volatile("" ::: "memory");
    const int c = lane & 7;
#pragma unroll
    for (int j = 0; j < 4; ++j) { const int n = (lane >> 3) + 8 * j; const LAS float* s = scr + (8 * c) * 33 + n;
        v4u o; o.x = cvtpk2(s[0 * 33], s[1 * 33]); o.y = cvtpk2(s[2 * 33], s[3 * 33]); o.z = cvtpk2(s[4 * 33], s[5 * 33]); o.w = cvtpk2(s[6 * 33], s[7 * 33]);
        *(GAS v4u*)(WT + (size_t)(ndst + n) * K + k0 + 8 * c) = o; }
    LDS_WAIT(); asm volatile("" ::: "memory");
}
__device__ __forceinline__ void p0_rows4(Frame& F, int m0) {
    f32x4 v[4][4]; float s[4];
#pragma unroll
    for (int u = 0; u < 4; ++u) { const GAS f32x4* xr = (const GAS f32x4*)(F.x + (size_t)(m0 + u) * D) + F.lane;
#pragma unroll
        for (int j = 0; j < 4; ++j) v[u][j] = __builtin_nontemporal_load(xr + 64 * j); }
#pragma unroll
    for (int u = 0; u < 4; ++u) { float a = 0.f;
#pragma unroll
        for (int j = 0; j < 4; ++j) a += (v[u][j].x * v[u][j].x + v[u][j].y * v[u][j].y) + (v[u][j].z * v[u][j].z + v[u][j].w * v[u][j].w);
        s[u] = a; }
#pragma unroll
    for (int u = 0; u < 4; ++u) {
        const float rstd = __builtin_amdgcn_rsqf(wave_sum(s[u]) * (1.f / D) + 1e-6f);
        GAS unsigned long long* o8 = (GAS unsigned long long*)(F.XN + (size_t)(m0 + u) * D) + F.lane;
#pragma unroll
        for (int j = 0; j < 4; ++j) o8[64 * j] = (unsigned long long)cvtpk2(v[u][j].x * rstd, v[u][j].y * rstd) | ((unsigned long long)cvtpk2(v[u][j].z * rstd, v[u][j].w * rstd) << 32);
    }
}
__device__ __forceinline__ void p0_prologue(Frame& F) {
    LAS float* scr = (LAS float*)(F.lds + RING_OFF + F.wave * 16384);
    const int gw = F.vcu * NWAVES + F.wave, NGW = F.G * NWAVES;
    constexpr int I_IN = (D / 64) * (NP / 32), I_OUT = (D / 64) * (D / 32), I_L = 512 / 32;
    constexpr int NITEMS = I_IN + I_OUT + 2 * I_L;
    int m0 = gw * 4;
    if (!(gw & 1) && m0 < M) { p0_rows4(F, m0); m0 += NGW * 4; }
#pragma unroll 1
    for (int it = gw; it < NITEMS; it += NGW) {
        int r = it;
        if (r < I_IN) { const int kb = r / (NP / 32), nb = r % (NP / 32), nd = 32 * nb; const int ns = nd < 1664 ? nd : (nd < 1792 ? -1 : nd - 128);
            p0_transpose_item(F.w_in, 4224, ns, F.norm_g, F.WinT, D, nd, scr, 64 * kb, F.lane); continue; } r -= I_IN;
        if (r < I_OUT) { const int kb = r / (D / 32), nb = r % (D / 32);
            p0_transpose_item(F.w_out, D, 32 * nb, nullptr, F.WoutT, D, 32 * nb, scr, 64 * kb, F.lane); continue; } r -= I_OUT;
        if (r < I_L) { p0_transpose_item(F.w_decay_up, 512, 32 * r, nullptr, F.WdT, 64, 32 * r, scr, 0, F.lane); continue; } r -= I_L;
        p0_transpose_item(F.w_iclr_up, 512, 32 * r, nullptr, F.WaT, 64, 32 * r, scr, 0, F.lane);
    }
#pragma unroll 1
    for (; m0 < M; m0 += NGW * 4) p0_rows4(F, m0);
}

__device__ __forceinline__ float tanh_f(float x) { const float e = __expf(-2.f * fabsf(x)); const float t = (1.f - e) * __builtin_amdgcn_rcpf(1.f + e); return x < 0.f ? -t : t; }
__device__ __forceinline__ void shifted8(const bf16* proj, size_t m, bool has_prev, int col, const float* mu, float (&o)[8]) {
    const v4u c = *(const GAS v4u*)(proj + m * NP + col);
    v4u p = (v4u){0u, 0u, 0u, 0u}; if (has_prev) p = *(const GAS v4u*)(proj + (m - 1) * NP + col);
    const f32x4 m0 = *(const GAS f32x4*)(mu), m1 = *(const GAS f32x4*)(mu + 4);
    const unsigned cw[4] = {c.x, c.y, c.z, c.w}, pw[4] = {p.x, p.y, p.z, p.w}; const float mm[8] = {m0.x, m0.y, m0.z, m0.w, m1.x, m1.y, m1.z, m1.w};
#pragma unroll
    for (int j = 0; j < 4; ++j) { const float c0 = bflo(cw[j]), c1 = bfhi(cw[j]), p0 = bflo(pw[j]), p1 = bfhi(pw[j]);
        o[2 * j] = c0 + (p0 - c0) * mm[2 * j]; o[2 * j + 1] = c1 + (p1 - c1) * mm[2 * j + 1]; }
}
__device__ __forceinline__ void shifted4(const bf16* proj, size_t m, bool has_prev, int col, const float* mu, float (&o)[4]) {
    const v2u c = *(const GAS v2u*)(proj + m * NP + col);
    v2u p = (v2u){0u, 0u}; if (has_prev) p = *(const GAS v2u*)(proj + (m - 1) * NP + col);
    const f32x4 m0 = *(const GAS f32x4*)(mu);
    o[0] = bflo(c.x) + (bflo(p.x) - bflo(c.x)) * m0.x; o[1] = bfhi(c.x) + (bfhi(p.x) - bfhi(c.x)) * m0.y;
    o[2] = bflo(c.y) + (bflo(p.y) - bflo(c.y)) * m0.z; o[3] = bfhi(c.y) + (bfhi(p.y) - bfhi(c.y)) * m0.w;
}
__device__ __forceinline__ void p2_qknorm(Frame& F) {
    const int gw = F.vcu * NWAVES + F.wave, NGW = F.G * NWAVES, lane = F.lane, sub = lane & 7;
    const f32x4 gq0 = *(const GAS f32x4*)(F.qn_g + sub * 8), gq1 = *(const GAS f32x4*)(F.qn_g + sub * 8 + 4), gk0 = *(const GAS f32x4*)(F.kn_g + sub * 8), gk1 = *(const GAS f32x4*)(F.kn_g + sub * 8 + 4);
    constexpr int UQ = 4;
    for (int it0 = gw * UQ; it0 < 2 * M; it0 += NGW * UQ) {
        bf16* p[UQ]; v4u c[UQ];
#pragma unroll
        for (int u = 0; u < UQ; ++u) { const int it = it0 + u; const size_t m = (size_t)(it >> 1); p[u] = F.PROJ + m * NP + ((it & 1) ? C_DK : C_DQ) + (lane >> 3) * 64 + sub * 8; c[u] = *(const GAS v4u*)p[u]; }
#pragma unroll
        for (int u = 0; u < UQ; ++u) {
            const int isk = (it0 + u) & 1; const unsigned cw[4] = {c[u].x, c[u].y, c[u].z, c[u].w};
            float xv[8]; float ss = 0.f;
#pragma unroll
            for (int j = 0; j < 4; ++j) { xv[2 * j] = bflo(cw[j]); xv[2 * j + 1] = bfhi(cw[j]); ss += xv[2 * j] * xv[2 * j] + xv[2 * j + 1] * xv[2 * j + 1]; }
            ss += dpp_f<0xB1>(ss); ss += dpp_f<0x4E>(ss); ss += dpp_f<0x141>(ss);
            const float r = __builtin_amdgcn_rsqf(ss * (1.f / 64.f) + 1e-6f) * (isk ? 1.f : C2);
            const f32x4 g0 = isk ? gk0 : gq0, g1 = isk ? gk1 : gq1;
            v4u o; o.x = cvtpk2(xv[0] * r * g0.x, xv[1] * r * g0.y); o.y = cvtpk2(xv[2] * r * g0.z, xv[3] * r * g0.w); o.z = cvtpk2(xv[4] * r * g1.x, xv[5] * r * g1.y); o.w = cvtpk2(xv[6] * r * g1.z, xv[7] * r * g1.w);
            *(GAS v4u*)p[u] = o;
        }
    }
}
typedef float f32x2_t __attribute__((ext_vector_type(2))); typedef __bf16 bf16x2_t __attribute__((ext_vector_type(2)));
__device__ __forceinline__ unsigned cvtpk(float lo, float hi) { f32x2_t v = {lo, hi}; bf16x2_t b = __builtin_convertvector(v, bf16x2_t); return __builtin_bit_cast(unsigned, b); }
#define MFMA32(a, b, c) __builtin_amdgcn_mfma_f32_32x32x16_bf16(__builtin_bit_cast(bf16x8, (a)), __builtin_bit_cast(bf16x8, (b)), (c), 0, 0, 0)
#define FRAGACC(z, s) ((v4u){cvtpk((z)[8 * (s)], (z)[8 * (s) + 1]), cvtpk((z)[8 * (s) + 2], (z)[8 * (s) + 3]), cvtpk((z)[8 * (s) + 4], (z)[8 * (s) + 5]), cvtpk((z)[8 * (s) + 6], (z)[8 * (s) + 7])})
template <int CTRL, int RM> __device__ __forceinline__ float dpp_upd0(float x) { return __builtin_bit_cast(float, __builtin_amdgcn_update_dpp(0, __builtin_bit_cast(int, x), CTRL, RM, 0xf, false)); }
__device__ __forceinline__ float scan32(float x) {
    x += dpp_upd0<0x111, 0xf>(x); x += dpp_upd0<0x112, 0xf>(x); x += dpp_upd0<0x114, 0xf>(x); x += dpp_upd0<0x118, 0xf>(x); x += dpp_upd0<0x142, 0xa>(x); return x;
}
__device__ __forceinline__ void st_wt16(v4u* p, const v4u v) { *(GAS v4u*)p = v; }
constexpr int RW_UNITS = BATCH * RH * (T / 32);
struct RwDump { v4u* PF; v4u* DD; v4u* QF; v4u* YD; float* GAM; float* RHO; };

__device__ __forceinline__ void rwkvA_unit(Frame& F, const RwDump& Dm, int bh, int ci, LAS float* wscr, LAS unsigned char* park, LAS v4u* zsh, int zpar) {
    int lane = mk_lane(); asm volatile("" : "+v"(lane));
    const int hi = lane >> 5, l31 = lane & 31, b = bh >> 3, w = bh & 7;
    LAS v4u* pk = (LAS v4u*)park + lane;
#define PARK(slot) pk[(slot) * 64]
    int tok = 0; asm volatile("" : "+v"(tok));
#define DEP(x) asm volatile("" : "+v"(tok) : "v"(x))
    const int t = ci * 32 + l31; const size_t m = (size_t)b * T + t; const bool hp = t > 0;
    const int u = ci * (BATCH * RH) + bh;
    const float pm = hp ? 1.f : 0.f;
    const bf16* pc = F.PROJ + m * NP + w * 64 + 4 * hi; const bf16* pp = F.PROJ + (hp ? m - 1 : m) * NP + w * 64 + 4 * hi;
    const float* mu = F.shift_mu + w * 64 + 4 * hi;
    const float *pw0 = F.w0 + w * 64 + 4 * hi, *pa0 = F.a0 + w * 64 + 4 * hi, *pkk = F.k_k + w * 64 + 4 * hi, *pka = F.k_a + w * 64 + 4 * hi, *prk = F.r_k + w * 64 + 4 * hi;
#define SH4(dst, COL, MU, OFF) do { const v2u c_ = *(const GAS v2u*)(pc + tok + (COL) + (OFF)), p_ = *(const GAS v2u*)(pp + tok + (COL) + (OFF)); const f32x4 m_ = *(const GAS f32x4*)(mu + tok + (MU) + (OFF)); \
        dst[0] = bflo(c_.x) + (bflo(p_.x) * pm - bflo(c_.x)) * m_.x; dst[1] = bfhi(c_.x) + (bfhi(p_.x) * pm - bfhi(c_.x)) * m_.y; \
        dst[2] = bflo(c_.y) + (bflo(p_.y) * pm - bflo(c_.y)) * m_.z; dst[3] = bfhi(c_.y) + (bfhi(p_.y) * pm - bfhi(c_.y)) * m_.w; } while (0)
    float ss = 0.f;
#pragma unroll
    for (int gq = 0; gq < 8; ++gq) { float k4[4]; SH4(k4, C_K, 512, 8 * gq); const f32x4 kkp = *(const GAS f32x4*)(pkk + tok + 8 * gq);
#pragma unroll
        for (int e = 0; e < 4; ++e) { const float q = k4[e] * kkp[e]; ss += q * q; }
        if (gq == 3) DEP(ss); }
    ss = swap32_sum(ss);
    const float inv = __builtin_amdgcn_rcpf(fmaxf(__builtin_amdgcn_sqrtf(ss), 1e-12f));
    asm volatile("" ::: "memory");
    v4u bz[4], ba[4];
    { const int s = F.wave >> 1; const bool which = (F.wave & 1) != 0;
      const bf16* zc = F.PROJ + m * NP + 8 * hi; const bf16* zp = F.PROJ + (hp ? m - 1 : m) * NP + 8 * hi; const float* zmu = F.shift_mu + 8 * hi;
      const int COL = (which ? C_ZA : C_ZW) + 16 * s, MUO = (which ? 1600 : 1536) + 16 * s;
      const v4u c = *(const GAS v4u*)(zc + tok + COL), p = *(const GAS v4u*)(zp + tok + COL); const f32x4 m0 = *(const GAS f32x4*)(zmu + tok + MUO), m1 = *(const GAS f32x4*)(zmu + tok + MUO + 4);
      float z[8];
#pragma unroll
      for (int j = 0; j < 4; ++j) { const float c0 = bflo(c[j]), c1 = bfhi(c[j]); const float mm0 = j < 2 ? m0[2 * j] : m1[2 * j - 4], mm1 = j < 2 ? m0[2 * j + 1] : m1[2 * j - 3];
          z[2 * j] = c0 + (bflo(p[j]) * pm - c0) * mm0; z[2 * j + 1] = c1 + (bfhi(p[j]) * pm - c1) * mm1; }
      if (!which) {
#pragma unroll
          for (int j = 0; j < 8; ++j) z[j] = tanh_f(z[j]); }
      LAS v4u* zs = zsh + zpar * 512;
      zs[((which ? 4 : 0) + s) * 64 + lane] = (v4u){cvtpk(z[0], z[1]), cvtpk(z[2], z[3]), cvtpk(z[4], z[5]), cvtpk(z[6], z[7])};
      __syncthreads();
#pragma unroll
      for (int q = 0; q < 4; ++q) { bz[q] = zs[q * 64 + lane]; ba[q] = zs[(4 + q) * 64 + lane]; }
      DEP(bz[3][3]); DEP(ba[3][3]); }
    asm volatile("" ::: "memory");
    v4u fa[4], fb[4], fk[4], fr[4], fv[4]; float rho = 0.f;
    float* gp = Dm.GAM + (size_t)u * 64 + hi * 32;
#define RW_LORA(cb) f32x16 accd = f32x16{}, acca = f32x16{}; _Pragma("unroll") for (int s = 0; s < 4; ++s) { \
        const v4u aD = *(const GAS v4u*)(F.WdT + tok + (size_t)(w * 64 + (cb) * 32 + l31) * 64 + 16 * s + 8 * hi); accd = MFMA32(aD, bz[s], accd); \
        const v4u aA = *(const GAS v4u*)(F.WaT + tok + (size_t)(w * 64 + (cb) * 32 + l31) * 64 + 16 * s + 8 * hi); acca = MFMA32(aA, ba[s], acca); }
    struct RwGL { v2u rc, rp, kc, kp, vc, vp; } gA, gB;
#define RW_LOADG(X, OFF) do { X.rc = *(const GAS v2u*)(pc + tok + C_R + (OFF)); X.rp = *(const GAS v2u*)(pp + tok + C_R + (OFF)); X.kc = *(const GAS v2u*)(pc + tok + C_K + (OFF)); X.kp = *(const GAS v2u*)(pp + tok + C_K + (OFF)); \
        X.vc = *(const GAS v2u*)(pc + tok + C_V + (OFF)); X.vp = *(const GAS v2u*)(pp + tok + C_V + (OFF)); } while (0)
#define RW_LERP(dst, c_, p_, m_) do { dst[0] = bflo(c_.x) + (bflo(p_.x) * pm - bflo(c_.x)) * m_.x; dst[1] = bfhi(c_.x) + (bfhi(p_.x) * pm - bfhi(c_.x)) * m_.y; \
        dst[2] = bflo(c_.y) + (bflo(p_.y) * pm - bflo(c_.y)) * m_.z; dst[3] = bfhi(c_.y) + (bfhi(p_.y) * pm - bfhi(c_.y)) * m_.w; } while (0)
#define RW_GROUP(cb, rg, CUR, NXT, HASN) do { constexpr int OFF = 32 * (cb) + 8 * (rg); const int ch0 = OFF + 4 * hi; \
            if (HASN) RW_LOADG(NXT, OFF + 8); \
            float rr[4], kk4[4], vv[4]; \
            const f32x4 mr_ = *(const GAS f32x4*)(mu + tok + OFF), mk_ = *(const GAS f32x4*)(mu + tok + 512 + OFF), mv_ = *(const GAS f32x4*)(mu + tok + 1024 + OFF); \
            const f32x4 w0v = *(const GAS f32x4*)(pw0 + tok + OFF), a0v = *(const GAS f32x4*)(pa0 + tok + OFF), kkp = *(const GAS f32x4*)(pkk + tok + OFF), kap = *(const GAS f32x4*)(pka + tok + OFF), rkp = *(const GAS f32x4*)(prk + tok + OFF); \
            RW_LERP(rr, CUR.rc, CUR.rp, mr_); RW_LERP(kk4, CUR.kc, CUR.kp, mk_); RW_LERP(vv, CUR.vc, CUR.vp, mv_); \
            float xa[4], xb[4], xk[4], xr[4], gg[4], ge[4]; \
            _Pragma("unroll") for (int e = 0; e < 4; ++e) { \
                const float nx = -(w0v[e] + accd[4 * (rg) + e]); const float sp = fmaxf(nx, 0.f) + __logf(1.f + __expf(-fabsf(nx))); \
                const float l2 = -__expf(-sp - 0.5f) * LOG2E; \
                const float g = scan32(l2); \
                const float a = __builtin_amdgcn_rcpf(1.f + __expf(-(a0v[e] + acca[4 * (rg) + e]))); \
                const float kk = kk4[e] * kkp[e] * inv; \
                const float kt = kk4[e] * (1.f + (a - 1.f) * kap[e]); \
                rho += rr[e] * kt * rkp[e]; \
                const float eg = __builtin_amdgcn_exp2f(g), egp = __builtin_amdgcn_exp2f(g - l2), eng = __builtin_amdgcn_rcpf(eg); \
                xa[e] = -kk * egp; xb[e] = kk * a * eng; xk[e] = kt * eng; xr[e] = rr[e] * eg; gg[e] = g; ge[e] = eg; } \
            if (l31 == 31) { *(LAS f32x4*)(wscr + ch0) = (f32x4){gg[0], gg[1], gg[2], gg[3]}; st_wt16((v4u*)(gp + (cb) * 16 + 4 * (rg)), (v4u){__float_as_uint(ge[0]), __float_as_uint(ge[1]), __float_as_uint(ge[2]), __float_as_uint(ge[3])}); } \
            constexpr int s_ = 2 * (cb) + ((rg) >> 1), vg = 2 * ((rg) & 1); \
            fa[s_][vg] = cvtpk(xa[0], xa[1]); fa[s_][vg + 1] = cvtpk(xa[2], xa[3]); \
            fb[s_][vg] = cvtpk(xb[0], xb[1]); fb[s_][vg + 1] = cvtpk(xb[2], xb[3]); \
            fk[s_][vg] = cvtpk(xk[0], xk[1]); fk[s_][vg + 1] = cvtpk(xk[2], xk[3]); \
            fr[s_][vg] = cvtpk(xr[0], xr[1]); fr[s_][vg + 1] = cvtpk(xr[2], xr[3]); \
            fv[s_][vg] = cvtpk(vv[0], vv[1]); fv[s_][vg + 1] = cvtpk(vv[2], vv[3]); \
            if (((rg) & 1) == 1) { PARK(s_) = fv[s_]; PARK(4 + s_) = fr[s_]; } \
            DEP(fa[s_][vg + 1]); DEP(fb[s_][vg + 1]); DEP(fk[s_][vg + 1]); DEP(fr[s_][vg + 1]); DEP(fv[s_][vg + 1]); DEP(rho); } while (0)
    RW_LOADG(gA, 0);
    { RW_LORA(0) RW_GROUP(0, 0, gA, gB, true); RW_GROUP(0, 1, gB, gA, true); RW_GROUP(0, 2, gA, gB, true); RW_GROUP(0, 3, gB, gA, true); }
    { RW_LORA(1) RW_GROUP(1, 0, gA, gB, true); RW_GROUP(1, 1, gB, gA, true); RW_GROUP(1, 2, gA, gB, true); RW_GROUP(1, 3, gB, gA, false); }
#undef RW_LOADG
#undef RW_LERP
#undef RW_LORA
#undef RW_GROUP
#undef SH4
    LDS_WAIT(); asm volatile("" ::: "memory");
    float EC[2]; EC[0] = __builtin_amdgcn_exp2f(wscr[l31]); EC[1] = __builtin_amdgcn_exp2f(wscr[32 + l31]);
    LDS_WAIT(); asm volatile("" ::: "memory");
    rho = swap32_sum(rho);
    if (hi == 0) __hip_atomic_store((gu32*)(Dm.RHO + (size_t)u * 32 + l31), __float_as_uint(rho), RLX_AGENT);
    v4u idf[2];
    { const int jst = 4 * ((l31 >> 3) & 1) + (l31 & 3); const bool hm = ((l31 >> 2) & 1) == hi; const unsigned one = 0x3F80u << (16 * (jst & 1));
#pragma unroll
      for (int sig = 0; sig < 2; ++sig) { const bool on = hm && ((l31 >> 4) == sig);
#pragma unroll
          for (int q = 0; q < 4; ++q) idf[sig][q] = (on && (jst >> 1) == q) ? one : 0u; } }
    LDS_WAIT();
    v4u Af[2][2], Vf[2][2];
#pragma unroll
    for (int blk = 0; blk < 2; ++blk) {
        f32x16 za = MFMA32(fa[2 * blk], idf[0], f32x16{}); za = MFMA32(fa[2 * blk + 1], idf[1], za);
        f32x16 zv = MFMA32(PARK(2 * blk), idf[0], f32x16{}); zv = MFMA32(PARK(2 * blk + 1), idf[1], zv);
        f32x16 zb = MFMA32(fb[2 * blk], idf[0], f32x16{}); zb = MFMA32(fb[2 * blk + 1], idf[1], zb);
        f32x16 zk = MFMA32(fk[2 * blk], idf[0], f32x16{}); zk = MFMA32(fk[2 * blk + 1], idf[1], zk);
        zb = zb * EC[blk]; zk = zk * EC[blk];
#pragma unroll
        for (int s = 0; s < 2; ++s) { Af[blk][s] = FRAGACC(za, s); Vf[blk][s] = FRAGACC(zv, s); PARK(8 + 2 * blk + s) = FRAGACC(zb, s); PARK(12 + 2 * blk + s) = FRAGACC(zk, s); }
        __builtin_amdgcn_sched_barrier(0);
    }
    f32x16 Aab = f32x16{}, TT = f32x16{}, AakT = f32x16{}, ArbT = f32x16{}, ArkT = f32x16{};
#pragma unroll
    for (int s = 0; s < 4; ++s) { const v4u frs = PARK(4 + s); Aab = MFMA32(fa[s], fb[s], Aab); TT = MFMA32(fb[s], fa[s], TT); AakT = MFMA32(fk[s], fa[s], AakT); ArbT = MFMA32(fb[s], frs, ArbT); ArkT = MFMA32(fk[s], frs, ArkT); }
#pragma unroll
    for (int r = 0; r < 16; ++r) { const int rowi = (r & 3) + 8 * (r >> 2) + 4 * hi;
        Aab[r] = (l31 < rowi) ? Aab[r] : 0.f; TT[r] = (rowi < l31) ? TT[r] : 0.f; AakT[r] = (rowi < l31) ? AakT[r] : 0.f;
        ArbT[r] = (rowi <= l31) ? ArbT[r] : 0.f; ArkT[r] = (rowi <= l31) ? ArkT[r] : 0.f; }
    v4u AakTf[2], ArbTf[2], ArkTf[2];
#pragma unroll
    for (int s = 0; s < 2; ++s) { AakTf[s] = FRAGACC(AakT, s); ArbTf[s] = FRAGACC(ArbT, s); ArkTf[s] = FRAGACC(ArkT, s); }
    __builtin_amdgcn_sched_barrier(0);
    v4u Xf[2], XTf[2], TTf[2];
#pragma unroll
    for (int s = 0; s < 2; ++s) { Xf[s] = FRAGACC(Aab, s); XTf[s] = FRAGACC(TT, s); }
#pragma unroll
    for (int r = 0; r < 16; ++r) { const int rowi = (r & 3) + 8 * (r >> 2) + 4 * hi; TT[r] += (rowi == l31) ? 1.f : 0.f; }
#pragma unroll
    for (int it = 0; it < 4; ++it) {
        f32x16 X2 = MFMA32(XTf[0], Xf[0], f32x16{}); X2 = MFMA32(XTf[1], Xf[1], X2);
        if (it < 3) { f32x16 X2T = MFMA32(Xf[0], XTf[0], f32x16{}); X2T = MFMA32(Xf[1], XTf[1], X2T);
#pragma unroll
            for (int s = 0; s < 2; ++s) XTf[s] = FRAGACC(X2T, s); }
#pragma unroll
        for (int s = 0; s < 2; ++s) { Xf[s] = FRAGACC(X2, s); TTf[s] = FRAGACC(TT, s); }
        TT = MFMA32(Xf[0], TTf[0], TT); TT = MFMA32(Xf[1], TTf[1], TT);
        __builtin_amdgcn_sched_barrier(0);
    }
#pragma unroll
    for (int s = 0; s < 2; ++s) TTf[s] = FRAGACC(TT, s);
    v4u Wf[2][2], Uf[2][2];
#pragma unroll
    for (int blk = 0; blk < 2; ++blk) {
        f32x16 av = MFMA32(AakTf[0], Vf[blk][0], f32x16{}); av = MFMA32(AakTf[1], Vf[blk][1], av);
        const v4u avf0 = FRAGACC(av, 0), avf1 = FRAGACC(av, 1);
        f32x16 uu = MFMA32(TTf[0], avf0, f32x16{}); uu = MFMA32(TTf[1], avf1, uu);
        f32x16 ww = MFMA32(TTf[0], Af[blk][0], f32x16{}); ww = MFMA32(TTf[1], Af[blk][1], ww);
#pragma unroll
        for (int s = 0; s < 2; ++s) { Wf[blk][s] = FRAGACC(ww, s); Uf[blk][s] = FRAGACC(uu, s); }
        __builtin_amdgcn_sched_barrier(0);
    }
    v4u* QFp = Dm.QF + (size_t)u * 256 + lane; v4u* YDp = Dm.YD + (size_t)u * 256 + lane;
#pragma unroll
    for (int blk = 0; blk < 2; ++blk) {
        f32x16 q;
#pragma unroll
        for (int s = 0; s < 2; ++s)
            { const v4u frs = PARK(4 + 2 * blk + s);
#pragma unroll
              for (int j = 0; j < 4; ++j) { q[8 * s + 2 * j] = bflo(frs[j]); q[8 * s + 2 * j + 1] = bfhi(frs[j]); } }
        q = MFMA32(Wf[blk][0], ArbTf[0], q); q = MFMA32(Wf[blk][1], ArbTf[1], q);
        st_wt16(QFp + (2 * blk) * 64, FRAGACC(q, 0)); st_wt16(QFp + (2 * blk + 1) * 64, FRAGACC(q, 1));
        f32x16 y = MFMA32(Uf[blk][0], ArbTf[0], f32x16{}); y = MFMA32(Uf[blk][1], ArbTf[1], y); y = MFMA32(Vf[blk][0], ArkTf[0], y); y = MFMA32(Vf[blk][1], ArkTf[1], y);
        st_wt16(YDp + (2 * blk) * 64, FRAGACC(y, 0)); st_wt16(YDp + (2 * blk + 1) * 64, FRAGACC(y, 1));
        __builtin_amdgcn_sched_barrier(0);
    }
    v4u* PFp = Dm.PF + (size_t)u * 512 + lane; v4u* DDp = Dm.DD + (size_t)u * 512 + lane;
#pragma unroll
    for (int c1 = 0; c1 < 2; ++c1)
#pragma unroll
        for (int cb = 0; cb < 2; ++cb) {
            f32x16 p = MFMA32(Wf[c1][0], PARK(8 + 2 * cb), f32x16{}); p = MFMA32(Wf[c1][1], PARK(8 + 2 * cb + 1), p);
            st_wt16(PFp + (cb * 4 + 2 * c1) * 64, FRAGACC(p, 0)); st_wt16(PFp + (cb * 4 + 2 * c1 + 1) * 64, FRAGACC(p, 1));
            __builtin_amdgcn_sched_barrier(0);
        }
#pragma unroll
    for (int cb = 0; cb < 2; ++cb)
#pragma unroll
        for (int ib = 0; ib < 2; ++ib) {
            f32x16 d = MFMA32(PARK(8 + 2 * cb), Uf[ib][0], f32x16{}); d = MFMA32(PARK(8 + 2 * cb + 1), Uf[ib][1], d); d = MFMA32(PARK(12 + 2 * cb), Vf[ib][0], d); d = MFMA32(PARK(12 + 2 * cb + 1), Vf[ib][1], d);
            st_wt16(DDp + ((cb * 2 + ib) * 2) * 64, FRAGACC(d, 0)); st_wt16(DDp + ((cb * 2 + ib) * 2 + 1) * 64, FRAGACC(d, 1));
            __builtin_amdgcn_sched_barrier(0);
        }
}

#undef PARK
#undef DEP
constexpr int RB_PF = 0, RB_DD = 8192, RB_QF = 16384, RB_YD = 20480, RB_GAM = 24576, RB_BUF = 24832, RB_STAT = 2 * RB_BUF, RB_Y = RB_STAT + 1024;
__device__ __forceinline__ void unpack16(const v4u a, const v4u b, f32x16& o) {
#pragma unroll
    for (int j = 0; j < 4; ++j) { o[2 * j] = bflo(a[j]); o[2 * j + 1] = bfhi(a[j]); o[8 + 2 * j] = bflo(b[j]); o[8 + 2 * j + 1] = bfhi(b[j]); }
}
constexpr int RW_SPLIT = T / 32, CW_DONE = 16384;
__device__ __forceinline__ void rw_wait_chunk(Frame& F, int ci) {
    unsigned spins = 0;
#pragma unroll 1
    for (int j = 7; j >= 0; --j) { gu32* c = F.ctl + CW_DONE + 64 * (ci + j);
        while ((unsigned)__builtin_amdgcn_readfirstlane(__hip_atomic_load(c, RLX_AGENT)) < (unsigned)BATCH) { __builtin_amdgcn_s_sleep(8); if (++spins > (1u << 22)) break; } }
    __builtin_amdgcn_fence(__ATOMIC_ACQUIRE, "agent");
}
__device__ __forceinline__ void rw_publish_chunk(Frame& F, int ci) {
    asm volatile("s_waitcnt vmcnt(0)" ::: "memory");
    __syncthreads();
    if (F.wave == 0 && mk_lane() == 0) {
        __hip_atomic_fetch_add(F.ctl + CW_DONE + 64 * ci, 1u, RLX_AGENT);
    }
}
struct RbStage { v4u p[2], d[2], q, y, g; };
struct RbEpi { v2u vc[2], vp[2], ga[2]; float rho; };
__device__ __forceinline__ void rwkvB_unit(Frame& F, const RwDump& Dm, int bh) {
    int lane = mk_lane(); asm volatile("" : "+v"(lane));
    const int wid = F.wave, tid = wid * 64 + lane, hi = lane >> 5, l31 = lane & 31, b = bh >> 3, h = bh & 7;
    LAS unsigned char* lds = F.lds + RING_OFF;
    constexpr int NS = T / 32;
    LAS float* stat = (LAS float*)(lds + RB_STAT);
    LAS float* ybuf = (LAS float*)(lds + RB_Y);
    const int stid = tid - 128;
    const bool st_p2 = wid < 4, st_q = wid < 6, st_y = wid >= 4;
#define ST_LOAD(X, ci_) do { { if ((ci_) >= RW_SPLIT && (ci_) < NS && (((ci_) - RW_SPLIT) & 7) == 0) rw_wait_chunk(F, (ci_)); const size_t u_ = (size_t)((ci_) < NS ? (ci_) : NS - 1) * (BATCH * RH) + bh; \
        X.p[0] = __builtin_nontemporal_load((const GAS v4u*)(Dm.PF + u_ * 512 + stid)); X.d[0] = __builtin_nontemporal_load((const GAS v4u*)(Dm.DD + u_ * 512 + stid)); \
        if (st_p2) { X.p[1] = __builtin_nontemporal_load((const GAS v4u*)(Dm.PF + u_ * 512 + 384 + stid)); X.d[1] = __builtin_nontemporal_load((const GAS v4u*)(Dm.DD + u_ * 512 + 384 + stid)); } \
        if (st_q) X.q = __builtin_nontemporal_load((const GAS v4u*)(Dm.QF + u_ * 256 + stid)); \
        if (st_y) X.y = __builtin_nontemporal_load((const GAS v4u*)(Dm.YD + u_ * 256 + (stid - 128))); \
        if (stid < 16) X.g = *(const GAS v4u*)((const v4u*)(Dm.GAM + u_ * 64) + stid); } } while (0)
#define ST_STORE(X, buf_) do { LAS unsigned char* b_ = lds + (buf_) * RB_BUF; \
        *(LAS v4u*)(b_ + RB_PF + stid * 16) = X.p[0]; *(LAS v4u*)(b_ + RB_DD + stid * 16) = X.d[0]; \
        if (st_p2) { *(LAS v4u*)(b_ + RB_PF + (384 + stid) * 16) = X.p[1]; *(LAS v4u*)(b_ + RB_DD + (384 + stid) * 16) = X.d[1]; } \
        if (st_q) *(LAS v4u*)(b_ + RB_QF + stid * 16) = X.q; \
        if (st_y) *(LAS v4u*)(b_ + RB_YD + (stid - 128) * 16) = X.y; \
        if (stid < 16) *(LAS v4u*)(b_ + RB_GAM + stid * 16) = X.g; } while (0)
    const int eib = wid & 1, eh = (wid >> 2) & 1;
    const bf16* epc = F.PROJ + (size_t)b * T * NP + h * 64 + 32 * eib + 16 * eh + 4 * hi;
#define EP_LOAD(X, cj_) do { { const int tt_ = ((cj_) < NS ? (cj_) : NS - 1) * 32 + l31; const bf16* pc_ = epc + (size_t)tt_ * NP; const bf16* pp_ = epc + (size_t)(tt_ > 0 ? tt_ - 1 : 0) * NP; \
        _Pragma("unroll") for (int rg = 0; rg < 2; ++rg) { X.vc[rg] = *(const GAS v2u*)(pc_ + C_V + 8 * rg); X.vp[rg] = *(const GAS v2u*)(pp_ + C_V + 8 * rg); X.ga[rg] = *(const GAS v2u*)(pc_ + C_GA + 8 * rg); } \
        X.rho = Dm.RHO[((size_t)((cj_) < NS ? (cj_) : NS - 1) * (BATCH * RH) + bh) * 32 + l31]; } } while (0)
#define EP_RUN(X, cj_) do { const int par_ = (cj_) & 1; \
        const float s1_ = stat[((par_ * 2 + 0) * 32 + l31) * 2] + stat[((par_ * 2 + 1) * 32 + l31) * 2], s2_ = stat[((par_ * 2 + 0) * 32 + l31) * 2 + 1] + stat[((par_ * 2 + 1) * 32 + l31) * 2 + 1]; \
        const float mean_ = s1_ * (1.f / 64.f), var_ = fmaxf(s2_ * (1.f / 64.f) - mean_ * mean_, 0.f), rstd_ = __builtin_amdgcn_rsqf(var_ + 64e-5f); \
        const int tt_ = (cj_) * 32 + l31; const size_t mm_ = (size_t)b * T + tt_; const float pm_ = tt_ > 0 ? 1.f : 0.f; \
        const LAS float* yb_ = ybuf + (par_ * 2 + eib) * 1024 + lane; \
        _Pragma("unroll") for (int rg = 0; rg < 2; ++rg) { const int hc_ = h * 64 + 32 * eib + 16 * eh + 8 * rg + 4 * hi; \
            const f32x4 mu_ = emu[rg], lw_ = elw[rg], lb_ = elb[rg]; \
            const float vc_[4] = {bflo(X.vc[rg].x), bfhi(X.vc[rg].x), bflo(X.vc[rg].y), bfhi(X.vc[rg].y)}, vp_[4] = {bflo(X.vp[rg].x), bfhi(X.vp[rg].x), bflo(X.vp[rg].y), bfhi(X.vp[rg].y)}; \
            const float g4_[4] = {bflo(X.ga[rg].x), bfhi(X.ga[rg].x), bflo(X.ga[rg].y), bfhi(X.ga[rg].y)}; float o_[4]; \
            _Pragma("unroll") for (int e = 0; e < 4; ++e) { const float vv_ = vc_[e] + (vp_[e] * pm_ - vc_[e]) * mu_[e]; \
                const float yn_ = (yb_[(4 * (2 * eh + rg) + e) * 64] - mean_) * rstd_ * lw_[e] + lb_[e] + X.rho * vv_; o_[e] = yn_ * g4_[e] * __builtin_amdgcn_rcpf(1.f + __expf(-g4_[e])); } \
            *(GAS v2u*)(F.MIX + mm_ * D + hc_) = (v2u){cvtpk(o_[0], o_[1]), cvtpk(o_[2], o_[3])}; } } while (0)
    f32x16 S[2]; S[0] = f32x16{}; S[1] = f32x16{};
    const int ib = wid & 1;
#define CONS(ci_) do { const LAS unsigned char* bb = lds + ((ci_) & 1) * RB_BUF; \
          \
        v4u pf_[8], qf_[4], dd_[4], yd_[2]; f32x4 gm_[8]; \
        _Pragma("unroll") for (int q = 0; q < 8; ++q) gm_[q] = *(const LAS f32x4*)(bb + RB_GAM + (hi * 32 + 4 * q) * 4); \
        _Pragma("unroll") for (int q = 0; q < 4; ++q) dd_[q] = *(const LAS v4u*)(bb + RB_DD + ((((q >> 1) * 2 + ib) * 2 + (q & 1)) * 64 + lane) * 16); \
        _Pragma("unroll") for (int q = 0; q < 8; ++q) pf_[q] = *(const LAS v4u*)(bb + RB_PF + (q * 64 + lane) * 16); \
        _Pragma("unroll") for (int q = 0; q < 2; ++q) yd_[q] = *(const LAS v4u*)(bb + RB_YD + ((2 * ib + q) * 64 + lane) * 16); \
        _Pragma("unroll") for (int q = 0; q < 4; ++q) qf_[q] = *(const LAS v4u*)(bb + RB_QF + (q * 64 + lane) * 16); \
        __builtin_amdgcn_sched_barrier(0); \
        v4u Sf[4]; _Pragma("unroll") for (int s = 0; s < 4; ++s) Sf[s] = FRAGACC(S[s >> 1], s & 1); \
        _Pragma("unroll") for (int rb = 0; rb < 2; ++rb) { \
            f32x16 acc; unpack16(dd_[2 * rb], dd_[2 * rb + 1], acc); \
            _Pragma("unroll") for (int q = 0; q < 4; ++q) { const f32x4 gv = gm_[4 * rb + q]; _Pragma("unroll") for (int e = 0; e < 4; ++e) acc[4 * q + e] += gv[e] * S[rb][4 * q + e]; } \
            _Pragma("unroll") for (int s = 0; s < 4; ++s) acc = MFMA32(pf_[rb * 4 + s], Sf[s], acc); \
            S[rb] = acc; } \
        f32x16 y; unpack16(yd_[0], yd_[1], y); \
        _Pragma("unroll") for (int s = 0; s < 4; ++s) y = MFMA32(Sf[s], qf_[s], y); \
        float s1 = 0.f, s2 = 0.f; LAS float* yb_ = ybuf + (((ci_) & 1) * 2 + ib) * 1024 + lane; \
        _Pragma("unroll") for (int r = 0; r < 16; ++r) { s1 += y[r]; s2 += y[r] * y[r]; yb_[r * 64] = y[r]; } \
        s1 = swap32_sum(s1); s2 = swap32_sum(s2); \
        if (hi == 0) { stat[((((ci_) & 1) * 2 + ib) * 32 + l31) * 2] = s1; stat[((((ci_) & 1) * 2 + ib) * 32 + l31) * 2 + 1] = s2; } } while (0)
#define RB_BAR() do { asm volatile("s_waitcnt lgkmcnt(0)" ::: "memory"); __builtin_amdgcn_s_barrier(); asm volatile("" ::: "memory"); } while (0)
    if (wid < 2) {
        RB_BAR();
#pragma unroll 1
        for (int k = 0; k < NS; ++k) { CONS(k); RB_BAR(); }
        RB_BAR();
    } else {
        const bool epi = (wid != 4 && wid != 5);
        RbStage sA, sB, sC; RbEpi eA, eB, eC; f32x4 emu[2], elw[2], elb[2];
#pragma unroll
        for (int rg = 0; rg < 2; ++rg) { const int hc_ = h * 64 + 32 * eib + 16 * eh + 8 * rg + 4 * hi; emu[rg] = *(const GAS f32x4*)(F.shift_mu + 1024 + hc_); elw[rg] = *(const GAS f32x4*)(F.ln_w + hc_); elb[rg] = *(const GAS f32x4*)(F.ln_b + hc_); }
        ST_LOAD(sA, 0); ST_LOAD(sB, 1); ST_LOAD(sC, 2); ST_STORE(sA, 0); ST_LOAD(sA, 3);
        if (epi) { EP_LOAD(eA, 0); EP_LOAD(eB, 1); }
        RB_BAR();
        ST_STORE(sB, 1); ST_LOAD(sB, 4); if (epi) EP_LOAD(eC, 2); RB_BAR();
#define HY_STEP(k_, SN, EP) do { ST_STORE(SN, ((k_) + 1) & 1); ST_LOAD(SN, (k_) + 4); if (epi) { EP_RUN(EP, (k_) - 1); EP_LOAD(EP, (k_) + 2); } RB_BAR(); } while (0)
#pragma unroll 1
        for (int k = 1; k < NS; k += 3) { HY_STEP(k, sC, eA); HY_STEP(k + 1, sA, eB); HY_STEP(k + 2, sB, eC); }
        if (epi) EP_RUN(eA, NS - 1);
        RB_BAR();
#undef HY_STEP
    }
#undef RB_BAR
#undef ST_LOAD
#undef ST_STORE
#undef EP_LOAD
#undef EP_RUN
#undef CONS
}
constexpr int CW_G17 = 12288;
struct OneUnit { int pm, pn;
    __device__ __forceinline__ bool next(int i, pg8::Unit& u) const { if (i != 0) return false; u.pm = pm; u.pn = pn; return true; }
    __device__ __forceinline__ void a_ready(const pg8::Unit&) const {}
    __device__ __forceinline__ void done(const pg8::Unit&) const {} };
constexpr int AT_KB = 64 * 256, AT_VB = 64 * 256, AT_BUF = AT_KB + AT_VB, AT_QOFF = 2 * AT_KB + 3 * AT_VB;
__device__ __forceinline__ s16x4 vtr(const LAS unsigned char* p) { typedef short v4i16_t __attribute__((ext_vector_type(4))); return __builtin_bit_cast(s16x4, __builtin_amdgcn_ds_read_tr16_b64_v4i16((LAS v4i16_t*)p)); }
__device__ __forceinline__ void attn_unit(Frame& F, int b, int h, int qb) {
    int lane = mk_lane(); asm volatile("" : "+v"(lane));
    const int wid = F.wave, tid = wid * 64 + lane, l31 = lane & 31, hi = lane >> 5, map = wid >> 2, qs = wid & 3;
    LAS unsigned char* lds = F.lds + RING_OFF;
    const float slope2 = exp2f(-2.f * (float)(h + 1)) * LOG2E, shift2 = __uint_as_float(F.MISC[15]);
    const int q0 = qb * 128, qrow = q0 + 32 * qs + l31;
    const size_t mrow = (size_t)b * T + qrow;
    LAS bf16x8* qpark = (LAS bf16x8*)(lds + AT_QOFF + wid * 4096) + lane;
    { const bf16* qp = F.PROJ + mrow * NP + C_DQ + h * 128 + map * 64 + 8 * hi;
#pragma unroll
      for (int s = 0; s < 4; ++s) qpark[s * 64] = *(const GAS bf16x8*)(qp + 16 * s); }
    const bf16* kg = F.PROJ + (size_t)b * T * NP + C_DK + h * 128;
    const bf16* vg = F.PROJ + (size_t)b * T * NP + C_DV + h * 128;
    const int NT = 2 * qb + 2, tl = 2 * qb + (qs >> 1);
    const int Wk = (int)__builtin_ceilf((2.f * shift2 + 32.2f) / slope2);
    const int tf = __builtin_amdgcn_readfirstlane(max(0, (qb * 128 - Wk) >> 6));
    constexpr int AT_V0 = 2 * AT_KB;
    const int drow0 = 4 * wid + (lane >> 4), drow1 = drow0 + 32, dch = lane & 15;
    const unsigned ksrc0 = (unsigned)(drow0 * NP + ((dch ^ (drow0 & 15)) * 8)), ksrc1 = (unsigned)(drow1 * NP + ((dch ^ (drow1 & 15)) * 8));
    const unsigned vsrc0 = (unsigned)(drow0 * NP + ((dch ^ ((drow0 & 3) << 2)) * 8)), vsrc1 = (unsigned)(drow1 * NP + ((dch ^ ((drow1 & 3) << 2)) * 8));
#define AT_DMA(t_, kb_, v3_) do { const size_t tb_ = (size_t)(64 * (t_)) * NP; LAS unsigned char* bk_ = lds + (kb_) * AT_KB + wid * 1024; LAS unsigned char* bv_ = lds + AT_V0 + (v3_) * AT_VB + wid * 1024; \
        __builtin_amdgcn_global_load_lds((const unsigned*)(kg + tb_ + ksrc0), (LAS unsigned*)bk_, 16, 0, 0); __builtin_amdgcn_global_load_lds((const unsigned*)(kg + tb_ + ksrc1), (LAS unsigned*)(bk_ + 8192), 16, 0, 0); \
        __builtin_amdgcn_global_load_lds((const unsigned*)(vg + tb_ + vsrc0), (LAS unsigned*)bv_, 16, 0, 0); __builtin_amdgcn_global_load_lds((const unsigned*)(vg + tb_ + vsrc1), (LAS unsigned*)(bv_ + 8192), 16, 0, 0); } while (0)
    f32x16 o[4];
#pragma unroll
    for (int vb = 0; vb < 4; ++vb) o[vb] = f32x16{};
    float lsum = 0.f;
    AT_DMA(tf, tf & 1, tf % 3);
    __syncthreads();
    const int G = lane >> 4, qq = (lane & 15) >> 2, pp = lane & 3;
    const int vrow = (4 * hi + qq) * 256 + 8 * (pp & 1), vch = 2 * (G & 1) + (pp >> 1);
    v4u pw[4];
#define SBAR_() __builtin_amdgcn_sched_barrier(0)
#define AT_QK(t) do { \
            const LAS unsigned char* Kb = lds + ((t) & 1) * AT_KB; \
            float sl_ = slope2; asm volatile("" : "+v"(sl_));     \
            const float base = sl_ * (float)(64 * (t) + 4 * hi - qrow) - shift2; \
            float ls = 0.f; \
            _Pragma("unroll") for (int hf = 0; hf < 2; ++hf) {        \
                f32x16 p; \
                _Pragma("unroll") for (int r = 0; r < 16; ++r) p[r] = __builtin_fmaf(sl_, (float)(32 * hf + (r & 3) + 8 * (r >> 2)), base); \
                _Pragma("unroll") for (int s = 0; s < 4; ++s) { \
                    const bf16x8 a0 = *(const LAS bf16x8*)(Kb + (32 * hf + l31) * 256 + (((map * 8 + 2 * s + hi) ^ (l31 & 15)) * 16)); \
                    p = __builtin_amdgcn_mfma_f32_32x32x16_bf16(a0, qpark[s * 64], p, 0, 0, 0); } \
                if ((t) == tl) { \
                    _Pragma("unroll") for (int r = 0; r < 16; ++r) { const int ki = 64 * (t) + 32 * hf + 4 * hi + (r & 3) + 8 * (r >> 2); if (ki > qrow) p[r] = -1e30f; } } \
                _Pragma("unroll") for (int r = 0; r < 16; ++r) { p[r] = __builtin_amdgcn_exp2f(p[r]); ls += p[r]; } \
                pw[2 * hf] = (v4u){cvtpk(p[0], p[1]), cvtpk(p[2], p[3]), cvtpk(p[4], p[5]), cvtpk(p[6], p[7])}; \
                pw[2 * hf + 1] = (v4u){cvtpk(p[8], p[9]), cvtpk(p[10], p[11]), cvtpk(p[12], p[13]), cvtpk(p[14], p[15])}; } \
            lsum += ls; } while (0)
#define AT_VRD(dst, ks, vb0) do { _Pragma("unroll") for (int vb = (vb0); vb < (vb0) + 2; ++vb) { const LAS unsigned char* a_ = Vb + vrow + ((4 * vb + vch) ^ (qq << 2)) * 16 + (32 * ((ks) >> 1) + 16 * ((ks) & 1)) * 256; \
        dst[2 * (vb - (vb0))] = vtr(a_); dst[2 * (vb - (vb0)) + 1] = vtr(a_ + 8 * 256); } } while (0)
#define AT_PV(src, pwk, vb0) do { _Pragma("unroll") for (int vb = (vb0); vb < (vb0) + 2; ++vb) { const int j_ = 2 * (vb - (vb0)); \
        const bf16x8 vf = (bf16x8){src[j_][0], src[j_][1], src[j_][2], src[j_][3], src[j_ + 1][0], src[j_ + 1][1], src[j_ + 1][2], src[j_ + 1][3]}; \
        o[vb] = __builtin_amdgcn_mfma_f32_32x32x16_bf16(vf, __builtin_bit_cast(bf16x8, pwk), o[vb], 0, 0, 0); } } while (0)
#define AT_PVV(v3_) do { const LAS unsigned char* Vb = lds + AT_V0 + (v3_) * AT_VB; s16x4 vA[4], vB[4]; \
            AT_VRD(vA, 0, 0); SBAR_(); AT_VRD(vB, 0, 2); SBAR_(); \
            AT_PV(vA, pw[0], 0); SBAR_(); AT_VRD(vA, 1, 0); SBAR_(); AT_PV(vB, pw[0], 2); SBAR_(); AT_VRD(vB, 1, 2); SBAR_(); \
            AT_PV(vA, pw[1], 0); SBAR_(); AT_VRD(vA, 2, 0); SBAR_(); AT_PV(vB, pw[1], 2); SBAR_(); AT_VRD(vB, 2, 2); SBAR_(); \
            AT_PV(vA, pw[2], 0); SBAR_(); AT_VRD(vA, 3, 0); SBAR_(); AT_PV(vB, pw[2], 2); SBAR_(); AT_VRD(vB, 3, 2); SBAR_(); \
            AT_PV(vA, pw[3], 0); SBAR_(); AT_PV(vB, pw[3], 2); } while (0)
    if (map == 0) {
        int v3 = tf % 3;
#pragma unroll 1
        for (int t = tf; t < NT; ++t) { const int vn = v3 == 2 ? 0 : v3 + 1;
            if (t + 1 < NT) AT_DMA(t + 1, (t + 1) & 1, vn);
            if (t <= tl) { AT_QK(t); AT_PVV(v3); }
            __syncthreads(); v3 = vn; }
    } else {
        int v3 = tf % 3;
#pragma unroll 1
        for (int t = tf; t < NT; ++t) { const int vp = v3 == 0 ? 2 : v3 - 1, vn = v3 == 2 ? 0 : v3 + 1;
            if (t + 1 < NT) AT_DMA(t + 1, (t + 1) & 1, vn);
            if (t > tf && t - 1 <= tl) AT_PVV(vp);
            if (t <= tl) AT_QK(t);
            __syncthreads(); v3 = vn; }
        if (NT - 1 <= tl) { const int vp = v3 == 0 ? 2 : v3 - 1; AT_PVV(vp); }
    }
#undef AT_PVV
#undef AT_QK
#undef AT_VRD
#undef AT_PV
#undef SBAR_
#undef AT_DMA
    __syncthreads();
    const float ltot = swap32_sum(lsum);
    LAS float* X = (LAS float*)lds;
    if (map == 1) {
        const float sc = __uint_as_float(F.MISC[14]) / ltot;
#pragma unroll
        for (int vb = 0; vb < 4; ++vb)
#pragma unroll
            for (int r = 0; r < 16; ++r) X[(qs * 64 + vb * 16 + r) * 64 + lane] = o[vb][r] * sc;
    }
    __syncthreads();
    if (map == 0) {
        const float il = 1.f / ltot; float ss = 0.f;
#pragma unroll
        for (int vb = 0; vb < 4; ++vb)
#pragma unroll
            for (int r = 0; r < 16; ++r) { const float v = o[vb][r] * il - X[(qs * 64 + vb * 16 + r) * 64 + lane]; o[vb][r] = v; ss += v * v; }
        ss = swap32_sum(ss);
        const float rn = (1.f / sqrtf(ss * (1.f / 128.f) + 1e-5f)) * (1.f - LAMBDA_INIT);
        int etok = 0; asm volatile("" : "+v"(etok));
        const int lane_e = mk_lane(), hi = lane_e >> 5;
        const size_t mrow_e = (size_t)b * T + qb * 128 + 32 * qs + (lane_e & 31);
        const bf16* gp = F.PROJ + mrow_e * NP + C_GB + h * 128;
        bf16* op = F.MIX + mrow_e * D + 512 + h * 128;
#pragma unroll
        for (int vb = 0; vb < 4; ++vb)
#pragma unroll
            for (int rg = 0; rg < 4; ++rg) {
                const int vc = 32 * vb + 8 * rg + 4 * hi + etok;
                const v2u gw = *(const GAS v2u*)(gp + vc); const f32x4 sg = *(const GAS f32x4*)(F.subln_g + vc);
                const float g4[4] = {bflo(gw.x), bfhi(gw.x), bflo(gw.y), bfhi(gw.y)}; float ov[4];
#pragma unroll
                for (int e = 0; e < 4; ++e) ov[e] = o[vb][4 * rg + e] * rn * sg[e] * g4[e] / (1.f + __expf(-g4[e]));
                const unsigned w1_ = cvtpk(ov[2], ov[3]);
                *(GAS v2u*)(op + vc) = (v2u){cvtpk(ov[0], ov[1]), w1_};
                asm volatile("" : "+v"(etok) : "v"(w1_));
            }
    }
    __syncthreads();
}
#ifndef DBL
#define DBL 0
#endif
constexpr int CW_QUEUE = 8192;
constexpr int QX_RW = 8, QX_A2 = 0, QX_AT = 64, QX_ALL = QX_RW + QX_A2 + QX_AT;
__device__ __forceinline__ void p3_queue(Frame& F, const RwDump& Dm, const int qbase = CW_QUEUE) {
    const int ql = mk_lane();
    const float l1 = wave_sum(F.lq1[ql] * F.lk1[ql]), l2 = wave_sum(F.lq2[ql] * F.lk2[ql]);
    const float lam = __uint_as_float(__builtin_amdgcn_readfirstlane(__float_as_uint(__expf(l1) - __expf(l2) + LAMBDA_INIT)));
    float gq = fabsf(F.qn_g[ql]), gk = fabsf(F.kn_g[ql]);
#pragma unroll
    for (int o = 1; o < 64; o <<= 1) { gq = fmaxf(gq, __shfl_xor(gq, o)); gk = fmaxf(gk, __shfl_xor(gk, o)); }
    const float shift2 = __uint_as_float(__builtin_amdgcn_readfirstlane(__float_as_uint(8.f * gq * gk * LOG2E)));
    if (F.wave == 0 && mk_lane() == 0) { F.MISC[14] = __float_as_uint(lam); F.MISC[15] = __float_as_uint(shift2); }
    __syncthreads();
#ifdef Q_BLK
    const int x0 = (int)(blockIdx.x & 7);
#else
    const int x0 = (int)(xb_xcc_id() & 7u);
#endif
#pragma unroll 1
    for (int dx = 0; dx < 8; ++dx) {
        const int xq = (x0 + dx) & 7;
        for (;;) {
            if (F.wave == 0 && mk_lane() == 0) F.MISC[12] = __hip_atomic_fetch_add(F.ctl + qbase + 64 * xq, 1u, RLX_AGENT);
            __syncthreads();
            const int item = __builtin_amdgcn_readfirstlane((int)F.MISC[12]);
            __syncthreads();
            if (item >= QX_ALL) break;
            if (item < QX_RW) { rwkvB_unit(F, Dm, xq * 8 + item); if (DBL & 64) rwkvB_unit(F, Dm, xq * 8 + item); }
            else { const int idx = item - QX_RW - QX_A2, h = 3 - (idx >> 4), qb = 15 - (idx & 15);
#pragma unroll 1
#ifndef NO_ATT
                for (int rep = 0; rep < ((DBL & 32) ? 2 : 1); ++rep) attn_unit(F, xq, h, qb);
#endif
            }
        }
    }
}

struct Args { const float* in[21]; float* out; unsigned char* ws; int ph_lo, ph_hi; };
__global__ void __launch_bounds__(NWAVES * 64, 2) hymba_fwd(Args args) {
    extern __shared__ __attribute__((aligned(16))) unsigned char lds[];
    Frame F;
    F.lds = (LAS unsigned char*)lds;
    F.MISC = (volatile LAS unsigned*)(F.lds + MISC_OFF);
    F.wave = __builtin_amdgcn_readfirstlane((int)threadIdx.x >> 6); F.lane = mk_lane(); F.tid = F.wave * 64 + F.lane;
    F.G = gridDim.x; { const int bx = blockIdx.x; F.vcu = (F.G % 8 == 0) ? (bx % 8) * (F.G / 8) + bx / 8 : bx; }
    unsigned char* ws = args.ws;
    F.ctl = (gu32*)(ws + WS_CTL);
    F.x = args.in[0]; F.norm_g = args.in[1]; F.w_in = args.in[2]; F.shift_mu = args.in[3]; F.w0 = args.in[4]; F.w_decay_up = args.in[5]; F.a0 = args.in[6]; F.w_iclr_up = args.in[7];
    F.k_k = args.in[8]; F.k_a = args.in[9]; F.r_k = args.in[10]; F.ln_w = args.in[11]; F.ln_b = args.in[12]; F.qn_g = args.in[13]; F.kn_g = args.in[14];
    F.lq1 = args.in[15]; F.lk1 = args.in[16]; F.lq2 = args.in[17]; F.lk2 = args.in[18]; F.subln_g = args.in[19]; F.w_out = args.in[20]; F.out = args.out;
    F.WinT = (bf16*)(ws + WS_WIN); F.WoutT = (bf16*)(ws + WS_WOUT); F.WdT = (bf16*)(ws + WS_WD); F.WaT = (bf16*)(ws + WS_WA);
    F.XN = (bf16*)(ws + WS_XN); F.PROJ = (bf16*)(ws + WS_PROJ); F.MIX = (bf16*)(ws + WS_MIX);
    for (int u = F.tid; u < (LDS_BYTES - LDSCTL_OFF) / 4; u += NWAVES * 64) ((LAS unsigned*)(F.lds + LDSCTL_OFF))[u] = 0u;
    __syncthreads();
    XcdBarrier bar; bar.bar = (unsigned*)(F.ctl + CW_BAR); bar.x = 0; bar.st = nullptr; bar.wave = F.wave;
    if (MK_N_LAUNCHES == 1) bar = xcd_barrier_post((unsigned*)(F.ctl + CW_BAR), F.MISC + 8, F.wave);
#define GRID_BAR() do { if (MK_N_LAUNCHES == 1) xcd_barrier(bar); } while (0)
    const int lo = args.ph_lo, hi = args.ph_hi;
#define IN(k) (lo <= (k) && (k) < hi)
#define BOTH(k) (IN(k) && IN((k) + 1))
#ifndef SKIP
#define SKIP 0
#endif
    if (IN(0) && !(SKIP & 1)) { p0_prologue(F); if (DBL & 1) { GRID_BAR(); p0_prologue(F); } if (BOTH(0)) GRID_BAR(); }
    if (IN(1) && !(SKIP & 2)) {
        pg8::Gemm g{F.XN, F.WinT, M, NP, D}; pg8::StaticOrder S; S.init(M, NP, F.G, (int)blockIdx.x);
        pg8::EpiBf16S E{F.PROJ, NP};
        pg8::gemm_phase<pg8::EpiBf16S, pg8::StaticOrder, true, true>(F.lds + RING_OFF, g, S, E, F.wave);
        if (DBL & 2) { GRID_BAR(); pg8::gemm_phase<pg8::EpiBf16S, pg8::StaticOrder, true, true>(F.lds + RING_OFF, g, S, E, F.wave); }
        if (BOTH(1)) GRID_BAR();
    }
    RwDump Dm; { unsigned char* so = (unsigned char*)args.out; Dm.PF = (v4u*)so; Dm.DD = (v4u*)(so + 32 * MiB); Dm.QF = (v4u*)(ws + WS_XN); Dm.YD = (v4u*)(ws + WS_XN + 16 * MiB);
        Dm.GAM = (float*)(ws + WS_END); Dm.RHO = (float*)(ws + WS_END + 1 * MiB); }
    if (IN(2) && !(SKIP & 4)) {
        LAS float* wscr = (LAS float*)(F.lds + LDSCTL_OFF + 1024) + F.wave * 64; int zpar = 0;
#pragma unroll 1
        for (int p = F.vcu; p < BATCH * (T / 32); p += F.G) { rwkvA_unit(F, Dm, (p >> 6) * RH + F.wave, p & 63, wscr, F.lds + RING_OFF + F.wave * 16384, (LAS v4u*)(F.lds + LDSCTL_OFF + 4096), zpar); zpar ^= 1; }
        if (DBL & 4) { GRID_BAR();
#pragma unroll 1
            for (int p = F.vcu; p < BATCH * (T / 32); p += F.G) { rwkvA_unit(F, Dm, (p >> 6) * RH + F.wave, p & 63, wscr, F.lds + RING_OFF + F.wave * 16384, (LAS v4u*)(F.lds + LDSCTL_OFF + 4096), zpar); zpar ^= 1; } }
        p2_qknorm(F);
        if (BOTH(2)) GRID_BAR();
    }
    if (IN(3) && !(SKIP & 8)) {
        p3_queue(F, Dm);
        if (DBL & 512) { GRID_BAR(); p3_queue(F, Dm, CW_QUEUE + 1024); }
        if (BOTH(3)) GRID_BAR();
    }
    if (IN(4) && !(SKIP & 16)) {
        pg8::Gemm g{F.MIX, F.WoutT, M, D, D}; pg8::StaticOrder S; S.init(M, D, F.G, (int)blockIdx.x);
        pg8::EpiResF32 E{F.x, F.out, D};
        pg8::gemm_phase<pg8::EpiResF32, pg8::StaticOrder, false, true>(F.lds + RING_OFF, g, S, E, F.wave);
        if (DBL & 16) { GRID_BAR(); pg8::gemm_phase<pg8::EpiResF32, pg8::StaticOrder, false, true>(F.lds + RING_OFF, g, S, E, F.wave); }
    }
#undef IN
#undef BOTH
}

extern "C" void kernel_launch(void* const* d_in, const int* in_sizes, int n_in, void* d_out, int out_size, void* d_ws, size_t ws_size, hipStream_t stream) {
    static int grid = 0;
    if (grid == 0) {
        if (n_in != 21 || in_sizes[0] != M * D || out_size != M * D || ws_size < WS_END + 2 * MiB) { fprintf(stderr, "kernel_launch: unexpected shapes (n_in %d, in0 %d, out %d, ws %zu); nothing launched\n", n_in, n_in > 0 ? in_sizes[0] : -1, out_size, ws_size); grid = -1; return; }
        int dev = 0, cus = 0, per_cu = 0;
        if (hipGetDevice(&dev) != hipSuccess || hipDeviceGetAttribute(&cus, hipDeviceAttributeMultiprocessorCount, dev) != hipSuccess) { grid = -1; return; }
        if (hipFuncSetAttribute((const void*)hymba_fwd, hipFuncAttributeMaxDynamicSharedMemorySize, LDS_BYTES) != hipSuccess) { fprintf(stderr, "kernel_launch: hipFuncSetAttribute failed\n"); grid = -1; return; }
        if (hipOccupancyMaxActiveBlocksPerMultiprocessor(&per_cu, (const void*)hymba_fwd, NWAVES * 64, LDS_BYTES) != hipSuccess || per_cu < 1) { fprintf(stderr, "kernel_launch: occupancy query reports %d workgroups per CU; nothing launched\n", per_cu); grid = -1; return; }
        (void)hipGetLastError();
        grid = cus;
        if (grid > 256) grid = 256;
    }
    if (grid < 0) return;
    if (hipMemsetAsync((char*)d_ws + WS_CTL, 0, CTL_ZERO_BYTES, stream) != hipSuccess) { fprintf(stderr, "kernel_launch: hipMemsetAsync failed\n"); return; }
    Args a{};
    for (int i = 0; i < 21; ++i) a.in[i] = (const float*)d_in[i];
    a.out = (float*)d_out; a.ws = (unsigned char*)d_ws;
    for (int li = 0; li < MK_N_LAUNCHES; ++li) {
        a.ph_lo = (MK_N_LAUNCHES == 1) ? 0 : li; a.ph_hi = (MK_N_LAUNCHES == 1) ? N_PHASES : li + 1;
        hipLaunchKernelGGL(hymba_fwd, dim3(grid), dim3(NWAVES * 64), LDS_BYTES, stream, a);
        const hipError_t le = hipPeekAtLastError();
        if (le != hipSuccess) { fprintf(stderr, "kernel_launch: launch %d failed: %s\n", li, hipGetErrorName(le)); break; }
    }
}
```

```cpp
#include <hip/hip_runtime.h>
#include <hip/hip_bf16.h>
#include <cstdio>
#include <cstdint>
#include <cmath>
namespace pg8 {
#define PG8_LAS __attribute__((address_space(3)))
typedef unsigned short bf16_t;
typedef short bf16x8 __attribute__((ext_vector_type(8)));
typedef float f32x4 __attribute__((ext_vector_type(4)));
typedef unsigned u32x4 __attribute__((ext_vector_type(4)));
constexpr int BM = 256, BK = 64, HALF = 128, HTB = HALF * BK * 2  , STAGE_BYTES = 8 * HTB, NXCD = 8, WGM = 8;

__host__ __device__ __forceinline__ int lds_byte(int r, int c) { const int st = (r >> 4) * 2 + (c >> 5), rr = r & 15, cc = c & 31, ob = rr * 64 + cc * 2; return st * 1024 + (ob ^ (((ob >> 9) & 1) << 5)); }
__host__ __device__ __forceinline__ void stage_rc(int b, int& R, int& C) { const int st = b / 1024, sb = b % 1024, swz = sb ^ (((sb >> 9) & 1) << 5); R = (st >> 1) * 16 + swz / 64; C = (st & 1) * 32 + (swz % 64) / 2; }
__host__ __device__ __forceinline__ int perm32(int rho) { const int n = rho >> 4, i = rho & 15; return 8 * (i >> 2) + 4 * n + (i & 3); }

__device__ __forceinline__ int mk_lane_pg8() { int l; asm volatile("v_mbcnt_lo_u32_b32 %0, -1, 0\n\tv_mbcnt_hi_u32_b32 %0, -1, %0" : "=v"(l)); return l; }
struct Unit { int pm, pn; };
struct Gemm { const bf16_t* A; const bf16_t* Bt; int M, N, K; };

struct StaticOrder {
    int nM, nN, nwg, G, c;
    __host__ __device__ void init(int M, int N, int G_, int c_) { nM = M / BM; nN = N / BM; nwg = nM * nN; G = G_; c = c_; }
    __host__ __device__ bool next(int i, Unit& u) const {
        const long L = (long)i * G + c; if (L >= nwg) return false;
        int wgid = (int)L; { const int q = nwg / NXCD, r = nwg % NXCD, xcd = wgid % NXCD, off = wgid / NXCD; wgid = (xcd < r ? xcd * (q + 1) : r * (q + 1) + (xcd - r) * q) + off; }
        const int nig = WGM * nN, gid = wgid / nig, fm = gid * WGM, gsz = (nM - fm) < WGM ? (nM - fm) : WGM;
        u.pm = fm + ((wgid % nig) % gsz); u.pn = (wgid % nig) / gsz; return true;
    }
    __device__ __forceinline__ void a_ready(const Unit&) const {}
    __device__ __forceinline__ void done(const Unit&) const {}
};

__device__ __forceinline__ unsigned cvt_pk_bf16(float lo, float hi) { unsigned r; asm volatile("v_cvt_pk_bf16_f32 %0, %1, %2" : "=v"(r) : "v"(lo), "v"(hi)); return r; }
struct EpiBf16S {
    static constexpr bool PERM = true, AFTER_DRAIN = false;
    bf16_t* O; int ldc;
    __device__ __forceinline__ void operator()(const f32x4 (&acc)[2][2][4][2], const Unit& u, int wr, int wc, int fr, int fq) const {
        const int row0 = u.pm * BM + wr * 64 + fr, col0 = u.pn * BM + wc * 32 + 8 * fq;
#pragma unroll
        for (int ai = 0; ai < 2; ++ai)
#pragma unroll
            for (int m = 0; m < 4; ++m) { bf16_t* rowp = O + (size_t)(row0 + ai * HALF + m * 16) * ldc + col0;
#pragma unroll
                for (int bj = 0; bj < 2; ++bj) { const f32x4 v0 = acc[ai][bj][m][0], v1 = acc[ai][bj][m][1];
                    u32x4 w; w.x = cvt_pk_bf16(v0[0], v0[1]); w.y = cvt_pk_bf16(v0[2], v0[3]); w.z = cvt_pk_bf16(v1[0], v1[1]); w.w = cvt_pk_bf16(v1[2], v1[3]);
                    *(u32x4*)(rowp + bj * HALF) = w; } }
    }
};
struct EpiResF32 {
    static constexpr bool PERM = false, AFTER_DRAIN = false;
    const float* base; float* out; int ldc;
    __device__ __forceinline__ void operator()(const f32x4 (&acc)[2][2][4][2], const Unit& u, int wr, int wc, int fr, int fq) const {
        const int row0 = u.pm * BM + wr * 64 + fr, col0 = u.pn * BM + wc * 32 + 4 * fq;
#pragma unroll
        for (int ai = 0; ai < 2; ++ai)
#pragma unroll
            for (int m = 0; m < 4; ++m) { const size_t off = (size_t)(row0 + ai * HALF + m * 16) * ldc + col0;
#pragma unroll
                for (int bj = 0; bj < 2; ++bj)
#pragma unroll
                    for (int n = 0; n < 2; ++n) { const f32x4 bs = *(const f32x4*)(base + off + bj * HALF + n * 16); *(f32x4*)(out + off + bj * HALF + n * 16) = bs + acc[ai][bj][m][n]; } }
    }
};
template <class Epi, class Sched, bool ALIGN_EPI = false, bool SP2 = false>
__device__ __forceinline__ void gemm_phase(PG8_LAS unsigned char* lds, const Gemm g, const Sched& S, const Epi& E, const int mk_wave_id  ) {
    const int wid = mk_wave_id, lane = mk_lane_pg8(), tid = wid * 64 + lane, wr = wid >> 2, wc = wid & 3, fr = lane & 15, fq = lane >> 4;
    const int K = g.K, nt = K / BK;
    unsigned voffA[2], voffB[2];
#pragma unroll
    for (int i = 0; i < 2; ++i) { int R, C; stage_rc(tid * 16 + i * 8192, R, C); const int Rb = Epi::PERM ? ((R & ~31) + perm32(R & 31)) : R;
        voffA[i] = (unsigned)(R * K + C) * 2u; voffB[i] = (unsigned)(Rb * K + C) * 2u; }
    const size_t kstep = (size_t)(BK * 2);
    const size_t hstep = (size_t)HALF * K * 2;
    const size_t tstep = 2 * hstep;
    const unsigned ldsw = (unsigned)wid * 1024u;
    const int aoff = lds_byte(wr * 64 + fr, fq * 8), boff = lds_byte(wc * 32 + fr, fq * 8);
#define PG8_SA(b, h) (((b) * 2 + (h)) * HTB)
#define PG8_SB(b, h) ((4 + (b) * 2 + (h)) * HTB)
#define PG8_STAGE(bufoff, gbase, voff) do { _Pragma("unroll") for (int _i = 0; _i < 2; ++_i) \
        __builtin_amdgcn_global_load_lds((const unsigned*)((const char*)(gbase) + (voff)[_i]), (PG8_LAS unsigned*)(lds + (bufoff) + ldsw + _i * 8192), 16, 0, 0); } while (0)
#define PG8_LDA(dst, b, h) do { _Pragma("unroll") for (int m = 0; m < 4; ++m) _Pragma("unroll") for (int k = 0; k < 2; ++k) dst[m][k] = *(const PG8_LAS bf16x8*)(lds + PG8_SA(b, h) + aoff + m * 2048 + k * 1024); } while (0)
#define PG8_LDB(dst, b, h) do { _Pragma("unroll") for (int n = 0; n < 2; ++n) _Pragma("unroll") for (int k = 0; k < 2; ++k) dst[n][k] = *(const PG8_LAS bf16x8*)(lds + PG8_SB(b, h) + boff + n * 2048 + k * 1024); } while (0)
#define PG8_MMA(ai, bj, At, Bt) do { __builtin_amdgcn_s_setprio(1); _Pragma("unroll") for (int m = 0; m < 4; ++m) _Pragma("unroll") for (int n = 0; n < 2; ++n) _Pragma("unroll") for (int k = 0; k < 2; ++k) \
        acc[ai][bj][m][n] = __builtin_amdgcn_mfma_f32_16x16x32_bf16(Bt[n][k], At[m][k], acc[ai][bj][m][n], 0, 0, 0); __builtin_amdgcn_s_setprio(0); } while (0)
#define PG8_WAIT_V(n) asm volatile("s_waitcnt vmcnt(" #n ")" ::: "memory")
#define PG8_WAIT_L(n) asm volatile("s_waitcnt lgkmcnt(" #n ")" ::: "memory")
#define PG8_BAR __builtin_amdgcn_s_barrier()
#define PG8_SCHED __builtin_amdgcn_sched_barrier(0)
    Unit cur, nxt; int ui = 0;
    if (!S.next(0, cur)) return;
    f32x4 acc[2][2][4][2];
#pragma unroll
    for (int a = 0; a < 2; ++a)
#pragma unroll
        for (int b = 0; b < 2; ++b)
#pragma unroll
            for (int m = 0; m < 4; ++m)
#pragma unroll
                for (int n = 0; n < 2; ++n) acc[a][b][m][n] = (f32x4){0.f, 0.f, 0.f, 0.f};
    bf16x8 At[4][2], B0[2][2], B1[2][2];
    const char* cA = (const char*)g.A + (size_t)cur.pm * tstep; const char* cB = (const char*)g.Bt + (size_t)cur.pn * tstep;
    S.a_ready(cur);
    if constexpr (SP2) {
        PG8_STAGE(PG8_SB(0, 0), cB, voffB); PG8_STAGE(PG8_SB(0, 1), cB + hstep, voffB); PG8_STAGE(PG8_SA(0, 0), cA, voffA); PG8_STAGE(PG8_SA(0, 1), cA + hstep, voffA);
        if (wr == 1) PG8_BAR;
        PG8_WAIT_V(2); PG8_BAR;
        PG8_STAGE(PG8_SB(1, 0), cB + kstep, voffB); PG8_STAGE(PG8_SA(1, 0), cA + kstep, voffA); PG8_STAGE(PG8_SB(1, 1), cB + hstep + kstep, voffB);
        PG8_WAIT_V(6); PG8_BAR;
    } else {
        PG8_STAGE(PG8_SB(0, 0), cB, voffB); PG8_STAGE(PG8_SA(0, 0), cA, voffA); PG8_STAGE(PG8_SB(0, 1), cB + hstep, voffB); PG8_STAGE(PG8_SA(0, 1), cA + hstep, voffA);
        if (wr == 1) PG8_BAR;
        PG8_WAIT_V(4); PG8_BAR;
        PG8_STAGE(PG8_SB(1, 0), cB + kstep, voffB); PG8_STAGE(PG8_SA(1, 0), cA + kstep, voffA); PG8_STAGE(PG8_SB(1, 1), cB + hstep + kstep, voffB);
        PG8_WAIT_V(6); PG8_BAR;
    }
    for (;;) {
        const bool has_next = S.next(ui + 1, nxt);
        const char* nA = has_next ? (const char*)g.A + (size_t)nxt.pm * tstep : cA; const char* nB = has_next ? (const char*)g.Bt + (size_t)nxt.pn * tstep : cB;
        for (int t = 0; t < nt; t += 2) {
            const bool last = (t == nt - 2);
            const char* a1 = cA + (size_t)(t + 1) * kstep;
            const char* a2 = last ? nA : cA + (size_t)(t + 2) * kstep; const char* b2 = last ? nB : cB + (size_t)(t + 2) * kstep;
            const char* a3 = a2 + kstep; const char* b3 = b2 + kstep;
            if (last && has_next) S.a_ready(nxt);
            if constexpr (SP2) {
            PG8_LDB(B0, 0, 0); PG8_LDB(B1, 0, 1); PG8_SCHED; PG8_LDA(At, 0, 0); PG8_STAGE(PG8_SA(1, 1), a1 + hstep, voffA);
            PG8_WAIT_V(8); PG8_WAIT_L(0); PG8_BAR; PG8_MMA(0, 0, At, B0); PG8_MMA(0, 1, At, B1); PG8_BAR; PG8_SCHED;
            PG8_LDA(At, 0, 1); PG8_STAGE(PG8_SB(0, 0), b2, voffB); PG8_STAGE(PG8_SB(0, 1), b2 + hstep, voffB); PG8_STAGE(PG8_SA(0, 0), a2, voffA);
            PG8_WAIT_V(8); PG8_WAIT_L(0); PG8_BAR; PG8_MMA(1, 0, At, B0); PG8_MMA(1, 1, At, B1); PG8_BAR; PG8_SCHED;
            PG8_LDB(B0, 1, 0); PG8_LDB(B1, 1, 1); PG8_SCHED; PG8_LDA(At, 1, 0); PG8_STAGE(PG8_SA(0, 1), a2 + hstep, voffA);
            PG8_WAIT_V(8); PG8_WAIT_L(0); PG8_BAR; PG8_MMA(0, 0, At, B0); PG8_MMA(0, 1, At, B1); PG8_BAR; PG8_SCHED;
            PG8_LDA(At, 1, 1); PG8_STAGE(PG8_SB(1, 0), b3, voffB); PG8_STAGE(PG8_SB(1, 1), b3 + hstep, voffB); PG8_STAGE(PG8_SA(1, 0), a3, voffA);
            PG8_WAIT_V(8); PG8_WAIT_L(0); PG8_BAR; PG8_MMA(1, 0, At, B0); PG8_MMA(1, 1, At, B1); PG8_BAR; PG8_SCHED;
            } else {
            PG8_LDB(B0, 0, 0); PG8_SCHED; PG8_LDA(At, 0, 0); PG8_STAGE(PG8_SA(1, 1), a1 + hstep, voffA);
            PG8_WAIT_L(8); PG8_BAR; PG8_WAIT_L(0); PG8_MMA(0, 0, At, B0); PG8_BAR; PG8_SCHED;
            PG8_LDB(B1, 0, 1); PG8_STAGE(PG8_SB(0, 0), b2, voffB);
            PG8_BAR; PG8_WAIT_L(0); PG8_MMA(0, 1, At, B1); PG8_BAR;
            PG8_LDA(At, 0, 1); PG8_STAGE(PG8_SA(0, 0), a2, voffA);
            PG8_BAR; PG8_WAIT_L(0); PG8_MMA(1, 0, At, B0); PG8_BAR; PG8_SCHED;
            PG8_STAGE(PG8_SB(0, 1), b2 + hstep, voffB);
            PG8_WAIT_V(6); PG8_BAR; PG8_MMA(1, 1, At, B1); PG8_BAR;
            PG8_LDB(B0, 1, 0); PG8_SCHED; PG8_LDA(At, 1, 0); PG8_STAGE(PG8_SA(0, 1), a2 + hstep, voffA);
            PG8_WAIT_L(8); PG8_BAR; PG8_WAIT_L(0); PG8_MMA(0, 0, At, B0); PG8_BAR; PG8_SCHED;
            PG8_LDB(B1, 1, 1); PG8_STAGE(PG8_SB(1, 0), b3, voffB);
            PG8_BAR; PG8_WAIT_L(0); PG8_MMA(0, 1, At, B1); PG8_BAR;
            PG8_LDA(At, 1, 1); PG8_STAGE(PG8_SA(1, 0), a3, voffA);
            PG8_BAR; PG8_WAIT_L(0); PG8_MMA(1, 0, At, B0); PG8_BAR; PG8_SCHED;
            PG8_STAGE(PG8_SB(1, 1), b3 + hstep, voffB);
            PG8_WAIT_V(6); PG8_BAR; PG8_MMA(1, 1, At, B1); PG8_BAR;
            }
        }
        if constexpr (ALIGN_EPI) { if (wr == 0) PG8_BAR; }
        if constexpr (!Epi::AFTER_DRAIN) { E(acc, cur, wr, wc, fr, fq); S.done(cur); }
        if (!has_next) break;
#pragma unroll
        for (int a = 0; a < 2; ++a)
#pragma unroll
            for (int b = 0; b < 2; ++b)
#pragma unroll
                for (int m = 0; m < 4; ++m)
#pragma unroll
                    for (int n = 0; n < 2; ++n) acc[a][b][m][n] = (f32x4){0.f, 0.f, 0.f, 0.f};
        cur = nxt; cA = nA; cB = nB; ++ui;
        if constexpr (ALIGN_EPI) { if (wr == 1) PG8_BAR; }
    }
    PG8_WAIT_V(0);
    if constexpr (!ALIGN_EPI) { if (wr == 0) PG8_BAR; }
    PG8_BAR;
    if constexpr (Epi::AFTER_DRAIN) { E.fused(acc, cur, wr, wc, fr, fq, lds, wid, lane); S.done(cur); }
#undef PG8_SA
#undef PG8_SB
#undef PG8_STAGE
#undef PG8_LDA
#undef PG8_LDB
#undef PG8_MMA
#undef PG8_WAIT_V
#undef PG8_WAIT_L
#undef PG8_BAR
#undef PG8_SCHED
}
}
constexpr int NWAVES = 8;
#ifndef MK_N_LAUNCHES
#define MK_N_LAUNCHES 1
#endif
constexpr int N_PHASES = 5;
constexpr int BATCH = 8, T = 2048, D = 1024, M = BATCH * T;
constexpr int NP = 4352;
constexpr int C_R = 0, C_K = 512, C_V = 1024, C_ZW = 1536, C_ZA = 1600, C_GA = 1792, C_DQ = 2304, C_DK = 2816, C_DV = 3328, C_GB = 3840;
constexpr int RH = 8, RN = 64;
constexpr int AH = 4;
constexpr float C2 = 0.125f * 1.4426950408889634f;
constexpr float LOG2E = 1.4426950408889634f;
constexpr float LAMBDA_INIT = 0.2f;

constexpr size_t MiB = 1u << 20;
constexpr size_t WS_CTL = 0, CTL_ZERO_BYTES = 1 * MiB;
constexpr size_t WS_WIN = 2 * MiB;
constexpr size_t WS_WOUT = 11 * MiB;
constexpr size_t WS_WD = 13 * MiB, WS_WA = 13 * MiB + 65536;
constexpr size_t WS_RHO = 13 * MiB + 2 * 65536;
constexpr size_t WS_XN = 14 * MiB;
constexpr size_t WS_PROJ = 46 * MiB;
constexpr size_t WS_MIX = 182 * MiB;
constexpr size_t WS_END = 214 * MiB;
constexpr int CW_BAR = 4096;

constexpr int RING_OFF = 0, RING_BYTES = 131072;
constexpr int LDSCTL_OFF = RING_BYTES, MISC_OFF = LDSCTL_OFF + 320;
constexpr int LDS_BYTES = 155648;

#define GAS __attribute__((address_space(1)))
#define LAS __attribute__((address_space(3)))
typedef unsigned short bf16;
typedef unsigned v4u __attribute__((ext_vector_type(4)));
typedef unsigned v2u __attribute__((ext_vector_type(2)));
typedef float f32x4 __attribute__((ext_vector_type(4)));
typedef float f32x16 __attribute__((ext_vector_type(16)));
typedef short bf16x8 __attribute__((ext_vector_type(8)));
typedef short s16x4 __attribute__((ext_vector_type(4)));
typedef GAS unsigned gu32;
typedef GAS unsigned long long gu64;
#define RLX_AGENT __ATOMIC_RELAXED, __HIP_MEMORY_SCOPE_AGENT
#define LDS_WAIT() asm volatile("s_waitcnt lgkmcnt(0)" ::: "memory")
#define VM_WAIT() asm volatile("s_waitcnt vmcnt(0)" ::: "memory")
__device__ __forceinline__ unsigned f2bf(float f) { unsigned u = __builtin_bit_cast(unsigned, f); return (u + 0x7fffu + ((u >> 16) & 1u)) >> 16; }
__device__ __forceinline__ unsigned pk2(float lo, float hi) { return f2bf(lo) | (f2bf(hi) << 16); }
__device__ __forceinline__ float bflo(unsigned u) { return __uint_as_float(u << 16); }
__device__ __forceinline__ float bfhi(unsigned u) { return __uint_as_float(u & 0xffff0000u); }
__device__ __forceinline__ float bf1(unsigned short u) { return __uint_as_float((unsigned)u << 16); }
__device__ __forceinline__ int mk_lane() { int l; asm volatile("v_mbcnt_lo_u32_b32 %0, -1, 0\n\tv_mbcnt_hi_u32_b32 %0, -1, %0" : "=v"(l)); return l; }
#define XB_TMO      128
#define XB_XCNT(j)  (256  + 64 * (j))
#define XB_XSUB(j)  (1280 + 64 * (j))
#define XB_XGEN(j)  (2304 + 64 * (j))
#define XB_TOP      3328
#define XB_TOPGEN   3392
#define XCD_BAR_WORDS 3456
#define XB_SPIN_CAP (1u << 18)

__device__ __forceinline__ unsigned xb_ld(unsigned* p)              { return __hip_atomic_load(p, __ATOMIC_RELAXED, __HIP_MEMORY_SCOPE_AGENT); }
__device__ __forceinline__ unsigned xb_add(unsigned* p, unsigned v) { return __hip_atomic_fetch_add(p, v, __ATOMIC_RELAXED, __HIP_MEMORY_SCOPE_AGENT); }
__device__ __forceinline__ unsigned xb_xcc_id() { return (unsigned)__builtin_amdgcn_s_getreg((3 << 11) | 20) & 0xFu; }
#define XB_SPIN(cond, bar) do { unsigned _sp = 0; while (cond) { __builtin_amdgcn_s_sleep(1); \
    if ((++_sp & 255u) == 0u) { if (xb_ld(&(bar)[XB_TMO])) break; if (_sp > XB_SPIN_CAP) { atomicAdd(&(bar)[XB_TMO], 1u); break; } } } } while (0)

struct XcdBarrier {
    unsigned* bar; unsigned x;
    volatile LAS unsigned* st;
    int wave;
};

__device__ __forceinline__ XcdBarrier xcd_barrier_post(unsigned* bar, volatile LAS unsigned* st, int wave) {
    XcdBarrier b; b.bar = bar; b.x = xb_xcc_id(); b.st = st; b.wave = wave;
    if (wave == 0 && mk_lane() == 0) (void)xb_add(&bar[XB_XCNT(b.x)], 1u);
    return b;
}
__device__ __forceinline__ void xcd_barrier_complete(unsigned* bar, unsigned x, unsigned& nloc, unsigned& nx) {
    const unsigned G = gridDim.x * gridDim.y * gridDim.z;
    unsigned sum, cnt, mine, sp = 0u;
    for (;;) {
        sum = 0u; cnt = 0u; mine = 0u;
#pragma unroll
        for (unsigned j = 0; j < 16; ++j) { const unsigned c = xb_ld(&bar[XB_XCNT(j)]); sum += c; cnt += (c > 0u) ? 1u : 0u; mine = (j == x) ? c : mine; }
        if (sum == G) break;
        __builtin_amdgcn_s_sleep(1);
        if ((++sp & 255u) == 0u) { if (xb_ld(&bar[XB_TMO])) break; if (sp > XB_SPIN_CAP) { atomicAdd(&bar[XB_TMO], 1u); break; } }
    }
    nloc = mine > 0u ? mine : 1u; nx = cnt > 0u ? cnt : 1u;
}

__device__ __forceinline__ void xcd_barrier(const XcdBarrier& b) {
    asm volatile("s_waitcnt vmcnt(0)" ::: "memory");
    __syncthreads();
    if (b.wave == 0 && mk_lane() == 0) {
        unsigned* bar = b.bar;
        __builtin_amdgcn_s_waitcnt(0);
        unsigned nloc = b.st[0], nx = b.st[1];
        if (nloc == 0u) { xcd_barrier_complete(bar, b.x, nloc, nx); b.st[0] = nloc; b.st[1] = nx; }
        const unsigned old = xb_add(&bar[XB_XSUB(b.x)], 1u);
        const unsigned gen = old / nloc;
        if (old + 1u == (gen + 1u) * nloc) {
            __builtin_amdgcn_fence(__ATOMIC_RELEASE, "agent");
            asm volatile("s_waitcnt vmcnt(0)" ::: "memory");
            const unsigned og = xb_add(&bar[XB_TOP], 1u);
            const unsigned tg = og / nx;
            if (og + 1u == (tg + 1u) * nx) xb_add(&bar[XB_TOPGEN], 1u);
            else XB_SPIN(xb_ld(&bar[XB_TOPGEN]) == tg, bar);
            __builtin_amdgcn_fence(__ATOMIC_ACQUIRE, "agent");
            xb_add(&bar[XB_XGEN(b.x)], 1u);
            asm volatile("s_waitcnt vmcnt(0)" ::: "memory");
        } else {
            XB_SPIN(xb_ld(&bar[XB_XGEN(b.x)]) == gen, bar);
            __builtin_amdgcn_fence(__ATOMIC_ACQUIRE, "agent");
            asm volatile("s_waitcnt vmcnt(0)" ::: "memory");
        }
    }
    __syncthreads();
}
struct Frame {
    LAS unsigned char* lds;
    volatile LAS unsigned* MISC;
    gu32* ctl;
    int tid, lane, wave;
    int vcu, G;
    const float* x; float* out;
    const float *norm_g, *w_in, *shift_mu, *w0, *w_decay_up, *a0, *w_iclr_up, *k_k, *k_a, *r_k, *ln_w, *ln_b, *qn_g, *kn_g, *lq1, *lk1, *lq2, *lk2, *subln_g, *w_out;
    bf16 *WinT, *WoutT, *WdT, *WaT, *XN, *PROJ, *MIX;
};

typedef float f32x2q_t __attribute__((ext_vector_type(2))); typedef __bf16 bf16x2q_t __attribute__((ext_vector_type(2)));
__device__ __forceinline__ unsigned cvtpk2(float lo, float hi) { f32x2q_t v = {lo, hi}; bf16x2q_t b = __builtin_convertvector(v, bf16x2q_t); return __builtin_bit_cast(unsigned, b); }
__device__ __forceinline__ float wave_sum(float v) {
#pragma unroll
    for (int o = 1; o < 64; o <<= 1) v += __shfl_xor(v, o);
    return v;
}
template <int CTRL> __device__ __forceinline__ float dpp_f(float x) { return __builtin_bit_cast(float, __builtin_amdgcn_mov_dpp(__builtin_bit_cast(int, x), CTRL, 0xf, 0xf, true)); }
__device__ __forceinline__ float row16_sum(float x) {
    x += dpp_f<0xB1>(x); x += dpp_f<0x4E>(x); x += dpp_f<0x141>(x); x += dpp_f<0x140>(x); return x;
}
__device__ __forceinline__ float swap32_sum(float x) {
    auto rr = __builtin_amdgcn_permlane32_swap(__float_as_uint(x), __float_as_uint(x), false, false);
    return __uint_as_float(rr[0]) + __uint_as_float(rr[1]);
}

__device__ __forceinline__ void p0_transpose_item(const float* W, int N, int nsrc, const float* kscale, bf16* WT, int K, int ndst, LAS float* scr, int k0, int lane) {
    float v[32];
#pragma unroll
    for (int i = 0; i < 32; ++i) { const int kk = 2 * i + (lane >> 5); v[i] = (nsrc >= 0) ? W[(size_t)(k0 + kk) * N + nsrc + (lane & 31)] : 0.f; }
    if (kscale && nsrc >= 0) {
#pragma unroll
        for (int i = 0; i < 32; ++i) v[i] *= kscale[k0 + 2 * i + (lane >> 5)];
    }
#pragma unroll
    for (int i = 0; i < 32; ++i) scr[(2 * i + (lane >> 5)) * 33 + (lane & 31)] = v[i];
    LDS_WAIT(); asm volatile("" ::: "memory");
    const int c = lane & 7;
#pragma unroll
    for (int j = 0; j < 4; ++j) { const int n = (lane >> 3) + 8 * j; const LAS float* s = scr + (8 * c) * 33 + n;
        v4u o; o.x = cvtpk2(s[0 * 33], s[1 * 33]); o.y = cvtpk2(s[2 * 33], s[3 * 33]); o.z = cvtpk2(s[4 * 33], s[5 * 33]); o.w = cvtpk2(s[6 * 33], s[7 * 33]);
        *(GAS v4u*)(WT + (size_t)(ndst + n) * K + k0 + 8 * c) = o; }
    LDS_WAIT(); asm volatile("" ::: "memory");
}
__device__ __forceinline__ void p0_rows4(Frame& F, int m0) {
    f32x4 v[4][4]; float s[4];
#pragma unroll
    for (int u = 0; u < 4; ++u) { const GAS f32x4* xr = (const GAS f32x4*)(F.x + (size_t)(m0 + u) * D) + F.lane;
#pragma unroll
        for (int j = 0; j < 4; ++j) v[u][j] = __builtin_nontemporal_load(xr + 64 * j); }
#pragma unroll
    for (int u = 0; u < 4; ++u) { float a = 0.f;
#pragma unroll
        for (int j = 0; j < 4; ++j) a += (v[u][j].x * v[u][j].x + v[u][j].y * v[u][j].y) + (v[u][j].z * v[u][j].z + v[u][j].w * v[u][j].w);
        s[u] = a; }
#pragma unroll
    for (int u = 0; u < 4; ++u) {
        const float rstd = __builtin_amdgcn_rsqf(wave_sum(s[u]) * (1.f / D) + 1e-6f);
        GAS unsigned long long* o8 = (GAS unsigned long long*)(F.XN + (size_t)(m0 + u) * D) + F.lane;
#pragma unroll
        for (int j = 0; j < 4; ++j) o8[64 * j] = (unsigned long long)cvtpk2(v[u][j].x * rstd, v[u][j].y * rstd) | ((unsigned long long)cvtpk2(v[u][j].z * rstd, v[u][j].w * rstd) << 32);
    }
}
__device__ __forceinline__ void p0_prologue(Frame& F) {
    LAS float* scr = (LAS float*)(F.lds + RING_OFF + F.wave * 16384);
    const int gw = F.vcu * NWAVES + F.wave, NGW = F.G * NWAVES;
    constexpr int I_IN = (D / 64) * (NP / 32), I_OUT = (D / 64) * (D / 32), I_L = 512 / 32;
    constexpr int NITEMS = I_IN + I_OUT + 2 * I_L;
    int m0 = gw * 4;
    if (!(gw & 1) && m0 < M) { p0_rows4(F, m0); m0 += NGW * 4; }
#pragma unroll 1
    for (int it = gw; it < NITEMS; it += NGW) {
        int r = it;
        if (r < I_IN) { const int kb = r / (NP / 32), nb = r % (NP / 32), nd = 32 * nb; const int ns = nd < 1664 ? nd : (nd < 1792 ? -1 : nd - 128);
            p0_transpose_item(F.w_in, 4224, ns, F.norm_g, F.WinT, D, nd, scr, 64 * kb, F.lane); continue; } r -= I_IN;
        if (r < I_OUT) { const int kb = r / (D / 32), nb = r % (D / 32);
            p0_transpose_item(F.w_out, D, 32 * nb, nullptr, F.WoutT, D, 32 * nb, scr, 64 * kb, F.lane); continue; } r -= I_OUT;
        if (r < I_L) { p0_transpose_item(F.w_decay_up, 512, 32 * r, nullptr, F.WdT, 64, 32 * r, scr, 0, F.lane); continue; } r -= I_L;
        p0_transpose_item(F.w_iclr_up, 512, 32 * r, nullptr, F.WaT, 64, 32 * r, scr, 0, F.lane);
    }
#pragma unroll 1
    for (; m0 < M; m0 += NGW * 4) p0_rows4(F, m0);
}

__device__ __forceinline__ float tanh_f(float x) { const float e = __expf(-2.f * fabsf(x)); const float t = (1.f - e) * __builtin_amdgcn_rcpf(1.f + e); return x < 0.f ? -t : t; }
__device__ __forceinline__ void shifted8(const bf16* proj, size_t m, bool has_prev, int col, const float* mu, float (&o)[8]) {
    const v4u c = *(const GAS v4u*)(proj + m * NP + col);
    v4u p = (v4u){0u, 0u, 0u, 0u}; if (has_prev) p = *(const GAS v4u*)(proj + (m - 1) * NP + col);
    const f32x4 m0 = *(const GAS f32x4*)(mu), m1 = *(const GAS f32x4*)(mu + 4);
    const unsigned cw[4] = {c.x, c.y, c.z, c.w}, pw[4] = {p.x, p.y, p.z, p.w}; const float mm[8] = {m0.x, m0.y, m0.z, m0.w, m1.x, m1.y, m1.z, m1.w};
#pragma unroll
    for (int j = 0; j < 4; ++j) { const float c0 = bflo(cw[j]), c1 = bfhi(cw[j]), p0 = bflo(pw[j]), p1 = bfhi(pw[j]);
        o[2 * j] = c0 + (p0 - c0) * mm[2 * j]; o[2 * j + 1] = c1 + (p1 - c1) * mm[2 * j + 1]; }
}
__device__ __forceinline__ void shifted4(const bf16* proj, size_t m, bool has_prev, int col, const float* mu, float (&o)[4]) {
    const v2u c = *(const GAS v2u*)(proj + m * NP + col);
    v2u p = (v2u){0u, 0u}; if (has_prev) p = *(const GAS v2u*)(proj + (m - 1) * NP + col);
    const f32x4 m0 = *(const GAS f32x4*)(mu);
    o[0] = bflo(c.x) + (bflo(p.x) - bflo(c.x)) * m0.x; o[1] = bfhi(c.x) + (bfhi(p.x) - bfhi(c.x)) * m0.y;
    o[2] = bflo(c.y) + (bflo(p.y) - bflo(c.y)) * m0.z; o[3] = bfhi(c.y) + (bfhi(p.y) - bfhi(c.y)) * m0.w;
}
__device__ __forceinline__ void p2_qknorm(Frame& F) {
    const int gw = F.vcu * NWAVES + F.wave, NGW = F.G * NWAVES, lane = F.lane, sub = lane & 7;
    const f32x4 gq0 = *(const GAS f32x4*)(F.qn_g + sub * 8), gq1 = *(const GAS f32x4*)(F.qn_g + sub * 8 + 4), gk0 = *(const GAS f32x4*)(F.kn_g + sub * 8), gk1 = *(const GAS f32x4*)(F.kn_g + sub * 8 + 4);
    constexpr int UQ = 4;
    for (int it0 = gw * UQ; it0 < 2 * M; it0 += NGW * UQ) {
        bf16* p[UQ]; v4u c[UQ];
#pragma unroll
        for (int u = 0; u < UQ; ++u) { const int it = it0 + u; const size_t m = (size_t)(it >> 1); p[u] = F.PROJ + m * NP + ((it & 1) ? C_DK : C_DQ) + (lane >> 3) * 64 + sub * 8; c[u] = *(const GAS v4u*)p[u]; }
#pragma unroll
        for (int u = 0; u < UQ; ++u) {
            const int isk = (it0 + u) & 1; const unsigned cw[4] = {c[u].x, c[u].y, c[u].z, c[u].w};
            float xv[8]; float ss = 0.f;
#pragma unroll
            for (int j = 0; j < 4; ++j) { xv[2 * j] = bflo(cw[j]); xv[2 * j + 1] = bfhi(cw[j]); ss += xv[2 * j] * xv[2 * j] + xv[2 * j + 1] * xv[2 * j + 1]; }
            ss += dpp_f<0xB1>(ss); ss += dpp_f<0x4E>(ss); ss += dpp_f<0x141>(ss);
            const float r = __builtin_amdgcn_rsqf(ss * (1.f / 64.f) + 1e-6f) * (isk ? 1.f : C2);
            const f32x4 g0 = isk ? gk0 : gq0, g1 = isk ? gk1 : gq1;
            v4u o; o.x = cvtpk2(xv[0] * r * g0.x, xv[1] * r * g0.y); o.y = cvtpk2(xv[2] * r * g0.z, xv[3] * r * g0.w); o.z = cvtpk2(xv[4] * r * g1.x, xv[5] * r * g1.y); o.w = cvtpk2(xv[6] * r * g1.z, xv[7] * r * g1.w);
            *(GAS v4u*)p[u] = o;
        }
    }
}
typedef float f32x2_t __attribute__((ext_vector_type(2))); typedef __bf16 bf16x2_t __attribute__((ext_vector_type(2)));
__device__ __forceinline__ unsigned cvtpk(float lo, float hi) { f32x2_t v = {lo, hi}; bf16x2_t b = __builtin_convertvector(v, bf16x2_t); return __builtin_bit_cast(unsigned, b); }
#define MFMA32(a, b, c) __builtin_amdgcn_mfma_f32_32x32x16_bf16(__builtin_bit_cast(bf16x8, (a)), __builtin_bit_cast(bf16x8, (b)), (c), 0, 0, 0)
#define FRAGACC(z, s) ((v4u){cvtpk((z)[8 * (s)], (z)[8 * (s) + 1]), cvtpk((z)[8 * (s) + 2], (z)[8 * (s) + 3]), cvtpk((z)[8 * (s) + 4], (z)[8 * (s) + 5]), cvtpk((z)[8 * (s) + 6], (z)[8 * (s) + 7])})
template <int CTRL, int RM> __device__ __forceinline__ float dpp_upd0(float x) { return __builtin_bit_cast(float, __builtin_amdgcn_update_dpp(0, __builtin_bit_cast(int, x), CTRL, RM, 0xf, false)); }
__device__ __forceinline__ float scan32(float x) {
    x += dpp_upd0<0x111, 0xf>(x); x += dpp_upd0<0x112, 0xf>(x); x += dpp_upd0<0x114, 0xf>(x); x += dpp_upd0<0x118, 0xf>(x); x += dpp_upd0<0x142, 0xa>(x); return x;
}
__device__ __forceinline__ void st_wt16(v4u* p, const v4u v) { *(GAS v4u*)p = v; }
constexpr int RW_UNITS = BATCH * RH * (T / 32);
struct RwDump { v4u* PF; v4u* DD; v4u* QF; v4u* YD; float* GAM; float* RHO; };

__device__ __forceinline__ void rwkvA_unit(Frame& F, const RwDump& Dm, int bh, int ci, LAS float* wscr, LAS unsigned char* park, LAS v4u* zsh, int zpar) {
    int lane = mk_lane(); asm volatile("" : "+v"(lane));
    const int hi = lane >> 5, l31 = lane & 31, b = bh >> 3, w = bh & 7;
    LAS v4u* pk = (LAS v4u*)park + lane;
#define PARK(slot) pk[(slot) * 64]
    int tok = 0; asm volatile("" : "+v"(tok));
#define DEP(x) asm volatile("" : "+v"(tok) : "v"(x))
    const int t = ci * 32 + l31; const size_t m = (size_t)b * T + t; const bool hp = t > 0;
    const int u = ci * (BATCH * RH) + bh;
    const float pm = hp ? 1.f : 0.f;
    const bf16* pc = F.PROJ + m * NP + w * 64 + 4 * hi; const bf16* pp = F.PROJ + (hp ? m - 1 : m) * NP + w * 64 + 4 * hi;
    const float* mu = F.shift_mu + w * 64 + 4 * hi;
    const float *pw0 = F.w0 + w * 64 + 4 * hi, *pa0 = F.a0 + w * 64 + 4 * hi, *pkk = F.k_k + w * 64 + 4 * hi, *pka = F.k_a + w * 64 + 4 * hi, *prk = F.r_k + w * 64 + 4 * hi;
#define SH4(dst, COL, MU, OFF) do { const v2u c_ = *(const GAS v2u*)(pc + tok + (COL) + (OFF)), p_ = *(const GAS v2u*)(pp + tok + (COL) + (OFF)); const f32x4 m_ = *(const GAS f32x4*)(mu + tok + (MU) + (OFF)); \
        dst[0] = bflo(c_.x) + (bflo(p_.x) * pm - bflo(c_.x)) * m_.x; dst[1] = bfhi(c_.x) + (bfhi(p_.x) * pm - bfhi(c_.x)) * m_.y; \
        dst[2] = bflo(c_.y) + (bflo(p_.y) * pm - bflo(c_.y)) * m_.z; dst[3] = bfhi(c_.y) + (bfhi(p_.y) * pm - bfhi(c_.y)) * m_.w; } while (0)
    float ss = 0.f;
#pragma unroll
    for (int gq = 0; gq < 8; ++gq) { float k4[4]; SH4(k4, C_K, 512, 8 * gq); const f32x4 kkp = *(const GAS f32x4*)(pkk + tok + 8 * gq);
#pragma unroll
        for (int e = 0; e < 4; ++e) { const float q = k4[e] * kkp[e]; ss += q * q; }
        if (gq == 3) DEP(ss); }
    ss = swap32_sum(ss);
    const float inv = __builtin_amdgcn_rcpf(fmaxf(__builtin_amdgcn_sqrtf(ss), 1e-12f));
    asm volatile("" ::: "memory");
    v4u bz[4], ba[4];
    { const int s = F.wave >> 1; const bool which = (F.wave & 1) != 0;
      const bf16* zc = F.PROJ + m * NP + 8 * hi; const bf16* zp = F.PROJ + (hp ? m - 1 : m) * NP + 8 * hi; const float* zmu = F.shift_mu + 8 * hi;
      const int COL = (which ? C_ZA : C_ZW) + 16 * s, MUO = (which ? 1600 : 1536) + 16 * s;
      const v4u c = *(const GAS v4u*)(zc + tok + COL), p = *(const GAS v4u*)(zp + tok + COL); const f32x4 m0 = *(const GAS f32x4*)(zmu + tok + MUO), m1 = *(const GAS f32x4*)(zmu + tok + MUO + 4);
      float z[8];
#pragma unroll
      for (int j = 0; j < 4; ++j) { const float c0 = bflo(c[j]), c1 = bfhi(c[j]); const float mm0 = j < 2 ? m0[2 * j] : m1[2 * j - 4], mm1 = j < 2 ? m0[2 * j + 1] : m1[2 * j - 3];
          z[2 * j] = c0 + (bflo(p[j]) * pm - c0) * mm0; z[2 * j + 1] = c1 + (bfhi(p[j]) * pm - c1) * mm1; }
      if (!which) {
#pragma unroll
          for (int j = 0; j < 8; ++j) z[j] = tanh_f(z[j]); }
      LAS v4u* zs = zsh + zpar * 512;
      zs[((which ? 4 : 0) + s) * 64 + lane] = (v4u){cvtpk(z[0], z[1]), cvtpk(z[2], z[3]), cvtpk(z[4], z[5]), cvtpk(z[6], z[7])};
      __syncthreads();
#pragma unroll
      for (int q = 0; q < 4; ++q) { bz[q] = zs[q * 64 + lane]; ba[q] = zs[(4 + q) * 64 + lane]; }
      DEP(bz[3][3]); DEP(ba[3][3]); }
    asm volatile("" ::: "memory");
    v4u fa[4], fb[4], fk[4], fr[4], fv[4]; float rho = 0.f;
    float* gp = Dm.GAM + (size_t)u * 64 + hi * 32;
#define RW_LORA(cb) f32x16 accd = f32x16{}, acca = f32x16{}; _Pragma("unroll") for (int s = 0; s < 4; ++s) { \
        const v4u aD = *(const GAS v4u*)(F.WdT + tok + (size_t)(w * 64 + (cb) * 32 + l31) * 64 + 16 * s + 8 * hi); accd = MFMA32(aD, bz[s], accd); \
        const v4u aA = *(const GAS v4u*)(F.WaT + tok + (size_t)(w * 64 + (cb) * 32 + l31) * 64 + 16 * s + 8 * hi); acca = MFMA32(aA, ba[s], acca); }
    struct RwGL { v2u rc, rp, kc, kp, vc, vp; } gA, gB;
#define RW_LOADG(X, OFF) do { X.rc = *(const GAS v2u*)(pc + tok + C_R + (OFF)); X.rp = *(const GAS v2u*)(pp + tok + C_R + (OFF)); X.kc = *(const GAS v2u*)(pc + tok + C_K + (OFF)); X.kp = *(const GAS v2u*)(pp + tok + C_K + (OFF)); \
        X.vc = *(const GAS v2u*)(pc + tok + C_V + (OFF)); X.vp = *(const GAS v2u*)(pp + tok + C_V + (OFF)); } while (0)
#define RW_LERP(dst, c_, p_, m_) do { dst[0] = bflo(c_.x) + (bflo(p_.x) * pm - bflo(c_.x)) * m_.x; dst[1] = bfhi(c_.x) + (bfhi(p_.x) * pm - bfhi(c_.x)) * m_.y; \
        dst[2] = bflo(c_.y) + (bflo(p_.y) * pm - bflo(c_.y)) * m_.z; dst[3] = bfhi(c_.y) + (bfhi(p_.y) * pm - bfhi(c_.y)) * m_.w; } while (0)
#define RW_GROUP(cb, rg, CUR, NXT, HASN) do { constexpr int OFF = 32 * (cb) + 8 * (rg); const int ch0 = OFF + 4 * hi; \
            if (HASN) RW_LOADG(NXT, OFF + 8); \
            float rr[4], kk4[4], vv[4]; \
            const f32x4 mr_ = *(const GAS f32x4*)(mu + tok + OFF), mk_ = *(const GAS f32x4*)(mu + tok + 512 + OFF), mv_ = *(const GAS f32x4*)(mu + tok + 1024 + OFF); \
            const f32x4 w0v = *(const GAS f32x4*)(pw0 + tok + OFF), a0v = *(const GAS f32x4*)(pa0 + tok + OFF), kkp = *(const GAS f32x4*)(pkk + tok + OFF), kap = *(const GAS f32x4*)(pka + tok + OFF), rkp = *(const GAS f32x4*)(prk + tok + OFF); \
            RW_LERP(rr, CUR.rc, CUR.rp, mr_); RW_LERP(kk4, CUR.kc, CUR.kp, mk_); RW_LERP(vv, CUR.vc, CUR.vp, mv_); \
            float xa[4], xb[4], xk[4], xr[4], gg[4], ge[4]; \
            _Pragma("unroll") for (int e = 0; e < 4; ++e) { \
                const float nx = -(w0v[e] + accd[4 * (rg) + e]); const float sp = fmaxf(nx, 0.f) + __logf(1.f + __expf(-fabsf(nx))); \
                const float l2 = -__expf(-sp - 0.5f) * LOG2E; \
                const float g = scan32(l2); \
                const float a = __builtin_amdgcn_rcpf(1.f + __expf(-(a0v[e] + acca[4 * (rg) + e]))); \
                const float kk = kk4[e] * kkp[e] * inv; \
                const float kt = kk4[e] * (1.f + (a - 1.f) * kap[e]); \
                rho += rr[e] * kt * rkp[e]; \
                const float eg = __builtin_amdgcn_exp2f(g), egp = __builtin_amdgcn_exp2f(g - l2), eng = __builtin_amdgcn_rcpf(eg); \
                xa[e] = -kk * egp; xb[e] = kk * a * eng; xk[e] = kt * eng; xr[e] = rr[e] * eg; gg[e] = g; ge[e] = eg; } \
            if (l31 == 31) { *(LAS f32x4*)(wscr + ch0) = (f32x4){gg[0], gg[1], gg[2], gg[3]}; st_wt16((v4u*)(gp + (cb) * 16 + 4 * (rg)), (v4u){__float_as_uint(ge[0]), __float_as_uint(ge[1]), __float_as_uint(ge[2]), __float_as_uint(ge[3])}); } \
            constexpr int s_ = 2 * (cb) + ((rg) >> 1), vg = 2 * ((rg) & 1); \
            fa[s_][vg] = cvtpk(xa[0], xa[1]); fa[s_][vg + 1] = cvtpk(xa[2], xa[3]); \
            fb[s_][vg] = cvtpk(xb[0], xb[1]); fb[s_][vg + 1] = cvtpk(xb[2], xb[3]); \
            fk[s_][vg] = cvtpk(xk[0], xk[1]); fk[s_][vg + 1] = cvtpk(xk[2], xk[3]); \
            fr[s_][vg] = cvtpk(xr[0], xr[1]); fr[s_][vg + 1] = cvtpk(xr[2], xr[3]); \
            fv[s_][vg] = cvtpk(vv[0], vv[1]); fv[s_][vg + 1] = cvtpk(vv[2], vv[3]); \
            if (((rg) & 1) == 1) { PARK(s_) = fv[s_]; PARK(4 + s_) = fr[s_]; } \
            DEP(fa[s_][vg + 1]); DEP(fb[s_][vg + 1]); DEP(fk[s_][vg + 1]); DEP(fr[s_][vg + 1]); DEP(fv[s_][vg + 1]); DEP(rho); } while (0)
    RW_LOADG(gA, 0);
    { RW_LORA(0) RW_GROUP(0, 0, gA, gB, true); RW_GROUP(0, 1, gB, gA, true); RW_GROUP(0, 2, gA, gB, true); RW_GROUP(0, 3, gB, gA, true); }
    { RW_LORA(1) RW_GROUP(1, 0, gA, gB, true); RW_GROUP(1, 1, gB, gA, true); RW_GROUP(1, 2, gA, gB, true); RW_GROUP(1, 3, gB, gA, false); }
#undef RW_LOADG
#undef RW_LERP
#undef RW_LORA
#undef RW_GROUP
#undef SH4
    LDS_WAIT(); asm volatile("" ::: "memory");
    float EC[2]; EC[0] = __builtin_amdgcn_exp2f(wscr[l31]); EC[1] = __builtin_amdgcn_exp2f(wscr[32 + l31]);
    LDS_WAIT(); asm volatile("" ::: "memory");
    rho = swap32_sum(rho);
    if (hi == 0) __hip_atomic_store((gu32*)(Dm.RHO + (size_t)u * 32 + l31), __float_as_uint(rho), RLX_AGENT);
    v4u idf[2];
    { const int jst = 4 * ((l31 >> 3) & 1) + (l31 & 3); const bool hm = ((l31 >> 2) & 1) == hi; const unsigned one = 0x3F80u << (16 * (jst & 1));
#pragma unroll
      for (int sig = 0; sig < 2; ++sig) { const bool on = hm && ((l31 >> 4) == sig);
#pragma unroll
          for (int q = 0; q < 4; ++q) idf[sig][q] = (on && (jst >> 1) == q) ? one : 0u; } }
    LDS_WAIT();
    v4u Af[2][2], Vf[2][2];
#pragma unroll
    for (int blk = 0; blk < 2; ++blk) {
        f32x16 za = MFMA32(fa[2 * blk], idf[0], f32x16{}); za = MFMA32(fa[2 * blk + 1], idf[1], za);
        f32x16 zv = MFMA32(PARK(2 * blk), idf[0], f32x16{}); zv = MFMA32(PARK(2 * blk + 1), idf[1], zv);
        f32x16 zb = MFMA32(fb[2 * blk], idf[0], f32x16{}); zb = MFMA32(fb[2 * blk + 1], idf[1], zb);
        f32x16 zk = MFMA32(fk[2 * blk], idf[0], f32x16{}); zk = MFMA32(fk[2 * blk + 1], idf[1], zk);
        zb = zb * EC[blk]; zk = zk * EC[blk];
#pragma unroll
        for (int s = 0; s < 2; ++s) { Af[blk][s] = FRAGACC(za, s); Vf[blk][s] = FRAGACC(zv, s); PARK(8 + 2 * blk + s) = FRAGACC(zb, s); PARK(12 + 2 * blk + s) = FRAGACC(zk, s); }
        __builtin_amdgcn_sched_barrier(0);
    }
    f32x16 Aab = f32x16{}, TT = f32x16{}, AakT = f32x16{}, ArbT = f32x16{}, ArkT = f32x16{};
#pragma unroll
    for (int s = 0; s < 4; ++s) { const v4u frs = PARK(4 + s); Aab = MFMA32(fa[s], fb[s], Aab); TT = MFMA32(fb[s], fa[s], TT); AakT = MFMA32(fk[s], fa[s], AakT); ArbT = MFMA32(fb[s], frs, ArbT); ArkT = MFMA32(fk[s], frs, ArkT); }
#pragma unroll
    for (int r = 0; r < 16; ++r) { const int rowi = (r & 3) + 8 * (r >> 2) + 4 * hi;
        Aab[r] = (l31 < rowi) ? Aab[r] : 0.f; TT[r] = (rowi < l31) ? TT[r] : 0.f; AakT[r] = (rowi < l31) ? AakT[r] : 0.f;
        ArbT[r] = (rowi <= l31) ? ArbT[r] : 0.f; ArkT[r] = (rowi <= l31) ? ArkT[r] : 0.f; }
    v4u AakTf[2], ArbTf[2], ArkTf[2];
#pragma unroll
    for (int s = 0; s < 2; ++s) { AakTf[s] = FRAGACC(AakT, s); ArbTf[s] = FRAGACC(ArbT, s); ArkTf[s] = FRAGACC(ArkT, s); }
    __builtin_amdgcn_sched_barrier(0);
    v4u Xf[2], XTf[2], TTf[2];
#pragma unroll
    for (int s = 0; s < 2; ++s) { Xf[s] = FRAGACC(Aab, s); XTf[s] = FRAGACC(TT, s); }
#pragma unroll
    for (int r = 0; r < 16; ++r) { const int rowi = (r & 3) + 8 * (r >> 2) + 4 * hi; TT[r] += (rowi == l31) ? 1.f : 0.f; }
#pragma unroll
    for (int it = 0; it < 4; ++it) {
        f32x16 X2 = MFMA32(XTf[0], Xf[0], f32x16{}); X2 = MFMA32(XTf[1], Xf[1], X2);
        if (it < 3) { f32x16 X2T = MFMA32(Xf[0], XTf[0], f32x16{}); X2T = MFMA32(Xf[1], XTf[1], X2T);
#pragma unroll
            for (int s = 0; s < 2; ++s) XTf[s] = FRAGACC(X2T, s); }
#pragma unroll
        for (int s = 0; s < 2; ++s) { Xf[s] = FRAGACC(X2, s); TTf[s] = FRAGACC(TT, s); }
        TT = MFMA32(Xf[0], TTf[0], TT); TT = MFMA32(Xf[1], TTf[1], TT);
        __builtin_amdgcn_sched_barrier(0);
    }
#pragma unroll
    for (int s = 0; s < 2; ++s) TTf[s] = FRAGACC(TT, s);
    v4u Wf[2][2], Uf[2][2];
#pragma unroll
    for (int blk = 0; blk < 2; ++blk) {
        f32x16 av = MFMA32(AakTf[0], Vf[blk][0], f32x16{}); av = MFMA32(AakTf[1], Vf[blk][1], av);
        const v4u avf0 = FRAGACC(av, 0), avf1 = FRAGACC(av, 1);
        f32x16 uu = MFMA32(TTf[0], avf0, f32x16{}); uu = MFMA32(TTf[1], avf1, uu);
        f32x16 ww = MFMA32(TTf[0], Af[blk][0], f32x16{}); ww = MFMA32(TTf[1], Af[blk][1], ww);
#pragma unroll
        for (int s = 0; s < 2; ++s) { Wf[blk][s] = FRAGACC(ww, s); Uf[blk][s] = FRAGACC(uu, s); }
        __builtin_amdgcn_sched_barrier(0);
    }
    v4u* QFp = Dm.QF + (size_t)u * 256 + lane; v4u* YDp = Dm.YD + (size_t)u * 256 + lane;
#pragma unroll
    for (int blk = 0; blk < 2; ++blk) {
        f32x16 q;
#pragma unroll
        for (int s = 0; s < 2; ++s)
            { const v4u frs = PARK(4 + 2 * blk + s);
#pragma unroll
              for (int j = 0; j < 4; ++j) { q[8 * s + 2 * j] = bflo(frs[j]); q[8 * s + 2 * j + 1] = bfhi(frs[j]); } }
        q = MFMA32(Wf[blk][0], ArbTf[0], q); q = MFMA32(Wf[blk][1], ArbTf[1], q);
        st_wt16(QFp + (2 * blk) * 64, FRAGACC(q, 0)); st_wt16(QFp + (2 * blk + 1) * 64, FRAGACC(q, 1));
        f32x16 y = MFMA32(Uf[blk][0], ArbTf[0], f32x16{}); y = MFMA32(Uf[blk][1], ArbTf[1], y); y = MFMA32(Vf[blk][0], ArkTf[0], y); y = MFMA32(Vf[blk][1], ArkTf[1], y);
        st_wt16(YDp + (2 * blk) * 64, FRAGACC(y, 0)); st_wt16(YDp + (2 * blk + 1) * 64, FRAGACC(y, 1));
        __builtin_amdgcn_sched_barrier(0);
    }
    v4u* PFp = Dm.PF + (size_t)u * 512 + lane; v4u* DDp = Dm.DD + (size_t)u * 512 + lane;
#pragma unroll
    for (int c1 = 0; c1 < 2; ++c1)
#pragma unroll
        for (int cb = 0; cb < 2; ++cb) {
            f32x16 p = MFMA32(Wf[c1][0], PARK(8 + 2 * cb), f32x16{}); p = MFMA32(Wf[c1][1], PARK(8 + 2 * cb + 1), p);
            st_wt16(PFp + (cb * 4 + 2 * c1) * 64, FRAGACC(p, 0)); st_wt16(PFp + (cb * 4 + 2 * c1 + 1) * 64, FRAGACC(p, 1));
            __builtin_amdgcn_sched_barrier(0);
        }
#pragma unroll
    for (int cb = 0; cb < 2; ++cb)
#pragma unroll
        for (int ib = 0; ib < 2; ++ib) {
            f32x16 d = MFMA32(PARK(8 + 2 * cb), Uf[ib][0], f32x16{}); d = MFMA32(PARK(8 + 2 * cb + 1), Uf[ib][1], d); d = MFMA32(PARK(12 + 2 * cb), Vf[ib][0], d); d = MFMA32(PARK(12 + 2 * cb + 1), Vf[ib][1], d);
            st_wt16(DDp + ((cb * 2 + ib) * 2) * 64, FRAGACC(d, 0)); st_wt16(DDp + ((cb * 2 + ib) * 2 + 1) * 64, FRAGACC(d, 1));
            __builtin_amdgcn_sched_barrier(0);
        }
}

#undef PARK
#undef DEP
constexpr int RB_PF = 0, RB_DD = 8192, RB_QF = 16384, RB_YD = 20480, RB_GAM = 24576, RB_BUF = 24832, RB_STAT = 2 * RB_BUF, RB_Y = RB_STAT + 1024;
__device__ __forceinline__ void unpack16(const v4u a, const v4u b, f32x16& o) {
#pragma unroll
    for (int j = 0; j < 4; ++j) { o[2 * j] = bflo(a[j]); o[2 * j + 1] = bfhi(a[j]); o[8 + 2 * j] = bflo(b[j]); o[8 + 2 * j + 1] = bfhi(b[j]); }
}
constexpr int RW_SPLIT = T / 32, CW_DONE = 16384;
__device__ __forceinline__ void rw_wait_chunk(Frame& F, int ci) {
    unsigned spins = 0;
#pragma unroll 1
    for (int j = 7; j >= 0; --j) { gu32* c = F.ctl + CW_DONE + 64 * (ci + j);
        while ((unsigned)__builtin_amdgcn_readfirstlane(__hip_atomic_load(c, RLX_AGENT)) < (unsigned)BATCH) { __builtin_amdgcn_s_sleep(8); if (++spins > (1u << 22)) break; } }
    __builtin_amdgcn_fence(__ATOMIC_ACQUIRE, "agent");
}
__device__ __forceinline__ void rw_publish_chunk(Frame& F, int ci) {
    asm volatile("s_waitcnt vmcnt(0)" ::: "memory");
    __syncthreads();
    if (F.wave == 0 && mk_lane() == 0) {
        __hip_atomic_fetch_add(F.ctl + CW_DONE + 64 * ci, 1u, RLX_AGENT);
    }
}
struct RbStage { v4u p[2], d[2], q, y, g; };
struct RbEpi { v2u vc[2], vp[2], ga[2]; float rho; };
__device__ __forceinline__ void rwkvB_unit(Frame& F, const RwDump& Dm, int bh) {
    int lane = mk_lane(); asm volatile("" : "+v"(lane));
    const int wid = F.wave, tid = wid * 64 + lane, hi = lane >> 5, l31 = lane & 31, b = bh >> 3, h = bh & 7;
    LAS unsigned char* lds = F.lds + RING_OFF;
    constexpr int NS = T / 32;
    LAS float* stat = (LAS float*)(lds + RB_STAT);
    LAS float* ybuf = (LAS float*)(lds + RB_Y);
    const int stid = tid - 128;
    const bool st_p2 = wid < 4, st_q = wid < 6, st_y = wid >= 4;
#define ST_LOAD(X, ci_) do { { if ((ci_) >= RW_SPLIT && (ci_) < NS && (((ci_) - RW_SPLIT) & 7) == 0) rw_wait_chunk(F, (ci_)); const size_t u_ = (size_t)((ci_) < NS ? (ci_) : NS - 1) * (BATCH * RH) + bh; \
        X.p[0] = __builtin_nontemporal_load((const GAS v4u*)(Dm.PF + u_ * 512 + stid)); X.d[0] = __builtin_nontemporal_load((const GAS v4u*)(Dm.DD + u_ * 512 + stid)); \
        if (st_p2) { X.p[1] = __builtin_nontemporal_load((const GAS v4u*)(Dm.PF + u_ * 512 + 384 + stid)); X.d[1] = __builtin_nontemporal_load((const GAS v4u*)(Dm.DD + u_ * 512 + 384 + stid)); } \
        if (st_q) X.q = __builtin_nontemporal_load((const GAS v4u*)(Dm.QF + u_ * 256 + stid)); \
        if (st_y) X.y = __builtin_nontemporal_load((const GAS v4u*)(Dm.YD + u_ * 256 + (stid - 128))); \
        if (stid < 16) X.g = *(const GAS v4u*)((const v4u*)(Dm.GAM + u_ * 64) + stid); } } while (0)
#define ST_STORE(X, buf_) do { LAS unsigned char* b_ = lds + (buf_) * RB_BUF; \
        *(LAS v4u*)(b_ + RB_PF + stid * 16) = X.p[0]; *(LAS v4u*)(b_ + RB_DD + stid * 16) = X.d[0]; \
        if (st_p2) { *(LAS v4u*)(b_ + RB_PF + (384 + stid) * 16) = X.p[1]; *(LAS v4u*)(b_ + RB_DD + (384 + stid) * 16) = X.d[1]; } \
        if (st_q) *(LAS v4u*)(b_ + RB_QF + stid * 16) = X.q; \
        if (st_y) *(LAS v4u*)(b_ + RB_YD + (stid - 128) * 16) = X.y; \
        if (stid < 16) *(LAS v4u*)(b_ + RB_GAM + stid * 16) = X.g; } while (0)
    const int eib = wid & 1, eh = (wid >> 2) & 1;
    const bf16* epc = F.PROJ + (size_t)b * T * NP + h * 64 + 32 * eib + 16 * eh + 4 * hi;
#define EP_LOAD(X, cj_) do { { const int tt_ = ((cj_) < NS ? (cj_) : NS - 1) * 32 + l31; const bf16* pc_ = epc + (size_t)tt_ * NP; const bf16* pp_ = epc + (size_t)(tt_ > 0 ? tt_ - 1 : 0) * NP; \
        _Pragma("unroll") for (int rg = 0; rg < 2; ++rg) { X.vc[rg] = *(const GAS v2u*)(pc_ + C_V + 8 * rg); X.vp[rg] = *(const GAS v2u*)(pp_ + C_V + 8 * rg); X.ga[rg] = *(const GAS v2u*)(pc_ + C_GA + 8 * rg); } \
        X.rho = Dm.RHO[((size_t)((cj_) < NS ? (cj_) : NS - 1) * (BATCH * RH) + bh) * 32 + l31]; } } while (0)
#define EP_RUN(X, cj_) do { const int par_ = (cj_) & 1; \
        const float s1_ = stat[((par_ * 2 + 0) * 32 + l31) * 2] + stat[((par_ * 2 + 1) * 32 + l31) * 2], s2_ = stat[((par_ * 2 + 0) * 32 + l31) * 2 + 1] + stat[((par_ * 2 + 1) * 32 + l31) * 2 + 1]; \
        const float mean_ = s1_ * (1.f / 64.f), var_ = fmaxf(s2_ * (1.f / 64.f) - mean_ * mean_, 0.f), rstd_ = __builtin_amdgcn_rsqf(var_ + 64e-5f); \
        const int tt_ = (cj_) * 32 + l31; const size_t mm_ = (size_t)b * T + tt_; const float pm_ = tt_ > 0 ? 1.f : 0.f; \
        const LAS float* yb_ = ybuf + (par_ * 2 + eib) * 1024 + lane; \
        _Pragma("unroll") for (int rg = 0; rg < 2; ++rg) { const int hc_ = h * 64 + 32 * eib + 16 * eh + 8 * rg + 4 * hi; \
            const f32x4 mu_ = emu[rg], lw_ = elw[rg], lb_ = elb[rg]; \
            const float vc_[4] = {bflo(X.vc[rg].x), bfhi(X.vc[rg].x), bflo(X.vc[rg].y), bfhi(X.vc[rg].y)}, vp_[4] = {bflo(X.vp[rg].x), bfhi(X.vp[rg].x), bflo(X.vp[rg].y), bfhi(X.vp[rg].y)}; \
            const float g4_[4] = {bflo(X.ga[rg].x), bfhi(X.ga[rg].x), bflo(X.ga[rg].y), bfhi(X.ga[rg].y)}; float o_[4]; \
            _Pragma("unroll") for (int e = 0; e < 4; ++e) { const float vv_ = vc_[e] + (vp_[e] * pm_ - vc_[e]) * mu_[e]; \
                const float yn_ = (yb_[(4 * (2 * eh + rg) + e) * 64] - mean_) * rstd_ * lw_[e] + lb_[e] + X.rho * vv_; o_[e] = yn_ * g4_[e] * __builtin_amdgcn_rcpf(1.f + __expf(-g4_[e])); } \
            *(GAS v2u*)(F.MIX + mm_ * D + hc_) = (v2u){cvtpk(o_[0], o_[1]), cvtpk(o_[2], o_[3])}; } } while (0)
    f32x16 S[2]; S[0] = f32x16{}; S[1] = f32x16{};
    const int ib = wid & 1;
#define CONS(ci_) do { const LAS unsigned char* bb = lds + ((ci_) & 1) * RB_BUF; \
          \
        v4u pf_[8], qf_[4], dd_[4], yd_[2]; f32x4 gm_[8]; \
        _Pragma("unroll") for (int q = 0; q < 8; ++q) gm_[q] = *(const LAS f32x4*)(bb + RB_GAM + (hi * 32 + 4 * q) * 4); \
        _Pragma("unroll") for (int q = 0; q < 4; ++q) dd_[q] = *(const LAS v4u*)(bb + RB_DD + ((((q >> 1) * 2 + ib) * 2 + (q & 1)) * 64 + lane) * 16); \
        _Pragma("unroll") for (int q = 0; q < 8; ++q) pf_[q] = *(const LAS v4u*)(bb + RB_PF + (q * 64 + lane) * 16); \
        _Pragma("unroll") for (int q = 0; q < 2; ++q) yd_[q] = *(const LAS v4u*)(bb + RB_YD + ((2 * ib + q) * 64 + lane) * 16); \
        _Pragma("unroll") for (int q = 0; q < 4; ++q) qf_[q] = *(const LAS v4u*)(bb + RB_QF + (q * 64 + lane) * 16); \
        __builtin_amdgcn_sched_barrier(0); \
        v4u Sf[4]; _Pragma("unroll") for (int s = 0; s < 4; ++s) Sf[s] = FRAGACC(S[s >> 1], s & 1); \
        _Pragma("unroll") for (int rb = 0; rb < 2; ++rb) { \
            f32x16 acc; unpack16(dd_[2 * rb], dd_[2 * rb + 1], acc); \
            _Pragma("unroll") for (int q = 0; q < 4; ++q) { const f32x4 gv = gm_[4 * rb + q]; _Pragma("unroll") for (int e = 0; e < 4; ++e) acc[4 * q + e] += gv[e] * S[rb][4 * q + e]; } \
            _Pragma("unroll") for (int s = 0; s < 4; ++s) acc = MFMA32(pf_[rb * 4 + s], Sf[s], acc); \
            S[rb] = acc; } \
        f32x16 y; unpack16(yd_[0], yd_[1], y); \
        _Pragma("unroll") for (int s = 0; s < 4; ++s) y = MFMA32(Sf[s], qf_[s], y); \
        float s1 = 0.f, s2 = 0.f; LAS float* yb_ = ybuf + (((ci_) & 1) * 2 + ib) * 1024 + lane; \
        _Pragma("unroll") for (int r = 0; r < 16; ++r) { s1 += y[r]; s2 += y[r] * y[r]; yb_[r * 64] = y[r]; } \
        s1 = swap32_sum(s1); s2 = swap32_sum(s2); \
        if (hi == 0) { stat[((((ci_) & 1) * 2 + ib) * 32 + l31) * 2] = s1; stat[((((ci_) & 1) * 2 + ib) * 32 + l31) * 2 + 1] = s2; } } while (0)
#define RB_BAR() do { asm volatile("s_waitcnt lgkmcnt(0)" ::: "memory"); __builtin_amdgcn_s_barrier(); asm volatile("" ::: "memory"); } while (0)
    if (wid < 2) {
        RB_BAR();
#pragma unroll 1
        for (int k = 0; k < NS; ++k) { CONS(k); RB_BAR(); }
        RB_BAR();
    } else {
        const bool epi = (wid != 4 && wid != 5);
        RbStage sA, sB, sC; RbEpi eA, eB, eC; f32x4 emu[2], elw[2], elb[2];
#pragma unroll
        for (int rg = 0; rg < 2; ++rg) { const int hc_ = h * 64 + 32 * eib + 16 * eh + 8 * rg + 4 * hi; emu[rg] = *(const GAS f32x4*)(F.shift_mu + 1024 + hc_); elw[rg] = *(const GAS f32x4*)(F.ln_w + hc_); elb[rg] = *(const GAS f32x4*)(F.ln_b + hc_); }
        ST_LOAD(sA, 0); ST_LOAD(sB, 1); ST_LOAD(sC, 2); ST_STORE(sA, 0); ST_LOAD(sA, 3);
        if (epi) { EP_LOAD(eA, 0); EP_LOAD(eB, 1); }
        RB_BAR();
        ST_STORE(sB, 1); ST_LOAD(sB, 4); if (epi) EP_LOAD(eC, 2); RB_BAR();
#define HY_STEP(k_, SN, EP) do { ST_STORE(SN, ((k_) + 1) & 1); ST_LOAD(SN, (k_) + 4); if (epi) { EP_RUN(EP, (k_) - 1); EP_LOAD(EP, (k_) + 2); } RB_BAR(); } while (0)
#pragma unroll 1
        for (int k = 1; k < NS; k += 3) { HY_STEP(k, sC, eA); HY_STEP(k + 1, sA, eB); HY_STEP(k + 2, sB, eC); }
        if (epi) EP_RUN(eA, NS - 1);
        RB_BAR();
#undef HY_STEP
    }
#undef RB_BAR
#undef ST_LOAD
#undef ST_STORE
#undef EP_LOAD
#undef EP_RUN
#undef CONS
}
constexpr int CW_G17 = 12288;
struct OneUnit { int pm, pn;
    __device__ __forceinline__ bool next(int i, pg8::Unit& u) const { if (i != 0) return false; u.pm = pm; u.pn = pn; return true; }
    __device__ __forceinline__ void a_ready(const pg8::Unit&) const {}
    __device__ __forceinline__ void done(const pg8::Unit&) const {} };
constexpr int AT_KB = 64 * 256, AT_VB = 64 * 256, AT_BUF = AT_KB + AT_VB, AT_QOFF = 2 * AT_KB + 3 * AT_VB;
__device__ __forceinline__ s16x4 vtr(const LAS unsigned char* p) { typedef short v4i16_t __attribute__((ext_vector_type(4))); return __builtin_bit_cast(s16x4, __builtin_amdgcn_ds_read_tr16_b64_v4i16((LAS v4i16_t*)p)); }
__device__ __forceinline__ void attn_unit(Frame& F, int b, int h, int qb) {
    int lane = mk_lane(); asm volatile("" : "+v"(lane));
    const int wid = F.wave, tid = wid * 64 + lane, l31 = lane & 31, hi = lane >> 5, map = wid >> 2, qs = wid & 3;
    LAS unsigned char* lds = F.lds + RING_OFF;
    const float slope2 = exp2f(-2.f * (float)(h + 1)) * LOG2E, shift2 = __uint_as_float(F.MISC[15]);
    const int q0 = qb * 128, qrow = q0 + 32 * qs + l31;
    const size_t mrow = (size_t)b * T + qrow;
    LAS bf16x8* qpark = (LAS bf16x8*)(lds + AT_QOFF + wid * 4096) + lane;
    { const bf16* qp = F.PROJ + mrow * NP + C_DQ + h * 128 + map * 64 + 8 * hi;
#pragma unroll
      for (int s = 0; s < 4; ++s) qpark[s * 64] = *(const GAS bf16x8*)(qp + 16 * s); }
    const bf16* kg = F.PROJ + (size_t)b * T * NP + C_DK + h * 128;
    const bf16* vg = F.PROJ + (size_t)b * T * NP + C_DV + h * 128;
    const int NT = 2 * qb + 2, tl = 2 * qb + (qs >> 1);
    const int Wk = (int)__builtin_ceilf((2.f * shift2 + 32.2f) / slope2);
    const int tf = __builtin_amdgcn_readfirstlane(max(0, (qb * 128 - Wk) >> 6));
    constexpr int AT_V0 = 2 * AT_KB;
    const int drow0 = 4 * wid + (lane >> 4), drow1 = drow0 + 32, dch = lane & 15;
    const unsigned ksrc0 = (unsigned)(drow0 * NP + ((dch ^ (drow0 & 15)) * 8)), ksrc1 = (unsigned)(drow1 * NP + ((dch ^ (drow1 & 15)) * 8));
    const unsigned vsrc0 = (unsigned)(drow0 * NP + ((dch ^ ((drow0 & 3) << 2)) * 8)), vsrc1 = (unsigned)(drow1 * NP + ((dch ^ ((drow1 & 3) << 2)) * 8));
#define AT_DMA(t_, kb_, v3_) do { const size_t tb_ = (size_t)(64 * (t_)) * NP; LAS unsigned char* bk_ = lds + (kb_) * AT_KB + wid * 1024; LAS unsigned char* bv_ = lds + AT_V0 + (v3_) * AT_VB + wid * 1024; \
        __builtin_amdgcn_global_load_lds((const unsigned*)(kg + tb_ + ksrc0), (LAS unsigned*)bk_, 16, 0, 0); __builtin_amdgcn_global_load_lds((const unsigned*)(kg + tb_ + ksrc1), (LAS unsigned*)(bk_ + 8192), 16, 0, 0); \
        __builtin_amdgcn_global_load_lds((const unsigned*)(vg + tb_ + vsrc0), (LAS unsigned*)bv_, 16, 0, 0); __builtin_amdgcn_global_load_lds((const unsigned*)(vg + tb_ + vsrc1), (LAS unsigned*)(bv_ + 8192), 16, 0, 0); } while (0)
    f32x16 o[4];
#pragma unroll
    for (int vb = 0; vb < 4; ++vb) o[vb] = f32x16{};
    float lsum = 0.f;
    AT_DMA(tf, tf & 1, tf % 3);
    __syncthreads();
    const int G = lane >> 4, qq = (lane & 15) >> 2, pp = lane & 3;
    const int vrow = (4 * hi + qq) * 256 + 8 * (pp & 1), vch = 2 * (G & 1) + (pp >> 1);
    v4u pw[4];
#define SBAR_() __builtin_amdgcn_sched_barrier(0)
#define AT_QK(t) do { \
            const LAS unsigned char* Kb = lds + ((t) & 1) * AT_KB; \
            float sl_ = slope2; asm volatile("" : "+v"(sl_));     \
            const float base = sl_ * (float)(64 * (t) + 4 * hi - qrow) - shift2; \
            float ls = 0.f; \
            _Pragma("unroll") for (int hf = 0; hf < 2; ++hf) {        \
                f32x16 p; \
                _Pragma("unroll") for (int r = 0; r < 16; ++r) p[r] = __builtin_fmaf(sl_, (float)(32 * hf + (r & 3) + 8 * (r >> 2)), base); \
                _Pragma("unroll") for (int s = 0; s < 4; ++s) { \
                    const bf16x8 a0 = *(const LAS bf16x8*)(Kb + (32 * hf + l31) * 256 + (((map * 8 + 2 * s + hi) ^ (l31 & 15)) * 16)); \
                    p = __builtin_amdgcn_mfma_f32_32x32x16_bf16(a0, qpark[s * 64], p, 0, 0, 0); } \
                if ((t) == tl) { \
                    _Pragma("unroll") for (int r = 0; r < 16; ++r) { const int ki = 64 * (t) + 32 * hf + 4 * hi + (r & 3) + 8 * (r >> 2); if (ki > qrow) p[r] = -1e30f; } } \
                _Pragma("unroll") for (int r = 0; r < 16; ++r) { p[r] = __builtin_amdgcn_exp2f(p[r]); ls += p[r]; } \
                pw[2 * hf] = (v4u){cvtpk(p[0], p[1]), cvtpk(p[2], p[3]), cvtpk(p[4], p[5]), cvtpk(p[6], p[7])}; \
                pw[2 * hf + 1] = (v4u){cvtpk(p[8], p[9]), cvtpk(p[10], p[11]), cvtpk(p[12], p[13]), cvtpk(p[14], p[15])}; } \
            lsum += ls; } while (0)
#define AT_VRD(dst, ks, vb0) do { _Pragma("unroll") for (int vb = (vb0); vb < (vb0) + 2; ++vb) { const LAS unsigned char* a_ = Vb + vrow + ((4 * vb + vch) ^ (qq << 2)) * 16 + (32 * ((ks) >> 1) + 16 * ((ks) & 1)) * 256; \
        dst[2 * (vb - (vb0))] = vtr(a_); dst[2 * (vb - (vb0)) + 1] = vtr(a_ + 8 * 256); } } while (0)
#define AT_PV(src, pwk, vb0) do { _Pragma("unroll") for (int vb = (vb0); vb < (vb0) + 2; ++vb) { const int j_ = 2 * (vb - (vb0)); \
        const bf16x8 vf = (bf16x8){src[j_][0], src[j_][1], src[j_][2], src[j_][3], src[j_ + 1][0], src[j_ + 1][1], src[j_ + 1][2], src[j_ + 1][3]}; \
        o[vb] = __builtin_amdgcn_mfma_f32_32x32x16_bf16(vf, __builtin_bit_cast(bf16x8, pwk), o[vb], 0, 0, 0); } } while (0)
#define AT_PVV(v3_) do { const LAS unsigned char* Vb = lds + AT_V0 + (v3_) * AT_VB; s16x4 vA[4], vB[4]; \
            AT_VRD(vA, 0, 0); SBAR_(); AT_VRD(vB, 0, 2); SBAR_(); \
            AT_PV(vA, pw[0], 0); SBAR_(); AT_VRD(vA, 1, 0); SBAR_(); AT_PV(vB, pw[0], 2); SBAR_(); AT_VRD(vB, 1, 2); SBAR_(); \
            AT_PV(vA, pw[1], 0); SBAR_(); AT_VRD(vA, 2, 0); SBAR_(); AT_PV(vB, pw[1], 2); SBAR_(); AT_VRD(vB, 2, 2); SBAR_(); \
            AT_PV(vA, pw[2], 0); SBAR_(); AT_VRD(vA, 3, 0); SBAR_(); AT_PV(vB, pw[2], 2); SBAR_(); AT_VRD(vB, 3, 2); SBAR_(); \
            AT_PV(vA, pw[3], 0); SBAR_(); AT_PV(vB, pw[3], 2); } while (0)
    if (map == 0) {
        int v3 = tf % 3;
#pragma unroll 1
        for (int t = tf; t < NT; ++t) { const int vn = v3 == 2 ? 0 : v3 + 1;
            if (t + 1 < NT) AT_DMA(t + 1, (t + 1) & 1, vn);
            if (t <= tl) { AT_QK(t); AT_PVV(v3); }
            __syncthreads(); v3 = vn; }
    } else {
        int v3 = tf % 3;
#pragma unroll 1
        for (int t = tf; t < NT; ++t) { const int vp = v3 == 0 ? 2 : v3 - 1, vn = v3 == 2 ? 0 : v3 + 1;
            if (t + 1 < NT) AT_DMA(t + 1, (t + 1) & 1, vn);
            if (t > tf && t - 1 <= tl) AT_PVV(vp);
            if (t <= tl) AT_QK(t);
            __syncthreads(); v3 = vn; }
        if (NT - 1 <= tl) { const int vp = v3 == 0 ? 2 : v3 - 1; AT_PVV(vp); }
    }
#undef AT_PVV
#undef AT_QK
#undef AT_VRD
#undef AT_PV
#undef SBAR_
#undef AT_DMA
    __syncthreads();
    const float ltot = swap32_sum(lsum);
    LAS float* X = (LAS float*)lds;
    if (map == 1) {
        const float sc = __uint_as_float(F.MISC[14]) / ltot;
#pragma unroll
        for (int vb = 0; vb < 4; ++vb)
#pragma unroll
            for (int r = 0; r < 16; ++r) X[(qs * 64 + vb * 16 + r) * 64 + lane] = o[vb][r] * sc;
    }
    __syncthreads();
    if (map == 0) {
        const float il = 1.f / ltot; float ss = 0.f;
#pragma unroll
        for (int vb = 0; vb < 4; ++vb)
#pragma unroll
            for (int r = 0; r < 16; ++r) { const float v = o[vb][r] * il - X[(qs * 64 + vb * 16 + r) * 64 + lane]; o[vb][r] = v; ss += v * v; }
        ss = swap32_sum(ss);
        const float rn = (1.f / sqrtf(ss * (1.f / 128.f) + 1e-5f)) * (1.f - LAMBDA_INIT);
        int etok = 0; asm volatile("" : "+v"(etok));
        const int lane_e = mk_lane(), hi = lane_e >> 5;
        const size_t mrow_e = (size_t)b * T + qb * 128 + 32 * qs + (lane_e & 31);
        const bf16* gp = F.PROJ + mrow_e * NP + C_GB + h * 128;
        bf16* op = F.MIX + mrow_e * D + 512 + h * 128;
#pragma unroll
        for (int vb = 0; vb < 4; ++vb)
#pragma unroll
            for (int rg = 0; rg < 4; ++rg) {
                const int vc = 32 * vb + 8 * rg + 4 * hi + etok;
                const v2u gw = *(const GAS v2u*)(gp + vc); const f32x4 sg = *(const GAS f32x4*)(F.subln_g + vc);
                const float g4[4] = {bflo(gw.x), bfhi(gw.x), bflo(gw.y), bfhi(gw.y)}; float ov[4];
#pragma unroll
                for (int e = 0; e < 4; ++e) ov[e] = o[vb][4 * rg + e] * rn * sg[e] * g4[e] / (1.f + __expf(-g4[e]));
                const unsigned w1_ = cvtpk(ov[2], ov[3]);
                *(GAS v2u*)(op + vc) = (v2u){cvtpk(ov[0], ov[1]), w1_};
                if (rg == 3) asm volatile("" : "+v"(etok) : "v"(w1_));
            }
    }
    __syncthreads();
}
#ifndef DBL
#define DBL 0
#endif
constexpr int CW_QUEUE = 8192;
constexpr int QX_RW = 8, QX_A2 = 0, QX_AT = 64, QX_ALL = QX_RW + QX_A2 + QX_AT;
__device__ __forceinline__ void p3_queue(Frame& F, const RwDump& Dm, const int qbase = CW_QUEUE) {
    const int ql = mk_lane();
    const float l1 = wave_sum(F.lq1[ql] * F.lk1[ql]), l2 = wave_sum(F.lq2[ql] * F.lk2[ql]);
    const float lam = __uint_as_float(__builtin_amdgcn_readfirstlane(__float_as_uint(__expf(l1) - __expf(l2) + LAMBDA_INIT)));
    float gq = fabsf(F.qn_g[ql]), gk = fabsf(F.kn_g[ql]);
#pragma unroll
    for (int o = 1; o < 64; o <<= 1) { gq = fmaxf(gq, __shfl_xor(gq, o)); gk = fmaxf(gk, __shfl_xor(gk, o)); }
    const float shift2 = __uint_as_float(__builtin_amdgcn_readfirstlane(__float_as_uint(8.f * gq * gk * LOG2E)));
    if (F.wave == 0 && mk_lane() == 0) { F.MISC[14] = __float_as_uint(lam); F.MISC[15] = __float_as_uint(shift2); }
    __syncthreads();
#ifdef Q_BLK
    const int x0 = (int)(blockIdx.x & 7);
#else
    const int x0 = (int)(xb_xcc_id() & 7u);
#endif
#pragma unroll 1
    for (int dx = 0; dx < 8; ++dx) {
        const int xq = (x0 + dx) & 7;
        for (;;) {
            if (F.wave == 0 && mk_lane() == 0) F.MISC[12] = __hip_atomic_fetch_add(F.ctl + qbase + 64 * xq, 1u, RLX_AGENT);
            __syncthreads();
            const int item = __builtin_amdgcn_readfirstlane((int)F.MISC[12]);
            __syncthreads();
            if (item >= QX_ALL) break;
            if (item < QX_RW) { rwkvB_unit(F, Dm, xq * 8 + item); if (DBL & 64) rwkvB_unit(F, Dm, xq * 8 + item); }
            else { const int idx = item - QX_RW - QX_A2, h = 3 - (idx >> 4), qb = 15 - (idx & 15);
#pragma unroll 1
#ifndef NO_ATT
                for (int rep = 0; rep < ((DBL & 32) ? 2 : 1); ++rep) attn_unit(F, xq, h, qb);
#endif
            }
        }
    }
}

struct Args { const float* in[21]; float* out; unsigned char* ws; int ph_lo, ph_hi; };
__global__ void __launch_bounds__(NWAVES * 64, 2) hymba_fwd(Args args) {
    extern __shared__ __attribute__((aligned(16))) unsigned char lds[];
    Frame F;
    F.lds = (LAS unsigned char*)lds;
    F.MISC = (volatile LAS unsigned*)(F.lds + MISC_OFF);
    F.wave = __builtin_amdgcn_readfirstlane((int)threadIdx.x >> 6); F.lane = mk_lane(); F.tid = F.wave * 64 + F.lane;
    F.G = gridDim.x; { const int bx = blockIdx.x; F.vcu = (F.G % 8 == 0) ? (bx % 8) * (F.G / 8) + bx / 8 : bx; }
    unsigned char* ws = args.ws;
    F.ctl = (gu32*)(ws + WS_CTL);
    F.x = args.in[0]; F.norm_g = args.in[1]; F.w_in = args.in[2]; F.shift_mu = args.in[3]; F.w0 = args.in[4]; F.w_decay_up = args.in[5]; F.a0 = args.in[6]; F.w_iclr_up = args.in[7];
    F.k_k = args.in[8]; F.k_a = args.in[9]; F.r_k = args.in[10]; F.ln_w = args.in[11]; F.ln_b = args.in[12]; F.qn_g = args.in[13]; F.kn_g = args.in[14];
    F.lq1 = args.in[15]; F.lk1 = args.in[16]; F.lq2 = args.in[17]; F.lk2 = args.in[18]; F.subln_g = args.in[19]; F.w_out = args.in[20]; F.out = args.out;
    F.WinT = (bf16*)(ws + WS_WIN); F.WoutT = (bf16*)(ws + WS_WOUT); F.WdT = (bf16*)(ws + WS_WD); F.WaT = (bf16*)(ws + WS_WA);
    F.XN = (bf16*)(ws + WS_XN); F.PROJ = (bf16*)(ws + WS_PROJ); F.MIX = (bf16*)(ws + WS_MIX);
    for (int u = F.tid; u < (LDS_BYTES - LDSCTL_OFF) / 4; u += NWAVES * 64) ((LAS unsigned*)(F.lds + LDSCTL_OFF))[u] = 0u;
    __syncthreads();
    XcdBarrier bar; bar.bar = (unsigned*)(F.ctl + CW_BAR); bar.x = 0; bar.st = nullptr; bar.wave = F.wave;
    if (MK_N_LAUNCHES == 1) bar = xcd_barrier_post((unsigned*)(F.ctl + CW_BAR), F.MISC + 8, F.wave);
#define GRID_BAR() do { if (MK_N_LAUNCHES == 1) xcd_barrier(bar); } while (0)
    const int lo = args.ph_lo, hi = args.ph_hi;
#define IN(k) (lo <= (k) && (k) < hi)
#define BOTH(k) (IN(k) && IN((k) + 1))
#ifndef SKIP
#define SKIP 0
#endif
    if (IN(0) && !(SKIP & 1)) { p0_prologue(F); if (DBL & 1) { GRID_BAR(); p0_prologue(F); } if (BOTH(0)) GRID_BAR(); }
    if (IN(1) && !(SKIP & 2)) {
        pg8::Gemm g{F.XN, F.WinT, M, NP, D}; pg8::StaticOrder S; S.init(M, NP, F.G, (int)blockIdx.x);
        pg8::EpiBf16S E{F.PROJ, NP};
        pg8::gemm_phase<pg8::EpiBf16S, pg8::StaticOrder, true, true>(F.lds + RING_OFF, g, S, E, F.wave);
        if (DBL & 2) { GRID_BAR(); pg8::gemm_phase<pg8::EpiBf16S, pg8::StaticOrder, true, true>(F.lds + RING_OFF, g, S, E, F.wave); }
        if (BOTH(1)) GRID_BAR();
    }
    RwDump Dm; { unsigned char* so = (unsigned char*)args.out; Dm.PF = (v4u*)so; Dm.DD = (v4u*)(so + 32 * MiB); Dm.QF = (v4u*)(ws + WS_XN); Dm.YD = (v4u*)(ws + WS_XN + 16 * MiB);
        Dm.GAM = (float*)(ws + WS_END); Dm.RHO = (float*)(ws + WS_END + 1 * MiB); }
    if (IN(2) && !(SKIP & 4)) {
        LAS float* wscr = (LAS float*)(F.lds + LDSCTL_OFF + 1024) + F.wave * 64; int zpar = 0;
#pragma unroll 1
        for (int p = F.vcu; p < BATCH * (T / 32); p += F.G) { rwkvA_unit(F, Dm, (p >> 6) * RH + F.wave, p & 63, wscr, F.lds + RING_OFF + F.wave * 16384, (LAS v4u*)(F.lds + LDSCTL_OFF + 4096), zpar); zpar ^= 1; }
        if (DBL & 4) { GRID_BAR();
#pragma unroll 1
            for (int p = F.vcu; p < BATCH * (T / 32); p += F.G) { rwkvA_unit(F, Dm, (p >> 6) * RH + F.wave, p & 63, wscr, F.lds + RING_OFF + F.wave * 16384, (LAS v4u*)(F.lds + LDSCTL_OFF + 4096), zpar); zpar ^= 1; } }
        p2_qknorm(F);
        if (BOTH(2)) GRID_BAR();
    }
    if (IN(3) && !(SKIP & 8)) {
        p3_queue(F, Dm);
        if (DBL & 512) { GRID_BAR(); p3_queue(F, Dm, CW_QUEUE + 1024); }
        if (BOTH(3)) GRID_BAR();
    }
    if (IN(4) && !(SKIP & 16)) {
        pg8::Gemm g{F.MIX, F.WoutT, M, D, D}; pg8::StaticOrder S; S.init(M, D, F.G, (int)blockIdx.x);
        pg8::EpiResF32 E{F.x, F.out, D};
        pg8::gemm_phase<pg8::EpiResF32, pg8::StaticOrder, false, true>(F.lds + RING_OFF, g, S, E, F.wave);
        if (DBL & 16) { GRID_BAR(); pg8::gemm_phase<pg8::EpiResF32, pg8::StaticOrder, false, true>(F.lds + RING_OFF, g, S, E, F.wave); }
    }
#undef IN
#undef BOTH
}

extern "C" void kernel_launch(void* const* d_in, const int* in_sizes, int n_in, void* d_out, int out_size, void* d_ws, size_t ws_size, hipStream_t stream) {
    static int grid = 0;
    if (grid == 0) {
        if (n_in != 21 || in_sizes[0] != M * D || out_size != M * D || ws_size < WS_END + 2 * MiB) { fprintf(stderr, "kernel_launch: unexpected shapes (n_in %d, in0 %d, out %d, ws %zu); nothing launched\n", n_in, n_in > 0 ? in_sizes[0] : -1, out_size, ws_size); grid = -1; return; }
        int dev = 0, cus = 0, per_cu = 0;
        if (hipGetDevice(&dev) != hipSuccess || hipDeviceGetAttribute(&cus, hipDeviceAttributeMultiprocessorCount, dev) != hipSuccess) { grid = -1; return; }
        if (hipFuncSetAttribute((const void*)hymba_fwd, hipFuncAttributeMaxDynamicSharedMemorySize, LDS_BYTES) != hipSuccess) { fprintf(stderr, "kernel_launch: hipFuncSetAttribute failed\n"); grid = -1; return; }
        if (hipOccupancyMaxActiveBlocksPerMultiprocessor(&per_cu, (const void*)hymba_fwd, NWAVES * 64, LDS_BYTES) != hipSuccess || per_cu < 1) { fprintf(stderr, "kernel_launch: occupancy query reports %d workgroups per CU; nothing launched\n", per_cu); grid = -1; return; }
        (void)hipGetLastError();
        grid = cus;
        if (grid > 256) grid = 256;
    }
    if (grid < 0) return;
    if (hipMemsetAsync((char*)d_ws + WS_CTL, 0, CTL_ZERO_BYTES, stream) != hipSuccess) { fprintf(stderr, "kernel_launch: hipMemsetAsync failed\n"); return; }
    Args a{};
    for (int i = 0; i < 21; ++i) a.in[i] = (const float*)d_in[i];
    a.out = (float*)d_out; a.ws = (unsigned char*)d_ws;
    for (int li = 0; li < MK_N_LAUNCHES; ++li) {
        a.ph_lo = (MK_N_LAUNCHES == 1) ? 0 : li; a.ph_hi = (MK_N_LAUNCHES == 1) ? N_PHASES : li + 1;
        hipLaunchKernelGGL(hymba_fwd, dim3(grid), dim3(NWAVES * 64), LDS_BYTES, stream, a);
        const hipError_t le = hipPeekAtLastError();
        if (le != hipSuccess) { fprintf(stderr, "kernel_launch: launch %d failed: %s\n", li, hipGetErrorName(le)); break; }
    }
}
```

```cpp
#include <hip/hip_runtime.h>
#include <hip/hip_bf16.h>
#include <cstdio>
#include <cstdint>
#include <cmath>
namespace pg8 {
#define PG8_LAS __attribute__((address_space(3)))
typedef unsigned short bf16_t;
typedef short bf16x8 __attribute__((ext_vector_type(8)));
typedef float f32x4 __attribute__((ext_vector_type(4)));
typedef unsigned u32x4 __attribute__((ext_vector_type(4)));
constexpr int BM = 256, BK = 64, HALF = 128, HTB = HALF * BK * 2  , STAGE_BYTES = 8 * HTB, NXCD = 8, WGM = 8;

__host__ __device__ __forceinline__ int lds_byte(int r, int c) { const int st = (r >> 4) * 2 + (c >> 5), rr = r & 15, cc = c & 31, ob = rr * 64 + cc * 2; return st * 1024 + (ob ^ (((ob >> 9) & 1) << 5)); }
__host__ __device__ __forceinline__ void stage_rc(int b, int& R, int& C) { const int st = b / 1024, sb = b % 1024, swz = sb ^ (((sb >> 9) & 1) << 5); R = (st >> 1) * 16 + swz / 64; C = (st & 1) * 32 + (swz % 64) / 2; }
__host__ __device__ __forceinline__ int perm32(int rho) { const int n = rho >> 4, i = rho & 15; return 8 * (i >> 2) + 4 * n + (i & 3); }

__device__ __forceinline__ int mk_lane_pg8() { int l; asm volatile("v_mbcnt_lo_u32_b32 %0, -1, 0\n\tv_mbcnt_hi_u32_b32 %0, -1, %0" : "=v"(l)); return l; }
struct Unit { int pm, pn; };
struct Gemm { const bf16_t* A; const bf16_t* Bt; int M, N, K; };

struct StaticOrder {
    int nM, nN, nwg, G, c;
    __host__ __device__ void init(int M, int N, int G_, int c_) { nM = M / BM; nN = N / BM; nwg = nM * nN; G = G_; c = c_; }
    __host__ __device__ bool next(int i, Unit& u) const {
        const long L = (long)i * G + c; if (L >= nwg) return false;
        int wgid = (int)L; { const int q = nwg / NXCD, r = nwg % NXCD, xcd = wgid % NXCD, off = wgid / NXCD; wgid = (xcd < r ? xcd * (q + 1) : r * (q + 1) + (xcd - r) * q) + off; }
        const int nig = WGM * nN, gid = wgid / nig, fm = gid * WGM, gsz = (nM - fm) < WGM ? (nM - fm) : WGM;
        u.pm = fm + ((wgid % nig) % gsz); u.pn = (wgid % nig) / gsz; return true;
    }
    __device__ __forceinline__ void a_ready(const Unit&) const {}
    __device__ __forceinline__ void done(const Unit&) const {}
};

__device__ __forceinline__ unsigned cvt_pk_bf16(float lo, float hi) { unsigned r; asm volatile("v_cvt_pk_bf16_f32 %0, %1, %2" : "=v"(r) : "v"(lo), "v"(hi)); return r; }
struct EpiBf16S {
    static constexpr bool PERM = true, AFTER_DRAIN = false, HAS_INIT = false;
    bf16_t* O; int ldc;
    __device__ __forceinline__ void operator()(const f32x4 (&acc)[2][2][4][2], const Unit& u, int wr, int wc, int fr, int fq) const {
        const int row0 = u.pm * BM + wr * 64 + fr, col0 = u.pn * BM + wc * 32 + 8 * fq;
#pragma unroll
        for (int ai = 0; ai < 2; ++ai)
#pragma unroll
            for (int m = 0; m < 4; ++m) { bf16_t* rowp = O + (size_t)(row0 + ai * HALF + m * 16) * ldc + col0;
#pragma unroll
                for (int bj = 0; bj < 2; ++bj) { const f32x4 v0 = acc[ai][bj][m][0], v1 = acc[ai][bj][m][1];
                    u32x4 w; w.x = cvt_pk_bf16(v0[0], v0[1]); w.y = cvt_pk_bf16(v0[2], v0[3]); w.z = cvt_pk_bf16(v1[0], v1[1]); w.w = cvt_pk_bf16(v1[2], v1[3]);
                    *(u32x4*)(rowp + bj * HALF) = w; } }
    }
};
struct EpiResF32 {
    static constexpr bool PERM = false, AFTER_DRAIN = false, HAS_INIT = true;
    const float* base; float* out; int ldc;
    __device__ __forceinline__ void init(f32x4 (&acc)[2][2][4][2], const Unit& u, int wr, int wc, int fr, int fq) const {
        const int row0 = u.pm * BM + wr * 64 + fr, col0 = u.pn * BM + wc * 32 + 4 * fq;
#pragma unroll
        for (int ai = 0; ai < 2; ++ai)
#pragma unroll
            for (int m = 0; m < 4; ++m) { const size_t off = (size_t)(row0 + ai * HALF + m * 16) * ldc + col0;
#pragma unroll
                for (int bj = 0; bj < 2; ++bj)
#pragma unroll
                    for (int n = 0; n < 2; ++n) acc[ai][bj][m][n] = *(const f32x4*)(base + off + bj * HALF + n * 16); }
    }
    __device__ __forceinline__ void operator()(const f32x4 (&acc)[2][2][4][2], const Unit& u, int wr, int wc, int fr, int fq) const {
        const int row0 = u.pm * BM + wr * 64 + fr, col0 = u.pn * BM + wc * 32 + 4 * fq;
#pragma unroll
        for (int ai = 0; ai < 2; ++ai)
#pragma unroll
            for (int m = 0; m < 4; ++m) { const size_t off = (size_t)(row0 + ai * HALF + m * 16) * ldc + col0;
#pragma unroll
                for (int bj = 0; bj < 2; ++bj)
#pragma unroll
                    for (int n = 0; n < 2; ++n) *(f32x4*)(out + off + bj * HALF + n * 16) = acc[ai][bj][m][n]; }
    }
};
template <class Epi, class Sched, bool ALIGN_EPI = false, bool SP2 = false>
__device__ __forceinline__ void gemm_phase(PG8_LAS unsigned char* lds, const Gemm g, const Sched& S, const Epi& E, const int mk_wave_id  ) {
    const int wid = mk_wave_id, lane = mk_lane_pg8(), tid = wid * 64 + lane, wr = wid >> 2, wc = wid & 3, fr = lane & 15, fq = lane >> 4;
    const int K = g.K, nt = K / BK;
    unsigned voffA[2], voffB[2];
#pragma unroll
    for (int i = 0; i < 2; ++i) { int R, C; stage_rc(tid * 16 + i * 8192, R, C); const int Rb = Epi::PERM ? ((R & ~31) + perm32(R & 31)) : R;
        voffA[i] = (unsigned)(R * K + C) * 2u; voffB[i] = (unsigned)(Rb * K + C) * 2u; }
    const size_t kstep = (size_t)(BK * 2);
    const size_t hstep = (size_t)HALF * K * 2;
    const size_t tstep = 2 * hstep;
    const unsigned ldsw = (unsigned)wid * 1024u;
    const int aoff = lds_byte(wr * 64 + fr, fq * 8), boff = lds_byte(wc * 32 + fr, fq * 8);
#define PG8_SA(b, h) (((b) * 2 + (h)) * HTB)
#define PG8_SB(b, h) ((4 + (b) * 2 + (h)) * HTB)
#define PG8_STAGE(bufoff, gbase, voff) do { _Pragma("unroll") for (int _i = 0; _i < 2; ++_i) \
        __builtin_amdgcn_global_load_lds((const unsigned*)((const char*)(gbase) + (voff)[_i]), (PG8_LAS unsigned*)(lds + (bufoff) + ldsw + _i * 8192), 16, 0, 0); } while (0)
#define PG8_LDA(dst, b, h) do { _Pragma("unroll") for (int m = 0; m < 4; ++m) _Pragma("unroll") for (int k = 0; k < 2; ++k) dst[m][k] = *(const PG8_LAS bf16x8*)(lds + PG8_SA(b, h) + aoff + m * 2048 + k * 1024); } while (0)
#define PG8_LDB(dst, b, h) do { _Pragma("unroll") for (int n = 0; n < 2; ++n) _Pragma("unroll") for (int k = 0; k < 2; ++k) dst[n][k] = *(const PG8_LAS bf16x8*)(lds + PG8_SB(b, h) + boff + n * 2048 + k * 1024); } while (0)
#define PG8_MMA(ai, bj, At, Bt) do { __builtin_amdgcn_s_setprio(1); _Pragma("unroll") for (int m = 0; m < 4; ++m) _Pragma("unroll") for (int n = 0; n < 2; ++n) _Pragma("unroll") for (int k = 0; k < 2; ++k) \
        acc[ai][bj][m][n] = __builtin_amdgcn_mfma_f32_16x16x32_bf16(Bt[n][k], At[m][k], acc[ai][bj][m][n], 0, 0, 0); __builtin_amdgcn_s_setprio(0); } while (0)
#define PG8_WAIT_V(n) asm volatile("s_waitcnt vmcnt(" #n ")" ::: "memory")
#define PG8_WAIT_L(n) asm volatile("s_waitcnt lgkmcnt(" #n ")" ::: "memory")
#define PG8_BAR __builtin_amdgcn_s_barrier()
#define PG8_SCHED __builtin_amdgcn_sched_barrier(0)
    Unit cur, nxt; int ui = 0;
    if (!S.next(0, cur)) return;
    f32x4 acc[2][2][4][2];
#pragma unroll
    for (int a = 0; a < 2; ++a)
#pragma unroll
        for (int b = 0; b < 2; ++b)
#pragma unroll
            for (int m = 0; m < 4; ++m)
#pragma unroll
                for (int n = 0; n < 2; ++n) acc[a][b][m][n] = (f32x4){0.f, 0.f, 0.f, 0.f};
    if constexpr (Epi::HAS_INIT) E.init(acc, cur, wr, wc, fr, fq);
    bf16x8 At[4][2], B0[2][2], B1[2][2];
    const char* cA = (const char*)g.A + (size_t)cur.pm * tstep; const char* cB = (const char*)g.Bt + (size_t)cur.pn * tstep;
    S.a_ready(cur);
    if constexpr (SP2) {
        PG8_STAGE(PG8_SB(0, 0), cB, voffB); PG8_STAGE(PG8_SB(0, 1), cB + hstep, voffB); PG8_STAGE(PG8_SA(0, 0), cA, voffA); PG8_STAGE(PG8_SA(0, 1), cA + hstep, voffA);
        if (wr == 1) PG8_BAR;
        PG8_WAIT_V(2); PG8_BAR;
        PG8_STAGE(PG8_SB(1, 0), cB + kstep, voffB); PG8_STAGE(PG8_SA(1, 0), cA + kstep, voffA); PG8_STAGE(PG8_SB(1, 1), cB + hstep + kstep, voffB);
        PG8_WAIT_V(6); PG8_BAR;
    } else {
        PG8_STAGE(PG8_SB(0, 0), cB, voffB); PG8_STAGE(PG8_SA(0, 0), cA, voffA); PG8_STAGE(PG8_SB(0, 1), cB + hstep, voffB); PG8_STAGE(PG8_SA(0, 1), cA + hstep, voffA);
        if (wr == 1) PG8_BAR;
        PG8_WAIT_V(4); PG8_BAR;
        PG8_STAGE(PG8_SB(1, 0), cB + kstep, voffB); PG8_STAGE(PG8_SA(1, 0), cA + kstep, voffA); PG8_STAGE(PG8_SB(1, 1), cB + hstep + kstep, voffB);
        PG8_WAIT_V(6); PG8_BAR;
    }
    for (;;) {
        const bool has_next = S.next(ui + 1, nxt);
        const char* nA = has_next ? (const char*)g.A + (size_t)nxt.pm * tstep : cA; const char* nB = has_next ? (const char*)g.Bt + (size_t)nxt.pn * tstep : cB;
        for (int t = 0; t < nt; t += 2) {
            const bool last = (t == nt - 2);
            const char* a1 = cA + (size_t)(t + 1) * kstep;
            const char* a2 = last ? nA : cA + (size_t)(t + 2) * kstep; const char* b2 = last ? nB : cB + (size_t)(t + 2) * kstep;
            const char* a3 = a2 + kstep; const char* b3 = b2 + kstep;
            if (last && has_next) S.a_ready(nxt);
            if constexpr (SP2) {
            PG8_LDB(B0, 0, 0); PG8_LDB(B1, 0, 1); PG8_SCHED; PG8_LDA(At, 0, 0); PG8_STAGE(PG8_SA(1, 1), a1 + hstep, voffA);
            PG8_WAIT_V(8); PG8_WAIT_L(0); PG8_BAR; PG8_MMA(0, 0, At, B0); PG8_MMA(0, 1, At, B1); PG8_BAR; PG8_SCHED;
            PG8_LDA(At, 0, 1); PG8_STAGE(PG8_SB(0, 0), b2, voffB); PG8_STAGE(PG8_SB(0, 1), b2 + hstep, voffB); PG8_STAGE(PG8_SA(0, 0), a2, voffA);
            PG8_WAIT_V(8); PG8_WAIT_L(0); PG8_BAR; PG8_MMA(1, 0, At, B0); PG8_MMA(1, 1, At, B1); PG8_BAR; PG8_SCHED;
            PG8_LDB(B0, 1, 0); PG8_LDB(B1, 1, 1); PG8_SCHED; PG8_LDA(At, 1, 0); PG8_STAGE(PG8_SA(0, 1), a2 + hstep, voffA);
            PG8_WAIT_V(8); PG8_WAIT_L(0); PG8_BAR; PG8_MMA(0, 0, At, B0); PG8_MMA(0, 1, At, B1); PG8_BAR; PG8_SCHED;
            PG8_LDA(At, 1, 1); PG8_STAGE(PG8_SB(1, 0), b3, voffB); PG8_STAGE(PG8_SB(1, 1), b3 + hstep, voffB); PG8_STAGE(PG8_SA(1, 0), a3, voffA);
            PG8_WAIT_V(8); PG8_WAIT_L(0); PG8_BAR; PG8_MMA(1, 0, At, B0); PG8_MMA(1, 1, At, B1); PG8_BAR; PG8_SCHED;
            } else {
            PG8_LDB(B0, 0, 0); PG8_SCHED; PG8_LDA(At, 0, 0); PG8_STAGE(PG8_SA(1, 1), a1 + hstep, voffA);
            PG8_WAIT_L(8); PG8_BAR; PG8_WAIT_L(0); PG8_MMA(0, 0, At, B0); PG8_BAR; PG8_SCHED;
            PG8_LDB(B1, 0, 1); PG8_STAGE(PG8_SB(0, 0), b2, voffB);
            PG8_BAR; PG8_WAIT_L(0); PG8_MMA(0, 1, At, B1); PG8_BAR;
            PG8_LDA(At, 0, 1); PG8_STAGE(PG8_SA(0, 0), a2, voffA);
            PG8_BAR; PG8_WAIT_L(0); PG8_MMA(1, 0, At, B0); PG8_BAR; PG8_SCHED;
            PG8_STAGE(PG8_SB(0, 1), b2 + hstep, voffB);
            PG8_WAIT_V(6); PG8_BAR; PG8_MMA(1, 1, At, B1); PG8_BAR;
            PG8_LDB(B0, 1, 0); PG8_SCHED; PG8_LDA(At, 1, 0); PG8_STAGE(PG8_SA(0, 1), a2 + hstep, voffA);
            PG8_WAIT_L(8); PG8_BAR; PG8_WAIT_L(0); PG8_MMA(0, 0, At, B0); PG8_BAR; PG8_SCHED;
            PG8_LDB(B1, 1, 1); PG8_STAGE(PG8_SB(1, 0), b3, voffB);
            PG8_BAR; PG8_WAIT_L(0); PG8_MMA(0, 1, At, B1); PG8_BAR;
            PG8_LDA(At, 1, 1); PG8_STAGE(PG8_SA(1, 0), a3, voffA);
            PG8_BAR; PG8_WAIT_L(0); PG8_MMA(1, 0, At, B0); PG8_BAR; PG8_SCHED;
            PG8_STAGE(PG8_SB(1, 1), b3 + hstep, voffB);
            PG8_WAIT_V(6); PG8_BAR; PG8_MMA(1, 1, At, B1); PG8_BAR;
            }
        }
        if constexpr (ALIGN_EPI) { if (wr == 0) PG8_BAR; }
        if constexpr (!Epi::AFTER_DRAIN) { E(acc, cur, wr, wc, fr, fq); S.done(cur); }
        if (!has_next) break;
#pragma unroll
        for (int a = 0; a < 2; ++a)
#pragma unroll
            for (int b = 0; b < 2; ++b)
#pragma unroll
                for (int m = 0; m < 4; ++m)
#pragma unroll
                    for (int n = 0; n < 2; ++n) acc[a][b][m][n] = (f32x4){0.f, 0.f, 0.f, 0.f};
        if constexpr (Epi::HAS_INIT) E.init(acc, nxt, wr, wc, fr, fq);
        cur = nxt; cA = nA; cB = nB; ++ui;
        if constexpr (ALIGN_EPI) { if (wr == 1) PG8_BAR; }
    }
    PG8_WAIT_V(0);
    if constexpr (!ALIGN_EPI) { if (wr == 0) PG8_BAR; }
    PG8_BAR;
    if constexpr (Epi::AFTER_DRAIN) { E.fused(acc, cur, wr, wc, fr, fq, lds, wid, lane); S.done(cur); }
#undef PG8_SA
#undef PG8_SB
#undef PG8_STAGE
#undef PG8_LDA
#undef PG8_LDB
#undef PG8_MMA
#undef PG8_WAIT_V
#undef PG8_WAIT_L
#undef PG8_BAR
#undef PG8_SCHED
}
}
constexpr int NWAVES = 8;
#ifndef MK_N_LAUNCHES
#define MK_N_LAUNCHES 1
#endif
constexpr int N_PHASES = 5;
constexpr int BATCH = 8, T = 2048, D = 1024, M = BATCH * T;
constexpr int NP = 4352;
constexpr int C_R = 0, C_K = 512, C_V = 1024, C_ZW = 1536, C_ZA = 1600, C_GA = 1792, C_DQ = 2304, C_DK = 2816, C_DV = 3328, C_GB = 3840;
constexpr int RH = 8, RN = 64;
constexpr int AH = 4;
constexpr float C2 = 0.125f * 1.4426950408889634f;
constexpr float LOG2E = 1.4426950408889634f;
constexpr float LAMBDA_INIT = 0.2f;

constexpr size_t MiB = 1u << 20;
constexpr size_t WS_CTL = 0, CTL_ZERO_BYTES = 1 * MiB;
constexpr size_t WS_WIN = 2 * MiB;
constexpr size_t WS_WOUT = 11 * MiB;
constexpr size_t WS_WD = 13 * MiB, WS_WA = 13 * MiB + 65536;
constexpr size_t WS_RHO = 13 * MiB + 2 * 65536;
constexpr size_t WS_XN = 14 * MiB;
constexpr size_t WS_PROJ = 46 * MiB;
constexpr size_t WS_MIX = 182 * MiB;
constexpr size_t WS_END = 214 * MiB;
constexpr int CW_BAR = 4096;

constexpr int RING_OFF = 0, RING_BYTES = 131072;
constexpr int LDSCTL_OFF = RING_BYTES, MISC_OFF = LDSCTL_OFF + 320;
constexpr int LDS_BYTES = 155648;

#define GAS __attribute__((address_space(1)))
#define LAS __attribute__((address_space(3)))
typedef unsigned short bf16;
typedef unsigned v4u __attribute__((ext_vector_type(4)));
typedef unsigned v2u __attribute__((ext_vector_type(2)));
typedef float f32x4 __attribute__((ext_vector_type(4)));
typedef float f32x16 __attribute__((ext_vector_type(16)));
typedef short bf16x8 __attribute__((ext_vector_type(8)));
typedef short s16x4 __attribute__((ext_vector_type(4)));
typedef GAS unsigned gu32;
typedef GAS unsigned long long gu64;
#define RLX_AGENT __ATOMIC_RELAXED, __HIP_MEMORY_SCOPE_AGENT
#define LDS_WAIT() asm volatile("s_waitcnt lgkmcnt(0)" ::: "memory")
#define VM_WAIT() asm volatile("s_waitcnt vmcnt(0)" ::: "memory")
__device__ __forceinline__ unsigned f2bf(float f) { unsigned u = __builtin_bit_cast(unsigned, f); return (u + 0x7fffu + ((u >> 16) & 1u)) >> 16; }
__device__ __forceinline__ unsigned pk2(float lo, float hi) { return f2bf(lo) | (f2bf(hi) << 16); }
__device__ __forceinline__ float bflo(unsigned u) { return __uint_as_float(u << 16); }
__device__ __forceinline__ float bfhi(unsigned u) { return __uint_as_float(u & 0xffff0000u); }
__device__ __forceinline__ float bf1(unsigned short u) { return __uint_as_float((unsigned)u << 16); }
__device__ __forceinline__ int mk_lane() { int l; asm volatile("v_mbcnt_lo_u32_b32 %0, -1, 0\n\tv_mbcnt_hi_u32_b32 %0, -1, %0" : "=v"(l)); return l; }
#define XB_TMO      128
#define XB_XCNT(j)  (256  + 64 * (j))
#define XB_XSUB(j)  (1280 + 64 * (j))
#define XB_XGEN(j)  (2304 + 64 * (j))
#define XB_TOP      3328
#define XB_TOPGEN   3392
#define XCD_BAR_WORDS 3456
#define XB_SPIN_CAP (1u << 18)

__device__ __forceinline__ unsigned xb_ld(unsigned* p)              { return __hip_atomic_load(p, __ATOMIC_RELAXED, __HIP_MEMORY_SCOPE_AGENT); }
__device__ __forceinline__ unsigned xb_add(unsigned* p, unsigned v) { return __hip_atomic_fetch_add(p, v, __ATOMIC_RELAXED, __HIP_MEMORY_SCOPE_AGENT); }
__device__ __forceinline__ unsigned xb_xcc_id() { return (unsigned)__builtin_amdgcn_s_getreg((3 << 11) | 20) & 0xFu; }
#define XB_SPIN(cond, bar) do { unsigned _sp = 0; while (cond) { __builtin_amdgcn_s_sleep(1); \
    if ((++_sp & 255u) == 0u) { if (xb_ld(&(bar)[XB_TMO])) break; if (_sp > XB_SPIN_CAP) { atomicAdd(&(bar)[XB_TMO], 1u); break; } } } } while (0)

struct XcdBarrier {
    unsigned* bar; unsigned x;
    volatile LAS unsigned* st;
    int wave;
};

__device__ __forceinline__ XcdBarrier xcd_barrier_post(unsigned* bar, volatile LAS unsigned* st, int wave) {
    XcdBarrier b; b.bar = bar; b.x = xb_xcc_id(); b.st = st; b.wave = wave;
    if (wave == 0 && mk_lane() == 0) (void)xb_add(&bar[XB_XCNT(b.x)], 1u);
    return b;
}
__device__ __forceinline__ void xcd_barrier_complete(unsigned* bar, unsigned x, unsigned& nloc, unsigned& nx) {
    const unsigned G = gridDim.x * gridDim.y * gridDim.z;
    unsigned sum, cnt, mine, sp = 0u;
    for (;;) {
        sum = 0u; cnt = 0u; mine = 0u;
#pragma unroll
        for (unsigned j = 0; j < 16; ++j) { const unsigned c = xb_ld(&bar[XB_XCNT(j)]); sum += c; cnt += (c > 0u) ? 1u : 0u; mine = (j == x) ? c : mine; }
        if (sum == G) break;
        __builtin_amdgcn_s_sleep(1);
        if ((++sp & 255u) == 0u) { if (xb_ld(&bar[XB_TMO])) break; if (sp > XB_SPIN_CAP) { atomicAdd(&bar[XB_TMO], 1u); break; } }
    }
    nloc = mine > 0u ? mine : 1u; nx = cnt > 0u ? cnt : 1u;
}

__device__ __forceinline__ void xcd_barrier(const XcdBarrier& b) {
    asm volatile("s_waitcnt vmcnt(0)" ::: "memory");
    __syncthreads();
    if (b.wave == 0 && mk_lane() == 0) {
        unsigned* bar = b.bar;
        __builtin_amdgcn_s_waitcnt(0);
        unsigned nloc = b.st[0], nx = b.st[1];
        if (nloc == 0u) { xcd_barrier_complete(bar, b.x, nloc, nx); b.st[0] = nloc; b.st[1] = nx; }
        const unsigned old = xb_add(&bar[XB_XSUB(b.x)], 1u);
        const unsigned gen = old / nloc;
        if (old + 1u == (gen + 1u) * nloc) {
            __builtin_amdgcn_fence(__ATOMIC_RELEASE, "agent");
            asm volatile("s_waitcnt vmcnt(0)" ::: "memory");
            const unsigned og = xb_add(&bar[XB_TOP], 1u);
            const unsigned tg = og / nx;
            if (og + 1u == (tg + 1u) * nx) xb_add(&bar[XB_TOPGEN], 1u);
            else XB_SPIN(xb_ld(&bar[XB_TOPGEN]) == tg, bar);
            __builtin_amdgcn_fence(__ATOMIC_ACQUIRE, "agent");
            xb_add(&bar[XB_XGEN(b.x)], 1u);
            asm volatile("s_waitcnt vmcnt(0)" ::: "memory");
        } else {
            XB_SPIN(xb_ld(&bar[XB_XGEN(b.x)]) == gen, bar);
            __builtin_amdgcn_fence(__ATOMIC_ACQUIRE, "agent");
            asm volatile("s_waitcnt vmcnt(0)" ::: "memory");
        }
    }
    __syncthreads();
}
struct Frame {
    LAS unsigned char* lds;
    volatile LAS unsigned* MISC;
    gu32* ctl;
    int tid, lane, wave;
    int vcu, G;
    const float* x; float* out;
    const float *norm_g, *w_in, *shift_mu, *w0, *w_decay_up, *a0, *w_iclr_up, *k_k, *k_a, *r_k, *ln_w, *ln_b, *qn_g, *kn_g, *lq1, *lk1, *lq2, *lk2, *subln_g, *w_out;
    bf16 *WinT, *WoutT, *WdT, *WaT, *XN, *PROJ, *MIX;
};

typedef float f32x2q_t __attribute__((ext_vector_type(2))); typedef __bf16 bf16x2q_t __attribute__((ext_vector_type(2)));
__device__ __forceinline__ unsigned cvtpk2(float lo, float hi) { f32x2q_t v = {lo, hi}; bf16x2q_t b = __builtin_convertvector(v, bf16x2q_t); return __builtin_bit_cast(unsigned, b); }
__device__ __forceinline__ float wave_sum(float v) {
#pragma unroll
    for (int o = 1; o < 64; o <<= 1) v += __shfl_xor(v, o);
    return v;
}
template <int CTRL> __device__ __forceinline__ float dpp_f(float x) { return __builtin_bit_cast(float, __builtin_amdgcn_mov_dpp(__builtin_bit_cast(int, x), CTRL, 0xf, 0xf, true)); }
__device__ __forceinline__ float row16_sum(float x) {
    x += dpp_f<0xB1>(x); x += dpp_f<0x4E>(x); x += dpp_f<0x141>(x); x += dpp_f<0x140>(x); return x;
}
__device__ __forceinline__ float swap32_sum(float x) {
    auto rr = __builtin_amdgcn_permlane32_swap(__float_as_uint(x), __float_as_uint(x), false, false);
    return __uint_as_float(rr[0]) + __uint_as_float(rr[1]);
}

__device__ __forceinline__ void p0_transpose_item(const float* W, int N, int nsrc, const float* kscale, bf16* WT, int K, int ndst, LAS float* scr, int k0, int lane) {
    float v[32];
#pragma unroll
    for (int i = 0; i < 32; ++i) { const int kk = 2 * i + (lane >> 5); v[i] = (nsrc >= 0) ? W[(size_t)(k0 + kk) * N + nsrc + (lane & 31)] : 0.f; }
    if (kscale && nsrc >= 0) {
#pragma unroll
        for (int i = 0; i < 32; ++i) v[i] *= kscale[k0 + 2 * i + (lane >> 5)];
    }
#pragma unroll
    for (int i = 0; i < 32; ++i) scr[(2 * i + (lane >> 5)) * 33 + (lane & 31)] = v[i];
    LDS_WAIT(); asm volatile("" ::: "memory");
    const int c = lane & 7;
#pragma unroll
    for (int j = 0; j < 4; ++j) { const int n = (lane >> 3) + 8 * j; const LAS float* s = scr + (8 * c) * 33 + n;
        v4u o; o.x = cvtpk2(s[0 * 33], s[1 * 33]); o.y = cvtpk2(s[2 * 33], s[3 * 33]); o.z = cvtpk2(s[4 * 33], s[5 * 33]); o.w = cvtpk2(s[6 * 33], s[7 * 33]);
        *(GAS v4u*)(WT + (size_t)(ndst + n) * K + k0 + 8 * c) = o; }
    LDS_WAIT(); asm volatile("" ::: "memory");
}
__device__ __forceinline__ void p0_rows4(Frame& F, int m0) {
    f32x4 v[4][4]; float s[4];
#pragma unroll
    for (int u = 0; u < 4; ++u) { const GAS f32x4* xr = (const GAS f32x4*)(F.x + (size_t)(m0 + u) * D) + F.lane;
#pragma unroll
        for (int j = 0; j < 4; ++j) v[u][j] = __builtin_nontemporal_load(xr + 64 * j); }
#pragma unroll
    for (int u = 0; u < 4; ++u) { float a = 0.f;
#pragma unroll
        for (int j = 0; j < 4; ++j) a += (v[u][j].x * v[u][j].x + v[u][j].y * v[u][j].y) + (v[u][j].z * v[u][j].z + v[u][j].w * v[u][j].w);
        s[u] = a; }
#pragma unroll
    for (int u = 0; u < 4; ++u) {
        const float rstd = __builtin_amdgcn_rsqf(wave_sum(s[u]) * (1.f / D) + 1e-6f);
        GAS unsigned long long* o8 = (GAS unsigned long long*)(F.XN + (size_t)(m0 + u) * D) + F.lane;
#pragma unroll
        for (int j = 0; j < 4; ++j) o8[64 * j] = (unsigned long long)cvtpk2(v[u][j].x * rstd, v[u][j].y * rstd) | ((unsigned long long)cvtpk2(v[u][j].z * rstd, v[u][j].w * rstd) << 32);
    }
}
__device__ __forceinline__ void p0_prologue(Frame& F) {
    LAS float* scr = (LAS float*)(F.lds + RING_OFF + F.wave * 16384);
    const int gw = F.vcu * NWAVES + F.wave, NGW = F.G * NWAVES;
    constexpr int I_IN = (D / 64) * (NP / 32), I_OUT = (D / 64) * (D / 32), I_L = 512 / 32;
    constexpr int NITEMS = I_IN + I_OUT + 2 * I_L;
    int m0 = gw * 4;
    if (!(gw & 1) && m0 < M) { p0_rows4(F, m0); m0 += NGW * 4; }
#pragma unroll 1
    for (int it = gw; it < NITEMS; it += NGW) {
        int r = it;
        if (r < I_IN) { const int kb = r / (NP / 32), nb = r % (NP / 32), nd = 32 * nb; const int ns = nd < 1664 ? nd : (nd < 1792 ? -1 : nd - 128);
            p0_transpose_item(F.w_in, 4224, ns, F.norm_g, F.WinT, D, nd, scr, 64 * kb, F.lane); continue; } r -= I_IN;
        if (r < I_OUT) { const int kb = r / (D / 32), nb = r % (D / 32);
            p0_transpose_item(F.w_out, D, 32 * nb, nullptr, F.WoutT, D, 32 * nb, scr, 64 * kb, F.lane); continue; } r -= I_OUT;
        if (r < I_L) { p0_transpose_item(F.w_decay_up, 512, 32 * r, nullptr, F.WdT, 64, 32 * r, scr, 0, F.lane); continue; } r -= I_L;
        p0_transpose_item(F.w_iclr_up, 512, 32 * r, nullptr, F.WaT, 64, 32 * r, scr, 0, F.lane);
    }
#pragma unroll 1
    for (; m0 < M; m0 += NGW * 4) p0_rows4(F, m0);
}

__device__ __forceinline__ float tanh_f(float x) { const float e = __expf(-2.f * fabsf(x)); const float t = (1.f - e) * __builtin_amdgcn_rcpf(1.f + e); return x < 0.f ? -t : t; }
__device__ __forceinline__ void shifted8(const bf16* proj, size_t m, bool has_prev, int col, const float* mu, float (&o)[8]) {
    const v4u c = *(const GAS v4u*)(proj + m * NP + col);
    v4u p = (v4u){0u, 0u, 0u, 0u}; if (has_prev) p = *(const GAS v4u*)(proj + (m - 1) * NP + col);
    const f32x4 m0 = *(const GAS f32x4*)(mu), m1 = *(const GAS f32x4*)(mu + 4);
    const unsigned cw[4] = {c.x, c.y, c.z, c.w}, pw[4] = {p.x, p.y, p.z, p.w}; const float mm[8] = {m0.x, m0.y, m0.z, m0.w, m1.x, m1.y, m1.z, m1.w};
#pragma unroll
    for (int j = 0; j < 4; ++j) { const float c0 = bflo(cw[j]), c1 = bfhi(cw[j]), p0 = bflo(pw[j]), p1 = bfhi(pw[j]);
        o[2 * j] = c0 + (p0 - c0) * mm[2 * j]; o[2 * j + 1] = c1 + (p1 - c1) * mm[2 * j + 1]; }
}
__device__ __forceinline__ void shifted4(const bf16* proj, size_t m, bool has_prev, int col, const float* mu, float (&o)[4]) {
    const v2u c = *(const GAS v2u*)(proj + m * NP + col);
    v2u p = (v2u){0u, 0u}; if (has_prev) p = *(const GAS v2u*)(proj + (m - 1) * NP + col);
    const f32x4 m0 = *(const GAS f32x4*)(mu);
    o[0] = bflo(c.x) + (bflo(p.x) - bflo(c.x)) * m0.x; o[1] = bfhi(c.x) + (bfhi(p.x) - bfhi(c.x)) * m0.y;
    o[2] = bflo(c.y) + (bflo(p.y) - bflo(c.y)) * m0.z; o[3] = bfhi(c.y) + (bfhi(p.y) - bfhi(c.y)) * m0.w;
}
__device__ __forceinline__ void p2_qknorm(Frame& F) {
    const int gw = F.vcu * NWAVES + F.wave, NGW = F.G * NWAVES, lane = F.lane, sub = lane & 7;
    const f32x4 gq0 = *(const GAS f32x4*)(F.qn_g + sub * 8), gq1 = *(const GAS f32x4*)(F.qn_g + sub * 8 + 4), gk0 = *(const GAS f32x4*)(F.kn_g + sub * 8), gk1 = *(const GAS f32x4*)(F.kn_g + sub * 8 + 4);
    constexpr int UQ = 4;
    for (int it0 = gw * UQ; it0 < 2 * M; it0 += NGW * UQ) {
        bf16* p[UQ]; v4u c[UQ];
#pragma unroll
        for (int u = 0; u < UQ; ++u) { const int it = it0 + u; const size_t m = (size_t)(it >> 1); p[u] = F.PROJ + m * NP + ((it & 1) ? C_DK : C_DQ) + (lane >> 3) * 64 + sub * 8; c[u] = *(const GAS v4u*)p[u]; }
#pragma unroll
        for (int u = 0; u < UQ; ++u) {
            const int isk = (it0 + u) & 1; const unsigned cw[4] = {c[u].x, c[u].y, c[u].z, c[u].w};
            float xv[8]; float ss = 0.f;
#pragma unroll
            for (int j = 0; j < 4; ++j) { xv[2 * j] = bflo(cw[j]); xv[2 * j + 1] = bfhi(cw[j]); ss += xv[2 * j] * xv[2 * j] + xv[2 * j + 1] * xv[2 * j + 1]; }
            ss += dpp_f<0xB1>(ss); ss += dpp_f<0x4E>(ss); ss += dpp_f<0x141>(ss);
            const float r = __builtin_amdgcn_rsqf(ss * (1.f / 64.f) + 1e-6f) * (isk ? 1.f : C2);
            const f32x4 g0 = isk ? gk0 : gq0, g1 = isk ? gk1 : gq1;
            v4u o; o.x = cvtpk2(xv[0] * r * g0.x, xv[1] * r * g0.y); o.y = cvtpk2(xv[2] * r * g0.z, xv[3] * r * g0.w); o.z = cvtpk2(xv[4] * r * g1.x, xv[5] * r * g1.y); o.w = cvtpk2(xv[6] * r * g1.z, xv[7] * r * g1.w);
            *(GAS v4u*)p[u] = o;
        }
    }
}
typedef float f32x2_t __attribute__((ext_vector_type(2))); typedef __bf16 bf16x2_t __attribute__((ext_vector_type(2)));
__device__ __forceinline__ unsigned cvtpk(float lo, float hi) { f32x2_t v = {lo, hi}; bf16x2_t b = __builtin_convertvector(v, bf16x2_t); return __builtin_bit_cast(unsigned, b); }
#define MFMA32(a, b, c) __builtin_amdgcn_mfma_f32_32x32x16_bf16(__builtin_bit_cast(bf16x8, (a)), __builtin_bit_cast(bf16x8, (b)), (c), 0, 0, 0)
#define FRAGACC(z, s) ((v4u){cvtpk((z)[8 * (s)], (z)[8 * (s) + 1]), cvtpk((z)[8 * (s) + 2], (z)[8 * (s) + 3]), cvtpk((z)[8 * (s) + 4], (z)[8 * (s) + 5]), cvtpk((z)[8 * (s) + 6], (z)[8 * (s) + 7])})
template <int CTRL, int RM> __device__ __forceinline__ float dpp_upd0(float x) { return __builtin_bit_cast(float, __builtin_amdgcn_update_dpp(0, __builtin_bit_cast(int, x), CTRL, RM, 0xf, false)); }
__device__ __forceinline__ float scan32(float x) {
    x += dpp_upd0<0x111, 0xf>(x); x += dpp_upd0<0x112, 0xf>(x); x += dpp_upd0<0x114, 0xf>(x); x += dpp_upd0<0x118, 0xf>(x); x += dpp_upd0<0x142, 0xa>(x); return x;
}
__device__ __forceinline__ void st_wt16(v4u* p, const v4u v) { *(GAS v4u*)p = v; }
constexpr int RW_UNITS = BATCH * RH * (T / 32);
struct RwDump { v4u* PF; v4u* DD; v4u* QF; v4u* YD; float* GAM; float* RHO; };

__device__ __forceinline__ void rwkvA_unit(Frame& F, const RwDump& Dm, int bh, int ci, LAS float* wscr, LAS unsigned char* park, LAS v4u* zsh, int zpar) {
    int lane = mk_lane(); asm volatile("" : "+v"(lane));
    const int hi = lane >> 5, l31 = lane & 31, b = bh >> 3, w = bh & 7;
    LAS v4u* pk = (LAS v4u*)park + lane;
#define PARK(slot) pk[(slot) * 64]
    int tok = 0; asm volatile("" : "+v"(tok));
#define DEP(x) asm volatile("" : "+v"(tok) : "v"(x))
    const int t = ci * 32 + l31; const size_t m = (size_t)b * T + t; const bool hp = t > 0;
    const int u = ci * (BATCH * RH) + bh;
    const float pm = hp ? 1.f : 0.f;
    const bf16* pc = F.PROJ + m * NP + w * 64 + 4 * hi; const bf16* pp = F.PROJ + (hp ? m - 1 : m) * NP + w * 64 + 4 * hi;
    const float* mu = F.shift_mu + w * 64 + 4 * hi;
    const float *pw0 = F.w0 + w * 64 + 4 * hi, *pa0 = F.a0 + w * 64 + 4 * hi, *pkk = F.k_k + w * 64 + 4 * hi, *pka = F.k_a + w * 64 + 4 * hi, *prk = F.r_k + w * 64 + 4 * hi;
#define SH4(dst, COL, MU, OFF) do { const v2u c_ = *(const GAS v2u*)(pc + tok + (COL) + (OFF)), p_ = *(const GAS v2u*)(pp + tok + (COL) + (OFF)); const f32x4 m_ = *(const GAS f32x4*)(mu + tok + (MU) + (OFF)); \
        dst[0] = bflo(c_.x) + (bflo(p_.x) * pm - bflo(c_.x)) * m_.x; dst[1] = bfhi(c_.x) + (bfhi(p_.x) * pm - bfhi(c_.x)) * m_.y; \
        dst[2] = bflo(c_.y) + (bflo(p_.y) * pm - bflo(c_.y)) * m_.z; dst[3] = bfhi(c_.y) + (bfhi(p_.y) * pm - bfhi(c_.y)) * m_.w; } while (0)
    float ss = 0.f;
#pragma unroll
    for (int gq = 0; gq < 8; ++gq) { float k4[4]; SH4(k4, C_K, 512, 8 * gq); const f32x4 kkp = *(const GAS f32x4*)(pkk + tok + 8 * gq);
#pragma unroll
        for (int e = 0; e < 4; ++e) { const float q = k4[e] * kkp[e]; ss += q * q; }
        if (gq == 3) DEP(ss); }
    ss = swap32_sum(ss);
    const float inv = __builtin_amdgcn_rcpf(fmaxf(__builtin_amdgcn_sqrtf(ss), 1e-12f));
    asm volatile("" ::: "memory");
    v4u bz[4], ba[4];
    { const int s = F.wave >> 1; const bool which = (F.wave & 1) != 0;
      const bf16* zc = F.PROJ + m * NP + 8 * hi; const bf16* zp = F.PROJ + (hp ? m - 1 : m) * NP + 8 * hi; const float* zmu = F.shift_mu + 8 * hi;
      const int COL = (which ? C_ZA : C_ZW) + 16 * s, MUO = (which ? 1600 : 1536) + 16 * s;
      const v4u c = *(const GAS v4u*)(zc + tok + COL), p = *(const GAS v4u*)(zp + tok + COL); const f32x4 m0 = *(const GAS f32x4*)(zmu + tok + MUO), m1 = *(const GAS f32x4*)(zmu + tok + MUO + 4);
      float z[8];
#pragma unroll
      for (int j = 0; j < 4; ++j) { const float c0 = bflo(c[j]), c1 = bfhi(c[j]); const float mm0 = j < 2 ? m0[2 * j] : m1[2 * j - 4], mm1 = j < 2 ? m0[2 * j + 1] : m1[2 * j - 3];
          z[2 * j] = c0 + (bflo(p[j]) * pm - c0) * mm0; z[2 * j + 1] = c1 + (bfhi(p[j]) * pm - c1) * mm1; }
      if (!which) {
#pragma unroll
          for (int j = 0; j < 8; ++j) z[j] = tanh_f(z[j]); }
      LAS v4u* zs = zsh + zpar * 512;
      zs[((which ? 4 : 0) + s) * 64 + lane] = (v4u){cvtpk(z[0], z[1]), cvtpk(z[2], z[3]), cvtpk(z[4], z[5]), cvtpk(z[6], z[7])};
      __syncthreads();
#pragma unroll
      for (int q = 0; q < 4; ++q) { bz[q] = zs[q * 64 + lane]; ba[q] = zs[(4 + q) * 64 + lane]; }
      DEP(bz[3][3]); DEP(ba[3][3]); }
    asm volatile("" ::: "memory");
    v4u fa[4], fb[4], fk[4], fr[4], fv[4]; float rho = 0.f;
    float* gp = Dm.GAM + (size_t)u * 64 + hi * 32;
#define RW_LORA(cb) f32x16 accd = f32x16{}, acca = f32x16{}; _Pragma("unroll") for (int s = 0; s < 4; ++s) { \
        const v4u aD = *(const GAS v4u*)(F.WdT + tok + (size_t)(w * 64 + (cb) * 32 + l31) * 64 + 16 * s + 8 * hi); accd = MFMA32(aD, bz[s], accd); \
        const v4u aA = *(const GAS v4u*)(F.WaT + tok + (size_t)(w * 64 + (cb) * 32 + l31) * 64 + 16 * s + 8 * hi); acca = MFMA32(aA, ba[s], acca); }
    struct RwGL { v2u rc, rp, kc, kp, vc, vp; } gA, gB;
#define RW_LOADG(X, OFF) do { X.rc = *(const GAS v2u*)(pc + tok + C_R + (OFF)); X.rp = *(const GAS v2u*)(pp + tok + C_R + (OFF)); X.kc = *(const GAS v2u*)(pc + tok + C_K + (OFF)); X.kp = *(const GAS v2u*)(pp + tok + C_K + (OFF)); \
        X.vc = *(const GAS v2u*)(pc + tok + C_V + (OFF)); X.vp = *(const GAS v2u*)(pp + tok + C_V + (OFF)); } while (0)
#define RW_LERP(dst, c_, p_, m_) do { dst[0] = bflo(c_.x) + (bflo(p_.x) * pm - bflo(c_.x)) * m_.x; dst[1] = bfhi(c_.x) + (bfhi(p_.x) * pm - bfhi(c_.x)) * m_.y; \
        dst[2] = bflo(c_.y) + (bflo(p_.y) * pm - bflo(c_.y)) * m_.z; dst[3] = bfhi(c_.y) + (bfhi(p_.y) * pm - bfhi(c_.y)) * m_.w; } while (0)
#define RW_GROUP(cb, rg, CUR, NXT, HASN) do { constexpr int OFF = 32 * (cb) + 8 * (rg); const int ch0 = OFF + 4 * hi; \
            if (HASN) RW_LOADG(NXT, OFF + 8); \
            float rr[4], kk4[4], vv[4]; \
            const f32x4 mr_ = *(const GAS f32x4*)(mu + tok + OFF), mk_ = *(const GAS f32x4*)(mu + tok + 512 + OFF), mv_ = *(const GAS f32x4*)(mu + tok + 1024 + OFF); \
            const f32x4 w0v = *(const GAS f32x4*)(pw0 + tok + OFF), a0v = *(const GAS f32x4*)(pa0 + tok + OFF), kkp = *(const GAS f32x4*)(pkk + tok + OFF), kap = *(const GAS f32x4*)(pka + tok + OFF), rkp = *(const GAS f32x4*)(prk + tok + OFF); \
            RW_LERP(rr, CUR.rc, CUR.rp, mr_); RW_LERP(kk4, CUR.kc, CUR.kp, mk_); RW_LERP(vv, CUR.vc, CUR.vp, mv_); \
            float xa[4], xb[4], xk[4], xr[4], gg[4], ge[4]; \
            _Pragma("unroll") for (int e = 0; e < 4; ++e) { \
                const float nx = -(w0v[e] + accd[4 * (rg) + e]); const float sp = fmaxf(nx, 0.f) + __logf(1.f + __expf(-fabsf(nx))); \
                const float l2 = -__expf(-sp - 0.5f) * LOG2E; \
                const float g = scan32(l2); \
                const float a = __builtin_amdgcn_rcpf(1.f + __expf(-(a0v[e] + acca[4 * (rg) + e]))); \
                const float kk = kk4[e] * kkp[e] * inv; \
                const float kt = kk4[e] * (1.f + (a - 1.f) * kap[e]); \
                rho += rr[e] * kt * rkp[e]; \
                const float eg = __builtin_amdgcn_exp2f(g), egp = __builtin_amdgcn_exp2f(g - l2), eng = __builtin_amdgcn_rcpf(eg); \
                xa[e] = -kk * egp; xb[e] = kk * a * eng; xk[e] = kt * eng; xr[e] = rr[e] * eg; gg[e] = g; ge[e] = eg; } \
            if (l31 == 31) { *(LAS f32x4*)(wscr + ch0) = (f32x4){gg[0], gg[1], gg[2], gg[3]}; st_wt16((v4u*)(gp + (cb) * 16 + 4 * (rg)), (v4u){__float_as_uint(ge[0]), __float_as_uint(ge[1]), __float_as_uint(ge[2]), __float_as_uint(ge[3])}); } \
            constexpr int s_ = 2 * (cb) + ((rg) >> 1), vg = 2 * ((rg) & 1); \
            fa[s_][vg] = cvtpk(xa[0], xa[1]); fa[s_][vg + 1] = cvtpk(xa[2], xa[3]); \
            fb[s_][vg] = cvtpk(xb[0], xb[1]); fb[s_][vg + 1] = cvtpk(xb[2], xb[3]); \
            fk[s_][vg] = cvtpk(xk[0], xk[1]); fk[s_][vg + 1] = cvtpk(xk[2], xk[3]); \
            fr[s_][vg] = cvtpk(xr[0], xr[1]); fr[s_][vg + 1] = cvtpk(xr[2], xr[3]); \
            fv[s_][vg] = cvtpk(vv[0], vv[1]); fv[s_][vg + 1] = cvtpk(vv[2], vv[3]); \
            if (((rg) & 1) == 1) { PARK(s_) = fv[s_]; PARK(4 + s_) = fr[s_]; } \
            DEP(fa[s_][vg + 1]); DEP(fb[s_][vg + 1]); DEP(fk[s_][vg + 1]); DEP(fr[s_][vg + 1]); DEP(fv[s_][vg + 1]); DEP(rho); } while (0)
    RW_LOADG(gA, 0);
    { RW_LORA(0) RW_GROUP(0, 0, gA, gB, true); RW_GROUP(0, 1, gB, gA, true); RW_GROUP(0, 2, gA, gB, true); RW_GROUP(0, 3, gB, gA, true); }
    { RW_LORA(1) RW_GROUP(1, 0, gA, gB, true); RW_GROUP(1, 1, gB, gA, true); RW_GROUP(1, 2, gA, gB, true); RW_GROUP(1, 3, gB, gA, false); }
#undef RW_LOADG
#undef RW_LERP
#undef RW_LORA
#undef RW_GROUP
#undef SH4
    LDS_WAIT(); asm volatile("" ::: "memory");
    float EC[2]; EC[0] = __builtin_amdgcn_exp2f(wscr[l31]); EC[1] = __builtin_amdgcn_exp2f(wscr[32 + l31]);
    LDS_WAIT(); asm volatile("" ::: "memory");
    rho = swap32_sum(rho);
    if (hi == 0) __hip_atomic_store((gu32*)(Dm.RHO + (size_t)u * 32 + l31), __float_as_uint(rho), RLX_AGENT);
    v4u idf[2];
    { const int jst = 4 * ((l31 >> 3) & 1) + (l31 & 3); const bool hm = ((l31 >> 2) & 1) == hi; const unsigned one = 0x3F80u << (16 * (jst & 1));
#pragma unroll
      for (int sig = 0; sig < 2; ++sig) { const bool on = hm && ((l31 >> 4) == sig);
#pragma unroll
          for (int q = 0; q < 4; ++q) idf[sig][q] = (on && (jst >> 1) == q) ? one : 0u; } }
    LDS_WAIT();
    v4u Af[2][2], Vf[2][2];
#pragma unroll
    for (int blk = 0; blk < 2; ++blk) {
        f32x16 za = MFMA32(fa[2 * blk], idf[0], f32x16{}); za = MFMA32(fa[2 * blk + 1], idf[1], za);
        f32x16 zv = MFMA32(PARK(2 * blk), idf[0], f32x16{}); zv = MFMA32(PARK(2 * blk + 1), idf[1], zv);
        f32x16 zb = MFMA32(fb[2 * blk], idf[0], f32x16{}); zb = MFMA32(fb[2 * blk + 1], idf[1], zb);
        f32x16 zk = MFMA32(fk[2 * blk], idf[0], f32x16{}); zk = MFMA32(fk[2 * blk + 1], idf[1], zk);
        zb = zb * EC[blk]; zk = zk * EC[blk];
#pragma unroll
        for (int s = 0; s < 2; ++s) { Af[blk][s] = FRAGACC(za, s); Vf[blk][s] = FRAGACC(zv, s); PARK(8 + 2 * blk + s) = FRAGACC(zb, s); PARK(12 + 2 * blk + s) = FRAGACC(zk, s); }
        __builtin_amdgcn_sched_barrier(0);
    }
    f32x16 Aab = f32x16{}, TT = f32x16{}, AakT = f32x16{}, ArbT = f32x16{}, ArkT = f32x16{};
#pragma unroll
    for (int s = 0; s < 4; ++s) { const v4u frs = PARK(4 + s); Aab = MFMA32(fa[s], fb[s], Aab); TT = MFMA32(fb[s], fa[s], TT); AakT = MFMA32(fk[s], fa[s], AakT); ArbT = MFMA32(fb[s], frs, ArbT); ArkT = MFMA32(fk[s], frs, ArkT); }
#pragma unroll
    for (int r = 0; r < 16; ++r) { const int rowi = (r & 3) + 8 * (r >> 2) + 4 * hi;
        Aab[r] = (l31 < rowi) ? Aab[r] : 0.f; TT[r] = (rowi < l31) ? TT[r] : 0.f; AakT[r] = (rowi < l31) ? AakT[r] : 0.f;
        ArbT[r] = (rowi <= l31) ? ArbT[r] : 0.f; ArkT[r] = (rowi <= l31) ? ArkT[r] : 0.f; }
    v4u AakTf[2], ArbTf[2], ArkTf[2];
#pragma unroll
    for (int s = 0; s < 2; ++s) { AakTf[s] = FRAGACC(AakT, s); ArbTf[s] = FRAGACC(ArbT, s); ArkTf[s] = FRAGACC(ArkT, s); }
    __builtin_amdgcn_sched_barrier(0);
    v4u Xf[2], XTf[2], TTf[2];
#pragma unroll
    for (int s = 0; s < 2; ++s) { Xf[s] = FRAGACC(Aab, s); XTf[s] = FRAGACC(TT, s); }
#pragma unroll
    for (int r = 0; r < 16; ++r) { const int rowi = (r & 3) + 8 * (r >> 2) + 4 * hi; TT[r] += (rowi == l31) ? 1.f : 0.f; }
#pragma unroll
    for (int it = 0; it < 4; ++it) {
        f32x16 X2 = MFMA32(XTf[0], Xf[0], f32x16{}); X2 = MFMA32(XTf[1], Xf[1], X2);
        if (it < 3) { f32x16 X2T = MFMA32(Xf[0], XTf[0], f32x16{}); X2T = MFMA32(Xf[1], XTf[1], X2T);
#pragma unroll
            for (int s = 0; s < 2; ++s) XTf[s] = FRAGACC(X2T, s); }
#pragma unroll
        for (int s = 0; s < 2; ++s) { Xf[s] = FRAGACC(X2, s); TTf[s] = FRAGACC(TT, s); }
        TT = MFMA32(Xf[0], TTf[0], TT); TT = MFMA32(Xf[1], TTf[1], TT);
        __builtin_amdgcn_sched_barrier(0);
    }
#pragma unroll
    for (int s = 0; s < 2; ++s) TTf[s] = FRAGACC(TT, s);
    v4u Wf[2][2], Uf[2][2];
#pragma unroll
    for (int blk = 0; blk < 2; ++blk) {
        f32x16 av = MFMA32(AakTf[0], Vf[blk][0], f32x16{}); av = MFMA32(AakTf[1], Vf[blk][1], av);
        const v4u avf0 = FRAGACC(av, 0), avf1 = FRAGACC(av, 1);
        f32x16 uu = MFMA32(TTf[0], avf0, f32x16{}); uu = MFMA32(TTf[1], avf1, uu);
        f32x16 ww = MFMA32(TTf[0], Af[blk][0], f32x16{}); ww = MFMA32(TTf[1], Af[blk][1], ww);
#pragma unroll
        for (int s = 0; s < 2; ++s) { Wf[blk][s] = FRAGACC(ww, s); Uf[blk][s] = FRAGACC(uu, s); }
        __builtin_amdgcn_sched_barrier(0);
    }
    v4u* QFp = Dm.QF + (size_t)u * 256 + lane; v4u* YDp = Dm.YD + (size_t)u * 256 + lane;
#pragma unroll
    for (int blk = 0; blk < 2; ++blk) {
        f32x16 q;
#pragma unroll
        for (int s = 0; s < 2; ++s)
            { const v4u frs = PARK(4 + 2 * blk + s);
#pragma unroll
              for (int j = 0; j < 4; ++j) { q[8 * s + 2 * j] = bflo(frs[j]); q[8 * s + 2 * j + 1] = bfhi(frs[j]); } }
        q = MFMA32(Wf[blk][0], ArbTf[0], q); q = MFMA32(Wf[blk][1], ArbTf[1], q);
        st_wt16(QFp + (2 * blk) * 64, FRAGACC(q, 0)); st_wt16(QFp + (2 * blk + 1) * 64, FRAGACC(q, 1));
        f32x16 y = MFMA32(Uf[blk][0], ArbTf[0], f32x16{}); y = MFMA32(Uf[blk][1], ArbTf[1], y); y = MFMA32(Vf[blk][0], ArkTf[0], y); y = MFMA32(Vf[blk][1], ArkTf[1], y);
        st_wt16(YDp + (2 * blk) * 64, FRAGACC(y, 0)); st_wt16(YDp + (2 * blk + 1) * 64, FRAGACC(y, 1));
        __builtin_amdgcn_sched_barrier(0);
    }
    v4u* PFp = Dm.PF + (size_t)u * 512 + lane; v4u* DDp = Dm.DD + (size_t)u * 512 + lane;
#pragma unroll
    for (int c1 = 0; c1 < 2; ++c1)
#pragma unroll
        for (int cb = 0; cb < 2; ++cb) {
            f32x16 p = MFMA32(Wf[c1][0], PARK(8 + 2 * cb), f32x16{}); p = MFMA32(Wf[c1][1], PARK(8 + 2 * cb + 1), p);
            st_wt16(PFp + (cb * 4 + 2 * c1) * 64, FRAGACC(p, 0)); st_wt16(PFp + (cb * 4 + 2 * c1 + 1) * 64, FRAGACC(p, 1));
            __builtin_amdgcn_sched_barrier(0);
        }
#pragma unroll
    for (int cb = 0; cb < 2; ++cb)
#pragma unroll
        for (int ib = 0; ib < 2; ++ib) {
            f32x16 d = MFMA32(PARK(8 + 2 * cb), Uf[ib][0], f32x16{}); d = MFMA32(PARK(8 + 2 * cb + 1), Uf[ib][1], d); d = MFMA32(PARK(12 + 2 * cb), Vf[ib][0], d); d = MFMA32(PARK(12 + 2 * cb + 1), Vf[ib][1], d);
            st_wt16(DDp + ((cb * 2 + ib) * 2) * 64, FRAGACC(d, 0)); st_wt16(DDp + ((cb * 2 + ib) * 2 + 1) * 64, FRAGACC(d, 1));
            __builtin_amdgcn_sched_barrier(0);
        }
}

#undef PARK
#undef DEP
constexpr int RB_PF = 0, RB_DD = 8192, RB_QF = 16384, RB_YD = 20480, RB_GAM = 24576, RB_BUF = 24832, RB_STAT = 2 * RB_BUF, RB_Y = RB_STAT + 1024;
__device__ __forceinline__ void unpack16(const v4u a, const v4u b, f32x16& o) {
#pragma unroll
    for (int j = 0; j < 4; ++j) { o[2 * j] = bflo(a[j]); o[2 * j + 1] = bfhi(a[j]); o[8 + 2 * j] = bflo(b[j]); o[8 + 2 * j + 1] = bfhi(b[j]); }
}
constexpr int RW_SPLIT = T / 32, CW_DONE = 16384;
__device__ __forceinline__ void rw_wait_chunk(Frame& F, int ci) {
    unsigned spins = 0;
#pragma unroll 1
    for (int j = 7; j >= 0; --j) { gu32* c = F.ctl + CW_DONE + 64 * (ci + j);
        while ((unsigned)__builtin_amdgcn_readfirstlane(__hip_atomic_load(c, RLX_AGENT)) < (unsigned)BATCH) { __builtin_amdgcn_s_sleep(8); if (++spins > (1u << 22)) break; } }
    __builtin_amdgcn_fence(__ATOMIC_ACQUIRE, "agent");
}
__device__ __forceinline__ void rw_publish_chunk(Frame& F, int ci) {
    asm volatile("s_waitcnt vmcnt(0)" ::: "memory");
    __syncthreads();
    if (F.wave == 0 && mk_lane() == 0) {
        __hip_atomic_fetch_add(F.ctl + CW_DONE + 64 * ci, 1u, RLX_AGENT);
    }
}
struct RbStage { v4u p[2], d[2], q, y, g; };
struct RbEpi { v2u vc[2], vp[2], ga[2]; float rho; };
__device__ __forceinline__ void rwkvB_unit(Frame& F, const RwDump& Dm, int bh) {
    int lane = mk_lane(); asm volatile("" : "+v"(lane));
    const int wid = F.wave, tid = wid * 64 + lane, hi = lane >> 5, l31 = lane & 31, b = bh >> 3, h = bh & 7;
    LAS unsigned char* lds = F.lds + RING_OFF;
    constexpr int NS = T / 32;
    LAS float* stat = (LAS float*)(lds + RB_STAT);
    LAS float* ybuf = (LAS float*)(lds + RB_Y);
    const int stid = tid - 128;
    const bool st_p2 = wid < 4, st_q = wid < 6, st_y = wid >= 4;
#define ST_LOAD(X, ci_) do { { if ((ci_) >= RW_SPLIT && (ci_) < NS && (((ci_) - RW_SPLIT) & 7) == 0) rw_wait_chunk(F, (ci_)); const size_t u_ = (size_t)((ci_) < NS ? (ci_) : NS - 1) * (BATCH * RH) + bh; \
        X.p[0] = __builtin_nontemporal_load((const GAS v4u*)(Dm.PF + u_ * 512 + stid)); X.d[0] = __builtin_nontemporal_load((const GAS v4u*)(Dm.DD + u_ * 512 + stid)); \
        if (st_p2) { X.p[1] = __builtin_nontemporal_load((const GAS v4u*)(Dm.PF + u_ * 512 + 384 + stid)); X.d[1] = __builtin_nontemporal_load((const GAS v4u*)(Dm.DD + u_ * 512 + 384 + stid)); } \
        if (st_q) X.q = __builtin_nontemporal_load((const GAS v4u*)(Dm.QF + u_ * 256 + stid)); \
        if (st_y) X.y = __builtin_nontemporal_load((const GAS v4u*)(Dm.YD + u_ * 256 + (stid - 128))); \
        if (stid < 16) X.g = *(const GAS v4u*)((const v4u*)(Dm.GAM + u_ * 64) + stid); } } while (0)
#define ST_STORE(X, buf_) do { LAS unsigned char* b_ = lds + (buf_) * RB_BUF; \
        *(LAS v4u*)(b_ + RB_PF + stid * 16) = X.p[0]; *(LAS v4u*)(b_ + RB_DD + stid * 16) = X.d[0]; \
        if (st_p2) { *(LAS v4u*)(b_ + RB_PF + (384 + stid) * 16) = X.p[1]; *(LAS v4u*)(b_ + RB_DD + (384 + stid) * 16) = X.d[1]; } \
        if (st_q) *(LAS v4u*)(b_ + RB_QF + stid * 16) = X.q; \
        if (st_y) *(LAS v4u*)(b_ + RB_YD + (stid - 128) * 16) = X.y; \
        if (stid < 16) *(LAS v4u*)(b_ + RB_GAM + stid * 16) = X.g; } while (0)
    const int eib = wid & 1, eh = (wid >> 2) & 1;
    const bf16* epc = F.PROJ + (size_t)b * T * NP + h * 64 + 32 * eib + 16 * eh + 4 * hi;
#define EP_LOAD(X, cj_) do { { const int tt_ = ((cj_) < NS ? (cj_) : NS - 1) * 32 + l31; const bf16* pc_ = epc + (size_t)tt_ * NP; const bf16* pp_ = epc + (size_t)(tt_ > 0 ? tt_ - 1 : 0) * NP; \
        _Pragma("unroll") for (int rg = 0; rg < 2; ++rg) { X.vc[rg] = *(const GAS v2u*)(pc_ + C_V + 8 * rg); X.vp[rg] = *(const GAS v2u*)(pp_ + C_V + 8 * rg); X.ga[rg] = *(const GAS v2u*)(pc_ + C_GA + 8 * rg); } \
        X.rho = Dm.RHO[((size_t)((cj_) < NS ? (cj_) : NS - 1) * (BATCH * RH) + bh) * 32 + l31]; } } while (0)
#define EP_RUN(X, cj_) do { const int par_ = (cj_) & 1; \
        const float s1_ = stat[((par_ * 2 + 0) * 32 + l31) * 2] + stat[((par_ * 2 + 1) * 32 + l31) * 2], s2_ = stat[((par_ * 2 + 0) * 32 + l31) * 2 + 1] + stat[((par_ * 2 + 1) * 32 + l31) * 2 + 1]; \
        const float mean_ = s1_ * (1.f / 64.f), var_ = fmaxf(s2_ * (1.f / 64.f) - mean_ * mean_, 0.f), rstd_ = __builtin_amdgcn_rsqf(var_ + 64e-5f); \
        const int tt_ = (cj_) * 32 + l31; const size_t mm_ = (size_t)b * T + tt_; const float pm_ = tt_ > 0 ? 1.f : 0.f; \
        const LAS float* yb_ = ybuf + (par_ * 2 + eib) * 1024 + lane; \
        _Pragma("unroll") for (int rg = 0; rg < 2; ++rg) { const int hc_ = h * 64 + 32 * eib + 16 * eh + 8 * rg + 4 * hi; \
            const f32x4 mu_ = emu[rg], lw_ = elw[rg], lb_ = elb[rg]; \
            const float vc_[4] = {bflo(X.vc[rg].x), bfhi(X.vc[rg].x), bflo(X.vc[rg].y), bfhi(X.vc[rg].y)}, vp_[4] = {bflo(X.vp[rg].x), bfhi(X.vp[rg].x), bflo(X.vp[rg].y), bfhi(X.vp[rg].y)}; \
            const float g4_[4] = {bflo(X.ga[rg].x), bfhi(X.ga[rg].x), bflo(X.ga[rg].y), bfhi(X.ga[rg].y)}; float o_[4]; \
            _Pragma("unroll") for (int e = 0; e < 4; ++e) { const float vv_ = vc_[e] + (vp_[e] * pm_ - vc_[e]) * mu_[e]; \
                const float yn_ = (yb_[(4 * (2 * eh + rg) + e) * 64] - mean_) * rstd_ * lw_[e] + lb_[e] + X.rho * vv_; o_[e] = yn_ * g4_[e] * __builtin_amdgcn_rcpf(1.f + __expf(-g4_[e])); } \
            *(GAS v2u*)(F.MIX + mm_ * D + hc_) = (v2u){cvtpk(o_[0], o_[1]), cvtpk(o_[2], o_[3])}; } } while (0)
    f32x16 S[2]; S[0] = f32x16{}; S[1] = f32x16{};
    const int ib = wid & 1;
#define CONS(ci_) do { const LAS unsigned char* bb = lds + ((ci_) & 1) * RB_BUF; \
          \
        v4u pf_[8], qf_[4], dd_[4], yd_[2]; f32x4 gm_[8]; \
        _Pragma("unroll") for (int q = 0; q < 8; ++q) gm_[q] = *(const LAS f32x4*)(bb + RB_GAM + (hi * 32 + 4 * q) * 4); \
        _Pragma("unroll") for (int q = 0; q < 4; ++q) dd_[q] = *(const LAS v4u*)(bb + RB_DD + ((((q >> 1) * 2 + ib) * 2 + (q & 1)) * 64 + lane) * 16); \
        _Pragma("unroll") for (int q = 0; q < 8; ++q) pf_[q] = *(const LAS v4u*)(bb + RB_PF + (q * 64 + lane) * 16); \
        _Pragma("unroll") for (int q = 0; q < 2; ++q) yd_[q] = *(const LAS v4u*)(bb + RB_YD + ((2 * ib + q) * 64 + lane) * 16); \
        _Pragma("unroll") for (int q = 0; q < 4; ++q) qf_[q] = *(const LAS v4u*)(bb + RB_QF + (q * 64 + lane) * 16); \
        __builtin_amdgcn_sched_barrier(0); \
        v4u Sf[4]; _Pragma("unroll") for (int s = 0; s < 4; ++s) Sf[s] = FRAGACC(S[s >> 1], s & 1); \
        _Pragma("unroll") for (int rb = 0; rb < 2; ++rb) { \
            f32x16 acc; unpack16(dd_[2 * rb], dd_[2 * rb + 1], acc); \
            _Pragma("unroll") for (int q = 0; q < 4; ++q) { const f32x4 gv = gm_[4 * rb + q]; _Pragma("unroll") for (int e = 0; e < 4; ++e) acc[4 * q + e] += gv[e] * S[rb][4 * q + e]; } \
            _Pragma("unroll") for (int s = 0; s < 4; ++s) acc = MFMA32(pf_[rb * 4 + s], Sf[s], acc); \
            S[rb] = acc; } \
        f32x16 y; unpack16(yd_[0], yd_[1], y); \
        _Pragma("unroll") for (int s = 0; s < 4; ++s) y = MFMA32(Sf[s], qf_[s], y); \
        float s1 = 0.f, s2 = 0.f; LAS float* yb_ = ybuf + (((ci_) & 1) * 2 + ib) * 1024 + lane; \
        _Pragma("unroll") for (int r = 0; r < 16; ++r) { s1 += y[r]; s2 += y[r] * y[r]; yb_[r * 64] = y[r]; } \
        s1 = swap32_sum(s1); s2 = swap32_sum(s2); \
        if (hi == 0) { stat[((((ci_) & 1) * 2 + ib) * 32 + l31) * 2] = s1; stat[((((ci_) & 1) * 2 + ib) * 32 + l31) * 2 + 1] = s2; } } while (0)
#define RB_BAR() do { asm volatile("s_waitcnt lgkmcnt(0)" ::: "memory"); __builtin_amdgcn_s_barrier(); asm volatile("" ::: "memory"); } while (0)
    if (wid < 2) {
        RB_BAR();
#pragma unroll 1
        for (int k = 0; k < NS; ++k) { CONS(k); RB_BAR(); }
        RB_BAR();
    } else {
        const bool epi = (wid != 4 && wid != 5);
        RbStage sA, sB, sC; RbEpi eA, eB, eC; f32x4 emu[2], elw[2], elb[2];
#pragma unroll
        for (int rg = 0; rg < 2; ++rg) { const int hc_ = h * 64 + 32 * eib + 16 * eh + 8 * rg + 4 * hi; emu[rg] = *(const GAS f32x4*)(F.shift_mu + 1024 + hc_); elw[rg] = *(const GAS f32x4*)(F.ln_w + hc_); elb[rg] = *(const GAS f32x4*)(F.ln_b + hc_); }
        ST_LOAD(sA, 0); ST_LOAD(sB, 1); ST_LOAD(sC, 2); ST_STORE(sA, 0); ST_LOAD(sA, 3);
        if (epi) { EP_LOAD(eA, 0); EP_LOAD(eB, 1); }
        RB_BAR();
        ST_STORE(sB, 1); ST_LOAD(sB, 4); if (epi) EP_LOAD(eC, 2); RB_BAR();
#define HY_STEP(k_, SN, EP) do { ST_STORE(SN, ((k_) + 1) & 1); ST_LOAD(SN, (k_) + 4); if (epi) { EP_RUN(EP, (k_) - 1); EP_LOAD(EP, (k_) + 2); } RB_BAR(); } while (0)
#pragma unroll 1
        for (int k = 1; k < NS; k += 3) { HY_STEP(k, sC, eA); HY_STEP(k + 1, sA, eB); HY_STEP(k + 2, sB, eC); }
        if (epi) EP_RUN(eA, NS - 1);
        RB_BAR();
#undef HY_STEP
    }
#undef RB_BAR
#undef ST_LOAD
#undef ST_STORE
#undef EP_LOAD
#undef EP_RUN
#undef CONS
}
constexpr int CW_G17 = 12288;
struct OneUnit { int pm, pn;
    __device__ __forceinline__ bool next(int i, pg8::Unit& u) const { if (i != 0) return false; u.pm = pm; u.pn = pn; return true; }
    __device__ __forceinline__ void a_ready(const pg8::Unit&) const {}
    __device__ __forceinline__ void done(const pg8::Unit&) const {} };
constexpr int AT_KB = 64 * 256, AT_VB = 64 * 256, AT_BUF = AT_KB + AT_VB, AT_QOFF = 2 * AT_KB + 3 * AT_VB;
__device__ __forceinline__ s16x4 vtr(const LAS unsigned char* p) { typedef short v4i16_t __attribute__((ext_vector_type(4))); return __builtin_bit_cast(s16x4, __builtin_amdgcn_ds_read_tr16_b64_v4i16((LAS v4i16_t*)p)); }
__device__ __forceinline__ void attn_unit(Frame& F, int b, int h, int qb) {
    int lane = mk_lane(); asm volatile("" : "+v"(lane));
    const int wid = F.wave, tid = wid * 64 + lane, l31 = lane & 31, hi = lane >> 5, map = wid >> 2, qs = wid & 3;
    LAS unsigned char* lds = F.lds + RING_OFF;
    const float slope2 = exp2f(-2.f * (float)(h + 1)) * LOG2E, shift2 = __uint_as_float(F.MISC[15]);
    const int q0 = qb * 128, qrow = q0 + 32 * qs + l31;
    const size_t mrow = (size_t)b * T + qrow;
    LAS bf16x8* qpark = (LAS bf16x8*)(lds + AT_QOFF + wid * 4096) + lane;
    { const bf16* qp = F.PROJ + mrow * NP + C_DQ + h * 128 + map * 64 + 8 * hi;
#pragma unroll
      for (int s = 0; s < 4; ++s) qpark[s * 64] = *(const GAS bf16x8*)(qp + 16 * s); }
    const bf16* kg = F.PROJ + (size_t)b * T * NP + C_DK + h * 128;
    const bf16* vg = F.PROJ + (size_t)b * T * NP + C_DV + h * 128;
    const int NT = 2 * qb + 2, tl = 2 * qb + (qs >> 1);
    const int Wk = (int)__builtin_ceilf((2.f * shift2 + 32.2f) / slope2);
    const int tf = __builtin_amdgcn_readfirstlane(max(0, (qb * 128 - Wk) >> 6));
    constexpr int AT_V0 = 2 * AT_KB;
    const int drow0 = 4 * wid + (lane >> 4), drow1 = drow0 + 32, dch = lane & 15;
    const unsigned ksrc0 = (unsigned)(drow0 * NP + ((dch ^ (drow0 & 15)) * 8)), ksrc1 = (unsigned)(drow1 * NP + ((dch ^ (drow1 & 15)) * 8));
    const unsigned vsrc0 = (unsigned)(drow0 * NP + ((dch ^ ((drow0 & 3) << 2)) * 8)), vsrc1 = (unsigned)(drow1 * NP + ((dch ^ ((drow1 & 3) << 2)) * 8));
#define AT_DMA(t_, kb_, v3_) do { const size_t tb_ = (size_t)(64 * (t_)) * NP; LAS unsigned char* bk_ = lds + (kb_) * AT_KB + wid * 1024; LAS unsigned char* bv_ = lds + AT_V0 + (v3_) * AT_VB + wid * 1024; \
        __builtin_amdgcn_global_load_lds((const unsigned*)(kg + tb_ + ksrc0), (LAS unsigned*)bk_, 16, 0, 0); __builtin_amdgcn_global_load_lds((const unsigned*)(kg + tb_ + ksrc1), (LAS unsigned*)(bk_ + 8192), 16, 0, 0); \
        __builtin_amdgcn_global_load_lds((const unsigned*)(vg + tb_ + vsrc0), (LAS unsigned*)bv_, 16, 0, 0); __builtin_amdgcn_global_load_lds((const unsigned*)(vg + tb_ + vsrc1), (LAS unsigned*)(bv_ + 8192), 16, 0, 0); } while (0)
    f32x16 o[4];
#pragma unroll
    for (int vb = 0; vb < 4; ++vb) o[vb] = f32x16{};
    float lsum = 0.f;
    AT_DMA(tf, tf & 1, tf % 3);
    __syncthreads();
    const int G = lane >> 4, qq = (lane & 15) >> 2, pp = lane & 3;
    const int vrow = (4 * hi + qq) * 256 + 8 * (pp & 1), vch = 2 * (G & 1) + (pp >> 1);
    v4u pw[4];
#define SBAR_() __builtin_amdgcn_sched_barrier(0)
#define AT_QK(t) do { \
            const LAS unsigned char* Kb = lds + ((t) & 1) * AT_KB; \
            float sl_ = slope2; asm volatile("" : "+v"(sl_));     \
            const float base = sl_ * (float)(64 * (t) + 4 * hi - qrow) - shift2; \
            float ls = 0.f; \
            _Pragma("unroll") for (int hf = 0; hf < 2; ++hf) {        \
                f32x16 p; \
                _Pragma("unroll") for (int r = 0; r < 16; ++r) p[r] = __builtin_fmaf(sl_, (float)(32 * hf + (r & 3) + 8 * (r >> 2)), base); \
                _Pragma("unroll") for (int s = 0; s < 4; ++s) { \
                    const bf16x8 a0 = *(const LAS bf16x8*)(Kb + (32 * hf + l31) * 256 + (((map * 8 + 2 * s + hi) ^ (l31 & 15)) * 16)); \
                    p = __builtin_amdgcn_mfma_f32_32x32x16_bf16(a0, qpark[s * 64], p, 0, 0, 0); } \
                if ((t) == tl) { \
                    _Pragma("unroll") for (int r = 0; r < 16; ++r) { const int ki = 64 * (t) + 32 * hf + 4 * hi + (r & 3) + 8 * (r >> 2); if (ki > qrow) p[r] = -1e30f; } } \
                _Pragma("unroll") for (int r = 0; r < 16; ++r) { p[r] = __builtin_amdgcn_exp2f(p[r]); ls += p[r]; } \
                pw[2 * hf] = (v4u){cvtpk(p[0], p[1]), cvtpk(p[2], p[3]), cvtpk(p[4], p[5]), cvtpk(p[6], p[7])}; \
                pw[2 * hf + 1] = (v4u){cvtpk(p[8], p[9]), cvtpk(p[10], p[11]), cvtpk(p[12], p[13]), cvtpk(p[14], p[15])}; } \
            lsum += ls; } while (0)
#define AT_VRD(dst, ks, vb0) do { _Pragma("unroll") for (int vb = (vb0); vb < (vb0) + 2; ++vb) { const LAS unsigned char* a_ = Vb + vrow + ((4 * vb + vch) ^ (qq << 2)) * 16 + (32 * ((ks) >> 1) + 16 * ((ks) & 1)) * 256; \
        dst[2 * (vb - (vb0))] = vtr(a_); dst[2 * (vb - (vb0)) + 1] = vtr(a_ + 8 * 256); } } while (0)
#define AT_PV(src, pwk, vb0) do { _Pragma("unroll") for (int vb = (vb0); vb < (vb0) + 2; ++vb) { const int j_ = 2 * (vb - (vb0)); \
        const bf16x8 vf = (bf16x8){src[j_][0], src[j_][1], src[j_][2], src[j_][3], src[j_ + 1][0], src[j_ + 1][1], src[j_ + 1][2], src[j_ + 1][3]}; \
        o[vb] = __builtin_amdgcn_mfma_f32_32x32x16_bf16(vf, __builtin_bit_cast(bf16x8, pwk), o[vb], 0, 0, 0); } } while (0)
#define AT_PVV(v3_) do { const LAS unsigned char* Vb = lds + AT_V0 + (v3_) * AT_VB; s16x4 vA[4], vB[4]; \
            AT_VRD(vA, 0, 0); SBAR_(); AT_VRD(vB, 0, 2); SBAR_(); \
            AT_PV(vA, pw[0], 0); SBAR_(); AT_VRD(vA, 1, 0); SBAR_(); AT_PV(vB, pw[0], 2); SBAR_(); AT_VRD(vB, 1, 2); SBAR_(); \
            AT_PV(vA, pw[1], 0); SBAR_(); AT_VRD(vA, 2, 0); SBAR_(); AT_PV(vB, pw[1], 2); SBAR_(); AT_VRD(vB, 2, 2); SBAR_(); \
            AT_PV(vA, pw[2], 0); SBAR_(); AT_VRD(vA, 3, 0); SBAR_(); AT_PV(vB, pw[2], 2); SBAR_(); AT_VRD(vB, 3, 2); SBAR_(); \
            AT_PV(vA, pw[3], 0); SBAR_(); AT_PV(vB, pw[3], 2); } while (0)
    if (map == 0) {
        int v3 = tf % 3;
#pragma unroll 1
        for (int t = tf; t < NT; ++t) { const int vn = v3 == 2 ? 0 : v3 + 1;
            if (t + 1 < NT) AT_DMA(t + 1, (t + 1) & 1, vn);
            if (t <= tl) { AT_QK(t); AT_PVV(v3); }
            __syncthreads(); v3 = vn; }
    } else {
        int v3 = tf % 3;
#pragma unroll 1
        for (int t = tf; t < NT; ++t) { const int vp = v3 == 0 ? 2 : v3 - 1, vn = v3 == 2 ? 0 : v3 + 1;
            if (t + 1 < NT) AT_DMA(t + 1, (t + 1) & 1, vn);
            if (t > tf && t - 1 <= tl) AT_PVV(vp);
            if (t <= tl) AT_QK(t);
            __syncthreads(); v3 = vn; }
        if (NT - 1 <= tl) { const int vp = v3 == 0 ? 2 : v3 - 1; AT_PVV(vp); }
    }
#undef AT_PVV
#undef AT_QK
#undef AT_VRD
#undef AT_PV
#undef SBAR_
#undef AT_DMA
    __syncthreads();
    const float ltot = swap32_sum(lsum);
    LAS float* X = (LAS float*)lds;
    if (map == 1) {
        const float sc = __uint_as_float(F.MISC[14]) / ltot;
#pragma unroll
        for (int vb = 0; vb < 4; ++vb)
#pragma unroll
            for (int r = 0; r < 16; ++r) X[(qs * 64 + vb * 16 + r) * 64 + lane] = o[vb][r] * sc;
    }
    __syncthreads();
    if (map == 0) {
        const float il = 1.f / ltot; float ss = 0.f;
#pragma unroll
        for (int vb = 0; vb < 4; ++vb)
#pragma unroll
            for (int r = 0; r < 16; ++r) { const float v = o[vb][r] * il - X[(qs * 64 + vb * 16 + r) * 64 + lane]; o[vb][r] = v; ss += v * v; }
        ss = swap32_sum(ss);
        const float rn = (1.f / sqrtf(ss * (1.f / 128.f) + 1e-5f)) * (1.f - LAMBDA_INIT);
        int etok = 0; asm volatile("" : "+v"(etok));
        const int lane_e = mk_lane(), hi = lane_e >> 5;
        const size_t mrow_e = (size_t)b * T + qb * 128 + 32 * qs + (lane_e & 31);
        const bf16* gp = F.PROJ + mrow_e * NP + C_GB + h * 128;
        bf16* op = F.MIX + mrow_e * D + 512 + h * 128;
#pragma unroll
        for (int vb = 0; vb < 4; ++vb)
#pragma unroll
            for (int rg = 0; rg < 4; ++rg) {
                const int vc = 32 * vb + 8 * rg + 4 * hi + etok;
                const v2u gw = *(const GAS v2u*)(gp + vc); const f32x4 sg = *(const GAS f32x4*)(F.subln_g + vc);
                const float g4[4] = {bflo(gw.x), bfhi(gw.x), bflo(gw.y), bfhi(gw.y)}; float ov[4];
#pragma unroll
                for (int e = 0; e < 4; ++e) ov[e] = o[vb][4 * rg + e] * rn * sg[e] * g4[e] / (1.f + __expf(-g4[e]));
                const unsigned w1_ = cvtpk(ov[2], ov[3]);
                *(GAS v2u*)(op + vc) = (v2u){cvtpk(ov[0], ov[1]), w1_};
                if (rg == 3) asm volatile("" : "+v"(etok) : "v"(w1_));
            }
    }
    __syncthreads();
}
#ifndef DBL
#define DBL 0
#endif
constexpr int CW_QUEUE = 8192;
constexpr int QX_RW = 8, QX_A2 = 0, QX_AT = 64, QX_ALL = QX_RW + QX_A2 + QX_AT;
__device__ __forceinline__ void p3_queue(Frame& F, const RwDump& Dm, const int qbase = CW_QUEUE) {
    const int ql = mk_lane();
    const float l1 = wave_sum(F.lq1[ql] * F.lk1[ql]), l2 = wave_sum(F.lq2[ql] * F.lk2[ql]);
    const float lam = __uint_as_float(__builtin_amdgcn_readfirstlane(__float_as_uint(__expf(l1) - __expf(l2) + LAMBDA_INIT)));
    float gq = fabsf(F.qn_g[ql]), gk = fabsf(F.kn_g[ql]);
#pragma unroll
    for (int o = 1; o < 64; o <<= 1) { gq = fmaxf(gq, __shfl_xor(gq, o)); gk = fmaxf(gk, __shfl_xor(gk, o)); }
    const float shift2 = __uint_as_float(__builtin_amdgcn_readfirstlane(__float_as_uint(8.f * gq * gk * LOG2E)));
    if (F.wave == 0 && mk_lane() == 0) { F.MISC[14] = __float_as_uint(lam); F.MISC[15] = __float_as_uint(shift2); }
    __syncthreads();
#ifdef Q_BLK
    const int x0 = (int)(blockIdx.x & 7);
#else
    const int x0 = (int)(xb_xcc_id() & 7u);
#endif
#pragma unroll 1
    for (int dx = 0; dx < 8; ++dx) {
        const int xq = (x0 + dx) & 7;
        for (;;) {
            if (F.wave == 0 && mk_lane() == 0) F.MISC[12] = __hip_atomic_fetch_add(F.ctl + qbase + 64 * xq, 1u, RLX_AGENT);
            __syncthreads();
            const int item = __builtin_amdgcn_readfirstlane((int)F.MISC[12]);
            __syncthreads();
            if (item >= QX_ALL) break;
            if (item < QX_RW) { rwkvB_unit(F, Dm, xq * 8 + item); if (DBL & 64) rwkvB_unit(F, Dm, xq * 8 + item); }
            else { const int idx = item - QX_RW - QX_A2, h = 3 - (idx >> 4), qb = 15 - (idx & 15);
#pragma unroll 1
#ifndef NO_ATT
                for (int rep = 0; rep < ((DBL & 32) ? 2 : 1); ++rep) attn_unit(F, xq, h, qb);
#endif
            }
        }
    }
}

struct Args { const float* in[21]; float* out; unsigned char* ws; int ph_lo, ph_hi; };
__global__ void __launch_bounds__(NWAVES * 64, 2) hymba_fwd(Args args) {
    extern __shared__ __attribute__((aligned(16))) unsigned char lds[];
    Frame F;
    F.lds = (LAS unsigned char*)lds;
    F.MISC = (volatile LAS unsigned*)(F.lds + MISC_OFF);
    F.wave = __builtin_amdgcn_readfirstlane((int)threadIdx.x >> 6); F.lane = mk_lane(); F.tid = F.wave * 64 + F.lane;
    F.G = gridDim.x; { const int bx = blockIdx.x; F.vcu = (F.G % 8 == 0) ? (bx % 8) * (F.G / 8) + bx / 8 : bx; }
    unsigned char* ws = args.ws;
    F.ctl = (gu32*)(ws + WS_CTL);
    F.x = args.in[0]; F.norm_g = args.in[1]; F.w_in = args.in[2]; F.shift_mu = args.in[3]; F.w0 = args.in[4]; F.w_decay_up = args.in[5]; F.a0 = args.in[6]; F.w_iclr_up = args.in[7];
    F.k_k = args.in[8]; F.k_a = args.in[9]; F.r_k = args.in[10]; F.ln_w = args.in[11]; F.ln_b = args.in[12]; F.qn_g = args.in[13]; F.kn_g = args.in[14];
    F.lq1 = args.in[15]; F.lk1 = args.in[16]; F.lq2 = args.in[17]; F.lk2 = args.in[18]; F.subln_g = args.in[19]; F.w_out = args.in[20]; F.out = args.out;
    F.WinT = (bf16*)(ws + WS_WIN); F.WoutT = (bf16*)(ws + WS_WOUT); F.WdT = (bf16*)(ws + WS_WD); F.WaT = (bf16*)(ws + WS_WA);
    F.XN = (bf16*)(ws + WS_XN); F.PROJ = (bf16*)(ws + WS_PROJ); F.MIX = (bf16*)(ws + WS_MIX);
    for (int u = F.tid; u < (LDS_BYTES - LDSCTL_OFF) / 4; u += NWAVES * 64) ((LAS unsigned*)(F.lds + LDSCTL_OFF))[u] = 0u;
    __syncthreads();
    XcdBarrier bar; bar.bar = (unsigned*)(F.ctl + CW_BAR); bar.x = 0; bar.st = nullptr; bar.wave = F.wave;
    if (MK_N_LAUNCHES == 1) bar = xcd_barrier_post((unsigned*)(F.ctl + CW_BAR), F.MISC + 8, F.wave);
#define GRID_BAR() do { if (MK_N_LAUNCHES == 1) xcd_barrier(bar); } while (0)
    const int lo = args.ph_lo, hi = args.ph_hi;
#define IN(k) (lo <= (k) && (k) < hi)
#define BOTH(k) (IN(k) && IN((k) + 1))
#ifndef SKIP
#define SKIP 0
#endif
    if (IN(0) && !(SKIP & 1)) { p0_prologue(F); if (DBL & 1) { GRID_BAR(); p0_prologue(F); } if (BOTH(0)) GRID_BAR(); }
    if (IN(1) && !(SKIP & 2)) {
        pg8::Gemm g{F.XN, F.WinT, M, NP, D}; pg8::StaticOrder S; S.init(M, NP, F.G, (int)blockIdx.x);
        pg8::EpiBf16S E{F.PROJ, NP};
        pg8::gemm_phase<pg8::EpiBf16S, pg8::StaticOrder, true, true>(F.lds + RING_OFF, g, S, E, F.wave);
        if (DBL & 2) { GRID_BAR(); pg8::gemm_phase<pg8::EpiBf16S, pg8::StaticOrder, true, true>(F.lds + RING_OFF, g, S, E, F.wave); }
        if (BOTH(1)) GRID_BAR();
    }
    RwDump Dm; { unsigned char* so = (unsigned char*)args.out; Dm.PF = (v4u*)so; Dm.DD = (v4u*)(so + 32 * MiB); Dm.QF = (v4u*)(ws + WS_XN); Dm.YD = (v4u*)(ws + WS_XN + 16 * MiB);
        Dm.GAM = (float*)(ws + WS_END); Dm.RHO = (float*)(ws + WS_END + 1 * MiB); }
    if (IN(2) && !(SKIP & 4)) {
        LAS float* wscr = (LAS float*)(F.lds + LDSCTL_OFF + 1024) + F.wave * 64; int zpar = 0;
#pragma unroll 1
        for (int p = F.vcu; p < BATCH * (T / 32); p += F.G) { rwkvA_unit(F, Dm, (p >> 6) * RH + F.wave, p & 63, wscr, F.lds + RING_OFF + F.wave * 16384, (LAS v4u*)(F.lds + LDSCTL_OFF + 4096), zpar); zpar ^= 1; }
        if (DBL & 4) { GRID_BAR();
#pragma unroll 1
            for (int p = F.vcu; p < BATCH * (T / 32); p += F.G) { rwkvA_unit(F, Dm, (p >> 6) * RH + F.wave, p & 63, wscr, F.lds + RING_OFF + F.wave * 16384, (LAS v4u*)(F.lds + LDSCTL_OFF + 4096), zpar); zpar ^= 1; } }
        p2_qknorm(F);
        if (BOTH(2)) GRID_BAR();
    }
    if (IN(3) && !(SKIP & 8)) {
        p3_queue(F, Dm);
        if (DBL & 512) { GRID_BAR(); p3_queue(F, Dm, CW_QUEUE + 1024); }
        if (BOTH(3)) GRID_BAR();
    }
    if (IN(4) && !(SKIP & 16)) {
        pg8::Gemm g{F.MIX, F.WoutT, M, D, D}; pg8::StaticOrder S; S.init(M, D, F.G, (int)blockIdx.x);
        pg8::EpiResF32 E{F.x, F.out, D};
        pg8::gemm_phase<pg8::EpiResF32, pg8::StaticOrder, false, true>(F.lds + RING_OFF, g, S, E, F.wave);
        if (DBL & 16) { GRID_BAR(); pg8::gemm_phase<pg8::EpiResF32, pg8::StaticOrder, false, true>(F.lds + RING_OFF, g, S, E, F.wave); }
    }
#undef IN
#undef BOTH
}

extern "C" void kernel_launch(void* const* d_in, const int* in_sizes, int n_in, void* d_out, int out_size, void* d_ws, size_t ws_size, hipStream_t stream) {
    static int grid = 0;
    if (grid == 0) {
        if (n_in != 21 || in_sizes[0] != M * D || out_size != M * D || ws_size < WS_END + 2 * MiB) { fprintf(stderr, "kernel_launch: unexpected shapes (n_in %d, in0 %d, out %d, ws %zu); nothing launched\n", n_in, n_in > 0 ? in_sizes[0] : -1, out_size, ws_size); grid = -1; return; }
        int dev = 0, cus = 0, per_cu = 0;
        if (hipGetDevice(&dev) != hipSuccess || hipDeviceGetAttribute(&cus, hipDeviceAttributeMultiprocessorCount, dev) != hipSuccess) { grid = -1; return; }
        if (hipFuncSetAttribute((const void*)hymba_fwd, hipFuncAttributeMaxDynamicSharedMemorySize, LDS_BYTES) != hipSuccess) { fprintf(stderr, "kernel_launch: hipFuncSetAttribute failed\n"); grid = -1; return; }
        if (hipOccupancyMaxActiveBlocksPerMultiprocessor(&per_cu, (const void*)hymba_fwd, NWAVES * 64, LDS_BYTES) != hipSuccess || per_cu < 1) { fprintf(stderr, "kernel_launch: occupancy query reports %d workgroups per CU; nothing launched\n", per_cu); grid = -1; return; }
        (void)hipGetLastError();
        grid = cus;
        if (grid > 256) grid = 256;
    }
    if (grid < 0) return;
    if (hipMemsetAsync((char*)d_ws + WS_CTL, 0, CTL_ZERO_BYTES, stream) != hipSuccess) { fprintf(stderr, "kernel_launch: hipMemsetAsync failed\n"); return; }
    Args a{};
    for (int i = 0; i < 21; ++i) a.in[i] = (const float*)d_in[i];
    a.out = (float*)d_out; a.ws = (unsigned char*)d_ws;
    for (int li = 0; li < MK_N_LAUNCHES; ++li) {
        a.ph_lo = (MK_N_LAUNCHES == 1) ? 0 : li; a.ph_hi = (MK_N_LAUNCHES == 1) ? N_PHASES : li + 1;
        hipLaunchKernelGGL(hymba_fwd, dim3(grid), dim3(NWAVES * 64), LDS_BYTES, stream, a);
        const hipError_t le = hipPeekAtLastError();
        if (le != hipSuccess) { fprintf(stderr, "kernel_launch: launch %d failed: %s\n", li, hipGetErrorName(le)); break; }
    }
}
```

```cpp
#include <hip/hip_runtime.h>
#include <hip/hip_bf16.h>
#include <cstdio>
#include <cstdint>
#include <cmath>
namespace pg8 {
#define PG8_LAS __attribute__((address_space(3)))
typedef unsigned short bf16_t;
typedef short bf16x8 __attribute__((ext_vector_type(8)));
typedef float f32x4 __attribute__((ext_vector_type(4)));
typedef unsigned u32x4 __attribute__((ext_vector_type(4)));
constexpr int BM = 256, BK = 64, HALF = 128, HTB = HALF * BK * 2  , STAGE_BYTES = 8 * HTB, NXCD = 8, WGM = 8;

__host__ __device__ __forceinline__ int lds_byte(int r, int c) { const int st = (r >> 4) * 2 + (c >> 5), rr = r & 15, cc = c & 31, ob = rr * 64 + cc * 2; return st * 1024 + (ob ^ (((ob >> 9) & 1) << 5)); }
__host__ __device__ __forceinline__ void stage_rc(int b, int& R, int& C) { const int st = b / 1024, sb = b % 1024, swz = sb ^ (((sb >> 9) & 1) << 5); R = (st >> 1) * 16 + swz / 64; C = (st & 1) * 32 + (swz % 64) / 2; }
__host__ __device__ __forceinline__ int perm32(int rho) { const int n = rho >> 4, i = rho & 15; return 8 * (i >> 2) + 4 * n + (i & 3); }

__device__ __forceinline__ int mk_lane_pg8() { int l; asm volatile("v_mbcnt_lo_u32_b32 %0, -1, 0\n\tv_mbcnt_hi_u32_b32 %0, -1, %0" : "=v"(l)); return l; }
struct Unit { int pm, pn; };
struct Gemm { const bf16_t* A; const bf16_t* Bt; int M, N, K; };

struct StaticOrder {
    int nM, nN, nwg, G, c;
    __host__ __device__ void init(int M, int N, int G_, int c_) { nM = M / BM; nN = N / BM; nwg = nM * nN; G = G_; c = c_; }
    __host__ __device__ bool next(int i, Unit& u) const {
        const long L = (long)i * G + c; if (L >= nwg) return false;
        int wgid = (int)L; { const int q = nwg / NXCD, r = nwg % NXCD, xcd = wgid % NXCD, off = wgid / NXCD; wgid = (xcd < r ? xcd * (q + 1) : r * (q + 1) + (xcd - r) * q) + off; }
        const int nig = WGM * nN, gid = wgid / nig, fm = gid * WGM, gsz = (nM - fm) < WGM ? (nM - fm) : WGM;
        u.pm = fm + ((wgid % nig) % gsz); u.pn = (wgid % nig) / gsz; return true;
    }
    __device__ __forceinline__ void a_ready(const Unit&) const {}
    __device__ __forceinline__ void done(const Unit&) const {}
};

__device__ __forceinline__ unsigned cvt_pk_bf16(float lo, float hi) { unsigned r; asm volatile("v_cvt_pk_bf16_f32 %0, %1, %2" : "=v"(r) : "v"(lo), "v"(hi)); return r; }
struct EpiBf16S {
    static constexpr bool PERM = true, AFTER_DRAIN = false, HAS_INIT = false;
    bf16_t* O; int ldc;
    __device__ __forceinline__ void operator()(const f32x4 (&acc)[2][2][4][2], const Unit& u, int wr, int wc, int fr, int fq) const {
        const int row0 = u.pm * BM + wr * 64 + fr, col0 = u.pn * BM + wc * 32 + 8 * fq;
#pragma unroll
        for (int ai = 0; ai < 2; ++ai)
#pragma unroll
            for (int m = 0; m < 4; ++m) { bf16_t* rowp = O + (size_t)(row0 + ai * HALF + m * 16) * ldc + col0;
#pragma unroll
                for (int bj = 0; bj < 2; ++bj) { const f32x4 v0 = acc[ai][bj][m][0], v1 = acc[ai][bj][m][1];
                    u32x4 w; w.x = cvt_pk_bf16(v0[0], v0[1]); w.y = cvt_pk_bf16(v0[2], v0[3]); w.z = cvt_pk_bf16(v1[0], v1[1]); w.w = cvt_pk_bf16(v1[2], v1[3]);
                    *(u32x4*)(rowp + bj * HALF) = w; } }
    }
};
struct EpiResF32 {
    static constexpr bool PERM = false, AFTER_DRAIN = false, HAS_INIT = true;
    const float* base; float* out; int ldc;
    __device__ __forceinline__ void init(f32x4 (&acc)[2][2][4][2], const Unit& u, int wr, int wc, int fr, int fq) const {
        const int row0 = u.pm * BM + wr * 64 + fr, col0 = u.pn * BM + wc * 32 + 4 * fq;
#pragma unroll
        for (int ai = 0; ai < 2; ++ai)
#pragma unroll
            for (int m = 0; m < 4; ++m) { const size_t off = (size_t)(row0 + ai * HALF + m * 16) * ldc + col0;
#pragma unroll
                for (int bj = 0; bj < 2; ++bj)
#pragma unroll
                    for (int n = 0; n < 2; ++n) acc[ai][bj][m][n] = *(const f32x4*)(base + off + bj * HALF + n * 16); }
    }
    __device__ __forceinline__ void operator()(const f32x4 (&acc)[2][2][4][2], const Unit& u, int wr, int wc, int fr, int fq) const {
        const int row0 = u.pm * BM + wr * 64 + fr, col0 = u.pn * BM + wc * 32 + 4 * fq;
#pragma unroll
        for (int ai = 0; ai < 2; ++ai)
#pragma unroll
            for (int m = 0; m < 4; ++m) { const size_t off = (size_t)(row0 + ai * HALF + m * 16) * ldc + col0;
#pragma unroll
                for (int bj = 0; bj < 2; ++bj)
#pragma unroll
                    for (int n = 0; n < 2; ++n) *(f32x4*)(out + off + bj * HALF + n * 16) = acc[ai][bj][m][n]; }
    }
};
template <class Epi, class Sched, bool ALIGN_EPI = false, bool SP2 = false>
__device__ __forceinline__ void gemm_phase(PG8_LAS unsigned char* lds, const Gemm g, const Sched& S, const Epi& E, const int mk_wave_id  ) {
    const int wid = mk_wave_id, lane = mk_lane_pg8(), tid = wid * 64 + lane, wr = wid >> 2, wc = wid & 3, fr = lane & 15, fq = lane >> 4;
    const int K = g.K, nt = K / BK;
    unsigned voffA[2], voffB[2];
#pragma unroll
    for (int i = 0; i < 2; ++i) { int R, C; stage_rc(tid * 16 + i * 8192, R, C); const int Rb = Epi::PERM ? ((R & ~31) + perm32(R & 31)) : R;
        voffA[i] = (unsigned)(R * K + C) * 2u; voffB[i] = (unsigned)(Rb * K + C) * 2u; }
    const size_t kstep = (size_t)(BK * 2);
    const size_t hstep = (size_t)HALF * K * 2;
    const size_t tstep = 2 * hstep;
    const unsigned ldsw = (unsigned)wid * 1024u;
    const int aoff = lds_byte(wr * 64 + fr, fq * 8), boff = lds_byte(wc * 32 + fr, fq * 8);
#define PG8_SA(b, h) (((b) * 2 + (h)) * HTB)
#define PG8_SB(b, h) ((4 + (b) * 2 + (h)) * HTB)
#define PG8_STAGE(bufoff, gbase, voff) do { _Pragma("unroll") for (int _i = 0; _i < 2; ++_i) \
        __builtin_amdgcn_global_load_lds((const unsigned*)((const char*)(gbase) + (voff)[_i]), (PG8_LAS unsigned*)(lds + (bufoff) + ldsw + _i * 8192), 16, 0, 0); } while (0)
#define PG8_LDA(dst, b, h) do { _Pragma("unroll") for (int m = 0; m < 4; ++m) _Pragma("unroll") for (int k = 0; k < 2; ++k) dst[m][k] = *(const PG8_LAS bf16x8*)(lds + PG8_SA(b, h) + aoff + m * 2048 + k * 1024); } while (0)
#define PG8_LDB(dst, b, h) do { _Pragma("unroll") for (int n = 0; n < 2; ++n) _Pragma("unroll") for (int k = 0; k < 2; ++k) dst[n][k] = *(const PG8_LAS bf16x8*)(lds + PG8_SB(b, h) + boff + n * 2048 + k * 1024); } while (0)
#define PG8_MMA(ai, bj, At, Bt) do { __builtin_amdgcn_s_setprio(1); _Pragma("unroll") for (int m = 0; m < 4; ++m) _Pragma("unroll") for (int n = 0; n < 2; ++n) _Pragma("unroll") for (int k = 0; k < 2; ++k) \
        acc[ai][bj][m][n] = __builtin_amdgcn_mfma_f32_16x16x32_bf16(Bt[n][k], At[m][k], acc[ai][bj][m][n], 0, 0, 0); __builtin_amdgcn_s_setprio(0); } while (0)
#define PG8_WAIT_V(n) asm volatile("s_waitcnt vmcnt(" #n ")" ::: "memory")
#define PG8_WAIT_L(n) asm volatile("s_waitcnt lgkmcnt(" #n ")" ::: "memory")
#define PG8_BAR __builtin_amdgcn_s_barrier()
#define PG8_SCHED __builtin_amdgcn_sched_barrier(0)
    Unit cur, nxt; int ui = 0;
    if (!S.next(0, cur)) return;
    f32x4 acc[2][2][4][2];
#pragma unroll
    for (int a = 0; a < 2; ++a)
#pragma unroll
        for (int b = 0; b < 2; ++b)
#pragma unroll
            for (int m = 0; m < 4; ++m)
#pragma unroll
                for (int n = 0; n < 2; ++n) acc[a][b][m][n] = (f32x4){0.f, 0.f, 0.f, 0.f};
    if constexpr (Epi::HAS_INIT) E.init(acc, cur, wr, wc, fr, fq);
    bf16x8 At[4][2], B0[2][2], B1[2][2];
    const char* cA = (const char*)g.A + (size_t)cur.pm * tstep; const char* cB = (const char*)g.Bt + (size_t)cur.pn * tstep;
    S.a_ready(cur);
    if constexpr (SP2) {
        PG8_STAGE(PG8_SB(0, 0), cB, voffB); PG8_STAGE(PG8_SB(0, 1), cB + hstep, voffB); PG8_STAGE(PG8_SA(0, 0), cA, voffA); PG8_STAGE(PG8_SA(0, 1), cA + hstep, voffA);
        if (wr == 1) PG8_BAR;
        PG8_WAIT_V(2); PG8_BAR;
        PG8_STAGE(PG8_SB(1, 0), cB + kstep, voffB); PG8_STAGE(PG8_SA(1, 0), cA + kstep, voffA); PG8_STAGE(PG8_SB(1, 1), cB + hstep + kstep, voffB);
        PG8_WAIT_V(6); PG8_BAR;
    } else {
        PG8_STAGE(PG8_SB(0, 0), cB, voffB); PG8_STAGE(PG8_SA(0, 0), cA, voffA); PG8_STAGE(PG8_SB(0, 1), cB + hstep, voffB); PG8_STAGE(PG8_SA(0, 1), cA + hstep, voffA);
        if (wr == 1) PG8_BAR;
        PG8_WAIT_V(4); PG8_BAR;
        PG8_STAGE(PG8_SB(1, 0), cB + kstep, voffB); PG8_STAGE(PG8_SA(1, 0), cA + kstep, voffA); PG8_STAGE(PG8_SB(1, 1), cB + hstep + kstep, voffB);
        PG8_WAIT_V(6); PG8_BAR;
    }
    for (;;) {
        const bool has_next = S.next(ui + 1, nxt);
        const char* nA = has_next ? (const char*)g.A + (size_t)nxt.pm * tstep : cA; const char* nB = has_next ? (const char*)g.Bt + (size_t)nxt.pn * tstep : cB;
        for (int t = 0; t < nt; t += 2) {
            const bool last = (t == nt - 2);
            const char* a1 = cA + (size_t)(t + 1) * kstep;
            const char* a2 = last ? nA : cA + (size_t)(t + 2) * kstep; const char* b2 = last ? nB : cB + (size_t)(t + 2) * kstep;
            const char* a3 = a2 + kstep; const char* b3 = b2 + kstep;
            if (last && has_next) S.a_ready(nxt);
            if constexpr (SP2) {
            PG8_LDB(B0, 0, 0); PG8_LDB(B1, 0, 1); PG8_SCHED; PG8_LDA(At, 0, 0); PG8_STAGE(PG8_SA(1, 1), a1 + hstep, voffA);
            PG8_WAIT_V(8); PG8_WAIT_L(0); PG8_BAR; PG8_MMA(0, 0, At, B0); PG8_MMA(0, 1, At, B1); PG8_BAR; PG8_SCHED;
            PG8_LDA(At, 0, 1); PG8_STAGE(PG8_SB(0, 0), b2, voffB); PG8_STAGE(PG8_SB(0, 1), b2 + hstep, voffB); PG8_STAGE(PG8_SA(0, 0), a2, voffA);
            PG8_WAIT_V(8); PG8_WAIT_L(0); PG8_BAR; PG8_MMA(1, 0, At, B0); PG8_MMA(1, 1, At, B1); PG8_BAR; PG8_SCHED;
            PG8_LDB(B0, 1, 0); PG8_LDB(B1, 1, 1); PG8_SCHED; PG8_LDA(At, 1, 0); PG8_STAGE(PG8_SA(0, 1), a2 + hstep, voffA);
            PG8_WAIT_V(8); PG8_WAIT_L(0); PG8_BAR; PG8_MMA(0, 0, At, B0); PG8_MMA(0, 1, At, B1); PG8_BAR; PG8_SCHED;
            PG8_LDA(At, 1, 1); PG8_STAGE(PG8_SB(1, 0), b3, voffB); PG8_STAGE(PG8_SB(1, 1), b3 + hstep, voffB); PG8_STAGE(PG8_SA(1, 0), a3, voffA);
            PG8_WAIT_V(8); PG8_WAIT_L(0); PG8_BAR; PG8_MMA(1, 0, At, B0); PG8_MMA(1, 1, At, B1); PG8_BAR; PG8_SCHED;
            } else {
            PG8_LDB(B0, 0, 0); PG8_SCHED; PG8_LDA(At, 0, 0); PG8_STAGE(PG8_SA(1, 1), a1 + hstep, voffA);
            PG8_WAIT_L(8); PG8_BAR; PG8_WAIT_L(0); PG8_MMA(0, 0, At, B0); PG8_BAR; PG8_SCHED;
            PG8_LDB(B1, 0, 1); PG8_STAGE(PG8_SB(0, 0), b2, voffB);
            PG8_BAR; PG8_WAIT_L(0); PG8_MMA(0, 1, At, B1); PG8_BAR;
            PG8_LDA(At, 0, 1); PG8_STAGE(PG8_SA(0, 0), a2, voffA);
            PG8_BAR; PG8_WAIT_L(0); PG8_MMA(1, 0, At, B0); PG8_BAR; PG8_SCHED;
            PG8_STAGE(PG8_SB(0, 1), b2 + hstep, voffB);
            PG8_WAIT_V(6); PG8_BAR; PG8_MMA(1, 1, At, B1); PG8_BAR;
            PG8_LDB(B0, 1, 0); PG8_SCHED; PG8_LDA(At, 1, 0); PG8_STAGE(PG8_SA(0, 1), a2 + hstep, voffA);
            PG8_WAIT_L(8); PG8_BAR; PG8_WAIT_L(0); PG8_MMA(0, 0, At, B0); PG8_BAR; PG8_SCHED;
            PG8_LDB(B1, 1, 1); PG8_STAGE(PG8_SB(1, 0), b3, voffB);
            PG8_BAR; PG8_WAIT_L(0); PG8_MMA(0, 1, At, B1); PG8_BAR;
            PG8_LDA(At, 1, 1); PG8_STAGE(PG8_SA(1, 0), a3, voffA);
            PG8_BAR; PG8_WAIT_L(0); PG8_MMA(1, 0, At, B0); PG8_BAR; PG8_SCHED;
            PG8_STAGE(PG8_SB(1, 1), b3 + hstep, voffB);
            PG8_WAIT_V(6); PG8_BAR; PG8_MMA(1, 1, At, B1); PG8_BAR;
            }
        }
        if constexpr (ALIGN_EPI) { if (wr == 0) PG8_BAR; }
        if constexpr (!Epi::AFTER_DRAIN) { E(acc, cur, wr, wc, fr, fq); S.done(cur); }
        if (!has_next) break;
#pragma unroll
        for (int a = 0; a < 2; ++a)
#pragma unroll
            for (int b = 0; b < 2; ++b)
#pragma unroll
                for (int m = 0; m < 4; ++m)
#pragma unroll
                    for (int n = 0; n < 2; ++n) acc[a][b][m][n] = (f32x4){0.f, 0.f, 0.f, 0.f};
        if constexpr (Epi::HAS_INIT) E.init(acc, nxt, wr, wc, fr, fq);
        cur = nxt; cA = nA; cB = nB; ++ui;
        if constexpr (ALIGN_EPI) { if (wr == 1) PG8_BAR; }
    }
    PG8_WAIT_V(0);
    if constexpr (!ALIGN_EPI) { if (wr == 0) PG8_BAR; }
    PG8_BAR;
    if constexpr (Epi::AFTER_DRAIN) { E.fused(acc, cur, wr, wc, fr, fq, lds, wid, lane); S.done(cur); }
#undef PG8_SA
#undef PG8_SB
#undef PG8_STAGE
#undef PG8_LDA
#undef PG8_LDB
#undef PG8_MMA
#undef PG8_WAIT_V
#undef PG8_WAIT_L
#undef PG8_BAR
#undef PG8_SCHED
}
}
constexpr int NWAVES = 8;
#ifndef MK_N_LAUNCHES
#define MK_N_LAUNCHES 1
#endif
constexpr int N_PHASES = 5;
constexpr int BATCH = 8, T = 2048, D = 1024, M = BATCH * T;
constexpr int NP = 4352;
constexpr int C_R = 0, C_K = 512, C_V = 1024, C_ZW = 1536, C_ZA = 1600, C_GA = 1792, C_DQ = 2304, C_DK = 2816, C_DV = 3328, C_GB = 3840;
constexpr int RH = 8, RN = 64;
constexpr int AH = 4;
constexpr float C2 = 0.125f * 1.4426950408889634f;
constexpr float LOG2E = 1.4426950408889634f;
constexpr float LAMBDA_INIT = 0.2f;

constexpr size_t MiB = 1u << 20;
constexpr size_t WS_CTL = 0, CTL_ZERO_BYTES = 1 * MiB;
constexpr size_t WS_WIN = 2 * MiB;
constexpr size_t WS_WOUT = 11 * MiB;
constexpr size_t WS_WD = 13 * MiB, WS_WA = 13 * MiB + 65536;
constexpr size_t WS_RHO = 13 * MiB + 2 * 65536;
constexpr size_t WS_XN = 14 * MiB;
constexpr size_t WS_PROJ = 46 * MiB;
constexpr size_t WS_MIX = 182 * MiB;
constexpr size_t WS_END = 214 * MiB;
constexpr int CW_BAR = 4096;

constexpr int RING_OFF = 0, RING_BYTES = 131072;
constexpr int LDSCTL_OFF = RING_BYTES, MISC_OFF = LDSCTL_OFF + 320;
constexpr int LDS_BYTES = 155648;

#define GAS __attribute__((address_space(1)))
#define LAS __attribute__((address_space(3)))
typedef unsigned short bf16;
typedef unsigned v4u __attribute__((ext_vector_type(4)));
typedef unsigned v2u __attribute__((ext_vector_type(2)));
typedef float f32x4 __attribute__((ext_vector_type(4)));
typedef float f32x16 __attribute__((ext_vector_type(16)));
typedef short bf16x8 __attribute__((ext_vector_type(8)));
typedef short s16x4 __attribute__((ext_vector_type(4)));
typedef GAS unsigned gu32;
typedef GAS unsigned long long gu64;
#define RLX_AGENT __ATOMIC_RELAXED, __HIP_MEMORY_SCOPE_AGENT
#define LDS_WAIT() asm volatile("s_waitcnt lgkmcnt(0)" ::: "memory")
#define VM_WAIT() asm volatile("s_waitcnt vmcnt(0)" ::: "memory")
__device__ __forceinline__ unsigned f2bf(float f) { unsigned u = __builtin_bit_cast(unsigned, f); return (u + 0x7fffu + ((u >> 16) & 1u)) >> 16; }
__device__ __forceinline__ unsigned pk2(float lo, float hi) { return f2bf(lo) | (f2bf(hi) << 16); }
__device__ __forceinline__ float bflo(unsigned u) { return __uint_as_float(u << 16); }
__device__ __forceinline__ float bfhi(unsigned u) { return __uint_as_float(u & 0xffff0000u); }
__device__ __forceinline__ float bf1(unsigned short u) { return __uint_as_float((unsigned)u << 16); }
__device__ __forceinline__ int mk_lane() { int l; asm volatile("v_mbcnt_lo_u32_b32 %0, -1, 0\n\tv_mbcnt_hi_u32_b32 %0, -1, %0" : "=v"(l)); return l; }
#define XB_TMO      128
#define XB_XCNT(j)  (256  + 64 * (j))
#define XB_XSUB(j)  (1280 + 64 * (j))
#define XB_XGEN(j)  (2304 + 64 * (j))
#define XB_TOP      3328
#define XB_TOPGEN   3392
#define XCD_BAR_WORDS 3456
#define XB_SPIN_CAP (1u << 18)

__device__ __forceinline__ unsigned xb_ld(unsigned* p)              { return __hip_atomic_load(p, __ATOMIC_RELAXED, __HIP_MEMORY_SCOPE_AGENT); }
__device__ __forceinline__ unsigned xb_add(unsigned* p, unsigned v) { return __hip_atomic_fetch_add(p, v, __ATOMIC_RELAXED, __HIP_MEMORY_SCOPE_AGENT); }
__device__ __forceinline__ unsigned xb_xcc_id() { return (unsigned)__builtin_amdgcn_s_getreg((3 << 11) | 20) & 0xFu; }
#define XB_SPIN(cond, bar) do { unsigned _sp = 0; while (cond) { __builtin_amdgcn_s_sleep(1); \
    if ((++_sp & 255u) == 0u) { if (xb_ld(&(bar)[XB_TMO])) break; if (_sp > XB_SPIN_CAP) { atomicAdd(&(bar)[XB_TMO], 1u); break; } } } } while (0)

struct XcdBarrier {
    unsigned* bar; unsigned x;
    volatile LAS unsigned* st;
    int wave;
};

__device__ __forceinline__ XcdBarrier xcd_barrier_post(unsigned* bar, volatile LAS unsigned* st, int wave) {
    XcdBarrier b; b.bar = bar; b.x = xb_xcc_id(); b.st = st; b.wave = wave;
    if (wave == 0 && mk_lane() == 0) (void)xb_add(&bar[XB_XCNT(b.x)], 1u);
    return b;
}
__device__ __forceinline__ void xcd_barrier_complete(unsigned* bar, unsigned x, unsigned& nloc, unsigned& nx) {
    const unsigned G = gridDim.x * gridDim.y * gridDim.z;
    unsigned sum, cnt, mine, sp = 0u;
    for (;;) {
        sum = 0u; cnt = 0u; mine = 0u;
#pragma unroll
        for (unsigned j = 0; j < 16; ++j) { const unsigned c = xb_ld(&bar[XB_XCNT(j)]); sum += c; cnt += (c > 0u) ? 1u : 0u; mine = (j == x) ? c : mine; }
        if (sum == G) break;
        __builtin_amdgcn_s_sleep(1);
        if ((++sp & 255u) == 0u) { if (xb_ld(&bar[XB_TMO])) break; if (sp > XB_SPIN_CAP) { atomicAdd(&bar[XB_TMO], 1u); break; } }
    }
    nloc = mine > 0u ? mine : 1u; nx = cnt > 0u ? cnt : 1u;
}

__device__ __forceinline__ void xcd_barrier(const XcdBarrier& b) {
    asm volatile("s_waitcnt vmcnt(0)" ::: "memory");
    __syncthreads();
    if (b.wave == 0 && mk_lane() == 0) {
        unsigned* bar = b.bar;
        __builtin_amdgcn_s_waitcnt(0);
        unsigned nloc = b.st[0], nx = b.st[1];
        if (nloc == 0u) { xcd_barrier_complete(bar, b.x, nloc, nx); b.st[0] = nloc; b.st[1] = nx; }
        const unsigned old = xb_add(&bar[XB_XSUB(b.x)], 1u);
        const unsigned gen = old / nloc;
        if (old + 1u == (gen + 1u) * nloc) {
            __builtin_amdgcn_fence(__ATOMIC_RELEASE, "agent");
            asm volatile("s_waitcnt vmcnt(0)" ::: "memory");
            const unsigned og = xb_add(&bar[XB_TOP], 1u);
            const unsigned tg = og / nx;
            if (og + 1u == (tg + 1u) * nx) xb_add(&bar[XB_TOPGEN], 1u);
            else XB_SPIN(xb_ld(&bar[XB_TOPGEN]) == tg, bar);
            __builtin_amdgcn_fence(__ATOMIC_ACQUIRE, "agent");
            xb_add(&bar[XB_XGEN(b.x)], 1u);
            asm volatile("s_waitcnt vmcnt(0)" ::: "memory");
        } else {
            XB_SPIN(xb_ld(&bar[XB_XGEN(b.x)]) == gen, bar);
            __builtin_amdgcn_fence(__ATOMIC_ACQUIRE, "agent");
            asm volatile("s_waitcnt vmcnt(0)" ::: "memory");
        }
    }
    __syncthreads();
}
struct Frame {
    LAS unsigned char* lds;
    volatile LAS unsigned* MISC;
    gu32* ctl;
    int tid, lane, wave;
    int vcu, G;
    const float* x; float* out;
    const float *norm_g, *w_in, *shift_mu, *w0, *w_decay_up, *a0, *w_iclr_up, *k_k, *k_a, *r_k, *ln_w, *ln_b, *qn_g, *kn_g, *lq1, *lk1, *lq2, *lk2, *subln_g, *w_out;
    bf16 *WinT, *WoutT, *WdT, *WaT, *XN, *PROJ, *MIX;
};

typedef float f32x2q_t __attribute__((ext_vector_type(2))); typedef __bf16 bf16x2q_t __attribute__((ext_vector_type(2)));
__device__ __forceinline__ unsigned cvtpk2(float lo, float hi) { f32x2q_t v = {lo, hi}; bf16x2q_t b = __builtin_convertvector(v, bf16x2q_t); return __builtin_bit_cast(unsigned, b); }
__device__ __forceinline__ float wave_sum(float v) {
#pragma unroll
    for (int o = 1; o < 64; o <<= 1) v += __shfl_xor(v, o);
    return v;
}
template <int CTRL> __device__ __forceinline__ float dpp_f(float x) { return __builtin_bit_cast(float, __builtin_amdgcn_mov_dpp(__builtin_bit_cast(int, x), CTRL, 0xf, 0xf, true)); }
__device__ __forceinline__ float row16_sum(float x) {
    x += dpp_f<0xB1>(x); x += dpp_f<0x4E>(x); x += dpp_f<0x141>(x); x += dpp_f<0x140>(x); return x;
}
__device__ __forceinline__ float swap32_sum(float x) {
    auto rr = __builtin_amdgcn_permlane32_swap(__float_as_uint(x), __float_as_uint(x), false, false);
    return __uint_as_float(rr[0]) + __uint_as_float(rr[1]);
}

__device__ __forceinline__ void p0_transpose_item(const float* W, int N, int nsrc, const float* kscale, bf16* WT, int K, int ndst, LAS float* scr, int k0, int lane) {
    float v[32];
#pragma unroll
    for (int i = 0; i < 32; ++i) { const int kk = 2 * i + (lane >> 5); v[i] = (nsrc >= 0) ? W[(size_t)(k0 + kk) * N + nsrc + (lane & 31)] : 0.f; }
    if (kscale && nsrc >= 0) {
#pragma unroll
        for (int i = 0; i < 32; ++i) v[i] *= kscale[k0 + 2 * i + (lane >> 5)];
    }
#pragma unroll
    for (int i = 0; i < 32; ++i) scr[(2 * i + (lane >> 5)) * 33 + (lane & 31)] = v[i];
    LDS_WAIT(); asm volatile("" ::: "memory");
    const int c = lane & 7;
#pragma unroll
    for (int j = 0; j < 4; ++j) { const int n = (lane >> 3) + 8 * j; const LAS float* s = scr + (8 * c) * 33 + n;
        v4u o; o.x = cvtpk2(s[0 * 33], s[1 * 33]); o.y = cvtpk2(s[2 * 33], s[3 * 33]); o.z = cvtpk2(s[4 * 33], s[5 * 33]); o.w = cvtpk2(s[6 * 33], s[7 * 33]);
        *(GAS v4u*)(WT + (size_t)(ndst + n) * K + k0 + 8 * c) = o; }
    LDS_WAIT(); asm volatile("" ::: "memory");
}
__device__ __forceinline__ void p0_rows4(Frame& F, int m0) {
    f32x4 v[4][4]; float s[4];
#pragma unroll
    for (int u = 0; u < 4; ++u) { const GAS f32x4* xr = (const GAS f32x4*)(F.x + (size_t)(m0 + u) * D) + F.lane;
#pragma unroll
        for (int j = 0; j < 4; ++j) v[u][j] = __builtin_nontemporal_load(xr + 64 * j); }
#pragma unroll
    for (int u = 0; u < 4; ++u) { float a = 0.f;
#pragma unroll
        for (int j = 0; j < 4; ++j) a += (v[u][j].x * v[u][j].x + v[u][j].y * v[u][j].y) + (v[u][j].z * v[u][j].z + v[u][j].w * v[u][j].w);
        s[u] = a; }
#pragma unroll
    for (int u = 0; u < 4; ++u) {
        const float rstd = __builtin_amdgcn_rsqf(wave_sum(s[u]) * (1.f / D) + 1e-6f);
        GAS unsigned long long* o8 = (GAS unsigned long long*)(F.XN + (size_t)(m0 + u) * D) + F.lane;
#pragma unroll
        for (int j = 0; j < 4; ++j) o8[64 * j] = (unsigned long long)cvtpk2(v[u][j].x * rstd, v[u][j].y * rstd) | ((unsigned long long)cvtpk2(v[u][j].z * rstd, v[u][j].w * rstd) << 32);
    }
}
__device__ __forceinline__ void p0_prologue(Frame& F) {
    LAS float* scr = (LAS float*)(F.lds + RING_OFF + F.wave * 16384);
    const int gw = F.vcu * NWAVES + F.wave, NGW = F.G * NWAVES;
    constexpr int I_IN = (D / 64) * (NP / 32), I_OUT = (D / 64) * (D / 32), I_L = 512 / 32;
    constexpr int NITEMS = I_IN + I_OUT + 2 * I_L;
    int m0 = gw * 4;
    if (!(gw & 1) && m0 < M) { p0_rows4(F, m0); m0 += NGW * 4; }
#pragma unroll 1
    for (int it = gw; it < NITEMS; it += NGW) {
        int r = it;
        if (r < I_IN) { const int kb = r / (NP / 32), nb = r % (NP / 32), nd = 32 * nb; const int ns = nd < 1664 ? nd : (nd < 1792 ? -1 : nd - 128);
            p0_transpose_item(F.w_in, 4224, ns, F.norm_g, F.WinT, D, nd, scr, 64 * kb, F.lane); continue; } r -= I_IN;
        if (r < I_OUT) { const int kb = r / (D / 32), nb = r % (D / 32);
            p0_transpose_item(F.w_out, D, 32 * nb, nullptr, F.WoutT, D, 32 * nb, scr, 64 * kb, F.lane); continue; } r -= I_OUT;
        if (r < I_L) { p0_transpose_item(F.w_decay_up, 512, 32 * r, nullptr, F.WdT, 64, 32 * r, scr, 0, F.lane); continue; } r -= I_L;
        p0_transpose_item(F.w_iclr_up, 512, 32 * r, nullptr, F.WaT, 64, 32 * r, scr, 0, F.lane);
    }
#pragma unroll 1
    for (; m0 < M; m0 += NGW * 4) p0_rows4(F, m0);
}

__device__ __forceinline__ float tanh_f(float x) { const float e = __expf(-2.f * fabsf(x)); const float t = (1.f - e) * __builtin_amdgcn_rcpf(1.f + e); return x < 0.f ? -t : t; }
__device__ __forceinline__ void shifted8(const bf16* proj, size_t m, bool has_prev, int col, const float* mu, float (&o)[8]) {
    const v4u c = *(const GAS v4u*)(proj + m * NP + col);
    v4u p = (v4u){0u, 0u, 0u, 0u}; if (has_prev) p = *(const GAS v4u*)(proj + (m - 1) * NP + col);
    const f32x4 m0 = *(const GAS f32x4*)(mu), m1 = *(const GAS f32x4*)(mu + 4);
    const unsigned cw[4] = {c.x, c.y, c.z, c.w}, pw[4] = {p.x, p.y, p.z, p.w}; const float mm[8] = {m0.x, m0.y, m0.z, m0.w, m1.x, m1.y, m1.z, m1.w};
#pragma unroll
    for (int j = 0; j < 4; ++j) { const float c0 = bflo(cw[j]), c1 = bfhi(cw[j]), p0 = bflo(pw[j]), p1 = bfhi(pw[j]);
        o[2 * j] = c0 + (p0 - c0) * mm[2 * j]; o[2 * j + 1] = c1 + (p1 - c1) * mm[2 * j + 1]; }
}
__device__ __forceinline__ void shifted4(const bf16* proj, size_t m, bool has_prev, int col, const float* mu, float (&o)[4]) {
    const v2u c = *(const GAS v2u*)(proj + m * NP + col);
    v2u p = (v2u){0u, 0u}; if (has_prev) p = *(const GAS v2u*)(proj + (m - 1) * NP + col);
    const f32x4 m0 = *(const GAS f32x4*)(mu);
    o[0] = bflo(c.x) + (bflo(p.x) - bflo(c.x)) * m0.x; o[1] = bfhi(c.x) + (bfhi(p.x) - bfhi(c.x)) * m0.y;
    o[2] = bflo(c.y) + (bflo(p.y) - bflo(c.y)) * m0.z; o[3] = bfhi(c.y) + (bfhi(p.y) - bfhi(c.y)) * m0.w;
}
__device__ __forceinline__ void p2_qknorm(Frame& F) {
    const int gw = F.vcu * NWAVES + F.wave, NGW = F.G * NWAVES, lane = F.lane, sub = lane & 7;
    const f32x4 gq0 = *(const GAS f32x4*)(F.qn_g + sub * 8), gq1 = *(const GAS f32x4*)(F.qn_g + sub * 8 + 4), gk0 = *(const GAS f32x4*)(F.kn_g + sub * 8), gk1 = *(const GAS f32x4*)(F.kn_g + sub * 8 + 4);
    constexpr int UQ = 4;
    for (int it0 = gw * UQ; it0 < 2 * M; it0 += NGW * UQ) {
        bf16* p[UQ]; v4u c[UQ];
#pragma unroll
        for (int u = 0; u < UQ; ++u) { const int it = it0 + u; const size_t m = (size_t)(it >> 1); p[u] = F.PROJ + m * NP + ((it & 1) ? C_DK : C_DQ) + (lane >> 3) * 64 + sub * 8; c[u] = *(const GAS v4u*)p[u]; }
#pragma unroll
        for (int u = 0; u < UQ; ++u) {
            const int isk = (it0 + u) & 1; const unsigned cw[4] = {c[u].x, c[u].y, c[u].z, c[u].w};
            float xv[8]; float ss = 0.f;
#pragma unroll
            for (int j = 0; j < 4; ++j) { xv[2 * j] = bflo(cw[j]); xv[2 * j + 1] = bfhi(cw[j]); ss += xv[2 * j] * xv[2 * j] + xv[2 * j + 1] * xv[2 * j + 1]; }
            ss += dpp_f<0xB1>(ss); ss += dpp_f<0x4E>(ss); ss += dpp_f<0x141>(ss);
            const float r = __builtin_amdgcn_rsqf(ss * (1.f / 64.f) + 1e-6f) * (isk ? 1.f : C2);
            const f32x4 g0 = isk ? gk0 : gq0, g1 = isk ? gk1 : gq1;
            v4u o; o.x = cvtpk2(xv[0] * r * g0.x, xv[1] * r * g0.y); o.y = cvtpk2(xv[2] * r * g0.z, xv[3] * r * g0.w); o.z = cvtpk2(xv[4] * r * g1.x, xv[5] * r * g1.y); o.w = cvtpk2(xv[6] * r * g1.z, xv[7] * r * g1.w);
            *(GAS v4u*)p[u] = o;
        }
    }
}
typedef float f32x2_t __attribute__((ext_vector_type(2))); typedef __bf16 bf16x2_t __attribute__((ext_vector_type(2)));
__device__ __forceinline__ unsigned cvtpk(float lo, float hi) { f32x2_t v = {lo, hi}; bf16x2_t b = __builtin_convertvector(v, bf16x2_t); return __builtin_bit_cast(unsigned, b); }
#define MFMA32(a, b, c) __builtin_amdgcn_mfma_f32_32x32x16_bf16(__builtin_bit_cast(bf16x8, (a)), __builtin_bit_cast(bf16x8, (b)), (c), 0, 0, 0)
#define FRAGACC(z, s) ((v4u){cvtpk((z)[8 * (s)], (z)[8 * (s) + 1]), cvtpk((z)[8 * (s) + 2], (z)[8 * (s) + 3]), cvtpk((z)[8 * (s) + 4], (z)[8 * (s) + 5]), cvtpk((z)[8 * (s) + 6], (z)[8 * (s) + 7])})
template <int CTRL, int RM> __device__ __forceinline__ float dpp_upd0(float x) { return __builtin_bit_cast(float, __builtin_amdgcn_update_dpp(0, __builtin_bit_cast(int, x), CTRL, RM, 0xf, false)); }
__device__ __forceinline__ float scan32(float x) {
    x += dpp_upd0<0x111, 0xf>(x); x += dpp_upd0<0x112, 0xf>(x); x += dpp_upd0<0x114, 0xf>(x); x += dpp_upd0<0x118, 0xf>(x); x += dpp_upd0<0x142, 0xa>(x); return x;
}
__device__ __forceinline__ void st_wt16(v4u* p, const v4u v) { *(GAS v4u*)p = v; }
constexpr int RW_UNITS = BATCH * RH * (T / 32);
struct RwDump { v4u* PF; v4u* DD; v4u* QF; v4u* YD; float* GAM; float* RHO; };

__device__ __forceinline__ void rwkvA_unit(Frame& F, const RwDump& Dm, int bh, int ci, LAS float* wscr, LAS unsigned char* park, LAS v4u* zsh, int zpar) {
    int lane = mk_lane(); asm volatile("" : "+v"(lane));
    const int hi = lane >> 5, l31 = lane & 31, b = bh >> 3, w = bh & 7;
    LAS v4u* pk = (LAS v4u*)park + lane;
#define PARK(slot) pk[(slot) * 64]
    int tok = 0; asm volatile("" : "+v"(tok));
#define DEP(x) asm volatile("" : "+v"(tok) : "v"(x))
    const int t = ci * 32 + l31; const size_t m = (size_t)b * T + t; const bool hp = t > 0;
    const int u = ci * (BATCH * RH) + bh;
    const float pm = hp ? 1.f : 0.f;
    const bf16* pc = F.PROJ + m * NP + w * 64 + 4 * hi; const bf16* pp = F.PROJ + (hp ? m - 1 : m) * NP + w * 64 + 4 * hi;
    const float* mu = F.shift_mu + w * 64 + 4 * hi;
    const float *pw0 = F.w0 + w * 64 + 4 * hi, *pa0 = F.a0 + w * 64 + 4 * hi, *pkk = F.k_k + w * 64 + 4 * hi, *pka = F.k_a + w * 64 + 4 * hi, *prk = F.r_k + w * 64 + 4 * hi;
#define SH4(dst, COL, MU, OFF) do { const v2u c_ = *(const GAS v2u*)(pc + tok + (COL) + (OFF)), p_ = *(const GAS v2u*)(pp + tok + (COL) + (OFF)); const f32x4 m_ = *(const GAS f32x4*)(mu + tok + (MU) + (OFF)); \
        dst[0] = bflo(c_.x) + (bflo(p_.x) * pm - bflo(c_.x)) * m_.x; dst[1] = bfhi(c_.x) + (bfhi(p_.x) * pm - bfhi(c_.x)) * m_.y; \
        dst[2] = bflo(c_.y) + (bflo(p_.y) * pm - bflo(c_.y)) * m_.z; dst[3] = bfhi(c_.y) + (bfhi(p_.y) * pm - bfhi(c_.y)) * m_.w; } while (0)
    float ss = 0.f;
#pragma unroll
    for (int gq = 0; gq < 8; ++gq) { float k4[4]; SH4(k4, C_K, 512, 8 * gq); const f32x4 kkp = *(const GAS f32x4*)(pkk + tok + 8 * gq);
#pragma unroll
        for (int e = 0; e < 4; ++e) { const float q = k4[e] * kkp[e]; ss += q * q; }
        if (gq == 3) DEP(ss); }
    ss = swap32_sum(ss);
    const float inv = __builtin_amdgcn_rcpf(fmaxf(__builtin_amdgcn_sqrtf(ss), 1e-12f));
    asm volatile("" ::: "memory");
    v4u bz[4], ba[4];
    { const int s = F.wave >> 1; const bool which = (F.wave & 1) != 0;
      const bf16* zc = F.PROJ + m * NP + 8 * hi; const bf16* zp = F.PROJ + (hp ? m - 1 : m) * NP + 8 * hi; const float* zmu = F.shift_mu + 8 * hi;
      const int COL = (which ? C_ZA : C_ZW) + 16 * s, MUO = (which ? 1600 : 1536) + 16 * s;
      const v4u c = *(const GAS v4u*)(zc + tok + COL), p = *(const GAS v4u*)(zp + tok + COL); const f32x4 m0 = *(const GAS f32x4*)(zmu + tok + MUO), m1 = *(const GAS f32x4*)(zmu + tok + MUO + 4);
      float z[8];
#pragma unroll
      for (int j = 0; j < 4; ++j) { const float c0 = bflo(c[j]), c1 = bfhi(c[j]); const float mm0 = j < 2 ? m0[2 * j] : m1[2 * j - 4], mm1 = j < 2 ? m0[2 * j + 1] : m1[2 * j - 3];
          z[2 * j] = c0 + (bflo(p[j]) * pm - c0) * mm0; z[2 * j + 1] = c1 + (bfhi(p[j]) * pm - c1) * mm1; }
      if (!which) {
#pragma unroll
          for (int j = 0; j < 8; ++j) z[j] = tanh_f(z[j]); }
      LAS v4u* zs = zsh + zpar * 512;
      zs[((which ? 4 : 0) + s) * 64 + lane] = (v4u){cvtpk(z[0], z[1]), cvtpk(z[2], z[3]), cvtpk(z[4], z[5]), cvtpk(z[6], z[7])};
      __syncthreads();
#pragma unroll
      for (int q = 0; q < 4; ++q) { bz[q] = zs[q * 64 + lane]; ba[q] = zs[(4 + q) * 64 + lane]; }
      DEP(bz[3][3]); DEP(ba[3][3]); }
    asm volatile("" ::: "memory");
    v4u fa[4], fb[4], fk[4], fr[4], fv[4]; float rho = 0.f;
    float* gp = Dm.GAM + (size_t)u * 64 + hi * 32;
#define RW_LORA(cb) f32x16 accd = f32x16{}, acca = f32x16{}; _Pragma("unroll") for (int s = 0; s < 4; ++s) { \
        const v4u aD = *(const GAS v4u*)(F.WdT + tok + (size_t)(w * 64 + (cb) * 32 + l31) * 64 + 16 * s + 8 * hi); accd = MFMA32(aD, bz[s], accd); \
        const v4u aA = *(const GAS v4u*)(F.WaT + tok + (size_t)(w * 64 + (cb) * 32 + l31) * 64 + 16 * s + 8 * hi); acca = MFMA32(aA, ba[s], acca); }
    struct RwGL { v2u rc, rp, kc, kp, vc, vp; } gA, gB;
#define RW_LOADG(X, OFF) do { X.rc = *(const GAS v2u*)(pc + tok + C_R + (OFF)); X.rp = *(const GAS v2u*)(pp + tok + C_R + (OFF)); X.kc = *(const GAS v2u*)(pc + tok + C_K + (OFF)); X.kp = *(const GAS v2u*)(pp + tok + C_K + (OFF)); \
        X.vc = *(const GAS v2u*)(pc + tok + C_V + (OFF)); X.vp = *(const GAS v2u*)(pp + tok + C_V + (OFF)); } while (0)
#define RW_LERP(dst, c_, p_, m_) do { dst[0] = bflo(c_.x) + (bflo(p_.x) * pm - bflo(c_.x)) * m_.x; dst[1] = bfhi(c_.x) + (bfhi(p_.x) * pm - bfhi(c_.x)) * m_.y; \
        dst[2] = bflo(c_.y) + (bflo(p_.y) * pm - bflo(c_.y)) * m_.z; dst[3] = bfhi(c_.y) + (bfhi(p_.y) * pm - bfhi(c_.y)) * m_.w; } while (0)
#define RW_GROUP(cb, rg, CUR, NXT, HASN) do { constexpr int OFF = 32 * (cb) + 8 * (rg); const int ch0 = OFF + 4 * hi; \
            if (HASN) RW_LOADG(NXT, OFF + 8); \
            float rr[4], kk4[4], vv[4]; \
            const f32x4 mr_ = *(const GAS f32x4*)(mu + tok + OFF), mk_ = *(const GAS f32x4*)(mu + tok + 512 + OFF), mv_ = *(const GAS f32x4*)(mu + tok + 1024 + OFF); \
            const f32x4 w0v = *(const GAS f32x4*)(pw0 + tok + OFF), a0v = *(const GAS f32x4*)(pa0 + tok + OFF), kkp = *(const GAS f32x4*)(pkk + tok + OFF), kap = *(const GAS f32x4*)(pka + tok + OFF), rkp = *(const GAS f32x4*)(prk + tok + OFF); \
            RW_LERP(rr, CUR.rc, CUR.rp, mr_); RW_LERP(kk4, CUR.kc, CUR.kp, mk_); RW_LERP(vv, CUR.vc, CUR.vp, mv_); \
            float xa[4], xb[4], xk[4], xr[4], gg[4], ge[4]; \
            _Pragma("unroll") for (int e = 0; e < 4; ++e) { \
                const float nx = -(w0v[e] + accd[4 * (rg) + e]); const float sp = fmaxf(nx, 0.f) + __logf(1.f + __expf(-fabsf(nx))); \
                const float l2 = -__expf(-sp - 0.5f) * LOG2E; \
                const float g = scan32(l2); \
                const float a = __builtin_amdgcn_rcpf(1.f + __expf(-(a0v[e] + acca[4 * (rg) + e]))); \
                const float kk = kk4[e] * kkp[e] * inv; \
                const float kt = kk4[e] * (1.f + (a - 1.f) * kap[e]); \
                rho += rr[e] * kt * rkp[e]; \
                const float eg = __builtin_amdgcn_exp2f(g), egp = __builtin_amdgcn_exp2f(g - l2), eng = __builtin_amdgcn_rcpf(eg); \
                xa[e] = -kk * egp; xb[e] = kk * a * eng; xk[e] = kt * eng; xr[e] = rr[e] * eg; gg[e] = g; ge[e] = eg; } \
            if (l31 == 31) { *(LAS f32x4*)(wscr + ch0) = (f32x4){gg[0], gg[1], gg[2], gg[3]}; st_wt16((v4u*)(gp + (cb) * 16 + 4 * (rg)), (v4u){__float_as_uint(ge[0]), __float_as_uint(ge[1]), __float_as_uint(ge[2]), __float_as_uint(ge[3])}); } \
            constexpr int s_ = 2 * (cb) + ((rg) >> 1), vg = 2 * ((rg) & 1); \
            fa[s_][vg] = cvtpk(xa[0], xa[1]); fa[s_][vg + 1] = cvtpk(xa[2], xa[3]); \
            fb[s_][vg] = cvtpk(xb[0], xb[1]); fb[s_][vg + 1] = cvtpk(xb[2], xb[3]); \
            fk[s_][vg] = cvtpk(xk[0], xk[1]); fk[s_][vg + 1] = cvtpk(xk[2], xk[3]); \
            fr[s_][vg] = cvtpk(xr[0], xr[1]); fr[s_][vg + 1] = cvtpk(xr[2], xr[3]); \
            fv[s_][vg] = cvtpk(vv[0], vv[1]); fv[s_][vg + 1] = cvtpk(vv[2], vv[3]); \
            if (((rg) & 1) == 1) { PARK(s_) = fv[s_]; PARK(4 + s_) = fr[s_]; } \
            DEP(fa[s_][vg + 1]); DEP(fb[s_][vg + 1]); DEP(fk[s_][vg + 1]); DEP(fr[s_][vg + 1]); DEP(fv[s_][vg + 1]); DEP(rho); } while (0)
    RW_LOADG(gA, 0);
    { RW_LORA(0) RW_GROUP(0, 0, gA, gB, true); RW_GROUP(0, 1, gB, gA, true); RW_GROUP(0, 2, gA, gB, true); RW_GROUP(0, 3, gB, gA, true); }
    { RW_LORA(1) RW_GROUP(1, 0, gA, gB, true); RW_GROUP(1, 1, gB, gA, true); RW_GROUP(1, 2, gA, gB, true); RW_GROUP(1, 3, gB, gA, false); }
#undef RW_LOADG
#undef RW_LERP
#undef RW_LORA
#undef RW_GROUP
#undef SH4
    LDS_WAIT(); asm volatile("" ::: "memory");
    float EC[2]; EC[0] = __builtin_amdgcn_exp2f(wscr[l31]); EC[1] = __builtin_amdgcn_exp2f(wscr[32 + l31]);
    LDS_WAIT(); asm volatile("" ::: "memory");
    rho = swap32_sum(rho);
    if (hi == 0) __hip_atomic_store((gu32*)(Dm.RHO + (size_t)u * 32 + l31), __float_as_uint(rho), RLX_AGENT);
    v4u idf[2];
    { const int jst = 4 * ((l31 >> 3) & 1) + (l31 & 3); const bool hm = ((l31 >> 2) & 1) == hi; const unsigned one = 0x3F80u << (16 * (jst & 1));
#pragma unroll
      for (int sig = 0; sig < 2; ++sig) { const bool on = hm && ((l31 >> 4) == sig);
#pragma unroll
          for (int q = 0; q < 4; ++q) idf[sig][q] = (on && (jst >> 1) == q) ? one : 0u; } }
    LDS_WAIT();
    v4u Af[2][2], Vf[2][2];
#pragma unroll
    for (int blk = 0; blk < 2; ++blk) {
        f32x16 za = MFMA32(fa[2 * blk], idf[0], f32x16{}); za = MFMA32(fa[2 * blk + 1], idf[1], za);
        f32x16 zv = MFMA32(PARK(2 * blk), idf[0], f32x16{}); zv = MFMA32(PARK(2 * blk + 1), idf[1], zv);
        f32x16 zb = MFMA32(fb[2 * blk], idf[0], f32x16{}); zb = MFMA32(fb[2 * blk + 1], idf[1], zb);
        f32x16 zk = MFMA32(fk[2 * blk], idf[0], f32x16{}); zk = MFMA32(fk[2 * blk + 1], idf[1], zk);
        zb = zb * EC[blk]; zk = zk * EC[blk];
#pragma unroll
        for (int s = 0; s < 2; ++s) { Af[blk][s] = FRAGACC(za, s); Vf[blk][s] = FRAGACC(zv, s); PARK(8 + 2 * blk + s) = FRAGACC(zb, s); PARK(12 + 2 * blk + s) = FRAGACC(zk, s); }
        __builtin_amdgcn_sched_barrier(0);
    }
    f32x16 Aab = f32x16{}, TT = f32x16{}, AakT = f32x16{}, ArbT = f32x16{}, ArkT = f32x16{};
#pragma unroll
    for (int s = 0; s < 4; ++s) { const v4u frs = PARK(4 + s); Aab = MFMA32(fa[s], fb[s], Aab); TT = MFMA32(fb[s], fa[s], TT); AakT = MFMA32(fk[s], fa[s], AakT); ArbT = MFMA32(fb[s], frs, ArbT); ArkT = MFMA32(fk[s], frs, ArkT); }
#pragma unroll
    for (int r = 0; r < 16; ++r) { const int rowi = (r & 3) + 8 * (r >> 2) + 4 * hi;
        Aab[r] = (l31 < rowi) ? Aab[r] : 0.f; TT[r] = (rowi < l31) ? TT[r] : 0.f; AakT[r] = (rowi < l31) ? AakT[r] : 0.f;
        ArbT[r] = (rowi <= l31) ? ArbT[r] : 0.f; ArkT[r] = (rowi <= l31) ? ArkT[r] : 0.f; }
    v4u AakTf[2], ArbTf[2], ArkTf[2];
#pragma unroll
    for (int s = 0; s < 2; ++s) { AakTf[s] = FRAGACC(AakT, s); ArbTf[s] = FRAGACC(ArbT, s); ArkTf[s] = FRAGACC(ArkT, s); }
    __builtin_amdgcn_sched_barrier(0);
    v4u Xf[2], XTf[2], TTf[2];
#pragma unroll
    for (int s = 0; s < 2; ++s) { Xf[s] = FRAGACC(Aab, s); XTf[s] = FRAGACC(TT, s); }
#pragma unroll
    for (int r = 0; r < 16; ++r) { const int rowi = (r & 3) + 8 * (r >> 2) + 4 * hi; TT[r] += (rowi == l31) ? 1.f : 0.f; }
#pragma unroll
    for (int it = 0; it < 4; ++it) {
        f32x16 X2 = MFMA32(XTf[0], Xf[0], f32x16{}); X2 = MFMA32(XTf[1], Xf[1], X2);
        if (it < 3) { f32x16 X2T = MFMA32(Xf[0], XTf[0], f32x16{}); X2T = MFMA32(Xf[1], XTf[1], X2T);
#pragma unroll
            for (int s = 0; s < 2; ++s) XTf[s] = FRAGACC(X2T, s); }
#pragma unroll
        for (int s = 0; s < 2; ++s) { Xf[s] = FRAGACC(X2, s); TTf[s] = FRAGACC(TT, s); }
        TT = MFMA32(Xf[0], TTf[0], TT); TT = MFMA32(Xf[1], TTf[1], TT);
        __builtin_amdgcn_sched_barrier(0);
    }
#pragma unroll
    for (int s = 0; s < 2; ++s) TTf[s] = FRAGACC(TT, s);
    v4u Wf[2][2], Uf[2][2];
#pragma unroll
    for (int blk = 0; blk < 2; ++blk) {
        f32x16 av = MFMA32(AakTf[0], Vf[blk][0], f32x16{}); av = MFMA32(AakTf[1], Vf[blk][1], av);
        const v4u avf0 = FRAGACC(av, 0), avf1 = FRAGACC(av, 1);
        f32x16 uu = MFMA32(TTf[0], avf0, f32x16{}); uu = MFMA32(TTf[1], avf1, uu);
        f32x16 ww = MFMA32(TTf[0], Af[blk][0], f32x16{}); ww = MFMA32(TTf[1], Af[blk][1], ww);
#pragma unroll
        for (int s = 0; s < 2; ++s) { Wf[blk][s] = FRAGACC(ww, s); Uf[blk][s] = FRAGACC(uu, s); }
        __builtin_amdgcn_sched_barrier(0);
    }
    v4u* QFp = Dm.QF + (size_t)u * 256 + lane; v4u* YDp = Dm.YD + (size_t)u * 256 + lane;
#pragma unroll
    for (int blk = 0; blk < 2; ++blk) {
        f32x16 q;
#pragma unroll
        for (int s = 0; s < 2; ++s)
            { const v4u frs = PARK(4 + 2 * blk + s);
#pragma unroll
              for (int j = 0; j < 4; ++j) { q[8 * s + 2 * j] = bflo(frs[j]); q[8 * s + 2 * j + 1] = bfhi(frs[j]); } }
        q = MFMA32(Wf[blk][0], ArbTf[0], q); q = MFMA32(Wf[blk][1], ArbTf[1], q);
        st_wt16(QFp + (2 * blk) * 64, FRAGACC(q, 0)); st_wt16(QFp + (2 * blk + 1) * 64, FRAGACC(q, 1));
        f32x16 y = MFMA32(Uf[blk][0], ArbTf[0], f32x16{}); y = MFMA32(Uf[blk][1], ArbTf[1], y); y = MFMA32(Vf[blk][0], ArkTf[0], y); y = MFMA32(Vf[blk][1], ArkTf[1], y);
        st_wt16(YDp + (2 * blk) * 64, FRAGACC(y, 0)); st_wt16(YDp + (2 * blk + 1) * 64, FRAGACC(y, 1));
        __builtin_amdgcn_sched_barrier(0);
    }
    v4u* PFp = Dm.PF + (size_t)u * 512 + lane; v4u* DDp = Dm.DD + (size_t)u * 512 + lane;
#pragma unroll
    for (int c1 = 0; c1 < 2; ++c1)
#pragma unroll
        for (int cb = 0; cb < 2; ++cb) {
            f32x16 p = MFMA32(Wf[c1][0], PARK(8 + 2 * cb), f32x16{}); p = MFMA32(Wf[c1][1], PARK(8 + 2 * cb + 1), p);
            st_wt16(PFp + (cb * 4 + 2 * c1) * 64, FRAGACC(p, 0)); st_wt16(PFp + (cb * 4 + 2 * c1 + 1) * 64, FRAGACC(p, 1));
            __builtin_amdgcn_sched_barrier(0);
        }
#pragma unroll
    for (int cb = 0; cb < 2; ++cb)
#pragma unroll
        for (int ib = 0; ib < 2; ++ib) {
            f32x16 d = MFMA32(PARK(8 + 2 * cb), Uf[ib][0], f32x16{}); d = MFMA32(PARK(8 + 2 * cb + 1), Uf[ib][1], d); d = MFMA32(PARK(12 + 2 * cb), Vf[ib][0], d); d = MFMA32(PARK(12 + 2 * cb + 1), Vf[ib][1], d);
            st_wt16(DDp + ((cb * 2 + ib) * 2) * 64, FRAGACC(d, 0)); st_wt16(DDp + ((cb * 2 + ib) * 2 + 1) * 64, FRAGACC(d, 1));
            __builtin_amdgcn_sched_barrier(0);
        }
}

#undef PARK
#undef DEP
constexpr int RB_PF = 0, RB_DD = 8192, RB_QF = 16384, RB_YD = 20480, RB_GAM = 24576, RB_BUF = 24832, RB_NB = 4, RB_STAT = RB_NB * RB_BUF, RB_Y = RB_STAT + 1024;
__device__ __forceinline__ void unpack16(const v4u a, const v4u b, f32x16& o) {
#pragma unroll
    for (int j = 0; j < 4; ++j) { o[2 * j] = bflo(a[j]); o[2 * j + 1] = bfhi(a[j]); o[8 + 2 * j] = bflo(b[j]); o[8 + 2 * j + 1] = bfhi(b[j]); }
}
constexpr int RW_SPLIT = T / 32, CW_DONE = 16384;
__device__ __forceinline__ void rw_wait_chunk(Frame& F, int ci) {
    unsigned spins = 0;
#pragma unroll 1
    for (int j = 7; j >= 0; --j) { gu32* c = F.ctl + CW_DONE + 64 * (ci + j);
        while ((unsigned)__builtin_amdgcn_readfirstlane(__hip_atomic_load(c, RLX_AGENT)) < (unsigned)BATCH) { __builtin_amdgcn_s_sleep(8); if (++spins > (1u << 22)) break; } }
    __builtin_amdgcn_fence(__ATOMIC_ACQUIRE, "agent");
}
__device__ __forceinline__ void rw_publish_chunk(Frame& F, int ci) {
    asm volatile("s_waitcnt vmcnt(0)" ::: "memory");
    __syncthreads();
    if (F.wave == 0 && mk_lane() == 0) {
        __hip_atomic_fetch_add(F.ctl + CW_DONE + 64 * ci, 1u, RLX_AGENT);
    }
}
#ifndef RB_AUX
#define RB_AUX 2
#endif
struct RbStage { v4u p[2], d[2], q, y, g; };
struct RbEpi { v4u vc, vp, ga; float rho; };
__device__ __forceinline__ void rwkvB_unit(Frame& F, const RwDump& Dm, int bh) {
    int lane = mk_lane(); asm volatile("" : "+v"(lane));
    const int wid = F.wave, tid = wid * 64 + lane, hi = lane >> 5, l31 = lane & 31, b = bh >> 3, h = bh & 7;
    LAS unsigned char* lds = F.lds + RING_OFF;
    constexpr int NS = T / 32;
    LAS float* stat = (LAS float*)(lds + RB_STAT);
    LAS float* ybuf = (LAS float*)(lds + RB_Y);
    const int stid = tid - 128;
    const bool st_p2 = wid < 4, st_q = wid < 6, st_y = wid >= 4;
#define ST_LOAD(X, ci_) do { { if ((ci_) >= RW_SPLIT && (ci_) < NS && (((ci_) - RW_SPLIT) & 7) == 0) rw_wait_chunk(F, (ci_)); const size_t u_ = (size_t)((ci_) < NS ? (ci_) : NS - 1) * (BATCH * RH) + bh; \
        X.p[0] = __builtin_nontemporal_load((const GAS v4u*)(Dm.PF + u_ * 512 + stid)); X.d[0] = __builtin_nontemporal_load((const GAS v4u*)(Dm.DD + u_ * 512 + stid)); \
        if (st_p2) { X.p[1] = __builtin_nontemporal_load((const GAS v4u*)(Dm.PF + u_ * 512 + 384 + stid)); X.d[1] = __builtin_nontemporal_load((const GAS v4u*)(Dm.DD + u_ * 512 + 384 + stid)); } \
        if (st_q) X.q = __builtin_nontemporal_load((const GAS v4u*)(Dm.QF + u_ * 256 + stid)); \
        if (st_y) X.y = __builtin_nontemporal_load((const GAS v4u*)(Dm.YD + u_ * 256 + (stid - 128))); \
        if (stid < 16) X.g = *(const GAS v4u*)((const v4u*)(Dm.GAM + u_ * 64) + stid); } } while (0)
#define ST_STORE(X, buf_) do { LAS unsigned char* b_ = lds + (buf_) * RB_BUF; \
        *(LAS v4u*)(b_ + RB_PF + stid * 16) = X.p[0]; *(LAS v4u*)(b_ + RB_DD + stid * 16) = X.d[0]; \
        if (st_p2) { *(LAS v4u*)(b_ + RB_PF + (384 + stid) * 16) = X.p[1]; *(LAS v4u*)(b_ + RB_DD + (384 + stid) * 16) = X.d[1]; } \
        if (st_q) *(LAS v4u*)(b_ + RB_QF + stid * 16) = X.q; \
        if (st_y) *(LAS v4u*)(b_ + RB_YD + (stid - 128) * 16) = X.y; \
        if (stid < 16) *(LAS v4u*)(b_ + RB_GAM + stid * 16) = X.g; } while (0)
    const int ew = (wid & 1) + 2 * ((wid >> 2) & 1), eidx = ew * 64 + lane, etok = eidx >> 3, ep = eidx & 7;
    const bf16* epc = F.PROJ + (size_t)b * T * NP + h * 64 + 8 * ep;
#define EP_LOAD(X, cj_) do { { const int cc_ = (cj_) < NS ? (cj_) : NS - 1, tt_ = cc_ * 32 + etok; const bf16* pc_ = epc + (size_t)tt_ * NP; const bf16* pp_ = epc + (size_t)(tt_ > 0 ? tt_ - 1 : 0) * NP; \
        X.vc = *(const GAS v4u*)(pc_ + C_V); X.vp = *(const GAS v4u*)(pp_ + C_V); X.ga = *(const GAS v4u*)(pc_ + C_GA); \
        X.rho = Dm.RHO[((size_t)cc_ * (BATCH * RH) + bh) * 32 + etok]; } } while (0)
#define EP_RUN(X, cj_) do { const int par_ = (cj_) & 1; \
        const float s1_ = stat[((par_ * 2 + 0) * 32 + etok) * 2] + stat[((par_ * 2 + 1) * 32 + etok) * 2], s2_ = stat[((par_ * 2 + 0) * 32 + etok) * 2 + 1] + stat[((par_ * 2 + 1) * 32 + etok) * 2 + 1]; \
        const float mean_ = s1_ * (1.f / 64.f), var_ = fmaxf(s2_ * (1.f / 64.f) - mean_ * mean_, 0.f), rstd_ = __builtin_amdgcn_rsqf(var_ + 64e-5f); \
        const int tt_ = (cj_) * 32 + etok; const size_t mm_ = (size_t)b * T + tt_; const float pm_ = tt_ > 0 ? 1.f : 0.f; \
        const LAS float* yb_ = ybuf + (par_ * 2 + (ep >> 2)) * 1024 + 4 * (ep & 3) * 64 + etok; \
        float o_[8]; \
        _Pragma("unroll") for (int j = 0; j < 8; ++j) { const unsigned vcw_ = X.vc[j >> 1], vpw_ = X.vp[j >> 1], gaw_ = X.ga[j >> 1]; \
            const float vc_ = (j & 1) ? bfhi(vcw_) : bflo(vcw_), vp_ = (j & 1) ? bfhi(vpw_) : bflo(vpw_), g_ = (j & 1) ? bfhi(gaw_) : bflo(gaw_); \
            const float vv_ = vc_ + (vp_ * pm_ - vc_) * emu[j >> 2][j & 3]; \
            const float yn_ = (yb_[(j & 3) * 64 + (j >> 2) * 32] - mean_) * rstd_ * elw[j >> 2][j & 3] + elb[j >> 2][j & 3] + X.rho * vv_; o_[j] = yn_ * g_ * __builtin_amdgcn_rcpf(1.f + __expf(-g_)); } \
        *(GAS v4u*)(F.MIX + mm_ * D + h * 64 + 8 * ep) = (v4u){cvtpk(o_[0], o_[1]), cvtpk(o_[2], o_[3]), cvtpk(o_[4], o_[5]), cvtpk(o_[6], o_[7])}; } while (0)
    f32x16 S[2]; S[0] = f32x16{}; S[1] = f32x16{};
    const int ib = wid & 1;
#define CONS(ci_) do { const LAS unsigned char* bb = lds + ((ci_) & (RB_NB - 1)) * RB_BUF; \
          \
        v4u pf_[8], qf_[4], dd_[4], yd_[2]; f32x4 gm_[8]; \
        _Pragma("unroll") for (int q = 0; q < 8; ++q) gm_[q] = *(const LAS f32x4*)(bb + RB_GAM + (hi * 32 + 4 * q) * 4); \
        _Pragma("unroll") for (int q = 0; q < 4; ++q) dd_[q] = *(const LAS v4u*)(bb + RB_DD + ((((q >> 1) * 2 + ib) * 2 + (q & 1)) * 64 + lane) * 16); \
        _Pragma("unroll") for (int q = 0; q < 8; ++q) pf_[q] = *(const LAS v4u*)(bb + RB_PF + (q * 64 + lane) * 16); \
        _Pragma("unroll") for (int q = 0; q < 2; ++q) yd_[q] = *(const LAS v4u*)(bb + RB_YD + ((2 * ib + q) * 64 + lane) * 16); \
        _Pragma("unroll") for (int q = 0; q < 4; ++q) qf_[q] = *(const LAS v4u*)(bb + RB_QF + (q * 64 + lane) * 16); \
        __builtin_amdgcn_sched_barrier(0); \
        v4u Sf[4]; _Pragma("unroll") for (int s = 0; s < 4; ++s) Sf[s] = FRAGACC(S[s >> 1], s & 1); \
        _Pragma("unroll") for (int rb = 0; rb < 2; ++rb) { \
            f32x16 acc; unpack16(dd_[2 * rb], dd_[2 * rb + 1], acc); \
            _Pragma("unroll") for (int q = 0; q < 4; ++q) { const f32x4 gv = gm_[4 * rb + q]; _Pragma("unroll") for (int e = 0; e < 4; ++e) acc[4 * q + e] += gv[e] * S[rb][4 * q + e]; } \
            _Pragma("unroll") for (int s = 0; s < 4; ++s) acc = MFMA32(pf_[rb * 4 + s], Sf[s], acc); \
            S[rb] = acc; } \
        f32x16 y; unpack16(yd_[0], yd_[1], y); \
        _Pragma("unroll") for (int s = 0; s < 4; ++s) y = MFMA32(Sf[s], qf_[s], y); \
        float s1 = 0.f, s2 = 0.f; LAS float* yb_ = ybuf + (((ci_) & 1) * 2 + ib) * 1024 + lane; \
        _Pragma("unroll") for (int r = 0; r < 16; ++r) { s1 += y[r]; s2 += y[r] * y[r]; yb_[r * 64] = y[r]; } \
        s1 = swap32_sum(s1); s2 = swap32_sum(s2); \
        if (hi == 0) { stat[((((ci_) & 1) * 2 + ib) * 32 + l31) * 2] = s1; stat[((((ci_) & 1) * 2 + ib) * 32 + l31) * 2 + 1] = s2; } } while (0)
#define RB_BAR() do { asm volatile("s_waitcnt lgkmcnt(0)" ::: "memory"); __builtin_amdgcn_s_barrier(); asm volatile("" ::: "memory"); } while (0)
    if (wid < 2) {
        RB_BAR();
#pragma unroll 1
        for (int k = 0; k < NS; ++k) { CONS(k); RB_BAR(); }
        RB_BAR();
    } else if (wid == 4 || wid == 5) {
        const GAS v4u* gA = (const GAS v4u*)(wid == 4 ? Dm.PF : Dm.DD) + lane; const GAS v4u* gB = (const GAS v4u*)(wid == 4 ? Dm.QF : Dm.YD) + lane;
        const int oA = wid == 4 ? RB_PF : RB_DD, oB = wid == 4 ? RB_QF : RB_YD;
#define LD_ISSUE(ci_) do { const size_t u_ = (size_t)((ci_) < NS ? (ci_) : NS - 1) * (BATCH * RH) + bh; LAS unsigned char* b_ = lds + ((ci_) & (RB_NB - 1)) * RB_BUF; \
        _Pragma("unroll") for (int q = 0; q < 8; ++q) __builtin_amdgcn_global_load_lds((const unsigned*)(gA + u_ * 512 + q * 64), (LAS unsigned*)(b_ + oA + q * 1024), 16, 0, RB_AUX); \
        _Pragma("unroll") for (int q = 0; q < 4; ++q) __builtin_amdgcn_global_load_lds((const unsigned*)(gB + u_ * 256 + q * 64), (LAS unsigned*)(b_ + oB + q * 1024), 16, 0, RB_AUX); \
        if (lane < 16) __builtin_amdgcn_global_load_lds((const unsigned*)((const GAS v4u*)(Dm.GAM + u_ * 64) + lane), (LAS unsigned*)(b_ + RB_GAM), 16, 0, 0); } while (0)
        LD_ISSUE(0); LD_ISSUE(1); LD_ISSUE(2);
        asm volatile("s_waitcnt vmcnt(26)" ::: "memory");
        RB_BAR();
#pragma unroll 1
        for (int k = 0; k < NS; ++k) { LD_ISSUE(k + 3); asm volatile("s_waitcnt vmcnt(26)" ::: "memory"); RB_BAR(); }
        asm volatile("s_waitcnt vmcnt(0)" ::: "memory");
        RB_BAR();
#undef LD_ISSUE
    } else {
        RbEpi eA, eB, eC; f32x4 emu[2], elw[2], elb[2];
#pragma unroll
        for (int rg = 0; rg < 2; ++rg) { const int hc_ = h * 64 + 8 * ep + 4 * rg; emu[rg] = *(const GAS f32x4*)(F.shift_mu + 1024 + hc_); elw[rg] = *(const GAS f32x4*)(F.ln_w + hc_); elb[rg] = *(const GAS f32x4*)(F.ln_b + hc_); }
        EP_LOAD(eA, 0); EP_LOAD(eB, 1);
        RB_BAR();
        EP_LOAD(eC, 2); RB_BAR();
#define HY_STEP(k_, EP) do { EP_RUN(EP, (k_) - 1); EP_LOAD(EP, (k_) + 2); RB_BAR(); } while (0)
#pragma unroll 1
        for (int k = 1; k < NS; k += 3) { HY_STEP(k, eA); HY_STEP(k + 1, eB); HY_STEP(k + 2, eC); }
        EP_RUN(eA, NS - 1);
        RB_BAR();
#undef HY_STEP
    }
#undef RB_BAR
#undef ST_LOAD
#undef ST_STORE
#undef EP_LOAD
#undef EP_RUN
#undef CONS
}
constexpr int CW_G17 = 12288;
struct OneUnit { int pm, pn;
    __device__ __forceinline__ bool next(int i, pg8::Unit& u) const { if (i != 0) return false; u.pm = pm; u.pn = pn; return true; }
    __device__ __forceinline__ void a_ready(const pg8::Unit&) const {}
    __device__ __forceinline__ void done(const pg8::Unit&) const {} };
constexpr int AT_KB = 64 * 256, AT_VB = 64 * 256, AT_BUF = AT_KB + AT_VB, AT_QOFF = 2 * AT_KB + 3 * AT_VB;
__device__ __forceinline__ s16x4 vtr(const LAS unsigned char* p) { typedef short v4i16_t __attribute__((ext_vector_type(4))); return __builtin_bit_cast(s16x4, __builtin_amdgcn_ds_read_tr16_b64_v4i16((LAS v4i16_t*)p)); }
__device__ __forceinline__ void attn_unit(Frame& F, int b, int h, int qb) {
    int lane = mk_lane(); asm volatile("" : "+v"(lane));
    const int wid = F.wave, tid = wid * 64 + lane, l31 = lane & 31, hi = lane >> 5, map = wid >> 2, qs = wid & 3;
    LAS unsigned char* lds = F.lds + RING_OFF;
    const float slope2 = exp2f(-2.f * (float)(h + 1)) * LOG2E, shift2 = __uint_as_float(F.MISC[15]);
    const int q0 = qb * 128, qrow = q0 + 32 * qs + l31;
    const size_t mrow = (size_t)b * T + qrow;
    LAS bf16x8* qpark = (LAS bf16x8*)(lds + AT_QOFF + wid * 4096) + lane;
    { const bf16* qp = F.PROJ + mrow * NP + C_DQ + h * 128 + map * 64 + 8 * hi;
#pragma unroll
      for (int s = 0; s < 4; ++s) qpark[s * 64] = *(const GAS bf16x8*)(qp + 16 * s); }
    const bf16* kg = F.PROJ + (size_t)b * T * NP + C_DK + h * 128;
    const bf16* vg = F.PROJ + (size_t)b * T * NP + C_DV + h * 128;
    const int NT = 2 * qb + 2, tl = 2 * qb + (qs >> 1);
    const int Wk = (int)__builtin_ceilf((2.f * shift2 + 32.2f) / slope2);
    const int tf = __builtin_amdgcn_readfirstlane(max(0, (qb * 128 - Wk) >> 6));
    constexpr int AT_V0 = 2 * AT_KB;
    const int drow0 = 4 * wid + (lane >> 4), drow1 = drow0 + 32, dch = lane & 15;
    const unsigned ksrc0 = (unsigned)(drow0 * NP + ((dch ^ (drow0 & 15)) * 8)), ksrc1 = (unsigned)(drow1 * NP + ((dch ^ (drow1 & 15)) * 8));
    const unsigned vsrc0 = (unsigned)(drow0 * NP + ((dch ^ ((drow0 & 3) << 2)) * 8)), vsrc1 = (unsigned)(drow1 * NP + ((dch ^ ((drow1 & 3) << 2)) * 8));
#define AT_DMA(t_, kb_, v3_) do { const size_t tb_ = (size_t)(64 * (t_)) * NP; LAS unsigned char* bk_ = lds + (kb_) * AT_KB + wid * 1024; LAS unsigned char* bv_ = lds + AT_V0 + (v3_) * AT_VB + wid * 1024; \
        __builtin_amdgcn_global_load_lds((const unsigned*)(kg + tb_ + ksrc0), (LAS unsigned*)bk_, 16, 0, 0); __builtin_amdgcn_global_load_lds((const unsigned*)(kg + tb_ + ksrc1), (LAS unsigned*)(bk_ + 8192), 16, 0, 0); \
        __builtin_amdgcn_global_load_lds((const unsigned*)(vg + tb_ + vsrc0), (LAS unsigned*)bv_, 16, 0, 0); __builtin_amdgcn_global_load_lds((const unsigned*)(vg + tb_ + vsrc1), (LAS unsigned*)(bv_ + 8192), 16, 0, 0); } while (0)
    f32x16 o[4];
#pragma unroll
    for (int vb = 0; vb < 4; ++vb) o[vb] = f32x16{};
    float lsum = 0.f;
    AT_DMA(tf, tf & 1, tf % 3);
    __syncthreads();
    const int G = lane >> 4, qq = (lane & 15) >> 2, pp = lane & 3;
    const int vrow = (4 * hi + qq) * 256 + 8 * (pp & 1), vch = 2 * (G & 1) + (pp >> 1);
    v4u pw[4];
#define SBAR_() __builtin_amdgcn_sched_barrier(0)
#define AT_QK(t) do { \
            const LAS unsigned char* Kb = lds + ((t) & 1) * AT_KB; \
            float sl_ = slope2; asm volatile("" : "+v"(sl_));     \
            const float base = sl_ * (float)(64 * (t) + 4 * hi - qrow) - shift2; \
            float ls = 0.f; \
            _Pragma("unroll") for (int hf = 0; hf < 2; ++hf) {        \
                f32x16 p; \
                _Pragma("unroll") for (int r = 0; r < 16; ++r) p[r] = __builtin_fmaf(sl_, (float)(32 * hf + (r & 3) + 8 * (r >> 2)), base); \
                _Pragma("unroll") for (int s = 0; s < 4; ++s) { \
                    const bf16x8 a0 = *(const LAS bf16x8*)(Kb + (32 * hf + l31) * 256 + (((map * 8 + 2 * s + hi) ^ (l31 & 15)) * 16)); \
                    p = __builtin_amdgcn_mfma_f32_32x32x16_bf16(a0, qpark[s * 64], p, 0, 0, 0); } \
                if ((t) == tl) { \
                    _Pragma("unroll") for (int r = 0; r < 16; ++r) { const int ki = 64 * (t) + 32 * hf + 4 * hi + (r & 3) + 8 * (r >> 2); if (ki > qrow) p[r] = -1e30f; } } \
                _Pragma("unroll") for (int r = 0; r < 16; ++r) { p[r] = __builtin_amdgcn_exp2f(p[r]); ls += p[r]; } \
                pw[2 * hf] = (v4u){cvtpk(p[0], p[1]), cvtpk(p[2], p[3]), cvtpk(p[4], p[5]), cvtpk(p[6], p[7])}; \
                pw[2 * hf + 1] = (v4u){cvtpk(p[8], p[9]), cvtpk(p[10], p[11]), cvtpk(p[12], p[13]), cvtpk(p[14], p[15])}; } \
            lsum += ls; } while (0)
#define AT_VRD(dst, ks, vb0) do { _Pragma("unroll") for (int vb = (vb0); vb < (vb0) + 2; ++vb) { const LAS unsigned char* a_ = Vb + vrow + ((4 * vb + vch) ^ (qq << 2)) * 16 + (32 * ((ks) >> 1) + 16 * ((ks) & 1)) * 256; \
        dst[2 * (vb - (vb0))] = vtr(a_); dst[2 * (vb - (vb0)) + 1] = vtr(a_ + 8 * 256); } } while (0)
#define AT_PV(src, pwk, vb0) do { _Pragma("unroll") for (int vb = (vb0); vb < (vb0) + 2; ++vb) { const int j_ = 2 * (vb - (vb0)); \
        const bf16x8 vf = (bf16x8){src[j_][0], src[j_][1], src[j_][2], src[j_][3], src[j_ + 1][0], src[j_ + 1][1], src[j_ + 1][2], src[j_ + 1][3]}; \
        o[vb] = __builtin_amdgcn_mfma_f32_32x32x16_bf16(vf, __builtin_bit_cast(bf16x8, pwk), o[vb], 0, 0, 0); } } while (0)
#define AT_PVV(v3_) do { const LAS unsigned char* Vb = lds + AT_V0 + (v3_) * AT_VB; s16x4 vA[4], vB[4]; \
            AT_VRD(vA, 0, 0); SBAR_(); AT_VRD(vB, 0, 2); SBAR_(); \
            AT_PV(vA, pw[0], 0); SBAR_(); AT_VRD(vA, 1, 0); SBAR_(); AT_PV(vB, pw[0], 2); SBAR_(); AT_VRD(vB, 1, 2); SBAR_(); \
            AT_PV(vA, pw[1], 0); SBAR_(); AT_VRD(vA, 2, 0); SBAR_(); AT_PV(vB, pw[1], 2); SBAR_(); AT_VRD(vB, 2, 2); SBAR_(); \
            AT_PV(vA, pw[2], 0); SBAR_(); AT_VRD(vA, 3, 0); SBAR_(); AT_PV(vB, pw[2], 2); SBAR_(); AT_VRD(vB, 3, 2); SBAR_(); \
            AT_PV(vA, pw[3], 0); SBAR_(); AT_PV(vB, pw[3], 2); } while (0)
    if (map == 0) {
        int v3 = tf % 3;
#pragma unroll 1
        for (int t = tf; t < NT; ++t) { const int vn = v3 == 2 ? 0 : v3 + 1;
            if (t + 1 < NT) AT_DMA(t + 1, (t + 1) & 1, vn);
            if (t <= tl) { AT_QK(t); AT_PVV(v3); }
            __syncthreads(); v3 = vn; }
    } else {
        int v3 = tf % 3;
#pragma unroll 1
        for (int t = tf; t < NT; ++t) { const int vp = v3 == 0 ? 2 : v3 - 1, vn = v3 == 2 ? 0 : v3 + 1;
            if (t + 1 < NT) AT_DMA(t + 1, (t + 1) & 1, vn);
            if (t > tf && t - 1 <= tl) AT_PVV(vp);
            if (t <= tl) AT_QK(t);
            __syncthreads(); v3 = vn; }
        if (NT - 1 <= tl) { const int vp = v3 == 0 ? 2 : v3 - 1; AT_PVV(vp); }
    }
#undef AT_PVV
#undef AT_QK
#undef AT_VRD
#undef AT_PV
#undef SBAR_
#undef AT_DMA
    __syncthreads();
    const float ltot = swap32_sum(lsum);
    LAS float* X = (LAS float*)lds;
    if (map == 1) {
        const float sc = __uint_as_float(F.MISC[14]) / ltot;
#pragma unroll
        for (int vb = 0; vb < 4; ++vb)
#pragma unroll
            for (int r = 0; r < 16; ++r) X[(qs * 64 + vb * 16 + r) * 64 + lane] = o[vb][r] * sc;
    }
    __syncthreads();
    if (map == 0) {
        const float il = 1.f / ltot; float ss = 0.f;
#pragma unroll
        for (int vb = 0; vb < 4; ++vb)
#pragma unroll
            for (int r = 0; r < 16; ++r) { const float v = o[vb][r] * il - X[(qs * 64 + vb * 16 + r) * 64 + lane]; o[vb][r] = v; ss += v * v; }
        ss = swap32_sum(ss);
        const float rn = (1.f / sqrtf(ss * (1.f / 128.f) + 1e-5f)) * (1.f - LAMBDA_INIT);
        int etok = 0; asm volatile("" : "+v"(etok));
        const int lane_e = mk_lane(), hi = lane_e >> 5;
        const size_t mrow_e = (size_t)b * T + qb * 128 + 32 * qs + (lane_e & 31);
        const bf16* gp = F.PROJ + mrow_e * NP + C_GB + h * 128;
        bf16* op = F.MIX + mrow_e * D + 512 + h * 128;
#pragma unroll
        for (int vb = 0; vb < 4; ++vb)
#pragma unroll
            for (int rg = 0; rg < 4; ++rg) {
                const int vc = 32 * vb + 8 * rg + 4 * hi + etok;
                const v2u gw = *(const GAS v2u*)(gp + vc); const f32x4 sg = *(const GAS f32x4*)(F.subln_g + vc);
                const float g4[4] = {bflo(gw.x), bfhi(gw.x), bflo(gw.y), bfhi(gw.y)}; float ov[4];
#pragma unroll
                for (int e = 0; e < 4; ++e) ov[e] = o[vb][4 * rg + e] * rn * sg[e] * g4[e] / (1.f + __expf(-g4[e]));
                const unsigned w1_ = cvtpk(ov[2], ov[3]);
                *(GAS v2u*)(op + vc) = (v2u){cvtpk(ov[0], ov[1]), w1_};
                if (rg == 3) asm volatile("" : "+v"(etok) : "v"(w1_));
            }
    }
    __syncthreads();
}
#ifndef DBL
#define DBL 0
#endif
constexpr int CW_QUEUE = 8192;
constexpr int QX_RW = 8, QX_A2 = 0, QX_AT = 64, QX_ALL = QX_RW + QX_A2 + QX_AT;
template <int MODE = 0> __device__ __forceinline__ void p3_queue(Frame& F, const RwDump& Dm, const int qbase = CW_QUEUE) {
    const int ql = mk_lane();
    const float l1 = wave_sum(F.lq1[ql] * F.lk1[ql]), l2 = wave_sum(F.lq2[ql] * F.lk2[ql]);
    const float lam = __uint_as_float(__builtin_amdgcn_readfirstlane(__float_as_uint(__expf(l1) - __expf(l2) + LAMBDA_INIT)));
    float gq = fabsf(F.qn_g[ql]), gk = fabsf(F.kn_g[ql]);
#pragma unroll
    for (int o = 1; o < 64; o <<= 1) { gq = fmaxf(gq, __shfl_xor(gq, o)); gk = fmaxf(gk, __shfl_xor(gk, o)); }
    const float shift2 = __uint_as_float(__builtin_amdgcn_readfirstlane(__float_as_uint(8.f * gq * gk * LOG2E)));
    if (F.wave == 0 && mk_lane() == 0) { F.MISC[14] = __float_as_uint(lam); F.MISC[15] = __float_as_uint(shift2); }
    __syncthreads();
#ifdef Q_BLK
    const int x0 = (int)(blockIdx.x & 7);
#else
    const int x0 = (int)(xb_xcc_id() & 7u);
#endif
#pragma unroll 1
    for (int dx = 0; dx < 8; ++dx) {
        const int xq = (x0 + dx) & 7;
        for (;;) {
            if (F.wave == 0 && mk_lane() == 0) F.MISC[12] = __hip_atomic_fetch_add(F.ctl + qbase + 64 * xq, 1u, RLX_AGENT);
            __syncthreads();
            int item = __builtin_amdgcn_readfirstlane((int)F.MISC[12]); if (MODE == 2) item += QX_RW;
            __syncthreads();
            if (item >= (MODE == 1 ? QX_RW : QX_ALL)) break;
            if (item < QX_RW) { rwkvB_unit(F, Dm, xq * 8 + item); if (DBL & 64) rwkvB_unit(F, Dm, xq * 8 + item); }
            else { const int idx = item - QX_RW - QX_A2, h = 3 - (idx >> 4), qb = 15 - (idx & 15);
#pragma unroll 1
#ifndef NO_ATT
                for (int rep = 0; rep < ((DBL & 32) ? 2 : 1); ++rep) attn_unit(F, xq, h, qb);
#endif
            }
        }
    }
}

struct Args { const float* in[21]; float* out; unsigned char* ws; int ph_lo, ph_hi; };
__global__ void __launch_bounds__(NWAVES * 64, 2) hymba_fwd(Args args) {
    extern __shared__ __attribute__((aligned(16))) unsigned char lds[];
    Frame F;
    F.lds = (LAS unsigned char*)lds;
    F.MISC = (volatile LAS unsigned*)(F.lds + MISC_OFF);
    F.wave = __builtin_amdgcn_readfirstlane((int)threadIdx.x >> 6); F.lane = mk_lane(); F.tid = F.wave * 64 + F.lane;
    F.G = gridDim.x; { const int bx = blockIdx.x; F.vcu = (F.G % 8 == 0) ? (bx % 8) * (F.G / 8) + bx / 8 : bx; }
    unsigned char* ws = args.ws;
    F.ctl = (gu32*)(ws + WS_CTL);
    F.x = args.in[0]; F.norm_g = args.in[1]; F.w_in = args.in[2]; F.shift_mu = args.in[3]; F.w0 = args.in[4]; F.w_decay_up = args.in[5]; F.a0 = args.in[6]; F.w_iclr_up = args.in[7];
    F.k_k = args.in[8]; F.k_a = args.in[9]; F.r_k = args.in[10]; F.ln_w = args.in[11]; F.ln_b = args.in[12]; F.qn_g = args.in[13]; F.kn_g = args.in[14];
    F.lq1 = args.in[15]; F.lk1 = args.in[16]; F.lq2 = args.in[17]; F.lk2 = args.in[18]; F.subln_g = args.in[19]; F.w_out = args.in[20]; F.out = args.out;
    F.WinT = (bf16*)(ws + WS_WIN); F.WoutT = (bf16*)(ws + WS_WOUT); F.WdT = (bf16*)(ws + WS_WD); F.WaT = (bf16*)(ws + WS_WA);
    F.XN = (bf16*)(ws + WS_XN); F.PROJ = (bf16*)(ws + WS_PROJ); F.MIX = (bf16*)(ws + WS_MIX);
    for (int u = F.tid; u < (LDS_BYTES - LDSCTL_OFF) / 4; u += NWAVES * 64) ((LAS unsigned*)(F.lds + LDSCTL_OFF))[u] = 0u;
    __syncthreads();
    XcdBarrier bar; bar.bar = (unsigned*)(F.ctl + CW_BAR); bar.x = 0; bar.st = nullptr; bar.wave = F.wave;
    if (MK_N_LAUNCHES == 1) bar = xcd_barrier_post((unsigned*)(F.ctl + CW_BAR), F.MISC + 8, F.wave);
#define GRID_BAR() do { if (MK_N_LAUNCHES == 1) xcd_barrier(bar); } while (0)
    const int lo = args.ph_lo, hi = args.ph_hi;
#define IN(k) (lo <= (k) && (k) < hi)
#define BOTH(k) (IN(k) && IN((k) + 1))
#ifndef SKIP
#define SKIP 0
#endif
    if (IN(0) && !(SKIP & 1)) { p0_prologue(F); if (DBL & 1) { GRID_BAR(); p0_prologue(F); } if (BOTH(0)) GRID_BAR(); }
    if (IN(1) && !(SKIP & 2)) {
        pg8::Gemm g{F.XN, F.WinT, M, NP, D}; pg8::StaticOrder S; S.init(M, NP, F.G, (int)blockIdx.x);
        pg8::EpiBf16S E{F.PROJ, NP};
        pg8::gemm_phase<pg8::EpiBf16S, pg8::StaticOrder, true, true>(F.lds + RING_OFF, g, S, E, F.wave);
        if (DBL & 2) { GRID_BAR(); pg8::gemm_phase<pg8::EpiBf16S, pg8::StaticOrder, true, true>(F.lds + RING_OFF, g, S, E, F.wave); }
        if (BOTH(1)) GRID_BAR();
    }
    RwDump Dm; { unsigned char* so = (unsigned char*)args.out; Dm.PF = (v4u*)so; Dm.DD = (v4u*)(so + 32 * MiB); Dm.QF = (v4u*)(ws + WS_XN); Dm.YD = (v4u*)(ws + WS_XN + 16 * MiB);
        Dm.GAM = (float*)(ws + WS_END); Dm.RHO = (float*)(ws + WS_END + 1 * MiB); }
    if (IN(2) && !(SKIP & 4)) {
        LAS float* wscr = (LAS float*)(F.lds + LDSCTL_OFF + 1024) + F.wave * 64; int zpar = 0;
#pragma unroll 1
        for (int p = F.vcu; p < BATCH * (T / 32); p += F.G) { rwkvA_unit(F, Dm, (p >> 6) * RH + F.wave, p & 63, wscr, F.lds + RING_OFF + F.wave * 16384, (LAS v4u*)(F.lds + LDSCTL_OFF + 4096), zpar); zpar ^= 1; }
        if (DBL & 4) { GRID_BAR();
#pragma unroll 1
            for (int p = F.vcu; p < BATCH * (T / 32); p += F.G) { rwkvA_unit(F, Dm, (p >> 6) * RH + F.wave, p & 63, wscr, F.lds + RING_OFF + F.wave * 16384, (LAS v4u*)(F.lds + LDSCTL_OFF + 4096), zpar); zpar ^= 1; } }
        p2_qknorm(F);
        if (BOTH(2)) GRID_BAR();
    }
    if (IN(3) && !(SKIP & 8)) {
#ifdef P3SPLIT
        p3_queue<1>(F, Dm); GRID_BAR(); p3_queue<2>(F, Dm, CW_QUEUE + 1024);
#else
        p3_queue(F, Dm);
#endif
        if (DBL & 512) { GRID_BAR(); p3_queue(F, Dm, CW_QUEUE + 1024); }
        if (BOTH(3)) GRID_BAR();
    }
    if (IN(4) && !(SKIP & 16)) {
        pg8::Gemm g{F.MIX, F.WoutT, M, D, D}; pg8::StaticOrder S; S.init(M, D, F.G, (int)blockIdx.x);
        pg8::EpiResF32 E{F.x, F.out, D};
        pg8::gemm_phase<pg8::EpiResF32, pg8::StaticOrder, false, true>(F.lds + RING_OFF, g, S, E, F.wave);
        if (DBL & 16) { GRID_BAR(); pg8::gemm_phase<pg8::EpiResF32, pg8::StaticOrder, false, true>(F.lds + RING_OFF, g, S, E, F.wave); }
    }
#undef IN
#undef BOTH
}

extern "C" void kernel_launch(void* const* d_in, const int* in_sizes, int n_in, void* d_out, int out_size, void* d_ws, size_t ws_size, hipStream_t stream) {
    static int grid = 0;
    if (grid == 0) {
        if (n_in != 21 || in_sizes[0] != M * D || out_size != M * D || ws_size < WS_END + 2 * MiB) { fprintf(stderr, "kernel_launch: unexpected shapes (n_in %d, in0 %d, out %d, ws %zu); nothing launched\n", n_in, n_in > 0 ? in_sizes[0] : -1, out_size, ws_size); grid = -1; return; }
        int dev = 0, cus = 0, per_cu = 0;
        if (hipGetDevice(&dev) != hipSuccess || hipDeviceGetAttribute(&cus, hipDeviceAttributeMultiprocessorCount, dev) != hipSuccess) { grid = -1; return; }
        if (hipFuncSetAttribute((const void*)hymba_fwd, hipFuncAttributeMaxDynamicSharedMemorySize, LDS_BYTES) != hipSuccess) { fprintf(stderr, "kernel_launch: hipFuncSetAttribute failed\n"); grid = -1; return; }
        if (hipOccupancyMaxActiveBlocksPerMultiprocessor(&per_cu, (const void*)hymba_fwd, NWAVES * 64, LDS_BYTES) != hipSuccess || per_cu < 1) { fprintf(stderr, "kernel_launch: occupancy query reports %d workgroups per CU; nothing launched\n", per_cu); grid = -1; return; }
        (void)hipGetLastError();
        grid = cus;
        if (grid > 256) grid = 256;
    }
    if (grid < 0) return;
    if (hipMemsetAsync((char*)d_ws + WS_CTL, 0, CTL_ZERO_BYTES, stream) != hipSuccess) { fprintf(stderr, "kernel_launch: hipMemsetAsync failed\n"); return; }
    Args a{};
    for (int i = 0; i < 21; ++i) a.in[i] = (const float*)d_in[i];
    a.out = (float*)d_out; a.ws = (unsigned char*)d_ws;
    for (int li = 0; li < MK_N_LAUNCHES; ++li) {
        a.ph_lo = (MK_N_LAUNCHES == 1) ? 0 : li; a.ph_hi = (MK_N_LAUNCHES == 1) ? N_PHASES : li + 1;
        hipLaunchKernelGGL(hymba_fwd, dim3(grid), dim3(NWAVES * 64), LDS_BYTES, stream, a);
        const hipError_t le = hipPeekAtLastError();
        if (le != hipSuccess) { fprintf(stderr, "kernel_launch: launch %d failed: %s\n", li, hipGetErrorName(le)); break; }
    }
}
```

```cpp
#include <hip/hip_runtime.h>
#include <hip/hip_bf16.h>
#include <cstdio>
#include <cstdint>
#include <cmath>
namespace pg8 {
#define PG8_LAS __attribute__((address_space(3)))
typedef unsigned short bf16_t;
typedef short bf16x8 __attribute__((ext_vector_type(8)));
typedef float f32x4 __attribute__((ext_vector_type(4)));
typedef unsigned u32x4 __attribute__((ext_vector_type(4)));
constexpr int BM = 256, BK = 64, HALF = 128, HTB = HALF * BK * 2  , STAGE_BYTES = 8 * HTB, NXCD = 8, WGM = 8;

__host__ __device__ __forceinline__ int lds_byte(int r, int c) { const int st = (r >> 4) * 2 + (c >> 5), rr = r & 15, cc = c & 31, ob = rr * 64 + cc * 2; return st * 1024 + (ob ^ (((ob >> 9) & 1) << 5)); }
__host__ __device__ __forceinline__ void stage_rc(int b, int& R, int& C) { const int st = b / 1024, sb = b % 1024, swz = sb ^ (((sb >> 9) & 1) << 5); R = (st >> 1) * 16 + swz / 64; C = (st & 1) * 32 + (swz % 64) / 2; }
__host__ __device__ __forceinline__ int perm32(int rho) { const int n = rho >> 4, i = rho & 15; return 8 * (i >> 2) + 4 * n + (i & 3); }

__device__ __forceinline__ int mk_lane_pg8() { int l; asm volatile("v_mbcnt_lo_u32_b32 %0, -1, 0\n\tv_mbcnt_hi_u32_b32 %0, -1, %0" : "=v"(l)); return l; }
struct Unit { int pm, pn; };
struct Gemm { const bf16_t* A; const bf16_t* Bt; int M, N, K; };

struct StaticOrder {
    int nM, nN, nwg, G, c;
    __host__ __device__ void init(int M, int N, int G_, int c_) { nM = M / BM; nN = N / BM; nwg = nM * nN; G = G_; c = c_; }
    __host__ __device__ bool next(int i, Unit& u) const {
        const long L = (long)i * G + c; if (L >= nwg) return false;
        int wgid = (int)L; { const int q = nwg / NXCD, r = nwg % NXCD, xcd = wgid % NXCD, off = wgid / NXCD; wgid = (xcd < r ? xcd * (q + 1) : r * (q + 1) + (xcd - r) * q) + off; }
        const int nig = WGM * nN, gid = wgid / nig, fm = gid * WGM, gsz = (nM - fm) < WGM ? (nM - fm) : WGM;
        u.pm = fm + ((wgid % nig) % gsz); u.pn = (wgid % nig) / gsz; return true;
    }
    __device__ __forceinline__ void a_ready(const Unit&) const {}
    __device__ __forceinline__ void done(const Unit&) const {}
};

__device__ __forceinline__ unsigned cvt_pk_bf16(float lo, float hi) { unsigned r; asm volatile("v_cvt_pk_bf16_f32 %0, %1, %2" : "=v"(r) : "v"(lo), "v"(hi)); return r; }
struct EpiBf16S {
    static constexpr bool PERM = true, AFTER_DRAIN = false, HAS_INIT = false;
    bf16_t* O; int ldc;
    __device__ __forceinline__ void operator()(const f32x4 (&acc)[2][2][4][2], const Unit& u, int wr, int wc, int fr, int fq) const {
        const int row0 = u.pm * BM + wr * 64 + fr, col0 = u.pn * BM + wc * 32 + 8 * fq;
#pragma unroll
        for (int ai = 0; ai < 2; ++ai)
#pragma unroll
            for (int m = 0; m < 4; ++m) { bf16_t* rowp = O + (size_t)(row0 + ai * HALF + m * 16) * ldc + col0;
#pragma unroll
                for (int bj = 0; bj < 2; ++bj) { const f32x4 v0 = acc[ai][bj][m][0], v1 = acc[ai][bj][m][1];
                    u32x4 w; w.x = cvt_pk_bf16(v0[0], v0[1]); w.y = cvt_pk_bf16(v0[2], v0[3]); w.z = cvt_pk_bf16(v1[0], v1[1]); w.w = cvt_pk_bf16(v1[2], v1[3]);
                    *(u32x4*)(rowp + bj * HALF) = w; } }
    }
};
struct EpiResF32 {
    static constexpr bool PERM = false, AFTER_DRAIN = false, HAS_INIT = true;
    const float* base; float* out; int ldc;
    __device__ __forceinline__ void init(f32x4 (&acc)[2][2][4][2], const Unit& u, int wr, int wc, int fr, int fq) const {
        const int row0 = u.pm * BM + wr * 64 + fr, col0 = u.pn * BM + wc * 32 + 4 * fq;
#pragma unroll
        for (int ai = 0; ai < 2; ++ai)
#pragma unroll
            for (int m = 0; m < 4; ++m) { const size_t off = (size_t)(row0 + ai * HALF + m * 16) * ldc + col0;
#pragma unroll
                for (int bj = 0; bj < 2; ++bj)
#pragma unroll
                    for (int n = 0; n < 2; ++n) acc[ai][bj][m][n] = *(const f32x4*)(base + off + bj * HALF + n * 16); }
    }
    __device__ __forceinline__ void operator()(const f32x4 (&acc)[2][2][4][2], const Unit& u, int wr, int wc, int fr, int fq) const {
        const int row0 = u.pm * BM + wr * 64 + fr, col0 = u.pn * BM + wc * 32 + 4 * fq;
#pragma unroll
        for (int ai = 0; ai < 2; ++ai)
#pragma unroll
            for (int m = 0; m < 4; ++m) { const size_t off = (size_t)(row0 + ai * HALF + m * 16) * ldc + col0;
#pragma unroll
                for (int bj = 0; bj < 2; ++bj)
#pragma unroll
                    for (int n = 0; n < 2; ++n) *(f32x4*)(out + off + bj * HALF + n * 16) = acc[ai][bj][m][n]; }
    }
};
template <class Epi, class Sched, bool ALIGN_EPI = false, bool SP2 = false>
__device__ __forceinline__ void gemm_phase(PG8_LAS unsigned char* lds, const Gemm g, const Sched& S, const Epi& E, const int mk_wave_id  ) {
    const int wid = mk_wave_id, lane = mk_lane_pg8(), tid = wid * 64 + lane, wr = wid >> 2, wc = wid & 3, fr = lane & 15, fq = lane >> 4;
    const int K = g.K, nt = K / BK;
    unsigned voffA[2], voffB[2];
#pragma unroll
    for (int i = 0; i < 2; ++i) { int R, C; stage_rc(tid * 16 + i * 8192, R, C); const int Rb = Epi::PERM ? ((R & ~31) + perm32(R & 31)) : R;
        voffA[i] = (unsigned)(R * K + C) * 2u; voffB[i] = (unsigned)(Rb * K + C) * 2u; }
    const size_t kstep = (size_t)(BK * 2);
    const size_t hstep = (size_t)HALF * K * 2;
    const size_t tstep = 2 * hstep;
    const unsigned ldsw = (unsigned)wid * 1024u;
    const int aoff = lds_byte(wr * 64 + fr, fq * 8), boff = lds_byte(wc * 32 + fr, fq * 8);
#define PG8_SA(b, h) (((b) * 2 + (h)) * HTB)
#define PG8_SB(b, h) ((4 + (b) * 2 + (h)) * HTB)
#define PG8_STAGE(bufoff, gbase, voff) do { _Pragma("unroll") for (int _i = 0; _i < 2; ++_i) \
        __builtin_amdgcn_global_load_lds((const unsigned*)((const char*)(gbase) + (voff)[_i]), (PG8_LAS unsigned*)(lds + (bufoff) + ldsw + _i * 8192), 16, 0, 0); } while (0)
#define PG8_LDA(dst, b, h) do { _Pragma("unroll") for (int m = 0; m < 4; ++m) _Pragma("unroll") for (int k = 0; k < 2; ++k) dst[m][k] = *(const PG8_LAS bf16x8*)(lds + PG8_SA(b, h) + aoff + m * 2048 + k * 1024); } while (0)
#define PG8_LDB(dst, b, h) do { _Pragma("unroll") for (int n = 0; n < 2; ++n) _Pragma("unroll") for (int k = 0; k < 2; ++k) dst[n][k] = *(const PG8_LAS bf16x8*)(lds + PG8_SB(b, h) + boff + n * 2048 + k * 1024); } while (0)
#define PG8_MMA(ai, bj, At, Bt) do { __builtin_amdgcn_s_setprio(1); _Pragma("unroll") for (int m = 0; m < 4; ++m) _Pragma("unroll") for (int n = 0; n < 2; ++n) _Pragma("unroll") for (int k = 0; k < 2; ++k) \
        acc[ai][bj][m][n] = __builtin_amdgcn_mfma_f32_16x16x32_bf16(Bt[n][k], At[m][k], acc[ai][bj][m][n], 0, 0, 0); __builtin_amdgcn_s_setprio(0); } while (0)
#define PG8_WAIT_V(n) asm volatile("s_waitcnt vmcnt(" #n ")" ::: "memory")
#define PG8_WAIT_L(n) asm volatile("s_waitcnt lgkmcnt(" #n ")" ::: "memory")
#define PG8_BAR __builtin_amdgcn_s_barrier()
#define PG8_SCHED __builtin_amdgcn_sched_barrier(0)
    Unit cur, nxt; int ui = 0;
    if (!S.next(0, cur)) return;
    f32x4 acc[2][2][4][2];
#pragma unroll
    for (int a = 0; a < 2; ++a)
#pragma unroll
        for (int b = 0; b < 2; ++b)
#pragma unroll
            for (int m = 0; m < 4; ++m)
#pragma unroll
                for (int n = 0; n < 2; ++n) acc[a][b][m][n] = (f32x4){0.f, 0.f, 0.f, 0.f};
    if constexpr (Epi::HAS_INIT) E.init(acc, cur, wr, wc, fr, fq);
    bf16x8 At[4][2], B0[2][2], B1[2][2];
    const char* cA = (const char*)g.A + (size_t)cur.pm * tstep; const char* cB = (const char*)g.Bt + (size_t)cur.pn * tstep;
    S.a_ready(cur);
    if constexpr (SP2) {
        PG8_STAGE(PG8_SB(0, 0), cB, voffB); PG8_STAGE(PG8_SB(0, 1), cB + hstep, voffB); PG8_STAGE(PG8_SA(0, 0), cA, voffA); PG8_STAGE(PG8_SA(0, 1), cA + hstep, voffA);
        if (wr == 1) PG8_BAR;
        PG8_WAIT_V(2); PG8_BAR;
        PG8_STAGE(PG8_SB(1, 0), cB + kstep, voffB); PG8_STAGE(PG8_SA(1, 0), cA + kstep, voffA); PG8_STAGE(PG8_SB(1, 1), cB + hstep + kstep, voffB);
        PG8_WAIT_V(6); PG8_BAR;
    } else {
        PG8_STAGE(PG8_SB(0, 0), cB, voffB); PG8_STAGE(PG8_SA(0, 0), cA, voffA); PG8_STAGE(PG8_SB(0, 1), cB + hstep, voffB); PG8_STAGE(PG8_SA(0, 1), cA + hstep, voffA);
        if (wr == 1) PG8_BAR;
        PG8_WAIT_V(4); PG8_BAR;
        PG8_STAGE(PG8_SB(1, 0), cB + kstep, voffB); PG8_STAGE(PG8_SA(1, 0), cA + kstep, voffA); PG8_STAGE(PG8_SB(1, 1), cB + hstep + kstep, voffB);
        PG8_WAIT_V(6); PG8_BAR;
    }
    for (;;) {
        const bool has_next = S.next(ui + 1, nxt);
        const char* nA = has_next ? (const char*)g.A + (size_t)nxt.pm * tstep : cA; const char* nB = has_next ? (const char*)g.Bt + (size_t)nxt.pn * tstep : cB;
        for (int t = 0; t < nt; t += 2) {
            const bool last = (t == nt - 2);
            const char* a1 = cA + (size_t)(t + 1) * kstep;
            const char* a2 = last ? nA : cA + (size_t)(t + 2) * kstep; const char* b2 = last ? nB : cB + (size_t)(t + 2) * kstep;
            const char* a3 = a2 + kstep; const char* b3 = b2 + kstep;
            if (last && has_next) S.a_ready(nxt);
            if constexpr (SP2) {
            PG8_LDB(B0, 0, 0); PG8_LDB(B1, 0, 1); PG8_SCHED; PG8_LDA(At, 0, 0); PG8_STAGE(PG8_SA(1, 1), a1 + hstep, voffA);
            PG8_WAIT_V(8); PG8_WAIT_L(0); PG8_BAR; PG8_MMA(0, 0, At, B0); PG8_MMA(0, 1, At, B1); PG8_BAR; PG8_SCHED;
            PG8_LDA(At, 0, 1); PG8_STAGE(PG8_SB(0, 0), b2, voffB); PG8_STAGE(PG8_SB(0, 1), b2 + hstep, voffB); PG8_STAGE(PG8_SA(0, 0), a2, voffA);
            PG8_WAIT_V(8); PG8_WAIT_L(0); PG8_BAR; PG8_MMA(1, 0, At, B0); PG8_MMA(1, 1, At, B1); PG8_BAR; PG8_SCHED;
            PG8_LDB(B0, 1, 0); PG8_LDB(B1, 1, 1); PG8_SCHED; PG8_LDA(At, 1, 0); PG8_STAGE(PG8_SA(0, 1), a2 + hstep, voffA);
            PG8_WAIT_V(8); PG8_WAIT_L(0); PG8_BAR; PG8_MMA(0, 0, At, B0); PG8_MMA(0, 1, At, B1); PG8_BAR; PG8_SCHED;
            PG8_LDA(At, 1, 1); PG8_STAGE(PG8_SB(1, 0), b3, voffB); PG8_STAGE(PG8_SB(1, 1), b3 + hstep, voffB); PG8_STAGE(PG8_SA(1, 0), a3, voffA);
            PG8_WAIT_V(8); PG8_WAIT_L(0); PG8_BAR; PG8_MMA(1, 0, At, B0); PG8_MMA(1, 1, At, B1); PG8_BAR; PG8_SCHED;
            } else {
            PG8_LDB(B0, 0, 0); PG8_SCHED; PG8_LDA(At, 0, 0); PG8_STAGE(PG8_SA(1, 1), a1 + hstep, voffA);
            PG8_WAIT_L(8); PG8_BAR; PG8_WAIT_L(0); PG8_MMA(0, 0, At, B0); PG8_BAR; PG8_SCHED;
            PG8_LDB(B1, 0, 1); PG8_STAGE(PG8_SB(0, 0), b2, voffB);
            PG8_BAR; PG8_WAIT_L(0); PG8_MMA(0, 1, At, B1); PG8_BAR;
            PG8_LDA(At, 0, 1); PG8_STAGE(PG8_SA(0, 0), a2, voffA);
            PG8_BAR; PG8_WAIT_L(0); PG8_MMA(1, 0, At, B0); PG8_BAR; PG8_SCHED;
            PG8_STAGE(PG8_SB(0, 1), b2 + hstep, voffB);
            PG8_WAIT_V(6); PG8_BAR; PG8_MMA(1, 1, At, B1); PG8_BAR;
            PG8_LDB(B0, 1, 0); PG8_SCHED; PG8_LDA(At, 1, 0); PG8_STAGE(PG8_SA(0, 1), a2 + hstep, voffA);
            PG8_WAIT_L(8); PG8_BAR; PG8_WAIT_L(0); PG8_MMA(0, 0, At, B0); PG8_BAR; PG8_SCHED;
            PG8_LDB(B1, 1, 1); PG8_STAGE(PG8_SB(1, 0), b3, voffB);
            PG8_BAR; PG8_WAIT_L(0); PG8_MMA(0, 1, At, B1); PG8_BAR;
            PG8_LDA(At, 1, 1); PG8_STAGE(PG8_SA(1, 0), a3, voffA);
            PG8_BAR; PG8_WAIT_L(0); PG8_MMA(1, 0, At, B0); PG8_BAR; PG8_SCHED;
            PG8_STAGE(PG8_SB(1, 1), b3 + hstep, voffB);
            PG8_WAIT_V(6); PG8_BAR; PG8_MMA(1, 1, At, B1); PG8_BAR;
            }
        }
        if constexpr (ALIGN_EPI) { if (wr == 0) PG8_BAR; }
        if constexpr (!Epi::AFTER_DRAIN) { E(acc, cur, wr, wc, fr, fq); S.done(cur); }
        if (!has_next) break;
#pragma unroll
        for (int a = 0; a < 2; ++a)
#pragma unroll
            for (int b = 0; b < 2; ++b)
#pragma unroll
                for (int m = 0; m < 4; ++m)
#pragma unroll
                    for (int n = 0; n < 2; ++n) acc[a][b][m][n] = (f32x4){0.f, 0.f, 0.f, 0.f};
        if constexpr (Epi::HAS_INIT) E.init(acc, nxt, wr, wc, fr, fq);
        cur = nxt; cA = nA; cB = nB; ++ui;
        if constexpr (ALIGN_EPI) { if (wr == 1) PG8_BAR; }
    }
    PG8_WAIT_V(0);
    if constexpr (!ALIGN_EPI) { if (wr == 0) PG8_BAR; }
    PG8_BAR;
    if constexpr (Epi::AFTER_DRAIN) { E.fused(acc, cur, wr, wc, fr, fq, lds, wid, lane); S.done(cur); }
#undef PG8_SA
#undef PG8_SB
#undef PG8_STAGE
#undef PG8_LDA
#undef PG8_LDB
#undef PG8_MMA
#undef PG8_WAIT_V
#undef PG8_WAIT_L
#undef PG8_BAR
#undef PG8_SCHED
}
}
constexpr int NWAVES = 8;
#ifndef MK_N_LAUNCHES
#define MK_N_LAUNCHES 1
#endif
constexpr int N_PHASES = 5;
constexpr int BATCH = 8, T = 2048, D = 1024, M = BATCH * T;
constexpr int NP = 4352;
constexpr int C_R = 0, C_K = 512, C_V = 1024, C_ZW = 1536, C_ZA = 1600, C_GA = 1792, C_DQ = 2304, C_DK = 2816, C_DV = 3328, C_GB = 3840;
constexpr int RH = 8, RN = 64;
constexpr int AH = 4;
constexpr float C2 = 0.125f * 1.4426950408889634f;
constexpr float LOG2E = 1.4426950408889634f;
constexpr float LAMBDA_INIT = 0.2f;

constexpr size_t MiB = 1u << 20;
constexpr size_t WS_CTL = 0, CTL_ZERO_BYTES = 1 * MiB;
constexpr size_t WS_WIN = 2 * MiB;
constexpr size_t WS_WOUT = 11 * MiB;
constexpr size_t WS_WD = 13 * MiB, WS_WA = 13 * MiB + 65536;
constexpr size_t WS_RHO = 13 * MiB + 2 * 65536;
constexpr size_t WS_XN = 14 * MiB;
constexpr size_t WS_PROJ = 46 * MiB;
constexpr size_t WS_MIX = 182 * MiB;
constexpr size_t WS_END = 214 * MiB;
constexpr int CW_BAR = 4096;

constexpr int RING_OFF = 0, RING_BYTES = 131072;
constexpr int LDSCTL_OFF = RING_BYTES, MISC_OFF = LDSCTL_OFF + 320;
constexpr int LDS_BYTES = 155648;

#define GAS __attribute__((address_space(1)))
#define LAS __attribute__((address_space(3)))
typedef unsigned short bf16;
typedef unsigned v4u __attribute__((ext_vector_type(4)));
typedef unsigned v2u __attribute__((ext_vector_type(2)));
typedef float f32x4 __attribute__((ext_vector_type(4)));
typedef float f32x16 __attribute__((ext_vector_type(16)));
typedef short bf16x8 __attribute__((ext_vector_type(8)));
typedef short s16x4 __attribute__((ext_vector_type(4)));
typedef GAS unsigned gu32;
typedef GAS unsigned long long gu64;
#define RLX_AGENT __ATOMIC_RELAXED, __HIP_MEMORY_SCOPE_AGENT
#define LDS_WAIT() asm volatile("s_waitcnt lgkmcnt(0)" ::: "memory")
#define VM_WAIT() asm volatile("s_waitcnt vmcnt(0)" ::: "memory")
__device__ __forceinline__ unsigned f2bf(float f) { unsigned u = __builtin_bit_cast(unsigned, f); return (u + 0x7fffu + ((u >> 16) & 1u)) >> 16; }
__device__ __forceinline__ unsigned pk2(float lo, float hi) { return f2bf(lo) | (f2bf(hi) << 16); }
__device__ __forceinline__ float bflo(unsigned u) { return __uint_as_float(u << 16); }
__device__ __forceinline__ float bfhi(unsigned u) { return __uint_as_float(u & 0xffff0000u); }
__device__ __forceinline__ float bf1(unsigned short u) { return __uint_as_float((unsigned)u << 16); }
__device__ __forceinline__ int mk_lane() { int l; asm volatile("v_mbcnt_lo_u32_b32 %0, -1, 0\n\tv_mbcnt_hi_u32_b32 %0, -1, %0" : "=v"(l)); return l; }
#define XB_TMO      128
#define XB_XCNT(j)  (256  + 64 * (j))
#define XB_XSUB(j)  (1280 + 64 * (j))
#define XB_XGEN(j)  (2304 + 64 * (j))
#define XB_TOP      3328
#define XB_TOPGEN   3392
#define XCD_BAR_WORDS 3456
#define XB_SPIN_CAP (1u << 18)

__device__ __forceinline__ unsigned xb_ld(unsigned* p)              { return __hip_atomic_load(p, __ATOMIC_RELAXED, __HIP_MEMORY_SCOPE_AGENT); }
__device__ __forceinline__ unsigned xb_add(unsigned* p, unsigned v) { return __hip_atomic_fetch_add(p, v, __ATOMIC_RELAXED, __HIP_MEMORY_SCOPE_AGENT); }
__device__ __forceinline__ unsigned xb_xcc_id() { return (unsigned)__builtin_amdgcn_s_getreg((3 << 11) | 20) & 0xFu; }
#define XB_SPIN(cond, bar) do { unsigned _sp = 0; while (cond) { __builtin_amdgcn_s_sleep(1); \
    if ((++_sp & 255u) == 0u) { if (xb_ld(&(bar)[XB_TMO])) break; if (_sp > XB_SPIN_CAP) { atomicAdd(&(bar)[XB_TMO], 1u); break; } } } } while (0)

struct XcdBarrier {
    unsigned* bar; unsigned x;
    volatile LAS unsigned* st;
    int wave;
};

__device__ __forceinline__ XcdBarrier xcd_barrier_post(unsigned* bar, volatile LAS unsigned* st, int wave) {
    XcdBarrier b; b.bar = bar; b.x = xb_xcc_id(); b.st = st; b.wave = wave;
    if (wave == 0 && mk_lane() == 0) (void)xb_add(&bar[XB_XCNT(b.x)], 1u);
    return b;
}
__device__ __forceinline__ void xcd_barrier_complete(unsigned* bar, unsigned x, unsigned& nloc, unsigned& nx) {
    const unsigned G = gridDim.x * gridDim.y * gridDim.z;
    unsigned sum, cnt, mine, sp = 0u;
    for (;;) {
        sum = 0u; cnt = 0u; mine = 0u;
#pragma unroll
        for (unsigned j = 0; j < 16; ++j) { const unsigned c = xb_ld(&bar[XB_XCNT(j)]); sum += c; cnt += (c > 0u) ? 1u : 0u; mine = (j == x) ? c : mine; }
        if (sum == G) break;
        __builtin_amdgcn_s_sleep(1);
        if ((++sp & 255u) == 0u) { if (xb_ld(&bar[XB_TMO])) break; if (sp > XB_SPIN_CAP) { atomicAdd(&bar[XB_TMO], 1u); break; } }
    }
    nloc = mine > 0u ? mine : 1u; nx = cnt > 0u ? cnt : 1u;
}

__device__ __forceinline__ void xcd_barrier(const XcdBarrier& b) {
    asm volatile("s_waitcnt vmcnt(0)" ::: "memory");
    __syncthreads();
    if (b.wave == 0 && mk_lane() == 0) {
        unsigned* bar = b.bar;
        __builtin_amdgcn_s_waitcnt(0);
        unsigned nloc = b.st[0], nx = b.st[1];
        if (nloc == 0u) { xcd_barrier_complete(bar, b.x, nloc, nx); b.st[0] = nloc; b.st[1] = nx; }
        const unsigned old = xb_add(&bar[XB_XSUB(b.x)], 1u);
        const unsigned gen = old / nloc;
        if (old + 1u == (gen + 1u) * nloc) {
            __builtin_amdgcn_fence(__ATOMIC_RELEASE, "agent");
            asm volatile("s_waitcnt vmcnt(0)" ::: "memory");
            const unsigned og = xb_add(&bar[XB_TOP], 1u);
            const unsigned tg = og / nx;
            if (og + 1u == (tg + 1u) * nx) xb_add(&bar[XB_TOPGEN], 1u);
            else XB_SPIN(xb_ld(&bar[XB_TOPGEN]) == tg, bar);
            __builtin_amdgcn_fence(__ATOMIC_ACQUIRE, "agent");
            xb_add(&bar[XB_XGEN(b.x)], 1u);
            asm volatile("s_waitcnt vmcnt(0)" ::: "memory");
        } else {
            XB_SPIN(xb_ld(&bar[XB_XGEN(b.x)]) == gen, bar);
            __builtin_amdgcn_fence(__ATOMIC_ACQUIRE, "agent");
            asm volatile("s_waitcnt vmcnt(0)" ::: "memory");
        }
    }
    __syncthreads();
}
struct Frame {
    LAS unsigned char* lds;
    volatile LAS unsigned* MISC;
    gu32* ctl;
    int tid, lane, wave;
    int vcu, G;
    const float* x; float* out;
    const float *norm_g, *w_in, *shift_mu, *w0, *w_decay_up, *a0, *w_iclr_up, *k_k, *k_a, *r_k, *ln_w, *ln_b, *qn_g, *kn_g, *lq1, *lk1, *lq2, *lk2, *subln_g, *w_out;
    bf16 *WinT, *WoutT, *WdT, *WaT, *XN, *PROJ, *MIX;
};

typedef float f32x2q_t __attribute__((ext_vector_type(2))); typedef __bf16 bf16x2q_t __attribute__((ext_vector_type(2)));
__device__ __forceinline__ unsigned cvtpk2(float lo, float hi) { f32x2q_t v = {lo, hi}; bf16x2q_t b = __builtin_convertvector(v, bf16x2q_t); return __builtin_bit_cast(unsigned, b); }
__device__ __forceinline__ float wave_sum(float v) {
#pragma unroll
    for (int o = 1; o < 64; o <<= 1) v += __shfl_xor(v, o);
    return v;
}
template <int CTRL> __device__ __forceinline__ float dpp_f(float x) { return __builtin_bit_cast(float, __builtin_amdgcn_mov_dpp(__builtin_bit_cast(int, x), CTRL, 0xf, 0xf, true)); }
__device__ __forceinline__ float row16_sum(float x) {
    x += dpp_f<0xB1>(x); x += dpp_f<0x4E>(x); x += dpp_f<0x141>(x); x += dpp_f<0x140>(x); return x;
}
__device__ __forceinline__ float swap32_sum(float x) {
    auto rr = __builtin_amdgcn_permlane32_swap(__float_as_uint(x), __float_as_uint(x), false, false);
    return __uint_as_float(rr[0]) + __uint_as_float(rr[1]);
}

__device__ __forceinline__ void p0_transpose_item(const float* W, int N, int nsrc, const float* kscale, bf16* WT, int K, int ndst, LAS float* scr, int k0, int lane) {
    float v[32];
#pragma unroll
    for (int i = 0; i < 32; ++i) { const int kk = 2 * i + (lane >> 5); v[i] = (nsrc >= 0) ? W[(size_t)(k0 + kk) * N + nsrc + (lane & 31)] : 0.f; }
    if (kscale && nsrc >= 0) {
#pragma unroll
        for (int i = 0; i < 32; ++i) v[i] *= kscale[k0 + 2 * i + (lane >> 5)];
    }
#pragma unroll
    for (int i = 0; i < 32; ++i) scr[(2 * i + (lane >> 5)) * 33 + (lane & 31)] = v[i];
    LDS_WAIT(); asm volatile("" ::: "memory");
    const int c = lane & 7;
#pragma unroll
    for (int j = 0; j < 4; ++j) { const int n = (lane >> 3) + 8 * j; const LAS float* s = scr + (8 * c) * 33 + n;
        v4u o; o.x = cvtpk2(s[0 * 33], s[1 * 33]); o.y = cvtpk2(s[2 * 33], s[3 * 33]); o.z = cvtpk2(s[4 * 33], s[5 * 33]); o.w = cvtpk2(s[6 * 33], s[7 * 33]);
        *(GAS v4u*)(WT + (size_t)(ndst + n) * K + k0 + 8 * c) = o; }
    LDS_WAIT(); asm volatile("" ::: "memory");
}
__device__ __forceinline__ void p0_rows4(Frame& F, int m0) {
    f32x4 v[4][4]; float s[4];
#pragma unroll
    for (int u = 0; u < 4; ++u) { const GAS f32x4* xr = (const GAS f32x4*)(F.x + (size_t)(m0 + u) * D) + F.lane;
#pragma unroll
        for (int j = 0; j < 4; ++j) v[u][j] = __builtin_nontemporal_load(xr + 64 * j); }
#pragma unroll
    for (int u = 0; u < 4; ++u) { float a = 0.f;
#pragma unroll
        for (int j = 0; j < 4; ++j) a += (v[u][j].x * v[u][j].x + v[u][j].y * v[u][j].y) + (v[u][j].z * v[u][j].z + v[u][j].w * v[u][j].w);
        s[u] = a; }
#pragma unroll
    for (int u = 0; u < 4; ++u) {
        const float rstd = __builtin_amdgcn_rsqf(wave_sum(s[u]) * (1.f / D) + 1e-6f);
        GAS unsigned long long* o8 = (GAS unsigned long long*)(F.XN + (size_t)(m0 + u) * D) + F.lane;
#pragma unroll
        for (int j = 0; j < 4; ++j) o8[64 * j] = (unsigned long long)cvtpk2(v[u][j].x * rstd, v[u][j].y * rstd) | ((unsigned long long)cvtpk2(v[u][j].z * rstd, v[u][j].w * rstd) << 32);
    }
}
__device__ __forceinline__ void p0_prologue(Frame& F) {
    LAS float* scr = (LAS float*)(F.lds + RING_OFF + F.wave * 16384);
    const int gw = F.vcu * NWAVES + F.wave, NGW = F.G * NWAVES;
    constexpr int I_IN = (D / 64) * (NP / 32), I_OUT = (D / 64) * (D / 32), I_L = 512 / 32;
    constexpr int NITEMS = I_IN + I_OUT + 2 * I_L;
    int m0 = gw * 4;
    if (!(gw & 1) && m0 < M) { p0_rows4(F, m0); m0 += NGW * 4; }
#pragma unroll 1
    for (int it = gw; it < NITEMS; it += NGW) {
        int r = it;
        if (r < I_IN) { const int kb = r / (NP / 32), nb = r % (NP / 32), nd = 32 * nb; const int ns = nd < 1664 ? nd : (nd < 1792 ? -1 : nd - 128);
            p0_transpose_item(F.w_in, 4224, ns, F.norm_g, F.WinT, D, nd, scr, 64 * kb, F.lane); continue; } r -= I_IN;
        if (r < I_OUT) { const int kb = r / (D / 32), nb = r % (D / 32);
            p0_transpose_item(F.w_out, D, 32 * nb, nullptr, F.WoutT, D, 32 * nb, scr, 64 * kb, F.lane); continue; } r -= I_OUT;
        if (r < I_L) { p0_transpose_item(F.w_decay_up, 512, 32 * r, nullptr, F.WdT, 64, 32 * r, scr, 0, F.lane); continue; } r -= I_L;
        p0_transpose_item(F.w_iclr_up, 512, 32 * r, nullptr, F.WaT, 64, 32 * r, scr, 0, F.lane);
    }
#pragma unroll 1
    for (; m0 < M; m0 += NGW * 4) p0_rows4(F, m0);
}

__device__ __forceinline__ float tanh_f(float x) { const float e = __expf(-2.f * fabsf(x)); const float t = (1.f - e) * __builtin_amdgcn_rcpf(1.f + e); return x < 0.f ? -t : t; }
__device__ __forceinline__ void shifted8(const bf16* proj, size_t m, bool has_prev, int col, const float* mu, float (&o)[8]) {
    const v4u c = *(const GAS v4u*)(proj + m * NP + col);
    v4u p = (v4u){0u, 0u, 0u, 0u}; if (has_prev) p = *(const GAS v4u*)(proj + (m - 1) * NP + col);
    const f32x4 m0 = *(const GAS f32x4*)(mu), m1 = *(const GAS f32x4*)(mu + 4);
    const unsigned cw[4] = {c.x, c.y, c.z, c.w}, pw[4] = {p.x, p.y, p.z, p.w}; const float mm[8] = {m0.x, m0.y, m0.z, m0.w, m1.x, m1.y, m1.z, m1.w};
#pragma unroll
    for (int j = 0; j < 4; ++j) { const float c0 = bflo(cw[j]), c1 = bfhi(cw[j]), p0 = bflo(pw[j]), p1 = bfhi(pw[j]);
        o[2 * j] = c0 + (p0 - c0) * mm[2 * j]; o[2 * j + 1] = c1 + (p1 - c1) * mm[2 * j + 1]; }
}
__device__ __forceinline__ void shifted4(const bf16* proj, size_t m, bool has_prev, int col, const float* mu, float (&o)[4]) {
    const v2u c = *(const GAS v2u*)(proj + m * NP + col);
    v2u p = (v2u){0u, 0u}; if (has_prev) p = *(const GAS v2u*)(proj + (m - 1) * NP + col);
    const f32x4 m0 = *(const GAS f32x4*)(mu);
    o[0] = bflo(c.x) + (bflo(p.x) - bflo(c.x)) * m0.x; o[1] = bfhi(c.x) + (bfhi(p.x) - bfhi(c.x)) * m0.y;
    o[2] = bflo(c.y) + (bflo(p.y) - bflo(c.y)) * m0.z; o[3] = bfhi(c.y) + (bfhi(p.y) - bfhi(c.y)) * m0.w;
}
__device__ __forceinline__ void p2_qknorm(Frame& F) {
    const int gw = F.vcu * NWAVES + F.wave, NGW = F.G * NWAVES, lane = F.lane, sub = lane & 7;
    const f32x4 gq0 = *(const GAS f32x4*)(F.qn_g + sub * 8), gq1 = *(const GAS f32x4*)(F.qn_g + sub * 8 + 4), gk0 = *(const GAS f32x4*)(F.kn_g + sub * 8), gk1 = *(const GAS f32x4*)(F.kn_g + sub * 8 + 4);
    constexpr int UQ = 4;
    for (int it0 = gw * UQ; it0 < 2 * M; it0 += NGW * UQ) {
        bf16* p[UQ]; v4u c[UQ];
#pragma unroll
        for (int u = 0; u < UQ; ++u) { const int it = it0 + u; const size_t m = (size_t)(it >> 1); p[u] = F.PROJ + m * NP + ((it & 1) ? C_DK : C_DQ) + (lane >> 3) * 64 + sub * 8; c[u] = *(const GAS v4u*)p[u]; }
#pragma unroll
        for (int u = 0; u < UQ; ++u) {
            const int isk = (it0 + u) & 1; const unsigned cw[4] = {c[u].x, c[u].y, c[u].z, c[u].w};
            float xv[8]; float ss = 0.f;
#pragma unroll
            for (int j = 0; j < 4; ++j) { xv[2 * j] = bflo(cw[j]); xv[2 * j + 1] = bfhi(cw[j]); ss += xv[2 * j] * xv[2 * j] + xv[2 * j + 1] * xv[2 * j + 1]; }
            ss += dpp_f<0xB1>(ss); ss += dpp_f<0x4E>(ss); ss += dpp_f<0x141>(ss);
            const float r = __builtin_amdgcn_rsqf(ss * (1.f / 64.f) + 1e-6f) * (isk ? 1.f : C2);
            const f32x4 g0 = isk ? gk0 : gq0, g1 = isk ? gk1 : gq1;
            v4u o; o.x = cvtpk2(xv[0] * r * g0.x, xv[1] * r * g0.y); o.y = cvtpk2(xv[2] * r * g0.z, xv[3] * r * g0.w); o.z = cvtpk2(xv[4] * r * g1.x, xv[5] * r * g1.y); o.w = cvtpk2(xv[6] * r * g1.z, xv[7] * r * g1.w);
            *(GAS v4u*)p[u] = o;
        }
    }
}
typedef float f32x2_t __attribute__((ext_vector_type(2))); typedef __bf16 bf16x2_t __attribute__((ext_vector_type(2)));
__device__ __forceinline__ unsigned cvtpk(float lo, float hi) { f32x2_t v = {lo, hi}; bf16x2_t b = __builtin_convertvector(v, bf16x2_t); return __builtin_bit_cast(unsigned, b); }
#define MFMA32(a, b, c) __builtin_amdgcn_mfma_f32_32x32x16_bf16(__builtin_bit_cast(bf16x8, (a)), __builtin_bit_cast(bf16x8, (b)), (c), 0, 0, 0)
#define FRAGACC(z, s) ((v4u){cvtpk((z)[8 * (s)], (z)[8 * (s) + 1]), cvtpk((z)[8 * (s) + 2], (z)[8 * (s) + 3]), cvtpk((z)[8 * (s) + 4], (z)[8 * (s) + 5]), cvtpk((z)[8 * (s) + 6], (z)[8 * (s) + 7])})
template <int CTRL, int RM> __device__ __forceinline__ float dpp_upd0(float x) { return __builtin_bit_cast(float, __builtin_amdgcn_update_dpp(0, __builtin_bit_cast(int, x), CTRL, RM, 0xf, false)); }
__device__ __forceinline__ float scan32(float x) {
    x += dpp_upd0<0x111, 0xf>(x); x += dpp_upd0<0x112, 0xf>(x); x += dpp_upd0<0x114, 0xf>(x); x += dpp_upd0<0x118, 0xf>(x); x += dpp_upd0<0x142, 0xa>(x); return x;
}
__device__ __forceinline__ void st_wt16(v4u* p, const v4u v) { *(GAS v4u*)p = v; }
constexpr int RW_UNITS = BATCH * RH * (T / 32);
struct RwDump { v4u* PF; v4u* DD; v4u* QF; v4u* YD; float* GAM; float* RHO; };

__device__ __forceinline__ void rwkvA_unit(Frame& F, const RwDump& Dm, int bh, int ci, LAS float* wscr, LAS unsigned char* park, LAS v4u* zsh, int zpar) {
    int lane = mk_lane(); asm volatile("" : "+v"(lane));
    const int hi = lane >> 5, l31 = lane & 31, b = bh >> 3, w = bh & 7;
    LAS v4u* pk = (LAS v4u*)park + lane;
#define PARK(slot) pk[(slot) * 64]
    int tok = 0; asm volatile("" : "+v"(tok));
#define DEP(x) asm volatile("" : "+v"(tok) : "v"(x))
    const int t = ci * 32 + l31; const size_t m = (size_t)b * T + t; const bool hp = t > 0;
    const int u = ci * (BATCH * RH) + bh;
    const float pm = hp ? 1.f : 0.f;
    const bf16* pc = F.PROJ + m * NP + w * 64 + 4 * hi; const bf16* pp = F.PROJ + (hp ? m - 1 : m) * NP + w * 64 + 4 * hi;
    const float* mu = F.shift_mu + w * 64 + 4 * hi;
    const float *pw0 = F.w0 + w * 64 + 4 * hi, *pa0 = F.a0 + w * 64 + 4 * hi, *pkk = F.k_k + w * 64 + 4 * hi, *pka = F.k_a + w * 64 + 4 * hi, *prk = F.r_k + w * 64 + 4 * hi;
#define SH4(dst, COL, MU, OFF) do { const v2u c_ = *(const GAS v2u*)(pc + tok + (COL) + (OFF)), p_ = *(const GAS v2u*)(pp + tok + (COL) + (OFF)); const f32x4 m_ = *(const GAS f32x4*)(mu + tok + (MU) + (OFF)); \
        dst[0] = bflo(c_.x) + (bflo(p_.x) * pm - bflo(c_.x)) * m_.x; dst[1] = bfhi(c_.x) + (bfhi(p_.x) * pm - bfhi(c_.x)) * m_.y; \
        dst[2] = bflo(c_.y) + (bflo(p_.y) * pm - bflo(c_.y)) * m_.z; dst[3] = bfhi(c_.y) + (bfhi(p_.y) * pm - bfhi(c_.y)) * m_.w; } while (0)
    float ss = 0.f;
#pragma unroll
    for (int gq = 0; gq < 8; ++gq) { float k4[4]; SH4(k4, C_K, 512, 8 * gq); const f32x4 kkp = *(const GAS f32x4*)(pkk + tok + 8 * gq);
#pragma unroll
        for (int e = 0; e < 4; ++e) { const float q = k4[e] * kkp[e]; ss += q * q; }
        if (gq == 3) DEP(ss); }
    ss = swap32_sum(ss);
    const float inv = __builtin_amdgcn_rcpf(fmaxf(__builtin_amdgcn_sqrtf(ss), 1e-12f));
    asm volatile("" ::: "memory");
    v4u bz[4], ba[4];
    { const int s = F.wave >> 1; const bool which = (F.wave & 1) != 0;
      const bf16* zc = F.PROJ + m * NP + 8 * hi; const bf16* zp = F.PROJ + (hp ? m - 1 : m) * NP + 8 * hi; const float* zmu = F.shift_mu + 8 * hi;
      const int COL = (which ? C_ZA : C_ZW) + 16 * s, MUO = (which ? 1600 : 1536) + 16 * s;
      const v4u c = *(const GAS v4u*)(zc + tok + COL), p = *(const GAS v4u*)(zp + tok + COL); const f32x4 m0 = *(const GAS f32x4*)(zmu + tok + MUO), m1 = *(const GAS f32x4*)(zmu + tok + MUO + 4);
      float z[8];
#pragma unroll
      for (int j = 0; j < 4; ++j) { const float c0 = bflo(c[j]), c1 = bfhi(c[j]); const float mm0 = j < 2 ? m0[2 * j] : m1[2 * j - 4], mm1 = j < 2 ? m0[2 * j + 1] : m1[2 * j - 3];
          z[2 * j] = c0 + (bflo(p[j]) * pm - c0) * mm0; z[2 * j + 1] = c1 + (bfhi(p[j]) * pm - c1) * mm1; }
      if (!which) {
#pragma unroll
          for (int j = 0; j < 8; ++j) z[j] = tanh_f(z[j]); }
      LAS v4u* zs = zsh + zpar * 512;
      zs[((which ? 4 : 0) + s) * 64 + lane] = (v4u){cvtpk(z[0], z[1]), cvtpk(z[2], z[3]), cvtpk(z[4], z[5]), cvtpk(z[6], z[7])};
      __syncthreads();
#pragma unroll
      for (int q = 0; q < 4; ++q) { bz[q] = zs[q * 64 + lane]; ba[q] = zs[(4 + q) * 64 + lane]; }
      DEP(bz[3][3]); DEP(ba[3][3]); }
    asm volatile("" ::: "memory");
    v4u fa[4], fb[4], fk[4], fr[4], fv[4]; float rho = 0.f;
    float* gp = Dm.GAM + (size_t)u * 64 + hi * 32;
#define RW_LORA(cb) f32x16 accd = f32x16{}, acca = f32x16{}; _Pragma("unroll") for (int s = 0; s < 4; ++s) { \
        const v4u aD = *(const GAS v4u*)(F.WdT + tok + (size_t)(w * 64 + (cb) * 32 + l31) * 64 + 16 * s + 8 * hi); accd = MFMA32(aD, bz[s], accd); \
        const v4u aA = *(const GAS v4u*)(F.WaT + tok + (size_t)(w * 64 + (cb) * 32 + l31) * 64 + 16 * s + 8 * hi); acca = MFMA32(aA, ba[s], acca); }
    struct RwGL { v2u rc, rp, kc, kp, vc, vp; } gA, gB;
#define RW_LOADG(X, OFF) do { X.rc = *(const GAS v2u*)(pc + tok + C_R + (OFF)); X.rp = *(const GAS v2u*)(pp + tok + C_R + (OFF)); X.kc = *(const GAS v2u*)(pc + tok + C_K + (OFF)); X.kp = *(const GAS v2u*)(pp + tok + C_K + (OFF)); \
        X.vc = *(const GAS v2u*)(pc + tok + C_V + (OFF)); X.vp = *(const GAS v2u*)(pp + tok + C_V + (OFF)); } while (0)
#define RW_LERP(dst, c_, p_, m_) do { dst[0] = bflo(c_.x) + (bflo(p_.x) * pm - bflo(c_.x)) * m_.x; dst[1] = bfhi(c_.x) + (bfhi(p_.x) * pm - bfhi(c_.x)) * m_.y; \
        dst[2] = bflo(c_.y) + (bflo(p_.y) * pm - bflo(c_.y)) * m_.z; dst[3] = bfhi(c_.y) + (bfhi(p_.y) * pm - bfhi(c_.y)) * m_.w; } while (0)
#define RW_GROUP(cb, rg, CUR, NXT, HASN) do { constexpr int OFF = 32 * (cb) + 8 * (rg); const int ch0 = OFF + 4 * hi; \
            if (HASN) RW_LOADG(NXT, OFF + 8); \
            float rr[4], kk4[4], vv[4]; \
            const f32x4 mr_ = *(const GAS f32x4*)(mu + tok + OFF), mk_ = *(const GAS f32x4*)(mu + tok + 512 + OFF), mv_ = *(const GAS f32x4*)(mu + tok + 1024 + OFF); \
            const f32x4 w0v = *(const GAS f32x4*)(pw0 + tok + OFF), a0v = *(const GAS f32x4*)(pa0 + tok + OFF), kkp = *(const GAS f32x4*)(pkk + tok + OFF), kap = *(const GAS f32x4*)(pka + tok + OFF), rkp = *(const GAS f32x4*)(prk + tok + OFF); \
            RW_LERP(rr, CUR.rc, CUR.rp, mr_); RW_LERP(kk4, CUR.kc, CUR.kp, mk_); RW_LERP(vv, CUR.vc, CUR.vp, mv_); \
            float xa[4], xb[4], xk[4], xr[4], gg[4], ge[4]; \
            _Pragma("unroll") for (int e = 0; e < 4; ++e) { \
                const float nx = -(w0v[e] + accd[4 * (rg) + e]); const float sp = fmaxf(nx, 0.f) + __logf(1.f + __expf(-fabsf(nx))); \
                const float l2 = -__expf(-sp - 0.5f) * LOG2E; \
                const float g = scan32(l2); \
                const float a = __builtin_amdgcn_rcpf(1.f + __expf(-(a0v[e] + acca[4 * (rg) + e]))); \
                const float kk = kk4[e] * kkp[e] * inv; \
                const float kt = kk4[e] * (1.f + (a - 1.f) * kap[e]); \
                rho += rr[e] * kt * rkp[e]; \
                const float eg = __builtin_amdgcn_exp2f(g), egp = __builtin_amdgcn_exp2f(g - l2), eng = __builtin_amdgcn_rcpf(eg); \
                xa[e] = -kk * egp; xb[e] = kk * a * eng; xk[e] = kt * eng; xr[e] = rr[e] * eg; gg[e] = g; ge[e] = eg; } \
            if (l31 == 31) { *(LAS f32x4*)(wscr + ch0) = (f32x4){gg[0], gg[1], gg[2], gg[3]}; st_wt16((v4u*)(gp + (cb) * 16 + 4 * (rg)), (v4u){__float_as_uint(ge[0]), __float_as_uint(ge[1]), __float_as_uint(ge[2]), __float_as_uint(ge[3])}); } \
            constexpr int s_ = 2 * (cb) + ((rg) >> 1), vg = 2 * ((rg) & 1); \
            fa[s_][vg] = cvtpk(xa[0], xa[1]); fa[s_][vg + 1] = cvtpk(xa[2], xa[3]); \
            fb[s_][vg] = cvtpk(xb[0], xb[1]); fb[s_][vg + 1] = cvtpk(xb[2], xb[3]); \
            fk[s_][vg] = cvtpk(xk[0], xk[1]); fk[s_][vg + 1] = cvtpk(xk[2], xk[3]); \
            fr[s_][vg] = cvtpk(xr[0], xr[1]); fr[s_][vg + 1] = cvtpk(xr[2], xr[3]); \
            fv[s_][vg] = cvtpk(vv[0], vv[1]); fv[s_][vg + 1] = cvtpk(vv[2], vv[3]); \
            if (((rg) & 1) == 1) { PARK(s_) = fv[s_]; PARK(4 + s_) = fr[s_]; } \
            DEP(fa[s_][vg + 1]); DEP(fb[s_][vg + 1]); DEP(fk[s_][vg + 1]); DEP(fr[s_][vg + 1]); DEP(fv[s_][vg + 1]); DEP(rho); } while (0)
    RW_LOADG(gA, 0);
    { RW_LORA(0) RW_GROUP(0, 0, gA, gB, true); RW_GROUP(0, 1, gB, gA, true); RW_GROUP(0, 2, gA, gB, true); RW_GROUP(0, 3, gB, gA, true); }
    { RW_LORA(1) RW_GROUP(1, 0, gA, gB, true); RW_GROUP(1, 1, gB, gA, true); RW_GROUP(1, 2, gA, gB, true); RW_GROUP(1, 3, gB, gA, false); }
#undef RW_LOADG
#undef RW_LERP
#undef RW_LORA
#undef RW_GROUP
#undef SH4
    LDS_WAIT(); asm volatile("" ::: "memory");
    float EC[2]; EC[0] = __builtin_amdgcn_exp2f(wscr[l31]); EC[1] = __builtin_amdgcn_exp2f(wscr[32 + l31]);
    LDS_WAIT(); asm volatile("" ::: "memory");
    rho = swap32_sum(rho);
    if (hi == 0) __hip_atomic_store((gu32*)(Dm.RHO + (size_t)u * 32 + l31), __float_as_uint(rho), RLX_AGENT);
    v4u idf[2];
    { const int jst = 4 * ((l31 >> 3) & 1) + (l31 & 3); const bool hm = ((l31 >> 2) & 1) == hi; const unsigned one = 0x3F80u << (16 * (jst & 1));
#pragma unroll
      for (int sig = 0; sig < 2; ++sig) { const bool on = hm && ((l31 >> 4) == sig);
#pragma unroll
          for (int q = 0; q < 4; ++q) idf[sig][q] = (on && (jst >> 1) == q) ? one : 0u; } }
    LDS_WAIT();
    v4u Af[2][2], Vf[2][2];
#pragma unroll
    for (int blk = 0; blk < 2; ++blk) {
        f32x16 za = MFMA32(fa[2 * blk], idf[0], f32x16{}); za = MFMA32(fa[2 * blk + 1], idf[1], za);
        f32x16 zv = MFMA32(PARK(2 * blk), idf[0], f32x16{}); zv = MFMA32(PARK(2 * blk + 1), idf[1], zv);
        f32x16 zb = MFMA32(fb[2 * blk], idf[0], f32x16{}); zb = MFMA32(fb[2 * blk + 1], idf[1], zb);
        f32x16 zk = MFMA32(fk[2 * blk], idf[0], f32x16{}); zk = MFMA32(fk[2 * blk + 1], idf[1], zk);
        zb = zb * EC[blk]; zk = zk * EC[blk];
#pragma unroll
        for (int s = 0; s < 2; ++s) { Af[blk][s] = FRAGACC(za, s); Vf[blk][s] = FRAGACC(zv, s); PARK(8 + 2 * blk + s) = FRAGACC(zb, s); PARK(12 + 2 * blk + s) = FRAGACC(zk, s); }
        __builtin_amdgcn_sched_barrier(0);
    }
    f32x16 Aab = f32x16{}, TT = f32x16{}, AakT = f32x16{}, ArbT = f32x16{}, ArkT = f32x16{};
#pragma unroll
    for (int s = 0; s < 4; ++s) { const v4u frs = PARK(4 + s); Aab = MFMA32(fa[s], fb[s], Aab); TT = MFMA32(fb[s], fa[s], TT); AakT = MFMA32(fk[s], fa[s], AakT); ArbT = MFMA32(fb[s], frs, ArbT); ArkT = MFMA32(fk[s], frs, ArkT); }
#pragma unroll
    for (int r = 0; r < 16; ++r) { const int rowi = (r & 3) + 8 * (r >> 2) + 4 * hi;
        Aab[r] = (l31 < rowi) ? Aab[r] : 0.f; TT[r] = (rowi < l31) ? TT[r] : 0.f; AakT[r] = (rowi < l31) ? AakT[r] : 0.f;
        ArbT[r] = (rowi <= l31) ? ArbT[r] : 0.f; ArkT[r] = (rowi <= l31) ? ArkT[r] : 0.f; }
    v4u AakTf[2], ArbTf[2], ArkTf[2];
#pragma unroll
    for (int s = 0; s < 2; ++s) { AakTf[s] = FRAGACC(AakT, s); ArbTf[s] = FRAGACC(ArbT, s); ArkTf[s] = FRAGACC(ArkT, s); }
    __builtin_amdgcn_sched_barrier(0);
    v4u Xf[2], XTf[2], TTf[2];
#pragma unroll
    for (int s = 0; s < 2; ++s) { Xf[s] = FRAGACC(Aab, s); XTf[s] = FRAGACC(TT, s); }
#pragma unroll
    for (int r = 0; r < 16; ++r) { const int rowi = (r & 3) + 8 * (r >> 2) + 4 * hi; TT[r] += (rowi == l31) ? 1.f : 0.f; }
#pragma unroll
    for (int it = 0; it < 4; ++it) {
        f32x16 X2 = MFMA32(XTf[0], Xf[0], f32x16{}); X2 = MFMA32(XTf[1], Xf[1], X2);
        if (it < 3) { f32x16 X2T = MFMA32(Xf[0], XTf[0], f32x16{}); X2T = MFMA32(Xf[1], XTf[1], X2T);
#pragma unroll
            for (int s = 0; s < 2; ++s) XTf[s] = FRAGACC(X2T, s); }
#pragma unroll
        for (int s = 0; s < 2; ++s) { Xf[s] = FRAGACC(X2, s); TTf[s] = FRAGACC(TT, s); }
        TT = MFMA32(Xf[0], TTf[0], TT); TT = MFMA32(Xf[1], TTf[1], TT);
        __builtin_amdgcn_sched_barrier(0);
    }
#pragma unroll
    for (int s = 0; s < 2; ++s) TTf[s] = FRAGACC(TT, s);
    v4u Wf[2][2], Uf[2][2];
#pragma unroll
    for (int blk = 0; blk < 2; ++blk) {
        f32x16 av = MFMA32(AakTf[0], Vf[blk][0], f32x16{}); av = MFMA32(AakTf[1], Vf[blk][1], av);
        const v4u avf0 = FRAGACC(av, 0), avf1 = FRAGACC(av, 1);
        f32x16 uu = MFMA32(TTf[0], avf0, f32x16{}); uu = MFMA32(TTf[1], avf1, uu);
        f32x16 ww = MFMA32(TTf[0], Af[blk][0], f32x16{}); ww = MFMA32(TTf[1], Af[blk][1], ww);
#pragma unroll
        for (int s = 0; s < 2; ++s) { Wf[blk][s] = FRAGACC(ww, s); Uf[blk][s] = FRAGACC(uu, s); }
        __builtin_amdgcn_sched_barrier(0);
    }
    v4u* QFp = Dm.QF + (size_t)u * 256 + lane; v4u* YDp = Dm.YD + (size_t)u * 256 + lane;
#pragma unroll
    for (int blk = 0; blk < 2; ++blk) {
        f32x16 q;
#pragma unroll
        for (int s = 0; s < 2; ++s)
            { const v4u frs = PARK(4 + 2 * blk + s);
#pragma unroll
              for (int j = 0; j < 4; ++j) { q[8 * s + 2 * j] = bflo(frs[j]); q[8 * s + 2 * j + 1] = bfhi(frs[j]); } }
        q = MFMA32(Wf[blk][0], ArbTf[0], q); q = MFMA32(Wf[blk][1], ArbTf[1], q);
        st_wt16(QFp + (2 * blk) * 64, FRAGACC(q, 0)); st_wt16(QFp + (2 * blk + 1) * 64, FRAGACC(q, 1));
        f32x16 y = MFMA32(Uf[blk][0], ArbTf[0], f32x16{}); y = MFMA32(Uf[blk][1], ArbTf[1], y); y = MFMA32(Vf[blk][0], ArkTf[0], y); y = MFMA32(Vf[blk][1], ArkTf[1], y);
        st_wt16(YDp + (2 * blk) * 64, FRAGACC(y, 0)); st_wt16(YDp + (2 * blk + 1) * 64, FRAGACC(y, 1));
        __builtin_amdgcn_sched_barrier(0);
    }
    v4u* PFp = Dm.PF + (size_t)u * 512 + lane; v4u* DDp = Dm.DD + (size_t)u * 512 + lane;
#pragma unroll
    for (int c1 = 0; c1 < 2; ++c1)
#pragma unroll
        for (int cb = 0; cb < 2; ++cb) {
            f32x16 p = MFMA32(Wf[c1][0], PARK(8 + 2 * cb), f32x16{}); p = MFMA32(Wf[c1][1], PARK(8 + 2 * cb + 1), p);
            st_wt16(PFp + (cb * 4 + 2 * c1) * 64, FRAGACC(p, 0)); st_wt16(PFp + (cb * 4 + 2 * c1 + 1) * 64, FRAGACC(p, 1));
            __builtin_amdgcn_sched_barrier(0);
        }
#pragma unroll
    for (int cb = 0; cb < 2; ++cb)
#pragma unroll
        for (int ib = 0; ib < 2; ++ib) {
            f32x16 d = MFMA32(PARK(8 + 2 * cb), Uf[ib][0], f32x16{}); d = MFMA32(PARK(8 + 2 * cb + 1), Uf[ib][1], d); d = MFMA32(PARK(12 + 2 * cb), Vf[ib][0], d); d = MFMA32(PARK(12 + 2 * cb + 1), Vf[ib][1], d);
            st_wt16(DDp + ((cb * 2 + ib) * 2) * 64, FRAGACC(d, 0)); st_wt16(DDp + ((cb * 2 + ib) * 2 + 1) * 64, FRAGACC(d, 1));
            __builtin_amdgcn_sched_barrier(0);
        }
}

#undef PARK
#undef DEP
constexpr int RB_PF = 0, RB_DD = 8192, RB_QF = 16384, RB_YD = 20480, RB_GAM = 24576, RB_BUF = 24832, RB_NB = 4, RB_STAT = RB_NB * RB_BUF, RB_Y = RB_STAT + 1024;
__device__ __forceinline__ void unpack16(const v4u a, const v4u b, f32x16& o) {
#pragma unroll
    for (int j = 0; j < 4; ++j) { o[2 * j] = bflo(a[j]); o[2 * j + 1] = bfhi(a[j]); o[8 + 2 * j] = bflo(b[j]); o[8 + 2 * j + 1] = bfhi(b[j]); }
}
constexpr int RW_SPLIT = T / 32, CW_DONE = 16384;
__device__ __forceinline__ void rw_wait_chunk(Frame& F, int ci) {
    unsigned spins = 0;
#pragma unroll 1
    for (int j = 7; j >= 0; --j) { gu32* c = F.ctl + CW_DONE + 64 * (ci + j);
        while ((unsigned)__builtin_amdgcn_readfirstlane(__hip_atomic_load(c, RLX_AGENT)) < (unsigned)BATCH) { __builtin_amdgcn_s_sleep(8); if (++spins > (1u << 22)) break; } }
    __builtin_amdgcn_fence(__ATOMIC_ACQUIRE, "agent");
}
__device__ __forceinline__ void rw_publish_chunk(Frame& F, int ci) {
    asm volatile("s_waitcnt vmcnt(0)" ::: "memory");
    __syncthreads();
    if (F.wave == 0 && mk_lane() == 0) {
        __hip_atomic_fetch_add(F.ctl + CW_DONE + 64 * ci, 1u, RLX_AGENT);
    }
}
#ifndef RB_AUX
#define RB_AUX 2
#endif
struct RbStage { v4u p[2], d[2], q, y, g; };
struct RbEpi { v4u vc, vp, ga; float rho; };
__device__ __forceinline__ void rwkvB_unit(Frame& F, const RwDump& Dm, int bh) {
    int lane = mk_lane(); asm volatile("" : "+v"(lane));
    const int wid = F.wave, tid = wid * 64 + lane, hi = lane >> 5, l31 = lane & 31, b = bh >> 3, h = bh & 7;
    LAS unsigned char* lds = F.lds + RING_OFF;
    constexpr int NS = T / 32;
    LAS float* stat = (LAS float*)(lds + RB_STAT);
    LAS float* ybuf = (LAS float*)(lds + RB_Y);
    const int stid = tid - 128;
    const bool st_p2 = wid < 4, st_q = wid < 6, st_y = wid >= 4;
#define ST_LOAD(X, ci_) do { { if ((ci_) >= RW_SPLIT && (ci_) < NS && (((ci_) - RW_SPLIT) & 7) == 0) rw_wait_chunk(F, (ci_)); const size_t u_ = (size_t)((ci_) < NS ? (ci_) : NS - 1) * (BATCH * RH) + bh; \
        X.p[0] = __builtin_nontemporal_load((const GAS v4u*)(Dm.PF + u_ * 512 + stid)); X.d[0] = __builtin_nontemporal_load((const GAS v4u*)(Dm.DD + u_ * 512 + stid)); \
        if (st_p2) { X.p[1] = __builtin_nontemporal_load((const GAS v4u*)(Dm.PF + u_ * 512 + 384 + stid)); X.d[1] = __builtin_nontemporal_load((const GAS v4u*)(Dm.DD + u_ * 512 + 384 + stid)); } \
        if (st_q) X.q = __builtin_nontemporal_load((const GAS v4u*)(Dm.QF + u_ * 256 + stid)); \
        if (st_y) X.y = __builtin_nontemporal_load((const GAS v4u*)(Dm.YD + u_ * 256 + (stid - 128))); \
        if (stid < 16) X.g = *(const GAS v4u*)((const v4u*)(Dm.GAM + u_ * 64) + stid); } } while (0)
#define ST_STORE(X, buf_) do { LAS unsigned char* b_ = lds + (buf_) * RB_BUF; \
        *(LAS v4u*)(b_ + RB_PF + stid * 16) = X.p[0]; *(LAS v4u*)(b_ + RB_DD + stid * 16) = X.d[0]; \
        if (st_p2) { *(LAS v4u*)(b_ + RB_PF + (384 + stid) * 16) = X.p[1]; *(LAS v4u*)(b_ + RB_DD + (384 + stid) * 16) = X.d[1]; } \
        if (st_q) *(LAS v4u*)(b_ + RB_QF + stid * 16) = X.q; \
        if (st_y) *(LAS v4u*)(b_ + RB_YD + (stid - 128) * 16) = X.y; \
        if (stid < 16) *(LAS v4u*)(b_ + RB_GAM + stid * 16) = X.g; } while (0)
    const int ew = (wid & 1) + 2 * ((wid >> 2) & 1), eidx = ew * 64 + lane, etok = eidx >> 3, ep = eidx & 7;
    const bf16* epc = F.PROJ + (size_t)b * T * NP + h * 64 + 8 * ep;
#define EP_LOAD(X, cj_) do { { const int cc_ = (cj_) < NS ? (cj_) : NS - 1, tt_ = cc_ * 32 + etok; const bf16* pc_ = epc + (size_t)tt_ * NP; const bf16* pp_ = epc + (size_t)(tt_ > 0 ? tt_ - 1 : 0) * NP; \
        X.vc = *(const GAS v4u*)(pc_ + C_V); X.vp = *(const GAS v4u*)(pp_ + C_V); X.ga = *(const GAS v4u*)(pc_ + C_GA); \
        X.rho = Dm.RHO[((size_t)cc_ * (BATCH * RH) + bh) * 32 + etok]; } } while (0)
#define EP_RUN(X, cj_) do { const int par_ = (cj_) & 1; \
        const float s1_ = stat[((par_ * 2 + 0) * 32 + etok) * 2] + stat[((par_ * 2 + 1) * 32 + etok) * 2], s2_ = stat[((par_ * 2 + 0) * 32 + etok) * 2 + 1] + stat[((par_ * 2 + 1) * 32 + etok) * 2 + 1]; \
        const float mean_ = s1_ * (1.f / 64.f), var_ = fmaxf(s2_ * (1.f / 64.f) - mean_ * mean_, 0.f), rstd_ = __builtin_amdgcn_rsqf(var_ + 64e-5f); \
        const int tt_ = (cj_) * 32 + etok; const size_t mm_ = (size_t)b * T + tt_; const float pm_ = tt_ > 0 ? 1.f : 0.f; \
        const LAS float* yb_ = ybuf + (par_ * 2 + (ep >> 2)) * 1024 + 4 * (ep & 3) * 64 + etok; \
        float o_[8]; \
        _Pragma("unroll") for (int j = 0; j < 8; ++j) { const unsigned vcw_ = X.vc[j >> 1], vpw_ = X.vp[j >> 1], gaw_ = X.ga[j >> 1]; \
            const float vc_ = (j & 1) ? bfhi(vcw_) : bflo(vcw_), vp_ = (j & 1) ? bfhi(vpw_) : bflo(vpw_), g_ = (j & 1) ? bfhi(gaw_) : bflo(gaw_); \
            const float vv_ = vc_ + (vp_ * pm_ - vc_) * emu[j >> 2][j & 3]; \
            const float yn_ = (yb_[(j & 3) * 64 + (j >> 2) * 32] - mean_) * rstd_ * elw[j >> 2][j & 3] + elb[j >> 2][j & 3] + X.rho * vv_; o_[j] = yn_ * g_ * __builtin_amdgcn_rcpf(1.f + __expf(-g_)); } \
        *(GAS v4u*)(F.MIX + mm_ * D + h * 64 + 8 * ep) = (v4u){cvtpk(o_[0], o_[1]), cvtpk(o_[2], o_[3]), cvtpk(o_[4], o_[5]), cvtpk(o_[6], o_[7])}; } while (0)
    f32x16 S[2]; S[0] = f32x16{}; S[1] = f32x16{};
    const int ib = wid & 1;
#define CONS(ci_) do { const LAS unsigned char* bb = lds + ((ci_) & (RB_NB - 1)) * RB_BUF; \
          \
        v4u pf_[8], qf_[4], dd_[4], yd_[2]; f32x4 gm_[8]; \
        _Pragma("unroll") for (int q = 0; q < 8; ++q) gm_[q] = *(const LAS f32x4*)(bb + RB_GAM + (hi * 32 + 4 * q) * 4); \
        _Pragma("unroll") for (int q = 0; q < 4; ++q) dd_[q] = *(const LAS v4u*)(bb + RB_DD + ((((q >> 1) * 2 + ib) * 2 + (q & 1)) * 64 + lane) * 16); \
        _Pragma("unroll") for (int q = 0; q < 8; ++q) pf_[q] = *(const LAS v4u*)(bb + RB_PF + (q * 64 + lane) * 16); \
        _Pragma("unroll") for (int q = 0; q < 2; ++q) yd_[q] = *(const LAS v4u*)(bb + RB_YD + ((2 * ib + q) * 64 + lane) * 16); \
        _Pragma("unroll") for (int q = 0; q < 4; ++q) qf_[q] = *(const LAS v4u*)(bb + RB_QF + (q * 64 + lane) * 16); \
        __builtin_amdgcn_sched_barrier(0); \
        v4u Sf[4]; _Pragma("unroll") for (int s = 0; s < 4; ++s) Sf[s] = FRAGACC(S[s >> 1], s & 1); \
        _Pragma("unroll") for (int rb = 0; rb < 2; ++rb) { \
            f32x16 acc; unpack16(dd_[2 * rb], dd_[2 * rb + 1], acc); \
            _Pragma("unroll") for (int q = 0; q < 4; ++q) { const f32x4 gv = gm_[4 * rb + q]; _Pragma("unroll") for (int e = 0; e < 4; ++e) acc[4 * q + e] += gv[e] * S[rb][4 * q + e]; } \
            _Pragma("unroll") for (int s = 0; s < 4; ++s) acc = MFMA32(pf_[rb * 4 + s], Sf[s], acc); \
            S[rb] = acc; } \
        f32x16 y; unpack16(yd_[0], yd_[1], y); \
        _Pragma("unroll") for (int s = 0; s < 4; ++s) y = MFMA32(Sf[s], qf_[s], y); \
        float s1 = 0.f, s2 = 0.f; LAS float* yb_ = ybuf + (((ci_) & 1) * 2 + ib) * 1024 + lane; \
        _Pragma("unroll") for (int r = 0; r < 16; ++r) { s1 += y[r]; s2 += y[r] * y[r]; yb_[r * 64] = y[r]; } \
        s1 = swap32_sum(s1); s2 = swap32_sum(s2); \
        if (hi == 0) { stat[((((ci_) & 1) * 2 + ib) * 32 + l31) * 2] = s1; stat[((((ci_) & 1) * 2 + ib) * 32 + l31) * 2 + 1] = s2; } } while (0)
#define RB_BAR() do { asm volatile("s_waitcnt lgkmcnt(0)" ::: "memory"); __builtin_amdgcn_s_barrier(); asm volatile("" ::: "memory"); } while (0)
    if (wid < 2) {
        RB_BAR();
#pragma unroll 1
        for (int k = 0; k < NS; ++k) { CONS(k); RB_BAR(); }
        RB_BAR();
    } else if (wid == 4 || wid == 5) {
        const GAS v4u* gA = (const GAS v4u*)(wid == 4 ? Dm.PF : Dm.DD) + lane; const GAS v4u* gB = (const GAS v4u*)(wid == 4 ? Dm.QF : Dm.YD) + lane;
        const int oA = wid == 4 ? RB_PF : RB_DD, oB = wid == 4 ? RB_QF : RB_YD;
#define LD_ISSUE(ci_) do { const size_t u_ = (size_t)((ci_) < NS ? (ci_) : NS - 1) * (BATCH * RH) + bh; LAS unsigned char* b_ = lds + ((ci_) & (RB_NB - 1)) * RB_BUF; \
        _Pragma("unroll") for (int q = 0; q < 8; ++q) __builtin_amdgcn_global_load_lds((const unsigned*)(gA + u_ * 512 + q * 64), (LAS unsigned*)(b_ + oA + q * 1024), 16, 0, RB_AUX); \
        _Pragma("unroll") for (int q = 0; q < 4; ++q) __builtin_amdgcn_global_load_lds((const unsigned*)(gB + u_ * 256 + q * 64), (LAS unsigned*)(b_ + oB + q * 1024), 16, 0, RB_AUX); \
        if (lane < 16) __builtin_amdgcn_global_load_lds((const unsigned*)((const GAS v4u*)(Dm.GAM + u_ * 64) + lane), (LAS unsigned*)(b_ + RB_GAM), 16, 0, 0); } while (0)
        LD_ISSUE(0); LD_ISSUE(1); LD_ISSUE(2);
        asm volatile("s_waitcnt vmcnt(26)" ::: "memory");
        RB_BAR();
#pragma unroll 1
        for (int k = 0; k < NS; ++k) { LD_ISSUE(k + 3); asm volatile("s_waitcnt vmcnt(26)" ::: "memory"); RB_BAR(); }
        asm volatile("s_waitcnt vmcnt(0)" ::: "memory");
        RB_BAR();
#undef LD_ISSUE
    } else {
        RbEpi eA, eB, eC; f32x4 emu[2], elw[2], elb[2];
#pragma unroll
        for (int rg = 0; rg < 2; ++rg) { const int hc_ = h * 64 + 8 * ep + 4 * rg; emu[rg] = *(const GAS f32x4*)(F.shift_mu + 1024 + hc_); elw[rg] = *(const GAS f32x4*)(F.ln_w + hc_); elb[rg] = *(const GAS f32x4*)(F.ln_b + hc_); }
        EP_LOAD(eA, 0); EP_LOAD(eB, 1);
        RB_BAR();
        EP_LOAD(eC, 2); RB_BAR();
#define HY_STEP(k_, EP) do { EP_RUN(EP, (k_) - 1); EP_LOAD(EP, (k_) + 2); RB_BAR(); } while (0)
#pragma unroll 1
        for (int k = 1; k < NS; k += 3) { HY_STEP(k, eA); HY_STEP(k + 1, eB); HY_STEP(k + 2, eC); }
        EP_RUN(eA, NS - 1);
        RB_BAR();
#undef HY_STEP
    }
#undef RB_BAR
#undef ST_LOAD
#undef ST_STORE
#undef EP_LOAD
#undef EP_RUN
#undef CONS
}
constexpr int CW_G17 = 12288;
struct OneUnit { int pm, pn;
    __device__ __forceinline__ bool next(int i, pg8::Unit& u) const { if (i != 0) return false; u.pm = pm; u.pn = pn; return true; }
    __device__ __forceinline__ void a_ready(const pg8::Unit&) const {}
    __device__ __forceinline__ void done(const pg8::Unit&) const {} };
constexpr int AT_OUT = 65536, AT_G0 = 114688, AT_G1 = LDSCTL_OFF + 1024;
constexpr int AT_KB = 64 * 256, AT_VB = 64 * 256, AT_BUF = AT_KB + AT_VB, AT_QOFF = 2 * AT_KB + 3 * AT_VB;
__device__ __forceinline__ s16x4 vtr(const LAS unsigned char* p) { typedef short v4i16_t __attribute__((ext_vector_type(4))); return __builtin_bit_cast(s16x4, __builtin_amdgcn_ds_read_tr16_b64_v4i16((LAS v4i16_t*)p)); }
__device__ __forceinline__ void attn_unit(Frame& F, int b, int h, int qb) {
    int lane = mk_lane(); asm volatile("" : "+v"(lane));
    const int wid = F.wave, tid = wid * 64 + lane, l31 = lane & 31, hi = lane >> 5, map = wid >> 2, qs = wid & 3;
    LAS unsigned char* lds = F.lds + RING_OFF;
    const float slope2 = exp2f(-2.f * (float)(h + 1)) * LOG2E, shift2 = __uint_as_float(F.MISC[15]);
    const int q0 = qb * 128, qrow = q0 + 32 * qs + l31;
    const size_t mrow = (size_t)b * T + qrow;
    LAS bf16x8* qpark = (LAS bf16x8*)(lds + AT_QOFF + wid * 4096) + lane;
    { const bf16* qp = F.PROJ + mrow * NP + C_DQ + h * 128 + map * 64 + 8 * hi;
#pragma unroll
      for (int s = 0; s < 4; ++s) qpark[s * 64] = *(const GAS bf16x8*)(qp + 16 * s); }
    const bf16* kg = F.PROJ + (size_t)b * T * NP + C_DK + h * 128;
    const bf16* vg = F.PROJ + (size_t)b * T * NP + C_DV + h * 128;
    const int NT = 2 * qb + 2, tl = 2 * qb + (qs >> 1);
    const int Wk = (int)__builtin_ceilf((2.f * shift2 + 32.2f) / slope2);
    const int tf = __builtin_amdgcn_readfirstlane(max(0, (qb * 128 - Wk) >> 6));
    constexpr int AT_V0 = 2 * AT_KB;
    const int drow0 = 4 * wid + (lane >> 4), drow1 = drow0 + 32, dch = lane & 15;
    const unsigned ksrc0 = (unsigned)(drow0 * NP + ((dch ^ (drow0 & 15)) * 8)), ksrc1 = (unsigned)(drow1 * NP + ((dch ^ (drow1 & 15)) * 8));
    const unsigned vsrc0 = (unsigned)(drow0 * NP + ((dch ^ ((drow0 & 3) << 2)) * 8)), vsrc1 = (unsigned)(drow1 * NP + ((dch ^ ((drow1 & 3) << 2)) * 8));
#define AT_DMA(t_, kb_, v3_) do { const size_t tb_ = (size_t)(64 * (t_)) * NP; LAS unsigned char* bk_ = lds + (kb_) * AT_KB + wid * 1024; LAS unsigned char* bv_ = lds + AT_V0 + (v3_) * AT_VB + wid * 1024; \
        __builtin_amdgcn_global_load_lds((const unsigned*)(kg + tb_ + ksrc0), (LAS unsigned*)bk_, 16, 0, 0); __builtin_amdgcn_global_load_lds((const unsigned*)(kg + tb_ + ksrc1), (LAS unsigned*)(bk_ + 8192), 16, 0, 0); \
        __builtin_amdgcn_global_load_lds((const unsigned*)(vg + tb_ + vsrc0), (LAS unsigned*)bv_, 16, 0, 0); __builtin_amdgcn_global_load_lds((const unsigned*)(vg + tb_ + vsrc1), (LAS unsigned*)(bv_ + 8192), 16, 0, 0); } while (0)
    f32x16 o[4];
#pragma unroll
    for (int vb = 0; vb < 4; ++vb) o[vb] = f32x16{};
    float lsum = 0.f;
    AT_DMA(tf, tf & 1, tf % 3);
    { const int gr_ = 16 * wid + (lane >> 4); const bf16* gsrc = F.PROJ + ((size_t)b * T + q0 + gr_) * NP + C_GB + h * 128;
      LAS unsigned char* gdst = F.lds + (wid < 4 ? AT_G0 + wid * 4096 : AT_G1 + (wid - 4) * 4096);
#pragma unroll
      for (int j = 0; j < 4; ++j) __builtin_amdgcn_global_load_lds((const unsigned*)(gsrc + (size_t)(4 * j) * NP + (((lane & 15) ^ (4 * j + (lane >> 4))) * 8)), (LAS unsigned*)(gdst + j * 1024), 16, 0, 0); }
    __syncthreads();
    const int G = lane >> 4, qq = (lane & 15) >> 2, pp = lane & 3;
    const int vrow = (4 * hi + qq) * 256 + 8 * (pp & 1), vch = 2 * (G & 1) + (pp >> 1);
    v4u pw[4];
#define SBAR_() __builtin_amdgcn_sched_barrier(0)
#define AT_QK(t) do { \
            const LAS unsigned char* Kb = lds + ((t) & 1) * AT_KB; \
            float sl_ = slope2; asm volatile("" : "+v"(sl_));     \
            const float base = sl_ * (float)(64 * (t) + 4 * hi - qrow) - shift2; \
            float ls = 0.f; \
            _Pragma("unroll") for (int hf = 0; hf < 2; ++hf) {        \
                f32x16 p; \
                _Pragma("unroll") for (int r = 0; r < 16; ++r) p[r] = __builtin_fmaf(sl_, (float)(32 * hf + (r & 3) + 8 * (r >> 2)), base); \
                _Pragma("unroll") for (int s = 0; s < 4; ++s) { \
                    const bf16x8 a0 = *(const LAS bf16x8*)(Kb + (32 * hf + l31) * 256 + (((map * 8 + 2 * s + hi) ^ (l31 & 15)) * 16)); \
                    p = __builtin_amdgcn_mfma_f32_32x32x16_bf16(a0, qpark[s * 64], p, 0, 0, 0); } \
                if ((t) == tl) { \
                    _Pragma("unroll") for (int r = 0; r < 16; ++r) { const int ki = 64 * (t) + 32 * hf + 4 * hi + (r & 3) + 8 * (r >> 2); if (ki > qrow) p[r] = -1e30f; } } \
                _Pragma("unroll") for (int r = 0; r < 16; ++r) { p[r] = __builtin_amdgcn_exp2f(p[r]); ls += p[r]; } \
                pw[2 * hf] = (v4u){cvtpk(p[0], p[1]), cvtpk(p[2], p[3]), cvtpk(p[4], p[5]), cvtpk(p[6], p[7])}; \
                pw[2 * hf + 1] = (v4u){cvtpk(p[8], p[9]), cvtpk(p[10], p[11]), cvtpk(p[12], p[13]), cvtpk(p[14], p[15])}; } \
            lsum += ls; } while (0)
#define AT_VRD(dst, ks, vb0) do { _Pragma("unroll") for (int vb = (vb0); vb < (vb0) + 2; ++vb) { const LAS unsigned char* a_ = Vb + vrow + ((4 * vb + vch) ^ (qq << 2)) * 16 + (32 * ((ks) >> 1) + 16 * ((ks) & 1)) * 256; \
        dst[2 * (vb - (vb0))] = vtr(a_); dst[2 * (vb - (vb0)) + 1] = vtr(a_ + 8 * 256); } } while (0)
#define AT_PV(src, pwk, vb0) do { _Pragma("unroll") for (int vb = (vb0); vb < (vb0) + 2; ++vb) { const int j_ = 2 * (vb - (vb0)); \
        const bf16x8 vf = (bf16x8){src[j_][0], src[j_][1], src[j_][2], src[j_][3], src[j_ + 1][0], src[j_ + 1][1], src[j_ + 1][2], src[j_ + 1][3]}; \
        o[vb] = __builtin_amdgcn_mfma_f32_32x32x16_bf16(vf, __builtin_bit_cast(bf16x8, pwk), o[vb], 0, 0, 0); } } while (0)
#define AT_PVV(v3_) do { const LAS unsigned char* Vb = lds + AT_V0 + (v3_) * AT_VB; s16x4 vA[4], vB[4]; \
            AT_VRD(vA, 0, 0); SBAR_(); AT_VRD(vB, 0, 2); SBAR_(); \
            AT_PV(vA, pw[0], 0); SBAR_(); AT_VRD(vA, 1, 0); SBAR_(); AT_PV(vB, pw[0], 2); SBAR_(); AT_VRD(vB, 1, 2); SBAR_(); \
            AT_PV(vA, pw[1], 0); SBAR_(); AT_VRD(vA, 2, 0); SBAR_(); AT_PV(vB, pw[1], 2); SBAR_(); AT_VRD(vB, 2, 2); SBAR_(); \
            AT_PV(vA, pw[2], 0); SBAR_(); AT_VRD(vA, 3, 0); SBAR_(); AT_PV(vB, pw[2], 2); SBAR_(); AT_VRD(vB, 3, 2); SBAR_(); \
            AT_PV(vA, pw[3], 0); SBAR_(); AT_PV(vB, pw[3], 2); } while (0)
    if (map == 0) {
        int v3 = tf % 3;
#pragma unroll 1
        for (int t = tf; t < NT; ++t) { const int vn = v3 == 2 ? 0 : v3 + 1;
            if (t + 1 < NT) AT_DMA(t + 1, (t + 1) & 1, vn);
            if (t <= tl) { AT_QK(t); AT_PVV(v3); }
            __syncthreads(); v3 = vn; }
    } else {
        int v3 = tf % 3;
#pragma unroll 1
        for (int t = tf; t < NT; ++t) { const int vp = v3 == 0 ? 2 : v3 - 1, vn = v3 == 2 ? 0 : v3 + 1;
            if (t + 1 < NT) AT_DMA(t + 1, (t + 1) & 1, vn);
            if (t > tf && t - 1 <= tl) AT_PVV(vp);
            if (t <= tl) AT_QK(t);
            __syncthreads(); v3 = vn; }
        if (NT - 1 <= tl) { const int vp = v3 == 0 ? 2 : v3 - 1; AT_PVV(vp); }
    }
#undef AT_PVV
#undef AT_QK
#undef AT_VRD
#undef AT_PV
#undef SBAR_
#undef AT_DMA
    __syncthreads();
    const float ltot = swap32_sum(lsum);
    LAS float* X = (LAS float*)lds;
    if (map == 1) {
        const float sc = __uint_as_float(F.MISC[14]) / ltot;
#pragma unroll
        for (int vb = 0; vb < 4; ++vb)
#pragma unroll
            for (int r = 0; r < 16; ++r) X[(qs * 64 + vb * 16 + r) * 64 + lane] = o[vb][r] * sc;
    }
    __syncthreads();
    if (map == 0) {
        const float il = 1.f / ltot; float ss = 0.f;
#pragma unroll
        for (int vb = 0; vb < 4; ++vb)
#pragma unroll
            for (int r = 0; r < 16; ++r) { const float v = o[vb][r] * il - X[(qs * 64 + vb * 16 + r) * 64 + lane]; o[vb][r] = v; ss += v * v; }
        ss = swap32_sum(ss);
        const float rn = (1.f / sqrtf(ss * (1.f / 128.f) + 1e-5f)) * (1.f - LAMBDA_INIT);
        int etok = 0; asm volatile("" : "+v"(etok));
        const int lane_e = mk_lane(), hi = lane_e >> 5, row = 32 * qs + (lane_e & 31);
        const LAS unsigned char* grow = F.lds + (qs < 2 ? AT_G0 : AT_G1 - 64 * 256) + row * 256 + 8 * hi;
        LAS unsigned char* orow = lds + AT_OUT + row * 256 + 8 * hi;
#pragma unroll
        for (int vb = 0; vb < 4; ++vb)
#pragma unroll
            for (int rg = 0; rg < 4; ++rg) {
                const int vc = 32 * vb + 8 * rg + 4 * hi, ch = (((4 * vb + rg) ^ (row & 15)) * 16) + etok;
                const v2u gw = *(const LAS v2u*)(grow + ch); const f32x4 sg = *(const GAS f32x4*)(F.subln_g + vc);
                const float g4[4] = {bflo(gw.x), bfhi(gw.x), bflo(gw.y), bfhi(gw.y)}; float ov[4];
#pragma unroll
                for (int e = 0; e < 4; ++e) ov[e] = o[vb][4 * rg + e] * rn * sg[e] * g4[e] / (1.f + __expf(-g4[e]));
                const unsigned w1_ = cvtpk(ov[2], ov[3]);
                *(LAS v2u*)(orow + ch) = (v2u){cvtpk(ov[0], ov[1]), w1_};
                if (rg == 3) asm volatile("" : "+v"(etok) : "v"(w1_));
            }
    }
    __syncthreads();
    { const int t_ = wid * 64 + mk_lane(); bf16* ob = F.MIX + ((size_t)b * T + q0) * D + 512 + h * 128;
#pragma unroll
      for (int i = 0; i < 4; ++i) { const int pc = t_ + 512 * i, r_ = pc >> 4, c_ = pc & 15;
          *(GAS v4u*)(ob + (size_t)r_ * D + c_ * 8) = *(const LAS v4u*)(lds + AT_OUT + r_ * 256 + ((c_ ^ (r_ & 15)) * 16)); } }
    __syncthreads();
}
#ifndef DBL
#define DBL 0
#endif
constexpr int CW_QUEUE = 8192;
constexpr int QX_RW = 8, QX_A2 = 0, QX_AT = 64, QX_ALL = QX_RW + QX_A2 + QX_AT;
template <int MODE = 0> __device__ __forceinline__ void p3_queue(Frame& F, const RwDump& Dm, const int qbase = CW_QUEUE) {
    const int ql = mk_lane();
    const float l1 = wave_sum(F.lq1[ql] * F.lk1[ql]), l2 = wave_sum(F.lq2[ql] * F.lk2[ql]);
    const float lam = __uint_as_float(__builtin_amdgcn_readfirstlane(__float_as_uint(__expf(l1) - __expf(l2) + LAMBDA_INIT)));
    float gq = fabsf(F.qn_g[ql]), gk = fabsf(F.kn_g[ql]);
#pragma unroll
    for (int o = 1; o < 64; o <<= 1) { gq = fmaxf(gq, __shfl_xor(gq, o)); gk = fmaxf(gk, __shfl_xor(gk, o)); }
    const float shift2 = __uint_as_float(__builtin_amdgcn_readfirstlane(__float_as_uint(8.f * gq * gk * LOG2E)));
    if (F.wave == 0 && mk_lane() == 0) { F.MISC[14] = __float_as_uint(lam); F.MISC[15] = __float_as_uint(shift2); }
    __syncthreads();
#ifdef Q_BLK
    const int x0 = (int)(blockIdx.x & 7);
#else
    const int x0 = (int)(xb_xcc_id() & 7u);
#endif
#pragma unroll 1
    for (int dx = 0; dx < 8; ++dx) {
        const int xq = (x0 + dx) & 7;
        for (;;) {
            if (F.wave == 0 && mk_lane() == 0) F.MISC[12] = __hip_atomic_fetch_add(F.ctl + qbase + 64 * xq, 1u, RLX_AGENT);
            __syncthreads();
            int item = __builtin_amdgcn_readfirstlane((int)F.MISC[12]); if (MODE == 2) item += QX_RW;
            __syncthreads();
            if (item >= (MODE == 1 ? QX_RW : QX_ALL)) break;
            if (item < QX_RW) { rwkvB_unit(F, Dm, xq * 8 + item); if (DBL & 64) rwkvB_unit(F, Dm, xq * 8 + item); }
            else { const int idx = item - QX_RW - QX_A2, h = 3 - (idx >> 4), qb = 15 - (idx & 15);
#pragma unroll 1
#ifndef NO_ATT
                for (int rep = 0; rep < ((DBL & 32) ? 2 : 1); ++rep) attn_unit(F, xq, h, qb);
#endif
            }
        }
    }
}

struct Args { const float* in[21]; float* out; unsigned char* ws; int ph_lo, ph_hi; };
__global__ void __launch_bounds__(NWAVES * 64, 2) hymba_fwd(Args args) {
    extern __shared__ __attribute__((aligned(16))) unsigned char lds[];
    Frame F;
    F.lds = (LAS unsigned char*)lds;
    F.MISC = (volatile LAS unsigned*)(F.lds + MISC_OFF);
    F.wave = __builtin_amdgcn_readfirstlane((int)threadIdx.x >> 6); F.lane = mk_lane(); F.tid = F.wave * 64 + F.lane;
    F.G = gridDim.x; { const int bx = blockIdx.x; F.vcu = (F.G % 8 == 0) ? (bx % 8) * (F.G / 8) + bx / 8 : bx; }
    unsigned char* ws = args.ws;
    F.ctl = (gu32*)(ws + WS_CTL);
    F.x = args.in[0]; F.norm_g = args.in[1]; F.w_in = args.in[2]; F.shift_mu = args.in[3]; F.w0 = args.in[4]; F.w_decay_up = args.in[5]; F.a0 = args.in[6]; F.w_iclr_up = args.in[7];
    F.k_k = args.in[8]; F.k_a = args.in[9]; F.r_k = args.in[10]; F.ln_w = args.in[11]; F.ln_b = args.in[12]; F.qn_g = args.in[13]; F.kn_g = args.in[14];
    F.lq1 = args.in[15]; F.lk1 = args.in[16]; F.lq2 = args.in[17]; F.lk2 = args.in[18]; F.subln_g = args.in[19]; F.w_out = args.in[20]; F.out = args.out;
    F.WinT = (bf16*)(ws + WS_WIN); F.WoutT = (bf16*)(ws + WS_WOUT); F.WdT = (bf16*)(ws + WS_WD); F.WaT = (bf16*)(ws + WS_WA);
    F.XN = (bf16*)(ws + WS_XN); F.PROJ = (bf16*)(ws + WS_PROJ); F.MIX = (bf16*)(ws + WS_MIX);
    for (int u = F.tid; u < (LDS_BYTES - LDSCTL_OFF) / 4; u += NWAVES * 64) ((LAS unsigned*)(F.lds + LDSCTL_OFF))[u] = 0u;
    __syncthreads();
    XcdBarrier bar; bar.bar = (unsigned*)(F.ctl + CW_BAR); bar.x = 0; bar.st = nullptr; bar.wave = F.wave;
    if (MK_N_LAUNCHES == 1) bar = xcd_barrier_post((unsigned*)(F.ctl + CW_BAR), F.MISC + 8, F.wave);
#define GRID_BAR() do { if (MK_N_LAUNCHES == 1) xcd_barrier(bar); } while (0)
    const int lo = args.ph_lo, hi = args.ph_hi;
#define IN(k) (lo <= (k) && (k) < hi)
#define BOTH(k) (IN(k) && IN((k) + 1))
#ifndef SKIP
#define SKIP 0
#endif
    if (IN(0) && !(SKIP & 1)) { p0_prologue(F); if (DBL & 1) { GRID_BAR(); p0_prologue(F); } if (BOTH(0)) GRID_BAR(); }
    if (IN(1) && !(SKIP & 2)) {
        pg8::Gemm g{F.XN, F.WinT, M, NP, D}; pg8::StaticOrder S; S.init(M, NP, F.G, (int)blockIdx.x);
        pg8::EpiBf16S E{F.PROJ, NP};
        pg8::gemm_phase<pg8::EpiBf16S, pg8::StaticOrder, true, true>(F.lds + RING_OFF, g, S, E, F.wave);
        if (DBL & 2) { GRID_BAR(); pg8::gemm_phase<pg8::EpiBf16S, pg8::StaticOrder, true, true>(F.lds + RING_OFF, g, S, E, F.wave); }
        if (BOTH(1)) GRID_BAR();
    }
    RwDump Dm; { unsigned char* so = (unsigned char*)args.out; Dm.PF = (v4u*)so; Dm.DD = (v4u*)(so + 32 * MiB); Dm.QF = (v4u*)(ws + WS_XN); Dm.YD = (v4u*)(ws + WS_XN + 16 * MiB);
        Dm.GAM = (float*)(ws + WS_END); Dm.RHO = (float*)(ws + WS_END + 1 * MiB); }
    if (IN(2) && !(SKIP & 4)) {
        LAS float* wscr = (LAS float*)(F.lds + LDSCTL_OFF + 1024) + F.wave * 64; int zpar = 0;
#pragma unroll 1
        for (int p = F.vcu; p < BATCH * (T / 32); p += F.G) { rwkvA_unit(F, Dm, (p >> 6) * RH + F.wave, p & 63, wscr, F.lds + RING_OFF + F.wave * 16384, (LAS v4u*)(F.lds + LDSCTL_OFF + 4096), zpar); zpar ^= 1; }
        if (DBL & 4) { GRID_BAR();
#pragma unroll 1
            for (int p = F.vcu; p < BATCH * (T / 32); p += F.G) { rwkvA_unit(F, Dm, (p >> 6) * RH + F.wave, p & 63, wscr, F.lds + RING_OFF + F.wave * 16384, (LAS v4u*)(F.lds + LDSCTL_OFF + 4096), zpar); zpar ^= 1; } }
        p2_qknorm(F);
        if (BOTH(2)) GRID_BAR();
    }
    if (IN(3) && !(SKIP & 8)) {
#ifdef P3SPLIT
        p3_queue<1>(F, Dm); GRID_BAR(); p3_queue<2>(F, Dm, CW_QUEUE + 1024);
#else
        p3_queue(F, Dm);
#endif
        if (DBL & 512) { GRID_BAR(); p3_queue(F, Dm, CW_QUEUE + 1024); }
        if (BOTH(3)) GRID_BAR();
    }
    if (IN(4) && !(SKIP & 16)) {
        pg8::Gemm g{F.MIX, F.WoutT, M, D, D}; pg8::StaticOrder S; S.init(M, D, F.G, (int)blockIdx.x);
        pg8::EpiResF32 E{F.x, F.out, D};
        pg8::gemm_phase<pg8::EpiResF32, pg8::StaticOrder, false, true>(F.lds + RING_OFF, g, S, E, F.wave);
        if (DBL & 16) { GRID_BAR(); pg8::gemm_phase<pg8::EpiResF32, pg8::StaticOrder, false, true>(F.lds + RING_OFF, g, S, E, F.wave); }
    }
#undef IN
#undef BOTH
}

extern "C" void kernel_launch(void* const* d_in, const int* in_sizes, int n_in, void* d_out, int out_size, void* d_ws, size_t ws_size, hipStream_t stream) {
    static int grid = 0;
    if (grid == 0) {
        if (n_in != 21 || in_sizes[0] != M * D || out_size != M * D || ws_size < WS_END + 2 * MiB) { fprintf(stderr, "kernel_launch: unexpected shapes (n_in %d, in0 %d, out %d, ws %zu); nothing launched\n", n_in, n_in > 0 ? in_sizes[0] : -1, out_size, ws_size); grid = -1; return; }
        int dev = 0, cus = 0, per_cu = 0;
        if (hipGetDevice(&dev) != hipSuccess || hipDeviceGetAttribute(&cus, hipDeviceAttributeMultiprocessorCount, dev) != hipSuccess) { grid = -1; return; }
        if (hipFuncSetAttribute((const void*)hymba_fwd, hipFuncAttributeMaxDynamicSharedMemorySize, LDS_BYTES) != hipSuccess) { fprintf(stderr, "kernel_launch: hipFuncSetAttribute failed\n"); grid = -1; return; }
        if (hipOccupancyMaxActiveBlocksPerMultiprocessor(&per_cu, (const void*)hymba_fwd, NWAVES * 64, LDS_BYTES) != hipSuccess || per_cu < 1) { fprintf(stderr, "kernel_launch: occupancy query reports %d workgroups per CU; nothing launched\n", per_cu); grid = -1; return; }
        (void)hipGetLastError();
        grid = cus;
        if (grid > 256) grid = 256;
    }
    if (grid < 0) return;
    if (hipMemsetAsync((char*)d_ws + WS_CTL, 0, CTL_ZERO_BYTES, stream) != hipSuccess) { fprintf(stderr, "kernel_launch: hipMemsetAsync failed\n"); return; }
    Args a{};
    for (int i = 0; i < 21; ++i) a.in[i] = (const float*)d_in[i];
    a.out = (float*)d_out; a.ws = (unsigned char*)d_ws;
    for (int li = 0; li < MK_N_LAUNCHES; ++li) {
        a.ph_lo = (MK_N_LAUNCHES == 1) ? 0 : li; a.ph_hi = (MK_N_LAUNCHES == 1) ? N_PHASES : li + 1;
        hipLaunchKernelGGL(hymba_fwd, dim3(grid), dim3(NWAVES * 64), LDS_BYTES, stream, a);
        const hipError_t le = hipPeekAtLastError();
        if (le != hipSuccess) { fprintf(stderr, "kernel_launch: launch %d failed: %s\n", li, hipGetErrorName(le)); break; }
    }
}
```

```cpp
#include <hip/hip_runtime.h>
#include <hip/hip_bf16.h>
#include <cstdio>
#include <cstdint>
#include <cmath>
namespace pg8 {
#define PG8_LAS __attribute__((address_space(3)))
typedef unsigned short bf16_t;
typedef short bf16x8 __attribute__((ext_vector_type(8)));
typedef float f32x4 __attribute__((ext_vector_type(4)));
typedef unsigned u32x4 __attribute__((ext_vector_type(4)));
constexpr int BM = 256, BK = 64, HALF = 128, HTB = HALF * BK * 2  , STAGE_BYTES = 8 * HTB, NXCD = 8, WGM = 8;

__host__ __device__ __forceinline__ int lds_byte(int r, int c) { const int st = (r >> 4) * 2 + (c >> 5), rr = r & 15, cc = c & 31, ob = rr * 64 + cc * 2; return st * 1024 + (ob ^ (((ob >> 9) & 1) << 5)); }
__host__ __device__ __forceinline__ void stage_rc(int b, int& R, int& C) { const int st = b / 1024, sb = b % 1024, swz = sb ^ (((sb >> 9) & 1) << 5); R = (st >> 1) * 16 + swz / 64; C = (st & 1) * 32 + (swz % 64) / 2; }
__host__ __device__ __forceinline__ int perm32(int rho) { const int n = rho >> 4, i = rho & 15; return 8 * (i >> 2) + 4 * n + (i & 3); }

__device__ __forceinline__ int mk_lane_pg8() { int l; asm volatile("v_mbcnt_lo_u32_b32 %0, -1, 0\n\tv_mbcnt_hi_u32_b32 %0, -1, %0" : "=v"(l)); return l; }
struct Unit { int pm, pn; };
struct Gemm { const bf16_t* A; const bf16_t* Bt; int M, N, K; };

struct StaticOrder {
    int nM, nN, nwg, G, c;
    __host__ __device__ void init(int M, int N, int G_, int c_) { nM = M / BM; nN = N / BM; nwg = nM * nN; G = G_; c = c_; }
    __host__ __device__ bool next(int i, Unit& u) const {
        const long L = (long)i * G + c; if (L >= nwg) return false;
        int wgid = (int)L; { const int q = nwg / NXCD, r = nwg % NXCD, xcd = wgid % NXCD, off = wgid / NXCD; wgid = (xcd < r ? xcd * (q + 1) : r * (q + 1) + (xcd - r) * q) + off; }
        const int nig = WGM * nN, gid = wgid / nig, fm = gid * WGM, gsz = (nM - fm) < WGM ? (nM - fm) : WGM;
        u.pm = fm + ((wgid % nig) % gsz); u.pn = (wgid % nig) / gsz; return true;
    }
    __device__ __forceinline__ void a_ready(const Unit&) const {}
    __device__ __forceinline__ void done(const Unit&) const {}
};

__device__ __forceinline__ unsigned cvt_pk_bf16(float lo, float hi) { unsigned r; asm volatile("v_cvt_pk_bf16_f32 %0, %1, %2" : "=v"(r) : "v"(lo), "v"(hi)); return r; }
struct EpiBf16S {
    static constexpr bool PERM = true, AFTER_DRAIN = false, HAS_INIT = false;
    bf16_t* O; int ldc;
    __device__ __forceinline__ void operator()(const f32x4 (&acc)[2][2][4][2], const Unit& u, int wr, int wc, int fr, int fq) const {
        const int row0 = u.pm * BM + wr * 64 + fr, col0 = u.pn * BM + wc * 32 + 8 * fq;
#pragma unroll
        for (int ai = 0; ai < 2; ++ai)
#pragma unroll
            for (int m = 0; m < 4; ++m) { bf16_t* rowp = O + (size_t)(row0 + ai * HALF + m * 16) * ldc + col0;
#pragma unroll
                for (int bj = 0; bj < 2; ++bj) { const f32x4 v0 = acc[ai][bj][m][0], v1 = acc[ai][bj][m][1];
                    u32x4 w; w.x = cvt_pk_bf16(v0[0], v0[1]); w.y = cvt_pk_bf16(v0[2], v0[3]); w.z = cvt_pk_bf16(v1[0], v1[1]); w.w = cvt_pk_bf16(v1[2], v1[3]);
                    *(u32x4*)(rowp + bj * HALF) = w; } }
    }
};
struct EpiResF32 {
    static constexpr bool PERM = false, AFTER_DRAIN = false, HAS_INIT = true;
    const float* base; float* out; int ldc;
    __device__ __forceinline__ void init(f32x4 (&acc)[2][2][4][2], const Unit& u, int wr, int wc, int fr, int fq) const {
        const int row0 = u.pm * BM + wr * 64 + fr, col0 = u.pn * BM + wc * 32 + 4 * fq;
#pragma unroll
        for (int ai = 0; ai < 2; ++ai)
#pragma unroll
            for (int m = 0; m < 4; ++m) { const size_t off = (size_t)(row0 + ai * HALF + m * 16) * ldc + col0;
#pragma unroll
                for (int bj = 0; bj < 2; ++bj)
#pragma unroll
                    for (int n = 0; n < 2; ++n) acc[ai][bj][m][n] = *(const f32x4*)(base + off + bj * HALF + n * 16); }
    }
    __device__ __forceinline__ void operator()(const f32x4 (&acc)[2][2][4][2], const Unit& u, int wr, int wc, int fr, int fq) const {
        const int row0 = u.pm * BM + wr * 64 + fr, col0 = u.pn * BM + wc * 32 + 4 * fq;
#pragma unroll
        for (int ai = 0; ai < 2; ++ai)
#pragma unroll
            for (int m = 0; m < 4; ++m) { const size_t off = (size_t)(row0 + ai * HALF + m * 16) * ldc + col0;
#pragma unroll
                for (int bj = 0; bj < 2; ++bj)
#pragma unroll
                    for (int n = 0; n < 2; ++n) *(f32x4*)(out + off + bj * HALF + n * 16) = acc[ai][bj][m][n]; }
    }
};
template <class Epi, class Sched, bool ALIGN_EPI = false, bool SP2 = false>
__device__ __forceinline__ void gemm_phase(PG8_LAS unsigned char* lds, const Gemm g, const Sched& S, const Epi& E, const int mk_wave_id  ) {
    const int wid = mk_wave_id, lane = mk_lane_pg8(), tid = wid * 64 + lane, wr = wid >> 2, wc = wid & 3, fr = lane & 15, fq = lane >> 4;
    const int K = g.K, nt = K / BK;
    unsigned voffA[2], voffB[2];
#pragma unroll
    for (int i = 0; i < 2; ++i) { int R, C; stage_rc(tid * 16 + i * 8192, R, C); const int Rb = Epi::PERM ? ((R & ~31) + perm32(R & 31)) : R;
        voffA[i] = (unsigned)(R * K + C) * 2u; voffB[i] = (unsigned)(Rb * K + C) * 2u; }
    const size_t kstep = (size_t)(BK * 2);
    const size_t hstep = (size_t)HALF * K * 2;
    const size_t tstep = 2 * hstep;
    const unsigned ldsw = (unsigned)wid * 1024u;
    const int aoff = lds_byte(wr * 64 + fr, fq * 8), boff = lds_byte(wc * 32 + fr, fq * 8);
#define PG8_SA(b, h) (((b) * 2 + (h)) * HTB)
#define PG8_SB(b, h) ((4 + (b) * 2 + (h)) * HTB)
#define PG8_STAGE(bufoff, gbase, voff) do { _Pragma("unroll") for (int _i = 0; _i < 2; ++_i) \
        __builtin_amdgcn_global_load_lds((const unsigned*)((const char*)(gbase) + (voff)[_i]), (PG8_LAS unsigned*)(lds + (bufoff) + ldsw + _i * 8192), 16, 0, 0); } while (0)
#define PG8_LDA(dst, b, h) do { _Pragma("unroll") for (int m = 0; m < 4; ++m) _Pragma("unroll") for (int k = 0; k < 2; ++k) dst[m][k] = *(const PG8_LAS bf16x8*)(lds + PG8_SA(b, h) + aoff + m * 2048 + k * 1024); } while (0)
#define PG8_LDB(dst, b, h) do { _Pragma("unroll") for (int n = 0; n < 2; ++n) _Pragma("unroll") for (int k = 0; k < 2; ++k) dst[n][k] = *(const PG8_LAS bf16x8*)(lds + PG8_SB(b, h) + boff + n * 2048 + k * 1024); } while (0)
#define PG8_MMA(ai, bj, At, Bt) do { __builtin_amdgcn_s_setprio(1); _Pragma("unroll") for (int m = 0; m < 4; ++m) _Pragma("unroll") for (int n = 0; n < 2; ++n) _Pragma("unroll") for (int k = 0; k < 2; ++k) \
        acc[ai][bj][m][n] = __builtin_amdgcn_mfma_f32_16x16x32_bf16(Bt[n][k], At[m][k], acc[ai][bj][m][n], 0, 0, 0); __builtin_amdgcn_s_setprio(0); } while (0)
#define PG8_WAIT_V(n) asm volatile("s_waitcnt vmcnt(" #n ")" ::: "memory")
#define PG8_WAIT_L(n) asm volatile("s_waitcnt lgkmcnt(" #n ")" ::: "memory")
#define PG8_BAR __builtin_amdgcn_s_barrier()
#define PG8_SCHED __builtin_amdgcn_sched_barrier(0)
    Unit cur, nxt; int ui = 0;
    if (!S.next(0, cur)) return;
    f32x4 acc[2][2][4][2];
#pragma unroll
    for (int a = 0; a < 2; ++a)
#pragma unroll
        for (int b = 0; b < 2; ++b)
#pragma unroll
            for (int m = 0; m < 4; ++m)
#pragma unroll
                for (int n = 0; n < 2; ++n) acc[a][b][m][n] = (f32x4){0.f, 0.f, 0.f, 0.f};
    if constexpr (Epi::HAS_INIT) E.init(acc, cur, wr, wc, fr, fq);
    bf16x8 At[4][2], B0[2][2], B1[2][2];
    const char* cA = (const char*)g.A + (size_t)cur.pm * tstep; const char* cB = (const char*)g.Bt + (size_t)cur.pn * tstep;
    S.a_ready(cur);
    if constexpr (SP2) {
        PG8_STAGE(PG8_SB(0, 0), cB, voffB); PG8_STAGE(PG8_SB(0, 1), cB + hstep, voffB); PG8_STAGE(PG8_SA(0, 0), cA, voffA); PG8_STAGE(PG8_SA(0, 1), cA + hstep, voffA);
        if (wr == 1) PG8_BAR;
        PG8_WAIT_V(2); PG8_BAR;
        PG8_STAGE(PG8_SB(1, 0), cB + kstep, voffB); PG8_STAGE(PG8_SA(1, 0), cA + kstep, voffA); PG8_STAGE(PG8_SB(1, 1), cB + hstep + kstep, voffB);
        PG8_WAIT_V(6); PG8_BAR;
    } else {
        PG8_STAGE(PG8_SB(0, 0), cB, voffB); PG8_STAGE(PG8_SA(0, 0), cA, voffA); PG8_STAGE(PG8_SB(0, 1), cB + hstep, voffB); PG8_STAGE(PG8_SA(0, 1), cA + hstep, voffA);
        if (wr == 1) PG8_BAR;
        PG8_WAIT_V(4); PG8_BAR;
        PG8_STAGE(PG8_SB(1, 0), cB + kstep, voffB); PG8_STAGE(PG8_SA(1, 0), cA + kstep, voffA); PG8_STAGE(PG8_SB(1, 1), cB + hstep + kstep, voffB);
        PG8_WAIT_V(6); PG8_BAR;
    }
    for (;;) {
        const bool has_next = S.next(ui + 1, nxt);
        const char* nA = has_next ? (const char*)g.A + (size_t)nxt.pm * tstep : cA; const char* nB = has_next ? (const char*)g.Bt + (size_t)nxt.pn * tstep : cB;
        for (int t = 0; t < nt; t += 2) {
            const bool last = (t == nt - 2);
            const char* a1 = cA + (size_t)(t + 1) * kstep;
            const char* a2 = last ? nA : cA + (size_t)(t + 2) * kstep; const char* b2 = last ? nB : cB + (size_t)(t + 2) * kstep;
            const char* a3 = a2 + kstep; const char* b3 = b2 + kstep;
            if (last && has_next) S.a_ready(nxt);
            if constexpr (SP2) {
            PG8_LDB(B0, 0, 0); PG8_LDB(B1, 0, 1); PG8_SCHED; PG8_LDA(At, 0, 0); PG8_STAGE(PG8_SA(1, 1), a1 + hstep, voffA);
            PG8_WAIT_V(8); PG8_WAIT_L(0); PG8_BAR; PG8_MMA(0, 0, At, B0); PG8_MMA(0, 1, At, B1); PG8_BAR; PG8_SCHED;
            PG8_LDA(At, 0, 1); PG8_STAGE(PG8_SB(0, 0), b2, voffB); PG8_STAGE(PG8_SB(0, 1), b2 + hstep, voffB); PG8_STAGE(PG8_SA(0, 0), a2, voffA);
            PG8_WAIT_V(8); PG8_WAIT_L(0); PG8_BAR; PG8_MMA(1, 0, At, B0); PG8_MMA(1, 1, At, B1); PG8_BAR; PG8_SCHED;
            PG8_LDB(B0, 1, 0); PG8_LDB(B1, 1, 1); PG8_SCHED; PG8_LDA(At, 1, 0); PG8_STAGE(PG8_SA(0, 1), a2 + hstep, voffA);
            PG8_WAIT_V(8); PG8_WAIT_L(0); PG8_BAR; PG8_MMA(0, 0, At, B0); PG8_MMA(0, 1, At, B1); PG8_BAR; PG8_SCHED;
            PG8_LDA(At, 1, 1); PG8_STAGE(PG8_SB(1, 0), b3, voffB); PG8_STAGE(PG8_SB(1, 1), b3 + hstep, voffB); PG8_STAGE(PG8_SA(1, 0), a3, voffA);
            PG8_WAIT_V(8); PG8_WAIT_L(0); PG8_BAR; PG8_MMA(1, 0, At, B0); PG8_MMA(1, 1, At, B1); PG8_BAR; PG8_SCHED;
            } else {
            PG8_LDB(B0, 0, 0); PG8_SCHED; PG8_LDA(At, 0, 0); PG8_STAGE(PG8_SA(1, 1), a1 + hstep, voffA);
            PG8_WAIT_L(8); PG8_BAR; PG8_WAIT_L(0); PG8_MMA(0, 0, At, B0); PG8_BAR; PG8_SCHED;
            PG8_LDB(B1, 0, 1); PG8_STAGE(PG8_SB(0, 0), b2, voffB);
            PG8_BAR; PG8_WAIT_L(0); PG8_MMA(0, 1, At, B1); PG8_BAR;
            PG8_LDA(At, 0, 1); PG8_STAGE(PG8_SA(0, 0), a2, voffA);
            PG8_BAR; PG8_WAIT_L(0); PG8_MMA(1, 0, At, B0); PG8_BAR; PG8_SCHED;
            PG8_STAGE(PG8_SB(0, 1), b2 + hstep, voffB);
            PG8_WAIT_V(6); PG8_BAR; PG8_MMA(1, 1, At, B1); PG8_BAR;
            PG8_LDB(B0, 1, 0); PG8_SCHED; PG8_LDA(At, 1, 0); PG8_STAGE(PG8_SA(0, 1), a2 + hstep, voffA);
            PG8_WAIT_L(8); PG8_BAR; PG8_WAIT_L(0); PG8_MMA(0, 0, At, B0); PG8_BAR; PG8_SCHED;
            PG8_LDB(B1, 1, 1); PG8_STAGE(PG8_SB(1, 0), b3, voffB);
            PG8_BAR; PG8_WAIT_L(0); PG8_MMA(0, 1, At, B1); PG8_BAR;
            PG8_LDA(At, 1, 1); PG8_STAGE(PG8_SA(1, 0), a3, voffA);
            PG8_BAR; PG8_WAIT_L(0); PG8_MMA(1, 0, At, B0); PG8_BAR; PG8_SCHED;
            PG8_STAGE(PG8_SB(1, 1), b3 + hstep, voffB);
            PG8_WAIT_V(6); PG8_BAR; PG8_MMA(1, 1, At, B1); PG8_BAR;
            }
        }
        if constexpr (ALIGN_EPI) { if (wr == 0) PG8_BAR; }
        if constexpr (!Epi::AFTER_DRAIN) { E(acc, cur, wr, wc, fr, fq); S.done(cur); }
        if (!has_next) break;
#pragma unroll
        for (int a = 0; a < 2; ++a)
#pragma unroll
            for (int b = 0; b < 2; ++b)
#pragma unroll
                for (int m = 0; m < 4; ++m)
#pragma unroll
                    for (int n = 0; n < 2; ++n) acc[a][b][m][n] = (f32x4){0.f, 0.f, 0.f, 0.f};
        if constexpr (Epi::HAS_INIT) E.init(acc, nxt, wr, wc, fr, fq);
        cur = nxt; cA = nA; cB = nB; ++ui;
        if constexpr (ALIGN_EPI) { if (wr == 1) PG8_BAR; }
    }
    PG8_WAIT_V(0);
    if constexpr (!ALIGN_EPI) { if (wr == 0) PG8_BAR; }
    PG8_BAR;
    if constexpr (Epi::AFTER_DRAIN) { E.fused(acc, cur, wr, wc, fr, fq, lds, wid, lane); S.done(cur); }
#undef PG8_SA
#undef PG8_SB
#undef PG8_STAGE
#undef PG8_LDA
#undef PG8_LDB
#undef PG8_MMA
#undef PG8_WAIT_V
#undef PG8_WAIT_L
#undef PG8_BAR
#undef PG8_SCHED
}
}
constexpr int NWAVES = 8;
#ifndef MK_N_LAUNCHES
#define MK_N_LAUNCHES 1
#endif
constexpr int N_PHASES = 5;
constexpr int BATCH = 8, T = 2048, D = 1024, M = BATCH * T;
constexpr int NP = 4352;
constexpr int C_R = 0, C_K = 512, C_V = 1024, C_ZW = 1536, C_ZA = 1600, C_GA = 1792, C_DQ = 2304, C_DK = 2816, C_DV = 3328, C_GB = 3840;
constexpr int RH = 8, RN = 64;
constexpr int AH = 4;
constexpr float C2 = 0.125f * 1.4426950408889634f;
constexpr float LOG2E = 1.4426950408889634f;
constexpr float LAMBDA_INIT = 0.2f;

constexpr size_t MiB = 1u << 20;
constexpr size_t WS_CTL = 0, CTL_ZERO_BYTES = 1 * MiB;
constexpr size_t WS_WIN = 2 * MiB;
constexpr size_t WS_WOUT = 11 * MiB;
constexpr size_t WS_WD = 13 * MiB, WS_WA = 13 * MiB + 65536;
constexpr size_t WS_RHO = 13 * MiB + 2 * 65536;
constexpr size_t WS_XN = 14 * MiB;
constexpr size_t WS_PROJ = 46 * MiB;
constexpr size_t WS_MIX = 182 * MiB;
constexpr size_t WS_END = 214 * MiB;
constexpr int CW_BAR = 4096;

constexpr int RING_OFF = 0, RING_BYTES = 131072;
constexpr int LDSCTL_OFF = RING_BYTES, MISC_OFF = LDSCTL_OFF + 320;
constexpr int LDS_BYTES = 155648;

#define GAS __attribute__((address_space(1)))
#define LAS __attribute__((address_space(3)))
typedef unsigned short bf16;
typedef unsigned v4u __attribute__((ext_vector_type(4)));
typedef unsigned v2u __attribute__((ext_vector_type(2)));
typedef float f32x4 __attribute__((ext_vector_type(4)));
typedef float f32x16 __attribute__((ext_vector_type(16)));
typedef short bf16x8 __attribute__((ext_vector_type(8)));
typedef short s16x4 __attribute__((ext_vector_type(4)));
typedef GAS unsigned gu32;
typedef GAS unsigned long long gu64;
#define RLX_AGENT __ATOMIC_RELAXED, __HIP_MEMORY_SCOPE_AGENT
#define LDS_WAIT() asm volatile("s_waitcnt lgkmcnt(0)" ::: "memory")
#define VM_WAIT() asm volatile("s_waitcnt vmcnt(0)" ::: "memory")
__device__ __forceinline__ unsigned f2bf(float f) { unsigned u = __builtin_bit_cast(unsigned, f); return (u + 0x7fffu + ((u >> 16) & 1u)) >> 16; }
__device__ __forceinline__ unsigned pk2(float lo, float hi) { return f2bf(lo) | (f2bf(hi) << 16); }
__device__ __forceinline__ float bflo(unsigned u) { return __uint_as_float(u << 16); }
__device__ __forceinline__ float bfhi(unsigned u) { return __uint_as_float(u & 0xffff0000u); }
__device__ __forceinline__ float bf1(unsigned short u) { return __uint_as_float((unsigned)u << 16); }
__device__ __forceinline__ int mk_lane() { int l; asm volatile("v_mbcnt_lo_u32_b32 %0, -1, 0\n\tv_mbcnt_hi_u32_b32 %0, -1, %0" : "=v"(l)); return l; }
#define XB_TMO      128
#define XB_XCNT(j)  (256  + 64 * (j))
#define XB_XSUB(j)  (1280 + 64 * (j))
#define XB_XGEN(j)  (2304 + 64 * (j))
#define XB_TOP      3328
#define XB_TOPGEN   3392
#define XCD_BAR_WORDS 3456
#define XB_SPIN_CAP (1u << 18)

__device__ __forceinline__ unsigned xb_ld(unsigned* p)              { return __hip_atomic_load(p, __ATOMIC_RELAXED, __HIP_MEMORY_SCOPE_AGENT); }
__device__ __forceinline__ unsigned xb_add(unsigned* p, unsigned v) { return __hip_atomic_fetch_add(p, v, __ATOMIC_RELAXED, __HIP_MEMORY_SCOPE_AGENT); }
__device__ __forceinline__ unsigned xb_xcc_id() { return (unsigned)__builtin_amdgcn_s_getreg((3 << 11) | 20) & 0xFu; }
#define XB_SPIN(cond, bar) do { unsigned _sp = 0; while (cond) { __builtin_amdgcn_s_sleep(1); \
    if ((++_sp & 255u) == 0u) { if (xb_ld(&(bar)[XB_TMO])) break; if (_sp > XB_SPIN_CAP) { atomicAdd(&(bar)[XB_TMO], 1u); break; } } } } while (0)

struct XcdBarrier {
    unsigned* bar; unsigned x;
    volatile LAS unsigned* st;
    int wave;
};

__device__ __forceinline__ XcdBarrier xcd_barrier_post(unsigned* bar, volatile LAS unsigned* st, int wave) {
    XcdBarrier b; b.bar = bar; b.x = xb_xcc_id(); b.st = st; b.wave = wave;
    if (wave == 0 && mk_lane() == 0) (void)xb_add(&bar[XB_XCNT(b.x)], 1u);
    return b;
}
__device__ __forceinline__ void xcd_barrier_complete(unsigned* bar, unsigned x, unsigned& nloc, unsigned& nx) {
    const unsigned G = gridDim.x * gridDim.y * gridDim.z;
    unsigned sum, cnt, mine, sp = 0u;
    for (;;) {
        sum = 0u; cnt = 0u; mine = 0u;
#pragma unroll
        for (unsigned j = 0; j < 16; ++j) { const unsigned c = xb_ld(&bar[XB_XCNT(j)]); sum += c; cnt += (c > 0u) ? 1u : 0u; mine = (j == x) ? c : mine; }
        if (sum == G) break;
        __builtin_amdgcn_s_sleep(1);
        if ((++sp & 255u) == 0u) { if (xb_ld(&bar[XB_TMO])) break; if (sp > XB_SPIN_CAP) { atomicAdd(&bar[XB_TMO], 1u); break; } }
    }
    nloc = mine > 0u ? mine : 1u; nx = cnt > 0u ? cnt : 1u;
}

__device__ __forceinline__ void xcd_barrier(const XcdBarrier& b) {
    asm volatile("s_waitcnt vmcnt(0)" ::: "memory");
    __syncthreads();
    if (b.wave == 0 && mk_lane() == 0) {
        unsigned* bar = b.bar;
        __builtin_amdgcn_s_waitcnt(0);
        unsigned nloc = b.st[0], nx = b.st[1];
        if (nloc == 0u) { xcd_barrier_complete(bar, b.x, nloc, nx); b.st[0] = nloc; b.st[1] = nx; }
        const unsigned old = xb_add(&bar[XB_XSUB(b.x)], 1u);
        const unsigned gen = old / nloc;
        if (old + 1u == (gen + 1u) * nloc) {
            __builtin_amdgcn_fence(__ATOMIC_RELEASE, "agent");
            asm volatile("s_waitcnt vmcnt(0)" ::: "memory");
            const unsigned og = xb_add(&bar[XB_TOP], 1u);
            const unsigned tg = og / nx;
            if (og + 1u == (tg + 1u) * nx) xb_add(&bar[XB_TOPGEN], 1u);
            else XB_SPIN(xb_ld(&bar[XB_TOPGEN]) == tg, bar);
            __builtin_amdgcn_fence(__ATOMIC_ACQUIRE, "agent");
            xb_add(&bar[XB_XGEN(b.x)], 1u);
            asm volatile("s_waitcnt vmcnt(0)" ::: "memory");
        } else {
            XB_SPIN(xb_ld(&bar[XB_XGEN(b.x)]) == gen, bar);
            __builtin_amdgcn_fence(__ATOMIC_ACQUIRE, "agent");
            asm volatile("s_waitcnt vmcnt(0)" ::: "memory");
        }
    }
    __syncthreads();
}
struct Frame {
    LAS unsigned char* lds;
    volatile LAS unsigned* MISC;
    gu32* ctl;
    int tid, lane, wave;
    int vcu, G;
    const float* x; float* out;
    const float *norm_g, *w_in, *shift_mu, *w0, *w_decay_up, *a0, *w_iclr_up, *k_k, *k_a, *r_k, *ln_w, *ln_b, *qn_g, *kn_g, *lq1, *lk1, *lq2, *lk2, *subln_g, *w_out;
    bf16 *WinT, *WoutT, *WdT, *WaT, *XN, *PROJ, *MIX;
};

typedef float f32x2q_t __attribute__((ext_vector_type(2))); typedef __bf16 bf16x2q_t __attribute__((ext_vector_type(2)));
__device__ __forceinline__ unsigned cvtpk2(float lo, float hi) { f32x2q_t v = {lo, hi}; bf16x2q_t b = __builtin_convertvector(v, bf16x2q_t); return __builtin_bit_cast(unsigned, b); }
__device__ __forceinline__ float wave_sum(float v) {
#pragma unroll
    for (int o = 1; o < 64; o <<= 1) v += __shfl_xor(v, o);
    return v;
}
template <int CTRL> __device__ __forceinline__ float dpp_f(float x) { return __builtin_bit_cast(float, __builtin_amdgcn_mov_dpp(__builtin_bit_cast(int, x), CTRL, 0xf, 0xf, true)); }
__device__ __forceinline__ float row16_sum(float x) {
    x += dpp_f<0xB1>(x); x += dpp_f<0x4E>(x); x += dpp_f<0x141>(x); x += dpp_f<0x140>(x); return x;
}
__device__ __forceinline__ float swap32_sum(float x) {
    auto rr = __builtin_amdgcn_permlane32_swap(__float_as_uint(x), __float_as_uint(x), false, false);
    return __uint_as_float(rr[0]) + __uint_as_float(rr[1]);
}

__device__ __forceinline__ void p0_transpose_item(const float* W, int N, int nsrc, const float* kscale, bf16* WT, int K, int ndst, LAS float* scr, int k0, int lane) {
    float v[32];
#pragma unroll
    for (int i = 0; i < 32; ++i) { const int kk = 2 * i + (lane >> 5); v[i] = (nsrc >= 0) ? W[(size_t)(k0 + kk) * N + nsrc + (lane & 31)] : 0.f; }
    if (kscale && nsrc >= 0) {
#pragma unroll
        for (int i = 0; i < 32; ++i) v[i] *= kscale[k0 + 2 * i + (lane >> 5)];
    }
#pragma unroll
    for (int i = 0; i < 32; ++i) scr[(2 * i + (lane >> 5)) * 33 + (lane & 31)] = v[i];
    LDS_WAIT(); asm volatile("" ::: "memory");
    const int c = lane & 7;
#pragma unroll
    for (int j = 0; j < 4; ++j) { const int n = (lane >> 3) + 8 * j; const LAS float* s = scr + (8 * c) * 33 + n;
        v4u o; o.x = cvtpk2(s[0 * 33], s[1 * 33]); o.y = cvtpk2(s[2 * 33], s[3 * 33]); o.z = cvtpk2(s[4 * 33], s[5 * 33]); o.w = cvtpk2(s[6 * 33], s[7 * 33]);
        *(GAS v4u*)(WT + (size_t)(ndst + n) * K + k0 + 8 * c) = o; }
    LDS_WAIT(); asm volatile("" ::: "memory");
}
__device__ __forceinline__ void p0_rows4(Frame& F, int m0) {
    f32x4 v[4][4]; float s[4];
#pragma unroll
    for (int u = 0; u < 4; ++u) { const GAS f32x4* xr = (const GAS f32x4*)(F.x + (size_t)(m0 + u) * D) + F.lane;
#pragma unroll
        for (int j = 0; j < 4; ++j) v[u][j] = __builtin_nontemporal_load(xr + 64 * j); }
#pragma unroll
    for (int u = 0; u < 4; ++u) { float a = 0.f;
#pragma unroll
        for (int j = 0; j < 4; ++j) a += (v[u][j].x * v[u][j].x + v[u][j].y * v[u][j].y) + (v[u][j].z * v[u][j].z + v[u][j].w * v[u][j].w);
        s[u] = a; }
#pragma unroll
    for (int u = 0; u < 4; ++u) {
        const float rstd = __builtin_amdgcn_rsqf(wave_sum(s[u]) * (1.f / D) + 1e-6f);
        GAS unsigned long long* o8 = (GAS unsigned long long*)(F.XN + (size_t)(m0 + u) * D) + F.lane;
#pragma unroll
        for (int j = 0; j < 4; ++j) o8[64 * j] = (unsigned long long)cvtpk2(v[u][j].x * rstd, v[u][j].y * rstd) | ((unsigned long long)cvtpk2(v[u][j].z * rstd, v[u][j].w * rstd) << 32);
    }
}
__device__ __forceinline__ void p0_prologue(Frame& F) {
    LAS float* scr = (LAS float*)(F.lds + RING_OFF + F.wave * 16384);
    const int gw = F.vcu * NWAVES + F.wave, NGW = F.G * NWAVES;
    constexpr int I_IN = (D / 64) * (NP / 32), I_OUT = (D / 64) * (D / 32), I_L = 512 / 32;
    constexpr int NITEMS = I_IN + I_OUT + 2 * I_L;
    int m0 = gw * 4;
    if (!(gw & 1) && m0 < M) { p0_rows4(F, m0); m0 += NGW * 4; }
#pragma unroll 1
    for (int it = gw; it < NITEMS; it += NGW) {
        int r = it;
        if (r < I_IN) { const int kb = r / (NP / 32), nb = r % (NP / 32), nd = 32 * nb; const int ns = nd < 1664 ? nd : (nd < 1792 ? -1 : nd - 128);
            p0_transpose_item(F.w_in, 4224, ns, F.norm_g, F.WinT, D, nd, scr, 64 * kb, F.lane); continue; } r -= I_IN;
        if (r < I_OUT) { const int kb = r / (D / 32), nb = r % (D / 32);
            p0_transpose_item(F.w_out, D, 32 * nb, nullptr, F.WoutT, D, 32 * nb, scr, 64 * kb, F.lane); continue; } r -= I_OUT;
        if (r < I_L) { p0_transpose_item(F.w_decay_up, 512, 32 * r, nullptr, F.WdT, 64, 32 * r, scr, 0, F.lane); continue; } r -= I_L;
        p0_transpose_item(F.w_iclr_up, 512, 32 * r, nullptr, F.WaT, 64, 32 * r, scr, 0, F.lane);
    }
#pragma unroll 1
    for (; m0 < M; m0 += NGW * 4) p0_rows4(F, m0);
}

__device__ __forceinline__ float tanh_f(float x) { const float e = __expf(-2.f * fabsf(x)); const float t = (1.f - e) * __builtin_amdgcn_rcpf(1.f + e); return x < 0.f ? -t : t; }
__device__ __forceinline__ void shifted8(const bf16* proj, size_t m, bool has_prev, int col, const float* mu, float (&o)[8]) {
    const v4u c = *(const GAS v4u*)(proj + m * NP + col);
    v4u p = (v4u){0u, 0u, 0u, 0u}; if (has_prev) p = *(const GAS v4u*)(proj + (m - 1) * NP + col);
    const f32x4 m0 = *(const GAS f32x4*)(mu), m1 = *(const GAS f32x4*)(mu + 4);
    const unsigned cw[4] = {c.x, c.y, c.z, c.w}, pw[4] = {p.x, p.y, p.z, p.w}; const float mm[8] = {m0.x, m0.y, m0.z, m0.w, m1.x, m1.y, m1.z, m1.w};
#pragma unroll
    for (int j = 0; j < 4; ++j) { const float c0 = bflo(cw[j]), c1 = bfhi(cw[j]), p0 = bflo(pw[j]), p1 = bfhi(pw[j]);
        o[2 * j] = c0 + (p0 - c0) * mm[2 * j]; o[2 * j + 1] = c1 + (p1 - c1) * mm[2 * j + 1]; }
}
__device__ __forceinline__ void shifted4(const bf16* proj, size_t m, bool has_prev, int col, const float* mu, float (&o)[4]) {
    const v2u c = *(const GAS v2u*)(proj + m * NP + col);
    v2u p = (v2u){0u, 0u}; if (has_prev) p = *(const GAS v2u*)(proj + (m - 1) * NP + col);
    const f32x4 m0 = *(const GAS f32x4*)(mu);
    o[0] = bflo(c.x) + (bflo(p.x) - bflo(c.x)) * m0.x; o[1] = bfhi(c.x) + (bfhi(p.x) - bfhi(c.x)) * m0.y;
    o[2] = bflo(c.y) + (bflo(p.y) - bflo(c.y)) * m0.z; o[3] = bfhi(c.y) + (bfhi(p.y) - bfhi(c.y)) * m0.w;
}
__device__ __forceinline__ void p2_qknorm(Frame& F) {
    const int gw = F.vcu * NWAVES + F.wave, NGW = F.G * NWAVES, lane = F.lane, sub = lane & 7;
    const f32x4 gk0 = *(const GAS f32x4*)(F.kn_g + sub * 8), gk1 = *(const GAS f32x4*)(F.kn_g + sub * 8 + 4);
    constexpr int UQ = 4;
    for (int it0 = gw * UQ; it0 < M; it0 += NGW * UQ) {
        bf16* p[UQ]; v4u c[UQ];
#pragma unroll
        for (int u = 0; u < UQ; ++u) { const size_t m = (size_t)(it0 + u); p[u] = F.PROJ + m * NP + C_DK + (lane >> 3) * 64 + sub * 8; c[u] = *(const GAS v4u*)p[u]; }
#pragma unroll
        for (int u = 0; u < UQ; ++u) {
            const unsigned cw[4] = {c[u].x, c[u].y, c[u].z, c[u].w};
            float xv[8]; float ss = 0.f;
#pragma unroll
            for (int j = 0; j < 4; ++j) { xv[2 * j] = bflo(cw[j]); xv[2 * j + 1] = bfhi(cw[j]); ss += xv[2 * j] * xv[2 * j] + xv[2 * j + 1] * xv[2 * j + 1]; }
            ss += dpp_f<0xB1>(ss); ss += dpp_f<0x4E>(ss); ss += dpp_f<0x141>(ss);
            const float r = __builtin_amdgcn_rsqf(ss * (1.f / 64.f) + 1e-6f);
            v4u o; o.x = cvtpk2(xv[0] * r * gk0.x, xv[1] * r * gk0.y); o.y = cvtpk2(xv[2] * r * gk0.z, xv[3] * r * gk0.w); o.z = cvtpk2(xv[4] * r * gk1.x, xv[5] * r * gk1.y); o.w = cvtpk2(xv[6] * r * gk1.z, xv[7] * r * gk1.w);
            *(GAS v4u*)p[u] = o;
        }
    }
}
typedef float f32x2_t __attribute__((ext_vector_type(2))); typedef __bf16 bf16x2_t __attribute__((ext_vector_type(2)));
__device__ __forceinline__ unsigned cvtpk(float lo, float hi) { f32x2_t v = {lo, hi}; bf16x2_t b = __builtin_convertvector(v, bf16x2_t); return __builtin_bit_cast(unsigned, b); }
#define MFMA32(a, b, c) __builtin_amdgcn_mfma_f32_32x32x16_bf16(__builtin_bit_cast(bf16x8, (a)), __builtin_bit_cast(bf16x8, (b)), (c), 0, 0, 0)
#define FRAGACC(z, s) ((v4u){cvtpk((z)[8 * (s)], (z)[8 * (s) + 1]), cvtpk((z)[8 * (s) + 2], (z)[8 * (s) + 3]), cvtpk((z)[8 * (s) + 4], (z)[8 * (s) + 5]), cvtpk((z)[8 * (s) + 6], (z)[8 * (s) + 7])})
template <int CTRL, int RM> __device__ __forceinline__ float dpp_upd0(float x) { return __builtin_bit_cast(float, __builtin_amdgcn_update_dpp(0, __builtin_bit_cast(int, x), CTRL, RM, 0xf, false)); }
__device__ __forceinline__ float scan32(float x) {
    x += dpp_upd0<0x111, 0xf>(x); x += dpp_upd0<0x112, 0xf>(x); x += dpp_upd0<0x114, 0xf>(x); x += dpp_upd0<0x118, 0xf>(x); x += dpp_upd0<0x142, 0xa>(x); return x;
}
__device__ __forceinline__ void st_wt16(v4u* p, const v4u v) { *(GAS v4u*)p = v; }
constexpr int RW_UNITS = BATCH * RH * (T / 32);
struct RwDump { v4u* PF; v4u* DD; v4u* QF; v4u* YD; float* GAM; float* RHO; };

__device__ __forceinline__ void rwkvA_unit(Frame& F, const RwDump& Dm, int bh, int ci, LAS float* wscr, LAS unsigned char* park, LAS v4u* zsh, int zpar) {
    int lane = mk_lane(); asm volatile("" : "+v"(lane));
    const int hi = lane >> 5, l31 = lane & 31, b = bh >> 3, w = bh & 7;
    LAS v4u* pk = (LAS v4u*)park + lane;
#define PARK(slot) pk[(slot) * 64]
    int tok = 0; asm volatile("" : "+v"(tok));
#define DEP(x) asm volatile("" : "+v"(tok) : "v"(x))
    const int t = ci * 32 + l31; const size_t m = (size_t)b * T + t; const bool hp = t > 0;
    const int u = ci * (BATCH * RH) + bh;
    const float pm = hp ? 1.f : 0.f;
    const bf16* pc = F.PROJ + m * NP + w * 64 + 4 * hi; const bf16* pp = F.PROJ + (hp ? m - 1 : m) * NP + w * 64 + 4 * hi;
    const float* mu = F.shift_mu + w * 64 + 4 * hi;
    const float *pw0 = F.w0 + w * 64 + 4 * hi, *pa0 = F.a0 + w * 64 + 4 * hi, *pkk = F.k_k + w * 64 + 4 * hi, *pka = F.k_a + w * 64 + 4 * hi, *prk = F.r_k + w * 64 + 4 * hi;
#define SH4(dst, COL, MU, OFF) do { const v2u c_ = *(const GAS v2u*)(pc + tok + (COL) + (OFF)), p_ = *(const GAS v2u*)(pp + tok + (COL) + (OFF)); const f32x4 m_ = *(const GAS f32x4*)(mu + tok + (MU) + (OFF)); \
        dst[0] = bflo(c_.x) + (bflo(p_.x) * pm - bflo(c_.x)) * m_.x; dst[1] = bfhi(c_.x) + (bfhi(p_.x) * pm - bfhi(c_.x)) * m_.y; \
        dst[2] = bflo(c_.y) + (bflo(p_.y) * pm - bflo(c_.y)) * m_.z; dst[3] = bfhi(c_.y) + (bfhi(p_.y) * pm - bfhi(c_.y)) * m_.w; } while (0)
    float ss = 0.f;
#pragma unroll
    for (int gq = 0; gq < 8; ++gq) { float k4[4]; SH4(k4, C_K, 512, 8 * gq); const f32x4 kkp = *(const GAS f32x4*)(pkk + tok + 8 * gq);
#pragma unroll
        for (int e = 0; e < 4; ++e) { const float q = k4[e] * kkp[e]; ss += q * q; }
        if (gq == 3) DEP(ss); }
    ss = swap32_sum(ss);
    const float inv = __builtin_amdgcn_rcpf(fmaxf(__builtin_amdgcn_sqrtf(ss), 1e-12f));
    asm volatile("" ::: "memory");
    v4u bz[4], ba[4];
    { const int s = F.wave >> 1; const bool which = (F.wave & 1) != 0;
      const bf16* zc = F.PROJ + m * NP + 8 * hi; const bf16* zp = F.PROJ + (hp ? m - 1 : m) * NP + 8 * hi; const float* zmu = F.shift_mu + 8 * hi;
      const int COL = (which ? C_ZA : C_ZW) + 16 * s, MUO = (which ? 1600 : 1536) + 16 * s;
      const v4u c = *(const GAS v4u*)(zc + tok + COL), p = *(const GAS v4u*)(zp + tok + COL); const f32x4 m0 = *(const GAS f32x4*)(zmu + tok + MUO), m1 = *(const GAS f32x4*)(zmu + tok + MUO + 4);
      float z[8];
#pragma unroll
      for (int j = 0; j < 4; ++j) { const float c0 = bflo(c[j]), c1 = bfhi(c[j]); const float mm0 = j < 2 ? m0[2 * j] : m1[2 * j - 4], mm1 = j < 2 ? m0[2 * j + 1] : m1[2 * j - 3];
          z[2 * j] = c0 + (bflo(p[j]) * pm - c0) * mm0; z[2 * j + 1] = c1 + (bfhi(p[j]) * pm - c1) * mm1; }
      if (!which) {
#pragma unroll
          for (int j = 0; j < 8; ++j) z[j] = tanh_f(z[j]); }
      LAS v4u* zs = zsh + zpar * 512;
      zs[((which ? 4 : 0) + s) * 64 + lane] = (v4u){cvtpk(z[0], z[1]), cvtpk(z[2], z[3]), cvtpk(z[4], z[5]), cvtpk(z[6], z[7])};
      __syncthreads();
#pragma unroll
      for (int q = 0; q < 4; ++q) { bz[q] = zs[q * 64 + lane]; ba[q] = zs[(4 + q) * 64 + lane]; }
      DEP(bz[3][3]); DEP(ba[3][3]); }
    asm volatile("" ::: "memory");
    v4u fa[4], fb[4], fk[4], fr[4], fv[4]; float rho = 0.f;
    float* gp = Dm.GAM + (size_t)u * 64 + hi * 32;
#define RW_LORA(cb) f32x16 accd = f32x16{}, acca = f32x16{}; _Pragma("unroll") for (int s = 0; s < 4; ++s) { \
        const v4u aD = *(const GAS v4u*)(F.WdT + tok + (size_t)(w * 64 + (cb) * 32 + l31) * 64 + 16 * s + 8 * hi); accd = MFMA32(aD, bz[s], accd); \
        const v4u aA = *(const GAS v4u*)(F.WaT + tok + (size_t)(w * 64 + (cb) * 32 + l31) * 64 + 16 * s + 8 * hi); acca = MFMA32(aA, ba[s], acca); }
    struct RwGL { v2u rc, rp, kc, kp, vc, vp; } gA, gB;
#define RW_LOADG(X, OFF) do { X.rc = *(const GAS v2u*)(pc + tok + C_R + (OFF)); X.rp = *(const GAS v2u*)(pp + tok + C_R + (OFF)); X.kc = *(const GAS v2u*)(pc + tok + C_K + (OFF)); X.kp = *(const GAS v2u*)(pp + tok + C_K + (OFF)); \
        X.vc = *(const GAS v2u*)(pc + tok + C_V + (OFF)); X.vp = *(const GAS v2u*)(pp + tok + C_V + (OFF)); } while (0)
#define RW_LERP(dst, c_, p_, m_) do { dst[0] = bflo(c_.x) + (bflo(p_.x) * pm - bflo(c_.x)) * m_.x; dst[1] = bfhi(c_.x) + (bfhi(p_.x) * pm - bfhi(c_.x)) * m_.y; \
        dst[2] = bflo(c_.y) + (bflo(p_.y) * pm - bflo(c_.y)) * m_.z; dst[3] = bfhi(c_.y) + (bfhi(p_.y) * pm - bfhi(c_.y)) * m_.w; } while (0)
#define RW_GROUP(cb, rg, CUR, NXT, HASN) do { constexpr int OFF = 32 * (cb) + 8 * (rg); const int ch0 = OFF + 4 * hi; \
            if (HASN) RW_LOADG(NXT, OFF + 8); \
            float rr[4], kk4[4], vv[4]; \
            const f32x4 mr_ = *(const GAS f32x4*)(mu + tok + OFF), mk_ = *(const GAS f32x4*)(mu + tok + 512 + OFF), mv_ = *(const GAS f32x4*)(mu + tok + 1024 + OFF); \
            const f32x4 w0v = *(const GAS f32x4*)(pw0 + tok + OFF), a0v = *(const GAS f32x4*)(pa0 + tok + OFF), kkp = *(const GAS f32x4*)(pkk + tok + OFF), kap = *(const GAS f32x4*)(pka + tok + OFF), rkp = *(const GAS f32x4*)(prk + tok + OFF); \
            RW_LERP(rr, CUR.rc, CUR.rp, mr_); RW_LERP(kk4, CUR.kc, CUR.kp, mk_); RW_LERP(vv, CUR.vc, CUR.vp, mv_); \
            float xa[4], xb[4], xk[4], xr[4], gg[4], ge[4]; \
            _Pragma("unroll") for (int e = 0; e < 4; ++e) { \
                const float nx = -(w0v[e] + accd[4 * (rg) + e]); const float sp = fmaxf(nx, 0.f) + __logf(1.f + __expf(-fabsf(nx))); \
                const float l2 = -__expf(-sp - 0.5f) * LOG2E; \
                const float g = scan32(l2); \
                const float a = __builtin_amdgcn_rcpf(1.f + __expf(-(a0v[e] + acca[4 * (rg) + e]))); \
                const float kk = kk4[e] * kkp[e] * inv; \
                const float kt = kk4[e] * (1.f + (a - 1.f) * kap[e]); \
                rho += rr[e] * kt * rkp[e]; \
                const float eg = __builtin_amdgcn_exp2f(g), egp = __builtin_amdgcn_exp2f(g - l2), eng = __builtin_amdgcn_rcpf(eg); \
                xa[e] = -kk * egp; xb[e] = kk * a * eng; xk[e] = kt * eng; xr[e] = rr[e] * eg; gg[e] = g; ge[e] = eg; } \
            if (l31 == 31) { *(LAS f32x4*)(wscr + ch0) = (f32x4){gg[0], gg[1], gg[2], gg[3]}; st_wt16((v4u*)(gp + (cb) * 16 + 4 * (rg)), (v4u){__float_as_uint(ge[0]), __float_as_uint(ge[1]), __float_as_uint(ge[2]), __float_as_uint(ge[3])}); } \
            constexpr int s_ = 2 * (cb) + ((rg) >> 1), vg = 2 * ((rg) & 1); \
            fa[s_][vg] = cvtpk(xa[0], xa[1]); fa[s_][vg + 1] = cvtpk(xa[2], xa[3]); \
            fb[s_][vg] = cvtpk(xb[0], xb[1]); fb[s_][vg + 1] = cvtpk(xb[2], xb[3]); \
            fk[s_][vg] = cvtpk(xk[0], xk[1]); fk[s_][vg + 1] = cvtpk(xk[2], xk[3]); \
            fr[s_][vg] = cvtpk(xr[0], xr[1]); fr[s_][vg + 1] = cvtpk(xr[2], xr[3]); \
            fv[s_][vg] = cvtpk(vv[0], vv[1]); fv[s_][vg + 1] = cvtpk(vv[2], vv[3]); \
            if (((rg) & 1) == 1) { PARK(s_) = fv[s_]; PARK(4 + s_) = fr[s_]; } \
            DEP(fa[s_][vg + 1]); DEP(fb[s_][vg + 1]); DEP(fk[s_][vg + 1]); DEP(fr[s_][vg + 1]); DEP(fv[s_][vg + 1]); DEP(rho); } while (0)
    RW_LOADG(gA, 0);
    { RW_LORA(0) RW_GROUP(0, 0, gA, gB, true); RW_GROUP(0, 1, gB, gA, true); RW_GROUP(0, 2, gA, gB, true); RW_GROUP(0, 3, gB, gA, true); }
    { RW_LORA(1) RW_GROUP(1, 0, gA, gB, true); RW_GROUP(1, 1, gB, gA, true); RW_GROUP(1, 2, gA, gB, true); RW_GROUP(1, 3, gB, gA, false); }
#undef RW_LOADG
#undef RW_LERP
#undef RW_LORA
#undef RW_GROUP
#undef SH4
    LDS_WAIT(); asm volatile("" ::: "memory");
    float EC[2]; EC[0] = __builtin_amdgcn_exp2f(wscr[l31]); EC[1] = __builtin_amdgcn_exp2f(wscr[32 + l31]);
    LDS_WAIT(); asm volatile("" ::: "memory");
    rho = swap32_sum(rho);
    if (hi == 0) __hip_atomic_store((gu32*)(Dm.RHO + (size_t)u * 32 + l31), __float_as_uint(rho), RLX_AGENT);
    v4u idf[2];
    { const int jst = 4 * ((l31 >> 3) & 1) + (l31 & 3); const bool hm = ((l31 >> 2) & 1) == hi; const unsigned one = 0x3F80u << (16 * (jst & 1));
#pragma unroll
      for (int sig = 0; sig < 2; ++sig) { const bool on = hm && ((l31 >> 4) == sig);
#pragma unroll
          for (int q = 0; q < 4; ++q) idf[sig][q] = (on && (jst >> 1) == q) ? one : 0u; } }
    LDS_WAIT();
    v4u Af[2][2], Vf[2][2];
#pragma unroll
    for (int blk = 0; blk < 2; ++blk) {
        f32x16 za = MFMA32(fa[2 * blk], idf[0], f32x16{}); za = MFMA32(fa[2 * blk + 1], idf[1], za);
        f32x16 zv = MFMA32(PARK(2 * blk), idf[0], f32x16{}); zv = MFMA32(PARK(2 * blk + 1), idf[1], zv);
        f32x16 zb = MFMA32(fb[2 * blk], idf[0], f32x16{}); zb = MFMA32(fb[2 * blk + 1], idf[1], zb);
        f32x16 zk = MFMA32(fk[2 * blk], idf[0], f32x16{}); zk = MFMA32(fk[2 * blk + 1], idf[1], zk);
        zb = zb * EC[blk]; zk = zk * EC[blk];
#pragma unroll
        for (int s = 0; s < 2; ++s) { Af[blk][s] = FRAGACC(za, s); Vf[blk][s] = FRAGACC(zv, s); PARK(8 + 2 * blk + s) = FRAGACC(zb, s); PARK(12 + 2 * blk + s) = FRAGACC(zk, s); }
        __builtin_amdgcn_sched_barrier(0);
    }
    f32x16 Aab = f32x16{}, TT = f32x16{}, AakT = f32x16{}, ArbT = f32x16{}, ArkT = f32x16{};
#pragma unroll
    for (int s = 0; s < 4; ++s) { const v4u frs = PARK(4 + s); Aab = MFMA32(fa[s], fb[s], Aab); TT = MFMA32(fb[s], fa[s], TT); AakT = MFMA32(fk[s], fa[s], AakT); ArbT = MFMA32(fb[s], frs, ArbT); ArkT = MFMA32(fk[s], frs, ArkT); }
#pragma unroll
    for (int r = 0; r < 16; ++r) { const int rowi = (r & 3) + 8 * (r >> 2) + 4 * hi;
        Aab[r] = (l31 < rowi) ? Aab[r] : 0.f; TT[r] = (rowi < l31) ? TT[r] : 0.f; AakT[r] = (rowi < l31) ? AakT[r] : 0.f;
        ArbT[r] = (rowi <= l31) ? ArbT[r] : 0.f; ArkT[r] = (rowi <= l31) ? ArkT[r] : 0.f; }
    v4u AakTf[2], ArbTf[2], ArkTf[2];
#pragma unroll
    for (int s = 0; s < 2; ++s) { AakTf[s] = FRAGACC(AakT, s); ArbTf[s] = FRAGACC(ArbT, s); ArkTf[s] = FRAGACC(ArkT, s); }
    __builtin_amdgcn_sched_barrier(0);
    v4u Xf[2], XTf[2], TTf[2];
#pragma unroll
    for (int s = 0; s < 2; ++s) { Xf[s] = FRAGACC(Aab, s); XTf[s] = FRAGACC(TT, s); }
#pragma unroll
    for (int r = 0; r < 16; ++r) { const int rowi = (r & 3) + 8 * (r >> 2) + 4 * hi; TT[r] += (rowi == l31) ? 1.f : 0.f; }
#pragma unroll
    for (int it = 0; it < 4; ++it) {
        f32x16 X2 = MFMA32(XTf[0], Xf[0], f32x16{}); X2 = MFMA32(XTf[1], Xf[1], X2);
        if (it < 3) { f32x16 X2T = MFMA32(Xf[0], XTf[0], f32x16{}); X2T = MFMA32(Xf[1], XTf[1], X2T);
#pragma unroll
            for (int s = 0; s < 2; ++s) XTf[s] = FRAGACC(X2T, s); }
#pragma unroll
        for (int s = 0; s < 2; ++s) { Xf[s] = FRAGACC(X2, s); TTf[s] = FRAGACC(TT, s); }
        TT = MFMA32(Xf[0], TTf[0], TT); TT = MFMA32(Xf[1], TTf[1], TT);
        __builtin_amdgcn_sched_barrier(0);
    }
#pragma unroll
    for (int s = 0; s < 2; ++s) TTf[s] = FRAGACC(TT, s);
    v4u Wf[2][2], Uf[2][2];
#pragma unroll
    for (int blk = 0; blk < 2; ++blk) {
        f32x16 av = MFMA32(AakTf[0], Vf[blk][0], f32x16{}); av = MFMA32(AakTf[1], Vf[blk][1], av);
        const v4u avf0 = FRAGACC(av, 0), avf1 = FRAGACC(av, 1);
        f32x16 uu = MFMA32(TTf[0], avf0, f32x16{}); uu = MFMA32(TTf[1], avf1, uu);
        f32x16 ww = MFMA32(TTf[0], Af[blk][0], f32x16{}); ww = MFMA32(TTf[1], Af[blk][1], ww);
#pragma unroll
        for (int s = 0; s < 2; ++s) { Wf[blk][s] = FRAGACC(ww, s); Uf[blk][s] = FRAGACC(uu, s); }
        __builtin_amdgcn_sched_barrier(0);
    }
    v4u* QFp = Dm.QF + (size_t)u * 256 + lane; v4u* YDp = Dm.YD + (size_t)u * 256 + lane;
#pragma unroll
    for (int blk = 0; blk < 2; ++blk) {
        f32x16 q;
#pragma unroll
        for (int s = 0; s < 2; ++s)
            { const v4u frs = PARK(4 + 2 * blk + s);
#pragma unroll
              for (int j = 0; j < 4; ++j) { q[8 * s + 2 * j] = bflo(frs[j]); q[8 * s + 2 * j + 1] = bfhi(frs[j]); } }
        q = MFMA32(Wf[blk][0], ArbTf[0], q); q = MFMA32(Wf[blk][1], ArbTf[1], q);
        st_wt16(QFp + (2 * blk) * 64, FRAGACC(q, 0)); st_wt16(QFp + (2 * blk + 1) * 64, FRAGACC(q, 1));
        f32x16 y = MFMA32(Uf[blk][0], ArbTf[0], f32x16{}); y = MFMA32(Uf[blk][1], ArbTf[1], y); y = MFMA32(Vf[blk][0], ArkTf[0], y); y = MFMA32(Vf[blk][1], ArkTf[1], y);
        st_wt16(YDp + (2 * blk) * 64, FRAGACC(y, 0)); st_wt16(YDp + (2 * blk + 1) * 64, FRAGACC(y, 1));
        __builtin_amdgcn_sched_barrier(0);
    }
    v4u* PFp = Dm.PF + (size_t)u * 512 + lane; v4u* DDp = Dm.DD + (size_t)u * 512 + lane;
#pragma unroll
    for (int c1 = 0; c1 < 2; ++c1)
#pragma unroll
        for (int cb = 0; cb < 2; ++cb) {
            f32x16 p = MFMA32(Wf[c1][0], PARK(8 + 2 * cb), f32x16{}); p = MFMA32(Wf[c1][1], PARK(8 + 2 * cb + 1), p);
            st_wt16(PFp + (cb * 4 + 2 * c1) * 64, FRAGACC(p, 0)); st_wt16(PFp + (cb * 4 + 2 * c1 + 1) * 64, FRAGACC(p, 1));
            __builtin_amdgcn_sched_barrier(0);
        }
#pragma unroll
    for (int cb = 0; cb < 2; ++cb)
#pragma unroll
        for (int ib = 0; ib < 2; ++ib) {
            f32x16 d = MFMA32(PARK(8 + 2 * cb), Uf[ib][0], f32x16{}); d = MFMA32(PARK(8 + 2 * cb + 1), Uf[ib][1], d); d = MFMA32(PARK(12 + 2 * cb), Vf[ib][0], d); d = MFMA32(PARK(12 + 2 * cb + 1), Vf[ib][1], d);
            st_wt16(DDp + ((cb * 2 + ib) * 2) * 64, FRAGACC(d, 0)); st_wt16(DDp + ((cb * 2 + ib) * 2 + 1) * 64, FRAGACC(d, 1));
            __builtin_amdgcn_sched_barrier(0);
        }
}

#undef PARK
#undef DEP
constexpr int RB_PF = 0, RB_DD = 8192, RB_QF = 16384, RB_YD = 20480, RB_GAM = 24576, RB_BUF = 24832, RB_NB = 4, RB_STAT = RB_NB * RB_BUF, RB_Y = RB_STAT + 1024;
__device__ __forceinline__ void unpack16(const v4u a, const v4u b, f32x16& o) {
#pragma unroll
    for (int j = 0; j < 4; ++j) { o[2 * j] = bflo(a[j]); o[2 * j + 1] = bfhi(a[j]); o[8 + 2 * j] = bflo(b[j]); o[8 + 2 * j + 1] = bfhi(b[j]); }
}
constexpr int RW_SPLIT = T / 32, CW_DONE = 16384;
__device__ __forceinline__ void rw_wait_chunk(Frame& F, int ci) {
    unsigned spins = 0;
#pragma unroll 1
    for (int j = 7; j >= 0; --j) { gu32* c = F.ctl + CW_DONE + 64 * (ci + j);
        while ((unsigned)__builtin_amdgcn_readfirstlane(__hip_atomic_load(c, RLX_AGENT)) < (unsigned)BATCH) { __builtin_amdgcn_s_sleep(8); if (++spins > (1u << 22)) break; } }
    __builtin_amdgcn_fence(__ATOMIC_ACQUIRE, "agent");
}
__device__ __forceinline__ void rw_publish_chunk(Frame& F, int ci) {
    asm volatile("s_waitcnt vmcnt(0)" ::: "memory");
    __syncthreads();
    if (F.wave == 0 && mk_lane() == 0) {
        __hip_atomic_fetch_add(F.ctl + CW_DONE + 64 * ci, 1u, RLX_AGENT);
    }
}
#ifndef RB_AUX
#define RB_AUX 2
#endif
struct RbStage { v4u p[2], d[2], q, y, g; };
struct RbEpi { v4u vc, vp, ga; float rho; };
__device__ __forceinline__ void rwkvB_unit(Frame& F, const RwDump& Dm, int bh) {
    int lane = mk_lane(); asm volatile("" : "+v"(lane));
    const int wid = F.wave, tid = wid * 64 + lane, hi = lane >> 5, l31 = lane & 31, b = bh >> 3, h = bh & 7;
    LAS unsigned char* lds = F.lds + RING_OFF;
    constexpr int NS = T / 32;
    LAS float* stat = (LAS float*)(lds + RB_STAT);
    LAS float* ybuf = (LAS float*)(lds + RB_Y);
    const int stid = tid - 128;
    const bool st_p2 = wid < 4, st_q = wid < 6, st_y = wid >= 4;
#define ST_LOAD(X, ci_) do { { if ((ci_) >= RW_SPLIT && (ci_) < NS && (((ci_) - RW_SPLIT) & 7) == 0) rw_wait_chunk(F, (ci_)); const size_t u_ = (size_t)((ci_) < NS ? (ci_) : NS - 1) * (BATCH * RH) + bh; \
        X.p[0] = __builtin_nontemporal_load((const GAS v4u*)(Dm.PF + u_ * 512 + stid)); X.d[0] = __builtin_nontemporal_load((const GAS v4u*)(Dm.DD + u_ * 512 + stid)); \
        if (st_p2) { X.p[1] = __builtin_nontemporal_load((const GAS v4u*)(Dm.PF + u_ * 512 + 384 + stid)); X.d[1] = __builtin_nontemporal_load((const GAS v4u*)(Dm.DD + u_ * 512 + 384 + stid)); } \
        if (st_q) X.q = __builtin_nontemporal_load((const GAS v4u*)(Dm.QF + u_ * 256 + stid)); \
        if (st_y) X.y = __builtin_nontemporal_load((const GAS v4u*)(Dm.YD + u_ * 256 + (stid - 128))); \
        if (stid < 16) X.g = *(const GAS v4u*)((const v4u*)(Dm.GAM + u_ * 64) + stid); } } while (0)
#define ST_STORE(X, buf_) do { LAS unsigned char* b_ = lds + (buf_) * RB_BUF; \
        *(LAS v4u*)(b_ + RB_PF + stid * 16) = X.p[0]; *(LAS v4u*)(b_ + RB_DD + stid * 16) = X.d[0]; \
        if (st_p2) { *(LAS v4u*)(b_ + RB_PF + (384 + stid) * 16) = X.p[1]; *(LAS v4u*)(b_ + RB_DD + (384 + stid) * 16) = X.d[1]; } \
        if (st_q) *(LAS v4u*)(b_ + RB_QF + stid * 16) = X.q; \
        if (st_y) *(LAS v4u*)(b_ + RB_YD + (stid - 128) * 16) = X.y; \
        if (stid < 16) *(LAS v4u*)(b_ + RB_GAM + stid * 16) = X.g; } while (0)
    const int ew = (wid & 1) + 2 * ((wid >> 2) & 1), eidx = ew * 64 + lane, etok = eidx >> 3, ep = eidx & 7;
    const bf16* epc = F.PROJ + (size_t)b * T * NP + h * 64 + 8 * ep;
#define EP_LOAD(X, cj_) do { { const int cc_ = (cj_) < NS ? (cj_) : NS - 1, tt_ = cc_ * 32 + etok; const bf16* pc_ = epc + (size_t)tt_ * NP; const bf16* pp_ = epc + (size_t)(tt_ > 0 ? tt_ - 1 : 0) * NP; \
        X.vc = *(const GAS v4u*)(pc_ + C_V); X.vp = *(const GAS v4u*)(pp_ + C_V); X.ga = *(const GAS v4u*)(pc_ + C_GA); \
        X.rho = Dm.RHO[((size_t)cc_ * (BATCH * RH) + bh) * 32 + etok]; } } while (0)
#define EP_RUN(X, cj_) do { const int par_ = (cj_) & 1; \
        const float s1_ = stat[((par_ * 2 + 0) * 32 + etok) * 2] + stat[((par_ * 2 + 1) * 32 + etok) * 2], s2_ = stat[((par_ * 2 + 0) * 32 + etok) * 2 + 1] + stat[((par_ * 2 + 1) * 32 + etok) * 2 + 1]; \
        const float mean_ = s1_ * (1.f / 64.f), var_ = fmaxf(s2_ * (1.f / 64.f) - mean_ * mean_, 0.f), rstd_ = __builtin_amdgcn_rsqf(var_ + 64e-5f); \
        const int tt_ = (cj_) * 32 + etok; const size_t mm_ = (size_t)b * T + tt_; const float pm_ = tt_ > 0 ? 1.f : 0.f; \
        const LAS float* yb_ = ybuf + (par_ * 2 + (ep >> 2)) * 1024 + 4 * (ep & 3) * 64 + etok; \
        float o_[8]; \
        _Pragma("unroll") for (int j = 0; j < 8; ++j) { const unsigned vcw_ = X.vc[j >> 1], vpw_ = X.vp[j >> 1], gaw_ = X.ga[j >> 1]; \
            const float vc_ = (j & 1) ? bfhi(vcw_) : bflo(vcw_), vp_ = (j & 1) ? bfhi(vpw_) : bflo(vpw_), g_ = (j & 1) ? bfhi(gaw_) : bflo(gaw_); \
            const float vv_ = vc_ + (vp_ * pm_ - vc_) * emu[j >> 2][j & 3]; \
            const float yn_ = (yb_[(j & 3) * 64 + (j >> 2) * 32] - mean_) * rstd_ * elw[j >> 2][j & 3] + elb[j >> 2][j & 3] + X.rho * vv_; o_[j] = yn_ * g_ * __builtin_amdgcn_rcpf(1.f + __expf(-g_)); } \
        *(GAS v4u*)(F.MIX + mm_ * D + h * 64 + 8 * ep) = (v4u){cvtpk(o_[0], o_[1]), cvtpk(o_[2], o_[3]), cvtpk(o_[4], o_[5]), cvtpk(o_[6], o_[7])}; } while (0)
    f32x16 S[2]; S[0] = f32x16{}; S[1] = f32x16{};
    const int ib = wid & 1;
#define CONS(ci_) do { const LAS unsigned char* bb = lds + ((ci_) & (RB_NB - 1)) * RB_BUF; \
          \
        v4u pf_[8], qf_[4], dd_[4], yd_[2]; f32x4 gm_[8]; \
        _Pragma("unroll") for (int q = 0; q < 8; ++q) gm_[q] = *(const LAS f32x4*)(bb + RB_GAM + (hi * 32 + 4 * q) * 4); \
        _Pragma("unroll") for (int q = 0; q < 4; ++q) dd_[q] = *(const LAS v4u*)(bb + RB_DD + ((((q >> 1) * 2 + ib) * 2 + (q & 1)) * 64 + lane) * 16); \
        _Pragma("unroll") for (int q = 0; q < 8; ++q) pf_[q] = *(const LAS v4u*)(bb + RB_PF + (q * 64 + lane) * 16); \
        _Pragma("unroll") for (int q = 0; q < 2; ++q) yd_[q] = *(const LAS v4u*)(bb + RB_YD + ((2 * ib + q) * 64 + lane) * 16); \
        _Pragma("unroll") for (int q = 0; q < 4; ++q) qf_[q] = *(const LAS v4u*)(bb + RB_QF + (q * 64 + lane) * 16); \
        __builtin_amdgcn_sched_barrier(0); \
        v4u Sf[4]; _Pragma("unroll") for (int s = 0; s < 4; ++s) Sf[s] = FRAGACC(S[s >> 1], s & 1); \
        _Pragma("unroll") for (int rb = 0; rb < 2; ++rb) { \
            f32x16 acc; unpack16(dd_[2 * rb], dd_[2 * rb + 1], acc); \
            _Pragma("unroll") for (int q = 0; q < 4; ++q) { const f32x4 gv = gm_[4 * rb + q]; _Pragma("unroll") for (int e = 0; e < 4; ++e) acc[4 * q + e] += gv[e] * S[rb][4 * q + e]; } \
            _Pragma("unroll") for (int s = 0; s < 4; ++s) acc = MFMA32(pf_[rb * 4 + s], Sf[s], acc); \
            S[rb] = acc; } \
        f32x16 y; unpack16(yd_[0], yd_[1], y); \
        _Pragma("unroll") for (int s = 0; s < 4; ++s) y = MFMA32(Sf[s], qf_[s], y); \
        float s1 = 0.f, s2 = 0.f; LAS float* yb_ = ybuf + (((ci_) & 1) * 2 + ib) * 1024 + lane; \
        _Pragma("unroll") for (int r = 0; r < 16; ++r) { s1 += y[r]; s2 += y[r] * y[r]; yb_[r * 64] = y[r]; } \
        s1 = swap32_sum(s1); s2 = swap32_sum(s2); \
        if (hi == 0) { stat[((((ci_) & 1) * 2 + ib) * 32 + l31) * 2] = s1; stat[((((ci_) & 1) * 2 + ib) * 32 + l31) * 2 + 1] = s2; } } while (0)
#define RB_BAR() do { asm volatile("s_waitcnt lgkmcnt(0)" ::: "memory"); __builtin_amdgcn_s_barrier(); asm volatile("" ::: "memory"); } while (0)
    if (wid < 2) {
        RB_BAR();
#pragma unroll 1
        for (int k = 0; k < NS; ++k) { CONS(k); RB_BAR(); }
        RB_BAR();
    } else if (wid == 4 || wid == 5) {
        const GAS v4u* gA = (const GAS v4u*)(wid == 4 ? Dm.PF : Dm.DD) + lane; const GAS v4u* gB = (const GAS v4u*)(wid == 4 ? Dm.QF : Dm.YD) + lane;
        const int oA = wid == 4 ? RB_PF : RB_DD, oB = wid == 4 ? RB_QF : RB_YD;
#define LD_ISSUE(ci_) do { const size_t u_ = (size_t)((ci_) < NS ? (ci_) : NS - 1) * (BATCH * RH) + bh; LAS unsigned char* b_ = lds + ((ci_) & (RB_NB - 1)) * RB_BUF; \
        _Pragma("unroll") for (int q = 0; q < 8; ++q) __builtin_amdgcn_global_load_lds((const unsigned*)(gA + u_ * 512 + q * 64), (LAS unsigned*)(b_ + oA + q * 1024), 16, 0, RB_AUX); \
        _Pragma("unroll") for (int q = 0; q < 4; ++q) __builtin_amdgcn_global_load_lds((const unsigned*)(gB + u_ * 256 + q * 64), (LAS unsigned*)(b_ + oB + q * 1024), 16, 0, RB_AUX); \
        if (lane < 16) __builtin_amdgcn_global_load_lds((const unsigned*)((const GAS v4u*)(Dm.GAM + u_ * 64) + lane), (LAS unsigned*)(b_ + RB_GAM), 16, 0, 0); } while (0)
        LD_ISSUE(0); LD_ISSUE(1); LD_ISSUE(2);
        asm volatile("s_waitcnt vmcnt(26)" ::: "memory");
        RB_BAR();
#pragma unroll 1
        for (int k = 0; k < NS; ++k) { LD_ISSUE(k + 3); asm volatile("s_waitcnt vmcnt(26)" ::: "memory"); RB_BAR(); }
        asm volatile("s_waitcnt vmcnt(0)" ::: "memory");
        RB_BAR();
#undef LD_ISSUE
    } else {
        RbEpi eA, eB, eC; f32x4 emu[2], elw[2], elb[2];
#pragma unroll
        for (int rg = 0; rg < 2; ++rg) { const int hc_ = h * 64 + 8 * ep + 4 * rg; emu[rg] = *(const GAS f32x4*)(F.shift_mu + 1024 + hc_); elw[rg] = *(const GAS f32x4*)(F.ln_w + hc_); elb[rg] = *(const GAS f32x4*)(F.ln_b + hc_); }
        EP_LOAD(eA, 0); EP_LOAD(eB, 1);
        RB_BAR();
        EP_LOAD(eC, 2); RB_BAR();
#define HY_STEP(k_, EP) do { EP_RUN(EP, (k_) - 1); EP_LOAD(EP, (k_) + 2); RB_BAR(); } while (0)
#pragma unroll 1
        for (int k = 1; k < NS; k += 3) { HY_STEP(k, eA); HY_STEP(k + 1, eB); HY_STEP(k + 2, eC); }
        EP_RUN(eA, NS - 1);
        RB_BAR();
#undef HY_STEP
    }
#undef RB_BAR
#undef ST_LOAD
#undef ST_STORE
#undef EP_LOAD
#undef EP_RUN
#undef CONS
}
constexpr int CW_G17 = 12288;
struct OneUnit { int pm, pn;
    __device__ __forceinline__ bool next(int i, pg8::Unit& u) const { if (i != 0) return false; u.pm = pm; u.pn = pn; return true; }
    __device__ __forceinline__ void a_ready(const pg8::Unit&) const {}
    __device__ __forceinline__ void done(const pg8::Unit&) const {} };
constexpr int AT_OUT = 65536, AT_G0 = 114688, AT_G1 = LDSCTL_OFF + 1024;
constexpr int AT_KB = 64 * 256, AT_VB = 64 * 256, AT_BUF = AT_KB + AT_VB, AT_QOFF = 2 * AT_KB + 3 * AT_VB;
__device__ __forceinline__ s16x4 vtr(const LAS unsigned char* p) { typedef short v4i16_t __attribute__((ext_vector_type(4))); return __builtin_bit_cast(s16x4, __builtin_amdgcn_ds_read_tr16_b64_v4i16((LAS v4i16_t*)p)); }
__device__ __forceinline__ void attn_unit(Frame& F, int b, int h, int qb) {
    int lane = mk_lane(); asm volatile("" : "+v"(lane));
    const int wid = F.wave, tid = wid * 64 + lane, l31 = lane & 31, hi = lane >> 5, map = wid >> 2, qs = wid & 3;
    LAS unsigned char* lds = F.lds + RING_OFF;
    const float slope2 = exp2f(-2.f * (float)(h + 1)) * LOG2E, shift2 = __uint_as_float(F.MISC[15]);
    const int q0 = qb * 128, qrow = q0 + 32 * qs + l31;
    const size_t mrow = (size_t)b * T + qrow;
    LAS bf16x8* qpark = (LAS bf16x8*)(lds + AT_QOFF + wid * 4096) + lane;
    { const bf16* qp = F.PROJ + mrow * NP + C_DQ + h * 128 + map * 64 + 8 * hi;
      v4u qraw[4]; float ss = 0.f;
#pragma unroll
      for (int s = 0; s < 4; ++s) qraw[s] = *(const GAS v4u*)(qp + 16 * s);
#pragma unroll
      for (int s = 0; s < 4; ++s)
#pragma unroll
          for (int j = 0; j < 4; ++j) { const float a_ = bflo(qraw[s][j]), b_ = bfhi(qraw[s][j]); ss += a_ * a_ + b_ * b_; }
      ss = swap32_sum(ss);
      const float rq = __builtin_amdgcn_rsqf(ss * (1.f / 64.f) + 1e-6f) * C2;
#pragma unroll
      for (int s = 0; s < 4; ++s) { const f32x4 g0 = *(const GAS f32x4*)(F.qn_g + 8 * hi + 16 * s), g1 = *(const GAS f32x4*)(F.qn_g + 8 * hi + 16 * s + 4);
          v4u w_; w_.x = cvtpk2(bflo(qraw[s].x) * rq * g0.x, bfhi(qraw[s].x) * rq * g0.y); w_.y = cvtpk2(bflo(qraw[s].y) * rq * g0.z, bfhi(qraw[s].y) * rq * g0.w);
          w_.z = cvtpk2(bflo(qraw[s].z) * rq * g1.x, bfhi(qraw[s].z) * rq * g1.y); w_.w = cvtpk2(bflo(qraw[s].w) * rq * g1.z, bfhi(qraw[s].w) * rq * g1.w);
          *(LAS v4u*)(qpark + s * 64) = w_; } }
    const bf16* kg = F.PROJ + (size_t)b * T * NP + C_DK + h * 128;
    const bf16* vg = F.PROJ + (size_t)b * T * NP + C_DV + h * 128;
    const int NT = 2 * qb + 2, tl = 2 * qb + (qs >> 1);
    const int Wk = (int)__builtin_ceilf((2.f * shift2 + 32.2f) / slope2);
    const int tf = __builtin_amdgcn_readfirstlane(max(0, (qb * 128 - Wk) >> 6));
    constexpr int AT_V0 = 2 * AT_KB;
    const int drow0 = 4 * wid + (lane >> 4), drow1 = drow0 + 32, dch = lane & 15;
    const unsigned ksrc0 = (unsigned)(drow0 * NP + ((dch ^ (drow0 & 15)) * 8)), ksrc1 = (unsigned)(drow1 * NP + ((dch ^ (drow1 & 15)) * 8));
    const unsigned vsrc0 = (unsigned)(drow0 * NP + ((dch ^ ((drow0 & 3) << 2)) * 8)), vsrc1 = (unsigned)(drow1 * NP + ((dch ^ ((drow1 & 3) << 2)) * 8));
#define AT_DMA(t_, kb_, v3_) do { const size_t tb_ = (size_t)(64 * (t_)) * NP; LAS unsigned char* bk_ = lds + (kb_) * AT_KB + wid * 1024; LAS unsigned char* bv_ = lds + AT_V0 + (v3_) * AT_VB + wid * 1024; \
        __builtin_amdgcn_global_load_lds((const unsigned*)(kg + tb_ + ksrc0), (LAS unsigned*)bk_, 16, 0, 0); __builtin_amdgcn_global_load_lds((const unsigned*)(kg + tb_ + ksrc1), (LAS unsigned*)(bk_ + 8192), 16, 0, 0); \
        __builtin_amdgcn_global_load_lds((const unsigned*)(vg + tb_ + vsrc0), (LAS unsigned*)bv_, 16, 0, 0); __builtin_amdgcn_global_load_lds((const unsigned*)(vg + tb_ + vsrc1), (LAS unsigned*)(bv_ + 8192), 16, 0, 0); } while (0)
    f32x16 o[4];
#pragma unroll
    for (int vb = 0; vb < 4; ++vb) o[vb] = f32x16{};
    float lsum = 0.f;
    AT_DMA(tf, tf & 1, tf % 3);
    { const int gr_ = 16 * wid + (lane >> 4); const bf16* gsrc = F.PROJ + ((size_t)b * T + q0 + gr_) * NP + C_GB + h * 128;
      LAS unsigned char* gdst = F.lds + (wid < 4 ? AT_G0 + wid * 4096 : AT_G1 + (wid - 4) * 4096);
#pragma unroll
      for (int j = 0; j < 4; ++j) __builtin_amdgcn_global_load_lds((const unsigned*)(gsrc + (size_t)(4 * j) * NP + (((lane & 15) ^ (4 * j + (lane >> 4))) * 8)), (LAS unsigned*)(gdst + j * 1024), 16, 0, 0); }
    __syncthreads();
    const int G = lane >> 4, qq = (lane & 15) >> 2, pp = lane & 3;
    const int vrow = (4 * hi + qq) * 256 + 8 * (pp & 1), vch = 2 * (G & 1) + (pp >> 1);
    v4u pw[4];
#define SBAR_() __builtin_amdgcn_sched_barrier(0)
#define AT_QK(t) do { \
            const LAS unsigned char* Kb = lds + ((t) & 1) * AT_KB; \
            float sl_ = slope2; asm volatile("" : "+v"(sl_));     \
            const float base = sl_ * (float)(64 * (t) + 4 * hi - qrow) - shift2; \
            float ls = 0.f; \
            _Pragma("unroll") for (int hf = 0; hf < 2; ++hf) {        \
                f32x16 p; \
                _Pragma("unroll") for (int r = 0; r < 16; ++r) p[r] = __builtin_fmaf(sl_, (float)(32 * hf + (r & 3) + 8 * (r >> 2)), base); \
                _Pragma("unroll") for (int s = 0; s < 4; ++s) { \
                    const bf16x8 a0 = *(const LAS bf16x8*)(Kb + (32 * hf + l31) * 256 + (((map * 8 + 2 * s + hi) ^ (l31 & 15)) * 16)); \
                    p = __builtin_amdgcn_mfma_f32_32x32x16_bf16(a0, qpark[s * 64], p, 0, 0, 0); } \
                if ((t) == tl) { \
                    _Pragma("unroll") for (int r = 0; r < 16; ++r) { const int ki = 64 * (t) + 32 * hf + 4 * hi + (r & 3) + 8 * (r >> 2); if (ki > qrow) p[r] = -1e30f; } } \
                _Pragma("unroll") for (int r = 0; r < 16; ++r) { p[r] = __builtin_amdgcn_exp2f(p[r]); ls += p[r]; } \
                pw[2 * hf] = (v4u){cvtpk(p[0], p[1]), cvtpk(p[2], p[3]), cvtpk(p[4], p[5]), cvtpk(p[6], p[7])}; \
                pw[2 * hf + 1] = (v4u){cvtpk(p[8], p[9]), cvtpk(p[10], p[11]), cvtpk(p[12], p[13]), cvtpk(p[14], p[15])}; } \
            lsum += ls; } while (0)
#define AT_VRD(dst, ks, vb0) do { _Pragma("unroll") for (int vb = (vb0); vb < (vb0) + 2; ++vb) { const LAS unsigned char* a_ = Vb + vrow + ((4 * vb + vch) ^ (qq << 2)) * 16 + (32 * ((ks) >> 1) + 16 * ((ks) & 1)) * 256; \
        dst[2 * (vb - (vb0))] = vtr(a_); dst[2 * (vb - (vb0)) + 1] = vtr(a_ + 8 * 256); } } while (0)
#define AT_PV(src, pwk, vb0) do { _Pragma("unroll") for (int vb = (vb0); vb < (vb0) + 2; ++vb) { const int j_ = 2 * (vb - (vb0)); \
        const bf16x8 vf = (bf16x8){src[j_][0], src[j_][1], src[j_][2], src[j_][3], src[j_ + 1][0], src[j_ + 1][1], src[j_ + 1][2], src[j_ + 1][3]}; \
        o[vb] = __builtin_amdgcn_mfma_f32_32x32x16_bf16(vf, __builtin_bit_cast(bf16x8, pwk), o[vb], 0, 0, 0); } } while (0)
#define AT_PVV(v3_) do { const LAS unsigned char* Vb = lds + AT_V0 + (v3_) * AT_VB; s16x4 vA[4], vB[4]; \
            AT_VRD(vA, 0, 0); SBAR_(); AT_VRD(vB, 0, 2); SBAR_(); \
            AT_PV(vA, pw[0], 0); SBAR_(); AT_VRD(vA, 1, 0); SBAR_(); AT_PV(vB, pw[0], 2); SBAR_(); AT_VRD(vB, 1, 2); SBAR_(); \
            AT_PV(vA, pw[1], 0); SBAR_(); AT_VRD(vA, 2, 0); SBAR_(); AT_PV(vB, pw[1], 2); SBAR_(); AT_VRD(vB, 2, 2); SBAR_(); \
            AT_PV(vA, pw[2], 0); SBAR_(); AT_VRD(vA, 3, 0); SBAR_(); AT_PV(vB, pw[2], 2); SBAR_(); AT_VRD(vB, 3, 2); SBAR_(); \
            AT_PV(vA, pw[3], 0); SBAR_(); AT_PV(vB, pw[3], 2); } while (0)
    if (map == 0) {
        int v3 = tf % 3;
#pragma unroll 1
        for (int t = tf; t < NT; ++t) { const int vn = v3 == 2 ? 0 : v3 + 1;
            if (t + 1 < NT) AT_DMA(t + 1, (t + 1) & 1, vn);
            if (t <= tl) { AT_QK(t); AT_PVV(v3); }
            __syncthreads(); v3 = vn; }
    } else {
        int v3 = tf % 3;
#pragma unroll 1
        for (int t = tf; t < NT; ++t) { const int vp = v3 == 0 ? 2 : v3 - 1, vn = v3 == 2 ? 0 : v3 + 1;
            if (t + 1 < NT) AT_DMA(t + 1, (t + 1) & 1, vn);
            if (t > tf && t - 1 <= tl) AT_PVV(vp);
            if (t <= tl) AT_QK(t);
            __syncthreads(); v3 = vn; }
        if (NT - 1 <= tl) { const int vp = v3 == 0 ? 2 : v3 - 1; AT_PVV(vp); }
    }
#undef AT_PVV
#undef AT_QK
#undef AT_VRD
#undef AT_PV
#undef SBAR_
#undef AT_DMA
    __syncthreads();
    const float ltot = swap32_sum(lsum);
    LAS float* X = (LAS float*)lds;
    if (map == 1) {
        const float sc = __uint_as_float(F.MISC[14]) / ltot;
#pragma unroll
        for (int vb = 0; vb < 4; ++vb)
#pragma unroll
            for (int r = 0; r < 16; ++r) X[(qs * 64 + vb * 16 + r) * 64 + lane] = o[vb][r] * sc;
    }
    __syncthreads();
    if (map == 0) {
        const float il = 1.f / ltot; float ss = 0.f;
#pragma unroll
        for (int vb = 0; vb < 4; ++vb)
#pragma unroll
            for (int r = 0; r < 16; ++r) { const float v = o[vb][r] * il - X[(qs * 64 + vb * 16 + r) * 64 + lane]; o[vb][r] = v; ss += v * v; }
        ss = swap32_sum(ss);
        const float rn = (1.f / sqrtf(ss * (1.f / 128.f) + 1e-5f)) * (1.f - LAMBDA_INIT);
        int etok = 0; asm volatile("" : "+v"(etok));
        const int lane_e = mk_lane(), hi = lane_e >> 5, row = 32 * qs + (lane_e & 31);
        const LAS unsigned char* grow = F.lds + (qs < 2 ? AT_G0 : AT_G1 - 64 * 256) + row * 256 + 8 * hi;
        LAS unsigned char* orow = lds + AT_OUT + row * 256 + 8 * hi;
#pragma unroll
        for (int vb = 0; vb < 4; ++vb)
#pragma unroll
            for (int rg = 0; rg < 4; ++rg) {
                const int vc = 32 * vb + 8 * rg + 4 * hi, ch = (((4 * vb + rg) ^ (row & 15)) * 16) + etok;
                const v2u gw = *(const LAS v2u*)(grow + ch); const f32x4 sg = *(const GAS f32x4*)(F.subln_g + vc);
                const float g4[4] = {bflo(gw.x), bfhi(gw.x), bflo(gw.y), bfhi(gw.y)}; float ov[4];
#pragma unroll
                for (int e = 0; e < 4; ++e) ov[e] = o[vb][4 * rg + e] * rn * sg[e] * g4[e] / (1.f + __expf(-g4[e]));
                const unsigned w1_ = cvtpk(ov[2], ov[3]);
                *(LAS v2u*)(orow + ch) = (v2u){cvtpk(ov[0], ov[1]), w1_};
                if (rg == 3) asm volatile("" : "+v"(etok) : "v"(w1_));
            }
    }
    __syncthreads();
    { const int t_ = wid * 64 + mk_lane(); bf16* ob = F.MIX + ((size_t)b * T + q0) * D + 512 + h * 128;
#pragma unroll
      for (int i = 0; i < 4; ++i) { const int pc = t_ + 512 * i, r_ = pc >> 4, c_ = pc & 15;
          *(GAS v4u*)(ob + (size_t)r_ * D + c_ * 8) = *(const LAS v4u*)(lds + AT_OUT + r_ * 256 + ((c_ ^ (r_ & 15)) * 16)); } }
    __syncthreads();
}
#ifndef DBL
#define DBL 0
#endif
constexpr int CW_QUEUE = 8192;
constexpr int QX_RW = 8, QX_A2 = 0, QX_AT = 64, QX_ALL = QX_RW + QX_A2 + QX_AT;
template <int MODE = 0> __device__ __forceinline__ void p3_queue(Frame& F, const RwDump& Dm, const int qbase = CW_QUEUE) {
    const int ql = mk_lane();
    const float l1 = wave_sum(F.lq1[ql] * F.lk1[ql]), l2 = wave_sum(F.lq2[ql] * F.lk2[ql]);
    const float lam = __uint_as_float(__builtin_amdgcn_readfirstlane(__float_as_uint(__expf(l1) - __expf(l2) + LAMBDA_INIT)));
    float gq = fabsf(F.qn_g[ql]), gk = fabsf(F.kn_g[ql]);
#pragma unroll
    for (int o = 1; o < 64; o <<= 1) { gq = fmaxf(gq, __shfl_xor(gq, o)); gk = fmaxf(gk, __shfl_xor(gk, o)); }
    const float shift2 = __uint_as_float(__builtin_amdgcn_readfirstlane(__float_as_uint(8.f * gq * gk * LOG2E)));
    if (F.wave == 0 && mk_lane() == 0) { F.MISC[14] = __float_as_uint(lam); F.MISC[15] = __float_as_uint(shift2); }
    __syncthreads();
#ifdef Q_BLK
    const int x0 = (int)(blockIdx.x & 7);
#else
    const int x0 = (int)(xb_xcc_id() & 7u);
#endif
#pragma unroll 1
    for (int dx = 0; dx < 8; ++dx) {
        const int xq = (x0 + dx) & 7;
        for (;;) {
            if (F.wave == 0 && mk_lane() == 0) F.MISC[12] = __hip_atomic_fetch_add(F.ctl + qbase + 64 * xq, 1u, RLX_AGENT);
            __syncthreads();
            int item = __builtin_amdgcn_readfirstlane((int)F.MISC[12]); if (MODE == 2) item += QX_RW;
            __syncthreads();
            if (item >= (MODE == 1 ? QX_RW : QX_ALL)) break;
            if (item < QX_RW) { rwkvB_unit(F, Dm, xq * 8 + item); if (DBL & 64) rwkvB_unit(F, Dm, xq * 8 + item); }
            else { const int idx = item - QX_RW - QX_A2, h = 3 - (idx >> 4), qb = 15 - (idx & 15);
#pragma unroll 1
#ifndef NO_ATT
                for (int rep = 0; rep < ((DBL & 32) ? 2 : 1); ++rep) attn_unit(F, xq, h, qb);
#endif
            }
        }
    }
}

struct Args { const float* in[21]; float* out; unsigned char* ws; int ph_lo, ph_hi; };
__global__ void __launch_bounds__(NWAVES * 64, 2) hymba_fwd(Args args) {
    extern __shared__ __attribute__((aligned(16))) unsigned char lds[];
    Frame F;
    F.lds = (LAS unsigned char*)lds;
    F.MISC = (volatile LAS unsigned*)(F.lds + MISC_OFF);
    F.wave = __builtin_amdgcn_readfirstlane((int)threadIdx.x >> 6); F.lane = mk_lane(); F.tid = F.wave * 64 + F.lane;
    F.G = gridDim.x; { const int bx = blockIdx.x; F.vcu = (F.G % 8 == 0) ? (bx % 8) * (F.G / 8) + bx / 8 : bx; }
    unsigned char* ws = args.ws;
    F.ctl = (gu32*)(ws + WS_CTL);
    F.x = args.in[0]; F.norm_g = args.in[1]; F.w_in = args.in[2]; F.shift_mu = args.in[3]; F.w0 = args.in[4]; F.w_decay_up = args.in[5]; F.a0 = args.in[6]; F.w_iclr_up = args.in[7];
    F.k_k = args.in[8]; F.k_a = args.in[9]; F.r_k = args.in[10]; F.ln_w = args.in[11]; F.ln_b = args.in[12]; F.qn_g = args.in[13]; F.kn_g = args.in[14];
    F.lq1 = args.in[15]; F.lk1 = args.in[16]; F.lq2 = args.in[17]; F.lk2 = args.in[18]; F.subln_g = args.in[19]; F.w_out = args.in[20]; F.out = args.out;
    F.WinT = (bf16*)(ws + WS_WIN); F.WoutT = (bf16*)(ws + WS_WOUT); F.WdT = (bf16*)(ws + WS_WD); F.WaT = (bf16*)(ws + WS_WA);
    F.XN = (bf16*)(ws + WS_XN); F.PROJ = (bf16*)(ws + WS_PROJ); F.MIX = (bf16*)(ws + WS_MIX);
    for (int u = F.tid; u < (LDS_BYTES - LDSCTL_OFF) / 4; u += NWAVES * 64) ((LAS unsigned*)(F.lds + LDSCTL_OFF))[u] = 0u;
    __syncthreads();
    XcdBarrier bar; bar.bar = (unsigned*)(F.ctl + CW_BAR); bar.x = 0; bar.st = nullptr; bar.wave = F.wave;
    if (MK_N_LAUNCHES == 1) bar = xcd_barrier_post((unsigned*)(F.ctl + CW_BAR), F.MISC + 8, F.wave);
#define GRID_BAR() do { if (MK_N_LAUNCHES == 1) xcd_barrier(bar); } while (0)
    const int lo = args.ph_lo, hi = args.ph_hi;
#define IN(k) (lo <= (k) && (k) < hi)
#define BOTH(k) (IN(k) && IN((k) + 1))
#ifndef SKIP
#define SKIP 0
#endif
    if (IN(0) && !(SKIP & 1)) { p0_prologue(F); if (DBL & 1) { GRID_BAR(); p0_prologue(F); } if (BOTH(0)) GRID_BAR(); }
    if (IN(1) && !(SKIP & 2)) {
        pg8::Gemm g{F.XN, F.WinT, M, NP, D}; pg8::StaticOrder S; S.init(M, NP, F.G, (int)blockIdx.x);
        pg8::EpiBf16S E{F.PROJ, NP};
        pg8::gemm_phase<pg8::EpiBf16S, pg8::StaticOrder, true, true>(F.lds + RING_OFF, g, S, E, F.wave);
        if (DBL & 2) { GRID_BAR(); pg8::gemm_phase<pg8::EpiBf16S, pg8::StaticOrder, true, true>(F.lds + RING_OFF, g, S, E, F.wave); }
        if (BOTH(1)) GRID_BAR();
    }
    RwDump Dm; { unsigned char* so = (unsigned char*)args.out; Dm.PF = (v4u*)so; Dm.DD = (v4u*)(so + 32 * MiB); Dm.QF = (v4u*)(ws + WS_XN); Dm.YD = (v4u*)(ws + WS_XN + 16 * MiB);
        Dm.GAM = (float*)(ws + WS_END); Dm.RHO = (float*)(ws + WS_END + 1 * MiB); }
    if (IN(2) && !(SKIP & 4)) {
        LAS float* wscr = (LAS float*)(F.lds + LDSCTL_OFF + 1024) + F.wave * 64; int zpar = 0;
#pragma unroll 1
        for (int p = F.vcu; p < BATCH * (T / 32); p += F.G) { rwkvA_unit(F, Dm, (p >> 6) * RH + F.wave, p & 63, wscr, F.lds + RING_OFF + F.wave * 16384, (LAS v4u*)(F.lds + LDSCTL_OFF + 4096), zpar); zpar ^= 1; }
        if (DBL & 4) { GRID_BAR();
#pragma unroll 1
            for (int p = F.vcu; p < BATCH * (T / 32); p += F.G) { rwkvA_unit(F, Dm, (p >> 6) * RH + F.wave, p & 63, wscr, F.lds + RING_OFF + F.wave * 16384, (LAS v4u*)(F.lds + LDSCTL_OFF + 4096), zpar); zpar ^= 1; } }
        p2_qknorm(F);
        if (BOTH(2)) GRID_BAR();
    }
    if (IN(3) && !(SKIP & 8)) {
#ifdef P3SPLIT
        p3_queue<1>(F, Dm); GRID_BAR(); p3_queue<2>(F, Dm, CW_QUEUE + 1024);
#else
        p3_queue(F, Dm);
#endif
        if (DBL & 512) { GRID_BAR(); p3_queue(F, Dm, CW_QUEUE + 1024); }
        if (BOTH(3)) GRID_BAR();
    }
    if (IN(4) && !(SKIP & 16)) {
        pg8::Gemm g{F.MIX, F.WoutT, M, D, D}; pg8::StaticOrder S; S.init(M, D, F.G, (int)blockIdx.x);
        pg8::EpiResF32 E{F.x, F.out, D};
        pg8::gemm_phase<pg8::EpiResF32, pg8::StaticOrder, false, true>(F.lds + RING_OFF, g, S, E, F.wave);
        if (DBL & 16) { GRID_BAR(); pg8::gemm_phase<pg8::EpiResF32, pg8::StaticOrder, false, true>(F.lds + RING_OFF, g, S, E, F.wave); }
    }
#undef IN
#undef BOTH
}

extern "C" void kernel_launch(void* const* d_in, const int* in_sizes, int n_in, void* d_out, int out_size, void* d_ws, size_t ws_size, hipStream_t stream) {
    static int grid = 0;
    if (grid == 0) {
        if (n_in != 21 || in_sizes[0] != M * D || out_size != M * D || ws_size < WS_END + 2 * MiB) { fprintf(stderr, "kernel_launch: unexpected shapes (n_in %d, in0 %d, out %d, ws %zu); nothing launched\n", n_in, n_in > 0 ? in_sizes[0] : -1, out_size, ws_size); grid = -1; return; }
        int dev = 0, cus = 0, per_cu = 0;
        if (hipGetDevice(&dev) != hipSuccess || hipDeviceGetAttribute(&cus, hipDeviceAttributeMultiprocessorCount, dev) != hipSuccess) { grid = -1; return; }
        if (hipFuncSetAttribute((const void*)hymba_fwd, hipFuncAttributeMaxDynamicSharedMemorySize, LDS_BYTES) != hipSuccess) { fprintf(stderr, "kernel_launch: hipFuncSetAttribute failed\n"); grid = -1; return; }
        if (hipOccupancyMaxActiveBlocksPerMultiprocessor(&per_cu, (const void*)hymba_fwd, NWAVES * 64, LDS_BYTES) != hipSuccess || per_cu < 1) { fprintf(stderr, "kernel_launch: occupancy query reports %d workgroups per CU; nothing launched\n", per_cu); grid = -1; return; }
        (void)hipGetLastError();
        grid = cus;
        if (grid > 256) grid = 256;
    }
    if (grid < 0) return;
    if (hipMemsetAsync((char*)d_ws + WS_CTL, 0, CTL_ZERO_BYTES, stream) != hipSuccess) { fprintf(stderr, "kernel_launch: hipMemsetAsync failed\n"); return; }
    Args a{};
    for (int i = 0; i < 21; ++i) a.in[i] = (const float*)d_in[i];
    a.out = (float*)d_out; a.ws = (unsigned char*)d_ws;
    for (int li = 0; li < MK_N_LAUNCHES; ++li) {
        a.ph_lo = (MK_N_LAUNCHES == 1) ? 0 : li; a.ph_hi = (MK_N_LAUNCHES == 1) ? N_PHASES : li + 1;
        hipLaunchKernelGGL(hymba_fwd, dim3(grid), dim3(NWAVES * 64), LDS_BYTES, stream, a);
        const hipError_t le = hipPeekAtLastError();
        if (le != hipSuccess) { fprintf(stderr, "kernel_launch: launch %d failed: %s\n", li, hipGetErrorName(le)); break; }
    }
}
```

```cpp
#include <hip/hip_runtime.h>
#include <hip/hip_bf16.h>
#include <cstdio>
#include <cstdint>
#include <cmath>
namespace pg8 {
#define PG8_LAS __attribute__((address_space(3)))
typedef unsigned short bf16_t;
typedef short bf16x8 __attribute__((ext_vector_type(8)));
typedef float f32x4 __attribute__((ext_vector_type(4)));
typedef unsigned u32x4 __attribute__((ext_vector_type(4)));
constexpr int BM = 256, BK = 64, HALF = 128, HTB = HALF * BK * 2  , STAGE_BYTES = 8 * HTB, NXCD = 8, WGM = 8;

__host__ __device__ __forceinline__ int lds_byte(int r, int c) { const int st = (r >> 4) * 2 + (c >> 5), rr = r & 15, cc = c & 31, ob = rr * 64 + cc * 2; return st * 1024 + (ob ^ (((ob >> 9) & 1) << 5)); }
__host__ __device__ __forceinline__ void stage_rc(int b, int& R, int& C) { const int st = b / 1024, sb = b % 1024, swz = sb ^ (((sb >> 9) & 1) << 5); R = (st >> 1) * 16 + swz / 64; C = (st & 1) * 32 + (swz % 64) / 2; }
__host__ __device__ __forceinline__ int perm32(int rho) { const int n = rho >> 4, i = rho & 15; return 8 * (i >> 2) + 4 * n + (i & 3); }

__device__ __forceinline__ int mk_lane_pg8() { int l; asm volatile("v_mbcnt_lo_u32_b32 %0, -1, 0\n\tv_mbcnt_hi_u32_b32 %0, -1, %0" : "=v"(l)); return l; }
struct Unit { int pm, pn; };
struct Gemm { const bf16_t* A; const bf16_t* Bt; int M, N, K; };

struct StaticOrder {
    int nM, nN, nwg, G, c;
    __host__ __device__ void init(int M, int N, int G_, int c_) { nM = M / BM; nN = N / BM; nwg = nM * nN; G = G_; c = c_; }
    __host__ __device__ bool next(int i, Unit& u) const {
        const long L = (long)i * G + c; if (L >= nwg) return false;
        int wgid = (int)L; { const int q = nwg / NXCD, r = nwg % NXCD, xcd = wgid % NXCD, off = wgid / NXCD; wgid = (xcd < r ? xcd * (q + 1) : r * (q + 1) + (xcd - r) * q) + off; }
        const int nig = WGM * nN, gid = wgid / nig, fm = gid * WGM, gsz = (nM - fm) < WGM ? (nM - fm) : WGM;
        u.pm = fm + ((wgid % nig) % gsz); u.pn = (wgid % nig) / gsz; return true;
    }
    __device__ __forceinline__ void a_ready(const Unit&) const {}
    __device__ __forceinline__ void done(const Unit&) const {}
};

__device__ __forceinline__ unsigned cvt_pk_bf16(float lo, float hi) { unsigned r; asm volatile("v_cvt_pk_bf16_f32 %0, %1, %2" : "=v"(r) : "v"(lo), "v"(hi)); return r; }
struct EpiBf16S {
    static constexpr bool PERM = true, AFTER_DRAIN = false, HAS_INIT = false;
    bf16_t* O; int ldc;
    __device__ __forceinline__ void operator()(const f32x4 (&acc)[2][2][4][2], const Unit& u, int wr, int wc, int fr, int fq) const {
        const int row0 = u.pm * BM + wr * 64 + fr, col0 = u.pn * BM + wc * 32 + 8 * fq;
#pragma unroll
        for (int ai = 0; ai < 2; ++ai)
#pragma unroll
            for (int m = 0; m < 4; ++m) { bf16_t* rowp = O + (size_t)(row0 + ai * HALF + m * 16) * ldc + col0;
#pragma unroll
                for (int bj = 0; bj < 2; ++bj) { const f32x4 v0 = acc[ai][bj][m][0], v1 = acc[ai][bj][m][1];
                    u32x4 w; w.x = cvt_pk_bf16(v0[0], v0[1]); w.y = cvt_pk_bf16(v0[2], v0[3]); w.z = cvt_pk_bf16(v1[0], v1[1]); w.w = cvt_pk_bf16(v1[2], v1[3]);
                    *(u32x4*)(rowp + bj * HALF) = w; } }
    }
};
struct EpiResF32 {
    static constexpr bool PERM = false, AFTER_DRAIN = false, HAS_INIT = true;
    const float* base; float* out; int ldc;
    __device__ __forceinline__ void init(f32x4 (&acc)[2][2][4][2], const Unit& u, int wr, int wc, int fr, int fq) const {
        const int row0 = u.pm * BM + wr * 64 + fr, col0 = u.pn * BM + wc * 32 + 4 * fq;
#pragma unroll
        for (int ai = 0; ai < 2; ++ai)
#pragma unroll
            for (int m = 0; m < 4; ++m) { const size_t off = (size_t)(row0 + ai * HALF + m * 16) * ldc + col0;
#pragma unroll
                for (int bj = 0; bj < 2; ++bj)
#pragma unroll
                    for (int n = 0; n < 2; ++n) acc[ai][bj][m][n] = *(const f32x4*)(base + off + bj * HALF + n * 16); }
    }
    __device__ __forceinline__ void operator()(const f32x4 (&acc)[2][2][4][2], const Unit& u, int wr, int wc, int fr, int fq) const {
        const int row0 = u.pm * BM + wr * 64 + fr, col0 = u.pn * BM + wc * 32 + 4 * fq;
#pragma unroll
        for (int ai = 0; ai < 2; ++ai)
#pragma unroll
            for (int m = 0; m < 4; ++m) { const size_t off = (size_t)(row0 + ai * HALF + m * 16) * ldc + col0;
#pragma unroll
                for (int bj = 0; bj < 2; ++bj)
#pragma unroll
                    for (int n = 0; n < 2; ++n) *(f32x4*)(out + off + bj * HALF + n * 16) = acc[ai][bj][m][n]; }
    }
};
template <class Epi, class Sched, bool ALIGN_EPI = false, bool SP2 = false>
__device__ __forceinline__ void gemm_phase(PG8_LAS unsigned char* lds, const Gemm g, const Sched& S, const Epi& E, const int mk_wave_id  ) {
    const int wid = mk_wave_id, lane = mk_lane_pg8(), tid = wid * 64 + lane, wr = wid >> 2, wc = wid & 3, fr = lane & 15, fq = lane >> 4;
    const int K = g.K, nt = K / BK;
    unsigned voffA[2], voffB[2];
#pragma unroll
    for (int i = 0; i < 2; ++i) { int R, C; stage_rc(tid * 16 + i * 8192, R, C); const int Rb = Epi::PERM ? ((R & ~31) + perm32(R & 31)) : R;
        voffA[i] = (unsigned)(R * K + C) * 2u; voffB[i] = (unsigned)(Rb * K + C) * 2u; }
    const size_t kstep = (size_t)(BK * 2);
    const size_t hstep = (size_t)HALF * K * 2;
    const size_t tstep = 2 * hstep;
    const unsigned ldsw = (unsigned)wid * 1024u;
    const int aoff = lds_byte(wr * 64 + fr, fq * 8), boff = lds_byte(wc * 32 + fr, fq * 8);
#define PG8_SA(b, h) (((b) * 2 + (h)) * HTB)
#define PG8_SB(b, h) ((4 + (b) * 2 + (h)) * HTB)
#define PG8_STAGE(bufoff, gbase, voff) do { _Pragma("unroll") for (int _i = 0; _i < 2; ++_i) \
        __builtin_amdgcn_global_load_lds((const unsigned*)((const char*)(gbase) + (voff)[_i]), (PG8_LAS unsigned*)(lds + (bufoff) + ldsw + _i * 8192), 16, 0, 0); } while (0)
#define PG8_LDA(dst, b, h) do { _Pragma("unroll") for (int m = 0; m < 4; ++m) _Pragma("unroll") for (int k = 0; k < 2; ++k) dst[m][k] = *(const PG8_LAS bf16x8*)(lds + PG8_SA(b, h) + aoff + m * 2048 + k * 1024); } while (0)
#define PG8_LDB(dst, b, h) do { _Pragma("unroll") for (int n = 0; n < 2; ++n) _Pragma("unroll") for (int k = 0; k < 2; ++k) dst[n][k] = *(const PG8_LAS bf16x8*)(lds + PG8_SB(b, h) + boff + n * 2048 + k * 1024); } while (0)
#define PG8_MMA(ai, bj, At, Bt) do { __builtin_amdgcn_s_setprio(1); _Pragma("unroll") for (int m = 0; m < 4; ++m) _Pragma("unroll") for (int n = 0; n < 2; ++n) _Pragma("unroll") for (int k = 0; k < 2; ++k) \
        acc[ai][bj][m][n] = __builtin_amdgcn_mfma_f32_16x16x32_bf16(Bt[n][k], At[m][k], acc[ai][bj][m][n], 0, 0, 0); __builtin_amdgcn_s_setprio(0); } while (0)
#define PG8_WAIT_V(n) asm volatile("s_waitcnt vmcnt(" #n ")" ::: "memory")
#define PG8_WAIT_L(n) asm volatile("s_waitcnt lgkmcnt(" #n ")" ::: "memory")
#define PG8_BAR __builtin_amdgcn_s_barrier()
#define PG8_SCHED __builtin_amdgcn_sched_barrier(0)
    Unit cur, nxt; int ui = 0;
    if (!S.next(0, cur)) return;
    f32x4 acc[2][2][4][2];
#pragma unroll
    for (int a = 0; a < 2; ++a)
#pragma unroll
        for (int b = 0; b < 2; ++b)
#pragma unroll
            for (int m = 0; m < 4; ++m)
#pragma unroll
                for (int n = 0; n < 2; ++n) acc[a][b][m][n] = (f32x4){0.f, 0.f, 0.f, 0.f};
    if constexpr (Epi::HAS_INIT) E.init(acc, cur, wr, wc, fr, fq);
    bf16x8 At[4][2], B0[2][2], B1[2][2];
    const char* cA = (const char*)g.A + (size_t)cur.pm * tstep; const char* cB = (const char*)g.Bt + (size_t)cur.pn * tstep;
    S.a_ready(cur);
    if constexpr (SP2) {
        PG8_STAGE(PG8_SB(0, 0), cB, voffB); PG8_STAGE(PG8_SB(0, 1), cB + hstep, voffB); PG8_STAGE(PG8_SA(0, 0), cA, voffA); PG8_STAGE(PG8_SA(0, 1), cA + hstep, voffA);
        if (wr == 1) PG8_BAR;
        PG8_WAIT_V(2); PG8_BAR;
        PG8_STAGE(PG8_SB(1, 0), cB + kstep, voffB); PG8_STAGE(PG8_SA(1, 0), cA + kstep, voffA); PG8_STAGE(PG8_SB(1, 1), cB + hstep + kstep, voffB);
        PG8_WAIT_V(6); PG8_BAR;
    } else {
        PG8_STAGE(PG8_SB(0, 0), cB, voffB); PG8_STAGE(PG8_SA(0, 0), cA, voffA); PG8_STAGE(PG8_SB(0, 1), cB + hstep, voffB); PG8_STAGE(PG8_SA(0, 1), cA + hstep, voffA);
        if (wr == 1) PG8_BAR;
        PG8_WAIT_V(4); PG8_BAR;
        PG8_STAGE(PG8_SB(1, 0), cB + kstep, voffB); PG8_STAGE(PG8_SA(1, 0), cA + kstep, voffA); PG8_STAGE(PG8_SB(1, 1), cB + hstep + kstep, voffB);
        PG8_WAIT_V(6); PG8_BAR;
    }
    for (;;) {
        const bool has_next = S.next(ui + 1, nxt);
        const char* nA = has_next ? (const char*)g.A + (size_t)nxt.pm * tstep : cA; const char* nB = has_next ? (const char*)g.Bt + (size_t)nxt.pn * tstep : cB;
        for (int t = 0; t < nt; t += 2) {
            const bool last = (t == nt - 2);
            const char* a1 = cA + (size_t)(t + 1) * kstep;
            const char* a2 = last ? nA : cA + (size_t)(t + 2) * kstep; const char* b2 = last ? nB : cB + (size_t)(t + 2) * kstep;
            const char* a3 = a2 + kstep; const char* b3 = b2 + kstep;
            if (last && has_next) S.a_ready(nxt);
            if constexpr (SP2) {
            PG8_LDB(B0, 0, 0); PG8_LDB(B1, 0, 1); PG8_SCHED; PG8_LDA(At, 0, 0); PG8_STAGE(PG8_SA(1, 1), a1 + hstep, voffA);
            PG8_WAIT_V(8); PG8_WAIT_L(0); PG8_BAR; PG8_MMA(0, 0, At, B0); PG8_MMA(0, 1, At, B1); PG8_BAR; PG8_SCHED;
            PG8_LDA(At, 0, 1); PG8_STAGE(PG8_SB(0, 0), b2, voffB); PG8_STAGE(PG8_SB(0, 1), b2 + hstep, voffB); PG8_STAGE(PG8_SA(0, 0), a2, voffA);
            PG8_WAIT_V(8); PG8_WAIT_L(0); PG8_BAR; PG8_MMA(1, 0, At, B0); PG8_MMA(1, 1, At, B1); PG8_BAR; PG8_SCHED;
            PG8_LDB(B0, 1, 0); PG8_LDB(B1, 1, 1); PG8_SCHED; PG8_LDA(At, 1, 0); PG8_STAGE(PG8_SA(0, 1), a2 + hstep, voffA);
            PG8_WAIT_V(8); PG8_WAIT_L(0); PG8_BAR; PG8_MMA(0, 0, At, B0); PG8_MMA(0, 1, At, B1); PG8_BAR; PG8_SCHED;
            PG8_LDA(At, 1, 1); PG8_STAGE(PG8_SB(1, 0), b3, voffB); PG8_STAGE(PG8_SB(1, 1), b3 + hstep, voffB); PG8_STAGE(PG8_SA(1, 0), a3, voffA);
            PG8_WAIT_V(8); PG8_WAIT_L(0); PG8_BAR; PG8_MMA(1, 0, At, B0); PG8_MMA(1, 1, At, B1); PG8_BAR; PG8_SCHED;
            } else {
            PG8_LDB(B0, 0, 0); PG8_SCHED; PG8_LDA(At, 0, 0); PG8_STAGE(PG8_SA(1, 1), a1 + hstep, voffA);
            PG8_WAIT_L(8); PG8_BAR; PG8_WAIT_L(0); PG8_MMA(0, 0, At, B0); PG8_BAR; PG8_SCHED;
            PG8_LDB(B1, 0, 1); PG8_STAGE(PG8_SB(0, 0), b2, voffB);
            PG8_BAR; PG8_WAIT_L(0); PG8_MMA(0, 1, At, B1); PG8_BAR;
            PG8_LDA(At, 0, 1); PG8_STAGE(PG8_SA(0, 0), a2, voffA);
            PG8_BAR; PG8_WAIT_L(0); PG8_MMA(1, 0, At, B0); PG8_BAR; PG8_SCHED;
            PG8_STAGE(PG8_SB(0, 1), b2 + hstep, voffB);
            PG8_WAIT_V(6); PG8_BAR; PG8_MMA(1, 1, At, B1); PG8_BAR;
            PG8_LDB(B0, 1, 0); PG8_SCHED; PG8_LDA(At, 1, 0); PG8_STAGE(PG8_SA(0, 1), a2 + hstep, voffA);
            PG8_WAIT_L(8); PG8_BAR; PG8_WAIT_L(0); PG8_MMA(0, 0, At, B0); PG8_BAR; PG8_SCHED;
            PG8_LDB(B1, 1, 1); PG8_STAGE(PG8_SB(1, 0), b3, voffB);
            PG8_BAR; PG8_WAIT_L(0); PG8_MMA(0, 1, At, B1); PG8_BAR;
            PG8_LDA(At, 1, 1); PG8_STAGE(PG8_SA(1, 0), a3, voffA);
            PG8_BAR; PG8_WAIT_L(0); PG8_MMA(1, 0, At, B0); PG8_BAR; PG8_SCHED;
            PG8_STAGE(PG8_SB(1, 1), b3 + hstep, voffB);
            PG8_WAIT_V(6); PG8_BAR; PG8_MMA(1, 1, At, B1); PG8_BAR;
            }
        }
        if constexpr (ALIGN_EPI) { if (wr == 0) PG8_BAR; }
        if constexpr (!Epi::AFTER_DRAIN) { E(acc, cur, wr, wc, fr, fq); S.done(cur); }
        if (!has_next) break;
#pragma unroll
        for (int a = 0; a < 2; ++a)
#pragma unroll
            for (int b = 0; b < 2; ++b)
#pragma unroll
                for (int m = 0; m < 4; ++m)
#pragma unroll
                    for (int n = 0; n < 2; ++n) acc[a][b][m][n] = (f32x4){0.f, 0.f, 0.f, 0.f};
        if constexpr (Epi::HAS_INIT) E.init(acc, nxt, wr, wc, fr, fq);
        cur = nxt; cA = nA; cB = nB; ++ui;
        if constexpr (ALIGN_EPI) { if (wr == 1) PG8_BAR; }
    }
    PG8_WAIT_V(0);
    if constexpr (!ALIGN_EPI) { if (wr == 0) PG8_BAR; }
    PG8_BAR;
    if constexpr (Epi::AFTER_DRAIN) { E.fused(acc, cur, wr, wc, fr, fq, lds, wid, lane); S.done(cur); }
#undef PG8_SA
#undef PG8_SB
#undef PG8_STAGE
#undef PG8_LDA
#undef PG8_LDB
#undef PG8_MMA
#undef PG8_WAIT_V
#undef PG8_WAIT_L
#undef PG8_BAR
#undef PG8_SCHED
}
}
constexpr int NWAVES = 8;
#ifndef MK_N_LAUNCHES
#define MK_N_LAUNCHES 1
#endif
constexpr int N_PHASES = 5;
constexpr int BATCH = 8, T = 2048, D = 1024, M = BATCH * T;
constexpr int NP = 4352;
constexpr int C_R = 0, C_K = 512, C_V = 1024, C_ZW = 1536, C_ZA = 1600, C_GA = 1792, C_DQ = 2304, C_DK = 2816, C_DV = 3328, C_GB = 3840;
constexpr int RH = 8, RN = 64;
constexpr int AH = 4;
constexpr float C2 = 0.125f * 1.4426950408889634f;
constexpr float LOG2E = 1.4426950408889634f;
constexpr float LAMBDA_INIT = 0.2f;

constexpr size_t MiB = 1u << 20;
constexpr size_t WS_CTL = 0, CTL_ZERO_BYTES = 1 * MiB;
constexpr size_t WS_WIN = 2 * MiB;
constexpr size_t WS_WOUT = 11 * MiB;
constexpr size_t WS_WD = 13 * MiB, WS_WA = 13 * MiB + 65536;
constexpr size_t WS_RHO = 13 * MiB + 2 * 65536;
constexpr size_t WS_XN = 14 * MiB;
constexpr size_t WS_PROJ = 46 * MiB;
constexpr size_t WS_MIX = 182 * MiB;
constexpr size_t WS_END = 214 * MiB;
constexpr int CW_BAR = 4096;

constexpr int RING_OFF = 0, RING_BYTES = 131072;
constexpr int LDSCTL_OFF = RING_BYTES, MISC_OFF = LDSCTL_OFF + 320;
constexpr int LDS_BYTES = 155648;

#define GAS __attribute__((address_space(1)))
#define LAS __attribute__((address_space(3)))
typedef unsigned short bf16;
typedef unsigned v4u __attribute__((ext_vector_type(4)));
typedef unsigned v2u __attribute__((ext_vector_type(2)));
typedef float f32x4 __attribute__((ext_vector_type(4)));
typedef float f32x16 __attribute__((ext_vector_type(16)));
typedef short bf16x8 __attribute__((ext_vector_type(8)));
typedef short s16x4 __attribute__((ext_vector_type(4)));
typedef GAS unsigned gu32;
typedef GAS unsigned long long gu64;
#define RLX_AGENT __ATOMIC_RELAXED, __HIP_MEMORY_SCOPE_AGENT
#define LDS_WAIT() asm volatile("s_waitcnt lgkmcnt(0)" ::: "memory")
#define VM_WAIT() asm volatile("s_waitcnt vmcnt(0)" ::: "memory")
__device__ __forceinline__ unsigned f2bf(float f) { unsigned u = __builtin_bit_cast(unsigned, f); return (u + 0x7fffu + ((u >> 16) & 1u)) >> 16; }
__device__ __forceinline__ unsigned pk2(float lo, float hi) { return f2bf(lo) | (f2bf(hi) << 16); }
__device__ __forceinline__ float bflo(unsigned u) { return __uint_as_float(u << 16); }
__device__ __forceinline__ float bfhi(unsigned u) { return __uint_as_float(u & 0xffff0000u); }
__device__ __forceinline__ float bf1(unsigned short u) { return __uint_as_float((unsigned)u << 16); }
__device__ __forceinline__ int mk_lane() { int l; asm volatile("v_mbcnt_lo_u32_b32 %0, -1, 0\n\tv_mbcnt_hi_u32_b32 %0, -1, %0" : "=v"(l)); return l; }
#define XB_TMO      128
#define XB_XCNT(j)  (256  + 64 * (j))
#define XB_XSUB(j)  (1280 + 64 * (j))
#define XB_XGEN(j)  (2304 + 64 * (j))
#define XB_TOP      3328
#define XB_TOPGEN   3392
#define XCD_BAR_WORDS 3456
#define XB_SPIN_CAP (1u << 18)

__device__ __forceinline__ unsigned xb_ld(unsigned* p)              { return __hip_atomic_load(p, __ATOMIC_RELAXED, __HIP_MEMORY_SCOPE_AGENT); }
__device__ __forceinline__ unsigned xb_add(unsigned* p, unsigned v) { return __hip_atomic_fetch_add(p, v, __ATOMIC_RELAXED, __HIP_MEMORY_SCOPE_AGENT); }
__device__ __forceinline__ unsigned xb_xcc_id() { return (unsigned)__builtin_amdgcn_s_getreg((3 << 11) | 20) & 0xFu; }
#define XB_SPIN(cond, bar) do { unsigned _sp = 0; while (cond) { __builtin_amdgcn_s_sleep(1); \
    if ((++_sp & 255u) == 0u) { if (xb_ld(&(bar)[XB_TMO])) break; if (_sp > XB_SPIN_CAP) { atomicAdd(&(bar)[XB_TMO], 1u); break; } } } } while (0)

struct XcdBarrier {
    unsigned* bar; unsigned x;
    volatile LAS unsigned* st;
    int wave;
};

__device__ __forceinline__ XcdBarrier xcd_barrier_post(unsigned* bar, volatile LAS unsigned* st, int wave) {
    XcdBarrier b; b.bar = bar; b.x = xb_xcc_id(); b.st = st; b.wave = wave;
    if (wave == 0 && mk_lane() == 0) (void)xb_add(&bar[XB_XCNT(b.x)], 1u);
    return b;
}
__device__ __forceinline__ void xcd_barrier_complete(unsigned* bar, unsigned x, unsigned& nloc, unsigned& nx) {
    const unsigned G = gridDim.x * gridDim.y * gridDim.z;
    unsigned sum, cnt, mine, sp = 0u;
    for (;;) {
        sum = 0u; cnt = 0u; mine = 0u;
#pragma unroll
        for (unsigned j = 0; j < 16; ++j) { const unsigned c = xb_ld(&bar[XB_XCNT(j)]); sum += c; cnt += (c > 0u) ? 1u : 0u; mine = (j == x) ? c : mine; }
        if (sum == G) break;
        __builtin_amdgcn_s_sleep(1);
        if ((++sp & 255u) == 0u) { if (xb_ld(&bar[XB_TMO])) break; if (sp > XB_SPIN_CAP) { atomicAdd(&bar[XB_TMO], 1u); break; } }
    }
    nloc = mine > 0u ? mine : 1u; nx = cnt > 0u ? cnt : 1u;
}

__device__ __forceinline__ void xcd_barrier(const XcdBarrier& b) {
    asm volatile("s_waitcnt vmcnt(0)" ::: "memory");
    __syncthreads();
    if (b.wave == 0 && mk_lane() == 0) {
        unsigned* bar = b.bar;
        __builtin_amdgcn_s_waitcnt(0);
        unsigned nloc = b.st[0], nx = b.st[1];
        if (nloc == 0u) { xcd_barrier_complete(bar, b.x, nloc, nx); b.st[0] = nloc; b.st[1] = nx; }
        const unsigned old = xb_add(&bar[XB_XSUB(b.x)], 1u);
        const unsigned gen = old / nloc;
        if (old + 1u == (gen + 1u) * nloc) {
            __builtin_amdgcn_fence(__ATOMIC_RELEASE, "agent");
            asm volatile("s_waitcnt vmcnt(0)" ::: "memory");
            const unsigned og = xb_add(&bar[XB_TOP], 1u);
            const unsigned tg = og / nx;
            if (og + 1u == (tg + 1u) * nx) xb_add(&bar[XB_TOPGEN], 1u);
            else XB_SPIN(xb_ld(&bar[XB_TOPGEN]) == tg, bar);
            __builtin_amdgcn_fence(__ATOMIC_ACQUIRE, "agent");
            xb_add(&bar[XB_XGEN(b.x)], 1u);
            asm volatile("s_waitcnt vmcnt(0)" ::: "memory");
        } else {
            XB_SPIN(xb_ld(&bar[XB_XGEN(b.x)]) == gen, bar);
            __builtin_amdgcn_fence(__ATOMIC_ACQUIRE, "agent");
            asm volatile("s_waitcnt vmcnt(0)" ::: "memory");
        }
    }
    __syncthreads();
}
struct Frame {
    LAS unsigned char* lds;
    volatile LAS unsigned* MISC;
    gu32* ctl;
    int tid, lane, wave;
    int vcu, G;
    const float* x; float* out;
    const float *norm_g, *w_in, *shift_mu, *w0, *w_decay_up, *a0, *w_iclr_up, *k_k, *k_a, *r_k, *ln_w, *ln_b, *qn_g, *kn_g, *lq1, *lk1, *lq2, *lk2, *subln_g, *w_out;
    bf16 *WinT, *WoutT, *WdT, *WaT, *XN, *PROJ, *MIX;
};

typedef float f32x2q_t __attribute__((ext_vector_type(2))); typedef __bf16 bf16x2q_t __attribute__((ext_vector_type(2)));
__device__ __forceinline__ unsigned cvtpk2(float lo, float hi) { f32x2q_t v = {lo, hi}; bf16x2q_t b = __builtin_convertvector(v, bf16x2q_t); return __builtin_bit_cast(unsigned, b); }
__device__ __forceinline__ float wave_sum(float v) {
#pragma unroll
    for (int o = 1; o < 64; o <<= 1) v += __shfl_xor(v, o);
    return v;
}
template <int CTRL> __device__ __forceinline__ float dpp_f(float x) { return __builtin_bit_cast(float, __builtin_amdgcn_mov_dpp(__builtin_bit_cast(int, x), CTRL, 0xf, 0xf, true)); }
__device__ __forceinline__ float row16_sum(float x) {
    x += dpp_f<0xB1>(x); x += dpp_f<0x4E>(x); x += dpp_f<0x141>(x); x += dpp_f<0x140>(x); return x;
}
__device__ __forceinline__ float swap32_sum(float x) {
    auto rr = __builtin_amdgcn_permlane32_swap(__float_as_uint(x), __float_as_uint(x), false, false);
    return __uint_as_float(rr[0]) + __uint_as_float(rr[1]);
}

__device__ __forceinline__ void p0_transpose_item(const float* W, int N, int nsrc, const float* kscale, bf16* WT, int K, int ndst, LAS float* scr, int k0, int lane) {
    float v[32];
#pragma unroll
    for (int i = 0; i < 32; ++i) { const int kk = 2 * i + (lane >> 5); v[i] = (nsrc >= 0) ? W[(size_t)(k0 + kk) * N + nsrc + (lane & 31)] : 0.f; }
    if (kscale && nsrc >= 0) {
#pragma unroll
        for (int i = 0; i < 32; ++i) v[i] *= kscale[k0 + 2 * i + (lane >> 5)];
    }
#pragma unroll
    for (int i = 0; i < 32; ++i) scr[(2 * i + (lane >> 5)) * 33 + (lane & 31)] = v[i];
    LDS_WAIT(); asm volatile("" ::: "memory");
    const int c = lane & 7;
#pragma unroll
    for (int j = 0; j < 4; ++j) { const int n = (lane >> 3) + 8 * j; const LAS float* s = scr + (8 * c) * 33 + n;
        v4u o; o.x = cvtpk2(s[0 * 33], s[1 * 33]); o.y = cvtpk2(s[2 * 33], s[3 * 33]); o.z = cvtpk2(s[4 * 33], s[5 * 33]); o.w = cvtpk2(s[6 * 33], s[7 * 33]);
        *(GAS v4u*)(WT + (size_t)(ndst + n) * K + k0 + 8 * c) = o; }
    LDS_WAIT(); asm volatile("" ::: "memory");
}
__device__ __forceinline__ void p0_rows4(Frame& F, int m0) {
    f32x4 v[4][4]; float s[4];
#pragma unroll
    for (int u = 0; u < 4; ++u) { const GAS f32x4* xr = (const GAS f32x4*)(F.x + (size_t)(m0 + u) * D) + F.lane;
#pragma unroll
        for (int j = 0; j < 4; ++j) v[u][j] = __builtin_nontemporal_load(xr + 64 * j); }
#pragma unroll
    for (int u = 0; u < 4; ++u) { float a = 0.f;
#pragma unroll
        for (int j = 0; j < 4; ++j) a += (v[u][j].x * v[u][j].x + v[u][j].y * v[u][j].y) + (v[u][j].z * v[u][j].z + v[u][j].w * v[u][j].w);
        s[u] = a; }
#pragma unroll
    for (int u = 0; u < 4; ++u) {
        const float rstd = __builtin_amdgcn_rsqf(wave_sum(s[u]) * (1.f / D) + 1e-6f);
        GAS unsigned long long* o8 = (GAS unsigned long long*)(F.XN + (size_t)(m0 + u) * D) + F.lane;
#pragma unroll
        for (int j = 0; j < 4; ++j) o8[64 * j] = (unsigned long long)cvtpk2(v[u][j].x * rstd, v[u][j].y * rstd) | ((unsigned long long)cvtpk2(v[u][j].z * rstd, v[u][j].w * rstd) << 32);
    }
}
__device__ __forceinline__ void p0_prologue(Frame& F) {
    LAS float* scr = (LAS float*)(F.lds + RING_OFF + F.wave * 16384);
    const int gw = F.vcu * NWAVES + F.wave, NGW = F.G * NWAVES;
    constexpr int I_IN = (D / 64) * (NP / 32), I_OUT = (D / 64) * (D / 32), I_L = 512 / 32;
    constexpr int NITEMS = I_IN + I_OUT + 2 * I_L;
    int m0 = gw * 4;
    if (!(gw & 1) && m0 < M) { p0_rows4(F, m0); m0 += NGW * 4; }
#pragma unroll 1
    for (int it = gw; it < NITEMS; it += NGW) {
        int r = it;
        if (r < I_IN) { const int kb = r / (NP / 32), nb = r % (NP / 32), nd = 32 * nb; const int ns = nd < 1664 ? nd : (nd < 1792 ? -1 : nd - 128);
            p0_transpose_item(F.w_in, 4224, ns, F.norm_g, F.WinT, D, nd, scr, 64 * kb, F.lane); continue; } r -= I_IN;
        if (r < I_OUT) { const int kb = r / (D / 32), nb = r % (D / 32);
            p0_transpose_item(F.w_out, D, 32 * nb, nullptr, F.WoutT, D, 32 * nb, scr, 64 * kb, F.lane); continue; } r -= I_OUT;
        if (r < I_L) { p0_transpose_item(F.w_decay_up, 512, 32 * r, nullptr, F.WdT, 64, 32 * r, scr, 0, F.lane); continue; } r -= I_L;
        p0_transpose_item(F.w_iclr_up, 512, 32 * r, nullptr, F.WaT, 64, 32 * r, scr, 0, F.lane);
    }
#pragma unroll 1
    for (; m0 < M; m0 += NGW * 4) p0_rows4(F, m0);
}

__device__ __forceinline__ float tanh_f(float x) { const float e = __expf(-2.f * fabsf(x)); const float t = (1.f - e) * __builtin_amdgcn_rcpf(1.f + e); return x < 0.f ? -t : t; }
__device__ __forceinline__ void shifted8(const bf16* proj, size_t m, bool has_prev, int col, const float* mu, float (&o)[8]) {
    const v4u c = *(const GAS v4u*)(proj + m * NP + col);
    v4u p = (v4u){0u, 0u, 0u, 0u}; if (has_prev) p = *(const GAS v4u*)(proj + (m - 1) * NP + col);
    const f32x4 m0 = *(const GAS f32x4*)(mu), m1 = *(const GAS f32x4*)(mu + 4);
    const unsigned cw[4] = {c.x, c.y, c.z, c.w}, pw[4] = {p.x, p.y, p.z, p.w}; const float mm[8] = {m0.x, m0.y, m0.z, m0.w, m1.x, m1.y, m1.z, m1.w};
#pragma unroll
    for (int j = 0; j < 4; ++j) { const float c0 = bflo(cw[j]), c1 = bfhi(cw[j]), p0 = bflo(pw[j]), p1 = bfhi(pw[j]);
        o[2 * j] = c0 + (p0 - c0) * mm[2 * j]; o[2 * j + 1] = c1 + (p1 - c1) * mm[2 * j + 1]; }
}
__device__ __forceinline__ void shifted4(const bf16* proj, size_t m, bool has_prev, int col, const float* mu, float (&o)[4]) {
    const v2u c = *(const GAS v2u*)(proj + m * NP + col);
    v2u p = (v2u){0u, 0u}; if (has_prev) p = *(const GAS v2u*)(proj + (m - 1) * NP + col);
    const f32x4 m0 = *(const GAS f32x4*)(mu);
    o[0] = bflo(c.x) + (bflo(p.x) - bflo(c.x)) * m0.x; o[1] = bfhi(c.x) + (bfhi(p.x) - bfhi(c.x)) * m0.y;
    o[2] = bflo(c.y) + (bflo(p.y) - bflo(c.y)) * m0.z; o[3] = bfhi(c.y) + (bfhi(p.y) - bfhi(c.y)) * m0.w;
}
__device__ __forceinline__ void p2_qknorm(Frame& F) {
    const int gw = F.vcu * NWAVES + F.wave, NGW = F.G * NWAVES, lane = F.lane, sub = lane & 7;
    const f32x4 gk0 = *(const GAS f32x4*)(F.kn_g + sub * 8), gk1 = *(const GAS f32x4*)(F.kn_g + sub * 8 + 4);
    constexpr int UQ = 4;
    for (int it0 = gw * UQ; it0 < M; it0 += NGW * UQ) {
        bf16* p[UQ]; v4u c[UQ];
#pragma unroll
        for (int u = 0; u < UQ; ++u) { const size_t m = (size_t)(it0 + u); p[u] = F.PROJ + m * NP + C_DK + (lane >> 3) * 64 + sub * 8; c[u] = *(const GAS v4u*)p[u]; }
#pragma unroll
        for (int u = 0; u < UQ; ++u) {
            const unsigned cw[4] = {c[u].x, c[u].y, c[u].z, c[u].w};
            float xv[8]; float ss = 0.f;
#pragma unroll
            for (int j = 0; j < 4; ++j) { xv[2 * j] = bflo(cw[j]); xv[2 * j + 1] = bfhi(cw[j]); ss += xv[2 * j] * xv[2 * j] + xv[2 * j + 1] * xv[2 * j + 1]; }
            ss += dpp_f<0xB1>(ss); ss += dpp_f<0x4E>(ss); ss += dpp_f<0x141>(ss);
            const float r = __builtin_amdgcn_rsqf(ss * (1.f / 64.f) + 1e-6f);
            v4u o; o.x = cvtpk2(xv[0] * r * gk0.x, xv[1] * r * gk0.y); o.y = cvtpk2(xv[2] * r * gk0.z, xv[3] * r * gk0.w); o.z = cvtpk2(xv[4] * r * gk1.x, xv[5] * r * gk1.y); o.w = cvtpk2(xv[6] * r * gk1.z, xv[7] * r * gk1.w);
            *(GAS v4u*)p[u] = o;
        }
    }
}
typedef float f32x2_t __attribute__((ext_vector_type(2))); typedef __bf16 bf16x2_t __attribute__((ext_vector_type(2)));
__device__ __forceinline__ unsigned cvtpk(float lo, float hi) { f32x2_t v = {lo, hi}; bf16x2_t b = __builtin_convertvector(v, bf16x2_t); return __builtin_bit_cast(unsigned, b); }
#define MFMA32(a, b, c) __builtin_amdgcn_mfma_f32_32x32x16_bf16(__builtin_bit_cast(bf16x8, (a)), __builtin_bit_cast(bf16x8, (b)), (c), 0, 0, 0)
#define FRAGACC(z, s) ((v4u){cvtpk((z)[8 * (s)], (z)[8 * (s) + 1]), cvtpk((z)[8 * (s) + 2], (z)[8 * (s) + 3]), cvtpk((z)[8 * (s) + 4], (z)[8 * (s) + 5]), cvtpk((z)[8 * (s) + 6], (z)[8 * (s) + 7])})
template <int CTRL, int RM> __device__ __forceinline__ float dpp_upd0(float x) { return __builtin_bit_cast(float, __builtin_amdgcn_update_dpp(0, __builtin_bit_cast(int, x), CTRL, RM, 0xf, false)); }
__device__ __forceinline__ float scan32(float x) {
    x += dpp_upd0<0x111, 0xf>(x); x += dpp_upd0<0x112, 0xf>(x); x += dpp_upd0<0x114, 0xf>(x); x += dpp_upd0<0x118, 0xf>(x); x += dpp_upd0<0x142, 0xa>(x); return x;
}
__device__ __forceinline__ void st_wt16(v4u* p, const v4u v) { *(GAS v4u*)p = v; }
constexpr int RW_UNITS = BATCH * RH * (T / 32);
struct RwDump { v4u* PF; v4u* DD; v4u* QF; v4u* YD; float* GAM; float* RHO; };

__device__ __forceinline__ void rwkvA_unit(Frame& F, const RwDump& Dm, int bh, int ci, LAS float* wscr, LAS unsigned char* park, LAS v4u* zsh, int zpar) {
    int lane = mk_lane(); asm volatile("" : "+v"(lane));
    const int hi = lane >> 5, l31 = lane & 31, b = bh >> 3, w = bh & 7;
    LAS v4u* pk = (LAS v4u*)park + lane;
#define PARK(slot) pk[(slot) * 64]
    int tok = 0; asm volatile("" : "+v"(tok));
#define DEP(x) asm volatile("" : "+v"(tok) : "v"(x))
    const int t = ci * 32 + l31; const size_t m = (size_t)b * T + t; const bool hp = t > 0;
    const int u = ci * (BATCH * RH) + bh;
    const float pm = hp ? 1.f : 0.f;
    const bf16* pc = F.PROJ + m * NP + w * 64 + 4 * hi; const bf16* pp = F.PROJ + (hp ? m - 1 : m) * NP + w * 64 + 4 * hi;
    const float* mu = F.shift_mu + w * 64 + 4 * hi;
    const float *pw0 = F.w0 + w * 64 + 4 * hi, *pa0 = F.a0 + w * 64 + 4 * hi, *pkk = F.k_k + w * 64 + 4 * hi, *pka = F.k_a + w * 64 + 4 * hi, *prk = F.r_k + w * 64 + 4 * hi;
#define SH4(dst, COL, MU, OFF) do { const v2u c_ = *(const GAS v2u*)(pc + tok + (COL) + (OFF)), p_ = *(const GAS v2u*)(pp + tok + (COL) + (OFF)); const f32x4 m_ = *(const GAS f32x4*)(mu + tok + (MU) + (OFF)); \
        dst[0] = bflo(c_.x) + (bflo(p_.x) * pm - bflo(c_.x)) * m_.x; dst[1] = bfhi(c_.x) + (bfhi(p_.x) * pm - bfhi(c_.x)) * m_.y; \
        dst[2] = bflo(c_.y) + (bflo(p_.y) * pm - bflo(c_.y)) * m_.z; dst[3] = bfhi(c_.y) + (bfhi(p_.y) * pm - bfhi(c_.y)) * m_.w; } while (0)
    float ss = 0.f;
#pragma unroll
    for (int gq = 0; gq < 8; ++gq) { float k4[4]; SH4(k4, C_K, 512, 8 * gq); const f32x4 kkp = *(const GAS f32x4*)(pkk + tok + 8 * gq);
#pragma unroll
        for (int e = 0; e < 4; ++e) { const float q = k4[e] * kkp[e]; ss += q * q; }
        if (gq == 3) DEP(ss); }
    ss = swap32_sum(ss);
    const float inv = __builtin_amdgcn_rcpf(fmaxf(__builtin_amdgcn_sqrtf(ss), 1e-12f));
    asm volatile("" ::: "memory");
    v4u bz[4], ba[4];
    { const int s = F.wave >> 1; const bool which = (F.wave & 1) != 0;
      const bf16* zc = F.PROJ + m * NP + 8 * hi; const bf16* zp = F.PROJ + (hp ? m - 1 : m) * NP + 8 * hi; const float* zmu = F.shift_mu + 8 * hi;
      const int COL = (which ? C_ZA : C_ZW) + 16 * s, MUO = (which ? 1600 : 1536) + 16 * s;
      const v4u c = *(const GAS v4u*)(zc + tok + COL), p = *(const GAS v4u*)(zp + tok + COL); const f32x4 m0 = *(const GAS f32x4*)(zmu + tok + MUO), m1 = *(const GAS f32x4*)(zmu + tok + MUO + 4);
      float z[8];
#pragma unroll
      for (int j = 0; j < 4; ++j) { const float c0 = bflo(c[j]), c1 = bfhi(c[j]); const float mm0 = j < 2 ? m0[2 * j] : m1[2 * j - 4], mm1 = j < 2 ? m0[2 * j + 1] : m1[2 * j - 3];
          z[2 * j] = c0 + (bflo(p[j]) * pm - c0) * mm0; z[2 * j + 1] = c1 + (bfhi(p[j]) * pm - c1) * mm1; }
      if (!which) {
#pragma unroll
          for (int j = 0; j < 8; ++j) z[j] = tanh_f(z[j]); }
      LAS v4u* zs = zsh + zpar * 512;
      zs[((which ? 4 : 0) + s) * 64 + lane] = (v4u){cvtpk(z[0], z[1]), cvtpk(z[2], z[3]), cvtpk(z[4], z[5]), cvtpk(z[6], z[7])};
      __syncthreads();
#pragma unroll
      for (int q = 0; q < 4; ++q) { bz[q] = zs[q * 64 + lane]; ba[q] = zs[(4 + q) * 64 + lane]; }
      DEP(bz[3][3]); DEP(ba[3][3]); }
    asm volatile("" ::: "memory");
    v4u fa[4], fb[4], fk[4], fr[4], fv[4]; float rho = 0.f;
    float* gp = Dm.GAM + (size_t)u * 64 + hi * 32;
#define RW_LORA(cb) f32x16 accd = f32x16{}, acca = f32x16{}; _Pragma("unroll") for (int s = 0; s < 4; ++s) { \
        const v4u aD = *(const GAS v4u*)(F.WdT + tok + (size_t)(w * 64 + (cb) * 32 + l31) * 64 + 16 * s + 8 * hi); accd = MFMA32(aD, bz[s], accd); \
        const v4u aA = *(const GAS v4u*)(F.WaT + tok + (size_t)(w * 64 + (cb) * 32 + l31) * 64 + 16 * s + 8 * hi); acca = MFMA32(aA, ba[s], acca); }
    struct RwGL { v2u rc, rp, kc, kp, vc, vp; } gA, gB;
#define RW_LOADG(X, OFF) do { X.rc = *(const GAS v2u*)(pc + tok + C_R + (OFF)); X.rp = *(const GAS v2u*)(pp + tok + C_R + (OFF)); X.kc = *(const GAS v2u*)(pc + tok + C_K + (OFF)); X.kp = *(const GAS v2u*)(pp + tok + C_K + (OFF)); \
        X.vc = *(const GAS v2u*)(pc + tok + C_V + (OFF)); X.vp = *(const GAS v2u*)(pp + tok + C_V + (OFF)); } while (0)
#define RW_LERP(dst, c_, p_, m_) do { dst[0] = bflo(c_.x) + (bflo(p_.x) * pm - bflo(c_.x)) * m_.x; dst[1] = bfhi(c_.x) + (bfhi(p_.x) * pm - bfhi(c_.x)) * m_.y; \
        dst[2] = bflo(c_.y) + (bflo(p_.y) * pm - bflo(c_.y)) * m_.z; dst[3] = bfhi(c_.y) + (bfhi(p_.y) * pm - bfhi(c_.y)) * m_.w; } while (0)
#define RW_GROUP(cb, rg, CUR, NXT, HASN) do { constexpr int OFF = 32 * (cb) + 8 * (rg); const int ch0 = OFF + 4 * hi; \
            if (HASN) RW_LOADG(NXT, OFF + 8); \
            float rr[4], kk4[4], vv[4]; \
            const f32x4 mr_ = *(const GAS f32x4*)(mu + tok + OFF), mk_ = *(const GAS f32x4*)(mu + tok + 512 + OFF), mv_ = *(const GAS f32x4*)(mu + tok + 1024 + OFF); \
            const f32x4 w0v = *(const GAS f32x4*)(pw0 + tok + OFF), a0v = *(const GAS f32x4*)(pa0 + tok + OFF), kkp = *(const GAS f32x4*)(pkk + tok + OFF), kap = *(const GAS f32x4*)(pka + tok + OFF), rkp = *(const GAS f32x4*)(prk + tok + OFF); \
            RW_LERP(rr, CUR.rc, CUR.rp, mr_); RW_LERP(kk4, CUR.kc, CUR.kp, mk_); RW_LERP(vv, CUR.vc, CUR.vp, mv_); \
            float xa[4], xb[4], xk[4], xr[4], gg[4], ge[4]; \
            _Pragma("unroll") for (int e = 0; e < 4; ++e) { \
                  \
                const float l2 = (-0.6065306597126334f * LOG2E) * __builtin_amdgcn_rcpf(1.f + __expf(-(w0v[e] + accd[4 * (rg) + e]))); \
                const float g = scan32(l2); \
                const float a = __builtin_amdgcn_rcpf(1.f + __expf(-(a0v[e] + acca[4 * (rg) + e]))); \
                const float kk = kk4[e] * kkp[e] * inv; \
                const float kt = kk4[e] * (1.f + (a - 1.f) * kap[e]); \
                rho += rr[e] * kt * rkp[e]; \
                const float eg = __builtin_amdgcn_exp2f(g), egp = __builtin_amdgcn_exp2f(g - l2), eng = __builtin_amdgcn_rcpf(eg); \
                xa[e] = -kk * egp; xb[e] = kk * a * eng; xk[e] = kt * eng; xr[e] = rr[e] * eg; gg[e] = g; ge[e] = eg; } \
            if (l31 == 31) { *(LAS f32x4*)(wscr + ch0) = (f32x4){gg[0], gg[1], gg[2], gg[3]}; st_wt16((v4u*)(gp + (cb) * 16 + 4 * (rg)), (v4u){__float_as_uint(ge[0]), __float_as_uint(ge[1]), __float_as_uint(ge[2]), __float_as_uint(ge[3])}); } \
            constexpr int s_ = 2 * (cb) + ((rg) >> 1), vg = 2 * ((rg) & 1); \
            fa[s_][vg] = cvtpk(xa[0], xa[1]); fa[s_][vg + 1] = cvtpk(xa[2], xa[3]); \
            fb[s_][vg] = cvtpk(xb[0], xb[1]); fb[s_][vg + 1] = cvtpk(xb[2], xb[3]); \
            fk[s_][vg] = cvtpk(xk[0], xk[1]); fk[s_][vg + 1] = cvtpk(xk[2], xk[3]); \
            fr[s_][vg] = cvtpk(xr[0], xr[1]); fr[s_][vg + 1] = cvtpk(xr[2], xr[3]); \
            fv[s_][vg] = cvtpk(vv[0], vv[1]); fv[s_][vg + 1] = cvtpk(vv[2], vv[3]); \
            if (((rg) & 1) == 1) { PARK(s_) = fv[s_]; PARK(4 + s_) = fr[s_]; } \
            DEP(fa[s_][vg + 1]); DEP(fb[s_][vg + 1]); DEP(fk[s_][vg + 1]); DEP(fr[s_][vg + 1]); DEP(fv[s_][vg + 1]); DEP(rho); } while (0)
    RW_LOADG(gA, 0);
    { RW_LORA(0) RW_GROUP(0, 0, gA, gB, true); RW_GROUP(0, 1, gB, gA, true); RW_GROUP(0, 2, gA, gB, true); RW_GROUP(0, 3, gB, gA, true); }
    { RW_LORA(1) RW_GROUP(1, 0, gA, gB, true); RW_GROUP(1, 1, gB, gA, true); RW_GROUP(1, 2, gA, gB, true); RW_GROUP(1, 3, gB, gA, false); }
#undef RW_LOADG
#undef RW_LERP
#undef RW_LORA
#undef RW_GROUP
#undef SH4
    LDS_WAIT(); asm volatile("" ::: "memory");
    float EC[2]; EC[0] = __builtin_amdgcn_exp2f(wscr[l31]); EC[1] = __builtin_amdgcn_exp2f(wscr[32 + l31]);
    LDS_WAIT(); asm volatile("" ::: "memory");
    rho = swap32_sum(rho);
    if (hi == 0) __hip_atomic_store((gu32*)(Dm.RHO + (size_t)u * 32 + l31), __float_as_uint(rho), RLX_AGENT);
    v4u idf[2];
    { const int jst = 4 * ((l31 >> 3) & 1) + (l31 & 3); const bool hm = ((l31 >> 2) & 1) == hi; const unsigned one = 0x3F80u << (16 * (jst & 1));
#pragma unroll
      for (int sig = 0; sig < 2; ++sig) { const bool on = hm && ((l31 >> 4) == sig);
#pragma unroll
          for (int q = 0; q < 4; ++q) idf[sig][q] = (on && (jst >> 1) == q) ? one : 0u; } }
    LDS_WAIT();
    v4u Af[2][2], Vf[2][2];
#pragma unroll
    for (int blk = 0; blk < 2; ++blk) {
        f32x16 za = MFMA32(fa[2 * blk], idf[0], f32x16{}); za = MFMA32(fa[2 * blk + 1], idf[1], za);
        f32x16 zv = MFMA32(PARK(2 * blk), idf[0], f32x16{}); zv = MFMA32(PARK(2 * blk + 1), idf[1], zv);
        f32x16 zb = MFMA32(fb[2 * blk], idf[0], f32x16{}); zb = MFMA32(fb[2 * blk + 1], idf[1], zb);
        f32x16 zk = MFMA32(fk[2 * blk], idf[0], f32x16{}); zk = MFMA32(fk[2 * blk + 1], idf[1], zk);
        zb = zb * EC[blk]; zk = zk * EC[blk];
#pragma unroll
        for (int s = 0; s < 2; ++s) { Af[blk][s] = FRAGACC(za, s); Vf[blk][s] = FRAGACC(zv, s); PARK(8 + 2 * blk + s) = FRAGACC(zb, s); PARK(12 + 2 * blk + s) = FRAGACC(zk, s); }
        __builtin_amdgcn_sched_barrier(0);
    }
    f32x16 Aab = f32x16{}, TT = f32x16{}, AakT = f32x16{}, ArbT = f32x16{}, ArkT = f32x16{};
#pragma unroll
    for (int s = 0; s < 4; ++s) { const v4u frs = PARK(4 + s); Aab = MFMA32(fa[s], fb[s], Aab); TT = MFMA32(fb[s], fa[s], TT); AakT = MFMA32(fk[s], fa[s], AakT); ArbT = MFMA32(fb[s], frs, ArbT); ArkT = MFMA32(fk[s], frs, ArkT); }
#pragma unroll
    for (int r = 0; r < 16; ++r) { const int rowi = (r & 3) + 8 * (r >> 2) + 4 * hi;
        Aab[r] = (l31 < rowi) ? Aab[r] : 0.f; TT[r] = (rowi < l31) ? TT[r] : 0.f; AakT[r] = (rowi < l31) ? AakT[r] : 0.f;
        ArbT[r] = (rowi <= l31) ? ArbT[r] : 0.f; ArkT[r] = (rowi <= l31) ? ArkT[r] : 0.f; }
    v4u AakTf[2], ArbTf[2], ArkTf[2];
#pragma unroll
    for (int s = 0; s < 2; ++s) { AakTf[s] = FRAGACC(AakT, s); ArbTf[s] = FRAGACC(ArbT, s); ArkTf[s] = FRAGACC(ArkT, s); }
    __builtin_amdgcn_sched_barrier(0);
    v4u Xf[2], XTf[2], TTf[2];
#pragma unroll
    for (int s = 0; s < 2; ++s) { Xf[s] = FRAGACC(Aab, s); XTf[s] = FRAGACC(TT, s); }
#pragma unroll
    for (int r = 0; r < 16; ++r) { const int rowi = (r & 3) + 8 * (r >> 2) + 4 * hi; TT[r] += (rowi == l31) ? 1.f : 0.f; }
#pragma unroll
    for (int it = 0; it < 4; ++it) {
        f32x16 X2 = MFMA32(XTf[0], Xf[0], f32x16{}); X2 = MFMA32(XTf[1], Xf[1], X2);
        if (it < 3) { f32x16 X2T = MFMA32(Xf[0], XTf[0], f32x16{}); X2T = MFMA32(Xf[1], XTf[1], X2T);
#pragma unroll
            for (int s = 0; s < 2; ++s) XTf[s] = FRAGACC(X2T, s); }
#pragma unroll
        for (int s = 0; s < 2; ++s) { Xf[s] = FRAGACC(X2, s); TTf[s] = FRAGACC(TT, s); }
        TT = MFMA32(Xf[0], TTf[0], TT); TT = MFMA32(Xf[1], TTf[1], TT);
        __builtin_amdgcn_sched_barrier(0);
    }
#pragma unroll
    for (int s = 0; s < 2; ++s) TTf[s] = FRAGACC(TT, s);
    v4u Wf[2][2], Uf[2][2];
#pragma unroll
    for (int blk = 0; blk < 2; ++blk) {
        f32x16 av = MFMA32(AakTf[0], Vf[blk][0], f32x16{}); av = MFMA32(AakTf[1], Vf[blk][1], av);
        const v4u avf0 = FRAGACC(av, 0), avf1 = FRAGACC(av, 1);
        f32x16 uu = MFMA32(TTf[0], avf0, f32x16{}); uu = MFMA32(TTf[1], avf1, uu);
        f32x16 ww = MFMA32(TTf[0], Af[blk][0], f32x16{}); ww = MFMA32(TTf[1], Af[blk][1], ww);
#pragma unroll
        for (int s = 0; s < 2; ++s) { Wf[blk][s] = FRAGACC(ww, s); Uf[blk][s] = FRAGACC(uu, s); }
        __builtin_amdgcn_sched_barrier(0);
    }
    v4u* QFp = Dm.QF + (size_t)u * 256 + lane; v4u* YDp = Dm.YD + (size_t)u * 256 + lane;
#pragma unroll
    for (int blk = 0; blk < 2; ++blk) {
        f32x16 q;
#pragma unroll
        for (int s = 0; s < 2; ++s)
            { const v4u frs = PARK(4 + 2 * blk + s);
#pragma unroll
              for (int j = 0; j < 4; ++j) { q[8 * s + 2 * j] = bflo(frs[j]); q[8 * s + 2 * j + 1] = bfhi(frs[j]); } }
        q = MFMA32(Wf[blk][0], ArbTf[0], q); q = MFMA32(Wf[blk][1], ArbTf[1], q);
        st_wt16(QFp + (2 * blk) * 64, FRAGACC(q, 0)); st_wt16(QFp + (2 * blk + 1) * 64, FRAGACC(q, 1));
        f32x16 y = MFMA32(Uf[blk][0], ArbTf[0], f32x16{}); y = MFMA32(Uf[blk][1], ArbTf[1], y); y = MFMA32(Vf[blk][0], ArkTf[0], y); y = MFMA32(Vf[blk][1], ArkTf[1], y);
        st_wt16(YDp + (2 * blk) * 64, FRAGACC(y, 0)); st_wt16(YDp + (2 * blk + 1) * 64, FRAGACC(y, 1));
        __builtin_amdgcn_sched_barrier(0);
    }
    v4u* PFp = Dm.PF + (size_t)u * 512 + lane; v4u* DDp = Dm.DD + (size_t)u * 512 + lane;
#pragma unroll
    for (int c1 = 0; c1 < 2; ++c1)
#pragma unroll
        for (int cb = 0; cb < 2; ++cb) {
            f32x16 p = MFMA32(Wf[c1][0], PARK(8 + 2 * cb), f32x16{}); p = MFMA32(Wf[c1][1], PARK(8 + 2 * cb + 1), p);
            st_wt16(PFp + (cb * 4 + 2 * c1) * 64, FRAGACC(p, 0)); st_wt16(PFp + (cb * 4 + 2 * c1 + 1) * 64, FRAGACC(p, 1));
            __builtin_amdgcn_sched_barrier(0);
        }
#pragma unroll
    for (int cb = 0; cb < 2; ++cb)
#pragma unroll
        for (int ib = 0; ib < 2; ++ib) {
            f32x16 d = MFMA32(PARK(8 + 2 * cb), Uf[ib][0], f32x16{}); d = MFMA32(PARK(8 + 2 * cb + 1), Uf[ib][1], d); d = MFMA32(PARK(12 + 2 * cb), Vf[ib][0], d); d = MFMA32(PARK(12 + 2 * cb + 1), Vf[ib][1], d);
            st_wt16(DDp + ((cb * 2 + ib) * 2) * 64, FRAGACC(d, 0)); st_wt16(DDp + ((cb * 2 + ib) * 2 + 1) * 64, FRAGACC(d, 1));
            __builtin_amdgcn_sched_barrier(0);
        }
}

#undef PARK
#undef DEP
constexpr int RB_PF = 0, RB_DD = 8192, RB_QF = 16384, RB_YD = 20480, RB_GAM = 24576, RB_BUF = 24832, RB_NB = 4, RB_STAT = RB_NB * RB_BUF, RB_Y = RB_STAT + 1024;
__device__ __forceinline__ void unpack16(const v4u a, const v4u b, f32x16& o) {
#pragma unroll
    for (int j = 0; j < 4; ++j) { o[2 * j] = bflo(a[j]); o[2 * j + 1] = bfhi(a[j]); o[8 + 2 * j] = bflo(b[j]); o[8 + 2 * j + 1] = bfhi(b[j]); }
}
constexpr int RW_SPLIT = T / 32, CW_DONE = 16384;
__device__ __forceinline__ void rw_wait_chunk(Frame& F, int ci) {
    unsigned spins = 0;
#pragma unroll 1
    for (int j = 7; j >= 0; --j) { gu32* c = F.ctl + CW_DONE + 64 * (ci + j);
        while ((unsigned)__builtin_amdgcn_readfirstlane(__hip_atomic_load(c, RLX_AGENT)) < (unsigned)BATCH) { __builtin_amdgcn_s_sleep(8); if (++spins > (1u << 22)) break; } }
    __builtin_amdgcn_fence(__ATOMIC_ACQUIRE, "agent");
}
__device__ __forceinline__ void rw_publish_chunk(Frame& F, int ci) {
    asm volatile("s_waitcnt vmcnt(0)" ::: "memory");
    __syncthreads();
    if (F.wave == 0 && mk_lane() == 0) {
        __hip_atomic_fetch_add(F.ctl + CW_DONE + 64 * ci, 1u, RLX_AGENT);
    }
}
#ifndef RB_AUX
#define RB_AUX 2
#endif
struct RbStage { v4u p[2], d[2], q, y, g; };
struct RbEpi { v4u vc, vp, ga; float rho; };
__device__ __forceinline__ void rwkvB_unit(Frame& F, const RwDump& Dm, int bh) {
    int lane = mk_lane(); asm volatile("" : "+v"(lane));
    const int wid = F.wave, tid = wid * 64 + lane, hi = lane >> 5, l31 = lane & 31, b = bh >> 3, h = bh & 7;
    LAS unsigned char* lds = F.lds + RING_OFF;
    constexpr int NS = T / 32;
    LAS float* stat = (LAS float*)(lds + RB_STAT);
    LAS float* ybuf = (LAS float*)(lds + RB_Y);
    const int stid = tid - 128;
    const bool st_p2 = wid < 4, st_q = wid < 6, st_y = wid >= 4;
#define ST_LOAD(X, ci_) do { { if ((ci_) >= RW_SPLIT && (ci_) < NS && (((ci_) - RW_SPLIT) & 7) == 0) rw_wait_chunk(F, (ci_)); const size_t u_ = (size_t)((ci_) < NS ? (ci_) : NS - 1) * (BATCH * RH) + bh; \
        X.p[0] = __builtin_nontemporal_load((const GAS v4u*)(Dm.PF + u_ * 512 + stid)); X.d[0] = __builtin_nontemporal_load((const GAS v4u*)(Dm.DD + u_ * 512 + stid)); \
        if (st_p2) { X.p[1] = __builtin_nontemporal_load((const GAS v4u*)(Dm.PF + u_ * 512 + 384 + stid)); X.d[1] = __builtin_nontemporal_load((const GAS v4u*)(Dm.DD + u_ * 512 + 384 + stid)); } \
        if (st_q) X.q = __builtin_nontemporal_load((const GAS v4u*)(Dm.QF + u_ * 256 + stid)); \
        if (st_y) X.y = __builtin_nontemporal_load((const GAS v4u*)(Dm.YD + u_ * 256 + (stid - 128))); \
        if (stid < 16) X.g = *(const GAS v4u*)((const v4u*)(Dm.GAM + u_ * 64) + stid); } } while (0)
#define ST_STORE(X, buf_) do { LAS unsigned char* b_ = lds + (buf_) * RB_BUF; \
        *(LAS v4u*)(b_ + RB_PF + stid * 16) = X.p[0]; *(LAS v4u*)(b_ + RB_DD + stid * 16) = X.d[0]; \
        if (st_p2) { *(LAS v4u*)(b_ + RB_PF + (384 + stid) * 16) = X.p[1]; *(LAS v4u*)(b_ + RB_DD + (384 + stid) * 16) = X.d[1]; } \
        if (st_q) *(LAS v4u*)(b_ + RB_QF + stid * 16) = X.q; \
        if (st_y) *(LAS v4u*)(b_ + RB_YD + (stid - 128) * 16) = X.y; \
        if (stid < 16) *(LAS v4u*)(b_ + RB_GAM + stid * 16) = X.g; } while (0)
    const int ew = (wid & 1) + 2 * ((wid >> 2) & 1), eidx = ew * 64 + lane, etok = eidx >> 3, ep = eidx & 7;
    const bf16* epc = F.PROJ + (size_t)b * T * NP + h * 64 + 8 * ep;
#define EP_LOAD(X, cj_) do { { const int cc_ = (cj_) < NS ? (cj_) : NS - 1, tt_ = cc_ * 32 + etok; const bf16* pc_ = epc + (size_t)tt_ * NP; const bf16* pp_ = epc + (size_t)(tt_ > 0 ? tt_ - 1 : 0) * NP; \
        X.vc = *(const GAS v4u*)(pc_ + C_V); X.vp = *(const GAS v4u*)(pp_ + C_V); X.ga = *(const GAS v4u*)(pc_ + C_GA); \
        X.rho = Dm.RHO[((size_t)cc_ * (BATCH * RH) + bh) * 32 + etok]; } } while (0)
#define EP_RUN(X, cj_) do { const int par_ = (cj_) & 1; \
        const float s1_ = stat[((par_ * 2 + 0) * 32 + etok) * 2] + stat[((par_ * 2 + 1) * 32 + etok) * 2], s2_ = stat[((par_ * 2 + 0) * 32 + etok) * 2 + 1] + stat[((par_ * 2 + 1) * 32 + etok) * 2 + 1]; \
        const float mean_ = s1_ * (1.f / 64.f), var_ = fmaxf(s2_ * (1.f / 64.f) - mean_ * mean_, 0.f), rstd_ = __builtin_amdgcn_rsqf(var_ + 64e-5f); \
        const int tt_ = (cj_) * 32 + etok; const size_t mm_ = (size_t)b * T + tt_; const float pm_ = tt_ > 0 ? 1.f : 0.f; \
        const LAS float* yb_ = ybuf + (par_ * 2 + (ep >> 2)) * 1024 + 4 * (ep & 3) * 64 + etok; \
        float o_[8]; \
        _Pragma("unroll") for (int j = 0; j < 8; ++j) { const unsigned vcw_ = X.vc[j >> 1], vpw_ = X.vp[j >> 1], gaw_ = X.ga[j >> 1]; \
            const float vc_ = (j & 1) ? bfhi(vcw_) : bflo(vcw_), vp_ = (j & 1) ? bfhi(vpw_) : bflo(vpw_), g_ = (j & 1) ? bfhi(gaw_) : bflo(gaw_); \
            const float vv_ = vc_ + (vp_ * pm_ - vc_) * emu[j >> 2][j & 3]; \
            const float yn_ = (yb_[(j & 3) * 64 + (j >> 2) * 32] - mean_) * rstd_ * elw[j >> 2][j & 3] + elb[j >> 2][j & 3] + X.rho * vv_; o_[j] = yn_ * g_ * __builtin_amdgcn_rcpf(1.f + __expf(-g_)); } \
        *(GAS v4u*)(F.MIX + mm_ * D + h * 64 + 8 * ep) = (v4u){cvtpk(o_[0], o_[1]), cvtpk(o_[2], o_[3]), cvtpk(o_[4], o_[5]), cvtpk(o_[6], o_[7])}; } while (0)
    f32x16 S[2]; S[0] = f32x16{}; S[1] = f32x16{};
    const int ib = wid & 1;
#define CONS(ci_) do { const LAS unsigned char* bb = lds + ((ci_) & (RB_NB - 1)) * RB_BUF; \
          \
        v4u pf_[8], qf_[4], dd_[4], yd_[2]; f32x4 gm_[8]; \
        _Pragma("unroll") for (int q = 0; q < 8; ++q) gm_[q] = *(const LAS f32x4*)(bb + RB_GAM + (hi * 32 + 4 * q) * 4); \
        _Pragma("unroll") for (int q = 0; q < 4; ++q) dd_[q] = *(const LAS v4u*)(bb + RB_DD + ((((q >> 1) * 2 + ib) * 2 + (q & 1)) * 64 + lane) * 16); \
        _Pragma("unroll") for (int q = 0; q < 8; ++q) pf_[q] = *(const LAS v4u*)(bb + RB_PF + (q * 64 + lane) * 16); \
        _Pragma("unroll") for (int q = 0; q < 2; ++q) yd_[q] = *(const LAS v4u*)(bb + RB_YD + ((2 * ib + q) * 64 + lane) * 16); \
        _Pragma("unroll") for (int q = 0; q < 4; ++q) qf_[q] = *(const LAS v4u*)(bb + RB_QF + (q * 64 + lane) * 16); \
        __builtin_amdgcn_sched_barrier(0); \
        v4u Sf[4]; _Pragma("unroll") for (int s = 0; s < 4; ++s) Sf[s] = FRAGACC(S[s >> 1], s & 1); \
        _Pragma("unroll") for (int rb = 0; rb < 2; ++rb) { \
            f32x16 acc; unpack16(dd_[2 * rb], dd_[2 * rb + 1], acc); \
            _Pragma("unroll") for (int q = 0; q < 4; ++q) { const f32x4 gv = gm_[4 * rb + q]; _Pragma("unroll") for (int e = 0; e < 4; ++e) acc[4 * q + e] += gv[e] * S[rb][4 * q + e]; } \
            _Pragma("unroll") for (int s = 0; s < 4; ++s) acc = MFMA32(pf_[rb * 4 + s], Sf[s], acc); \
            S[rb] = acc; } \
        f32x16 y; unpack16(yd_[0], yd_[1], y); \
        _Pragma("unroll") for (int s = 0; s < 4; ++s) y = MFMA32(Sf[s], qf_[s], y); \
        float s1 = 0.f, s2 = 0.f; LAS float* yb_ = ybuf + (((ci_) & 1) * 2 + ib) * 1024 + lane; \
        _Pragma("unroll") for (int r = 0; r < 16; ++r) { s1 += y[r]; s2 += y[r] * y[r]; yb_[r * 64] = y[r]; } \
        s1 = swap32_sum(s1); s2 = swap32_sum(s2); \
        if (hi == 0) { stat[((((ci_) & 1) * 2 + ib) * 32 + l31) * 2] = s1; stat[((((ci_) & 1) * 2 + ib) * 32 + l31) * 2 + 1] = s2; } } while (0)
#define RB_BAR() do { asm volatile("s_waitcnt lgkmcnt(0)" ::: "memory"); __builtin_amdgcn_s_barrier(); asm volatile("" ::: "memory"); } while (0)
    if (wid < 2) {
        RB_BAR();
#pragma unroll 1
        for (int k = 0; k < NS; ++k) { CONS(k); RB_BAR(); }
        RB_BAR();
    } else if (wid == 4 || wid == 5) {
        const GAS v4u* gA = (const GAS v4u*)(wid == 4 ? Dm.PF : Dm.DD) + lane; const GAS v4u* gB = (const GAS v4u*)(wid == 4 ? Dm.QF : Dm.YD) + lane;
        const int oA = wid == 4 ? RB_PF : RB_DD, oB = wid == 4 ? RB_QF : RB_YD;
#define LD_ISSUE(ci_) do { const size_t u_ = (size_t)((ci_) < NS ? (ci_) : NS - 1) * (BATCH * RH) + bh; LAS unsigned char* b_ = lds + ((ci_) & (RB_NB - 1)) * RB_BUF; \
        _Pragma("unroll") for (int q = 0; q < 8; ++q) __builtin_amdgcn_global_load_lds((const unsigned*)(gA + u_ * 512 + q * 64), (LAS unsigned*)(b_ + oA + q * 1024), 16, 0, RB_AUX); \
        _Pragma("unroll") for (int q = 0; q < 4; ++q) __builtin_amdgcn_global_load_lds((const unsigned*)(gB + u_ * 256 + q * 64), (LAS unsigned*)(b_ + oB + q * 1024), 16, 0, RB_AUX); \
        if (lane < 16) __builtin_amdgcn_global_load_lds((const unsigned*)((const GAS v4u*)(Dm.GAM + u_ * 64) + lane), (LAS unsigned*)(b_ + RB_GAM), 16, 0, 0); } while (0)
        LD_ISSUE(0); LD_ISSUE(1); LD_ISSUE(2);
        asm volatile("s_waitcnt vmcnt(26)" ::: "memory");
        RB_BAR();
#pragma unroll 1
        for (int k = 0; k < NS; ++k) { LD_ISSUE(k + 3); asm volatile("s_waitcnt vmcnt(26)" ::: "memory"); RB_BAR(); }
        asm volatile("s_waitcnt vmcnt(0)" ::: "memory");
        RB_BAR();
#undef LD_ISSUE
    } else {
        RbEpi eA, eB, eC; f32x4 emu[2], elw[2], elb[2];
#pragma unroll
        for (int rg = 0; rg < 2; ++rg) { const int hc_ = h * 64 + 8 * ep + 4 * rg; emu[rg] = *(const GAS f32x4*)(F.shift_mu + 1024 + hc_); elw[rg] = *(const GAS f32x4*)(F.ln_w + hc_); elb[rg] = *(const GAS f32x4*)(F.ln_b + hc_); }
        EP_LOAD(eA, 0); EP_LOAD(eB, 1);
        RB_BAR();
        EP_LOAD(eC, 2); RB_BAR();
#define HY_STEP(k_, EP) do { EP_RUN(EP, (k_) - 1); EP_LOAD(EP, (k_) + 2); RB_BAR(); } while (0)
#pragma unroll 1
        for (int k = 1; k < NS; k += 3) { HY_STEP(k, eA); HY_STEP(k + 1, eB); HY_STEP(k + 2, eC); }
        EP_RUN(eA, NS - 1);
        RB_BAR();
#undef HY_STEP
    }
#undef RB_BAR
#undef ST_LOAD
#undef ST_STORE
#undef EP_LOAD
#undef EP_RUN
#undef CONS
}
constexpr int CW_G17 = 12288;
struct OneUnit { int pm, pn;
    __device__ __forceinline__ bool next(int i, pg8::Unit& u) const { if (i != 0) return false; u.pm = pm; u.pn = pn; return true; }
    __device__ __forceinline__ void a_ready(const pg8::Unit&) const {}
    __device__ __forceinline__ void done(const pg8::Unit&) const {} };
constexpr int AT_OUT = 65536, AT_G0 = 114688, AT_G1 = LDSCTL_OFF + 1024;
constexpr int AT_KB = 64 * 256, AT_VB = 64 * 256, AT_BUF = AT_KB + AT_VB, AT_QOFF = 2 * AT_KB + 3 * AT_VB;
__device__ __forceinline__ s16x4 vtr(const LAS unsigned char* p) { typedef short v4i16_t __attribute__((ext_vector_type(4))); return __builtin_bit_cast(s16x4, __builtin_amdgcn_ds_read_tr16_b64_v4i16((LAS v4i16_t*)p)); }
__device__ __forceinline__ void attn_unit(Frame& F, int b, int h, int qb) {
    int lane = mk_lane(); asm volatile("" : "+v"(lane));
    const int wid = F.wave, tid = wid * 64 + lane, l31 = lane & 31, hi = lane >> 5, map = wid >> 2, qs = wid & 3;
    LAS unsigned char* lds = F.lds + RING_OFF;
    const float slope2 = exp2f(-2.f * (float)(h + 1)) * LOG2E, shift2 = __uint_as_float(F.MISC[15]);
    const int q0 = qb * 128, qrow = q0 + 32 * qs + l31;
    const size_t mrow = (size_t)b * T + qrow;
    LAS bf16x8* qpark = (LAS bf16x8*)(lds + AT_QOFF + wid * 4096) + lane;
    { const bf16* qp = F.PROJ + mrow * NP + C_DQ + h * 128 + map * 64 + 8 * hi;
      v4u qraw[4]; float ss = 0.f;
#pragma unroll
      for (int s = 0; s < 4; ++s) qraw[s] = *(const GAS v4u*)(qp + 16 * s);
#pragma unroll
      for (int s = 0; s < 4; ++s)
#pragma unroll
          for (int j = 0; j < 4; ++j) { const float a_ = bflo(qraw[s][j]), b_ = bfhi(qraw[s][j]); ss += a_ * a_ + b_ * b_; }
      ss = swap32_sum(ss);
      const float rq = __builtin_amdgcn_rsqf(ss * (1.f / 64.f) + 1e-6f) * C2;
#pragma unroll
      for (int s = 0; s < 4; ++s) { const f32x4 g0 = *(const GAS f32x4*)(F.qn_g + 8 * hi + 16 * s), g1 = *(const GAS f32x4*)(F.qn_g + 8 * hi + 16 * s + 4);
          v4u w_; w_.x = cvtpk2(bflo(qraw[s].x) * rq * g0.x, bfhi(qraw[s].x) * rq * g0.y); w_.y = cvtpk2(bflo(qraw[s].y) * rq * g0.z, bfhi(qraw[s].y) * rq * g0.w);
          w_.z = cvtpk2(bflo(qraw[s].z) * rq * g1.x, bfhi(qraw[s].z) * rq * g1.y); w_.w = cvtpk2(bflo(qraw[s].w) * rq * g1.z, bfhi(qraw[s].w) * rq * g1.w);
          *(LAS v4u*)(qpark + s * 64) = w_; } }
    const bf16* kg = F.PROJ + (size_t)b * T * NP + C_DK + h * 128;
    const bf16* vg = F.PROJ + (size_t)b * T * NP + C_DV + h * 128;
    const int NT = 2 * qb + 2, tl = 2 * qb + (qs >> 1);
    const int Wk = (int)__builtin_ceilf((2.f * shift2 + 32.2f) / slope2);
    const int tf = __builtin_amdgcn_readfirstlane(max(0, (qb * 128 - Wk) >> 6));
    constexpr int AT_V0 = 2 * AT_KB;
    const int drow0 = 4 * wid + (lane >> 4), drow1 = drow0 + 32, dch = lane & 15;
    const unsigned ksrc0 = (unsigned)(drow0 * NP + ((dch ^ (drow0 & 15)) * 8)), ksrc1 = (unsigned)(drow1 * NP + ((dch ^ (drow1 & 15)) * 8));
    const unsigned vsrc0 = (unsigned)(drow0 * NP + ((dch ^ ((drow0 & 3) << 2)) * 8)), vsrc1 = (unsigned)(drow1 * NP + ((dch ^ ((drow1 & 3) << 2)) * 8));
#define AT_DMA(t_, kb_, v3_) do { const size_t tb_ = (size_t)(64 * (t_)) * NP; LAS unsigned char* bk_ = lds + (kb_) * AT_KB + wid * 1024; LAS unsigned char* bv_ = lds + AT_V0 + (v3_) * AT_VB + wid * 1024; \
        __builtin_amdgcn_global_load_lds((const unsigned*)(kg + tb_ + ksrc0), (LAS unsigned*)bk_, 16, 0, 0); __builtin_amdgcn_global_load_lds((const unsigned*)(kg + tb_ + ksrc1), (LAS unsigned*)(bk_ + 8192), 16, 0, 0); \
        __builtin_amdgcn_global_load_lds((const unsigned*)(vg + tb_ + vsrc0), (LAS unsigned*)bv_, 16, 0, 0); __builtin_amdgcn_global_load_lds((const unsigned*)(vg + tb_ + vsrc1), (LAS unsigned*)(bv_ + 8192), 16, 0, 0); } while (0)
    f32x16 o[4];
#pragma unroll
    for (int vb = 0; vb < 4; ++vb) o[vb] = f32x16{};
    float lsum = 0.f;
    AT_DMA(tf, tf & 1, tf % 3);
    { const int gr_ = 16 * wid + (lane >> 4); const bf16* gsrc = F.PROJ + ((size_t)b * T + q0 + gr_) * NP + C_GB + h * 128;
      LAS unsigned char* gdst = F.lds + (wid < 4 ? AT_G0 + wid * 4096 : AT_G1 + (wid - 4) * 4096);
#pragma unroll
      for (int j = 0; j < 4; ++j) __builtin_amdgcn_global_load_lds((const unsigned*)(gsrc + (size_t)(4 * j) * NP + (((lane & 15) ^ (4 * j + (lane >> 4))) * 8)), (LAS unsigned*)(gdst + j * 1024), 16, 0, 0); }
    __syncthreads();
    const int G = lane >> 4, qq = (lane & 15) >> 2, pp = lane & 3;
    const int vrow = (4 * hi + qq) * 256 + 8 * (pp & 1), vch = 2 * (G & 1) + (pp >> 1);
    v4u pw[4];
#define SBAR_() __builtin_amdgcn_sched_barrier(0)
#define AT_QK(t) do { \
            const LAS unsigned char* Kb = lds + ((t) & 1) * AT_KB; \
            float sl_ = slope2; asm volatile("" : "+v"(sl_));     \
            const float base = sl_ * (float)(64 * (t) + 4 * hi - qrow) - shift2; \
            float ls = 0.f; \
            _Pragma("unroll") for (int hf = 0; hf < 2; ++hf) {        \
                f32x16 p; \
                _Pragma("unroll") for (int r = 0; r < 16; ++r) p[r] = __builtin_fmaf(sl_, (float)(32 * hf + (r & 3) + 8 * (r >> 2)), base); \
                _Pragma("unroll") for (int s = 0; s < 4; ++s) { \
                    const bf16x8 a0 = *(const LAS bf16x8*)(Kb + (32 * hf + l31) * 256 + (((map * 8 + 2 * s + hi) ^ (l31 & 15)) * 16)); \
                    p = __builtin_amdgcn_mfma_f32_32x32x16_bf16(a0, qpark[s * 64], p, 0, 0, 0); } \
                if ((t) == tl) { \
                    _Pragma("unroll") for (int r = 0; r < 16; ++r) { const int ki = 64 * (t) + 32 * hf + 4 * hi + (r & 3) + 8 * (r >> 2); if (ki > qrow) p[r] = -1e30f; } } \
                _Pragma("unroll") for (int r = 0; r < 16; ++r) { p[r] = __builtin_amdgcn_exp2f(p[r]); ls += p[r]; } \
                pw[2 * hf] = (v4u){cvtpk(p[0], p[1]), cvtpk(p[2], p[3]), cvtpk(p[4], p[5]), cvtpk(p[6], p[7])}; \
                pw[2 * hf + 1] = (v4u){cvtpk(p[8], p[9]), cvtpk(p[10], p[11]), cvtpk(p[12], p[13]), cvtpk(p[14], p[15])}; } \
            lsum += ls; } while (0)
#define AT_VRD(dst, ks, vb0) do { _Pragma("unroll") for (int vb = (vb0); vb < (vb0) + 2; ++vb) { const LAS unsigned char* a_ = Vb + vrow + ((4 * vb + vch) ^ (qq << 2)) * 16 + (32 * ((ks) >> 1) + 16 * ((ks) & 1)) * 256; \
        dst[2 * (vb - (vb0))] = vtr(a_); dst[2 * (vb - (vb0)) + 1] = vtr(a_ + 8 * 256); } } while (0)
#define AT_PV(src, pwk, vb0) do { _Pragma("unroll") for (int vb = (vb0); vb < (vb0) + 2; ++vb) { const int j_ = 2 * (vb - (vb0)); \
        const bf16x8 vf = (bf16x8){src[j_][0], src[j_][1], src[j_][2], src[j_][3], src[j_ + 1][0], src[j_ + 1][1], src[j_ + 1][2], src[j_ + 1][3]}; \
        o[vb] = __builtin_amdgcn_mfma_f32_32x32x16_bf16(vf, __builtin_bit_cast(bf16x8, pwk), o[vb], 0, 0, 0); } } while (0)
#define AT_PVV(v3_) do { const LAS unsigned char* Vb = lds + AT_V0 + (v3_) * AT_VB; s16x4 vA[4], vB[4]; \
            AT_VRD(vA, 0, 0); SBAR_(); AT_VRD(vB, 0, 2); SBAR_(); \
            AT_PV(vA, pw[0], 0); SBAR_(); AT_VRD(vA, 1, 0); SBAR_(); AT_PV(vB, pw[0], 2); SBAR_(); AT_VRD(vB, 1, 2); SBAR_(); \
            AT_PV(vA, pw[1], 0); SBAR_(); AT_VRD(vA, 2, 0); SBAR_(); AT_PV(vB, pw[1], 2); SBAR_(); AT_VRD(vB, 2, 2); SBAR_(); \
            AT_PV(vA, pw[2], 0); SBAR_(); AT_VRD(vA, 3, 0); SBAR_(); AT_PV(vB, pw[2], 2); SBAR_(); AT_VRD(vB, 3, 2); SBAR_(); \
            AT_PV(vA, pw[3], 0); SBAR_(); AT_PV(vB, pw[3], 2); } while (0)
    if (map == 0) {
        int v3 = tf % 3;
#pragma unroll 1
        for (int t = tf; t < NT; ++t) { const int vn = v3 == 2 ? 0 : v3 + 1;
            if (t + 1 < NT) AT_DMA(t + 1, (t + 1) & 1, vn);
            if (t <= tl) { AT_QK(t); AT_PVV(v3); }
            __syncthreads(); v3 = vn; }
    } else {
        int v3 = tf % 3;
#pragma unroll 1
        for (int t = tf; t < NT; ++t) { const int vp = v3 == 0 ? 2 : v3 - 1, vn = v3 == 2 ? 0 : v3 + 1;
            if (t + 1 < NT) AT_DMA(t + 1, (t + 1) & 1, vn);
            if (t > tf && t - 1 <= tl) AT_PVV(vp);
            if (t <= tl) AT_QK(t);
            __syncthreads(); v3 = vn; }
        if (NT - 1 <= tl) { const int vp = v3 == 0 ? 2 : v3 - 1; AT_PVV(vp); }
    }
#undef AT_PVV
#undef AT_QK
#undef AT_VRD
#undef AT_PV
#undef SBAR_
#undef AT_DMA
    __syncthreads();
    const float ltot = swap32_sum(lsum);
    LAS float* X = (LAS float*)lds;
    if (map == 1) {
        const float sc = __uint_as_float(F.MISC[14]) / ltot;
#pragma unroll
        for (int vb = 0; vb < 4; ++vb)
#pragma unroll
            for (int r = 0; r < 16; ++r) X[(qs * 64 + vb * 16 + r) * 64 + lane] = o[vb][r] * sc;
    }
    __syncthreads();
    if (map == 0) {
        const float il = 1.f / ltot; float ss = 0.f;
#pragma unroll
        for (int vb = 0; vb < 4; ++vb)
#pragma unroll
            for (int r = 0; r < 16; ++r) { const float v = o[vb][r] * il - X[(qs * 64 + vb * 16 + r) * 64 + lane]; o[vb][r] = v; ss += v * v; }
        ss = swap32_sum(ss);
        const float rn = (1.f / sqrtf(ss * (1.f / 128.f) + 1e-5f)) * (1.f - LAMBDA_INIT);
        int etok = 0; asm volatile("" : "+v"(etok));
        const int lane_e = mk_lane(), hi = lane_e >> 5, row = 32 * qs + (lane_e & 31);
        const LAS unsigned char* grow = F.lds + (qs < 2 ? AT_G0 : AT_G1 - 64 * 256) + row * 256 + 8 * hi;
        LAS unsigned char* orow = lds + AT_OUT + row * 256 + 8 * hi;
#pragma unroll
        for (int vb = 0; vb < 4; ++vb)
#pragma unroll
            for (int rg = 0; rg < 4; ++rg) {
                const int vc = 32 * vb + 8 * rg + 4 * hi, ch = (((4 * vb + rg) ^ (row & 15)) * 16) + etok;
                const v2u gw = *(const LAS v2u*)(grow + ch); const f32x4 sg = *(const GAS f32x4*)(F.subln_g + vc);
                const float g4[4] = {bflo(gw.x), bfhi(gw.x), bflo(gw.y), bfhi(gw.y)}; float ov[4];
#pragma unroll
                for (int e = 0; e < 4; ++e) ov[e] = o[vb][4 * rg + e] * rn * sg[e] * g4[e] / (1.f + __expf(-g4[e]));
                const unsigned w1_ = cvtpk(ov[2], ov[3]);
                *(LAS v2u*)(orow + ch) = (v2u){cvtpk(ov[0], ov[1]), w1_};
                if (rg == 3) asm volatile("" : "+v"(etok) : "v"(w1_));
            }
    }
    __syncthreads();
    { const int t_ = wid * 64 + mk_lane(); bf16* ob = F.MIX + ((size_t)b * T + q0) * D + 512 + h * 128;
#pragma unroll
      for (int i = 0; i < 4; ++i) { const int pc = t_ + 512 * i, r_ = pc >> 4, c_ = pc & 15;
          *(GAS v4u*)(ob + (size_t)r_ * D + c_ * 8) = *(const LAS v4u*)(lds + AT_OUT + r_ * 256 + ((c_ ^ (r_ & 15)) * 16)); } }
    __syncthreads();
}
#ifndef DBL
#define DBL 0
#endif
constexpr int CW_QUEUE = 8192;
constexpr int QX_RW = 8, QX_A2 = 0, QX_AT = 64, QX_ALL = QX_RW + QX_A2 + QX_AT;
template <int MODE = 0> __device__ __forceinline__ void p3_queue(Frame& F, const RwDump& Dm, const int qbase = CW_QUEUE) {
    const int ql = mk_lane();
    const float l1 = wave_sum(F.lq1[ql] * F.lk1[ql]), l2 = wave_sum(F.lq2[ql] * F.lk2[ql]);
    const float lam = __uint_as_float(__builtin_amdgcn_readfirstlane(__float_as_uint(__expf(l1) - __expf(l2) + LAMBDA_INIT)));
    float gq = fabsf(F.qn_g[ql]), gk = fabsf(F.kn_g[ql]);
#pragma unroll
    for (int o = 1; o < 64; o <<= 1) { gq = fmaxf(gq, __shfl_xor(gq, o)); gk = fmaxf(gk, __shfl_xor(gk, o)); }
    const float shift2 = __uint_as_float(__builtin_amdgcn_readfirstlane(__float_as_uint(8.f * gq * gk * LOG2E)));
    if (F.wave == 0 && mk_lane() == 0) { F.MISC[14] = __float_as_uint(lam); F.MISC[15] = __float_as_uint(shift2); }
    __syncthreads();
#ifdef Q_BLK
    const int x0 = (int)(blockIdx.x & 7);
#else
    const int x0 = (int)(xb_xcc_id() & 7u);
#endif
#pragma unroll 1
    for (int dx = 0; dx < 8; ++dx) {
        const int xq = (x0 + dx) & 7;
        for (;;) {
            if (F.wave == 0 && mk_lane() == 0) F.MISC[12] = __hip_atomic_fetch_add(F.ctl + qbase + 64 * xq, 1u, RLX_AGENT);
            __syncthreads();
            int item = __builtin_amdgcn_readfirstlane((int)F.MISC[12]); if (MODE == 2) item += QX_RW;
            __syncthreads();
            if (item >= (MODE == 1 ? QX_RW : QX_ALL)) break;
            if (item < QX_RW) { rwkvB_unit(F, Dm, xq * 8 + item); if (DBL & 64) rwkvB_unit(F, Dm, xq * 8 + item); }
            else { const int idx = item - QX_RW - QX_A2, h = 3 - (idx >> 4), qb = 15 - (idx & 15);
#pragma unroll 1
#ifndef NO_ATT
                for (int rep = 0; rep < ((DBL & 32) ? 2 : 1); ++rep) attn_unit(F, xq, h, qb);
#endif
            }
        }
    }
}

constexpr int GT_STAGE = 40960, GT_NS = 3, GT_NK = D / 64;
__device__ __forceinline__ void gemm1_tail_unit(Frame& F, int qu) {
    int lane = mk_lane(); asm volatile("" : "+v"(lane));
    const int wid = F.wave, l31 = lane & 31, hi = lane >> 5;
    const int xcd = qu & 7, j = qu >> 3, R0 = (8 * xcd + (j & 7)) * 256 + (j >> 3) * 64;
    LAS unsigned char* lds = F.lds + RING_OFF;
    const int vr0 = 40 * wid + (lane >> 3), cp = lane & 7;
#define GT_ISSUE(kc_) do { LAS unsigned char* sb_ = lds + ((kc_) % GT_NS) * GT_STAGE + wid * 5120; \
        _Pragma("unroll") for (int i = 0; i < 5; ++i) { const int v_ = vr0 + 8 * i; \
            const bf16* src_ = (5 * wid + i < 8 ? F.XN + (size_t)(R0 + v_) * D : F.WinT + (size_t)(4096 + v_ - 64) * D) + (kc_) * 64 + ((cp ^ ((v_ >> 1) & 7)) * 8); \
            __builtin_amdgcn_global_load_lds((const unsigned*)src_, (LAS unsigned*)(sb_ + i * 1024), 16, 0, 0); } } while (0)
    f32x16 acc0 = f32x16{}, acc1 = f32x16{};
    const int nW = 32 * wid + l31, offW = 8192 + nW * 128, kyW = (nW >> 1) & 7, offX0 = l31 * 128, offX1 = (32 + l31) * 128, kyX = (l31 >> 1) & 7;
    GT_ISSUE(0); GT_ISSUE(1);
#pragma unroll 1
    for (int kc = 0; kc < GT_NK; ++kc) {
        if (kc + 1 < GT_NK) asm volatile("s_waitcnt vmcnt(5)" ::: "memory"); else asm volatile("s_waitcnt vmcnt(0)" ::: "memory");
        __builtin_amdgcn_s_barrier(); asm volatile("" ::: "memory");
        if (kc + 2 < GT_NK) GT_ISSUE(kc + 2);
        const LAS unsigned char* sb = lds + (kc % GT_NS) * GT_STAGE;
        v4u wf[4], x0[4], x1[4];
#pragma unroll
        for (int s = 0; s < 4; ++s) { wf[s] = *(const LAS v4u*)(sb + offW + (((2 * s + hi) ^ kyW) * 16)); x0[s] = *(const LAS v4u*)(sb + offX0 + (((2 * s + hi) ^ kyX) * 16)); x1[s] = *(const LAS v4u*)(sb + offX1 + (((2 * s + hi) ^ kyX) * 16)); }
#pragma unroll
        for (int s = 0; s < 4; ++s) { acc0 = MFMA32(wf[s], x0[s], acc0); acc1 = MFMA32(wf[s], x1[s], acc1); }
        asm volatile("s_waitcnt lgkmcnt(0)" ::: "memory");
    }
#undef GT_ISSUE
    bf16* op = F.PROJ + (size_t)(R0 + l31) * NP + 4096 + 32 * wid + 4 * hi;
#pragma unroll
    for (int q = 0; q < 4; ++q) {
        *(GAS v2u*)(op + 8 * q) = (v2u){cvtpk(acc0[4 * q], acc0[4 * q + 1]), cvtpk(acc0[4 * q + 2], acc0[4 * q + 3])};
        *(GAS v2u*)(op + (size_t)32 * NP + 8 * q) = (v2u){cvtpk(acc1[4 * q], acc1[4 * q + 1]), cvtpk(acc1[4 * q + 2], acc1[4 * q + 3])}; }
    __syncthreads();
}
struct Args { const float* in[21]; float* out; unsigned char* ws; int ph_lo, ph_hi; };
__global__ void __launch_bounds__(NWAVES * 64, 2) hymba_fwd(Args args) {
    extern __shared__ __attribute__((aligned(16))) unsigned char lds[];
    Frame F;
    F.lds = (LAS unsigned char*)lds;
    F.MISC = (volatile LAS unsigned*)(F.lds + MISC_OFF);
    F.wave = __builtin_amdgcn_readfirstlane((int)threadIdx.x >> 6); F.lane = mk_lane(); F.tid = F.wave * 64 + F.lane;
    F.G = gridDim.x; { const int bx = blockIdx.x; F.vcu = (F.G % 8 == 0) ? (bx % 8) * (F.G / 8) + bx / 8 : bx; }
    unsigned char* ws = args.ws;
    F.ctl = (gu32*)(ws + WS_CTL);
    F.x = args.in[0]; F.norm_g = args.in[1]; F.w_in = args.in[2]; F.shift_mu = args.in[3]; F.w0 = args.in[4]; F.w_decay_up = args.in[5]; F.a0 = args.in[6]; F.w_iclr_up = args.in[7];
    F.k_k = args.in[8]; F.k_a = args.in[9]; F.r_k = args.in[10]; F.ln_w = args.in[11]; F.ln_b = args.in[12]; F.qn_g = args.in[13]; F.kn_g = args.in[14];
    F.lq1 = args.in[15]; F.lk1 = args.in[16]; F.lq2 = args.in[17]; F.lk2 = args.in[18]; F.subln_g = args.in[19]; F.w_out = args.in[20]; F.out = args.out;
    F.WinT = (bf16*)(ws + WS_WIN); F.WoutT = (bf16*)(ws + WS_WOUT); F.WdT = (bf16*)(ws + WS_WD); F.WaT = (bf16*)(ws + WS_WA);
    F.XN = (bf16*)(ws + WS_XN); F.PROJ = (bf16*)(ws + WS_PROJ); F.MIX = (bf16*)(ws + WS_MIX);
    for (int u = F.tid; u < (LDS_BYTES - LDSCTL_OFF) / 4; u += NWAVES * 64) ((LAS unsigned*)(F.lds + LDSCTL_OFF))[u] = 0u;
    __syncthreads();
    XcdBarrier bar; bar.bar = (unsigned*)(F.ctl + CW_BAR); bar.x = 0; bar.st = nullptr; bar.wave = F.wave;
    if (MK_N_LAUNCHES == 1) bar = xcd_barrier_post((unsigned*)(F.ctl + CW_BAR), F.MISC + 8, F.wave);
#define GRID_BAR() do { if (MK_N_LAUNCHES == 1) xcd_barrier(bar); } while (0)
    const int lo = args.ph_lo, hi = args.ph_hi;
#define IN(k) (lo <= (k) && (k) < hi)
#define BOTH(k) (IN(k) && IN((k) + 1))
#ifndef SKIP
#define SKIP 0
#endif
    if (IN(0) && !(SKIP & 1)) { p0_prologue(F); if (DBL & 1) { GRID_BAR(); p0_prologue(F); } if (BOTH(0)) GRID_BAR(); }
    if (IN(1) && !(SKIP & 2)) {
        pg8::Gemm g{F.XN, F.WinT, M, 4096, D}; pg8::StaticOrder S; S.init(M, 4096, F.G, (int)blockIdx.x);
        pg8::EpiBf16S E{F.PROJ, NP};
        pg8::gemm_phase<pg8::EpiBf16S, pg8::StaticOrder, true, true>(F.lds + RING_OFF, g, S, E, F.wave);
#pragma unroll 1
        for (int qu = (int)blockIdx.x; qu < 256; qu += F.G) gemm1_tail_unit(F, qu);
#ifdef TAILX2
#pragma unroll 1
        for (int rep = 0; rep < TAILX2; ++rep) {
#pragma unroll 1
        for (int qu = (int)blockIdx.x; qu < 256; qu += F.G) gemm1_tail_unit(F, qu); }
#endif
        if (DBL & 2) { GRID_BAR(); pg8::gemm_phase<pg8::EpiBf16S, pg8::StaticOrder, true, true>(F.lds + RING_OFF, g, S, E, F.wave); }
        if (BOTH(1)) GRID_BAR();
    }
    RwDump Dm; { unsigned char* so = (unsigned char*)args.out; Dm.PF = (v4u*)so; Dm.DD = (v4u*)(so + 32 * MiB); Dm.QF = (v4u*)(ws + WS_XN); Dm.YD = (v4u*)(ws + WS_XN + 16 * MiB);
        Dm.GAM = (float*)(ws + WS_END); Dm.RHO = (float*)(ws + WS_END + 1 * MiB); }
    if (IN(2) && !(SKIP & 4)) {
        LAS float* wscr = (LAS float*)(F.lds + LDSCTL_OFF + 1024) + F.wave * 64; int zpar = 0;
#pragma unroll 1
        for (int p = F.vcu; p < BATCH * (T / 32); p += F.G) { rwkvA_unit(F, Dm, (p >> 6) * RH + F.wave, p & 63, wscr, F.lds + RING_OFF + F.wave * 16384, (LAS v4u*)(F.lds + LDSCTL_OFF + 4096), zpar); zpar ^= 1; }
        if (DBL & 4) { GRID_BAR();
#pragma unroll 1
            for (int p = F.vcu; p < BATCH * (T / 32); p += F.G) { rwkvA_unit(F, Dm, (p >> 6) * RH + F.wave, p & 63, wscr, F.lds + RING_OFF + F.wave * 16384, (LAS v4u*)(F.lds + LDSCTL_OFF + 4096), zpar); zpar ^= 1; } }
        p2_qknorm(F);
        if (BOTH(2)) GRID_BAR();
    }
    if (IN(3) && !(SKIP & 8)) {
#ifdef P3SPLIT
        p3_queue<1>(F, Dm); GRID_BAR(); p3_queue<2>(F, Dm, CW_QUEUE + 1024);
#else
        p3_queue(F, Dm);
#endif
        if (DBL & 512) { GRID_BAR(); p3_queue(F, Dm, CW_QUEUE + 1024); }
        if (BOTH(3)) GRID_BAR();
    }
    if (IN(4) && !(SKIP & 16)) {
        pg8::Gemm g{F.MIX, F.WoutT, M, D, D}; pg8::StaticOrder S; S.init(M, D, F.G, (int)blockIdx.x);
        pg8::EpiResF32 E{F.x, F.out, D};
        pg8::gemm_phase<pg8::EpiResF32, pg8::StaticOrder, false, true>(F.lds + RING_OFF, g, S, E, F.wave);
        if (DBL & 16) { GRID_BAR(); pg8::gemm_phase<pg8::EpiResF32, pg8::StaticOrder, false, true>(F.lds + RING_OFF, g, S, E, F.wave); }
    }
#undef IN
#undef BOTH
}

extern "C" void kernel_launch(void* const* d_in, const int* in_sizes, int n_in, void* d_out, int out_size, void* d_ws, size_t ws_size, hipStream_t stream) {
    static int grid = 0;
    if (grid == 0) {
        if (n_in != 21 || in_sizes[0] != M * D || out_size != M * D || ws_size < WS_END + 2 * MiB) { fprintf(stderr, "kernel_launch: unexpected shapes (n_in %d, in0 %d, out %d, ws %zu); nothing launched\n", n_in, n_in > 0 ? in_sizes[0] : -1, out_size, ws_size); grid = -1; return; }
        int dev = 0, cus = 0, per_cu = 0;
        if (hipGetDevice(&dev) != hipSuccess || hipDeviceGetAttribute(&cus, hipDeviceAttributeMultiprocessorCount, dev) != hipSuccess) { grid = -1; return; }
        if (hipFuncSetAttribute((const void*)hymba_fwd, hipFuncAttributeMaxDynamicSharedMemorySize, LDS_BYTES) != hipSuccess) { fprintf(stderr, "kernel_launch: hipFuncSetAttribute failed\n"); grid = -1; return; }
        if (hipOccupancyMaxActiveBlocksPerMultiprocessor(&per_cu, (const void*)hymba_fwd, NWAVES * 64, LDS_BYTES) != hipSuccess || per_cu < 1) { fprintf(stderr, "kernel_launch: occupancy query reports %d workgroups per CU; nothing launched\n", per_cu); grid = -1; return; }
        (void)hipGetLastError();
        grid = cus;
        if (grid > 256) grid = 256;
    }
    if (grid < 0) return;
    if (hipMemsetAsync((char*)d_ws + WS_CTL, 0, CTL_ZERO_BYTES, stream) != hipSuccess) { fprintf(stderr, "kernel_launch: hipMemsetAsync failed\n"); return; }
    Args a{};
    for (int i = 0; i < 21; ++i) a.in[i] = (const float*)d_in[i];
    a.out = (float*)d_out; a.ws = (unsigned char*)d_ws;
    for (int li = 0; li < MK_N_LAUNCHES; ++li) {
        a.ph_lo = (MK_N_LAUNCHES == 1) ? 0 : li; a.ph_hi = (MK_N_LAUNCHES == 1) ? N_PHASES : li + 1;
        hipLaunchKernelGGL(hymba_fwd, dim3(grid), dim3(NWAVES * 64), LDS_BYTES, stream, a);
        const hipError_t le = hipPeekAtLastError();
        if (le != hipSuccess) { fprintf(stderr, "kernel_launch: launch %d failed: %s\n", li, hipGetErrorName(le)); break; }
    }
}
```

```cpp
#include <hip/hip_runtime.h>
#include <hip/hip_bf16.h>
#include <cstdio>
#include <cstdint>
#include <cmath>
namespace pg8 {
#define PG8_LAS __attribute__((address_space(3)))
typedef unsigned short bf16_t;
typedef short bf16x8 __attribute__((ext_vector_type(8)));
typedef float f32x4 __attribute__((ext_vector_type(4)));
typedef unsigned u32x4 __attribute__((ext_vector_type(4)));
constexpr int BM = 256, BK = 64, HALF = 128, HTB = HALF * BK * 2  , STAGE_BYTES = 8 * HTB, NXCD = 8, WGM = 8;

__host__ __device__ __forceinline__ int lds_byte(int r, int c) { const int st = (r >> 4) * 2 + (c >> 5), rr = r & 15, cc = c & 31, ob = rr * 64 + cc * 2; return st * 1024 + (ob ^ (((ob >> 9) & 1) << 5)); }
__host__ __device__ __forceinline__ void stage_rc(int b, int& R, int& C) { const int st = b / 1024, sb = b % 1024, swz = sb ^ (((sb >> 9) & 1) << 5); R = (st >> 1) * 16 + swz / 64; C = (st & 1) * 32 + (swz % 64) / 2; }
__host__ __device__ __forceinline__ int perm32(int rho) { const int n = rho >> 4, i = rho & 15; return 8 * (i >> 2) + 4 * n + (i & 3); }

__device__ __forceinline__ int mk_lane_pg8() { int l; asm volatile("v_mbcnt_lo_u32_b32 %0, -1, 0\n\tv_mbcnt_hi_u32_b32 %0, -1, %0" : "=v"(l)); return l; }
struct Unit { int pm, pn; };
struct Gemm { const bf16_t* A; const bf16_t* Bt; int M, N, K; };

struct StaticOrder {
    int nM, nN, nwg, G, c;
    __host__ __device__ void init(int M, int N, int G_, int c_) { nM = M / BM; nN = N / BM; nwg = nM * nN; G = G_; c = c_; }
    __host__ __device__ bool next(int i, Unit& u) const {
        const long L = (long)i * G + c; if (L >= nwg) return false;
        int wgid = (int)L; { const int q = nwg / NXCD, r = nwg % NXCD, xcd = wgid % NXCD, off = wgid / NXCD; wgid = (xcd < r ? xcd * (q + 1) : r * (q + 1) + (xcd - r) * q) + off; }
        const int nig = WGM * nN, gid = wgid / nig, fm = gid * WGM, gsz = (nM - fm) < WGM ? (nM - fm) : WGM;
        u.pm = fm + ((wgid % nig) % gsz); u.pn = (wgid % nig) / gsz; return true;
    }
    __device__ __forceinline__ void a_ready(const Unit&) const {}
    __device__ __forceinline__ void done(const Unit&) const {}
};

__device__ __forceinline__ unsigned cvt_pk_bf16(float lo, float hi) { unsigned r; asm volatile("v_cvt_pk_bf16_f32 %0, %1, %2" : "=v"(r) : "v"(lo), "v"(hi)); return r; }
struct EpiBf16S {
    static constexpr bool PERM = true, AFTER_DRAIN = false, HAS_INIT = false;
    bf16_t* O; int ldc;
    __device__ __forceinline__ void operator()(const f32x4 (&acc)[2][2][4][2], const Unit& u, int wr, int wc, int fr, int fq) const {
        const int row0 = u.pm * BM + wr * 64 + fr, col0 = u.pn * BM + wc * 32 + 8 * fq;
#pragma unroll
        for (int ai = 0; ai < 2; ++ai)
#pragma unroll
            for (int m = 0; m < 4; ++m) { bf16_t* rowp = O + (size_t)(row0 + ai * HALF + m * 16) * ldc + col0;
#pragma unroll
                for (int bj = 0; bj < 2; ++bj) { const f32x4 v0 = acc[ai][bj][m][0], v1 = acc[ai][bj][m][1];
                    u32x4 w; w.x = cvt_pk_bf16(v0[0], v0[1]); w.y = cvt_pk_bf16(v0[2], v0[3]); w.z = cvt_pk_bf16(v1[0], v1[1]); w.w = cvt_pk_bf16(v1[2], v1[3]);
                    *(u32x4*)(rowp + bj * HALF) = w; } }
    }
};
struct EpiResF32 {
    static constexpr bool PERM = false, AFTER_DRAIN = false, HAS_INIT = true;
    const float* base; float* out; int ldc;
    __device__ __forceinline__ void init(f32x4 (&acc)[2][2][4][2], const Unit& u, int wr, int wc, int fr, int fq) const {
        const int row0 = u.pm * BM + wr * 64 + fr, col0 = u.pn * BM + wc * 32 + 4 * fq;
#pragma unroll
        for (int ai = 0; ai < 2; ++ai)
#pragma unroll
            for (int m = 0; m < 4; ++m) { const size_t off = (size_t)(row0 + ai * HALF + m * 16) * ldc + col0;
#pragma unroll
                for (int bj = 0; bj < 2; ++bj)
#pragma unroll
                    for (int n = 0; n < 2; ++n) acc[ai][bj][m][n] = *(const f32x4*)(base + off + bj * HALF + n * 16); }
    }
    __device__ __forceinline__ void operator()(const f32x4 (&acc)[2][2][4][2], const Unit& u, int wr, int wc, int fr, int fq) const {
        const int row0 = u.pm * BM + wr * 64 + fr, col0 = u.pn * BM + wc * 32 + 4 * fq;
#pragma unroll
        for (int ai = 0; ai < 2; ++ai)
#pragma unroll
            for (int m = 0; m < 4; ++m) { const size_t off = (size_t)(row0 + ai * HALF + m * 16) * ldc + col0;
#pragma unroll
                for (int bj = 0; bj < 2; ++bj)
#pragma unroll
                    for (int n = 0; n < 2; ++n) *(f32x4*)(out + off + bj * HALF + n * 16) = acc[ai][bj][m][n]; }
    }
};
template <class Epi, class Sched, bool ALIGN_EPI = false, bool SP2 = false>
__device__ __forceinline__ void gemm_phase(PG8_LAS unsigned char* lds, const Gemm g, const Sched& S, const Epi& E, const int mk_wave_id  ) {
    const int wid = mk_wave_id, lane = mk_lane_pg8(), tid = wid * 64 + lane, wr = wid >> 2, wc = wid & 3, fr = lane & 15, fq = lane >> 4;
    const int K = g.K, nt = K / BK;
    unsigned voffA[2], voffB[2];
#pragma unroll
    for (int i = 0; i < 2; ++i) { int R, C; stage_rc(tid * 16 + i * 8192, R, C); const int Rb = Epi::PERM ? ((R & ~31) + perm32(R & 31)) : R;
        voffA[i] = (unsigned)(R * K + C) * 2u; voffB[i] = (unsigned)(Rb * K + C) * 2u; }
    const size_t kstep = (size_t)(BK * 2);
    const size_t hstep = (size_t)HALF * K * 2;
    const size_t tstep = 2 * hstep;
    const unsigned ldsw = (unsigned)wid * 1024u;
    const int aoff = lds_byte(wr * 64 + fr, fq * 8), boff = lds_byte(wc * 32 + fr, fq * 8);
#define PG8_SA(b, h) (((b) * 2 + (h)) * HTB)
#define PG8_SB(b, h) ((4 + (b) * 2 + (h)) * HTB)
#define PG8_STAGE(bufoff, gbase, voff) do { _Pragma("unroll") for (int _i = 0; _i < 2; ++_i) \
        __builtin_amdgcn_global_load_lds((const unsigned*)((const char*)(gbase) + (voff)[_i]), (PG8_LAS unsigned*)(lds + (bufoff) + ldsw + _i * 8192), 16, 0, 0); } while (0)
#define PG8_LDA(dst, b, h) do { _Pragma("unroll") for (int m = 0; m < 4; ++m) _Pragma("unroll") for (int k = 0; k < 2; ++k) dst[m][k] = *(const PG8_LAS bf16x8*)(lds + PG8_SA(b, h) + aoff + m * 2048 + k * 1024); } while (0)
#define PG8_LDB(dst, b, h) do { _Pragma("unroll") for (int n = 0; n < 2; ++n) _Pragma("unroll") for (int k = 0; k < 2; ++k) dst[n][k] = *(const PG8_LAS bf16x8*)(lds + PG8_SB(b, h) + boff + n * 2048 + k * 1024); } while (0)
#define PG8_MMA(ai, bj, At, Bt) do { __builtin_amdgcn_s_setprio(1); _Pragma("unroll") for (int m = 0; m < 4; ++m) _Pragma("unroll") for (int n = 0; n < 2; ++n) _Pragma("unroll") for (int k = 0; k < 2; ++k) \
        acc[ai][bj][m][n] = __builtin_amdgcn_mfma_f32_16x16x32_bf16(Bt[n][k], At[m][k], acc[ai][bj][m][n], 0, 0, 0); __builtin_amdgcn_s_setprio(0); } while (0)
#define PG8_WAIT_V(n) asm volatile("s_waitcnt vmcnt(" #n ")" ::: "memory")
#define PG8_WAIT_L(n) asm volatile("s_waitcnt lgkmcnt(" #n ")" ::: "memory")
#define PG8_BAR __builtin_amdgcn_s_barrier()
#define PG8_SCHED __builtin_amdgcn_sched_barrier(0)
    Unit cur, nxt; int ui = 0;
    if (!S.next(0, cur)) return;
    f32x4 acc[2][2][4][2];
#pragma unroll
    for (int a = 0; a < 2; ++a)
#pragma unroll
        for (int b = 0; b < 2; ++b)
#pragma unroll
            for (int m = 0; m < 4; ++m)
#pragma unroll
                for (int n = 0; n < 2; ++n) acc[a][b][m][n] = (f32x4){0.f, 0.f, 0.f, 0.f};
    if constexpr (Epi::HAS_INIT) E.init(acc, cur, wr, wc, fr, fq);
    bf16x8 At[4][2], B0[2][2], B1[2][2];
    const char* cA = (const char*)g.A + (size_t)cur.pm * tstep; const char* cB = (const char*)g.Bt + (size_t)cur.pn * tstep;
    S.a_ready(cur);
    if constexpr (SP2) {
        PG8_STAGE(PG8_SB(0, 0), cB, voffB); PG8_STAGE(PG8_SB(0, 1), cB + hstep, voffB); PG8_STAGE(PG8_SA(0, 0), cA, voffA); PG8_STAGE(PG8_SA(0, 1), cA + hstep, voffA);
        if (wr == 1) PG8_BAR;
        PG8_WAIT_V(2); PG8_BAR;
        PG8_STAGE(PG8_SB(1, 0), cB + kstep, voffB); PG8_STAGE(PG8_SA(1, 0), cA + kstep, voffA); PG8_STAGE(PG8_SB(1, 1), cB + hstep + kstep, voffB);
        PG8_WAIT_V(6); PG8_BAR;
    } else {
        PG8_STAGE(PG8_SB(0, 0), cB, voffB); PG8_STAGE(PG8_SA(0, 0), cA, voffA); PG8_STAGE(PG8_SB(0, 1), cB + hstep, voffB); PG8_STAGE(PG8_SA(0, 1), cA + hstep, voffA);
        if (wr == 1) PG8_BAR;
        PG8_WAIT_V(4); PG8_BAR;
        PG8_STAGE(PG8_SB(1, 0), cB + kstep, voffB); PG8_STAGE(PG8_SA(1, 0), cA + kstep, voffA); PG8_STAGE(PG8_SB(1, 1), cB + hstep + kstep, voffB);
        PG8_WAIT_V(6); PG8_BAR;
    }
    for (;;) {
        const bool has_next = S.next(ui + 1, nxt);
        const char* nA = has_next ? (const char*)g.A + (size_t)nxt.pm * tstep : cA; const char* nB = has_next ? (const char*)g.Bt + (size_t)nxt.pn * tstep : cB;
        for (int t = 0; t < nt; t += 2) {
            const bool last = (t == nt - 2);
            const char* a1 = cA + (size_t)(t + 1) * kstep;
            const char* a2 = last ? nA : cA + (size_t)(t + 2) * kstep; const char* b2 = last ? nB : cB + (size_t)(t + 2) * kstep;
            const char* a3 = a2 + kstep; const char* b3 = b2 + kstep;
            if (last && has_next) S.a_ready(nxt);
            if constexpr (SP2) {
            PG8_LDB(B0, 0, 0); PG8_LDB(B1, 0, 1); PG8_SCHED; PG8_LDA(At, 0, 0); PG8_STAGE(PG8_SA(1, 1), a1 + hstep, voffA);
            PG8_WAIT_V(8); PG8_WAIT_L(0); PG8_BAR; PG8_MMA(0, 0, At, B0); PG8_MMA(0, 1, At, B1); PG8_BAR; PG8_SCHED;
            PG8_LDA(At, 0, 1); PG8_STAGE(PG8_SB(0, 0), b2, voffB); PG8_STAGE(PG8_SB(0, 1), b2 + hstep, voffB); PG8_STAGE(PG8_SA(0, 0), a2, voffA);
            PG8_WAIT_V(8); PG8_WAIT_L(0); PG8_BAR; PG8_MMA(1, 0, At, B0); PG8_MMA(1, 1, At, B1); PG8_BAR; PG8_SCHED;
            PG8_LDB(B0, 1, 0); PG8_LDB(B1, 1, 1); PG8_SCHED; PG8_LDA(At, 1, 0); PG8_STAGE(PG8_SA(0, 1), a2 + hstep, voffA);
            PG8_WAIT_V(8); PG8_WAIT_L(0); PG8_BAR; PG8_MMA(0, 0, At, B0); PG8_MMA(0, 1, At, B1); PG8_BAR; PG8_SCHED;
            PG8_LDA(At, 1, 1); PG8_STAGE(PG8_SB(1, 0), b3, voffB); PG8_STAGE(PG8_SB(1, 1), b3 + hstep, voffB); PG8_STAGE(PG8_SA(1, 0), a3, voffA);
            PG8_WAIT_V(8); PG8_WAIT_L(0); PG8_BAR; PG8_MMA(1, 0, At, B0); PG8_MMA(1, 1, At, B1); PG8_BAR; PG8_SCHED;
            } else {
            PG8_LDB(B0, 0, 0); PG8_SCHED; PG8_LDA(At, 0, 0); PG8_STAGE(PG8_SA(1, 1), a1 + hstep, voffA);
            PG8_WAIT_L(8); PG8_BAR; PG8_WAIT_L(0); PG8_MMA(0, 0, At, B0); PG8_BAR; PG8_SCHED;
            PG8_LDB(B1, 0, 1); PG8_STAGE(PG8_SB(0, 0), b2, voffB);
            PG8_BAR; PG8_WAIT_L(0); PG8_MMA(0, 1, At, B1); PG8_BAR;
            PG8_LDA(At, 0, 1); PG8_STAGE(PG8_SA(0, 0), a2, voffA);
            PG8_BAR; PG8_WAIT_L(0); PG8_MMA(1, 0, At, B0); PG8_BAR; PG8_SCHED;
            PG8_STAGE(PG8_SB(0, 1), b2 + hstep, voffB);
            PG8_WAIT_V(6); PG8_BAR; PG8_MMA(1, 1, At, B1); PG8_BAR;
            PG8_LDB(B0, 1, 0); PG8_SCHED; PG8_LDA(At, 1, 0); PG8_STAGE(PG8_SA(0, 1), a2 + hstep, voffA);
            PG8_WAIT_L(8); PG8_BAR; PG8_WAIT_L(0); PG8_MMA(0, 0, At, B0); PG8_BAR; PG8_SCHED;
            PG8_LDB(B1, 1, 1); PG8_STAGE(PG8_SB(1, 0), b3, voffB);
            PG8_BAR; PG8_WAIT_L(0); PG8_MMA(0, 1, At, B1); PG8_BAR;
            PG8_LDA(At, 1, 1); PG8_STAGE(PG8_SA(1, 0), a3, voffA);
            PG8_BAR; PG8_WAIT_L(0); PG8_MMA(1, 0, At, B0); PG8_BAR; PG8_SCHED;
            PG8_STAGE(PG8_SB(1, 1), b3 + hstep, voffB);
            PG8_WAIT_V(6); PG8_BAR; PG8_MMA(1, 1, At, B1); PG8_BAR;
            }
        }
        if constexpr (ALIGN_EPI) { if (wr == 0) PG8_BAR; }
        if constexpr (!Epi::AFTER_DRAIN) { E(acc, cur, wr, wc, fr, fq); S.done(cur); }
        if (!has_next) break;
#pragma unroll
        for (int a = 0; a < 2; ++a)
#pragma unroll
            for (int b = 0; b < 2; ++b)
#pragma unroll
                for (int m = 0; m < 4; ++m)
#pragma unroll
                    for (int n = 0; n < 2; ++n) acc[a][b][m][n] = (f32x4){0.f, 0.f, 0.f, 0.f};
        if constexpr (Epi::HAS_INIT) E.init(acc, nxt, wr, wc, fr, fq);
        cur = nxt; cA = nA; cB = nB; ++ui;
        if constexpr (ALIGN_EPI) { if (wr == 1) PG8_BAR; }
    }
    PG8_WAIT_V(0);
    if constexpr (!ALIGN_EPI) { if (wr == 0) PG8_BAR; }
    PG8_BAR;
    if constexpr (Epi::AFTER_DRAIN) { E.fused(acc, cur, wr, wc, fr, fq, lds, wid, lane); S.done(cur); }
#undef PG8_SA
#undef PG8_SB
#undef PG8_STAGE
#undef PG8_LDA
#undef PG8_LDB
#undef PG8_MMA
#undef PG8_WAIT_V
#undef PG8_WAIT_L
#undef PG8_BAR
#undef PG8_SCHED
}
}
constexpr int NWAVES = 8;
#ifndef MK_N_LAUNCHES
#define MK_N_LAUNCHES 1
#endif
constexpr int N_PHASES = 5;
constexpr int BATCH = 8, T = 2048, D = 1024, M = BATCH * T;
constexpr int NP = 4352;
constexpr int C_R = 0, C_K = 512, C_V = 1024, C_ZW = 1536, C_ZA = 1600, C_GA = 1792, C_DQ = 2304, C_DK = 2816, C_DV = 3328, C_GB = 3840;
constexpr int RH = 8, RN = 64;
constexpr int AH = 4;
constexpr float C2 = 0.125f * 1.4426950408889634f;
constexpr float LOG2E = 1.4426950408889634f;
constexpr float LAMBDA_INIT = 0.2f;

constexpr size_t MiB = 1u << 20;
constexpr size_t WS_CTL = 0, CTL_ZERO_BYTES = 1 * MiB;
constexpr size_t WS_WIN = 2 * MiB;
constexpr size_t WS_WOUT = 11 * MiB;
constexpr size_t WS_WD = 13 * MiB, WS_WA = 13 * MiB + 65536;
constexpr size_t WS_RHO = 13 * MiB + 2 * 65536;
constexpr size_t WS_XN = 14 * MiB;
constexpr size_t WS_PROJ = 46 * MiB;
constexpr size_t WS_MIX = 182 * MiB;
constexpr size_t WS_END = 214 * MiB;
constexpr int CW_BAR = 4096;

constexpr int RING_OFF = 0, RING_BYTES = 131072;
constexpr int LDSCTL_OFF = RING_BYTES, MISC_OFF = LDSCTL_OFF + 320;
constexpr int LDS_BYTES = 155648;

#define GAS __attribute__((address_space(1)))
#define LAS __attribute__((address_space(3)))
typedef unsigned short bf16;
typedef unsigned v4u __attribute__((ext_vector_type(4)));
typedef unsigned v2u __attribute__((ext_vector_type(2)));
typedef float f32x4 __attribute__((ext_vector_type(4)));
typedef float f32x16 __attribute__((ext_vector_type(16)));
typedef short bf16x8 __attribute__((ext_vector_type(8)));
typedef short s16x4 __attribute__((ext_vector_type(4)));
typedef GAS unsigned gu32;
typedef GAS unsigned long long gu64;
#define RLX_AGENT __ATOMIC_RELAXED, __HIP_MEMORY_SCOPE_AGENT
#define LDS_WAIT() asm volatile("s_waitcnt lgkmcnt(0)" ::: "memory")
#define VM_WAIT() asm volatile("s_waitcnt vmcnt(0)" ::: "memory")
__device__ __forceinline__ unsigned f2bf(float f) { unsigned u = __builtin_bit_cast(unsigned, f); return (u + 0x7fffu + ((u >> 16) & 1u)) >> 16; }
__device__ __forceinline__ unsigned pk2(float lo, float hi) { return f2bf(lo) | (f2bf(hi) << 16); }
__device__ __forceinline__ float bflo(unsigned u) { return __uint_as_float(u << 16); }
__device__ __forceinline__ float bfhi(unsigned u) { return __uint_as_float(u & 0xffff0000u); }
__device__ __forceinline__ float bf1(unsigned short u) { return __uint_as_float((unsigned)u << 16); }
__device__ __forceinline__ int mk_lane() { int l; asm volatile("v_mbcnt_lo_u32_b32 %0, -1, 0\n\tv_mbcnt_hi_u32_b32 %0, -1, %0" : "=v"(l)); return l; }
#define XB_TMO      128
#define XB_XCNT(j)  (256  + 64 * (j))
#define XB_XSUB(j)  (1280 + 64 * (j))
#define XB_XGEN(j)  (2304 + 64 * (j))
#define XB_TOP      3328
#define XB_TOPGEN   3392
#define XCD_BAR_WORDS 3456
#define XB_SPIN_CAP (1u << 18)

__device__ __forceinline__ unsigned xb_ld(unsigned* p)              { return __hip_atomic_load(p, __ATOMIC_RELAXED, __HIP_MEMORY_SCOPE_AGENT); }
__device__ __forceinline__ unsigned xb_add(unsigned* p, unsigned v) { return __hip_atomic_fetch_add(p, v, __ATOMIC_RELAXED, __HIP_MEMORY_SCOPE_AGENT); }
__device__ __forceinline__ unsigned xb_xcc_id() { return (unsigned)__builtin_amdgcn_s_getreg((3 << 11) | 20) & 0xFu; }
#define XB_SPIN(cond, bar) do { unsigned _sp = 0; while (cond) { __builtin_amdgcn_s_sleep(1); \
    if ((++_sp & 255u) == 0u) { if (xb_ld(&(bar)[XB_TMO])) break; if (_sp > XB_SPIN_CAP) { atomicAdd(&(bar)[XB_TMO], 1u); break; } } } } while (0)

struct XcdBarrier {
    unsigned* bar; unsigned x;
    volatile LAS unsigned* st;
    int wave;
};

__device__ __forceinline__ XcdBarrier xcd_barrier_post(unsigned* bar, volatile LAS unsigned* st, int wave) {
    XcdBarrier b; b.bar = bar; b.x = xb_xcc_id(); b.st = st; b.wave = wave;
    if (wave == 0 && mk_lane() == 0) (void)xb_add(&bar[XB_XCNT(b.x)], 1u);
    return b;
}
__device__ __forceinline__ void xcd_barrier_complete(unsigned* bar, unsigned x, unsigned& nloc, unsigned& nx) {
    const unsigned G = gridDim.x * gridDim.y * gridDim.z;
    unsigned sum, cnt, mine, sp = 0u;
    for (;;) {
        sum = 0u; cnt = 0u; mine = 0u;
#pragma unroll
        for (unsigned j = 0; j < 16; ++j) { const unsigned c = xb_ld(&bar[XB_XCNT(j)]); sum += c; cnt += (c > 0u) ? 1u : 0u; mine = (j == x) ? c : mine; }
        if (sum == G) break;
        __builtin_amdgcn_s_sleep(1);
        if ((++sp & 255u) == 0u) { if (xb_ld(&bar[XB_TMO])) break; if (sp > XB_SPIN_CAP) { atomicAdd(&bar[XB_TMO], 1u); break; } }
    }
    nloc = mine > 0u ? mine : 1u; nx = cnt > 0u ? cnt : 1u;
}

__device__ __forceinline__ void xcd_barrier(const XcdBarrier& b) {
    asm volatile("s_waitcnt vmcnt(0)" ::: "memory");
    __syncthreads();
    if (b.wave == 0 && mk_lane() == 0) {
        unsigned* bar = b.bar;
        __builtin_amdgcn_s_waitcnt(0);
        unsigned nloc = b.st[0], nx = b.st[1];
        if (nloc == 0u) { xcd_barrier_complete(bar, b.x, nloc, nx); b.st[0] = nloc; b.st[1] = nx; }
        const unsigned old = xb_add(&bar[XB_XSUB(b.x)], 1u);
        const unsigned gen = old / nloc;
        if (old + 1u == (gen + 1u) * nloc) {
            __builtin_amdgcn_fence(__ATOMIC_RELEASE, "agent");
            asm volatile("s_waitcnt vmcnt(0)" ::: "memory");
            const unsigned og = xb_add(&bar[XB_TOP], 1u);
            const unsigned tg = og / nx;
            if (og + 1u == (tg + 1u) * nx) xb_add(&bar[XB_TOPGEN], 1u);
            else XB_SPIN(xb_ld(&bar[XB_TOPGEN]) == tg, bar);
            __builtin_amdgcn_fence(__ATOMIC_ACQUIRE, "agent");
            xb_add(&bar[XB_XGEN(b.x)], 1u);
            asm volatile("s_waitcnt vmcnt(0)" ::: "memory");
        } else {
            XB_SPIN(xb_ld(&bar[XB_XGEN(b.x)]) == gen, bar);
            __builtin_amdgcn_fence(__ATOMIC_ACQUIRE, "agent");
            asm volatile("s_waitcnt vmcnt(0)" ::: "memory");
        }
    }
    __syncthreads();
}
struct Frame {
    LAS unsigned char* lds;
    volatile LAS unsigned* MISC;
    gu32* ctl;
    int tid, lane, wave;
    int vcu, G;
    const float* x; float* out;
    const float *norm_g, *w_in, *shift_mu, *w0, *w_decay_up, *a0, *w_iclr_up, *k_k, *k_a, *r_k, *ln_w, *ln_b, *qn_g, *kn_g, *lq1, *lk1, *lq2, *lk2, *subln_g, *w_out;
    bf16 *WinT, *WoutT, *WdT, *WaT, *XN, *PROJ, *MIX;
};

typedef float f32x2q_t __attribute__((ext_vector_type(2))); typedef __bf16 bf16x2q_t __attribute__((ext_vector_type(2)));
__device__ __forceinline__ unsigned cvtpk2(float lo, float hi) { f32x2q_t v = {lo, hi}; bf16x2q_t b = __builtin_convertvector(v, bf16x2q_t); return __builtin_bit_cast(unsigned, b); }
__device__ __forceinline__ float wave_sum(float v) {
#pragma unroll
    for (int o = 1; o < 64; o <<= 1) v += __shfl_xor(v, o);
    return v;
}
template <int CTRL> __device__ __forceinline__ float dpp_f(float x) { return __builtin_bit_cast(float, __builtin_amdgcn_mov_dpp(__builtin_bit_cast(int, x), CTRL, 0xf, 0xf, true)); }
__device__ __forceinline__ float row16_sum(float x) {
    x += dpp_f<0xB1>(x); x += dpp_f<0x4E>(x); x += dpp_f<0x141>(x); x += dpp_f<0x140>(x); return x;
}
__device__ __forceinline__ float swap32_sum(float x) {
    auto rr = __builtin_amdgcn_permlane32_swap(__float_as_uint(x), __float_as_uint(x), false, false);
    return __uint_as_float(rr[0]) + __uint_as_float(rr[1]);
}

__device__ __forceinline__ void p0_transpose_item(const float* W, int N, int nsrc, const float* kscale, bf16* WT, int K, int ndst, LAS float* scr, int k0, int lane) {
    float v[32];
#pragma unroll
    for (int i = 0; i < 32; ++i) { const int kk = 2 * i + (lane >> 5); v[i] = (nsrc >= 0) ? W[(size_t)(k0 + kk) * N + nsrc + (lane & 31)] : 0.f; }
    if (kscale && nsrc >= 0) {
#pragma unroll
        for (int i = 0; i < 32; ++i) v[i] *= kscale[k0 + 2 * i + (lane >> 5)];
    }
#pragma unroll
    for (int i = 0; i < 32; ++i) scr[(2 * i + (lane >> 5)) * 33 + (lane & 31)] = v[i];
    LDS_WAIT(); asm volatile("" ::: "memory");
    const int c = lane & 7;
#pragma unroll
    for (int j = 0; j < 4; ++j) { const int n = (lane >> 3) + 8 * j; const LAS float* s = scr + (8 * c) * 33 + n;
        v4u o; o.x = cvtpk2(s[0 * 33], s[1 * 33]); o.y = cvtpk2(s[2 * 33], s[3 * 33]); o.z = cvtpk2(s[4 * 33], s[5 * 33]); o.w = cvtpk2(s[6 * 33], s[7 * 33]);
        *(GAS v4u*)(WT + (size_t)(ndst + n) * K + k0 + 8 * c) = o; }
    LDS_WAIT(); asm volatile("" ::: "memory");
}
__device__ __forceinline__ void p0_rows4(Frame& F, int m0) {
    f32x4 v[4][4]; float s[4];
#pragma unroll
    for (int u = 0; u < 4; ++u) { const GAS f32x4* xr = (const GAS f32x4*)(F.x + (size_t)(m0 + u) * D) + F.lane;
#pragma unroll
        for (int j = 0; j < 4; ++j) v[u][j] = __builtin_nontemporal_load(xr + 64 * j); }
#pragma unroll
    for (int u = 0; u < 4; ++u) { float a = 0.f;
#pragma unroll
        for (int j = 0; j < 4; ++j) a += (v[u][j].x * v[u][j].x + v[u][j].y * v[u][j].y) + (v[u][j].z * v[u][j].z + v[u][j].w * v[u][j].w);
        s[u] = a; }
#pragma unroll
    for (int u = 0; u < 4; ++u) {
        const float rstd = __builtin_amdgcn_rsqf(wave_sum(s[u]) * (1.f / D) + 1e-6f);
        GAS unsigned long long* o8 = (GAS unsigned long long*)(F.XN + (size_t)(m0 + u) * D) + F.lane;
#pragma unroll
        for (int j = 0; j < 4; ++j) o8[64 * j] = (unsigned long long)cvtpk2(v[u][j].x * rstd, v[u][j].y * rstd) | ((unsigned long long)cvtpk2(v[u][j].z * rstd, v[u][j].w * rstd) << 32);
    }
}
__device__ __forceinline__ void p0_prologue(Frame& F) {
    LAS float* scr = (LAS float*)(F.lds + RING_OFF + F.wave * 16384);
    const int gw = F.vcu * NWAVES + F.wave, NGW = F.G * NWAVES;
    constexpr int I_IN = (D / 64) * (NP / 32), I_OUT = (D / 64) * (D / 32), I_L = 512 / 32;
    constexpr int NITEMS = I_IN + I_OUT + 2 * I_L;
    int m0 = gw * 4;
    if (!(gw & 1) && m0 < M) { p0_rows4(F, m0); m0 += NGW * 4; }
#pragma unroll 1
    for (int it = gw; it < NITEMS; it += NGW) {
        int r = it;
        if (r < I_IN) { const int kb = r / (NP / 32), nb = r % (NP / 32), nd = 32 * nb; const int ns = nd < 1664 ? nd : (nd < 1792 ? -1 : nd - 128);
            p0_transpose_item(F.w_in, 4224, ns, F.norm_g, F.WinT, D, nd, scr, 64 * kb, F.lane); continue; } r -= I_IN;
        if (r < I_OUT) { const int kb = r / (D / 32), nb = r % (D / 32);
            p0_transpose_item(F.w_out, D, 32 * nb, nullptr, F.WoutT, D, 32 * nb, scr, 64 * kb, F.lane); continue; } r -= I_OUT;
        if (r < I_L) { p0_transpose_item(F.w_decay_up, 512, 32 * r, nullptr, F.WdT, 64, 32 * r, scr, 0, F.lane); continue; } r -= I_L;
        p0_transpose_item(F.w_iclr_up, 512, 32 * r, nullptr, F.WaT, 64, 32 * r, scr, 0, F.lane);
    }
#pragma unroll 1
    for (; m0 < M; m0 += NGW * 4) p0_rows4(F, m0);
}

__device__ __forceinline__ float tanh_f(float x) { const float e = __expf(-2.f * fabsf(x)); const float t = (1.f - e) * __builtin_amdgcn_rcpf(1.f + e); return x < 0.f ? -t : t; }
__device__ __forceinline__ void shifted8(const bf16* proj, size_t m, bool has_prev, int col, const float* mu, float (&o)[8]) {
    const v4u c = *(const GAS v4u*)(proj + m * NP + col);
    v4u p = (v4u){0u, 0u, 0u, 0u}; if (has_prev) p = *(const GAS v4u*)(proj + (m - 1) * NP + col);
    const f32x4 m0 = *(const GAS f32x4*)(mu), m1 = *(const GAS f32x4*)(mu + 4);
    const unsigned cw[4] = {c.x, c.y, c.z, c.w}, pw[4] = {p.x, p.y, p.z, p.w}; const float mm[8] = {m0.x, m0.y, m0.z, m0.w, m1.x, m1.y, m1.z, m1.w};
#pragma unroll
    for (int j = 0; j < 4; ++j) { const float c0 = bflo(cw[j]), c1 = bfhi(cw[j]), p0 = bflo(pw[j]), p1 = bfhi(pw[j]);
        o[2 * j] = c0 + (p0 - c0) * mm[2 * j]; o[2 * j + 1] = c1 + (p1 - c1) * mm[2 * j + 1]; }
}
__device__ __forceinline__ void shifted4(const bf16* proj, size_t m, bool has_prev, int col, const float* mu, float (&o)[4]) {
    const v2u c = *(const GAS v2u*)(proj + m * NP + col);
    v2u p = (v2u){0u, 0u}; if (has_prev) p = *(const GAS v2u*)(proj + (m - 1) * NP + col);
    const f32x4 m0 = *(const GAS f32x4*)(mu);
    o[0] = bflo(c.x) + (bflo(p.x) - bflo(c.x)) * m0.x; o[1] = bfhi(c.x) + (bfhi(p.x) - bfhi(c.x)) * m0.y;
    o[2] = bflo(c.y) + (bflo(p.y) - bflo(c.y)) * m0.z; o[3] = bfhi(c.y) + (bfhi(p.y) - bfhi(c.y)) * m0.w;
}
__device__ __forceinline__ void p2_qknorm(Frame& F) {
    const int gw = F.vcu * NWAVES + F.wave, NGW = F.G * NWAVES, lane = F.lane, sub = lane & 7;
    const f32x4 gk0 = *(const GAS f32x4*)(F.kn_g + sub * 8), gk1 = *(const GAS f32x4*)(F.kn_g + sub * 8 + 4);
    constexpr int UQ = 4;
    for (int it0 = gw * UQ; it0 < M; it0 += NGW * UQ) {
        bf16* p[UQ]; v4u c[UQ];
#pragma unroll
        for (int u = 0; u < UQ; ++u) { const size_t m = (size_t)(it0 + u); p[u] = F.PROJ + m * NP + C_DK + (lane >> 3) * 64 + sub * 8; c[u] = *(const GAS v4u*)p[u]; }
#pragma unroll
        for (int u = 0; u < UQ; ++u) {
            const unsigned cw[4] = {c[u].x, c[u].y, c[u].z, c[u].w};
            float xv[8]; float ss = 0.f;
#pragma unroll
            for (int j = 0; j < 4; ++j) { xv[2 * j] = bflo(cw[j]); xv[2 * j + 1] = bfhi(cw[j]); ss += xv[2 * j] * xv[2 * j] + xv[2 * j + 1] * xv[2 * j + 1]; }
            ss += dpp_f<0xB1>(ss); ss += dpp_f<0x4E>(ss); ss += dpp_f<0x141>(ss);
            const float r = __builtin_amdgcn_rsqf(ss * (1.f / 64.f) + 1e-6f);
            v4u o; o.x = cvtpk2(xv[0] * r * gk0.x, xv[1] * r * gk0.y); o.y = cvtpk2(xv[2] * r * gk0.z, xv[3] * r * gk0.w); o.z = cvtpk2(xv[4] * r * gk1.x, xv[5] * r * gk1.y); o.w = cvtpk2(xv[6] * r * gk1.z, xv[7] * r * gk1.w);
            *(GAS v4u*)p[u] = o;
        }
    }
}
typedef float f32x2_t __attribute__((ext_vector_type(2))); typedef __bf16 bf16x2_t __attribute__((ext_vector_type(2)));
__device__ __forceinline__ unsigned cvtpk(float lo, float hi) { f32x2_t v = {lo, hi}; bf16x2_t b = __builtin_convertvector(v, bf16x2_t); return __builtin_bit_cast(unsigned, b); }
#define MFMA32(a, b, c) __builtin_amdgcn_mfma_f32_32x32x16_bf16(__builtin_bit_cast(bf16x8, (a)), __builtin_bit_cast(bf16x8, (b)), (c), 0, 0, 0)
#define FRAGACC(z, s) ((v4u){cvtpk((z)[8 * (s)], (z)[8 * (s) + 1]), cvtpk((z)[8 * (s) + 2], (z)[8 * (s) + 3]), cvtpk((z)[8 * (s) + 4], (z)[8 * (s) + 5]), cvtpk((z)[8 * (s) + 6], (z)[8 * (s) + 7])})
template <int CTRL, int RM> __device__ __forceinline__ float dpp_upd0(float x) { return __builtin_bit_cast(float, __builtin_amdgcn_update_dpp(0, __builtin_bit_cast(int, x), CTRL, RM, 0xf, false)); }
__device__ __forceinline__ float scan32(float x) {
    x += dpp_upd0<0x111, 0xf>(x); x += dpp_upd0<0x112, 0xf>(x); x += dpp_upd0<0x114, 0xf>(x); x += dpp_upd0<0x118, 0xf>(x); x += dpp_upd0<0x142, 0xa>(x); return x;
}
__device__ __forceinline__ void st_wt16(v4u* p, const v4u v) { *(GAS v4u*)p = v; }
constexpr int RW_UNITS = BATCH * RH * (T / 32);
struct RwDump { v4u* PF; v4u* DD; v4u* QF; v4u* YD; float* GAM; float* RHO; };

__device__ __forceinline__ void rwkvA_unit(Frame& F, const RwDump& Dm, int bh, int ci, LAS float* wscr, LAS unsigned char* park, LAS v4u* zsh, int zpar) {
    int lane = mk_lane(); asm volatile("" : "+v"(lane));
    const int hi = lane >> 5, l31 = lane & 31, b = bh >> 3, w = bh & 7;
    LAS v4u* pk = (LAS v4u*)park + lane;
#define PARK(slot) pk[(slot) * 64]
    int tok = 0; asm volatile("" : "+v"(tok));
#define DEP(x) asm volatile("" : "+v"(tok) : "v"(x))
    const int t = ci * 32 + l31; const size_t m = (size_t)b * T + t; const bool hp = t > 0;
    const int u = ci * (BATCH * RH) + bh;
    const float pm = hp ? 1.f : 0.f;
    const float* mu = F.shift_mu + w * 64 + 4 * hi;
    const float *pw0 = F.w0 + w * 64 + 4 * hi, *pa0 = F.a0 + w * 64 + 4 * hi, *pkk = F.k_k + w * 64 + 4 * hi, *pka = F.k_a + w * 64 + 4 * hi, *prk = F.r_k + w * 64 + 4 * hi;
    LAS unsigned char* stg = park + 8192;
    LAS unsigned char* prv = F.lds + LDSCTL_OFF + 20480 + F.wave * 256;
    const bf16* gk = F.PROJ + ((size_t)b * T + ci * 32) * NP + w * 64;
    const bf16* gpr = gk - (ci > 0 ? NP : 0);
#define RW_DMA(src, dst) __builtin_amdgcn_global_load_lds((const unsigned*)(src), (LAS unsigned*)(dst), 16, 0, 0)
    LDS_WAIT();
    { const bf16* s_ = gk + (size_t)(lane >> 3) * NP + C_K + (lane & 7) * 8;
#pragma unroll
      for (int p = 0; p < 4; ++p) RW_DMA(s_ + (size_t)(8 * p) * NP, stg + p * 1024);
      if (lane < 8) RW_DMA(gpr + C_K + lane * 8, prv); }
#define RW_STAGE_RV(cb) do { const bf16* s_ = gk + (size_t)(lane >> 2) * NP + 32 * (cb) + (lane & 3) * 8; \
      _Pragma("unroll") for (int p = 0; p < 2; ++p) { RW_DMA(s_ + C_R + (size_t)(16 * p) * NP, stg + 4096 + p * 1024); RW_DMA(s_ + C_V + (size_t)(16 * p) * NP, stg + 6144 + p * 1024); } \
      if (lane < 4) { RW_DMA(gpr + C_R + 32 * (cb) + lane * 8, prv + 128); RW_DMA(gpr + C_V + 32 * (cb) + lane * 8, prv + 192); } } while (0)
    RW_STAGE_RV(0);
    const LAS unsigned char* kcur = stg + l31 * 128 + 8 * hi; const LAS unsigned char* kprv = l31 ? kcur - 128 : prv + 8 * hi;
    const LAS unsigned char* rcur = stg + 4096 + l31 * 64 + 8 * hi; const LAS unsigned char* rprv = l31 ? rcur - 64 : prv + 128 + 8 * hi;
    const LAS unsigned char* vcur = stg + 6144 + l31 * 64 + 8 * hi; const LAS unsigned char* vprv = l31 ? vcur - 64 : prv + 192 + 8 * hi;
    v4u bz[4], ba[4];
    { const int s = F.wave >> 1; const bool which = (F.wave & 1) != 0;
      const bf16* zc = F.PROJ + m * NP + 8 * hi; const bf16* zp = F.PROJ + (hp ? m - 1 : m) * NP + 8 * hi; const float* zmu = F.shift_mu + 8 * hi;
      const int COL = (which ? C_ZA : C_ZW) + 16 * s, MUO = (which ? 1600 : 1536) + 16 * s;
      const v4u c = *(const GAS v4u*)(zc + tok + COL), p = *(const GAS v4u*)(zp + tok + COL); const f32x4 m0 = *(const GAS f32x4*)(zmu + tok + MUO), m1 = *(const GAS f32x4*)(zmu + tok + MUO + 4);
      float z[8];
#pragma unroll
      for (int j = 0; j < 4; ++j) { const float c0 = bflo(c[j]), c1 = bfhi(c[j]); const float mm0 = j < 2 ? m0[2 * j] : m1[2 * j - 4], mm1 = j < 2 ? m0[2 * j + 1] : m1[2 * j - 3];
          z[2 * j] = c0 + (bflo(p[j]) * pm - c0) * mm0; z[2 * j + 1] = c1 + (bfhi(p[j]) * pm - c1) * mm1; }
      if (!which) {
#pragma unroll
          for (int j = 0; j < 8; ++j) z[j] = tanh_f(z[j]); }
      LAS v4u* zs = zsh + zpar * 512;
      zs[((which ? 4 : 0) + s) * 64 + lane] = (v4u){cvtpk(z[0], z[1]), cvtpk(z[2], z[3]), cvtpk(z[4], z[5]), cvtpk(z[6], z[7])};
      __syncthreads();
#pragma unroll
      for (int q = 0; q < 4; ++q) { bz[q] = zs[q * 64 + lane]; ba[q] = zs[(4 + q) * 64 + lane]; }
      DEP(bz[3][3]); DEP(ba[3][3]); }
    asm volatile("" ::: "memory");
    asm volatile("s_waitcnt vmcnt(0)" ::: "memory");
    float ss = 0.f;
#pragma unroll
    for (int gq = 0; gq < 8; ++gq) { const v2u c_ = *(const LAS v2u*)(kcur + tok + 16 * gq), p_ = *(const LAS v2u*)(kprv + tok + 16 * gq);
        const f32x4 m_ = *(const GAS f32x4*)(mu + tok + 512 + 8 * gq), kkp = *(const GAS f32x4*)(pkk + tok + 8 * gq);
        float k4[4]; k4[0] = bflo(c_.x) + (bflo(p_.x) * pm - bflo(c_.x)) * m_.x; k4[1] = bfhi(c_.x) + (bfhi(p_.x) * pm - bfhi(c_.x)) * m_.y;
        k4[2] = bflo(c_.y) + (bflo(p_.y) * pm - bflo(c_.y)) * m_.z; k4[3] = bfhi(c_.y) + (bfhi(p_.y) * pm - bfhi(c_.y)) * m_.w;
#pragma unroll
        for (int e = 0; e < 4; ++e) { const float q = k4[e] * kkp[e]; ss += q * q; }
        if (gq == 3) DEP(ss); }
    ss = swap32_sum(ss);
    const float inv = __builtin_amdgcn_rcpf(fmaxf(__builtin_amdgcn_sqrtf(ss), 1e-12f));
    asm volatile("" ::: "memory");
    v4u fa[4], fb[4], fk[4], fr[4], fv[4]; float rho = 0.f;
    float* gp = Dm.GAM + (size_t)u * 64 + hi * 32;
#define RW_LORA(cb) f32x16 accd = f32x16{}, acca = f32x16{}; _Pragma("unroll") for (int s = 0; s < 4; ++s) { \
        const v4u aD = *(const GAS v4u*)(F.WdT + tok + (size_t)(w * 64 + (cb) * 32 + l31) * 64 + 16 * s + 8 * hi); accd = MFMA32(aD, bz[s], accd); \
        const v4u aA = *(const GAS v4u*)(F.WaT + tok + (size_t)(w * 64 + (cb) * 32 + l31) * 64 + 16 * s + 8 * hi); acca = MFMA32(aA, ba[s], acca); }
    struct RwGL { v2u rc, rp, kc, kp, vc, vp; } gA, gB;
#define RW_LOADG(X, CB, RG) do { X.rc = *(const LAS v2u*)(rcur + tok + 16 * (RG)); X.rp = *(const LAS v2u*)(rprv + tok + 16 * (RG)); X.kc = *(const LAS v2u*)(kcur + tok + 64 * (CB) + 16 * (RG)); X.kp = *(const LAS v2u*)(kprv + tok + 64 * (CB) + 16 * (RG)); \
        X.vc = *(const LAS v2u*)(vcur + tok + 16 * (RG)); X.vp = *(const LAS v2u*)(vprv + tok + 16 * (RG)); } while (0)
#define RW_LERP(dst, c_, p_, m_) do { dst[0] = bflo(c_.x) + (bflo(p_.x) * pm - bflo(c_.x)) * m_.x; dst[1] = bfhi(c_.x) + (bfhi(p_.x) * pm - bfhi(c_.x)) * m_.y; \
        dst[2] = bflo(c_.y) + (bflo(p_.y) * pm - bflo(c_.y)) * m_.z; dst[3] = bfhi(c_.y) + (bfhi(p_.y) * pm - bfhi(c_.y)) * m_.w; } while (0)
#define RW_GROUP(cb, rg, CUR, NXT, HASN) do { constexpr int OFF = 32 * (cb) + 8 * (rg); const int ch0 = OFF + 4 * hi; \
            if (HASN) RW_LOADG(NXT, cb, (rg) + 1); \
            float rr[4], kk4[4], vv[4]; \
            const f32x4 mr_ = *(const GAS f32x4*)(mu + tok + OFF), mk_ = *(const GAS f32x4*)(mu + tok + 512 + OFF), mv_ = *(const GAS f32x4*)(mu + tok + 1024 + OFF); \
            const f32x4 w0v = *(const GAS f32x4*)(pw0 + tok + OFF), a0v = *(const GAS f32x4*)(pa0 + tok + OFF), kkp = *(const GAS f32x4*)(pkk + tok + OFF), kap = *(const GAS f32x4*)(pka + tok + OFF), rkp = *(const GAS f32x4*)(prk + tok + OFF); \
            RW_LERP(rr, CUR.rc, CUR.rp, mr_); RW_LERP(kk4, CUR.kc, CUR.kp, mk_); RW_LERP(vv, CUR.vc, CUR.vp, mv_); \
            float xa[4], xb[4], xk[4], xr[4], gg[4], ge[4]; \
            _Pragma("unroll") for (int e = 0; e < 4; ++e) { \
                  \
                const float l2 = (-0.6065306597126334f * LOG2E) * __builtin_amdgcn_rcpf(1.f + __expf(-(w0v[e] + accd[4 * (rg) + e]))); \
                const float g = scan32(l2); \
                const float a = __builtin_amdgcn_rcpf(1.f + __expf(-(a0v[e] + acca[4 * (rg) + e]))); \
                const float kk = kk4[e] * kkp[e] * inv; \
                const float kt = kk4[e] * (1.f + (a - 1.f) * kap[e]); \
                rho += rr[e] * kt * rkp[e]; \
                const float eg = __builtin_amdgcn_exp2f(g), egp = __builtin_amdgcn_exp2f(g - l2), eng = __builtin_amdgcn_rcpf(eg); \
                xa[e] = -kk * egp; xb[e] = kk * a * eng; xk[e] = kt * eng; xr[e] = rr[e] * eg; gg[e] = g; ge[e] = eg; } \
            if (l31 == 31) { *(LAS f32x4*)(wscr + ch0) = (f32x4){gg[0], gg[1], gg[2], gg[3]}; st_wt16((v4u*)(gp + (cb) * 16 + 4 * (rg)), (v4u){__float_as_uint(ge[0]), __float_as_uint(ge[1]), __float_as_uint(ge[2]), __float_as_uint(ge[3])}); } \
            constexpr int s_ = 2 * (cb) + ((rg) >> 1), vg = 2 * ((rg) & 1); \
            fa[s_][vg] = cvtpk(xa[0], xa[1]); fa[s_][vg + 1] = cvtpk(xa[2], xa[3]); \
            fb[s_][vg] = cvtpk(xb[0], xb[1]); fb[s_][vg + 1] = cvtpk(xb[2], xb[3]); \
            fk[s_][vg] = cvtpk(xk[0], xk[1]); fk[s_][vg + 1] = cvtpk(xk[2], xk[3]); \
            fr[s_][vg] = cvtpk(xr[0], xr[1]); fr[s_][vg + 1] = cvtpk(xr[2], xr[3]); \
            fv[s_][vg] = cvtpk(vv[0], vv[1]); fv[s_][vg + 1] = cvtpk(vv[2], vv[3]); \
            if (((rg) & 1) == 1) { PARK(s_) = fv[s_]; PARK(4 + s_) = fr[s_]; } \
            DEP(fa[s_][vg + 1]); DEP(fb[s_][vg + 1]); DEP(fk[s_][vg + 1]); DEP(fr[s_][vg + 1]); DEP(fv[s_][vg + 1]); DEP(rho); } while (0)
    RW_LOADG(gA, 0, 0);
    { RW_LORA(0) RW_GROUP(0, 0, gA, gB, true); RW_GROUP(0, 1, gB, gA, true); RW_GROUP(0, 2, gA, gB, true); RW_GROUP(0, 3, gB, gA, false); }
    LDS_WAIT(); RW_STAGE_RV(1);
    { RW_LORA(1) asm volatile("s_waitcnt vmcnt(0)" ::: "memory"); RW_LOADG(gA, 1, 0);
      RW_GROUP(1, 0, gA, gB, true); RW_GROUP(1, 1, gB, gA, true); RW_GROUP(1, 2, gA, gB, true); RW_GROUP(1, 3, gB, gA, false); }
#undef RW_STAGE_RV
#undef RW_DMA
#undef RW_LOADG
#undef RW_LERP
#undef RW_LORA
#undef RW_GROUP
    LDS_WAIT(); asm volatile("" ::: "memory");
    float EC[2]; EC[0] = __builtin_amdgcn_exp2f(wscr[l31]); EC[1] = __builtin_amdgcn_exp2f(wscr[32 + l31]);
    LDS_WAIT(); asm volatile("" ::: "memory");
    rho = swap32_sum(rho);
    if (hi == 0) __hip_atomic_store((gu32*)(Dm.RHO + (size_t)u * 32 + l31), __float_as_uint(rho), RLX_AGENT);
    v4u idf[2];
    { const int jst = 4 * ((l31 >> 3) & 1) + (l31 & 3); const bool hm = ((l31 >> 2) & 1) == hi; const unsigned one = 0x3F80u << (16 * (jst & 1));
#pragma unroll
      for (int sig = 0; sig < 2; ++sig) { const bool on = hm && ((l31 >> 4) == sig);
#pragma unroll
          for (int q = 0; q < 4; ++q) idf[sig][q] = (on && (jst >> 1) == q) ? one : 0u; } }
    LDS_WAIT();
    v4u Af[2][2], Vf[2][2];
#pragma unroll
    for (int blk = 0; blk < 2; ++blk) {
        f32x16 za = MFMA32(fa[2 * blk], idf[0], f32x16{}); za = MFMA32(fa[2 * blk + 1], idf[1], za);
        f32x16 zv = MFMA32(PARK(2 * blk), idf[0], f32x16{}); zv = MFMA32(PARK(2 * blk + 1), idf[1], zv);
        f32x16 zb = MFMA32(fb[2 * blk], idf[0], f32x16{}); zb = MFMA32(fb[2 * blk + 1], idf[1], zb);
        f32x16 zk = MFMA32(fk[2 * blk], idf[0], f32x16{}); zk = MFMA32(fk[2 * blk + 1], idf[1], zk);
        zb = zb * EC[blk]; zk = zk * EC[blk];
#pragma unroll
        for (int s = 0; s < 2; ++s) { Af[blk][s] = FRAGACC(za, s); Vf[blk][s] = FRAGACC(zv, s); PARK(8 + 2 * blk + s) = FRAGACC(zb, s); PARK(12 + 2 * blk + s) = FRAGACC(zk, s); }
        __builtin_amdgcn_sched_barrier(0);
    }
    f32x16 Aab = f32x16{}, TT = f32x16{}, AakT = f32x16{}, ArbT = f32x16{}, ArkT = f32x16{};
#pragma unroll
    for (int s = 0; s < 4; ++s) { const v4u frs = PARK(4 + s); Aab = MFMA32(fa[s], fb[s], Aab); TT = MFMA32(fb[s], fa[s], TT); AakT = MFMA32(fk[s], fa[s], AakT); ArbT = MFMA32(fb[s], frs, ArbT); ArkT = MFMA32(fk[s], frs, ArkT); }
#pragma unroll
    for (int r = 0; r < 16; ++r) { const int rowi = (r & 3) + 8 * (r >> 2) + 4 * hi;
        Aab[r] = (l31 < rowi) ? Aab[r] : 0.f; TT[r] = (rowi < l31) ? TT[r] : 0.f; AakT[r] = (rowi < l31) ? AakT[r] : 0.f;
        ArbT[r] = (rowi <= l31) ? ArbT[r] : 0.f; ArkT[r] = (rowi <= l31) ? ArkT[r] : 0.f; }
    v4u AakTf[2], ArbTf[2], ArkTf[2];
#pragma unroll
    for (int s = 0; s < 2; ++s) { AakTf[s] = FRAGACC(AakT, s); ArbTf[s] = FRAGACC(ArbT, s); ArkTf[s] = FRAGACC(ArkT, s); }
    __builtin_amdgcn_sched_barrier(0);
    v4u Xf[2], XTf[2], TTf[2];
#pragma unroll
    for (int s = 0; s < 2; ++s) { Xf[s] = FRAGACC(Aab, s); XTf[s] = FRAGACC(TT, s); }
#pragma unroll
    for (int r = 0; r < 16; ++r) { const int rowi = (r & 3) + 8 * (r >> 2) + 4 * hi; TT[r] += (rowi == l31) ? 1.f : 0.f; }
#pragma unroll
    for (int it = 0; it < 4; ++it) {
        f32x16 X2 = MFMA32(XTf[0], Xf[0], f32x16{}); X2 = MFMA32(XTf[1], Xf[1], X2);
        if (it < 3) { f32x16 X2T = MFMA32(Xf[0], XTf[0], f32x16{}); X2T = MFMA32(Xf[1], XTf[1], X2T);
#pragma unroll
            for (int s = 0; s < 2; ++s) XTf[s] = FRAGACC(X2T, s); }
#pragma unroll
        for (int s = 0; s < 2; ++s) { Xf[s] = FRAGACC(X2, s); TTf[s] = FRAGACC(TT, s); }
        TT = MFMA32(Xf[0], TTf[0], TT); TT = MFMA32(Xf[1], TTf[1], TT);
        __builtin_amdgcn_sched_barrier(0);
    }
#pragma unroll
    for (int s = 0; s < 2; ++s) TTf[s] = FRAGACC(TT, s);
    v4u Wf[2][2], Uf[2][2];
#pragma unroll
    for (int blk = 0; blk < 2; ++blk) {
        f32x16 av = MFMA32(AakTf[0], Vf[blk][0], f32x16{}); av = MFMA32(AakTf[1], Vf[blk][1], av);
        const v4u avf0 = FRAGACC(av, 0), avf1 = FRAGACC(av, 1);
        f32x16 uu = MFMA32(TTf[0], avf0, f32x16{}); uu = MFMA32(TTf[1], avf1, uu);
        f32x16 ww = MFMA32(TTf[0], Af[blk][0], f32x16{}); ww = MFMA32(TTf[1], Af[blk][1], ww);
#pragma unroll
        for (int s = 0; s < 2; ++s) { Wf[blk][s] = FRAGACC(ww, s); Uf[blk][s] = FRAGACC(uu, s); }
        __builtin_amdgcn_sched_barrier(0);
    }
    v4u* QFp = Dm.QF + (size_t)u * 256 + lane; v4u* YDp = Dm.YD + (size_t)u * 256 + lane;
#pragma unroll
    for (int blk = 0; blk < 2; ++blk) {
        f32x16 q;
#pragma unroll
        for (int s = 0; s < 2; ++s)
            { const v4u frs = PARK(4 + 2 * blk + s);
#pragma unroll
              for (int j = 0; j < 4; ++j) { q[8 * s + 2 * j] = bflo(frs[j]); q[8 * s + 2 * j + 1] = bfhi(frs[j]); } }
        q = MFMA32(Wf[blk][0], ArbTf[0], q); q = MFMA32(Wf[blk][1], ArbTf[1], q);
        st_wt16(QFp + (2 * blk) * 64, FRAGACC(q, 0)); st_wt16(QFp + (2 * blk + 1) * 64, FRAGACC(q, 1));
        f32x16 y = MFMA32(Uf[blk][0], ArbTf[0], f32x16{}); y = MFMA32(Uf[blk][1], ArbTf[1], y); y = MFMA32(Vf[blk][0], ArkTf[0], y); y = MFMA32(Vf[blk][1], ArkTf[1], y);
        st_wt16(YDp + (2 * blk) * 64, FRAGACC(y, 0)); st_wt16(YDp + (2 * blk + 1) * 64, FRAGACC(y, 1));
        __builtin_amdgcn_sched_barrier(0);
    }
    v4u* PFp = Dm.PF + (size_t)u * 512 + lane; v4u* DDp = Dm.DD + (size_t)u * 512 + lane;
#pragma unroll
    for (int c1 = 0; c1 < 2; ++c1)
#pragma unroll
        for (int cb = 0; cb < 2; ++cb) {
            f32x16 p = MFMA32(Wf[c1][0], PARK(8 + 2 * cb), f32x16{}); p = MFMA32(Wf[c1][1], PARK(8 + 2 * cb + 1), p);
            st_wt16(PFp + (cb * 4 + 2 * c1) * 64, FRAGACC(p, 0)); st_wt16(PFp + (cb * 4 + 2 * c1 + 1) * 64, FRAGACC(p, 1));
            __builtin_amdgcn_sched_barrier(0);
        }
#pragma unroll
    for (int cb = 0; cb < 2; ++cb)
#pragma unroll
        for (int ib = 0; ib < 2; ++ib) {
            f32x16 d = MFMA32(PARK(8 + 2 * cb), Uf[ib][0], f32x16{}); d = MFMA32(PARK(8 + 2 * cb + 1), Uf[ib][1], d); d = MFMA32(PARK(12 + 2 * cb), Vf[ib][0], d); d = MFMA32(PARK(12 + 2 * cb + 1), Vf[ib][1], d);
            st_wt16(DDp + ((cb * 2 + ib) * 2) * 64, FRAGACC(d, 0)); st_wt16(DDp + ((cb * 2 + ib) * 2 + 1) * 64, FRAGACC(d, 1));
            __builtin_amdgcn_sched_barrier(0);
        }
}

#undef PARK
#undef DEP
constexpr int RB_PF = 0, RB_DD = 8192, RB_QF = 16384, RB_YD = 20480, RB_GAM = 24576, RB_BUF = 24832, RB_NB = 4, RB_STAT = RB_NB * RB_BUF, RB_Y = RB_STAT + 1024;
__device__ __forceinline__ void unpack16(const v4u a, const v4u b, f32x16& o) {
#pragma unroll
    for (int j = 0; j < 4; ++j) { o[2 * j] = bflo(a[j]); o[2 * j + 1] = bfhi(a[j]); o[8 + 2 * j] = bflo(b[j]); o[8 + 2 * j + 1] = bfhi(b[j]); }
}
constexpr int RW_SPLIT = T / 32, CW_DONE = 16384;
__device__ __forceinline__ void rw_wait_chunk(Frame& F, int ci) {
    unsigned spins = 0;
#pragma unroll 1
    for (int j = 7; j >= 0; --j) { gu32* c = F.ctl + CW_DONE + 64 * (ci + j);
        while ((unsigned)__builtin_amdgcn_readfirstlane(__hip_atomic_load(c, RLX_AGENT)) < (unsigned)BATCH) { __builtin_amdgcn_s_sleep(8); if (++spins > (1u << 22)) break; } }
    __builtin_amdgcn_fence(__ATOMIC_ACQUIRE, "agent");
}
__device__ __forceinline__ void rw_publish_chunk(Frame& F, int ci) {
    asm volatile("s_waitcnt vmcnt(0)" ::: "memory");
    __syncthreads();
    if (F.wave == 0 && mk_lane() == 0) {
        __hip_atomic_fetch_add(F.ctl + CW_DONE + 64 * ci, 1u, RLX_AGENT);
    }
}
#ifndef RB_AUX
#define RB_AUX 2
#endif
struct RbStage { v4u p[2], d[2], q, y, g; };
struct RbEpi { v4u vc, vp, ga; float rho; };
__device__ __forceinline__ void rwkvB_unit(Frame& F, const RwDump& Dm, int bh) {
    int lane = mk_lane(); asm volatile("" : "+v"(lane));
    const int wid = F.wave, tid = wid * 64 + lane, hi = lane >> 5, l31 = lane & 31, b = bh >> 3, h = bh & 7;
    LAS unsigned char* lds = F.lds + RING_OFF;
    constexpr int NS = T / 32;
    LAS float* stat = (LAS float*)(lds + RB_STAT);
    LAS float* ybuf = (LAS float*)(lds + RB_Y);
    const int stid = tid - 128;
    const bool st_p2 = wid < 4, st_q = wid < 6, st_y = wid >= 4;
#define ST_LOAD(X, ci_) do { { if ((ci_) >= RW_SPLIT && (ci_) < NS && (((ci_) - RW_SPLIT) & 7) == 0) rw_wait_chunk(F, (ci_)); const size_t u_ = (size_t)((ci_) < NS ? (ci_) : NS - 1) * (BATCH * RH) + bh; \
        X.p[0] = __builtin_nontemporal_load((const GAS v4u*)(Dm.PF + u_ * 512 + stid)); X.d[0] = __builtin_nontemporal_load((const GAS v4u*)(Dm.DD + u_ * 512 + stid)); \
        if (st_p2) { X.p[1] = __builtin_nontemporal_load((const GAS v4u*)(Dm.PF + u_ * 512 + 384 + stid)); X.d[1] = __builtin_nontemporal_load((const GAS v4u*)(Dm.DD + u_ * 512 + 384 + stid)); } \
        if (st_q) X.q = __builtin_nontemporal_load((const GAS v4u*)(Dm.QF + u_ * 256 + stid)); \
        if (st_y) X.y = __builtin_nontemporal_load((const GAS v4u*)(Dm.YD + u_ * 256 + (stid - 128))); \
        if (stid < 16) X.g = *(const GAS v4u*)((const v4u*)(Dm.GAM + u_ * 64) + stid); } } while (0)
#define ST_STORE(X, buf_) do { LAS unsigned char* b_ = lds + (buf_) * RB_BUF; \
        *(LAS v4u*)(b_ + RB_PF + stid * 16) = X.p[0]; *(LAS v4u*)(b_ + RB_DD + stid * 16) = X.d[0]; \
        if (st_p2) { *(LAS v4u*)(b_ + RB_PF + (384 + stid) * 16) = X.p[1]; *(LAS v4u*)(b_ + RB_DD + (384 + stid) * 16) = X.d[1]; } \
        if (st_q) *(LAS v4u*)(b_ + RB_QF + stid * 16) = X.q; \
        if (st_y) *(LAS v4u*)(b_ + RB_YD + (stid - 128) * 16) = X.y; \
        if (stid < 16) *(LAS v4u*)(b_ + RB_GAM + stid * 16) = X.g; } while (0)
    const int ew = (wid & 1) + 2 * ((wid >> 2) & 1), eidx = ew * 64 + lane, etok = eidx >> 3, ep = eidx & 7;
    const bf16* epc = F.PROJ + (size_t)b * T * NP + h * 64 + 8 * ep;
#define EP_LOAD(X, cj_) do { { const int cc_ = (cj_) < NS ? (cj_) : NS - 1, tt_ = cc_ * 32 + etok; const bf16* pc_ = epc + (size_t)tt_ * NP; const bf16* pp_ = epc + (size_t)(tt_ > 0 ? tt_ - 1 : 0) * NP; \
        X.vc = *(const GAS v4u*)(pc_ + C_V); X.vp = *(const GAS v4u*)(pp_ + C_V); X.ga = *(const GAS v4u*)(pc_ + C_GA); \
        X.rho = Dm.RHO[((size_t)cc_ * (BATCH * RH) + bh) * 32 + etok]; } } while (0)
#define EP_RUN(X, cj_) do { const int par_ = (cj_) & 1; \
        const float s1_ = stat[((par_ * 2 + 0) * 32 + etok) * 2] + stat[((par_ * 2 + 1) * 32 + etok) * 2], s2_ = stat[((par_ * 2 + 0) * 32 + etok) * 2 + 1] + stat[((par_ * 2 + 1) * 32 + etok) * 2 + 1]; \
        const float mean_ = s1_ * (1.f / 64.f), var_ = fmaxf(s2_ * (1.f / 64.f) - mean_ * mean_, 0.f), rstd_ = __builtin_amdgcn_rsqf(var_ + 64e-5f); \
        const int tt_ = (cj_) * 32 + etok; const size_t mm_ = (size_t)b * T + tt_; const float pm_ = tt_ > 0 ? 1.f : 0.f; \
        const LAS float* yb_ = ybuf + (par_ * 2 + (ep >> 2)) * 1024 + 4 * (ep & 3) * 64 + etok; \
        float o_[8]; \
        _Pragma("unroll") for (int j = 0; j < 8; ++j) { const unsigned vcw_ = X.vc[j >> 1], vpw_ = X.vp[j >> 1], gaw_ = X.ga[j >> 1]; \
            const float vc_ = (j & 1) ? bfhi(vcw_) : bflo(vcw_), vp_ = (j & 1) ? bfhi(vpw_) : bflo(vpw_), g_ = (j & 1) ? bfhi(gaw_) : bflo(gaw_); \
            const float vv_ = vc_ + (vp_ * pm_ - vc_) * emu[j >> 2][j & 3]; \
            const float yn_ = (yb_[(j & 3) * 64 + (j >> 2) * 32] - mean_) * rstd_ * elw[j >> 2][j & 3] + elb[j >> 2][j & 3] + X.rho * vv_; o_[j] = yn_ * g_ * __builtin_amdgcn_rcpf(1.f + __expf(-g_)); } \
        *(GAS v4u*)(F.MIX + mm_ * D + h * 64 + 8 * ep) = (v4u){cvtpk(o_[0], o_[1]), cvtpk(o_[2], o_[3]), cvtpk(o_[4], o_[5]), cvtpk(o_[6], o_[7])}; } while (0)
    f32x16 S[2]; S[0] = f32x16{}; S[1] = f32x16{};
    const int ib = wid & 1;
#define CONS(ci_) do { const LAS unsigned char* bb = lds + ((ci_) & (RB_NB - 1)) * RB_BUF; \
          \
        v4u pf_[8], qf_[4], dd_[4], yd_[2]; f32x4 gm_[8]; \
        _Pragma("unroll") for (int q = 0; q < 8; ++q) gm_[q] = *(const LAS f32x4*)(bb + RB_GAM + (hi * 32 + 4 * q) * 4); \
        _Pragma("unroll") for (int q = 0; q < 4; ++q) dd_[q] = *(const LAS v4u*)(bb + RB_DD + ((((q >> 1) * 2 + ib) * 2 + (q & 1)) * 64 + lane) * 16); \
        _Pragma("unroll") for (int q = 0; q < 8; ++q) pf_[q] = *(const LAS v4u*)(bb + RB_PF + (q * 64 + lane) * 16); \
        _Pragma("unroll") for (int q = 0; q < 2; ++q) yd_[q] = *(const LAS v4u*)(bb + RB_YD + ((2 * ib + q) * 64 + lane) * 16); \
        _Pragma("unroll") for (int q = 0; q < 4; ++q) qf_[q] = *(const LAS v4u*)(bb + RB_QF + (q * 64 + lane) * 16); \
        __builtin_amdgcn_sched_barrier(0); \
        v4u Sf[4]; _Pragma("unroll") for (int s = 0; s < 4; ++s) Sf[s] = FRAGACC(S[s >> 1], s & 1); \
        _Pragma("unroll") for (int rb = 0; rb < 2; ++rb) { \
            f32x16 acc; unpack16(dd_[2 * rb], dd_[2 * rb + 1], acc); \
            _Pragma("unroll") for (int q = 0; q < 4; ++q) { const f32x4 gv = gm_[4 * rb + q]; _Pragma("unroll") for (int e = 0; e < 4; ++e) acc[4 * q + e] += gv[e] * S[rb][4 * q + e]; } \
            _Pragma("unroll") for (int s = 0; s < 4; ++s) acc = MFMA32(pf_[rb * 4 + s], Sf[s], acc); \
            S[rb] = acc; } \
        f32x16 y; unpack16(yd_[0], yd_[1], y); \
        _Pragma("unroll") for (int s = 0; s < 4; ++s) y = MFMA32(Sf[s], qf_[s], y); \
        float s1 = 0.f, s2 = 0.f; LAS float* yb_ = ybuf + (((ci_) & 1) * 2 + ib) * 1024 + lane; \
        _Pragma("unroll") for (int r = 0; r < 16; ++r) { s1 += y[r]; s2 += y[r] * y[r]; yb_[r * 64] = y[r]; } \
        s1 = swap32_sum(s1); s2 = swap32_sum(s2); \
        if (hi == 0) { stat[((((ci_) & 1) * 2 + ib) * 32 + l31) * 2] = s1; stat[((((ci_) & 1) * 2 + ib) * 32 + l31) * 2 + 1] = s2; } } while (0)
#define RB_BAR() do { asm volatile("s_waitcnt lgkmcnt(0)" ::: "memory"); __builtin_amdgcn_s_barrier(); asm volatile("" ::: "memory"); } while (0)
    if (wid < 2) {
        RB_BAR();
#pragma unroll 1
        for (int k = 0; k < NS; ++k) { CONS(k); RB_BAR(); }
        RB_BAR();
    } else if (wid == 4 || wid == 5) {
        const GAS v4u* gA = (const GAS v4u*)(wid == 4 ? Dm.PF : Dm.DD) + lane; const GAS v4u* gB = (const GAS v4u*)(wid == 4 ? Dm.QF : Dm.YD) + lane;
        const int oA = wid == 4 ? RB_PF : RB_DD, oB = wid == 4 ? RB_QF : RB_YD;
#define LD_ISSUE(ci_) do { const size_t u_ = (size_t)((ci_) < NS ? (ci_) : NS - 1) * (BATCH * RH) + bh; LAS unsigned char* b_ = lds + ((ci_) & (RB_NB - 1)) * RB_BUF; \
        _Pragma("unroll") for (int q = 0; q < 8; ++q) __builtin_amdgcn_global_load_lds((const unsigned*)(gA + u_ * 512 + q * 64), (LAS unsigned*)(b_ + oA + q * 1024), 16, 0, RB_AUX); \
        _Pragma("unroll") for (int q = 0; q < 4; ++q) __builtin_amdgcn_global_load_lds((const unsigned*)(gB + u_ * 256 + q * 64), (LAS unsigned*)(b_ + oB + q * 1024), 16, 0, RB_AUX); \
        if (lane < 16) __builtin_amdgcn_global_load_lds((const unsigned*)((const GAS v4u*)(Dm.GAM + u_ * 64) + lane), (LAS unsigned*)(b_ + RB_GAM), 16, 0, 0); } while (0)
        LD_ISSUE(0); LD_ISSUE(1); LD_ISSUE(2);
        asm volatile("s_waitcnt vmcnt(26)" ::: "memory");
        RB_BAR();
#pragma unroll 1
        for (int k = 0; k < NS; ++k) { LD_ISSUE(k + 3); asm volatile("s_waitcnt vmcnt(26)" ::: "memory"); RB_BAR(); }
        asm volatile("s_waitcnt vmcnt(0)" ::: "memory");
        RB_BAR();
#undef LD_ISSUE
    } else {
        RbEpi eA, eB, eC; f32x4 emu[2], elw[2], elb[2];
#pragma unroll
        for (int rg = 0; rg < 2; ++rg) { const int hc_ = h * 64 + 8 * ep + 4 * rg; emu[rg] = *(const GAS f32x4*)(F.shift_mu + 1024 + hc_); elw[rg] = *(const GAS f32x4*)(F.ln_w + hc_); elb[rg] = *(const GAS f32x4*)(F.ln_b + hc_); }
        EP_LOAD(eA, 0); EP_LOAD(eB, 1);
        RB_BAR();
        EP_LOAD(eC, 2); RB_BAR();
#define HY_STEP(k_, EP) do { EP_RUN(EP, (k_) - 1); EP_LOAD(EP, (k_) + 2); RB_BAR(); } while (0)
#pragma unroll 1
        for (int k = 1; k < NS; k += 3) { HY_STEP(k, eA); HY_STEP(k + 1, eB); HY_STEP(k + 2, eC); }
        EP_RUN(eA, NS - 1);
        RB_BAR();
#undef HY_STEP
    }
#undef RB_BAR
#undef ST_LOAD
#undef ST_STORE
#undef EP_LOAD
#undef EP_RUN
#undef CONS
}
constexpr int CW_G17 = 12288;
struct OneUnit { int pm, pn;
    __device__ __forceinline__ bool next(int i, pg8::Unit& u) const { if (i != 0) return false; u.pm = pm; u.pn = pn; return true; }
    __device__ __forceinline__ void a_ready(const pg8::Unit&) const {}
    __device__ __forceinline__ void done(const pg8::Unit&) const {} };
constexpr int AT_OUT = 65536, AT_G0 = 114688, AT_G1 = LDSCTL_OFF + 1024;
constexpr int AT_KB = 64 * 256, AT_VB = 64 * 256, AT_BUF = AT_KB + AT_VB, AT_QOFF = 2 * AT_KB + 3 * AT_VB;
__device__ __forceinline__ s16x4 vtr(const LAS unsigned char* p) { typedef short v4i16_t __attribute__((ext_vector_type(4))); return __builtin_bit_cast(s16x4, __builtin_amdgcn_ds_read_tr16_b64_v4i16((LAS v4i16_t*)p)); }
__device__ __forceinline__ void attn_unit(Frame& F, int b, int h, int qb) {
    int lane = mk_lane(); asm volatile("" : "+v"(lane));
    const int wid = F.wave, tid = wid * 64 + lane, l31 = lane & 31, hi = lane >> 5, map = wid >> 2, qs = wid & 3;
    LAS unsigned char* lds = F.lds + RING_OFF;
    const float slope2 = exp2f(-2.f * (float)(h + 1)) * LOG2E, shift2 = __uint_as_float(F.MISC[15]);
    const int q0 = qb * 128, qrow = q0 + 32 * qs + l31;
    const size_t mrow = (size_t)b * T + qrow;
    LAS bf16x8* qpark = (LAS bf16x8*)(lds + AT_QOFF + wid * 4096) + lane;
    { const bf16* qp = F.PROJ + mrow * NP + C_DQ + h * 128 + map * 64 + 8 * hi;
      v4u qraw[4]; float ss = 0.f;
#pragma unroll
      for (int s = 0; s < 4; ++s) qraw[s] = *(const GAS v4u*)(qp + 16 * s);
#pragma unroll
      for (int s = 0; s < 4; ++s)
#pragma unroll
          for (int j = 0; j < 4; ++j) { const float a_ = bflo(qraw[s][j]), b_ = bfhi(qraw[s][j]); ss += a_ * a_ + b_ * b_; }
      ss = swap32_sum(ss);
      const float rq = __builtin_amdgcn_rsqf(ss * (1.f / 64.f) + 1e-6f) * C2;
#pragma unroll
      for (int s = 0; s < 4; ++s) { const f32x4 g0 = *(const GAS f32x4*)(F.qn_g + 8 * hi + 16 * s), g1 = *(const GAS f32x4*)(F.qn_g + 8 * hi + 16 * s + 4);
          v4u w_; w_.x = cvtpk2(bflo(qraw[s].x) * rq * g0.x, bfhi(qraw[s].x) * rq * g0.y); w_.y = cvtpk2(bflo(qraw[s].y) * rq * g0.z, bfhi(qraw[s].y) * rq * g0.w);
          w_.z = cvtpk2(bflo(qraw[s].z) * rq * g1.x, bfhi(qraw[s].z) * rq * g1.y); w_.w = cvtpk2(bflo(qraw[s].w) * rq * g1.z, bfhi(qraw[s].w) * rq * g1.w);
          *(LAS v4u*)(qpark + s * 64) = w_; } }
    const bf16* kg = F.PROJ + (size_t)b * T * NP + C_DK + h * 128;
    const bf16* vg = F.PROJ + (size_t)b * T * NP + C_DV + h * 128;
    const int NT = 2 * qb + 2, tl = 2 * qb + (qs >> 1);
    const int Wk = (int)__builtin_ceilf((2.f * shift2 + 32.2f) / slope2);
    const int tf = __builtin_amdgcn_readfirstlane(max(0, (qb * 128 - Wk) >> 6));
    constexpr int AT_V0 = 2 * AT_KB;
    const int drow0 = 4 * wid + (lane >> 4), drow1 = drow0 + 32, dch = lane & 15;
    const unsigned ksrc0 = (unsigned)(drow0 * NP + ((dch ^ (drow0 & 15)) * 8)), ksrc1 = (unsigned)(drow1 * NP + ((dch ^ (drow1 & 15)) * 8));
    const unsigned vsrc0 = (unsigned)(drow0 * NP + ((dch ^ ((drow0 & 3) << 2)) * 8)), vsrc1 = (unsigned)(drow1 * NP + ((dch ^ ((drow1 & 3) << 2)) * 8));
#define AT_DMA(t_, kb_, v3_) do { const size_t tb_ = (size_t)(64 * (t_)) * NP; LAS unsigned char* bk_ = lds + (kb_) * AT_KB + wid * 1024; LAS unsigned char* bv_ = lds + AT_V0 + (v3_) * AT_VB + wid * 1024; \
        __builtin_amdgcn_global_load_lds((const unsigned*)(kg + tb_ + ksrc0), (LAS unsigned*)bk_, 16, 0, 0); __builtin_amdgcn_global_load_lds((const unsigned*)(kg + tb_ + ksrc1), (LAS unsigned*)(bk_ + 8192), 16, 0, 0); \
        __builtin_amdgcn_global_load_lds((const unsigned*)(vg + tb_ + vsrc0), (LAS unsigned*)bv_, 16, 0, 0); __builtin_amdgcn_global_load_lds((const unsigned*)(vg + tb_ + vsrc1), (LAS unsigned*)(bv_ + 8192), 16, 0, 0); } while (0)
    f32x16 o[4];
#pragma unroll
    for (int vb = 0; vb < 4; ++vb) o[vb] = f32x16{};
    float lsum = 0.f;
    AT_DMA(tf, tf & 1, tf % 3);
    { const int gr_ = 16 * wid + (lane >> 4); const bf16* gsrc = F.PROJ + ((size_t)b * T + q0 + gr_) * NP + C_GB + h * 128;
      LAS unsigned char* gdst = F.lds + (wid < 4 ? AT_G0 + wid * 4096 : AT_G1 + (wid - 4) * 4096);
#pragma unroll
      for (int j = 0; j < 4; ++j) __builtin_amdgcn_global_load_lds((const unsigned*)(gsrc + (size_t)(4 * j) * NP + (((lane & 15) ^ (4 * j + (lane >> 4))) * 8)), (LAS unsigned*)(gdst + j * 1024), 16, 0, 0); }
    __syncthreads();
    const int G = lane >> 4, qq = (lane & 15) >> 2, pp = lane & 3;
    const int vrow = (4 * hi + qq) * 256 + 8 * (pp & 1), vch = 2 * (G & 1) + (pp >> 1);
    v4u pw[4];
#define SBAR_() __builtin_amdgcn_sched_barrier(0)
#define AT_QK(t) do { \
            const LAS unsigned char* Kb = lds + ((t) & 1) * AT_KB; \
            float sl_ = slope2; asm volatile("" : "+v"(sl_));     \
            const float base = sl_ * (float)(64 * (t) + 4 * hi - qrow) - shift2; \
            float ls = 0.f; \
            _Pragma("unroll") for (int hf = 0; hf < 2; ++hf) {        \
                f32x16 p; \
                _Pragma("unroll") for (int r = 0; r < 16; ++r) p[r] = __builtin_fmaf(sl_, (float)(32 * hf + (r & 3) + 8 * (r >> 2)), base); \
                _Pragma("unroll") for (int s = 0; s < 4; ++s) { \
                    const bf16x8 a0 = *(const LAS bf16x8*)(Kb + (32 * hf + l31) * 256 + (((map * 8 + 2 * s + hi) ^ (l31 & 15)) * 16)); \
                    p = __builtin_amdgcn_mfma_f32_32x32x16_bf16(a0, qpark[s * 64], p, 0, 0, 0); } \
                if ((t) == tl) { \
                    _Pragma("unroll") for (int r = 0; r < 16; ++r) { const int ki = 64 * (t) + 32 * hf + 4 * hi + (r & 3) + 8 * (r >> 2); if (ki > qrow) p[r] = -1e30f; } } \
                _Pragma("unroll") for (int r = 0; r < 16; ++r) { p[r] = __builtin_amdgcn_exp2f(p[r]); ls += p[r]; } \
                pw[2 * hf] = (v4u){cvtpk(p[0], p[1]), cvtpk(p[2], p[3]), cvtpk(p[4], p[5]), cvtpk(p[6], p[7])}; \
                pw[2 * hf + 1] = (v4u){cvtpk(p[8], p[9]), cvtpk(p[10], p[11]), cvtpk(p[12], p[13]), cvtpk(p[14], p[15])}; } \
            lsum += ls; } while (0)
#define AT_VRD(dst, ks, vb0) do { _Pragma("unroll") for (int vb = (vb0); vb < (vb0) + 2; ++vb) { const LAS unsigned char* a_ = Vb + vrow + ((4 * vb + vch) ^ (qq << 2)) * 16 + (32 * ((ks) >> 1) + 16 * ((ks) & 1)) * 256; \
        dst[2 * (vb - (vb0))] = vtr(a_); dst[2 * (vb - (vb0)) + 1] = vtr(a_ + 8 * 256); } } while (0)
#define AT_PV(src, pwk, vb0) do { _Pragma("unroll") for (int vb = (vb0); vb < (vb0) + 2; ++vb) { const int j_ = 2 * (vb - (vb0)); \
        const bf16x8 vf = (bf16x8){src[j_][0], src[j_][1], src[j_][2], src[j_][3], src[j_ + 1][0], src[j_ + 1][1], src[j_ + 1][2], src[j_ + 1][3]}; \
        o[vb] = __builtin_amdgcn_mfma_f32_32x32x16_bf16(vf, __builtin_bit_cast(bf16x8, pwk), o[vb], 0, 0, 0); } } while (0)
#define AT_PVV(v3_) do { const LAS unsigned char* Vb = lds + AT_V0 + (v3_) * AT_VB; s16x4 vA[4], vB[4]; \
            AT_VRD(vA, 0, 0); SBAR_(); AT_VRD(vB, 0, 2); SBAR_(); \
            AT_PV(vA, pw[0], 0); SBAR_(); AT_VRD(vA, 1, 0); SBAR_(); AT_PV(vB, pw[0], 2); SBAR_(); AT_VRD(vB, 1, 2); SBAR_(); \
            AT_PV(vA, pw[1], 0); SBAR_(); AT_VRD(vA, 2, 0); SBAR_(); AT_PV(vB, pw[1], 2); SBAR_(); AT_VRD(vB, 2, 2); SBAR_(); \
            AT_PV(vA, pw[2], 0); SBAR_(); AT_VRD(vA, 3, 0); SBAR_(); AT_PV(vB, pw[2], 2); SBAR_(); AT_VRD(vB, 3, 2); SBAR_(); \
            AT_PV(vA, pw[3], 0); SBAR_(); AT_PV(vB, pw[3], 2); } while (0)
    if (map == 0) {
        int v3 = tf % 3;
#pragma unroll 1
        for (int t = tf; t < NT; ++t) { const int vn = v3 == 2 ? 0 : v3 + 1;
            if (t + 1 < NT) AT_DMA(t + 1, (t + 1) & 1, vn);
            if (t <= tl) { AT_QK(t); AT_PVV(v3); }
            __syncthreads(); v3 = vn; }
    } else {
        int v3 = tf % 3;
#pragma unroll 1
        for (int t = tf; t < NT; ++t) { const int vp = v3 == 0 ? 2 : v3 - 1, vn = v3 == 2 ? 0 : v3 + 1;
            if (t + 1 < NT) AT_DMA(t + 1, (t + 1) & 1, vn);
            if (t > tf && t - 1 <= tl) AT_PVV(vp);
            if (t <= tl) AT_QK(t);
            __syncthreads(); v3 = vn; }
        if (NT - 1 <= tl) { const int vp = v3 == 0 ? 2 : v3 - 1; AT_PVV(vp); }
    }
#undef AT_PVV
#undef AT_QK
#undef AT_VRD
#undef AT_PV
#undef SBAR_
#undef AT_DMA
    __syncthreads();
    const float ltot = swap32_sum(lsum);
    LAS float* X = (LAS float*)lds;
    if (map == 1) {
        const float sc = __uint_as_float(F.MISC[14]) / ltot;
#pragma unroll
        for (int vb = 0; vb < 4; ++vb)
#pragma unroll
            for (int r = 0; r < 16; ++r) X[(qs * 64 + vb * 16 + r) * 64 + lane] = o[vb][r] * sc;
    }
    __syncthreads();
    if (map == 0) {
        const float il = 1.f / ltot; float ss = 0.f;
#pragma unroll
        for (int vb = 0; vb < 4; ++vb)
#pragma unroll
            for (int r = 0; r < 16; ++r) { const float v = o[vb][r] * il - X[(qs * 64 + vb * 16 + r) * 64 + lane]; o[vb][r] = v; ss += v * v; }
        ss = swap32_sum(ss);
        const float rn = (1.f / sqrtf(ss * (1.f / 128.f) + 1e-5f)) * (1.f - LAMBDA_INIT);
        int etok = 0; asm volatile("" : "+v"(etok));
        const int lane_e = mk_lane(), hi = lane_e >> 5, row = 32 * qs + (lane_e & 31);
        const LAS unsigned char* grow = F.lds + (qs < 2 ? AT_G0 : AT_G1 - 64 * 256) + row * 256 + 8 * hi;
        LAS unsigned char* orow = lds + AT_OUT + row * 256 + 8 * hi;
#pragma unroll
        for (int vb = 0; vb < 4; ++vb)
#pragma unroll
            for (int rg = 0; rg < 4; ++rg) {
                const int vc = 32 * vb + 8 * rg + 4 * hi, ch = (((4 * vb + rg) ^ (row & 15)) * 16) + etok;
                const v2u gw = *(const LAS v2u*)(grow + ch); const f32x4 sg = *(const GAS f32x4*)(F.subln_g + vc);
                const float g4[4] = {bflo(gw.x), bfhi(gw.x), bflo(gw.y), bfhi(gw.y)}; float ov[4];
#pragma unroll
                for (int e = 0; e < 4; ++e) ov[e] = o[vb][4 * rg + e] * rn * sg[e] * g4[e] / (1.f + __expf(-g4[e]));
                const unsigned w1_ = cvtpk(ov[2], ov[3]);
                *(LAS v2u*)(orow + ch) = (v2u){cvtpk(ov[0], ov[1]), w1_};
                if (rg == 3) asm volatile("" : "+v"(etok) : "v"(w1_));
            }
    }
    __syncthreads();
    { const int t_ = wid * 64 + mk_lane(); bf16* ob = F.MIX + ((size_t)b * T + q0) * D + 512 + h * 128;
#pragma unroll
      for (int i = 0; i < 4; ++i) { const int pc = t_ + 512 * i, r_ = pc >> 4, c_ = pc & 15;
          *(GAS v4u*)(ob + (size_t)r_ * D + c_ * 8) = *(const LAS v4u*)(lds + AT_OUT + r_ * 256 + ((c_ ^ (r_ & 15)) * 16)); } }
    __syncthreads();
}
#ifndef DBL
#define DBL 0
#endif
constexpr int CW_QUEUE = 8192;
constexpr int QX_RW = 8, QX_A2 = 0, QX_AT = 64, QX_ALL = QX_RW + QX_A2 + QX_AT;
template <int MODE = 0> __device__ __forceinline__ void p3_queue(Frame& F, const RwDump& Dm, const int qbase = CW_QUEUE) {
    const int ql = mk_lane();
    const float l1 = wave_sum(F.lq1[ql] * F.lk1[ql]), l2 = wave_sum(F.lq2[ql] * F.lk2[ql]);
    const float lam = __uint_as_float(__builtin_amdgcn_readfirstlane(__float_as_uint(__expf(l1) - __expf(l2) + LAMBDA_INIT)));
    float gq = fabsf(F.qn_g[ql]), gk = fabsf(F.kn_g[ql]);
#pragma unroll
    for (int o = 1; o < 64; o <<= 1) { gq = fmaxf(gq, __shfl_xor(gq, o)); gk = fmaxf(gk, __shfl_xor(gk, o)); }
    const float shift2 = __uint_as_float(__builtin_amdgcn_readfirstlane(__float_as_uint(8.f * gq * gk * LOG2E)));
    if (F.wave == 0 && mk_lane() == 0) { F.MISC[14] = __float_as_uint(lam); F.MISC[15] = __float_as_uint(shift2); }
    __syncthreads();
#ifdef Q_BLK
    const int x0 = (int)(blockIdx.x & 7);
#else
    const int x0 = (int)(xb_xcc_id() & 7u);
#endif
#pragma unroll 1
    for (int dx = 0; dx < 8; ++dx) {
        const int xq = (x0 + dx) & 7;
        for (;;) {
            if (F.wave == 0 && mk_lane() == 0) F.MISC[12] = __hip_atomic_fetch_add(F.ctl + qbase + 64 * xq, 1u, RLX_AGENT);
            __syncthreads();
            int item = __builtin_amdgcn_readfirstlane((int)F.MISC[12]); if (MODE == 2) item += QX_RW;
            __syncthreads();
            if (item >= (MODE == 1 ? QX_RW : QX_ALL)) break;
            if (item < QX_RW) { rwkvB_unit(F, Dm, xq * 8 + item); if (DBL & 64) rwkvB_unit(F, Dm, xq * 8 + item); }
            else { const int idx = item - QX_RW - QX_A2, h = 3 - (idx >> 4), qb = 15 - (idx & 15);
#pragma unroll 1
#ifndef NO_ATT
                for (int rep = 0; rep < ((DBL & 32) ? 2 : 1); ++rep) attn_unit(F, xq, h, qb);
#endif
            }
        }
    }
}

constexpr int GT_STAGE = 40960, GT_NS = 3, GT_NK = D / 64;
__device__ __forceinline__ void gemm1_tail_unit(Frame& F, int qu) {
    int lane = mk_lane(); asm volatile("" : "+v"(lane));
    const int wid = F.wave, l31 = lane & 31, hi = lane >> 5;
    const int xcd = qu & 7, j = qu >> 3, R0 = (8 * xcd + (j & 7)) * 256 + (j >> 3) * 64;
    LAS unsigned char* lds = F.lds + RING_OFF;
    const int vr0 = 40 * wid + (lane >> 3), cp = lane & 7;
#define GT_ISSUE(kc_) do { LAS unsigned char* sb_ = lds + ((kc_) % GT_NS) * GT_STAGE + wid * 5120; \
        _Pragma("unroll") for (int i = 0; i < 5; ++i) { const int v_ = vr0 + 8 * i; \
            const bf16* src_ = (5 * wid + i < 8 ? F.XN + (size_t)(R0 + v_) * D : F.WinT + (size_t)(4096 + v_ - 64) * D) + (kc_) * 64 + ((cp ^ ((v_ >> 1) & 7)) * 8); \
            __builtin_amdgcn_global_load_lds((const unsigned*)src_, (LAS unsigned*)(sb_ + i * 1024), 16, 0, 0); } } while (0)
    f32x16 acc0 = f32x16{}, acc1 = f32x16{};
    const int nW = 32 * wid + l31, offW = 8192 + nW * 128, kyW = (nW >> 1) & 7, offX0 = l31 * 128, offX1 = (32 + l31) * 128, kyX = (l31 >> 1) & 7;
    GT_ISSUE(0); GT_ISSUE(1);
#pragma unroll 1
    for (int kc = 0; kc < GT_NK; ++kc) {
        if (kc + 1 < GT_NK) asm volatile("s_waitcnt vmcnt(5)" ::: "memory"); else asm volatile("s_waitcnt vmcnt(0)" ::: "memory");
        __builtin_amdgcn_s_barrier(); asm volatile("" ::: "memory");
        if (kc + 2 < GT_NK) GT_ISSUE(kc + 2);
        const LAS unsigned char* sb = lds + (kc % GT_NS) * GT_STAGE;
        v4u wf[4], x0[4], x1[4];
#pragma unroll
        for (int s = 0; s < 4; ++s) { wf[s] = *(const LAS v4u*)(sb + offW + (((2 * s + hi) ^ kyW) * 16)); x0[s] = *(const LAS v4u*)(sb + offX0 + (((2 * s + hi) ^ kyX) * 16)); x1[s] = *(const LAS v4u*)(sb + offX1 + (((2 * s + hi) ^ kyX) * 16)); }
#pragma unroll
        for (int s = 0; s < 4; ++s) { acc0 = MFMA32(wf[s], x0[s], acc0); acc1 = MFMA32(wf[s], x1[s], acc1); }
        asm volatile("s_waitcnt lgkmcnt(0)" ::: "memory");
    }
#undef GT_ISSUE
    bf16* op = F.PROJ + (size_t)(R0 + l31) * NP + 4096 + 32 * wid + 4 * hi;
#pragma unroll
    for (int q = 0; q < 4; ++q) {
        *(GAS v2u*)(op + 8 * q) = (v2u){cvtpk(acc0[4 * q], acc0[4 * q + 1]), cvtpk(acc0[4 * q + 2], acc0[4 * q + 3])};
        *(GAS v2u*)(op + (size_t)32 * NP + 8 * q) = (v2u){cvtpk(acc1[4 * q], acc1[4 * q + 1]), cvtpk(acc1[4 * q + 2], acc1[4 * q + 3])}; }
    __syncthreads();
}
struct Args { const float* in[21]; float* out; unsigned char* ws; int ph_lo, ph_hi; };
__global__ void __launch_bounds__(NWAVES * 64, 2) hymba_fwd(Args args) {
    extern __shared__ __attribute__((aligned(16))) unsigned char lds[];
    Frame F;
    F.lds = (LAS unsigned char*)lds;
    F.MISC = (volatile LAS unsigned*)(F.lds + MISC_OFF);
    F.wave = __builtin_amdgcn_readfirstlane((int)threadIdx.x >> 6); F.lane = mk_lane(); F.tid = F.wave * 64 + F.lane;
    F.G = gridDim.x; { const int bx = blockIdx.x; F.vcu = (F.G % 8 == 0) ? (bx % 8) * (F.G / 8) + bx / 8 : bx; }
    unsigned char* ws = args.ws;
    F.ctl = (gu32*)(ws + WS_CTL);
    F.x = args.in[0]; F.norm_g = args.in[1]; F.w_in = args.in[2]; F.shift_mu = args.in[3]; F.w0 = args.in[4]; F.w_decay_up = args.in[5]; F.a0 = args.in[6]; F.w_iclr_up = args.in[7];
    F.k_k = args.in[8]; F.k_a = args.in[9]; F.r_k = args.in[10]; F.ln_w = args.in[11]; F.ln_b = args.in[12]; F.qn_g = args.in[13]; F.kn_g = args.in[14];
    F.lq1 = args.in[15]; F.lk1 = args.in[16]; F.lq2 = args.in[17]; F.lk2 = args.in[18]; F.subln_g = args.in[19]; F.w_out = args.in[20]; F.out = args.out;
    F.WinT = (bf16*)(ws + WS_WIN); F.WoutT = (bf16*)(ws + WS_WOUT); F.WdT = (bf16*)(ws + WS_WD); F.WaT = (bf16*)(ws + WS_WA);
    F.XN = (bf16*)(ws + WS_XN); F.PROJ = (bf16*)(ws + WS_PROJ); F.MIX = (bf16*)(ws + WS_MIX);
    for (int u = F.tid; u < (LDS_BYTES - LDSCTL_OFF) / 4; u += NWAVES * 64) ((LAS unsigned*)(F.lds + LDSCTL_OFF))[u] = 0u;
    __syncthreads();
    XcdBarrier bar; bar.bar = (unsigned*)(F.ctl + CW_BAR); bar.x = 0; bar.st = nullptr; bar.wave = F.wave;
    if (MK_N_LAUNCHES == 1) bar = xcd_barrier_post((unsigned*)(F.ctl + CW_BAR), F.MISC + 8, F.wave);
#define GRID_BAR() do { if (MK_N_LAUNCHES == 1) xcd_barrier(bar); } while (0)
    const int lo = args.ph_lo, hi = args.ph_hi;
#define IN(k) (lo <= (k) && (k) < hi)
#define BOTH(k) (IN(k) && IN((k) + 1))
#ifndef SKIP
#define SKIP 0
#endif
    if (IN(0) && !(SKIP & 1)) { p0_prologue(F); if (DBL & 1) { GRID_BAR(); p0_prologue(F); } if (BOTH(0)) GRID_BAR(); }
    if (IN(1) && !(SKIP & 2)) {
        pg8::Gemm g{F.XN, F.WinT, M, 4096, D}; pg8::StaticOrder S; S.init(M, 4096, F.G, (int)blockIdx.x);
        pg8::EpiBf16S E{F.PROJ, NP};
        pg8::gemm_phase<pg8::EpiBf16S, pg8::StaticOrder, true, true>(F.lds + RING_OFF, g, S, E, F.wave);
#pragma unroll 1
        for (int qu = (int)blockIdx.x; qu < 256; qu += F.G) gemm1_tail_unit(F, qu);
#ifdef TAILX2
#pragma unroll 1
        for (int rep = 0; rep < TAILX2; ++rep) {
#pragma unroll 1
        for (int qu = (int)blockIdx.x; qu < 256; qu += F.G) gemm1_tail_unit(F, qu); }
#endif
        if (DBL & 2) { GRID_BAR(); pg8::gemm_phase<pg8::EpiBf16S, pg8::StaticOrder, true, true>(F.lds + RING_OFF, g, S, E, F.wave); }
        if (BOTH(1)) GRID_BAR();
    }
    RwDump Dm; { unsigned char* so = (unsigned char*)args.out; Dm.PF = (v4u*)so; Dm.DD = (v4u*)(so + 32 * MiB); Dm.QF = (v4u*)(ws + WS_XN); Dm.YD = (v4u*)(ws + WS_XN + 16 * MiB);
        Dm.GAM = (float*)(ws + WS_END); Dm.RHO = (float*)(ws + WS_END + 1 * MiB); }
    if (IN(2) && !(SKIP & 4)) {
        LAS float* wscr = (LAS float*)(F.lds + LDSCTL_OFF + 1024) + F.wave * 64; int zpar = 0;
#pragma unroll 1
        for (int p = F.vcu; p < BATCH * (T / 32); p += F.G) { rwkvA_unit(F, Dm, (p >> 6) * RH + F.wave, p & 63, wscr, F.lds + RING_OFF + F.wave * 16384, (LAS v4u*)(F.lds + LDSCTL_OFF + 4096), zpar); zpar ^= 1; }
        if (DBL & 4) { GRID_BAR();
#pragma unroll 1
            for (int p = F.vcu; p < BATCH * (T / 32); p += F.G) { rwkvA_unit(F, Dm, (p >> 6) * RH + F.wave, p & 63, wscr, F.lds + RING_OFF + F.wave * 16384, (LAS v4u*)(F.lds + LDSCTL_OFF + 4096), zpar); zpar ^= 1; } }
        p2_qknorm(F);
        if (BOTH(2)) GRID_BAR();
    }
    if (IN(3) && !(SKIP & 8)) {
#ifdef P3SPLIT
        p3_queue<1>(F, Dm); GRID_BAR(); p3_queue<2>(F, Dm, CW_QUEUE + 1024);
#else
        p3_queue(F, Dm);
#endif
        if (DBL & 512) { GRID_BAR(); p3_queue(F, Dm, CW_QUEUE + 1024); }
        if (BOTH(3)) GRID_BAR();
    }
    if (IN(4) && !(SKIP & 16)) {
        pg8::Gemm g{F.MIX, F.WoutT, M, D, D}; pg8::StaticOrder S; S.init(M, D, F.G, (int)blockIdx.x);
        pg8::EpiResF32 E{F.x, F.out, D};
        pg8::gemm_phase<pg8::EpiResF32, pg8::StaticOrder, false, true>(F.lds + RING_OFF, g, S, E, F.wave);
        if (DBL & 16) { GRID_BAR(); pg8::gemm_phase<pg8::EpiResF32, pg8::StaticOrder, false, true>(F.lds + RING_OFF, g, S, E, F.wave); }
    }
#undef IN
#undef BOTH
}

extern "C" void kernel_launch(void* const* d_in, const int* in_sizes, int n_in, void* d_out, int out_size, void* d_ws, size_t ws_size, hipStream_t stream) {
    static int grid = 0;
    if (grid == 0) {
        if (n_in != 21 || in_sizes[0] != M * D || out_size != M * D || ws_size < WS_END + 2 * MiB) { fprintf(stderr, "kernel_launch: unexpected shapes (n_in %d, in0 %d, out %d, ws %zu); nothing launched\n", n_in, n_in > 0 ? in_sizes[0] : -1, out_size, ws_size); grid = -1; return; }
        int dev = 0, cus = 0, per_cu = 0;
        if (hipGetDevice(&dev) != hipSuccess || hipDeviceGetAttribute(&cus, hipDeviceAttributeMultiprocessorCount, dev) != hipSuccess) { grid = -1; return; }
        if (hipFuncSetAttribute((const void*)hymba_fwd, hipFuncAttributeMaxDynamicSharedMemorySize, LDS_BYTES) != hipSuccess) { fprintf(stderr, "kernel_launch: hipFuncSetAttribute failed\n"); grid = -1; return; }
        if (hipOccupancyMaxActiveBlocksPerMultiprocessor(&per_cu, (const void*)hymba_fwd, NWAVES * 64, LDS_BYTES) != hipSuccess || per_cu < 1) { fprintf(stderr, "kernel_launch: occupancy query reports %d workgroups per CU; nothing launched\n", per_cu); grid = -1; return; }
        (void)hipGetLastError();
        grid = cus;
        if (grid > 256) grid = 256;
    }
    if (grid < 0) return;
    if (hipMemsetAsync((char*)d_ws + WS_CTL, 0, CTL_ZERO_BYTES, stream) != hipSuccess) { fprintf(stderr, "kernel_launch: hipMemsetAsync failed\n"); return; }
    Args a{};
    for (int i = 0; i < 21; ++i) a.in[i] = (const float*)d_in[i];
    a.out = (float*)d_out; a.ws = (unsigned char*)d_ws;
    for (int li = 0; li < MK_N_LAUNCHES; ++li) {
        a.ph_lo = (MK_N_LAUNCHES == 1) ? 0 : li; a.ph_hi = (MK_N_LAUNCHES == 1) ? N_PHASES : li + 1;
        hipLaunchKernelGGL(hymba_fwd, dim3(grid), dim3(NWAVES * 64), LDS_BYTES, stream, a);
        const hipError_t le = hipPeekAtLastError();
        if (le != hipSuccess) { fprintf(stderr, "kernel_launch: launch %d failed: %s\n", li, hipGetErrorName(le)); break; }
    }
}
```

```cpp
#include <hip/hip_runtime.h>
#include <hip/hip_bf16.h>
#include <cstdio>
#include <cstdint>
#include <cmath>
namespace pg8 {
#define PG8_LAS __attribute__((address_space(3)))
typedef unsigned short bf16_t;
typedef short bf16x8 __attribute__((ext_vector_type(8)));
typedef float f32x4 __attribute__((ext_vector_type(4)));
typedef unsigned u32x4 __attribute__((ext_vector_type(4)));
constexpr int BM = 256, BK = 64, HALF = 128, HTB = HALF * BK * 2  , STAGE_BYTES = 8 * HTB, NXCD = 8, WGM = 8;

__host__ __device__ __forceinline__ int lds_byte(int r, int c) { const int st = (r >> 4) * 2 + (c >> 5), rr = r & 15, cc = c & 31, ob = rr * 64 + cc * 2; return st * 1024 + (ob ^ (((ob >> 9) & 1) << 5)); }
__host__ __device__ __forceinline__ void stage_rc(int b, int& R, int& C) { const int st = b / 1024, sb = b % 1024, swz = sb ^ (((sb >> 9) & 1) << 5); R = (st >> 1) * 16 + swz / 64; C = (st & 1) * 32 + (swz % 64) / 2; }
__host__ __device__ __forceinline__ int perm32(int rho) { const int n = rho >> 4, i = rho & 15; return 8 * (i >> 2) + 4 * n + (i & 3); }

__device__ __forceinline__ int mk_lane_pg8() { int l; asm volatile("v_mbcnt_lo_u32_b32 %0, -1, 0\n\tv_mbcnt_hi_u32_b32 %0, -1, %0" : "=v"(l)); return l; }
struct Unit { int pm, pn; };
struct Gemm { const bf16_t* A; const bf16_t* Bt; int M, N, K; };

struct StaticOrder {
    int nM, nN, nwg, G, c;
    __host__ __device__ void init(int M, int N, int G_, int c_) { nM = M / BM; nN = N / BM; nwg = nM * nN; G = G_; c = c_; }
    __host__ __device__ bool next(int i, Unit& u) const {
        const long L = (long)i * G + c; if (L >= nwg) return false;
        int wgid = (int)L; { const int q = nwg / NXCD, r = nwg % NXCD, xcd = wgid % NXCD, off = wgid / NXCD; wgid = (xcd < r ? xcd * (q + 1) : r * (q + 1) + (xcd - r) * q) + off; }
        const int nig = WGM * nN, gid = wgid / nig, fm = gid * WGM, gsz = (nM - fm) < WGM ? (nM - fm) : WGM;
        u.pm = fm + ((wgid % nig) % gsz); u.pn = (wgid % nig) / gsz; return true;
    }
    __device__ __forceinline__ void a_ready(const Unit&) const {}
    __device__ __forceinline__ void done(const Unit&) const {}
};

__device__ __forceinline__ unsigned cvt_pk_bf16(float lo, float hi) { unsigned r; asm volatile("v_cvt_pk_bf16_f32 %0, %1, %2" : "=v"(r) : "v"(lo), "v"(hi)); return r; }
struct EpiBf16S {
    static constexpr bool PERM = true, AFTER_DRAIN = false, HAS_INIT = false;
    bf16_t* O; int ldc;
    __device__ __forceinline__ void operator()(const f32x4 (&acc)[2][2][4][2], const Unit& u, int wr, int wc, int fr, int fq) const {
        const int row0 = u.pm * BM + wr * 64 + fr, col0 = u.pn * BM + wc * 32 + 8 * fq;
#pragma unroll
        for (int ai = 0; ai < 2; ++ai)
#pragma unroll
            for (int m = 0; m < 4; ++m) { bf16_t* rowp = O + (size_t)(row0 + ai * HALF + m * 16) * ldc + col0;
#pragma unroll
                for (int bj = 0; bj < 2; ++bj) { const f32x4 v0 = acc[ai][bj][m][0], v1 = acc[ai][bj][m][1];
                    u32x4 w; w.x = cvt_pk_bf16(v0[0], v0[1]); w.y = cvt_pk_bf16(v0[2], v0[3]); w.z = cvt_pk_bf16(v1[0], v1[1]); w.w = cvt_pk_bf16(v1[2], v1[3]);
                    *(u32x4*)(rowp + bj * HALF) = w; } }
    }
};
struct EpiResF32 {
    static constexpr bool PERM = false, AFTER_DRAIN = false, HAS_INIT = true;
    const float* base; float* out; int ldc;
    __device__ __forceinline__ void init(f32x4 (&acc)[2][2][4][2], const Unit& u, int wr, int wc, int fr, int fq) const {
        const int row0 = u.pm * BM + wr * 64 + fr, col0 = u.pn * BM + wc * 32 + 4 * fq;
#pragma unroll
        for (int ai = 0; ai < 2; ++ai)
#pragma unroll
            for (int m = 0; m < 4; ++m) { const size_t off = (size_t)(row0 + ai * HALF + m * 16) * ldc + col0;
#pragma unroll
                for (int bj = 0; bj < 2; ++bj)
#pragma unroll
                    for (int n = 0; n < 2; ++n) acc[ai][bj][m][n] = *(const f32x4*)(base + off + bj * HALF + n * 16); }
    }
    __device__ __forceinline__ void operator()(const f32x4 (&acc)[2][2][4][2], const Unit& u, int wr, int wc, int fr, int fq) const {
        const int row0 = u.pm * BM + wr * 64 + fr, col0 = u.pn * BM + wc * 32 + 4 * fq;
#pragma unroll
        for (int ai = 0; ai < 2; ++ai)
#pragma unroll
            for (int m = 0; m < 4; ++m) { const size_t off = (size_t)(row0 + ai * HALF + m * 16) * ldc + col0;
#pragma unroll
                for (int bj = 0; bj < 2; ++bj)
#pragma unroll
                    for (int n = 0; n < 2; ++n) *(f32x4*)(out + off + bj * HALF + n * 16) = acc[ai][bj][m][n]; }
    }
};
template <class Epi, class Sched, bool ALIGN_EPI = false, bool SP2 = false>
__device__ __forceinline__ void gemm_phase(PG8_LAS unsigned char* lds, const Gemm g, const Sched& S, const Epi& E, const int mk_wave_id  ) {
    const int wid = mk_wave_id, lane = mk_lane_pg8(), tid = wid * 64 + lane, wr = wid >> 2, wc = wid & 3, fr = lane & 15, fq = lane >> 4;
    const int K = g.K, nt = K / BK;
    unsigned voffA[2], voffB[2];
#pragma unroll
    for (int i = 0; i < 2; ++i) { int R, C; stage_rc(tid * 16 + i * 8192, R, C); const int Rb = Epi::PERM ? ((R & ~31) + perm32(R & 31)) : R;
        voffA[i] = (unsigned)(R * K + C) * 2u; voffB[i] = (unsigned)(Rb * K + C) * 2u; }
    const size_t kstep = (size_t)(BK * 2);
    const size_t hstep = (size_t)HALF * K * 2;
    const size_t tstep = 2 * hstep;
    const unsigned ldsw = (unsigned)wid * 1024u;
    const int aoff = lds_byte(wr * 64 + fr, fq * 8), boff = lds_byte(wc * 32 + fr, fq * 8);
#define PG8_SA(b, h) (((b) * 2 + (h)) * HTB)
#define PG8_SB(b, h) ((4 + (b) * 2 + (h)) * HTB)
#define PG8_STAGE(bufoff, gbase, voff) do { _Pragma("unroll") for (int _i = 0; _i < 2; ++_i) \
        __builtin_amdgcn_global_load_lds((const unsigned*)((const char*)(gbase) + (voff)[_i]), (PG8_LAS unsigned*)(lds + (bufoff) + ldsw + _i * 8192), 16, 0, 0); } while (0)
#define PG8_LDA(dst, b, h) do { _Pragma("unroll") for (int m = 0; m < 4; ++m) _Pragma("unroll") for (int k = 0; k < 2; ++k) dst[m][k] = *(const PG8_LAS bf16x8*)(lds + PG8_SA(b, h) + aoff + m * 2048 + k * 1024); } while (0)
#define PG8_LDB(dst, b, h) do { _Pragma("unroll") for (int n = 0; n < 2; ++n) _Pragma("unroll") for (int k = 0; k < 2; ++k) dst[n][k] = *(const PG8_LAS bf16x8*)(lds + PG8_SB(b, h) + boff + n * 2048 + k * 1024); } while (0)
#define PG8_MMA(ai, bj, At, Bt) do { __builtin_amdgcn_s_setprio(1); _Pragma("unroll") for (int m = 0; m < 4; ++m) _Pragma("unroll") for (int n = 0; n < 2; ++n) _Pragma("unroll") for (int k = 0; k < 2; ++k) \
        acc[ai][bj][m][n] = __builtin_amdgcn_mfma_f32_16x16x32_bf16(Bt[n][k], At[m][k], acc[ai][bj][m][n], 0, 0, 0); __builtin_amdgcn_s_setprio(0); } while (0)
#define PG8_WAIT_V(n) asm volatile("s_waitcnt vmcnt(" #n ")" ::: "memory")
#define PG8_WAIT_L(n) asm volatile("s_waitcnt lgkmcnt(" #n ")" ::: "memory")
#define PG8_BAR __builtin_amdgcn_s_barrier()
#define PG8_SCHED __builtin_amdgcn_sched_barrier(0)
    Unit cur, nxt; int ui = 0;
    if (!S.next(0, cur)) return;
    f32x4 acc[2][2][4][2];
#pragma unroll
    for (int a = 0; a < 2; ++a)
#pragma unroll
        for (int b = 0; b < 2; ++b)
#pragma unroll
            for (int m = 0; m < 4; ++m)
#pragma unroll
                for (int n = 0; n < 2; ++n) acc[a][b][m][n] = (f32x4){0.f, 0.f, 0.f, 0.f};
    if constexpr (Epi::HAS_INIT) E.init(acc, cur, wr, wc, fr, fq);
    bf16x8 At[4][2], B0[2][2], B1[2][2];
    const char* cA = (const char*)g.A + (size_t)cur.pm * tstep; const char* cB = (const char*)g.Bt + (size_t)cur.pn * tstep;
    S.a_ready(cur);
    if constexpr (SP2) {
        PG8_STAGE(PG8_SB(0, 0), cB, voffB); PG8_STAGE(PG8_SB(0, 1), cB + hstep, voffB); PG8_STAGE(PG8_SA(0, 0), cA, voffA); PG8_STAGE(PG8_SA(0, 1), cA + hstep, voffA);
        if (wr == 1) PG8_BAR;
        PG8_WAIT_V(2); PG8_BAR;
        PG8_STAGE(PG8_SB(1, 0), cB + kstep, voffB); PG8_STAGE(PG8_SA(1, 0), cA + kstep, voffA); PG8_STAGE(PG8_SB(1, 1), cB + hstep + kstep, voffB);
        PG8_WAIT_V(6); PG8_BAR;
    } else {
        PG8_STAGE(PG8_SB(0, 0), cB, voffB); PG8_STAGE(PG8_SA(0, 0), cA, voffA); PG8_STAGE(PG8_SB(0, 1), cB + hstep, voffB); PG8_STAGE(PG8_SA(0, 1), cA + hstep, voffA);
        if (wr == 1) PG8_BAR;
        PG8_WAIT_V(4); PG8_BAR;
        PG8_STAGE(PG8_SB(1, 0), cB + kstep, voffB); PG8_STAGE(PG8_SA(1, 0), cA + kstep, voffA); PG8_STAGE(PG8_SB(1, 1), cB + hstep + kstep, voffB);
        PG8_WAIT_V(6); PG8_BAR;
    }
    for (;;) {
        const bool has_next = S.next(ui + 1, nxt);
        const char* nA = has_next ? (const char*)g.A + (size_t)nxt.pm * tstep : cA; const char* nB = has_next ? (const char*)g.Bt + (size_t)nxt.pn * tstep : cB;
        for (int t = 0; t < nt; t += 2) {
            const bool last = (t == nt - 2);
            const char* a1 = cA + (size_t)(t + 1) * kstep;
            const char* a2 = last ? nA : cA + (size_t)(t + 2) * kstep; const char* b2 = last ? nB : cB + (size_t)(t + 2) * kstep;
            const char* a3 = a2 + kstep; const char* b3 = b2 + kstep;
            if (last && has_next) S.a_ready(nxt);
            if constexpr (SP2) {
            PG8_LDB(B0, 0, 0); PG8_LDB(B1, 0, 1); PG8_SCHED; PG8_LDA(At, 0, 0); PG8_STAGE(PG8_SA(1, 1), a1 + hstep, voffA);
            PG8_WAIT_V(8); PG8_WAIT_L(0); PG8_BAR; PG8_MMA(0, 0, At, B0); PG8_MMA(0, 1, At, B1); PG8_BAR; PG8_SCHED;
            PG8_LDA(At, 0, 1); PG8_STAGE(PG8_SB(0, 0), b2, voffB); PG8_STAGE(PG8_SB(0, 1), b2 + hstep, voffB); PG8_STAGE(PG8_SA(0, 0), a2, voffA);
            PG8_WAIT_V(8); PG8_WAIT_L(0); PG8_BAR; PG8_MMA(1, 0, At, B0); PG8_MMA(1, 1, At, B1); PG8_BAR; PG8_SCHED;
            PG8_LDB(B0, 1, 0); PG8_LDB(B1, 1, 1); PG8_SCHED; PG8_LDA(At, 1, 0); PG8_STAGE(PG8_SA(0, 1), a2 + hstep, voffA);
            PG8_WAIT_V(8); PG8_WAIT_L(0); PG8_BAR; PG8_MMA(0, 0, At, B0); PG8_MMA(0, 1, At, B1); PG8_BAR; PG8_SCHED;
            PG8_LDA(At, 1, 1); PG8_STAGE(PG8_SB(1, 0), b3, voffB); PG8_STAGE(PG8_SB(1, 1), b3 + hstep, voffB); PG8_STAGE(PG8_SA(1, 0), a3, voffA);
            PG8_WAIT_V(8); PG8_WAIT_L(0); PG8_BAR; PG8_MMA(1, 0, At, B0); PG8_MMA(1, 1, At, B1); PG8_BAR; PG8_SCHED;
            } else {
            PG8_LDB(B0, 0, 0); PG8_SCHED; PG8_LDA(At, 0, 0); PG8_STAGE(PG8_SA(1, 1), a1 + hstep, voffA);
            PG8_WAIT_L(8); PG8_BAR; PG8_WAIT_L(0); PG8_MMA(0, 0, At, B0); PG8_BAR; PG8_SCHED;
            PG8_LDB(B1, 0, 1); PG8_STAGE(PG8_SB(0, 0), b2, voffB);
            PG8_BAR; PG8_WAIT_L(0); PG8_MMA(0, 1, At, B1); PG8_BAR;
            PG8_LDA(At, 0, 1); PG8_STAGE(PG8_SA(0, 0), a2, voffA);
            PG8_BAR; PG8_WAIT_L(0); PG8_MMA(1, 0, At, B0); PG8_BAR; PG8_SCHED;
            PG8_STAGE(PG8_SB(0, 1), b2 + hstep, voffB);
            PG8_WAIT_V(6); PG8_BAR; PG8_MMA(1, 1, At, B1); PG8_BAR;
            PG8_LDB(B0, 1, 0); PG8_SCHED; PG8_LDA(At, 1, 0); PG8_STAGE(PG8_SA(0, 1), a2 + hstep, voffA);
            PG8_WAIT_L(8); PG8_BAR; PG8_WAIT_L(0); PG8_MMA(0, 0, At, B0); PG8_BAR; PG8_SCHED;
            PG8_LDB(B1, 1, 1); PG8_STAGE(PG8_SB(1, 0), b3, voffB);
            PG8_BAR; PG8_WAIT_L(0); PG8_MMA(0, 1, At, B1); PG8_BAR;
            PG8_LDA(At, 1, 1); PG8_STAGE(PG8_SA(1, 0), a3, voffA);
            PG8_BAR; PG8_WAIT_L(0); PG8_MMA(1, 0, At, B0); PG8_BAR; PG8_SCHED;
            PG8_STAGE(PG8_SB(1, 1), b3 + hstep, voffB);
            PG8_WAIT_V(6); PG8_BAR; PG8_MMA(1, 1, At, B1); PG8_BAR;
            }
        }
        if constexpr (ALIGN_EPI) { if (wr == 0) PG8_BAR; }
        if constexpr (!Epi::AFTER_DRAIN) { E(acc, cur, wr, wc, fr, fq); S.done(cur); }
        if (!has_next) break;
#pragma unroll
        for (int a = 0; a < 2; ++a)
#pragma unroll
            for (int b = 0; b < 2; ++b)
#pragma unroll
                for (int m = 0; m < 4; ++m)
#pragma unroll
                    for (int n = 0; n < 2; ++n) acc[a][b][m][n] = (f32x4){0.f, 0.f, 0.f, 0.f};
        if constexpr (Epi::HAS_INIT) E.init(acc, nxt, wr, wc, fr, fq);
        cur = nxt; cA = nA; cB = nB; ++ui;
        if constexpr (ALIGN_EPI) { if (wr == 1) PG8_BAR; }
    }
    PG8_WAIT_V(0);
    if constexpr (!ALIGN_EPI) { if (wr == 0) PG8_BAR; }
    PG8_BAR;
    if constexpr (Epi::AFTER_DRAIN) { E.fused(acc, cur, wr, wc, fr, fq, lds, wid, lane); S.done(cur); }
#undef PG8_SA
#undef PG8_SB
#undef PG8_STAGE
#undef PG8_LDA
#undef PG8_LDB
#undef PG8_MMA
#undef PG8_WAIT_V
#undef PG8_WAIT_L
#undef PG8_BAR
#undef PG8_SCHED
}
}
constexpr int NWAVES = 8;
#ifndef MK_N_LAUNCHES
#define MK_N_LAUNCHES 1
#endif
constexpr int N_PHASES = 5;
constexpr int BATCH = 8, T = 2048, D = 1024, M = BATCH * T;
constexpr int NP = 4352;
constexpr int C_R = 0, C_K = 512, C_V = 1024, C_ZW = 1536, C_ZA = 1600, C_GA = 1792, C_DQ = 2304, C_DK = 2816, C_DV = 3328, C_GB = 3840;
constexpr int RH = 8, RN = 64;
constexpr int AH = 4;
constexpr float C2 = 0.125f * 1.4426950408889634f;
constexpr float LOG2E = 1.4426950408889634f;
constexpr float LAMBDA_INIT = 0.2f;

constexpr size_t MiB = 1u << 20;
constexpr size_t WS_CTL = 0, CTL_ZERO_BYTES = 1 * MiB;
constexpr size_t WS_WIN = 2 * MiB;
constexpr size_t WS_WOUT = 11 * MiB;
constexpr size_t WS_WD = 13 * MiB, WS_WA = 13 * MiB + 65536;
constexpr size_t WS_RHO = 13 * MiB + 2 * 65536;
constexpr size_t WS_XN = 14 * MiB;
constexpr size_t WS_PROJ = 46 * MiB;
constexpr size_t WS_MIX = 182 * MiB;
constexpr size_t WS_END = 214 * MiB;
constexpr int CW_BAR = 4096;

constexpr int RING_OFF = 0, RING_BYTES = 131072;
constexpr int LDSCTL_OFF = RING_BYTES, MISC_OFF = LDSCTL_OFF + 320;
constexpr int LDS_BYTES = 155648;

#define GAS __attribute__((address_space(1)))
#define LAS __attribute__((address_space(3)))
typedef unsigned short bf16;
typedef unsigned v4u __attribute__((ext_vector_type(4)));
typedef unsigned v2u __attribute__((ext_vector_type(2)));
typedef float f32x4 __attribute__((ext_vector_type(4)));
typedef float f32x16 __attribute__((ext_vector_type(16)));
typedef short bf16x8 __attribute__((ext_vector_type(8)));
typedef short s16x4 __attribute__((ext_vector_type(4)));
typedef GAS unsigned gu32;
typedef GAS unsigned long long gu64;
#define RLX_AGENT __ATOMIC_RELAXED, __HIP_MEMORY_SCOPE_AGENT
#define LDS_WAIT() asm volatile("s_waitcnt lgkmcnt(0)" ::: "memory")
#define VM_WAIT() asm volatile("s_waitcnt vmcnt(0)" ::: "memory")
__device__ __forceinline__ unsigned f2bf(float f) { unsigned u = __builtin_bit_cast(unsigned, f); return (u + 0x7fffu + ((u >> 16) & 1u)) >> 16; }
__device__ __forceinline__ unsigned pk2(float lo, float hi) { return f2bf(lo) | (f2bf(hi) << 16); }
__device__ __forceinline__ float bflo(unsigned u) { return __uint_as_float(u << 16); }
__device__ __forceinline__ float bfhi(unsigned u) { return __uint_as_float(u & 0xffff0000u); }
__device__ __forceinline__ float bf1(unsigned short u) { return __uint_as_float((unsigned)u << 16); }
__device__ __forceinline__ int mk_lane() { int l; asm volatile("v_mbcnt_lo_u32_b32 %0, -1, 0\n\tv_mbcnt_hi_u32_b32 %0, -1, %0" : "=v"(l)); return l; }
#define XB_TMO      128
#define XB_XCNT(j)  (256  + 64 * (j))
#define XB_XSUB(j)  (1280 + 64 * (j))
#define XB_XGEN(j)  (2304 + 64 * (j))
#define XB_TOP      3328
#define XB_TOPGEN   3392
#define XCD_BAR_WORDS 3456
#define XB_SPIN_CAP (1u << 18)

__device__ __forceinline__ unsigned xb_ld(unsigned* p)              { return __hip_atomic_load(p, __ATOMIC_RELAXED, __HIP_MEMORY_SCOPE_AGENT); }
__device__ __forceinline__ unsigned xb_add(unsigned* p, unsigned v) { return __hip_atomic_fetch_add(p, v, __ATOMIC_RELAXED, __HIP_MEMORY_SCOPE_AGENT); }
__device__ __forceinline__ unsigned xb_xcc_id() { return (unsigned)__builtin_amdgcn_s_getreg((3 << 11) | 20) & 0xFu; }
#define XB_SPIN(cond, bar) do { unsigned _sp = 0; while (cond) { __builtin_amdgcn_s_sleep(1); \
    if ((++_sp & 255u) == 0u) { if (xb_ld(&(bar)[XB_TMO])) break; if (_sp > XB_SPIN_CAP) { atomicAdd(&(bar)[XB_TMO], 1u); break; } } } } while (0)

struct XcdBarrier {
    unsigned* bar; unsigned x;
    volatile LAS unsigned* st;
    int wave;
};

__device__ __forceinline__ XcdBarrier xcd_barrier_post(unsigned* bar, volatile LAS unsigned* st, int wave) {
    XcdBarrier b; b.bar = bar; b.x = xb_xcc_id(); b.st = st; b.wave = wave;
    if (wave == 0 && mk_lane() == 0) (void)xb_add(&bar[XB_XCNT(b.x)], 1u);
    return b;
}
__device__ __forceinline__ void xcd_barrier_complete(unsigned* bar, unsigned x, unsigned& nloc, unsigned& nx) {
    const unsigned G = gridDim.x * gridDim.y * gridDim.z;
    unsigned sum, cnt, mine, sp = 0u;
    for (;;) {
        sum = 0u; cnt = 0u; mine = 0u;
#pragma unroll
        for (unsigned j = 0; j < 16; ++j) { const unsigned c = xb_ld(&bar[XB_XCNT(j)]); sum += c; cnt += (c > 0u) ? 1u : 0u; mine = (j == x) ? c : mine; }
        if (sum == G) break;
        __builtin_amdgcn_s_sleep(1);
        if ((++sp & 255u) == 0u) { if (xb_ld(&bar[XB_TMO])) break; if (sp > XB_SPIN_CAP) { atomicAdd(&bar[XB_TMO], 1u); break; } }
    }
    nloc = mine > 0u ? mine : 1u; nx = cnt > 0u ? cnt : 1u;
}

__device__ __forceinline__ void xcd_barrier(const XcdBarrier& b) {
    asm volatile("s_waitcnt vmcnt(0)" ::: "memory");
    __syncthreads();
    if (b.wave == 0 && mk_lane() == 0) {
        unsigned* bar = b.bar;
        __builtin_amdgcn_s_waitcnt(0);
        unsigned nloc = b.st[0], nx = b.st[1];
        if (nloc == 0u) { xcd_barrier_complete(bar, b.x, nloc, nx); b.st[0] = nloc; b.st[1] = nx; }
        const unsigned old = xb_add(&bar[XB_XSUB(b.x)], 1u);
        const unsigned gen = old / nloc;
        if (old + 1u == (gen + 1u) * nloc) {
            __builtin_amdgcn_fence(__ATOMIC_RELEASE, "agent");
            asm volatile("s_waitcnt vmcnt(0)" ::: "memory");
            const unsigned og = xb_add(&bar[XB_TOP], 1u);
            const unsigned tg = og / nx;
            if (og + 1u == (tg + 1u) * nx) xb_add(&bar[XB_TOPGEN], 1u);
            else XB_SPIN(xb_ld(&bar[XB_TOPGEN]) == tg, bar);
            __builtin_amdgcn_fence(__ATOMIC_ACQUIRE, "agent");
            xb_add(&bar[XB_XGEN(b.x)], 1u);
            asm volatile("s_waitcnt vmcnt(0)" ::: "memory");
        } else {
            XB_SPIN(xb_ld(&bar[XB_XGEN(b.x)]) == gen, bar);
            __builtin_amdgcn_fence(__ATOMIC_ACQUIRE, "agent");
            asm volatile("s_waitcnt vmcnt(0)" ::: "memory");
        }
    }
    __syncthreads();
}
struct Frame {
    LAS unsigned char* lds;
    volatile LAS unsigned* MISC;
    gu32* ctl;
    int tid, lane, wave;
    int vcu, G;
    const float* x; float* out;
    const float *norm_g, *w_in, *shift_mu, *w0, *w_decay_up, *a0, *w_iclr_up, *k_k, *k_a, *r_k, *ln_w, *ln_b, *qn_g, *kn_g, *lq1, *lk1, *lq2, *lk2, *subln_g, *w_out;
    bf16 *WinT, *WoutT, *WdT, *WaT, *XN, *PROJ, *MIX;
};

typedef float f32x2q_t __attribute__((ext_vector_type(2))); typedef __bf16 bf16x2q_t __attribute__((ext_vector_type(2)));
__device__ __forceinline__ unsigned cvtpk2(float lo, float hi) { f32x2q_t v = {lo, hi}; bf16x2q_t b = __builtin_convertvector(v, bf16x2q_t); return __builtin_bit_cast(unsigned, b); }
__device__ __forceinline__ float wave_sum(float v) {
#pragma unroll
    for (int o = 1; o < 64; o <<= 1) v += __shfl_xor(v, o);
    return v;
}
template <int CTRL> __device__ __forceinline__ float dpp_f(float x) { return __builtin_bit_cast(float, __builtin_amdgcn_mov_dpp(__builtin_bit_cast(int, x), CTRL, 0xf, 0xf, true)); }
__device__ __forceinline__ float row16_sum(float x) {
    x += dpp_f<0xB1>(x); x += dpp_f<0x4E>(x); x += dpp_f<0x141>(x); x += dpp_f<0x140>(x); return x;
}
__device__ __forceinline__ float swap32_sum(float x) {
    auto rr = __builtin_amdgcn_permlane32_swap(__float_as_uint(x), __float_as_uint(x), false, false);
    return __uint_as_float(rr[0]) + __uint_as_float(rr[1]);
}

template <bool FRAG = false> __device__ __forceinline__ void p0_transpose_item(const float* W, int N, int nsrc, const float* kscale, bf16* WT, int K, int ndst, LAS float* scr, int k0, int lane) {
    float v[32];
#pragma unroll
    for (int i = 0; i < 32; ++i) { const int kk = 2 * i + (lane >> 5); v[i] = (nsrc >= 0) ? W[(size_t)(k0 + kk) * N + nsrc + (lane & 31)] : 0.f; }
    if (kscale && nsrc >= 0) {
#pragma unroll
        for (int i = 0; i < 32; ++i) v[i] *= kscale[k0 + 2 * i + (lane >> 5)];
    }
#pragma unroll
    for (int i = 0; i < 32; ++i) scr[(2 * i + (lane >> 5)) * 33 + (lane & 31)] = v[i];
    LDS_WAIT(); asm volatile("" ::: "memory");
    const int c = lane & 7;
#pragma unroll
    for (int j = 0; j < 4; ++j) { const int n = (lane >> 3) + 8 * j; const LAS float* s = scr + (8 * c) * 33 + n;
        v4u o; o.x = cvtpk2(s[0 * 33], s[1 * 33]); o.y = cvtpk2(s[2 * 33], s[3 * 33]); o.z = cvtpk2(s[4 * 33], s[5 * 33]); o.w = cvtpk2(s[6 * 33], s[7 * 33]);
        if (FRAG) *(GAS v4u*)(WT + ((size_t)((ndst >> 5) * 4 + (c >> 1)) * 64 + ((c & 1) * 32 + n)) * 8) = o;
        else *(GAS v4u*)(WT + (size_t)(ndst + n) * K + k0 + 8 * c) = o; }
    LDS_WAIT(); asm volatile("" ::: "memory");
}
__device__ __forceinline__ void p0_rows4(Frame& F, int m0) {
    f32x4 v[4][4]; float s[4];
#pragma unroll
    for (int u = 0; u < 4; ++u) { const GAS f32x4* xr = (const GAS f32x4*)(F.x + (size_t)(m0 + u) * D) + F.lane;
#pragma unroll
        for (int j = 0; j < 4; ++j) v[u][j] = __builtin_nontemporal_load(xr + 64 * j); }
#pragma unroll
    for (int u = 0; u < 4; ++u) { float a = 0.f;
#pragma unroll
        for (int j = 0; j < 4; ++j) a += (v[u][j].x * v[u][j].x + v[u][j].y * v[u][j].y) + (v[u][j].z * v[u][j].z + v[u][j].w * v[u][j].w);
        s[u] = a; }
#pragma unroll
    for (int u = 0; u < 4; ++u) {
        const float rstd = __builtin_amdgcn_rsqf(wave_sum(s[u]) * (1.f / D) + 1e-6f);
        GAS unsigned long long* o8 = (GAS unsigned long long*)(F.XN + (size_t)(m0 + u) * D) + F.lane;
#pragma unroll
        for (int j = 0; j < 4; ++j) o8[64 * j] = (unsigned long long)cvtpk2(v[u][j].x * rstd, v[u][j].y * rstd) | ((unsigned long long)cvtpk2(v[u][j].z * rstd, v[u][j].w * rstd) << 32);
    }
}
__device__ __forceinline__ void p0_prologue(Frame& F) {
    LAS float* scr = (LAS float*)(F.lds + RING_OFF + F.wave * 16384);
    const int gw = F.vcu * NWAVES + F.wave, NGW = F.G * NWAVES;
    constexpr int I_IN = (D / 64) * (NP / 32), I_OUT = (D / 64) * (D / 32), I_L = 512 / 32;
    constexpr int NITEMS = I_IN + I_OUT + 2 * I_L;
    int m0 = gw * 4;
    if (!(gw & 1) && m0 < M) { p0_rows4(F, m0); m0 += NGW * 4; }
#pragma unroll 1
    for (int it = gw; it < NITEMS; it += NGW) {
        int r = it;
        if (r < I_IN) { const int kb = r / (NP / 32), nb = r % (NP / 32), nd = 32 * nb; const int ns = nd < 1664 ? nd : (nd < 1792 ? -1 : nd - 128);
            p0_transpose_item(F.w_in, 4224, ns, F.norm_g, F.WinT, D, nd, scr, 64 * kb, F.lane); continue; } r -= I_IN;
        if (r < I_OUT) { const int kb = r / (D / 32), nb = r % (D / 32);
            p0_transpose_item(F.w_out, D, 32 * nb, nullptr, F.WoutT, D, 32 * nb, scr, 64 * kb, F.lane); continue; } r -= I_OUT;
        if (r < I_L) { p0_transpose_item<true>(F.w_decay_up, 512, 32 * r, nullptr, F.WdT, 64, 32 * r, scr, 0, F.lane); continue; } r -= I_L;
        p0_transpose_item<true>(F.w_iclr_up, 512, 32 * r, nullptr, F.WaT, 64, 32 * r, scr, 0, F.lane);
    }
#pragma unroll 1
    for (; m0 < M; m0 += NGW * 4) p0_rows4(F, m0);
}

__device__ __forceinline__ float tanh_f(float x) { const float e = __expf(-2.f * fabsf(x)); const float t = (1.f - e) * __builtin_amdgcn_rcpf(1.f + e); return x < 0.f ? -t : t; }
__device__ __forceinline__ void shifted8(const bf16* proj, size_t m, bool has_prev, int col, const float* mu, float (&o)[8]) {
    const v4u c = *(const GAS v4u*)(proj + m * NP + col);
    v4u p = (v4u){0u, 0u, 0u, 0u}; if (has_prev) p = *(const GAS v4u*)(proj + (m - 1) * NP + col);
    const f32x4 m0 = *(const GAS f32x4*)(mu), m1 = *(const GAS f32x4*)(mu + 4);
    const unsigned cw[4] = {c.x, c.y, c.z, c.w}, pw[4] = {p.x, p.y, p.z, p.w}; const float mm[8] = {m0.x, m0.y, m0.z, m0.w, m1.x, m1.y, m1.z, m1.w};
#pragma unroll
    for (int j = 0; j < 4; ++j) { const float c0 = bflo(cw[j]), c1 = bfhi(cw[j]), p0 = bflo(pw[j]), p1 = bfhi(pw[j]);
        o[2 * j] = c0 + (p0 - c0) * mm[2 * j]; o[2 * j + 1] = c1 + (p1 - c1) * mm[2 * j + 1]; }
}
__device__ __forceinline__ void shifted4(const bf16* proj, size_t m, bool has_prev, int col, const float* mu, float (&o)[4]) {
    const v2u c = *(const GAS v2u*)(proj + m * NP + col);
    v2u p = (v2u){0u, 0u}; if (has_prev) p = *(const GAS v2u*)(proj + (m - 1) * NP + col);
    const f32x4 m0 = *(const GAS f32x4*)(mu);
    o[0] = bflo(c.x) + (bflo(p.x) - bflo(c.x)) * m0.x; o[1] = bfhi(c.x) + (bfhi(p.x) - bfhi(c.x)) * m0.y;
    o[2] = bflo(c.y) + (bflo(p.y) - bflo(c.y)) * m0.z; o[3] = bfhi(c.y) + (bfhi(p.y) - bfhi(c.y)) * m0.w;
}
__device__ __forceinline__ void p2_qknorm(Frame& F) {
    const int gw = F.vcu * NWAVES + F.wave, NGW = F.G * NWAVES, lane = F.lane, sub = lane & 7;
    const f32x4 gk0 = *(const GAS f32x4*)(F.kn_g + sub * 8), gk1 = *(const GAS f32x4*)(F.kn_g + sub * 8 + 4);
    constexpr int UQ = 4;
    for (int it0 = gw * UQ; it0 < M; it0 += NGW * UQ) {
        bf16* p[UQ]; v4u c[UQ];
#pragma unroll
        for (int u = 0; u < UQ; ++u) { const size_t m = (size_t)(it0 + u); p[u] = F.PROJ + m * NP + C_DK + (lane >> 3) * 64 + sub * 8; c[u] = *(const GAS v4u*)p[u]; }
#pragma unroll
        for (int u = 0; u < UQ; ++u) {
            const unsigned cw[4] = {c[u].x, c[u].y, c[u].z, c[u].w};
            float xv[8]; float ss = 0.f;
#pragma unroll
            for (int j = 0; j < 4; ++j) { xv[2 * j] = bflo(cw[j]); xv[2 * j + 1] = bfhi(cw[j]); ss += xv[2 * j] * xv[2 * j] + xv[2 * j + 1] * xv[2 * j + 1]; }
            ss += dpp_f<0xB1>(ss); ss += dpp_f<0x4E>(ss); ss += dpp_f<0x141>(ss);
            const float r = __builtin_amdgcn_rsqf(ss * (1.f / 64.f) + 1e-6f);
            v4u o; o.x = cvtpk2(xv[0] * r * gk0.x, xv[1] * r * gk0.y); o.y = cvtpk2(xv[2] * r * gk0.z, xv[3] * r * gk0.w); o.z = cvtpk2(xv[4] * r * gk1.x, xv[5] * r * gk1.y); o.w = cvtpk2(xv[6] * r * gk1.z, xv[7] * r * gk1.w);
            *(GAS v4u*)p[u] = o;
        }
    }
}
typedef float f32x2_t __attribute__((ext_vector_type(2))); typedef __bf16 bf16x2_t __attribute__((ext_vector_type(2)));
__device__ __forceinline__ unsigned cvtpk(float lo, float hi) { f32x2_t v = {lo, hi}; bf16x2_t b = __builtin_convertvector(v, bf16x2_t); return __builtin_bit_cast(unsigned, b); }
#define MFMA32(a, b, c) __builtin_amdgcn_mfma_f32_32x32x16_bf16(__builtin_bit_cast(bf16x8, (a)), __builtin_bit_cast(bf16x8, (b)), (c), 0, 0, 0)
#define FRAGACC(z, s) ((v4u){cvtpk((z)[8 * (s)], (z)[8 * (s) + 1]), cvtpk((z)[8 * (s) + 2], (z)[8 * (s) + 3]), cvtpk((z)[8 * (s) + 4], (z)[8 * (s) + 5]), cvtpk((z)[8 * (s) + 6], (z)[8 * (s) + 7])})
template <int CTRL, int RM> __device__ __forceinline__ float dpp_upd0(float x) { return __builtin_bit_cast(float, __builtin_amdgcn_update_dpp(0, __builtin_bit_cast(int, x), CTRL, RM, 0xf, false)); }
__device__ __forceinline__ float scan32(float x) {
    x += dpp_upd0<0x111, 0xf>(x); x += dpp_upd0<0x112, 0xf>(x); x += dpp_upd0<0x114, 0xf>(x); x += dpp_upd0<0x118, 0xf>(x); x += dpp_upd0<0x142, 0xa>(x); return x;
}
__device__ __forceinline__ void st_wt16(v4u* p, const v4u v) { *(GAS v4u*)p = v; }
constexpr int RW_UNITS = BATCH * RH * (T / 32);
struct RwDump { v4u* PF; v4u* DD; v4u* QF; v4u* YD; float* GAM; float* RHO; };

__device__ __forceinline__ void rwkvA_unit(Frame& F, const RwDump& Dm, int bh, int ci, LAS float* wscr, LAS unsigned char* park, LAS v4u* zsh, int zpar) {
    int lane = mk_lane(); asm volatile("" : "+v"(lane));
    const int hi = lane >> 5, l31 = lane & 31, b = bh >> 3, w = bh & 7;
    LAS v4u* pk = (LAS v4u*)park + lane;
#define PARK(slot) pk[(slot) * 64]
    int tok = 0; asm volatile("" : "+v"(tok));
#define DEP(x) asm volatile("" : "+v"(tok) : "v"(x))
    const int t = ci * 32 + l31; const size_t m = (size_t)b * T + t; const bool hp = t > 0;
    const int u = ci * (BATCH * RH) + bh;
    const float pm = hp ? 1.f : 0.f;
    const float* mu = F.shift_mu + w * 64 + 4 * hi;
    const float *pw0 = F.w0 + w * 64 + 4 * hi, *pa0 = F.a0 + w * 64 + 4 * hi, *pkk = F.k_k + w * 64 + 4 * hi, *pka = F.k_a + w * 64 + 4 * hi, *prk = F.r_k + w * 64 + 4 * hi;
    LAS unsigned char* stg = park + 8192;
    LAS unsigned char* prv = F.lds + LDSCTL_OFF + 20480 + F.wave * 256;
    const bf16* gk = F.PROJ + ((size_t)b * T + ci * 32) * NP + w * 64;
    const bf16* gpr = gk - (ci > 0 ? NP : 0);
#define RW_DMA(src, dst) __builtin_amdgcn_global_load_lds((const unsigned*)(src), (LAS unsigned*)(dst), 16, 0, 0)
    LDS_WAIT();
    { const bf16* s_ = gk + (size_t)(lane >> 3) * NP + C_K + (lane & 7) * 8;
#pragma unroll
      for (int p = 0; p < 4; ++p) RW_DMA(s_ + (size_t)(8 * p) * NP, stg + p * 1024);
      if (lane < 8) RW_DMA(gpr + C_K + lane * 8, prv); }
#define RW_STAGE_RV(cb) do { const bf16* s_ = gk + (size_t)(lane >> 2) * NP + 32 * (cb) + (lane & 3) * 8; \
      _Pragma("unroll") for (int p = 0; p < 2; ++p) { RW_DMA(s_ + C_R + (size_t)(16 * p) * NP, stg + 4096 + p * 1024); RW_DMA(s_ + C_V + (size_t)(16 * p) * NP, stg + 6144 + p * 1024); } \
      if (lane < 4) { RW_DMA(gpr + C_R + 32 * (cb) + lane * 8, prv + 128); RW_DMA(gpr + C_V + 32 * (cb) + lane * 8, prv + 192); } } while (0)
    RW_STAGE_RV(0);
    const LAS unsigned char* kcur = stg + l31 * 128 + 8 * hi; const LAS unsigned char* kprv = l31 ? kcur - 128 : prv + 8 * hi;
    const LAS unsigned char* rcur = stg + 4096 + l31 * 64 + 8 * hi; const LAS unsigned char* rprv = l31 ? rcur - 64 : prv + 128 + 8 * hi;
    const LAS unsigned char* vcur = stg + 6144 + l31 * 64 + 8 * hi; const LAS unsigned char* vprv = l31 ? vcur - 64 : prv + 192 + 8 * hi;
    v4u bz[4], ba[4];
    { const int s = F.wave >> 1; const bool which = (F.wave & 1) != 0;
      const bf16* zc = F.PROJ + m * NP + 8 * hi; const bf16* zp = F.PROJ + (hp ? m - 1 : m) * NP + 8 * hi; const float* zmu = F.shift_mu + 8 * hi;
      const int COL = (which ? C_ZA : C_ZW) + 16 * s, MUO = (which ? 1600 : 1536) + 16 * s;
      const v4u c = *(const GAS v4u*)(zc + tok + COL), p = *(const GAS v4u*)(zp + tok + COL); const f32x4 m0 = *(const GAS f32x4*)(zmu + tok + MUO), m1 = *(const GAS f32x4*)(zmu + tok + MUO + 4);
      float z[8];
#pragma unroll
      for (int j = 0; j < 4; ++j) { const float c0 = bflo(c[j]), c1 = bfhi(c[j]); const float mm0 = j < 2 ? m0[2 * j] : m1[2 * j - 4], mm1 = j < 2 ? m0[2 * j + 1] : m1[2 * j - 3];
          z[2 * j] = c0 + (bflo(p[j]) * pm - c0) * mm0; z[2 * j + 1] = c1 + (bfhi(p[j]) * pm - c1) * mm1; }
      if (!which) {
#pragma unroll
          for (int j = 0; j < 8; ++j) z[j] = tanh_f(z[j]); }
      LAS v4u* zs = zsh + zpar * 512;
      zs[((which ? 4 : 0) + s) * 64 + lane] = (v4u){cvtpk(z[0], z[1]), cvtpk(z[2], z[3]), cvtpk(z[4], z[5]), cvtpk(z[6], z[7])};
      __syncthreads();
#pragma unroll
      for (int q = 0; q < 4; ++q) { bz[q] = zs[q * 64 + lane]; ba[q] = zs[(4 + q) * 64 + lane]; }
      DEP(bz[3][3]); DEP(ba[3][3]); }
    asm volatile("" ::: "memory");
    asm volatile("s_waitcnt vmcnt(0)" ::: "memory");
    float ss = 0.f;
#pragma unroll
    for (int gq = 0; gq < 8; ++gq) { const v2u c_ = *(const LAS v2u*)(kcur + tok + 16 * gq), p_ = *(const LAS v2u*)(kprv + tok + 16 * gq);
        const f32x4 m_ = *(const GAS f32x4*)(mu + tok + 512 + 8 * gq), kkp = *(const GAS f32x4*)(pkk + tok + 8 * gq);
        float k4[4]; k4[0] = bflo(c_.x) + (bflo(p_.x) * pm - bflo(c_.x)) * m_.x; k4[1] = bfhi(c_.x) + (bfhi(p_.x) * pm - bfhi(c_.x)) * m_.y;
        k4[2] = bflo(c_.y) + (bflo(p_.y) * pm - bflo(c_.y)) * m_.z; k4[3] = bfhi(c_.y) + (bfhi(p_.y) * pm - bfhi(c_.y)) * m_.w;
#pragma unroll
        for (int e = 0; e < 4; ++e) { const float q = k4[e] * kkp[e]; ss += q * q; }
        if (gq == 3) DEP(ss); }
    ss = swap32_sum(ss);
    const float inv = __builtin_amdgcn_rcpf(fmaxf(__builtin_amdgcn_sqrtf(ss), 1e-12f));
    asm volatile("" ::: "memory");
    v4u fa[4], fb[4], fk[4], fr[4], fv[4]; float rho = 0.f;
    float* gp = Dm.GAM + (size_t)u * 64 + hi * 32;
#define RW_LORA(cb) f32x16 accd = f32x16{}, acca = f32x16{}; _Pragma("unroll") for (int s = 0; s < 4; ++s) { \
        const v4u aD = *(const GAS v4u*)(F.WdT + tok + ((size_t)((w * 2 + (cb)) * 4 + s) * 64 + lane) * 8); accd = MFMA32(aD, bz[s], accd);     \
        const v4u aA = *(const GAS v4u*)(F.WaT + tok + ((size_t)((w * 2 + (cb)) * 4 + s) * 64 + lane) * 8); acca = MFMA32(aA, ba[s], acca); }
        struct RwGL { v2u rc, rp, kc, kp, vc, vp; };
    struct RwPar { f32x4 mr, mk, mv, w0, a0, kk; } pA, pB;
#define RW_LOADG(X, CB, RG) do { X.rc = *(const LAS v2u*)(rcur + tok + 16 * (RG)); X.rp = *(const LAS v2u*)(rprv + tok + 16 * (RG)); X.kc = *(const LAS v2u*)(kcur + tok + 64 * (CB) + 16 * (RG)); X.kp = *(const LAS v2u*)(kprv + tok + 64 * (CB) + 16 * (RG)); \
        X.vc = *(const LAS v2u*)(vcur + tok + 16 * (RG)); X.vp = *(const LAS v2u*)(vprv + tok + 16 * (RG)); } while (0)
#define RW_LOADP(X, OFF_) do { X.mr = *(const GAS f32x4*)(mu + tok + (OFF_)); X.mk = *(const GAS f32x4*)(mu + tok + 512 + (OFF_)); X.mv = *(const GAS f32x4*)(mu + tok + 1024 + (OFF_)); \
        X.w0 = *(const GAS f32x4*)(pw0 + tok + (OFF_)); X.a0 = *(const GAS f32x4*)(pa0 + tok + (OFF_)); X.kk = *(const GAS f32x4*)(pkk + tok + (OFF_)); } while (0)
#define RW_LERP(dst, c_, p_, m_) do { dst[0] = bflo(c_.x) + (bflo(p_.x) * pm - bflo(c_.x)) * m_.x; dst[1] = bfhi(c_.x) + (bfhi(p_.x) * pm - bfhi(c_.x)) * m_.y; \
        dst[2] = bflo(c_.y) + (bflo(p_.y) * pm - bflo(c_.y)) * m_.z; dst[3] = bfhi(c_.y) + (bfhi(p_.y) * pm - bfhi(c_.y)) * m_.w; } while (0)
#define RW_GROUP(cb, rg, CUR, NXT, HASN) do { constexpr int OFF = 32 * (cb) + 8 * (rg); const int ch0 = OFF + 4 * hi; \
            if (HASN) RW_LOADP(NXT, OFF + 8); \
            RwGL g_; RW_LOADG(g_, cb, rg); \
            float rr[4], kk4[4], vv[4]; \
            const f32x4 kap = *(const GAS f32x4*)(pka + tok + OFF), rkp = *(const GAS f32x4*)(prk + tok + OFF);     \
            const f32x4 mr_ = CUR.mr, mk_ = CUR.mk, mv_ = CUR.mv, w0v = CUR.w0, a0v = CUR.a0, kkp = CUR.kk; \
            RW_LERP(rr, g_.rc, g_.rp, mr_); RW_LERP(kk4, g_.kc, g_.kp, mk_); RW_LERP(vv, g_.vc, g_.vp, mv_); \
            float xa[4], xb[4], xk[4], xr[4], gg[4], ge[4]; \
            _Pragma("unroll") for (int e = 0; e < 4; ++e) { \
                  \
                const float l2 = (-0.6065306597126334f * LOG2E) * __builtin_amdgcn_rcpf(1.f + __expf(-(w0v[e] + accd[4 * (rg) + e]))); \
                const float g = scan32(l2); \
                const float a = __builtin_amdgcn_rcpf(1.f + __expf(-(a0v[e] + acca[4 * (rg) + e]))); \
                const float kk = kk4[e] * kkp[e] * inv; \
                const float kt = kk4[e] * (1.f + (a - 1.f) * kap[e]); \
                rho += rr[e] * kt * rkp[e]; \
                const float eg = __builtin_amdgcn_exp2f(g), egp = __builtin_amdgcn_exp2f(g - l2), eng = __builtin_amdgcn_rcpf(eg); \
                xa[e] = -kk * egp; xb[e] = kk * a * eng; xk[e] = kt * eng; xr[e] = rr[e] * eg; gg[e] = g; ge[e] = eg; } \
            if (l31 == 31) { *(LAS f32x4*)(wscr + ch0) = (f32x4){gg[0], gg[1], gg[2], gg[3]}; st_wt16((v4u*)(gp + (cb) * 16 + 4 * (rg)), (v4u){__float_as_uint(ge[0]), __float_as_uint(ge[1]), __float_as_uint(ge[2]), __float_as_uint(ge[3])}); } \
            constexpr int s_ = 2 * (cb) + ((rg) >> 1), vg = 2 * ((rg) & 1); \
            fa[s_][vg] = cvtpk(xa[0], xa[1]); fa[s_][vg + 1] = cvtpk(xa[2], xa[3]); \
            fb[s_][vg] = cvtpk(xb[0], xb[1]); fb[s_][vg + 1] = cvtpk(xb[2], xb[3]); \
            fk[s_][vg] = cvtpk(xk[0], xk[1]); fk[s_][vg + 1] = cvtpk(xk[2], xk[3]); \
            fr[s_][vg] = cvtpk(xr[0], xr[1]); fr[s_][vg + 1] = cvtpk(xr[2], xr[3]); \
            fv[s_][vg] = cvtpk(vv[0], vv[1]); fv[s_][vg + 1] = cvtpk(vv[2], vv[3]); \
            if (((rg) & 1) == 1) { PARK(s_) = fv[s_]; PARK(4 + s_) = fr[s_]; } \
            DEP(fa[s_][vg + 1]); DEP(fb[s_][vg + 1]); DEP(fk[s_][vg + 1]); DEP(fr[s_][vg + 1]); DEP(fv[s_][vg + 1]); DEP(rho); } while (0)
    RW_LOADP(pA, 0);
    { RW_LORA(0) RW_GROUP(0, 0, pA, pB, true); RW_GROUP(0, 1, pB, pA, true); RW_GROUP(0, 2, pA, pB, true); RW_GROUP(0, 3, pB, pA, true); }
    LDS_WAIT(); RW_STAGE_RV(1);
    { RW_LORA(1) asm volatile("s_waitcnt vmcnt(0)" ::: "memory");
      RW_GROUP(1, 0, pA, pB, true); RW_GROUP(1, 1, pB, pA, true); RW_GROUP(1, 2, pA, pB, true); RW_GROUP(1, 3, pB, pA, false); }
#undef RW_STAGE_RV
#undef RW_DMA
#undef RW_LOADG
#undef RW_LOADP
#undef RW_LERP
#undef RW_LORA
#undef RW_GROUP
    LDS_WAIT(); asm volatile("" ::: "memory");
    float EC[2]; EC[0] = __builtin_amdgcn_exp2f(wscr[l31]); EC[1] = __builtin_amdgcn_exp2f(wscr[32 + l31]);
    LDS_WAIT(); asm volatile("" ::: "memory");
    rho = swap32_sum(rho);
    if (hi == 0) __hip_atomic_store((gu32*)(Dm.RHO + (size_t)u * 32 + l31), __float_as_uint(rho), RLX_AGENT);
    v4u idf[2];
    { const int jst = 4 * ((l31 >> 3) & 1) + (l31 & 3); const bool hm = ((l31 >> 2) & 1) == hi; const unsigned one = 0x3F80u << (16 * (jst & 1));
#pragma unroll
      for (int sig = 0; sig < 2; ++sig) { const bool on = hm && ((l31 >> 4) == sig);
#pragma unroll
          for (int q = 0; q < 4; ++q) idf[sig][q] = (on && (jst >> 1) == q) ? one : 0u; } }
    LDS_WAIT();
    v4u Af[2][2], Vf[2][2];
#pragma unroll
    for (int blk = 0; blk < 2; ++blk) {
        f32x16 za = MFMA32(fa[2 * blk], idf[0], f32x16{}); za = MFMA32(fa[2 * blk + 1], idf[1], za);
        f32x16 zv = MFMA32(PARK(2 * blk), idf[0], f32x16{}); zv = MFMA32(PARK(2 * blk + 1), idf[1], zv);
        f32x16 zb = MFMA32(fb[2 * blk], idf[0], f32x16{}); zb = MFMA32(fb[2 * blk + 1], idf[1], zb);
        f32x16 zk = MFMA32(fk[2 * blk], idf[0], f32x16{}); zk = MFMA32(fk[2 * blk + 1], idf[1], zk);
        zb = zb * EC[blk]; zk = zk * EC[blk];
#pragma unroll
        for (int s = 0; s < 2; ++s) { Af[blk][s] = FRAGACC(za, s); Vf[blk][s] = FRAGACC(zv, s); PARK(8 + 2 * blk + s) = FRAGACC(zb, s); PARK(12 + 2 * blk + s) = FRAGACC(zk, s); }
        __builtin_amdgcn_sched_barrier(0);
    }
    f32x16 Aab = f32x16{}, TT = f32x16{}, AakT = f32x16{}, ArbT = f32x16{}, ArkT = f32x16{};
#pragma unroll
    for (int s = 0; s < 4; ++s) { const v4u frs = PARK(4 + s); Aab = MFMA32(fa[s], fb[s], Aab); TT = MFMA32(fb[s], fa[s], TT); AakT = MFMA32(fk[s], fa[s], AakT); ArbT = MFMA32(fb[s], frs, ArbT); ArkT = MFMA32(fk[s], frs, ArkT); }
#pragma unroll
    for (int r = 0; r < 16; ++r) { const int rowi = (r & 3) + 8 * (r >> 2) + 4 * hi;
        Aab[r] = (l31 < rowi) ? Aab[r] : 0.f; TT[r] = (rowi < l31) ? TT[r] : 0.f; AakT[r] = (rowi < l31) ? AakT[r] : 0.f;
        ArbT[r] = (rowi <= l31) ? ArbT[r] : 0.f; ArkT[r] = (rowi <= l31) ? ArkT[r] : 0.f; }
    v4u AakTf[2], ArbTf[2], ArkTf[2];
#pragma unroll
    for (int s = 0; s < 2; ++s) { AakTf[s] = FRAGACC(AakT, s); ArbTf[s] = FRAGACC(ArbT, s); ArkTf[s] = FRAGACC(ArkT, s); }
    __builtin_amdgcn_sched_barrier(0);
    v4u Xf[2], XTf[2], TTf[2];
#pragma unroll
    for (int s = 0; s < 2; ++s) { Xf[s] = FRAGACC(Aab, s); XTf[s] = FRAGACC(TT, s); }
#pragma unroll
    for (int r = 0; r < 16; ++r) { const int rowi = (r & 3) + 8 * (r >> 2) + 4 * hi; TT[r] += (rowi == l31) ? 1.f : 0.f; }
#pragma unroll
    for (int it = 0; it < 4; ++it) {
        f32x16 X2 = MFMA32(XTf[0], Xf[0], f32x16{}); X2 = MFMA32(XTf[1], Xf[1], X2);
        if (it < 3) { f32x16 X2T = MFMA32(Xf[0], XTf[0], f32x16{}); X2T = MFMA32(Xf[1], XTf[1], X2T);
#pragma unroll
            for (int s = 0; s < 2; ++s) XTf[s] = FRAGACC(X2T, s); }
#pragma unroll
        for (int s = 0; s < 2; ++s) { Xf[s] = FRAGACC(X2, s); TTf[s] = FRAGACC(TT, s); }
        TT = MFMA32(Xf[0], TTf[0], TT); TT = MFMA32(Xf[1], TTf[1], TT);
        __builtin_amdgcn_sched_barrier(0);
    }
#pragma unroll
    for (int s = 0; s < 2; ++s) TTf[s] = FRAGACC(TT, s);
    v4u Wf[2][2], Uf[2][2];
#pragma unroll
    for (int blk = 0; blk < 2; ++blk) {
        f32x16 av = MFMA32(AakTf[0], Vf[blk][0], f32x16{}); av = MFMA32(AakTf[1], Vf[blk][1], av);
        const v4u avf0 = FRAGACC(av, 0), avf1 = FRAGACC(av, 1);
        f32x16 uu = MFMA32(TTf[0], avf0, f32x16{}); uu = MFMA32(TTf[1], avf1, uu);
        f32x16 ww = MFMA32(TTf[0], Af[blk][0], f32x16{}); ww = MFMA32(TTf[1], Af[blk][1], ww);
#pragma unroll
        for (int s = 0; s < 2; ++s) { Wf[blk][s] = FRAGACC(ww, s); Uf[blk][s] = FRAGACC(uu, s); }
        __builtin_amdgcn_sched_barrier(0);
    }
    v4u* QFp = Dm.QF + (size_t)u * 256 + lane; v4u* YDp = Dm.YD + (size_t)u * 256 + lane;
#pragma unroll
    for (int blk = 0; blk < 2; ++blk) {
        f32x16 q;
#pragma unroll
        for (int s = 0; s < 2; ++s)
            { const v4u frs = PARK(4 + 2 * blk + s);
#pragma unroll
              for (int j = 0; j < 4; ++j) { q[8 * s + 2 * j] = bflo(frs[j]); q[8 * s + 2 * j + 1] = bfhi(frs[j]); } }
        q = MFMA32(Wf[blk][0], ArbTf[0], q); q = MFMA32(Wf[blk][1], ArbTf[1], q);
        st_wt16(QFp + (2 * blk) * 64, FRAGACC(q, 0)); st_wt16(QFp + (2 * blk + 1) * 64, FRAGACC(q, 1));
        f32x16 y = MFMA32(Uf[blk][0], ArbTf[0], f32x16{}); y = MFMA32(Uf[blk][1], ArbTf[1], y); y = MFMA32(Vf[blk][0], ArkTf[0], y); y = MFMA32(Vf[blk][1], ArkTf[1], y);
        st_wt16(YDp + (2 * blk) * 64, FRAGACC(y, 0)); st_wt16(YDp + (2 * blk + 1) * 64, FRAGACC(y, 1));
        __builtin_amdgcn_sched_barrier(0);
    }
    v4u* PFp = Dm.PF + (size_t)u * 512 + lane; v4u* DDp = Dm.DD + (size_t)u * 512 + lane;
#pragma unroll
    for (int c1 = 0; c1 < 2; ++c1)
#pragma unroll
        for (int cb = 0; cb < 2; ++cb) {
            f32x16 p = MFMA32(Wf[c1][0], PARK(8 + 2 * cb), f32x16{}); p = MFMA32(Wf[c1][1], PARK(8 + 2 * cb + 1), p);
            st_wt16(PFp + (cb * 4 + 2 * c1) * 64, FRAGACC(p, 0)); st_wt16(PFp + (cb * 4 + 2 * c1 + 1) * 64, FRAGACC(p, 1));
            __builtin_amdgcn_sched_barrier(0);
        }
#pragma unroll
    for (int cb = 0; cb < 2; ++cb)
#pragma unroll
        for (int ib = 0; ib < 2; ++ib) {
            f32x16 d = MFMA32(PARK(8 + 2 * cb), Uf[ib][0], f32x16{}); d = MFMA32(PARK(8 + 2 * cb + 1), Uf[ib][1], d); d = MFMA32(PARK(12 + 2 * cb), Vf[ib][0], d); d = MFMA32(PARK(12 + 2 * cb + 1), Vf[ib][1], d);
            st_wt16(DDp + ((cb * 2 + ib) * 2) * 64, FRAGACC(d, 0)); st_wt16(DDp + ((cb * 2 + ib) * 2 + 1) * 64, FRAGACC(d, 1));
            __builtin_amdgcn_sched_barrier(0);
        }
}

#undef PARK
#undef DEP
constexpr int RB_PF = 0, RB_DD = 8192, RB_QF = 16384, RB_YD = 20480, RB_GAM = 24576, RB_BUF = 24832, RB_NB = 4, RB_STAT = RB_NB * RB_BUF, RB_Y = RB_STAT + 1024;
__device__ __forceinline__ void unpack16(const v4u a, const v4u b, f32x16& o) {
#pragma unroll
    for (int j = 0; j < 4; ++j) { o[2 * j] = bflo(a[j]); o[2 * j + 1] = bfhi(a[j]); o[8 + 2 * j] = bflo(b[j]); o[8 + 2 * j + 1] = bfhi(b[j]); }
}
constexpr int RW_SPLIT = T / 32, CW_DONE = 16384;
__device__ __forceinline__ void rw_wait_chunk(Frame& F, int ci) {
    unsigned spins = 0;
#pragma unroll 1
    for (int j = 7; j >= 0; --j) { gu32* c = F.ctl + CW_DONE + 64 * (ci + j);
        while ((unsigned)__builtin_amdgcn_readfirstlane(__hip_atomic_load(c, RLX_AGENT)) < (unsigned)BATCH) { __builtin_amdgcn_s_sleep(8); if (++spins > (1u << 22)) break; } }
    __builtin_amdgcn_fence(__ATOMIC_ACQUIRE, "agent");
}
__device__ __forceinline__ void rw_publish_chunk(Frame& F, int ci) {
    asm volatile("s_waitcnt vmcnt(0)" ::: "memory");
    __syncthreads();
    if (F.wave == 0 && mk_lane() == 0) {
        __hip_atomic_fetch_add(F.ctl + CW_DONE + 64 * ci, 1u, RLX_AGENT);
    }
}
#ifndef RB_AUX
#define RB_AUX 2
#endif
struct RbStage { v4u p[2], d[2], q, y, g; };
struct RbEpi { v4u vc, vp, ga; float rho; };
__device__ __forceinline__ void rwkvB_unit(Frame& F, const RwDump& Dm, int bh) {
    int lane = mk_lane(); asm volatile("" : "+v"(lane));
    const int wid = F.wave, tid = wid * 64 + lane, hi = lane >> 5, l31 = lane & 31, b = bh >> 3, h = bh & 7;
    LAS unsigned char* lds = F.lds + RING_OFF;
    constexpr int NS = T / 32;
    LAS float* stat = (LAS float*)(lds + RB_STAT);
    LAS float* ybuf = (LAS float*)(lds + RB_Y);
    const int stid = tid - 128;
    const bool st_p2 = wid < 4, st_q = wid < 6, st_y = wid >= 4;
#define ST_LOAD(X, ci_) do { { if ((ci_) >= RW_SPLIT && (ci_) < NS && (((ci_) - RW_SPLIT) & 7) == 0) rw_wait_chunk(F, (ci_)); const size_t u_ = (size_t)((ci_) < NS ? (ci_) : NS - 1) * (BATCH * RH) + bh; \
        X.p[0] = __builtin_nontemporal_load((const GAS v4u*)(Dm.PF + u_ * 512 + stid)); X.d[0] = __builtin_nontemporal_load((const GAS v4u*)(Dm.DD + u_ * 512 + stid)); \
        if (st_p2) { X.p[1] = __builtin_nontemporal_load((const GAS v4u*)(Dm.PF + u_ * 512 + 384 + stid)); X.d[1] = __builtin_nontemporal_load((const GAS v4u*)(Dm.DD + u_ * 512 + 384 + stid)); } \
        if (st_q) X.q = __builtin_nontemporal_load((const GAS v4u*)(Dm.QF + u_ * 256 + stid)); \
        if (st_y) X.y = __builtin_nontemporal_load((const GAS v4u*)(Dm.YD + u_ * 256 + (stid - 128))); \
        if (stid < 16) X.g = *(const GAS v4u*)((const v4u*)(Dm.GAM + u_ * 64) + stid); } } while (0)
#define ST_STORE(X, buf_) do { LAS unsigned char* b_ = lds + (buf_) * RB_BUF; \
        *(LAS v4u*)(b_ + RB_PF + stid * 16) = X.p[0]; *(LAS v4u*)(b_ + RB_DD + stid * 16) = X.d[0]; \
        if (st_p2) { *(LAS v4u*)(b_ + RB_PF + (384 + stid) * 16) = X.p[1]; *(LAS v4u*)(b_ + RB_DD + (384 + stid) * 16) = X.d[1]; } \
        if (st_q) *(LAS v4u*)(b_ + RB_QF + stid * 16) = X.q; \
        if (st_y) *(LAS v4u*)(b_ + RB_YD + (stid - 128) * 16) = X.y; \
        if (stid < 16) *(LAS v4u*)(b_ + RB_GAM + stid * 16) = X.g; } while (0)
    const int ew = (wid & 1) + 2 * ((wid >> 2) & 1), eidx = ew * 64 + lane, etok = eidx >> 3, ep = eidx & 7;
    const bf16* epc = F.PROJ + (size_t)b * T * NP + h * 64 + 8 * ep;
#define EP_LOAD(X, cj_) do { { const int cc_ = (cj_) < NS ? (cj_) : NS - 1, tt_ = cc_ * 32 + etok; const bf16* pc_ = epc + (size_t)tt_ * NP; const bf16* pp_ = epc + (size_t)(tt_ > 0 ? tt_ - 1 : 0) * NP; \
        X.vc = *(const GAS v4u*)(pc_ + C_V); X.vp = *(const GAS v4u*)(pp_ + C_V); X.ga = *(const GAS v4u*)(pc_ + C_GA); \
        X.rho = Dm.RHO[((size_t)cc_ * (BATCH * RH) + bh) * 32 + etok]; } } while (0)
#define EP_RUN(X, cj_) do { const int par_ = (cj_) & 1; \
        const float s1_ = stat[((par_ * 2 + 0) * 32 + etok) * 2] + stat[((par_ * 2 + 1) * 32 + etok) * 2], s2_ = stat[((par_ * 2 + 0) * 32 + etok) * 2 + 1] + stat[((par_ * 2 + 1) * 32 + etok) * 2 + 1]; \
        const float mean_ = s1_ * (1.f / 64.f), var_ = fmaxf(s2_ * (1.f / 64.f) - mean_ * mean_, 0.f), rstd_ = __builtin_amdgcn_rsqf(var_ + 64e-5f); \
        const int tt_ = (cj_) * 32 + etok; const size_t mm_ = (size_t)b * T + tt_; const float pm_ = tt_ > 0 ? 1.f : 0.f; \
        const LAS float* yb_ = ybuf + (par_ * 2 + (ep >> 2)) * 1024 + 4 * (ep & 3) * 64 + etok; \
        float o_[8]; \
        _Pragma("unroll") for (int j = 0; j < 8; ++j) { const unsigned vcw_ = X.vc[j >> 1], vpw_ = X.vp[j >> 1], gaw_ = X.ga[j >> 1]; \
            const float vc_ = (j & 1) ? bfhi(vcw_) : bflo(vcw_), vp_ = (j & 1) ? bfhi(vpw_) : bflo(vpw_), g_ = (j & 1) ? bfhi(gaw_) : bflo(gaw_); \
            const float vv_ = vc_ + (vp_ * pm_ - vc_) * emu[j >> 2][j & 3]; \
            const float yn_ = (yb_[(j & 3) * 64 + (j >> 2) * 32] - mean_) * rstd_ * elw[j >> 2][j & 3] + elb[j >> 2][j & 3] + X.rho * vv_; o_[j] = yn_ * g_ * __builtin_amdgcn_rcpf(1.f + __expf(-g_)); } \
        *(GAS v4u*)(F.MIX + mm_ * D + h * 64 + 8 * ep) = (v4u){cvtpk(o_[0], o_[1]), cvtpk(o_[2], o_[3]), cvtpk(o_[4], o_[5]), cvtpk(o_[6], o_[7])}; } while (0)
    f32x16 S[2]; S[0] = f32x16{}; S[1] = f32x16{};
    const int ib = wid & 1;
#define CONS(ci_) do { const LAS unsigned char* bb = lds + ((ci_) & (RB_NB - 1)) * RB_BUF; \
          \
        v4u pf_[8], qf_[4], dd_[4], yd_[2]; f32x4 gm_[8]; \
        _Pragma("unroll") for (int q = 0; q < 8; ++q) gm_[q] = *(const LAS f32x4*)(bb + RB_GAM + (hi * 32 + 4 * q) * 4); \
        _Pragma("unroll") for (int q = 0; q < 4; ++q) dd_[q] = *(const LAS v4u*)(bb + RB_DD + ((((q >> 1) * 2 + ib) * 2 + (q & 1)) * 64 + lane) * 16); \
        _Pragma("unroll") for (int q = 0; q < 8; ++q) pf_[q] = *(const LAS v4u*)(bb + RB_PF + (q * 64 + lane) * 16); \
        _Pragma("unroll") for (int q = 0; q < 2; ++q) yd_[q] = *(const LAS v4u*)(bb + RB_YD + ((2 * ib + q) * 64 + lane) * 16); \
        _Pragma("unroll") for (int q = 0; q < 4; ++q) qf_[q] = *(const LAS v4u*)(bb + RB_QF + (q * 64 + lane) * 16); \
        __builtin_amdgcn_sched_barrier(0); \
        v4u Sf[4]; _Pragma("unroll") for (int s = 0; s < 4; ++s) Sf[s] = FRAGACC(S[s >> 1], s & 1); \
        _Pragma("unroll") for (int rb = 0; rb < 2; ++rb) { \
            f32x16 acc; unpack16(dd_[2 * rb], dd_[2 * rb + 1], acc); \
            _Pragma("unroll") for (int q = 0; q < 4; ++q) { const f32x4 gv = gm_[4 * rb + q]; _Pragma("unroll") for (int e = 0; e < 4; ++e) acc[4 * q + e] += gv[e] * S[rb][4 * q + e]; } \
            _Pragma("unroll") for (int s = 0; s < 4; ++s) acc = MFMA32(pf_[rb * 4 + s], Sf[s], acc); \
            S[rb] = acc; } \
        f32x16 y; unpack16(yd_[0], yd_[1], y); \
        _Pragma("unroll") for (int s = 0; s < 4; ++s) y = MFMA32(Sf[s], qf_[s], y); \
        float s1 = 0.f, s2 = 0.f; LAS float* yb_ = ybuf + (((ci_) & 1) * 2 + ib) * 1024 + lane; \
        _Pragma("unroll") for (int r = 0; r < 16; ++r) { s1 += y[r]; s2 += y[r] * y[r]; yb_[r * 64] = y[r]; } \
        s1 = swap32_sum(s1); s2 = swap32_sum(s2); \
        if (hi == 0) { stat[((((ci_) & 1) * 2 + ib) * 32 + l31) * 2] = s1; stat[((((ci_) & 1) * 2 + ib) * 32 + l31) * 2 + 1] = s2; } } while (0)
#define RB_BAR() do { asm volatile("s_waitcnt lgkmcnt(0)" ::: "memory"); __builtin_amdgcn_s_barrier(); asm volatile("" ::: "memory"); } while (0)
    if (wid < 2) {
        RB_BAR();
#pragma unroll 1
        for (int k = 0; k < NS; ++k) { CONS(k); RB_BAR(); }
        RB_BAR();
    } else if (wid == 4 || wid == 5) {
        const GAS v4u* gA = (const GAS v4u*)(wid == 4 ? Dm.PF : Dm.DD) + lane; const GAS v4u* gB = (const GAS v4u*)(wid == 4 ? Dm.QF : Dm.YD) + lane;
        const int oA = wid == 4 ? RB_PF : RB_DD, oB = wid == 4 ? RB_QF : RB_YD;
#define LD_ISSUE(ci_) do { const size_t u_ = (size_t)((ci_) < NS ? (ci_) : NS - 1) * (BATCH * RH) + bh; LAS unsigned char* b_ = lds + ((ci_) & (RB_NB - 1)) * RB_BUF; \
        _Pragma("unroll") for (int q = 0; q < 8; ++q) __builtin_amdgcn_global_load_lds((const unsigned*)(gA + u_ * 512 + q * 64), (LAS unsigned*)(b_ + oA + q * 1024), 16, 0, RB_AUX); \
        _Pragma("unroll") for (int q = 0; q < 4; ++q) __builtin_amdgcn_global_load_lds((const unsigned*)(gB + u_ * 256 + q * 64), (LAS unsigned*)(b_ + oB + q * 1024), 16, 0, RB_AUX); \
        if (lane < 16) __builtin_amdgcn_global_load_lds((const unsigned*)((const GAS v4u*)(Dm.GAM + u_ * 64) + lane), (LAS unsigned*)(b_ + RB_GAM), 16, 0, 0); } while (0)
        LD_ISSUE(0); LD_ISSUE(1); LD_ISSUE(2);
        asm volatile("s_waitcnt vmcnt(26)" ::: "memory");
        RB_BAR();
#pragma unroll 1
        for (int k = 0; k < NS; ++k) { LD_ISSUE(k + 3); asm volatile("s_waitcnt vmcnt(26)" ::: "memory"); RB_BAR(); }
        asm volatile("s_waitcnt vmcnt(0)" ::: "memory");
        RB_BAR();
#undef LD_ISSUE
    } else {
        RbEpi eA, eB, eC; f32x4 emu[2], elw[2], elb[2];
#pragma unroll
        for (int rg = 0; rg < 2; ++rg) { const int hc_ = h * 64 + 8 * ep + 4 * rg; emu[rg] = *(const GAS f32x4*)(F.shift_mu + 1024 + hc_); elw[rg] = *(const GAS f32x4*)(F.ln_w + hc_); elb[rg] = *(const GAS f32x4*)(F.ln_b + hc_); }
        EP_LOAD(eA, 0); EP_LOAD(eB, 1);
        RB_BAR();
        EP_LOAD(eC, 2); RB_BAR();
#define HY_STEP(k_, EP) do { EP_RUN(EP, (k_) - 1); EP_LOAD(EP, (k_) + 2); RB_BAR(); } while (0)
#pragma unroll 1
        for (int k = 1; k < NS; k += 3) { HY_STEP(k, eA); HY_STEP(k + 1, eB); HY_STEP(k + 2, eC); }
        EP_RUN(eA, NS - 1);
        RB_BAR();
#undef HY_STEP
    }
#undef RB_BAR
#undef ST_LOAD
#undef ST_STORE
#undef EP_LOAD
#undef EP_RUN
#undef CONS
}
constexpr int CW_G17 = 12288;
struct OneUnit { int pm, pn;
    __device__ __forceinline__ bool next(int i, pg8::Unit& u) const { if (i != 0) return false; u.pm = pm; u.pn = pn; return true; }
    __device__ __forceinline__ void a_ready(const pg8::Unit&) const {}
    __device__ __forceinline__ void done(const pg8::Unit&) const {} };
constexpr int AT_OUT = 65536, AT_G0 = 114688, AT_G1 = LDSCTL_OFF + 1024;
constexpr int AT_KB = 64 * 256, AT_VB = 64 * 256, AT_BUF = AT_KB + AT_VB, AT_QOFF = 2 * AT_KB + 3 * AT_VB;
__device__ __forceinline__ s16x4 vtr(const LAS unsigned char* p) { typedef short v4i16_t __attribute__((ext_vector_type(4))); return __builtin_bit_cast(s16x4, __builtin_amdgcn_ds_read_tr16_b64_v4i16((LAS v4i16_t*)p)); }
__device__ __forceinline__ void attn_unit(Frame& F, int b, int h, int qb) {
    int lane = mk_lane(); asm volatile("" : "+v"(lane));
    const int wid = F.wave, tid = wid * 64 + lane, l31 = lane & 31, hi = lane >> 5, map = wid >> 2, qs = wid & 3;
    LAS unsigned char* lds = F.lds + RING_OFF;
    const float slope2 = exp2f(-2.f * (float)(h + 1)) * LOG2E, shift2 = __uint_as_float(F.MISC[15]);
    const int q0 = qb * 128, qrow = q0 + 32 * qs + l31;
    const size_t mrow = (size_t)b * T + qrow;
    LAS bf16x8* qpark = (LAS bf16x8*)(lds + AT_QOFF + wid * 4096) + lane;
    { const bf16* qp = F.PROJ + mrow * NP + C_DQ + h * 128 + map * 64 + 8 * hi;
      v4u qraw[4]; float ss = 0.f;
#pragma unroll
      for (int s = 0; s < 4; ++s) qraw[s] = *(const GAS v4u*)(qp + 16 * s);
#pragma unroll
      for (int s = 0; s < 4; ++s)
#pragma unroll
          for (int j = 0; j < 4; ++j) { const float a_ = bflo(qraw[s][j]), b_ = bfhi(qraw[s][j]); ss += a_ * a_ + b_ * b_; }
      ss = swap32_sum(ss);
      const float rq = __builtin_amdgcn_rsqf(ss * (1.f / 64.f) + 1e-6f) * C2;
#pragma unroll
      for (int s = 0; s < 4; ++s) { const f32x4 g0 = *(const GAS f32x4*)(F.qn_g + 8 * hi + 16 * s), g1 = *(const GAS f32x4*)(F.qn_g + 8 * hi + 16 * s + 4);
          v4u w_; w_.x = cvtpk2(bflo(qraw[s].x) * rq * g0.x, bfhi(qraw[s].x) * rq * g0.y); w_.y = cvtpk2(bflo(qraw[s].y) * rq * g0.z, bfhi(qraw[s].y) * rq * g0.w);
          w_.z = cvtpk2(bflo(qraw[s].z) * rq * g1.x, bfhi(qraw[s].z) * rq * g1.y); w_.w = cvtpk2(bflo(qraw[s].w) * rq * g1.z, bfhi(qraw[s].w) * rq * g1.w);
          *(LAS v4u*)(qpark + s * 64) = w_; } }
    const bf16* kg = F.PROJ + (size_t)b * T * NP + C_DK + h * 128;
    const bf16* vg = F.PROJ + (size_t)b * T * NP + C_DV + h * 128;
    const int NT = 2 * qb + 2, tl = 2 * qb + (qs >> 1);
    const int Wk = (int)__builtin_ceilf((2.f * shift2 + 32.2f) / slope2);
    const int tf = __builtin_amdgcn_readfirstlane(max(0, (qb * 128 - Wk) >> 6));
    constexpr int AT_V0 = 2 * AT_KB;
    const int drow0 = 4 * wid + (lane >> 4), drow1 = drow0 + 32, dch = lane & 15;
    const unsigned ksrc0 = (unsigned)(drow0 * NP + ((dch ^ (drow0 & 15)) * 8)), ksrc1 = (unsigned)(drow1 * NP + ((dch ^ (drow1 & 15)) * 8));
    const unsigned vsrc0 = (unsigned)(drow0 * NP + ((dch ^ ((drow0 & 3) << 2)) * 8)), vsrc1 = (unsigned)(drow1 * NP + ((dch ^ ((drow1 & 3) << 2)) * 8));
#define AT_DMA(t_, kb_, v3_) do { const size_t tb_ = (size_t)(64 * (t_)) * NP; LAS unsigned char* bk_ = lds + (kb_) * AT_KB + wid * 1024; LAS unsigned char* bv_ = lds + AT_V0 + (v3_) * AT_VB + wid * 1024; \
        __builtin_amdgcn_global_load_lds((const unsigned*)(kg + tb_ + ksrc0), (LAS unsigned*)bk_, 16, 0, 0); __builtin_amdgcn_global_load_lds((const unsigned*)(kg + tb_ + ksrc1), (LAS unsigned*)(bk_ + 8192), 16, 0, 0); \
        __builtin_amdgcn_global_load_lds((const unsigned*)(vg + tb_ + vsrc0), (LAS unsigned*)bv_, 16, 0, 0); __builtin_amdgcn_global_load_lds((const unsigned*)(vg + tb_ + vsrc1), (LAS unsigned*)(bv_ + 8192), 16, 0, 0); } while (0)
    f32x16 o[4];
#pragma unroll
    for (int vb = 0; vb < 4; ++vb) o[vb] = f32x16{};
    float lsum = 0.f;
    AT_DMA(tf, tf & 1, tf % 3);
    { const int gr_ = 16 * wid + (lane >> 4); const bf16* gsrc = F.PROJ + ((size_t)b * T + q0 + gr_) * NP + C_GB + h * 128;
      LAS unsigned char* gdst = F.lds + (wid < 4 ? AT_G0 + wid * 4096 : AT_G1 + (wid - 4) * 4096);
#pragma unroll
      for (int j = 0; j < 4; ++j) __builtin_amdgcn_global_load_lds((const unsigned*)(gsrc + (size_t)(4 * j) * NP + (((lane & 15) ^ (4 * j + (lane >> 4))) * 8)), (LAS unsigned*)(gdst + j * 1024), 16, 0, 0); }
    __syncthreads();
    const int G = lane >> 4, qq = (lane & 15) >> 2, pp = lane & 3;
    const int vrow = (4 * hi + qq) * 256 + 8 * (pp & 1), vch = 2 * (G & 1) + (pp >> 1);
    v4u pw[4];
#define SBAR_() __builtin_amdgcn_sched_barrier(0)
#define AT_QK(t) do { \
            const LAS unsigned char* Kb = lds + ((t) & 1) * AT_KB; \
            float sl_ = slope2; asm volatile("" : "+v"(sl_));     \
            const float base = sl_ * (float)(64 * (t) + 4 * hi - qrow) - shift2; \
            float ls = 0.f; \
            _Pragma("unroll") for (int hf = 0; hf < 2; ++hf) {        \
                f32x16 p; \
                _Pragma("unroll") for (int r = 0; r < 16; ++r) p[r] = __builtin_fmaf(sl_, (float)(32 * hf + (r & 3) + 8 * (r >> 2)), base); \
                _Pragma("unroll") for (int s = 0; s < 4; ++s) { \
                    const bf16x8 a0 = *(const LAS bf16x8*)(Kb + (32 * hf + l31) * 256 + (((map * 8 + 2 * s + hi) ^ (l31 & 15)) * 16)); \
                    p = __builtin_amdgcn_mfma_f32_32x32x16_bf16(a0, qpark[s * 64], p, 0, 0, 0); } \
                if ((t) == tl) { \
                    _Pragma("unroll") for (int r = 0; r < 16; ++r) { const int ki = 64 * (t) + 32 * hf + 4 * hi + (r & 3) + 8 * (r >> 2); if (ki > qrow) p[r] = -1e30f; } } \
                _Pragma("unroll") for (int r = 0; r < 16; ++r) { p[r] = __builtin_amdgcn_exp2f(p[r]); ls += p[r]; } \
                pw[2 * hf] = (v4u){cvtpk(p[0], p[1]), cvtpk(p[2], p[3]), cvtpk(p[4], p[5]), cvtpk(p[6], p[7])}; \
                pw[2 * hf + 1] = (v4u){cvtpk(p[8], p[9]), cvtpk(p[10], p[11]), cvtpk(p[12], p[13]), cvtpk(p[14], p[15])}; } \
            lsum += ls; } while (0)
#define AT_VRD(dst, ks, vb0) do { _Pragma("unroll") for (int vb = (vb0); vb < (vb0) + 2; ++vb) { const LAS unsigned char* a_ = Vb + vrow + ((4 * vb + vch) ^ (qq << 2)) * 16 + (32 * ((ks) >> 1) + 16 * ((ks) & 1)) * 256; \
        dst[2 * (vb - (vb0))] = vtr(a_); dst[2 * (vb - (vb0)) + 1] = vtr(a_ + 8 * 256); } } while (0)
#define AT_PV(src, pwk, vb0) do { _Pragma("unroll") for (int vb = (vb0); vb < (vb0) + 2; ++vb) { const int j_ = 2 * (vb - (vb0)); \
        const bf16x8 vf = (bf16x8){src[j_][0], src[j_][1], src[j_][2], src[j_][3], src[j_ + 1][0], src[j_ + 1][1], src[j_ + 1][2], src[j_ + 1][3]}; \
        o[vb] = __builtin_amdgcn_mfma_f32_32x32x16_bf16(vf, __builtin_bit_cast(bf16x8, pwk), o[vb], 0, 0, 0); } } while (0)
#define AT_PVV(v3_) do { const LAS unsigned char* Vb = lds + AT_V0 + (v3_) * AT_VB; s16x4 vA[4], vB[4]; \
            AT_VRD(vA, 0, 0); SBAR_(); AT_VRD(vB, 0, 2); SBAR_(); \
            AT_PV(vA, pw[0], 0); SBAR_(); AT_VRD(vA, 1, 0); SBAR_(); AT_PV(vB, pw[0], 2); SBAR_(); AT_VRD(vB, 1, 2); SBAR_(); \
            AT_PV(vA, pw[1], 0); SBAR_(); AT_VRD(vA, 2, 0); SBAR_(); AT_PV(vB, pw[1], 2); SBAR_(); AT_VRD(vB, 2, 2); SBAR_(); \
            AT_PV(vA, pw[2], 0); SBAR_(); AT_VRD(vA, 3, 0); SBAR_(); AT_PV(vB, pw[2], 2); SBAR_(); AT_VRD(vB, 3, 2); SBAR_(); \
            AT_PV(vA, pw[3], 0); SBAR_(); AT_PV(vB, pw[3], 2); } while (0)
    if (map == 0) {
        int v3 = tf % 3;
#pragma unroll 1
        for (int t = tf; t < NT; ++t) { const int vn = v3 == 2 ? 0 : v3 + 1;
            if (t + 1 < NT) AT_DMA(t + 1, (t + 1) & 1, vn);
            if (t <= tl) { AT_QK(t); AT_PVV(v3); }
            __syncthreads(); v3 = vn; }
    } else {
        int v3 = tf % 3;
#pragma unroll 1
        for (int t = tf; t < NT; ++t) { const int vp = v3 == 0 ? 2 : v3 - 1, vn = v3 == 2 ? 0 : v3 + 1;
            if (t + 1 < NT) AT_DMA(t + 1, (t + 1) & 1, vn);
            if (t > tf && t - 1 <= tl) AT_PVV(vp);
            if (t <= tl) AT_QK(t);
            __syncthreads(); v3 = vn; }
        if (NT - 1 <= tl) { const int vp = v3 == 0 ? 2 : v3 - 1; AT_PVV(vp); }
    }
#undef AT_PVV
#undef AT_QK
#undef AT_VRD
#undef AT_PV
#undef SBAR_
#undef AT_DMA
    __syncthreads();
    const float ltot = swap32_sum(lsum);
    LAS float* X = (LAS float*)lds;
    if (map == 1) {
        const float sc = __uint_as_float(F.MISC[14]) / ltot;
#pragma unroll
        for (int vb = 0; vb < 4; ++vb)
#pragma unroll
            for (int r = 0; r < 16; ++r) X[(qs * 64 + vb * 16 + r) * 64 + lane] = o[vb][r] * sc;
    }
    __syncthreads();
    if (map == 0) {
        const float il = 1.f / ltot; float ss = 0.f;
#pragma unroll
        for (int vb = 0; vb < 4; ++vb)
#pragma unroll
            for (int r = 0; r < 16; ++r) { const float v = o[vb][r] * il - X[(qs * 64 + vb * 16 + r) * 64 + lane]; o[vb][r] = v; ss += v * v; }
        ss = swap32_sum(ss);
        const float rn = (1.f / sqrtf(ss * (1.f / 128.f) + 1e-5f)) * (1.f - LAMBDA_INIT);
        int etok = 0; asm volatile("" : "+v"(etok));
        const int lane_e = mk_lane(), hi = lane_e >> 5, row = 32 * qs + (lane_e & 31);
        const LAS unsigned char* grow = F.lds + (qs < 2 ? AT_G0 : AT_G1 - 64 * 256) + row * 256 + 8 * hi;
        LAS unsigned char* orow = lds + AT_OUT + row * 256 + 8 * hi;
#pragma unroll
        for (int vb = 0; vb < 4; ++vb)
#pragma unroll
            for (int rg = 0; rg < 4; ++rg) {
                const int vc = 32 * vb + 8 * rg + 4 * hi, ch = (((4 * vb + rg) ^ (row & 15)) * 16) + etok;
                const v2u gw = *(const LAS v2u*)(grow + ch); const f32x4 sg = *(const GAS f32x4*)(F.subln_g + vc);
                const float g4[4] = {bflo(gw.x), bfhi(gw.x), bflo(gw.y), bfhi(gw.y)}; float ov[4];
#pragma unroll
                for (int e = 0; e < 4; ++e) ov[e] = o[vb][4 * rg + e] * rn * sg[e] * g4[e] / (1.f + __expf(-g4[e]));
                const unsigned w1_ = cvtpk(ov[2], ov[3]);
                *(LAS v2u*)(orow + ch) = (v2u){cvtpk(ov[0], ov[1]), w1_};
                if (rg == 3) asm volatile("" : "+v"(etok) : "v"(w1_));
            }
    }
    __syncthreads();
    { const int t_ = wid * 64 + mk_lane(); bf16* ob = F.MIX + ((size_t)b * T + q0) * D + 512 + h * 128;
#pragma unroll
      for (int i = 0; i < 4; ++i) { const int pc = t_ + 512 * i, r_ = pc >> 4, c_ = pc & 15;
          *(GAS v4u*)(ob + (size_t)r_ * D + c_ * 8) = *(const LAS v4u*)(lds + AT_OUT + r_ * 256 + ((c_ ^ (r_ & 15)) * 16)); } }
    __syncthreads();
}
#ifndef DBL
#define DBL 0
#endif
constexpr int CW_QUEUE = 8192;
constexpr int QX_RW = 8, QX_A2 = 0, QX_AT = 64, QX_ALL = QX_RW + QX_A2 + QX_AT;
template <int MODE = 0> __device__ __forceinline__ void p3_queue(Frame& F, const RwDump& Dm, const int qbase = CW_QUEUE) {
    const int ql = mk_lane();
    const float l1 = wave_sum(F.lq1[ql] * F.lk1[ql]), l2 = wave_sum(F.lq2[ql] * F.lk2[ql]);
    const float lam = __uint_as_float(__builtin_amdgcn_readfirstlane(__float_as_uint(__expf(l1) - __expf(l2) + LAMBDA_INIT)));
    float gq = fabsf(F.qn_g[ql]), gk = fabsf(F.kn_g[ql]);
#pragma unroll
    for (int o = 1; o < 64; o <<= 1) { gq = fmaxf(gq, __shfl_xor(gq, o)); gk = fmaxf(gk, __shfl_xor(gk, o)); }
    const float shift2 = __uint_as_float(__builtin_amdgcn_readfirstlane(__float_as_uint(8.f * gq * gk * LOG2E)));
    if (F.wave == 0 && mk_lane() == 0) { F.MISC[14] = __float_as_uint(lam); F.MISC[15] = __float_as_uint(shift2); }
    __syncthreads();
#ifdef Q_BLK
    const int x0 = (int)(blockIdx.x & 7);
#else
    const int x0 = (int)(xb_xcc_id() & 7u);
#endif
#pragma unroll 1
    for (int dx = 0; dx < 8; ++dx) {
        const int xq = (x0 + dx) & 7;
        for (;;) {
            if (F.wave == 0 && mk_lane() == 0) F.MISC[12] = __hip_atomic_fetch_add(F.ctl + qbase + 64 * xq, 1u, RLX_AGENT);
            __syncthreads();
            int item = __builtin_amdgcn_readfirstlane((int)F.MISC[12]); if (MODE == 2) item += QX_RW;
            __syncthreads();
            if (item >= (MODE == 1 ? QX_RW : QX_ALL)) break;
            if (item < QX_RW) { rwkvB_unit(F, Dm, xq * 8 + item); if (DBL & 64) rwkvB_unit(F, Dm, xq * 8 + item); }
            else { const int idx = item - QX_RW - QX_A2, h = 3 - (idx >> 4), qb = 15 - (idx & 15);
#pragma unroll 1
#ifndef NO_ATT
                for (int rep = 0; rep < ((DBL & 32) ? 2 : 1); ++rep) attn_unit(F, xq, h, qb);
#endif
            }
        }
    }
}

constexpr int GT_STAGE = 40960, GT_NS = 3, GT_NK = D / 64;
__device__ __forceinline__ void gemm1_tail_unit(Frame& F, int qu) {
    int lane = mk_lane(); asm volatile("" : "+v"(lane));
    const int wid = F.wave, l31 = lane & 31, hi = lane >> 5;
    const int xcd = qu & 7, j = qu >> 3, R0 = (8 * xcd + (j & 7)) * 256 + (j >> 3) * 64;
    LAS unsigned char* lds = F.lds + RING_OFF;
    const int vr0 = 40 * wid + (lane >> 3), cp = lane & 7;
#define GT_ISSUE(kc_) do { LAS unsigned char* sb_ = lds + ((kc_) % GT_NS) * GT_STAGE + wid * 5120; \
        _Pragma("unroll") for (int i = 0; i < 5; ++i) { const int v_ = vr0 + 8 * i; \
            const bf16* src_ = (5 * wid + i < 8 ? F.XN + (size_t)(R0 + v_) * D : F.WinT + (size_t)(4096 + v_ - 64) * D) + (kc_) * 64 + ((cp ^ ((v_ >> 1) & 7)) * 8); \
            __builtin_amdgcn_global_load_lds((const unsigned*)src_, (LAS unsigned*)(sb_ + i * 1024), 16, 0, 0); } } while (0)
    f32x16 acc0 = f32x16{}, acc1 = f32x16{};
    const int nW = 32 * wid + l31, offW = 8192 + nW * 128, kyW = (nW >> 1) & 7, offX0 = l31 * 128, offX1 = (32 + l31) * 128, kyX = (l31 >> 1) & 7;
    GT_ISSUE(0); GT_ISSUE(1);
#pragma unroll 1
    for (int kc = 0; kc < GT_NK; ++kc) {
        if (kc + 1 < GT_NK) asm volatile("s_waitcnt vmcnt(5)" ::: "memory"); else asm volatile("s_waitcnt vmcnt(0)" ::: "memory");
        __builtin_amdgcn_s_barrier(); asm volatile("" ::: "memory");
        if (kc + 2 < GT_NK) GT_ISSUE(kc + 2);
        const LAS unsigned char* sb = lds + (kc % GT_NS) * GT_STAGE;
        v4u wf[4], x0[4], x1[4];
#pragma unroll
        for (int s = 0; s < 4; ++s) { wf[s] = *(const LAS v4u*)(sb + offW + (((2 * s + hi) ^ kyW) * 16)); x0[s] = *(const LAS v4u*)(sb + offX0 + (((2 * s + hi) ^ kyX) * 16)); x1[s] = *(const LAS v4u*)(sb + offX1 + (((2 * s + hi) ^ kyX) * 16)); }
#pragma unroll
        for (int s = 0; s < 4; ++s) { acc0 = MFMA32(wf[s], x0[s], acc0); acc1 = MFMA32(wf[s], x1[s], acc1); }
        asm volatile("s_waitcnt lgkmcnt(0)" ::: "memory");
    }
#undef GT_ISSUE
    bf16* op = F.PROJ + (size_t)(R0 + l31) * NP + 4096 + 32 * wid + 4 * hi;
#pragma unroll
    for (int q = 0; q < 4; ++q) {
        *(GAS v2u*)(op + 8 * q) = (v2u){cvtpk(acc0[4 * q], acc0[4 * q + 1]), cvtpk(acc0[4 * q + 2], acc0[4 * q + 3])};
        *(GAS v2u*)(op + (size_t)32 * NP + 8 * q) = (v2u){cvtpk(acc1[4 * q], acc1[4 * q + 1]), cvtpk(acc1[4 * q + 2], acc1[4 * q + 3])}; }
    __syncthreads();
}
struct Args { const float* in[21]; float* out; unsigned char* ws; int ph_lo, ph_hi; };
__global__ void __launch_bounds__(NWAVES * 64, 2) hymba_fwd(Args args) {
    extern __shared__ __attribute__((aligned(16))) unsigned char lds[];
    Frame F;
    F.lds = (LAS unsigned char*)lds;
    F.MISC = (volatile LAS unsigned*)(F.lds + MISC_OFF);
    F.wave = __builtin_amdgcn_readfirstlane((int)threadIdx.x >> 6); F.lane = mk_lane(); F.tid = F.wave * 64 + F.lane;
    F.G = gridDim.x; { const int bx = blockIdx.x; F.vcu = (F.G % 8 == 0) ? (bx % 8) * (F.G / 8) + bx / 8 : bx; }
    unsigned char* ws = args.ws;
    F.ctl = (gu32*)(ws + WS_CTL);
    F.x = args.in[0]; F.norm_g = args.in[1]; F.w_in = args.in[2]; F.shift_mu = args.in[3]; F.w0 = args.in[4]; F.w_decay_up = args.in[5]; F.a0 = args.in[6]; F.w_iclr_up = args.in[7];
    F.k_k = args.in[8]; F.k_a = args.in[9]; F.r_k = args.in[10]; F.ln_w = args.in[11]; F.ln_b = args.in[12]; F.qn_g = args.in[13]; F.kn_g = args.in[14];
    F.lq1 = args.in[15]; F.lk1 = args.in[16]; F.lq2 = args.in[17]; F.lk2 = args.in[18]; F.subln_g = args.in[19]; F.w_out = args.in[20]; F.out = args.out;
    F.WinT = (bf16*)(ws + WS_WIN); F.WoutT = (bf16*)(ws + WS_WOUT); F.WdT = (bf16*)(ws + WS_WD); F.WaT = (bf16*)(ws + WS_WA);
    F.XN = (bf16*)(ws + WS_XN); F.PROJ = (bf16*)(ws + WS_PROJ); F.MIX = (bf16*)(ws + WS_MIX);
    for (int u = F.tid; u < (LDS_BYTES - LDSCTL_OFF) / 4; u += NWAVES * 64) ((LAS unsigned*)(F.lds + LDSCTL_OFF))[u] = 0u;
    __syncthreads();
    XcdBarrier bar; bar.bar = (unsigned*)(F.ctl + CW_BAR); bar.x = 0; bar.st = nullptr; bar.wave = F.wave;
    if (MK_N_LAUNCHES == 1) bar = xcd_barrier_post((unsigned*)(F.ctl + CW_BAR), F.MISC + 8, F.wave);
#define GRID_BAR() do { if (MK_N_LAUNCHES == 1) xcd_barrier(bar); } while (0)
    const int lo = args.ph_lo, hi = args.ph_hi;
#define IN(k) (lo <= (k) && (k) < hi)
#define BOTH(k) (IN(k) && IN((k) + 1))
#ifndef SKIP
#define SKIP 0
#endif
    if (IN(0) && !(SKIP & 1)) { p0_prologue(F); if (DBL & 1) { GRID_BAR(); p0_prologue(F); } if (BOTH(0)) GRID_BAR(); }
    if (IN(1) && !(SKIP & 2)) {
        pg8::Gemm g{F.XN, F.WinT, M, 4096, D}; pg8::StaticOrder S; S.init(M, 4096, F.G, (int)blockIdx.x);
        pg8::EpiBf16S E{F.PROJ, NP};
        pg8::gemm_phase<pg8::EpiBf16S, pg8::StaticOrder, true, true>(F.lds + RING_OFF, g, S, E, F.wave);
#pragma unroll 1
        for (int qu = (int)blockIdx.x; qu < 256; qu += F.G) gemm1_tail_unit(F, qu);
#ifdef TAILX2
#pragma unroll 1
        for (int rep = 0; rep < TAILX2; ++rep) {
#pragma unroll 1
        for (int qu = (int)blockIdx.x; qu < 256; qu += F.G) gemm1_tail_unit(F, qu); }
#endif
        if (DBL & 2) { GRID_BAR(); pg8::gemm_phase<pg8::EpiBf16S, pg8::StaticOrder, true, true>(F.lds + RING_OFF, g, S, E, F.wave); }
        if (BOTH(1)) GRID_BAR();
    }
    RwDump Dm; { unsigned char* so = (unsigned char*)args.out; Dm.PF = (v4u*)so; Dm.DD = (v4u*)(so + 32 * MiB); Dm.QF = (v4u*)(ws + WS_XN); Dm.YD = (v4u*)(ws + WS_XN + 16 * MiB);
        Dm.GAM = (float*)(ws + WS_END); Dm.RHO = (float*)(ws + WS_END + 1 * MiB); }
    if (IN(2) && !(SKIP & 4)) {
        LAS float* wscr = (LAS float*)(F.lds + LDSCTL_OFF + 1024) + F.wave * 64; int zpar = 0;
#pragma unroll 1
        for (int p = F.vcu; p < BATCH * (T / 32); p += F.G) { rwkvA_unit(F, Dm, (p >> 6) * RH + F.wave, p & 63, wscr, F.lds + RING_OFF + F.wave * 16384, (LAS v4u*)(F.lds + LDSCTL_OFF + 4096), zpar); zpar ^= 1; }
        if (DBL & 4) { GRID_BAR();
#pragma unroll 1
            for (int p = F.vcu; p < BATCH * (T / 32); p += F.G) { rwkvA_unit(F, Dm, (p >> 6) * RH + F.wave, p & 63, wscr, F.lds + RING_OFF + F.wave * 16384, (LAS v4u*)(F.lds + LDSCTL_OFF + 4096), zpar); zpar ^= 1; } }
        p2_qknorm(F);
        if (BOTH(2)) GRID_BAR();
    }
    if (IN(3) && !(SKIP & 8)) {
#ifdef P3SPLIT
        p3_queue<1>(F, Dm); GRID_BAR(); p3_queue<2>(F, Dm, CW_QUEUE + 1024);
#else
        p3_queue(F, Dm);
#endif
        if (DBL & 512) { GRID_BAR(); p3_queue(F, Dm, CW_QUEUE + 1024); }
        if (BOTH(3)) GRID_BAR();
    }
    if (IN(4) && !(SKIP & 16)) {
        pg8::Gemm g{F.MIX, F.WoutT, M, D, D}; pg8::StaticOrder S; S.init(M, D, F.G, (int)blockIdx.x);
        pg8::EpiResF32 E{F.x, F.out, D};
        pg8::gemm_phase<pg8::EpiResF32, pg8::StaticOrder, false, true>(F.lds + RING_OFF, g, S, E, F.wave);
        if (DBL & 16) { GRID_BAR(); pg8::gemm_phase<pg8::EpiResF32, pg8::StaticOrder, false, true>(F.lds + RING_OFF, g, S, E, F.wave); }
    }
#undef IN
#undef BOTH
}

extern "C" void kernel_launch(void* const* d_in, const int* in_sizes, int n_in, void* d_out, int out_size, void* d_ws, size_t ws_size, hipStream_t stream) {
    static int grid = 0;
    if (grid == 0) {
        if (n_in != 21 || in_sizes[0] != M * D || out_size != M * D || ws_size < WS_END + 2 * MiB) { fprintf(stderr, "kernel_launch: unexpected shapes (n_in %d, in0 %d, out %d, ws %zu); nothing launched\n", n_in, n_in > 0 ? in_sizes[0] : -1, out_size, ws_size); grid = -1; return; }
        int dev = 0, cus = 0, per_cu = 0;
        if (hipGetDevice(&dev) != hipSuccess || hipDeviceGetAttribute(&cus, hipDeviceAttributeMultiprocessorCount, dev) != hipSuccess) { grid = -1; return; }
        if (hipFuncSetAttribute((const void*)hymba_fwd, hipFuncAttributeMaxDynamicSharedMemorySize, LDS_BYTES) != hipSuccess) { fprintf(stderr, "kernel_launch: hipFuncSetAttribute failed\n"); grid = -1; return; }
        if (hipOccupancyMaxActiveBlocksPerMultiprocessor(&per_cu, (const void*)hymba_fwd, NWAVES * 64, LDS_BYTES) != hipSuccess || per_cu < 1) { fprintf(stderr, "kernel_launch: occupancy query reports %d workgroups per CU; nothing launched\n", per_cu); grid = -1; return; }
        (void)hipGetLastError();
        grid = cus;
        if (grid > 256) grid = 256;
    }
    if (grid < 0) return;
    if (hipMemsetAsync((char*)d_ws + WS_CTL, 0, CTL_ZERO_BYTES, stream) != hipSuccess) { fprintf(stderr, "kernel_launch: hipMemsetAsync failed\n"); return; }
    Args a{};
    for (int i = 0; i < 21; ++i) a.in[i] = (const float*)d_in[i];
    a.out = (float*)d_out; a.ws = (unsigned char*)d_ws;
    for (int li = 0; li < MK_N_LAUNCHES; ++li) {
        a.ph_lo = (MK_N_LAUNCHES == 1) ? 0 : li; a.ph_hi = (MK_N_LAUNCHES == 1) ? N_PHASES : li + 1;
        hipLaunchKernelGGL(hymba_fwd, dim3(grid), dim3(NWAVES * 64), LDS_BYTES, stream, a);
        const hipError_t le = hipPeekAtLastError();
        if (le != hipSuccess) { fprintf(stderr, "kernel_launch: launch %d failed: %s\n", li, hipGetErrorName(le)); break; }
    }
}
```

```cpp
#include <hip/hip_runtime.h>
#include <hip/hip_bf16.h>
#include <cstdio>
#include <cstdint>
#include <cmath>
namespace pg8 {
#define PG8_LAS __attribute__((address_space(3)))
typedef unsigned short bf16_t;
typedef short bf16x8 __attribute__((ext_vector_type(8)));
typedef float f32x4 __attribute__((ext_vector_type(4)));
typedef unsigned u32x4 __attribute__((ext_vector_type(4)));
constexpr int BM = 256, BK = 64, HALF = 128, HTB = HALF * BK * 2  , STAGE_BYTES = 8 * HTB, NXCD = 8, WGM = 8;

__host__ __device__ __forceinline__ int lds_byte(int r, int c) { const int st = (r >> 4) * 2 + (c >> 5), rr = r & 15, cc = c & 31, ob = rr * 64 + cc * 2; return st * 1024 + (ob ^ (((ob >> 9) & 1) << 5)); }
__host__ __device__ __forceinline__ void stage_rc(int b, int& R, int& C) { const int st = b / 1024, sb = b % 1024, swz = sb ^ (((sb >> 9) & 1) << 5); R = (st >> 1) * 16 + swz / 64; C = (st & 1) * 32 + (swz % 64) / 2; }
__host__ __device__ __forceinline__ int perm32(int rho) { const int n = rho >> 4, i = rho & 15; return 8 * (i >> 2) + 4 * n + (i & 3); }

__device__ __forceinline__ int mk_lane_pg8() { int l; asm volatile("v_mbcnt_lo_u32_b32 %0, -1, 0\n\tv_mbcnt_hi_u32_b32 %0, -1, %0" : "=v"(l)); return l; }
struct Unit { int pm, pn; };
struct Gemm { const bf16_t* A; const bf16_t* Bt; int M, N, K; };

struct StaticOrder {
    int nM, nN, nwg, G, c;
    __host__ __device__ void init(int M, int N, int G_, int c_) { nM = M / BM; nN = N / BM; nwg = nM * nN; G = G_; c = c_; }
    __host__ __device__ bool next(int i, Unit& u) const {
        const long L = (long)i * G + c; if (L >= nwg) return false;
        int wgid = (int)L; { const int q = nwg / NXCD, r = nwg % NXCD, xcd = wgid % NXCD, off = wgid / NXCD; wgid = (xcd < r ? xcd * (q + 1) : r * (q + 1) + (xcd - r) * q) + off; }
        const int nig = WGM * nN, gid = wgid / nig, fm = gid * WGM, gsz = (nM - fm) < WGM ? (nM - fm) : WGM;
        u.pm = fm + ((wgid % nig) % gsz); u.pn = (wgid % nig) / gsz; return true;
    }
    __device__ __forceinline__ void a_ready(const Unit&) const {}
    __device__ __forceinline__ void done(const Unit&) const {}
};

__device__ __forceinline__ unsigned cvt_pk_bf16(float lo, float hi) { unsigned r; asm volatile("v_cvt_pk_bf16_f32 %0, %1, %2" : "=v"(r) : "v"(lo), "v"(hi)); return r; }
struct EpiBf16S {
    static constexpr bool PERM = true, AFTER_DRAIN = false, HAS_INIT = false;
    bf16_t* O; int ldc;
    __device__ __forceinline__ void operator()(const f32x4 (&acc)[2][2][4][2], const Unit& u, int wr, int wc, int fr, int fq) const {
        const int row0 = u.pm * BM + wr * 64 + fr, col0 = u.pn * BM + wc * 32 + 8 * fq;
#pragma unroll
        for (int ai = 0; ai < 2; ++ai)
#pragma unroll
            for (int m = 0; m < 4; ++m) { bf16_t* rowp = O + (size_t)(row0 + ai * HALF + m * 16) * ldc + col0;
#pragma unroll
                for (int bj = 0; bj < 2; ++bj) { const f32x4 v0 = acc[ai][bj][m][0], v1 = acc[ai][bj][m][1];
                    u32x4 w; w.x = cvt_pk_bf16(v0[0], v0[1]); w.y = cvt_pk_bf16(v0[2], v0[3]); w.z = cvt_pk_bf16(v1[0], v1[1]); w.w = cvt_pk_bf16(v1[2], v1[3]);
                    *(u32x4*)(rowp + bj * HALF) = w; } }
    }
};
struct EpiResF32 {
    static constexpr bool PERM = false, AFTER_DRAIN = false, HAS_INIT = true;
    const float* base; float* out; int ldc;
    __device__ __forceinline__ void init(f32x4 (&acc)[2][2][4][2], const Unit& u, int wr, int wc, int fr, int fq) const {
        const int row0 = u.pm * BM + wr * 64 + fr, col0 = u.pn * BM + wc * 32 + 4 * fq;
#pragma unroll
        for (int ai = 0; ai < 2; ++ai)
#pragma unroll
            for (int m = 0; m < 4; ++m) { const size_t off = (size_t)(row0 + ai * HALF + m * 16) * ldc + col0;
#pragma unroll
                for (int bj = 0; bj < 2; ++bj)
#pragma unroll
                    for (int n = 0; n < 2; ++n) acc[ai][bj][m][n] = *(const f32x4*)(base + off + bj * HALF + n * 16); }
    }
    __device__ __forceinline__ void operator()(const f32x4 (&acc)[2][2][4][2], const Unit& u, int wr, int wc, int fr, int fq) const {
        const int row0 = u.pm * BM + wr * 64 + fr, col0 = u.pn * BM + wc * 32 + 4 * fq;
#pragma unroll
        for (int ai = 0; ai < 2; ++ai)
#pragma unroll
            for (int m = 0; m < 4; ++m) { const size_t off = (size_t)(row0 + ai * HALF + m * 16) * ldc + col0;
#pragma unroll
                for (int bj = 0; bj < 2; ++bj)
#pragma unroll
                    for (int n = 0; n < 2; ++n) *(f32x4*)(out + off + bj * HALF + n * 16) = acc[ai][bj][m][n]; }
    }
};
template <class Epi, class Sched, bool ALIGN_EPI = false, bool SP2 = false>
__device__ __forceinline__ void gemm_phase(PG8_LAS unsigned char* lds, const Gemm g, const Sched& S, const Epi& E, const int mk_wave_id  ) {
    const int wid = mk_wave_id, lane = mk_lane_pg8(), tid = wid * 64 + lane, wr = wid >> 2, wc = wid & 3, fr = lane & 15, fq = lane >> 4;
    const int K = g.K, nt = K / BK;
    unsigned voffA[2], voffB[2];
#pragma unroll
    for (int i = 0; i < 2; ++i) { int R, C; stage_rc(tid * 16 + i * 8192, R, C); const int Rb = Epi::PERM ? ((R & ~31) + perm32(R & 31)) : R;
        voffA[i] = (unsigned)(R * K + C) * 2u; voffB[i] = (unsigned)(Rb * K + C) * 2u; }
    const size_t kstep = (size_t)(BK * 2);
    const size_t hstep = (size_t)HALF * K * 2;
    const size_t tstep = 2 * hstep;
    const unsigned ldsw = (unsigned)wid * 1024u;
    const int aoff = lds_byte(wr * 64 + fr, fq * 8), boff = lds_byte(wc * 32 + fr, fq * 8);
#define PG8_SA(b, h) (((b) * 2 + (h)) * HTB)
#define PG8_SB(b, h) ((4 + (b) * 2 + (h)) * HTB)
#define PG8_STAGE(bufoff, gbase, voff) do { _Pragma("unroll") for (int _i = 0; _i < 2; ++_i) \
        __builtin_amdgcn_global_load_lds((const unsigned*)((const char*)(gbase) + (voff)[_i]), (PG8_LAS unsigned*)(lds + (bufoff) + ldsw + _i * 8192), 16, 0, 0); } while (0)
#define PG8_LDA(dst, b, h) do { _Pragma("unroll") for (int m = 0; m < 4; ++m) _Pragma("unroll") for (int k = 0; k < 2; ++k) dst[m][k] = *(const PG8_LAS bf16x8*)(lds + PG8_SA(b, h) + aoff + m * 2048 + k * 1024); } while (0)
#define PG8_LDB(dst, b, h) do { _Pragma("unroll") for (int n = 0; n < 2; ++n) _Pragma("unroll") for (int k = 0; k < 2; ++k) dst[n][k] = *(const PG8_LAS bf16x8*)(lds + PG8_SB(b, h) + boff + n * 2048 + k * 1024); } while (0)
#define PG8_MMA(ai, bj, At, Bt) do { __builtin_amdgcn_s_setprio(1); _Pragma("unroll") for (int m = 0; m < 4; ++m) _Pragma("unroll") for (int n = 0; n < 2; ++n) _Pragma("unroll") for (int k = 0; k < 2; ++k) \
        acc[ai][bj][m][n] = __builtin_amdgcn_mfma_f32_16x16x32_bf16(Bt[n][k], At[m][k], acc[ai][bj][m][n], 0, 0, 0); __builtin_amdgcn_s_setprio(0); } while (0)
#define PG8_WAIT_V(n) asm volatile("s_waitcnt vmcnt(" #n ")" ::: "memory")
#define PG8_WAIT_L(n) asm volatile("s_waitcnt lgkmcnt(" #n ")" ::: "memory")
#define PG8_BAR __builtin_amdgcn_s_barrier()
#define PG8_SCHED __builtin_amdgcn_sched_barrier(0)
    Unit cur, nxt; int ui = 0;
    if (!S.next(0, cur)) return;
    f32x4 acc[2][2][4][2];
#pragma unroll
    for (int a = 0; a < 2; ++a)
#pragma unroll
        for (int b = 0; b < 2; ++b)
#pragma unroll
            for (int m = 0; m < 4; ++m)
#pragma unroll
                for (int n = 0; n < 2; ++n) acc[a][b][m][n] = (f32x4){0.f, 0.f, 0.f, 0.f};
    if constexpr (Epi::HAS_INIT) E.init(acc, cur, wr, wc, fr, fq);
    bf16x8 At[4][2], B0[2][2], B1[2][2];
    const char* cA = (const char*)g.A + (size_t)cur.pm * tstep; const char* cB = (const char*)g.Bt + (size_t)cur.pn * tstep;
    S.a_ready(cur);
    if constexpr (SP2) {
        PG8_STAGE(PG8_SB(0, 0), cB, voffB); PG8_STAGE(PG8_SB(0, 1), cB + hstep, voffB); PG8_STAGE(PG8_SA(0, 0), cA, voffA); PG8_STAGE(PG8_SA(0, 1), cA + hstep, voffA);
        if (wr == 1) PG8_BAR;
        PG8_WAIT_V(2); PG8_BAR;
        PG8_STAGE(PG8_SB(1, 0), cB + kstep, voffB); PG8_STAGE(PG8_SA(1, 0), cA + kstep, voffA); PG8_STAGE(PG8_SB(1, 1), cB + hstep + kstep, voffB);
        PG8_WAIT_V(6); PG8_BAR;
    } else {
        PG8_STAGE(PG8_SB(0, 0), cB, voffB); PG8_STAGE(PG8_SA(0, 0), cA, voffA); PG8_STAGE(PG8_SB(0, 1), cB + hstep, voffB); PG8_STAGE(PG8_SA(0, 1), cA + hstep, voffA);
        if (wr == 1) PG8_BAR;
        PG8_WAIT_V(4); PG8_BAR;
        PG8_STAGE(PG8_SB(1, 0), cB + kstep, voffB); PG8_STAGE(PG8_SA(1, 0), cA + kstep, voffA); PG8_STAGE(PG8_SB(1, 1), cB + hstep + kstep, voffB);
        PG8_WAIT_V(6); PG8_BAR;
    }
    for (;;) {
        const bool has_next = S.next(ui + 1, nxt);
        const char* nA = has_next ? (const char*)g.A + (size_t)nxt.pm * tstep : cA; const char* nB = has_next ? (const char*)g.Bt + (size_t)nxt.pn * tstep : cB;
        for (int t = 0; t < nt; t += 2) {
            const bool last = (t == nt - 2);
            const char* a1 = cA + (size_t)(t + 1) * kstep;
            const char* a2 = last ? nA : cA + (size_t)(t + 2) * kstep; const char* b2 = last ? nB : cB + (size_t)(t + 2) * kstep;
            const char* a3 = a2 + kstep; const char* b3 = b2 + kstep;
            if (last && has_next) S.a_ready(nxt);
            if constexpr (SP2) {
            PG8_LDB(B0, 0, 0); PG8_LDB(B1, 0, 1); PG8_SCHED; PG8_LDA(At, 0, 0); PG8_STAGE(PG8_SA(1, 1), a1 + hstep, voffA);
            PG8_WAIT_V(8); PG8_WAIT_L(0); PG8_BAR; PG8_MMA(0, 0, At, B0); PG8_MMA(0, 1, At, B1); PG8_BAR; PG8_SCHED;
            PG8_LDA(At, 0, 1); PG8_STAGE(PG8_SB(0, 0), b2, voffB); PG8_STAGE(PG8_SB(0, 1), b2 + hstep, voffB); PG8_STAGE(PG8_SA(0, 0), a2, voffA);
            PG8_WAIT_V(8); PG8_WAIT_L(0); PG8_BAR; PG8_MMA(1, 0, At, B0); PG8_MMA(1, 1, At, B1); PG8_BAR; PG8_SCHED;
            PG8_LDB(B0, 1, 0); PG8_LDB(B1, 1, 1); PG8_SCHED; PG8_LDA(At, 1, 0); PG8_STAGE(PG8_SA(0, 1), a2 + hstep, voffA);
            PG8_WAIT_V(8); PG8_WAIT_L(0); PG8_BAR; PG8_MMA(0, 0, At, B0); PG8_MMA(0, 1, At, B1); PG8_BAR; PG8_SCHED;
            PG8_LDA(At, 1, 1); PG8_STAGE(PG8_SB(1, 0), b3, voffB); PG8_STAGE(PG8_SB(1, 1), b3 + hstep, voffB); PG8_STAGE(PG8_SA(1, 0), a3, voffA);
            PG8_WAIT_V(8); PG8_WAIT_L(0); PG8_BAR; PG8_MMA(1, 0, At, B0); PG8_MMA(1, 1, At, B1); PG8_BAR; PG8_SCHED;
            } else {
            PG8_LDB(B0, 0, 0); PG8_SCHED; PG8_LDA(At, 0, 0); PG8_STAGE(PG8_SA(1, 1), a1 + hstep, voffA);
            PG8_WAIT_L(8); PG8_BAR; PG8_WAIT_L(0); PG8_MMA(0, 0, At, B0); PG8_BAR; PG8_SCHED;
            PG8_LDB(B1, 0, 1); PG8_STAGE(PG8_SB(0, 0), b2, voffB);
            PG8_BAR; PG8_WAIT_L(0); PG8_MMA(0, 1, At, B1); PG8_BAR;
            PG8_LDA(At, 0, 1); PG8_STAGE(PG8_SA(0, 0), a2, voffA);
            PG8_BAR; PG8_WAIT_L(0); PG8_MMA(1, 0, At, B0); PG8_BAR; PG8_SCHED;
            PG8_STAGE(PG8_SB(0, 1), b2 + hstep, voffB);
            PG8_WAIT_V(6); PG8_BAR; PG8_MMA(1, 1, At, B1); PG8_BAR;
            PG8_LDB(B0, 1, 0); PG8_SCHED; PG8_LDA(At, 1, 0); PG8_STAGE(PG8_SA(0, 1), a2 + hstep, voffA);
            PG8_WAIT_L(8); PG8_BAR; PG8_WAIT_L(0); PG8_MMA(0, 0, At, B0); PG8_BAR; PG8_SCHED;
            PG8_LDB(B1, 1, 1); PG8_STAGE(PG8_SB(1, 0), b3, voffB);
            PG8_BAR; PG8_WAIT_L(0); PG8_MMA(0, 1, At, B1); PG8_BAR;
            PG8_LDA(At, 1, 1); PG8_STAGE(PG8_SA(1, 0), a3, voffA);
            PG8_BAR; PG8_WAIT_L(0); PG8_MMA(1, 0, At, B0); PG8_BAR; PG8_SCHED;
            PG8_STAGE(PG8_SB(1, 1), b3 + hstep, voffB);
            PG8_WAIT_V(6); PG8_BAR; PG8_MMA(1, 1, At, B1); PG8_BAR;
            }
        }
        if constexpr (ALIGN_EPI) { if (wr == 0) PG8_BAR; }
        if constexpr (!Epi::AFTER_DRAIN) { E(acc, cur, wr, wc, fr, fq); S.done(cur); }
        if (!has_next) break;
#pragma unroll
        for (int a = 0; a < 2; ++a)
#pragma unroll
            for (int b = 0; b < 2; ++b)
#pragma unroll
                for (int m = 0; m < 4; ++m)
#pragma unroll
                    for (int n = 0; n < 2; ++n) acc[a][b][m][n] = (f32x4){0.f, 0.f, 0.f, 0.f};
        if constexpr (Epi::HAS_INIT) E.init(acc, nxt, wr, wc, fr, fq);
        cur = nxt; cA = nA; cB = nB; ++ui;
        if constexpr (ALIGN_EPI) { if (wr == 1) PG8_BAR; }
    }
    PG8_WAIT_V(0);
    if constexpr (!ALIGN_EPI) { if (wr == 0) PG8_BAR; }
    PG8_BAR;
    if constexpr (Epi::AFTER_DRAIN) { E.fused(acc, cur, wr, wc, fr, fq, lds, wid, lane); S.done(cur); }
#undef PG8_SA
#undef PG8_SB
#undef PG8_STAGE
#undef PG8_LDA
#undef PG8_LDB
#undef PG8_MMA
#undef PG8_WAIT_V
#undef PG8_WAIT_L
#undef PG8_BAR
#undef PG8_SCHED
}
}
constexpr int NWAVES = 8;
#ifndef MK_N_LAUNCHES
#define MK_N_LAUNCHES 1
#endif
constexpr int N_PHASES = 5;
constexpr int BATCH = 8, T = 2048, D = 1024, M = BATCH * T;
constexpr int NP = 4352;
constexpr int C_R = 0, C_K = 512, C_V = 1024, C_ZW = 1536, C_ZA = 1600, C_GA = 1792, C_DQ = 2304, C_DK = 2816, C_DV = 3328, C_GB = 3840;
constexpr int RH = 8, RN = 64;
constexpr int AH = 4;
constexpr float C2 = 0.125f * 1.4426950408889634f;
constexpr float LOG2E = 1.4426950408889634f;
constexpr float LAMBDA_INIT = 0.2f;

constexpr size_t MiB = 1u << 20;
constexpr size_t WS_CTL = 0, CTL_ZERO_BYTES = 1 * MiB;
constexpr size_t WS_WIN = 2 * MiB;
constexpr size_t WS_WOUT = 11 * MiB;
constexpr size_t WS_WD = 13 * MiB, WS_WA = 13 * MiB + 65536;
constexpr size_t WS_RHO = 13 * MiB + 2 * 65536;
constexpr size_t WS_XN = 14 * MiB;
constexpr size_t WS_PROJ = 46 * MiB;
constexpr size_t WS_MIX = 182 * MiB;
constexpr size_t WS_END = 214 * MiB;
constexpr int CW_BAR = 4096;

constexpr int RING_OFF = 0, RING_BYTES = 131072;
constexpr int LDSCTL_OFF = RING_BYTES, MISC_OFF = LDSCTL_OFF + 320;
constexpr int LDS_BYTES = 155648;

#define GAS __attribute__((address_space(1)))
#define LAS __attribute__((address_space(3)))
typedef unsigned short bf16;
typedef unsigned v4u __attribute__((ext_vector_type(4)));
typedef unsigned v2u __attribute__((ext_vector_type(2)));
typedef float f32x4 __attribute__((ext_vector_type(4)));
typedef float f32x16 __attribute__((ext_vector_type(16)));
typedef short bf16x8 __attribute__((ext_vector_type(8)));
typedef short s16x4 __attribute__((ext_vector_type(4)));
typedef GAS unsigned gu32;
typedef GAS unsigned long long gu64;
#define RLX_AGENT __ATOMIC_RELAXED, __HIP_MEMORY_SCOPE_AGENT
#define LDS_WAIT() asm volatile("s_waitcnt lgkmcnt(0)" ::: "memory")
#define VM_WAIT() asm volatile("s_waitcnt vmcnt(0)" ::: "memory")
__device__ __forceinline__ unsigned f2bf(float f) { unsigned u = __builtin_bit_cast(unsigned, f); return (u + 0x7fffu + ((u >> 16) & 1u)) >> 16; }
__device__ __forceinline__ unsigned pk2(float lo, float hi) { return f2bf(lo) | (f2bf(hi) << 16); }
__device__ __forceinline__ float bflo(unsigned u) { return __uint_as_float(u << 16); }
__device__ __forceinline__ float bfhi(unsigned u) { return __uint_as_float(u & 0xffff0000u); }
__device__ __forceinline__ float bf1(unsigned short u) { return __uint_as_float((unsigned)u << 16); }
__device__ __forceinline__ int mk_lane() { int l; asm volatile("v_mbcnt_lo_u32_b32 %0, -1, 0\n\tv_mbcnt_hi_u32_b32 %0, -1, %0" : "=v"(l)); return l; }
#define XB_TMO      128
#define XB_XCNT(j)  (256  + 64 * (j))
#define XB_XSUB(j)  (1280 + 64 * (j))
#define XB_XGEN(j)  (2304 + 64 * (j))
#define XB_TOP      3328
#define XB_TOPGEN   3392
#define XCD_BAR_WORDS 3456
#define XB_SPIN_CAP (1u << 18)

__device__ __forceinline__ unsigned xb_ld(unsigned* p)              { return __hip_atomic_load(p, __ATOMIC_RELAXED, __HIP_MEMORY_SCOPE_AGENT); }
__device__ __forceinline__ unsigned xb_add(unsigned* p, unsigned v) { return __hip_atomic_fetch_add(p, v, __ATOMIC_RELAXED, __HIP_MEMORY_SCOPE_AGENT); }
__device__ __forceinline__ unsigned xb_xcc_id() { return (unsigned)__builtin_amdgcn_s_getreg((3 << 11) | 20) & 0xFu; }
#define XB_SPIN(cond, bar) do { unsigned _sp = 0; while (cond) { __builtin_amdgcn_s_sleep(1); \
    if ((++_sp & 255u) == 0u) { if (xb_ld(&(bar)[XB_TMO])) break; if (_sp > XB_SPIN_CAP) { atomicAdd(&(bar)[XB_TMO], 1u); break; } } } } while (0)

struct XcdBarrier {
    unsigned* bar; unsigned x;
    volatile LAS unsigned* st;
    int wave;
};

__device__ __forceinline__ XcdBarrier xcd_barrier_post(unsigned* bar, volatile LAS unsigned* st, int wave) {
    XcdBarrier b; b.bar = bar; b.x = xb_xcc_id(); b.st = st; b.wave = wave;
    if (wave == 0 && mk_lane() == 0) (void)xb_add(&bar[XB_XCNT(b.x)], 1u);
    return b;
}
__device__ __forceinline__ void xcd_barrier_complete(unsigned* bar, unsigned x, unsigned& nloc, unsigned& nx) {
    const unsigned G = gridDim.x * gridDim.y * gridDim.z;
    unsigned sum, cnt, mine, sp = 0u;
    for (;;) {
        sum = 0u; cnt = 0u; mine = 0u;
#pragma unroll
        for (unsigned j = 0; j < 16; ++j) { const unsigned c = xb_ld(&bar[XB_XCNT(j)]); sum += c; cnt += (c > 0u) ? 1u : 0u; mine = (j == x) ? c : mine; }
        if (sum == G) break;
        __builtin_amdgcn_s_sleep(1);
        if ((++sp & 255u) == 0u) { if (xb_ld(&bar[XB_TMO])) break; if (sp > XB_SPIN_CAP) { atomicAdd(&bar[XB_TMO], 1u); break; } }
    }
    nloc = mine > 0u ? mine : 1u; nx = cnt > 0u ? cnt : 1u;
}

__device__ __forceinline__ void xcd_barrier(const XcdBarrier& b) {
    asm volatile("s_waitcnt vmcnt(0)" ::: "memory");
    __syncthreads();
    if (b.wave == 0 && mk_lane() == 0) {
        unsigned* bar = b.bar;
        __builtin_amdgcn_s_waitcnt(0);
        unsigned nloc = b.st[0], nx = b.st[1];
        if (nloc == 0u) { xcd_barrier_complete(bar, b.x, nloc, nx); b.st[0] = nloc; b.st[1] = nx; }
        const unsigned old = xb_add(&bar[XB_XSUB(b.x)], 1u);
        const unsigned gen = old / nloc;
        if (old + 1u == (gen + 1u) * nloc) {
            __builtin_amdgcn_fence(__ATOMIC_RELEASE, "agent");
            asm volatile("s_waitcnt vmcnt(0)" ::: "memory");
            const unsigned og = xb_add(&bar[XB_TOP], 1u);
            const unsigned tg = og / nx;
            if (og + 1u == (tg + 1u) * nx) xb_add(&bar[XB_TOPGEN], 1u);
            else XB_SPIN(xb_ld(&bar[XB_TOPGEN]) == tg, bar);
            __builtin_amdgcn_fence(__ATOMIC_ACQUIRE, "agent");
            xb_add(&bar[XB_XGEN(b.x)], 1u);
            asm volatile("s_waitcnt vmcnt(0)" ::: "memory");
        } else {
            XB_SPIN(xb_ld(&bar[XB_XGEN(b.x)]) == gen, bar);
            __builtin_amdgcn_fence(__ATOMIC_ACQUIRE, "agent");
            asm volatile("s_waitcnt vmcnt(0)" ::: "memory");
        }
    }
    __syncthreads();
}
struct Frame {
    LAS unsigned char* lds;
    volatile LAS unsigned* MISC;
    gu32* ctl;
    int tid, lane, wave;
    int vcu, G;
    const float* x; float* out;
    const float *norm_g, *w_in, *shift_mu, *w0, *w_decay_up, *a0, *w_iclr_up, *k_k, *k_a, *r_k, *ln_w, *ln_b, *qn_g, *kn_g, *lq1, *lk1, *lq2, *lk2, *subln_g, *w_out;
    bf16 *WinT, *WoutT, *WdT, *WaT, *XN, *PROJ, *MIX;
};

typedef float f32x2q_t __attribute__((ext_vector_type(2))); typedef __bf16 bf16x2q_t __attribute__((ext_vector_type(2)));
__device__ __forceinline__ unsigned cvtpk2(float lo, float hi) { f32x2q_t v = {lo, hi}; bf16x2q_t b = __builtin_convertvector(v, bf16x2q_t); return __builtin_bit_cast(unsigned, b); }
__device__ __forceinline__ float wave_sum(float v) {
#pragma unroll
    for (int o = 1; o < 64; o <<= 1) v += __shfl_xor(v, o);
    return v;
}
template <int CTRL> __device__ __forceinline__ float dpp_f(float x) { return __builtin_bit_cast(float, __builtin_amdgcn_mov_dpp(__builtin_bit_cast(int, x), CTRL, 0xf, 0xf, true)); }
__device__ __forceinline__ float row16_sum(float x) {
    x += dpp_f<0xB1>(x); x += dpp_f<0x4E>(x); x += dpp_f<0x141>(x); x += dpp_f<0x140>(x); return x;
}
__device__ __forceinline__ float swap32_sum(float x) {
    auto rr = __builtin_amdgcn_permlane32_swap(__float_as_uint(x), __float_as_uint(x), false, false);
    return __uint_as_float(rr[0]) + __uint_as_float(rr[1]);
}

template <bool FRAG = false> __device__ __forceinline__ void p0_transpose_item(const float* W, int N, int nsrc, const float* kscale, bf16* WT, int K, int ndst, LAS float* scr, int k0, int lane) {
    float v[32];
#pragma unroll
    for (int i = 0; i < 32; ++i) { const int kk = 2 * i + (lane >> 5); v[i] = (nsrc >= 0) ? W[(size_t)(k0 + kk) * N + nsrc + (lane & 31)] : 0.f; }
    if (kscale && nsrc >= 0) {
#pragma unroll
        for (int i = 0; i < 32; ++i) v[i] *= kscale[k0 + 2 * i + (lane >> 5)];
    }
#pragma unroll
    for (int i = 0; i < 32; ++i) scr[(2 * i + (lane >> 5)) * 33 + (lane & 31)] = v[i];
    LDS_WAIT(); asm volatile("" ::: "memory");
    const int c = lane & 7;
#pragma unroll
    for (int j = 0; j < 4; ++j) { const int n = (lane >> 3) + 8 * j; const LAS float* s = scr + (8 * c) * 33 + n;
        v4u o; o.x = cvtpk2(s[0 * 33], s[1 * 33]); o.y = cvtpk2(s[2 * 33], s[3 * 33]); o.z = cvtpk2(s[4 * 33], s[5 * 33]); o.w = cvtpk2(s[6 * 33], s[7 * 33]);
        if (FRAG) *(GAS v4u*)(WT + ((size_t)((ndst >> 5) * 4 + (c >> 1)) * 64 + ((c & 1) * 32 + n)) * 8) = o;
        else *(GAS v4u*)(WT + (size_t)(ndst + n) * K + k0 + 8 * c) = o; }
    LDS_WAIT(); asm volatile("" ::: "memory");
}
template <int NQ> __device__ __forceinline__ void p0_rowsq(Frame& F, int mq, int mstep) {
    f32x4 v[NQ][4][4];
#pragma unroll
    for (int q = 0; q < NQ; ++q)
#pragma unroll
        for (int u = 0; u < 4; ++u) { const GAS f32x4* xr = (const GAS f32x4*)(F.x + (size_t)(mq + q * mstep + u) * D) + 2 * F.lane;
#pragma unroll
            for (int j = 0; j < 2; ++j) { v[q][u][2 * j] = __builtin_nontemporal_load(xr + 128 * j); v[q][u][2 * j + 1] = __builtin_nontemporal_load(xr + 128 * j + 1); } }
#pragma unroll
    for (int q = 0; q < NQ; ++q) {
        float s[4];
#pragma unroll
        for (int u = 0; u < 4; ++u) { float a = 0.f;
#pragma unroll
            for (int j = 0; j < 4; ++j) a += (v[q][u][j].x * v[q][u][j].x + v[q][u][j].y * v[q][u][j].y) + (v[q][u][j].z * v[q][u][j].z + v[q][u][j].w * v[q][u][j].w);
            s[u] = a; }
#pragma unroll
        for (int u = 0; u < 4; ++u) {
            const float rstd = __builtin_amdgcn_rsqf(wave_sum(s[u]) * (1.f / D) + 1e-6f);
            GAS v4u* o16 = (GAS v4u*)(F.XN + (size_t)(mq + q * mstep + u) * D) + F.lane;
#pragma unroll
            for (int j = 0; j < 2; ++j) { const f32x4 a = v[q][u][2 * j], c = v[q][u][2 * j + 1];
                o16[64 * j] = (v4u){cvtpk2(a.x * rstd, a.y * rstd), cvtpk2(a.z * rstd, a.w * rstd), cvtpk2(c.x * rstd, c.y * rstd), cvtpk2(c.z * rstd, c.w * rstd)}; }
        }
    }
}
__device__ __forceinline__ void p0_prologue(Frame& F) {
    LAS float* scr = (LAS float*)(F.lds + RING_OFF + F.wave * 16384);
    const int gw = F.vcu * NWAVES + F.wave, NGW = F.G * NWAVES;
    constexpr int I_IN = (D / 64) * (NP / 32), I_OUT = (D / 64) * (D / 32), I_L = 512 / 32;
    constexpr int NITEMS = I_IN + I_OUT + 2 * I_L;
    int m0 = gw * 4;
    const bool two = (m0 + NGW * 4 < M) && (m0 + 2 * NGW * 4 >= M);
    if (!(gw & 1) && m0 < M) { if (two) { p0_rowsq<2>(F, m0, NGW * 4); m0 += 2 * NGW * 4; } else { p0_rowsq<1>(F, m0, 0); m0 += NGW * 4; } }
#pragma unroll 1
    for (int it = gw; it < NITEMS; it += NGW) {
        int r = it;
        if (r < I_IN) { const int kb = r / (NP / 32), nb = r % (NP / 32), nd = 32 * nb; const int ns = nd < 1664 ? nd : (nd < 1792 ? -1 : nd - 128);
            p0_transpose_item(F.w_in, 4224, ns, F.norm_g, F.WinT, D, nd, scr, 64 * kb, F.lane); continue; } r -= I_IN;
        if (r < I_OUT) { const int kb = r / (D / 32), nb = r % (D / 32);
            p0_transpose_item(F.w_out, D, 32 * nb, nullptr, F.WoutT, D, 32 * nb, scr, 64 * kb, F.lane); continue; } r -= I_OUT;
        if (r < I_L) { p0_transpose_item<true>(F.w_decay_up, 512, 32 * r, nullptr, F.WdT, 64, 32 * r, scr, 0, F.lane); continue; } r -= I_L;
        p0_transpose_item<true>(F.w_iclr_up, 512, 32 * r, nullptr, F.WaT, 64, 32 * r, scr, 0, F.lane);
    }
    if (two && m0 + NGW * 4 < M) { p0_rowsq<2>(F, m0, NGW * 4); m0 += 2 * NGW * 4; }
#pragma unroll 1
    for (; m0 < M; m0 += NGW * 4) p0_rowsq<1>(F, m0, 0);
}

__device__ __forceinline__ float tanh_f(float x) { const float e = __expf(-2.f * fabsf(x)); const float t = (1.f - e) * __builtin_amdgcn_rcpf(1.f + e); return x < 0.f ? -t : t; }
__device__ __forceinline__ void shifted8(const bf16* proj, size_t m, bool has_prev, int col, const float* mu, float (&o)[8]) {
    const v4u c = *(const GAS v4u*)(proj + m * NP + col);
    v4u p = (v4u){0u, 0u, 0u, 0u}; if (has_prev) p = *(const GAS v4u*)(proj + (m - 1) * NP + col);
    const f32x4 m0 = *(const GAS f32x4*)(mu), m1 = *(const GAS f32x4*)(mu + 4);
    const unsigned cw[4] = {c.x, c.y, c.z, c.w}, pw[4] = {p.x, p.y, p.z, p.w}; const float mm[8] = {m0.x, m0.y, m0.z, m0.w, m1.x, m1.y, m1.z, m1.w};
#pragma unroll
    for (int j = 0; j < 4; ++j) { const float c0 = bflo(cw[j]), c1 = bfhi(cw[j]), p0 = bflo(pw[j]), p1 = bfhi(pw[j]);
        o[2 * j] = c0 + (p0 - c0) * mm[2 * j]; o[2 * j + 1] = c1 + (p1 - c1) * mm[2 * j + 1]; }
}
__device__ __forceinline__ void shifted4(const bf16* proj, size_t m, bool has_prev, int col, const float* mu, float (&o)[4]) {
    const v2u c = *(const GAS v2u*)(proj + m * NP + col);
    v2u p = (v2u){0u, 0u}; if (has_prev) p = *(const GAS v2u*)(proj + (m - 1) * NP + col);
    const f32x4 m0 = *(const GAS f32x4*)(mu);
    o[0] = bflo(c.x) + (bflo(p.x) - bflo(c.x)) * m0.x; o[1] = bfhi(c.x) + (bfhi(p.x) - bfhi(c.x)) * m0.y;
    o[2] = bflo(c.y) + (bflo(p.y) - bflo(c.y)) * m0.z; o[3] = bfhi(c.y) + (bfhi(p.y) - bfhi(c.y)) * m0.w;
}
__device__ __forceinline__ void p2_qknorm(Frame& F) {
    const int gw = F.vcu * NWAVES + F.wave, NGW = F.G * NWAVES, lane = F.lane, sub = lane & 7;
    const f32x4 gk0 = *(const GAS f32x4*)(F.kn_g + sub * 8), gk1 = *(const GAS f32x4*)(F.kn_g + sub * 8 + 4);
    constexpr int UQ = 4;
    for (int it0 = gw * UQ; it0 < M; it0 += NGW * UQ) {
        bf16* p[UQ]; v4u c[UQ];
#pragma unroll
        for (int u = 0; u < UQ; ++u) { const size_t m = (size_t)(it0 + u); p[u] = F.PROJ + m * NP + C_DK + (lane >> 3) * 64 + sub * 8; c[u] = *(const GAS v4u*)p[u]; }
#pragma unroll
        for (int u = 0; u < UQ; ++u) {
            const unsigned cw[4] = {c[u].x, c[u].y, c[u].z, c[u].w};
            float xv[8]; float ss = 0.f;
#pragma unroll
            for (int j = 0; j < 4; ++j) { xv[2 * j] = bflo(cw[j]); xv[2 * j + 1] = bfhi(cw[j]); ss += xv[2 * j] * xv[2 * j] + xv[2 * j + 1] * xv[2 * j + 1]; }
            ss += dpp_f<0xB1>(ss); ss += dpp_f<0x4E>(ss); ss += dpp_f<0x141>(ss);
            const float r = __builtin_amdgcn_rsqf(ss * (1.f / 64.f) + 1e-6f);
            v4u o; o.x = cvtpk2(xv[0] * r * gk0.x, xv[1] * r * gk0.y); o.y = cvtpk2(xv[2] * r * gk0.z, xv[3] * r * gk0.w); o.z = cvtpk2(xv[4] * r * gk1.x, xv[5] * r * gk1.y); o.w = cvtpk2(xv[6] * r * gk1.z, xv[7] * r * gk1.w);
            *(GAS v4u*)p[u] = o;
        }
    }
}
typedef float f32x2_t __attribute__((ext_vector_type(2))); typedef __bf16 bf16x2_t __attribute__((ext_vector_type(2)));
__device__ __forceinline__ unsigned cvtpk(float lo, float hi) { f32x2_t v = {lo, hi}; bf16x2_t b = __builtin_convertvector(v, bf16x2_t); return __builtin_bit_cast(unsigned, b); }
#define MFMA32(a, b, c) __builtin_amdgcn_mfma_f32_32x32x16_bf16(__builtin_bit_cast(bf16x8, (a)), __builtin_bit_cast(bf16x8, (b)), (c), 0, 0, 0)
#define FRAGACC(z, s) ((v4u){cvtpk((z)[8 * (s)], (z)[8 * (s) + 1]), cvtpk((z)[8 * (s) + 2], (z)[8 * (s) + 3]), cvtpk((z)[8 * (s) + 4], (z)[8 * (s) + 5]), cvtpk((z)[8 * (s) + 6], (z)[8 * (s) + 7])})
template <int CTRL, int RM> __device__ __forceinline__ float dpp_upd0(float x) { return __builtin_bit_cast(float, __builtin_amdgcn_update_dpp(0, __builtin_bit_cast(int, x), CTRL, RM, 0xf, false)); }
__device__ __forceinline__ float scan32(float x) {
    x += dpp_upd0<0x111, 0xf>(x); x += dpp_upd0<0x112, 0xf>(x); x += dpp_upd0<0x114, 0xf>(x); x += dpp_upd0<0x118, 0xf>(x); x += dpp_upd0<0x142, 0xa>(x); return x;
}
__device__ __forceinline__ void st_wt16(v4u* p, const v4u v) { *(GAS v4u*)p = v; }
constexpr int RW_UNITS = BATCH * RH * (T / 32);
struct RwDump { v4u* PF; v4u* DD; v4u* QF; v4u* YD; float* GAM; float* RHO; };

__device__ __forceinline__ void rwkvA_unit(Frame& F, const RwDump& Dm, int bh, int ci, LAS float* wscr, LAS unsigned char* park, LAS v4u* zsh, int zpar) {
    int lane = mk_lane(); asm volatile("" : "+v"(lane));
    const int hi = lane >> 5, l31 = lane & 31, b = bh >> 3, w = bh & 7;
    LAS v4u* pk = (LAS v4u*)park + lane;
#define PARK(slot) pk[(slot) * 64]
    int tok = 0; asm volatile("" : "+v"(tok));
#define DEP(x) asm volatile("" : "+v"(tok) : "v"(x))
    const int t = ci * 32 + l31; const size_t m = (size_t)b * T + t; const bool hp = t > 0;
    const int u = ci * (BATCH * RH) + bh;
    const float pm = hp ? 1.f : 0.f;
    const float* mu = F.shift_mu + w * 64 + 4 * hi;
    const float *pw0 = F.w0 + w * 64 + 4 * hi, *pa0 = F.a0 + w * 64 + 4 * hi, *pkk = F.k_k + w * 64 + 4 * hi, *pka = F.k_a + w * 64 + 4 * hi, *prk = F.r_k + w * 64 + 4 * hi;
    LAS unsigned char* stg = park + 8192;
    LAS unsigned char* prv = F.lds + LDSCTL_OFF + 20480 + F.wave * 256;
    const bf16* gk = F.PROJ + ((size_t)b * T + ci * 32) * NP + w * 64;
    const bf16* gpr = gk - (ci > 0 ? NP : 0);
#define RW_DMA(src, dst) __builtin_amdgcn_global_load_lds((const unsigned*)(src), (LAS unsigned*)(dst), 16, 0, 0)
    LDS_WAIT();
    { const bf16* s_ = gk + (size_t)(lane >> 3) * NP + C_K;
#pragma unroll
      for (int p = 0; p < 4; ++p) RW_DMA(s_ + (size_t)(8 * p) * NP + (((lane & 7) ^ ((4 * p + (lane >> 4)) & 7)) * 8), stg + p * 1024);
      if (lane < 8) RW_DMA(gpr + C_K + lane * 8, prv); }
#define RW_STAGE_RV(cb) do { const bf16* s_ = gk + (size_t)(lane >> 2) * NP + 32 * (cb) + (((lane & 3) ^ ((lane >> 4) & 3)) * 8); \
      _Pragma("unroll") for (int p = 0; p < 2; ++p) { RW_DMA(s_ + C_R + (size_t)(16 * p) * NP, stg + 4096 + p * 1024); RW_DMA(s_ + C_V + (size_t)(16 * p) * NP, stg + 6144 + p * 1024); } \
      if (lane < 4) { RW_DMA(gpr + C_R + 32 * (cb) + lane * 8, prv + 128); RW_DMA(gpr + C_V + 32 * (cb) + lane * 8, prv + 192); } } while (0)
    RW_STAGE_RV(0);
    const LAS unsigned char* kcur = stg + l31 * 128 + 8 * hi; const LAS unsigned char* kprv = l31 ? kcur - 128 : prv + 8 * hi;
    const LAS unsigned char* rcur = stg + 4096 + l31 * 64 + 8 * hi; const LAS unsigned char* rprv = l31 ? rcur - 64 : prv + 128 + 8 * hi;
    const LAS unsigned char* vcur = stg + 6144 + l31 * 64 + 8 * hi; const LAS unsigned char* vprv = l31 ? vcur - 64 : prv + 192 + 8 * hi;
    const int fKc = ((l31 >> 1) & 7) << 4, fKp = l31 ? (((l31 - 1) >> 1) & 7) << 4 : 0, fRc = ((l31 >> 2) & 3) << 4, fRp = l31 ? (((l31 - 1) >> 2) & 3) << 4 : 0;
    v4u bz[4], ba[4];
    { const int s = F.wave >> 1; const bool which = (F.wave & 1) != 0;
      const bf16* zc = F.PROJ + m * NP + 8 * hi; const bf16* zp = F.PROJ + (hp ? m - 1 : m) * NP + 8 * hi; const float* zmu = F.shift_mu + 8 * hi;
      const int COL = (which ? C_ZA : C_ZW) + 16 * s, MUO = (which ? 1600 : 1536) + 16 * s;
      const v4u c = *(const GAS v4u*)(zc + tok + COL), p = *(const GAS v4u*)(zp + tok + COL); const f32x4 m0 = *(const GAS f32x4*)(zmu + tok + MUO), m1 = *(const GAS f32x4*)(zmu + tok + MUO + 4);
      float z[8];
#pragma unroll
      for (int j = 0; j < 4; ++j) { const float c0 = bflo(c[j]), c1 = bfhi(c[j]); const float mm0 = j < 2 ? m0[2 * j] : m1[2 * j - 4], mm1 = j < 2 ? m0[2 * j + 1] : m1[2 * j - 3];
          z[2 * j] = c0 + (bflo(p[j]) * pm - c0) * mm0; z[2 * j + 1] = c1 + (bfhi(p[j]) * pm - c1) * mm1; }
      if (!which) {
#pragma unroll
          for (int j = 0; j < 8; ++j) z[j] = tanh_f(z[j]); }
      LAS v4u* zs = zsh + zpar * 512;
      zs[((which ? 4 : 0) + s) * 64 + lane] = (v4u){cvtpk(z[0], z[1]), cvtpk(z[2], z[3]), cvtpk(z[4], z[5]), cvtpk(z[6], z[7])};
      __syncthreads();
#pragma unroll
      for (int q = 0; q < 4; ++q) { bz[q] = zs[q * 64 + lane]; ba[q] = zs[(4 + q) * 64 + lane]; }
      DEP(bz[3][3]); DEP(ba[3][3]); }
    asm volatile("" ::: "memory");
    asm volatile("s_waitcnt vmcnt(0)" ::: "memory");
    float ss = 0.f;
#pragma unroll
    for (int gq = 0; gq < 8; ++gq) { const v2u c_ = *(const LAS v2u*)(kcur + tok + ((16 * gq) ^ fKc)), p_ = *(const LAS v2u*)(kprv + tok + ((16 * gq) ^ fKp));
        const f32x4 m_ = *(const GAS f32x4*)(mu + tok + 512 + 8 * gq), kkp = *(const GAS f32x4*)(pkk + tok + 8 * gq);
        float k4[4]; k4[0] = bflo(c_.x) + (bflo(p_.x) * pm - bflo(c_.x)) * m_.x; k4[1] = bfhi(c_.x) + (bfhi(p_.x) * pm - bfhi(c_.x)) * m_.y;
        k4[2] = bflo(c_.y) + (bflo(p_.y) * pm - bflo(c_.y)) * m_.z; k4[3] = bfhi(c_.y) + (bfhi(p_.y) * pm - bfhi(c_.y)) * m_.w;
#pragma unroll
        for (int e = 0; e < 4; ++e) { const float q = k4[e] * kkp[e]; ss += q * q; }
        if (gq == 3) DEP(ss); }
    ss = swap32_sum(ss);
    const float inv = __builtin_amdgcn_rcpf(fmaxf(__builtin_amdgcn_sqrtf(ss), 1e-12f));
    asm volatile("" ::: "memory");
    v4u fa[4], fb[4], fk[4], fr[4], fv[4]; float rho = 0.f;
    float* gp = Dm.GAM + (size_t)u * 64 + hi * 32;
#define RW_LORA(cb) f32x16 accd = f32x16{}, acca = f32x16{}; _Pragma("unroll") for (int s = 0; s < 4; ++s) { \
        const v4u aD = *(const GAS v4u*)(F.WdT + tok + ((size_t)((w * 2 + (cb)) * 4 + s) * 64 + lane) * 8); accd = MFMA32(aD, bz[s], accd);     \
        const v4u aA = *(const GAS v4u*)(F.WaT + tok + ((size_t)((w * 2 + (cb)) * 4 + s) * 64 + lane) * 8); acca = MFMA32(aA, ba[s], acca); }
        struct RwGL { v2u rc, rp, kc, kp, vc, vp; };
    struct RwPar { f32x4 mr, mk, mv, w0, a0, kk; } pA, pB;
#define RW_LOADG(X, CB, RG) do { X.rc = *(const LAS v2u*)(rcur + tok + ((16 * (RG)) ^ fRc)); X.rp = *(const LAS v2u*)(rprv + tok + ((16 * (RG)) ^ fRp)); \
        X.kc = *(const LAS v2u*)(kcur + tok + ((64 * (CB) + 16 * (RG)) ^ fKc)); X.kp = *(const LAS v2u*)(kprv + tok + ((64 * (CB) + 16 * (RG)) ^ fKp)); \
        X.vc = *(const LAS v2u*)(vcur + tok + ((16 * (RG)) ^ fRc)); X.vp = *(const LAS v2u*)(vprv + tok + ((16 * (RG)) ^ fRp)); } while (0)
#define RW_LOADP(X, OFF_) do { X.mr = *(const GAS f32x4*)(mu + tok + (OFF_)); X.mk = *(const GAS f32x4*)(mu + tok + 512 + (OFF_)); X.mv = *(const GAS f32x4*)(mu + tok + 1024 + (OFF_)); \
        X.w0 = *(const GAS f32x4*)(pw0 + tok + (OFF_)); X.a0 = *(const GAS f32x4*)(pa0 + tok + (OFF_)); X.kk = *(const GAS f32x4*)(pkk + tok + (OFF_)); } while (0)
#define RW_LERP(dst, c_, p_, m_) do { dst[0] = bflo(c_.x) + (bflo(p_.x) * pm - bflo(c_.x)) * m_.x; dst[1] = bfhi(c_.x) + (bfhi(p_.x) * pm - bfhi(c_.x)) * m_.y; \
        dst[2] = bflo(c_.y) + (bflo(p_.y) * pm - bflo(c_.y)) * m_.z; dst[3] = bfhi(c_.y) + (bfhi(p_.y) * pm - bfhi(c_.y)) * m_.w; } while (0)
#define RW_GROUP(cb, rg, CUR, NXT, HASN) do { constexpr int OFF = 32 * (cb) + 8 * (rg); const int ch0 = OFF + 4 * hi; \
            if (HASN) RW_LOADP(NXT, OFF + 8); \
            RwGL g_; RW_LOADG(g_, cb, rg); \
            float rr[4], kk4[4], vv[4]; \
            const f32x4 kap = *(const GAS f32x4*)(pka + tok + OFF), rkp = *(const GAS f32x4*)(prk + tok + OFF);     \
            const f32x4 mr_ = CUR.mr, mk_ = CUR.mk, mv_ = CUR.mv, w0v = CUR.w0, a0v = CUR.a0, kkp = CUR.kk; \
            RW_LERP(rr, g_.rc, g_.rp, mr_); RW_LERP(kk4, g_.kc, g_.kp, mk_); RW_LERP(vv, g_.vc, g_.vp, mv_); \
            float xa[4], xb[4], xk[4], xr[4], gg[4], ge[4]; \
            _Pragma("unroll") for (int e = 0; e < 4; ++e) { \
                  \
                const float l2 = (-0.6065306597126334f * LOG2E) * __builtin_amdgcn_rcpf(1.f + __expf(-(w0v[e] + accd[4 * (rg) + e]))); \
                const float g = scan32(l2); \
                const float a = __builtin_amdgcn_rcpf(1.f + __expf(-(a0v[e] + acca[4 * (rg) + e]))); \
                const float kk = kk4[e] * kkp[e] * inv; \
                const float kt = kk4[e] * (1.f + (a - 1.f) * kap[e]); \
                rho += rr[e] * kt * rkp[e]; \
                const float eg = __builtin_amdgcn_exp2f(g), egp = __builtin_amdgcn_exp2f(g - l2), eng = __builtin_amdgcn_rcpf(eg); \
                xa[e] = -kk * egp; xb[e] = kk * a * eng; xk[e] = kt * eng; xr[e] = rr[e] * eg; gg[e] = g; ge[e] = eg; } \
            if (l31 == 31) { *(LAS f32x4*)(wscr + ch0) = (f32x4){gg[0], gg[1], gg[2], gg[3]}; st_wt16((v4u*)(gp + (cb) * 16 + 4 * (rg)), (v4u){__float_as_uint(ge[0]), __float_as_uint(ge[1]), __float_as_uint(ge[2]), __float_as_uint(ge[3])}); } \
            constexpr int s_ = 2 * (cb) + ((rg) >> 1), vg = 2 * ((rg) & 1); \
            fa[s_][vg] = cvtpk(xa[0], xa[1]); fa[s_][vg + 1] = cvtpk(xa[2], xa[3]); \
            fb[s_][vg] = cvtpk(xb[0], xb[1]); fb[s_][vg + 1] = cvtpk(xb[2], xb[3]); \
            fk[s_][vg] = cvtpk(xk[0], xk[1]); fk[s_][vg + 1] = cvtpk(xk[2], xk[3]); \
            fr[s_][vg] = cvtpk(xr[0], xr[1]); fr[s_][vg + 1] = cvtpk(xr[2], xr[3]); \
            fv[s_][vg] = cvtpk(vv[0], vv[1]); fv[s_][vg + 1] = cvtpk(vv[2], vv[3]); \
            if (((rg) & 1) == 1) { PARK(s_) = fv[s_]; PARK(4 + s_) = fr[s_]; } \
            DEP(fa[s_][vg + 1]); DEP(fb[s_][vg + 1]); DEP(fk[s_][vg + 1]); DEP(fr[s_][vg + 1]); DEP(fv[s_][vg + 1]); DEP(rho); } while (0)
    RW_LOADP(pA, 0);
    { RW_LORA(0) RW_GROUP(0, 0, pA, pB, true); RW_GROUP(0, 1, pB, pA, true); RW_GROUP(0, 2, pA, pB, true); RW_GROUP(0, 3, pB, pA, true); }
    LDS_WAIT(); RW_STAGE_RV(1);
    { RW_LORA(1) asm volatile("s_waitcnt vmcnt(0)" ::: "memory");
      RW_GROUP(1, 0, pA, pB, true); RW_GROUP(1, 1, pB, pA, true); RW_GROUP(1, 2, pA, pB, true); RW_GROUP(1, 3, pB, pA, false); }
#undef RW_STAGE_RV
#undef RW_DMA
#undef RW_LOADG
#undef RW_LOADP
#undef RW_LERP
#undef RW_LORA
#undef RW_GROUP
    LDS_WAIT(); asm volatile("" ::: "memory");
    float EC[2]; EC[0] = __builtin_amdgcn_exp2f(wscr[l31]); EC[1] = __builtin_amdgcn_exp2f(wscr[32 + l31]);
    LDS_WAIT(); asm volatile("" ::: "memory");
    rho = swap32_sum(rho);
    if (hi == 0) __hip_atomic_store((gu32*)(Dm.RHO + (size_t)u * 32 + l31), __float_as_uint(rho), RLX_AGENT);
    v4u idf[2];
    { const int jst = 4 * ((l31 >> 3) & 1) + (l31 & 3); const bool hm = ((l31 >> 2) & 1) == hi; const unsigned one = 0x3F80u << (16 * (jst & 1));
#pragma unroll
      for (int sig = 0; sig < 2; ++sig) { const bool on = hm && ((l31 >> 4) == sig);
#pragma unroll
          for (int q = 0; q < 4; ++q) idf[sig][q] = (on && (jst >> 1) == q) ? one : 0u; } }
    LDS_WAIT();
    v4u Af[2][2], Vf[2][2];
#pragma unroll
    for (int blk = 0; blk < 2; ++blk) {
        f32x16 za = MFMA32(fa[2 * blk], idf[0], f32x16{}); za = MFMA32(fa[2 * blk + 1], idf[1], za);
        f32x16 zv = MFMA32(PARK(2 * blk), idf[0], f32x16{}); zv = MFMA32(PARK(2 * blk + 1), idf[1], zv);
        f32x16 zb = MFMA32(fb[2 * blk], idf[0], f32x16{}); zb = MFMA32(fb[2 * blk + 1], idf[1], zb);
        f32x16 zk = MFMA32(fk[2 * blk], idf[0], f32x16{}); zk = MFMA32(fk[2 * blk + 1], idf[1], zk);
        zb = zb * EC[blk]; zk = zk * EC[blk];
#pragma unroll
        for (int s = 0; s < 2; ++s) { Af[blk][s] = FRAGACC(za, s); Vf[blk][s] = FRAGACC(zv, s); PARK(8 + 2 * blk + s) = FRAGACC(zb, s); PARK(12 + 2 * blk + s) = FRAGACC(zk, s); }
        __builtin_amdgcn_sched_barrier(0);
    }
    f32x16 Aab = f32x16{}, TT = f32x16{}, AakT = f32x16{}, ArbT = f32x16{}, ArkT = f32x16{};
#pragma unroll
    for (int s = 0; s < 4; ++s) { const v4u frs = PARK(4 + s); Aab = MFMA32(fa[s], fb[s], Aab); TT = MFMA32(fb[s], fa[s], TT); AakT = MFMA32(fk[s], fa[s], AakT); ArbT = MFMA32(fb[s], frs, ArbT); ArkT = MFMA32(fk[s], frs, ArkT); }
#pragma unroll
    for (int r = 0; r < 16; ++r) { const int rowi = (r & 3) + 8 * (r >> 2) + 4 * hi;
        Aab[r] = (l31 < rowi) ? Aab[r] : 0.f; TT[r] = (rowi < l31) ? TT[r] : 0.f; AakT[r] = (rowi < l31) ? AakT[r] : 0.f;
        ArbT[r] = (rowi <= l31) ? ArbT[r] : 0.f; ArkT[r] = (rowi <= l31) ? ArkT[r] : 0.f; }
    v4u AakTf[2], ArbTf[2], ArkTf[2];
#pragma unroll
    for (int s = 0; s < 2; ++s) { AakTf[s] = FRAGACC(AakT, s); ArbTf[s] = FRAGACC(ArbT, s); ArkTf[s] = FRAGACC(ArkT, s); }
    __builtin_amdgcn_sched_barrier(0);
    v4u Xf[2], XTf[2], TTf[2];
#pragma unroll
    for (int s = 0; s < 2; ++s) { Xf[s] = FRAGACC(Aab, s); XTf[s] = FRAGACC(TT, s); }
#pragma unroll
    for (int r = 0; r < 16; ++r) { const int rowi = (r & 3) + 8 * (r >> 2) + 4 * hi; TT[r] += (rowi == l31) ? 1.f : 0.f; }
#pragma unroll
    for (int it = 0; it < 4; ++it) {
        f32x16 X2 = MFMA32(XTf[0], Xf[0], f32x16{}); X2 = MFMA32(XTf[1], Xf[1], X2);
        if (it < 3) { f32x16 X2T = MFMA32(Xf[0], XTf[0], f32x16{}); X2T = MFMA32(Xf[1], XTf[1], X2T);
#pragma unroll
            for (int s = 0; s < 2; ++s) XTf[s] = FRAGACC(X2T, s); }
#pragma unroll
        for (int s = 0; s < 2; ++s) { Xf[s] = FRAGACC(X2, s); TTf[s] = FRAGACC(TT, s); }
        TT = MFMA32(Xf[0], TTf[0], TT); TT = MFMA32(Xf[1], TTf[1], TT);
        __builtin_amdgcn_sched_barrier(0);
    }
#pragma unroll
    for (int s = 0; s < 2; ++s) TTf[s] = FRAGACC(TT, s);
    v4u Wf[2][2], Uf[2][2];
#pragma unroll
    for (int blk = 0; blk < 2; ++blk) {
        f32x16 av = MFMA32(AakTf[0], Vf[blk][0], f32x16{}); av = MFMA32(AakTf[1], Vf[blk][1], av);
        const v4u avf0 = FRAGACC(av, 0), avf1 = FRAGACC(av, 1);
        f32x16 uu = MFMA32(TTf[0], avf0, f32x16{}); uu = MFMA32(TTf[1], avf1, uu);
        f32x16 ww = MFMA32(TTf[0], Af[blk][0], f32x16{}); ww = MFMA32(TTf[1], Af[blk][1], ww);
#pragma unroll
        for (int s = 0; s < 2; ++s) { Wf[blk][s] = FRAGACC(ww, s); Uf[blk][s] = FRAGACC(uu, s); }
        __builtin_amdgcn_sched_barrier(0);
    }
    v4u* QFp = Dm.QF + (size_t)u * 256 + lane; v4u* YDp = Dm.YD + (size_t)u * 256 + lane;
#pragma unroll
    for (int blk = 0; blk < 2; ++blk) {
        f32x16 q;
#pragma unroll
        for (int s = 0; s < 2; ++s)
            { const v4u frs = PARK(4 + 2 * blk + s);
#pragma unroll
              for (int j = 0; j < 4; ++j) { q[8 * s + 2 * j] = bflo(frs[j]); q[8 * s + 2 * j + 1] = bfhi(frs[j]); } }
        q = MFMA32(Wf[blk][0], ArbTf[0], q); q = MFMA32(Wf[blk][1], ArbTf[1], q);
        st_wt16(QFp + (2 * blk) * 64, FRAGACC(q, 0)); st_wt16(QFp + (2 * blk + 1) * 64, FRAGACC(q, 1));
        f32x16 y = MFMA32(Uf[blk][0], ArbTf[0], f32x16{}); y = MFMA32(Uf[blk][1], ArbTf[1], y); y = MFMA32(Vf[blk][0], ArkTf[0], y); y = MFMA32(Vf[blk][1], ArkTf[1], y);
        st_wt16(YDp + (2 * blk) * 64, FRAGACC(y, 0)); st_wt16(YDp + (2 * blk + 1) * 64, FRAGACC(y, 1));
        __builtin_amdgcn_sched_barrier(0);
    }
    v4u* PFp = Dm.PF + (size_t)u * 512 + lane; v4u* DDp = Dm.DD + (size_t)u * 512 + lane;
#pragma unroll
    for (int c1 = 0; c1 < 2; ++c1)
#pragma unroll
        for (int cb = 0; cb < 2; ++cb) {
            f32x16 p = MFMA32(Wf[c1][0], PARK(8 + 2 * cb), f32x16{}); p = MFMA32(Wf[c1][1], PARK(8 + 2 * cb + 1), p);
            st_wt16(PFp + (cb * 4 + 2 * c1) * 64, FRAGACC(p, 0)); st_wt16(PFp + (cb * 4 + 2 * c1 + 1) * 64, FRAGACC(p, 1));
            __builtin_amdgcn_sched_barrier(0);
        }
#pragma unroll
    for (int cb = 0; cb < 2; ++cb)
#pragma unroll
        for (int ib = 0; ib < 2; ++ib) {
            f32x16 d = MFMA32(PARK(8 + 2 * cb), Uf[ib][0], f32x16{}); d = MFMA32(PARK(8 + 2 * cb + 1), Uf[ib][1], d); d = MFMA32(PARK(12 + 2 * cb), Vf[ib][0], d); d = MFMA32(PARK(12 + 2 * cb + 1), Vf[ib][1], d);
            st_wt16(DDp + ((cb * 2 + ib) * 2) * 64, FRAGACC(d, 0)); st_wt16(DDp + ((cb * 2 + ib) * 2 + 1) * 64, FRAGACC(d, 1));
            __builtin_amdgcn_sched_barrier(0);
        }
}

#undef PARK
#undef DEP
constexpr int RB_PF = 0, RB_DD = 8192, RB_QF = 16384, RB_YD = 20480, RB_GAM = 24576, RB_BUF = 24832, RB_NB = 4, RB_STAT = RB_NB * RB_BUF, RB_Y = RB_STAT + 1024;
__device__ __forceinline__ void unpack16(const v4u a, const v4u b, f32x16& o) {
#pragma unroll
    for (int j = 0; j < 4; ++j) { o[2 * j] = bflo(a[j]); o[2 * j + 1] = bfhi(a[j]); o[8 + 2 * j] = bflo(b[j]); o[8 + 2 * j + 1] = bfhi(b[j]); }
}
constexpr int RW_SPLIT = T / 32, CW_DONE = 16384;
__device__ __forceinline__ void rw_wait_chunk(Frame& F, int ci) {
    unsigned spins = 0;
#pragma unroll 1
    for (int j = 7; j >= 0; --j) { gu32* c = F.ctl + CW_DONE + 64 * (ci + j);
        while ((unsigned)__builtin_amdgcn_readfirstlane(__hip_atomic_load(c, RLX_AGENT)) < (unsigned)BATCH) { __builtin_amdgcn_s_sleep(8); if (++spins > (1u << 22)) break; } }
    __builtin_amdgcn_fence(__ATOMIC_ACQUIRE, "agent");
}
__device__ __forceinline__ void rw_publish_chunk(Frame& F, int ci) {
    asm volatile("s_waitcnt vmcnt(0)" ::: "memory");
    __syncthreads();
    if (F.wave == 0 && mk_lane() == 0) {
        __hip_atomic_fetch_add(F.ctl + CW_DONE + 64 * ci, 1u, RLX_AGENT);
    }
}
#ifndef RB_AUX
#define RB_AUX 2
#endif
struct RbStage { v4u p[2], d[2], q, y, g; };
struct RbEpi { v4u vc, vp, ga; float rho; };
__device__ __forceinline__ void rwkvB_unit(Frame& F, const RwDump& Dm, int bh) {
    int lane = mk_lane(); asm volatile("" : "+v"(lane));
    const int wid = F.wave, tid = wid * 64 + lane, hi = lane >> 5, l31 = lane & 31, b = bh >> 3, h = bh & 7;
    LAS unsigned char* lds = F.lds + RING_OFF;
    constexpr int NS = T / 32;
    LAS float* stat = (LAS float*)(lds + RB_STAT);
    LAS float* ybuf = (LAS float*)(lds + RB_Y);
    const int stid = tid - 128;
    const bool st_p2 = wid < 4, st_q = wid < 6, st_y = wid >= 4;
#define ST_LOAD(X, ci_) do { { if ((ci_) >= RW_SPLIT && (ci_) < NS && (((ci_) - RW_SPLIT) & 7) == 0) rw_wait_chunk(F, (ci_)); const size_t u_ = (size_t)((ci_) < NS ? (ci_) : NS - 1) * (BATCH * RH) + bh; \
        X.p[0] = __builtin_nontemporal_load((const GAS v4u*)(Dm.PF + u_ * 512 + stid)); X.d[0] = __builtin_nontemporal_load((const GAS v4u*)(Dm.DD + u_ * 512 + stid)); \
        if (st_p2) { X.p[1] = __builtin_nontemporal_load((const GAS v4u*)(Dm.PF + u_ * 512 + 384 + stid)); X.d[1] = __builtin_nontemporal_load((const GAS v4u*)(Dm.DD + u_ * 512 + 384 + stid)); } \
        if (st_q) X.q = __builtin_nontemporal_load((const GAS v4u*)(Dm.QF + u_ * 256 + stid)); \
        if (st_y) X.y = __builtin_nontemporal_load((const GAS v4u*)(Dm.YD + u_ * 256 + (stid - 128))); \
        if (stid < 16) X.g = *(const GAS v4u*)((const v4u*)(Dm.GAM + u_ * 64) + stid); } } while (0)
#define ST_STORE(X, buf_) do { LAS unsigned char* b_ = lds + (buf_) * RB_BUF; \
        *(LAS v4u*)(b_ + RB_PF + stid * 16) = X.p[0]; *(LAS v4u*)(b_ + RB_DD + stid * 16) = X.d[0]; \
        if (st_p2) { *(LAS v4u*)(b_ + RB_PF + (384 + stid) * 16) = X.p[1]; *(LAS v4u*)(b_ + RB_DD + (384 + stid) * 16) = X.d[1]; } \
        if (st_q) *(LAS v4u*)(b_ + RB_QF + stid * 16) = X.q; \
        if (st_y) *(LAS v4u*)(b_ + RB_YD + (stid - 128) * 16) = X.y; \
        if (stid < 16) *(LAS v4u*)(b_ + RB_GAM + stid * 16) = X.g; } while (0)
    const int ew = (wid & 1) + 2 * ((wid >> 2) & 1), eidx = ew * 64 + lane, etok = eidx >> 3, ep = eidx & 7;
    const bf16* epc = F.PROJ + (size_t)b * T * NP + h * 64 + 8 * ep;
#define EP_LOAD(X, cj_) do { { const int cc_ = (cj_) < NS ? (cj_) : NS - 1, tt_ = cc_ * 32 + etok; const bf16* pc_ = epc + (size_t)tt_ * NP; const bf16* pp_ = epc + (size_t)(tt_ > 0 ? tt_ - 1 : 0) * NP; \
        X.vc = *(const GAS v4u*)(pc_ + C_V); X.vp = *(const GAS v4u*)(pp_ + C_V); X.ga = *(const GAS v4u*)(pc_ + C_GA); \
        X.rho = Dm.RHO[((size_t)cc_ * (BATCH * RH) + bh) * 32 + etok]; } } while (0)
#define EP_RUN(X, cj_) do { const int par_ = (cj_) & 1; \
        const float s1_ = stat[((par_ * 2 + 0) * 32 + etok) * 2] + stat[((par_ * 2 + 1) * 32 + etok) * 2], s2_ = stat[((par_ * 2 + 0) * 32 + etok) * 2 + 1] + stat[((par_ * 2 + 1) * 32 + etok) * 2 + 1]; \
        const float mean_ = s1_ * (1.f / 64.f), var_ = fmaxf(s2_ * (1.f / 64.f) - mean_ * mean_, 0.f), rstd_ = __builtin_amdgcn_rsqf(var_ + 64e-5f); \
        const int tt_ = (cj_) * 32 + etok; const size_t mm_ = (size_t)b * T + tt_; const float pm_ = tt_ > 0 ? 1.f : 0.f; \
        const LAS float* yb_ = ybuf + (par_ * 2 + (ep >> 2)) * 1024 + 4 * (ep & 3) * 64 + etok; \
        float o_[8]; \
        _Pragma("unroll") for (int j = 0; j < 8; ++j) { const unsigned vcw_ = X.vc[j >> 1], vpw_ = X.vp[j >> 1], gaw_ = X.ga[j >> 1]; \
            const float vc_ = (j & 1) ? bfhi(vcw_) : bflo(vcw_), vp_ = (j & 1) ? bfhi(vpw_) : bflo(vpw_), g_ = (j & 1) ? bfhi(gaw_) : bflo(gaw_); \
            const float vv_ = vc_ + (vp_ * pm_ - vc_) * emu[j >> 2][j & 3]; \
            const float yn_ = (yb_[(j & 3) * 64 + (j >> 2) * 32] - mean_) * rstd_ * elw[j >> 2][j & 3] + elb[j >> 2][j & 3] + X.rho * vv_; o_[j] = yn_ * g_ * __builtin_amdgcn_rcpf(1.f + __expf(-g_)); } \
        *(GAS v4u*)(F.MIX + mm_ * D + h * 64 + 8 * ep) = (v4u){cvtpk(o_[0], o_[1]), cvtpk(o_[2], o_[3]), cvtpk(o_[4], o_[5]), cvtpk(o_[6], o_[7])}; } while (0)
    f32x16 S[2]; S[0] = f32x16{}; S[1] = f32x16{};
    const int ib = wid & 1;
#define CONS(ci_) do { const LAS unsigned char* bb = lds + ((ci_) & (RB_NB - 1)) * RB_BUF; \
          \
        v4u pf_[8], qf_[4], dd_[4], yd_[2]; f32x4 gm_[8]; \
        _Pragma("unroll") for (int q = 0; q < 8; ++q) gm_[q] = *(const LAS f32x4*)(bb + RB_GAM + (hi * 32 + 4 * q) * 4); \
        _Pragma("unroll") for (int q = 0; q < 4; ++q) dd_[q] = *(const LAS v4u*)(bb + RB_DD + ((((q >> 1) * 2 + ib) * 2 + (q & 1)) * 64 + lane) * 16); \
        _Pragma("unroll") for (int q = 0; q < 8; ++q) pf_[q] = *(const LAS v4u*)(bb + RB_PF + (q * 64 + lane) * 16); \
        _Pragma("unroll") for (int q = 0; q < 2; ++q) yd_[q] = *(const LAS v4u*)(bb + RB_YD + ((2 * ib + q) * 64 + lane) * 16); \
        _Pragma("unroll") for (int q = 0; q < 4; ++q) qf_[q] = *(const LAS v4u*)(bb + RB_QF + (q * 64 + lane) * 16); \
        __builtin_amdgcn_sched_barrier(0); \
        v4u Sf[4]; _Pragma("unroll") for (int s = 0; s < 4; ++s) Sf[s] = FRAGACC(S[s >> 1], s & 1); \
        _Pragma("unroll") for (int rb = 0; rb < 2; ++rb) { \
            f32x16 acc; unpack16(dd_[2 * rb], dd_[2 * rb + 1], acc); \
            _Pragma("unroll") for (int q = 0; q < 4; ++q) { const f32x4 gv = gm_[4 * rb + q]; _Pragma("unroll") for (int e = 0; e < 4; ++e) acc[4 * q + e] += gv[e] * S[rb][4 * q + e]; } \
            _Pragma("unroll") for (int s = 0; s < 4; ++s) acc = MFMA32(pf_[rb * 4 + s], Sf[s], acc); \
            S[rb] = acc; } \
        f32x16 y; unpack16(yd_[0], yd_[1], y); \
        _Pragma("unroll") for (int s = 0; s < 4; ++s) y = MFMA32(Sf[s], qf_[s], y); \
        float s1 = 0.f, s2 = 0.f; LAS float* yb_ = ybuf + (((ci_) & 1) * 2 + ib) * 1024 + lane; \
        _Pragma("unroll") for (int r = 0; r < 16; ++r) { s1 += y[r]; s2 += y[r] * y[r]; yb_[r * 64] = y[r]; } \
        s1 = swap32_sum(s1); s2 = swap32_sum(s2); \
        if (hi == 0) { stat[((((ci_) & 1) * 2 + ib) * 32 + l31) * 2] = s1; stat[((((ci_) & 1) * 2 + ib) * 32 + l31) * 2 + 1] = s2; } } while (0)
#define RB_BAR() do { asm volatile("s_waitcnt lgkmcnt(0)" ::: "memory"); __builtin_amdgcn_s_barrier(); asm volatile("" ::: "memory"); } while (0)
    if (wid < 2) {
        RB_BAR();
#pragma unroll 1
        for (int k = 0; k < NS; ++k) { CONS(k); RB_BAR(); }
        RB_BAR();
    } else if (wid == 4 || wid == 5) {
        const GAS v4u* gA = (const GAS v4u*)(wid == 4 ? Dm.PF : Dm.DD) + lane; const GAS v4u* gB = (const GAS v4u*)(wid == 4 ? Dm.QF : Dm.YD) + lane;
        const int oA = wid == 4 ? RB_PF : RB_DD, oB = wid == 4 ? RB_QF : RB_YD;
#define LD_ISSUE(ci_) do { const size_t u_ = (size_t)((ci_) < NS ? (ci_) : NS - 1) * (BATCH * RH) + bh; LAS unsigned char* b_ = lds + ((ci_) & (RB_NB - 1)) * RB_BUF; \
        _Pragma("unroll") for (int q = 0; q < 8; ++q) __builtin_amdgcn_global_load_lds((const unsigned*)(gA + u_ * 512 + q * 64), (LAS unsigned*)(b_ + oA + q * 1024), 16, 0, RB_AUX); \
        _Pragma("unroll") for (int q = 0; q < 4; ++q) __builtin_amdgcn_global_load_lds((const unsigned*)(gB + u_ * 256 + q * 64), (LAS unsigned*)(b_ + oB + q * 1024), 16, 0, RB_AUX); \
        if (lane < 16) __builtin_amdgcn_global_load_lds((const unsigned*)((const GAS v4u*)(Dm.GAM + u_ * 64) + lane), (LAS unsigned*)(b_ + RB_GAM), 16, 0, 0); } while (0)
        LD_ISSUE(0); LD_ISSUE(1); LD_ISSUE(2);
        asm volatile("s_waitcnt vmcnt(26)" ::: "memory");
        RB_BAR();
#pragma unroll 1
        for (int k = 0; k < NS; ++k) { LD_ISSUE(k + 3); asm volatile("s_waitcnt vmcnt(26)" ::: "memory"); RB_BAR(); }
        asm volatile("s_waitcnt vmcnt(0)" ::: "memory");
        RB_BAR();
#undef LD_ISSUE
    } else {
        RbEpi eA, eB, eC; f32x4 emu[2], elw[2], elb[2];
#pragma unroll
        for (int rg = 0; rg < 2; ++rg) { const int hc_ = h * 64 + 8 * ep + 4 * rg; emu[rg] = *(const GAS f32x4*)(F.shift_mu + 1024 + hc_); elw[rg] = *(const GAS f32x4*)(F.ln_w + hc_); elb[rg] = *(const GAS f32x4*)(F.ln_b + hc_); }
        EP_LOAD(eA, 0); EP_LOAD(eB, 1);
        RB_BAR();
        EP_LOAD(eC, 2); RB_BAR();
#define HY_STEP(k_, EP) do { EP_RUN(EP, (k_) - 1); EP_LOAD(EP, (k_) + 2); RB_BAR(); } while (0)
#pragma unroll 1
        for (int k = 1; k < NS; k += 3) { HY_STEP(k, eA); HY_STEP(k + 1, eB); HY_STEP(k + 2, eC); }
        EP_RUN(eA, NS - 1);
        RB_BAR();
#undef HY_STEP
    }
#undef RB_BAR
#undef ST_LOAD
#undef ST_STORE
#undef EP_LOAD
#undef EP_RUN
#undef CONS
}
constexpr int CW_G17 = 12288;
struct OneUnit { int pm, pn;
    __device__ __forceinline__ bool next(int i, pg8::Unit& u) const { if (i != 0) return false; u.pm = pm; u.pn = pn; return true; }
    __device__ __forceinline__ void a_ready(const pg8::Unit&) const {}
    __device__ __forceinline__ void done(const pg8::Unit&) const {} };
constexpr int AT_OUT = 65536, AT_G0 = 114688, AT_G1 = LDSCTL_OFF + 1024;
constexpr int AT_KB = 64 * 256, AT_VB = 64 * 256, AT_BUF = AT_KB + AT_VB, AT_QOFF = 2 * AT_KB + 3 * AT_VB;
__device__ __forceinline__ s16x4 vtr(const LAS unsigned char* p) { typedef short v4i16_t __attribute__((ext_vector_type(4))); return __builtin_bit_cast(s16x4, __builtin_amdgcn_ds_read_tr16_b64_v4i16((LAS v4i16_t*)p)); }
__device__ __forceinline__ void glds16_asm(const void* gsrc, unsigned lds_dst) {
    unsigned keep; const unsigned d_ = __builtin_amdgcn_readfirstlane(lds_dst);
    asm volatile("s_mov_b32 %0, m0\n\ts_mov_b32 m0, %2\n\ts_nop 0\n\tglobal_load_lds_dwordx4 %1, off\n\ts_mov_b32 m0, %0" : "=&s"(keep) : "v"(gsrc), "s"(d_) : "memory");
}
__device__ __forceinline__ void attn_unit(Frame& F, int b, int h, int qb) {
    int lane = mk_lane(); asm volatile("" : "+v"(lane));
    const int wid = F.wave, tid = wid * 64 + lane, l31 = lane & 31, hi = lane >> 5, map = wid >> 2, qs = wid & 3;
    LAS unsigned char* lds = F.lds + RING_OFF;
    const float slope2 = exp2f(-2.f * (float)(h + 1)) * LOG2E, shift2 = __uint_as_float(F.MISC[15]);
    const int q0 = qb * 128, qrow = q0 + 32 * qs + l31;
    const size_t mrow = (size_t)b * T + qrow;
    LAS bf16x8* qpark = (LAS bf16x8*)(lds + AT_QOFF + wid * 4096) + lane;
    { const bf16* qp = F.PROJ + mrow * NP + C_DQ + h * 128 + map * 64 + 8 * hi;
      v4u qraw[4]; float ss = 0.f;
#pragma unroll
      for (int s = 0; s < 4; ++s) qraw[s] = *(const GAS v4u*)(qp + 16 * s);
#pragma unroll
      for (int s = 0; s < 4; ++s)
#pragma unroll
          for (int j = 0; j < 4; ++j) { const float a_ = bflo(qraw[s][j]), b_ = bfhi(qraw[s][j]); ss += a_ * a_ + b_ * b_; }
      ss = swap32_sum(ss);
      const float rq = __builtin_amdgcn_rsqf(ss * (1.f / 64.f) + 1e-6f) * C2;
#pragma unroll
      for (int s = 0; s < 4; ++s) { const f32x4 g0 = *(const GAS f32x4*)(F.qn_g + 8 * hi + 16 * s), g1 = *(const GAS f32x4*)(F.qn_g + 8 * hi + 16 * s + 4);
          v4u w_; w_.x = cvtpk2(bflo(qraw[s].x) * rq * g0.x, bfhi(qraw[s].x) * rq * g0.y); w_.y = cvtpk2(bflo(qraw[s].y) * rq * g0.z, bfhi(qraw[s].y) * rq * g0.w);
          w_.z = cvtpk2(bflo(qraw[s].z) * rq * g1.x, bfhi(qraw[s].z) * rq * g1.y); w_.w = cvtpk2(bflo(qraw[s].w) * rq * g1.z, bfhi(qraw[s].w) * rq * g1.w);
          *(LAS v4u*)(qpark + s * 64) = w_; } }
    const bf16* kg = F.PROJ + (size_t)b * T * NP + C_DK + h * 128;
    const bf16* vg = F.PROJ + (size_t)b * T * NP + C_DV + h * 128;
    const int NT = 2 * qb + 2, tl = 2 * qb + (qs >> 1);
    const int Wk = (int)__builtin_ceilf((2.f * shift2 + 32.2f) / slope2);
    const int tf = __builtin_amdgcn_readfirstlane(max(0, (qb * 128 - Wk) >> 6));
    constexpr int AT_V0 = 2 * AT_KB;
    const int drow0 = 4 * wid + (lane >> 4), drow1 = drow0 + 32, dch = lane & 15;
    const unsigned ksrc0 = (unsigned)(drow0 * NP + ((dch ^ (drow0 & 15)) * 8)), ksrc1 = (unsigned)(drow1 * NP + ((dch ^ (drow1 & 15)) * 8));
    const unsigned vsrc0 = (unsigned)(drow0 * NP + ((dch ^ ((drow0 & 3) << 2)) * 8)), vsrc1 = (unsigned)(drow1 * NP + ((dch ^ ((drow1 & 3) << 2)) * 8));
#define AT_DMA(t_, kb_, v3_) do { const size_t tb_ = (size_t)(64 * (t_)) * NP; const unsigned bk_ = (unsigned)(size_t)(lds + (kb_) * AT_KB + wid * 1024), bv_ = (unsigned)(size_t)(lds + AT_V0 + (v3_) * AT_VB + wid * 1024); \
        glds16_asm(kg + tb_ + ksrc0, bk_); glds16_asm(kg + tb_ + ksrc1, bk_ + 8192u); glds16_asm(vg + tb_ + vsrc0, bv_); glds16_asm(vg + tb_ + vsrc1, bv_ + 8192u); } while (0)
#define AT_LAND() asm volatile("s_waitcnt vmcnt(0)" ::: "memory")
    f32x16 o[4];
#pragma unroll
    for (int vb = 0; vb < 4; ++vb) o[vb] = f32x16{};
    float lsum = 0.f;
    AT_DMA(tf, tf & 1, tf % 3);
    { const int gr_ = 16 * wid + (lane >> 4); const bf16* gsrc = F.PROJ + ((size_t)b * T + q0 + gr_) * NP + C_GB + h * 128;
      LAS unsigned char* gdst = F.lds + (wid < 4 ? AT_G0 + wid * 4096 : AT_G1 + (wid - 4) * 4096);
#pragma unroll
      for (int j = 0; j < 4; ++j) __builtin_amdgcn_global_load_lds((const unsigned*)(gsrc + (size_t)(4 * j) * NP + (((lane & 15) ^ (4 * j + (lane >> 4))) * 8)), (LAS unsigned*)(gdst + j * 1024), 16, 0, 0); }
    AT_LAND(); __syncthreads();
    const int G = lane >> 4, qq = (lane & 15) >> 2, pp = lane & 3;
    const int vrow = (4 * hi + qq) * 256 + 8 * (pp & 1), vch = 2 * (G & 1) + (pp >> 1);
    v4u pw[4];
#define SBAR_() __builtin_amdgcn_sched_barrier(0)
#define AT_QK(t) do { \
            const LAS unsigned char* Kb = lds + ((t) & 1) * AT_KB; \
            float sl_ = slope2; asm volatile("" : "+v"(sl_));     \
            const float base = sl_ * (float)(64 * (t) + 4 * hi - qrow) - shift2; \
            float ls = 0.f; \
            _Pragma("unroll") for (int hf = 0; hf < 2; ++hf) {        \
                f32x16 p; \
                _Pragma("unroll") for (int r = 0; r < 16; ++r) p[r] = __builtin_fmaf(sl_, (float)(32 * hf + (r & 3) + 8 * (r >> 2)), base); \
                _Pragma("unroll") for (int s = 0; s < 4; ++s) { \
                    const bf16x8 a0 = *(const LAS bf16x8*)(Kb + (32 * hf + l31) * 256 + (((map * 8 + 2 * s + hi) ^ (l31 & 15)) * 16)); \
                    p = __builtin_amdgcn_mfma_f32_32x32x16_bf16(a0, qpark[s * 64], p, 0, 0, 0); } \
                if ((t) == tl) { \
                    _Pragma("unroll") for (int r = 0; r < 16; ++r) { const int ki = 64 * (t) + 32 * hf + 4 * hi + (r & 3) + 8 * (r >> 2); if (ki > qrow) p[r] = -1e30f; } } \
                _Pragma("unroll") for (int r = 0; r < 16; ++r) { p[r] = __builtin_amdgcn_exp2f(p[r]); ls += p[r]; } \
                pw[2 * hf] = (v4u){cvtpk(p[0], p[1]), cvtpk(p[2], p[3]), cvtpk(p[4], p[5]), cvtpk(p[6], p[7])}; \
                pw[2 * hf + 1] = (v4u){cvtpk(p[8], p[9]), cvtpk(p[10], p[11]), cvtpk(p[12], p[13]), cvtpk(p[14], p[15])}; } \
            lsum += ls; } while (0)
#define AT_VRD(dst, ks, vb0) do { _Pragma("unroll") for (int vb = (vb0); vb < (vb0) + 2; ++vb) { const LAS unsigned char* a_ = Vb + vrow + ((4 * vb + vch) ^ (qq << 2)) * 16 + (32 * ((ks) >> 1) + 16 * ((ks) & 1)) * 256; \
        dst[2 * (vb - (vb0))] = vtr(a_); dst[2 * (vb - (vb0)) + 1] = vtr(a_ + 8 * 256); } } while (0)
#define AT_PV(src, pwk, vb0) do { _Pragma("unroll") for (int vb = (vb0); vb < (vb0) + 2; ++vb) { const int j_ = 2 * (vb - (vb0)); \
        const bf16x8 vf = (bf16x8){src[j_][0], src[j_][1], src[j_][2], src[j_][3], src[j_ + 1][0], src[j_ + 1][1], src[j_ + 1][2], src[j_ + 1][3]}; \
        o[vb] = __builtin_amdgcn_mfma_f32_32x32x16_bf16(vf, __builtin_bit_cast(bf16x8, pwk), o[vb], 0, 0, 0); } } while (0)
#define AT_PVV(v3_) do { const LAS unsigned char* Vb = lds + AT_V0 + (v3_) * AT_VB; s16x4 vA[4], vB[4]; \
            AT_VRD(vA, 0, 0); SBAR_(); AT_VRD(vB, 0, 2); SBAR_(); \
            AT_PV(vA, pw[0], 0); SBAR_(); AT_VRD(vA, 1, 0); SBAR_(); AT_PV(vB, pw[0], 2); SBAR_(); AT_VRD(vB, 1, 2); SBAR_(); \
            AT_PV(vA, pw[1], 0); SBAR_(); AT_VRD(vA, 2, 0); SBAR_(); AT_PV(vB, pw[1], 2); SBAR_(); AT_VRD(vB, 2, 2); SBAR_(); \
            AT_PV(vA, pw[2], 0); SBAR_(); AT_VRD(vA, 3, 0); SBAR_(); AT_PV(vB, pw[2], 2); SBAR_(); AT_VRD(vB, 3, 2); SBAR_(); \
            AT_PV(vA, pw[3], 0); SBAR_(); AT_PV(vB, pw[3], 2); } while (0)
    if (map == 0) {
        int v3 = tf % 3;
#pragma unroll 1
        for (int t = tf; t < NT; ++t) { const int vn = v3 == 2 ? 0 : v3 + 1;
            if (t + 1 < NT) AT_DMA(t + 1, (t + 1) & 1, vn);
            if (t <= tl) { AT_QK(t); AT_PVV(v3); }
            AT_LAND(); __syncthreads(); v3 = vn; }
    } else {
        int v3 = tf % 3;
#pragma unroll 1
        for (int t = tf; t < NT; ++t) { const int vp = v3 == 0 ? 2 : v3 - 1, vn = v3 == 2 ? 0 : v3 + 1;
            if (t + 1 < NT) AT_DMA(t + 1, (t + 1) & 1, vn);
            if (t > tf && t - 1 <= tl) AT_PVV(vp);
            if (t <= tl) AT_QK(t);
            AT_LAND(); __syncthreads(); v3 = vn; }
        if (NT - 1 <= tl) { const int vp = v3 == 0 ? 2 : v3 - 1; AT_PVV(vp); }
    }
#undef AT_PVV
#undef AT_QK
#undef AT_VRD
#undef AT_PV
#undef SBAR_
#undef AT_DMA
#undef AT_LAND
    __syncthreads();
    const float ltot = swap32_sum(lsum);
    LAS float* X = (LAS float*)lds;
    if (map == 1) {
        const float sc = __uint_as_float(F.MISC[14]) / ltot;
#pragma unroll
        for (int vb = 0; vb < 4; ++vb)
#pragma unroll
            for (int r = 0; r < 16; ++r) X[(qs * 64 + vb * 16 + r) * 64 + lane] = o[vb][r] * sc;
    }
    __syncthreads();
    if (map == 0) {
        const float il = 1.f / ltot; float ss = 0.f;
#pragma unroll
        for (int vb = 0; vb < 4; ++vb)
#pragma unroll
            for (int r = 0; r < 16; ++r) { const float v = o[vb][r] * il - X[(qs * 64 + vb * 16 + r) * 64 + lane]; o[vb][r] = v; ss += v * v; }
        ss = swap32_sum(ss);
        const float rn = (1.f / sqrtf(ss * (1.f / 128.f) + 1e-5f)) * (1.f - LAMBDA_INIT);
        int etok = 0; asm volatile("" : "+v"(etok));
        const int lane_e = mk_lane(), hi = lane_e >> 5, row = 32 * qs + (lane_e & 31);
        const LAS unsigned char* grow = F.lds + (qs < 2 ? AT_G0 : AT_G1 - 64 * 256) + row * 256 + 8 * hi;
        LAS unsigned char* orow = lds + AT_OUT + row * 256 + 8 * hi;
#pragma unroll
        for (int vb = 0; vb < 4; ++vb)
#pragma unroll
            for (int rg = 0; rg < 4; ++rg) {
                const int vc = 32 * vb + 8 * rg + 4 * hi, ch = (((4 * vb + rg) ^ (row & 15)) * 16) + etok;
                const v2u gw = *(const LAS v2u*)(grow + ch); const f32x4 sg = *(const GAS f32x4*)(F.subln_g + vc);
                const float g4[4] = {bflo(gw.x), bfhi(gw.x), bflo(gw.y), bfhi(gw.y)}; float ov[4];
#pragma unroll
                for (int e = 0; e < 4; ++e) ov[e] = o[vb][4 * rg + e] * rn * sg[e] * g4[e] / (1.f + __expf(-g4[e]));
                const unsigned w1_ = cvtpk(ov[2], ov[3]);
                *(LAS v2u*)(orow + ch) = (v2u){cvtpk(ov[0], ov[1]), w1_};
                if (rg == 3) asm volatile("" : "+v"(etok) : "v"(w1_));
            }
    }
    __syncthreads();
    { const int t_ = wid * 64 + mk_lane(); bf16* ob = F.MIX + ((size_t)b * T + q0) * D + 512 + h * 128;
#pragma unroll
      for (int i = 0; i < 4; ++i) { const int pc = t_ + 512 * i, r_ = pc >> 4, c_ = pc & 15;
          *(GAS v4u*)(ob + (size_t)r_ * D + c_ * 8) = *(const LAS v4u*)(lds + AT_OUT + r_ * 256 + ((c_ ^ (r_ & 15)) * 16)); } }
    __syncthreads();
}
#ifndef DBL
#define DBL 0
#endif
constexpr int CW_QUEUE = 8192;
constexpr int QX_RW = 8, QX_A2 = 0, QX_AT = 64, QX_ALL = QX_RW + QX_A2 + QX_AT;
template <int MODE = 0> __device__ __forceinline__ void p3_queue(Frame& F, const RwDump& Dm, const int qbase = CW_QUEUE) {
    const int ql = mk_lane();
    const float l1 = wave_sum(F.lq1[ql] * F.lk1[ql]), l2 = wave_sum(F.lq2[ql] * F.lk2[ql]);
    const float lam = __uint_as_float(__builtin_amdgcn_readfirstlane(__float_as_uint(__expf(l1) - __expf(l2) + LAMBDA_INIT)));
    float gq = fabsf(F.qn_g[ql]), gk = fabsf(F.kn_g[ql]);
#pragma unroll
    for (int o = 1; o < 64; o <<= 1) { gq = fmaxf(gq, __shfl_xor(gq, o)); gk = fmaxf(gk, __shfl_xor(gk, o)); }
    const float shift2 = __uint_as_float(__builtin_amdgcn_readfirstlane(__float_as_uint(8.f * gq * gk * LOG2E)));
    if (F.wave == 0 && mk_lane() == 0) { F.MISC[14] = __float_as_uint(lam); F.MISC[15] = __float_as_uint(shift2); }
    __syncthreads();
#ifdef Q_BLK
    const int x0 = (int)(blockIdx.x & 7);
#else
    const int x0 = (int)(xb_xcc_id() & 7u);
#endif
#pragma unroll 1
    for (int dx = 0; dx < 8; ++dx) {
        const int xq = (x0 + dx) & 7;
        for (;;) {
            if (F.wave == 0 && mk_lane() == 0) F.MISC[12] = __hip_atomic_fetch_add(F.ctl + qbase + 64 * xq, 1u, RLX_AGENT);
            __syncthreads();
            int item = __builtin_amdgcn_readfirstlane((int)F.MISC[12]); if (MODE == 2) item += QX_RW;
            __syncthreads();
            if (item >= (MODE == 1 ? QX_RW : QX_ALL)) break;
            if (item < QX_RW) { rwkvB_unit(F, Dm, xq * 8 + item); if (DBL & 64) rwkvB_unit(F, Dm, xq * 8 + item); }
            else { const int idx = item - QX_RW - QX_A2, h = 3 - (idx >> 4), qb = 15 - (idx & 15);
#pragma unroll 1
#ifndef NO_ATT
                for (int rep = 0; rep < ((DBL & 32) ? 2 : 1); ++rep) attn_unit(F, xq, h, qb);
#endif
            }
        }
    }
}

constexpr int GT_STAGE = 40960, GT_NS = 3, GT_NK = D / 64;
__device__ __forceinline__ void gemm1_tail_unit(Frame& F, int qu) {
    int lane = mk_lane(); asm volatile("" : "+v"(lane));
    const int wid = F.wave, l31 = lane & 31, hi = lane >> 5;
    const int xcd = qu & 7, j = qu >> 3, R0 = (8 * xcd + (j & 7)) * 256 + (j >> 3) * 64;
    LAS unsigned char* lds = F.lds + RING_OFF;
    const int vr0 = 40 * wid + (lane >> 3), cp = lane & 7;
#define GT_ISSUE(kc_) do { LAS unsigned char* sb_ = lds + ((kc_) % GT_NS) * GT_STAGE + wid * 5120; \
        _Pragma("unroll") for (int i = 0; i < 5; ++i) { const int v_ = vr0 + 8 * i; \
            const bf16* src_ = (5 * wid + i < 8 ? F.XN + (size_t)(R0 + v_) * D : F.WinT + (size_t)(4096 + v_ - 64) * D) + (kc_) * 64 + ((cp ^ ((v_ >> 1) & 7)) * 8); \
            __builtin_amdgcn_global_load_lds((const unsigned*)src_, (LAS unsigned*)(sb_ + i * 1024), 16, 0, 0); } } while (0)
    f32x16 acc0 = f32x16{}, acc1 = f32x16{};
    const int nW = 32 * wid + l31, offW = 8192 + nW * 128, kyW = (nW >> 1) & 7, offX0 = l31 * 128, offX1 = (32 + l31) * 128, kyX = (l31 >> 1) & 7;
    GT_ISSUE(0); GT_ISSUE(1);
#pragma unroll 1
    for (int kc = 0; kc < GT_NK; ++kc) {
        if (kc + 1 < GT_NK) asm volatile("s_waitcnt vmcnt(5)" ::: "memory"); else asm volatile("s_waitcnt vmcnt(0)" ::: "memory");
        __builtin_amdgcn_s_barrier(); asm volatile("" ::: "memory");
        if (kc + 2 < GT_NK) GT_ISSUE(kc + 2);
        const LAS unsigned char* sb = lds + (kc % GT_NS) * GT_STAGE;
        v4u wf[4], x0[4], x1[4];
#pragma unroll
        for (int s = 0; s < 4; ++s) { wf[s] = *(const LAS v4u*)(sb + offW + (((2 * s + hi) ^ kyW) * 16)); x0[s] = *(const LAS v4u*)(sb + offX0 + (((2 * s + hi) ^ kyX) * 16)); x1[s] = *(const LAS v4u*)(sb + offX1 + (((2 * s + hi) ^ kyX) * 16)); }
#pragma unroll
        for (int s = 0; s < 4; ++s) { acc0 = MFMA32(wf[s], x0[s], acc0); acc1 = MFMA32(wf[s], x1[s], acc1); }
        asm volatile("s_waitcnt lgkmcnt(0)" ::: "memory");
    }
#undef GT_ISSUE
    bf16* op = F.PROJ + (size_t)(R0 + l31) * NP + 4096 + 32 * wid + 4 * hi;
#pragma unroll
    for (int q = 0; q < 4; ++q) {
        *(GAS v2u*)(op + 8 * q) = (v2u){cvtpk(acc0[4 * q], acc0[4 * q + 1]), cvtpk(acc0[4 * q + 2], acc0[4 * q + 3])};
        *(GAS v2u*)(op + (size_t)32 * NP + 8 * q) = (v2u){cvtpk(acc1[4 * q], acc1[4 * q + 1]), cvtpk(acc1[4 * q + 2], acc1[4 * q + 3])}; }
    __syncthreads();
}
struct Args { const float* in[21]; float* out; unsigned char* ws; int ph_lo, ph_hi; };
__global__ void __launch_bounds__(NWAVES * 64, 2) hymba_fwd(Args args) {
    extern __shared__ __attribute__((aligned(16))) unsigned char lds[];
    Frame F;
    F.lds = (LAS unsigned char*)lds;
    F.MISC = (volatile LAS unsigned*)(F.lds + MISC_OFF);
    F.wave = __builtin_amdgcn_readfirstlane((int)threadIdx.x >> 6); F.lane = mk_lane(); F.tid = F.wave * 64 + F.lane;
    F.G = gridDim.x; { const int bx = blockIdx.x; F.vcu = (F.G % 8 == 0) ? (bx % 8) * (F.G / 8) + bx / 8 : bx; }
    unsigned char* ws = args.ws;
    F.ctl = (gu32*)(ws + WS_CTL);
    F.x = args.in[0]; F.norm_g = args.in[1]; F.w_in = args.in[2]; F.shift_mu = args.in[3]; F.w0 = args.in[4]; F.w_decay_up = args.in[5]; F.a0 = args.in[6]; F.w_iclr_up = args.in[7];
    F.k_k = args.in[8]; F.k_a = args.in[9]; F.r_k = args.in[10]; F.ln_w = args.in[11]; F.ln_b = args.in[12]; F.qn_g = args.in[13]; F.kn_g = args.in[14];
    F.lq1 = args.in[15]; F.lk1 = args.in[16]; F.lq2 = args.in[17]; F.lk2 = args.in[18]; F.subln_g = args.in[19]; F.w_out = args.in[20]; F.out = args.out;
    F.WinT = (bf16*)(ws + WS_WIN); F.WoutT = (bf16*)(ws + WS_WOUT); F.WdT = (bf16*)(ws + WS_WD); F.WaT = (bf16*)(ws + WS_WA);
    F.XN = (bf16*)(ws + WS_XN); F.PROJ = (bf16*)(ws + WS_PROJ); F.MIX = (bf16*)(ws + WS_MIX);
    for (int u = F.tid; u < (LDS_BYTES - LDSCTL_OFF) / 4; u += NWAVES * 64) ((LAS unsigned*)(F.lds + LDSCTL_OFF))[u] = 0u;
    __syncthreads();
    XcdBarrier bar; bar.bar = (unsigned*)(F.ctl + CW_BAR); bar.x = 0; bar.st = nullptr; bar.wave = F.wave;
    if (MK_N_LAUNCHES == 1) bar = xcd_barrier_post((unsigned*)(F.ctl + CW_BAR), F.MISC + 8, F.wave);
#define GRID_BAR() do { if (MK_N_LAUNCHES == 1) xcd_barrier(bar); } while (0)
    const int lo = args.ph_lo, hi = args.ph_hi;
#define IN(k) (lo <= (k) && (k) < hi)
#define BOTH(k) (IN(k) && IN((k) + 1))
#ifndef SKIP
#define SKIP 0
#endif
    if (IN(0) && !(SKIP & 1)) { p0_prologue(F); if (DBL & 1) { GRID_BAR(); p0_prologue(F); } if (BOTH(0)) GRID_BAR(); }
    if (IN(1) && !(SKIP & 2)) {
        pg8::Gemm g{F.XN, F.WinT, M, 4096, D}; pg8::StaticOrder S; S.init(M, 4096, F.G, (int)blockIdx.x);
        pg8::EpiBf16S E{F.PROJ, NP};
        pg8::gemm_phase<pg8::EpiBf16S, pg8::StaticOrder, true, true>(F.lds + RING_OFF, g, S, E, F.wave);
#pragma unroll 1
        for (int qu = (int)blockIdx.x; qu < 256; qu += F.G) gemm1_tail_unit(F, qu);
#ifdef TAILX2
#pragma unroll 1
        for (int rep = 0; rep < TAILX2; ++rep) {
#pragma unroll 1
        for (int qu = (int)blockIdx.x; qu < 256; qu += F.G) gemm1_tail_unit(F, qu); }
#endif
        if (DBL & 2) { GRID_BAR(); pg8::gemm_phase<pg8::EpiBf16S, pg8::StaticOrder, true, true>(F.lds + RING_OFF, g, S, E, F.wave); }
        if (BOTH(1)) GRID_BAR();
    }
    RwDump Dm; { unsigned char* so = (unsigned char*)args.out; Dm.PF = (v4u*)so; Dm.DD = (v4u*)(so + 32 * MiB); Dm.QF = (v4u*)(ws + WS_XN); Dm.YD = (v4u*)(ws + WS_XN + 16 * MiB);
        Dm.GAM = (float*)(ws + WS_END); Dm.RHO = (float*)(ws + WS_END + 1 * MiB); }
    if (IN(2) && !(SKIP & 4)) {
        LAS float* wscr = (LAS float*)(F.lds + LDSCTL_OFF + 1024) + F.wave * 64; int zpar = 0;
#pragma unroll 1
        for (int p = F.vcu; p < BATCH * (T / 32); p += F.G) { rwkvA_unit(F, Dm, (p >> 6) * RH + F.wave, p & 63, wscr, F.lds + RING_OFF + F.wave * 16384, (LAS v4u*)(F.lds + LDSCTL_OFF + 4096), zpar); zpar ^= 1; }
        if (DBL & 4) { GRID_BAR();
#pragma unroll 1
            for (int p = F.vcu; p < BATCH * (T / 32); p += F.G) { rwkvA_unit(F, Dm, (p >> 6) * RH + F.wave, p & 63, wscr, F.lds + RING_OFF + F.wave * 16384, (LAS v4u*)(F.lds + LDSCTL_OFF + 4096), zpar); zpar ^= 1; } }
        p2_qknorm(F);
        if (BOTH(2)) GRID_BAR();
    }
    if (IN(3) && !(SKIP & 8)) {
#ifdef P3SPLIT
        p3_queue<1>(F, Dm); GRID_BAR(); p3_queue<2>(F, Dm, CW_QUEUE + 1024);
#else
        p3_queue(F, Dm);
#endif
        if (DBL & 512) { GRID_BAR(); p3_queue(F, Dm, CW_QUEUE + 1024); }
        if (BOTH(3)) GRID_BAR();
    }
    if (IN(4) && !(SKIP & 16)) {
        pg8::Gemm g{F.MIX, F.WoutT, M, D, D}; pg8::StaticOrder S; S.init(M, D, F.G, (int)blockIdx.x);
        pg8::EpiResF32 E{F.x, F.out, D};
        pg8::gemm_phase<pg8::EpiResF32, pg8::StaticOrder, false, true>(F.lds + RING_OFF, g, S, E, F.wave);
        if (DBL & 16) { GRID_BAR(); pg8::gemm_phase<pg8::EpiResF32, pg8::StaticOrder, false, true>(F.lds + RING_OFF, g, S, E, F.wave); }
    }
#undef IN
#undef BOTH
}

extern "C" void kernel_launch(void* const* d_in, const int* in_sizes, int n_in, void* d_out, int out_size, void* d_ws, size_t ws_size, hipStream_t stream) {
    static int grid = 0;
    if (grid == 0) {
        if (n_in != 21 || in_sizes[0] != M * D || out_size != M * D || ws_size < WS_END + 2 * MiB) { fprintf(stderr, "kernel_launch: unexpected shapes (n_in %d, in0 %d, out %d, ws %zu); nothing launched\n", n_in, n_in > 0 ? in_sizes[0] : -1, out_size, ws_size); grid = -1; return; }
        int dev = 0, cus = 0, per_cu = 0;
        if (hipGetDevice(&dev) != hipSuccess || hipDeviceGetAttribute(&cus, hipDeviceAttributeMultiprocessorCount, dev) != hipSuccess) { grid = -1; return; }
        if (hipFuncSetAttribute((const void*)hymba_fwd, hipFuncAttributeMaxDynamicSharedMemorySize, LDS_BYTES) != hipSuccess) { fprintf(stderr, "kernel_launch: hipFuncSetAttribute failed\n"); grid = -1; return; }
        if (hipOccupancyMaxActiveBlocksPerMultiprocessor(&per_cu, (const void*)hymba_fwd, NWAVES * 64, LDS_BYTES) != hipSuccess || per_cu < 1) { fprintf(stderr, "kernel_launch: occupancy query reports %d workgroups per CU; nothing launched\n", per_cu); grid = -1; return; }
        (void)hipGetLastError();
        grid = cus;
        if (grid > 256) grid = 256;
    }
    if (grid < 0) return;
    if (hipMemsetAsync((char*)d_ws + WS_CTL, 0, CTL_ZERO_BYTES, stream) != hipSuccess) { fprintf(stderr, "kernel_launch: hipMemsetAsync failed\n"); return; }
    Args a{};
    for (int i = 0; i < 21; ++i) a.in[i] = (const float*)d_in[i];
    a.out = (float*)d_out; a.ws = (unsigned char*)d_ws;
    for (int li = 0; li < MK_N_LAUNCHES; ++li) {
        a.ph_lo = (MK_N_LAUNCHES == 1) ? 0 : li; a.ph_hi = (MK_N_LAUNCHES == 1) ? N_PHASES : li + 1;
        hipLaunchKernelGGL(hymba_fwd, dim3(grid), dim3(NWAVES * 64), LDS_BYTES, stream, a);
        const hipError_t le = hipPeekAtLastError();
        if (le != hipSuccess) { fprintf(stderr, "kernel_launch: launch %d failed: %s\n", li, hipGetErrorName(le)); break; }
    }
}
```

```cpp
#include <hip/hip_runtime.h>
#include <hip/hip_bf16.h>
#include <cstdio>
#include <cstdint>
#include <cmath>
namespace pg8 {
#define PG8_LAS __attribute__((address_space(3)))
typedef unsigned short bf16_t;
typedef short bf16x8 __attribute__((ext_vector_type(8)));
typedef float f32x4 __attribute__((ext_vector_type(4)));
typedef unsigned u32x4 __attribute__((ext_vector_type(4)));
constexpr int BM = 256, BK = 64, HALF = 128, HTB = HALF * BK * 2  , STAGE_BYTES = 8 * HTB, NXCD = 8, WGM = 8;

__host__ __device__ __forceinline__ int lds_byte(int r, int c) { const int st = (r >> 4) * 2 + (c >> 5), rr = r & 15, cc = c & 31, ob = rr * 64 + cc * 2; return st * 1024 + (ob ^ (((ob >> 9) & 1) << 5)); }
__host__ __device__ __forceinline__ void stage_rc(int b, int& R, int& C) { const int st = b / 1024, sb = b % 1024, swz = sb ^ (((sb >> 9) & 1) << 5); R = (st >> 1) * 16 + swz / 64; C = (st & 1) * 32 + (swz % 64) / 2; }
__host__ __device__ __forceinline__ int perm32(int rho) { const int n = rho >> 4, i = rho & 15; return 8 * (i >> 2) + 4 * n + (i & 3); }

__device__ __forceinline__ int mk_lane_pg8() { int l; asm volatile("v_mbcnt_lo_u32_b32 %0, -1, 0\n\tv_mbcnt_hi_u32_b32 %0, -1, %0" : "=v"(l)); return l; }
struct Unit { int pm, pn; };
struct Gemm { const bf16_t* A; const bf16_t* Bt; int M, N, K; };

struct StaticOrder {
    int nM, nN, nwg, G, c;
    __host__ __device__ void init(int M, int N, int G_, int c_) { nM = M / BM; nN = N / BM; nwg = nM * nN; G = G_; c = c_; }
    __host__ __device__ bool next(int i, Unit& u) const {
        const long L = (long)i * G + c; if (L >= nwg) return false;
        int wgid = (int)L; { const int q = nwg / NXCD, r = nwg % NXCD, xcd = wgid % NXCD, off = wgid / NXCD; wgid = (xcd < r ? xcd * (q + 1) : r * (q + 1) + (xcd - r) * q) + off; }
        const int nig = WGM * nN, gid = wgid / nig, fm = gid * WGM, gsz = (nM - fm) < WGM ? (nM - fm) : WGM;
        u.pm = fm + ((wgid % nig) % gsz); u.pn = (wgid % nig) / gsz; return true;
    }
    __device__ __forceinline__ void a_ready(const Unit&) const {}
    __device__ __forceinline__ void done(const Unit&) const {}
};

__device__ __forceinline__ unsigned cvt_pk_bf16(float lo, float hi) { unsigned r; asm volatile("v_cvt_pk_bf16_f32 %0, %1, %2" : "=v"(r) : "v"(lo), "v"(hi)); return r; }
struct EpiBf16S {
    static constexpr bool PERM = true, AFTER_DRAIN = false, HAS_INIT = false;
    bf16_t* O; int ldc;
    __device__ __forceinline__ void operator()(const f32x4 (&acc)[2][2][4][2], const Unit& u, int wr, int wc, int fr, int fq) const {
        const int row0 = u.pm * BM + wr * 64 + fr, col0 = u.pn * BM + wc * 32 + 8 * fq;
#pragma unroll
        for (int ai = 0; ai < 2; ++ai)
#pragma unroll
            for (int m = 0; m < 4; ++m) { bf16_t* rowp = O + (size_t)(row0 + ai * HALF + m * 16) * ldc + col0;
#pragma unroll
                for (int bj = 0; bj < 2; ++bj) { const f32x4 v0 = acc[ai][bj][m][0], v1 = acc[ai][bj][m][1];
                    u32x4 w; w.x = cvt_pk_bf16(v0[0], v0[1]); w.y = cvt_pk_bf16(v0[2], v0[3]); w.z = cvt_pk_bf16(v1[0], v1[1]); w.w = cvt_pk_bf16(v1[2], v1[3]);
                    *(u32x4*)(rowp + bj * HALF) = w; } }
    }
};
struct EpiResF32 {
    static constexpr bool PERM = false, AFTER_DRAIN = false, HAS_INIT = true;
    const float* base; float* out; int ldc;
    __device__ __forceinline__ void init(f32x4 (&acc)[2][2][4][2], const Unit& u, int wr, int wc, int fr, int fq) const {
        const int row0 = u.pm * BM + wr * 64 + fr, col0 = u.pn * BM + wc * 32 + 4 * fq;
#pragma unroll
        for (int ai = 0; ai < 2; ++ai)
#pragma unroll
            for (int m = 0; m < 4; ++m) { const size_t off = (size_t)(row0 + ai * HALF + m * 16) * ldc + col0;
#pragma unroll
                for (int bj = 0; bj < 2; ++bj)
#pragma unroll
                    for (int n = 0; n < 2; ++n) acc[ai][bj][m][n] = *(const f32x4*)(base + off + bj * HALF + n * 16); }
    }
    __device__ __forceinline__ void operator()(const f32x4 (&acc)[2][2][4][2], const Unit& u, int wr, int wc, int fr, int fq) const {
        const int row0 = u.pm * BM + wr * 64 + fr, col0 = u.pn * BM + wc * 32 + 4 * fq;
#pragma unroll
        for (int ai = 0; ai < 2; ++ai)
#pragma unroll
            for (int m = 0; m < 4; ++m) { const size_t off = (size_t)(row0 + ai * HALF + m * 16) * ldc + col0;
#pragma unroll
                for (int bj = 0; bj < 2; ++bj)
#pragma unroll
                    for (int n = 0; n < 2; ++n) *(f32x4*)(out + off + bj * HALF + n * 16) = acc[ai][bj][m][n]; }
    }
};
template <class Epi, class Sched, bool ALIGN_EPI = false, bool SP2 = false>
__device__ __forceinline__ void gemm_phase(PG8_LAS unsigned char* lds, const Gemm g, const Sched& S, const Epi& E, const int mk_wave_id  ) {
    const int wid = mk_wave_id, lane = mk_lane_pg8(), tid = wid * 64 + lane, wr = wid >> 2, wc = wid & 3, fr = lane & 15, fq = lane >> 4;
    const int K = g.K, nt = K / BK;
    unsigned voffA[2], voffB[2];
#pragma unroll
    for (int i = 0; i < 2; ++i) { int R, C; stage_rc(tid * 16 + i * 8192, R, C); const int Rb = Epi::PERM ? ((R & ~31) + perm32(R & 31)) : R;
        voffA[i] = (unsigned)(R * K + C) * 2u; voffB[i] = (unsigned)(Rb * K + C) * 2u; }
    const size_t kstep = (size_t)(BK * 2);
    const size_t hstep = (size_t)HALF * K * 2;
    const size_t tstep = 2 * hstep;
    const unsigned ldsw = (unsigned)wid * 1024u;
    const int aoff = lds_byte(wr * 64 + fr, fq * 8), boff = lds_byte(wc * 32 + fr, fq * 8);
#define PG8_SA(b, h) (((b) * 2 + (h)) * HTB)
#define PG8_SB(b, h) ((4 + (b) * 2 + (h)) * HTB)
#define PG8_STAGE(bufoff, gbase, voff) do { _Pragma("unroll") for (int _i = 0; _i < 2; ++_i) \
        __builtin_amdgcn_global_load_lds((const unsigned*)((const char*)(gbase) + (voff)[_i]), (PG8_LAS unsigned*)(lds + (bufoff) + ldsw + _i * 8192), 16, 0, 0); } while (0)
#define PG8_LDA(dst, b, h) do { _Pragma("unroll") for (int m = 0; m < 4; ++m) _Pragma("unroll") for (int k = 0; k < 2; ++k) dst[m][k] = *(const PG8_LAS bf16x8*)(lds + PG8_SA(b, h) + aoff + m * 2048 + k * 1024); } while (0)
#define PG8_LDB(dst, b, h) do { _Pragma("unroll") for (int n = 0; n < 2; ++n) _Pragma("unroll") for (int k = 0; k < 2; ++k) dst[n][k] = *(const PG8_LAS bf16x8*)(lds + PG8_SB(b, h) + boff + n * 2048 + k * 1024); } while (0)
#define PG8_MMA(ai, bj, At, Bt) do { __builtin_amdgcn_s_setprio(1); _Pragma("unroll") for (int m = 0; m < 4; ++m) _Pragma("unroll") for (int n = 0; n < 2; ++n) _Pragma("unroll") for (int k = 0; k < 2; ++k) \
        acc[ai][bj][m][n] = __builtin_amdgcn_mfma_f32_16x16x32_bf16(Bt[n][k], At[m][k], acc[ai][bj][m][n], 0, 0, 0); __builtin_amdgcn_s_setprio(0); } while (0)
#define PG8_WAIT_V(n) asm volatile("s_waitcnt vmcnt(" #n ")" ::: "memory")
#define PG8_WAIT_L(n) asm volatile("s_waitcnt lgkmcnt(" #n ")" ::: "memory")
#define PG8_BAR __builtin_amdgcn_s_barrier()
#define PG8_SCHED __builtin_amdgcn_sched_barrier(0)
    Unit cur, nxt; int ui = 0;
    if (!S.next(0, cur)) return;
    f32x4 acc[2][2][4][2];
#pragma unroll
    for (int a = 0; a < 2; ++a)
#pragma unroll
        for (int b = 0; b < 2; ++b)
#pragma unroll
            for (int m = 0; m < 4; ++m)
#pragma unroll
                for (int n = 0; n < 2; ++n) acc[a][b][m][n] = (f32x4){0.f, 0.f, 0.f, 0.f};
    if constexpr (Epi::HAS_INIT) E.init(acc, cur, wr, wc, fr, fq);
    bf16x8 At[4][2], B0[2][2], B1[2][2];
    const char* cA = (const char*)g.A + (size_t)cur.pm * tstep; const char* cB = (const char*)g.Bt + (size_t)cur.pn * tstep;
    S.a_ready(cur);
    if constexpr (SP2) {
        PG8_STAGE(PG8_SB(0, 0), cB, voffB); PG8_STAGE(PG8_SB(0, 1), cB + hstep, voffB); PG8_STAGE(PG8_SA(0, 0), cA, voffA); PG8_STAGE(PG8_SA(0, 1), cA + hstep, voffA);
        if (wr == 1) PG8_BAR;
        PG8_WAIT_V(2); PG8_BAR;
        PG8_STAGE(PG8_SB(1, 0), cB + kstep, voffB); PG8_STAGE(PG8_SA(1, 0), cA + kstep, voffA); PG8_STAGE(PG8_SB(1, 1), cB + hstep + kstep, voffB);
        PG8_WAIT_V(6); PG8_BAR;
    } else {
        PG8_STAGE(PG8_SB(0, 0), cB, voffB); PG8_STAGE(PG8_SA(0, 0), cA, voffA); PG8_STAGE(PG8_SB(0, 1), cB + hstep, voffB); PG8_STAGE(PG8_SA(0, 1), cA + hstep, voffA);
        if (wr == 1) PG8_BAR;
        PG8_WAIT_V(4); PG8_BAR;
        PG8_STAGE(PG8_SB(1, 0), cB + kstep, voffB); PG8_STAGE(PG8_SA(1, 0), cA + kstep, voffA); PG8_STAGE(PG8_SB(1, 1), cB + hstep + kstep, voffB);
        PG8_WAIT_V(6); PG8_BAR;
    }
    for (;;) {
        const bool has_next = S.next(ui + 1, nxt);
        const char* nA = has_next ? (const char*)g.A + (size_t)nxt.pm * tstep : cA; const char* nB = has_next ? (const char*)g.Bt + (size_t)nxt.pn * tstep : cB;
        for (int t = 0; t < nt; t += 2) {
            const bool last = (t == nt - 2);
            const char* a1 = cA + (size_t)(t + 1) * kstep;
            const char* a2 = last ? nA : cA + (size_t)(t + 2) * kstep; const char* b2 = last ? nB : cB + (size_t)(t + 2) * kstep;
            const char* a3 = a2 + kstep; const char* b3 = b2 + kstep;
            if (last && has_next) S.a_ready(nxt);
            if constexpr (SP2) {
            PG8_LDB(B0, 0, 0); PG8_LDB(B1, 0, 1); PG8_SCHED; PG8_LDA(At, 0, 0); PG8_STAGE(PG8_SA(1, 1), a1 + hstep, voffA);
            PG8_WAIT_V(8); PG8_WAIT_L(0); PG8_BAR; PG8_MMA(0, 0, At, B0); PG8_MMA(0, 1, At, B1); PG8_BAR; PG8_SCHED;
            PG8_LDA(At, 0, 1); PG8_STAGE(PG8_SB(0, 0), b2, voffB); PG8_STAGE(PG8_SB(0, 1), b2 + hstep, voffB); PG8_STAGE(PG8_SA(0, 0), a2, voffA);
            PG8_WAIT_V(8); PG8_WAIT_L(0); PG8_BAR; PG8_MMA(1, 0, At, B0); PG8_MMA(1, 1, At, B1); PG8_BAR; PG8_SCHED;
            PG8_LDB(B0, 1, 0); PG8_LDB(B1, 1, 1); PG8_SCHED; PG8_LDA(At, 1, 0); PG8_STAGE(PG8_SA(0, 1), a2 + hstep, voffA);
            PG8_WAIT_V(8); PG8_WAIT_L(0); PG8_BAR; PG8_MMA(0, 0, At, B0); PG8_MMA(0, 1, At, B1); PG8_BAR; PG8_SCHED;
            PG8_LDA(At, 1, 1); PG8_STAGE(PG8_SB(1, 0), b3, voffB); PG8_STAGE(PG8_SB(1, 1), b3 + hstep, voffB); PG8_STAGE(PG8_SA(1, 0), a3, voffA);
            PG8_WAIT_V(8); PG8_WAIT_L(0); PG8_BAR; PG8_MMA(1, 0, At, B0); PG8_MMA(1, 1, At, B1); PG8_BAR; PG8_SCHED;
            } else {
            PG8_LDB(B0, 0, 0); PG8_SCHED; PG8_LDA(At, 0, 0); PG8_STAGE(PG8_SA(1, 1), a1 + hstep, voffA);
            PG8_WAIT_L(8); PG8_BAR; PG8_WAIT_L(0); PG8_MMA(0, 0, At, B0); PG8_BAR; PG8_SCHED;
            PG8_LDB(B1, 0, 1); PG8_STAGE(PG8_SB(0, 0), b2, voffB);
            PG8_BAR; PG8_WAIT_L(0); PG8_MMA(0, 1, At, B1); PG8_BAR;
            PG8_LDA(At, 0, 1); PG8_STAGE(PG8_SA(0, 0), a2, voffA);
            PG8_BAR; PG8_WAIT_L(0); PG8_MMA(1, 0, At, B0); PG8_BAR; PG8_SCHED;
            PG8_STAGE(PG8_SB(0, 1), b2 + hstep, voffB);
            PG8_WAIT_V(6); PG8_BAR; PG8_MMA(1, 1, At, B1); PG8_BAR;
            PG8_LDB(B0, 1, 0); PG8_SCHED; PG8_LDA(At, 1, 0); PG8_STAGE(PG8_SA(0, 1), a2 + hstep, voffA);
            PG8_WAIT_L(8); PG8_BAR; PG8_WAIT_L(0); PG8_MMA(0, 0, At, B0); PG8_BAR; PG8_SCHED;
            PG8_LDB(B1, 1, 1); PG8_STAGE(PG8_SB(1, 0), b3, voffB);
            PG8_BAR; PG8_WAIT_L(0); PG8_MMA(0, 1, At, B1); PG8_BAR;
            PG8_LDA(At, 1, 1); PG8_STAGE(PG8_SA(1, 0), a3, voffA);
            PG8_BAR; PG8_WAIT_L(0); PG8_MMA(1, 0, At, B0); PG8_BAR; PG8_SCHED;
            PG8_STAGE(PG8_SB(1, 1), b3 + hstep, voffB);
            PG8_WAIT_V(6); PG8_BAR; PG8_MMA(1, 1, At, B1); PG8_BAR;
            }
        }
        if constexpr (ALIGN_EPI) { if (wr == 0) PG8_BAR; }
        if constexpr (!Epi::AFTER_DRAIN) { E(acc, cur, wr, wc, fr, fq); S.done(cur); }
        if (!has_next) break;
#pragma unroll
        for (int a = 0; a < 2; ++a)
#pragma unroll
            for (int b = 0; b < 2; ++b)
#pragma unroll
                for (int m = 0; m < 4; ++m)
#pragma unroll
                    for (int n = 0; n < 2; ++n) acc[a][b][m][n] = (f32x4){0.f, 0.f, 0.f, 0.f};
        if constexpr (Epi::HAS_INIT) E.init(acc, nxt, wr, wc, fr, fq);
        cur = nxt; cA = nA; cB = nB; ++ui;
        if constexpr (ALIGN_EPI) { if (wr == 1) PG8_BAR; }
    }
    PG8_WAIT_V(0);
    if constexpr (!ALIGN_EPI) { if (wr == 0) PG8_BAR; }
    PG8_BAR;
    if constexpr (Epi::AFTER_DRAIN) { E.fused(acc, cur, wr, wc, fr, fq, lds, wid, lane); S.done(cur); }
#undef PG8_SA
#undef PG8_SB
#undef PG8_STAGE
#undef PG8_LDA
#undef PG8_LDB
#undef PG8_MMA
#undef PG8_WAIT_V
#undef PG8_WAIT_L
#undef PG8_BAR
#undef PG8_SCHED
}
}
constexpr int NWAVES = 8;
#ifndef MK_N_LAUNCHES
#define MK_N_LAUNCHES 1
#endif
constexpr int N_PHASES = 5;
constexpr int BATCH = 8, T = 2048, D = 1024, M = BATCH * T;
constexpr int NP = 4352;
constexpr int C_R = 0, C_K = 512, C_V = 1024, C_ZW = 1536, C_ZA = 1600, C_GA = 1792, C_DQ = 2304, C_DK = 2816, C_DV = 3328, C_GB = 3840;
constexpr int RH = 8, RN = 64;
constexpr int AH = 4;
constexpr float C2 = 0.125f * 1.4426950408889634f;
constexpr float LOG2E = 1.4426950408889634f;
constexpr float LAMBDA_INIT = 0.2f;

constexpr size_t MiB = 1u << 20;
constexpr size_t WS_CTL = 0, CTL_ZERO_BYTES = 1 * MiB;
constexpr size_t WS_WIN = 2 * MiB;
constexpr size_t WS_WOUT = 11 * MiB;
constexpr size_t WS_WD = 13 * MiB, WS_WA = 13 * MiB + 65536;
constexpr size_t WS_RHO = 13 * MiB + 2 * 65536;
constexpr size_t WS_XN = 14 * MiB;
constexpr size_t WS_PROJ = 46 * MiB;
constexpr size_t WS_MIX = 182 * MiB;
constexpr size_t WS_END = 214 * MiB;
constexpr int CW_BAR = 4096;

constexpr int RING_OFF = 0, RING_BYTES = 131072;
constexpr int LDSCTL_OFF = RING_BYTES, MISC_OFF = LDSCTL_OFF + 320;
constexpr int LDS_BYTES = 155648;

#define GAS __attribute__((address_space(1)))
#define LAS __attribute__((address_space(3)))
typedef unsigned short bf16;
typedef unsigned v4u __attribute__((ext_vector_type(4)));
typedef unsigned v2u __attribute__((ext_vector_type(2)));
typedef float f32x4 __attribute__((ext_vector_type(4)));
typedef float f32x16 __attribute__((ext_vector_type(16)));
typedef short bf16x8 __attribute__((ext_vector_type(8)));
typedef short s16x4 __attribute__((ext_vector_type(4)));
typedef GAS unsigned gu32;
typedef GAS unsigned long long gu64;
#define RLX_AGENT __ATOMIC_RELAXED, __HIP_MEMORY_SCOPE_AGENT
#define LDS_WAIT() asm volatile("s_waitcnt lgkmcnt(0)" ::: "memory")
#define VM_WAIT() asm volatile("s_waitcnt vmcnt(0)" ::: "memory")
__device__ __forceinline__ unsigned f2bf(float f) { unsigned u = __builtin_bit_cast(unsigned, f); return (u + 0x7fffu + ((u >> 16) & 1u)) >> 16; }
__device__ __forceinline__ unsigned pk2(float lo, float hi) { return f2bf(lo) | (f2bf(hi) << 16); }
__device__ __forceinline__ float bflo(unsigned u) { return __uint_as_float(u << 16); }
__device__ __forceinline__ float bfhi(unsigned u) { return __uint_as_float(u & 0xffff0000u); }
__device__ __forceinline__ float bf1(unsigned short u) { return __uint_as_float((unsigned)u << 16); }
__device__ __forceinline__ int mk_lane() { int l; asm volatile("v_mbcnt_lo_u32_b32 %0, -1, 0\n\tv_mbcnt_hi_u32_b32 %0, -1, %0" : "=v"(l)); return l; }
#define XB_TMO      128
#define XB_XCNT(j)  (256  + 64 * (j))
#define XB_XSUB(j)  (1280 + 64 * (j))
#define XB_XGEN(j)  (2304 + 64 * (j))
#define XB_TOP      3328
#define XB_TOPGEN   3392
#define XCD_BAR_WORDS 3456
#define XB_SPIN_CAP (1u << 18)

__device__ __forceinline__ unsigned xb_ld(unsigned* p)              { return __hip_atomic_load(p, __ATOMIC_RELAXED, __HIP_MEMORY_SCOPE_AGENT); }
__device__ __forceinline__ unsigned xb_add(unsigned* p, unsigned v) { return __hip_atomic_fetch_add(p, v, __ATOMIC_RELAXED, __HIP_MEMORY_SCOPE_AGENT); }
__device__ __forceinline__ unsigned xb_xcc_id() { return (unsigned)__builtin_amdgcn_s_getreg((3 << 11) | 20) & 0xFu; }
#define XB_SPIN(cond, bar) do { unsigned _sp = 0; while (cond) { __builtin_amdgcn_s_sleep(1); \
    if ((++_sp & 255u) == 0u) { if (xb_ld(&(bar)[XB_TMO])) break; if (_sp > XB_SPIN_CAP) { atomicAdd(&(bar)[XB_TMO], 1u); break; } } } } while (0)

struct XcdBarrier {
    unsigned* bar; unsigned x;
    volatile LAS unsigned* st;
    int wave;
};

__device__ __forceinline__ XcdBarrier xcd_barrier_post(unsigned* bar, volatile LAS unsigned* st, int wave) {
    XcdBarrier b; b.bar = bar; b.x = xb_xcc_id(); b.st = st; b.wave = wave;
    if (wave == 0 && mk_lane() == 0) (void)xb_add(&bar[XB_XCNT(b.x)], 1u);
    return b;
}
__device__ __forceinline__ void xcd_barrier_complete(unsigned* bar, unsigned x, unsigned& nloc, unsigned& nx) {
    const unsigned G = gridDim.x * gridDim.y * gridDim.z;
    unsigned sum, cnt, mine, sp = 0u;
    for (;;) {
        sum = 0u; cnt = 0u; mine = 0u;
#pragma unroll
        for (unsigned j = 0; j < 16; ++j) { const unsigned c = xb_ld(&bar[XB_XCNT(j)]); sum += c; cnt += (c > 0u) ? 1u : 0u; mine = (j == x) ? c : mine; }
        if (sum == G) break;
        __builtin_amdgcn_s_sleep(1);
        if ((++sp & 255u) == 0u) { if (xb_ld(&bar[XB_TMO])) break; if (sp > XB_SPIN_CAP) { atomicAdd(&bar[XB_TMO], 1u); break; } }
    }
    nloc = mine > 0u ? mine : 1u; nx = cnt > 0u ? cnt : 1u;
}

__device__ __forceinline__ void xcd_barrier(const XcdBarrier& b) {
    asm volatile("s_waitcnt vmcnt(0)" ::: "memory");
    __syncthreads();
    if (b.wave == 0 && mk_lane() == 0) {
        unsigned* bar = b.bar;
        __builtin_amdgcn_s_waitcnt(0);
        unsigned nloc = b.st[0], nx = b.st[1];
        if (nloc == 0u) { xcd_barrier_complete(bar, b.x, nloc, nx); b.st[0] = nloc; b.st[1] = nx; }
        const unsigned old = xb_add(&bar[XB_XSUB(b.x)], 1u);
        const unsigned gen = old / nloc;
        if (old + 1u == (gen + 1u) * nloc) {
            __builtin_amdgcn_fence(__ATOMIC_RELEASE, "agent");
            asm volatile("s_waitcnt vmcnt(0)" ::: "memory");
            const unsigned og = xb_add(&bar[XB_TOP], 1u);
            const unsigned tg = og / nx;
            if (og + 1u == (tg + 1u) * nx) xb_add(&bar[XB_TOPGEN], 1u);
            else XB_SPIN(xb_ld(&bar[XB_TOPGEN]) == tg, bar);
            __builtin_amdgcn_fence(__ATOMIC_ACQUIRE, "agent");
            xb_add(&bar[XB_XGEN(b.x)], 1u);
            asm volatile("s_waitcnt vmcnt(0)" ::: "memory");
        } else {
            XB_SPIN(xb_ld(&bar[XB_XGEN(b.x)]) == gen, bar);
            __builtin_amdgcn_fence(__ATOMIC_ACQUIRE, "agent");
            asm volatile("s_waitcnt vmcnt(0)" ::: "memory");
        }
    }
    __syncthreads();
}
struct Frame {
    LAS unsigned char* lds;
    volatile LAS unsigned* MISC;
    gu32* ctl;
    int tid, lane, wave;
    int vcu, G;
    const float* x; float* out;
    const float *norm_g, *w_in, *shift_mu, *w0, *w_decay_up, *a0, *w_iclr_up, *k_k, *k_a, *r_k, *ln_w, *ln_b, *qn_g, *kn_g, *lq1, *lk1, *lq2, *lk2, *subln_g, *w_out;
    bf16 *WinT, *WoutT, *WdT, *WaT, *XN, *PROJ, *MIX;
};

typedef float f32x2q_t __attribute__((ext_vector_type(2))); typedef __bf16 bf16x2q_t __attribute__((ext_vector_type(2)));
__device__ __forceinline__ unsigned cvtpk2(float lo, float hi) { f32x2q_t v = {lo, hi}; bf16x2q_t b = __builtin_convertvector(v, bf16x2q_t); return __builtin_bit_cast(unsigned, b); }
__device__ __forceinline__ float wave_sum(float v) {
#pragma unroll
    for (int o = 1; o < 64; o <<= 1) v += __shfl_xor(v, o);
    return v;
}
template <int CTRL> __device__ __forceinline__ float dpp_f(float x) { return __builtin_bit_cast(float, __builtin_amdgcn_mov_dpp(__builtin_bit_cast(int, x), CTRL, 0xf, 0xf, true)); }
__device__ __forceinline__ float row16_sum(float x) {
    x += dpp_f<0xB1>(x); x += dpp_f<0x4E>(x); x += dpp_f<0x141>(x); x += dpp_f<0x140>(x); return x;
}
__device__ __forceinline__ float swap32_sum(float x) {
    auto rr = __builtin_amdgcn_permlane32_swap(__float_as_uint(x), __float_as_uint(x), false, false);
    return __uint_as_float(rr[0]) + __uint_as_float(rr[1]);
}

template <bool FRAG = false> __device__ __forceinline__ void p0_transpose_item(const float* W, int N, int nsrc, const float* kscale, bf16* WT, int K, int ndst, LAS float* scr, int k0, int lane) {
    float v[32];
#pragma unroll
    for (int i = 0; i < 32; ++i) { const int kk = 2 * i + (lane >> 5); v[i] = (nsrc >= 0) ? W[(size_t)(k0 + kk) * N + nsrc + (lane & 31)] : 0.f; }
    if (kscale && nsrc >= 0) {
#pragma unroll
        for (int i = 0; i < 32; ++i) v[i] *= kscale[k0 + 2 * i + (lane >> 5)];
    }
#pragma unroll
    for (int i = 0; i < 32; ++i) scr[(2 * i + (lane >> 5)) * 33 + (lane & 31)] = v[i];
    LDS_WAIT(); asm volatile("" ::: "memory");
    const int c = lane & 7;
#pragma unroll
    for (int j = 0; j < 4; ++j) { const int n = (lane >> 3) + 8 * j; const LAS float* s = scr + (8 * c) * 33 + n;
        v4u o; o.x = cvtpk2(s[0 * 33], s[1 * 33]); o.y = cvtpk2(s[2 * 33], s[3 * 33]); o.z = cvtpk2(s[4 * 33], s[5 * 33]); o.w = cvtpk2(s[6 * 33], s[7 * 33]);
        if (FRAG) *(GAS v4u*)(WT + ((size_t)((ndst >> 5) * 4 + (c >> 1)) * 64 + ((c & 1) * 32 + n)) * 8) = o;
        else *(GAS v4u*)(WT + (size_t)(ndst + n) * K + k0 + 8 * c) = o; }
    LDS_WAIT(); asm volatile("" ::: "memory");
}
template <int NQ> __device__ __forceinline__ void p0_rowsq(Frame& F, int mq, int mstep) {
    f32x4 v[NQ][4][4];
#pragma unroll
    for (int q = 0; q < NQ; ++q)
#pragma unroll
        for (int u = 0; u < 4; ++u) { const GAS f32x4* xr = (const GAS f32x4*)(F.x + (size_t)(mq + q * mstep + u) * D) + 2 * F.lane;
#pragma unroll
            for (int j = 0; j < 2; ++j) { v[q][u][2 * j] = __builtin_nontemporal_load(xr + 128 * j); v[q][u][2 * j + 1] = __builtin_nontemporal_load(xr + 128 * j + 1); } }
#pragma unroll
    for (int q = 0; q < NQ; ++q) {
        float s[4];
#pragma unroll
        for (int u = 0; u < 4; ++u) { float a = 0.f;
#pragma unroll
            for (int j = 0; j < 4; ++j) a += (v[q][u][j].x * v[q][u][j].x + v[q][u][j].y * v[q][u][j].y) + (v[q][u][j].z * v[q][u][j].z + v[q][u][j].w * v[q][u][j].w);
            s[u] = a; }
#pragma unroll
        for (int u = 0; u < 4; ++u) {
            const float rstd = __builtin_amdgcn_rsqf(wave_sum(s[u]) * (1.f / D) + 1e-6f);
            GAS v4u* o16 = (GAS v4u*)(F.XN + (size_t)(mq + q * mstep + u) * D) + F.lane;
#pragma unroll
            for (int j = 0; j < 2; ++j) { const f32x4 a = v[q][u][2 * j], c = v[q][u][2 * j + 1];
                o16[64 * j] = (v4u){cvtpk2(a.x * rstd, a.y * rstd), cvtpk2(a.z * rstd, a.w * rstd), cvtpk2(c.x * rstd, c.y * rstd), cvtpk2(c.z * rstd, c.w * rstd)}; }
        }
    }
}
__device__ __forceinline__ void p0_prologue(Frame& F) {
    LAS float* scr = (LAS float*)(F.lds + RING_OFF + F.wave * 16384);
    const int gw = F.vcu * NWAVES + F.wave, NGW = F.G * NWAVES;
    constexpr int I_IN = (D / 64) * (NP / 32), I_OUT = (D / 64) * (D / 32), I_L = 512 / 32;
    constexpr int NITEMS = I_IN + I_OUT + 2 * I_L;
    int m0 = gw * 4;
    const bool two = (m0 + NGW * 4 < M) && (m0 + 2 * NGW * 4 >= M);
    if (!(gw & 1) && m0 < M) { if (two) { p0_rowsq<2>(F, m0, NGW * 4); m0 += 2 * NGW * 4; } else { p0_rowsq<1>(F, m0, 0); m0 += NGW * 4; } }
#pragma unroll 1
    for (int it = gw; it < NITEMS; it += NGW) {
        int r = it;
        if (r < I_IN) { const int kb = r / (NP / 32), nb = r % (NP / 32), nd = 32 * nb; const int ns = nd < 1664 ? nd : (nd < 1792 ? -1 : nd - 128);
            p0_transpose_item(F.w_in, 4224, ns, F.norm_g, F.WinT, D, nd, scr, 64 * kb, F.lane); continue; } r -= I_IN;
        if (r < I_OUT) { const int kb = r / (D / 32), nb = r % (D / 32);
            p0_transpose_item(F.w_out, D, 32 * nb, nullptr, F.WoutT, D, 32 * nb, scr, 64 * kb, F.lane); continue; } r -= I_OUT;
        if (r < I_L) { p0_transpose_item<true>(F.w_decay_up, 512, 32 * r, nullptr, F.WdT, 64, 32 * r, scr, 0, F.lane); continue; } r -= I_L;
        p0_transpose_item<true>(F.w_iclr_up, 512, 32 * r, nullptr, F.WaT, 64, 32 * r, scr, 0, F.lane);
    }
    if (two && m0 + NGW * 4 < M) { p0_rowsq<2>(F, m0, NGW * 4); m0 += 2 * NGW * 4; }
#pragma unroll 1
    for (; m0 < M; m0 += NGW * 4) p0_rowsq<1>(F, m0, 0);
}

__device__ __forceinline__ float tanh_f(float x) { const float e = __expf(-2.f * fabsf(x)); const float t = (1.f - e) * __builtin_amdgcn_rcpf(1.f + e); return x < 0.f ? -t : t; }
__device__ __forceinline__ void shifted8(const bf16* proj, size_t m, bool has_prev, int col, const float* mu, float (&o)[8]) {
    const v4u c = *(const GAS v4u*)(proj + m * NP + col);
    v4u p = (v4u){0u, 0u, 0u, 0u}; if (has_prev) p = *(const GAS v4u*)(proj + (m - 1) * NP + col);
    const f32x4 m0 = *(const GAS f32x4*)(mu), m1 = *(const GAS f32x4*)(mu + 4);
    const unsigned cw[4] = {c.x, c.y, c.z, c.w}, pw[4] = {p.x, p.y, p.z, p.w}; const float mm[8] = {m0.x, m0.y, m0.z, m0.w, m1.x, m1.y, m1.z, m1.w};
#pragma unroll
    for (int j = 0; j < 4; ++j) { const float c0 = bflo(cw[j]), c1 = bfhi(cw[j]), p0 = bflo(pw[j]), p1 = bfhi(pw[j]);
        o[2 * j] = c0 + (p0 - c0) * mm[2 * j]; o[2 * j + 1] = c1 + (p1 - c1) * mm[2 * j + 1]; }
}
__device__ __forceinline__ void shifted4(const bf16* proj, size_t m, bool has_prev, int col, const float* mu, float (&o)[4]) {
    const v2u c = *(const GAS v2u*)(proj + m * NP + col);
    v2u p = (v2u){0u, 0u}; if (has_prev) p = *(const GAS v2u*)(proj + (m - 1) * NP + col);
    const f32x4 m0 = *(const GAS f32x4*)(mu);
    o[0] = bflo(c.x) + (bflo(p.x) - bflo(c.x)) * m0.x; o[1] = bfhi(c.x) + (bfhi(p.x) - bfhi(c.x)) * m0.y;
    o[2] = bflo(c.y) + (bflo(p.y) - bflo(c.y)) * m0.z; o[3] = bfhi(c.y) + (bfhi(p.y) - bfhi(c.y)) * m0.w;
}
__device__ __forceinline__ void p2_qknorm(Frame& F) {
    const int gw = F.vcu * NWAVES + F.wave, NGW = F.G * NWAVES, lane = F.lane, sub = lane & 7;
    const f32x4 gk0 = *(const GAS f32x4*)(F.kn_g + sub * 8), gk1 = *(const GAS f32x4*)(F.kn_g + sub * 8 + 4);
    constexpr int UQ = 4;
    for (int it0 = gw * UQ; it0 < M; it0 += NGW * UQ) {
        bf16* p[UQ]; v4u c[UQ];
#pragma unroll
        for (int u = 0; u < UQ; ++u) { const size_t m = (size_t)(it0 + u); p[u] = F.PROJ + m * NP + C_DK + (lane >> 3) * 64 + sub * 8; c[u] = *(const GAS v4u*)p[u]; }
#pragma unroll
        for (int u = 0; u < UQ; ++u) {
            const unsigned cw[4] = {c[u].x, c[u].y, c[u].z, c[u].w};
            float xv[8]; float ss = 0.f;
#pragma unroll
            for (int j = 0; j < 4; ++j) { xv[2 * j] = bflo(cw[j]); xv[2 * j + 1] = bfhi(cw[j]); ss += xv[2 * j] * xv[2 * j] + xv[2 * j + 1] * xv[2 * j + 1]; }
            ss += dpp_f<0xB1>(ss); ss += dpp_f<0x4E>(ss); ss += dpp_f<0x141>(ss);
            const float r = __builtin_amdgcn_rsqf(ss * (1.f / 64.f) + 1e-6f);
            v4u o; o.x = cvtpk2(xv[0] * r * gk0.x, xv[1] * r * gk0.y); o.y = cvtpk2(xv[2] * r * gk0.z, xv[3] * r * gk0.w); o.z = cvtpk2(xv[4] * r * gk1.x, xv[5] * r * gk1.y); o.w = cvtpk2(xv[6] * r * gk1.z, xv[7] * r * gk1.w);
            *(GAS v4u*)p[u] = o;
        }
    }
}
typedef float f32x2_t __attribute__((ext_vector_type(2))); typedef __bf16 bf16x2_t __attribute__((ext_vector_type(2)));
__device__ __forceinline__ unsigned cvtpk(float lo, float hi) { f32x2_t v = {lo, hi}; bf16x2_t b = __builtin_convertvector(v, bf16x2_t); return __builtin_bit_cast(unsigned, b); }
#define MFMA32(a, b, c) __builtin_amdgcn_mfma_f32_32x32x16_bf16(__builtin_bit_cast(bf16x8, (a)), __builtin_bit_cast(bf16x8, (b)), (c), 0, 0, 0)
#define FRAGACC(z, s) ((v4u){cvtpk((z)[8 * (s)], (z)[8 * (s) + 1]), cvtpk((z)[8 * (s) + 2], (z)[8 * (s) + 3]), cvtpk((z)[8 * (s) + 4], (z)[8 * (s) + 5]), cvtpk((z)[8 * (s) + 6], (z)[8 * (s) + 7])})
template <int CTRL, int RM> __device__ __forceinline__ float dpp_upd0(float x) { return __builtin_bit_cast(float, __builtin_amdgcn_update_dpp(0, __builtin_bit_cast(int, x), CTRL, RM, 0xf, false)); }
__device__ __forceinline__ float scan32(float x) {
    x += dpp_upd0<0x111, 0xf>(x); x += dpp_upd0<0x112, 0xf>(x); x += dpp_upd0<0x114, 0xf>(x); x += dpp_upd0<0x118, 0xf>(x); x += dpp_upd0<0x142, 0xa>(x); return x;
}
__device__ __forceinline__ void st_wt16(v4u* p, const v4u v) { *(GAS v4u*)p = v; }
constexpr int RW_UNITS = BATCH * RH * (T / 32);
struct RwDump { v4u* PF; v4u* DD; v4u* QF; v4u* YD; float* GAM; float* RHO; };

__device__ __forceinline__ void rwkvA_unit(Frame& F, const RwDump& Dm, int bh, int ci, LAS float* wscr, LAS unsigned char* park, LAS v4u* zsh, int zpar) {
    int lane = mk_lane(); asm volatile("" : "+v"(lane));
    const int hi = lane >> 5, l31 = lane & 31, b = bh >> 3, w = bh & 7;
    LAS v4u* pk = (LAS v4u*)park + lane;
#define PARK(slot) pk[(slot) * 64]
    int tok = 0; asm volatile("" : "+v"(tok));
#define DEP(x) asm volatile("" : "+v"(tok) : "v"(x))
    const int t = ci * 32 + l31; const size_t m = (size_t)b * T + t; const bool hp = t > 0;
    const int u = ci * (BATCH * RH) + bh;
    const float pm = hp ? 1.f : 0.f;
    const float* mu = F.shift_mu + w * 64 + 4 * hi;
    const float *pw0 = F.w0 + w * 64 + 4 * hi, *pa0 = F.a0 + w * 64 + 4 * hi, *pkk = F.k_k + w * 64 + 4 * hi, *pka = F.k_a + w * 64 + 4 * hi, *prk = F.r_k + w * 64 + 4 * hi;
    LAS unsigned char* stg = park + 8192;
    LAS unsigned char* prv = F.lds + LDSCTL_OFF + 20480 + F.wave * 256;
    const bf16* gk = F.PROJ + ((size_t)b * T + ci * 32) * NP + w * 64;
    const bf16* gpr = gk - (ci > 0 ? NP : 0);
#define RW_DMA(src, dst) __builtin_amdgcn_global_load_lds((const unsigned*)(src), (LAS unsigned*)(dst), 16, 0, 0)
    LDS_WAIT();
    { const bf16* s_ = gk + (size_t)(lane >> 3) * NP + C_K;
#pragma unroll
      for (int p = 0; p < 4; ++p) RW_DMA(s_ + (size_t)(8 * p) * NP + (((lane & 7) ^ ((4 * p + (lane >> 4)) & 7)) * 8), stg + p * 1024);
      if (lane < 8) RW_DMA(gpr + C_K + lane * 8, prv); }
#define RW_STAGE_RV(cb) do { const bf16* s_ = gk + (size_t)(lane >> 2) * NP + 32 * (cb) + (((lane & 3) ^ ((lane >> 4) & 3)) * 8); \
      _Pragma("unroll") for (int p = 0; p < 2; ++p) { RW_DMA(s_ + C_R + (size_t)(16 * p) * NP, stg + 4096 + p * 1024); RW_DMA(s_ + C_V + (size_t)(16 * p) * NP, stg + 6144 + p * 1024); } \
      if (lane < 4) { RW_DMA(gpr + C_R + 32 * (cb) + lane * 8, prv + 128); RW_DMA(gpr + C_V + 32 * (cb) + lane * 8, prv + 192); } } while (0)
    RW_STAGE_RV(0);
    const LAS unsigned char* kcur = stg + l31 * 128 + 8 * hi; const LAS unsigned char* kprv = l31 ? kcur - 128 : prv + 8 * hi;
    const LAS unsigned char* rcur = stg + 4096 + l31 * 64 + 8 * hi; const LAS unsigned char* rprv = l31 ? rcur - 64 : prv + 128 + 8 * hi;
    const LAS unsigned char* vcur = stg + 6144 + l31 * 64 + 8 * hi; const LAS unsigned char* vprv = l31 ? vcur - 64 : prv + 192 + 8 * hi;
    const int fKc = ((l31 >> 1) & 7) << 4, fKp = l31 ? (((l31 - 1) >> 1) & 7) << 4 : 0, fRc = ((l31 >> 2) & 3) << 4, fRp = l31 ? (((l31 - 1) >> 2) & 3) << 4 : 0;
    v4u bz[4], ba[4];
    { const int s = F.wave >> 1; const bool which = (F.wave & 1) != 0;
      const bf16* zc = F.PROJ + m * NP + 8 * hi; const bf16* zp = F.PROJ + (hp ? m - 1 : m) * NP + 8 * hi; const float* zmu = F.shift_mu + 8 * hi;
      const int COL = (which ? C_ZA : C_ZW) + 16 * s, MUO = (which ? 1600 : 1536) + 16 * s;
      const v4u c = *(const GAS v4u*)(zc + tok + COL), p = *(const GAS v4u*)(zp + tok + COL); const f32x4 m0 = *(const GAS f32x4*)(zmu + tok + MUO), m1 = *(const GAS f32x4*)(zmu + tok + MUO + 4);
      float z[8];
#pragma unroll
      for (int j = 0; j < 4; ++j) { const float c0 = bflo(c[j]), c1 = bfhi(c[j]); const float mm0 = j < 2 ? m0[2 * j] : m1[2 * j - 4], mm1 = j < 2 ? m0[2 * j + 1] : m1[2 * j - 3];
          z[2 * j] = c0 + (bflo(p[j]) * pm - c0) * mm0; z[2 * j + 1] = c1 + (bfhi(p[j]) * pm - c1) * mm1; }
      if (!which) {
#pragma unroll
          for (int j = 0; j < 8; ++j) z[j] = tanh_f(z[j]); }
      LAS v4u* zs = zsh + zpar * 512;
      zs[((which ? 4 : 0) + s) * 64 + lane] = (v4u){cvtpk(z[0], z[1]), cvtpk(z[2], z[3]), cvtpk(z[4], z[5]), cvtpk(z[6], z[7])};
      __syncthreads();
#pragma unroll
      for (int q = 0; q < 4; ++q) { bz[q] = zs[q * 64 + lane]; ba[q] = zs[(4 + q) * 64 + lane]; }
      DEP(bz[3][3]); DEP(ba[3][3]); }
    asm volatile("" ::: "memory");
    asm volatile("s_waitcnt vmcnt(0)" ::: "memory");
    float ss = 0.f;
#pragma unroll
    for (int gq = 0; gq < 8; ++gq) { const v2u c_ = *(const LAS v2u*)(kcur + tok + ((16 * gq) ^ fKc)), p_ = *(const LAS v2u*)(kprv + tok + ((16 * gq) ^ fKp));
        const f32x4 m_ = *(const GAS f32x4*)(mu + tok + 512 + 8 * gq), kkp = *(const GAS f32x4*)(pkk + tok + 8 * gq);
        float k4[4]; k4[0] = bflo(c_.x) + (bflo(p_.x) * pm - bflo(c_.x)) * m_.x; k4[1] = bfhi(c_.x) + (bfhi(p_.x) * pm - bfhi(c_.x)) * m_.y;
        k4[2] = bflo(c_.y) + (bflo(p_.y) * pm - bflo(c_.y)) * m_.z; k4[3] = bfhi(c_.y) + (bfhi(p_.y) * pm - bfhi(c_.y)) * m_.w;
#pragma unroll
        for (int e = 0; e < 4; ++e) { const float q = k4[e] * kkp[e]; ss += q * q; }
        if (gq == 3) DEP(ss); }
    ss = swap32_sum(ss);
    const float inv = __builtin_amdgcn_rcpf(fmaxf(__builtin_amdgcn_sqrtf(ss), 1e-12f));
    asm volatile("" ::: "memory");
    v4u fa[4], fb[4], fk[4], fr[4], fv[4]; float rho = 0.f;
    float* gp = Dm.GAM + (size_t)u * 64 + hi * 32;
#define RW_LORA(cb) f32x16 accd = f32x16{}, acca = f32x16{}; _Pragma("unroll") for (int s = 0; s < 4; ++s) { \
        const v4u aD = *(const GAS v4u*)(F.WdT + tok + ((size_t)((w * 2 + (cb)) * 4 + s) * 64 + lane) * 8); accd = MFMA32(aD, bz[s], accd);     \
        const v4u aA = *(const GAS v4u*)(F.WaT + tok + ((size_t)((w * 2 + (cb)) * 4 + s) * 64 + lane) * 8); acca = MFMA32(aA, ba[s], acca); }
        struct RwGL { v2u rc, rp, kc, kp, vc, vp; };
    struct RwPar { f32x4 mr, mk, mv, w0, a0, kk; } pA, pB;
#define RW_LOADG(X, CB, RG) do { X.rc = *(const LAS v2u*)(rcur + tok + ((16 * (RG)) ^ fRc)); X.rp = *(const LAS v2u*)(rprv + tok + ((16 * (RG)) ^ fRp)); \
        X.kc = *(const LAS v2u*)(kcur + tok + ((64 * (CB) + 16 * (RG)) ^ fKc)); X.kp = *(const LAS v2u*)(kprv + tok + ((64 * (CB) + 16 * (RG)) ^ fKp)); \
        X.vc = *(const LAS v2u*)(vcur + tok + ((16 * (RG)) ^ fRc)); X.vp = *(const LAS v2u*)(vprv + tok + ((16 * (RG)) ^ fRp)); } while (0)
#define RW_LOADP(X, OFF_) do { X.mr = *(const GAS f32x4*)(mu + tok + (OFF_)); X.mk = *(const GAS f32x4*)(mu + tok + 512 + (OFF_)); X.mv = *(const GAS f32x4*)(mu + tok + 1024 + (OFF_)); \
        X.w0 = *(const GAS f32x4*)(pw0 + tok + (OFF_)); X.a0 = *(const GAS f32x4*)(pa0 + tok + (OFF_)); X.kk = *(const GAS f32x4*)(pkk + tok + (OFF_)); } while (0)
#define RW_LERP(dst, c_, p_, m_) do { dst[0] = bflo(c_.x) + (bflo(p_.x) * pm - bflo(c_.x)) * m_.x; dst[1] = bfhi(c_.x) + (bfhi(p_.x) * pm - bfhi(c_.x)) * m_.y; \
        dst[2] = bflo(c_.y) + (bflo(p_.y) * pm - bflo(c_.y)) * m_.z; dst[3] = bfhi(c_.y) + (bfhi(p_.y) * pm - bfhi(c_.y)) * m_.w; } while (0)
#define RW_GROUP(cb, rg, CUR, NXT, HASN) do { constexpr int OFF = 32 * (cb) + 8 * (rg); const int ch0 = OFF + 4 * hi; \
            if (HASN) RW_LOADP(NXT, OFF + 8); \
            RwGL g_; RW_LOADG(g_, cb, rg); \
            float rr[4], kk4[4], vv[4]; \
            const f32x4 kap = *(const GAS f32x4*)(pka + tok + OFF), rkp = *(const GAS f32x4*)(prk + tok + OFF);     \
            const f32x4 mr_ = CUR.mr, mk_ = CUR.mk, mv_ = CUR.mv, w0v = CUR.w0, a0v = CUR.a0, kkp = CUR.kk; \
            RW_LERP(rr, g_.rc, g_.rp, mr_); RW_LERP(kk4, g_.kc, g_.kp, mk_); RW_LERP(vv, g_.vc, g_.vp, mv_); \
            float xa[4], xb[4], xk[4], xr[4], gg[4], ge[4]; \
            _Pragma("unroll") for (int e = 0; e < 4; ++e) { \
                  \
                const float l2 = (-0.6065306597126334f * LOG2E) * __builtin_amdgcn_rcpf(1.f + __expf(-(w0v[e] + accd[4 * (rg) + e]))); \
                const float g = scan32(l2); \
                const float a = __builtin_amdgcn_rcpf(1.f + __expf(-(a0v[e] + acca[4 * (rg) + e]))); \
                const float kk = kk4[e] * kkp[e] * inv; \
                const float kt = kk4[e] * (1.f + (a - 1.f) * kap[e]); \
                rho += rr[e] * kt * rkp[e]; \
                const float eg = __builtin_amdgcn_exp2f(g), egp = __builtin_amdgcn_exp2f(g - l2), eng = __builtin_amdgcn_rcpf(eg); \
                xa[e] = -kk * egp; xb[e] = kk * a * eng; xk[e] = kt * eng; xr[e] = rr[e] * eg; gg[e] = g; ge[e] = eg; } \
            if (l31 == 31) { *(LAS f32x4*)(wscr + ch0) = (f32x4){gg[0], gg[1], gg[2], gg[3]}; st_wt16((v4u*)(gp + (cb) * 16 + 4 * (rg)), (v4u){__float_as_uint(ge[0]), __float_as_uint(ge[1]), __float_as_uint(ge[2]), __float_as_uint(ge[3])}); } \
            constexpr int s_ = 2 * (cb) + ((rg) >> 1), vg = 2 * ((rg) & 1); \
            fa[s_][vg] = cvtpk(xa[0], xa[1]); fa[s_][vg + 1] = cvtpk(xa[2], xa[3]); \
            fb[s_][vg] = cvtpk(xb[0], xb[1]); fb[s_][vg + 1] = cvtpk(xb[2], xb[3]); \
            fk[s_][vg] = cvtpk(xk[0], xk[1]); fk[s_][vg + 1] = cvtpk(xk[2], xk[3]); \
            fr[s_][vg] = cvtpk(xr[0], xr[1]); fr[s_][vg + 1] = cvtpk(xr[2], xr[3]); \
            fv[s_][vg] = cvtpk(vv[0], vv[1]); fv[s_][vg + 1] = cvtpk(vv[2], vv[3]); \
            if (((rg) & 1) == 1) { PARK(s_) = fv[s_]; PARK(4 + s_) = fr[s_]; } \
            DEP(fa[s_][vg + 1]); DEP(fb[s_][vg + 1]); DEP(fk[s_][vg + 1]); DEP(fr[s_][vg + 1]); DEP(fv[s_][vg + 1]); DEP(rho); } while (0)
    RW_LOADP(pA, 0);
    { RW_LORA(0) RW_GROUP(0, 0, pA, pB, true); RW_GROUP(0, 1, pB, pA, true); RW_GROUP(0, 2, pA, pB, true); RW_GROUP(0, 3, pB, pA, true); }
    LDS_WAIT(); RW_STAGE_RV(1);
    { RW_LORA(1) asm volatile("s_waitcnt vmcnt(0)" ::: "memory");
      RW_GROUP(1, 0, pA, pB, true); RW_GROUP(1, 1, pB, pA, true); RW_GROUP(1, 2, pA, pB, true); RW_GROUP(1, 3, pB, pA, false); }
#undef RW_STAGE_RV
#undef RW_DMA
#undef RW_LOADG
#undef RW_LOADP
#undef RW_LERP
#undef RW_LORA
#undef RW_GROUP
    LDS_WAIT(); asm volatile("" ::: "memory");
    float EC[2]; EC[0] = __builtin_amdgcn_exp2f(wscr[l31]); EC[1] = __builtin_amdgcn_exp2f(wscr[32 + l31]);
    LDS_WAIT(); asm volatile("" ::: "memory");
    rho = swap32_sum(rho);
    if (hi == 0) __hip_atomic_store((gu32*)(Dm.RHO + (size_t)u * 32 + l31), __float_as_uint(rho), RLX_AGENT);
    v4u idf[2];
    { const int jst = 4 * ((l31 >> 3) & 1) + (l31 & 3); const bool hm = ((l31 >> 2) & 1) == hi; const unsigned one = 0x3F80u << (16 * (jst & 1));
#pragma unroll
      for (int sig = 0; sig < 2; ++sig) { const bool on = hm && ((l31 >> 4) == sig);
#pragma unroll
          for (int q = 0; q < 4; ++q) idf[sig][q] = (on && (jst >> 1) == q) ? one : 0u; } }
    LDS_WAIT();
    v4u Af[2][2], Vf[2][2];
#pragma unroll
    for (int blk = 0; blk < 2; ++blk) {
        f32x16 za = MFMA32(fa[2 * blk], idf[0], f32x16{}); za = MFMA32(fa[2 * blk + 1], idf[1], za);
        f32x16 zv = MFMA32(PARK(2 * blk), idf[0], f32x16{}); zv = MFMA32(PARK(2 * blk + 1), idf[1], zv);
        f32x16 zb = MFMA32(fb[2 * blk], idf[0], f32x16{}); zb = MFMA32(fb[2 * blk + 1], idf[1], zb);
        f32x16 zk = MFMA32(fk[2 * blk], idf[0], f32x16{}); zk = MFMA32(fk[2 * blk + 1], idf[1], zk);
        zb = zb * EC[blk]; zk = zk * EC[blk];
#pragma unroll
        for (int s = 0; s < 2; ++s) { Af[blk][s] = FRAGACC(za, s); Vf[blk][s] = FRAGACC(zv, s); PARK(8 + 2 * blk + s) = FRAGACC(zb, s); PARK(12 + 2 * blk + s) = FRAGACC(zk, s); }
        __builtin_amdgcn_sched_barrier(0);
    }
    f32x16 Aab = f32x16{}, TT = f32x16{}, AakT = f32x16{}, ArbT = f32x16{}, ArkT = f32x16{};
#pragma unroll
    for (int s = 0; s < 4; ++s) { const v4u frs = PARK(4 + s); Aab = MFMA32(fa[s], fb[s], Aab); TT = MFMA32(fb[s], fa[s], TT); AakT = MFMA32(fk[s], fa[s], AakT); ArbT = MFMA32(fb[s], frs, ArbT); ArkT = MFMA32(fk[s], frs, ArkT); }
#pragma unroll
    for (int r = 0; r < 16; ++r) { const int rowi = (r & 3) + 8 * (r >> 2) + 4 * hi;
        Aab[r] = (l31 < rowi) ? Aab[r] : 0.f; TT[r] = (rowi < l31) ? TT[r] : 0.f; AakT[r] = (rowi < l31) ? AakT[r] : 0.f;
        ArbT[r] = (rowi <= l31) ? ArbT[r] : 0.f; ArkT[r] = (rowi <= l31) ? ArkT[r] : 0.f; }
    v4u AakTf[2], ArbTf[2], ArkTf[2];
#pragma unroll
    for (int s = 0; s < 2; ++s) { AakTf[s] = FRAGACC(AakT, s); ArbTf[s] = FRAGACC(ArbT, s); ArkTf[s] = FRAGACC(ArkT, s); }
    __builtin_amdgcn_sched_barrier(0);
    v4u Xf[2], XTf[2], TTf[2];
#pragma unroll
    for (int s = 0; s < 2; ++s) { Xf[s] = FRAGACC(Aab, s); XTf[s] = FRAGACC(TT, s); }
#pragma unroll
    for (int r = 0; r < 16; ++r) { const int rowi = (r & 3) + 8 * (r >> 2) + 4 * hi; TT[r] += (rowi == l31) ? 1.f : 0.f; }
#pragma unroll
    for (int it = 0; it < 4; ++it) {
        f32x16 X2 = MFMA32(XTf[0], Xf[0], f32x16{}); X2 = MFMA32(XTf[1], Xf[1], X2);
        if (it < 3) { f32x16 X2T = MFMA32(Xf[0], XTf[0], f32x16{}); X2T = MFMA32(Xf[1], XTf[1], X2T);
#pragma unroll
            for (int s = 0; s < 2; ++s) XTf[s] = FRAGACC(X2T, s); }
#pragma unroll
        for (int s = 0; s < 2; ++s) { Xf[s] = FRAGACC(X2, s); TTf[s] = FRAGACC(TT, s); }
        TT = MFMA32(Xf[0], TTf[0], TT); TT = MFMA32(Xf[1], TTf[1], TT);
        __builtin_amdgcn_sched_barrier(0);
    }
#pragma unroll
    for (int s = 0; s < 2; ++s) TTf[s] = FRAGACC(TT, s);
    v4u Wf[2][2], Uf[2][2];
#pragma unroll
    for (int blk = 0; blk < 2; ++blk) {
        f32x16 av = MFMA32(AakTf[0], Vf[blk][0], f32x16{}); av = MFMA32(AakTf[1], Vf[blk][1], av);
        const v4u avf0 = FRAGACC(av, 0), avf1 = FRAGACC(av, 1);
        f32x16 uu = MFMA32(TTf[0], avf0, f32x16{}); uu = MFMA32(TTf[1], avf1, uu);
        f32x16 ww = MFMA32(TTf[0], Af[blk][0], f32x16{}); ww = MFMA32(TTf[1], Af[blk][1], ww);
#pragma unroll
        for (int s = 0; s < 2; ++s) { Wf[blk][s] = FRAGACC(ww, s); Uf[blk][s] = FRAGACC(uu, s); }
        __builtin_amdgcn_sched_barrier(0);
    }
    v4u* QFp = Dm.QF + (size_t)u * 256 + lane; v4u* YDp = Dm.YD + (size_t)u * 256 + lane;
#pragma unroll
    for (int blk = 0; blk < 2; ++blk) {
        f32x16 q;
#pragma unroll
        for (int s = 0; s < 2; ++s)
            { const v4u frs = PARK(4 + 2 * blk + s);
#pragma unroll
              for (int j = 0; j < 4; ++j) { q[8 * s + 2 * j] = bflo(frs[j]); q[8 * s + 2 * j + 1] = bfhi(frs[j]); } }
        q = MFMA32(Wf[blk][0], ArbTf[0], q); q = MFMA32(Wf[blk][1], ArbTf[1], q);
        st_wt16(QFp + (2 * blk) * 64, FRAGACC(q, 0)); st_wt16(QFp + (2 * blk + 1) * 64, FRAGACC(q, 1));
        f32x16 y = MFMA32(Uf[blk][0], ArbTf[0], f32x16{}); y = MFMA32(Uf[blk][1], ArbTf[1], y); y = MFMA32(Vf[blk][0], ArkTf[0], y); y = MFMA32(Vf[blk][1], ArkTf[1], y);
        st_wt16(YDp + (2 * blk) * 64, FRAGACC(y, 0)); st_wt16(YDp + (2 * blk + 1) * 64, FRAGACC(y, 1));
        __builtin_amdgcn_sched_barrier(0);
    }
    v4u* PFp = Dm.PF + (size_t)u * 512 + lane; v4u* DDp = Dm.DD + (size_t)u * 512 + lane;
#pragma unroll
    for (int c1 = 0; c1 < 2; ++c1)
#pragma unroll
        for (int cb = 0; cb < 2; ++cb) {
            f32x16 p = MFMA32(Wf[c1][0], PARK(8 + 2 * cb), f32x16{}); p = MFMA32(Wf[c1][1], PARK(8 + 2 * cb + 1), p);
            st_wt16(PFp + (cb * 4 + 2 * c1) * 64, FRAGACC(p, 0)); st_wt16(PFp + (cb * 4 + 2 * c1 + 1) * 64, FRAGACC(p, 1));
            __builtin_amdgcn_sched_barrier(0);
        }
#pragma unroll
    for (int cb = 0; cb < 2; ++cb)
#pragma unroll
        for (int ib = 0; ib < 2; ++ib) {
            f32x16 d = MFMA32(PARK(8 + 2 * cb), Uf[ib][0], f32x16{}); d = MFMA32(PARK(8 + 2 * cb + 1), Uf[ib][1], d); d = MFMA32(PARK(12 + 2 * cb), Vf[ib][0], d); d = MFMA32(PARK(12 + 2 * cb + 1), Vf[ib][1], d);
            st_wt16(DDp + ((cb * 2 + ib) * 2) * 64, FRAGACC(d, 0)); st_wt16(DDp + ((cb * 2 + ib) * 2 + 1) * 64, FRAGACC(d, 1));
            __builtin_amdgcn_sched_barrier(0);
        }
}

#undef PARK
#undef DEP
constexpr int RB_PF = 0, RB_DD = 8192, RB_QF = 16384, RB_YD = 20480, RB_GAM = 24576, RB_BUF = 24832, RB_NB = 4, RB_STAT = RB_NB * RB_BUF, RB_Y = RB_STAT + 1024;
__device__ __forceinline__ void unpack16(const v4u a, const v4u b, f32x16& o) {
#pragma unroll
    for (int j = 0; j < 4; ++j) { o[2 * j] = bflo(a[j]); o[2 * j + 1] = bfhi(a[j]); o[8 + 2 * j] = bflo(b[j]); o[8 + 2 * j + 1] = bfhi(b[j]); }
}
constexpr int RW_SPLIT = T / 32, CW_DONE = 16384;
__device__ __forceinline__ void rw_wait_chunk(Frame& F, int ci) {
    unsigned spins = 0;
#pragma unroll 1
    for (int j = 7; j >= 0; --j) { gu32* c = F.ctl + CW_DONE + 64 * (ci + j);
        while ((unsigned)__builtin_amdgcn_readfirstlane(__hip_atomic_load(c, RLX_AGENT)) < (unsigned)BATCH) { __builtin_amdgcn_s_sleep(8); if (++spins > (1u << 22)) break; } }
    __builtin_amdgcn_fence(__ATOMIC_ACQUIRE, "agent");
}
__device__ __forceinline__ void rw_publish_chunk(Frame& F, int ci) {
    asm volatile("s_waitcnt vmcnt(0)" ::: "memory");
    __syncthreads();
    if (F.wave == 0 && mk_lane() == 0) {
        __hip_atomic_fetch_add(F.ctl + CW_DONE + 64 * ci, 1u, RLX_AGENT);
    }
}
#ifndef RB_AUX
#define RB_AUX 2
#endif
struct RbStage { v4u p[2], d[2], q, y, g; };
struct RbEpi { v4u vc, vp, ga; float rho; };
__device__ __forceinline__ void rwkvB_unit(Frame& F, const RwDump& Dm, int bh) {
    int lane = mk_lane(); asm volatile("" : "+v"(lane));
    const int wid = F.wave, tid = wid * 64 + lane, hi = lane >> 5, l31 = lane & 31, b = bh >> 3, h = bh & 7;
    LAS unsigned char* lds = F.lds + RING_OFF;
    constexpr int NS = T / 32;
    LAS float* stat = (LAS float*)(lds + RB_STAT);
    LAS float* ybuf = (LAS float*)(lds + RB_Y);
    const int stid = tid - 128;
    const bool st_p2 = wid < 4, st_q = wid < 6, st_y = wid >= 4;
#define ST_LOAD(X, ci_) do { { if ((ci_) >= RW_SPLIT && (ci_) < NS && (((ci_) - RW_SPLIT) & 7) == 0) rw_wait_chunk(F, (ci_)); const size_t u_ = (size_t)((ci_) < NS ? (ci_) : NS - 1) * (BATCH * RH) + bh; \
        X.p[0] = __builtin_nontemporal_load((const GAS v4u*)(Dm.PF + u_ * 512 + stid)); X.d[0] = __builtin_nontemporal_load((const GAS v4u*)(Dm.DD + u_ * 512 + stid)); \
        if (st_p2) { X.p[1] = __builtin_nontemporal_load((const GAS v4u*)(Dm.PF + u_ * 512 + 384 + stid)); X.d[1] = __builtin_nontemporal_load((const GAS v4u*)(Dm.DD + u_ * 512 + 384 + stid)); } \
        if (st_q) X.q = __builtin_nontemporal_load((const GAS v4u*)(Dm.QF + u_ * 256 + stid)); \
        if (st_y) X.y = __builtin_nontemporal_load((const GAS v4u*)(Dm.YD + u_ * 256 + (stid - 128))); \
        if (stid < 16) X.g = *(const GAS v4u*)((const v4u*)(Dm.GAM + u_ * 64) + stid); } } while (0)
#define ST_STORE(X, buf_) do { LAS unsigned char* b_ = lds + (buf_) * RB_BUF; \
        *(LAS v4u*)(b_ + RB_PF + stid * 16) = X.p[0]; *(LAS v4u*)(b_ + RB_DD + stid * 16) = X.d[0]; \
        if (st_p2) { *(LAS v4u*)(b_ + RB_PF + (384 + stid) * 16) = X.p[1]; *(LAS v4u*)(b_ + RB_DD + (384 + stid) * 16) = X.d[1]; } \
        if (st_q) *(LAS v4u*)(b_ + RB_QF + stid * 16) = X.q; \
        if (st_y) *(LAS v4u*)(b_ + RB_YD + (stid - 128) * 16) = X.y; \
        if (stid < 16) *(LAS v4u*)(b_ + RB_GAM + stid * 16) = X.g; } while (0)
    const int ew = (wid & 1) + 2 * ((wid >> 2) & 1), eidx = ew * 64 + lane, etok = eidx >> 3, ep = eidx & 7;
    const bf16* epc = F.PROJ + (size_t)b * T * NP + h * 64 + 8 * ep;
#define EP_LOAD(X, cj_) do { { const int cc_ = (cj_) < NS ? (cj_) : NS - 1, tt_ = cc_ * 32 + etok; const bf16* pc_ = epc + (size_t)tt_ * NP; const bf16* pp_ = epc + (size_t)(tt_ > 0 ? tt_ - 1 : 0) * NP; \
        X.vc = *(const GAS v4u*)(pc_ + C_V); X.vp = *(const GAS v4u*)(pp_ + C_V); X.ga = *(const GAS v4u*)(pc_ + C_GA); \
        X.rho = Dm.RHO[((size_t)cc_ * (BATCH * RH) + bh) * 32 + etok]; } } while (0)
#define EP_RUN(X, cj_) do { const int par_ = (cj_) & 1; \
        const float s1_ = stat[((par_ * 2 + 0) * 32 + etok) * 2] + stat[((par_ * 2 + 1) * 32 + etok) * 2], s2_ = stat[((par_ * 2 + 0) * 32 + etok) * 2 + 1] + stat[((par_ * 2 + 1) * 32 + etok) * 2 + 1]; \
        const float mean_ = s1_ * (1.f / 64.f), var_ = fmaxf(s2_ * (1.f / 64.f) - mean_ * mean_, 0.f), rstd_ = __builtin_amdgcn_rsqf(var_ + 64e-5f); \
        const int tt_ = (cj_) * 32 + etok; const size_t mm_ = (size_t)b * T + tt_; const float pm_ = tt_ > 0 ? 1.f : 0.f; \
        const LAS float* yb_ = ybuf + (par_ * 2 + (ep >> 2)) * 1024 + 4 * (ep & 3) * 64 + etok; \
        float o_[8]; \
        _Pragma("unroll") for (int j = 0; j < 8; ++j) { const unsigned vcw_ = X.vc[j >> 1], vpw_ = X.vp[j >> 1], gaw_ = X.ga[j >> 1]; \
            const float vc_ = (j & 1) ? bfhi(vcw_) : bflo(vcw_), vp_ = (j & 1) ? bfhi(vpw_) : bflo(vpw_), g_ = (j & 1) ? bfhi(gaw_) : bflo(gaw_); \
            const float vv_ = vc_ + (vp_ * pm_ - vc_) * emu[j >> 2][j & 3]; \
            const float yn_ = (yb_[(j & 3) * 64 + (j >> 2) * 32] - mean_) * rstd_ * elw[j >> 2][j & 3] + elb[j >> 2][j & 3] + X.rho * vv_; o_[j] = yn_ * g_ * __builtin_amdgcn_rcpf(1.f + __expf(-g_)); } \
        *(GAS v4u*)(F.MIX + mm_ * D + h * 64 + 8 * ep) = (v4u){cvtpk(o_[0], o_[1]), cvtpk(o_[2], o_[3]), cvtpk(o_[4], o_[5]), cvtpk(o_[6], o_[7])}; } while (0)
    f32x16 S[2]; S[0] = f32x16{}; S[1] = f32x16{};
    const int ib = wid & 1;
#define CONS(ci_) do { const LAS unsigned char* bb = lds + ((ci_) & (RB_NB - 1)) * RB_BUF; \
          \
        v4u pf_[8], qf_[4], dd_[4], yd_[2]; f32x4 gm_[8]; \
        _Pragma("unroll") for (int q = 0; q < 8; ++q) gm_[q] = *(const LAS f32x4*)(bb + RB_GAM + (hi * 32 + 4 * q) * 4); \
        _Pragma("unroll") for (int q = 0; q < 4; ++q) dd_[q] = *(const LAS v4u*)(bb + RB_DD + ((((q >> 1) * 2 + ib) * 2 + (q & 1)) * 64 + lane) * 16); \
        _Pragma("unroll") for (int q = 0; q < 8; ++q) pf_[q] = *(const LAS v4u*)(bb + RB_PF + (q * 64 + lane) * 16); \
        _Pragma("unroll") for (int q = 0; q < 2; ++q) yd_[q] = *(const LAS v4u*)(bb + RB_YD + ((2 * ib + q) * 64 + lane) * 16); \
        _Pragma("unroll") for (int q = 0; q < 4; ++q) qf_[q] = *(const LAS v4u*)(bb + RB_QF + (q * 64 + lane) * 16); \
        __builtin_amdgcn_sched_barrier(0); \
        v4u Sf[4]; _Pragma("unroll") for (int s = 0; s < 4; ++s) Sf[s] = FRAGACC(S[s >> 1], s & 1); \
        _Pragma("unroll") for (int rb = 0; rb < 2; ++rb) { \
            f32x16 acc; unpack16(dd_[2 * rb], dd_[2 * rb + 1], acc); \
            _Pragma("unroll") for (int q = 0; q < 4; ++q) { const f32x4 gv = gm_[4 * rb + q]; _Pragma("unroll") for (int e = 0; e < 4; ++e) acc[4 * q + e] += gv[e] * S[rb][4 * q + e]; } \
            _Pragma("unroll") for (int s = 0; s < 4; ++s) acc = MFMA32(pf_[rb * 4 + s], Sf[s], acc); \
            S[rb] = acc; } \
        f32x16 y; unpack16(yd_[0], yd_[1], y); \
        _Pragma("unroll") for (int s = 0; s < 4; ++s) y = MFMA32(Sf[s], qf_[s], y); \
        float s1 = 0.f, s2 = 0.f; LAS float* yb_ = ybuf + (((ci_) & 1) * 2 + ib) * 1024 + lane; \
        _Pragma("unroll") for (int r = 0; r < 16; ++r) { s1 += y[r]; s2 += y[r] * y[r]; yb_[r * 64] = y[r]; } \
        s1 = swap32_sum(s1); s2 = swap32_sum(s2); \
        if (hi == 0) { stat[((((ci_) & 1) * 2 + ib) * 32 + l31) * 2] = s1; stat[((((ci_) & 1) * 2 + ib) * 32 + l31) * 2 + 1] = s2; } } while (0)
#define RB_BAR() do { asm volatile("s_waitcnt lgkmcnt(0)" ::: "memory"); __builtin_amdgcn_s_barrier(); asm volatile("" ::: "memory"); } while (0)
    if (wid < 2) {
        RB_BAR();
#pragma unroll 1
        for (int k = 0; k < NS; ++k) { CONS(k); RB_BAR(); }
        RB_BAR();
    } else if (wid == 4 || wid == 5) {
        const GAS v4u* gA = (const GAS v4u*)(wid == 4 ? Dm.PF : Dm.DD) + lane; const GAS v4u* gB = (const GAS v4u*)(wid == 4 ? Dm.QF : Dm.YD) + lane;
        const int oA = wid == 4 ? RB_PF : RB_DD, oB = wid == 4 ? RB_QF : RB_YD;
#define LD_ISSUE(ci_) do { const size_t u_ = (size_t)((ci_) < NS ? (ci_) : NS - 1) * (BATCH * RH) + bh; LAS unsigned char* b_ = lds + ((ci_) & (RB_NB - 1)) * RB_BUF; \
        _Pragma("unroll") for (int q = 0; q < 8; ++q) __builtin_amdgcn_global_load_lds((const unsigned*)(gA + u_ * 512 + q * 64), (LAS unsigned*)(b_ + oA + q * 1024), 16, 0, RB_AUX); \
        _Pragma("unroll") for (int q = 0; q < 4; ++q) __builtin_amdgcn_global_load_lds((const unsigned*)(gB + u_ * 256 + q * 64), (LAS unsigned*)(b_ + oB + q * 1024), 16, 0, RB_AUX); \
        if (lane < 16) __builtin_amdgcn_global_load_lds((const unsigned*)((const GAS v4u*)(Dm.GAM + u_ * 64) + lane), (LAS unsigned*)(b_ + RB_GAM), 16, 0, 0); } while (0)
        LD_ISSUE(0); LD_ISSUE(1); LD_ISSUE(2);
        asm volatile("s_waitcnt vmcnt(26)" ::: "memory");
        RB_BAR();
#pragma unroll 1
        for (int k = 0; k < NS; ++k) { LD_ISSUE(k + 3); asm volatile("s_waitcnt vmcnt(26)" ::: "memory"); RB_BAR(); }
        asm volatile("s_waitcnt vmcnt(0)" ::: "memory");
        RB_BAR();
#undef LD_ISSUE
    } else {
        RbEpi eA, eB, eC; f32x4 emu[2], elw[2], elb[2];
#pragma unroll
        for (int rg = 0; rg < 2; ++rg) { const int hc_ = h * 64 + 8 * ep + 4 * rg; emu[rg] = *(const GAS f32x4*)(F.shift_mu + 1024 + hc_); elw[rg] = *(const GAS f32x4*)(F.ln_w + hc_); elb[rg] = *(const GAS f32x4*)(F.ln_b + hc_); }
        EP_LOAD(eA, 0); EP_LOAD(eB, 1);
        RB_BAR();
        EP_LOAD(eC, 2); RB_BAR();
#define HY_STEP(k_, EP) do { EP_RUN(EP, (k_) - 1); EP_LOAD(EP, (k_) + 2); RB_BAR(); } while (0)
#pragma unroll 1
        for (int k = 1; k < NS; k += 3) { HY_STEP(k, eA); HY_STEP(k + 1, eB); HY_STEP(k + 2, eC); }
        EP_RUN(eA, NS - 1);
        RB_BAR();
#undef HY_STEP
    }
#undef RB_BAR
#undef ST_LOAD
#undef ST_STORE
#undef EP_LOAD
#undef EP_RUN
#undef CONS
}
constexpr int CW_G17 = 12288;
struct OneUnit { int pm, pn;
    __device__ __forceinline__ bool next(int i, pg8::Unit& u) const { if (i != 0) return false; u.pm = pm; u.pn = pn; return true; }
    __device__ __forceinline__ void a_ready(const pg8::Unit&) const {}
    __device__ __forceinline__ void done(const pg8::Unit&) const {} };
constexpr int AT_OUT = 65536, AT_G0 = 114688, AT_G1 = LDSCTL_OFF + 1024;
constexpr int AT_KB = 64 * 256, AT_VB = 64 * 256, AT_BUF = AT_KB + AT_VB, AT_QOFF = 2 * AT_KB + 3 * AT_VB;
__device__ __forceinline__ s16x4 vtr(const LAS unsigned char* p) { typedef short v4i16_t __attribute__((ext_vector_type(4))); return __builtin_bit_cast(s16x4, __builtin_amdgcn_ds_read_tr16_b64_v4i16((LAS v4i16_t*)p)); }
__device__ __forceinline__ void glds16_asm(const void* gsrc, unsigned lds_dst) {
    unsigned keep; const unsigned d_ = __builtin_amdgcn_readfirstlane(lds_dst);
    asm volatile("s_mov_b32 %0, m0\n\ts_mov_b32 m0, %2\n\ts_nop 0\n\tglobal_load_lds_dwordx4 %1, off\n\ts_mov_b32 m0, %0" : "=&s"(keep) : "v"(gsrc), "s"(d_) : "memory");
}
__device__ __forceinline__ void attn_unit(Frame& F, int b, int h, int qb) {
    int lane = mk_lane(); asm volatile("" : "+v"(lane));
    const int wid = F.wave, tid = wid * 64 + lane, l31 = lane & 31, hi = lane >> 5, map = wid >> 2, qs = wid & 3;
    LAS unsigned char* lds = F.lds + RING_OFF;
    const float slope2 = exp2f(-2.f * (float)(h + 1)) * LOG2E, shift2 = __uint_as_float(F.MISC[15]);
    const int q0 = qb * 128, qrow = q0 + 32 * qs + l31;
    const size_t mrow = (size_t)b * T + qrow;
    LAS bf16x8* qpark = (LAS bf16x8*)(lds + AT_QOFF + wid * 4096) + lane;
    { const bf16* qp = F.PROJ + mrow * NP + C_DQ + h * 128 + map * 64 + 8 * hi;
      v4u qraw[4]; float ss = 0.f;
#pragma unroll
      for (int s = 0; s < 4; ++s) qraw[s] = *(const GAS v4u*)(qp + 16 * s);
#pragma unroll
      for (int s = 0; s < 4; ++s)
#pragma unroll
          for (int j = 0; j < 4; ++j) { const float a_ = bflo(qraw[s][j]), b_ = bfhi(qraw[s][j]); ss += a_ * a_ + b_ * b_; }
      ss = swap32_sum(ss);
      const float rq = __builtin_amdgcn_rsqf(ss * (1.f / 64.f) + 1e-6f) * C2;
#pragma unroll
      for (int s = 0; s < 4; ++s) { const f32x4 g0 = *(const GAS f32x4*)(F.qn_g + 8 * hi + 16 * s), g1 = *(const GAS f32x4*)(F.qn_g + 8 * hi + 16 * s + 4);
          v4u w_; w_.x = cvtpk2(bflo(qraw[s].x) * rq * g0.x, bfhi(qraw[s].x) * rq * g0.y); w_.y = cvtpk2(bflo(qraw[s].y) * rq * g0.z, bfhi(qraw[s].y) * rq * g0.w);
          w_.z = cvtpk2(bflo(qraw[s].z) * rq * g1.x, bfhi(qraw[s].z) * rq * g1.y); w_.w = cvtpk2(bflo(qraw[s].w) * rq * g1.z, bfhi(qraw[s].w) * rq * g1.w);
          *(LAS v4u*)(qpark + s * 64) = w_; } }
    const bf16* kg = F.PROJ + (size_t)b * T * NP + C_DK + h * 128;
    const bf16* vg = F.PROJ + (size_t)b * T * NP + C_DV + h * 128;
    const int NT = 2 * qb + 2, tl = 2 * qb + (qs >> 1);
    const int Wk = (int)__builtin_ceilf((2.f * shift2 + 32.2f) / slope2);
    const int tf = __builtin_amdgcn_readfirstlane(max(0, (qb * 128 - Wk) >> 6));
    constexpr int AT_V0 = 2 * AT_KB;
    const int drow0 = 4 * wid + (lane >> 4), drow1 = drow0 + 32, dch = lane & 15;
    const unsigned ksrc0 = (unsigned)(drow0 * NP + ((dch ^ (drow0 & 15)) * 8)), ksrc1 = (unsigned)(drow1 * NP + ((dch ^ (drow1 & 15)) * 8));
    const unsigned vsrc0 = (unsigned)(drow0 * NP + ((dch ^ ((drow0 & 3) << 2)) * 8)), vsrc1 = (unsigned)(drow1 * NP + ((dch ^ ((drow1 & 3) << 2)) * 8));
#define AT_DMA(t_, kb_, v3_) do { const size_t tb_ = (size_t)(64 * (t_)) * NP; const unsigned bk_ = (unsigned)(size_t)(lds + (kb_) * AT_KB + wid * 1024), bv_ = (unsigned)(size_t)(lds + AT_V0 + (v3_) * AT_VB + wid * 1024); \
        glds16_asm(kg + tb_ + ksrc0, bk_); glds16_asm(kg + tb_ + ksrc1, bk_ + 8192u); glds16_asm(vg + tb_ + vsrc0, bv_); glds16_asm(vg + tb_ + vsrc1, bv_ + 8192u); } while (0)
#define AT_LAND() asm volatile("s_waitcnt vmcnt(0)" ::: "memory")
    f32x16 o[4];
#pragma unroll
    for (int vb = 0; vb < 4; ++vb) o[vb] = f32x16{};
    float lsum = 0.f;
    AT_DMA(tf, tf & 1, tf % 3);
    { const int gr_ = 16 * wid + (lane >> 4); const bf16* gsrc = F.PROJ + ((size_t)b * T + q0 + gr_) * NP + C_GB + h * 128;
      LAS unsigned char* gdst = F.lds + (wid < 4 ? AT_G0 + wid * 4096 : AT_G1 + (wid - 4) * 4096);
#pragma unroll
      for (int j = 0; j < 4; ++j) __builtin_amdgcn_global_load_lds((const unsigned*)(gsrc + (size_t)(4 * j) * NP + (((lane & 15) ^ (4 * j + (lane >> 4))) * 8)), (LAS unsigned*)(gdst + j * 1024), 16, 0, 0); }
    AT_LAND(); __syncthreads();
    const int G = lane >> 4, qq = (lane & 15) >> 2, pp = lane & 3;
    const int vrow = (4 * hi + qq) * 256 + 8 * (pp & 1), vch = 2 * (G & 1) + (pp >> 1);
    v4u pw[4];
#define SBAR_() __builtin_amdgcn_sched_barrier(0)
#define AT_QK(t) do { \
            const LAS unsigned char* Kb = lds + ((t) & 1) * AT_KB; \
            float sl_ = slope2; asm volatile("" : "+v"(sl_));     \
            const float base = sl_ * (float)(64 * (t) + 4 * hi - qrow) - shift2; \
            float ls = 0.f; \
            _Pragma("unroll") for (int hf = 0; hf < 2; ++hf) {        \
                f32x16 p; \
                _Pragma("unroll") for (int r = 0; r < 16; ++r) p[r] = __builtin_fmaf(sl_, (float)(32 * hf + (r & 3) + 8 * (r >> 2)), base); \
                _Pragma("unroll") for (int s = 0; s < 4; ++s) { \
                    const bf16x8 a0 = *(const LAS bf16x8*)(Kb + (32 * hf + l31) * 256 + (((map * 8 + 2 * s + hi) ^ (l31 & 15)) * 16)); \
                    p = __builtin_amdgcn_mfma_f32_32x32x16_bf16(a0, qpark[s * 64], p, 0, 0, 0); } \
                if ((t) == tl) { \
                    _Pragma("unroll") for (int r = 0; r < 16; ++r) { const int ki = 64 * (t) + 32 * hf + 4 * hi + (r & 3) + 8 * (r >> 2); if (ki > qrow) p[r] = -1e30f; } } \
                _Pragma("unroll") for (int r = 0; r < 16; ++r) { p[r] = __builtin_amdgcn_exp2f(p[r]); ls += p[r]; } \
                pw[2 * hf] = (v4u){cvtpk(p[0], p[1]), cvtpk(p[2], p[3]), cvtpk(p[4], p[5]), cvtpk(p[6], p[7])}; \
                pw[2 * hf + 1] = (v4u){cvtpk(p[8], p[9]), cvtpk(p[10], p[11]), cvtpk(p[12], p[13]), cvtpk(p[14], p[15])}; } \
            lsum += ls; } while (0)
#define AT_VRD(dst, ks, vb0) do { _Pragma("unroll") for (int vb = (vb0); vb < (vb0) + 2; ++vb) { const LAS unsigned char* a_ = Vb + vrow + ((4 * vb + vch) ^ (qq << 2)) * 16 + (32 * ((ks) >> 1) + 16 * ((ks) & 1)) * 256; \
        dst[2 * (vb - (vb0))] = vtr(a_); dst[2 * (vb - (vb0)) + 1] = vtr(a_ + 8 * 256); } } while (0)
#define AT_PV(src, pwk, vb0) do { _Pragma("unroll") for (int vb = (vb0); vb < (vb0) + 2; ++vb) { const int j_ = 2 * (vb - (vb0)); \
        const bf16x8 vf = (bf16x8){src[j_][0], src[j_][1], src[j_][2], src[j_][3], src[j_ + 1][0], src[j_ + 1][1], src[j_ + 1][2], src[j_ + 1][3]}; \
        o[vb] = __builtin_amdgcn_mfma_f32_32x32x16_bf16(vf, __builtin_bit_cast(bf16x8, pwk), o[vb], 0, 0, 0); } } while (0)
#define AT_PVV(v3_) do { const LAS unsigned char* Vb = lds + AT_V0 + (v3_) * AT_VB; s16x4 vA[4], vB[4]; \
            AT_VRD(vA, 0, 0); SBAR_(); AT_VRD(vB, 0, 2); SBAR_(); \
            AT_PV(vA, pw[0], 0); SBAR_(); AT_VRD(vA, 1, 0); SBAR_(); AT_PV(vB, pw[0], 2); SBAR_(); AT_VRD(vB, 1, 2); SBAR_(); \
            AT_PV(vA, pw[1], 0); SBAR_(); AT_VRD(vA, 2, 0); SBAR_(); AT_PV(vB, pw[1], 2); SBAR_(); AT_VRD(vB, 2, 2); SBAR_(); \
            AT_PV(vA, pw[2], 0); SBAR_(); AT_VRD(vA, 3, 0); SBAR_(); AT_PV(vB, pw[2], 2); SBAR_(); AT_VRD(vB, 3, 2); SBAR_(); \
            AT_PV(vA, pw[3], 0); SBAR_(); AT_PV(vB, pw[3], 2); } while (0)
    if (map == 0) {
        int v3 = tf % 3;
#pragma unroll 1
        for (int t = tf; t < NT; ++t) { const int vn = v3 == 2 ? 0 : v3 + 1;
            if (t + 1 < NT) AT_DMA(t + 1, (t + 1) & 1, vn);
            if (t <= tl) { AT_QK(t); AT_PVV(v3); }
            AT_LAND(); __syncthreads(); v3 = vn; }
    } else {
        int v3 = tf % 3;
#pragma unroll 1
        for (int t = tf; t < NT; ++t) { const int vp = v3 == 0 ? 2 : v3 - 1, vn = v3 == 2 ? 0 : v3 + 1;
            if (t + 1 < NT) AT_DMA(t + 1, (t + 1) & 1, vn);
            if (t > tf && t - 1 <= tl) AT_PVV(vp);
            if (t <= tl) AT_QK(t);
            AT_LAND(); __syncthreads(); v3 = vn; }
        if (NT - 1 <= tl) { const int vp = v3 == 0 ? 2 : v3 - 1; AT_PVV(vp); }
    }
#undef AT_PVV
#undef AT_QK
#undef AT_VRD
#undef AT_PV
#undef SBAR_
#undef AT_DMA
#undef AT_LAND
    __syncthreads();
    const float ltot = swap32_sum(lsum);
    LAS float* X = (LAS float*)lds;
    if (map == 1) {
        const float sc = __uint_as_float(F.MISC[14]) / ltot;
#pragma unroll
        for (int vb = 0; vb < 4; ++vb)
#pragma unroll
            for (int r = 0; r < 16; ++r) X[(qs * 64 + vb * 16 + r) * 64 + lane] = o[vb][r] * sc;
    }
    __syncthreads();
    if (map == 0) {
        const float il = 1.f / ltot; float ss = 0.f;
#pragma unroll
        for (int vb = 0; vb < 4; ++vb)
#pragma unroll
            for (int r = 0; r < 16; ++r) { const float v = o[vb][r] * il - X[(qs * 64 + vb * 16 + r) * 64 + lane]; o[vb][r] = v; ss += v * v; }
        ss = swap32_sum(ss);
        const float rn = (1.f / sqrtf(ss * (1.f / 128.f) + 1e-5f)) * (1.f - LAMBDA_INIT);
        int etok = 0; asm volatile("" : "+v"(etok));
        const int lane_e = mk_lane(), hi = lane_e >> 5, row = 32 * qs + (lane_e & 31);
        const LAS unsigned char* grow = F.lds + (qs < 2 ? AT_G0 : AT_G1 - 64 * 256) + row * 256 + 8 * hi;
        LAS unsigned char* orow = lds + AT_OUT + row * 256 + 8 * hi;
#pragma unroll
        for (int vb = 0; vb < 4; ++vb)
#pragma unroll
            for (int rg = 0; rg < 4; ++rg) {
                const int vc = 32 * vb + 8 * rg + 4 * hi, ch = (((4 * vb + rg) ^ (row & 15)) * 16) + etok;
                const v2u gw = *(const LAS v2u*)(grow + ch); const f32x4 sg = *(const GAS f32x4*)(F.subln_g + vc);
                const float g4[4] = {bflo(gw.x), bfhi(gw.x), bflo(gw.y), bfhi(gw.y)}; float ov[4];
#pragma unroll
                for (int e = 0; e < 4; ++e) ov[e] = o[vb][4 * rg + e] * rn * sg[e] * g4[e] / (1.f + __expf(-g4[e]));
                const unsigned w1_ = cvtpk(ov[2], ov[3]);
                *(LAS v2u*)(orow + ch) = (v2u){cvtpk(ov[0], ov[1]), w1_};
                if (rg == 3) asm volatile("" : "+v"(etok) : "v"(w1_));
            }
    }
    __syncthreads();
    { const int t_ = wid * 64 + mk_lane(); bf16* ob = F.MIX + ((size_t)b * T + q0) * D + 512 + h * 128;
#pragma unroll
      for (int i = 0; i < 4; ++i) { const int pc = t_ + 512 * i, r_ = pc >> 4, c_ = pc & 15;
          *(GAS v4u*)(ob + (size_t)r_ * D + c_ * 8) = *(const LAS v4u*)(lds + AT_OUT + r_ * 256 + ((c_ ^ (r_ & 15)) * 16)); } }
    __syncthreads();
}
#ifndef DBL
#define DBL 0
#endif
constexpr int CW_QUEUE = 8192;
constexpr int QX_RW = 8, QX_A2 = 0, QX_AT = 64, QX_ALL = QX_RW + QX_A2 + QX_AT;
template <int MODE = 0> __device__ __forceinline__ void p3_queue(Frame& F, const RwDump& Dm, const int qbase = CW_QUEUE) {
    const int ql = mk_lane();
    const float l1 = wave_sum(F.lq1[ql] * F.lk1[ql]), l2 = wave_sum(F.lq2[ql] * F.lk2[ql]);
    const float lam = __uint_as_float(__builtin_amdgcn_readfirstlane(__float_as_uint(__expf(l1) - __expf(l2) + LAMBDA_INIT)));
    float gq = fabsf(F.qn_g[ql]), gk = fabsf(F.kn_g[ql]);
#pragma unroll
    for (int o = 1; o < 64; o <<= 1) { gq = fmaxf(gq, __shfl_xor(gq, o)); gk = fmaxf(gk, __shfl_xor(gk, o)); }
    const float shift2 = __uint_as_float(__builtin_amdgcn_readfirstlane(__float_as_uint(8.f * gq * gk * LOG2E)));
    if (F.wave == 0 && mk_lane() == 0) { F.MISC[14] = __float_as_uint(lam); F.MISC[15] = __float_as_uint(shift2); }
    __syncthreads();
#ifdef Q_BLK
    const int x0 = (int)(blockIdx.x & 7);
#else
    const int x0 = (int)(xb_xcc_id() & 7u);
#endif
#pragma unroll 1
    for (int dx = 0; dx < 8; ++dx) {
        const int xq = (x0 + dx) & 7;
        for (;;) {
            if (F.wave == 0 && mk_lane() == 0) F.MISC[12] = __hip_atomic_fetch_add(F.ctl + qbase + 64 * xq, 1u, RLX_AGENT);
            __syncthreads();
            int item = __builtin_amdgcn_readfirstlane((int)F.MISC[12]); if (MODE == 2) item += QX_RW;
            __syncthreads();
            if (item >= (MODE == 1 ? QX_RW : QX_ALL)) break;
            if (item < QX_RW) { rwkvB_unit(F, Dm, xq * 8 + item); if (DBL & 64) rwkvB_unit(F, Dm, xq * 8 + item); }
            else { const int idx = item - QX_RW - QX_A2, h = 3 - (idx >> 4), qb = 15 - (idx & 15);
#pragma unroll 1
#ifndef NO_ATT
                for (int rep = 0; rep < ((DBL & 32) ? 2 : 1); ++rep) attn_unit(F, xq, h, qb);
#endif
            }
        }
    }
}

constexpr int GT_STAGE = 32768, GT_NS = 4, GT_NK = D / 64;
__device__ __forceinline__ void gemm1_tail_unit(Frame& F, int qu) {
    int lane = mk_lane(); asm volatile("" : "+v"(lane));
    const int wid = F.wave, l31 = lane & 31, hi = lane >> 5, wm = wid >> 1, wn = wid & 1;
    const int xcd = qu & 7, j = qu >> 3, R0 = (8 * xcd + (j & 7)) * 256 + ((j >> 3) >> 1) * 128, C0 = 4096 + ((j >> 3) & 1) * 128;
    LAS unsigned char* lds = F.lds + RING_OFF;
    const int vr0 = 32 * wid + (lane >> 3), cp = lane & 7;
#define GT_ISSUE(kc_) do { LAS unsigned char* sb_ = lds + ((kc_) % GT_NS) * GT_STAGE + wid * 4096; \
        _Pragma("unroll") for (int i = 0; i < 4; ++i) { const int v_ = vr0 + 8 * i; \
            const bf16* src_ = (wid < 4 ? F.XN + (size_t)(R0 + v_) * D : F.WinT + (size_t)(C0 + v_ - 128) * D) + (kc_) * 64 + ((cp ^ ((v_ >> 1) & 7)) * 8); \
            __builtin_amdgcn_global_load_lds((const unsigned*)src_, (LAS unsigned*)(sb_ + i * 1024), 16, 0, 0); } } while (0)
    f32x16 acc0 = f32x16{}, acc1 = f32x16{};
    const int rX = 32 * wm + l31, nW = 64 * wn + l31, offX = rX * 128, offW0 = 16384 + nW * 128, offW1 = offW0 + 32 * 128, kyX = (rX >> 1) & 7, kyW = (nW >> 1) & 7;
    GT_ISSUE(0); GT_ISSUE(1); GT_ISSUE(2);
#pragma unroll 1
    for (int kc = 0; kc < GT_NK; ++kc) {
        if (kc + 2 < GT_NK) asm volatile("s_waitcnt vmcnt(8)" ::: "memory"); else if (kc + 1 < GT_NK) asm volatile("s_waitcnt vmcnt(4)" ::: "memory"); else asm volatile("s_waitcnt vmcnt(0)" ::: "memory");
        __builtin_amdgcn_s_barrier(); asm volatile("" ::: "memory");
        if (kc + 3 < GT_NK) GT_ISSUE(kc + 3);
        const LAS unsigned char* sb = lds + (kc % GT_NS) * GT_STAGE;
        v4u xf[4], w0[4], w1[4];
#pragma unroll
        for (int s = 0; s < 4; ++s) { xf[s] = *(const LAS v4u*)(sb + offX + (((2 * s + hi) ^ kyX) * 16)); w0[s] = *(const LAS v4u*)(sb + offW0 + (((2 * s + hi) ^ kyW) * 16)); w1[s] = *(const LAS v4u*)(sb + offW1 + (((2 * s + hi) ^ kyW) * 16)); }
        __builtin_amdgcn_sched_barrier(0);
#pragma unroll
        for (int s = 0; s < 4; ++s) { acc0 = MFMA32(w0[s], xf[s], acc0); acc1 = MFMA32(w1[s], xf[s], acc1); }
        asm volatile("s_waitcnt lgkmcnt(0)" ::: "memory");
    }
#undef GT_ISSUE
    __syncthreads();
    { LAS unsigned char* orow = lds + rX * 256 + 8 * hi;
#pragma unroll
      for (int q = 0; q < 4; ++q) {
          *(LAS v2u*)(orow + (((8 * wn + q) ^ (rX & 15)) * 16)) = (v2u){cvtpk(acc0[4 * q], acc0[4 * q + 1]), cvtpk(acc0[4 * q + 2], acc0[4 * q + 3])};
          *(LAS v2u*)(orow + (((8 * wn + 4 + q) ^ (rX & 15)) * 16)) = (v2u){cvtpk(acc1[4 * q], acc1[4 * q + 1]), cvtpk(acc1[4 * q + 2], acc1[4 * q + 3])}; } }
    __syncthreads();
    { const int t_ = wid * 64 + lane; bf16* ob = F.PROJ + (size_t)R0 * NP + C0;
#pragma unroll
      for (int i = 0; i < 4; ++i) { const int pc = t_ + 512 * i, r_ = pc >> 4, c_ = pc & 15;
          *(GAS v4u*)(ob + (size_t)r_ * NP + c_ * 8) = *(const LAS v4u*)(lds + r_ * 256 + ((c_ ^ (r_ & 15)) * 16)); } }
    __syncthreads();
}
struct Args { const float* in[21]; float* out; unsigned char* ws; int ph_lo, ph_hi; };
__global__ void __launch_bounds__(NWAVES * 64, 2) hymba_fwd(Args args) {
    extern __shared__ __attribute__((aligned(16))) unsigned char lds[];
    Frame F;
    F.lds = (LAS unsigned char*)lds;
    F.MISC = (volatile LAS unsigned*)(F.lds + MISC_OFF);
    F.wave = __builtin_amdgcn_readfirstlane((int)threadIdx.x >> 6); F.lane = mk_lane(); F.tid = F.wave * 64 + F.lane;
    F.G = gridDim.x; { const int bx = blockIdx.x; F.vcu = (F.G % 8 == 0) ? (bx % 8) * (F.G / 8) + bx / 8 : bx; }
    unsigned char* ws = args.ws;
    F.ctl = (gu32*)(ws + WS_CTL);
    F.x = args.in[0]; F.norm_g = args.in[1]; F.w_in = args.in[2]; F.shift_mu = args.in[3]; F.w0 = args.in[4]; F.w_decay_up = args.in[5]; F.a0 = args.in[6]; F.w_iclr_up = args.in[7];
    F.k_k = args.in[8]; F.k_a = args.in[9]; F.r_k = args.in[10]; F.ln_w = args.in[11]; F.ln_b = args.in[12]; F.qn_g = args.in[13]; F.kn_g = args.in[14];
    F.lq1 = args.in[15]; F.lk1 = args.in[16]; F.lq2 = args.in[17]; F.lk2 = args.in[18]; F.subln_g = args.in[19]; F.w_out = args.in[20]; F.out = args.out;
    F.WinT = (bf16*)(ws + WS_WIN); F.WoutT = (bf16*)(ws + WS_WOUT); F.WdT = (bf16*)(ws + WS_WD); F.WaT = (bf16*)(ws + WS_WA);
    F.XN = (bf16*)(ws + WS_XN); F.PROJ = (bf16*)(ws + WS_PROJ); F.MIX = (bf16*)(ws + WS_MIX);
    for (int u = F.tid; u < (LDS_BYTES - LDSCTL_OFF) / 4; u += NWAVES * 64) ((LAS unsigned*)(F.lds + LDSCTL_OFF))[u] = 0u;
    __syncthreads();
    XcdBarrier bar; bar.bar = (unsigned*)(F.ctl + CW_BAR); bar.x = 0; bar.st = nullptr; bar.wave = F.wave;
    if (MK_N_LAUNCHES == 1) bar = xcd_barrier_post((unsigned*)(F.ctl + CW_BAR), F.MISC + 8, F.wave);
#define GRID_BAR() do { if (MK_N_LAUNCHES == 1) xcd_barrier(bar); } while (0)
    const int lo = args.ph_lo, hi = args.ph_hi;
#define IN(k) (lo <= (k) && (k) < hi)
#define BOTH(k) (IN(k) && IN((k) + 1))
#ifndef SKIP
#define SKIP 0
#endif
    if (IN(0) && !(SKIP & 1)) { p0_prologue(F); if (DBL & 1) { GRID_BAR(); p0_prologue(F); } if (BOTH(0)) GRID_BAR(); }
    if (IN(1) && !(SKIP & 2)) {
        pg8::Gemm g{F.XN, F.WinT, M, 4096, D}; pg8::StaticOrder S; S.init(M, 4096, F.G, (int)blockIdx.x);
        pg8::EpiBf16S E{F.PROJ, NP};
        pg8::gemm_phase<pg8::EpiBf16S, pg8::StaticOrder, true, true>(F.lds + RING_OFF, g, S, E, F.wave);
#pragma unroll 1
        for (int qu = (int)blockIdx.x; qu < 256; qu += F.G) gemm1_tail_unit(F, qu);
#ifdef TAILX2
#pragma unroll 1
        for (int rep = 0; rep < TAILX2; ++rep) {
#pragma unroll 1
        for (int qu = (int)blockIdx.x; qu < 256; qu += F.G) gemm1_tail_unit(F, qu); }
#endif
        if (DBL & 2) { GRID_BAR(); pg8::gemm_phase<pg8::EpiBf16S, pg8::StaticOrder, true, true>(F.lds + RING_OFF, g, S, E, F.wave); }
        if (BOTH(1)) GRID_BAR();
    }
    RwDump Dm; { unsigned char* so = (unsigned char*)args.out; Dm.PF = (v4u*)so; Dm.DD = (v4u*)(so + 32 * MiB); Dm.QF = (v4u*)(ws + WS_XN); Dm.YD = (v4u*)(ws + WS_XN + 16 * MiB);
        Dm.GAM = (float*)(ws + WS_END); Dm.RHO = (float*)(ws + WS_END + 1 * MiB); }
    if (IN(2) && !(SKIP & 4)) {
        LAS float* wscr = (LAS float*)(F.lds + LDSCTL_OFF + 1024) + F.wave * 64; int zpar = 0;
#pragma unroll 1
        for (int p = F.vcu; p < BATCH * (T / 32); p += F.G) { rwkvA_unit(F, Dm, (p >> 6) * RH + F.wave, p & 63, wscr, F.lds + RING_OFF + F.wave * 16384, (LAS v4u*)(F.lds + LDSCTL_OFF + 4096), zpar); zpar ^= 1; }
        if (DBL & 4) { GRID_BAR();
#pragma unroll 1
            for (int p = F.vcu; p < BATCH * (T / 32); p += F.G) { rwkvA_unit(F, Dm, (p >> 6) * RH + F.wave, p & 63, wscr, F.lds + RING_OFF + F.wave * 16384, (LAS v4u*)(F.lds + LDSCTL_OFF + 4096), zpar); zpar ^= 1; } }
        p2_qknorm(F);
        if (BOTH(2)) GRID_BAR();
    }
    if (IN(3) && !(SKIP & 8)) {
#ifdef P3SPLIT
        p3_queue<1>(F, Dm); GRID_BAR(); p3_queue<2>(F, Dm, CW_QUEUE + 1024);
#else
        p3_queue(F, Dm);
#endif
        if (DBL & 512) { GRID_BAR(); p3_queue(F, Dm, CW_QUEUE + 1024); }
        if (BOTH(3)) GRID_BAR();
    }
    if (IN(4) && !(SKIP & 16)) {
        pg8::Gemm g{F.MIX, F.WoutT, M, D, D}; pg8::StaticOrder S; S.init(M, D, F.G, (int)blockIdx.x);
        pg8::EpiResF32 E{F.x, F.out, D};
        pg8::gemm_phase<pg8::EpiResF32, pg8::StaticOrder, false, true>(F.lds + RING_OFF, g, S, E, F.wave);
        if (DBL & 16) { GRID_BAR(); pg8::gemm_phase<pg8::EpiResF32, pg8::StaticOrder, false, true>(F.lds + RING_OFF, g, S, E, F.wave); }
    }
#undef IN
#undef BOTH
}

extern "C" void kernel_launch(void* const* d_in, const int* in_sizes, int n_in, void* d_out, int out_size, void* d_ws, size_t ws_size, hipStream_t stream) {
    static int grid = 0;
    if (grid == 0) {
        if (n_in != 21 || in_sizes[0] != M * D || out_size != M * D || ws_size < WS_END + 2 * MiB) { fprintf(stderr, "kernel_launch: unexpected shapes (n_in %d, in0 %d, out %d, ws %zu); nothing launched\n", n_in, n_in > 0 ? in_sizes[0] : -1, out_size, ws_size); grid = -1; return; }
        int dev = 0, cus = 0, per_cu = 0;
        if (hipGetDevice(&dev) != hipSuccess || hipDeviceGetAttribute(&cus, hipDeviceAttributeMultiprocessorCount, dev) != hipSuccess) { grid = -1; return; }
        if (hipFuncSetAttribute((const void*)hymba_fwd, hipFuncAttributeMaxDynamicSharedMemorySize, LDS_BYTES) != hipSuccess) { fprintf(stderr, "kernel_launch: hipFuncSetAttribute failed\n"); grid = -1; return; }
        if (hipOccupancyMaxActiveBlocksPerMultiprocessor(&per_cu, (const void*)hymba_fwd, NWAVES * 64, LDS_BYTES) != hipSuccess || per_cu < 1) { fprintf(stderr, "kernel_launch: occupancy query reports %d workgroups per CU; nothing launched\n", per_cu); grid = -1; return; }
        (void)hipGetLastError();
        grid = cus;
        if (grid > 256) grid = 256;
    }
    if (grid < 0) return;
    if (hipMemsetAsync((char*)d_ws + WS_CTL, 0, CTL_ZERO_BYTES, stream) != hipSuccess) { fprintf(stderr, "kernel_launch: hipMemsetAsync failed\n"); return; }
    Args a{};
    for (int i = 0; i < 21; ++i) a.in[i] = (const float*)d_in[i];
    a.out = (float*)d_out; a.ws = (unsigned char*)d_ws;
    for (int li = 0; li < MK_N_LAUNCHES; ++li) {
        a.ph_lo = (MK_N_LAUNCHES == 1) ? 0 : li; a.ph_hi = (MK_N_LAUNCHES == 1) ? N_PHASES : li + 1;
        hipLaunchKernelGGL(hymba_fwd, dim3(grid), dim3(NWAVES * 64), LDS_BYTES, stream, a);
        const hipError_t le = hipPeekAtLastError();
        if (le != hipSuccess) { fprintf(stderr, "kernel_launch: launch %d failed: %s\n", li, hipGetErrorName(le)); break; }
    }
}
```

```cpp
#include <hip/hip_runtime.h>
#include <hip/hip_bf16.h>
#include <cstdio>
#include <cstdint>
#include <cmath>
namespace pg8 {
#define PG8_LAS __attribute__((address_space(3)))
typedef unsigned short bf16_t;
typedef short bf16x8 __attribute__((ext_vector_type(8)));
typedef float f32x4 __attribute__((ext_vector_type(4)));
typedef unsigned u32x4 __attribute__((ext_vector_type(4)));
constexpr int BM = 256, BK = 64, HALF = 128, HTB = HALF * BK * 2  , STAGE_BYTES = 8 * HTB, NXCD = 8, WGM = 8;

__host__ __device__ __forceinline__ int lds_byte(int r, int c) { const int st = (r >> 4) * 2 + (c >> 5), rr = r & 15, cc = c & 31, ob = rr * 64 + cc * 2; return st * 1024 + (ob ^ (((ob >> 9) & 1) << 5)); }
__host__ __device__ __forceinline__ void stage_rc(int b, int& R, int& C) { const int st = b / 1024, sb = b % 1024, swz = sb ^ (((sb >> 9) & 1) << 5); R = (st >> 1) * 16 + swz / 64; C = (st & 1) * 32 + (swz % 64) / 2; }
__host__ __device__ __forceinline__ int perm32(int rho) { const int n = rho >> 4, i = rho & 15; return 8 * (i >> 2) + 4 * n + (i & 3); }

__device__ __forceinline__ int mk_lane_pg8() { int l; asm volatile("v_mbcnt_lo_u32_b32 %0, -1, 0\n\tv_mbcnt_hi_u32_b32 %0, -1, %0" : "=v"(l)); return l; }
struct Unit { int pm, pn; };
struct Gemm { const bf16_t* A; const bf16_t* Bt; int M, N, K; };

struct StaticOrder {
    int nM, nN, nwg, G, c;
    __host__ __device__ void init(int M, int N, int G_, int c_) { nM = M / BM; nN = N / BM; nwg = nM * nN; G = G_; c = c_; }
    __host__ __device__ bool next(int i, Unit& u) const {
        const long L = (long)i * G + c; if (L >= nwg) return false;
        int wgid = (int)L; { const int q = nwg / NXCD, r = nwg % NXCD, xcd = wgid % NXCD, off = wgid / NXCD; wgid = (xcd < r ? xcd * (q + 1) : r * (q + 1) + (xcd - r) * q) + off; }
        const int nig = WGM * nN, gid = wgid / nig, fm = gid * WGM, gsz = (nM - fm) < WGM ? (nM - fm) : WGM;
        u.pm = fm + ((wgid % nig) % gsz); u.pn = (wgid % nig) / gsz; return true;
    }
    __device__ __forceinline__ void a_ready(const Unit&) const {}
    __device__ __forceinline__ void done(const Unit&) const {}
};

__device__ __forceinline__ unsigned cvt_pk_bf16(float lo, float hi) { unsigned r; asm volatile("v_cvt_pk_bf16_f32 %0, %1, %2" : "=v"(r) : "v"(lo), "v"(hi)); return r; }
struct EpiBf16S {
    static constexpr bool PERM = true, AFTER_DRAIN = false, HAS_INIT = false;
    bf16_t* O; int ldc;
    __device__ __forceinline__ void operator()(const f32x4 (&acc)[2][2][4][2], const Unit& u, int wr, int wc, int fr, int fq) const {
        const int row0 = u.pm * BM + wr * 64 + fr, col0 = u.pn * BM + wc * 32 + 8 * fq;
#pragma unroll
        for (int ai = 0; ai < 2; ++ai)
#pragma unroll
            for (int m = 0; m < 4; ++m) { bf16_t* rowp = O + (size_t)(row0 + ai * HALF + m * 16) * ldc + col0;
#pragma unroll
                for (int bj = 0; bj < 2; ++bj) { const f32x4 v0 = acc[ai][bj][m][0], v1 = acc[ai][bj][m][1];
                    u32x4 w; w.x = cvt_pk_bf16(v0[0], v0[1]); w.y = cvt_pk_bf16(v0[2], v0[3]); w.z = cvt_pk_bf16(v1[0], v1[1]); w.w = cvt_pk_bf16(v1[2], v1[3]);
                    *(u32x4*)(rowp + bj * HALF) = w; } }
    }
};
struct EpiResF32 {
    static constexpr bool PERM = false, AFTER_DRAIN = false, HAS_INIT = true;
    const float* base; float* out; int ldc;
    __device__ __forceinline__ void init(f32x4 (&acc)[2][2][4][2], const Unit& u, int wr, int wc, int fr, int fq) const {
        const int row0 = u.pm * BM + wr * 64 + fr, col0 = u.pn * BM + wc * 32 + 4 * fq;
#pragma unroll
        for (int ai = 0; ai < 2; ++ai)
#pragma unroll
            for (int m = 0; m < 4; ++m) { const size_t off = (size_t)(row0 + ai * HALF + m * 16) * ldc + col0;
#pragma unroll
                for (int bj = 0; bj < 2; ++bj)
#pragma unroll
                    for (int n = 0; n < 2; ++n) acc[ai][bj][m][n] = *(const f32x4*)(base + off + bj * HALF + n * 16); }
    }
    __device__ __forceinline__ void operator()(const f32x4 (&acc)[2][2][4][2], const Unit& u, int wr, int wc, int fr, int fq) const {
        const int row0 = u.pm * BM + wr * 64 + fr, col0 = u.pn * BM + wc * 32 + 4 * fq;
#pragma unroll
        for (int ai = 0; ai < 2; ++ai)
#pragma unroll
            for (int m = 0; m < 4; ++m) { const size_t off = (size_t)(row0 + ai * HALF + m * 16) * ldc + col0;
#pragma unroll
                for (int bj = 0; bj < 2; ++bj)
#pragma unroll
                    for (int n = 0; n < 2; ++n) *(f32x4*)(out + off + bj * HALF + n * 16) = acc[ai][bj][m][n]; }
    }
};
template <class Epi, class Sched, bool ALIGN_EPI = false, bool SP2 = false>
__device__ __forceinline__ void gemm_phase(PG8_LAS unsigned char* lds, const Gemm g, const Sched& S, const Epi& E, const int mk_wave_id  ) {
    const int wid = mk_wave_id, lane = mk_lane_pg8(), tid = wid * 64 + lane, wr = wid >> 2, wc = wid & 3, fr = lane & 15, fq = lane >> 4;
    const int K = g.K, nt = K / BK;
    unsigned voffA[2], voffB[2];
#pragma unroll
    for (int i = 0; i < 2; ++i) { int R, C; stage_rc(tid * 16 + i * 8192, R, C); const int Rb = Epi::PERM ? ((R & ~31) + perm32(R & 31)) : R;
        voffA[i] = (unsigned)(R * K + C) * 2u; voffB[i] = (unsigned)(Rb * K + C) * 2u; }
    const size_t kstep = (size_t)(BK * 2);
    const size_t hstep = (size_t)HALF * K * 2;
    const size_t tstep = 2 * hstep;
    const unsigned ldsw = (unsigned)wid * 1024u;
    const int aoff = lds_byte(wr * 64 + fr, fq * 8), boff = lds_byte(wc * 32 + fr, fq * 8);
#define PG8_SA(b, h) (((b) * 2 + (h)) * HTB)
#define PG8_SB(b, h) ((4 + (b) * 2 + (h)) * HTB)
#define PG8_STAGE(bufoff, gbase, voff) do { _Pragma("unroll") for (int _i = 0; _i < 2; ++_i) \
        __builtin_amdgcn_global_load_lds((const unsigned*)((const char*)(gbase) + (voff)[_i]), (PG8_LAS unsigned*)(lds + (bufoff) + ldsw + _i * 8192), 16, 0, 0); } while (0)
#define PG8_LDA(dst, b, h) do { _Pragma("unroll") for (int m = 0; m < 4; ++m) _Pragma("unroll") for (int k = 0; k < 2; ++k) dst[m][k] = *(const PG8_LAS bf16x8*)(lds + PG8_SA(b, h) + aoff + m * 2048 + k * 1024); } while (0)
#define PG8_LDB(dst, b, h) do { _Pragma("unroll") for (int n = 0; n < 2; ++n) _Pragma("unroll") for (int k = 0; k < 2; ++k) dst[n][k] = *(const PG8_LAS bf16x8*)(lds + PG8_SB(b, h) + boff + n * 2048 + k * 1024); } while (0)
#define PG8_MMA(ai, bj, At, Bt) do { __builtin_amdgcn_s_setprio(1); _Pragma("unroll") for (int m = 0; m < 4; ++m) _Pragma("unroll") for (int n = 0; n < 2; ++n) _Pragma("unroll") for (int k = 0; k < 2; ++k) \
        acc[ai][bj][m][n] = __builtin_amdgcn_mfma_f32_16x16x32_bf16(Bt[n][k], At[m][k], acc[ai][bj][m][n], 0, 0, 0); __builtin_amdgcn_s_setprio(0); } while (0)
#define PG8_WAIT_V(n) asm volatile("s_waitcnt vmcnt(" #n ")" ::: "memory")
#define PG8_WAIT_L(n) asm volatile("s_waitcnt lgkmcnt(" #n ")" ::: "memory")
#define PG8_BAR __builtin_amdgcn_s_barrier()
#define PG8_SCHED __builtin_amdgcn_sched_barrier(0)
    Unit cur, nxt; int ui = 0;
    if (!S.next(0, cur)) return;
    f32x4 acc[2][2][4][2];
#pragma unroll
    for (int a = 0; a < 2; ++a)
#pragma unroll
        for (int b = 0; b < 2; ++b)
#pragma unroll
            for (int m = 0; m < 4; ++m)
#pragma unroll
                for (int n = 0; n < 2; ++n) acc[a][b][m][n] = (f32x4){0.f, 0.f, 0.f, 0.f};
    if constexpr (Epi::HAS_INIT) E.init(acc, cur, wr, wc, fr, fq);
    bf16x8 At[4][2], B0[2][2], B1[2][2];
    const char* cA = (const char*)g.A + (size_t)cur.pm * tstep; const char* cB = (const char*)g.Bt + (size_t)cur.pn * tstep;
    S.a_ready(cur);
    if constexpr (SP2) {
        PG8_STAGE(PG8_SB(0, 0), cB, voffB); PG8_STAGE(PG8_SB(0, 1), cB + hstep, voffB); PG8_STAGE(PG8_SA(0, 0), cA, voffA); PG8_STAGE(PG8_SA(0, 1), cA + hstep, voffA);
        if (wr == 1) PG8_BAR;
        PG8_WAIT_V(2); PG8_BAR;
        PG8_STAGE(PG8_SB(1, 0), cB + kstep, voffB); PG8_STAGE(PG8_SA(1, 0), cA + kstep, voffA); PG8_STAGE(PG8_SB(1, 1), cB + hstep + kstep, voffB);
        PG8_WAIT_V(6); PG8_BAR;
    } else {
        PG8_STAGE(PG8_SB(0, 0), cB, voffB); PG8_STAGE(PG8_SA(0, 0), cA, voffA); PG8_STAGE(PG8_SB(0, 1), cB + hstep, voffB); PG8_STAGE(PG8_SA(0, 1), cA + hstep, voffA);
        if (wr == 1) PG8_BAR;
        PG8_WAIT_V(4); PG8_BAR;
        PG8_STAGE(PG8_SB(1, 0), cB + kstep, voffB); PG8_STAGE(PG8_SA(1, 0), cA + kstep, voffA); PG8_STAGE(PG8_SB(1, 1), cB + hstep + kstep, voffB);
        PG8_WAIT_V(6); PG8_BAR;
    }
    for (;;) {
        const bool has_next = S.next(ui + 1, nxt);
        const char* nA = has_next ? (const char*)g.A + (size_t)nxt.pm * tstep : cA; const char* nB = has_next ? (const char*)g.Bt + (size_t)nxt.pn * tstep : cB;
        for (int t = 0; t < nt; t += 2) {
            const bool last = (t == nt - 2);
            const char* a1 = cA + (size_t)(t + 1) * kstep;
            const char* a2 = last ? nA : cA + (size_t)(t + 2) * kstep; const char* b2 = last ? nB : cB + (size_t)(t + 2) * kstep;
            const char* a3 = a2 + kstep; const char* b3 = b2 + kstep;
            if (last && has_next) S.a_ready(nxt);
            if constexpr (SP2) {
            PG8_LDB(B0, 0, 0); PG8_LDB(B1, 0, 1); PG8_SCHED; PG8_LDA(At, 0, 0); PG8_STAGE(PG8_SA(1, 1), a1 + hstep, voffA);
            PG8_WAIT_V(8); PG8_WAIT_L(0); PG8_BAR; PG8_MMA(0, 0, At, B0); PG8_MMA(0, 1, At, B1); PG8_BAR; PG8_SCHED;
            PG8_LDA(At, 0, 1); PG8_STAGE(PG8_SB(0, 0), b2, voffB); PG8_STAGE(PG8_SB(0, 1), b2 + hstep, voffB); PG8_STAGE(PG8_SA(0, 0), a2, voffA);
            PG8_WAIT_V(8); PG8_WAIT_L(0); PG8_BAR; PG8_MMA(1, 0, At, B0); PG8_MMA(1, 1, At, B1); PG8_BAR; PG8_SCHED;
            PG8_LDB(B0, 1, 0); PG8_LDB(B1, 1, 1); PG8_SCHED; PG8_LDA(At, 1, 0); PG8_STAGE(PG8_SA(0, 1), a2 + hstep, voffA);
            PG8_WAIT_V(8); PG8_WAIT_L(0); PG8_BAR; PG8_MMA(0, 0, At, B0); PG8_MMA(0, 1, At, B1); PG8_BAR; PG8_SCHED;
            PG8_LDA(At, 1, 1); PG8_STAGE(PG8_SB(1, 0), b3, voffB); PG8_STAGE(PG8_SB(1, 1), b3 + hstep, voffB); PG8_STAGE(PG8_SA(1, 0), a3, voffA);
            PG8_WAIT_V(8); PG8_WAIT_L(0); PG8_BAR; PG8_MMA(1, 0, At, B0); PG8_MMA(1, 1, At, B1); PG8_BAR; PG8_SCHED;
            } else {
            PG8_LDB(B0, 0, 0); PG8_SCHED; PG8_LDA(At, 0, 0); PG8_STAGE(PG8_SA(1, 1), a1 + hstep, voffA);
            PG8_WAIT_L(8); PG8_BAR; PG8_WAIT_L(0); PG8_MMA(0, 0, At, B0); PG8_BAR; PG8_SCHED;
            PG8_LDB(B1, 0, 1); PG8_STAGE(PG8_SB(0, 0), b2, voffB);
            PG8_BAR; PG8_WAIT_L(0); PG8_MMA(0, 1, At, B1); PG8_BAR;
            PG8_LDA(At, 0, 1); PG8_STAGE(PG8_SA(0, 0), a2, voffA);
            PG8_BAR; PG8_WAIT_L(0); PG8_MMA(1, 0, At, B0); PG8_BAR; PG8_SCHED;
            PG8_STAGE(PG8_SB(0, 1), b2 + hstep, voffB);
            PG8_WAIT_V(6); PG8_BAR; PG8_MMA(1, 1, At, B1); PG8_BAR;
            PG8_LDB(B0, 1, 0); PG8_SCHED; PG8_LDA(At, 1, 0); PG8_STAGE(PG8_SA(0, 1), a2 + hstep, voffA);
            PG8_WAIT_L(8); PG8_BAR; PG8_WAIT_L(0); PG8_MMA(0, 0, At, B0); PG8_BAR; PG8_SCHED;
            PG8_LDB(B1, 1, 1); PG8_STAGE(PG8_SB(1, 0), b3, voffB);
            PG8_BAR; PG8_WAIT_L(0); PG8_MMA(0, 1, At, B1); PG8_BAR;
            PG8_LDA(At, 1, 1); PG8_STAGE(PG8_SA(1, 0), a3, voffA);
            PG8_BAR; PG8_WAIT_L(0); PG8_MMA(1, 0, At, B0); PG8_BAR; PG8_SCHED;
            PG8_STAGE(PG8_SB(1, 1), b3 + hstep, voffB);
            PG8_WAIT_V(6); PG8_BAR; PG8_MMA(1, 1, At, B1); PG8_BAR;
            }
        }
        if constexpr (ALIGN_EPI) { if (wr == 0) PG8_BAR; }
        if constexpr (!Epi::AFTER_DRAIN) { E(acc, cur, wr, wc, fr, fq); S.done(cur); }
        if (!has_next) break;
#pragma unroll
        for (int a = 0; a < 2; ++a)
#pragma unroll
            for (int b = 0; b < 2; ++b)
#pragma unroll
                for (int m = 0; m < 4; ++m)
#pragma unroll
                    for (int n = 0; n < 2; ++n) acc[a][b][m][n] = (f32x4){0.f, 0.f, 0.f, 0.f};
        if constexpr (Epi::HAS_INIT) E.init(acc, nxt, wr, wc, fr, fq);
        cur = nxt; cA = nA; cB = nB; ++ui;
        if constexpr (ALIGN_EPI) { if (wr == 1) PG8_BAR; }
    }
    PG8_WAIT_V(0);
    if constexpr (!ALIGN_EPI) { if (wr == 0) PG8_BAR; }
    PG8_BAR;
    if constexpr (Epi::AFTER_DRAIN) { E.fused(acc, cur, wr, wc, fr, fq, lds, wid, lane); S.done(cur); }
#undef PG8_SA
#undef PG8_SB
#undef PG8_STAGE
#undef PG8_LDA
#undef PG8_LDB
#undef PG8_MMA
#undef PG8_WAIT_V
#undef PG8_WAIT_L
#undef PG8_BAR
#undef PG8_SCHED
}
}
constexpr int NWAVES = 8;
#ifndef MK_N_LAUNCHES
#define MK_N_LAUNCHES 1
#endif
constexpr int N_PHASES = 5;
constexpr int BATCH = 8, T = 2048, D = 1024, M = BATCH * T;
constexpr int NP = 4224;
constexpr int C_R = 0, C_K = 512, C_V = 1024, C_ZW = 1536, C_ZA = 1600, C_GA = 1664, C_DQ = 2176, C_DK = 2688, C_DV = 3200, C_GB = 3712;
constexpr int RH = 8, RN = 64;
constexpr int AH = 4;
constexpr float C2 = 0.125f * 1.4426950408889634f;
constexpr float LOG2E = 1.4426950408889634f;
constexpr float LAMBDA_INIT = 0.2f;

constexpr size_t MiB = 1u << 20;
constexpr size_t WS_CTL = 0, CTL_ZERO_BYTES = 1 * MiB;
constexpr size_t WS_WIN = 2 * MiB;
constexpr size_t WS_WOUT = 11 * MiB;
constexpr size_t WS_WD = 13 * MiB, WS_WA = 13 * MiB + 65536;
constexpr size_t WS_RHO = 13 * MiB + 2 * 65536;
constexpr size_t WS_XN = 14 * MiB;
constexpr size_t WS_PROJ = 46 * MiB;
constexpr size_t WS_MIX = 182 * MiB;
constexpr size_t WS_END = 214 * MiB;
constexpr int CW_BAR = 4096;

constexpr int RING_OFF = 0, RING_BYTES = 131072;
constexpr int LDSCTL_OFF = RING_BYTES, MISC_OFF = LDSCTL_OFF + 320;
constexpr int LDS_BYTES = 155648;

#define GAS __attribute__((address_space(1)))
#define LAS __attribute__((address_space(3)))
typedef unsigned short bf16;
typedef unsigned v4u __attribute__((ext_vector_type(4)));
typedef unsigned v2u __attribute__((ext_vector_type(2)));
typedef float f32x4 __attribute__((ext_vector_type(4)));
typedef float f32x16 __attribute__((ext_vector_type(16)));
typedef short bf16x8 __attribute__((ext_vector_type(8)));
typedef short s16x4 __attribute__((ext_vector_type(4)));
typedef GAS unsigned gu32;
typedef GAS unsigned long long gu64;
#define RLX_AGENT __ATOMIC_RELAXED, __HIP_MEMORY_SCOPE_AGENT
#define LDS_WAIT() asm volatile("s_waitcnt lgkmcnt(0)" ::: "memory")
#define VM_WAIT() asm volatile("s_waitcnt vmcnt(0)" ::: "memory")
__device__ __forceinline__ unsigned f2bf(float f) { unsigned u = __builtin_bit_cast(unsigned, f); return (u + 0x7fffu + ((u >> 16) & 1u)) >> 16; }
__device__ __forceinline__ unsigned pk2(float lo, float hi) { return f2bf(lo) | (f2bf(hi) << 16); }
__device__ __forceinline__ float bflo(unsigned u) { return __uint_as_float(u << 16); }
__device__ __forceinline__ float bfhi(unsigned u) { return __uint_as_float(u & 0xffff0000u); }
__device__ __forceinline__ float bf1(unsigned short u) { return __uint_as_float((unsigned)u << 16); }
__device__ __forceinline__ int mk_lane() { int l; asm volatile("v_mbcnt_lo_u32_b32 %0, -1, 0\n\tv_mbcnt_hi_u32_b32 %0, -1, %0" : "=v"(l)); return l; }
#define XB_TMO      128
#define XB_XCNT(j)  (256  + 64 * (j))
#define XB_XSUB(j)  (1280 + 64 * (j))
#define XB_XGEN(j)  (2304 + 64 * (j))
#define XB_TOP      3328
#define XB_TOPGEN   3392
#define XCD_BAR_WORDS 3456
#define XB_SPIN_CAP (1u << 18)

__device__ __forceinline__ unsigned xb_ld(unsigned* p)              { return __hip_atomic_load(p, __ATOMIC_RELAXED, __HIP_MEMORY_SCOPE_AGENT); }
__device__ __forceinline__ unsigned xb_add(unsigned* p, unsigned v) { return __hip_atomic_fetch_add(p, v, __ATOMIC_RELAXED, __HIP_MEMORY_SCOPE_AGENT); }
__device__ __forceinline__ unsigned xb_xcc_id() { return (unsigned)__builtin_amdgcn_s_getreg((3 << 11) | 20) & 0xFu; }
#define XB_SPIN(cond, bar) do { unsigned _sp = 0; while (cond) { __builtin_amdgcn_s_sleep(1); \
    if ((++_sp & 255u) == 0u) { if (xb_ld(&(bar)[XB_TMO])) break; if (_sp > XB_SPIN_CAP) { atomicAdd(&(bar)[XB_TMO], 1u); break; } } } } while (0)

struct XcdBarrier {
    unsigned* bar; unsigned x;
    volatile LAS unsigned* st;
    int wave;
};

__device__ __forceinline__ XcdBarrier xcd_barrier_post(unsigned* bar, volatile LAS unsigned* st, int wave) {
    XcdBarrier b; b.bar = bar; b.x = xb_xcc_id(); b.st = st; b.wave = wave;
    if (wave == 0 && mk_lane() == 0) (void)xb_add(&bar[XB_XCNT(b.x)], 1u);
    return b;
}
__device__ __forceinline__ void xcd_barrier_complete(unsigned* bar, unsigned x, unsigned& nloc, unsigned& nx) {
    const unsigned G = gridDim.x * gridDim.y * gridDim.z;
    unsigned sum, cnt, mine, sp = 0u;
    for (;;) {
        sum = 0u; cnt = 0u; mine = 0u;
#pragma unroll
        for (unsigned j = 0; j < 16; ++j) { const unsigned c = xb_ld(&bar[XB_XCNT(j)]); sum += c; cnt += (c > 0u) ? 1u : 0u; mine = (j == x) ? c : mine; }
        if (sum == G) break;
        __builtin_amdgcn_s_sleep(1);
        if ((++sp & 255u) == 0u) { if (xb_ld(&bar[XB_TMO])) break; if (sp > XB_SPIN_CAP) { atomicAdd(&bar[XB_TMO], 1u); break; } }
    }
    nloc = mine > 0u ? mine : 1u; nx = cnt > 0u ? cnt : 1u;
}

__device__ __forceinline__ void xcd_barrier(const XcdBarrier& b) {
    asm volatile("s_waitcnt vmcnt(0)" ::: "memory");
    __syncthreads();
    if (b.wave == 0 && mk_lane() == 0) {
        unsigned* bar = b.bar;
        __builtin_amdgcn_s_waitcnt(0);
        unsigned nloc = b.st[0], nx = b.st[1];
        if (nloc == 0u) { xcd_barrier_complete(bar, b.x, nloc, nx); b.st[0] = nloc; b.st[1] = nx; }
        const unsigned old = xb_add(&bar[XB_XSUB(b.x)], 1u);
        const unsigned gen = old / nloc;
        if (old + 1u == (gen + 1u) * nloc) {
            __builtin_amdgcn_fence(__ATOMIC_RELEASE, "agent");
            asm volatile("s_waitcnt vmcnt(0)" ::: "memory");
            const unsigned og = xb_add(&bar[XB_TOP], 1u);
            const unsigned tg = og / nx;
            if (og + 1u == (tg + 1u) * nx) xb_add(&bar[XB_TOPGEN], 1u);
            else XB_SPIN(xb_ld(&bar[XB_TOPGEN]) == tg, bar);
            __builtin_amdgcn_fence(__ATOMIC_ACQUIRE, "agent");
            xb_add(&bar[XB_XGEN(b.x)], 1u);
            asm volatile("s_waitcnt vmcnt(0)" ::: "memory");
        } else {
            XB_SPIN(xb_ld(&bar[XB_XGEN(b.x)]) == gen, bar);
            __builtin_amdgcn_fence(__ATOMIC_ACQUIRE, "agent");
            asm volatile("s_waitcnt vmcnt(0)" ::: "memory");
        }
    }
    __syncthreads();
}
struct Frame {
    LAS unsigned char* lds;
    volatile LAS unsigned* MISC;
    gu32* ctl;
    int tid, lane, wave;
    int vcu, G;
    const float* x; float* out;
    const float *norm_g, *w_in, *shift_mu, *w0, *w_decay_up, *a0, *w_iclr_up, *k_k, *k_a, *r_k, *ln_w, *ln_b, *qn_g, *kn_g, *lq1, *lk1, *lq2, *lk2, *subln_g, *w_out;
    bf16 *WinT, *WoutT, *WdT, *WaT, *XN, *PROJ, *MIX;
};

typedef float f32x2q_t __attribute__((ext_vector_type(2))); typedef __bf16 bf16x2q_t __attribute__((ext_vector_type(2)));
__device__ __forceinline__ unsigned cvtpk2(float lo, float hi) { f32x2q_t v = {lo, hi}; bf16x2q_t b = __builtin_convertvector(v, bf16x2q_t); return __builtin_bit_cast(unsigned, b); }
__device__ __forceinline__ float wave_sum(float v) {
#pragma unroll
    for (int o = 1; o < 64; o <<= 1) v += __shfl_xor(v, o);
    return v;
}
template <int CTRL> __device__ __forceinline__ float dpp_f(float x) { return __builtin_bit_cast(float, __builtin_amdgcn_mov_dpp(__builtin_bit_cast(int, x), CTRL, 0xf, 0xf, true)); }
__device__ __forceinline__ float row16_sum(float x) {
    x += dpp_f<0xB1>(x); x += dpp_f<0x4E>(x); x += dpp_f<0x141>(x); x += dpp_f<0x140>(x); return x;
}
__device__ __forceinline__ float swap32_sum(float x) {
    auto rr = __builtin_amdgcn_permlane32_swap(__float_as_uint(x), __float_as_uint(x), false, false);
    return __uint_as_float(rr[0]) + __uint_as_float(rr[1]);
}

template <bool FRAG = false> __device__ __forceinline__ void p0_transpose_item(const float* W, int N, int nsrc, const float* kscale, bf16* WT, int K, int ndst, LAS float* scr, int k0, int lane) {
    float v[32];
#pragma unroll
    for (int i = 0; i < 32; ++i) { const int kk = 2 * i + (lane >> 5); v[i] = (nsrc >= 0) ? W[(size_t)(k0 + kk) * N + nsrc + (lane & 31)] : 0.f; }
    if (kscale && nsrc >= 0) {
#pragma unroll
        for (int i = 0; i < 32; ++i) v[i] *= kscale[k0 + 2 * i + (lane >> 5)];
    }
#pragma unroll
    for (int i = 0; i < 32; ++i) scr[(2 * i + (lane >> 5)) * 33 + (lane & 31)] = v[i];
    LDS_WAIT(); asm volatile("" ::: "memory");
    const int c = lane & 7;
#pragma unroll
    for (int j = 0; j < 4; ++j) { const int n = (lane >> 3) + 8 * j; const LAS float* s = scr + (8 * c) * 33 + n;
        v4u o; o.x = cvtpk2(s[0 * 33], s[1 * 33]); o.y = cvtpk2(s[2 * 33], s[3 * 33]); o.z = cvtpk2(s[4 * 33], s[5 * 33]); o.w = cvtpk2(s[6 * 33], s[7 * 33]);
        if (FRAG) *(GAS v4u*)(WT + ((size_t)((ndst >> 5) * 4 + (c >> 1)) * 64 + ((c & 1) * 32 + n)) * 8) = o;
        else *(GAS v4u*)(WT + (size_t)(ndst + n) * K + k0 + 8 * c) = o; }
    LDS_WAIT(); asm volatile("" ::: "memory");
}
template <int NQ> __device__ __forceinline__ void p0_rowsq(Frame& F, int mq, int mstep) {
    f32x4 v[NQ][4][4];
#pragma unroll
    for (int q = 0; q < NQ; ++q)
#pragma unroll
        for (int u = 0; u < 4; ++u) { const GAS f32x4* xr = (const GAS f32x4*)(F.x + (size_t)(mq + q * mstep + u) * D) + 2 * F.lane;
#pragma unroll
            for (int j = 0; j < 2; ++j) { v[q][u][2 * j] = __builtin_nontemporal_load(xr + 128 * j); v[q][u][2 * j + 1] = __builtin_nontemporal_load(xr + 128 * j + 1); } }
#pragma unroll
    for (int q = 0; q < NQ; ++q) {
        float s[4];
#pragma unroll
        for (int u = 0; u < 4; ++u) { float a = 0.f;
#pragma unroll
            for (int j = 0; j < 4; ++j) a += (v[q][u][j].x * v[q][u][j].x + v[q][u][j].y * v[q][u][j].y) + (v[q][u][j].z * v[q][u][j].z + v[q][u][j].w * v[q][u][j].w);
            s[u] = a; }
#pragma unroll
        for (int u = 0; u < 4; ++u) {
            const float rstd = __builtin_amdgcn_rsqf(wave_sum(s[u]) * (1.f / D) + 1e-6f);
            GAS v4u* o16 = (GAS v4u*)(F.XN + (size_t)(mq + q * mstep + u) * D) + F.lane;
#pragma unroll
            for (int j = 0; j < 2; ++j) { const f32x4 a = v[q][u][2 * j], c = v[q][u][2 * j + 1];
                o16[64 * j] = (v4u){cvtpk2(a.x * rstd, a.y * rstd), cvtpk2(a.z * rstd, a.w * rstd), cvtpk2(c.x * rstd, c.y * rstd), cvtpk2(c.z * rstd, c.w * rstd)}; }
        }
    }
}
__device__ __forceinline__ void p0_prologue(Frame& F) {
    LAS float* scr = (LAS float*)(F.lds + RING_OFF + F.wave * 16384);
    const int gw = F.vcu * NWAVES + F.wave, NGW = F.G * NWAVES;
    constexpr int I_IN = (D / 64) * (NP / 32), I_OUT = (D / 64) * (D / 32), I_L = 512 / 32;
    constexpr int NITEMS = I_IN + I_OUT + 2 * I_L;
    int m0 = gw * 4;
    const bool two = (m0 + NGW * 4 < M) && (m0 + 2 * NGW * 4 >= M);
    if (!(gw & 1) && m0 < M) { if (two) { p0_rowsq<2>(F, m0, NGW * 4); m0 += 2 * NGW * 4; } else { p0_rowsq<1>(F, m0, 0); m0 += NGW * 4; } }
#pragma unroll 1
    for (int it = gw; it < NITEMS; it += NGW) {
        int r = it;
        if (r < I_IN) { const int kb = r / (NP / 32), nb = r % (NP / 32), nd = 32 * nb; const int ns = nd;
            p0_transpose_item(F.w_in, 4224, ns, F.norm_g, F.WinT, D, nd, scr, 64 * kb, F.lane); continue; } r -= I_IN;
        if (r < I_OUT) { const int kb = r / (D / 32), nb = r % (D / 32);
            p0_transpose_item(F.w_out, D, 32 * nb, nullptr, F.WoutT, D, 32 * nb, scr, 64 * kb, F.lane); continue; } r -= I_OUT;
        if (r < I_L) { p0_transpose_item<true>(F.w_decay_up, 512, 32 * r, nullptr, F.WdT, 64, 32 * r, scr, 0, F.lane); continue; } r -= I_L;
        p0_transpose_item<true>(F.w_iclr_up, 512, 32 * r, nullptr, F.WaT, 64, 32 * r, scr, 0, F.lane);
    }
    if (two && m0 + NGW * 4 < M) { p0_rowsq<2>(F, m0, NGW * 4); m0 += 2 * NGW * 4; }
#pragma unroll 1
    for (; m0 < M; m0 += NGW * 4) p0_rowsq<1>(F, m0, 0);
}

__device__ __forceinline__ float tanh_f(float x) { const float e = __expf(-2.f * fabsf(x)); const float t = (1.f - e) * __builtin_amdgcn_rcpf(1.f + e); return x < 0.f ? -t : t; }
__device__ __forceinline__ void shifted8(const bf16* proj, size_t m, bool has_prev, int col, const float* mu, float (&o)[8]) {
    const v4u c = *(const GAS v4u*)(proj + m * NP + col);
    v4u p = (v4u){0u, 0u, 0u, 0u}; if (has_prev) p = *(const GAS v4u*)(proj + (m - 1) * NP + col);
    const f32x4 m0 = *(const GAS f32x4*)(mu), m1 = *(const GAS f32x4*)(mu + 4);
    const unsigned cw[4] = {c.x, c.y, c.z, c.w}, pw[4] = {p.x, p.y, p.z, p.w}; const float mm[8] = {m0.x, m0.y, m0.z, m0.w, m1.x, m1.y, m1.z, m1.w};
#pragma unroll
    for (int j = 0; j < 4; ++j) { const float c0 = bflo(cw[j]), c1 = bfhi(cw[j]), p0 = bflo(pw[j]), p1 = bfhi(pw[j]);
        o[2 * j] = c0 + (p0 - c0) * mm[2 * j]; o[2 * j + 1] = c1 + (p1 - c1) * mm[2 * j + 1]; }
}
__device__ __forceinline__ void shifted4(const bf16* proj, size_t m, bool has_prev, int col, const float* mu, float (&o)[4]) {
    const v2u c = *(const GAS v2u*)(proj + m * NP + col);
    v2u p = (v2u){0u, 0u}; if (has_prev) p = *(const GAS v2u*)(proj + (m - 1) * NP + col);
    const f32x4 m0 = *(const GAS f32x4*)(mu);
    o[0] = bflo(c.x) + (bflo(p.x) - bflo(c.x)) * m0.x; o[1] = bfhi(c.x) + (bfhi(p.x) - bfhi(c.x)) * m0.y;
    o[2] = bflo(c.y) + (bflo(p.y) - bflo(c.y)) * m0.z; o[3] = bfhi(c.y) + (bfhi(p.y) - bfhi(c.y)) * m0.w;
}
__device__ __forceinline__ void p2_qknorm(Frame& F) {
    const int gw = F.vcu * NWAVES + F.wave, NGW = F.G * NWAVES, lane = F.lane, sub = lane & 7;
    const f32x4 gk0 = *(const GAS f32x4*)(F.kn_g + sub * 8), gk1 = *(const GAS f32x4*)(F.kn_g + sub * 8 + 4);
    constexpr int UQ = 4;
    for (int it0 = gw * UQ; it0 < M; it0 += NGW * UQ) {
        bf16* p[UQ]; v4u c[UQ];
#pragma unroll
        for (int u = 0; u < UQ; ++u) { const size_t m = (size_t)(it0 + u); p[u] = F.PROJ + m * NP + C_DK + (lane >> 3) * 64 + sub * 8; c[u] = *(const GAS v4u*)p[u]; }
#pragma unroll
        for (int u = 0; u < UQ; ++u) {
            const unsigned cw[4] = {c[u].x, c[u].y, c[u].z, c[u].w};
            float xv[8]; float ss = 0.f;
#pragma unroll
            for (int j = 0; j < 4; ++j) { xv[2 * j] = bflo(cw[j]); xv[2 * j + 1] = bfhi(cw[j]); ss += xv[2 * j] * xv[2 * j] + xv[2 * j + 1] * xv[2 * j + 1]; }
            ss += dpp_f<0xB1>(ss); ss += dpp_f<0x4E>(ss); ss += dpp_f<0x141>(ss);
            const float r = __builtin_amdgcn_rsqf(ss * (1.f / 64.f) + 1e-6f);
            v4u o; o.x = cvtpk2(xv[0] * r * gk0.x, xv[1] * r * gk0.y); o.y = cvtpk2(xv[2] * r * gk0.z, xv[3] * r * gk0.w); o.z = cvtpk2(xv[4] * r * gk1.x, xv[5] * r * gk1.y); o.w = cvtpk2(xv[6] * r * gk1.z, xv[7] * r * gk1.w);
            *(GAS v4u*)p[u] = o;
        }
    }
}
typedef float f32x2_t __attribute__((ext_vector_type(2))); typedef __bf16 bf16x2_t __attribute__((ext_vector_type(2)));
__device__ __forceinline__ unsigned cvtpk(float lo, float hi) { f32x2_t v = {lo, hi}; bf16x2_t b = __builtin_convertvector(v, bf16x2_t); return __builtin_bit_cast(unsigned, b); }
#define MFMA32(a, b, c) __builtin_amdgcn_mfma_f32_32x32x16_bf16(__builtin_bit_cast(bf16x8, (a)), __builtin_bit_cast(bf16x8, (b)), (c), 0, 0, 0)
#define FRAGACC(z, s) ((v4u){cvtpk((z)[8 * (s)], (z)[8 * (s) + 1]), cvtpk((z)[8 * (s) + 2], (z)[8 * (s) + 3]), cvtpk((z)[8 * (s) + 4], (z)[8 * (s) + 5]), cvtpk((z)[8 * (s) + 6], (z)[8 * (s) + 7])})
template <int CTRL, int RM> __device__ __forceinline__ float dpp_upd0(float x) { return __builtin_bit_cast(float, __builtin_amdgcn_update_dpp(0, __builtin_bit_cast(int, x), CTRL, RM, 0xf, false)); }
__device__ __forceinline__ float scan32(float x) {
    x += dpp_upd0<0x111, 0xf>(x); x += dpp_upd0<0x112, 0xf>(x); x += dpp_upd0<0x114, 0xf>(x); x += dpp_upd0<0x118, 0xf>(x); x += dpp_upd0<0x142, 0xa>(x); return x;
}
__device__ __forceinline__ void st_wt16(v4u* p, const v4u v) { *(GAS v4u*)p = v; }
constexpr int RW_UNITS = BATCH * RH * (T / 32);
struct RwDump { v4u* PF; v4u* DD; v4u* QF; v4u* YD; float* GAM; float* RHO; };

__device__ __forceinline__ void rwkvA_unit(Frame& F, const RwDump& Dm, int bh, int ci, LAS float* wscr, LAS unsigned char* park, LAS v4u* zsh, int zpar) {
    int lane = mk_lane(); asm volatile("" : "+v"(lane));
    const int hi = lane >> 5, l31 = lane & 31, b = bh >> 3, w = bh & 7;
    LAS v4u* pk = (LAS v4u*)park + lane;
#define PARK(slot) pk[(slot) * 64]
    int tok = 0; asm volatile("" : "+v"(tok));
#define DEP(x) asm volatile("" : "+v"(tok) : "v"(x))
    const int t = ci * 32 + l31; const size_t m = (size_t)b * T + t; const bool hp = t > 0;
    const int u = ci * (BATCH * RH) + bh;
    const float pm = hp ? 1.f : 0.f;
    const float* mu = F.shift_mu + w * 64 + 4 * hi;
    const float *pw0 = F.w0 + w * 64 + 4 * hi, *pa0 = F.a0 + w * 64 + 4 * hi, *pkk = F.k_k + w * 64 + 4 * hi, *pka = F.k_a + w * 64 + 4 * hi, *prk = F.r_k + w * 64 + 4 * hi;
    LAS unsigned char* stg = park + 8192;
    LAS unsigned char* prv = F.lds + LDSCTL_OFF + 20480 + F.wave * 256;
    const bf16* gk = F.PROJ + ((size_t)b * T + ci * 32) * NP + w * 64;
    const bf16* gpr = gk - (ci > 0 ? NP : 0);
#define RW_DMA(src, dst) __builtin_amdgcn_global_load_lds((const unsigned*)(src), (LAS unsigned*)(dst), 16, 0, 0)
    LDS_WAIT();
    { const bf16* s_ = gk + (size_t)(lane >> 3) * NP + C_K;
#pragma unroll
      for (int p = 0; p < 4; ++p) RW_DMA(s_ + (size_t)(8 * p) * NP + (((lane & 7) ^ ((4 * p + (lane >> 4)) & 7)) * 8), stg + p * 1024);
      if (lane < 8) RW_DMA(gpr + C_K + lane * 8, prv); }
#define RW_STAGE_RV(cb) do { const bf16* s_ = gk + (size_t)(lane >> 2) * NP + 32 * (cb) + (((lane & 3) ^ ((lane >> 4) & 3)) * 8); \
      _Pragma("unroll") for (int p = 0; p < 2; ++p) { RW_DMA(s_ + C_R + (size_t)(16 * p) * NP, stg + 4096 + p * 1024); RW_DMA(s_ + C_V + (size_t)(16 * p) * NP, stg + 6144 + p * 1024); } \
      if (lane < 4) { RW_DMA(gpr + C_R + 32 * (cb) + lane * 8, prv + 128); RW_DMA(gpr + C_V + 32 * (cb) + lane * 8, prv + 192); } } while (0)
    RW_STAGE_RV(0);
    const LAS unsigned char* kcur = stg + l31 * 128 + 8 * hi; const LAS unsigned char* kprv = l31 ? kcur - 128 : prv + 8 * hi;
    const LAS unsigned char* rcur = stg + 4096 + l31 * 64 + 8 * hi; const LAS unsigned char* rprv = l31 ? rcur - 64 : prv + 128 + 8 * hi;
    const LAS unsigned char* vcur = stg + 6144 + l31 * 64 + 8 * hi; const LAS unsigned char* vprv = l31 ? vcur - 64 : prv + 192 + 8 * hi;
    const int fKc = ((l31 >> 1) & 7) << 4, fKp = l31 ? (((l31 - 1) >> 1) & 7) << 4 : 0, fRc = ((l31 >> 2) & 3) << 4, fRp = l31 ? (((l31 - 1) >> 2) & 3) << 4 : 0;
    v4u bz[4], ba[4];
    { const int s = F.wave >> 1; const bool which = (F.wave & 1) != 0;
      const bf16* zc = F.PROJ + m * NP + 8 * hi; const bf16* zp = F.PROJ + (hp ? m - 1 : m) * NP + 8 * hi; const float* zmu = F.shift_mu + 8 * hi;
      const int COL = (which ? C_ZA : C_ZW) + 16 * s, MUO = (which ? 1600 : 1536) + 16 * s;
      const v4u c = *(const GAS v4u*)(zc + tok + COL), p = *(const GAS v4u*)(zp + tok + COL); const f32x4 m0 = *(const GAS f32x4*)(zmu + tok + MUO), m1 = *(const GAS f32x4*)(zmu + tok + MUO + 4);
      float z[8];
#pragma unroll
      for (int j = 0; j < 4; ++j) { const float c0 = bflo(c[j]), c1 = bfhi(c[j]); const float mm0 = j < 2 ? m0[2 * j] : m1[2 * j - 4], mm1 = j < 2 ? m0[2 * j + 1] : m1[2 * j - 3];
          z[2 * j] = c0 + (bflo(p[j]) * pm - c0) * mm0; z[2 * j + 1] = c1 + (bfhi(p[j]) * pm - c1) * mm1; }
      if (!which) {
#pragma unroll
          for (int j = 0; j < 8; ++j) z[j] = tanh_f(z[j]); }
      LAS v4u* zs = zsh + zpar * 512;
      zs[((which ? 4 : 0) + s) * 64 + lane] = (v4u){cvtpk(z[0], z[1]), cvtpk(z[2], z[3]), cvtpk(z[4], z[5]), cvtpk(z[6], z[7])};
      __syncthreads();
#pragma unroll
      for (int q = 0; q < 4; ++q) { bz[q] = zs[q * 64 + lane]; ba[q] = zs[(4 + q) * 64 + lane]; }
      DEP(bz[3][3]); DEP(ba[3][3]); }
    asm volatile("" ::: "memory");
    asm volatile("s_waitcnt vmcnt(0)" ::: "memory");
    float ss = 0.f;
#pragma unroll
    for (int gq = 0; gq < 8; ++gq) { const v2u c_ = *(const LAS v2u*)(kcur + tok + ((16 * gq) ^ fKc)), p_ = *(const LAS v2u*)(kprv + tok + ((16 * gq) ^ fKp));
        const f32x4 m_ = *(const GAS f32x4*)(mu + tok + 512 + 8 * gq), kkp = *(const GAS f32x4*)(pkk + tok + 8 * gq);
        float k4[4]; k4[0] = bflo(c_.x) + (bflo(p_.x) * pm - bflo(c_.x)) * m_.x; k4[1] = bfhi(c_.x) + (bfhi(p_.x) * pm - bfhi(c_.x)) * m_.y;
        k4[2] = bflo(c_.y) + (bflo(p_.y) * pm - bflo(c_.y)) * m_.z; k4[3] = bfhi(c_.y) + (bfhi(p_.y) * pm - bfhi(c_.y)) * m_.w;
#pragma unroll
        for (int e = 0; e < 4; ++e) { const float q = k4[e] * kkp[e]; ss += q * q; }
        if (gq == 3) DEP(ss); }
    ss = swap32_sum(ss);
    const float inv = __builtin_amdgcn_rcpf(fmaxf(__builtin_amdgcn_sqrtf(ss), 1e-12f));
    asm volatile("" ::: "memory");
    v4u fa[4], fb[4], fk[4], fr[4], fv[4]; float rho = 0.f;
    float* gp = Dm.GAM + (size_t)u * 64 + hi * 32;
#define RW_LORA(cb) f32x16 accd = f32x16{}, acca = f32x16{}; _Pragma("unroll") for (int s = 0; s < 4; ++s) { \
        const v4u aD = *(const GAS v4u*)(F.WdT + tok + ((size_t)((w * 2 + (cb)) * 4 + s) * 64 + lane) * 8); accd = MFMA32(aD, bz[s], accd);     \
        const v4u aA = *(const GAS v4u*)(F.WaT + tok + ((size_t)((w * 2 + (cb)) * 4 + s) * 64 + lane) * 8); acca = MFMA32(aA, ba[s], acca); }
        struct RwGL { v2u rc, rp, kc, kp, vc, vp; };
    struct RwPar { f32x4 mr, mk, mv, w0, a0, kk; } pA, pB;
#define RW_LOADG(X, CB, RG) do { X.rc = *(const LAS v2u*)(rcur + tok + ((16 * (RG)) ^ fRc)); X.rp = *(const LAS v2u*)(rprv + tok + ((16 * (RG)) ^ fRp)); \
        X.kc = *(const LAS v2u*)(kcur + tok + ((64 * (CB) + 16 * (RG)) ^ fKc)); X.kp = *(const LAS v2u*)(kprv + tok + ((64 * (CB) + 16 * (RG)) ^ fKp)); \
        X.vc = *(const LAS v2u*)(vcur + tok + ((16 * (RG)) ^ fRc)); X.vp = *(const LAS v2u*)(vprv + tok + ((16 * (RG)) ^ fRp)); } while (0)
#define RW_LOADP(X, OFF_) do { X.mr = *(const GAS f32x4*)(mu + tok + (OFF_)); X.mk = *(const GAS f32x4*)(mu + tok + 512 + (OFF_)); X.mv = *(const GAS f32x4*)(mu + tok + 1024 + (OFF_)); \
        X.w0 = *(const GAS f32x4*)(pw0 + tok + (OFF_)); X.a0 = *(const GAS f32x4*)(pa0 + tok + (OFF_)); X.kk = *(const GAS f32x4*)(pkk + tok + (OFF_)); } while (0)
#define RW_LERP(dst, c_, p_, m_) do { dst[0] = bflo(c_.x) + (bflo(p_.x) * pm - bflo(c_.x)) * m_.x; dst[1] = bfhi(c_.x) + (bfhi(p_.x) * pm - bfhi(c_.x)) * m_.y; \
        dst[2] = bflo(c_.y) + (bflo(p_.y) * pm - bflo(c_.y)) * m_.z; dst[3] = bfhi(c_.y) + (bfhi(p_.y) * pm - bfhi(c_.y)) * m_.w; } while (0)
#define RW_GROUP(cb, rg, CUR, NXT, HASN) do { constexpr int OFF = 32 * (cb) + 8 * (rg); const int ch0 = OFF + 4 * hi; \
            if (HASN) RW_LOADP(NXT, OFF + 8); \
            RwGL g_; RW_LOADG(g_, cb, rg); \
            float rr[4], kk4[4], vv[4]; \
            const f32x4 kap = *(const GAS f32x4*)(pka + tok + OFF), rkp = *(const GAS f32x4*)(prk + tok + OFF);     \
            const f32x4 mr_ = CUR.mr, mk_ = CUR.mk, mv_ = CUR.mv, w0v = CUR.w0, a0v = CUR.a0, kkp = CUR.kk; \
            RW_LERP(rr, g_.rc, g_.rp, mr_); RW_LERP(kk4, g_.kc, g_.kp, mk_); RW_LERP(vv, g_.vc, g_.vp, mv_); \
            float xa[4], xb[4], xk[4], xr[4], gg[4], ge[4]; \
            _Pragma("unroll") for (int e = 0; e < 4; ++e) { \
                  \
                const float l2 = (-0.6065306597126334f * LOG2E) * __builtin_amdgcn_rcpf(1.f + __expf(-(w0v[e] + accd[4 * (rg) + e]))); \
                const float g = scan32(l2); \
                const float a = __builtin_amdgcn_rcpf(1.f + __expf(-(a0v[e] + acca[4 * (rg) + e]))); \
                const float kk = kk4[e] * kkp[e] * inv; \
                const float kt = kk4[e] * (1.f + (a - 1.f) * kap[e]); \
                rho += rr[e] * kt * rkp[e]; \
                const float eg = __builtin_amdgcn_exp2f(g), egp = __builtin_amdgcn_exp2f(g - l2), eng = __builtin_amdgcn_rcpf(eg); \
                xa[e] = -kk * egp; xb[e] = kk * a * eng; xk[e] = kt * eng; xr[e] = rr[e] * eg; gg[e] = g; ge[e] = eg; } \
            if (l31 == 31) { *(LAS f32x4*)(wscr + ch0) = (f32x4){gg[0], gg[1], gg[2], gg[3]}; st_wt16((v4u*)(gp + (cb) * 16 + 4 * (rg)), (v4u){__float_as_uint(ge[0]), __float_as_uint(ge[1]), __float_as_uint(ge[2]), __float_as_uint(ge[3])}); } \
            constexpr int s_ = 2 * (cb) + ((rg) >> 1), vg = 2 * ((rg) & 1); \
            fa[s_][vg] = cvtpk(xa[0], xa[1]); fa[s_][vg + 1] = cvtpk(xa[2], xa[3]); \
            fb[s_][vg] = cvtpk(xb[0], xb[1]); fb[s_][vg + 1] = cvtpk(xb[2], xb[3]); \
            fk[s_][vg] = cvtpk(xk[0], xk[1]); fk[s_][vg + 1] = cvtpk(xk[2], xk[3]); \
            fr[s_][vg] = cvtpk(xr[0], xr[1]); fr[s_][vg + 1] = cvtpk(xr[2], xr[3]); \
            fv[s_][vg] = cvtpk(vv[0], vv[1]); fv[s_][vg + 1] = cvtpk(vv[2], vv[3]); \
            if (((rg) & 1) == 1) { PARK(s_) = fv[s_]; PARK(4 + s_) = fr[s_]; } \
            DEP(fa[s_][vg + 1]); DEP(fb[s_][vg + 1]); DEP(fk[s_][vg + 1]); DEP(fr[s_][vg + 1]); DEP(fv[s_][vg + 1]); DEP(rho); } while (0)
    RW_LOADP(pA, 0);
    { RW_LORA(0) RW_GROUP(0, 0, pA, pB, true); RW_GROUP(0, 1, pB, pA, true); RW_GROUP(0, 2, pA, pB, true); RW_GROUP(0, 3, pB, pA, true); }
    LDS_WAIT(); RW_STAGE_RV(1);
    { RW_LORA(1) asm volatile("s_waitcnt vmcnt(0)" ::: "memory");
      RW_GROUP(1, 0, pA, pB, true); RW_GROUP(1, 1, pB, pA, true); RW_GROUP(1, 2, pA, pB, true); RW_GROUP(1, 3, pB, pA, false); }
#undef RW_STAGE_RV
#undef RW_DMA
#undef RW_LOADG
#undef RW_LOADP
#undef RW_LERP
#undef RW_LORA
#undef RW_GROUP
    LDS_WAIT(); asm volatile("" ::: "memory");
    float EC[2]; EC[0] = __builtin_amdgcn_exp2f(wscr[l31]); EC[1] = __builtin_amdgcn_exp2f(wscr[32 + l31]);
    LDS_WAIT(); asm volatile("" ::: "memory");
    rho = swap32_sum(rho);
    if (hi == 0) __hip_atomic_store((gu32*)(Dm.RHO + (size_t)u * 32 + l31), __float_as_uint(rho), RLX_AGENT);
    v4u idf[2];
    { const int jst = 4 * ((l31 >> 3) & 1) + (l31 & 3); const bool hm = ((l31 >> 2) & 1) == hi; const unsigned one = 0x3F80u << (16 * (jst & 1));
#pragma unroll
      for (int sig = 0; sig < 2; ++sig) { const bool on = hm && ((l31 >> 4) == sig);
#pragma unroll
          for (int q = 0; q < 4; ++q) idf[sig][q] = (on && (jst >> 1) == q) ? one : 0u; } }
    LDS_WAIT();
    v4u Af[2][2], Vf[2][2];
#pragma unroll
    for (int blk = 0; blk < 2; ++blk) {
        f32x16 za = MFMA32(fa[2 * blk], idf[0], f32x16{}); za = MFMA32(fa[2 * blk + 1], idf[1], za);
        f32x16 zv = MFMA32(PARK(2 * blk), idf[0], f32x16{}); zv = MFMA32(PARK(2 * blk + 1), idf[1], zv);
        f32x16 zb = MFMA32(fb[2 * blk], idf[0], f32x16{}); zb = MFMA32(fb[2 * blk + 1], idf[1], zb);
        f32x16 zk = MFMA32(fk[2 * blk], idf[0], f32x16{}); zk = MFMA32(fk[2 * blk + 1], idf[1], zk);
        zb = zb * EC[blk]; zk = zk * EC[blk];
#pragma unroll
        for (int s = 0; s < 2; ++s) { Af[blk][s] = FRAGACC(za, s); Vf[blk][s] = FRAGACC(zv, s); PARK(8 + 2 * blk + s) = FRAGACC(zb, s); PARK(12 + 2 * blk + s) = FRAGACC(zk, s); }
        __builtin_amdgcn_sched_barrier(0);
    }
    f32x16 Aab = f32x16{}, TT = f32x16{}, AakT = f32x16{}, ArbT = f32x16{}, ArkT = f32x16{};
#pragma unroll
    for (int s = 0; s < 4; ++s) { const v4u frs = PARK(4 + s); Aab = MFMA32(fa[s], fb[s], Aab); TT = MFMA32(fb[s], fa[s], TT); AakT = MFMA32(fk[s], fa[s], AakT); ArbT = MFMA32(fb[s], frs, ArbT); ArkT = MFMA32(fk[s], frs, ArkT); }
#pragma unroll
    for (int r = 0; r < 16; ++r) { const int rowi = (r & 3) + 8 * (r >> 2) + 4 * hi;
        Aab[r] = (l31 < rowi) ? Aab[r] : 0.f; TT[r] = (rowi < l31) ? TT[r] : 0.f; AakT[r] = (rowi < l31) ? AakT[r] : 0.f;
        ArbT[r] = (rowi <= l31) ? ArbT[r] : 0.f; ArkT[r] = (rowi <= l31) ? ArkT[r] : 0.f; }
    v4u AakTf[2], ArbTf[2], ArkTf[2];
#pragma unroll
    for (int s = 0; s < 2; ++s) { AakTf[s] = FRAGACC(AakT, s); ArbTf[s] = FRAGACC(ArbT, s); ArkTf[s] = FRAGACC(ArkT, s); }
    __builtin_amdgcn_sched_barrier(0);
    v4u Xf[2], XTf[2], TTf[2];
#pragma unroll
    for (int s = 0; s < 2; ++s) { Xf[s] = FRAGACC(Aab, s); XTf[s] = FRAGACC(TT, s); }
#pragma unroll
    for (int r = 0; r < 16; ++r) { const int rowi = (r & 3) + 8 * (r >> 2) + 4 * hi; TT[r] += (rowi == l31) ? 1.f : 0.f; }
#pragma unroll
    for (int it = 0; it < 4; ++it) {
        f32x16 X2 = MFMA32(XTf[0], Xf[0], f32x16{}); X2 = MFMA32(XTf[1], Xf[1], X2);
        if (it < 3) { f32x16 X2T = MFMA32(Xf[0], XTf[0], f32x16{}); X2T = MFMA32(Xf[1], XTf[1], X2T);
#pragma unroll
            for (int s = 0; s < 2; ++s) XTf[s] = FRAGACC(X2T, s); }
#pragma unroll
        for (int s = 0; s < 2; ++s) { Xf[s] = FRAGACC(X2, s); TTf[s] = FRAGACC(TT, s); }
        TT = MFMA32(Xf[0], TTf[0], TT); TT = MFMA32(Xf[1], TTf[1], TT);
        __builtin_amdgcn_sched_barrier(0);
    }
#pragma unroll
    for (int s = 0; s < 2; ++s) TTf[s] = FRAGACC(TT, s);
    v4u Wf[2][2], Uf[2][2];
#pragma unroll
    for (int blk = 0; blk < 2; ++blk) {
        f32x16 av = MFMA32(AakTf[0], Vf[blk][0], f32x16{}); av = MFMA32(AakTf[1], Vf[blk][1], av);
        const v4u avf0 = FRAGACC(av, 0), avf1 = FRAGACC(av, 1);
        f32x16 uu = MFMA32(TTf[0], avf0, f32x16{}); uu = MFMA32(TTf[1], avf1, uu);
        f32x16 ww = MFMA32(TTf[0], Af[blk][0], f32x16{}); ww = MFMA32(TTf[1], Af[blk][1], ww);
#pragma unroll
        for (int s = 0; s < 2; ++s) { Wf[blk][s] = FRAGACC(ww, s); Uf[blk][s] = FRAGACC(uu, s); }
        __builtin_amdgcn_sched_barrier(0);
    }
    v4u* QFp = Dm.QF + (size_t)u * 256 + lane; v4u* YDp = Dm.YD + (size_t)u * 256 + lane;
#pragma unroll
    for (int blk = 0; blk < 2; ++blk) {
        f32x16 q;
#pragma unroll
        for (int s = 0; s < 2; ++s)
            { const v4u frs = PARK(4 + 2 * blk + s);
#pragma unroll
              for (int j = 0; j < 4; ++j) { q[8 * s + 2 * j] = bflo(frs[j]); q[8 * s + 2 * j + 1] = bfhi(frs[j]); } }
        q = MFMA32(Wf[blk][0], ArbTf[0], q); q = MFMA32(Wf[blk][1], ArbTf[1], q);
        st_wt16(QFp + (2 * blk) * 64, FRAGACC(q, 0)); st_wt16(QFp + (2 * blk + 1) * 64, FRAGACC(q, 1));
        f32x16 y = MFMA32(Uf[blk][0], ArbTf[0], f32x16{}); y = MFMA32(Uf[blk][1], ArbTf[1], y); y = MFMA32(Vf[blk][0], ArkTf[0], y); y = MFMA32(Vf[blk][1], ArkTf[1], y);
        st_wt16(YDp + (2 * blk) * 64, FRAGACC(y, 0)); st_wt16(YDp + (2 * blk + 1) * 64, FRAGACC(y, 1));
        __builtin_amdgcn_sched_barrier(0);
    }
    v4u* PFp = Dm.PF + (size_t)u * 512 + lane; v4u* DDp = Dm.DD + (size_t)u * 512 + lane;
#pragma unroll
    for (int c1 = 0; c1 < 2; ++c1)
#pragma unroll
        for (int cb = 0; cb < 2; ++cb) {
            f32x16 p = MFMA32(Wf[c1][0], PARK(8 + 2 * cb), f32x16{}); p = MFMA32(Wf[c1][1], PARK(8 + 2 * cb + 1), p);
            st_wt16(PFp + (cb * 4 + 2 * c1) * 64, FRAGACC(p, 0)); st_wt16(PFp + (cb * 4 + 2 * c1 + 1) * 64, FRAGACC(p, 1));
            __builtin_amdgcn_sched_barrier(0);
        }
#pragma unroll
    for (int cb = 0; cb < 2; ++cb)
#pragma unroll
        for (int ib = 0; ib < 2; ++ib) {
            f32x16 d = MFMA32(PARK(8 + 2 * cb), Uf[ib][0], f32x16{}); d = MFMA32(PARK(8 + 2 * cb + 1), Uf[ib][1], d); d = MFMA32(PARK(12 + 2 * cb), Vf[ib][0], d); d = MFMA32(PARK(12 + 2 * cb + 1), Vf[ib][1], d);
            st_wt16(DDp + ((cb * 2 + ib) * 2) * 64, FRAGACC(d, 0)); st_wt16(DDp + ((cb * 2 + ib) * 2 + 1) * 64, FRAGACC(d, 1));
            __builtin_amdgcn_sched_barrier(0);
        }
}

#undef PARK
#undef DEP
constexpr int RB_PF = 0, RB_DD = 8192, RB_QF = 16384, RB_YD = 20480, RB_GAM = 24576, RB_BUF = 24832, RB_NB = 4, RB_STAT = RB_NB * RB_BUF, RB_Y = RB_STAT + 1024;
__device__ __forceinline__ void unpack16(const v4u a, const v4u b, f32x16& o) {
#pragma unroll
    for (int j = 0; j < 4; ++j) { o[2 * j] = bflo(a[j]); o[2 * j + 1] = bfhi(a[j]); o[8 + 2 * j] = bflo(b[j]); o[8 + 2 * j + 1] = bfhi(b[j]); }
}
constexpr int RW_SPLIT = T / 32, CW_DONE = 16384;
__device__ __forceinline__ void rw_wait_chunk(Frame& F, int ci) {
    unsigned spins = 0;
#pragma unroll 1
    for (int j = 7; j >= 0; --j) { gu32* c = F.ctl + CW_DONE + 64 * (ci + j);
        while ((unsigned)__builtin_amdgcn_readfirstlane(__hip_atomic_load(c, RLX_AGENT)) < (unsigned)BATCH) { __builtin_amdgcn_s_sleep(8); if (++spins > (1u << 22)) break; } }
    __builtin_amdgcn_fence(__ATOMIC_ACQUIRE, "agent");
}
__device__ __forceinline__ void rw_publish_chunk(Frame& F, int ci) {
    asm volatile("s_waitcnt vmcnt(0)" ::: "memory");
    __syncthreads();
    if (F.wave == 0 && mk_lane() == 0) {
        __hip_atomic_fetch_add(F.ctl + CW_DONE + 64 * ci, 1u, RLX_AGENT);
    }
}
#ifndef RB_AUX
#define RB_AUX 2
#endif
struct RbStage { v4u p[2], d[2], q, y, g; };
struct RbEpi { v4u vc, vp, ga; float rho; };
__device__ __forceinline__ void rwkvB_unit(Frame& F, const RwDump& Dm, int bh) {
    int lane = mk_lane(); asm volatile("" : "+v"(lane));
    const int wid = F.wave, tid = wid * 64 + lane, hi = lane >> 5, l31 = lane & 31, b = bh >> 3, h = bh & 7;
    LAS unsigned char* lds = F.lds + RING_OFF;
    constexpr int NS = T / 32;
    LAS float* stat = (LAS float*)(lds + RB_STAT);
    LAS float* ybuf = (LAS float*)(lds + RB_Y);
    const int stid = tid - 128;
    const bool st_p2 = wid < 4, st_q = wid < 6, st_y = wid >= 4;
#define ST_LOAD(X, ci_) do { { if ((ci_) >= RW_SPLIT && (ci_) < NS && (((ci_) - RW_SPLIT) & 7) == 0) rw_wait_chunk(F, (ci_)); const size_t u_ = (size_t)((ci_) < NS ? (ci_) : NS - 1) * (BATCH * RH) + bh; \
        X.p[0] = __builtin_nontemporal_load((const GAS v4u*)(Dm.PF + u_ * 512 + stid)); X.d[0] = __builtin_nontemporal_load((const GAS v4u*)(Dm.DD + u_ * 512 + stid)); \
        if (st_p2) { X.p[1] = __builtin_nontemporal_load((const GAS v4u*)(Dm.PF + u_ * 512 + 384 + stid)); X.d[1] = __builtin_nontemporal_load((const GAS v4u*)(Dm.DD + u_ * 512 + 384 + stid)); } \
        if (st_q) X.q = __builtin_nontemporal_load((const GAS v4u*)(Dm.QF + u_ * 256 + stid)); \
        if (st_y) X.y = __builtin_nontemporal_load((const GAS v4u*)(Dm.YD + u_ * 256 + (stid - 128))); \
        if (stid < 16) X.g = *(const GAS v4u*)((const v4u*)(Dm.GAM + u_ * 64) + stid); } } while (0)
#define ST_STORE(X, buf_) do { LAS unsigned char* b_ = lds + (buf_) * RB_BUF; \
        *(LAS v4u*)(b_ + RB_PF + stid * 16) = X.p[0]; *(LAS v4u*)(b_ + RB_DD + stid * 16) = X.d[0]; \
        if (st_p2) { *(LAS v4u*)(b_ + RB_PF + (384 + stid) * 16) = X.p[1]; *(LAS v4u*)(b_ + RB_DD + (384 + stid) * 16) = X.d[1]; } \
        if (st_q) *(LAS v4u*)(b_ + RB_QF + stid * 16) = X.q; \
        if (st_y) *(LAS v4u*)(b_ + RB_YD + (stid - 128) * 16) = X.y; \
        if (stid < 16) *(LAS v4u*)(b_ + RB_GAM + stid * 16) = X.g; } while (0)
    const int ew = (wid & 1) + 2 * ((wid >> 2) & 1), eidx = ew * 64 + lane, etok = eidx >> 3, ep = eidx & 7;
    const bf16* epc = F.PROJ + (size_t)b * T * NP + h * 64 + 8 * ep;
#define EP_LOAD(X, cj_) do { { const int cc_ = (cj_) < NS ? (cj_) : NS - 1, tt_ = cc_ * 32 + etok; const bf16* pc_ = epc + (size_t)tt_ * NP; const bf16* pp_ = epc + (size_t)(tt_ > 0 ? tt_ - 1 : 0) * NP; \
        X.vc = *(const GAS v4u*)(pc_ + C_V); X.vp = *(const GAS v4u*)(pp_ + C_V); X.ga = *(const GAS v4u*)(pc_ + C_GA); \
        X.rho = Dm.RHO[((size_t)cc_ * (BATCH * RH) + bh) * 32 + etok]; } } while (0)
#define EP_RUN(X, cj_) do { const int par_ = (cj_) & 1; \
        const float s1_ = stat[((par_ * 2 + 0) * 32 + etok) * 2] + stat[((par_ * 2 + 1) * 32 + etok) * 2], s2_ = stat[((par_ * 2 + 0) * 32 + etok) * 2 + 1] + stat[((par_ * 2 + 1) * 32 + etok) * 2 + 1]; \
        const float mean_ = s1_ * (1.f / 64.f), var_ = fmaxf(s2_ * (1.f / 64.f) - mean_ * mean_, 0.f), rstd_ = __builtin_amdgcn_rsqf(var_ + 64e-5f); \
        const int tt_ = (cj_) * 32 + etok; const size_t mm_ = (size_t)b * T + tt_; const float pm_ = tt_ > 0 ? 1.f : 0.f; \
        const LAS float* yb_ = ybuf + (par_ * 2 + (ep >> 2)) * 1024 + 4 * (ep & 3) * 64 + etok; \
        float o_[8]; \
        _Pragma("unroll") for (int j = 0; j < 8; ++j) { const unsigned vcw_ = X.vc[j >> 1], vpw_ = X.vp[j >> 1], gaw_ = X.ga[j >> 1]; \
            const float vc_ = (j & 1) ? bfhi(vcw_) : bflo(vcw_), vp_ = (j & 1) ? bfhi(vpw_) : bflo(vpw_), g_ = (j & 1) ? bfhi(gaw_) : bflo(gaw_); \
            const float vv_ = vc_ + (vp_ * pm_ - vc_) * emu[j >> 2][j & 3]; \
            const float yn_ = (yb_[(j & 3) * 64 + (j >> 2) * 32] - mean_) * rstd_ * elw[j >> 2][j & 3] + elb[j >> 2][j & 3] + X.rho * vv_; o_[j] = yn_ * g_ * __builtin_amdgcn_rcpf(1.f + __expf(-g_)); } \
        *(GAS v4u*)(F.MIX + mm_ * D + h * 64 + 8 * ep) = (v4u){cvtpk(o_[0], o_[1]), cvtpk(o_[2], o_[3]), cvtpk(o_[4], o_[5]), cvtpk(o_[6], o_[7])}; } while (0)
    f32x16 S[2]; S[0] = f32x16{}; S[1] = f32x16{};
    const int ib = wid & 1;
#define CONS(ci_) do { const LAS unsigned char* bb = lds + ((ci_) & (RB_NB - 1)) * RB_BUF; \
          \
        v4u pf_[8], qf_[4], dd_[4], yd_[2]; f32x4 gm_[8]; \
        _Pragma("unroll") for (int q = 0; q < 8; ++q) gm_[q] = *(const LAS f32x4*)(bb + RB_GAM + (hi * 32 + 4 * q) * 4); \
        _Pragma("unroll") for (int q = 0; q < 4; ++q) dd_[q] = *(const LAS v4u*)(bb + RB_DD + ((((q >> 1) * 2 + ib) * 2 + (q & 1)) * 64 + lane) * 16); \
        _Pragma("unroll") for (int q = 0; q < 8; ++q) pf_[q] = *(const LAS v4u*)(bb + RB_PF + (q * 64 + lane) * 16); \
        _Pragma("unroll") for (int q = 0; q < 2; ++q) yd_[q] = *(const LAS v4u*)(bb + RB_YD + ((2 * ib + q) * 64 + lane) * 16); \
        _Pragma("unroll") for (int q = 0; q < 4; ++q) qf_[q] = *(const LAS v4u*)(bb + RB_QF + (q * 64 + lane) * 16); \
        __builtin_amdgcn_sched_barrier(0); \
        v4u Sf[4]; _Pragma("unroll") for (int s = 0; s < 4; ++s) Sf[s] = FRAGACC(S[s >> 1], s & 1); \
        _Pragma("unroll") for (int rb = 0; rb < 2; ++rb) { \
            f32x16 acc; unpack16(dd_[2 * rb], dd_[2 * rb + 1], acc); \
            _Pragma("unroll") for (int q = 0; q < 4; ++q) { const f32x4 gv = gm_[4 * rb + q]; _Pragma("unroll") for (int e = 0; e < 4; ++e) acc[4 * q + e] += gv[e] * S[rb][4 * q + e]; } \
            _Pragma("unroll") for (int s = 0; s < 4; ++s) acc = MFMA32(pf_[rb * 4 + s], Sf[s], acc); \
            S[rb] = acc; } \
        f32x16 y; unpack16(yd_[0], yd_[1], y); \
        _Pragma("unroll") for (int s = 0; s < 4; ++s) y = MFMA32(Sf[s], qf_[s], y); \
        float s1 = 0.f, s2 = 0.f; LAS float* yb_ = ybuf + (((ci_) & 1) * 2 + ib) * 1024 + lane; \
        _Pragma("unroll") for (int r = 0; r < 16; ++r) { s1 += y[r]; s2 += y[r] * y[r]; yb_[r * 64] = y[r]; } \
        s1 = swap32_sum(s1); s2 = swap32_sum(s2); \
        if (hi == 0) { stat[((((ci_) & 1) * 2 + ib) * 32 + l31) * 2] = s1; stat[((((ci_) & 1) * 2 + ib) * 32 + l31) * 2 + 1] = s2; } } while (0)
#define RB_BAR() do { asm volatile("s_waitcnt lgkmcnt(0)" ::: "memory"); __builtin_amdgcn_s_barrier(); asm volatile("" ::: "memory"); } while (0)
    if (wid < 2) {
        RB_BAR();
#pragma unroll 1
        for (int k = 0; k < NS; ++k) { CONS(k); RB_BAR(); }
        RB_BAR();
    } else if (wid == 4 || wid == 5) {
        const GAS v4u* gA = (const GAS v4u*)(wid == 4 ? Dm.PF : Dm.DD) + lane; const GAS v4u* gB = (const GAS v4u*)(wid == 4 ? Dm.QF : Dm.YD) + lane;
        const int oA = wid == 4 ? RB_PF : RB_DD, oB = wid == 4 ? RB_QF : RB_YD;
#define LD_ISSUE(ci_) do { const size_t u_ = (size_t)((ci_) < NS ? (ci_) : NS - 1) * (BATCH * RH) + bh; LAS unsigned char* b_ = lds + ((ci_) & (RB_NB - 1)) * RB_BUF; \
        _Pragma("unroll") for (int q = 0; q < 8; ++q) __builtin_amdgcn_global_load_lds((const unsigned*)(gA + u_ * 512 + q * 64), (LAS unsigned*)(b_ + oA + q * 1024), 16, 0, RB_AUX); \
        _Pragma("unroll") for (int q = 0; q < 4; ++q) __builtin_amdgcn_global_load_lds((const unsigned*)(gB + u_ * 256 + q * 64), (LAS unsigned*)(b_ + oB + q * 1024), 16, 0, RB_AUX); \
        if (lane < 16) __builtin_amdgcn_global_load_lds((const unsigned*)((const GAS v4u*)(Dm.GAM + u_ * 64) + lane), (LAS unsigned*)(b_ + RB_GAM), 16, 0, 0); } while (0)
        LD_ISSUE(0); LD_ISSUE(1); LD_ISSUE(2);
        asm volatile("s_waitcnt vmcnt(26)" ::: "memory");
        RB_BAR();
#pragma unroll 1
        for (int k = 0; k < NS; ++k) { LD_ISSUE(k + 3); asm volatile("s_waitcnt vmcnt(26)" ::: "memory"); RB_BAR(); }
        asm volatile("s_waitcnt vmcnt(0)" ::: "memory");
        RB_BAR();
#undef LD_ISSUE
    } else {
        RbEpi eA, eB, eC; f32x4 emu[2], elw[2], elb[2];
#pragma unroll
        for (int rg = 0; rg < 2; ++rg) { const int hc_ = h * 64 + 8 * ep + 4 * rg; emu[rg] = *(const GAS f32x4*)(F.shift_mu + 1024 + hc_); elw[rg] = *(const GAS f32x4*)(F.ln_w + hc_); elb[rg] = *(const GAS f32x4*)(F.ln_b + hc_); }
        EP_LOAD(eA, 0); EP_LOAD(eB, 1);
        RB_BAR();
        EP_LOAD(eC, 2); RB_BAR();
#define HY_STEP(k_, EP) do { EP_RUN(EP, (k_) - 1); EP_LOAD(EP, (k_) + 2); RB_BAR(); } while (0)
#pragma unroll 1
        for (int k = 1; k < NS; k += 3) { HY_STEP(k, eA); HY_STEP(k + 1, eB); HY_STEP(k + 2, eC); }
        EP_RUN(eA, NS - 1);
        RB_BAR();
#undef HY_STEP
    }
#undef RB_BAR
#undef ST_LOAD
#undef ST_STORE
#undef EP_LOAD
#undef EP_RUN
#undef CONS
}
constexpr int CW_G17 = 12288;
struct OneUnit { int pm, pn;
    __device__ __forceinline__ bool next(int i, pg8::Unit& u) const { if (i != 0) return false; u.pm = pm; u.pn = pn; return true; }
    __device__ __forceinline__ void a_ready(const pg8::Unit&) const {}
    __device__ __forceinline__ void done(const pg8::Unit&) const {} };
constexpr int AT_OUT = 65536, AT_G0 = 114688, AT_G1 = LDSCTL_OFF + 1024;
constexpr int AT_KB = 64 * 256, AT_VB = 64 * 256, AT_BUF = AT_KB + AT_VB, AT_QOFF = 2 * AT_KB + 3 * AT_VB;
__device__ __forceinline__ s16x4 vtr(const LAS unsigned char* p) { typedef short v4i16_t __attribute__((ext_vector_type(4))); return __builtin_bit_cast(s16x4, __builtin_amdgcn_ds_read_tr16_b64_v4i16((LAS v4i16_t*)p)); }
__device__ __forceinline__ void glds16_asm(const void* gsrc, unsigned lds_dst) {
    unsigned keep; const unsigned d_ = __builtin_amdgcn_readfirstlane(lds_dst);
    asm volatile("s_mov_b32 %0, m0\n\ts_mov_b32 m0, %2\n\ts_nop 0\n\tglobal_load_lds_dwordx4 %1, off\n\ts_mov_b32 m0, %0" : "=&s"(keep) : "v"(gsrc), "s"(d_) : "memory");
}
__device__ __forceinline__ void attn_unit(Frame& F, int b, int h, int qb) {
    int lane = mk_lane(); asm volatile("" : "+v"(lane));
    const int wid = F.wave, tid = wid * 64 + lane, l31 = lane & 31, hi = lane >> 5, map = wid >> 2, qs = wid & 3;
    LAS unsigned char* lds = F.lds + RING_OFF;
    const float slope2 = exp2f(-2.f * (float)(h + 1)) * LOG2E, shift2 = __uint_as_float(F.MISC[15]);
    const int q0 = qb * 128, qrow = q0 + 32 * qs + l31;
    const size_t mrow = (size_t)b * T + qrow;
    LAS bf16x8* qpark = (LAS bf16x8*)(lds + AT_QOFF + wid * 4096) + lane;
    { const bf16* qp = F.PROJ + mrow * NP + C_DQ + h * 128 + map * 64 + 8 * hi;
      v4u qraw[4]; float ss = 0.f;
#pragma unroll
      for (int s = 0; s < 4; ++s) qraw[s] = *(const GAS v4u*)(qp + 16 * s);
#pragma unroll
      for (int s = 0; s < 4; ++s)
#pragma unroll
          for (int j = 0; j < 4; ++j) { const float a_ = bflo(qraw[s][j]), b_ = bfhi(qraw[s][j]); ss += a_ * a_ + b_ * b_; }
      ss = swap32_sum(ss);
      const float rq = __builtin_amdgcn_rsqf(ss * (1.f / 64.f) + 1e-6f) * C2;
#pragma unroll
      for (int s = 0; s < 4; ++s) { const f32x4 g0 = *(const GAS f32x4*)(F.qn_g + 8 * hi + 16 * s), g1 = *(const GAS f32x4*)(F.qn_g + 8 * hi + 16 * s + 4);
          v4u w_; w_.x = cvtpk2(bflo(qraw[s].x) * rq * g0.x, bfhi(qraw[s].x) * rq * g0.y); w_.y = cvtpk2(bflo(qraw[s].y) * rq * g0.z, bfhi(qraw[s].y) * rq * g0.w);
          w_.z = cvtpk2(bflo(qraw[s].z) * rq * g1.x, bfhi(qraw[s].z) * rq * g1.y); w_.w = cvtpk2(bflo(qraw[s].w) * rq * g1.z, bfhi(qraw[s].w) * rq * g1.w);
          *(LAS v4u*)(qpark + s * 64) = w_; } }
    const bf16* kg = F.PROJ + (size_t)b * T * NP + C_DK + h * 128;
    const bf16* vg = F.PROJ + (size_t)b * T * NP + C_DV + h * 128;
    const int NT = 2 * qb + 2, tl = 2 * qb + (qs >> 1);
    const int Wk = (int)__builtin_ceilf((2.f * shift2 + 32.2f) / slope2);
    const int tf = __builtin_amdgcn_readfirstlane(max(0, (qb * 128 - Wk) >> 6));
    constexpr int AT_V0 = 2 * AT_KB;
    const int drow0 = 4 * wid + (lane >> 4), drow1 = drow0 + 32, dch = lane & 15;
    const unsigned ksrc0 = (unsigned)(drow0 * NP + ((dch ^ (drow0 & 15)) * 8)), ksrc1 = (unsigned)(drow1 * NP + ((dch ^ (drow1 & 15)) * 8));
    const unsigned vsrc0 = (unsigned)(drow0 * NP + ((dch ^ ((drow0 & 3) << 2)) * 8)), vsrc1 = (unsigned)(drow1 * NP + ((dch ^ ((drow1 & 3) << 2)) * 8));
#define AT_DMA(t_, kb_, v3_) do { const size_t tb_ = (size_t)(64 * (t_)) * NP; const unsigned bk_ = (unsigned)(size_t)(lds + (kb_) * AT_KB + wid * 1024), bv_ = (unsigned)(size_t)(lds + AT_V0 + (v3_) * AT_VB + wid * 1024); \
        glds16_asm(kg + tb_ + ksrc0, bk_); glds16_asm(kg + tb_ + ksrc1, bk_ + 8192u); glds16_asm(vg + tb_ + vsrc0, bv_); glds16_asm(vg + tb_ + vsrc1, bv_ + 8192u); } while (0)
#define AT_LAND() asm volatile("s_waitcnt vmcnt(0)" ::: "memory")
    f32x16 o[4];
#pragma unroll
    for (int vb = 0; vb < 4; ++vb) o[vb] = f32x16{};
    float lsum = 0.f;
    AT_DMA(tf, tf & 1, tf % 3);
    { const int gr_ = 16 * wid + (lane >> 4); const bf16* gsrc = F.PROJ + ((size_t)b * T + q0 + gr_) * NP + C_GB + h * 128;
      LAS unsigned char* gdst = F.lds + (wid < 4 ? AT_G0 + wid * 4096 : AT_G1 + (wid - 4) * 4096);
#pragma unroll
      for (int j = 0; j < 4; ++j) __builtin_amdgcn_global_load_lds((const unsigned*)(gsrc + (size_t)(4 * j) * NP + (((lane & 15) ^ (4 * j + (lane >> 4))) * 8)), (LAS unsigned*)(gdst + j * 1024), 16, 0, 0); }
    AT_LAND(); __syncthreads();
    const int G = lane >> 4, qq = (lane & 15) >> 2, pp = lane & 3;
    const int vrow = (4 * hi + qq) * 256 + 8 * (pp & 1), vch = 2 * (G & 1) + (pp >> 1);
    v4u pw[4];
#define SBAR_() __builtin_amdgcn_sched_barrier(0)
#define AT_QK(t) do { \
            const LAS unsigned char* Kb = lds + ((t) & 1) * AT_KB; \
            float sl_ = slope2; asm volatile("" : "+v"(sl_));     \
            const float base = sl_ * (float)(64 * (t) + 4 * hi - qrow) - shift2; \
            float ls = 0.f; \
            _Pragma("unroll") for (int hf = 0; hf < 2; ++hf) {        \
                f32x16 p; \
                _Pragma("unroll") for (int r = 0; r < 16; ++r) p[r] = __builtin_fmaf(sl_, (float)(32 * hf + (r & 3) + 8 * (r >> 2)), base); \
                _Pragma("unroll") for (int s = 0; s < 4; ++s) { \
                    const bf16x8 a0 = *(const LAS bf16x8*)(Kb + (32 * hf + l31) * 256 + (((map * 8 + 2 * s + hi) ^ (l31 & 15)) * 16)); \
                    p = __builtin_amdgcn_mfma_f32_32x32x16_bf16(a0, qpark[s * 64], p, 0, 0, 0); } \
                if ((t) == tl) { \
                    _Pragma("unroll") for (int r = 0; r < 16; ++r) { const int ki = 64 * (t) + 32 * hf + 4 * hi + (r & 3) + 8 * (r >> 2); if (ki > qrow) p[r] = -1e30f; } } \
                _Pragma("unroll") for (int r = 0; r < 16; ++r) { p[r] = __builtin_amdgcn_exp2f(p[r]); ls += p[r]; } \
                pw[2 * hf] = (v4u){cvtpk(p[0], p[1]), cvtpk(p[2], p[3]), cvtpk(p[4], p[5]), cvtpk(p[6], p[7])}; \
                pw[2 * hf + 1] = (v4u){cvtpk(p[8], p[9]), cvtpk(p[10], p[11]), cvtpk(p[12], p[13]), cvtpk(p[14], p[15])}; } \
            lsum += ls; } while (0)
#define AT_VRD(dst, ks, vb0) do { _Pragma("unroll") for (int vb = (vb0); vb < (vb0) + 2; ++vb) { const LAS unsigned char* a_ = Vb + vrow + ((4 * vb + vch) ^ (qq << 2)) * 16 + (32 * ((ks) >> 1) + 16 * ((ks) & 1)) * 256; \
        dst[2 * (vb - (vb0))] = vtr(a_); dst[2 * (vb - (vb0)) + 1] = vtr(a_ + 8 * 256); } } while (0)
#define AT_PV(src, pwk, vb0) do { _Pragma("unroll") for (int vb = (vb0); vb < (vb0) + 2; ++vb) { const int j_ = 2 * (vb - (vb0)); \
        const bf16x8 vf = (bf16x8){src[j_][0], src[j_][1], src[j_][2], src[j_][3], src[j_ + 1][0], src[j_ + 1][1], src[j_ + 1][2], src[j_ + 1][3]}; \
        o[vb] = __builtin_amdgcn_mfma_f32_32x32x16_bf16(vf, __builtin_bit_cast(bf16x8, pwk), o[vb], 0, 0, 0); } } while (0)
#define AT_PVV(v3_) do { const LAS unsigned char* Vb = lds + AT_V0 + (v3_) * AT_VB; s16x4 vA[4], vB[4]; \
            AT_VRD(vA, 0, 0); SBAR_(); AT_VRD(vB, 0, 2); SBAR_(); \
            AT_PV(vA, pw[0], 0); SBAR_(); AT_VRD(vA, 1, 0); SBAR_(); AT_PV(vB, pw[0], 2); SBAR_(); AT_VRD(vB, 1, 2); SBAR_(); \
            AT_PV(vA, pw[1], 0); SBAR_(); AT_VRD(vA, 2, 0); SBAR_(); AT_PV(vB, pw[1], 2); SBAR_(); AT_VRD(vB, 2, 2); SBAR_(); \
            AT_PV(vA, pw[2], 0); SBAR_(); AT_VRD(vA, 3, 0); SBAR_(); AT_PV(vB, pw[2], 2); SBAR_(); AT_VRD(vB, 3, 2); SBAR_(); \
            AT_PV(vA, pw[3], 0); SBAR_(); AT_PV(vB, pw[3], 2); } while (0)
    if (map == 0) {
        int v3 = tf % 3;
#pragma unroll 1
        for (int t = tf; t < NT; ++t) { const int vn = v3 == 2 ? 0 : v3 + 1;
            if (t + 1 < NT) AT_DMA(t + 1, (t + 1) & 1, vn);
            if (t <= tl) { AT_QK(t); AT_PVV(v3); }
            AT_LAND(); __syncthreads(); v3 = vn; }
    } else {
        int v3 = tf % 3;
#pragma unroll 1
        for (int t = tf; t < NT; ++t) { const int vp = v3 == 0 ? 2 : v3 - 1, vn = v3 == 2 ? 0 : v3 + 1;
            if (t + 1 < NT) AT_DMA(t + 1, (t + 1) & 1, vn);
            if (t > tf && t - 1 <= tl) AT_PVV(vp);
            if (t <= tl) AT_QK(t);
            AT_LAND(); __syncthreads(); v3 = vn; }
        if (NT - 1 <= tl) { const int vp = v3 == 0 ? 2 : v3 - 1; AT_PVV(vp); }
    }
#undef AT_PVV
#undef AT_QK
#undef AT_VRD
#undef AT_PV
#undef SBAR_
#undef AT_DMA
#undef AT_LAND
    __syncthreads();
    const float ltot = swap32_sum(lsum);
    LAS float* X = (LAS float*)lds;
    if (map == 1) {
        const float sc = __uint_as_float(F.MISC[14]) / ltot;
#pragma unroll
        for (int vb = 0; vb < 4; ++vb)
#pragma unroll
            for (int r = 0; r < 16; ++r) X[(qs * 64 + vb * 16 + r) * 64 + lane] = o[vb][r] * sc;
    }
    __syncthreads();
    if (map == 0) {
        const float il = 1.f / ltot; float ss = 0.f;
#pragma unroll
        for (int vb = 0; vb < 4; ++vb)
#pragma unroll
            for (int r = 0; r < 16; ++r) { const float v = o[vb][r] * il - X[(qs * 64 + vb * 16 + r) * 64 + lane]; o[vb][r] = v; ss += v * v; }
        ss = swap32_sum(ss);
        const float rn = (1.f / sqrtf(ss * (1.f / 128.f) + 1e-5f)) * (1.f - LAMBDA_INIT);
        int etok = 0; asm volatile("" : "+v"(etok));
        const int lane_e = mk_lane(), hi = lane_e >> 5, row = 32 * qs + (lane_e & 31);
        const LAS unsigned char* grow = F.lds + (qs < 2 ? AT_G0 : AT_G1 - 64 * 256) + row * 256 + 8 * hi;
        LAS unsigned char* orow = lds + AT_OUT + row * 256 + 8 * hi;
#pragma unroll
        for (int vb = 0; vb < 4; ++vb)
#pragma unroll
            for (int rg = 0; rg < 4; ++rg) {
                const int vc = 32 * vb + 8 * rg + 4 * hi, ch = (((4 * vb + rg) ^ (row & 15)) * 16) + etok;
                const v2u gw = *(const LAS v2u*)(grow + ch); const f32x4 sg = *(const GAS f32x4*)(F.subln_g + vc);
                const float g4[4] = {bflo(gw.x), bfhi(gw.x), bflo(gw.y), bfhi(gw.y)}; float ov[4];
#pragma unroll
                for (int e = 0; e < 4; ++e) ov[e] = o[vb][4 * rg + e] * rn * sg[e] * g4[e] / (1.f + __expf(-g4[e]));
                const unsigned w1_ = cvtpk(ov[2], ov[3]);
                *(LAS v2u*)(orow + ch) = (v2u){cvtpk(ov[0], ov[1]), w1_};
                if (rg == 3) asm volatile("" : "+v"(etok) : "v"(w1_));
            }
    }
    __syncthreads();
    { const int t_ = wid * 64 + mk_lane(); bf16* ob = F.MIX + ((size_t)b * T + q0) * D + 512 + h * 128;
#pragma unroll
      for (int i = 0; i < 4; ++i) { const int pc = t_ + 512 * i, r_ = pc >> 4, c_ = pc & 15;
          *(GAS v4u*)(ob + (size_t)r_ * D + c_ * 8) = *(const LAS v4u*)(lds + AT_OUT + r_ * 256 + ((c_ ^ (r_ & 15)) * 16)); } }
    __syncthreads();
}
#ifndef DBL
#define DBL 0
#endif
constexpr int CW_QUEUE = 8192;
constexpr int QX_RW = 8, QX_A2 = 0, QX_AT = 64, QX_ALL = QX_RW + QX_A2 + QX_AT;
template <int MODE = 0> __device__ __forceinline__ void p3_queue(Frame& F, const RwDump& Dm, const int qbase = CW_QUEUE) {
    const int ql = mk_lane();
    const float l1 = wave_sum(F.lq1[ql] * F.lk1[ql]), l2 = wave_sum(F.lq2[ql] * F.lk2[ql]);
    const float lam = __uint_as_float(__builtin_amdgcn_readfirstlane(__float_as_uint(__expf(l1) - __expf(l2) + LAMBDA_INIT)));
    float gq = fabsf(F.qn_g[ql]), gk = fabsf(F.kn_g[ql]);
#pragma unroll
    for (int o = 1; o < 64; o <<= 1) { gq = fmaxf(gq, __shfl_xor(gq, o)); gk = fmaxf(gk, __shfl_xor(gk, o)); }
    const float shift2 = __uint_as_float(__builtin_amdgcn_readfirstlane(__float_as_uint(8.f * gq * gk * LOG2E)));
    if (F.wave == 0 && mk_lane() == 0) { F.MISC[14] = __float_as_uint(lam); F.MISC[15] = __float_as_uint(shift2); }
    __syncthreads();
#ifdef Q_BLK
    const int x0 = (int)(blockIdx.x & 7);
#else
    const int x0 = (int)(xb_xcc_id() & 7u);
#endif
#pragma unroll 1
    for (int dx = 0; dx < 8; ++dx) {
        const int xq = (x0 + dx) & 7;
        for (;;) {
            if (F.wave == 0 && mk_lane() == 0) F.MISC[12] = __hip_atomic_fetch_add(F.ctl + qbase + 64 * xq, 1u, RLX_AGENT);
            __syncthreads();
            int item = __builtin_amdgcn_readfirstlane((int)F.MISC[12]); if (MODE == 2) item += QX_RW;
            __syncthreads();
            if (item >= (MODE == 1 ? QX_RW : QX_ALL)) break;
            if (item < QX_RW) { rwkvB_unit(F, Dm, xq * 8 + item); if (DBL & 64) rwkvB_unit(F, Dm, xq * 8 + item); }
            else { const int idx = item - QX_RW - QX_A2, h = 3 - (idx >> 4), qb = 15 - (idx & 15);
#pragma unroll 1
#ifndef NO_ATT
                for (int rep = 0; rep < ((DBL & 32) ? 2 : 1); ++rep) attn_unit(F, xq, h, qb);
#endif
            }
        }
    }
}

constexpr int GT_STAGE = 24576, GT_NS = 5, GT_NK = D / 64;
__device__ __forceinline__ void gemm1_tail_unit(Frame& F, int qu) {
    int lane = mk_lane(); asm volatile("" : "+v"(lane));
    const int wid = F.wave, l31 = lane & 31, hi = lane >> 5, wm = wid >> 2, wn = wid & 3;
    const int xcd = qu & 7, j = qu >> 3, R0 = (8 * xcd + (j & 7)) * 256 + (j >> 3) * 64, C0 = 4096;
    LAS unsigned char* lds = F.lds + RING_OFF;
    const int vr0 = 24 * wid + (lane >> 3), cp = lane & 7;
#define GT_ISSUE(kc_) do { LAS unsigned char* sb_ = lds + ((kc_) % GT_NS) * GT_STAGE + wid * 3072; \
        _Pragma("unroll") for (int i = 0; i < 3; ++i) { const int v_ = vr0 + 8 * i; \
            const bf16* src_ = (3 * wid + i < 8 ? F.XN + (size_t)(R0 + v_) * D : F.WinT + (size_t)(C0 + v_ - 64) * D) + (kc_) * 64 + ((cp ^ ((v_ >> 1) & 7)) * 8); \
            __builtin_amdgcn_global_load_lds((const unsigned*)src_, (LAS unsigned*)(sb_ + i * 1024), 16, 0, 0); } } while (0)
    f32x16 acc0 = f32x16{};
    const int rX = 32 * wm + l31, nW = 32 * wn + l31, offX = rX * 128, offW = 8192 + nW * 128, kyX = (rX >> 1) & 7, kyW = (nW >> 1) & 7;
    GT_ISSUE(0); GT_ISSUE(1); GT_ISSUE(2); GT_ISSUE(3);
#pragma unroll 1
    for (int kc = 0; kc < GT_NK; ++kc) {
        if (kc + 3 < GT_NK) asm volatile("s_waitcnt vmcnt(9)" ::: "memory"); else if (kc + 2 < GT_NK) asm volatile("s_waitcnt vmcnt(6)" ::: "memory");
        else if (kc + 1 < GT_NK) asm volatile("s_waitcnt vmcnt(3)" ::: "memory"); else asm volatile("s_waitcnt vmcnt(0)" ::: "memory");
        __builtin_amdgcn_s_barrier(); asm volatile("" ::: "memory");
        if (kc + 4 < GT_NK) GT_ISSUE(kc + 4);
        const LAS unsigned char* sb = lds + (kc % GT_NS) * GT_STAGE;
        v4u xf[4], w0[4];
#pragma unroll
        for (int s = 0; s < 4; ++s) { xf[s] = *(const LAS v4u*)(sb + offX + (((2 * s + hi) ^ kyX) * 16)); w0[s] = *(const LAS v4u*)(sb + offW + (((2 * s + hi) ^ kyW) * 16)); }
        __builtin_amdgcn_sched_barrier(0);
#pragma unroll
        for (int s = 0; s < 4; ++s) acc0 = MFMA32(w0[s], xf[s], acc0);
        asm volatile("s_waitcnt lgkmcnt(0)" ::: "memory");
    }
#undef GT_ISSUE
    __syncthreads();
    { LAS unsigned char* orow = lds + rX * 256 + 8 * hi;
#pragma unroll
      for (int q = 0; q < 4; ++q) *(LAS v2u*)(orow + (((4 * wn + q) ^ (rX & 15)) * 16)) = (v2u){cvtpk(acc0[4 * q], acc0[4 * q + 1]), cvtpk(acc0[4 * q + 2], acc0[4 * q + 3])}; }
    __syncthreads();
    { const int t_ = wid * 64 + lane; bf16* ob = F.PROJ + (size_t)R0 * NP + C0;
#pragma unroll
      for (int i = 0; i < 2; ++i) { const int pc = t_ + 512 * i, r_ = pc >> 4, c_ = pc & 15;
          *(GAS v4u*)(ob + (size_t)r_ * NP + c_ * 8) = *(const LAS v4u*)(lds + r_ * 256 + ((c_ ^ (r_ & 15)) * 16)); } }
    __syncthreads();
}
struct Args { const float* in[21]; float* out; unsigned char* ws; int ph_lo, ph_hi; };
__global__ void __launch_bounds__(NWAVES * 64, 2) hymba_fwd(Args args) {
    extern __shared__ __attribute__((aligned(16))) unsigned char lds[];
    Frame F;
    F.lds = (LAS unsigned char*)lds;
    F.MISC = (volatile LAS unsigned*)(F.lds + MISC_OFF);
    F.wave = __builtin_amdgcn_readfirstlane((int)threadIdx.x >> 6); F.lane = mk_lane(); F.tid = F.wave * 64 + F.lane;
    F.G = gridDim.x; { const int bx = blockIdx.x; F.vcu = (F.G % 8 == 0) ? (bx % 8) * (F.G / 8) + bx / 8 : bx; }
    unsigned char* ws = args.ws;
    F.ctl = (gu32*)(ws + WS_CTL);
    F.x = args.in[0]; F.norm_g = args.in[1]; F.w_in = args.in[2]; F.shift_mu = args.in[3]; F.w0 = args.in[4]; F.w_decay_up = args.in[5]; F.a0 = args.in[6]; F.w_iclr_up = args.in[7];
    F.k_k = args.in[8]; F.k_a = args.in[9]; F.r_k = args.in[10]; F.ln_w = args.in[11]; F.ln_b = args.in[12]; F.qn_g = args.in[13]; F.kn_g = args.in[14];
    F.lq1 = args.in[15]; F.lk1 = args.in[16]; F.lq2 = args.in[17]; F.lk2 = args.in[18]; F.subln_g = args.in[19]; F.w_out = args.in[20]; F.out = args.out;
    F.WinT = (bf16*)(ws + WS_WIN); F.WoutT = (bf16*)(ws + WS_WOUT); F.WdT = (bf16*)(ws + WS_WD); F.WaT = (bf16*)(ws + WS_WA);
    F.XN = (bf16*)(ws + WS_XN); F.PROJ = (bf16*)(ws + WS_PROJ); F.MIX = (bf16*)(ws + WS_MIX);
    for (int u = F.tid; u < (LDS_BYTES - LDSCTL_OFF) / 4; u += NWAVES * 64) ((LAS unsigned*)(F.lds + LDSCTL_OFF))[u] = 0u;
    __syncthreads();
    XcdBarrier bar; bar.bar = (unsigned*)(F.ctl + CW_BAR); bar.x = 0; bar.st = nullptr; bar.wave = F.wave;
    if (MK_N_LAUNCHES == 1) bar = xcd_barrier_post((unsigned*)(F.ctl + CW_BAR), F.MISC + 8, F.wave);
#define GRID_BAR() do { if (MK_N_LAUNCHES == 1) xcd_barrier(bar); } while (0)
    const int lo = args.ph_lo, hi = args.ph_hi;
#define IN(k) (lo <= (k) && (k) < hi)
#define BOTH(k) (IN(k) && IN((k) + 1))
#ifndef SKIP
#define SKIP 0
#endif
    if (IN(0) && !(SKIP & 1)) { p0_prologue(F); if (DBL & 1) { GRID_BAR(); p0_prologue(F); } if (BOTH(0)) GRID_BAR(); }
    if (IN(1) && !(SKIP & 2)) {
        pg8::Gemm g{F.XN, F.WinT, M, 4096, D}; pg8::StaticOrder S; S.init(M, 4096, F.G, (int)blockIdx.x);
        pg8::EpiBf16S E{F.PROJ, NP};
        pg8::gemm_phase<pg8::EpiBf16S, pg8::StaticOrder, true, true>(F.lds + RING_OFF, g, S, E, F.wave);
#pragma unroll 1
        for (int qu = (int)blockIdx.x; qu < 256; qu += F.G) gemm1_tail_unit(F, qu);
#ifdef TAILX2
#pragma unroll 1
        for (int rep = 0; rep < TAILX2; ++rep) {
#pragma unroll 1
        for (int qu = (int)blockIdx.x; qu < 256; qu += F.G) gemm1_tail_unit(F, qu); }
#endif
        if (DBL & 2) { GRID_BAR(); pg8::gemm_phase<pg8::EpiBf16S, pg8::StaticOrder, true, true>(F.lds + RING_OFF, g, S, E, F.wave); }
        if (BOTH(1)) GRID_BAR();
    }
    RwDump Dm; { unsigned char* so = (unsigned char*)args.out; Dm.PF = (v4u*)so; Dm.DD = (v4u*)(so + 32 * MiB); Dm.QF = (v4u*)(ws + WS_XN); Dm.YD = (v4u*)(ws + WS_XN + 16 * MiB);
        Dm.GAM = (float*)(ws + WS_END); Dm.RHO = (float*)(ws + WS_END + 1 * MiB); }
    if (IN(2) && !(SKIP & 4)) {
        LAS float* wscr = (LAS float*)(F.lds + LDSCTL_OFF + 1024) + F.wave * 64; int zpar = 0;
#pragma unroll 1
        for (int p = F.vcu; p < BATCH * (T / 32); p += F.G) { rwkvA_unit(F, Dm, (p >> 6) * RH + F.wave, p & 63, wscr, F.lds + RING_OFF + F.wave * 16384, (LAS v4u*)(F.lds + LDSCTL_OFF + 4096), zpar); zpar ^= 1; }
        if (DBL & 4) { GRID_BAR();
#pragma unroll 1
            for (int p = F.vcu; p < BATCH * (T / 32); p += F.G) { rwkvA_unit(F, Dm, (p >> 6) * RH + F.wave, p & 63, wscr, F.lds + RING_OFF + F.wave * 16384, (LAS v4u*)(F.lds + LDSCTL_OFF + 4096), zpar); zpar ^= 1; } }
        p2_qknorm(F);
        if (BOTH(2)) GRID_BAR();
    }
    if (IN(3) && !(SKIP & 8)) {
#ifdef P3SPLIT
        p3_queue<1>(F, Dm); GRID_BAR(); p3_queue<2>(F, Dm, CW_QUEUE + 1024);
#else
        p3_queue(F, Dm);
#endif
        if (DBL & 512) { GRID_BAR(); p3_queue(F, Dm, CW_QUEUE + 1024); }
        if (BOTH(3)) GRID_BAR();
    }
    if (IN(4) && !(SKIP & 16)) {
        pg8::Gemm g{F.MIX, F.WoutT, M, D, D}; pg8::StaticOrder S; S.init(M, D, F.G, (int)blockIdx.x);
        pg8::EpiResF32 E{F.x, F.out, D};
        pg8::gemm_phase<pg8::EpiResF32, pg8::StaticOrder, false, true>(F.lds + RING_OFF, g, S, E, F.wave);
        if (DBL & 16) { GRID_BAR(); pg8::gemm_phase<pg8::EpiResF32, pg8::StaticOrder, false, true>(F.lds + RING_OFF, g, S, E, F.wave); }
    }
#undef IN
#undef BOTH
}

extern "C" void kernel_launch(void* const* d_in, const int* in_sizes, int n_in, void* d_out, int out_size, void* d_ws, size_t ws_size, hipStream_t stream) {
    static int grid = 0;
    if (grid == 0) {
        if (n_in != 21 || in_sizes[0] != M * D || out_size != M * D || ws_size < WS_END + 2 * MiB) { fprintf(stderr, "kernel_launch: unexpected shapes (n_in %d, in0 %d, out %d, ws %zu); nothing launched\n", n_in, n_in > 0 ? in_sizes[0] : -1, out_size, ws_size); grid = -1; return; }
        int dev = 0, cus = 0, per_cu = 0;
        if (hipGetDevice(&dev) != hipSuccess || hipDeviceGetAttribute(&cus, hipDeviceAttributeMultiprocessorCount, dev) != hipSuccess) { grid = -1; return; }
        if (hipFuncSetAttribute((const void*)hymba_fwd, hipFuncAttributeMaxDynamicSharedMemorySize, LDS_BYTES) != hipSuccess) { fprintf(stderr, "kernel_launch: hipFuncSetAttribute failed\n"); grid = -1; return; }
        if (hipOccupancyMaxActiveBlocksPerMultiprocessor(&per_cu, (const void*)hymba_fwd, NWAVES * 64, LDS_BYTES) != hipSuccess || per_cu < 1) { fprintf(stderr, "kernel_launch: occupancy query reports %d workgroups per CU; nothing launched\n", per_cu); grid = -1; return; }
        (void)hipGetLastError();
        grid = cus;
        if (grid > 256) grid = 256;
    }
    if (grid < 0) return;
    if (hipMemsetAsync((char*)d_ws + WS_CTL, 0, CTL_ZERO_BYTES, stream) != hipSuccess) { fprintf(stderr, "kernel_launch: hipMemsetAsync failed\n"); return; }
    Args a{};
    for (int i = 0; i < 21; ++i) a.in[i] = (const float*)d_in[i];
    a.out = (float*)d_out; a.ws = (unsigned char*)d_ws;
    for (int li = 0; li < MK_N_LAUNCHES; ++li) {
        a.ph_lo = (MK_N_LAUNCHES == 1) ? 0 : li; a.ph_hi = (MK_N_LAUNCHES == 1) ? N_PHASES : li + 1;
        hipLaunchKernelGGL(hymba_fwd, dim3(grid), dim3(NWAVES * 64), LDS_BYTES, stream, a);
        const hipError_t le = hipPeekAtLastError();
        if (le != hipSuccess) { fprintf(stderr, "kernel_launch: launch %d failed: %s\n", li, hipGetErrorName(le)); break; }
    }
}
```

```cpp
#include <hip/hip_runtime.h>
#include <hip/hip_bf16.h>
#include <cstdio>
#include <cstdint>
#include <cmath>
namespace pg8 {
#define PG8_LAS __attribute__((address_space(3)))
typedef unsigned short bf16_t;
typedef short bf16x8 __attribute__((ext_vector_type(8)));
typedef float f32x4 __attribute__((ext_vector_type(4)));
typedef unsigned u32x4 __attribute__((ext_vector_type(4)));
constexpr int BM = 256, BK = 64, HALF = 128, HTB = HALF * BK * 2  , STAGE_BYTES = 8 * HTB, NXCD = 8, WGM = 8;

__host__ __device__ __forceinline__ int lds_byte(int r, int c) { const int st = (r >> 4) * 2 + (c >> 5), rr = r & 15, cc = c & 31, ob = rr * 64 + cc * 2; return st * 1024 + (ob ^ (((ob >> 9) & 1) << 5)); }
__host__ __device__ __forceinline__ void stage_rc(int b, int& R, int& C) { const int st = b / 1024, sb = b % 1024, swz = sb ^ (((sb >> 9) & 1) << 5); R = (st >> 1) * 16 + swz / 64; C = (st & 1) * 32 + (swz % 64) / 2; }
__host__ __device__ __forceinline__ int perm32(int rho) { const int n = rho >> 4, i = rho & 15; return 8 * (i >> 2) + 4 * n + (i & 3); }

__device__ __forceinline__ int mk_lane_pg8() { int l; asm volatile("v_mbcnt_lo_u32_b32 %0, -1, 0\n\tv_mbcnt_hi_u32_b32 %0, -1, %0" : "=v"(l)); return l; }
struct Unit { int pm, pn; };
struct Gemm { const bf16_t* A; const bf16_t* Bt; int M, N, K; };

struct StaticOrder {
    int nM, nN, nwg, G, c;
    __host__ __device__ void init(int M, int N, int G_, int c_) { nM = M / BM; nN = N / BM; nwg = nM * nN; G = G_; c = c_; }
    __host__ __device__ bool next(int i, Unit& u) const {
        const long L = (long)i * G + c; if (L >= nwg) return false;
        int wgid = (int)L; { const int q = nwg / NXCD, r = nwg % NXCD, xcd = wgid % NXCD, off = wgid / NXCD; wgid = (xcd < r ? xcd * (q + 1) : r * (q + 1) + (xcd - r) * q) + off; }
        const int nig = WGM * nN, gid = wgid / nig, fm = gid * WGM, gsz = (nM - fm) < WGM ? (nM - fm) : WGM;
        u.pm = fm + ((wgid % nig) % gsz); u.pn = (wgid % nig) / gsz; return true;
    }
    __device__ __forceinline__ void a_ready(const Unit&) const {}
    __device__ __forceinline__ void done(const Unit&) const {}
};

__device__ __forceinline__ unsigned cvt_pk_bf16(float lo, float hi) { unsigned r; asm volatile("v_cvt_pk_bf16_f32 %0, %1, %2" : "=v"(r) : "v"(lo), "v"(hi)); return r; }
struct EpiBf16S {
    static constexpr bool PERM = true, AFTER_DRAIN = false, HAS_INIT = false;
    bf16_t* O; int ldc;
    __device__ __forceinline__ void operator()(const f32x4 (&acc)[2][2][4][2], const Unit& u, int wr, int wc, int fr, int fq) const {
        const int row0 = u.pm * BM + wr * 64 + fr, col0 = u.pn * BM + wc * 32 + 8 * fq;
#pragma unroll
        for (int ai = 0; ai < 2; ++ai)
#pragma unroll
            for (int m = 0; m < 4; ++m) { bf16_t* rowp = O + (size_t)(row0 + ai * HALF + m * 16) * ldc + col0;
#pragma unroll
                for (int bj = 0; bj < 2; ++bj) { const f32x4 v0 = acc[ai][bj][m][0], v1 = acc[ai][bj][m][1];
                    u32x4 w; w.x = cvt_pk_bf16(v0[0], v0[1]); w.y = cvt_pk_bf16(v0[2], v0[3]); w.z = cvt_pk_bf16(v1[0], v1[1]); w.w = cvt_pk_bf16(v1[2], v1[3]);
                    *(u32x4*)(rowp + bj * HALF) = w; } }
    }
};
struct EpiResF32 {
    static constexpr bool PERM = false, AFTER_DRAIN = false, HAS_INIT = true;
    const float* base; float* out; int ldc;
    __device__ __forceinline__ void init(f32x4 (&acc)[2][2][4][2], const Unit& u, int wr, int wc, int fr, int fq) const {
        const int row0 = u.pm * BM + wr * 64 + fr, col0 = u.pn * BM + wc * 32 + 4 * fq;
#pragma unroll
        for (int ai = 0; ai < 2; ++ai)
#pragma unroll
            for (int m = 0; m < 4; ++m) { const size_t off = (size_t)(row0 + ai * HALF + m * 16) * ldc + col0;
#pragma unroll
                for (int bj = 0; bj < 2; ++bj)
#pragma unroll
                    for (int n = 0; n < 2; ++n) acc[ai][bj][m][n] = *(const f32x4*)(base + off + bj * HALF + n * 16); }
    }
    __device__ __forceinline__ void operator()(const f32x4 (&acc)[2][2][4][2], const Unit& u, int wr, int wc, int fr, int fq) const {
        const int row0 = u.pm * BM + wr * 64 + fr, col0 = u.pn * BM + wc * 32 + 4 * fq;
#pragma unroll
        for (int ai = 0; ai < 2; ++ai)
#pragma unroll
            for (int m = 0; m < 4; ++m) { const size_t off = (size_t)(row0 + ai * HALF + m * 16) * ldc + col0;
#pragma unroll
                for (int bj = 0; bj < 2; ++bj)
#pragma unroll
                    for (int n = 0; n < 2; ++n) *(f32x4*)(out + off + bj * HALF + n * 16) = acc[ai][bj][m][n]; }
    }
};
template <class Epi, class Sched, bool ALIGN_EPI = false, bool SP2 = false, bool PRE = false>
__device__ __forceinline__ void gemm_phase(PG8_LAS unsigned char* lds, const Gemm g, const Sched& S, const Epi& E, const int mk_wave_id  , f32x4 (*pre_acc)[2][4][2] = nullptr) {
    const int wid = mk_wave_id, lane = mk_lane_pg8(), tid = wid * 64 + lane, wr = wid >> 2, wc = wid & 3, fr = lane & 15, fq = lane >> 4;
    const int K = g.K, nt = K / BK;
    unsigned voffA[2], voffB[2];
#pragma unroll
    for (int i = 0; i < 2; ++i) { int R, C; stage_rc(tid * 16 + i * 8192, R, C); const int Rb = Epi::PERM ? ((R & ~31) + perm32(R & 31)) : R;
        voffA[i] = (unsigned)(R * K + C) * 2u; voffB[i] = (unsigned)(Rb * K + C) * 2u; }
    const size_t kstep = (size_t)(BK * 2);
    const size_t hstep = (size_t)HALF * K * 2;
    const size_t tstep = 2 * hstep;
    const unsigned ldsw = (unsigned)wid * 1024u;
    const int aoff = lds_byte(wr * 64 + fr, fq * 8), boff = lds_byte(wc * 32 + fr, fq * 8);
#define PG8_SA(b, h) (((b) * 2 + (h)) * HTB)
#define PG8_SB(b, h) ((4 + (b) * 2 + (h)) * HTB)
#define PG8_STAGE(bufoff, gbase, voff) do { _Pragma("unroll") for (int _i = 0; _i < 2; ++_i) \
        __builtin_amdgcn_global_load_lds((const unsigned*)((const char*)(gbase) + (voff)[_i]), (PG8_LAS unsigned*)(lds + (bufoff) + ldsw + _i * 8192), 16, 0, 0); } while (0)
#define PG8_LDA(dst, b, h) do { _Pragma("unroll") for (int m = 0; m < 4; ++m) _Pragma("unroll") for (int k = 0; k < 2; ++k) dst[m][k] = *(const PG8_LAS bf16x8*)(lds + PG8_SA(b, h) + aoff + m * 2048 + k * 1024); } while (0)
#define PG8_LDB(dst, b, h) do { _Pragma("unroll") for (int n = 0; n < 2; ++n) _Pragma("unroll") for (int k = 0; k < 2; ++k) dst[n][k] = *(const PG8_LAS bf16x8*)(lds + PG8_SB(b, h) + boff + n * 2048 + k * 1024); } while (0)
#define PG8_MMA(ai, bj, At, Bt) do { __builtin_amdgcn_s_setprio(1); _Pragma("unroll") for (int m = 0; m < 4; ++m) _Pragma("unroll") for (int n = 0; n < 2; ++n) _Pragma("unroll") for (int k = 0; k < 2; ++k) \
        acc[ai][bj][m][n] = __builtin_amdgcn_mfma_f32_16x16x32_bf16(Bt[n][k], At[m][k], acc[ai][bj][m][n], 0, 0, 0); __builtin_amdgcn_s_setprio(0); } while (0)
#define PG8_WAIT_V(n) asm volatile("s_waitcnt vmcnt(" #n ")" ::: "memory")
#define PG8_WAIT_L(n) asm volatile("s_waitcnt lgkmcnt(" #n ")" ::: "memory")
#define PG8_BAR __builtin_amdgcn_s_barrier()
#define PG8_SCHED __builtin_amdgcn_sched_barrier(0)
    Unit cur, nxt; int ui = 0;
    if (!S.next(0, cur)) return;
    f32x4 acc[2][2][4][2];
#pragma unroll
    for (int a = 0; a < 2; ++a)
#pragma unroll
        for (int b = 0; b < 2; ++b)
#pragma unroll
            for (int m = 0; m < 4; ++m)
#pragma unroll
                for (int n = 0; n < 2; ++n) acc[a][b][m][n] = PRE ? pre_acc[a][b][m][n] : (f32x4){0.f, 0.f, 0.f, 0.f};
    if constexpr (Epi::HAS_INIT && !PRE) E.init(acc, cur, wr, wc, fr, fq);
    bf16x8 At[4][2], B0[2][2], B1[2][2];
    const char* cA = (const char*)g.A + (size_t)cur.pm * tstep; const char* cB = (const char*)g.Bt + (size_t)cur.pn * tstep;
    S.a_ready(cur);
    if constexpr (SP2) {
        PG8_STAGE(PG8_SB(0, 0), cB, voffB); PG8_STAGE(PG8_SB(0, 1), cB + hstep, voffB); PG8_STAGE(PG8_SA(0, 0), cA, voffA); PG8_STAGE(PG8_SA(0, 1), cA + hstep, voffA);
        if (wr == 1) PG8_BAR;
        PG8_WAIT_V(2); PG8_BAR;
        PG8_STAGE(PG8_SB(1, 0), cB + kstep, voffB); PG8_STAGE(PG8_SA(1, 0), cA + kstep, voffA); PG8_STAGE(PG8_SB(1, 1), cB + hstep + kstep, voffB);
        PG8_WAIT_V(6); PG8_BAR;
    } else {
        PG8_STAGE(PG8_SB(0, 0), cB, voffB); PG8_STAGE(PG8_SA(0, 0), cA, voffA); PG8_STAGE(PG8_SB(0, 1), cB + hstep, voffB); PG8_STAGE(PG8_SA(0, 1), cA + hstep, voffA);
        if (wr == 1) PG8_BAR;
        PG8_WAIT_V(4); PG8_BAR;
        PG8_STAGE(PG8_SB(1, 0), cB + kstep, voffB); PG8_STAGE(PG8_SA(1, 0), cA + kstep, voffA); PG8_STAGE(PG8_SB(1, 1), cB + hstep + kstep, voffB);
        PG8_WAIT_V(6); PG8_BAR;
    }
    for (;;) {
        const bool has_next = S.next(ui + 1, nxt);
        const char* nA = has_next ? (const char*)g.A + (size_t)nxt.pm * tstep : cA; const char* nB = has_next ? (const char*)g.Bt + (size_t)nxt.pn * tstep : cB;
        for (int t = 0; t < nt; t += 2) {
            const bool last = (t == nt - 2);
            const char* a1 = cA + (size_t)(t + 1) * kstep;
            const char* a2 = last ? nA : cA + (size_t)(t + 2) * kstep; const char* b2 = last ? nB : cB + (size_t)(t + 2) * kstep;
            const char* a3 = a2 + kstep; const char* b3 = b2 + kstep;
            if (last && has_next) S.a_ready(nxt);
            if constexpr (SP2) {
            PG8_LDB(B0, 0, 0); PG8_LDB(B1, 0, 1); PG8_SCHED; PG8_LDA(At, 0, 0); PG8_STAGE(PG8_SA(1, 1), a1 + hstep, voffA);
            PG8_WAIT_V(8); PG8_WAIT_L(0); PG8_BAR; PG8_MMA(0, 0, At, B0); PG8_MMA(0, 1, At, B1); PG8_BAR; PG8_SCHED;
            PG8_LDA(At, 0, 1); PG8_STAGE(PG8_SB(0, 0), b2, voffB); PG8_STAGE(PG8_SB(0, 1), b2 + hstep, voffB); PG8_STAGE(PG8_SA(0, 0), a2, voffA);
            PG8_WAIT_V(8); PG8_WAIT_L(0); PG8_BAR; PG8_MMA(1, 0, At, B0); PG8_MMA(1, 1, At, B1); PG8_BAR; PG8_SCHED;
            PG8_LDB(B0, 1, 0); PG8_LDB(B1, 1, 1); PG8_SCHED; PG8_LDA(At, 1, 0); PG8_STAGE(PG8_SA(0, 1), a2 + hstep, voffA);
            PG8_WAIT_V(8); PG8_WAIT_L(0); PG8_BAR; PG8_MMA(0, 0, At, B0); PG8_MMA(0, 1, At, B1); PG8_BAR; PG8_SCHED;
            PG8_LDA(At, 1, 1); PG8_STAGE(PG8_SB(1, 0), b3, voffB); PG8_STAGE(PG8_SB(1, 1), b3 + hstep, voffB); PG8_STAGE(PG8_SA(1, 0), a3, voffA);
            PG8_WAIT_V(8); PG8_WAIT_L(0); PG8_BAR; PG8_MMA(1, 0, At, B0); PG8_MMA(1, 1, At, B1); PG8_BAR; PG8_SCHED;
            } else {
            PG8_LDB(B0, 0, 0); PG8_SCHED; PG8_LDA(At, 0, 0); PG8_STAGE(PG8_SA(1, 1), a1 + hstep, voffA);
            PG8_WAIT_L(8); PG8_BAR; PG8_WAIT_L(0); PG8_MMA(0, 0, At, B0); PG8_BAR; PG8_SCHED;
            PG8_LDB(B1, 0, 1); PG8_STAGE(PG8_SB(0, 0), b2, voffB);
            PG8_BAR; PG8_WAIT_L(0); PG8_MMA(0, 1, At, B1); PG8_BAR;
            PG8_LDA(At, 0, 1); PG8_STAGE(PG8_SA(0, 0), a2, voffA);
            PG8_BAR; PG8_WAIT_L(0); PG8_MMA(1, 0, At, B0); PG8_BAR; PG8_SCHED;
            PG8_STAGE(PG8_SB(0, 1), b2 + hstep, voffB);
            PG8_WAIT_V(6); PG8_BAR; PG8_MMA(1, 1, At, B1); PG8_BAR;
            PG8_LDB(B0, 1, 0); PG8_SCHED; PG8_LDA(At, 1, 0); PG8_STAGE(PG8_SA(0, 1), a2 + hstep, voffA);
            PG8_WAIT_L(8); PG8_BAR; PG8_WAIT_L(0); PG8_MMA(0, 0, At, B0); PG8_BAR; PG8_SCHED;
            PG8_LDB(B1, 1, 1); PG8_STAGE(PG8_SB(1, 0), b3, voffB);
            PG8_BAR; PG8_WAIT_L(0); PG8_MMA(0, 1, At, B1); PG8_BAR;
            PG8_LDA(At, 1, 1); PG8_STAGE(PG8_SA(1, 0), a3, voffA);
            PG8_BAR; PG8_WAIT_L(0); PG8_MMA(1, 0, At, B0); PG8_BAR; PG8_SCHED;
            PG8_STAGE(PG8_SB(1, 1), b3 + hstep, voffB);
            PG8_WAIT_V(6); PG8_BAR; PG8_MMA(1, 1, At, B1); PG8_BAR;
            }
        }
        if constexpr (ALIGN_EPI) { if (wr == 0) PG8_BAR; }
        if constexpr (!Epi::AFTER_DRAIN) { E(acc, cur, wr, wc, fr, fq); S.done(cur); }
        if (!has_next) break;
#pragma unroll
        for (int a = 0; a < 2; ++a)
#pragma unroll
            for (int b = 0; b < 2; ++b)
#pragma unroll
                for (int m = 0; m < 4; ++m)
#pragma unroll
                    for (int n = 0; n < 2; ++n) acc[a][b][m][n] = (f32x4){0.f, 0.f, 0.f, 0.f};
        if constexpr (Epi::HAS_INIT) E.init(acc, nxt, wr, wc, fr, fq);
        cur = nxt; cA = nA; cB = nB; ++ui;
        if constexpr (ALIGN_EPI) { if (wr == 1) PG8_BAR; }
    }
    PG8_WAIT_V(0);
    if constexpr (!ALIGN_EPI) { if (wr == 0) PG8_BAR; }
    PG8_BAR;
    if constexpr (Epi::AFTER_DRAIN) { E.fused(acc, cur, wr, wc, fr, fq, lds, wid, lane); S.done(cur); }
#undef PG8_SA
#undef PG8_SB
#undef PG8_STAGE
#undef PG8_LDA
#undef PG8_LDB
#undef PG8_MMA
#undef PG8_WAIT_V
#undef PG8_WAIT_L
#undef PG8_BAR
#undef PG8_SCHED
}
}
constexpr int NWAVES = 8;
#ifndef MK_N_LAUNCHES
#define MK_N_LAUNCHES 1
#endif
constexpr int N_PHASES = 5;
constexpr int BATCH = 8, T = 2048, D = 1024, M = BATCH * T;
constexpr int NP = 4224;
constexpr int C_R = 0, C_K = 512, C_V = 1024, C_ZW = 1536, C_ZA = 1600, C_GA = 1664, C_DQ = 2176, C_DK = 2688, C_DV = 3200, C_GB = 3712;
constexpr int RH = 8, RN = 64;
constexpr int AH = 4;
constexpr float C2 = 0.125f * 1.4426950408889634f;
constexpr float LOG2E = 1.4426950408889634f;
constexpr float LAMBDA_INIT = 0.2f;

constexpr size_t MiB = 1u << 20;
constexpr size_t WS_CTL = 0, CTL_ZERO_BYTES = 1 * MiB;
constexpr size_t WS_WIN = 2 * MiB;
constexpr size_t WS_WOUT = 11 * MiB;
constexpr size_t WS_WD = 13 * MiB, WS_WA = 13 * MiB + 65536;
constexpr size_t WS_RHO = 13 * MiB + 2 * 65536;
constexpr size_t WS_XN = 14 * MiB;
constexpr size_t WS_PROJ = 46 * MiB;
constexpr size_t WS_MIX = 182 * MiB;
constexpr size_t WS_END = 214 * MiB;
constexpr int CW_BAR = 4096;

constexpr int RING_OFF = 0, RING_BYTES = 131072;
constexpr int LDSCTL_OFF = RING_BYTES, MISC_OFF = LDSCTL_OFF + 320;
constexpr int LDS_BYTES = 155648;

#define GAS __attribute__((address_space(1)))
#define LAS __attribute__((address_space(3)))
typedef unsigned short bf16;
typedef unsigned v4u __attribute__((ext_vector_type(4)));
typedef unsigned v2u __attribute__((ext_vector_type(2)));
typedef float f32x4 __attribute__((ext_vector_type(4)));
typedef float f32x16 __attribute__((ext_vector_type(16)));
typedef short bf16x8 __attribute__((ext_vector_type(8)));
typedef short s16x4 __attribute__((ext_vector_type(4)));
typedef GAS unsigned gu32;
typedef GAS unsigned long long gu64;
#define RLX_AGENT __ATOMIC_RELAXED, __HIP_MEMORY_SCOPE_AGENT
#define LDS_WAIT() asm volatile("s_waitcnt lgkmcnt(0)" ::: "memory")
#define VM_WAIT() asm volatile("s_waitcnt vmcnt(0)" ::: "memory")
__device__ __forceinline__ unsigned f2bf(float f) { unsigned u = __builtin_bit_cast(unsigned, f); return (u + 0x7fffu + ((u >> 16) & 1u)) >> 16; }
__device__ __forceinline__ unsigned pk2(float lo, float hi) { return f2bf(lo) | (f2bf(hi) << 16); }
__device__ __forceinline__ float bflo(unsigned u) { return __uint_as_float(u << 16); }
__device__ __forceinline__ float bfhi(unsigned u) { return __uint_as_float(u & 0xffff0000u); }
__device__ __forceinline__ float bf1(unsigned short u) { return __uint_as_float((unsigned)u << 16); }
__device__ __forceinline__ int mk_lane() { int l; asm volatile("v_mbcnt_lo_u32_b32 %0, -1, 0\n\tv_mbcnt_hi_u32_b32 %0, -1, %0" : "=v"(l)); return l; }
#define XB_TMO      128
#define XB_XCNT(j)  (256  + 64 * (j))
#define XB_XSUB(j)  (1280 + 64 * (j))
#define XB_XGEN(j)  (2304 + 64 * (j))
#define XB_TOP      3328
#define XB_TOPGEN   3392
#define XCD_BAR_WORDS 3456
#define XB_SPIN_CAP (1u << 18)

__device__ __forceinline__ unsigned xb_ld(unsigned* p)              { return __hip_atomic_load(p, __ATOMIC_RELAXED, __HIP_MEMORY_SCOPE_AGENT); }
__device__ __forceinline__ unsigned xb_add(unsigned* p, unsigned v) { return __hip_atomic_fetch_add(p, v, __ATOMIC_RELAXED, __HIP_MEMORY_SCOPE_AGENT); }
__device__ __forceinline__ unsigned xb_xcc_id() { return (unsigned)__builtin_amdgcn_s_getreg((3 << 11) | 20) & 0xFu; }
#define XB_SPIN(cond, bar) do { unsigned _sp = 0; while (cond) { __builtin_amdgcn_s_sleep(1); \
    if ((++_sp & 255u) == 0u) { if (xb_ld(&(bar)[XB_TMO])) break; if (_sp > XB_SPIN_CAP) { atomicAdd(&(bar)[XB_TMO], 1u); break; } } } } while (0)

struct XcdBarrier {
    unsigned* bar; unsigned x;
    volatile LAS unsigned* st;
    int wave;
};

__device__ __forceinline__ XcdBarrier xcd_barrier_post(unsigned* bar, volatile LAS unsigned* st, int wave) {
    XcdBarrier b; b.bar = bar; b.x = xb_xcc_id(); b.st = st; b.wave = wave;
    if (wave == 0 && mk_lane() == 0) (void)xb_add(&bar[XB_XCNT(b.x)], 1u);
    return b;
}
__device__ __forceinline__ void xcd_barrier_complete(unsigned* bar, unsigned x, unsigned& nloc, unsigned& nx) {
    const unsigned G = gridDim.x * gridDim.y * gridDim.z;
    unsigned sum, cnt, mine, sp = 0u;
    for (;;) {
        sum = 0u; cnt = 0u; mine = 0u;
#pragma unroll
        for (unsigned j = 0; j < 16; ++j) { const unsigned c = xb_ld(&bar[XB_XCNT(j)]); sum += c; cnt += (c > 0u) ? 1u : 0u; mine = (j == x) ? c : mine; }
        if (sum == G) break;
        __builtin_amdgcn_s_sleep(1);
        if ((++sp & 255u) == 0u) { if (xb_ld(&bar[XB_TMO])) break; if (sp > XB_SPIN_CAP) { atomicAdd(&bar[XB_TMO], 1u); break; } }
    }
    nloc = mine > 0u ? mine : 1u; nx = cnt > 0u ? cnt : 1u;
}

struct XbNoHook { __device__ __forceinline__ void operator()() const {} };
template <class Hook = XbNoHook> __device__ __forceinline__ void xcd_barrier(const XcdBarrier& b, const Hook& hook = Hook()) {
    asm volatile("s_waitcnt vmcnt(0)" ::: "memory");
    __syncthreads();
    if (b.wave != 0) hook();
    if (b.wave == 0 && mk_lane() == 0) {
        unsigned* bar = b.bar;
        __builtin_amdgcn_s_waitcnt(0);
        unsigned nloc = b.st[0], nx = b.st[1];
        if (nloc == 0u) { xcd_barrier_complete(bar, b.x, nloc, nx); b.st[0] = nloc; b.st[1] = nx; }
        const unsigned old = xb_add(&bar[XB_XSUB(b.x)], 1u);
        const unsigned gen = old / nloc;
        if (old + 1u == (gen + 1u) * nloc) {
            __builtin_amdgcn_fence(__ATOMIC_RELEASE, "agent");
            asm volatile("s_waitcnt vmcnt(0)" ::: "memory");
            const unsigned og = xb_add(&bar[XB_TOP], 1u);
            const unsigned tg = og / nx;
            if (og + 1u == (tg + 1u) * nx) xb_add(&bar[XB_TOPGEN], 1u);
            else XB_SPIN(xb_ld(&bar[XB_TOPGEN]) == tg, bar);
            __builtin_amdgcn_fence(__ATOMIC_ACQUIRE, "agent");
            xb_add(&bar[XB_XGEN(b.x)], 1u);
            asm volatile("s_waitcnt vmcnt(0)" ::: "memory");
        } else {
            XB_SPIN(xb_ld(&bar[XB_XGEN(b.x)]) == gen, bar);
            __builtin_amdgcn_fence(__ATOMIC_ACQUIRE, "agent");
            asm volatile("s_waitcnt vmcnt(0)" ::: "memory");
        }
    }
    if (b.wave == 0) hook();
    __syncthreads();
}
struct Frame {
    LAS unsigned char* lds;
    volatile LAS unsigned* MISC;
    gu32* ctl;
    int tid, lane, wave;
    int vcu, G;
    const float* x; float* out;
    const float *norm_g, *w_in, *shift_mu, *w0, *w_decay_up, *a0, *w_iclr_up, *k_k, *k_a, *r_k, *ln_w, *ln_b, *qn_g, *kn_g, *lq1, *lk1, *lq2, *lk2, *subln_g, *w_out;
    bf16 *WinT, *WoutT, *WdT, *WaT, *XN, *PROJ, *MIX;
};

typedef float f32x2q_t __attribute__((ext_vector_type(2))); typedef __bf16 bf16x2q_t __attribute__((ext_vector_type(2)));
__device__ __forceinline__ unsigned cvtpk2(float lo, float hi) { f32x2q_t v = {lo, hi}; bf16x2q_t b = __builtin_convertvector(v, bf16x2q_t); return __builtin_bit_cast(unsigned, b); }
__device__ __forceinline__ float wave_sum(float v) {
#pragma unroll
    for (int o = 1; o < 64; o <<= 1) v += __shfl_xor(v, o);
    return v;
}
template <int CTRL> __device__ __forceinline__ float dpp_f(float x) { return __builtin_bit_cast(float, __builtin_amdgcn_mov_dpp(__builtin_bit_cast(int, x), CTRL, 0xf, 0xf, true)); }
__device__ __forceinline__ float row16_sum(float x) {
    x += dpp_f<0xB1>(x); x += dpp_f<0x4E>(x); x += dpp_f<0x141>(x); x += dpp_f<0x140>(x); return x;
}
__device__ __forceinline__ float swap32_sum(float x) {
    auto rr = __builtin_amdgcn_permlane32_swap(__float_as_uint(x), __float_as_uint(x), false, false);
    return __uint_as_float(rr[0]) + __uint_as_float(rr[1]);
}

template <bool FRAG = false> __device__ __forceinline__ void p0_transpose_item(const float* W, int N, int nsrc, const float* kscale, bf16* WT, int K, int ndst, LAS float* scr, int k0, int lane) {
    float v[32];
#pragma unroll
    for (int i = 0; i < 32; ++i) { const int kk = 2 * i + (lane >> 5); v[i] = (nsrc >= 0) ? W[(size_t)(k0 + kk) * N + nsrc + (lane & 31)] : 0.f; }
    if (kscale && nsrc >= 0) {
#pragma unroll
        for (int i = 0; i < 32; ++i) v[i] *= kscale[k0 + 2 * i + (lane >> 5)];
    }
#pragma unroll
    for (int i = 0; i < 32; ++i) scr[(2 * i + (lane >> 5)) * 33 + (lane & 31)] = v[i];
    LDS_WAIT(); asm volatile("" ::: "memory");
    const int c = lane & 7;
#pragma unroll
    for (int j = 0; j < 4; ++j) { const int n = (lane >> 3) + 8 * j; const LAS float* s = scr + (8 * c) * 33 + n;
        v4u o; o.x = cvtpk2(s[0 * 33], s[1 * 33]); o.y = cvtpk2(s[2 * 33], s[3 * 33]); o.z = cvtpk2(s[4 * 33], s[5 * 33]); o.w = cvtpk2(s[6 * 33], s[7 * 33]);
        if (FRAG) *(GAS v4u*)(WT + ((size_t)((ndst >> 5) * 4 + (c >> 1)) * 64 + ((c & 1) * 32 + n)) * 8) = o;
        else *(GAS v4u*)(WT + (size_t)(ndst + n) * K + k0 + 8 * c) = o; }
    LDS_WAIT(); asm volatile("" ::: "memory");
}
template <int NQ> __device__ __forceinline__ void p0_rowsq(Frame& F, int mq, int mstep) {
    f32x4 v[NQ][4][4];
#pragma unroll
    for (int q = 0; q < NQ; ++q)
#pragma unroll
        for (int u = 0; u < 4; ++u) { const GAS f32x4* xr = (const GAS f32x4*)(F.x + (size_t)(mq + q * mstep + u) * D) + 2 * F.lane;
#pragma unroll
            for (int j = 0; j < 2; ++j) { v[q][u][2 * j] = __builtin_nontemporal_load(xr + 128 * j); v[q][u][2 * j + 1] = __builtin_nontemporal_load(xr + 128 * j + 1); } }
#pragma unroll
    for (int q = 0; q < NQ; ++q) {
        float s[4];
#pragma unroll
        for (int u = 0; u < 4; ++u) { float a = 0.f;
#pragma unroll
            for (int j = 0; j < 4; ++j) a += (v[q][u][j].x * v[q][u][j].x + v[q][u][j].y * v[q][u][j].y) + (v[q][u][j].z * v[q][u][j].z + v[q][u][j].w * v[q][u][j].w);
            s[u] = a; }
#pragma unroll
        for (int u = 0; u < 4; ++u) {
            const float rstd = __builtin_amdgcn_rsqf(wave_sum(s[u]) * (1.f / D) + 1e-6f);
            GAS v4u* o16 = (GAS v4u*)(F.XN + (size_t)(mq + q * mstep + u) * D) + F.lane;
#pragma unroll
            for (int j = 0; j < 2; ++j) { const f32x4 a = v[q][u][2 * j], c = v[q][u][2 * j + 1];
                o16[64 * j] = (v4u){cvtpk2(a.x * rstd, a.y * rstd), cvtpk2(a.z * rstd, a.w * rstd), cvtpk2(c.x * rstd, c.y * rstd), cvtpk2(c.z * rstd, c.w * rstd)}; }
        }
    }
}
__device__ __forceinline__ void p0_prologue(Frame& F) {
    LAS float* scr = (LAS float*)(F.lds + RING_OFF + F.wave * 16384);
    const int gw = F.vcu * NWAVES + F.wave, NGW = F.G * NWAVES;
    constexpr int I_IN = (D / 64) * (NP / 32), I_OUT = (D / 64) * (D / 32), I_L = 512 / 32;
    constexpr int NITEMS = I_IN + I_OUT + 2 * I_L;
    int m0 = gw * 4;
    const bool two = (m0 + NGW * 4 < M) && (m0 + 2 * NGW * 4 >= M);
    if (!(gw & 1) && m0 < M) { if (two) { p0_rowsq<2>(F, m0, NGW * 4); m0 += 2 * NGW * 4; } else { p0_rowsq<1>(F, m0, 0); m0 += NGW * 4; } }
#pragma unroll 1
    for (int it = gw; it < NITEMS; it += NGW) {
        int r = it;
        if (r < I_IN) { const int kb = r / (NP / 32), nb = r % (NP / 32), nd = 32 * nb; const int ns = nd;
            p0_transpose_item(F.w_in, 4224, ns, F.norm_g, F.WinT, D, nd, scr, 64 * kb, F.lane); continue; } r -= I_IN;
        if (r < I_OUT) { const int kb = r / (D / 32), nb = r % (D / 32);
            p0_transpose_item(F.w_out, D, 32 * nb, nullptr, F.WoutT, D, 32 * nb, scr, 64 * kb, F.lane); continue; } r -= I_OUT;
        if (r < I_L) { p0_transpose_item<true>(F.w_decay_up, 512, 32 * r, nullptr, F.WdT, 64, 32 * r, scr, 0, F.lane); continue; } r -= I_L;
        p0_transpose_item<true>(F.w_iclr_up, 512, 32 * r, nullptr, F.WaT, 64, 32 * r, scr, 0, F.lane);
    }
    if (two && m0 + NGW * 4 < M) { p0_rowsq<2>(F, m0, NGW * 4); m0 += 2 * NGW * 4; }
#pragma unroll 1
    for (; m0 < M; m0 += NGW * 4) p0_rowsq<1>(F, m0, 0);
}

__device__ __forceinline__ float tanh_f(float x) { const float e = __expf(-2.f * fabsf(x)); const float t = (1.f - e) * __builtin_amdgcn_rcpf(1.f + e); return x < 0.f ? -t : t; }
__device__ __forceinline__ void shifted8(const bf16* proj, size_t m, bool has_prev, int col, const float* mu, float (&o)[8]) {
    const v4u c = *(const GAS v4u*)(proj + m * NP + col);
    v4u p = (v4u){0u, 0u, 0u, 0u}; if (has_prev) p = *(const GAS v4u*)(proj + (m - 1) * NP + col);
    const f32x4 m0 = *(const GAS f32x4*)(mu), m1 = *(const GAS f32x4*)(mu + 4);
    const unsigned cw[4] = {c.x, c.y, c.z, c.w}, pw[4] = {p.x, p.y, p.z, p.w}; const float mm[8] = {m0.x, m0.y, m0.z, m0.w, m1.x, m1.y, m1.z, m1.w};
#pragma unroll
    for (int j = 0; j < 4; ++j) { const float c0 = bflo(cw[j]), c1 = bfhi(cw[j]), p0 = bflo(pw[j]), p1 = bfhi(pw[j]);
        o[2 * j] = c0 + (p0 - c0) * mm[2 * j]; o[2 * j + 1] = c1 + (p1 - c1) * mm[2 * j + 1]; }
}
__device__ __forceinline__ void shifted4(const bf16* proj, size_t m, bool has_prev, int col, const float* mu, float (&o)[4]) {
    const v2u c = *(const GAS v2u*)(proj + m * NP + col);
    v2u p = (v2u){0u, 0u}; if (has_prev) p = *(const GAS v2u*)(proj + (m - 1) * NP + col);
    const f32x4 m0 = *(const GAS f32x4*)(mu);
    o[0] = bflo(c.x) + (bflo(p.x) - bflo(c.x)) * m0.x; o[1] = bfhi(c.x) + (bfhi(p.x) - bfhi(c.x)) * m0.y;
    o[2] = bflo(c.y) + (bflo(p.y) - bflo(c.y)) * m0.z; o[3] = bfhi(c.y) + (bfhi(p.y) - bfhi(c.y)) * m0.w;
}
__device__ __forceinline__ void p2_qknorm(Frame& F) {
    const int gw = F.vcu * NWAVES + F.wave, NGW = F.G * NWAVES, lane = F.lane, sub = lane & 7;
    const f32x4 gk0 = *(const GAS f32x4*)(F.kn_g + sub * 8), gk1 = *(const GAS f32x4*)(F.kn_g + sub * 8 + 4);
    constexpr int UQ = 4;
    for (int it0 = gw * UQ; it0 < M; it0 += NGW * UQ) {
        bf16* p[UQ]; v4u c[UQ];
#pragma unroll
        for (int u = 0; u < UQ; ++u) { const size_t m = (size_t)(it0 + u); p[u] = F.PROJ + m * NP + C_DK + (lane >> 3) * 64 + sub * 8; c[u] = *(const GAS v4u*)p[u]; }
#pragma unroll
        for (int u = 0; u < UQ; ++u) {
            const unsigned cw[4] = {c[u].x, c[u].y, c[u].z, c[u].w};
            float xv[8]; float ss = 0.f;
#pragma unroll
            for (int j = 0; j < 4; ++j) { xv[2 * j] = bflo(cw[j]); xv[2 * j + 1] = bfhi(cw[j]); ss += xv[2 * j] * xv[2 * j] + xv[2 * j + 1] * xv[2 * j + 1]; }
            ss += dpp_f<0xB1>(ss); ss += dpp_f<0x4E>(ss); ss += dpp_f<0x141>(ss);
            const float r = __builtin_amdgcn_rsqf(ss * (1.f / 64.f) + 1e-6f);
            v4u o; o.x = cvtpk2(xv[0] * r * gk0.x, xv[1] * r * gk0.y); o.y = cvtpk2(xv[2] * r * gk0.z, xv[3] * r * gk0.w); o.z = cvtpk2(xv[4] * r * gk1.x, xv[5] * r * gk1.y); o.w = cvtpk2(xv[6] * r * gk1.z, xv[7] * r * gk1.w);
            *(GAS v4u*)p[u] = o;
        }
    }
}
typedef float f32x2_t __attribute__((ext_vector_type(2))); typedef __bf16 bf16x2_t __attribute__((ext_vector_type(2)));
__device__ __forceinline__ unsigned cvtpk(float lo, float hi) { f32x2_t v = {lo, hi}; bf16x2_t b = __builtin_convertvector(v, bf16x2_t); return __builtin_bit_cast(unsigned, b); }
#define MFMA32(a, b, c) __builtin_amdgcn_mfma_f32_32x32x16_bf16(__builtin_bit_cast(bf16x8, (a)), __builtin_bit_cast(bf16x8, (b)), (c), 0, 0, 0)
#define FRAGACC(z, s) ((v4u){cvtpk((z)[8 * (s)], (z)[8 * (s) + 1]), cvtpk((z)[8 * (s) + 2], (z)[8 * (s) + 3]), cvtpk((z)[8 * (s) + 4], (z)[8 * (s) + 5]), cvtpk((z)[8 * (s) + 6], (z)[8 * (s) + 7])})
template <int CTRL, int RM> __device__ __forceinline__ float dpp_upd0(float x) { return __builtin_bit_cast(float, __builtin_amdgcn_update_dpp(0, __builtin_bit_cast(int, x), CTRL, RM, 0xf, false)); }
__device__ __forceinline__ float scan32(float x) {
    x += dpp_upd0<0x111, 0xf>(x); x += dpp_upd0<0x112, 0xf>(x); x += dpp_upd0<0x114, 0xf>(x); x += dpp_upd0<0x118, 0xf>(x); x += dpp_upd0<0x142, 0xa>(x); return x;
}
__device__ __forceinline__ void st_wt16(v4u* p, const v4u v) { *(GAS v4u*)p = v; }
constexpr int RW_UNITS = BATCH * RH * (T / 32);
struct RwDump { v4u* PF; v4u* DD; v4u* QF; v4u* YD; float* GAM; float* RHO; };

__device__ __forceinline__ void rwkvA_unit(Frame& F, const RwDump& Dm, int bh, int ci, LAS float* wscr, LAS unsigned char* park, LAS v4u* zsh, int zpar) {
    int lane = mk_lane(); asm volatile("" : "+v"(lane));
    const int hi = lane >> 5, l31 = lane & 31, b = bh >> 3, w = bh & 7;
    LAS v4u* pk = (LAS v4u*)park + lane;
#define PARK(slot) pk[(slot) * 64]
    int tok = 0; asm volatile("" : "+v"(tok));
#define DEP(x) asm volatile("" : "+v"(tok) : "v"(x))
    const int t = ci * 32 + l31; const size_t m = (size_t)b * T + t; const bool hp = t > 0;
    const int u = ci * (BATCH * RH) + bh;
    const float pm = hp ? 1.f : 0.f;
    const float* mu = F.shift_mu + w * 64 + 4 * hi;
    const float *pw0 = F.w0 + w * 64 + 4 * hi, *pa0 = F.a0 + w * 64 + 4 * hi, *pkk = F.k_k + w * 64 + 4 * hi, *pka = F.k_a + w * 64 + 4 * hi, *prk = F.r_k + w * 64 + 4 * hi;
    LAS unsigned char* stg = park + 8192;
    LAS unsigned char* prv = F.lds + LDSCTL_OFF + 20480 + F.wave * 256;
    const bf16* gk = F.PROJ + ((size_t)b * T + ci * 32) * NP + w * 64;
    const bf16* gpr = gk - (ci > 0 ? NP : 0);
#define RW_DMA(src, dst) __builtin_amdgcn_global_load_lds((const unsigned*)(src), (LAS unsigned*)(dst), 16, 0, 0)
    LDS_WAIT();
    { const bf16* s_ = gk + (size_t)(lane >> 3) * NP + C_K;
#pragma unroll
      for (int p = 0; p < 4; ++p) RW_DMA(s_ + (size_t)(8 * p) * NP + (((lane & 7) ^ ((4 * p + (lane >> 4)) & 7)) * 8), stg + p * 1024);
      if (lane < 8) RW_DMA(gpr + C_K + lane * 8, prv); }
#define RW_STAGE_RV(cb) do { const bf16* s_ = gk + (size_t)(lane >> 2) * NP + 32 * (cb) + (((lane & 3) ^ ((lane >> 4) & 3)) * 8); \
      _Pragma("unroll") for (int p = 0; p < 2; ++p) { RW_DMA(s_ + C_R + (size_t)(16 * p) * NP, stg + 4096 + p * 1024); RW_DMA(s_ + C_V + (size_t)(16 * p) * NP, stg + 6144 + p * 1024); } \
      if (lane < 4) { RW_DMA(gpr + C_R + 32 * (cb) + lane * 8, prv + 128); RW_DMA(gpr + C_V + 32 * (cb) + lane * 8, prv + 192); } } while (0)
    RW_STAGE_RV(0);
    const LAS unsigned char* kcur = stg + l31 * 128 + 8 * hi; const LAS unsigned char* kprv = l31 ? kcur - 128 : prv + 8 * hi;
    const LAS unsigned char* rcur = stg + 4096 + l31 * 64 + 8 * hi; const LAS unsigned char* rprv = l31 ? rcur - 64 : prv + 128 + 8 * hi;
    const LAS unsigned char* vcur = stg + 6144 + l31 * 64 + 8 * hi; const LAS unsigned char* vprv = l31 ? vcur - 64 : prv + 192 + 8 * hi;
    const int fKc = ((l31 >> 1) & 7) << 4, fKp = l31 ? (((l31 - 1) >> 1) & 7) << 4 : 0, fRc = ((l31 >> 2) & 3) << 4, fRp = l31 ? (((l31 - 1) >> 2) & 3) << 4 : 0;
    v4u bz[4], ba[4];
    { const int s = F.wave >> 1; const bool which = (F.wave & 1) != 0;
      const bf16* zc = F.PROJ + m * NP + 8 * hi; const bf16* zp = F.PROJ + (hp ? m - 1 : m) * NP + 8 * hi; const float* zmu = F.shift_mu + 8 * hi;
      const int COL = (which ? C_ZA : C_ZW) + 16 * s, MUO = (which ? 1600 : 1536) + 16 * s;
      const v4u c = *(const GAS v4u*)(zc + tok + COL), p = *(const GAS v4u*)(zp + tok + COL); const f32x4 m0 = *(const GAS f32x4*)(zmu + tok + MUO), m1 = *(const GAS f32x4*)(zmu + tok + MUO + 4);
      float z[8];
#pragma unroll
      for (int j = 0; j < 4; ++j) { const float c0 = bflo(c[j]), c1 = bfhi(c[j]); const float mm0 = j < 2 ? m0[2 * j] : m1[2 * j - 4], mm1 = j < 2 ? m0[2 * j + 1] : m1[2 * j - 3];
          z[2 * j] = c0 + (bflo(p[j]) * pm - c0) * mm0; z[2 * j + 1] = c1 + (bfhi(p[j]) * pm - c1) * mm1; }
      if (!which) {
#pragma unroll
          for (int j = 0; j < 8; ++j) z[j] = tanh_f(z[j]); }
      LAS v4u* zs = zsh + zpar * 512;
      zs[((which ? 4 : 0) + s) * 64 + lane] = (v4u){cvtpk(z[0], z[1]), cvtpk(z[2], z[3]), cvtpk(z[4], z[5]), cvtpk(z[6], z[7])};
      __syncthreads();
#pragma unroll
      for (int q = 0; q < 4; ++q) { bz[q] = zs[q * 64 + lane]; ba[q] = zs[(4 + q) * 64 + lane]; }
      DEP(bz[3][3]); DEP(ba[3][3]); }
    asm volatile("" ::: "memory");
    asm volatile("s_waitcnt vmcnt(0)" ::: "memory");
    float ss = 0.f;
#pragma unroll
    for (int gq = 0; gq < 8; ++gq) { const v2u c_ = *(const LAS v2u*)(kcur + tok + ((16 * gq) ^ fKc)), p_ = *(const LAS v2u*)(kprv + tok + ((16 * gq) ^ fKp));
        const f32x4 m_ = *(const GAS f32x4*)(mu + tok + 512 + 8 * gq), kkp = *(const GAS f32x4*)(pkk + tok + 8 * gq);
        float k4[4]; k4[0] = bflo(c_.x) + (bflo(p_.x) * pm - bflo(c_.x)) * m_.x; k4[1] = bfhi(c_.x) + (bfhi(p_.x) * pm - bfhi(c_.x)) * m_.y;
        k4[2] = bflo(c_.y) + (bflo(p_.y) * pm - bflo(c_.y)) * m_.z; k4[3] = bfhi(c_.y) + (bfhi(p_.y) * pm - bfhi(c_.y)) * m_.w;
#pragma unroll
        for (int e = 0; e < 4; ++e) { const float q = k4[e] * kkp[e]; ss += q * q; }
        if (gq == 3) DEP(ss); }
    ss = swap32_sum(ss);
    const float inv = __builtin_amdgcn_rcpf(fmaxf(__builtin_amdgcn_sqrtf(ss), 1e-12f));
    asm volatile("" ::: "memory");
    v4u fa[4], fb[4], fk[4], fr[4], fv[4]; float rho = 0.f;
    float* gp = Dm.GAM + (size_t)u * 64 + hi * 32;
#define RW_LORA(cb) f32x16 accd = f32x16{}, acca = f32x16{}; _Pragma("unroll") for (int s = 0; s < 4; ++s) { \
        const v4u aD = *(const GAS v4u*)(F.WdT + tok + ((size_t)((w * 2 + (cb)) * 4 + s) * 64 + lane) * 8); accd = MFMA32(aD, bz[s], accd);     \
        const v4u aA = *(const GAS v4u*)(F.WaT + tok + ((size_t)((w * 2 + (cb)) * 4 + s) * 64 + lane) * 8); acca = MFMA32(aA, ba[s], acca); }
        struct RwGL { v2u rc, rp, kc, kp, vc, vp; };
    struct RwPar { f32x4 mr, mk, mv, w0, a0, kk; } pA, pB;
#define RW_LOADG(X, CB, RG) do { X.rc = *(const LAS v2u*)(rcur + tok + ((16 * (RG)) ^ fRc)); X.rp = *(const LAS v2u*)(rprv + tok + ((16 * (RG)) ^ fRp)); \
        X.kc = *(const LAS v2u*)(kcur + tok + ((64 * (CB) + 16 * (RG)) ^ fKc)); X.kp = *(const LAS v2u*)(kprv + tok + ((64 * (CB) + 16 * (RG)) ^ fKp)); \
        X.vc = *(const LAS v2u*)(vcur + tok + ((16 * (RG)) ^ fRc)); X.vp = *(const LAS v2u*)(vprv + tok + ((16 * (RG)) ^ fRp)); } while (0)
#define RW_LOADP(X, OFF_) do { X.mr = *(const GAS f32x4*)(mu + tok + (OFF_)); X.mk = *(const GAS f32x4*)(mu + tok + 512 + (OFF_)); X.mv = *(const GAS f32x4*)(mu + tok + 1024 + (OFF_)); \
        X.w0 = *(const GAS f32x4*)(pw0 + tok + (OFF_)); X.a0 = *(const GAS f32x4*)(pa0 + tok + (OFF_)); X.kk = *(const GAS f32x4*)(pkk + tok + (OFF_)); } while (0)
#define RW_LERP(dst, c_, p_, m_) do { dst[0] = bflo(c_.x) + (bflo(p_.x) * pm - bflo(c_.x)) * m_.x; dst[1] = bfhi(c_.x) + (bfhi(p_.x) * pm - bfhi(c_.x)) * m_.y; \
        dst[2] = bflo(c_.y) + (bflo(p_.y) * pm - bflo(c_.y)) * m_.z; dst[3] = bfhi(c_.y) + (bfhi(p_.y) * pm - bfhi(c_.y)) * m_.w; } while (0)
#define RW_GROUP(cb, rg, CUR, NXT, HASN) do { constexpr int OFF = 32 * (cb) + 8 * (rg); const int ch0 = OFF + 4 * hi; \
            if (HASN) RW_LOADP(NXT, OFF + 8); \
            RwGL g_; RW_LOADG(g_, cb, rg); \
            float rr[4], kk4[4], vv[4]; \
            const f32x4 kap = *(const GAS f32x4*)(pka + tok + OFF), rkp = *(const GAS f32x4*)(prk + tok + OFF);     \
            const f32x4 mr_ = CUR.mr, mk_ = CUR.mk, mv_ = CUR.mv, w0v = CUR.w0, a0v = CUR.a0, kkp = CUR.kk; \
            RW_LERP(rr, g_.rc, g_.rp, mr_); RW_LERP(kk4, g_.kc, g_.kp, mk_); RW_LERP(vv, g_.vc, g_.vp, mv_); \
            float xa[4], xb[4], xk[4], xr[4], gg[4], ge[4]; \
            _Pragma("unroll") for (int e = 0; e < 4; ++e) { \
                  \
                const float l2 = (-0.6065306597126334f * LOG2E) * __builtin_amdgcn_rcpf(1.f + __expf(-(w0v[e] + accd[4 * (rg) + e]))); \
                const float g = scan32(l2); \
                const float a = __builtin_amdgcn_rcpf(1.f + __expf(-(a0v[e] + acca[4 * (rg) + e]))); \
                const float kk = kk4[e] * kkp[e] * inv; \
                const float kt = kk4[e] * (1.f + (a - 1.f) * kap[e]); \
                rho += rr[e] * kt * rkp[e]; \
                const float eg = __builtin_amdgcn_exp2f(g), egp = __builtin_amdgcn_exp2f(g - l2), eng = __builtin_amdgcn_rcpf(eg); \
                xa[e] = -kk * egp; xb[e] = kk * a * eng; xk[e] = kt * eng; xr[e] = rr[e] * eg; gg[e] = g; ge[e] = eg; } \
            if (l31 == 31) { *(LAS f32x4*)(wscr + ch0) = (f32x4){gg[0], gg[1], gg[2], gg[3]}; st_wt16((v4u*)(gp + (cb) * 16 + 4 * (rg)), (v4u){__float_as_uint(ge[0]), __float_as_uint(ge[1]), __float_as_uint(ge[2]), __float_as_uint(ge[3])}); } \
            constexpr int s_ = 2 * (cb) + ((rg) >> 1), vg = 2 * ((rg) & 1); \
            fa[s_][vg] = cvtpk(xa[0], xa[1]); fa[s_][vg + 1] = cvtpk(xa[2], xa[3]); \
            fb[s_][vg] = cvtpk(xb[0], xb[1]); fb[s_][vg + 1] = cvtpk(xb[2], xb[3]); \
            fk[s_][vg] = cvtpk(xk[0], xk[1]); fk[s_][vg + 1] = cvtpk(xk[2], xk[3]); \
            fr[s_][vg] = cvtpk(xr[0], xr[1]); fr[s_][vg + 1] = cvtpk(xr[2], xr[3]); \
            fv[s_][vg] = cvtpk(vv[0], vv[1]); fv[s_][vg + 1] = cvtpk(vv[2], vv[3]); \
            if (((rg) & 1) == 1) { PARK(s_) = fv[s_]; PARK(4 + s_) = fr[s_]; } \
            DEP(fa[s_][vg + 1]); DEP(fb[s_][vg + 1]); DEP(fk[s_][vg + 1]); DEP(fr[s_][vg + 1]); DEP(fv[s_][vg + 1]); DEP(rho); } while (0)
    RW_LOADP(pA, 0);
    { RW_LORA(0) RW_GROUP(0, 0, pA, pB, true); RW_GROUP(0, 1, pB, pA, true); RW_GROUP(0, 2, pA, pB, true); RW_GROUP(0, 3, pB, pA, true); }
    LDS_WAIT(); RW_STAGE_RV(1);
    { RW_LORA(1) asm volatile("s_waitcnt vmcnt(0)" ::: "memory");
      RW_GROUP(1, 0, pA, pB, true); RW_GROUP(1, 1, pB, pA, true); RW_GROUP(1, 2, pA, pB, true); RW_GROUP(1, 3, pB, pA, false); }
#undef RW_STAGE_RV
#undef RW_DMA
#undef RW_LOADG
#undef RW_LOADP
#undef RW_LERP
#undef RW_LORA
#undef RW_GROUP
    LDS_WAIT(); asm volatile("" ::: "memory");
    float EC[2]; EC[0] = __builtin_amdgcn_exp2f(wscr[l31]); EC[1] = __builtin_amdgcn_exp2f(wscr[32 + l31]);
    LDS_WAIT(); asm volatile("" ::: "memory");
    rho = swap32_sum(rho);
    if (hi == 0) __hip_atomic_store((gu32*)(Dm.RHO + (size_t)u * 32 + l31), __float_as_uint(rho), RLX_AGENT);
    v4u idf[2];
    { const int jst = 4 * ((l31 >> 3) & 1) + (l31 & 3); const bool hm = ((l31 >> 2) & 1) == hi; const unsigned one = 0x3F80u << (16 * (jst & 1));
#pragma unroll
      for (int sig = 0; sig < 2; ++sig) { const bool on = hm && ((l31 >> 4) == sig);
#pragma unroll
          for (int q = 0; q < 4; ++q) idf[sig][q] = (on && (jst >> 1) == q) ? one : 0u; } }
    LDS_WAIT();
    v4u Af[2][2], Vf[2][2];
#pragma unroll
    for (int blk = 0; blk < 2; ++blk) {
        f32x16 za = MFMA32(fa[2 * blk], idf[0], f32x16{}); za = MFMA32(fa[2 * blk + 1], idf[1], za);
        f32x16 zv = MFMA32(PARK(2 * blk), idf[0], f32x16{}); zv = MFMA32(PARK(2 * blk + 1), idf[1], zv);
        f32x16 zb = MFMA32(fb[2 * blk], idf[0], f32x16{}); zb = MFMA32(fb[2 * blk + 1], idf[1], zb);
        f32x16 zk = MFMA32(fk[2 * blk], idf[0], f32x16{}); zk = MFMA32(fk[2 * blk + 1], idf[1], zk);
        zb = zb * EC[blk]; zk = zk * EC[blk];
#pragma unroll
        for (int s = 0; s < 2; ++s) { Af[blk][s] = FRAGACC(za, s); Vf[blk][s] = FRAGACC(zv, s); PARK(8 + 2 * blk + s) = FRAGACC(zb, s); PARK(12 + 2 * blk + s) = FRAGACC(zk, s); }
        __builtin_amdgcn_sched_barrier(0);
    }
    f32x16 Aab = f32x16{}, TT = f32x16{}, AakT = f32x16{}, ArbT = f32x16{}, ArkT = f32x16{};
#pragma unroll
    for (int s = 0; s < 4; ++s) { const v4u frs = PARK(4 + s); Aab = MFMA32(fa[s], fb[s], Aab); TT = MFMA32(fb[s], fa[s], TT); AakT = MFMA32(fk[s], fa[s], AakT); ArbT = MFMA32(fb[s], frs, ArbT); ArkT = MFMA32(fk[s], frs, ArkT); }
#pragma unroll
    for (int r = 0; r < 16; ++r) { const int rowi = (r & 3) + 8 * (r >> 2) + 4 * hi;
        Aab[r] = (l31 < rowi) ? Aab[r] : 0.f; TT[r] = (rowi < l31) ? TT[r] : 0.f; AakT[r] = (rowi < l31) ? AakT[r] : 0.f;
        ArbT[r] = (rowi <= l31) ? ArbT[r] : 0.f; ArkT[r] = (rowi <= l31) ? ArkT[r] : 0.f; }
    v4u AakTf[2], ArbTf[2], ArkTf[2];
#pragma unroll
    for (int s = 0; s < 2; ++s) { AakTf[s] = FRAGACC(AakT, s); ArbTf[s] = FRAGACC(ArbT, s); ArkTf[s] = FRAGACC(ArkT, s); }
    __builtin_amdgcn_sched_barrier(0);
    v4u Xf[2], XTf[2], TTf[2];
#pragma unroll
    for (int s = 0; s < 2; ++s) { Xf[s] = FRAGACC(Aab, s); XTf[s] = FRAGACC(TT, s); }
#pragma unroll
    for (int r = 0; r < 16; ++r) { const int rowi = (r & 3) + 8 * (r >> 2) + 4 * hi; TT[r] += (rowi == l31) ? 1.f : 0.f; }
#pragma unroll
    for (int it = 0; it < 4; ++it) {
        f32x16 X2 = MFMA32(XTf[0], Xf[0], f32x16{}); X2 = MFMA32(XTf[1], Xf[1], X2);
        if (it < 3) { f32x16 X2T = MFMA32(Xf[0], XTf[0], f32x16{}); X2T = MFMA32(Xf[1], XTf[1], X2T);
#pragma unroll
            for (int s = 0; s < 2; ++s) XTf[s] = FRAGACC(X2T, s); }
#pragma unroll
        for (int s = 0; s < 2; ++s) { Xf[s] = FRAGACC(X2, s); TTf[s] = FRAGACC(TT, s); }
        TT = MFMA32(Xf[0], TTf[0], TT); TT = MFMA32(Xf[1], TTf[1], TT);
        __builtin_amdgcn_sched_barrier(0);
    }
#pragma unroll
    for (int s = 0; s < 2; ++s) TTf[s] = FRAGACC(TT, s);
    v4u Wf[2][2], Uf[2][2];
#pragma unroll
    for (int blk = 0; blk < 2; ++blk) {
        f32x16 av = MFMA32(AakTf[0], Vf[blk][0], f32x16{}); av = MFMA32(AakTf[1], Vf[blk][1], av);
        const v4u avf0 = FRAGACC(av, 0), avf1 = FRAGACC(av, 1);
        f32x16 uu = MFMA32(TTf[0], avf0, f32x16{}); uu = MFMA32(TTf[1], avf1, uu);
        f32x16 ww = MFMA32(TTf[0], Af[blk][0], f32x16{}); ww = MFMA32(TTf[1], Af[blk][1], ww);
#pragma unroll
        for (int s = 0; s < 2; ++s) { Wf[blk][s] = FRAGACC(ww, s); Uf[blk][s] = FRAGACC(uu, s); }
        __builtin_amdgcn_sched_barrier(0);
    }
    v4u* QFp = Dm.QF + (size_t)u * 256 + lane; v4u* YDp = Dm.YD + (size_t)u * 256 + lane;
#pragma unroll
    for (int blk = 0; blk < 2; ++blk) {
        f32x16 q;
#pragma unroll
        for (int s = 0; s < 2; ++s)
            { const v4u frs = PARK(4 + 2 * blk + s);
#pragma unroll
              for (int j = 0; j < 4; ++j) { q[8 * s + 2 * j] = bflo(frs[j]); q[8 * s + 2 * j + 1] = bfhi(frs[j]); } }
        q = MFMA32(Wf[blk][0], ArbTf[0], q); q = MFMA32(Wf[blk][1], ArbTf[1], q);
        st_wt16(QFp + (2 * blk) * 64, FRAGACC(q, 0)); st_wt16(QFp + (2 * blk + 1) * 64, FRAGACC(q, 1));
        f32x16 y = MFMA32(Uf[blk][0], ArbTf[0], f32x16{}); y = MFMA32(Uf[blk][1], ArbTf[1], y); y = MFMA32(Vf[blk][0], ArkTf[0], y); y = MFMA32(Vf[blk][1], ArkTf[1], y);
        st_wt16(YDp + (2 * blk) * 64, FRAGACC(y, 0)); st_wt16(YDp + (2 * blk + 1) * 64, FRAGACC(y, 1));
        __builtin_amdgcn_sched_barrier(0);
    }
    v4u* PFp = Dm.PF + (size_t)u * 512 + lane; v4u* DDp = Dm.DD + (size_t)u * 512 + lane;
#pragma unroll
    for (int c1 = 0; c1 < 2; ++c1)
#pragma unroll
        for (int cb = 0; cb < 2; ++cb) {
            f32x16 p = MFMA32(Wf[c1][0], PARK(8 + 2 * cb), f32x16{}); p = MFMA32(Wf[c1][1], PARK(8 + 2 * cb + 1), p);
            st_wt16(PFp + (cb * 4 + 2 * c1) * 64, FRAGACC(p, 0)); st_wt16(PFp + (cb * 4 + 2 * c1 + 1) * 64, FRAGACC(p, 1));
            __builtin_amdgcn_sched_barrier(0);
        }
#pragma unroll
    for (int cb = 0; cb < 2; ++cb)
#pragma unroll
        for (int ib = 0; ib < 2; ++ib) {
            f32x16 d = MFMA32(PARK(8 + 2 * cb), Uf[ib][0], f32x16{}); d = MFMA32(PARK(8 + 2 * cb + 1), Uf[ib][1], d); d = MFMA32(PARK(12 + 2 * cb), Vf[ib][0], d); d = MFMA32(PARK(12 + 2 * cb + 1), Vf[ib][1], d);
            st_wt16(DDp + ((cb * 2 + ib) * 2) * 64, FRAGACC(d, 0)); st_wt16(DDp + ((cb * 2 + ib) * 2 + 1) * 64, FRAGACC(d, 1));
            __builtin_amdgcn_sched_barrier(0);
        }
}

#undef PARK
#undef DEP
constexpr int RB_PF = 0, RB_DD = 8192, RB_QF = 16384, RB_YD = 20480, RB_GAM = 24576, RB_BUF = 24832, RB_NB = 4, RB_STAT = RB_NB * RB_BUF, RB_Y = RB_STAT + 1024;
__device__ __forceinline__ void unpack16(const v4u a, const v4u b, f32x16& o) {
#pragma unroll
    for (int j = 0; j < 4; ++j) { o[2 * j] = bflo(a[j]); o[2 * j + 1] = bfhi(a[j]); o[8 + 2 * j] = bflo(b[j]); o[8 + 2 * j + 1] = bfhi(b[j]); }
}
constexpr int RW_SPLIT = T / 32, CW_DONE = 16384;
__device__ __forceinline__ void rw_wait_chunk(Frame& F, int ci) {
    unsigned spins = 0;
#pragma unroll 1
    for (int j = 7; j >= 0; --j) { gu32* c = F.ctl + CW_DONE + 64 * (ci + j);
        while ((unsigned)__builtin_amdgcn_readfirstlane(__hip_atomic_load(c, RLX_AGENT)) < (unsigned)BATCH) { __builtin_amdgcn_s_sleep(8); if (++spins > (1u << 22)) break; } }
    __builtin_amdgcn_fence(__ATOMIC_ACQUIRE, "agent");
}
__device__ __forceinline__ void rw_publish_chunk(Frame& F, int ci) {
    asm volatile("s_waitcnt vmcnt(0)" ::: "memory");
    __syncthreads();
    if (F.wave == 0 && mk_lane() == 0) {
        __hip_atomic_fetch_add(F.ctl + CW_DONE + 64 * ci, 1u, RLX_AGENT);
    }
}
#ifndef RB_AUX
#define RB_AUX 2
#endif
struct RbStage { v4u p[2], d[2], q, y, g; };
struct RbEpi { v4u vc, vp, ga; float rho; };
__device__ __forceinline__ void rwkvB_unit(Frame& F, const RwDump& Dm, int bh) {
    int lane = mk_lane(); asm volatile("" : "+v"(lane));
    const int wid = F.wave, tid = wid * 64 + lane, hi = lane >> 5, l31 = lane & 31, b = bh >> 3, h = bh & 7;
    LAS unsigned char* lds = F.lds + RING_OFF;
    constexpr int NS = T / 32;
    LAS float* stat = (LAS float*)(lds + RB_STAT);
    LAS float* ybuf = (LAS float*)(lds + RB_Y);
    const int stid = tid - 128;
    const bool st_p2 = wid < 4, st_q = wid < 6, st_y = wid >= 4;
#define ST_LOAD(X, ci_) do { { if ((ci_) >= RW_SPLIT && (ci_) < NS && (((ci_) - RW_SPLIT) & 7) == 0) rw_wait_chunk(F, (ci_)); const size_t u_ = (size_t)((ci_) < NS ? (ci_) : NS - 1) * (BATCH * RH) + bh; \
        X.p[0] = __builtin_nontemporal_load((const GAS v4u*)(Dm.PF + u_ * 512 + stid)); X.d[0] = __builtin_nontemporal_load((const GAS v4u*)(Dm.DD + u_ * 512 + stid)); \
        if (st_p2) { X.p[1] = __builtin_nontemporal_load((const GAS v4u*)(Dm.PF + u_ * 512 + 384 + stid)); X.d[1] = __builtin_nontemporal_load((const GAS v4u*)(Dm.DD + u_ * 512 + 384 + stid)); } \
        if (st_q) X.q = __builtin_nontemporal_load((const GAS v4u*)(Dm.QF + u_ * 256 + stid)); \
        if (st_y) X.y = __builtin_nontemporal_load((const GAS v4u*)(Dm.YD + u_ * 256 + (stid - 128))); \
        if (stid < 16) X.g = *(const GAS v4u*)((const v4u*)(Dm.GAM + u_ * 64) + stid); } } while (0)
#define ST_STORE(X, buf_) do { LAS unsigned char* b_ = lds + (buf_) * RB_BUF; \
        *(LAS v4u*)(b_ + RB_PF + stid * 16) = X.p[0]; *(LAS v4u*)(b_ + RB_DD + stid * 16) = X.d[0]; \
        if (st_p2) { *(LAS v4u*)(b_ + RB_PF + (384 + stid) * 16) = X.p[1]; *(LAS v4u*)(b_ + RB_DD + (384 + stid) * 16) = X.d[1]; } \
        if (st_q) *(LAS v4u*)(b_ + RB_QF + stid * 16) = X.q; \
        if (st_y) *(LAS v4u*)(b_ + RB_YD + (stid - 128) * 16) = X.y; \
        if (stid < 16) *(LAS v4u*)(b_ + RB_GAM + stid * 16) = X.g; } while (0)
    const int ew = (wid & 1) + 2 * ((wid >> 2) & 1), eidx = ew * 64 + lane, etok = eidx >> 3, ep = eidx & 7;
    const bf16* epc = F.PROJ + (size_t)b * T * NP + h * 64 + 8 * ep;
#define EP_LOAD(X, cj_) do { { const int cc_ = (cj_) < NS ? (cj_) : NS - 1, tt_ = cc_ * 32 + etok; const bf16* pc_ = epc + (size_t)tt_ * NP; const bf16* pp_ = epc + (size_t)(tt_ > 0 ? tt_ - 1 : 0) * NP; \
        X.vc = *(const GAS v4u*)(pc_ + C_V); X.vp = *(const GAS v4u*)(pp_ + C_V); X.ga = *(const GAS v4u*)(pc_ + C_GA); \
        X.rho = Dm.RHO[((size_t)cc_ * (BATCH * RH) + bh) * 32 + etok]; } } while (0)
#define EP_RUN(X, cj_) do { const int par_ = (cj_) & 1; \
        const float s1_ = stat[((par_ * 2 + 0) * 32 + etok) * 2] + stat[((par_ * 2 + 1) * 32 + etok) * 2], s2_ = stat[((par_ * 2 + 0) * 32 + etok) * 2 + 1] + stat[((par_ * 2 + 1) * 32 + etok) * 2 + 1]; \
        const float mean_ = s1_ * (1.f / 64.f), var_ = fmaxf(s2_ * (1.f / 64.f) - mean_ * mean_, 0.f), rstd_ = __builtin_amdgcn_rsqf(var_ + 64e-5f); \
        const int tt_ = (cj_) * 32 + etok; const size_t mm_ = (size_t)b * T + tt_; const float pm_ = tt_ > 0 ? 1.f : 0.f; \
        const LAS float* yb_ = ybuf + (par_ * 2 + (ep >> 2)) * 1024 + 4 * (ep & 3) * 64 + etok; \
        float o_[8]; \
        _Pragma("unroll") for (int j = 0; j < 8; ++j) { const unsigned vcw_ = X.vc[j >> 1], vpw_ = X.vp[j >> 1], gaw_ = X.ga[j >> 1]; \
            const float vc_ = (j & 1) ? bfhi(vcw_) : bflo(vcw_), vp_ = (j & 1) ? bfhi(vpw_) : bflo(vpw_), g_ = (j & 1) ? bfhi(gaw_) : bflo(gaw_); \
            const float vv_ = vc_ + (vp_ * pm_ - vc_) * emu[j >> 2][j & 3]; \
            const float yn_ = (yb_[(j & 3) * 64 + (j >> 2) * 32] - mean_) * rstd_ * elw[j >> 2][j & 3] + elb[j >> 2][j & 3] + X.rho * vv_; o_[j] = yn_ * g_ * __builtin_amdgcn_rcpf(1.f + __expf(-g_)); } \
        *(GAS v4u*)(F.MIX + mm_ * D + h * 64 + 8 * ep) = (v4u){cvtpk(o_[0], o_[1]), cvtpk(o_[2], o_[3]), cvtpk(o_[4], o_[5]), cvtpk(o_[6], o_[7])}; } while (0)
    f32x16 S[2]; S[0] = f32x16{}; S[1] = f32x16{};
    const int ib = wid & 1;
#define CONS(ci_) do { const LAS unsigned char* bb = lds + ((ci_) & (RB_NB - 1)) * RB_BUF; \
          \
        v4u pf_[8], qf_[4], dd_[4], yd_[2]; f32x4 gm_[8]; \
        _Pragma("unroll") for (int q = 0; q < 8; ++q) gm_[q] = *(const LAS f32x4*)(bb + RB_GAM + (hi * 32 + 4 * q) * 4); \
        _Pragma("unroll") for (int q = 0; q < 4; ++q) dd_[q] = *(const LAS v4u*)(bb + RB_DD + ((((q >> 1) * 2 + ib) * 2 + (q & 1)) * 64 + lane) * 16); \
        _Pragma("unroll") for (int q = 0; q < 8; ++q) pf_[q] = *(const LAS v4u*)(bb + RB_PF + (q * 64 + lane) * 16); \
        _Pragma("unroll") for (int q = 0; q < 2; ++q) yd_[q] = *(const LAS v4u*)(bb + RB_YD + ((2 * ib + q) * 64 + lane) * 16); \
        _Pragma("unroll") for (int q = 0; q < 4; ++q) qf_[q] = *(const LAS v4u*)(bb + RB_QF + (q * 64 + lane) * 16); \
        __builtin_amdgcn_sched_barrier(0); \
        v4u Sf[4]; _Pragma("unroll") for (int s = 0; s < 4; ++s) Sf[s] = FRAGACC(S[s >> 1], s & 1); \
        _Pragma("unroll") for (int rb = 0; rb < 2; ++rb) { \
            f32x16 acc; unpack16(dd_[2 * rb], dd_[2 * rb + 1], acc); \
            _Pragma("unroll") for (int q = 0; q < 4; ++q) { const f32x4 gv = gm_[4 * rb + q]; _Pragma("unroll") for (int e = 0; e < 4; ++e) acc[4 * q + e] += gv[e] * S[rb][4 * q + e]; } \
            _Pragma("unroll") for (int s = 0; s < 4; ++s) acc = MFMA32(pf_[rb * 4 + s], Sf[s], acc); \
            S[rb] = acc; } \
        f32x16 y; unpack16(yd_[0], yd_[1], y); \
        _Pragma("unroll") for (int s = 0; s < 4; ++s) y = MFMA32(Sf[s], qf_[s], y); \
        float s1 = 0.f, s2 = 0.f; LAS float* yb_ = ybuf + (((ci_) & 1) * 2 + ib) * 1024 + lane; \
        _Pragma("unroll") for (int r = 0; r < 16; ++r) { s1 += y[r]; s2 += y[r] * y[r]; yb_[r * 64] = y[r]; } \
        s1 = swap32_sum(s1); s2 = swap32_sum(s2); \
        if (hi == 0) { stat[((((ci_) & 1) * 2 + ib) * 32 + l31) * 2] = s1; stat[((((ci_) & 1) * 2 + ib) * 32 + l31) * 2 + 1] = s2; } } while (0)
#define RB_BAR() do { asm volatile("s_waitcnt lgkmcnt(0)" ::: "memory"); __builtin_amdgcn_s_barrier(); asm volatile("" ::: "memory"); } while (0)
    if (wid < 2) {
        __builtin_amdgcn_s_setprio(2);
        RB_BAR();
#pragma unroll 1
        for (int k = 0; k < NS; ++k) { CONS(k); RB_BAR(); }
        RB_BAR();
        __builtin_amdgcn_s_setprio(0);
    } else if (wid == 4 || wid == 5) {
        const GAS v4u* gA = (const GAS v4u*)(wid == 4 ? Dm.PF : Dm.DD) + lane; const GAS v4u* gB = (const GAS v4u*)(wid == 4 ? Dm.QF : Dm.YD) + lane;
        const int oA = wid == 4 ? RB_PF : RB_DD, oB = wid == 4 ? RB_QF : RB_YD;
#define LD_ISSUE(ci_) do { const size_t u_ = (size_t)((ci_) < NS ? (ci_) : NS - 1) * (BATCH * RH) + bh; LAS unsigned char* b_ = lds + ((ci_) & (RB_NB - 1)) * RB_BUF; \
        _Pragma("unroll") for (int q = 0; q < 8; ++q) __builtin_amdgcn_global_load_lds((const unsigned*)(gA + u_ * 512 + q * 64), (LAS unsigned*)(b_ + oA + q * 1024), 16, 0, RB_AUX); \
        _Pragma("unroll") for (int q = 0; q < 4; ++q) __builtin_amdgcn_global_load_lds((const unsigned*)(gB + u_ * 256 + q * 64), (LAS unsigned*)(b_ + oB + q * 1024), 16, 0, RB_AUX); \
        if (lane < 16) __builtin_amdgcn_global_load_lds((const unsigned*)((const GAS v4u*)(Dm.GAM + u_ * 64) + lane), (LAS unsigned*)(b_ + RB_GAM), 16, 0, 0); } while (0)
        LD_ISSUE(0); LD_ISSUE(1); LD_ISSUE(2);
        asm volatile("s_waitcnt vmcnt(26)" ::: "memory");
        RB_BAR();
#pragma unroll 1
        for (int k = 0; k < NS; ++k) { LD_ISSUE(k + 3); asm volatile("s_waitcnt vmcnt(26)" ::: "memory"); RB_BAR(); }
        asm volatile("s_waitcnt vmcnt(0)" ::: "memory");
        RB_BAR();
#undef LD_ISSUE
    } else {
        RbEpi eA, eB, eC; f32x4 emu[2], elw[2], elb[2];
#pragma unroll
        for (int rg = 0; rg < 2; ++rg) { const int hc_ = h * 64 + 8 * ep + 4 * rg; emu[rg] = *(const GAS f32x4*)(F.shift_mu + 1024 + hc_); elw[rg] = *(const GAS f32x4*)(F.ln_w + hc_); elb[rg] = *(const GAS f32x4*)(F.ln_b + hc_); }
        EP_LOAD(eA, 0); EP_LOAD(eB, 1);
        RB_BAR();
        EP_LOAD(eC, 2); RB_BAR();
#define HY_STEP(k_, EP) do { EP_RUN(EP, (k_) - 1); EP_LOAD(EP, (k_) + 2); RB_BAR(); } while (0)
#pragma unroll 1
        for (int k = 1; k < NS; k += 3) { HY_STEP(k, eA); HY_STEP(k + 1, eB); HY_STEP(k + 2, eC); }
        EP_RUN(eA, NS - 1);
        RB_BAR();
#undef HY_STEP
    }
#undef RB_BAR
#undef ST_LOAD
#undef ST_STORE
#undef EP_LOAD
#undef EP_RUN
#undef CONS
}
constexpr int CW_G17 = 12288;
struct OneUnit { int pm, pn;
    __device__ __forceinline__ bool next(int i, pg8::Unit& u) const { if (i != 0) return false; u.pm = pm; u.pn = pn; return true; }
    __device__ __forceinline__ void a_ready(const pg8::Unit&) const {}
    __device__ __forceinline__ void done(const pg8::Unit&) const {} };
constexpr int AT_OUT = 65536, AT_G0 = 114688, AT_G1 = LDSCTL_OFF + 1024;
constexpr int AT_KB = 64 * 256, AT_VB = 64 * 256, AT_BUF = AT_KB + AT_VB, AT_QOFF = 2 * AT_KB + 3 * AT_VB;
__device__ __forceinline__ s16x4 vtr(const LAS unsigned char* p) { typedef short v4i16_t __attribute__((ext_vector_type(4))); return __builtin_bit_cast(s16x4, __builtin_amdgcn_ds_read_tr16_b64_v4i16((LAS v4i16_t*)p)); }
__device__ __forceinline__ void glds16_asm(const void* gsrc, unsigned lds_dst) {
    unsigned keep; const unsigned d_ = __builtin_amdgcn_readfirstlane(lds_dst);
    asm volatile("s_mov_b32 %0, m0\n\ts_mov_b32 m0, %2\n\ts_nop 0\n\tglobal_load_lds_dwordx4 %1, off\n\ts_mov_b32 m0, %0" : "=&s"(keep) : "v"(gsrc), "s"(d_) : "memory");
}
__device__ __forceinline__ void attn_unit(Frame& F, int b, int h, int qb) {
    int lane = mk_lane(); asm volatile("" : "+v"(lane));
    const int wid = F.wave, tid = wid * 64 + lane, l31 = lane & 31, hi = lane >> 5, map = wid >> 2, qs = wid & 3;
    LAS unsigned char* lds = F.lds + RING_OFF;
    const float slope2 = exp2f(-2.f * (float)(h + 1)) * LOG2E, shift2 = __uint_as_float(F.MISC[15]);
    const int q0 = qb * 128, qrow = q0 + 32 * qs + l31;
    const size_t mrow = (size_t)b * T + qrow;
    LAS bf16x8* qpark = (LAS bf16x8*)(lds + AT_QOFF + wid * 4096) + lane;
    { const bf16* qp = F.PROJ + mrow * NP + C_DQ + h * 128 + map * 64 + 8 * hi;
      v4u qraw[4]; float ss = 0.f;
#pragma unroll
      for (int s = 0; s < 4; ++s) qraw[s] = *(const GAS v4u*)(qp + 16 * s);
#pragma unroll
      for (int s = 0; s < 4; ++s)
#pragma unroll
          for (int j = 0; j < 4; ++j) { const float a_ = bflo(qraw[s][j]), b_ = bfhi(qraw[s][j]); ss += a_ * a_ + b_ * b_; }
      ss = swap32_sum(ss);
      const float rq = __builtin_amdgcn_rsqf(ss * (1.f / 64.f) + 1e-6f) * C2;
#pragma unroll
      for (int s = 0; s < 4; ++s) { const f32x4 g0 = *(const GAS f32x4*)(F.qn_g + 8 * hi + 16 * s), g1 = *(const GAS f32x4*)(F.qn_g + 8 * hi + 16 * s + 4);
          v4u w_; w_.x = cvtpk2(bflo(qraw[s].x) * rq * g0.x, bfhi(qraw[s].x) * rq * g0.y); w_.y = cvtpk2(bflo(qraw[s].y) * rq * g0.z, bfhi(qraw[s].y) * rq * g0.w);
          w_.z = cvtpk2(bflo(qraw[s].z) * rq * g1.x, bfhi(qraw[s].z) * rq * g1.y); w_.w = cvtpk2(bflo(qraw[s].w) * rq * g1.z, bfhi(qraw[s].w) * rq * g1.w);
          *(LAS v4u*)(qpark + s * 64) = w_; } }
    const bf16* kg = F.PROJ + (size_t)b * T * NP + C_DK + h * 128;
    const bf16* vg = F.PROJ + (size_t)b * T * NP + C_DV + h * 128;
    const int NT = 2 * qb + 2, tl = 2 * qb + (qs >> 1);
    const int Wk = (int)__builtin_ceilf((2.f * shift2 + 32.2f) / slope2);
    const int tf = __builtin_amdgcn_readfirstlane(max(0, (qb * 128 - Wk) >> 6));
    constexpr int AT_V0 = 2 * AT_KB;
    const int drow0 = 4 * wid + (lane >> 4), drow1 = drow0 + 32, dch = lane & 15;
    const unsigned ksrc0 = (unsigned)(drow0 * NP + ((dch ^ (drow0 & 15)) * 8)), ksrc1 = (unsigned)(drow1 * NP + ((dch ^ (drow1 & 15)) * 8));
    const unsigned vsrc0 = (unsigned)(drow0 * NP + ((dch ^ ((drow0 & 3) << 2)) * 8)), vsrc1 = (unsigned)(drow1 * NP + ((dch ^ ((drow1 & 3) << 2)) * 8));
#define AT_DMA(t_, kb_, v3_) do { const size_t tb_ = (size_t)(64 * (t_)) * NP; const unsigned bk_ = (unsigned)(size_t)(lds + (kb_) * AT_KB + wid * 1024), bv_ = (unsigned)(size_t)(lds + AT_V0 + (v3_) * AT_VB + wid * 1024); \
        glds16_asm(kg + tb_ + ksrc0, bk_); glds16_asm(kg + tb_ + ksrc1, bk_ + 8192u); glds16_asm(vg + tb_ + vsrc0, bv_); glds16_asm(vg + tb_ + vsrc1, bv_ + 8192u); } while (0)
#define AT_LAND() asm volatile("s_waitcnt vmcnt(0)" ::: "memory")
    f32x16 o[4];
#pragma unroll
    for (int vb = 0; vb < 4; ++vb) o[vb] = f32x16{};
    float lsum = 0.f;
    AT_DMA(tf, tf & 1, tf % 3);
    { const int gr_ = 16 * wid + (lane >> 4); const bf16* gsrc = F.PROJ + ((size_t)b * T + q0 + gr_) * NP + C_GB + h * 128;
      LAS unsigned char* gdst = F.lds + (wid < 4 ? AT_G0 + wid * 4096 : AT_G1 + (wid - 4) * 4096);
#pragma unroll
      for (int j = 0; j < 4; ++j) __builtin_amdgcn_global_load_lds((const unsigned*)(gsrc + (size_t)(4 * j) * NP + (((lane & 15) ^ (4 * j + (lane >> 4))) * 8)), (LAS unsigned*)(gdst + j * 1024), 16, 0, 0); }
    AT_LAND(); __syncthreads();
    const int G = lane >> 4, qq = (lane & 15) >> 2, pp = lane & 3;
    const int vrow = (4 * hi + qq) * 256 + 8 * (pp & 1), vch = 2 * (G & 1) + (pp >> 1);
    v4u pw[4];
#define SBAR_() __builtin_amdgcn_sched_barrier(0)
#define AT_QK(t) do { \
            const LAS unsigned char* Kb = lds + ((t) & 1) * AT_KB; \
            float sl_ = slope2; asm volatile("" : "+v"(sl_));     \
            const float base = sl_ * (float)(64 * (t) + 4 * hi - qrow) - shift2; \
            float ls = 0.f; \
            _Pragma("unroll") for (int hf = 0; hf < 2; ++hf) {        \
                f32x16 p; \
                _Pragma("unroll") for (int r = 0; r < 16; ++r) p[r] = __builtin_fmaf(sl_, (float)(32 * hf + (r & 3) + 8 * (r >> 2)), base); \
                _Pragma("unroll") for (int s = 0; s < 4; ++s) { \
                    const bf16x8 a0 = *(const LAS bf16x8*)(Kb + (32 * hf + l31) * 256 + (((map * 8 + 2 * s + hi) ^ (l31 & 15)) * 16)); \
                    p = __builtin_amdgcn_mfma_f32_32x32x16_bf16(a0, qpark[s * 64], p, 0, 0, 0); } \
                if ((t) == tl) { \
                    _Pragma("unroll") for (int r = 0; r < 16; ++r) { const int ki = 64 * (t) + 32 * hf + 4 * hi + (r & 3) + 8 * (r >> 2); if (ki > qrow) p[r] = -1e30f; } } \
                _Pragma("unroll") for (int r = 0; r < 16; ++r) { p[r] = __builtin_amdgcn_exp2f(p[r]); ls += p[r]; } \
                pw[2 * hf] = (v4u){cvtpk(p[0], p[1]), cvtpk(p[2], p[3]), cvtpk(p[4], p[5]), cvtpk(p[6], p[7])}; \
                pw[2 * hf + 1] = (v4u){cvtpk(p[8], p[9]), cvtpk(p[10], p[11]), cvtpk(p[12], p[13]), cvtpk(p[14], p[15])}; } \
            lsum += ls; } while (0)
#define AT_VRD(dst, ks, vb0) do { _Pragma("unroll") for (int vb = (vb0); vb < (vb0) + 2; ++vb) { const LAS unsigned char* a_ = Vb + vrow + ((4 * vb + vch) ^ (qq << 2)) * 16 + (32 * ((ks) >> 1) + 16 * ((ks) & 1)) * 256; \
        dst[2 * (vb - (vb0))] = vtr(a_); dst[2 * (vb - (vb0)) + 1] = vtr(a_ + 8 * 256); } } while (0)
#define AT_PV(src, pwk, vb0) do { _Pragma("unroll") for (int vb = (vb0); vb < (vb0) + 2; ++vb) { const int j_ = 2 * (vb - (vb0)); \
        const bf16x8 vf = (bf16x8){src[j_][0], src[j_][1], src[j_][2], src[j_][3], src[j_ + 1][0], src[j_ + 1][1], src[j_ + 1][2], src[j_ + 1][3]}; \
        o[vb] = __builtin_amdgcn_mfma_f32_32x32x16_bf16(vf, __builtin_bit_cast(bf16x8, pwk), o[vb], 0, 0, 0); } } while (0)
#define AT_PVV(v3_) do { const LAS unsigned char* Vb = lds + AT_V0 + (v3_) * AT_VB; s16x4 vA[4], vB[4]; \
            AT_VRD(vA, 0, 0); SBAR_(); AT_VRD(vB, 0, 2); SBAR_(); \
            AT_PV(vA, pw[0], 0); SBAR_(); AT_VRD(vA, 1, 0); SBAR_(); AT_PV(vB, pw[0], 2); SBAR_(); AT_VRD(vB, 1, 2); SBAR_(); \
            AT_PV(vA, pw[1], 0); SBAR_(); AT_VRD(vA, 2, 0); SBAR_(); AT_PV(vB, pw[1], 2); SBAR_(); AT_VRD(vB, 2, 2); SBAR_(); \
            AT_PV(vA, pw[2], 0); SBAR_(); AT_VRD(vA, 3, 0); SBAR_(); AT_PV(vB, pw[2], 2); SBAR_(); AT_VRD(vB, 3, 2); SBAR_(); \
            AT_PV(vA, pw[3], 0); SBAR_(); AT_PV(vB, pw[3], 2); } while (0)
    if (map == 0) {
        int v3 = tf % 3;
#pragma unroll 1
        for (int t = tf; t < NT; ++t) { const int vn = v3 == 2 ? 0 : v3 + 1;
            if (t + 1 < NT) AT_DMA(t + 1, (t + 1) & 1, vn);
            if (t <= tl) { AT_QK(t); AT_PVV(v3); }
            AT_LAND(); __syncthreads(); v3 = vn; }
    } else {
        int v3 = tf % 3;
        __builtin_amdgcn_s_setprio(1);
#pragma unroll 1
        for (int t = tf; t < NT; ++t) { const int vp = v3 == 0 ? 2 : v3 - 1, vn = v3 == 2 ? 0 : v3 + 1;
            if (t + 1 < NT) AT_DMA(t + 1, (t + 1) & 1, vn);
            if (t > tf && t - 1 <= tl) AT_PVV(vp);
            if (t <= tl) AT_QK(t);
            AT_LAND(); __syncthreads(); v3 = vn; }
        if (NT - 1 <= tl) { const int vp = v3 == 0 ? 2 : v3 - 1; AT_PVV(vp); }
        __builtin_amdgcn_s_setprio(0);
    }
#undef AT_PVV
#undef AT_QK
#undef AT_VRD
#undef AT_PV
#undef SBAR_
#undef AT_DMA
#undef AT_LAND
    __syncthreads();
    const float ltot = swap32_sum(lsum);
    LAS float* X = (LAS float*)lds;
    if (map == 1) {
        const float sc = __uint_as_float(F.MISC[14]) / ltot;
#pragma unroll
        for (int vb = 0; vb < 4; ++vb)
#pragma unroll
            for (int r = 0; r < 16; ++r) X[(qs * 64 + vb * 16 + r) * 64 + lane] = o[vb][r] * sc;
    }
    __syncthreads();
    if (map == 0) {
        const float il = 1.f / ltot; float ss = 0.f;
#pragma unroll
        for (int vb = 0; vb < 4; ++vb)
#pragma unroll
            for (int r = 0; r < 16; ++r) { const float v = o[vb][r] * il - X[(qs * 64 + vb * 16 + r) * 64 + lane]; o[vb][r] = v; ss += v * v; }
        ss = swap32_sum(ss);
        const float rn = (1.f / sqrtf(ss * (1.f / 128.f) + 1e-5f)) * (1.f - LAMBDA_INIT);
        int etok = 0; asm volatile("" : "+v"(etok));
        const int lane_e = mk_lane(), hi = lane_e >> 5, row = 32 * qs + (lane_e & 31);
        const LAS unsigned char* grow = F.lds + (qs < 2 ? AT_G0 : AT_G1 - 64 * 256) + row * 256 + 8 * hi;
        LAS unsigned char* orow = lds + AT_OUT + row * 256 + 8 * hi;
#pragma unroll
        for (int vb = 0; vb < 4; ++vb)
#pragma unroll
            for (int rg = 0; rg < 4; ++rg) {
                const int vc = 32 * vb + 8 * rg + 4 * hi, ch = (((4 * vb + rg) ^ (row & 15)) * 16) + etok;
                const v2u gw = *(const LAS v2u*)(grow + ch); const f32x4 sg = *(const GAS f32x4*)(F.subln_g + vc);
                const float g4[4] = {bflo(gw.x), bfhi(gw.x), bflo(gw.y), bfhi(gw.y)}; float ov[4];
#pragma unroll
                for (int e = 0; e < 4; ++e) ov[e] = o[vb][4 * rg + e] * rn * sg[e] * g4[e] / (1.f + __expf(-g4[e]));
                const unsigned w1_ = cvtpk(ov[2], ov[3]);
                *(LAS v2u*)(orow + ch) = (v2u){cvtpk(ov[0], ov[1]), w1_};
                if (rg == 3) asm volatile("" : "+v"(etok) : "v"(w1_));
            }
    }
    __syncthreads();
    { const int t_ = wid * 64 + mk_lane(); bf16* ob = F.MIX + ((size_t)b * T + q0) * D + 512 + h * 128;
#pragma unroll
      for (int i = 0; i < 4; ++i) { const int pc = t_ + 512 * i, r_ = pc >> 4, c_ = pc & 15;
          *(GAS v4u*)(ob + (size_t)r_ * D + c_ * 8) = *(const LAS v4u*)(lds + AT_OUT + r_ * 256 + ((c_ ^ (r_ & 15)) * 16)); } }
    __syncthreads();
}
#ifndef DBL
#define DBL 0
#endif
constexpr int CW_QUEUE = 8192;
constexpr int QX_RW = 8, QX_A2 = 0, QX_AT = 64, QX_ALL = QX_RW + QX_A2 + QX_AT;
template <int MODE = 0> __device__ __forceinline__ void p3_queue(Frame& F, const RwDump& Dm, const int qbase = CW_QUEUE) {
    const int ql = mk_lane();
    const float l1 = wave_sum(F.lq1[ql] * F.lk1[ql]), l2 = wave_sum(F.lq2[ql] * F.lk2[ql]);
    const float lam = __uint_as_float(__builtin_amdgcn_readfirstlane(__float_as_uint(__expf(l1) - __expf(l2) + LAMBDA_INIT)));
    float gq = fabsf(F.qn_g[ql]), gk = fabsf(F.kn_g[ql]);
#pragma unroll
    for (int o = 1; o < 64; o <<= 1) { gq = fmaxf(gq, __shfl_xor(gq, o)); gk = fmaxf(gk, __shfl_xor(gk, o)); }
    const float shift2 = __uint_as_float(__builtin_amdgcn_readfirstlane(__float_as_uint(8.f * gq * gk * LOG2E)));
    if (F.wave == 0 && mk_lane() == 0) { F.MISC[14] = __float_as_uint(lam); F.MISC[15] = __float_as_uint(shift2); }
    __syncthreads();
#ifdef Q_BLK
    const int x0 = (int)(blockIdx.x & 7);
#else
    const int x0 = (int)(xb_xcc_id() & 7u);
#endif
#pragma unroll 1
    for (int dx = 0; dx < 8; ++dx) {
        const int xq = (x0 + dx) & 7;
        for (;;) {
            if (F.wave == 0 && mk_lane() == 0) F.MISC[12] = __hip_atomic_fetch_add(F.ctl + qbase + 64 * xq, 1u, RLX_AGENT);
            __syncthreads();
            int item = __builtin_amdgcn_readfirstlane((int)F.MISC[12]); if (MODE == 2) item += QX_RW;
            __syncthreads();
            if (item >= (MODE == 1 ? QX_RW : QX_ALL)) break;
            if (item < QX_RW) { rwkvB_unit(F, Dm, xq * 8 + item); if (DBL & 64) rwkvB_unit(F, Dm, xq * 8 + item); }
            else { const int idx = item - QX_RW - QX_A2, h = 3 - (idx >> 4), qb = 15 - (idx & 15);
#pragma unroll 1
#ifndef NO_ATT
                for (int rep = 0; rep < ((DBL & 32) ? 2 : 1); ++rep) attn_unit(F, xq, h, qb);
#endif
            }
        }
    }
}

constexpr int GT_STAGE = 24576, GT_NS = 5, GT_NK = D / 64;
__device__ __forceinline__ void gemm1_tail_unit(Frame& F, int qu) {
    int lane = mk_lane(); asm volatile("" : "+v"(lane));
    const int wid = F.wave, l31 = lane & 31, hi = lane >> 5, wm = wid >> 2, wn = wid & 3;
    const int xcd = qu & 7, j = qu >> 3, R0 = (8 * xcd + (j & 7)) * 256 + (j >> 3) * 64, C0 = 4096;
    LAS unsigned char* lds = F.lds + RING_OFF;
    const int vr0 = 24 * wid + (lane >> 3), cp = lane & 7;
#define GT_ISSUE(kc_) do { LAS unsigned char* sb_ = lds + ((kc_) % GT_NS) * GT_STAGE + wid * 3072; \
        _Pragma("unroll") for (int i = 0; i < 3; ++i) { const int v_ = vr0 + 8 * i; \
            const bf16* src_ = (3 * wid + i < 8 ? F.XN + (size_t)(R0 + v_) * D : F.WinT + (size_t)(C0 + v_ - 64) * D) + (kc_) * 64 + ((cp ^ ((v_ >> 1) & 7)) * 8); \
            __builtin_amdgcn_global_load_lds((const unsigned*)src_, (LAS unsigned*)(sb_ + i * 1024), 16, 0, 0); } } while (0)
    f32x16 acc0 = f32x16{};
    const int rX = 32 * wm + l31, nW = 32 * wn + l31, offX = rX * 128, offW = 8192 + nW * 128, kyX = (rX >> 1) & 7, kyW = (nW >> 1) & 7;
    GT_ISSUE(0); GT_ISSUE(1); GT_ISSUE(2); GT_ISSUE(3);
#pragma unroll 1
    for (int kc = 0; kc < GT_NK; ++kc) {
        if (kc + 3 < GT_NK) asm volatile("s_waitcnt vmcnt(9)" ::: "memory"); else if (kc + 2 < GT_NK) asm volatile("s_waitcnt vmcnt(6)" ::: "memory");
        else if (kc + 1 < GT_NK) asm volatile("s_waitcnt vmcnt(3)" ::: "memory"); else asm volatile("s_waitcnt vmcnt(0)" ::: "memory");
        __builtin_amdgcn_s_barrier(); asm volatile("" ::: "memory");
        if (kc + 4 < GT_NK) GT_ISSUE(kc + 4);
        const LAS unsigned char* sb = lds + (kc % GT_NS) * GT_STAGE;
        v4u xf[4], w0[4];
#pragma unroll
        for (int s = 0; s < 4; ++s) { xf[s] = *(const LAS v4u*)(sb + offX + (((2 * s + hi) ^ kyX) * 16)); w0[s] = *(const LAS v4u*)(sb + offW + (((2 * s + hi) ^ kyW) * 16)); }
        __builtin_amdgcn_sched_barrier(0);
#pragma unroll
        for (int s = 0; s < 4; ++s) acc0 = MFMA32(w0[s], xf[s], acc0);
        asm volatile("s_waitcnt lgkmcnt(0)" ::: "memory");
    }
#undef GT_ISSUE
    __syncthreads();
    { LAS unsigned char* orow = lds + rX * 256 + 8 * hi;
#pragma unroll
      for (int q = 0; q < 4; ++q) *(LAS v2u*)(orow + (((4 * wn + q) ^ (rX & 15)) * 16)) = (v2u){cvtpk(acc0[4 * q], acc0[4 * q + 1]), cvtpk(acc0[4 * q + 2], acc0[4 * q + 3])}; }
    __syncthreads();
    { const int t_ = wid * 64 + lane; bf16* ob = F.PROJ + (size_t)R0 * NP + C0;
#pragma unroll
      for (int i = 0; i < 2; ++i) { const int pc = t_ + 512 * i, r_ = pc >> 4, c_ = pc & 15;
          *(GAS v4u*)(ob + (size_t)r_ * NP + c_ * 8) = *(const LAS v4u*)(lds + r_ * 256 + ((c_ ^ (r_ & 15)) * 16)); } }
    __syncthreads();
}
struct Args { const float* in[21]; float* out; unsigned char* ws; int ph_lo, ph_hi; };
__global__ void __launch_bounds__(NWAVES * 64, 2) hymba_fwd(Args args) {
    extern __shared__ __attribute__((aligned(16))) unsigned char lds[];
    Frame F;
    F.lds = (LAS unsigned char*)lds;
    F.MISC = (volatile LAS unsigned*)(F.lds + MISC_OFF);
    F.wave = __builtin_amdgcn_readfirstlane((int)threadIdx.x >> 6); F.lane = mk_lane(); F.tid = F.wave * 64 + F.lane;
    F.G = gridDim.x; { const int bx = blockIdx.x; F.vcu = (F.G % 8 == 0) ? (bx % 8) * (F.G / 8) + bx / 8 : bx; }
    unsigned char* ws = args.ws;
    F.ctl = (gu32*)(ws + WS_CTL);
    F.x = args.in[0]; F.norm_g = args.in[1]; F.w_in = args.in[2]; F.shift_mu = args.in[3]; F.w0 = args.in[4]; F.w_decay_up = args.in[5]; F.a0 = args.in[6]; F.w_iclr_up = args.in[7];
    F.k_k = args.in[8]; F.k_a = args.in[9]; F.r_k = args.in[10]; F.ln_w = args.in[11]; F.ln_b = args.in[12]; F.qn_g = args.in[13]; F.kn_g = args.in[14];
    F.lq1 = args.in[15]; F.lk1 = args.in[16]; F.lq2 = args.in[17]; F.lk2 = args.in[18]; F.subln_g = args.in[19]; F.w_out = args.in[20]; F.out = args.out;
    F.WinT = (bf16*)(ws + WS_WIN); F.WoutT = (bf16*)(ws + WS_WOUT); F.WdT = (bf16*)(ws + WS_WD); F.WaT = (bf16*)(ws + WS_WA);
    F.XN = (bf16*)(ws + WS_XN); F.PROJ = (bf16*)(ws + WS_PROJ); F.MIX = (bf16*)(ws + WS_MIX);
    for (int u = F.tid; u < (LDS_BYTES - LDSCTL_OFF) / 4; u += NWAVES * 64) ((LAS unsigned*)(F.lds + LDSCTL_OFF))[u] = 0u;
    __syncthreads();
    XcdBarrier bar; bar.bar = (unsigned*)(F.ctl + CW_BAR); bar.x = 0; bar.st = nullptr; bar.wave = F.wave;
    if (MK_N_LAUNCHES == 1) bar = xcd_barrier_post((unsigned*)(F.ctl + CW_BAR), F.MISC + 8, F.wave);
#define GRID_BAR() do { if (MK_N_LAUNCHES == 1) xcd_barrier(bar); } while (0)
    const int lo = args.ph_lo, hi = args.ph_hi;
#define IN(k) (lo <= (k) && (k) < hi)
#define BOTH(k) (IN(k) && IN((k) + 1))
#ifndef SKIP
#define SKIP 0
#endif
    if (IN(0) && !(SKIP & 1)) { p0_prologue(F); if (DBL & 1) { GRID_BAR(); p0_prologue(F); } if (BOTH(0)) GRID_BAR(); }
    if (IN(1) && !(SKIP & 2)) {
        pg8::Gemm g{F.XN, F.WinT, M, 4096, D}; pg8::StaticOrder S; S.init(M, 4096, F.G, (int)blockIdx.x);
        pg8::EpiBf16S E{F.PROJ, NP};
        pg8::gemm_phase<pg8::EpiBf16S, pg8::StaticOrder, true, true>(F.lds + RING_OFF, g, S, E, F.wave);
#pragma unroll 1
        for (int qu = (int)blockIdx.x; qu < 256; qu += F.G) gemm1_tail_unit(F, qu);
#ifdef TAILX2
#pragma unroll 1
        for (int rep = 0; rep < TAILX2; ++rep) {
#pragma unroll 1
        for (int qu = (int)blockIdx.x; qu < 256; qu += F.G) gemm1_tail_unit(F, qu); }
#endif
        if (DBL & 2) { GRID_BAR(); pg8::gemm_phase<pg8::EpiBf16S, pg8::StaticOrder, true, true>(F.lds + RING_OFF, g, S, E, F.wave); }
        if (BOTH(1)) GRID_BAR();
    }
    RwDump Dm; { unsigned char* so = (unsigned char*)args.out; Dm.PF = (v4u*)so; Dm.DD = (v4u*)(so + 32 * MiB); Dm.QF = (v4u*)(ws + WS_XN); Dm.YD = (v4u*)(ws + WS_XN + 16 * MiB);
        Dm.GAM = (float*)(ws + WS_END); Dm.RHO = (float*)(ws + WS_END + 1 * MiB); }
    if (IN(2) && !(SKIP & 4)) {
        LAS float* wscr = (LAS float*)(F.lds + LDSCTL_OFF + 1024) + F.wave * 64; int zpar = 0;
#pragma unroll 1
        for (int p = F.vcu; p < BATCH * (T / 32); p += F.G) { rwkvA_unit(F, Dm, (p >> 6) * RH + F.wave, p & 63, wscr, F.lds + RING_OFF + F.wave * 16384, (LAS v4u*)(F.lds + LDSCTL_OFF + 4096), zpar); zpar ^= 1; }
        if (DBL & 4) { GRID_BAR();
#pragma unroll 1
            for (int p = F.vcu; p < BATCH * (T / 32); p += F.G) { rwkvA_unit(F, Dm, (p >> 6) * RH + F.wave, p & 63, wscr, F.lds + RING_OFF + F.wave * 16384, (LAS v4u*)(F.lds + LDSCTL_OFF + 4096), zpar); zpar ^= 1; } }
        p2_qknorm(F);
        if (BOTH(2)) GRID_BAR();
    }
    if (IN(3) && !(SKIP & 8)) {
#ifdef P3SPLIT
        p3_queue<1>(F, Dm); GRID_BAR(); p3_queue<2>(F, Dm, CW_QUEUE + 1024);
#else
        p3_queue(F, Dm);
#endif
        if (DBL & 512) { GRID_BAR(); p3_queue(F, Dm, CW_QUEUE + 1024); }
        if (BOTH(3) && !(MK_N_LAUNCHES == 1 && F.G == 256)) GRID_BAR();
    }
    if (IN(4) && !(SKIP & 16)) {
        pg8::Gemm g{F.MIX, F.WoutT, M, D, D}; pg8::StaticOrder S; S.init(M, D, F.G, (int)blockIdx.x);
        pg8::EpiResF32 E{F.x, F.out, D};
        if (MK_N_LAUNCHES == 1 && F.G == 256 && BOTH(3)) {
            pg8::f32x4 acc2[2][2][4][2]; pg8::Unit u2; S.next(0, u2);
            const int l2_ = mk_lane(), wid2_ = F.wave;
            xcd_barrier(bar, [&]() { E.init(acc2, u2, wid2_ >> 2, wid2_ & 3, l2_ & 15, l2_ >> 4); });
            pg8::gemm_phase<pg8::EpiResF32, pg8::StaticOrder, false, true, true>(F.lds + RING_OFF, g, S, E, F.wave, acc2);
        } else
        pg8::gemm_phase<pg8::EpiResF32, pg8::StaticOrder, false, true>(F.lds + RING_OFF, g, S, E, F.wave);
        if (DBL & 16) { GRID_BAR(); pg8::gemm_phase<pg8::EpiResF32, pg8::StaticOrder, false, true>(F.lds + RING_OFF, g, S, E, F.wave); }
    }
#undef IN
#undef BOTH
}

extern "C" void kernel_launch(void* const* d_in, const int* in_sizes, int n_in, void* d_out, int out_size, void* d_ws, size_t ws_size, hipStream_t stream) {
    static int grid = 0;
    if (grid == 0) {
        if (n_in != 21 || in_sizes[0] != M * D || out_size != M * D || ws_size < WS_END + 2 * MiB) { fprintf(stderr, "kernel_launch: unexpected shapes (n_in %d, in0 %d, out %d, ws %zu); nothing launched\n", n_in, n_in > 0 ? in_sizes[0] : -1, out_size, ws_size); grid = -1; return; }
        int dev = 0, cus = 0, per_cu = 0;
        if (hipGetDevice(&dev) != hipSuccess || hipDeviceGetAttribute(&cus, hipDeviceAttributeMultiprocessorCount, dev) != hipSuccess) { grid = -1; return; }
        if (hipFuncSetAttribute((const void*)hymba_fwd, hipFuncAttributeMaxDynamicSharedMemorySize, LDS_BYTES) != hipSuccess) { fprintf(stderr, "kernel_launch: hipFuncSetAttribute failed\n"); grid = -1; return; }
        if (hipOccupancyMaxActiveBlocksPerMultiprocessor(&per_cu, (const void*)hymba_fwd, NWAVES * 64, LDS_BYTES) != hipSuccess || per_cu < 1) { fprintf(stderr, "kernel_launch: occupancy query reports %d workgroups per CU; nothing launched\n", per_cu); grid = -1; return; }
        (void)hipGetLastError();
        grid = cus;
        if (grid > 256) grid = 256;
    }
    if (grid < 0) return;
    if (hipMemsetAsync((char*)d_ws + WS_CTL, 0, CTL_ZERO_BYTES, stream) != hipSuccess) { fprintf(stderr, "kernel_launch: hipMemsetAsync failed\n"); return; }
    Args a{};
    for (int i = 0; i < 21; ++i) a.in[i] = (const float*)d_in[i];
    a.out = (float*)d_out; a.ws = (unsigned char*)d_ws;
    for (int li = 0; li < MK_N_LAUNCHES; ++li) {
        a.ph_lo = (MK_N_LAUNCHES == 1) ? 0 : li; a.ph_hi = (MK_N_LAUNCHES == 1) ? N_PHASES : li + 1;
        hipLaunchKernelGGL(hymba_fwd, dim3(grid), dim3(NWAVES * 64), LDS_BYTES, stream, a);
        const hipError_t le = hipPeekAtLastError();
        if (le != hipSuccess) { fprintf(stderr, "kernel_launch: launch %d failed: %s\n", li, hipGetErrorName(le)); break; }
    }
}
```
